# Optimizing an MI355X kernel written in HIP

```python
import math
import jax
import jax.numpy as jnp
from jax import lax
import numpy as np

D_MODEL = 1024
BATCH = 2
SEQ = 16384
DEPTH = 2

GRID_W = 64
CTX_LEN = 256
N_MIX_GROUPS = 4
D_GROUP = D_MODEL // N_MIX_GROUPS
D_MIX = N_MIX_GROUPS * D_GROUP
A_HEADS = 4
A_QK = 32
A_V = D_GROUP // A_HEADS
Q_BLOCK = 128
ROPE_BASE = 10000.0
B_HEADS = 4
B_DIM = D_GROUP // B_HEADS
WIN_R = 8
WIN_C = 16
POOL_SIZES = (2, 4, 8, 16)
POOL_CH = D_GROUP // len(POOL_SIZES)
HY_CH = D_GROUP
HY_ORDER = 2
HY_SHORT = 3
HY_BANDS = 16
HY_EMB = 1 + 2 * HY_BANDS
HY_HIDDEN = 64
HY_SIN_FREQ = 1.0
HY_MIN_DECAY = math.log(1e-2) / 1.5
HY_MAX_DECAY = math.log(1e-2) / 0.3
D_IN = 2 * A_HEADS * 2 * A_QK + A_HEADS * A_V + 3 * B_HEADS * B_DIM + D_GROUP + (HY_ORDER + 1) * HY_CH
N_EXPERTS = 16
N_EXPERT_GROUPS = 4
TOPK_GROUPS = 1
TOP_K = 2
D_EXPERT = 512
EPS = 1e-6

kernel_name = 'hybrid_diffusion_parallel_heads_moe'

F32 = jnp.float32


def rmsnorm(x, g):
    xf = x.astype(F32)
    return (xf * lax.rsqrt(jnp.mean(xf * xf, axis=-1, keepdims=True) + EPS)).astype(x.dtype) * g


def split_cols(u):
    sizes = (A_HEADS * 2 * A_QK, A_HEADS * 2 * A_QK, A_HEADS * A_V,
             B_HEADS * B_DIM, B_HEADS * B_DIM, B_HEADS * B_DIM,
             D_GROUP, (HY_ORDER + 1) * HY_CH)
    offs, acc = [], 0
    for s in sizes[:-1]:
        acc += s
        offs.append(acc)
    return jnp.split(u, offs, axis=-1)


def axial_rope(x):
    L, dim = x.shape[1], x.shape[-1]
    n_freq = dim // 4
    inv = ROPE_BASE ** (-jnp.arange(n_freq, dtype=F32) / n_freq)
    t = jnp.arange(L)
    row = (t // GRID_W).astype(F32)
    col = (t % GRID_W).astype(F32)
    ang = jnp.concatenate([row[:, None] * inv, col[:, None] * inv], axis=-1)
    shape = (1, L) + (1,) * (x.ndim - 3) + (dim // 2,)
    cos, sin = jnp.cos(ang).reshape(shape), jnp.sin(ang).reshape(shape)
    x1, x2 = x[..., : dim // 2].astype(F32), x[..., dim // 2:].astype(F32)
    return jnp.concatenate([x1 * cos - x2 * sin, x2 * cos + x1 * sin], axis=-1).astype(x.dtype)


def diff_attention(uq_c, uk_c, uv_c, uq_l, uk_l, uv_l, lam_vecs, subln_g, li, need_ctx):
    B, S = uq_l.shape[:2]
    C = uq_c.shape[1]
    lam_init = 0.8 - 0.6 * math.exp(-0.3 * li)
    lv = lam_vecs.astype(F32)
    lam = jnp.exp(jnp.sum(lv[0] * lv[1])) - jnp.exp(jnp.sum(lv[2] * lv[3])) + lam_init
    qc = uq_c.reshape(B, C, A_HEADS, 2, A_QK)
    kc = uk_c.reshape(B, C, A_HEADS, 2, A_QK)
    vc = uv_c.reshape(B, C, A_HEADS, A_V)
    ql = axial_rope(uq_l.reshape(B, S, A_HEADS, 2, A_QK))
    kl = axial_rope(uk_l.reshape(B, S, A_HEADS, 2, A_QK))
    vl = uv_l.reshape(B, S, A_HEADS, A_V)
    k_all = jnp.concatenate([kc, kl], axis=1)
    v_all = jnp.concatenate([vc, vl], axis=1)

    def attend(q, k, v):
        s = jnp.einsum('bqhcd,bkhcd->bhcqk', q, k, preferred_element_type=F32) * (A_QK ** -0.5)
        p = jax.nn.softmax(s, axis=-1)
        a = p[:, :, 0] - lam * p[:, :, 1]
        return jnp.einsum('bhqk,bkhd->bqhd', a.astype(v.dtype), v)

    def post(o):
        o = rmsnorm(o, subln_g) * (1.0 - lam_init)
        return o.reshape(o.shape[0], o.shape[1], A_HEADS * A_V)

    nb = S // Q_BLOCK
    qb = jnp.moveaxis(ql.reshape(B, nb, Q_BLOCK, A_HEADS, 2, A_QK), 1, 0)
    ol = lax.map(lambda qblk: attend(qblk, k_all, v_all), qb)
    ol = jnp.moveaxis(ol, 0, 1).reshape(B, S, A_HEADS, A_V)
    out_c = post(attend(qc, kc, vc)) if need_ctx else None
    return out_c, post(ol)


def neighbourhood_attention(uq_c, uk_c, uv_c, uq_l, uk_l, uv_l, rpb, need_ctx):
    B, S = uq_l.shape[:2]
    C = uq_c.shape[1]
    R = S // GRID_W
    wr = min(WIN_R, R)
    scale = B_DIM ** -0.5
    qc = uq_c.reshape(B, C, B_HEADS, B_DIM)
    kc = uk_c.reshape(B, C, B_HEADS, B_DIM)
    vc = uv_c.reshape(B, C, B_HEADS, B_DIM)
    qg = uq_l.reshape(B, R, GRID_W, B_HEADS, B_DIM)
    kg = uk_l.reshape(B, R, GRID_W, B_HEADS, B_DIM)
    vg = uv_l.reshape(B, R, GRID_W, B_HEADS, B_DIM)
    rows = jnp.arange(R)
    r0 = jnp.clip(rows - wr // 2, 0, R - wr)
    row_idx = r0[:, None] + jnp.arange(wr)[None, :]
    k_rows = kg[:, row_idx]
    v_rows = vg[:, row_idx]
    cols = jnp.arange(GRID_W)
    c0 = jnp.clip(cols - WIN_C // 2, 0, GRID_W - WIN_C)
    in_win = (cols[None, :] >= c0[:, None]) & (cols[None, :] < c0[:, None] + WIN_C)
    dr = row_idx - rows[:, None]
    dc = jnp.clip(cols[None, :] - cols[:, None], -(WIN_C - 1), WIN_C - 1)
    bias = rpb.astype(F32)[:, dr[:, None, :, None] + (WIN_R - 1), dc[None, :, None, :] + (WIN_C - 1)]
    bias = jnp.where(in_win[:, None, :], bias, -jnp.inf)
    bias = jnp.transpose(bias, (1, 0, 2, 3, 4))[None]
    s_win = jnp.einsum('brqhd,brikhd->brhqik', qg, k_rows, preferred_element_type=F32) * scale + bias
    s_win = s_win.reshape(B, R, B_HEADS, GRID_W, wr * GRID_W)
    s_ctx = jnp.einsum('brqhd,bkhd->brhqk', qg, kc, preferred_element_type=F32) * scale
    p = jax.nn.softmax(jnp.concatenate([s_win, s_ctx], axis=-1), axis=-1)
    p_win = p[..., : wr * GRID_W].reshape(B, R, B_HEADS, GRID_W, wr, GRID_W).astype(vg.dtype)
    p_ctx = p[..., wr * GRID_W:].astype(vg.dtype)
    ol = jnp.einsum('brhqik,brikhd->brqhd', p_win, v_rows) + jnp.einsum('brhqk,bkhd->brqhd', p_ctx, vc)
    ol = ol.reshape(B, S, B_HEADS * B_DIM)
    out_c = None
    if need_ctx:
        pc = jax.nn.softmax(jnp.einsum('bqhd,bkhd->bhqk', qc, kc, preferred_element_type=F32) * scale, axis=-1)
        out_c = jnp.einsum('bhqk,bkhd->bqhd', pc.astype(vc.dtype), vc).reshape(B, C, B_HEADS * B_DIM)
    return out_c, ol


def pool_mix(u, w_pool, pool_scale):
    B, L, _ = u.shape
    uf = u.astype(F32)
    cs = jnp.concatenate([jnp.zeros((B, 1, D_GROUP), F32), lax.cumsum(uf, axis=1)], axis=1)
    t = jnp.arange(L)
    outs = []
    for g, w in enumerate(POOL_SIZES):
        lo = jnp.clip(t - w // 2, 0, L)
        hi = jnp.clip(t + w // 2, 0, L)
        sl = slice(g * POOL_CH, (g + 1) * POOL_CH)
        mean = (cs[:, hi, sl] - cs[:, lo, sl]) / (hi - lo).astype(F32)[None, :, None]
        outs.append((mean - uf[..., sl]).astype(u.dtype) @ w_pool[g])
    return jnp.concatenate(outs, axis=-1) * pool_scale


def hyena_filters(L, w1, b1, w2, b2, w3, b3):
    t = jnp.arange(L, dtype=F32)
    t_norm = t / max(L - 1, 1)
    bands = jnp.linspace(1e-4, HY_BANDS - 1, HY_BANDS, dtype=F32)
    ang = (2.0 * math.pi / L) * t[:, None] * bands[None, :]
    z = jnp.concatenate([t_norm[:, None], jnp.cos(ang), jnp.sin(ang)], axis=-1)
    h = jnp.sin(HY_SIN_FREQ * (z @ w1.astype(F32) + b1.astype(F32)))
    h = jnp.sin(HY_SIN_FREQ * (h @ w2.astype(F32) + b2.astype(F32)))
    h = (h @ w3.astype(F32) + b3.astype(F32)).reshape(L, HY_ORDER, 2, HY_CH)
    deltas = jnp.abs(jnp.linspace(HY_MIN_DECAY, HY_MAX_DECAY, HY_CH, dtype=F32))
    h = h * jnp.exp(-t_norm[:, None, None, None] * deltas)
    return h * lax.rsqrt(jnp.sum(h * h, axis=(0, 2), keepdims=True) + EPS)


def bidir_long_conv(u, h_fwd, h_bwd, d_skip):
    L = u.shape[1]
    k = jnp.concatenate([h_fwd, jnp.zeros_like(h_fwd[:1]), h_bwd[:0:-1]], axis=0)
    uf = u.astype(F32)
    y = jnp.fft.irfft(jnp.fft.rfft(uf, n=2 * L, axis=1) * jnp.fft.rfft(k, axis=0)[None], n=2 * L, axis=1)[:, :L]
    return (y + uf * d_skip.astype(F32)).astype(u.dtype)


def hyena_mix(u, w_short, b_short, filt, d_skip):
    up = jnp.pad(u, ((0, 0), (1, 1), (0, 0)))
    u = up[:, :-2] * w_short[0] + up[:, 1:-1] * w_short[1] + up[:, 2:] * w_short[2] + b_short
    x1, x2, v = jnp.split(u, 3, axis=-1)
    z = x1 * bidir_long_conv(v, filt[:, 0, 0], filt[:, 0, 1], d_skip[0])
    return x2 * bidir_long_conv(z, filt[:, 1, 0], filt[:, 1, 1], d_skip[1])


def moe(x, router_w, router_b, w1, w3, w2):
    N = x.shape[0]
    per_group = N_EXPERTS // N_EXPERT_GROUPS
    scores = jax.nn.softmax((x @ router_w).astype(F32), axis=-1)
    sel = scores + router_b.astype(F32)
    grp_score = jnp.sum(lax.top_k(sel.reshape(N, N_EXPERT_GROUPS, per_group), TOP_K)[0], axis=-1)
    _, gidx = lax.top_k(grp_score, TOPK_GROUPS)
    gmask = jnp.sum(jax.nn.one_hot(gidx, N_EXPERT_GROUPS, dtype=F32), axis=1)
    emask = jnp.repeat(gmask, per_group, axis=1) > 0
    _, eidx = lax.top_k(jnp.where(emask, sel, -jnp.inf), TOP_K)
    w = jnp.take_along_axis(scores, eidx, axis=1)
    w = w / jnp.sum(w, axis=-1, keepdims=True)
    gates = jnp.sum(jax.nn.one_hot(eidx, N_EXPERTS, dtype=F32) * w[..., None], axis=1).astype(x.dtype)
    out = jnp.zeros_like(x)
    for e in range(N_EXPERTS):
        h = jax.nn.silu(x @ w1[e]) * (x @ w3[e])
        out = out + gates[:, e:e + 1] * (h @ w2[e])
    return out


def trunk_layer(xc, xl, c, c_ctx, lp, router_w, router_b, li, need_ctx):
    B, S, D = xl.shape
    C = xc.shape[1]
    mod_l = jnp.split(jax.nn.silu(c) @ lp['ada_w'] + lp['ada_b'], 6, axis=-1)
    mod_c = jnp.split(jax.nn.silu(c_ctx) @ lp['ada_w'] + lp['ada_b'], 6, axis=-1)
    sh1_l, sc1_l, g1_l, sh2_l, sc2_l, g2_l = [m[:, None, :] for m in mod_l]
    sh1_c, sc1_c, g1_c, sh2_c, sc2_c, g2_c = mod_c
    hl = rmsnorm(xl, lp['norm1_g']) * (1.0 + sc1_l) + sh1_l
    hc = rmsnorm(xc, lp['norm1_g']) * (1.0 + sc1_c) + sh1_c
    aq_l, ak_l, av_l, bq_l, bk_l, bv_l, pool_l, hy_l = split_cols(hl @ lp['w_in'])
    aq_c, ak_c, av_c, bq_c, bk_c, bv_c, pool_c, hy_c = split_cols(hc @ lp['w_in'])
    a_c, a_l = diff_attention(aq_c, ak_c, av_c, aq_l, ak_l, av_l, lp['a_lambda'], lp['a_subln_g'], li, need_ctx)
    b_c, b_l = neighbourhood_attention(bq_c, bk_c, bv_c, bq_l, bk_l, bv_l, lp['b_rpb'], need_ctx)
    p_l = pool_mix(pool_l, lp['pool_w'], lp['pool_scale'])
    filt_l = hyena_filters(S, lp['hy_f_w1'], lp['hy_f_b1'], lp['hy_f_w2'], lp['hy_f_b2'], lp['hy_f_w3'], lp['hy_f_b3'])
    h_l = hyena_mix(hy_l, lp['hy_short_w'], lp['hy_short_b'], filt_l, lp['hy_skip'])
    xl = xl + g1_l * (jnp.concatenate([a_l, b_l, p_l, h_l], axis=-1) @ lp['w_out'])
    if need_ctx:
        p_c = pool_mix(pool_c, lp['pool_w'], lp['pool_scale'])
        filt_c = hyena_filters(C, lp['hy_f_w1'], lp['hy_f_b1'], lp['hy_f_w2'], lp['hy_f_b2'], lp['hy_f_w3'], lp['hy_f_b3'])
        h_c = hyena_mix(hy_c, lp['hy_short_w'], lp['hy_short_b'], filt_c, lp['hy_skip'])
        xc = xc + g1_c * (jnp.concatenate([a_c, b_c, p_c, h_c], axis=-1) @ lp['w_out'])
    hl2 = rmsnorm(xl, lp['norm2_g']) * (1.0 + sc2_l) + sh2_l
    if need_ctx:
        hc2 = rmsnorm(xc, lp['norm2_g']) * (1.0 + sc2_c) + sh2_c
        tok = jnp.concatenate([hc2, hl2], axis=1).reshape(B * (C + S), D)
        y = moe(tok, router_w, router_b, lp['moe_w1'], lp['moe_w3'], lp['moe_w2']).reshape(B, C + S, D)
        xc = xc + g2_c * y[:, :C]
        xl = xl + g2_l * y[:, C:]
    else:
        y = moe(hl2.reshape(B * S, D), router_w, router_b, lp['moe_w1'], lp['moe_w3'], lp['moe_w2'])
        xl = xl + g2_l * y.reshape(B, S, D)
    return xc, xl


def setup_inputs(seed: int = 0) -> dict:
    key = jax.random.key(seed)
    ks = iter(jax.random.split(key, 40))

    def nrm(shape, s):
        return s * jax.random.normal(next(ks), shape, F32)

    return {
        'x': nrm((BATCH, SEQ, D_MODEL), 1.0),
        'c': nrm((BATCH, D_MODEL), 1.0),
        'ctx': nrm((BATCH, CTX_LEN, D_MODEL), 1.0),
        'c_ctx': nrm((D_MODEL,), 1.0),
        'norm1_g': 1.0 + nrm((DEPTH, D_MODEL), 0.1),
        'norm2_g': 1.0 + nrm((DEPTH, D_MODEL), 0.1),
        'ada_w': nrm((DEPTH, D_MODEL, 6 * D_MODEL), 0.5 * D_MODEL ** -0.5),
        'ada_b': nrm((DEPTH, 6 * D_MODEL), 0.02),
        'w_in': nrm((DEPTH, D_MODEL, D_IN), D_MODEL ** -0.5),
        'w_out': nrm((DEPTH, D_MIX, D_MODEL), D_MIX ** -0.5),
        'a_lambda': nrm((DEPTH, 4, A_QK), 0.1),
        'a_subln_g': 1.0 + nrm((DEPTH, A_V), 0.1),
        'b_rpb': nrm((DEPTH, B_HEADS, 2 * WIN_R - 1, 2 * WIN_C - 1), 0.1),
        'pool_w': nrm((DEPTH, len(POOL_SIZES), POOL_CH, POOL_CH), POOL_CH ** -0.5),
        'pool_scale': 1.0 + nrm((DEPTH, D_GROUP), 0.1),
        'hy_short_w': nrm((DEPTH, HY_SHORT, (HY_ORDER + 1) * HY_CH), 0.5),
        'hy_short_b': nrm((DEPTH, (HY_ORDER + 1) * HY_CH), 0.02),
        'hy_f_w1': nrm((DEPTH, HY_EMB, HY_HIDDEN), HY_EMB ** -0.5),
        'hy_f_b1': nrm((DEPTH, HY_HIDDEN), 0.1),
        'hy_f_w2': nrm((DEPTH, HY_HIDDEN, HY_HIDDEN), HY_HIDDEN ** -0.5),
        'hy_f_b2': nrm((DEPTH, HY_HIDDEN), 0.1),
        'hy_f_w3': nrm((DEPTH, HY_HIDDEN, HY_ORDER * 2 * HY_CH), HY_HIDDEN ** -0.5),
        'hy_f_b3': nrm((DEPTH, HY_ORDER * 2 * HY_CH), 0.1),
        'hy_skip': nrm((DEPTH, HY_ORDER, HY_CH), 0.5),
        'router_w': nrm((D_MODEL, N_EXPERTS), D_MODEL ** -0.5),
        'router_b': nrm((N_EXPERTS,), 0.01),
        'moe_w1': nrm((DEPTH, N_EXPERTS, D_MODEL, D_EXPERT), D_MODEL ** -0.5),
        'moe_w3': nrm((DEPTH, N_EXPERTS, D_MODEL, D_EXPERT), D_MODEL ** -0.5),
        'moe_w2': nrm((DEPTH, N_EXPERTS, D_EXPERT, D_MODEL), D_EXPERT ** -0.5),
        'final_g': 1.0 + nrm((D_MODEL,), 0.1),
    }


def reference(x, c, ctx, c_ctx, norm1_g, norm2_g, ada_w, ada_b, w_in, w_out, a_lambda, a_subln_g,
              b_rpb, pool_w, pool_scale, hy_short_w, hy_short_b, hy_f_w1, hy_f_b1, hy_f_w2, hy_f_b2,
              hy_f_w3, hy_f_b3, hy_skip, router_w, router_b, moe_w1, moe_w3, moe_w2, final_g):
    xl, xc = x, ctx
    for li in range(DEPTH):
        lp = {
            'norm1_g': norm1_g[li], 'norm2_g': norm2_g[li], 'ada_w': ada_w[li], 'ada_b': ada_b[li],
            'w_in': w_in[li], 'w_out': w_out[li], 'a_lambda': a_lambda[li], 'a_subln_g': a_subln_g[li],
            'b_rpb': b_rpb[li], 'pool_w': pool_w[li], 'pool_scale': pool_scale[li],
            'hy_short_w': hy_short_w[li], 'hy_short_b': hy_short_b[li],
            'hy_f_w1': hy_f_w1[li], 'hy_f_b1': hy_f_b1[li], 'hy_f_w2': hy_f_w2[li], 'hy_f_b2': hy_f_b2[li],
            'hy_f_w3': hy_f_w3[li], 'hy_f_b3': hy_f_b3[li], 'hy_skip': hy_skip[li],
            'moe_w1': moe_w1[li], 'moe_w3': moe_w3[li], 'moe_w2': moe_w2[li],
        }
        xc, xl = trunk_layer(xc, xl, c, c_ctx, lp, router_w, router_b, li, need_ctx=(li < DEPTH - 1))
    return rmsnorm(xl, final_g)
```

```cpp
#include <hip/hip_runtime.h>
#include <stdint.h>
#include <stdio.h>

#ifndef N_LAUNCH_MODE
#define N_LAUNCH_MODE 0
#endif

#define DI __device__ __forceinline__
#define LAS __attribute__((address_space(3)))
typedef unsigned short bf16_t;
typedef short bf16x8 __attribute__((ext_vector_type(8)));
typedef short s16x4 __attribute__((ext_vector_type(4)));
typedef float f32x4 __attribute__((ext_vector_type(4)));
typedef float f32x2 __attribute__((ext_vector_type(2)));
typedef float f32x16 __attribute__((ext_vector_type(16)));
typedef unsigned u32x4 __attribute__((ext_vector_type(4)));
typedef unsigned u32x2 __attribute__((ext_vector_type(2)));

constexpr int D = 1024, NB = 2, S = 16384, CTX = 256, NLAT = NB * S, NCTX = NB * CTX, NTOK = NLAT + NCTX, DIN = 2560;
constexpr int NE = 16, DE = 512, GW = 64;
constexpr int NKEY = CTX + S;
constexpr int NTHR = 512;
constexpr int SLOT_CAP = 70656;
constexpr float EPS = 1e-6f;
constexpr float LOG2E = 1.4426950408889634f;
constexpr float QSCALE_A = 0.17677669529663687f * LOG2E;
constexpr float QSCALE_B = 0.125f * LOG2E;

enum { I_X = 0, I_C, I_CTX, I_CCTX, I_N1G, I_N2G, I_ADAW, I_ADAB, I_WIN, I_WOUT, I_ALAM, I_ASUB, I_RPB, I_POOLW, I_POOLS, I_HYSW, I_HYSB,
       I_HW1, I_HB1, I_HW2, I_HB2, I_HW3, I_HB3, I_HSKIP, I_RW, I_RB, I_MW1, I_MW3, I_MW2, I_FG, N_IN };

struct Args { const float* in[N_IN]; float* out; unsigned char* ws; int ph_lo, ph_hi; };

constexpr size_t al256(size_t x) { return (x + 255) & ~(size_t)255; }
constexpr size_t WS_CTL = 0, CTL_BYTES = 65536;
constexpr size_t WS_MOD = WS_CTL + CTL_BYTES;
constexpr size_t WS_ROPE = WS_MOD + al256(2 * 3 * 6144 * 4);
constexpr size_t WS_FPART = WS_ROPE + 16384;
constexpr size_t WS_FPARTC = WS_FPART + 256 * 1024 * 4;
constexpr size_t WS_XC = WS_FPARTC + 4 * 1024 * 4;
constexpr size_t WS_WIN = WS_XC + (size_t)NCTX * D * 4;
constexpr size_t WS_WOUT = WS_WIN + (size_t)2 * DIN * D * 2;
constexpr size_t WS_W13 = WS_WOUT + (size_t)2 * D * D * 2;
constexpr size_t WS_W2 = WS_W13 + (size_t)2 * NE * 1024 * 1024 * 2;
constexpr size_t WS_FILT = WS_W2 + (size_t)2 * NE * 1024 * 512 * 2;
constexpr size_t WS_FILTC = WS_FILT + (size_t)4 * 256 * S * 4;
constexpr size_t WS_ZBUF = WS_FILTC + (size_t)4 * 256 * 256 * 4;
constexpr size_t WS_R1 = WS_ZBUF + (size_t)256 * 2 * S * 4;
constexpr size_t WS_HBF = WS_R1;
constexpr size_t TOKB = (size_t)NTOK * 256 * 2;
constexpr size_t WS_AQ = WS_HBF + (size_t)NTOK * D * 2;
constexpr size_t WS_AK = WS_AQ + TOKB;
constexpr size_t WS_AVT = WS_AK + TOKB;
constexpr size_t WS_BQ = WS_AVT + (size_t)NB * 4 * 64 * NKEY * 2;
constexpr size_t WS_BK = WS_BQ + TOKB;
constexpr size_t WS_BV = WS_BK + TOKB;
constexpr size_t WS_PL = WS_BV + TOKB;
constexpr size_t WS_HYT = WS_PL + TOKB;
constexpr size_t WS_HYC = WS_HYT + (size_t)NB * 768 * S * 2;
constexpr size_t WS_END_MIX = WS_HYC + (size_t)NCTX * 768 * 2;
constexpr size_t WS_TOK = WS_AQ;
constexpr size_t WS_A1 = WS_TOK + al256((size_t)NTOK * 32);
constexpr size_t WS_HMID = WS_A1 + (size_t)SLOT_CAP * D * 2;
constexpr size_t WS_END_MOE = WS_HMID + (size_t)SLOT_CAP * DE * 2;
constexpr size_t WS_END = WS_END_MIX > WS_END_MOE ? WS_END_MIX : WS_END_MOE;

#define XB_TMO      128
#define XB_XCNT(j)  (256  + 64 * (j))
#define XB_XSUB(j)  (1280 + 64 * (j))
#define XB_XGEN(j)  (2304 + 64 * (j))
#define XB_TOP      3328
#define XB_TOPGEN   3392
#define XCD_BAR_WORDS 3456
#define XB_SPIN_CAP (1u << 18)
constexpr int CW_CNT = 4096;
constexpr int CW_KMAX = 4160;
constexpr int CW_QHEAD = 4224;

constexpr int LDS_MAIN = 131072, LDS_MISC = LDS_MAIN, LDS_BYTES = LDS_MAIN + 2048;

DI float bf2f(bf16_t v) { return __uint_as_float(((unsigned)v) << 16); }
DI bf16_t f2bf(float f) { unsigned u = __float_as_uint(f); u += 0x7FFFu + ((u >> 16) & 1u); return (bf16_t)(u >> 16); }
DI unsigned pk2(float lo, float hi) { unsigned r; asm volatile("v_cvt_pk_bf16_f32 %0, %1, %2" : "=v"(r) : "v"(lo), "v"(hi)); return r; }
DI float wave_sum(float v) { for (int o = 32; o > 0; o >>= 1) v += __shfl_xor(v, o); return v; }
DI float wave_max(float v) { for (int o = 32; o > 0; o >>= 1) v = fmaxf(v, __shfl_xor(v, o)); return v; }
DI float siluf(float x) { return x / (1.f + __expf(-x)); }
DI float sin_rev(float rev) { return __builtin_amdgcn_sinf(rev - floorf(rev)); }
DI float cos_rev(float rev) { return __builtin_amdgcn_cosf(rev - floorf(rev)); }
DI float sin_rad(float x) { return sin_rev(x * 0.15915494309189535f); }

DI unsigned xb_ld(unsigned* p)              { return __hip_atomic_load(p, __ATOMIC_RELAXED, __HIP_MEMORY_SCOPE_AGENT); }
DI unsigned xb_add(unsigned* p, unsigned v) { return __hip_atomic_fetch_add(p, v, __ATOMIC_RELAXED, __HIP_MEMORY_SCOPE_AGENT); }
DI unsigned xb_xcc_id() { return (unsigned)__builtin_amdgcn_s_getreg((3 << 11) | 20) & 0xFu; }
#define XB_SPIN(cond, bar) do { unsigned _sp = 0; while (cond) { __builtin_amdgcn_s_sleep(1); \
    if ((++_sp & 255u) == 0u) { if (xb_ld(&(bar)[XB_TMO])) break; if (_sp > XB_SPIN_CAP) { atomicAdd(&(bar)[XB_TMO], 1u); break; } } } } while (0)
struct XcdBarrier { unsigned* bar; unsigned x; volatile LAS unsigned* st; };
DI XcdBarrier xcd_barrier_post(unsigned* bar, volatile LAS unsigned* st) {
    XcdBarrier b; b.bar = bar; b.x = xb_xcc_id(); b.st = st;
    if (threadIdx.x == 0) (void)xb_add(&bar[XB_XCNT(b.x)], 1u);
    return b;
}
DI void xcd_barrier_complete(unsigned* bar, unsigned x, unsigned& nloc, unsigned& nx) {
    const unsigned G = gridDim.x * gridDim.y * gridDim.z;
    unsigned sum, cnt, mine, sp = 0u;
    for (;;) {
        sum = 0u; cnt = 0u; mine = 0u;
#pragma unroll
        for (unsigned j = 0; j < 16; ++j) { const unsigned c = xb_ld(&bar[XB_XCNT(j)]); sum += c; cnt += (c > 0u) ? 1u : 0u; mine = (j == x) ? c : mine; }
        if (sum == G) break;
        __builtin_amdgcn_s_sleep(1);
        if ((++sp & 255u) == 0u) { if (xb_ld(&bar[XB_TMO])) break; if (sp > XB_SPIN_CAP) { atomicAdd(&bar[XB_TMO], 1u); break; } }
    }
    nloc = mine > 0u ? mine : 1u; nx = cnt > 0u ? cnt : 1u;
}
DI void xcd_barrier(const XcdBarrier& b) {
    asm volatile("s_waitcnt vmcnt(0)" ::: "memory");
    __syncthreads();
    if (threadIdx.x == 0) {
        unsigned* bar = b.bar;
        __builtin_amdgcn_s_waitcnt(0);
        unsigned nloc = b.st[0], nx = b.st[1];
        if (nloc == 0u) { xcd_barrier_complete(bar, b.x, nloc, nx); b.st[0] = nloc; b.st[1] = nx; }
        const unsigned old = xb_add(&bar[XB_XSUB(b.x)], 1u);
        const unsigned gen = old / nloc;
        if (old + 1u == (gen + 1u) * nloc) {
            __builtin_amdgcn_fence(__ATOMIC_RELEASE, "agent");
            asm volatile("s_waitcnt vmcnt(0)" ::: "memory");
            const unsigned og = xb_add(&bar[XB_TOP], 1u);
            const unsigned tg = og / nx;
            if (og + 1u == (tg + 1u) * nx) xb_add(&bar[XB_TOPGEN], 1u);
            else XB_SPIN(xb_ld(&bar[XB_TOPGEN]) == tg, bar);
            __builtin_amdgcn_fence(__ATOMIC_ACQUIRE, "agent");
            xb_add(&bar[XB_XGEN(b.x)], 1u);
            asm volatile("s_waitcnt vmcnt(0)" ::: "memory");
        } else {
            XB_SPIN(xb_ld(&bar[XB_XGEN(b.x)]) == gen, bar);
            __builtin_amdgcn_fence(__ATOMIC_ACQUIRE, "agent");
            asm volatile("s_waitcnt vmcnt(0)" ::: "memory");
        }
    }
    __syncthreads();
}

struct Frame {
    const float* const* in; float* out; unsigned char* ws; unsigned* ctl;
    unsigned char* lds;
    int tid, lane, wave, G, bid;
};
#define WSP(T, off) ((T*)(F.ws + (off)))
DI void refresh(Frame& F) { int t = threadIdx.x; asm volatile("" : "+v"(t)); F.tid = t; F.lane = t & 63; F.wave = __builtin_amdgcn_readfirstlane(t >> 6);
}

namespace pg8 {
constexpr int BM = 256, BK = 64, HALF = 128, HTB = HALF * BK * 2, STAGE_BYTES = 8 * HTB, NXCD = 8, WGM = 8;
DI int lds_byte(int r, int c) { const int st = (r >> 4) * 2 + (c >> 5), rr = r & 15, cc = c & 31, ob = rr * 64 + cc * 2; return st * 1024 + (ob ^ (((ob >> 9) & 1) << 5)); }
DI void stage_rc(int b, int& R, int& C) { const int st = b / 1024, sb = b % 1024, swz = sb ^ (((sb >> 9) & 1) << 5); R = (st >> 1) * 16 + swz / 64; C = (st & 1) * 32 + (swz % 64) / 2; }
struct Unit { int pm, pn, e; };
struct Gemm { const bf16_t* A; const bf16_t* Bt; int K; size_t bstride; };
struct StaticOrder {
    int nM, nN, nwg, G, c;
    DI void init(int M, int N, int G_, int c_) { nM = M / BM; nN = N / BM; nwg = nM * nN; G = G_; c = c_; }
    DI bool next(int i, Unit& u) const {
        const long L = (long)i * G + c; if (L >= nwg) return false;
        int wgid = (int)L; { const int q = nwg / NXCD, r = nwg % NXCD, xcd = wgid % NXCD, off = wgid / NXCD; wgid = (xcd < r ? xcd * (q + 1) : r * (q + 1) + (xcd - r) * q) + off; }
        const int nig = WGM * nN, gid = wgid / nig, fm = gid * WGM, gsz = (nM - fm) < WGM ? (nM - fm) : WGM;
        u.pm = fm + ((wgid % nig) % gsz); u.pn = (wgid % nig) / gsz; u.e = 0; return true;
    }
};
struct MoeOrder {
    const int* toff; int ntile, nN, G, c;
    DI bool next(int i, Unit& u) const {
        const long L = (long)i * G + c; if (L >= (long)ntile * nN) return false;
        const int t = (int)(L / nN); u.pm = t; u.pn = (int)(L % nN);
        u.e = toff[t]; return true;
    }
};

template <class Epi, class Sched>
DI void gemm_phase(LAS unsigned char* lds, const Gemm g, const Sched& S, const Epi& E, int tid) {
    const int wid = __builtin_amdgcn_readfirstlane(tid >> 6), lane = tid & 63, wr = wid >> 2, wc = wid & 3, fr = lane & 15, fq = lane >> 4;
    const int K = g.K, nt = K / BK;
    unsigned voffA[2];
#pragma unroll
    for (int i = 0; i < 2; ++i) { int R, C; stage_rc(tid * 16 + i * 8192, R, C); voffA[i] = (unsigned)(R * K + C) * 2u; }
    const size_t kstep = (size_t)(BK * 2);
    const size_t hstep = (size_t)HALF * K * 2;
    const size_t tstep = 2 * hstep;
    const unsigned ldsw = (unsigned)wid * 1024u;
    const int aoff = lds_byte(wr * 64 + fr, fq * 8), boff = lds_byte(wc * 32 + fr, fq * 8);
#define PG8_SA(b, h) (((b) * 2 + (h)) * HTB)
#define PG8_SB(b, h) ((4 + (b) * 2 + (h)) * HTB)
#define PG8_STAGE(bufoff, gbase, voff) do { _Pragma("unroll") for (int _i = 0; _i < 2; ++_i) \
        __builtin_amdgcn_global_load_lds((const unsigned*)((const char*)(gbase) + (voff)[_i]), (LAS unsigned*)(lds + (bufoff) + ldsw + _i * 8192), 16, 0, 0); } while (0)
#define PG8_LDA(dst, b, h) do { _Pragma("unroll") for (int m = 0; m < 4; ++m) _Pragma("unroll") for (int k = 0; k < 2; ++k) dst[m][k] = *(const LAS bf16x8*)(lds + PG8_SA(b, h) + aoff + m * 2048 + k * 1024); } while (0)
#define PG8_LDB(dst, b, h) do { _Pragma("unroll") for (int n = 0; n < 2; ++n) _Pragma("unroll") for (int k = 0; k < 2; ++k) dst[n][k] = *(const LAS bf16x8*)(lds + PG8_SB(b, h) + boff + n * 2048 + k * 1024); } while (0)
#define PG8_MMA(ai, bj, At, Bt) do { __builtin_amdgcn_s_setprio(1); _Pragma("unroll") for (int m = 0; m < 4; ++m) _Pragma("unroll") for (int n = 0; n < 2; ++n) _Pragma("unroll") for (int k = 0; k < 2; ++k) \
        acc[ai][bj][m][n] = __builtin_amdgcn_mfma_f32_16x16x32_bf16(Bt[n][k], At[m][k], acc[ai][bj][m][n], 0, 0, 0); __builtin_amdgcn_s_setprio(0); } while (0)
#define PG8_WAIT_V(n) asm volatile("s_waitcnt vmcnt(" #n ")" ::: "memory")
#define PG8_WAIT_L(n) asm volatile("s_waitcnt lgkmcnt(" #n ")" ::: "memory")
#define PG8_BAR __builtin_amdgcn_s_barrier()
#define PG8_SCHED __builtin_amdgcn_sched_barrier(0)
    Unit cur, nxt; int ui = 0;
    if (!S.next(0, cur)) return;
    f32x4 acc[2][2][4][2];
#pragma unroll
    for (int a = 0; a < 2; ++a)
#pragma unroll
        for (int b = 0; b < 2; ++b)
#pragma unroll
            for (int m = 0; m < 4; ++m)
#pragma unroll
                for (int n = 0; n < 2; ++n) acc[a][b][m][n] = (f32x4){0.f, 0.f, 0.f, 0.f};
    bf16x8 At[4][2], B0[2][2], B1[2][2];
    const char* cA = (const char*)g.A + (size_t)cur.pm * tstep; const char* cB = (const char*)(g.Bt + (size_t)cur.e * g.bstride) + (size_t)cur.pn * tstep;
    PG8_STAGE(PG8_SB(0, 0), cB, voffA); PG8_STAGE(PG8_SA(0, 0), cA, voffA); PG8_STAGE(PG8_SB(0, 1), cB + hstep, voffA); PG8_STAGE(PG8_SA(0, 1), cA + hstep, voffA);
    if (wr == 1) PG8_BAR;
    PG8_WAIT_V(4); PG8_BAR;
    PG8_STAGE(PG8_SB(1, 0), cB + kstep, voffA); PG8_STAGE(PG8_SA(1, 0), cA + kstep, voffA); PG8_STAGE(PG8_SB(1, 1), cB + hstep + kstep, voffA);
    PG8_WAIT_V(6); PG8_BAR;
    for (;;) {
        const bool has_next = S.next(ui + 1, nxt);
        const char* nA = has_next ? (const char*)g.A + (size_t)nxt.pm * tstep : cA; const char* nB = has_next ? (const char*)(g.Bt + (size_t)nxt.e * g.bstride) + (size_t)nxt.pn * tstep : cB;
        for (int t = 0; t < nt; t += 2) {
            const bool last = (t == nt - 2);
            const char* a1 = cA + (size_t)(t + 1) * kstep;
            const char* a2 = last ? nA : cA + (size_t)(t + 2) * kstep; const char* b2 = last ? nB : cB + (size_t)(t + 2) * kstep;
            const char* a3 = a2 + kstep; const char* b3 = b2 + kstep;
            PG8_LDB(B0, 0, 0); PG8_SCHED; PG8_LDA(At, 0, 0); PG8_STAGE(PG8_SA(1, 1), a1 + hstep, voffA);
            PG8_WAIT_L(8); PG8_BAR; PG8_WAIT_L(0); PG8_MMA(0, 0, At, B0); PG8_BAR; PG8_SCHED;
            PG8_LDB(B1, 0, 1); PG8_STAGE(PG8_SB(0, 0), b2, voffA);
            PG8_BAR; PG8_WAIT_L(0); PG8_MMA(0, 1, At, B1); PG8_BAR;
            PG8_LDA(At, 0, 1); PG8_STAGE(PG8_SA(0, 0), a2, voffA);
            PG8_BAR; PG8_WAIT_L(0); PG8_MMA(1, 0, At, B0); PG8_BAR; PG8_SCHED;
            PG8_STAGE(PG8_SB(0, 1), b2 + hstep, voffA);
            PG8_WAIT_V(6); PG8_BAR; PG8_MMA(1, 1, At, B1); PG8_BAR;
            PG8_LDB(B0, 1, 0); PG8_SCHED; PG8_LDA(At, 1, 0); PG8_STAGE(PG8_SA(0, 1), a2 + hstep, voffA);
            PG8_WAIT_L(8); PG8_BAR; PG8_WAIT_L(0); PG8_MMA(0, 0, At, B0); PG8_BAR; PG8_SCHED;
            PG8_LDB(B1, 1, 1); PG8_STAGE(PG8_SB(1, 0), b3, voffA);
            PG8_BAR; PG8_WAIT_L(0); PG8_MMA(0, 1, At, B1); PG8_BAR;
            PG8_LDA(At, 1, 1); PG8_STAGE(PG8_SA(1, 0), a3, voffA);
            PG8_BAR; PG8_WAIT_L(0); PG8_MMA(1, 0, At, B0); PG8_BAR; PG8_SCHED;
            PG8_STAGE(PG8_SB(1, 1), b3 + hstep, voffA);
            PG8_WAIT_V(6); PG8_BAR; PG8_MMA(1, 1, At, B1); PG8_BAR;
        }
        E(acc, cur, wr, wc, fr, fq);
        if (!has_next) break;
#pragma unroll
        for (int a = 0; a < 2; ++a)
#pragma unroll
            for (int b = 0; b < 2; ++b)
#pragma unroll
                for (int m = 0; m < 4; ++m)
#pragma unroll
                    for (int n = 0; n < 2; ++n) acc[a][b][m][n] = (f32x4){0.f, 0.f, 0.f, 0.f};
        cur = nxt; cA = nA; cB = nB; ++ui;
    }
    PG8_WAIT_V(0);
    if (wr == 0) PG8_BAR;
    PG8_BAR;
#undef PG8_SA
#undef PG8_SB
#undef PG8_STAGE
#undef PG8_LDA
#undef PG8_LDB
#undef PG8_MMA
#undef PG8_WAIT_V
#undef PG8_WAIT_L
#undef PG8_BAR
#undef PG8_SCHED
}
}

typedef f32x4 AccT[2][2][4][2];

struct EpiIn {
    unsigned char* ws; const float* rope; unsigned* kmax;
    DI void operator()(const AccT& acc, const pg8::Unit& u, int wr, int wc, int fr, int fq) const {
        const int pn = u.pn, row0 = u.pm * 256 + wr * 64 + fr;
        const bool isctx = (u.pm >= NLAT / 256);
        if (pn <= 1) {
            bf16_t* dst = (bf16_t*)(ws + (pn == 0 ? WS_AQ : WS_AK));
            const float sc = (pn == 0) ? QSCALE_A : 1.f;
            float nmax[2] = {0.f, 0.f};
#pragma unroll
            for (int ai = 0; ai < 2; ++ai)
#pragma unroll
                for (int m = 0; m < 4; ++m) {
                    const int r = row0 + ai * 128 + m * 16;
                    f32x4 cs0 = (f32x4){1.f, 0.f, 1.f, 0.f}, cs1 = cs0;
                    if (!isctx) { const int t = r & (S - 1); const int pos = (fq < 2) ? (t >> 6) : (t & 63);
                        const f32x4* tp = (const f32x4*)(rope + (size_t)pos * 16 + (fq & 1) * 8); cs0 = tp[0]; cs1 = tp[1]; }
                    const float cc[4] = {cs0[0], cs0[2], cs1[0], cs1[2]}, ss[4] = {cs0[1], cs0[3], cs1[1], cs1[3]};
#pragma unroll
                    for (int bj = 0; bj < 2; ++bj) {
                        const f32x4 x1 = acc[ai][bj][m][0], x2 = acc[ai][bj][m][1];
                        float o1[4], o2[4], n2 = 0.f;
#pragma unroll
                        for (int j = 0; j < 4; ++j) { o1[j] = (x1[j] * cc[j] - x2[j] * ss[j]) * sc; o2[j] = (x2[j] * cc[j] + x1[j] * ss[j]) * sc; n2 += x1[j] * x1[j] + x2[j] * x2[j]; }
                        bf16_t* p = dst + (size_t)r * 256 + bj * 128 + wc * 32 + 4 * fq;
                        *(u32x2*)p = (u32x2){pk2(o1[0], o1[1]), pk2(o1[2], o1[3])};
                        *(u32x2*)(p + 16) = (u32x2){pk2(o2[0], o2[1]), pk2(o2[2], o2[3])};
                        if (pn == 1) { n2 += __shfl_xor(n2, 16); n2 += __shfl_xor(n2, 32); nmax[bj] = fmaxf(nmax[bj], n2); }
                    }
                }
            if (pn == 1) {
                const int b = isctx ? (u.pm - NLAT / 256) : (u.pm / (S / 256));
#pragma unroll
                for (int bj = 0; bj < 2; ++bj) {
                    float v = nmax[bj];
                    v = fmaxf(v, __shfl_xor(v, 1)); v = fmaxf(v, __shfl_xor(v, 2)); v = fmaxf(v, __shfl_xor(v, 4)); v = fmaxf(v, __shfl_xor(v, 8));
                    if ((fr | fq) == 0) atomicMax(kmax + (b * 4 + (2 * bj + (wc >> 1))) * 2 + (wc & 1), __float_as_uint(v));
                }
            }
        } else if (pn == 2) {
            bf16_t* dst = (bf16_t*)(ws + WS_AVT);
#pragma unroll
            for (int ai = 0; ai < 2; ++ai)
#pragma unroll
                for (int m = 0; m < 4; ++m) {
                    const int r = row0 + ai * 128 + m * 16;
                    int b, key; if (isctx) { b = (r - NLAT) >> 8; key = (r - NLAT) & 255; } else { b = r >> 14; key = CTX + (r & (S - 1)); }
#pragma unroll
                    for (int bj = 0; bj < 2; ++bj)
#pragma unroll
                        for (int n = 0; n < 2; ++n) {
                            const int lc = bj * 128 + wc * 32 + n * 16 + 4 * fq;
#pragma unroll
                            for (int j = 0; j < 4; ++j) dst[((size_t)(b * 256 + lc + j)) * NKEY + key] = f2bf(acc[ai][bj][m][n][j]);
                        }
                }
        } else if (pn <= 6) {
            bf16_t* dst = (bf16_t*)(ws + (pn == 3 ? WS_BQ : pn == 4 ? WS_BK : pn == 5 ? WS_BV : WS_PL));
            const float sc = (pn == 3) ? QSCALE_B : 1.f;
#pragma unroll
            for (int ai = 0; ai < 2; ++ai)
#pragma unroll
                for (int m = 0; m < 4; ++m) {
                    const int r = row0 + ai * 128 + m * 16;
#pragma unroll
                    for (int bj = 0; bj < 2; ++bj)
#pragma unroll
                        for (int n = 0; n < 2; ++n) {
                            const f32x4 v = acc[ai][bj][m][n] * sc;
                            *(u32x2*)(dst + (size_t)r * 256 + bj * 128 + wc * 32 + n * 16 + 4 * fq) = (u32x2){pk2(v[0], v[1]), pk2(v[2], v[3])};
                        }
                }
        } else {
            const int hc0 = (pn - 7) * 256;
#pragma unroll
            for (int ai = 0; ai < 2; ++ai)
#pragma unroll
                for (int m = 0; m < 4; ++m) {
                    const int r = row0 + ai * 128 + m * 16;
#pragma unroll
                    for (int bj = 0; bj < 2; ++bj)
#pragma unroll
                        for (int n = 0; n < 2; ++n) {
                            const int hc = hc0 + bj * 128 + wc * 32 + n * 16 + 4 * fq; const f32x4 v = acc[ai][bj][m][n];
                            if (isctx) *(u32x2*)((bf16_t*)(ws + WS_HYC) + (size_t)(r - NLAT) * 768 + hc) = (u32x2){pk2(v[0], v[1]), pk2(v[2], v[3])};
                            else { bf16_t* dst = (bf16_t*)(ws + WS_HYT) + ((size_t)(r >> 14) * 768 + hc) * S + (r & (S - 1));
#pragma unroll
                                for (int j = 0; j < 4; ++j) dst[(size_t)j * S] = f2bf(v[j]); }
                        }
                }
        }
    }
};

struct EpiOut {
    const float* xl_old; const float* xc_old; float* xl_new; float* xc_new; const float* mod;
    DI void operator()(const AccT& acc, const pg8::Unit& u, int wr, int wc, int fr, int fq) const {
        const int row0 = u.pm * 256 + wr * 64 + fr; const bool isctx = (u.pm >= NLAT / 256);
        const int v = isctx ? 2 : (u.pm / (S / 256));
        const float* g1 = mod + (size_t)v * 6144 + 2 * 1024;
        const float* so = isctx ? xc_old - (size_t)NLAT * D : xl_old; float* dn = isctx ? xc_new - (size_t)NLAT * D : xl_new;
#pragma unroll
        for (int bj = 0; bj < 2; ++bj)
#pragma unroll
            for (int n = 0; n < 2; ++n) {
                const int c = u.pn * 256 + bj * 128 + wc * 32 + n * 16 + 4 * fq;
                const f32x4 g = *(const f32x4*)(g1 + c);
#pragma unroll
                for (int ai = 0; ai < 2; ++ai)
#pragma unroll
                    for (int m = 0; m < 4; ++m) {
                        const size_t o = (size_t)(row0 + ai * 128 + m * 16) * D + c;
                        *(f32x4*)(dn + o) = *(const f32x4*)(so + o) + g * acc[ai][bj][m][n];
                    }
            }
    }
};

struct EpiMoe1 {
    bf16_t* hmid;
    DI void operator()(const AccT& acc, const pg8::Unit& u, int wr, int wc, int fr, int fq) const {
        const int row0 = u.pm * 256 + wr * 64 + fr;
#pragma unroll
        for (int ai = 0; ai < 2; ++ai)
#pragma unroll
            for (int m = 0; m < 4; ++m)
#pragma unroll
                for (int bj = 0; bj < 2; ++bj) {
                    const f32x4 a = acc[ai][bj][m][0], b = acc[ai][bj][m][1]; float h[4];
#pragma unroll
                    for (int j = 0; j < 4; ++j) h[j] = siluf(a[j]) * b[j];
                    *(u32x2*)(hmid + (size_t)(row0 + ai * 128 + m * 16) * DE + (u.pn * 256 + bj * 128 + wc * 32) / 2 + 4 * fq) = (u32x2){pk2(h[0], h[1]), pk2(h[2], h[3])};
                }
    }
};
struct EpiMoe2 {
    bf16_t* ys;
    DI void operator()(const AccT& acc, const pg8::Unit& u, int wr, int wc, int fr, int fq) const {
        const int row0 = u.pm * 256 + wr * 64 + fr;
#pragma unroll
        for (int ai = 0; ai < 2; ++ai)
#pragma unroll
            for (int m = 0; m < 4; ++m)
#pragma unroll
                for (int bj = 0; bj < 2; ++bj)
#pragma unroll
                    for (int n = 0; n < 2; ++n) { const f32x4 v = acc[ai][bj][m][n];
                        *(u32x2*)(ys + (size_t)(row0 + ai * 128 + m * 16) * D + u.pn * 256 + bj * 128 + wc * 32 + n * 16 + 4 * fq) = (u32x2){pk2(v[0], v[1]), pk2(v[2], v[3])}; }
    }
};

DI void tconv_tile(const Frame& F, const float* src, int N, int k0, int n0, bf16_t* dst, int ldd, int mode) {
    float* tl = (float*)F.lds;
    __syncthreads();
#pragma unroll
    for (int i = 0; i < 8; ++i) { const int idx = F.tid + 512 * i, k = idx >> 6, n = idx & 63; tl[k * 65 + n] = src[(size_t)(k0 + k) * N + n0 + n]; }
    __syncthreads();
#pragma unroll
    for (int i = 0; i < 4; ++i) { const int idx = F.tid + 512 * i, n = idx >> 5, kp = idx & 31;
        const int nn = n0 + n; const int row = (mode == 0) ? nn : ((nn >> 4) * 32 + (mode - 1) * 16 + (nn & 15));
        *(unsigned*)(dst + (size_t)row * ldd + k0 + 2 * kp) = pk2(tl[(2 * kp) * 65 + n], tl[(2 * kp + 1) * 65 + n]); }
}
DI void phase_prologue(const Frame& F) {
    const int T_IN = 16 * 40, T_OUT = 16 * 16, T_E = 16 * 8;
    const int per_layer = T_IN + T_OUT + NE * 3 * T_E, total = 2 * per_layer;
    for (int u = F.bid; u < total; u += F.G) {
        const int li = u / per_layer; int r = u % per_layer;
        if (r < T_IN) { tconv_tile(F, F.in[I_WIN] + (size_t)li * D * DIN, DIN, (r / 40) * 64, (r % 40) * 64, WSP(bf16_t, WS_WIN) + (size_t)li * DIN * D, D, 0); continue; }
        r -= T_IN;
        if (r < T_OUT) { tconv_tile(F, F.in[I_WOUT] + (size_t)li * D * D, D, (r / 16) * 64, (r % 16) * 64, WSP(bf16_t, WS_WOUT) + (size_t)li * D * D, D, 0); continue; }
        r -= T_OUT;
        const int e = r / (3 * T_E), w = (r / T_E) % 3, t = r % T_E;
        if (w < 2) tconv_tile(F, F.in[w == 0 ? I_MW1 : I_MW3] + ((size_t)li * NE + e) * D * DE, DE, (t / 8) * 64, (t % 8) * 64, WSP(bf16_t, WS_W13) + ((size_t)li * NE + e) * 1024 * 1024, D, 1 + w);
        else tconv_tile(F, F.in[I_MW2] + ((size_t)li * NE + e) * DE * D, D, (t / 16) * 64, (t % 16) * 64, WSP(bf16_t, WS_W2) + ((size_t)li * NE + e) * 1024 * 512, DE, 0);
    }
    __syncthreads();
    {
        float* sc = (float*)F.lds;
        float* red = sc + 3072;
        for (int i = F.tid; i < 3072; i += NTHR) { const int v = i >> 10, k = i & 1023; const float x = (v < 2) ? F.in[I_C][v * 1024 + k] : F.in[I_CCTX][k]; sc[i] = siluf(x); }
        __syncthreads();
        for (int u = F.bid; u < 2 * 96; u += F.G) {
            const int li = u / 96, j = (u % 96) * 64 + F.lane, ko = F.wave;
            const float* w = F.in[I_ADAW] + (size_t)li * D * 6144 + j;
            float a0 = 0.f, a1 = 0.f, a2 = 0.f;
            for (int k = ko * 128; k < ko * 128 + 128; ++k) { const float wv = w[(size_t)k * 6144]; a0 += sc[k] * wv; a1 += sc[1024 + k] * wv; a2 += sc[2048 + k] * wv; }
            red[(ko * 3 + 0) * 64 + F.lane] = a0; red[(ko * 3 + 1) * 64 + F.lane] = a1; red[(ko * 3 + 2) * 64 + F.lane] = a2;
            __syncthreads();
            if (F.tid < 192) { const int v = F.tid / 64, l = F.tid % 64; float s = 0.f;
#pragma unroll
                for (int q = 0; q < 8; ++q) s += red[(q * 3 + v) * 64 + l];
                const int jj = (u % 96) * 64 + l;
                WSP(float, WS_MOD)[((size_t)li * 3 + v) * 6144 + jj] = s + F.in[I_ADAB][li * 6144 + jj]; }
            __syncthreads();
        }
    }
    if (F.bid == (F.G > 1 ? 1 : 0)) {
        for (int i = F.tid; i < 256 * 8; i += NTHR) { const int pos = i >> 3, f = i & 7; const float inv = exp2f(-(float)f * (13.287712379549449f / 8.f)); const float rev = (float)pos * inv * 0.15915494309189535f;
            WSP(float, WS_ROPE)[i * 2] = cos_rev(rev); WSP(float, WS_ROPE)[i * 2 + 1] = sin_rev(rev); }
    }
}

DI void filter_tile(const Frame& F, int li, int L, int tile, float* hT, float* part) {
    float* h1s = (float*)F.lds;
    float* h2s = h1s + 4096;
    float* stg = h2s + 4096;
    float* sq2 = stg + 256 * 65;
    const float* w1 = F.in[I_HW1] + (size_t)li * 33 * 64; const float* b1 = F.in[I_HB1] + li * 64;
    const float* w2 = F.in[I_HW2] + (size_t)li * 64 * 64; const float* b2 = F.in[I_HB2] + li * 64;
    const float* w3 = F.in[I_HW3] + (size_t)li * 64 * 1024; const float* b3 = F.in[I_HB3] + li * 1024;
    const int t0 = tile * 64;
    const float inv_lm1 = 1.f / (float)(L > 1 ? L - 1 : 1);
    __syncthreads();
    {
        const int tl = F.tid & 63, pt = F.tid >> 6; const float t = (float)(t0 + tl);
        float a[8];
#pragma unroll
        for (int jj = 0; jj < 8; ++jj) a[jj] = b1[pt * 8 + jj] + (t * inv_lm1) * w1[pt * 8 + jj];
#pragma unroll 1
        for (int i = 0; i < 16; ++i) { const float band = 1e-4f + (15.f - 1e-4f) * (float)i / 15.f; const float rev = t * band / (float)L; const float cz = cos_rev(rev), sz = sin_rev(rev);
#pragma unroll
            for (int jj = 0; jj < 8; ++jj) a[jj] += cz * w1[(1 + i) * 64 + pt * 8 + jj] + sz * w1[(17 + i) * 64 + pt * 8 + jj]; }
#pragma unroll
        for (int jj = 0; jj < 8; ++jj) h1s[tl * 64 + pt * 8 + jj] = sin_rad(a[jj]);
    }
    __syncthreads();
    {
        const int tl = F.tid & 63, pt = F.tid >> 6;
        float a[8];
#pragma unroll
        for (int jj = 0; jj < 8; ++jj) a[jj] = b2[pt * 8 + jj];
#pragma unroll 1
        for (int i = 0; i < 64; ++i) { const float hv = h1s[tl * 64 + i];
#pragma unroll
            for (int jj = 0; jj < 8; ++jj) a[jj] += hv * w2[i * 64 + pt * 8 + jj]; }
#pragma unroll
        for (int jj = 0; jj < 8; ++jj) h2s[tl * 64 + pt * 8 + jj] = sin_rad(a[jj]);
    }
    __syncthreads();
    const int c = F.tid & 255, th = F.tid >> 8;
    const float delta = 3.0701134573253945f + (15.350567286626973f - 3.0701134573253945f) * (float)c / 255.f;
#pragma unroll 1
    for (int cc = 0; cc < 4; ++cc) {
        float wr[64];
#pragma unroll
        for (int i = 0; i < 64; ++i) wr[i] = w3[(size_t)i * 1024 + cc * 256 + c];
        const float bb = b3[cc * 256 + c]; float sq = 0.f;
#pragma unroll 1
        for (int tt = th * 32; tt < th * 32 + 32; ++tt) {
            float a = bb;
#pragma unroll
            for (int i = 0; i < 64; ++i) a += h2s[tt * 64 + i] * wr[i];
            a *= __expf(-((float)(t0 + tt) * inv_lm1) * delta);
            stg[c * 65 + tt] = a; sq += a * a;
        }
        if (th == 1) sq2[c] = sq;
        __syncthreads();
        if (th == 0) part[(size_t)tile * 1024 + cc * 256 + c] = sq + sq2[c];
        for (int ch = F.wave * 32; ch < F.wave * 32 + 32; ++ch) hT[((size_t)cc * 256 + ch) * L + t0 + F.lane] = stg[ch * 65 + F.lane];
        __syncthreads();
    }
}

struct TokInfo { unsigned e0, e1, p0, p1; float g0, g1; unsigned s0, s1; };
DI void phase_norm1(const Frame& F, int li, int mode) {
    const int nrows = (mode == 2) ? NLAT : NTOK;
    const float* modp = WSP(float, WS_MOD) + (size_t)li * 3 * 6144;
    const float* modprev = WSP(float, WS_MOD) + (size_t)(mode == 2 ? 1 : li - 1) * 3 * 6144;
    const float* gam = (mode == 2) ? F.in[I_FG] : F.in[I_N1G] + (size_t)li * D;
    const TokInfo* tok = WSP(TokInfo, WS_TOK); const bf16_t* ys = WSP(bf16_t, WS_A1);
    bf16_t* hbf = WSP(bf16_t, WS_HBF);
    for (int r = F.bid * 8 + F.wave; r < nrows; r += F.G * 8) {
        const bool isctx = r >= NLAT; const int v = isctx ? 2 : (r >> 14);
        float* xrow = isctx ? WSP(float, WS_XC) + (size_t)(r - NLAT) * D : F.out + (size_t)r * D;
        const float* src = (mode == 0) ? (isctx ? F.in[I_CTX] + (size_t)(r - NLAT) * D : F.in[I_X] + (size_t)r * D) : xrow;
        f32x4 x[4];
#pragma unroll
        for (int i = 0; i < 4; ++i) x[i] = *(const f32x4*)(src + i * 256 + F.lane * 4);
        if (mode != 0) {
            const TokInfo ti = tok[r];
            const float* g2 = modprev + (size_t)v * 6144 + 5 * 1024;
#pragma unroll
            for (int i = 0; i < 4; ++i) {
                const int c = i * 256 + F.lane * 4;
                const u32x2 a = *(const u32x2*)(ys + (size_t)ti.s0 * D + c), b = *(const u32x2*)(ys + (size_t)ti.s1 * D + c);
                const f32x4 gg = *(const f32x4*)(g2 + c);
                f32x4 y;
                y[0] = ti.g0 * __uint_as_float(a[0] << 16) + ti.g1 * __uint_as_float(b[0] << 16);
                y[1] = ti.g0 * __uint_as_float(a[0] & 0xffff0000u) + ti.g1 * __uint_as_float(b[0] & 0xffff0000u);
                y[2] = ti.g0 * __uint_as_float(a[1] << 16) + ti.g1 * __uint_as_float(b[1] << 16);
                y[3] = ti.g0 * __uint_as_float(a[1] & 0xffff0000u) + ti.g1 * __uint_as_float(b[1] & 0xffff0000u);
                x[i] = x[i] + gg * y;
            }
            if (mode == 1) {
#pragma unroll
                for (int i = 0; i < 4; ++i) *(f32x4*)(xrow + i * 256 + F.lane * 4) = x[i];
            }
        }
        float ss = 0.f;
#pragma unroll
        for (int i = 0; i < 4; ++i) ss += x[i][0] * x[i][0] + x[i][1] * x[i][1] + x[i][2] * x[i][2] + x[i][3] * x[i][3];
        ss = wave_sum(ss);
        const float rstd = rsqrtf(ss * (1.f / D) + EPS);
#pragma unroll
        for (int i = 0; i < 4; ++i) {
            const int c = i * 256 + F.lane * 4;
            const f32x4 g = *(const f32x4*)(gam + c);
            if (mode == 2) { *(f32x4*)(F.out + (size_t)r * D + c) = x[i] * rstd * g; }
            else {
                const f32x4 sh = *(const f32x4*)(modp + (size_t)v * 6144 + c), sc = *(const f32x4*)(modp + (size_t)v * 6144 + 1024 + c);
                const f32x4 h = x[i] * rstd * g * (sc + 1.f) + sh;
                *(u32x2*)(hbf + (size_t)r * D + c) = (u32x2){pk2(h[0], h[1]), pk2(h[2], h[3])};
            }
        }
    }
}

DI void phase_norm2(const Frame& F, int li, int nrows) {
    float* wt = (float*)F.lds;
    __syncthreads();
    for (int i = F.tid; i < 16384; i += NTHR) { const int k = i >> 4, e = i & 15; wt[e * 1024 + k] = F.in[I_RW][i]; }
    __syncthreads();
    const float* modp = WSP(float, WS_MOD) + (size_t)li * 3 * 6144;
    const float* gam = F.in[I_N2G] + (size_t)li * D;
    bf16_t* hbf = WSP(bf16_t, WS_HBF); TokInfo* tok = WSP(TokInfo, WS_TOK);
    unsigned* cnt = F.ctl + CW_CNT + li * 16;
    for (int r = F.bid * 8 + F.wave; r < nrows; r += F.G * 8) {
        const bool isctx = r >= NLAT; const int v = isctx ? 2 : (r >> 14);
        const float* src = isctx ? WSP(float, WS_XC) + (size_t)(r - NLAT) * D : F.out + (size_t)r * D;
        f32x4 x[4]; float ss = 0.f;
#pragma unroll
        for (int i = 0; i < 4; ++i) { x[i] = *(const f32x4*)(src + i * 256 + F.lane * 4); ss += x[i][0] * x[i][0] + x[i][1] * x[i][1] + x[i][2] * x[i][2] + x[i][3] * x[i][3]; }
        ss = wave_sum(ss);
        const float rstd = rsqrtf(ss * (1.f / D) + EPS);
        float lg[16];
#pragma unroll
        for (int e = 0; e < 16; ++e) lg[e] = 0.f;
#pragma unroll
        for (int i = 0; i < 4; ++i) {
            const int c = i * 256 + F.lane * 4;
            const f32x4 g = *(const f32x4*)(gam + c), sh = *(const f32x4*)(modp + (size_t)v * 6144 + 3 * 1024 + c), sc = *(const f32x4*)(modp + (size_t)v * 6144 + 4 * 1024 + c);
            const f32x4 h = x[i] * rstd * g * (sc + 1.f) + sh;
            *(u32x2*)(hbf + (size_t)r * D + c) = (u32x2){pk2(h[0], h[1]), pk2(h[2], h[3])};
#pragma unroll
            for (int e = 0; e < 16; ++e) { const f32x4 w = *(const f32x4*)(wt + e * 1024 + c); lg[e] += h[0] * w[0] + h[1] * w[1] + h[2] * w[2] + h[3] * w[3]; }
        }
#pragma unroll
        for (int e = 0; e < 16; ++e) lg[e] = wave_sum(lg[e]);
        float mx = lg[0];
#pragma unroll
        for (int e = 1; e < 16; ++e) mx = fmaxf(mx, lg[e]);
        float sc[16], sel[16], den = 0.f;
#pragma unroll
        for (int e = 0; e < 16; ++e) { sc[e] = __expf(lg[e] - mx); den += sc[e]; }
        const float rden = 1.f / den;
#pragma unroll
        for (int e = 0; e < 16; ++e) { sc[e] *= rden; sel[e] = sc[e] + F.in[I_RB][e]; }
        int bg = 0; float bgs = -1e30f;
#pragma unroll
        for (int g = 0; g < 4; ++g) {
            float m1 = -1e30f, m2 = -1e30f;
#pragma unroll
            for (int q = 0; q < 4; ++q) { const float s = sel[g * 4 + q]; if (s > m1) { m2 = m1; m1 = s; } else if (s > m2) m2 = s; }
            const float gs = m1 + m2; if (gs > bgs) { bgs = gs; bg = g; }
        }
        int e0 = 0, e1 = 0; float s0v = -1e30f, s1v = -1e30f, w0 = 0.f, w1 = 0.f;
#pragma unroll
        for (int e = 0; e < 16; ++e) {
            const bool ing = (e >> 2) == bg; const float s = sel[e];
            if (ing && s > s0v) { s1v = s0v; e1 = e0; w1 = w0; s0v = s; e0 = e; w0 = sc[e]; }
            else if (ing && s > s1v) { s1v = s; e1 = e; w1 = sc[e]; }
        }
        if (F.lane == 0) {
            TokInfo ti; ti.e0 = e0; ti.e1 = e1; ti.p0 = atomicAdd(cnt + e0, 1u); ti.p1 = atomicAdd(cnt + e1, 1u);
            const float ws = 1.f / (w0 + w1); ti.g0 = w0 * ws; ti.g1 = w1 * ws; ti.s0 = 0; ti.s1 = 0;
            tok[r] = ti;
        }
    }
}

DI void moe_offsets(const Frame& F, int li, int* offs) {
    __syncthreads();
    if (F.tid == 0) { int o = 0; for (int e = 0; e < NE; ++e) { offs[e] = o; offs[17 + e] = o >> 8; const unsigned c = __hip_atomic_load(F.ctl + CW_CNT + li * 16 + e, __ATOMIC_RELAXED, __HIP_MEMORY_SCOPE_AGENT); o += (int)((c + 255u) & ~255u); }
        offs[16] = o; offs[17 + 16] = o >> 8; }
    __syncthreads();
    for (int t = F.tid; t < SLOT_CAP / 256; t += NTHR) { int e = 0; for (int k = 1; k < NE; ++k) e += (offs[17 + k] <= t) ? 1 : 0; offs[40 + t] = e; }
    __syncthreads();
}
DI void phase_gather(const Frame& F, int li, int nrows) {
    int* offs = (int*)(F.lds + LDS_MISC + 64);
    moe_offsets(F, li, offs);
    const bf16_t* hbf = WSP(bf16_t, WS_HBF); bf16_t* a1 = WSP(bf16_t, WS_A1); TokInfo* tok = WSP(TokInfo, WS_TOK);
    for (int r = F.bid * 8 + F.wave; r < nrows; r += F.G * 8) {
        TokInfo ti = tok[r];
        const unsigned s0 = offs[ti.e0] + ti.p0, s1 = offs[ti.e1] + ti.p1;
        const u32x4 a = *(const u32x4*)(hbf + (size_t)r * D + F.lane * 8), b = *(const u32x4*)(hbf + (size_t)r * D + 512 + F.lane * 8);
        *(u32x4*)(a1 + (size_t)s0 * D + F.lane * 8) = a; *(u32x4*)(a1 + (size_t)s0 * D + 512 + F.lane * 8) = b;
        *(u32x4*)(a1 + (size_t)s1 * D + F.lane * 8) = a; *(u32x4*)(a1 + (size_t)s1 * D + 512 + F.lane * 8) = b;
        if (F.lane == 0) { tok[r].s0 = s0; tok[r].s1 = s1; }
    }
}

#define MFMA32(a, b, c) __builtin_amdgcn_mfma_f32_32x32x16_bf16((a), (b), (c), 0, 0, 0)
DI float lam_of(const Frame& F, int li, float& lam_init) {
    const float* lv = F.in[I_ALAM] + (size_t)li * 128;
    const int i = F.lane & 31, hi = F.lane >> 5;
    float d = lv[hi * 64 + i] * lv[hi * 64 + 32 + i];
    for (int o = 16; o > 0; o >>= 1) d += __shfl_xor(d, o);
    const float d0 = __shfl(d, 0), d1 = __shfl(d, 32);
    lam_init = 0.8f - 0.6f * __expf(-0.3f * (float)li);
    return __expf(d0) - __expf(d1) + lam_init;
}
DI bf16x8 pack8(const f32x16& x, int s) {
    u32x4 p; p[0] = pk2(x[8 * s], x[8 * s + 1]); p[1] = pk2(x[8 * s + 2], x[8 * s + 3]); p[2] = pk2(x[8 * s + 4], x[8 * s + 5]); p[3] = pk2(x[8 * s + 6], x[8 * s + 7]);
    return __builtin_bit_cast(bf16x8, p);
}

DI void diffattn_unit(const Frame& F, int li, int b, int h, int qt) {
    const int lane = F.lane, r = lane & 31, hh = lane >> 5;
    const bf16_t* AQ = WSP(bf16_t, WS_AQ); const bf16_t* AK = WSP(bf16_t, WS_AK); const bf16_t* AVT = WSP(bf16_t, WS_AVT) + (size_t)(b * 4 + h) * 64 * NKEY;
    unsigned char* Ks = F.lds;
    unsigned char* Vt = F.lds + 16384;
    constexpr int VTB = 64 * 136;
    float lam_init; const float lam = lam_of(F, li, lam_init);
    const int q = qt * 256 + F.wave * 32 + r;
    const size_t qrow = (size_t)b * S + q;
    bf16x8 qf[2][2]; float qn2[2];
#pragma unroll
    for (int c = 0; c < 2; ++c) { qn2[c] = 0.f;
#pragma unroll
        for (int ks = 0; ks < 2; ++ks) { qf[c][ks] = *(const bf16x8*)(AQ + qrow * 256 + h * 64 + c * 32 + ks * 16 + 8 * hh);
#pragma unroll
            for (int j = 0; j < 8; ++j) { const float v = bf2f((bf16_t)qf[c][ks][j]); qn2[c] += v * v; } }
        qn2[c] += __shfl_xor(qn2[c], 32); }
    const unsigned* kmx = F.ctl + CW_KMAX + li * 16 + (b * 4 + h) * 2;
    f32x16 cinit;
    { float cn = 0.f;
#pragma unroll
      for (int c = 0; c < 2; ++c) { const float km = sqrtf(__uint_as_float(__hip_atomic_load(kmx + c, __ATOMIC_RELAXED, __HIP_MEMORY_SCOPE_AGENT))); cn = fmaxf(cn, sqrtf(qn2[c]) * km); }
      cn = -(cn * 1.02f + 1e-3f);
#pragma unroll
      for (int i = 0; i < 16; ++i) cinit[i] = cn; }
    f32x16 O[2][2];
#pragma unroll
    for (int c = 0; c < 2; ++c)
#pragma unroll
        for (int dh = 0; dh < 2; ++dh)
#pragma unroll
            for (int i = 0; i < 16; ++i) O[c][dh][i] = 0.f;
    float lsum[2] = {0.f, 0.f};
    const int skey = F.tid >> 3, sch = F.tid & 7;
    const int kdst = (sch >> 2) * 4096 + skey * 64 + (((sch & 3) ^ ((skey >> 2) & 3)) * 16);
    const int vd = F.tid >> 3, vkc = F.tid & 7;
    const int vdst = vd * 136 + vkc * 16;
    auto krow_of = [&](int j) -> size_t { return j < CTX ? (size_t)NLAT + b * CTX + j : (size_t)b * S + (j - CTX); };
    u32x4 kreg, vreg;
    kreg = *(const u32x4*)(AK + krow_of(skey) * 256 + h * 64 + sch * 8);
    vreg = *(const u32x4*)(AVT + (size_t)vd * NKEY + vkc * 8);
    __syncthreads();
    *(u32x4*)(Ks + kdst) = kreg;
    *(u32x2*)(Vt + vdst) = (u32x2){vreg[0], vreg[1]}; *(u32x2*)(Vt + vdst + 8) = (u32x2){vreg[2], vreg[3]};
    __syncthreads();
    constexpr int NT = NKEY / 64;
    for (int kt = 0; kt < NT; ++kt) {
        const int buf = kt & 1;
        if (kt + 1 < NT) {
            const int j0 = (kt + 1) * 64;
            kreg = *(const u32x4*)(AK + krow_of(j0 + skey) * 256 + h * 64 + sch * 8);
            vreg = *(const u32x4*)(AVT + (size_t)vd * NKEY + j0 + vkc * 8);
        }
        const unsigned char* kb = Ks + buf * 8192; const unsigned char* vb = Vt + buf * VTB;
#pragma unroll 1
        for (int st = 0; st < 2; ++st) {
            const int key = 32 * st + r;
            bf16x8 pb[2][2];
#pragma unroll
            for (int c = 0; c < 2; ++c) {
                const bf16x8 k0 = *(const bf16x8*)(kb + c * 4096 + key * 64 + (((0 + hh) ^ ((key >> 2) & 3)) * 16));
                const bf16x8 k1 = *(const bf16x8*)(kb + c * 4096 + key * 64 + (((2 + hh) ^ ((key >> 2) & 3)) * 16));
                f32x16 s = MFMA32(k0, qf[c][0], cinit);
                s = MFMA32(k1, qf[c][1], s);
#pragma unroll
                for (int i = 0; i < 16; ++i) { s[i] = __builtin_amdgcn_exp2f(s[i]); lsum[c] += s[i]; }
                pb[c][0] = pack8(s, 0); pb[c][1] = pack8(s, 1);
            }
#pragma unroll
            for (int dh = 0; dh < 2; ++dh)
#pragma unroll
                for (int s = 0; s < 2; ++s) {
                    const unsigned char* vp = vb + (32 * dh + r) * 136 + (32 * st + 16 * s + 4 * hh) * 2;
                    const s16x4 lo = *(const s16x4*)vp, hi = *(const s16x4*)(vp + 16);
                    const bf16x8 vf = __builtin_shufflevector(lo, hi, 0, 1, 2, 3, 4, 5, 6, 7);
                    O[0][dh] = MFMA32(vf, pb[0][s], O[0][dh]);
                    O[1][dh] = MFMA32(vf, pb[1][s], O[1][dh]);
                }
        }
        if (kt + 1 < NT) {
            unsigned char* kw = Ks + (buf ^ 1) * 8192; unsigned char* vw = Vt + (buf ^ 1) * VTB;
            *(u32x4*)(kw + kdst) = kreg;
            *(u32x2*)(vw + vdst) = (u32x2){vreg[0], vreg[1]}; *(u32x2*)(vw + vdst + 8) = (u32x2){vreg[2], vreg[3]};
        }
        __syncthreads();
    }
    const float l0 = lsum[0] + __shfl_xor(lsum[0], 32), l1 = lsum[1] + __shfl_xor(lsum[1], 32);
    const float r0 = 1.f / l0, r1 = lam / l1;
    float o[2][16]; float ss = 0.f;
#pragma unroll
    for (int dh = 0; dh < 2; ++dh)
#pragma unroll
        for (int i = 0; i < 16; ++i) { o[dh][i] = O[0][dh][i] * r0 - O[1][dh][i] * r1; ss += o[dh][i] * o[dh][i]; }
    ss += __shfl_xor(ss, 32);
    const float rs = rsqrtf(ss * (1.f / 64.f) + EPS) * (1.f - lam_init);
    const float* sg = F.in[I_ASUB] + li * 64;
    bf16_t* mix = WSP(bf16_t, WS_HBF) + qrow * D + h * 64;
#pragma unroll
    for (int dh = 0; dh < 2; ++dh)
#pragma unroll
        for (int g = 0; g < 4; ++g) {
            const int d = 32 * dh + 8 * g + 4 * hh;
            const f32x4 gg = *(const f32x4*)(sg + d);
            *(u32x2*)(mix + d) = (u32x2){pk2(o[dh][4 * g] * rs * gg[0], o[dh][4 * g + 1] * rs * gg[1]), pk2(o[dh][4 * g + 2] * rs * gg[2], o[dh][4 * g + 3] * rs * gg[3])};
        }
}

DI void ctx_attn_a_unit(const Frame& F, int li, int u) {
    const int idx = u * NTHR + F.tid, cr = idx >> 2, h = idx & 3, b = cr >> 8;
    const bf16_t* AQ = WSP(bf16_t, WS_AQ) + (size_t)(NLAT + cr) * 256 + h * 64;
    const bf16_t* AK = WSP(bf16_t, WS_AK) + (size_t)(NLAT + b * CTX) * 256 + h * 64;
    const bf16_t* AVT = WSP(bf16_t, WS_AVT) + (size_t)(b * 4 + h) * 64 * NKEY;
    float lam_init; const float lam = lam_of(F, li, lam_init);
    float o[64];
#pragma unroll
    for (int i = 0; i < 64; ++i) o[i] = 0.f;
#pragma unroll 1
    for (int c = 0; c < 2; ++c) {
        float q[32];
#pragma unroll
        for (int i = 0; i < 32; ++i) q[i] = bf2f(AQ[c * 32 + i]);
        float m = -1e30f, l = 0.f, acc[64];
#pragma unroll
        for (int i = 0; i < 64; ++i) acc[i] = 0.f;
#pragma unroll 1
        for (int j = 0; j < CTX; ++j) {
            float s = 0.f;
#pragma unroll
            for (int i = 0; i < 32; ++i) s += q[i] * bf2f(AK[(size_t)j * 256 + c * 32 + i]);
            const float mn = fmaxf(m, s), al = __builtin_amdgcn_exp2f(m - mn), p = __builtin_amdgcn_exp2f(s - mn);
            l = l * al + p; m = mn;
#pragma unroll
            for (int i = 0; i < 64; ++i) acc[i] = acc[i] * al + p * bf2f(AVT[(size_t)i * NKEY + j]);
        }
        const float sc = (c == 0) ? 1.f / l : -lam / l;
#pragma unroll
        for (int i = 0; i < 64; ++i) o[i] += acc[i] * sc;
    }
    float ss = 0.f;
#pragma unroll
    for (int i = 0; i < 64; ++i) ss += o[i] * o[i];
    const float rs = rsqrtf(ss * (1.f / 64.f) + EPS) * (1.f - lam_init);
    bf16_t* mix = WSP(bf16_t, WS_HBF) + (size_t)(NLAT + cr) * D + h * 64;
#pragma unroll
    for (int i = 0; i < 64; ++i) mix[i] = f2bf(o[i] * rs * F.in[I_ASUB][li * 64 + i]);
}
DI void ctx_attn_b_unit(const Frame& F, int u) {
    const int idx = u * NTHR + F.tid, cr = idx >> 2, h = idx & 3, b = cr >> 8;
    const bf16_t* BQ = WSP(bf16_t, WS_BQ) + (size_t)(NLAT + cr) * 256 + h * 64;
    const bf16_t* BK = WSP(bf16_t, WS_BK) + (size_t)(NLAT + b * CTX) * 256 + h * 64;
    const bf16_t* BV = WSP(bf16_t, WS_BV) + (size_t)(NLAT + b * CTX) * 256 + h * 64;
    float q[64], acc[64];
#pragma unroll
    for (int i = 0; i < 64; ++i) { q[i] = bf2f(BQ[i]); acc[i] = 0.f; }
    float m = -1e30f, l = 0.f;
    for (int j = 0; j < CTX; ++j) {
        float s = 0.f;
#pragma unroll
        for (int i = 0; i < 64; ++i) s += q[i] * bf2f(BK[(size_t)j * 256 + i]);
        const float mn = fmaxf(m, s), al = __builtin_amdgcn_exp2f(m - mn), p = __builtin_amdgcn_exp2f(s - mn);
        l = l * al + p; m = mn;
#pragma unroll
        for (int i = 0; i < 64; ++i) acc[i] = acc[i] * al + p * bf2f(BV[(size_t)j * 256 + i]);
    }
    const float rl = 1.f / l;
    bf16_t* mix = WSP(bf16_t, WS_HBF) + (size_t)(NLAT + cr) * D + 256 + h * 64;
#pragma unroll
    for (int i = 0; i < 64; ++i) mix[i] = f2bf(acc[i] * rl);
}

DI void na_unit(const Frame& F, int li, int u) {
    const int b = u >> 7, rp = u & 127;
    const int qi = F.tid >> 2, h = F.tid & 3;
    const int row = rp * 2 + (qi >> 6), col = qi & 63, t = row * GW + col;
    const bf16_t* BQ = WSP(bf16_t, WS_BQ) + ((size_t)b * S + t) * 256 + h * 64;
    const bf16_t* BKl = WSP(bf16_t, WS_BK) + (size_t)b * S * 256 + h * 64;
    const bf16_t* BVl = WSP(bf16_t, WS_BV) + (size_t)b * S * 256 + h * 64;
    const bf16_t* BKc = WSP(bf16_t, WS_BK) + (size_t)(NLAT + b * CTX) * 256 + h * 64;
    const bf16_t* BVc = WSP(bf16_t, WS_BV) + (size_t)(NLAT + b * CTX) * 256 + h * 64;
    const float* rpb = F.in[I_RPB] + ((size_t)li * 4 + h) * 15 * 31;
    float q[64], acc[64];
#pragma unroll
    for (int i = 0; i < 64; ++i) { q[i] = bf2f(BQ[i]); acc[i] = 0.f; }
    float m = -1e30f, l = 0.f;
    int r0 = row - 4; r0 = r0 < 0 ? 0 : (r0 > 248 ? 248 : r0);
    int c0 = col - 8; c0 = c0 < 0 ? 0 : (c0 > 48 ? 48 : c0);
    for (int j = 0; j < 128 + CTX; ++j) {
        const bf16_t *kp, *vp; float bias = 0.f;
        if (j < 128) { const int kr = r0 + (j >> 4), kc = c0 + (j & 15); kp = BKl + (size_t)(kr * GW + kc) * 256; vp = BVl + (size_t)(kr * GW + kc) * 256;
            bias = rpb[(kr - row + 7) * 31 + (kc - col + 15)] * LOG2E; }
        else { kp = BKc + (size_t)(j - 128) * 256; vp = BVc + (size_t)(j - 128) * 256; }
        float s = bias;
#pragma unroll
        for (int i8 = 0; i8 < 8; ++i8) { const u32x4 kk = *(const u32x4*)(kp + i8 * 8);
#pragma unroll
            for (int e = 0; e < 4; ++e) { s += q[i8 * 8 + 2 * e] * __uint_as_float(kk[e] << 16) + q[i8 * 8 + 2 * e + 1] * __uint_as_float(kk[e] & 0xffff0000u); } }
        const float mn = fmaxf(m, s), al = __builtin_amdgcn_exp2f(m - mn), p = __builtin_amdgcn_exp2f(s - mn);
        l = l * al + p; m = mn;
#pragma unroll
        for (int i8 = 0; i8 < 8; ++i8) { const u32x4 vv = *(const u32x4*)(vp + i8 * 8);
#pragma unroll
            for (int e = 0; e < 4; ++e) { acc[i8 * 8 + 2 * e] = acc[i8 * 8 + 2 * e] * al + p * __uint_as_float(vv[e] << 16); acc[i8 * 8 + 2 * e + 1] = acc[i8 * 8 + 2 * e + 1] * al + p * __uint_as_float(vv[e] & 0xffff0000u); } }
    }
    const float rl = 1.f / l;
    bf16_t* mix = WSP(bf16_t, WS_HBF) + ((size_t)b * S + t) * D + 256 + h * 64;
#pragma unroll
    for (int i8 = 0; i8 < 8; ++i8) *(u32x4*)(mix + i8 * 8) = (u32x4){pk2(acc[i8 * 8] * rl, acc[i8 * 8 + 1] * rl), pk2(acc[i8 * 8 + 2] * rl, acc[i8 * 8 + 3] * rl), pk2(acc[i8 * 8 + 4] * rl, acc[i8 * 8 + 5] * rl), pk2(acc[i8 * 8 + 6] * rl, acc[i8 * 8 + 7] * rl)};
}

DI void pool_unit(const Frame& F, int li, size_t seq_row0, int L, int t0) {
    float* us = (float*)F.lds;
    float* df = us + 80 * 256;
    const bf16_t* PL = WSP(bf16_t, WS_PL);
    __syncthreads();
    for (int i = F.tid; i < 80 * 32; i += NTHR) {
        const int tt = i >> 5, c8 = i & 31, t = t0 - 8 + tt;
        float v[8] = {0.f, 0.f, 0.f, 0.f, 0.f, 0.f, 0.f, 0.f};
        if (t >= 0 && t < L) { const u32x4 x = *(const u32x4*)(PL + (seq_row0 + t) * 256 + c8 * 8);
#pragma unroll
            for (int e = 0; e < 4; ++e) { v[2 * e] = __uint_as_float(x[e] << 16); v[2 * e + 1] = __uint_as_float(x[e] & 0xffff0000u); } }
#pragma unroll
        for (int e = 0; e < 8; ++e) us[tt * 256 + c8 * 8 + e] = v[e];
    }
    __syncthreads();
    for (int i = F.tid; i < 64 * 256; i += NTHR) {
        const int tl = i >> 8, ch = i & 255, g = ch >> 6, t = t0 + tl; const int hw = 1 << g;
        int lo = t - hw; lo = lo < 0 ? 0 : lo; int hi = t + hw; hi = hi > L ? L : hi;
        float s = 0.f;
        for (int tt = lo; tt < hi; ++tt) s += us[(tt - t0 + 8) * 256 + ch];
        df[tl * 256 + ch] = s / (float)(hi - lo) - us[(tl + 8) * 256 + ch];
    }
    __syncthreads();
    const float* pw = F.in[I_POOLW] + (size_t)li * 4 * 64 * 64; const float* ps = F.in[I_POOLS] + li * 256;
    bf16_t* mix = WSP(bf16_t, WS_HBF);
    {
        const int ch = F.tid & 255, th = F.tid >> 8, g = ch >> 6, j = ch & 63;
        float w[64];
#pragma unroll
        for (int i = 0; i < 64; ++i) w[i] = pw[((size_t)g * 64 + i) * 64 + j];
        const float scale = ps[ch];
        for (int tl = th * 32; tl < th * 32 + 32; ++tl) {
            float a = 0.f;
#pragma unroll
            for (int i = 0; i < 64; ++i) a += df[tl * 256 + g * 64 + i] * w[i];
            mix[(seq_row0 + t0 + tl) * D + 512 + ch] = f2bf(a * scale);
        }
    }
}

DI float hy_norm(const float* part, int ntile, int o, int ch) {
    float s = 0.f;
    for (int t = 0; t < ntile; ++t) s += part[(size_t)t * 1024 + (o * 2) * 256 + ch] + part[(size_t)t * 1024 + (o * 2 + 1) * 256 + ch];
    return rsqrtf(s + EPS);
}
DI float hy_short(const bf16_t* p, int t, int L, float w0, float w1, float w2, float bb) {
    const float a = t > 0 ? bf2f(p[t - 1]) : 0.f, c = t + 1 < L ? bf2f(p[t + 1]) : 0.f;
    return a * w0 + bf2f(p[t]) * w1 + c * w2 + bb;
}
DI void hy_conv(const float* vb, const float* hf, const float* hb, int t0, float (&acc)[2][16]) {
#pragma unroll
    for (int b = 0; b < 2; ++b)
#pragma unroll
        for (int i = 0; i < 16; ++i) acc[b][i] = 0.f;
#pragma unroll 1
    for (int s0 = 0; s0 < S; s0 += 16) {
        float kw[31];
#pragma unroll
        for (int i = 0; i < 31; ++i) { const int dl = t0 - s0 - 15 + i; const float* p = dl >= 0 ? hf : hb; kw[i] = p[dl >= 0 ? dl : -dl]; }
#pragma unroll
        for (int j4 = 0; j4 < 4; ++j4) {
            const f32x4 va = *(const f32x4*)(vb + s0 + 4 * j4), vc = *(const f32x4*)(vb + S + s0 + 4 * j4);
#pragma unroll
            for (int e = 0; e < 4; ++e) { const int jj = 4 * j4 + e;
#pragma unroll
                for (int ii = 0; ii < 16; ++ii) { acc[0][ii] += kw[ii - jj + 15] * va[e]; acc[1][ii] += kw[ii - jj + 15] * vc[e]; } }
        }
    }
}
DI void hyena_unit(const Frame& F, int li, int ch) {
    float* vb = (float*)F.lds;
    const bf16_t* HYT = WSP(bf16_t, WS_HYT); const float* filt = WSP(float, WS_FILT); float* zb = WSP(float, WS_ZBUF) + (size_t)ch * 2 * S;
    const float* sw = F.in[I_HYSW] + (size_t)li * 3 * 768; const float* sb = F.in[I_HYSB] + li * 768; const float* sk = F.in[I_HSKIP] + li * 512;
    const float n0 = hy_norm(WSP(float, WS_FPART), 256, 0, ch), n1 = hy_norm(WSP(float, WS_FPART), 256, 1, ch);
    __syncthreads();
    for (int i = F.tid; i < 2 * S; i += NTHR) { const int b = i >> 14, t = i & (S - 1); const int c = 512 + ch;
        vb[i] = hy_short(HYT + ((size_t)b * 768 + c) * S, t, S, sw[c], sw[768 + c], sw[1536 + c], sb[c]); }
    __syncthreads();
    float acc[2][16];
#pragma unroll 1
    for (int half = 0; half < 2; ++half) {
        const int t0 = F.tid * 32 + half * 16;
        hy_conv(vb, filt + ((size_t)0 * 256 + ch) * S, filt + ((size_t)1 * 256 + ch) * S, t0, acc);
#pragma unroll
        for (int b = 0; b < 2; ++b)
#pragma unroll
            for (int i = 0; i < 16; ++i) { const int t = t0 + i;
                const float x1 = hy_short(HYT + ((size_t)b * 768 + ch) * S, t, S, sw[ch], sw[768 + ch], sw[1536 + ch], sb[ch]);
                zb[b * S + t] = x1 * (acc[b][i] * n0 + sk[ch] * vb[b * S + t]); }
    }
    __syncthreads();
    for (int i = F.tid; i < 2 * S; i += NTHR) vb[i] = zb[i];
    __syncthreads();
    bf16_t* mix = WSP(bf16_t, WS_HBF);
#pragma unroll 1
    for (int half = 0; half < 2; ++half) {
        const int t0 = F.tid * 32 + half * 16;
        hy_conv(vb, filt + ((size_t)2 * 256 + ch) * S, filt + ((size_t)3 * 256 + ch) * S, t0, acc);
#pragma unroll
        for (int b = 0; b < 2; ++b)
#pragma unroll
            for (int i = 0; i < 16; ++i) { const int t = t0 + i; const int c = 256 + ch;
                const float x2 = hy_short(HYT + ((size_t)b * 768 + c) * S, t, S, sw[c], sw[768 + c], sw[1536 + c], sb[c]);
                mix[((size_t)b * S + t) * D + 768 + ch] = f2bf(x2 * (acc[b][i] * n1 + sk[256 + ch] * vb[b * S + t])); }
    }
}
DI void hyena_ctx_unit(const Frame& F, int li, int ch) {
    float* vs = (float*)F.lds;
    float* zs = vs + 512;
    float* fl = zs + 512;
    const bf16_t* HYC = WSP(bf16_t, WS_HYC); const float* filt = WSP(float, WS_FILTC);
    const float* sw = F.in[I_HYSW] + (size_t)li * 3 * 768; const float* sb = F.in[I_HYSB] + li * 768; const float* sk = F.in[I_HSKIP] + li * 512;
    const float n0 = hy_norm(WSP(float, WS_FPARTC), 4, 0, ch), n1 = hy_norm(WSP(float, WS_FPARTC), 4, 1, ch);
    const int b = F.tid >> 8, t = F.tid & 255;
    auto sc = [&](int c) -> float { const bf16_t* p = HYC + (size_t)(b * CTX) * 768 + c;
        const float a = t > 0 ? bf2f(p[(size_t)(t - 1) * 768]) : 0.f, d = t + 1 < CTX ? bf2f(p[(size_t)(t + 1) * 768]) : 0.f;
        return a * sw[c] + bf2f(p[(size_t)t * 768]) * sw[768 + c] + d * sw[1536 + c] + sb[c]; };
    __syncthreads();
    const float x1 = sc(ch), x2 = sc(256 + ch), v = sc(512 + ch);
    vs[F.tid] = v;
    for (int i = F.tid; i < 1024; i += NTHR) fl[i] = filt[((size_t)(i >> 8) * 256 + ch) * CTX + (i & 255)];
    __syncthreads();
    float a = 0.f;
    for (int s = 0; s < CTX; ++s) { const int dl = t - s; a += (dl >= 0 ? fl[dl] : fl[256 - dl]) * vs[b * 256 + s]; }
    const float z = x1 * (a * n0 + sk[ch] * v);
    zs[F.tid] = z;
    __syncthreads();
    a = 0.f;
    for (int s = 0; s < CTX; ++s) { const int dl = t - s; a += (dl >= 0 ? fl[512 + dl] : fl[768 - dl]) * zs[b * 256 + s]; }
    WSP(bf16_t, WS_HBF)[((size_t)NLAT + b * CTX + t) * D + 768 + ch] = f2bf(x2 * (a * n1 + sk[256 + ch] * z));
}

DI void phase_mix(const Frame& F0, int li) {
    const Frame& F = F0;
    unsigned* head = F.ctl + CW_QHEAD + li * 64;
    volatile unsigned* qs = (volatile unsigned*)(F.lds + LDS_MISC + 32);
    const int n_hy = 256, n_da = 512, n_na = 256, n_pl = 512;
    const int n_ctx = (li == 0) ? (4 + 4 + 8 + 256) : 0;
    const int total = n_hy + n_da + n_na + n_pl + n_ctx;
    for (;;) {
        __syncthreads();
        if (F.tid == 0) qs[0] = __hip_atomic_fetch_add(head, 1u, __ATOMIC_RELAXED, __HIP_MEMORY_SCOPE_AGENT);
        __syncthreads();
        int u = (int)qs[0];
        if (u >= total) break;
        Frame F = F0; refresh(F);
        if (u < n_hy) {
#ifndef SKIP_HY
 hyena_unit(F, li, u);
#endif
 continue; }
        u -= n_hy;
        if (u < n_da) {
#ifndef SKIP_DA
 diffattn_unit(F, li, u >> 8, (u >> 6) & 3, u & 63);
#endif
 continue; }
        u -= n_da;
        if (u < n_na) {
#ifndef SKIP_NA
 na_unit(F, li, u);
#endif
 continue; }
        u -= n_na;
        if (u < n_pl) {
#ifndef SKIP_PL
 pool_unit(F, li, (size_t)(u >> 8) * S, S, (u & 255) * 64);
#endif
 continue; }
        u -= n_pl;
        if (u < 4) {
#ifndef SKIP_CA
 ctx_attn_a_unit(F, li, u);
#endif
 continue; }
        u -= 4;
        if (u < 4) {
#ifndef SKIP_CB
 ctx_attn_b_unit(F, u);
#endif
 continue; }
        u -= 4;
        if (u < 8) {
#ifndef SKIP_PL
 pool_unit(F, li, (size_t)NLAT + (u >> 2) * CTX, CTX, (u & 3) * 64);
#endif
 continue; }
        u -= 8;
#ifndef SKIP_HC
        hyena_ctx_unit(F, li, u);
#endif
    }
}

constexpr int PH_PER_LAYER = 8, NPH = 2 + 2 * PH_PER_LAYER;
__global__ void __launch_bounds__(NTHR, 2) mega(Args args) {
    extern __shared__ __attribute__((aligned(16))) unsigned char smem[];
    Frame F;
    F.in = args.in; F.out = args.out; F.ws = args.ws; F.ctl = (unsigned*)(args.ws + WS_CTL); F.lds = smem;
    F.tid = threadIdx.x; F.lane = F.tid & 63; F.wave = __builtin_amdgcn_readfirstlane(F.tid >> 6); F.G = gridDim.x; F.bid = blockIdx.x;
    if (F.tid < 64) ((unsigned*)(smem + LDS_MISC))[F.tid] = 0u;
    __syncthreads();
    const int lo = args.ph_lo, hi = args.ph_hi;
    const bool fused = (hi - lo) > 1;
    XcdBarrier bar; bar.bar = F.ctl; bar.x = 0; bar.st = (volatile LAS unsigned*)(smem + LDS_MISC);
    if (fused) bar = xcd_barrier_post(F.ctl, (volatile LAS unsigned*)(smem + LDS_MISC));
#define IN(k) (lo <= (k) && (k) < hi)
#define SEAM(k) do { if (IN(k) && IN((k) + 1)) xcd_barrier(bar); } while (0)
#ifndef SKIP_P0
    if (IN(0)) { refresh(F); phase_prologue(F); }
#endif
    SEAM(0);
    for (int li = 0; li < 2; ++li) {
        const int p0 = 1 + li * PH_PER_LAYER;
        const int nrows = (li == 0) ? NTOK : NLAT;
        if (IN(p0)) {
            refresh(F);
            phase_norm1(F, li, li == 0 ? 0 : 1);
            refresh(F);
#ifndef SKIP_FILT
            for (int t = F.bid; t < 256; t += F.G) filter_tile(F, li, S, t, WSP(float, WS_FILT), WSP(float, WS_FPART));
            if (li == 0) for (int t = F.bid; t < 4; t += F.G) filter_tile(F, li, CTX, t, WSP(float, WS_FILTC), WSP(float, WS_FPARTC));
#endif
        }
        SEAM(p0);
        if (IN(p0 + 1)) {
            refresh(F);
            pg8::Gemm g{WSP(bf16_t, WS_HBF), WSP(bf16_t, WS_WIN) + (size_t)li * DIN * D, D, 0};
            pg8::StaticOrder So; So.init(NTOK, DIN, F.G, F.bid);
            EpiIn E{F.ws, WSP(float, WS_ROPE), F.ctl + CW_KMAX + li * 16};
#ifndef SKIP_G1
            pg8::gemm_phase<EpiIn, pg8::StaticOrder>((LAS unsigned char*)smem, g, So, E, F.tid);
#endif
        }
        SEAM(p0 + 1);
        if (IN(p0 + 2)) { refresh(F); phase_mix(F, li); }
        SEAM(p0 + 2);
        if (IN(p0 + 3)) {
            refresh(F);
            pg8::Gemm g{WSP(bf16_t, WS_HBF), WSP(bf16_t, WS_WOUT) + (size_t)li * D * D, D, 0};
            pg8::StaticOrder So; So.init(nrows, D, F.G, F.bid);
            EpiOut E{li == 0 ? F.in[I_X] : F.out, li == 0 ? F.in[I_CTX] : WSP(float, WS_XC), F.out, WSP(float, WS_XC), WSP(float, WS_MOD) + (size_t)li * 3 * 6144};
#ifndef SKIP_G2
            pg8::gemm_phase<EpiOut, pg8::StaticOrder>((LAS unsigned char*)smem, g, So, E, F.tid);
#endif
        }
        SEAM(p0 + 3);
#ifndef SKIP_N2
        if (IN(p0 + 4)) { refresh(F); phase_norm2(F, li, nrows); }
#endif
        SEAM(p0 + 4);
        if (IN(p0 + 5)) { refresh(F); phase_gather(F, li, nrows); }
        SEAM(p0 + 5);
        if (IN(p0 + 6)) {
            refresh(F);
            int* offs = (int*)(smem + LDS_MISC + 64);
            moe_offsets(F, li, offs);
            pg8::Gemm g{WSP(bf16_t, WS_A1), WSP(bf16_t, WS_W13) + (size_t)li * NE * 1024 * 1024, D, (size_t)1024 * 1024};
            pg8::MoeOrder Mo{offs + 40, offs[17 + 16], 4, F.G, F.bid};
            EpiMoe1 E{WSP(bf16_t, WS_HMID)};
#ifndef SKIP_G3
            pg8::gemm_phase<EpiMoe1, pg8::MoeOrder>((LAS unsigned char*)smem, g, Mo, E, F.tid);
#endif
        }
        SEAM(p0 + 6);
        if (IN(p0 + 7)) {
            refresh(F);
            int* offs = (int*)(smem + LDS_MISC + 64);
            moe_offsets(F, li, offs);
            pg8::Gemm g{WSP(bf16_t, WS_HMID), WSP(bf16_t, WS_W2) + (size_t)li * NE * 1024 * 512, DE, (size_t)1024 * 512};
            pg8::MoeOrder Mo{offs + 40, offs[17 + 16], 4, F.G, F.bid};
            EpiMoe2 E{WSP(bf16_t, WS_A1)};
#ifndef SKIP_G4
            pg8::gemm_phase<EpiMoe2, pg8::MoeOrder>((LAS unsigned char*)smem, g, Mo, E, F.tid);
#endif
        }
        SEAM(p0 + 7);
    }
    if (IN(NPH - 1)) { refresh(F); phase_norm1(F, 1, 2); }
#undef IN
#undef SEAM
}

extern "C" void kernel_launch(void* const* d_in, const int* in_sizes, int n_in, void* d_out, int out_size, void* d_ws, size_t ws_size, hipStream_t stream) {
    static int grid = 0;
    if (grid == 0) {
        if (n_in != N_IN || out_size != NLAT * D || ws_size < WS_END) { fprintf(stderr, "kernel_launch: unexpected shapes (n_in %d out %d ws %zu need %zu)\n", n_in, out_size, ws_size, (size_t)WS_END); grid = -1; return; }
        int dev = 0, cus = 0, per_cu = 0;
        if (hipGetDevice(&dev) != hipSuccess || hipDeviceGetAttribute(&cus, hipDeviceAttributeMultiprocessorCount, dev) != hipSuccess) { grid = -1; return; }
        if (hipFuncSetAttribute((const void*)mega, hipFuncAttributeMaxDynamicSharedMemorySize, LDS_BYTES) != hipSuccess) { fprintf(stderr, "kernel_launch: hipFuncSetAttribute failed\n"); grid = -1; return; }
        if (hipOccupancyMaxActiveBlocksPerMultiprocessor(&per_cu, (const void*)mega, NTHR, LDS_BYTES) != hipSuccess || per_cu < 1) { fprintf(stderr, "kernel_launch: occupancy query says %d\n", per_cu); }
        (void)hipGetLastError();
        grid = cus;
    }
    if (grid < 0) return;
    (void)hipMemsetAsync((char*)d_ws + WS_CTL, 0, CTL_BYTES, stream);
    Args a{};
    for (int i = 0; i < N_IN; ++i) a.in[i] = (const float*)d_in[i];
    a.out = (float*)d_out; a.ws = (unsigned char*)d_ws;
#if N_LAUNCH_MODE == 1
    a.ph_lo = 0; a.ph_hi = NPH;
    hipLaunchKernelGGL(mega, dim3(grid), dim3(NTHR), LDS_BYTES, stream, a);
#else
    for (int p = 0; p < NPH; ++p) { a.ph_lo = p; a.ph_hi = p + 1; hipLaunchKernelGGL(mega, dim3(grid), dim3(NTHR), LDS_BYTES, stream, a); }
#endif
}
#ifdef TEST_UNITS
__global__ void __launch_bounds__(NTHR, 2) t_da(Args args) {
    extern __shared__ __attribute__((aligned(16))) unsigned char smem[];
    Frame F; F.in = args.in; F.out = args.out; F.ws = args.ws; F.ctl = (unsigned*)(args.ws + WS_CTL); F.lds = smem; F.G = gridDim.x; F.bid = blockIdx.x; refresh(F);
    diffattn_unit(F, args.ph_lo, blockIdx.x >> 8, (blockIdx.x >> 6) & 3, blockIdx.x & 63);
}
#endif
```

```cpp
#include <hip/hip_runtime.h>
#include <stdint.h>
#include <stdio.h>

#ifndef N_LAUNCH_MODE
#define N_LAUNCH_MODE 1
#endif

#define DI __device__ __forceinline__
#define LAS __attribute__((address_space(3)))
typedef unsigned short bf16_t;
typedef short bf16x8 __attribute__((ext_vector_type(8)));
typedef short s16x4 __attribute__((ext_vector_type(4)));
typedef float f32x4 __attribute__((ext_vector_type(4)));
typedef float f32x2 __attribute__((ext_vector_type(2)));
typedef float f32x16 __attribute__((ext_vector_type(16)));
typedef unsigned u32x4 __attribute__((ext_vector_type(4)));
typedef unsigned u32x2 __attribute__((ext_vector_type(2)));

constexpr int D = 1024, NB = 2, S = 16384, CTX = 256, NLAT = NB * S, NCTX = NB * CTX, NTOK = NLAT + NCTX, DIN = 2560;
constexpr int NE = 16, DE = 512, GW = 64;
constexpr int NKEY = CTX + S;
constexpr int NTHR = 512;
constexpr int SLOT_CAP = 70656;
constexpr float EPS = 1e-6f;
constexpr float LOG2E = 1.4426950408889634f;
constexpr float QSCALE_A = 0.17677669529663687f * LOG2E;
constexpr float QSCALE_B = 0.125f * LOG2E;

enum { I_X = 0, I_C, I_CTX, I_CCTX, I_N1G, I_N2G, I_ADAW, I_ADAB, I_WIN, I_WOUT, I_ALAM, I_ASUB, I_RPB, I_POOLW, I_POOLS, I_HYSW, I_HYSB,
       I_HW1, I_HB1, I_HW2, I_HB2, I_HW3, I_HB3, I_HSKIP, I_RW, I_RB, I_MW1, I_MW3, I_MW2, I_FG, N_IN };

struct Args { const float* in[N_IN]; float* out; unsigned char* ws; int ph_lo, ph_hi; };

constexpr size_t al256(size_t x) { return (x + 255) & ~(size_t)255; }
constexpr size_t WS_CTL = 0, CTL_BYTES = 65536;
constexpr size_t WS_MOD = WS_CTL + CTL_BYTES;
constexpr size_t WS_ROPE = WS_MOD + al256(2 * 3 * 6144 * 4);
constexpr size_t WS_FPART = WS_ROPE + 16384;
constexpr size_t WS_FPARTC = WS_FPART + 256 * 1024 * 4;
constexpr size_t WS_XC = WS_FPARTC + 4 * 1024 * 4;
constexpr size_t WS_WIN = WS_XC + (size_t)NCTX * D * 4;
constexpr size_t WS_WOUT = WS_WIN + (size_t)2 * DIN * D * 2;
constexpr size_t WS_W13 = WS_WOUT + (size_t)2 * D * D * 2;
constexpr size_t WS_W2 = WS_W13 + (size_t)2 * NE * 1024 * 1024 * 2;
constexpr size_t WS_FILT = WS_W2 + (size_t)2 * NE * 1024 * 512 * 2;
constexpr size_t WS_FILTC = WS_FILT + (size_t)4 * 256 * S * 4;
constexpr size_t WS_ZBUF = WS_FILTC + (size_t)4 * 256 * 256 * 4;
constexpr size_t WS_R1 = WS_ZBUF + (size_t)256 * 2 * S * 4;
constexpr size_t WS_HBF = WS_R1;
constexpr size_t TOKB = (size_t)NTOK * 256 * 2;
constexpr size_t WS_AQ = WS_HBF + (size_t)NTOK * D * 2;
constexpr size_t WS_AK = WS_AQ + TOKB;
constexpr size_t WS_AVT = WS_AK + TOKB;
constexpr size_t WS_BQ = WS_AVT + (size_t)NB * 4 * 64 * NKEY * 2;
constexpr size_t WS_BK = WS_BQ + TOKB;
constexpr size_t WS_BV = WS_BK + TOKB;
constexpr size_t WS_PL = WS_BV + TOKB;
constexpr size_t WS_HYT = WS_PL + TOKB;
constexpr size_t WS_HYC = WS_HYT + (size_t)NB * 768 * S * 2;
constexpr size_t WS_END_MIX = WS_HYC + (size_t)NCTX * 768 * 2;
constexpr size_t WS_TOK = WS_AQ;
constexpr size_t WS_A1 = WS_TOK + al256((size_t)NTOK * 32);
constexpr size_t WS_HMID = WS_A1 + (size_t)SLOT_CAP * D * 2;
constexpr size_t WS_END_MOE = WS_HMID + (size_t)SLOT_CAP * DE * 2;
constexpr size_t WS_END = WS_END_MIX > WS_END_MOE ? WS_END_MIX : WS_END_MOE;

#define XB_TMO      128
#define XB_XCNT(j)  (256  + 64 * (j))
#define XB_XSUB(j)  (1280 + 64 * (j))
#define XB_XGEN(j)  (2304 + 64 * (j))
#define XB_TOP      3328
#define XB_TOPGEN   3392
#define XCD_BAR_WORDS 3456
#define XB_SPIN_CAP (1u << 18)
constexpr int CW_CNT = 4096;
constexpr int CW_KMAX = 4160;
constexpr int CW_QHEAD = 4224;

constexpr int LDS_MAIN = 131072, LDS_MISC = LDS_MAIN, LDS_BYTES = LDS_MAIN + 2048;

DI float bf2f(bf16_t v) { return __uint_as_float(((unsigned)v) << 16); }
DI bf16_t f2bf(float f) { unsigned u = __float_as_uint(f); u += 0x7FFFu + ((u >> 16) & 1u); return (bf16_t)(u >> 16); }
DI unsigned pk2(float lo, float hi) { unsigned r; asm volatile("v_cvt_pk_bf16_f32 %0, %1, %2" : "=v"(r) : "v"(lo), "v"(hi)); return r; }
DI float wave_sum(float v) { for (int o = 32; o > 0; o >>= 1) v += __shfl_xor(v, o); return v; }
DI float wave_max(float v) { for (int o = 32; o > 0; o >>= 1) v = fmaxf(v, __shfl_xor(v, o)); return v; }
DI float siluf(float x) { return x / (1.f + __expf(-x)); }
DI float sin_rev(float rev) { return __builtin_amdgcn_sinf(rev - floorf(rev)); }
DI float cos_rev(float rev) { return __builtin_amdgcn_cosf(rev - floorf(rev)); }
DI float sin_rad(float x) { return sin_rev(x * 0.15915494309189535f); }

DI unsigned xb_ld(unsigned* p)              { return __hip_atomic_load(p, __ATOMIC_RELAXED, __HIP_MEMORY_SCOPE_AGENT); }
DI unsigned xb_add(unsigned* p, unsigned v) { return __hip_atomic_fetch_add(p, v, __ATOMIC_RELAXED, __HIP_MEMORY_SCOPE_AGENT); }
DI unsigned xb_xcc_id() { return (unsigned)__builtin_amdgcn_s_getreg((3 << 11) | 20) & 0xFu; }
#define XB_SPIN(cond, bar) do { unsigned _sp = 0; while (cond) { __builtin_amdgcn_s_sleep(1); \
    if ((++_sp & 255u) == 0u) { if (xb_ld(&(bar)[XB_TMO])) break; if (_sp > XB_SPIN_CAP) { atomicAdd(&(bar)[XB_TMO], 1u); break; } } } } while (0)
struct XcdBarrier { unsigned* bar; unsigned x; volatile LAS unsigned* st; };
DI XcdBarrier xcd_barrier_post(unsigned* bar, volatile LAS unsigned* st) {
    XcdBarrier b; b.bar = bar; b.x = xb_xcc_id(); b.st = st;
    if (threadIdx.x == 0) (void)xb_add(&bar[XB_XCNT(b.x)], 1u);
    return b;
}
DI void xcd_barrier_complete(unsigned* bar, unsigned x, unsigned& nloc, unsigned& nx) {
    const unsigned G = gridDim.x * gridDim.y * gridDim.z;
    unsigned sum, cnt, mine, sp = 0u;
    for (;;) {
        sum = 0u; cnt = 0u; mine = 0u;
#pragma unroll
        for (unsigned j = 0; j < 16; ++j) { const unsigned c = xb_ld(&bar[XB_XCNT(j)]); sum += c; cnt += (c > 0u) ? 1u : 0u; mine = (j == x) ? c : mine; }
        if (sum == G) break;
        __builtin_amdgcn_s_sleep(1);
        if ((++sp & 255u) == 0u) { if (xb_ld(&bar[XB_TMO])) break; if (sp > XB_SPIN_CAP) { atomicAdd(&bar[XB_TMO], 1u); break; } }
    }
    nloc = mine > 0u ? mine : 1u; nx = cnt > 0u ? cnt : 1u;
}
DI void xcd_barrier(const XcdBarrier& b) {
    asm volatile("s_waitcnt vmcnt(0)" ::: "memory");
    __syncthreads();
    if (threadIdx.x == 0) {
        unsigned* bar = b.bar;
        __builtin_amdgcn_s_waitcnt(0);
        unsigned nloc = b.st[0], nx = b.st[1];
        if (nloc == 0u) { xcd_barrier_complete(bar, b.x, nloc, nx); b.st[0] = nloc; b.st[1] = nx; }
        const unsigned old = xb_add(&bar[XB_XSUB(b.x)], 1u);
        const unsigned gen = old / nloc;
        if (old + 1u == (gen + 1u) * nloc) {
            __builtin_amdgcn_fence(__ATOMIC_RELEASE, "agent");
            asm volatile("s_waitcnt vmcnt(0)" ::: "memory");
            const unsigned og = xb_add(&bar[XB_TOP], 1u);
            const unsigned tg = og / nx;
            if (og + 1u == (tg + 1u) * nx) xb_add(&bar[XB_TOPGEN], 1u);
            else XB_SPIN(xb_ld(&bar[XB_TOPGEN]) == tg, bar);
            __builtin_amdgcn_fence(__ATOMIC_ACQUIRE, "agent");
            xb_add(&bar[XB_XGEN(b.x)], 1u);
            asm volatile("s_waitcnt vmcnt(0)" ::: "memory");
        } else {
            XB_SPIN(xb_ld(&bar[XB_XGEN(b.x)]) == gen, bar);
            __builtin_amdgcn_fence(__ATOMIC_ACQUIRE, "agent");
            asm volatile("s_waitcnt vmcnt(0)" ::: "memory");
        }
    }
    __syncthreads();
}

struct Frame {
    const float* const* in; float* out; unsigned char* ws; unsigned* ctl;
    unsigned char* lds;
    int tid, lane, wave, G, bid;
};
#define WSP(T, off) ((T*)(F.ws + (off)))
DI void refresh(Frame& F) { int t = threadIdx.x; asm volatile("" : "+v"(t)); F.tid = t; F.lane = t & 63; F.wave = __builtin_amdgcn_readfirstlane(t >> 6);
}

namespace pg8 {
constexpr int BM = 256, BK = 64, HALF = 128, HTB = HALF * BK * 2, STAGE_BYTES = 8 * HTB, NXCD = 8, WGM = 8;
DI int lds_byte(int r, int c) { const int st = (r >> 4) * 2 + (c >> 5), rr = r & 15, cc = c & 31, ob = rr * 64 + cc * 2; return st * 1024 + (ob ^ (((ob >> 9) & 1) << 5)); }
DI void stage_rc(int b, int& R, int& C) { const int st = b / 1024, sb = b % 1024, swz = sb ^ (((sb >> 9) & 1) << 5); R = (st >> 1) * 16 + swz / 64; C = (st & 1) * 32 + (swz % 64) / 2; }
struct Unit { int pm, pn, e; };
struct Gemm { const bf16_t* A; const bf16_t* Bt; int K; size_t bstride; };
struct StaticOrder {
    int nM, nN, nwg, G, c;
    DI void init(int M, int N, int G_, int c_) { nM = M / BM; nN = N / BM; nwg = nM * nN; G = G_; c = c_; }
    DI bool next(int i, Unit& u) const {
        const long L = (long)i * G + c; if (L >= nwg) return false;
        int wgid = (int)L; { const int q = nwg / NXCD, r = nwg % NXCD, xcd = wgid % NXCD, off = wgid / NXCD; wgid = (xcd < r ? xcd * (q + 1) : r * (q + 1) + (xcd - r) * q) + off; }
        const int nig = WGM * nN, gid = wgid / nig, fm = gid * WGM, gsz = (nM - fm) < WGM ? (nM - fm) : WGM;
        u.pm = fm + ((wgid % nig) % gsz); u.pn = (wgid % nig) / gsz; u.e = 0; return true;
    }
};
struct MoeOrder {
    const int* toff; int ntile, nN, G, c;
    DI bool next(int i, Unit& u) const {
        const long L = (long)i * G + c; if (L >= (long)ntile * nN) return false;
        const int t = (int)(L / nN); u.pm = t; u.pn = (int)(L % nN);
        u.e = toff[t]; return true;
    }
};

template <class Epi, class Sched>
DI void gemm_phase(LAS unsigned char* lds, const Gemm g, const Sched& S, const Epi& E, int tid) {
    const int wid = __builtin_amdgcn_readfirstlane(tid >> 6), lane = tid & 63, wr = wid >> 2, wc = wid & 3, fr = lane & 15, fq = lane >> 4;
    const int K = g.K, nt = K / BK;
    unsigned voffA[2];
#pragma unroll
    for (int i = 0; i < 2; ++i) { int R, C; stage_rc(tid * 16 + i * 8192, R, C); voffA[i] = (unsigned)(R * K + C) * 2u; }
    const size_t kstep = (size_t)(BK * 2);
    const size_t hstep = (size_t)HALF * K * 2;
    const size_t tstep = 2 * hstep;
    const unsigned ldsw = (unsigned)wid * 1024u;
    const int aoff = lds_byte(wr * 64 + fr, fq * 8), boff = lds_byte(wc * 32 + fr, fq * 8);
#define PG8_SA(b, h) (((b) * 2 + (h)) * HTB)
#define PG8_SB(b, h) ((4 + (b) * 2 + (h)) * HTB)
#define PG8_STAGE(bufoff, gbase, voff) do { _Pragma("unroll") for (int _i = 0; _i < 2; ++_i) \
        __builtin_amdgcn_global_load_lds((const unsigned*)((const char*)(gbase) + (voff)[_i]), (LAS unsigned*)(lds + (bufoff) + ldsw + _i * 8192), 16, 0, 0); } while (0)
#define PG8_LDA(dst, b, h) do { _Pragma("unroll") for (int m = 0; m < 4; ++m) _Pragma("unroll") for (int k = 0; k < 2; ++k) dst[m][k] = *(const LAS bf16x8*)(lds + PG8_SA(b, h) + aoff + m * 2048 + k * 1024); } while (0)
#define PG8_LDB(dst, b, h) do { _Pragma("unroll") for (int n = 0; n < 2; ++n) _Pragma("unroll") for (int k = 0; k < 2; ++k) dst[n][k] = *(const LAS bf16x8*)(lds + PG8_SB(b, h) + boff + n * 2048 + k * 1024); } while (0)
#define PG8_MMA(ai, bj, At, Bt) do { __builtin_amdgcn_s_setprio(1); _Pragma("unroll") for (int m = 0; m < 4; ++m) _Pragma("unroll") for (int n = 0; n < 2; ++n) _Pragma("unroll") for (int k = 0; k < 2; ++k) \
        acc[ai][bj][m][n] = __builtin_amdgcn_mfma_f32_16x16x32_bf16(Bt[n][k], At[m][k], acc[ai][bj][m][n], 0, 0, 0); __builtin_amdgcn_s_setprio(0); } while (0)
#define PG8_WAIT_V(n) asm volatile("s_waitcnt vmcnt(" #n ")" ::: "memory")
#define PG8_WAIT_L(n) asm volatile("s_waitcnt lgkmcnt(" #n ")" ::: "memory")
#define PG8_BAR __builtin_amdgcn_s_barrier()
#define PG8_SCHED __builtin_amdgcn_sched_barrier(0)
    Unit cur, nxt; int ui = 0;
    if (!S.next(0, cur)) return;
    f32x4 acc[2][2][4][2];
#pragma unroll
    for (int a = 0; a < 2; ++a)
#pragma unroll
        for (int b = 0; b < 2; ++b)
#pragma unroll
            for (int m = 0; m < 4; ++m)
#pragma unroll
                for (int n = 0; n < 2; ++n) acc[a][b][m][n] = (f32x4){0.f, 0.f, 0.f, 0.f};
    bf16x8 At[4][2], B0[2][2], B1[2][2];
    const char* cA = (const char*)g.A + (size_t)cur.pm * tstep; const char* cB = (const char*)(g.Bt + (size_t)cur.e * g.bstride) + (size_t)cur.pn * tstep;
    PG8_STAGE(PG8_SB(0, 0), cB, voffA); PG8_STAGE(PG8_SA(0, 0), cA, voffA); PG8_STAGE(PG8_SB(0, 1), cB + hstep, voffA); PG8_STAGE(PG8_SA(0, 1), cA + hstep, voffA);
    if (wr == 1) PG8_BAR;
    PG8_WAIT_V(4); PG8_BAR;
    PG8_STAGE(PG8_SB(1, 0), cB + kstep, voffA); PG8_STAGE(PG8_SA(1, 0), cA + kstep, voffA); PG8_STAGE(PG8_SB(1, 1), cB + hstep + kstep, voffA);
    PG8_WAIT_V(6); PG8_BAR;
    for (;;) {
        const bool has_next = S.next(ui + 1, nxt);
        const char* nA = has_next ? (const char*)g.A + (size_t)nxt.pm * tstep : cA; const char* nB = has_next ? (const char*)(g.Bt + (size_t)nxt.e * g.bstride) + (size_t)nxt.pn * tstep : cB;
        for (int t = 0; t < nt; t += 2) {
            const bool last = (t == nt - 2);
            const char* a1 = cA + (size_t)(t + 1) * kstep;
            const char* a2 = last ? nA : cA + (size_t)(t + 2) * kstep; const char* b2 = last ? nB : cB + (size_t)(t + 2) * kstep;
            const char* a3 = a2 + kstep; const char* b3 = b2 + kstep;
            PG8_LDB(B0, 0, 0); PG8_SCHED; PG8_LDA(At, 0, 0); PG8_STAGE(PG8_SA(1, 1), a1 + hstep, voffA);
            PG8_WAIT_L(8); PG8_BAR; PG8_WAIT_L(0); PG8_MMA(0, 0, At, B0); PG8_BAR; PG8_SCHED;
            PG8_LDB(B1, 0, 1); PG8_STAGE(PG8_SB(0, 0), b2, voffA);
            PG8_BAR; PG8_WAIT_L(0); PG8_MMA(0, 1, At, B1); PG8_BAR;
            PG8_LDA(At, 0, 1); PG8_STAGE(PG8_SA(0, 0), a2, voffA);
            PG8_BAR; PG8_WAIT_L(0); PG8_MMA(1, 0, At, B0); PG8_BAR; PG8_SCHED;
            PG8_STAGE(PG8_SB(0, 1), b2 + hstep, voffA);
            PG8_WAIT_V(6); PG8_BAR; PG8_MMA(1, 1, At, B1); PG8_BAR;
            PG8_LDB(B0, 1, 0); PG8_SCHED; PG8_LDA(At, 1, 0); PG8_STAGE(PG8_SA(0, 1), a2 + hstep, voffA);
            PG8_WAIT_L(8); PG8_BAR; PG8_WAIT_L(0); PG8_MMA(0, 0, At, B0); PG8_BAR; PG8_SCHED;
            PG8_LDB(B1, 1, 1); PG8_STAGE(PG8_SB(1, 0), b3, voffA);
            PG8_BAR; PG8_WAIT_L(0); PG8_MMA(0, 1, At, B1); PG8_BAR;
            PG8_LDA(At, 1, 1); PG8_STAGE(PG8_SA(1, 0), a3, voffA);
            PG8_BAR; PG8_WAIT_L(0); PG8_MMA(1, 0, At, B0); PG8_BAR; PG8_SCHED;
            PG8_STAGE(PG8_SB(1, 1), b3 + hstep, voffA);
            PG8_WAIT_V(6); PG8_BAR; PG8_MMA(1, 1, At, B1); PG8_BAR;
        }
        E(acc, cur, wr, wc, fr, fq);
        if (!has_next) break;
#pragma unroll
        for (int a = 0; a < 2; ++a)
#pragma unroll
            for (int b = 0; b < 2; ++b)
#pragma unroll
                for (int m = 0; m < 4; ++m)
#pragma unroll
                    for (int n = 0; n < 2; ++n) acc[a][b][m][n] = (f32x4){0.f, 0.f, 0.f, 0.f};
        cur = nxt; cA = nA; cB = nB; ++ui;
    }
    PG8_WAIT_V(0);
    if (wr == 0) PG8_BAR;
    PG8_BAR;
#undef PG8_SA
#undef PG8_SB
#undef PG8_STAGE
#undef PG8_LDA
#undef PG8_LDB
#undef PG8_MMA
#undef PG8_WAIT_V
#undef PG8_WAIT_L
#undef PG8_BAR
#undef PG8_SCHED
}
}

typedef f32x4 AccT[2][2][4][2];

struct EpiIn {
    unsigned char* ws; const float* rope; unsigned* kmax;
    DI void operator()(const AccT& acc, const pg8::Unit& u, int wr, int wc, int fr, int fq) const {
        const int pn = u.pn, row0 = u.pm * 256 + wr * 64 + fr;
        const bool isctx = (u.pm >= NLAT / 256);
        if (pn <= 1) {
            bf16_t* dst = (bf16_t*)(ws + (pn == 0 ? WS_AQ : WS_AK));
            const float sc = (pn == 0) ? QSCALE_A : 1.f;
            float nmax[2] = {0.f, 0.f};
#pragma unroll
            for (int ai = 0; ai < 2; ++ai)
#pragma unroll
                for (int m = 0; m < 4; ++m) {
                    const int r = row0 + ai * 128 + m * 16;
                    f32x4 cs0 = (f32x4){1.f, 0.f, 1.f, 0.f}, cs1 = cs0;
                    if (!isctx) { const int t = r & (S - 1); const int pos = (fq < 2) ? (t >> 6) : (t & 63);
                        const f32x4* tp = (const f32x4*)(rope + (size_t)pos * 16 + (fq & 1) * 8); cs0 = tp[0]; cs1 = tp[1]; }
                    const float cc[4] = {cs0[0], cs0[2], cs1[0], cs1[2]}, ss[4] = {cs0[1], cs0[3], cs1[1], cs1[3]};
#pragma unroll
                    for (int bj = 0; bj < 2; ++bj) {
                        const f32x4 x1 = acc[ai][bj][m][0], x2 = acc[ai][bj][m][1];
                        float o1[4], o2[4], n2 = 0.f;
#pragma unroll
                        for (int j = 0; j < 4; ++j) { o1[j] = (x1[j] * cc[j] - x2[j] * ss[j]) * sc; o2[j] = (x2[j] * cc[j] + x1[j] * ss[j]) * sc; n2 += x1[j] * x1[j] + x2[j] * x2[j]; }
                        bf16_t* p = dst + (size_t)r * 256 + bj * 128 + wc * 32 + 4 * fq;
                        *(u32x2*)p = (u32x2){pk2(o1[0], o1[1]), pk2(o1[2], o1[3])};
                        *(u32x2*)(p + 16) = (u32x2){pk2(o2[0], o2[1]), pk2(o2[2], o2[3])};
                        if (pn == 1) { n2 += __shfl_xor(n2, 16); n2 += __shfl_xor(n2, 32); nmax[bj] = fmaxf(nmax[bj], n2); }
                    }
                }
            if (pn == 1) {
                const int b = isctx ? (u.pm - NLAT / 256) : (u.pm / (S / 256));
#pragma unroll
                for (int bj = 0; bj < 2; ++bj) {
                    float v = nmax[bj];
                    v = fmaxf(v, __shfl_xor(v, 1)); v = fmaxf(v, __shfl_xor(v, 2)); v = fmaxf(v, __shfl_xor(v, 4)); v = fmaxf(v, __shfl_xor(v, 8));
                    if ((fr | fq) == 0) atomicMax(kmax + (b * 4 + (2 * bj + (wc >> 1))) * 2 + (wc & 1), __float_as_uint(v));
                }
            }
        } else if (pn == 2) {
            bf16_t* dst = (bf16_t*)(ws + WS_AVT);
#pragma unroll
            for (int ai = 0; ai < 2; ++ai)
#pragma unroll
                for (int m = 0; m < 4; ++m) {
                    const int r = row0 + ai * 128 + m * 16;
                    int b, key; if (isctx) { b = (r - NLAT) >> 8; key = (r - NLAT) & 255; } else { b = r >> 14; key = CTX + (r & (S - 1)); }
#pragma unroll
                    for (int bj = 0; bj < 2; ++bj)
#pragma unroll
                        for (int n = 0; n < 2; ++n) {
                            const int lc = bj * 128 + wc * 32 + n * 16 + 4 * fq;
#pragma unroll
                            for (int j = 0; j < 4; ++j) dst[((size_t)(b * 256 + lc + j)) * NKEY + key] = f2bf(acc[ai][bj][m][n][j]);
                        }
                }
        } else if (pn <= 6) {
            bf16_t* dst = (bf16_t*)(ws + (pn == 3 ? WS_BQ : pn == 4 ? WS_BK : pn == 5 ? WS_BV : WS_PL));
            const float sc = (pn == 3) ? QSCALE_B : 1.f;
#pragma unroll
            for (int ai = 0; ai < 2; ++ai)
#pragma unroll
                for (int m = 0; m < 4; ++m) {
                    const int r = row0 + ai * 128 + m * 16;
#pragma unroll
                    for (int bj = 0; bj < 2; ++bj)
#pragma unroll
                        for (int n = 0; n < 2; ++n) {
                            const f32x4 v = acc[ai][bj][m][n] * sc;
                            *(u32x2*)(dst + (size_t)r * 256 + bj * 128 + wc * 32 + n * 16 + 4 * fq) = (u32x2){pk2(v[0], v[1]), pk2(v[2], v[3])};
                        }
                }
        } else {
            const int hc0 = (pn - 7) * 256;
#pragma unroll
            for (int ai = 0; ai < 2; ++ai)
#pragma unroll
                for (int m = 0; m < 4; ++m) {
                    const int r = row0 + ai * 128 + m * 16;
#pragma unroll
                    for (int bj = 0; bj < 2; ++bj)
#pragma unroll
                        for (int n = 0; n < 2; ++n) {
                            const int hc = hc0 + bj * 128 + wc * 32 + n * 16 + 4 * fq; const f32x4 v = acc[ai][bj][m][n];
                            if (isctx) *(u32x2*)((bf16_t*)(ws + WS_HYC) + (size_t)(r - NLAT) * 768 + hc) = (u32x2){pk2(v[0], v[1]), pk2(v[2], v[3])};
                            else { bf16_t* dst = (bf16_t*)(ws + WS_HYT) + ((size_t)(r >> 14) * 768 + hc) * S + (r & (S - 1));
#pragma unroll
                                for (int j = 0; j < 4; ++j) dst[(size_t)j * S] = f2bf(v[j]); }
                        }
                }
        }
    }
};

struct EpiOut {
    const float* xl_old; const float* xc_old; float* xl_new; float* xc_new; const float* mod;
    DI void operator()(const AccT& acc, const pg8::Unit& u, int wr, int wc, int fr, int fq) const {
        const int row0 = u.pm * 256 + wr * 64 + fr; const bool isctx = (u.pm >= NLAT / 256);
        const int v = isctx ? 2 : (u.pm / (S / 256));
        const float* g1 = mod + (size_t)v * 6144 + 2 * 1024;
        const float* so = isctx ? xc_old - (size_t)NLAT * D : xl_old; float* dn = isctx ? xc_new - (size_t)NLAT * D : xl_new;
#pragma unroll
        for (int bj = 0; bj < 2; ++bj)
#pragma unroll
            for (int n = 0; n < 2; ++n) {
                const int c = u.pn * 256 + bj * 128 + wc * 32 + n * 16 + 4 * fq;
                const f32x4 g = *(const f32x4*)(g1 + c);
#pragma unroll
                for (int ai = 0; ai < 2; ++ai)
#pragma unroll
                    for (int m = 0; m < 4; ++m) {
                        const size_t o = (size_t)(row0 + ai * 128 + m * 16) * D + c;
                        *(f32x4*)(dn + o) = *(const f32x4*)(so + o) + g * acc[ai][bj][m][n];
                    }
            }
    }
};

struct EpiMoe1 {
    bf16_t* hmid;
    DI void operator()(const AccT& acc, const pg8::Unit& u, int wr, int wc, int fr, int fq) const {
        const int row0 = u.pm * 256 + wr * 64 + fr;
#pragma unroll
        for (int ai = 0; ai < 2; ++ai)
#pragma unroll
            for (int m = 0; m < 4; ++m)
#pragma unroll
                for (int bj = 0; bj < 2; ++bj) {
                    const f32x4 a = acc[ai][bj][m][0], b = acc[ai][bj][m][1]; float h[4];
#pragma unroll
                    for (int j = 0; j < 4; ++j) h[j] = siluf(a[j]) * b[j];
                    *(u32x2*)(hmid + (size_t)(row0 + ai * 128 + m * 16) * DE + (u.pn * 256 + bj * 128 + wc * 32) / 2 + 4 * fq) = (u32x2){pk2(h[0], h[1]), pk2(h[2], h[3])};
                }
    }
};
struct EpiMoe2 {
    bf16_t* ys;
    DI void operator()(const AccT& acc, const pg8::Unit& u, int wr, int wc, int fr, int fq) const {
        const int row0 = u.pm * 256 + wr * 64 + fr;
#pragma unroll
        for (int ai = 0; ai < 2; ++ai)
#pragma unroll
            for (int m = 0; m < 4; ++m)
#pragma unroll
                for (int bj = 0; bj < 2; ++bj)
#pragma unroll
                    for (int n = 0; n < 2; ++n) { const f32x4 v = acc[ai][bj][m][n];
                        *(u32x2*)(ys + (size_t)(row0 + ai * 128 + m * 16) * D + u.pn * 256 + bj * 128 + wc * 32 + n * 16 + 4 * fq) = (u32x2){pk2(v[0], v[1]), pk2(v[2], v[3])}; }
    }
};

DI void tconv_tile(const Frame& F, const float* src, int N, int k0, int n0, bf16_t* dst, int ldd, int mode) {
    float* tl = (float*)F.lds;
    __syncthreads();
#pragma unroll
    for (int i = 0; i < 8; ++i) { const int idx = F.tid + 512 * i, k = idx >> 6, n = idx & 63; tl[k * 65 + n] = src[(size_t)(k0 + k) * N + n0 + n]; }
    __syncthreads();
#pragma unroll
    for (int i = 0; i < 4; ++i) { const int idx = F.tid + 512 * i, n = idx >> 5, kp = idx & 31;
        const int nn = n0 + n; const int row = (mode == 0) ? nn : ((nn >> 4) * 32 + (mode - 1) * 16 + (nn & 15));
        *(unsigned*)(dst + (size_t)row * ldd + k0 + 2 * kp) = pk2(tl[(2 * kp) * 65 + n], tl[(2 * kp + 1) * 65 + n]); }
}
DI void phase_prologue(const Frame& F) {
    const int T_IN = 16 * 40, T_OUT = 16 * 16, T_E = 16 * 8;
    const int per_layer = T_IN + T_OUT + NE * 3 * T_E, total = 2 * per_layer;
    for (int u = F.bid; u < total; u += F.G) {
        const int li = u / per_layer; int r = u % per_layer;
        if (r < T_IN) { tconv_tile(F, F.in[I_WIN] + (size_t)li * D * DIN, DIN, (r / 40) * 64, (r % 40) * 64, WSP(bf16_t, WS_WIN) + (size_t)li * DIN * D, D, 0); continue; }
        r -= T_IN;
        if (r < T_OUT) { tconv_tile(F, F.in[I_WOUT] + (size_t)li * D * D, D, (r / 16) * 64, (r % 16) * 64, WSP(bf16_t, WS_WOUT) + (size_t)li * D * D, D, 0); continue; }
        r -= T_OUT;
        const int e = r / (3 * T_E), w = (r / T_E) % 3, t = r % T_E;
        if (w < 2) tconv_tile(F, F.in[w == 0 ? I_MW1 : I_MW3] + ((size_t)li * NE + e) * D * DE, DE, (t / 8) * 64, (t % 8) * 64, WSP(bf16_t, WS_W13) + ((size_t)li * NE + e) * 1024 * 1024, D, 1 + w);
        else tconv_tile(F, F.in[I_MW2] + ((size_t)li * NE + e) * DE * D, D, (t / 16) * 64, (t % 16) * 64, WSP(bf16_t, WS_W2) + ((size_t)li * NE + e) * 1024 * 512, DE, 0);
    }
    __syncthreads();
    {
        float* sc = (float*)F.lds;
        float* red = sc + 3072;
        for (int i = F.tid; i < 3072; i += NTHR) { const int v = i >> 10, k = i & 1023; const float x = (v < 2) ? F.in[I_C][v * 1024 + k] : F.in[I_CCTX][k]; sc[i] = siluf(x); }
        __syncthreads();
        for (int u = F.bid; u < 2 * 96; u += F.G) {
            const int li = u / 96, j = (u % 96) * 64 + F.lane, ko = F.wave;
            const float* w = F.in[I_ADAW] + (size_t)li * D * 6144 + j;
            float a0 = 0.f, a1 = 0.f, a2 = 0.f;
            for (int k = ko * 128; k < ko * 128 + 128; ++k) { const float wv = w[(size_t)k * 6144]; a0 += sc[k] * wv; a1 += sc[1024 + k] * wv; a2 += sc[2048 + k] * wv; }
            red[(ko * 3 + 0) * 64 + F.lane] = a0; red[(ko * 3 + 1) * 64 + F.lane] = a1; red[(ko * 3 + 2) * 64 + F.lane] = a2;
            __syncthreads();
            if (F.tid < 192) { const int v = F.tid / 64, l = F.tid % 64; float s = 0.f;
#pragma unroll
                for (int q = 0; q < 8; ++q) s += red[(q * 3 + v) * 64 + l];
                const int jj = (u % 96) * 64 + l;
                WSP(float, WS_MOD)[((size_t)li * 3 + v) * 6144 + jj] = s + F.in[I_ADAB][li * 6144 + jj]; }
            __syncthreads();
        }
    }
    if (F.bid == (F.G > 1 ? 1 : 0)) {
        for (int i = F.tid; i < 256 * 8; i += NTHR) { const int pos = i >> 3, f = i & 7; const float inv = exp2f(-(float)f * (13.287712379549449f / 8.f)); const float rev = (float)pos * inv * 0.15915494309189535f;
            WSP(float, WS_ROPE)[i * 2] = cos_rev(rev); WSP(float, WS_ROPE)[i * 2 + 1] = sin_rev(rev); }
    }
}

DI void filter_tile(const Frame& F, int li, int L, int tile, float* hT, float* part) {
    float* h1s = (float*)F.lds;
    float* h2s = h1s + 4096;
    float* stg = h2s + 4096;
    float* sq2 = stg + 256 * 65;
    const float* w1 = F.in[I_HW1] + (size_t)li * 33 * 64; const float* b1 = F.in[I_HB1] + li * 64;
    const float* w2 = F.in[I_HW2] + (size_t)li * 64 * 64; const float* b2 = F.in[I_HB2] + li * 64;
    const float* w3 = F.in[I_HW3] + (size_t)li * 64 * 1024; const float* b3 = F.in[I_HB3] + li * 1024;
    const int t0 = tile * 64;
    const float inv_lm1 = 1.f / (float)(L > 1 ? L - 1 : 1);
    __syncthreads();
    {
        const int tl = F.tid & 63, pt = F.tid >> 6; const float t = (float)(t0 + tl);
        float a[8];
#pragma unroll
        for (int jj = 0; jj < 8; ++jj) a[jj] = b1[pt * 8 + jj] + (t * inv_lm1) * w1[pt * 8 + jj];
#pragma unroll 1
        for (int i = 0; i < 16; ++i) { const float band = 1e-4f + (15.f - 1e-4f) * (float)i / 15.f; const float rev = t * band / (float)L; const float cz = cos_rev(rev), sz = sin_rev(rev);
#pragma unroll
            for (int jj = 0; jj < 8; ++jj) a[jj] += cz * w1[(1 + i) * 64 + pt * 8 + jj] + sz * w1[(17 + i) * 64 + pt * 8 + jj]; }
#pragma unroll
        for (int jj = 0; jj < 8; ++jj) h1s[tl * 64 + pt * 8 + jj] = sin_rad(a[jj]);
    }
    __syncthreads();
    {
        const int tl = F.tid & 63, pt = F.tid >> 6;
        float a[8];
#pragma unroll
        for (int jj = 0; jj < 8; ++jj) a[jj] = b2[pt * 8 + jj];
#pragma unroll 1
        for (int i = 0; i < 64; ++i) { const float hv = h1s[tl * 64 + i];
#pragma unroll
            for (int jj = 0; jj < 8; ++jj) a[jj] += hv * w2[i * 64 + pt * 8 + jj]; }
#pragma unroll
        for (int jj = 0; jj < 8; ++jj) h2s[tl * 64 + pt * 8 + jj] = sin_rad(a[jj]);
    }
    __syncthreads();
    const int c = F.tid & 255, th = F.tid >> 8;
    const float delta = 3.0701134573253945f + (15.350567286626973f - 3.0701134573253945f) * (float)c / 255.f;
#pragma unroll 1
    for (int cc = 0; cc < 4; ++cc) {
        float wr[64];
#pragma unroll
        for (int i = 0; i < 64; ++i) wr[i] = w3[(size_t)i * 1024 + cc * 256 + c];
        const float bb = b3[cc * 256 + c]; float sq = 0.f;
#pragma unroll 1
        for (int tt = th * 32; tt < th * 32 + 32; ++tt) {
            float a = bb;
#pragma unroll
            for (int i = 0; i < 64; ++i) a += h2s[tt * 64 + i] * wr[i];
            a *= __expf(-((float)(t0 + tt) * inv_lm1) * delta);
            stg[c * 65 + tt] = a; sq += a * a;
        }
        if (th == 1) sq2[c] = sq;
        __syncthreads();
        if (th == 0) part[(size_t)tile * 1024 + cc * 256 + c] = sq + sq2[c];
        for (int ch = F.wave * 32; ch < F.wave * 32 + 32; ++ch) hT[((size_t)cc * 256 + ch) * L + t0 + F.lane] = stg[ch * 65 + F.lane];
        __syncthreads();
    }
}

struct TokInfo { unsigned e0, e1, p0, p1; float g0, g1; unsigned s0, s1; };
DI void phase_norm1(const Frame& F, int li, int mode) {
    const int nrows = (mode == 2) ? NLAT : NTOK;
    const float* modp = WSP(float, WS_MOD) + (size_t)li * 3 * 6144;
    const float* modprev = WSP(float, WS_MOD) + (size_t)(mode == 2 ? 1 : li - 1) * 3 * 6144;
    const float* gam = (mode == 2) ? F.in[I_FG] : F.in[I_N1G] + (size_t)li * D;
    const TokInfo* tok = WSP(TokInfo, WS_TOK); const bf16_t* ys = WSP(bf16_t, WS_A1);
    bf16_t* hbf = WSP(bf16_t, WS_HBF);
    for (int r = F.bid * 8 + F.wave; r < nrows; r += F.G * 8) {
        const bool isctx = r >= NLAT; const int v = isctx ? 2 : (r >> 14);
        float* xrow = isctx ? WSP(float, WS_XC) + (size_t)(r - NLAT) * D : F.out + (size_t)r * D;
        const float* src = (mode == 0) ? (isctx ? F.in[I_CTX] + (size_t)(r - NLAT) * D : F.in[I_X] + (size_t)r * D) : xrow;
        f32x4 x[4];
#pragma unroll
        for (int i = 0; i < 4; ++i) x[i] = *(const f32x4*)(src + i * 256 + F.lane * 4);
        if (mode != 0) {
            const TokInfo ti = tok[r];
            const float* g2 = modprev + (size_t)v * 6144 + 5 * 1024;
#pragma unroll
            for (int i = 0; i < 4; ++i) {
                const int c = i * 256 + F.lane * 4;
                const u32x2 a = *(const u32x2*)(ys + (size_t)ti.s0 * D + c), b = *(const u32x2*)(ys + (size_t)ti.s1 * D + c);
                const f32x4 gg = *(const f32x4*)(g2 + c);
                f32x4 y;
                y[0] = ti.g0 * __uint_as_float(a[0] << 16) + ti.g1 * __uint_as_float(b[0] << 16);
                y[1] = ti.g0 * __uint_as_float(a[0] & 0xffff0000u) + ti.g1 * __uint_as_float(b[0] & 0xffff0000u);
                y[2] = ti.g0 * __uint_as_float(a[1] << 16) + ti.g1 * __uint_as_float(b[1] << 16);
                y[3] = ti.g0 * __uint_as_float(a[1] & 0xffff0000u) + ti.g1 * __uint_as_float(b[1] & 0xffff0000u);
                x[i] = x[i] + gg * y;
            }
            if (mode == 1) {
#pragma unroll
                for (int i = 0; i < 4; ++i) *(f32x4*)(xrow + i * 256 + F.lane * 4) = x[i];
            }
        }
        float ss = 0.f;
#pragma unroll
        for (int i = 0; i < 4; ++i) ss += x[i][0] * x[i][0] + x[i][1] * x[i][1] + x[i][2] * x[i][2] + x[i][3] * x[i][3];
        ss = wave_sum(ss);
        const float rstd = rsqrtf(ss * (1.f / D) + EPS);
#pragma unroll
        for (int i = 0; i < 4; ++i) {
            const int c = i * 256 + F.lane * 4;
            const f32x4 g = *(const f32x4*)(gam + c);
            if (mode == 2) { *(f32x4*)(F.out + (size_t)r * D + c) = x[i] * rstd * g; }
            else {
                const f32x4 sh = *(const f32x4*)(modp + (size_t)v * 6144 + c), sc = *(const f32x4*)(modp + (size_t)v * 6144 + 1024 + c);
                const f32x4 h = x[i] * rstd * g * (sc + 1.f) + sh;
                *(u32x2*)(hbf + (size_t)r * D + c) = (u32x2){pk2(h[0], h[1]), pk2(h[2], h[3])};
            }
        }
    }
}

DI void phase_norm2(const Frame& F, int li, int nrows) {
    float* wt = (float*)F.lds;
    __syncthreads();
    for (int i = F.tid; i < 16384; i += NTHR) { const int k = i >> 4, e = i & 15; wt[e * 1024 + k] = F.in[I_RW][i]; }
    __syncthreads();
    const float* modp = WSP(float, WS_MOD) + (size_t)li * 3 * 6144;
    const float* gam = F.in[I_N2G] + (size_t)li * D;
    bf16_t* hbf = WSP(bf16_t, WS_HBF); TokInfo* tok = WSP(TokInfo, WS_TOK);
    unsigned* cnt = F.ctl + CW_CNT + li * 16;
    for (int r = F.bid * 8 + F.wave; r < nrows; r += F.G * 8) {
        const bool isctx = r >= NLAT; const int v = isctx ? 2 : (r >> 14);
        const float* src = isctx ? WSP(float, WS_XC) + (size_t)(r - NLAT) * D : F.out + (size_t)r * D;
        f32x4 x[4]; float ss = 0.f;
#pragma unroll
        for (int i = 0; i < 4; ++i) { x[i] = *(const f32x4*)(src + i * 256 + F.lane * 4); ss += x[i][0] * x[i][0] + x[i][1] * x[i][1] + x[i][2] * x[i][2] + x[i][3] * x[i][3]; }
        ss = wave_sum(ss);
        const float rstd = rsqrtf(ss * (1.f / D) + EPS);
        float lg[16];
#pragma unroll
        for (int e = 0; e < 16; ++e) lg[e] = 0.f;
#pragma unroll
        for (int i = 0; i < 4; ++i) {
            const int c = i * 256 + F.lane * 4;
            const f32x4 g = *(const f32x4*)(gam + c), sh = *(const f32x4*)(modp + (size_t)v * 6144 + 3 * 1024 + c), sc = *(const f32x4*)(modp + (size_t)v * 6144 + 4 * 1024 + c);
            const f32x4 h = x[i] * rstd * g * (sc + 1.f) + sh;
            *(u32x2*)(hbf + (size_t)r * D + c) = (u32x2){pk2(h[0], h[1]), pk2(h[2], h[3])};
#pragma unroll
            for (int e = 0; e < 16; ++e) { const f32x4 w = *(const f32x4*)(wt + e * 1024 + c); lg[e] += h[0] * w[0] + h[1] * w[1] + h[2] * w[2] + h[3] * w[3]; }
        }
#pragma unroll
        for (int e = 0; e < 16; ++e) lg[e] = wave_sum(lg[e]);
        float mx = lg[0];
#pragma unroll
        for (int e = 1; e < 16; ++e) mx = fmaxf(mx, lg[e]);
        float sc[16], sel[16], den = 0.f;
#pragma unroll
        for (int e = 0; e < 16; ++e) { sc[e] = __expf(lg[e] - mx); den += sc[e]; }
        const float rden = 1.f / den;
#pragma unroll
        for (int e = 0; e < 16; ++e) { sc[e] *= rden; sel[e] = sc[e] + F.in[I_RB][e]; }
        int bg = 0; float bgs = -1e30f;
#pragma unroll
        for (int g = 0; g < 4; ++g) {
            float m1 = -1e30f, m2 = -1e30f;
#pragma unroll
            for (int q = 0; q < 4; ++q) { const float s = sel[g * 4 + q]; if (s > m1) { m2 = m1; m1 = s; } else if (s > m2) m2 = s; }
            const float gs = m1 + m2; if (gs > bgs) { bgs = gs; bg = g; }
        }
        int e0 = 0, e1 = 0; float s0v = -1e30f, s1v = -1e30f, w0 = 0.f, w1 = 0.f;
#pragma unroll
        for (int e = 0; e < 16; ++e) {
            const bool ing = (e >> 2) == bg; const float s = sel[e];
            if (ing && s > s0v) { s1v = s0v; e1 = e0; w1 = w0; s0v = s; e0 = e; w0 = sc[e]; }
            else if (ing && s > s1v) { s1v = s; e1 = e; w1 = sc[e]; }
        }
        if (F.lane == 0) {
            TokInfo ti; ti.e0 = e0; ti.e1 = e1; ti.p0 = atomicAdd(cnt + e0, 1u); ti.p1 = atomicAdd(cnt + e1, 1u);
            const float ws = 1.f / (w0 + w1); ti.g0 = w0 * ws; ti.g1 = w1 * ws; ti.s0 = 0; ti.s1 = 0;
            tok[r] = ti;
        }
    }
}

DI void moe_offsets(const Frame& F, int li, int* offs) {
    __syncthreads();
    if (F.tid == 0) { int o = 0; for (int e = 0; e < NE; ++e) { offs[e] = o; offs[17 + e] = o >> 8; const unsigned c = __hip_atomic_load(F.ctl + CW_CNT + li * 16 + e, __ATOMIC_RELAXED, __HIP_MEMORY_SCOPE_AGENT); o += (int)((c + 255u) & ~255u); }
        offs[16] = o; offs[17 + 16] = o >> 8; }
    __syncthreads();
    for (int t = F.tid; t < SLOT_CAP / 256; t += NTHR) { int e = 0; for (int k = 1; k < NE; ++k) e += (offs[17 + k] <= t) ? 1 : 0; offs[40 + t] = e; }
    __syncthreads();
}
DI void phase_gather(const Frame& F, int li, int nrows) {
    int* offs = (int*)(F.lds + LDS_MISC + 64);
    moe_offsets(F, li, offs);
    const bf16_t* hbf = WSP(bf16_t, WS_HBF); bf16_t* a1 = WSP(bf16_t, WS_A1); TokInfo* tok = WSP(TokInfo, WS_TOK);
    for (int r = F.bid * 8 + F.wave; r < nrows; r += F.G * 8) {
        TokInfo ti = tok[r];
        const unsigned s0 = offs[ti.e0] + ti.p0, s1 = offs[ti.e1] + ti.p1;
        const u32x4 a = *(const u32x4*)(hbf + (size_t)r * D + F.lane * 8), b = *(const u32x4*)(hbf + (size_t)r * D + 512 + F.lane * 8);
        *(u32x4*)(a1 + (size_t)s0 * D + F.lane * 8) = a; *(u32x4*)(a1 + (size_t)s0 * D + 512 + F.lane * 8) = b;
        *(u32x4*)(a1 + (size_t)s1 * D + F.lane * 8) = a; *(u32x4*)(a1 + (size_t)s1 * D + 512 + F.lane * 8) = b;
        if (F.lane == 0) { tok[r].s0 = s0; tok[r].s1 = s1; }
    }
}

#define MFMA32(a, b, c) __builtin_amdgcn_mfma_f32_32x32x16_bf16((a), (b), (c), 0, 0, 0)
DI float lam_of(const Frame& F, int li, float& lam_init) {
    const float* lv = F.in[I_ALAM] + (size_t)li * 128;
    const int i = F.lane & 31, hi = F.lane >> 5;
    float d = lv[hi * 64 + i] * lv[hi * 64 + 32 + i];
    for (int o = 16; o > 0; o >>= 1) d += __shfl_xor(d, o);
    const float d0 = __shfl(d, 0), d1 = __shfl(d, 32);
    lam_init = 0.8f - 0.6f * __expf(-0.3f * (float)li);
    return __expf(d0) - __expf(d1) + lam_init;
}
DI bf16x8 pack8(const f32x16& x, int s) {
    u32x4 p; p[0] = pk2(x[8 * s], x[8 * s + 1]); p[1] = pk2(x[8 * s + 2], x[8 * s + 3]); p[2] = pk2(x[8 * s + 4], x[8 * s + 5]); p[3] = pk2(x[8 * s + 6], x[8 * s + 7]);
    return __builtin_bit_cast(bf16x8, p);
}

DI void diffattn_unit(const Frame& F, int li, int b, int h, int qt) {
    const int lane = F.lane, r = lane & 31, hh = lane >> 5;
    const bf16_t* AQ = WSP(bf16_t, WS_AQ); const bf16_t* AK = WSP(bf16_t, WS_AK); const bf16_t* AVT = WSP(bf16_t, WS_AVT) + (size_t)(b * 4 + h) * 64 * NKEY;
    unsigned char* Ks = F.lds;
    unsigned char* Vt = F.lds + 16384;
    constexpr int VTB = 64 * 136;
    float lam_init; const float lam = lam_of(F, li, lam_init);
    const int q = qt * 256 + F.wave * 32 + r;
    const size_t qrow = (size_t)b * S + q;
    bf16x8 qf[2][2]; float qn2[2];
#pragma unroll
    for (int c = 0; c < 2; ++c) { qn2[c] = 0.f;
#pragma unroll
        for (int ks = 0; ks < 2; ++ks) { qf[c][ks] = *(const bf16x8*)(AQ + qrow * 256 + h * 64 + c * 32 + ks * 16 + 8 * hh);
#pragma unroll
            for (int j = 0; j < 8; ++j) { const float v = bf2f((bf16_t)qf[c][ks][j]); qn2[c] += v * v; } }
        qn2[c] += __shfl_xor(qn2[c], 32); }
    const unsigned* kmx = F.ctl + CW_KMAX + li * 16 + (b * 4 + h) * 2;
    f32x16 cinit;
    { float cn = 0.f;
#pragma unroll
      for (int c = 0; c < 2; ++c) { const float km = sqrtf(__uint_as_float(__hip_atomic_load(kmx + c, __ATOMIC_RELAXED, __HIP_MEMORY_SCOPE_AGENT))); cn = fmaxf(cn, sqrtf(qn2[c]) * km); }
      cn = -(cn * 1.02f + 1e-3f);
#pragma unroll
      for (int i = 0; i < 16; ++i) cinit[i] = cn; }
    f32x16 O[2][2];
#pragma unroll
    for (int c = 0; c < 2; ++c)
#pragma unroll
        for (int dh = 0; dh < 2; ++dh)
#pragma unroll
            for (int i = 0; i < 16; ++i) O[c][dh][i] = 0.f;
    float lsum[2] = {0.f, 0.f};
    const int skey = F.tid >> 3, sch = F.tid & 7;
    const int kdst = (sch >> 2) * 4096 + skey * 64 + (((sch & 3) ^ ((skey >> 2) & 3)) * 16);
    const int vd = F.tid >> 3, vkc = F.tid & 7;
    const int vdst = vd * 136 + vkc * 16;
    auto krow_of = [&](int j) -> size_t { return j < CTX ? (size_t)NLAT + b * CTX + j : (size_t)b * S + (j - CTX); };
    u32x4 kreg, vreg;
    kreg = *(const u32x4*)(AK + krow_of(skey) * 256 + h * 64 + sch * 8);
    vreg = *(const u32x4*)(AVT + (size_t)vd * NKEY + vkc * 8);
    __syncthreads();
    *(u32x4*)(Ks + kdst) = kreg;
    *(u32x2*)(Vt + vdst) = (u32x2){vreg[0], vreg[1]}; *(u32x2*)(Vt + vdst + 8) = (u32x2){vreg[2], vreg[3]};
    __syncthreads();
    constexpr int NT = NKEY / 64;
    for (int kt = 0; kt < NT; ++kt) {
        const int buf = kt & 1;
        if (kt + 1 < NT) {
            const int j0 = (kt + 1) * 64;
            kreg = *(const u32x4*)(AK + krow_of(j0 + skey) * 256 + h * 64 + sch * 8);
            vreg = *(const u32x4*)(AVT + (size_t)vd * NKEY + j0 + vkc * 8);
        }
        const unsigned char* kb = Ks + buf * 8192; const unsigned char* vb = Vt + buf * VTB;
#pragma unroll 1
        for (int st = 0; st < 2; ++st) {
            const int key = 32 * st + r;
            bf16x8 pb[2][2];
#pragma unroll
            for (int c = 0; c < 2; ++c) {
                const bf16x8 k0 = *(const bf16x8*)(kb + c * 4096 + key * 64 + (((0 + hh) ^ ((key >> 2) & 3)) * 16));
                const bf16x8 k1 = *(const bf16x8*)(kb + c * 4096 + key * 64 + (((2 + hh) ^ ((key >> 2) & 3)) * 16));
                f32x16 s = MFMA32(k0, qf[c][0], cinit);
                s = MFMA32(k1, qf[c][1], s);
#pragma unroll
                for (int i = 0; i < 16; ++i) { s[i] = __builtin_amdgcn_exp2f(s[i]); lsum[c] += s[i]; }
                pb[c][0] = pack8(s, 0); pb[c][1] = pack8(s, 1);
            }
#pragma unroll
            for (int dh = 0; dh < 2; ++dh)
#pragma unroll
                for (int s = 0; s < 2; ++s) {
                    const unsigned char* vp = vb + (32 * dh + r) * 136 + (32 * st + 16 * s + 4 * hh) * 2;
                    const s16x4 lo = *(const s16x4*)vp, hi = *(const s16x4*)(vp + 16);
                    const bf16x8 vf = __builtin_shufflevector(lo, hi, 0, 1, 2, 3, 4, 5, 6, 7);
                    O[0][dh] = MFMA32(vf, pb[0][s], O[0][dh]);
                    O[1][dh] = MFMA32(vf, pb[1][s], O[1][dh]);
                }
        }
        if (kt + 1 < NT) {
            unsigned char* kw = Ks + (buf ^ 1) * 8192; unsigned char* vw = Vt + (buf ^ 1) * VTB;
            *(u32x4*)(kw + kdst) = kreg;
            *(u32x2*)(vw + vdst) = (u32x2){vreg[0], vreg[1]}; *(u32x2*)(vw + vdst + 8) = (u32x2){vreg[2], vreg[3]};
        }
        __syncthreads();
    }
    const float l0 = lsum[0] + __shfl_xor(lsum[0], 32), l1 = lsum[1] + __shfl_xor(lsum[1], 32);
    const float r0 = 1.f / l0, r1 = lam / l1;
    float o[2][16]; float ss = 0.f;
#pragma unroll
    for (int dh = 0; dh < 2; ++dh)
#pragma unroll
        for (int i = 0; i < 16; ++i) { o[dh][i] = O[0][dh][i] * r0 - O[1][dh][i] * r1; ss += o[dh][i] * o[dh][i]; }
    ss += __shfl_xor(ss, 32);
    const float rs = rsqrtf(ss * (1.f / 64.f) + EPS) * (1.f - lam_init);
    const float* sg = F.in[I_ASUB] + li * 64;
    bf16_t* mix = WSP(bf16_t, WS_HBF) + qrow * D + h * 64;
#pragma unroll
    for (int dh = 0; dh < 2; ++dh)
#pragma unroll
        for (int g = 0; g < 4; ++g) {
            const int d = 32 * dh + 8 * g + 4 * hh;
            const f32x4 gg = *(const f32x4*)(sg + d);
            *(u32x2*)(mix + d) = (u32x2){pk2(o[dh][4 * g] * rs * gg[0], o[dh][4 * g + 1] * rs * gg[1]), pk2(o[dh][4 * g + 2] * rs * gg[2], o[dh][4 * g + 3] * rs * gg[3])};
        }
}

DI void ctx_attn_a_unit(const Frame& F, int li, int u) {
    const int idx = u * NTHR + F.tid, cr = idx >> 2, h = idx & 3, b = cr >> 8;
    const bf16_t* AQ = WSP(bf16_t, WS_AQ) + (size_t)(NLAT + cr) * 256 + h * 64;
    const bf16_t* AK = WSP(bf16_t, WS_AK) + (size_t)(NLAT + b * CTX) * 256 + h * 64;
    const bf16_t* AVT = WSP(bf16_t, WS_AVT) + (size_t)(b * 4 + h) * 64 * NKEY;
    float lam_init; const float lam = lam_of(F, li, lam_init);
    float o[64];
#pragma unroll
    for (int i = 0; i < 64; ++i) o[i] = 0.f;
#pragma unroll 1
    for (int c = 0; c < 2; ++c) {
        float q[32];
#pragma unroll
        for (int i = 0; i < 32; ++i) q[i] = bf2f(AQ[c * 32 + i]);
        float m = -1e30f, l = 0.f, acc[64];
#pragma unroll
        for (int i = 0; i < 64; ++i) acc[i] = 0.f;
#pragma unroll 1
        for (int j = 0; j < CTX; ++j) {
            float s = 0.f;
#pragma unroll
            for (int i = 0; i < 32; ++i) s += q[i] * bf2f(AK[(size_t)j * 256 + c * 32 + i]);
            const float mn = fmaxf(m, s), al = __builtin_amdgcn_exp2f(m - mn), p = __builtin_amdgcn_exp2f(s - mn);
            l = l * al + p; m = mn;
#pragma unroll
            for (int i = 0; i < 64; ++i) acc[i] = acc[i] * al + p * bf2f(AVT[(size_t)i * NKEY + j]);
        }
        const float sc = (c == 0) ? 1.f / l : -lam / l;
#pragma unroll
        for (int i = 0; i < 64; ++i) o[i] += acc[i] * sc;
    }
    float ss = 0.f;
#pragma unroll
    for (int i = 0; i < 64; ++i) ss += o[i] * o[i];
    const float rs = rsqrtf(ss * (1.f / 64.f) + EPS) * (1.f - lam_init);
    bf16_t* mix = WSP(bf16_t, WS_HBF) + (size_t)(NLAT + cr) * D + h * 64;
#pragma unroll
    for (int i = 0; i < 64; ++i) mix[i] = f2bf(o[i] * rs * F.in[I_ASUB][li * 64 + i]);
}
DI void ctx_attn_b_unit(const Frame& F, int u) {
    const int idx = u * NTHR + F.tid, cr = idx >> 2, h = idx & 3, b = cr >> 8;
    const bf16_t* BQ = WSP(bf16_t, WS_BQ) + (size_t)(NLAT + cr) * 256 + h * 64;
    const bf16_t* BK = WSP(bf16_t, WS_BK) + (size_t)(NLAT + b * CTX) * 256 + h * 64;
    const bf16_t* BV = WSP(bf16_t, WS_BV) + (size_t)(NLAT + b * CTX) * 256 + h * 64;
    float q[64], acc[64];
#pragma unroll
    for (int i = 0; i < 64; ++i) { q[i] = bf2f(BQ[i]); acc[i] = 0.f; }
    float m = -1e30f, l = 0.f;
    for (int j = 0; j < CTX; ++j) {
        float s = 0.f;
#pragma unroll
        for (int i = 0; i < 64; ++i) s += q[i] * bf2f(BK[(size_t)j * 256 + i]);
        const float mn = fmaxf(m, s), al = __builtin_amdgcn_exp2f(m - mn), p = __builtin_amdgcn_exp2f(s - mn);
        l = l * al + p; m = mn;
#pragma unroll
        for (int i = 0; i < 64; ++i) acc[i] = acc[i] * al + p * bf2f(BV[(size_t)j * 256 + i]);
    }
    const float rl = 1.f / l;
    bf16_t* mix = WSP(bf16_t, WS_HBF) + (size_t)(NLAT + cr) * D + 256 + h * 64;
#pragma unroll
    for (int i = 0; i < 64; ++i) mix[i] = f2bf(acc[i] * rl);
}

DI void na_unit(const Frame& F, int li, int u) {
    const int b = u >> 7, rp = u & 127;
    const int qi = F.tid >> 2, h = F.tid & 3;
    const int row = rp * 2 + (qi >> 6), col = qi & 63, t = row * GW + col;
    const bf16_t* BQ = WSP(bf16_t, WS_BQ) + ((size_t)b * S + t) * 256 + h * 64;
    const bf16_t* BKl = WSP(bf16_t, WS_BK) + (size_t)b * S * 256 + h * 64;
    const bf16_t* BVl = WSP(bf16_t, WS_BV) + (size_t)b * S * 256 + h * 64;
    const bf16_t* BKc = WSP(bf16_t, WS_BK) + (size_t)(NLAT + b * CTX) * 256 + h * 64;
    const bf16_t* BVc = WSP(bf16_t, WS_BV) + (size_t)(NLAT + b * CTX) * 256 + h * 64;
    const float* rpb = F.in[I_RPB] + ((size_t)li * 4 + h) * 15 * 31;
    float q[64], acc[64];
#pragma unroll
    for (int i = 0; i < 64; ++i) { q[i] = bf2f(BQ[i]); acc[i] = 0.f; }
    float m = -1e30f, l = 0.f;
    int r0 = row - 4; r0 = r0 < 0 ? 0 : (r0 > 248 ? 248 : r0);
    int c0 = col - 8; c0 = c0 < 0 ? 0 : (c0 > 48 ? 48 : c0);
    for (int j = 0; j < 128 + CTX; ++j) {
        const bf16_t *kp, *vp; float bias = 0.f;
        if (j < 128) { const int kr = r0 + (j >> 4), kc = c0 + (j & 15); kp = BKl + (size_t)(kr * GW + kc) * 256; vp = BVl + (size_t)(kr * GW + kc) * 256;
            bias = rpb[(kr - row + 7) * 31 + (kc - col + 15)] * LOG2E; }
        else { kp = BKc + (size_t)(j - 128) * 256; vp = BVc + (size_t)(j - 128) * 256; }
        float s = bias;
#pragma unroll
        for (int i8 = 0; i8 < 8; ++i8) { const u32x4 kk = *(const u32x4*)(kp + i8 * 8);
#pragma unroll
            for (int e = 0; e < 4; ++e) { s += q[i8 * 8 + 2 * e] * __uint_as_float(kk[e] << 16) + q[i8 * 8 + 2 * e + 1] * __uint_as_float(kk[e] & 0xffff0000u); } }
        const float mn = fmaxf(m, s), al = __builtin_amdgcn_exp2f(m - mn), p = __builtin_amdgcn_exp2f(s - mn);
        l = l * al + p; m = mn;
#pragma unroll
        for (int i8 = 0; i8 < 8; ++i8) { const u32x4 vv = *(const u32x4*)(vp + i8 * 8);
#pragma unroll
            for (int e = 0; e < 4; ++e) { acc[i8 * 8 + 2 * e] = acc[i8 * 8 + 2 * e] * al + p * __uint_as_float(vv[e] << 16); acc[i8 * 8 + 2 * e + 1] = acc[i8 * 8 + 2 * e + 1] * al + p * __uint_as_float(vv[e] & 0xffff0000u); } }
    }
    const float rl = 1.f / l;
    bf16_t* mix = WSP(bf16_t, WS_HBF) + ((size_t)b * S + t) * D + 256 + h * 64;
#pragma unroll
    for (int i8 = 0; i8 < 8; ++i8) *(u32x4*)(mix + i8 * 8) = (u32x4){pk2(acc[i8 * 8] * rl, acc[i8 * 8 + 1] * rl), pk2(acc[i8 * 8 + 2] * rl, acc[i8 * 8 + 3] * rl), pk2(acc[i8 * 8 + 4] * rl, acc[i8 * 8 + 5] * rl), pk2(acc[i8 * 8 + 6] * rl, acc[i8 * 8 + 7] * rl)};
}

DI void pool_unit(const Frame& F, int li, size_t seq_row0, int L, int t0) {
    float* us = (float*)F.lds;
    float* df = us + 48 * 256;
    const bf16_t* PL = WSP(bf16_t, WS_PL);
    __syncthreads();
    for (int i = F.tid; i < 48 * 32; i += NTHR) {
        const int tt = i >> 5, c8 = i & 31, t = t0 - 8 + tt;
        float v[8] = {0.f, 0.f, 0.f, 0.f, 0.f, 0.f, 0.f, 0.f};
        if (t >= 0 && t < L) { const u32x4 x = *(const u32x4*)(PL + (seq_row0 + t) * 256 + c8 * 8);
#pragma unroll
            for (int e = 0; e < 4; ++e) { v[2 * e] = __uint_as_float(x[e] << 16); v[2 * e + 1] = __uint_as_float(x[e] & 0xffff0000u); } }
#pragma unroll
        for (int e = 0; e < 8; ++e) us[tt * 256 + c8 * 8 + e] = v[e];
    }
    __syncthreads();
    for (int i = F.tid; i < 32 * 256; i += NTHR) {
        const int tl = i >> 8, ch = i & 255, g = ch >> 6, t = t0 + tl; const int hw = 1 << g;
        int lo = t - hw; lo = lo < 0 ? 0 : lo; int hi = t + hw; hi = hi > L ? L : hi;
        float s = 0.f;
        for (int tt = lo; tt < hi; ++tt) s += us[(tt - t0 + 8) * 256 + ch];
        df[tl * 256 + ch] = s / (float)(hi - lo) - us[(tl + 8) * 256 + ch];
    }
    __syncthreads();
    const float* pw = F.in[I_POOLW] + (size_t)li * 4 * 64 * 64; const float* ps = F.in[I_POOLS] + li * 256;
    bf16_t* mix = WSP(bf16_t, WS_HBF);
    {
        const int ch = F.tid & 255, th = F.tid >> 8, g = ch >> 6, j = ch & 63;
        float w[64];
#pragma unroll
        for (int i = 0; i < 64; ++i) w[i] = pw[((size_t)g * 64 + i) * 64 + j];
        const float scale = ps[ch];
        for (int tl = th * 16; tl < th * 16 + 16; ++tl) {
            float a = 0.f;
#pragma unroll
            for (int i = 0; i < 64; ++i) a += df[tl * 256 + g * 64 + i] * w[i];
            mix[(seq_row0 + t0 + tl) * D + 512 + ch] = f2bf(a * scale);
        }
    }
}

DI float hy_norm(const float* part, int ntile, int o, int ch) {
    float s = 0.f;
    for (int t = 0; t < ntile; ++t) s += part[(size_t)t * 1024 + (o * 2) * 256 + ch] + part[(size_t)t * 1024 + (o * 2 + 1) * 256 + ch];
    return rsqrtf(s + EPS);
}
DI float hy_short(const bf16_t* p, int t, int L, float w0, float w1, float w2, float bb) {
    const float a = t > 0 ? bf2f(p[t - 1]) : 0.f, c = t + 1 < L ? bf2f(p[t + 1]) : 0.f;
    return a * w0 + bf2f(p[t]) * w1 + c * w2 + bb;
}
DI void hy_conv(const float* vb, const float* hf, const float* hb, int t0, float (&acc)[2][16]) {
#pragma unroll
    for (int b = 0; b < 2; ++b)
#pragma unroll
        for (int i = 0; i < 16; ++i) acc[b][i] = 0.f;
#pragma unroll 1
    for (int s0 = 0; s0 < S; s0 += 16) {
        float kw[31];
#pragma unroll
        for (int i = 0; i < 31; ++i) { const int dl = t0 - s0 - 15 + i; const float* p = dl >= 0 ? hf : hb; kw[i] = p[dl >= 0 ? dl : -dl]; }
#pragma unroll
        for (int j4 = 0; j4 < 4; ++j4) {
            const f32x4 va = *(const f32x4*)(vb + s0 + 4 * j4), vc = *(const f32x4*)(vb + S + s0 + 4 * j4);
#pragma unroll
            for (int e = 0; e < 4; ++e) { const int jj = 4 * j4 + e;
#pragma unroll
                for (int ii = 0; ii < 16; ++ii) { acc[0][ii] += kw[ii - jj + 15] * va[e]; acc[1][ii] += kw[ii - jj + 15] * vc[e]; } }
        }
    }
}
DI void hyena_unit(const Frame& F, int li, int ch) {
    float* vb = (float*)F.lds;
    const bf16_t* HYT = WSP(bf16_t, WS_HYT); const float* filt = WSP(float, WS_FILT); float* zb = WSP(float, WS_ZBUF) + (size_t)ch * 2 * S;
    const float* sw = F.in[I_HYSW] + (size_t)li * 3 * 768; const float* sb = F.in[I_HYSB] + li * 768; const float* sk = F.in[I_HSKIP] + li * 512;
    const float n0 = hy_norm(WSP(float, WS_FPART), 256, 0, ch), n1 = hy_norm(WSP(float, WS_FPART), 256, 1, ch);
    __syncthreads();
    for (int i = F.tid; i < 2 * S; i += NTHR) { const int b = i >> 14, t = i & (S - 1); const int c = 512 + ch;
        vb[i] = hy_short(HYT + ((size_t)b * 768 + c) * S, t, S, sw[c], sw[768 + c], sw[1536 + c], sb[c]); }
    __syncthreads();
    float acc[2][16];
#pragma unroll 1
    for (int half = 0; half < 2; ++half) {
        const int t0 = F.tid * 32 + half * 16;
        hy_conv(vb, filt + ((size_t)0 * 256 + ch) * S, filt + ((size_t)1 * 256 + ch) * S, t0, acc);
#pragma unroll
        for (int b = 0; b < 2; ++b)
#pragma unroll
            for (int i = 0; i < 16; ++i) { const int t = t0 + i;
                const float x1 = hy_short(HYT + ((size_t)b * 768 + ch) * S, t, S, sw[ch], sw[768 + ch], sw[1536 + ch], sb[ch]);
                zb[b * S + t] = x1 * (acc[b][i] * n0 + sk[ch] * vb[b * S + t]); }
    }
    __syncthreads();
    for (int i = F.tid; i < 2 * S; i += NTHR) vb[i] = zb[i];
    __syncthreads();
    bf16_t* mix = WSP(bf16_t, WS_HBF);
#pragma unroll 1
    for (int half = 0; half < 2; ++half) {
        const int t0 = F.tid * 32 + half * 16;
        hy_conv(vb, filt + ((size_t)2 * 256 + ch) * S, filt + ((size_t)3 * 256 + ch) * S, t0, acc);
#pragma unroll
        for (int b = 0; b < 2; ++b)
#pragma unroll
            for (int i = 0; i < 16; ++i) { const int t = t0 + i; const int c = 256 + ch;
                const float x2 = hy_short(HYT + ((size_t)b * 768 + c) * S, t, S, sw[c], sw[768 + c], sw[1536 + c], sb[c]);
                mix[((size_t)b * S + t) * D + 768 + ch] = f2bf(x2 * (acc[b][i] * n1 + sk[256 + ch] * vb[b * S + t])); }
    }
}
DI void hyena_ctx_unit(const Frame& F, int li, int ch) {
    float* vs = (float*)F.lds;
    float* zs = vs + 512;
    float* fl = zs + 512;
    const bf16_t* HYC = WSP(bf16_t, WS_HYC); const float* filt = WSP(float, WS_FILTC);
    const float* sw = F.in[I_HYSW] + (size_t)li * 3 * 768; const float* sb = F.in[I_HYSB] + li * 768; const float* sk = F.in[I_HSKIP] + li * 512;
    const float n0 = hy_norm(WSP(float, WS_FPARTC), 4, 0, ch), n1 = hy_norm(WSP(float, WS_FPARTC), 4, 1, ch);
    const int b = F.tid >> 8, t = F.tid & 255;
    auto sc = [&](int c) -> float { const bf16_t* p = HYC + (size_t)(b * CTX) * 768 + c;
        const float a = t > 0 ? bf2f(p[(size_t)(t - 1) * 768]) : 0.f, d = t + 1 < CTX ? bf2f(p[(size_t)(t + 1) * 768]) : 0.f;
        return a * sw[c] + bf2f(p[(size_t)t * 768]) * sw[768 + c] + d * sw[1536 + c] + sb[c]; };
    __syncthreads();
    const float x1 = sc(ch), x2 = sc(256 + ch), v = sc(512 + ch);
    vs[F.tid] = v;
    for (int i = F.tid; i < 1024; i += NTHR) fl[i] = filt[((size_t)(i >> 8) * 256 + ch) * CTX + (i & 255)];
    __syncthreads();
    float a = 0.f;
    for (int s = 0; s < CTX; ++s) { const int dl = t - s; a += (dl >= 0 ? fl[dl] : fl[256 - dl]) * vs[b * 256 + s]; }
    const float z = x1 * (a * n0 + sk[ch] * v);
    zs[F.tid] = z;
    __syncthreads();
    a = 0.f;
    for (int s = 0; s < CTX; ++s) { const int dl = t - s; a += (dl >= 0 ? fl[512 + dl] : fl[768 - dl]) * zs[b * 256 + s]; }
    WSP(bf16_t, WS_HBF)[((size_t)NLAT + b * CTX + t) * D + 768 + ch] = f2bf(x2 * (a * n1 + sk[256 + ch] * z));
}

DI void phase_mix(const Frame& F0, int li) {
    const Frame& F = F0;
    unsigned* head = F.ctl + CW_QHEAD + li * 64;
    volatile unsigned* qs = (volatile unsigned*)(F.lds + LDS_MISC + 32);
    const int n_hy = 256, n_da = 512, n_na = 256, n_pl = 1024;
    const int n_ctx = (li == 0) ? (4 + 4 + 16 + 256) : 0;
    const int total = n_hy + n_da + n_na + n_pl + n_ctx;
    for (;;) {
        __syncthreads();
        if (F.tid == 0) qs[0] = __hip_atomic_fetch_add(head, 1u, __ATOMIC_RELAXED, __HIP_MEMORY_SCOPE_AGENT);
        __syncthreads();
        int u = (int)qs[0];
        if (u >= total) break;
        Frame F = F0; refresh(F);
        if (u < n_hy) {
#ifndef SKIP_HY
 hyena_unit(F, li, u);
#endif
 continue; }
        u -= n_hy;
        if (u < n_da) {
#ifndef SKIP_DA
 diffattn_unit(F, li, u >> 8, (u >> 6) & 3, u & 63);
#endif
 continue; }
        u -= n_da;
        if (u < n_na) {
#ifndef SKIP_NA
 na_unit(F, li, u);
#endif
 continue; }
        u -= n_na;
        if (u < n_pl) {
#ifndef SKIP_PL
 pool_unit(F, li, (size_t)(u >> 9) * S, S, (u & 511) * 32);
#endif
 continue; }
        u -= n_pl;
        if (u < 4) {
#ifndef SKIP_CA
 ctx_attn_a_unit(F, li, u);
#endif
 continue; }
        u -= 4;
        if (u < 4) {
#ifndef SKIP_CB
 ctx_attn_b_unit(F, u);
#endif
 continue; }
        u -= 4;
        if (u < 16) {
#ifndef SKIP_PL
 pool_unit(F, li, (size_t)NLAT + (u >> 3) * CTX, CTX, (u & 7) * 32);
#endif
 continue; }
        u -= 16;
#ifndef SKIP_HC
        hyena_ctx_unit(F, li, u);
#endif
    }
}

constexpr int PH_PER_LAYER = 8, NPH = 2 + 2 * PH_PER_LAYER;
__global__ void __launch_bounds__(NTHR, 2) mega(Args args) {
    extern __shared__ __attribute__((aligned(16))) unsigned char smem[];
    Frame F;
    F.in = args.in; F.out = args.out; F.ws = args.ws; F.ctl = (unsigned*)(args.ws + WS_CTL); F.lds = smem;
    F.tid = threadIdx.x; F.lane = F.tid & 63; F.wave = __builtin_amdgcn_readfirstlane(F.tid >> 6); F.G = gridDim.x; F.bid = blockIdx.x;
    if (F.tid < 64) ((unsigned*)(smem + LDS_MISC))[F.tid] = 0u;
    __syncthreads();
    const int lo = args.ph_lo, hi = args.ph_hi;
    const bool fused = (hi - lo) > 1;
    XcdBarrier bar; bar.bar = F.ctl; bar.x = 0; bar.st = (volatile LAS unsigned*)(smem + LDS_MISC);
    if (fused) bar = xcd_barrier_post(F.ctl, (volatile LAS unsigned*)(smem + LDS_MISC));
#define IN(k) (lo <= (k) && (k) < hi)
#define SEAM(k) do { if (IN(k) && IN((k) + 1)) xcd_barrier(bar); } while (0)
#ifndef SKIP_P0
    if (IN(0)) { refresh(F); phase_prologue(F); }
#endif
    SEAM(0);
    for (int li = 0; li < 2; ++li) {
        const int p0 = 1 + li * PH_PER_LAYER;
        const int nrows = (li == 0) ? NTOK : NLAT;
        if (IN(p0)) {
            refresh(F);
            phase_norm1(F, li, li == 0 ? 0 : 1);
            refresh(F);
#ifndef SKIP_FILT
            for (int t = F.bid; t < 256; t += F.G) filter_tile(F, li, S, t, WSP(float, WS_FILT), WSP(float, WS_FPART));
            if (li == 0) for (int t = F.bid; t < 4; t += F.G) filter_tile(F, li, CTX, t, WSP(float, WS_FILTC), WSP(float, WS_FPARTC));
#endif
        }
        SEAM(p0);
        if (IN(p0 + 1)) {
            refresh(F);
            pg8::Gemm g{WSP(bf16_t, WS_HBF), WSP(bf16_t, WS_WIN) + (size_t)li * DIN * D, D, 0};
            pg8::StaticOrder So; So.init(NTOK, DIN, F.G, F.bid);
            EpiIn E{F.ws, WSP(float, WS_ROPE), F.ctl + CW_KMAX + li * 16};
#ifndef SKIP_G1
            pg8::gemm_phase<EpiIn, pg8::StaticOrder>((LAS unsigned char*)smem, g, So, E, F.tid);
#endif
        }
        SEAM(p0 + 1);
        if (IN(p0 + 2)) { refresh(F); phase_mix(F, li); }
        SEAM(p0 + 2);
        if (IN(p0 + 3)) {
            refresh(F);
            pg8::Gemm g{WSP(bf16_t, WS_HBF), WSP(bf16_t, WS_WOUT) + (size_t)li * D * D, D, 0};
            pg8::StaticOrder So; So.init(nrows, D, F.G, F.bid);
            EpiOut E{li == 0 ? F.in[I_X] : F.out, li == 0 ? F.in[I_CTX] : WSP(float, WS_XC), F.out, WSP(float, WS_XC), WSP(float, WS_MOD) + (size_t)li * 3 * 6144};
#ifndef SKIP_G2
            pg8::gemm_phase<EpiOut, pg8::StaticOrder>((LAS unsigned char*)smem, g, So, E, F.tid);
#endif
        }
        SEAM(p0 + 3);
#ifndef SKIP_N2
        if (IN(p0 + 4)) { refresh(F); phase_norm2(F, li, nrows); }
#endif
        SEAM(p0 + 4);
        if (IN(p0 + 5)) { refresh(F); phase_gather(F, li, nrows); }
        SEAM(p0 + 5);
        if (IN(p0 + 6)) {
            refresh(F);
            int* offs = (int*)(smem + LDS_MISC + 64);
            moe_offsets(F, li, offs);
            pg8::Gemm g{WSP(bf16_t, WS_A1), WSP(bf16_t, WS_W13) + (size_t)li * NE * 1024 * 1024, D, (size_t)1024 * 1024};
            pg8::MoeOrder Mo{offs + 40, offs[17 + 16], 4, F.G, F.bid};
            EpiMoe1 E{WSP(bf16_t, WS_HMID)};
#ifndef SKIP_G3
            pg8::gemm_phase<EpiMoe1, pg8::MoeOrder>((LAS unsigned char*)smem, g, Mo, E, F.tid);
#endif
        }
        SEAM(p0 + 6);
        if (IN(p0 + 7)) {
            refresh(F);
            int* offs = (int*)(smem + LDS_MISC + 64);
            moe_offsets(F, li, offs);
            pg8::Gemm g{WSP(bf16_t, WS_HMID), WSP(bf16_t, WS_W2) + (size_t)li * NE * 1024 * 512, DE, (size_t)1024 * 512};
            pg8::MoeOrder Mo{offs + 40, offs[17 + 16], 4, F.G, F.bid};
            EpiMoe2 E{WSP(bf16_t, WS_A1)};
#ifndef SKIP_G4
            pg8::gemm_phase<EpiMoe2, pg8::MoeOrder>((LAS unsigned char*)smem, g, Mo, E, F.tid);
#endif
        }
        SEAM(p0 + 7);
    }
    if (IN(NPH - 1)) { refresh(F); phase_norm1(F, 1, 2); }
#undef IN
#undef SEAM
}

extern "C" void kernel_launch(void* const* d_in, const int* in_sizes, int n_in, void* d_out, int out_size, void* d_ws, size_t ws_size, hipStream_t stream) {
    static int grid = 0;
    if (grid == 0) {
        if (n_in != N_IN || out_size != NLAT * D || ws_size < WS_END) { fprintf(stderr, "kernel_launch: unexpected shapes (n_in %d out %d ws %zu need %zu)\n", n_in, out_size, ws_size, (size_t)WS_END); grid = -1; return; }
        int dev = 0, cus = 0, per_cu = 0;
        if (hipGetDevice(&dev) != hipSuccess || hipDeviceGetAttribute(&cus, hipDeviceAttributeMultiprocessorCount, dev) != hipSuccess) { grid = -1; return; }
        if (hipFuncSetAttribute((const void*)mega, hipFuncAttributeMaxDynamicSharedMemorySize, LDS_BYTES) != hipSuccess) { fprintf(stderr, "kernel_launch: hipFuncSetAttribute failed\n"); grid = -1; return; }
        if (hipOccupancyMaxActiveBlocksPerMultiprocessor(&per_cu, (const void*)mega, NTHR, LDS_BYTES) != hipSuccess || per_cu < 1) { fprintf(stderr, "kernel_launch: occupancy query says %d\n", per_cu); }
        (void)hipGetLastError();
        grid = cus;
    }
    if (grid < 0) return;
    (void)hipMemsetAsync((char*)d_ws + WS_CTL, 0, CTL_BYTES, stream);
    Args a{};
    for (int i = 0; i < N_IN; ++i) a.in[i] = (const float*)d_in[i];
    a.out = (float*)d_out; a.ws = (unsigned char*)d_ws;
#if N_LAUNCH_MODE == 1
    a.ph_lo = 0; a.ph_hi = NPH;
    hipLaunchKernelGGL(mega, dim3(grid), dim3(NTHR), LDS_BYTES, stream, a);
#else
    for (int p = 0; p < NPH; ++p) { a.ph_lo = p; a.ph_hi = p + 1; hipLaunchKernelGGL(mega, dim3(grid), dim3(NTHR), LDS_BYTES, stream, a); }
#endif
}
#ifdef TEST_UNITS
__global__ void __launch_bounds__(NTHR, 2) t_da(Args args) {
    extern __shared__ __attribute__((aligned(16))) unsigned char smem[];
    Frame F; F.in = args.in; F.out = args.out; F.ws = args.ws; F.ctl = (unsigned*)(args.ws + WS_CTL); F.lds = smem; F.G = gridDim.x; F.bid = blockIdx.x; refresh(F);
    diffattn_unit(F, args.ph_lo, blockIdx.x >> 8, (blockIdx.x >> 6) & 3, blockIdx.x & 63);
}
#endif
```

```cpp
#include <hip/hip_runtime.h>
#include <stdint.h>
#include <stdio.h>

#ifndef N_LAUNCH_MODE
#define N_LAUNCH_MODE 1
#endif

#define DI __device__ __forceinline__
#define LAS __attribute__((address_space(3)))
typedef unsigned short bf16_t;
typedef short bf16x8 __attribute__((ext_vector_type(8)));
typedef short s16x4 __attribute__((ext_vector_type(4)));
typedef float f32x4 __attribute__((ext_vector_type(4)));
typedef float f32x2 __attribute__((ext_vector_type(2)));
typedef float f32x16 __attribute__((ext_vector_type(16)));
typedef unsigned u32x4 __attribute__((ext_vector_type(4)));
typedef unsigned u32x2 __attribute__((ext_vector_type(2)));
typedef _Float16 h16x2 __attribute__((ext_vector_type(2)));

constexpr int D = 1024, NB = 2, S = 16384, CTX = 256, NLAT = NB * S, NCTX = NB * CTX, NTOK = NLAT + NCTX, DIN = 2560;
constexpr int NE = 16, DE = 512, GW = 64;
constexpr int NKEY = CTX + S;
constexpr int NTHR = 512;
constexpr int SLOT_CAP = 70656;
constexpr float EPS = 1e-6f;
constexpr float LOG2E = 1.4426950408889634f;
constexpr float QSCALE_A = 0.17677669529663687f * LOG2E;
constexpr float QSCALE_B = 0.125f * LOG2E;

enum { I_X = 0, I_C, I_CTX, I_CCTX, I_N1G, I_N2G, I_ADAW, I_ADAB, I_WIN, I_WOUT, I_ALAM, I_ASUB, I_RPB, I_POOLW, I_POOLS, I_HYSW, I_HYSB,
       I_HW1, I_HB1, I_HW2, I_HB2, I_HW3, I_HB3, I_HSKIP, I_RW, I_RB, I_MW1, I_MW3, I_MW2, I_FG, N_IN };

struct Args { const float* in[N_IN]; float* out; unsigned char* ws; int ph_lo, ph_hi; };

constexpr size_t al256(size_t x) { return (x + 255) & ~(size_t)255; }
constexpr size_t WS_CTL = 0, CTL_BYTES = 65536;
constexpr size_t WS_MOD = WS_CTL + CTL_BYTES;
constexpr size_t WS_ROPE = WS_MOD + al256(2 * 3 * 6144 * 4);
constexpr size_t WS_FPART = WS_ROPE + 16384;
constexpr size_t WS_FPARTC = WS_FPART + 256 * 1024 * 4;
constexpr size_t WS_XC = WS_FPARTC + 4 * 1024 * 4;
constexpr size_t WS_WIN = WS_XC + (size_t)NCTX * D * 4;
constexpr size_t WS_WOUT = WS_WIN + (size_t)2 * DIN * D * 2;
constexpr size_t WS_W13 = WS_WOUT + (size_t)2 * D * D * 2;
constexpr size_t WS_W2 = WS_W13 + (size_t)2 * NE * 1024 * 1024 * 2;
constexpr size_t WS_FILT = WS_W2 + (size_t)2 * NE * 1024 * 512 * 2;
constexpr size_t WS_FILTC = WS_FILT + (size_t)4 * 256 * S * 4;
constexpr size_t WS_ZBUF = WS_FILTC + (size_t)4 * 256 * 256 * 4;
constexpr size_t WS_R1 = WS_ZBUF + (size_t)256 * 2 * S * 4;
constexpr size_t WS_HBF = WS_R1;
constexpr size_t TOKB = (size_t)NTOK * 256 * 2;
constexpr size_t WS_AQ = WS_HBF + (size_t)NTOK * D * 2;
constexpr size_t WS_AK = WS_AQ + TOKB;
constexpr size_t WS_AVT = WS_AK + TOKB;
constexpr size_t WS_BQ = WS_AVT + (size_t)NB * 4 * 64 * NKEY * 2;
constexpr size_t WS_BK = WS_BQ + TOKB;
constexpr size_t WS_BV = WS_BK + TOKB;
constexpr size_t WS_PL = WS_BV + TOKB;
constexpr size_t WS_HYT = WS_PL + TOKB;
constexpr size_t WS_HYC = WS_HYT + (size_t)NB * 768 * S * 2;
constexpr size_t WS_Z1BUF = WS_HYC + (size_t)NCTX * 768 * 2;
constexpr size_t WS_END_MIX = WS_Z1BUF + (size_t)256 * S * 8;
constexpr size_t WS_TOK = WS_AQ;
constexpr size_t WS_A1 = WS_TOK + al256((size_t)NTOK * 32);
constexpr size_t WS_HMID = WS_A1 + (size_t)SLOT_CAP * D * 2;
constexpr size_t WS_END_MOE = WS_HMID + (size_t)SLOT_CAP * DE * 2;
constexpr size_t WS_END = WS_END_MIX > WS_END_MOE ? WS_END_MIX : WS_END_MOE;

#define XB_TMO      128
#define XB_XCNT(j)  (256  + 64 * (j))
#define XB_XSUB(j)  (1280 + 64 * (j))
#define XB_XGEN(j)  (2304 + 64 * (j))
#define XB_TOP      3328
#define XB_TOPGEN   3392
#define XCD_BAR_WORDS 3456
#define XB_SPIN_CAP (1u << 18)
constexpr int CW_CNT = 4096;
constexpr int CW_KMAX = 4160;
constexpr int CW_QHEAD = 4224;

constexpr int LDS_MAIN = 143360, LDS_MISC = LDS_MAIN, LDS_BYTES = LDS_MAIN + 2048;

DI float bf2f(bf16_t v) { return __uint_as_float(((unsigned)v) << 16); }
DI bf16_t f2bf(float f) { unsigned u = __float_as_uint(f); u += 0x7FFFu + ((u >> 16) & 1u); return (bf16_t)(u >> 16); }
DI unsigned pk2(float lo, float hi) { unsigned r; asm volatile("v_cvt_pk_bf16_f32 %0, %1, %2" : "=v"(r) : "v"(lo), "v"(hi)); return r; }
template <int K> DI float swz_xor(float v) { return __int_as_float(__builtin_amdgcn_ds_swizzle(__float_as_int(v), (K << 10) | 0x1F)); }
DI float half_sum(float v) { const auto r = __builtin_amdgcn_permlane32_swap(__float_as_uint(v), __float_as_uint(v), false, false); return __uint_as_float(r[0]) + __uint_as_float(r[1]); }
DI float half_max(float v) { const auto r = __builtin_amdgcn_permlane32_swap(__float_as_uint(v), __float_as_uint(v), false, false); return fmaxf(__uint_as_float(r[0]), __uint_as_float(r[1])); }
DI float wave_sum(float v) { v += swz_xor<16>(v); v += swz_xor<8>(v); v += swz_xor<4>(v); v += swz_xor<2>(v); v += swz_xor<1>(v); return half_sum(v); }
DI float wave_max(float v) { v = fmaxf(v, swz_xor<16>(v)); v = fmaxf(v, swz_xor<8>(v)); v = fmaxf(v, swz_xor<4>(v)); v = fmaxf(v, swz_xor<2>(v)); v = fmaxf(v, swz_xor<1>(v)); return half_max(v); }
DI float siluf(float x) { return x / (1.f + __expf(-x)); }
DI float sin_rev(float rev) { return __builtin_amdgcn_sinf(rev - floorf(rev)); }
DI float cos_rev(float rev) { return __builtin_amdgcn_cosf(rev - floorf(rev)); }
DI float sin_rad(float x) { return sin_rev(x * 0.15915494309189535f); }

DI unsigned xb_ld(unsigned* p)              { return __hip_atomic_load(p, __ATOMIC_RELAXED, __HIP_MEMORY_SCOPE_AGENT); }
DI unsigned xb_add(unsigned* p, unsigned v) { return __hip_atomic_fetch_add(p, v, __ATOMIC_RELAXED, __HIP_MEMORY_SCOPE_AGENT); }
DI unsigned xb_xcc_id() { return (unsigned)__builtin_amdgcn_s_getreg((3 << 11) | 20) & 0xFu; }
#define XB_SPIN(cond, bar) do { unsigned _sp = 0; while (cond) { __builtin_amdgcn_s_sleep(1); \
    if ((++_sp & 255u) == 0u) { if (xb_ld(&(bar)[XB_TMO])) break; if (_sp > XB_SPIN_CAP) { atomicAdd(&(bar)[XB_TMO], 1u); break; } } } } while (0)
struct XcdBarrier { unsigned* bar; unsigned x; volatile LAS unsigned* st; };
DI XcdBarrier xcd_barrier_post(unsigned* bar, volatile LAS unsigned* st) {
    XcdBarrier b; b.bar = bar; b.x = xb_xcc_id(); b.st = st;
    if (threadIdx.x == 0) (void)xb_add(&bar[XB_XCNT(b.x)], 1u);
    return b;
}
DI void xcd_barrier_complete(unsigned* bar, unsigned x, unsigned& nloc, unsigned& nx) {
    const unsigned G = gridDim.x * gridDim.y * gridDim.z;
    unsigned sum, cnt, mine, sp = 0u;
    for (;;) {
        sum = 0u; cnt = 0u; mine = 0u;
#pragma unroll
        for (unsigned j = 0; j < 16; ++j) { const unsigned c = xb_ld(&bar[XB_XCNT(j)]); sum += c; cnt += (c > 0u) ? 1u : 0u; mine = (j == x) ? c : mine; }
        if (sum == G) break;
        __builtin_amdgcn_s_sleep(1);
        if ((++sp & 255u) == 0u) { if (xb_ld(&bar[XB_TMO])) break; if (sp > XB_SPIN_CAP) { atomicAdd(&bar[XB_TMO], 1u); break; } }
    }
    nloc = mine > 0u ? mine : 1u; nx = cnt > 0u ? cnt : 1u;
}
DI void xcd_barrier(const XcdBarrier& b) {
    asm volatile("s_waitcnt vmcnt(0)" ::: "memory");
    __syncthreads();
    if (threadIdx.x == 0) {
        unsigned* bar = b.bar;
        __builtin_amdgcn_s_waitcnt(0);
        unsigned nloc = b.st[0], nx = b.st[1];
        if (nloc == 0u) { xcd_barrier_complete(bar, b.x, nloc, nx); b.st[0] = nloc; b.st[1] = nx; }
        const unsigned old = xb_add(&bar[XB_XSUB(b.x)], 1u);
        const unsigned gen = old / nloc;
        if (old + 1u == (gen + 1u) * nloc) {
            __builtin_amdgcn_fence(__ATOMIC_RELEASE, "agent");
            asm volatile("s_waitcnt vmcnt(0)" ::: "memory");
            const unsigned og = xb_add(&bar[XB_TOP], 1u);
            const unsigned tg = og / nx;
            if (og + 1u == (tg + 1u) * nx) xb_add(&bar[XB_TOPGEN], 1u);
            else XB_SPIN(xb_ld(&bar[XB_TOPGEN]) == tg, bar);
            __builtin_amdgcn_fence(__ATOMIC_ACQUIRE, "agent");
            xb_add(&bar[XB_XGEN(b.x)], 1u);
            asm volatile("s_waitcnt vmcnt(0)" ::: "memory");
        } else {
            XB_SPIN(xb_ld(&bar[XB_XGEN(b.x)]) == gen, bar);
            __builtin_amdgcn_fence(__ATOMIC_ACQUIRE, "agent");
            asm volatile("s_waitcnt vmcnt(0)" ::: "memory");
        }
    }
    __syncthreads();
}

struct Frame {
    const float* const* in; float* out; unsigned char* ws; unsigned* ctl;
    unsigned char* lds;
    int tid, lane, wave, G, bid;
};
#define WSP(T, off) ((T*)(F.ws + (off)))
DI void refresh(Frame& F) { int t = threadIdx.x; asm volatile("" : "+v"(t)); F.tid = t; F.lane = t & 63; F.wave = __builtin_amdgcn_readfirstlane(t >> 6);
}

namespace pg8 {
constexpr int BM = 256, BK = 64, HALF = 128, HTB = HALF * BK * 2, STAGE_BYTES = 8 * HTB, NXCD = 8, WGM = 8;
DI int lds_byte(int r, int c) { const int st = (r >> 4) * 2 + (c >> 5), rr = r & 15, cc = c & 31, ob = rr * 64 + cc * 2; return st * 1024 + (ob ^ (((ob >> 9) & 1) << 5)); }
DI void stage_rc(int b, int& R, int& C) { const int st = b / 1024, sb = b % 1024, swz = sb ^ (((sb >> 9) & 1) << 5); R = (st >> 1) * 16 + swz / 64; C = (st & 1) * 32 + (swz % 64) / 2; }
struct Unit { int pm, pn, e; };
struct Gemm { const bf16_t* A; const bf16_t* Bt; int K; size_t bstride; };
struct StaticOrder {
    int nM, nN, nwg, G, c;
    DI void init(int M, int N, int G_, int c_) { nM = M / BM; nN = N / BM; nwg = nM * nN; G = G_; c = c_; }
    DI bool next(int i, Unit& u) const {
        const long L = (long)i * G + c; if (L >= nwg) return false;
        int wgid = (int)L; { const int q = nwg / NXCD, r = nwg % NXCD, xcd = wgid % NXCD, off = wgid / NXCD; wgid = (xcd < r ? xcd * (q + 1) : r * (q + 1) + (xcd - r) * q) + off; }
        const int nig = WGM * nN, gid = wgid / nig, fm = gid * WGM, gsz = (nM - fm) < WGM ? (nM - fm) : WGM;
        u.pm = fm + ((wgid % nig) % gsz); u.pn = (wgid % nig) / gsz; u.e = 0; return true;
    }
};
struct MoeOrder {
    const int* toff; int ntile, nN, G, c;
    DI bool next(int i, Unit& u) const {
        const long L = (long)i * G + c; if (L >= (long)ntile * nN) return false;
        const int t = (int)(L / nN); u.pm = t; u.pn = (int)(L % nN);
        u.e = toff[t]; return true;
    }
};

template <class Epi, class Sched>
DI void gemm_phase(LAS unsigned char* lds, const Gemm g, const Sched& S, const Epi& E, int tid) {
    const int wid = __builtin_amdgcn_readfirstlane(tid >> 6), lane = tid & 63, wr = wid >> 2, wc = wid & 3, fr = lane & 15, fq = lane >> 4;
    const int K = g.K, nt = K / BK;
    unsigned voffA[2];
#pragma unroll
    for (int i = 0; i < 2; ++i) { int R, C; stage_rc(tid * 16 + i * 8192, R, C); voffA[i] = (unsigned)(R * K + C) * 2u; }
    const size_t kstep = (size_t)(BK * 2);
    const size_t hstep = (size_t)HALF * K * 2;
    const size_t tstep = 2 * hstep;
    const unsigned ldsw = (unsigned)wid * 1024u;
    const int aoff = lds_byte(wr * 64 + fr, fq * 8), boff = lds_byte(wc * 32 + fr, fq * 8);
#define PG8_SA(b, h) (((b) * 2 + (h)) * HTB)
#define PG8_SB(b, h) ((4 + (b) * 2 + (h)) * HTB)
#define PG8_STAGE(bufoff, gbase, voff) do { _Pragma("unroll") for (int _i = 0; _i < 2; ++_i) \
        __builtin_amdgcn_global_load_lds((const unsigned*)((const char*)(gbase) + (voff)[_i]), (LAS unsigned*)(lds + (bufoff) + ldsw + _i * 8192), 16, 0, 0); } while (0)
#define PG8_LDA(dst, b, h) do { _Pragma("unroll") for (int m = 0; m < 4; ++m) _Pragma("unroll") for (int k = 0; k < 2; ++k) dst[m][k] = *(const LAS bf16x8*)(lds + PG8_SA(b, h) + aoff + m * 2048 + k * 1024); } while (0)
#define PG8_LDB(dst, b, h) do { _Pragma("unroll") for (int n = 0; n < 2; ++n) _Pragma("unroll") for (int k = 0; k < 2; ++k) dst[n][k] = *(const LAS bf16x8*)(lds + PG8_SB(b, h) + boff + n * 2048 + k * 1024); } while (0)
#define PG8_MMA(ai, bj, At, Bt) do { __builtin_amdgcn_s_setprio(1); _Pragma("unroll") for (int m = 0; m < 4; ++m) _Pragma("unroll") for (int n = 0; n < 2; ++n) _Pragma("unroll") for (int k = 0; k < 2; ++k) \
        acc[ai][bj][m][n] = __builtin_amdgcn_mfma_f32_16x16x32_bf16(Bt[n][k], At[m][k], acc[ai][bj][m][n], 0, 0, 0); __builtin_amdgcn_s_setprio(0); } while (0)
#define PG8_WAIT_V(n) asm volatile("s_waitcnt vmcnt(" #n ")" ::: "memory")
#define PG8_WAIT_L(n) asm volatile("s_waitcnt lgkmcnt(" #n ")" ::: "memory")
#define PG8_BAR __builtin_amdgcn_s_barrier()
#define PG8_SCHED __builtin_amdgcn_sched_barrier(0)
    Unit cur, nxt; int ui = 0;
    if (!S.next(0, cur)) return;
    f32x4 acc[2][2][4][2];
#pragma unroll
    for (int a = 0; a < 2; ++a)
#pragma unroll
        for (int b = 0; b < 2; ++b)
#pragma unroll
            for (int m = 0; m < 4; ++m)
#pragma unroll
                for (int n = 0; n < 2; ++n) acc[a][b][m][n] = (f32x4){0.f, 0.f, 0.f, 0.f};
    bf16x8 At[4][2], B0[2][2], B1[2][2];
    const char* cA = (const char*)g.A + (size_t)cur.pm * tstep; const char* cB = (const char*)(g.Bt + (size_t)cur.e * g.bstride) + (size_t)cur.pn * tstep;
    PG8_STAGE(PG8_SB(0, 0), cB, voffA); PG8_STAGE(PG8_SA(0, 0), cA, voffA); PG8_STAGE(PG8_SB(0, 1), cB + hstep, voffA); PG8_STAGE(PG8_SA(0, 1), cA + hstep, voffA);
    if (wr == 1) PG8_BAR;
    PG8_WAIT_V(4); PG8_BAR;
    PG8_STAGE(PG8_SB(1, 0), cB + kstep, voffA); PG8_STAGE(PG8_SA(1, 0), cA + kstep, voffA); PG8_STAGE(PG8_SB(1, 1), cB + hstep + kstep, voffA);
    PG8_WAIT_V(6); PG8_BAR;
    for (;;) {
        const bool has_next = S.next(ui + 1, nxt);
        const char* nA = has_next ? (const char*)g.A + (size_t)nxt.pm * tstep : cA; const char* nB = has_next ? (const char*)(g.Bt + (size_t)nxt.e * g.bstride) + (size_t)nxt.pn * tstep : cB;
        for (int t = 0; t < nt; t += 2) {
            const bool last = (t == nt - 2);
            const char* a1 = cA + (size_t)(t + 1) * kstep;
            const char* a2 = last ? nA : cA + (size_t)(t + 2) * kstep; const char* b2 = last ? nB : cB + (size_t)(t + 2) * kstep;
            const char* a3 = a2 + kstep; const char* b3 = b2 + kstep;
            PG8_LDB(B0, 0, 0); PG8_SCHED; PG8_LDA(At, 0, 0); PG8_STAGE(PG8_SA(1, 1), a1 + hstep, voffA);
            PG8_WAIT_L(8); PG8_BAR; PG8_WAIT_L(0); PG8_MMA(0, 0, At, B0); PG8_BAR; PG8_SCHED;
            PG8_LDB(B1, 0, 1); PG8_STAGE(PG8_SB(0, 0), b2, voffA);
            PG8_BAR; PG8_WAIT_L(0); PG8_MMA(0, 1, At, B1); PG8_BAR;
            PG8_LDA(At, 0, 1); PG8_STAGE(PG8_SA(0, 0), a2, voffA);
            PG8_BAR; PG8_WAIT_L(0); PG8_MMA(1, 0, At, B0); PG8_BAR; PG8_SCHED;
            PG8_STAGE(PG8_SB(0, 1), b2 + hstep, voffA);
            PG8_WAIT_V(6); PG8_BAR; PG8_MMA(1, 1, At, B1); PG8_BAR;
            PG8_LDB(B0, 1, 0); PG8_SCHED; PG8_LDA(At, 1, 0); PG8_STAGE(PG8_SA(0, 1), a2 + hstep, voffA);
            PG8_WAIT_L(8); PG8_BAR; PG8_WAIT_L(0); PG8_MMA(0, 0, At, B0); PG8_BAR; PG8_SCHED;
            PG8_LDB(B1, 1, 1); PG8_STAGE(PG8_SB(1, 0), b3, voffA);
            PG8_BAR; PG8_WAIT_L(0); PG8_MMA(0, 1, At, B1); PG8_BAR;
            PG8_LDA(At, 1, 1); PG8_STAGE(PG8_SA(1, 0), a3, voffA);
            PG8_BAR; PG8_WAIT_L(0); PG8_MMA(1, 0, At, B0); PG8_BAR; PG8_SCHED;
            PG8_STAGE(PG8_SB(1, 1), b3 + hstep, voffA);
            PG8_WAIT_V(6); PG8_BAR; PG8_MMA(1, 1, At, B1); PG8_BAR;
        }
        E(acc, cur, wr, wc, fr, fq);
        if (!has_next) break;
#pragma unroll
        for (int a = 0; a < 2; ++a)
#pragma unroll
            for (int b = 0; b < 2; ++b)
#pragma unroll
                for (int m = 0; m < 4; ++m)
#pragma unroll
                    for (int n = 0; n < 2; ++n) acc[a][b][m][n] = (f32x4){0.f, 0.f, 0.f, 0.f};
        cur = nxt; cA = nA; cB = nB; ++ui;
    }
    PG8_WAIT_V(0);
    if (wr == 0) PG8_BAR;
    PG8_BAR;
#undef PG8_SA
#undef PG8_SB
#undef PG8_STAGE
#undef PG8_LDA
#undef PG8_LDB
#undef PG8_MMA
#undef PG8_WAIT_V
#undef PG8_WAIT_L
#undef PG8_BAR
#undef PG8_SCHED
}
}

typedef f32x4 AccT[2][2][4][2];

struct EpiIn {
    unsigned char* ws; const float* rope; unsigned* kmax;
    DI void operator()(const AccT& acc, const pg8::Unit& u, int wr, int wc, int fr, int fq) const {
        const int pn = u.pn, row0 = u.pm * 256 + wr * 64 + fr;
        const bool isctx = (u.pm >= NLAT / 256);
        if (pn <= 1) {
            bf16_t* dst = (bf16_t*)(ws + (pn == 0 ? WS_AQ : WS_AK));
            const float sc = (pn == 0) ? QSCALE_A : 1.f;
            float nmax[2] = {0.f, 0.f};
#pragma unroll
            for (int ai = 0; ai < 2; ++ai)
#pragma unroll
                for (int m = 0; m < 4; ++m) {
                    const int r = row0 + ai * 128 + m * 16;
                    f32x4 cs0 = (f32x4){1.f, 0.f, 1.f, 0.f}, cs1 = cs0;
                    if (!isctx) { const int t = r & (S - 1); const int pos = (fq < 2) ? (t >> 6) : (t & 63);
                        const f32x4* tp = (const f32x4*)(rope + (size_t)pos * 16 + (fq & 1) * 8); cs0 = tp[0]; cs1 = tp[1]; }
                    const float cc[4] = {cs0[0], cs0[2], cs1[0], cs1[2]}, ss[4] = {cs0[1], cs0[3], cs1[1], cs1[3]};
#pragma unroll
                    for (int bj = 0; bj < 2; ++bj) {
                        const f32x4 x1 = acc[ai][bj][m][0], x2 = acc[ai][bj][m][1];
                        float o1[4], o2[4], n2 = 0.f;
#pragma unroll
                        for (int j = 0; j < 4; ++j) { o1[j] = (x1[j] * cc[j] - x2[j] * ss[j]) * sc; o2[j] = (x2[j] * cc[j] + x1[j] * ss[j]) * sc; n2 += x1[j] * x1[j] + x2[j] * x2[j]; }
                        bf16_t* p = dst + (size_t)r * 256 + bj * 128 + wc * 32 + 4 * fq;
                        *(u32x2*)p = (u32x2){pk2(o1[0], o1[1]), pk2(o1[2], o1[3])};
                        *(u32x2*)(p + 16) = (u32x2){pk2(o2[0], o2[1]), pk2(o2[2], o2[3])};
                        if (pn == 1) { n2 += swz_xor<16>(n2); n2 = half_sum(n2); nmax[bj] = fmaxf(nmax[bj], n2); }
                    }
                }
            if (pn == 1) {
                const int b = isctx ? (u.pm - NLAT / 256) : (u.pm / (S / 256));
#pragma unroll
                for (int bj = 0; bj < 2; ++bj) {
                    float v = nmax[bj];
                    v = fmaxf(v, swz_xor<1>(v)); v = fmaxf(v, swz_xor<2>(v)); v = fmaxf(v, swz_xor<4>(v)); v = fmaxf(v, swz_xor<8>(v));
                    if ((fr | fq) == 0) atomicMax(kmax + (b * 4 + (2 * bj + (wc >> 1))) * 2 + (wc & 1), __float_as_uint(v));
                }
            }
        } else if (pn == 2) {
            bf16_t* dst = (bf16_t*)(ws + WS_AVT);
#pragma unroll
            for (int ai = 0; ai < 2; ++ai)
#pragma unroll
                for (int m = 0; m < 4; ++m) {
                    const int r = row0 + ai * 128 + m * 16;
                    int b, key; if (isctx) { b = (r - NLAT) >> 8; key = (r - NLAT) & 255; } else { b = r >> 14; key = CTX + (r & (S - 1)); }
#pragma unroll
                    for (int bj = 0; bj < 2; ++bj)
#pragma unroll
                        for (int n = 0; n < 2; ++n) {
                            const int lc = bj * 128 + wc * 32 + n * 16 + 4 * fq;
#pragma unroll
                            for (int j = 0; j < 4; ++j) dst[((size_t)(b * 256 + lc + j)) * NKEY + key] = f2bf(acc[ai][bj][m][n][j]);
                        }
                }
        } else if (pn <= 6) {
            bf16_t* dst = (bf16_t*)(ws + (pn == 3 ? WS_BQ : pn == 4 ? WS_BK : pn == 5 ? WS_BV : WS_PL));
            const float sc = (pn == 3) ? QSCALE_B : 1.f;
#pragma unroll
            for (int ai = 0; ai < 2; ++ai)
#pragma unroll
                for (int m = 0; m < 4; ++m) {
                    const int r = row0 + ai * 128 + m * 16;
#pragma unroll
                    for (int bj = 0; bj < 2; ++bj)
#pragma unroll
                        for (int n = 0; n < 2; ++n) {
                            const f32x4 v = acc[ai][bj][m][n] * sc;
                            *(u32x2*)(dst + (size_t)r * 256 + bj * 128 + wc * 32 + n * 16 + 4 * fq) = (u32x2){pk2(v[0], v[1]), pk2(v[2], v[3])};
                        }
                }
        } else {
            const int hc0 = (pn - 7) * 256;
#pragma unroll
            for (int ai = 0; ai < 2; ++ai)
#pragma unroll
                for (int m = 0; m < 4; ++m) {
                    const int r = row0 + ai * 128 + m * 16;
#pragma unroll
                    for (int bj = 0; bj < 2; ++bj)
#pragma unroll
                        for (int n = 0; n < 2; ++n) {
                            const int hc = hc0 + bj * 128 + wc * 32 + n * 16 + 4 * fq; const f32x4 v = acc[ai][bj][m][n];
                            if (isctx) *(u32x2*)((bf16_t*)(ws + WS_HYC) + (size_t)(r - NLAT) * 768 + hc) = (u32x2){pk2(v[0], v[1]), pk2(v[2], v[3])};
                            else { bf16_t* dst = (bf16_t*)(ws + WS_HYT) + ((size_t)(r >> 14) * 768 + hc) * S + (r & (S - 1));
#pragma unroll
                                for (int j = 0; j < 4; ++j) dst[(size_t)j * S] = f2bf(v[j]); }
                        }
                }
        }
    }
};

struct EpiOut {
    const float* xl_old; const float* xc_old; float* xl_new; float* xc_new; const float* mod;
    DI void operator()(const AccT& acc, const pg8::Unit& u, int wr, int wc, int fr, int fq) const {
        const int row0 = u.pm * 256 + wr * 64 + fr; const bool isctx = (u.pm >= NLAT / 256);
        const int v = isctx ? 2 : (u.pm / (S / 256));
        const float* g1 = mod + (size_t)v * 6144 + 2 * 1024;
        const float* so = isctx ? xc_old - (size_t)NLAT * D : xl_old; float* dn = isctx ? xc_new - (size_t)NLAT * D : xl_new;
#pragma unroll
        for (int bj = 0; bj < 2; ++bj)
#pragma unroll
            for (int n = 0; n < 2; ++n) {
                const int c = u.pn * 256 + bj * 128 + wc * 32 + n * 16 + 4 * fq;
                const f32x4 g = *(const f32x4*)(g1 + c);
#pragma unroll
                for (int ai = 0; ai < 2; ++ai)
#pragma unroll
                    for (int m = 0; m < 4; ++m) {
                        const size_t o = (size_t)(row0 + ai * 128 + m * 16) * D + c;
                        *(f32x4*)(dn + o) = *(const f32x4*)(so + o) + g * acc[ai][bj][m][n];
                    }
            }
    }
};

struct EpiMoe1 {
    bf16_t* hmid;
    DI void operator()(const AccT& acc, const pg8::Unit& u, int wr, int wc, int fr, int fq) const {
        const int row0 = u.pm * 256 + wr * 64 + fr;
#pragma unroll
        for (int ai = 0; ai < 2; ++ai)
#pragma unroll
            for (int m = 0; m < 4; ++m)
#pragma unroll
                for (int bj = 0; bj < 2; ++bj) {
                    const f32x4 a = acc[ai][bj][m][0], b = acc[ai][bj][m][1]; float h[4];
#pragma unroll
                    for (int j = 0; j < 4; ++j) h[j] = siluf(a[j]) * b[j];
                    *(u32x2*)(hmid + (size_t)(row0 + ai * 128 + m * 16) * DE + (u.pn * 256 + bj * 128 + wc * 32) / 2 + 4 * fq) = (u32x2){pk2(h[0], h[1]), pk2(h[2], h[3])};
                }
    }
};
struct EpiMoe2 {
    bf16_t* ys;
    DI void operator()(const AccT& acc, const pg8::Unit& u, int wr, int wc, int fr, int fq) const {
        const int row0 = u.pm * 256 + wr * 64 + fr;
#pragma unroll
        for (int ai = 0; ai < 2; ++ai)
#pragma unroll
            for (int m = 0; m < 4; ++m)
#pragma unroll
                for (int bj = 0; bj < 2; ++bj)
#pragma unroll
                    for (int n = 0; n < 2; ++n) { const f32x4 v = acc[ai][bj][m][n];
                        *(u32x2*)(ys + (size_t)(row0 + ai * 128 + m * 16) * D + u.pn * 256 + bj * 128 + wc * 32 + n * 16 + 4 * fq) = (u32x2){pk2(v[0], v[1]), pk2(v[2], v[3])}; }
    }
};

DI void tconv_tile(const Frame& F, const float* src, int N, int k0, int n0, bf16_t* dst, int ldd, int mode) {
    float* tl = (float*)F.lds;
    __syncthreads();
#pragma unroll
    for (int i = 0; i < 8; ++i) { const int idx = F.tid + 512 * i, k = idx >> 6, n = idx & 63; tl[k * 65 + n] = src[(size_t)(k0 + k) * N + n0 + n]; }
    __syncthreads();
#pragma unroll
    for (int i = 0; i < 4; ++i) { const int idx = F.tid + 512 * i, n = idx >> 5, kp = idx & 31;
        const int nn = n0 + n; const int row = (mode == 0) ? nn : ((nn >> 4) * 32 + (mode - 1) * 16 + (nn & 15));
        *(unsigned*)(dst + (size_t)row * ldd + k0 + 2 * kp) = pk2(tl[(2 * kp) * 65 + n], tl[(2 * kp + 1) * 65 + n]); }
}
DI void phase_prologue(const Frame& F) {
    const int T_IN = 16 * 40, T_OUT = 16 * 16, T_E = 16 * 8;
    const int per_layer = T_IN + T_OUT + NE * 3 * T_E, total = 2 * per_layer;
    for (int u = F.bid; u < total; u += F.G) {
        const int li = u / per_layer; int r = u % per_layer;
        if (r < T_IN) { tconv_tile(F, F.in[I_WIN] + (size_t)li * D * DIN, DIN, (r / 40) * 64, (r % 40) * 64, WSP(bf16_t, WS_WIN) + (size_t)li * DIN * D, D, 0); continue; }
        r -= T_IN;
        if (r < T_OUT) { tconv_tile(F, F.in[I_WOUT] + (size_t)li * D * D, D, (r / 16) * 64, (r % 16) * 64, WSP(bf16_t, WS_WOUT) + (size_t)li * D * D, D, 0); continue; }
        r -= T_OUT;
        const int e = r / (3 * T_E), w = (r / T_E) % 3, t = r % T_E;
        if (w < 2) tconv_tile(F, F.in[w == 0 ? I_MW1 : I_MW3] + ((size_t)li * NE + e) * D * DE, DE, (t / 8) * 64, (t % 8) * 64, WSP(bf16_t, WS_W13) + ((size_t)li * NE + e) * 1024 * 1024, D, 1 + w);
        else tconv_tile(F, F.in[I_MW2] + ((size_t)li * NE + e) * DE * D, D, (t / 16) * 64, (t % 16) * 64, WSP(bf16_t, WS_W2) + ((size_t)li * NE + e) * 1024 * 512, DE, 0);
    }
    __syncthreads();
    {
        float* sc = (float*)F.lds;
        float* red = sc + 3072;
        for (int i = F.tid; i < 3072; i += NTHR) { const int v = i >> 10, k = i & 1023; const float x = (v < 2) ? F.in[I_C][v * 1024 + k] : F.in[I_CCTX][k]; sc[i] = siluf(x); }
        __syncthreads();
        for (int u = F.bid; u < 2 * 96; u += F.G) {
            const int li = u / 96, j = (u % 96) * 64 + F.lane, ko = F.wave;
            const float* w = F.in[I_ADAW] + (size_t)li * D * 6144 + j;
            float a0 = 0.f, a1 = 0.f, a2 = 0.f;
            for (int k = ko * 128; k < ko * 128 + 128; ++k) { const float wv = w[(size_t)k * 6144]; a0 += sc[k] * wv; a1 += sc[1024 + k] * wv; a2 += sc[2048 + k] * wv; }
            red[(ko * 3 + 0) * 64 + F.lane] = a0; red[(ko * 3 + 1) * 64 + F.lane] = a1; red[(ko * 3 + 2) * 64 + F.lane] = a2;
            __syncthreads();
            if (F.tid < 192) { const int v = F.tid / 64, l = F.tid % 64; float s = 0.f;
#pragma unroll
                for (int q = 0; q < 8; ++q) s += red[(q * 3 + v) * 64 + l];
                const int jj = (u % 96) * 64 + l;
                WSP(float, WS_MOD)[((size_t)li * 3 + v) * 6144 + jj] = s + F.in[I_ADAB][li * 6144 + jj]; }
            __syncthreads();
        }
    }
    if (F.bid == (F.G > 1 ? 1 : 0)) {
        for (int i = F.tid; i < 256 * 8; i += NTHR) { const int pos = i >> 3, f = i & 7; const float inv = exp2f(-(float)f * (13.287712379549449f / 8.f)); const float rev = (float)pos * inv * 0.15915494309189535f;
            WSP(float, WS_ROPE)[i * 2] = cos_rev(rev); WSP(float, WS_ROPE)[i * 2 + 1] = sin_rev(rev); }
    }
}

DI void filter_tile(const Frame& F, int li, int L, int tile, float* hT, float* part) {
    float* h1s = (float*)F.lds;
    float* h2s = h1s + 4096;
    float* stg = h2s + 4096;
    float* sq2 = stg + 256 * 65;
    const float* w1 = F.in[I_HW1] + (size_t)li * 33 * 64; const float* b1 = F.in[I_HB1] + li * 64;
    const float* w2 = F.in[I_HW2] + (size_t)li * 64 * 64; const float* b2 = F.in[I_HB2] + li * 64;
    const float* w3 = F.in[I_HW3] + (size_t)li * 64 * 1024; const float* b3 = F.in[I_HB3] + li * 1024;
    const int t0 = tile * 64;
    const float inv_lm1 = 1.f / (float)(L > 1 ? L - 1 : 1);
    __syncthreads();
    {
        const int tl = F.tid & 63, pt = F.tid >> 6; const float t = (float)(t0 + tl);
        float a[8];
#pragma unroll
        for (int jj = 0; jj < 8; ++jj) a[jj] = b1[pt * 8 + jj] + (t * inv_lm1) * w1[pt * 8 + jj];
#pragma unroll 1
        for (int i = 0; i < 16; ++i) { const float band = 1e-4f + (15.f - 1e-4f) * (float)i / 15.f; const float rev = t * band / (float)L; const float cz = cos_rev(rev), sz = sin_rev(rev);
#pragma unroll
            for (int jj = 0; jj < 8; ++jj) a[jj] += cz * w1[(1 + i) * 64 + pt * 8 + jj] + sz * w1[(17 + i) * 64 + pt * 8 + jj]; }
#pragma unroll
        for (int jj = 0; jj < 8; ++jj) h1s[tl * 64 + pt * 8 + jj] = sin_rad(a[jj]);
    }
    __syncthreads();
    {
        const int tl = F.tid & 63, pt = F.tid >> 6;
        float a[8];
#pragma unroll
        for (int jj = 0; jj < 8; ++jj) a[jj] = b2[pt * 8 + jj];
#pragma unroll 1
        for (int i = 0; i < 64; ++i) { const float hv = h1s[tl * 64 + i];
#pragma unroll
            for (int jj = 0; jj < 8; ++jj) a[jj] += hv * w2[i * 64 + pt * 8 + jj]; }
#pragma unroll
        for (int jj = 0; jj < 8; ++jj) h2s[tl * 64 + pt * 8 + jj] = sin_rad(a[jj]);
    }
    __syncthreads();
    const int c = F.tid & 255, th = F.tid >> 8;
    const float delta = 3.0701134573253945f + (15.350567286626973f - 3.0701134573253945f) * (float)c / 255.f;
#pragma unroll 1
    for (int cc = 0; cc < 4; ++cc) {
        float wr[64];
#pragma unroll
        for (int i = 0; i < 64; ++i) wr[i] = w3[(size_t)i * 1024 + cc * 256 + c];
        const float bb = b3[cc * 256 + c]; float sq = 0.f;
#pragma unroll 1
        for (int tt = th * 32; tt < th * 32 + 32; ++tt) {
            float a = bb;
#pragma unroll
            for (int i = 0; i < 64; ++i) a += h2s[tt * 64 + i] * wr[i];
            a *= __expf(-((float)(t0 + tt) * inv_lm1) * delta);
            stg[c * 65 + tt] = a; sq += a * a;
        }
        if (th == 1) sq2[c] = sq;
        __syncthreads();
        if (th == 0) part[(size_t)tile * 1024 + cc * 256 + c] = sq + sq2[c];
        for (int ch = F.wave * 32; ch < F.wave * 32 + 32; ++ch) hT[((size_t)cc * 256 + ch) * L + t0 + F.lane] = stg[ch * 65 + F.lane];
        __syncthreads();
    }
}

struct TokInfo { unsigned e0, e1, p0, p1; float g0, g1; unsigned s0, s1; };
DI void phase_norm1(const Frame& F, int li, int mode) {
    const int nrows = (mode == 2) ? NLAT : NTOK;
    const float* modp = WSP(float, WS_MOD) + (size_t)li * 3 * 6144;
    const float* modprev = WSP(float, WS_MOD) + (size_t)(mode == 2 ? 1 : li - 1) * 3 * 6144;
    const float* gam = (mode == 2) ? F.in[I_FG] : F.in[I_N1G] + (size_t)li * D;
    const TokInfo* tok = WSP(TokInfo, WS_TOK); const bf16_t* ys = WSP(bf16_t, WS_A1);
    bf16_t* hbf = WSP(bf16_t, WS_HBF);
    for (int r = F.bid * 8 + F.wave; r < nrows; r += F.G * 8) {
        const bool isctx = r >= NLAT; const int v = isctx ? 2 : (r >> 14);
        float* xrow = isctx ? WSP(float, WS_XC) + (size_t)(r - NLAT) * D : F.out + (size_t)r * D;
        const float* src = (mode == 0) ? (isctx ? F.in[I_CTX] + (size_t)(r - NLAT) * D : F.in[I_X] + (size_t)r * D) : xrow;
        f32x4 x[4];
#pragma unroll
        for (int i = 0; i < 4; ++i) x[i] = *(const f32x4*)(src + i * 256 + F.lane * 4);
        if (mode != 0) {
            const TokInfo ti = tok[r];
            const float* g2 = modprev + (size_t)v * 6144 + 5 * 1024;
#pragma unroll
            for (int i = 0; i < 4; ++i) {
                const int c = i * 256 + F.lane * 4;
                const u32x2 a = *(const u32x2*)(ys + (size_t)ti.s0 * D + c), b = *(const u32x2*)(ys + (size_t)ti.s1 * D + c);
                const f32x4 gg = *(const f32x4*)(g2 + c);
                f32x4 y;
                y[0] = ti.g0 * __uint_as_float(a[0] << 16) + ti.g1 * __uint_as_float(b[0] << 16);
                y[1] = ti.g0 * __uint_as_float(a[0] & 0xffff0000u) + ti.g1 * __uint_as_float(b[0] & 0xffff0000u);
                y[2] = ti.g0 * __uint_as_float(a[1] << 16) + ti.g1 * __uint_as_float(b[1] << 16);
                y[3] = ti.g0 * __uint_as_float(a[1] & 0xffff0000u) + ti.g1 * __uint_as_float(b[1] & 0xffff0000u);
                x[i] = x[i] + gg * y;
            }
            if (mode == 1) {
#pragma unroll
                for (int i = 0; i < 4; ++i) *(f32x4*)(xrow + i * 256 + F.lane * 4) = x[i];
            }
        }
        float ss = 0.f;
#pragma unroll
        for (int i = 0; i < 4; ++i) ss += x[i][0] * x[i][0] + x[i][1] * x[i][1] + x[i][2] * x[i][2] + x[i][3] * x[i][3];
        ss = wave_sum(ss);
        const float rstd = rsqrtf(ss * (1.f / D) + EPS);
#pragma unroll
        for (int i = 0; i < 4; ++i) {
            const int c = i * 256 + F.lane * 4;
            const f32x4 g = *(const f32x4*)(gam + c);
            if (mode == 2) { *(f32x4*)(F.out + (size_t)r * D + c) = x[i] * rstd * g; }
            else {
                const f32x4 sh = *(const f32x4*)(modp + (size_t)v * 6144 + c), sc = *(const f32x4*)(modp + (size_t)v * 6144 + 1024 + c);
                const f32x4 h = x[i] * rstd * g * (sc + 1.f) + sh;
                *(u32x2*)(hbf + (size_t)r * D + c) = (u32x2){pk2(h[0], h[1]), pk2(h[2], h[3])};
            }
        }
    }
}

DI void phase_norm2(const Frame& F, int li, int nrows) {
    float* wt = (float*)F.lds;
    __syncthreads();
    for (int i = F.tid; i < 16384; i += NTHR) { const int k = i >> 4, e = i & 15; wt[e * 1024 + k] = F.in[I_RW][i]; }
    __syncthreads();
    const float* modp = WSP(float, WS_MOD) + (size_t)li * 3 * 6144;
    const float* gam = F.in[I_N2G] + (size_t)li * D;
    bf16_t* hbf = WSP(bf16_t, WS_HBF); TokInfo* tok = WSP(TokInfo, WS_TOK);
    unsigned* cnt = F.ctl + CW_CNT + li * 16;
    for (int r = F.bid * 8 + F.wave; r < nrows; r += F.G * 8) {
        const bool isctx = r >= NLAT; const int v = isctx ? 2 : (r >> 14);
        const float* src = isctx ? WSP(float, WS_XC) + (size_t)(r - NLAT) * D : F.out + (size_t)r * D;
        f32x4 x[4]; float ss = 0.f;
#pragma unroll
        for (int i = 0; i < 4; ++i) { x[i] = *(const f32x4*)(src + i * 256 + F.lane * 4); ss += x[i][0] * x[i][0] + x[i][1] * x[i][1] + x[i][2] * x[i][2] + x[i][3] * x[i][3]; }
        ss = wave_sum(ss);
        const float rstd = rsqrtf(ss * (1.f / D) + EPS);
        float lg[16];
#pragma unroll
        for (int e = 0; e < 16; ++e) lg[e] = 0.f;
#pragma unroll
        for (int i = 0; i < 4; ++i) {
            const int c = i * 256 + F.lane * 4;
            const f32x4 g = *(const f32x4*)(gam + c), sh = *(const f32x4*)(modp + (size_t)v * 6144 + 3 * 1024 + c), sc = *(const f32x4*)(modp + (size_t)v * 6144 + 4 * 1024 + c);
            const f32x4 h = x[i] * rstd * g * (sc + 1.f) + sh;
            *(u32x2*)(hbf + (size_t)r * D + c) = (u32x2){pk2(h[0], h[1]), pk2(h[2], h[3])};
#pragma unroll
            for (int e = 0; e < 16; ++e) { const f32x4 w = *(const f32x4*)(wt + e * 1024 + c); lg[e] += h[0] * w[0] + h[1] * w[1] + h[2] * w[2] + h[3] * w[3]; }
        }
#pragma unroll
        for (int e = 0; e < 16; ++e) lg[e] = wave_sum(lg[e]);
        float mx = lg[0];
#pragma unroll
        for (int e = 1; e < 16; ++e) mx = fmaxf(mx, lg[e]);
        float sc[16], sel[16], den = 0.f;
#pragma unroll
        for (int e = 0; e < 16; ++e) { sc[e] = __expf(lg[e] - mx); den += sc[e]; }
        const float rden = 1.f / den;
#pragma unroll
        for (int e = 0; e < 16; ++e) { sc[e] *= rden; sel[e] = sc[e] + F.in[I_RB][e]; }
        int bg = 0; float bgs = -1e30f;
#pragma unroll
        for (int g = 0; g < 4; ++g) {
            float m1 = -1e30f, m2 = -1e30f;
#pragma unroll
            for (int q = 0; q < 4; ++q) { const float s = sel[g * 4 + q]; if (s > m1) { m2 = m1; m1 = s; } else if (s > m2) m2 = s; }
            const float gs = m1 + m2; if (gs > bgs) { bgs = gs; bg = g; }
        }
        int e0 = 0, e1 = 0; float s0v = -1e30f, s1v = -1e30f, w0 = 0.f, w1 = 0.f;
#pragma unroll
        for (int e = 0; e < 16; ++e) {
            const bool ing = (e >> 2) == bg; const float s = sel[e];
            if (ing && s > s0v) { s1v = s0v; e1 = e0; w1 = w0; s0v = s; e0 = e; w0 = sc[e]; }
            else if (ing && s > s1v) { s1v = s; e1 = e; w1 = sc[e]; }
        }
        if (F.lane == 0) {
            TokInfo ti; ti.e0 = e0; ti.e1 = e1; ti.p0 = atomicAdd(cnt + e0, 1u); ti.p1 = atomicAdd(cnt + e1, 1u);
            const float ws = 1.f / (w0 + w1); ti.g0 = w0 * ws; ti.g1 = w1 * ws; ti.s0 = 0; ti.s1 = 0;
            tok[r] = ti;
        }
    }
}

DI void moe_offsets(const Frame& F, int li, int* offs) {
    __syncthreads();
    if (F.tid == 0) { int o = 0; for (int e = 0; e < NE; ++e) { offs[e] = o; offs[17 + e] = o >> 8; const unsigned c = __hip_atomic_load(F.ctl + CW_CNT + li * 16 + e, __ATOMIC_RELAXED, __HIP_MEMORY_SCOPE_AGENT); o += (int)((c + 255u) & ~255u); }
        offs[16] = o; offs[17 + 16] = o >> 8; }
    __syncthreads();
    for (int t = F.tid; t < SLOT_CAP / 256; t += NTHR) { int e = 0; for (int k = 1; k < NE; ++k) e += (offs[17 + k] <= t) ? 1 : 0; offs[40 + t] = e; }
    __syncthreads();
}
DI void phase_gather(const Frame& F, int li, int nrows) {
    int* offs = (int*)(F.lds + LDS_MISC + 64);
    moe_offsets(F, li, offs);
    const bf16_t* hbf = WSP(bf16_t, WS_HBF); bf16_t* a1 = WSP(bf16_t, WS_A1); TokInfo* tok = WSP(TokInfo, WS_TOK);
    for (int r = F.bid * 8 + F.wave; r < nrows; r += F.G * 8) {
        TokInfo ti = tok[r];
        const unsigned s0 = offs[ti.e0] + ti.p0, s1 = offs[ti.e1] + ti.p1;
        const u32x4 a = *(const u32x4*)(hbf + (size_t)r * D + F.lane * 8), b = *(const u32x4*)(hbf + (size_t)r * D + 512 + F.lane * 8);
        *(u32x4*)(a1 + (size_t)s0 * D + F.lane * 8) = a; *(u32x4*)(a1 + (size_t)s0 * D + 512 + F.lane * 8) = b;
        *(u32x4*)(a1 + (size_t)s1 * D + F.lane * 8) = a; *(u32x4*)(a1 + (size_t)s1 * D + 512 + F.lane * 8) = b;
        if (F.lane == 0) { tok[r].s0 = s0; tok[r].s1 = s1; }
    }
}

#define MFMA32(a, b, c) __builtin_amdgcn_mfma_f32_32x32x16_bf16((a), (b), (c), 0, 0, 0)
DI float lam_of(const Frame& F, int li, float& lam_init) {
    const float* lv = F.in[I_ALAM] + (size_t)li * 128;
    const int i = F.lane & 31, hi = F.lane >> 5;
    float d = lv[hi * 64 + i] * lv[hi * 64 + 32 + i];
    d += swz_xor<16>(d); d += swz_xor<8>(d); d += swz_xor<4>(d); d += swz_xor<2>(d); d += swz_xor<1>(d);
    const float d0 = __int_as_float(__builtin_amdgcn_readlane(__float_as_int(d), 0)), d1 = __int_as_float(__builtin_amdgcn_readlane(__float_as_int(d), 32));
    lam_init = 0.8f - 0.6f * __expf(-0.3f * (float)li);
    return __expf(d0) - __expf(d1) + lam_init;
}
DI bf16x8 pack8(const f32x16& x, int s) {
    u32x4 p; p[0] = pk2(x[8 * s], x[8 * s + 1]); p[1] = pk2(x[8 * s + 2], x[8 * s + 3]); p[2] = pk2(x[8 * s + 4], x[8 * s + 5]); p[3] = pk2(x[8 * s + 6], x[8 * s + 7]);
    return __builtin_bit_cast(bf16x8, p);
}

DI void diffattn_unit(const Frame& F, int li, int b, int h, int qt) {
    const int lane = F.lane, r = lane & 31, hh = lane >> 5;
    const bf16_t* AQ = WSP(bf16_t, WS_AQ); const bf16_t* AK = WSP(bf16_t, WS_AK); const bf16_t* AVT = WSP(bf16_t, WS_AVT) + (size_t)(b * 4 + h) * 64 * NKEY;
    unsigned char* Ks = F.lds;
    unsigned char* Vt = F.lds + 16384;
    constexpr int VTB = 64 * 136;
    float lam_init; const float lam = lam_of(F, li, lam_init);
    const int q = qt * 256 + F.wave * 32 + r;
    const size_t qrow = (size_t)b * S + q;
    bf16x8 qf[2][2]; float qn2[2];
#pragma unroll
    for (int c = 0; c < 2; ++c) { qn2[c] = 0.f;
#pragma unroll
        for (int ks = 0; ks < 2; ++ks) { qf[c][ks] = *(const bf16x8*)(AQ + qrow * 256 + h * 64 + c * 32 + ks * 16 + 8 * hh);
#pragma unroll
            for (int j = 0; j < 8; ++j) { const float v = bf2f((bf16_t)qf[c][ks][j]); qn2[c] += v * v; } }
        qn2[c] = half_sum(qn2[c]); }
    const unsigned* kmx = F.ctl + CW_KMAX + li * 16 + (b * 4 + h) * 2;
    f32x16 cinit;
    { float cn = 0.f;
#pragma unroll
      for (int c = 0; c < 2; ++c) { const float km = sqrtf(__uint_as_float(__hip_atomic_load(kmx + c, __ATOMIC_RELAXED, __HIP_MEMORY_SCOPE_AGENT))); cn = fmaxf(cn, sqrtf(qn2[c]) * km); }
      cn = -(cn * 1.02f + 1e-3f);
#pragma unroll
      for (int i = 0; i < 16; ++i) cinit[i] = cn; }
    f32x16 O[2][2];
#pragma unroll
    for (int c = 0; c < 2; ++c)
#pragma unroll
        for (int dh = 0; dh < 2; ++dh)
#pragma unroll
            for (int i = 0; i < 16; ++i) O[c][dh][i] = 0.f;
    float lsum[2] = {0.f, 0.f};
    const int skey = F.tid >> 3, sch = F.tid & 7;
    const int kdst = (sch >> 2) * 4096 + skey * 64 + (((sch & 3) ^ ((skey >> 2) & 3)) * 16);
    const int vd = F.tid >> 3, vkc = F.tid & 7;
    const int vdst = vd * 136 + vkc * 16;
    auto krow_of = [&](int j) -> size_t { return j < CTX ? (size_t)NLAT + b * CTX + j : (size_t)b * S + (j - CTX); };
    u32x4 kreg, vreg;
    kreg = *(const u32x4*)(AK + krow_of(skey) * 256 + h * 64 + sch * 8);
    vreg = *(const u32x4*)(AVT + (size_t)vd * NKEY + vkc * 8);
    __syncthreads();
    *(u32x4*)(Ks + kdst) = kreg;
    *(u32x2*)(Vt + vdst) = (u32x2){vreg[0], vreg[1]}; *(u32x2*)(Vt + vdst + 8) = (u32x2){vreg[2], vreg[3]};
    __syncthreads();
    constexpr int NT = NKEY / 64;
    for (int kt = 0; kt < NT; ++kt) {
        const int buf = kt & 1;
        if (kt + 1 < NT) {
            const int j0 = (kt + 1) * 64;
            kreg = *(const u32x4*)(AK + krow_of(j0 + skey) * 256 + h * 64 + sch * 8);
            vreg = *(const u32x4*)(AVT + (size_t)vd * NKEY + j0 + vkc * 8);
        }
        const unsigned char* kb = Ks + buf * 8192; const unsigned char* vb = Vt + buf * VTB;
#pragma unroll 1
        for (int st = 0; st < 2; ++st) {
            const int key = 32 * st + r;
            bf16x8 pb[2][2];
#pragma unroll
            for (int c = 0; c < 2; ++c) {
                const bf16x8 k0 = *(const bf16x8*)(kb + c * 4096 + key * 64 + (((0 + hh) ^ ((key >> 2) & 3)) * 16));
                const bf16x8 k1 = *(const bf16x8*)(kb + c * 4096 + key * 64 + (((2 + hh) ^ ((key >> 2) & 3)) * 16));
                f32x16 s = MFMA32(k0, qf[c][0], cinit);
                s = MFMA32(k1, qf[c][1], s);
#pragma unroll
                for (int i = 0; i < 16; ++i) { s[i] = __builtin_amdgcn_exp2f(s[i]); lsum[c] += s[i]; }
                pb[c][0] = pack8(s, 0); pb[c][1] = pack8(s, 1);
            }
#pragma unroll
            for (int dh = 0; dh < 2; ++dh)
#pragma unroll
                for (int s = 0; s < 2; ++s) {
                    const unsigned char* vp = vb + (32 * dh + r) * 136 + (32 * st + 16 * s + 4 * hh) * 2;
                    const s16x4 lo = *(const s16x4*)vp, hi = *(const s16x4*)(vp + 16);
                    const bf16x8 vf = __builtin_shufflevector(lo, hi, 0, 1, 2, 3, 4, 5, 6, 7);
                    O[0][dh] = MFMA32(vf, pb[0][s], O[0][dh]);
                    O[1][dh] = MFMA32(vf, pb[1][s], O[1][dh]);
                }
        }
        if (kt + 1 < NT) {
            unsigned char* kw = Ks + (buf ^ 1) * 8192; unsigned char* vw = Vt + (buf ^ 1) * VTB;
            *(u32x4*)(kw + kdst) = kreg;
            *(u32x2*)(vw + vdst) = (u32x2){vreg[0], vreg[1]}; *(u32x2*)(vw + vdst + 8) = (u32x2){vreg[2], vreg[3]};
        }
        __syncthreads();
    }
    const float l0 = half_sum(lsum[0]), l1 = half_sum(lsum[1]);
    const float r0 = 1.f / l0, r1 = lam / l1;
    float o[2][16]; float ss = 0.f;
#pragma unroll
    for (int dh = 0; dh < 2; ++dh)
#pragma unroll
        for (int i = 0; i < 16; ++i) { o[dh][i] = O[0][dh][i] * r0 - O[1][dh][i] * r1; ss += o[dh][i] * o[dh][i]; }
    ss = half_sum(ss);
    const float rs = rsqrtf(ss * (1.f / 64.f) + EPS) * (1.f - lam_init);
    const float* sg = F.in[I_ASUB] + li * 64;
    bf16_t* mix = WSP(bf16_t, WS_HBF) + qrow * D + h * 64;
#pragma unroll
    for (int dh = 0; dh < 2; ++dh)
#pragma unroll
        for (int g = 0; g < 4; ++g) {
            const int d = 32 * dh + 8 * g + 4 * hh;
            const f32x4 gg = *(const f32x4*)(sg + d);
            *(u32x2*)(mix + d) = (u32x2){pk2(o[dh][4 * g] * rs * gg[0], o[dh][4 * g + 1] * rs * gg[1]), pk2(o[dh][4 * g + 2] * rs * gg[2], o[dh][4 * g + 3] * rs * gg[3])};
        }
}

DI void ctx_attn_a_unit(const Frame& F, int li, int u) {
    const int idx = u * NTHR + F.tid, cr = idx >> 2, h = idx & 3, b = cr >> 8;
    const bf16_t* AQ = WSP(bf16_t, WS_AQ) + (size_t)(NLAT + cr) * 256 + h * 64;
    const bf16_t* AK = WSP(bf16_t, WS_AK) + (size_t)(NLAT + b * CTX) * 256 + h * 64;
    const bf16_t* AVT = WSP(bf16_t, WS_AVT) + (size_t)(b * 4 + h) * 64 * NKEY;
    float lam_init; const float lam = lam_of(F, li, lam_init);
    float o[64];
#pragma unroll
    for (int i = 0; i < 64; ++i) o[i] = 0.f;
#pragma unroll 1
    for (int c = 0; c < 2; ++c) {
        float q[32];
#pragma unroll
        for (int i = 0; i < 32; ++i) q[i] = bf2f(AQ[c * 32 + i]);
        float m = -1e30f, l = 0.f, acc[64];
#pragma unroll
        for (int i = 0; i < 64; ++i) acc[i] = 0.f;
#pragma unroll 1
        for (int j = 0; j < CTX; ++j) {
            float s = 0.f;
#pragma unroll
            for (int i = 0; i < 32; ++i) s += q[i] * bf2f(AK[(size_t)j * 256 + c * 32 + i]);
            const float mn = fmaxf(m, s), al = __builtin_amdgcn_exp2f(m - mn), p = __builtin_amdgcn_exp2f(s - mn);
            l = l * al + p; m = mn;
#pragma unroll
            for (int i = 0; i < 64; ++i) acc[i] = acc[i] * al + p * bf2f(AVT[(size_t)i * NKEY + j]);
        }
        const float sc = (c == 0) ? 1.f / l : -lam / l;
#pragma unroll
        for (int i = 0; i < 64; ++i) o[i] += acc[i] * sc;
    }
    float ss = 0.f;
#pragma unroll
    for (int i = 0; i < 64; ++i) ss += o[i] * o[i];
    const float rs = rsqrtf(ss * (1.f / 64.f) + EPS) * (1.f - lam_init);
    bf16_t* mix = WSP(bf16_t, WS_HBF) + (size_t)(NLAT + cr) * D + h * 64;
#pragma unroll
    for (int i = 0; i < 64; ++i) mix[i] = f2bf(o[i] * rs * F.in[I_ASUB][li * 64 + i]);
}
DI void ctx_attn_b_unit(const Frame& F, int u) {
    const int idx = u * NTHR + F.tid, cr = idx >> 2, h = idx & 3, b = cr >> 8;
    const bf16_t* BQ = WSP(bf16_t, WS_BQ) + (size_t)(NLAT + cr) * 256 + h * 64;
    const bf16_t* BK = WSP(bf16_t, WS_BK) + (size_t)(NLAT + b * CTX) * 256 + h * 64;
    const bf16_t* BV = WSP(bf16_t, WS_BV) + (size_t)(NLAT + b * CTX) * 256 + h * 64;
    float q[64], acc[64];
#pragma unroll
    for (int i = 0; i < 64; ++i) { q[i] = bf2f(BQ[i]); acc[i] = 0.f; }
    float m = -1e30f, l = 0.f;
    for (int j = 0; j < CTX; ++j) {
        float s = 0.f;
#pragma unroll
        for (int i = 0; i < 64; ++i) s += q[i] * bf2f(BK[(size_t)j * 256 + i]);
        const float mn = fmaxf(m, s), al = __builtin_amdgcn_exp2f(m - mn), p = __builtin_amdgcn_exp2f(s - mn);
        l = l * al + p; m = mn;
#pragma unroll
        for (int i = 0; i < 64; ++i) acc[i] = acc[i] * al + p * bf2f(BV[(size_t)j * 256 + i]);
    }
    const float rl = 1.f / l;
    bf16_t* mix = WSP(bf16_t, WS_HBF) + (size_t)(NLAT + cr) * D + 256 + h * 64;
#pragma unroll
    for (int i = 0; i < 64; ++i) mix[i] = f2bf(acc[i] * rl);
}

DI void na_unit(const Frame& F, int li, int u) {
    const int b = u >> 7, rp = u & 127;
    const int qi = F.tid >> 2, h = F.tid & 3;
    const int row = rp * 2 + (qi >> 6), col = qi & 63, t = row * GW + col;
    const bf16_t* BQ = WSP(bf16_t, WS_BQ) + ((size_t)b * S + t) * 256 + h * 64;
    const bf16_t* BKl = WSP(bf16_t, WS_BK) + (size_t)b * S * 256 + h * 64;
    const bf16_t* BVl = WSP(bf16_t, WS_BV) + (size_t)b * S * 256 + h * 64;
    const bf16_t* BKc = WSP(bf16_t, WS_BK) + (size_t)(NLAT + b * CTX) * 256 + h * 64;
    const bf16_t* BVc = WSP(bf16_t, WS_BV) + (size_t)(NLAT + b * CTX) * 256 + h * 64;
    const float* rpb = F.in[I_RPB] + ((size_t)li * 4 + h) * 15 * 31;
    float q[64], acc[64];
#pragma unroll
    for (int i = 0; i < 64; ++i) { q[i] = bf2f(BQ[i]); acc[i] = 0.f; }
    float m = -1e30f, l = 0.f;
    int r0 = row - 4; r0 = r0 < 0 ? 0 : (r0 > 248 ? 248 : r0);
    int c0 = col - 8; c0 = c0 < 0 ? 0 : (c0 > 48 ? 48 : c0);
    for (int j = 0; j < 128 + CTX; ++j) {
        const bf16_t *kp, *vp; float bias = 0.f;
        if (j < 128) { const int kr = r0 + (j >> 4), kc = c0 + (j & 15); kp = BKl + (size_t)(kr * GW + kc) * 256; vp = BVl + (size_t)(kr * GW + kc) * 256;
            bias = rpb[(kr - row + 7) * 31 + (kc - col + 15)] * LOG2E; }
        else { kp = BKc + (size_t)(j - 128) * 256; vp = BVc + (size_t)(j - 128) * 256; }
        float s = bias;
#pragma unroll
        for (int i8 = 0; i8 < 8; ++i8) { const u32x4 kk = *(const u32x4*)(kp + i8 * 8);
#pragma unroll
            for (int e = 0; e < 4; ++e) { s += q[i8 * 8 + 2 * e] * __uint_as_float(kk[e] << 16) + q[i8 * 8 + 2 * e + 1] * __uint_as_float(kk[e] & 0xffff0000u); } }
        const float mn = fmaxf(m, s), al = __builtin_amdgcn_exp2f(m - mn), p = __builtin_amdgcn_exp2f(s - mn);
        l = l * al + p; m = mn;
#pragma unroll
        for (int i8 = 0; i8 < 8; ++i8) { const u32x4 vv = *(const u32x4*)(vp + i8 * 8);
#pragma unroll
            for (int e = 0; e < 4; ++e) { acc[i8 * 8 + 2 * e] = acc[i8 * 8 + 2 * e] * al + p * __uint_as_float(vv[e] << 16); acc[i8 * 8 + 2 * e + 1] = acc[i8 * 8 + 2 * e + 1] * al + p * __uint_as_float(vv[e] & 0xffff0000u); } }
    }
    const float rl = 1.f / l;
    bf16_t* mix = WSP(bf16_t, WS_HBF) + ((size_t)b * S + t) * D + 256 + h * 64;
#pragma unroll
    for (int i8 = 0; i8 < 8; ++i8) *(u32x4*)(mix + i8 * 8) = (u32x4){pk2(acc[i8 * 8] * rl, acc[i8 * 8 + 1] * rl), pk2(acc[i8 * 8 + 2] * rl, acc[i8 * 8 + 3] * rl), pk2(acc[i8 * 8 + 4] * rl, acc[i8 * 8 + 5] * rl), pk2(acc[i8 * 8 + 6] * rl, acc[i8 * 8 + 7] * rl)};
}

DI void pool_unit(const Frame& F, int li, size_t seq_row0, int L, int t0) {
    float* us = (float*)F.lds;
    float* df = us + 48 * 256;
    const bf16_t* PL = WSP(bf16_t, WS_PL);
    __syncthreads();
    for (int i = F.tid; i < 48 * 32; i += NTHR) {
        const int tt = i >> 5, c8 = i & 31, t = t0 - 8 + tt;
        float v[8] = {0.f, 0.f, 0.f, 0.f, 0.f, 0.f, 0.f, 0.f};
        if (t >= 0 && t < L) { const u32x4 x = *(const u32x4*)(PL + (seq_row0 + t) * 256 + c8 * 8);
#pragma unroll
            for (int e = 0; e < 4; ++e) { v[2 * e] = __uint_as_float(x[e] << 16); v[2 * e + 1] = __uint_as_float(x[e] & 0xffff0000u); } }
#pragma unroll
        for (int e = 0; e < 8; ++e) us[tt * 256 + c8 * 8 + e] = v[e];
    }
    __syncthreads();
    for (int i = F.tid; i < 32 * 256; i += NTHR) {
        const int tl = i >> 8, ch = i & 255, g = ch >> 6, t = t0 + tl; const int hw = 1 << g;
        int lo = t - hw; lo = lo < 0 ? 0 : lo; int hi = t + hw; hi = hi > L ? L : hi;
        float s = 0.f;
        for (int tt = lo; tt < hi; ++tt) s += us[(tt - t0 + 8) * 256 + ch];
        df[tl * 256 + ch] = s / (float)(hi - lo) - us[(tl + 8) * 256 + ch];
    }
    __syncthreads();
    const float* pw = F.in[I_POOLW] + (size_t)li * 4 * 64 * 64; const float* ps = F.in[I_POOLS] + li * 256;
    bf16_t* mix = WSP(bf16_t, WS_HBF);
    {
        const int ch = F.tid & 255, th = F.tid >> 8, g = ch >> 6, j = ch & 63;
        float w[64];
#pragma unroll
        for (int i = 0; i < 64; ++i) w[i] = pw[((size_t)g * 64 + i) * 64 + j];
        const float scale = ps[ch];
        for (int tl = th * 16; tl < th * 16 + 16; ++tl) {
            float a = 0.f;
#pragma unroll
            for (int i = 0; i < 64; ++i) a += df[tl * 256 + g * 64 + i] * w[i];
            mix[(seq_row0 + t0 + tl) * D + 512 + ch] = f2bf(a * scale);
        }
    }
}

DI float hy_norm(const float* part, int ntile, int o, int ch) {
    float s = 0.f;
    for (int t = 0; t < ntile; ++t) s += part[(size_t)t * 1024 + (o * 2) * 256 + ch] + part[(size_t)t * 1024 + (o * 2 + 1) * 256 + ch];
    return rsqrtf(s + EPS);
}
DI float hy_short(const bf16_t* p, int t, int L, float w0, float w1, float w2, float bb) {
    const float a = t > 0 ? bf2f(p[t - 1]) : 0.f, c = t + 1 < L ? bf2f(p[t + 1]) : 0.f;
    return a * w0 + bf2f(p[t]) * w1 + c * w2 + bb;
}
DI void hy_conv(const float* vb, const float* hf, const float* hb, int t0, float (&acc)[2][16]) {
#pragma unroll
    for (int b = 0; b < 2; ++b)
#pragma unroll
        for (int i = 0; i < 16; ++i) acc[b][i] = 0.f;
#pragma unroll 1
    for (int s0 = 0; s0 < S; s0 += 16) {
        float kw[31];
#pragma unroll
        for (int i = 0; i < 31; ++i) { const int dl = t0 - s0 - 15 + i; const float* p = dl >= 0 ? hf : hb; kw[i] = p[dl >= 0 ? dl : -dl]; }
#pragma unroll
        for (int j4 = 0; j4 < 4; ++j4) {
            const f32x4 va = *(const f32x4*)(vb + s0 + 4 * j4), vc = *(const f32x4*)(vb + S + s0 + 4 * j4);
#pragma unroll
            for (int e = 0; e < 4; ++e) { const int jj = 4 * j4 + e;
#pragma unroll
                for (int ii = 0; ii < 16; ++ii) { acc[0][ii] += kw[ii - jj + 15] * va[e]; acc[1][ii] += kw[ii - jj + 15] * vc[e]; } }
        }
    }
}
DI void hyena_unit(const Frame& F, int li, int ch) {
    float* vb = (float*)F.lds;
    const bf16_t* HYT = WSP(bf16_t, WS_HYT); const float* filt = WSP(float, WS_FILT); float* zb = WSP(float, WS_ZBUF) + (size_t)ch * 2 * S;
    const float* sw = F.in[I_HYSW] + (size_t)li * 3 * 768; const float* sb = F.in[I_HYSB] + li * 768; const float* sk = F.in[I_HSKIP] + li * 512;
    const float n0 = hy_norm(WSP(float, WS_FPART), 256, 0, ch), n1 = hy_norm(WSP(float, WS_FPART), 256, 1, ch);
    __syncthreads();
    for (int i = F.tid; i < 2 * S; i += NTHR) { const int b = i >> 14, t = i & (S - 1); const int c = 512 + ch;
        vb[i] = hy_short(HYT + ((size_t)b * 768 + c) * S, t, S, sw[c], sw[768 + c], sw[1536 + c], sb[c]); }
    __syncthreads();
    float acc[2][16];
#pragma unroll 1
    for (int half = 0; half < 2; ++half) {
        const int t0 = F.tid * 32 + half * 16;
        hy_conv(vb, filt + ((size_t)0 * 256 + ch) * S, filt + ((size_t)1 * 256 + ch) * S, t0, acc);
#pragma unroll
        for (int b = 0; b < 2; ++b)
#pragma unroll
            for (int i = 0; i < 16; ++i) { const int t = t0 + i;
                const float x1 = hy_short(HYT + ((size_t)b * 768 + ch) * S, t, S, sw[ch], sw[768 + ch], sw[1536 + ch], sb[ch]);
                zb[b * S + t] = x1 * (acc[b][i] * n0 + sk[ch] * vb[b * S + t]); }
    }
    __syncthreads();
    for (int i = F.tid; i < 2 * S; i += NTHR) vb[i] = zb[i];
    __syncthreads();
    bf16_t* mix = WSP(bf16_t, WS_HBF);
#pragma unroll 1
    for (int half = 0; half < 2; ++half) {
        const int t0 = F.tid * 32 + half * 16;
        hy_conv(vb, filt + ((size_t)2 * 256 + ch) * S, filt + ((size_t)3 * 256 + ch) * S, t0, acc);
#pragma unroll
        for (int b = 0; b < 2; ++b)
#pragma unroll
            for (int i = 0; i < 16; ++i) { const int t = t0 + i; const int c = 256 + ch;
                const float x2 = hy_short(HYT + ((size_t)b * 768 + c) * S, t, S, sw[c], sw[768 + c], sw[1536 + c], sb[c]);
                mix[((size_t)b * S + t) * D + 768 + ch] = f2bf(x2 * (acc[b][i] * n1 + sk[256 + ch] * vb[b * S + t])); }
    }
}
constexpr int FM = 16384;
DI int fphys(int i) { return i + (i >> 4) + ((i >> 9) << 4); }
constexpr int brev(int m, int bits) { return bits == 5 ? (((m & 1) << 4) | ((m & 2) << 2) | (m & 4) | ((m & 8) >> 2) | ((m & 16) >> 4)) : (((m & 1) << 3) | ((m & 2) << 1) | ((m & 4) >> 1) | ((m & 8) >> 3)); }
template <int R, int LOG2R, bool INV> DI void dft_regs(float (&re)[R], float (&im)[R]) {
    constexpr float C32[16] = {1.f, 0.98078528040323043f, 0.92387953251128674f, 0.83146961230254524f, 0.70710678118654752f, 0.55557023301960218f, 0.38268343236508977f, 0.19509032201612825f,
                               0.f, -0.19509032201612825f, -0.38268343236508977f, -0.55557023301960218f, -0.70710678118654752f, -0.83146961230254524f, -0.92387953251128674f, -0.98078528040323043f};
    constexpr float S32[16] = {0.f, 0.19509032201612825f, 0.38268343236508977f, 0.55557023301960218f, 0.70710678118654752f, 0.83146961230254524f, 0.92387953251128674f, 0.98078528040323043f,
                               1.f, 0.98078528040323043f, 0.92387953251128674f, 0.83146961230254524f, 0.70710678118654752f, 0.55557023301960218f, 0.38268343236508977f, 0.19509032201612825f};
#pragma unroll
    for (int st = 0; st < LOG2R; ++st) {
        const int h = R >> (st + 1);
#pragma unroll
        for (int i = 0; i < R; i += 2 * h) {
#pragma unroll
            for (int j = 0; j < h; ++j) {
                const float xr = re[i + j], xi = im[i + j], yr = re[i + j + h], yi = im[i + j + h];
                re[i + j] = xr + yr; im[i + j] = xi + yi;
                const float dr = xr - yr, di = xi - yi;
                const int k = j * (16 / h);
                if (k == 0) { re[i + j + h] = dr; im[i + j + h] = di; }
                else if (k == 8) { re[i + j + h] = INV ? -di : di; im[i + j + h] = INV ? dr : -dr; }
                else { const float c = C32[k], sn = INV ? S32[k] : -S32[k]; re[i + j + h] = dr * c - di * sn; im[i + j + h] = dr * sn + di * c; }
            }
        }
    }
}
template <bool INV, int SP> DI void fft_pass32(f32x2* X, int bp, int rem, float inv_bs) {
    asm volatile("" : "+v"(bp), "+v"(rem));
    f32x2* P = X + bp;
    float re[32], im[32];
    if (!INV) {
#pragma unroll
        for (int q = 0; q < 32; ++q) { const f32x2 v = P[q * SP]; re[q] = v[0]; im[q] = v[1]; }
        dft_regs<32, 5, false>(re, im);
#pragma unroll
        for (int m = 0; m < 32; ++m) { const int qp = brev(m, 5);
            float r = re[m], i = im[m];
            if (qp != 0) { const float rev = (float)(rem * qp) * inv_bs; const float c = __builtin_amdgcn_cosf(rev), sn = -__builtin_amdgcn_sinf(rev); const float t = r * c - i * sn; i = r * sn + i * c; r = t; }
            P[qp * SP] = (f32x2){r, i}; }
    } else {
#pragma unroll
        for (int qp = 0; qp < 32; ++qp) { const f32x2 v = P[qp * SP]; float r = v[0], i = v[1];
            if (qp != 0) { const float rev = (float)(rem * qp) * inv_bs; const float c = __builtin_amdgcn_cosf(rev), sn = __builtin_amdgcn_sinf(rev); const float t = r * c - i * sn; i = r * sn + i * c; r = t; }
            re[qp] = r; im[qp] = i; }
        dft_regs<32, 5, true>(re, im);
#pragma unroll
        for (int m = 0; m < 32; ++m) P[brev(m, 5) * SP] = (f32x2){re[m], im[m]};
    }
}
DI void fft_fwd12(f32x2* X, int tid) {
    __syncthreads(); fft_pass32<false, 560>(X, fphys(tid), tid, 1.f / 16384.f);
    __syncthreads(); fft_pass32<false, 17>(X, (tid >> 4) * 560 + (tid & 15), tid & 15, 1.f / 512.f);
    __syncthreads();
}
DI void fft_inv21(f32x2* X, int tid) {
    __syncthreads(); fft_pass32<true, 17>(X, (tid >> 4) * 560 + (tid & 15), tid & 15, 1.f / 512.f);
    __syncthreads(); fft_pass32<true, 560>(X, fphys(tid), tid, 1.f / 16384.f);
    __syncthreads();
}
DI void hyena_fft_unit(const Frame& F, int li, int ch) {
    f32x2* X = (f32x2*)F.lds;
    const bf16_t* HYT = WSP(bf16_t, WS_HYT); const float* filt = WSP(float, WS_FILT);
    f32x2* Ye = WSP(f32x2, WS_ZBUF) + (size_t)ch * FM; f32x2* Z1 = WSP(f32x2, WS_Z1BUF) + (size_t)ch * FM;
    const float* sw = F.in[I_HYSW] + (size_t)li * 3 * 768; const float* sb = F.in[I_HYSB] + li * 768; const float* sk = F.in[I_HSKIP] + li * 512;
    const int tid = F.tid;
    const bf16_t* px1[2] = {HYT + ((size_t)0 * 768 + ch) * S, HYT + ((size_t)1 * 768 + ch) * S};
    const bf16_t* px2[2] = {HYT + ((size_t)0 * 768 + 256 + ch) * S, HYT + ((size_t)1 * 768 + 256 + ch) * S};
    const bf16_t* pv[2] = {HYT + ((size_t)0 * 768 + 512 + ch) * S, HYT + ((size_t)1 * 768 + 512 + ch) * S};
    const float wx1[4] = {sw[ch], sw[768 + ch], sw[1536 + ch], sb[ch]};
    const float wx2[4] = {sw[256 + ch], sw[768 + 256 + ch], sw[1536 + 256 + ch], sb[256 + ch]};
    const float wv[4] = {sw[512 + ch], sw[768 + 512 + ch], sw[1536 + 512 + ch], sb[512 + ch]};
#pragma unroll 1
    for (int cv = 0; cv < 2; ++cv) {
        const float* hf = filt + ((size_t)(2 * cv) * 256 + ch) * S; const float* hb = filt + ((size_t)(2 * cv + 1) * 256 + ch) * S;
        const float fnrm = hy_norm(WSP(float, WS_FPART), 256, cv, ch); const float nrm = 1.f / 32768.f;
        const float skip = sk[cv * 256 + ch];
#pragma unroll 1
        for (int half = 0; half < 2; ++half) {
            __syncthreads();
            int pb = fphys(tid); int tq = tid; asm volatile("" : "+v"(pb), "+v"(tq));
#pragma unroll 2
            for (int j = 0; j < 32; ++j) { const int n = tq + 512 * j; const float a = hf[n] * fnrm, bq = n ? hb[FM - n] * fnrm : 0.f;
                f32x2 v;
                if (half == 0) v = (f32x2){a + bq, 0.f};
                else { const float d = a - bq, rev = (float)n * (1.f / 32768.f); v = (f32x2){d * __builtin_amdgcn_cosf(rev), -d * __builtin_amdgcn_sinf(rev)}; }
                X[pb + 560 * j] = v; }
            fft_fwd12(X, tid);
            h16x2 kpk[2][16];
#pragma unroll
            for (int g = 0; g < 2; ++g) { int b16 = fphys((tid + 512 * g) * 16); asm volatile("" : "+v"(b16));
                float kre[16], kim[16];
#pragma unroll
                for (int q = 0; q < 16; ++q) { const f32x2 v = X[b16 + q]; kre[q] = v[0]; kim[q] = v[1]; }
                dft_regs<16, 4, false>(kre, kim);
#pragma unroll
                for (int q = 0; q < 16; ++q) kpk[g][q] = (h16x2){(_Float16)kre[q], (_Float16)kim[q]}; }
            __syncthreads();
            asm volatile("" : "+v"(pb), "+v"(tq));
#pragma unroll 2
            for (int j = 0; j < 32; ++j) { const int n = tq + 512 * j; f32x2 v;
                if (cv == 0) v = (f32x2){hy_short(pv[0], n, S, wv[0], wv[1], wv[2], wv[3]), hy_short(pv[1], n, S, wv[0], wv[1], wv[2], wv[3])};
                else v = Z1[n];
                if (half == 1) { const float rev = (float)n * (1.f / 32768.f); const float c = __builtin_amdgcn_cosf(rev), sn = -__builtin_amdgcn_sinf(rev); v = (f32x2){v[0] * c - v[1] * sn, v[0] * sn + v[1] * c}; }
                X[pb + 560 * j] = v; }
            fft_fwd12(X, tid);
#pragma unroll
            for (int g = 0; g < 2; ++g) { int b16 = fphys((tid + 512 * g) * 16); asm volatile("" : "+v"(b16));
                float re[16], im[16];
#pragma unroll
                for (int q = 0; q < 16; ++q) { const f32x2 v = X[b16 + q]; re[q] = v[0]; im[q] = v[1]; }
                dft_regs<16, 4, false>(re, im);
                float br[16], bi[16];
#pragma unroll
                for (int m = 0; m < 16; ++m) { const int qp = brev(m, 4); const float kr = (float)kpk[g][m][0], ki = (float)kpk[g][m][1]; br[qp] = re[m] * kr - im[m] * ki; bi[qp] = re[m] * ki + im[m] * kr; }
                dft_regs<16, 4, true>(br, bi);
#pragma unroll
                for (int m = 0; m < 16; ++m) X[b16 + brev(m, 4)] = (f32x2){br[m], bi[m]};
            }
            fft_inv21(X, tid);
            asm volatile("" : "+v"(pb), "+v"(tq));
            if (half == 0) {
#pragma unroll 2
                for (int j = 0; j < 32; ++j) { const int n = tq + 512 * j; Ye[n] = X[pb + 560 * j]; }
            } else {
#pragma unroll 1
                for (int j = 0; j < 32; ++j) { const int n = tq + 512 * j;
                    const f32x2 yo = X[pb + 560 * j], ye = Ye[n];
                    const float rev = (float)n * (1.f / 32768.f); const float c = __builtin_amdgcn_cosf(rev), sn = __builtin_amdgcn_sinf(rev);
                    const float y0 = (ye[0] + yo[0] * c - yo[1] * sn) * nrm, y1 = (ye[1] + yo[0] * sn + yo[1] * c) * nrm;
                    if (cv == 0) {
                        const float v0 = hy_short(pv[0], n, S, wv[0], wv[1], wv[2], wv[3]), v1 = hy_short(pv[1], n, S, wv[0], wv[1], wv[2], wv[3]);
                        const float a0 = hy_short(px1[0], n, S, wx1[0], wx1[1], wx1[2], wx1[3]), a1 = hy_short(px1[1], n, S, wx1[0], wx1[1], wx1[2], wx1[3]);
                        Z1[n] = (f32x2){a0 * (y0 + skip * v0), a1 * (y1 + skip * v1)};
                    } else {
                        const f32x2 z1 = Z1[n];
                        const float a0 = hy_short(px2[0], n, S, wx2[0], wx2[1], wx2[2], wx2[3]), a1 = hy_short(px2[1], n, S, wx2[0], wx2[1], wx2[2], wx2[3]);
                        bf16_t* mix = WSP(bf16_t, WS_HBF);
                        mix[((size_t)n) * D + 768 + ch] = f2bf(a0 * (y0 + skip * z1[0]));
                        mix[((size_t)S + n) * D + 768 + ch] = f2bf(a1 * (y1 + skip * z1[1]));
                    }
                }
            }
        }
    }
}
DI void hyena_ctx_unit(const Frame& F, int li, int ch) {
    float* vs = (float*)F.lds;
    float* zs = vs + 512;
    float* fl = zs + 512;
    const bf16_t* HYC = WSP(bf16_t, WS_HYC); const float* filt = WSP(float, WS_FILTC);
    const float* sw = F.in[I_HYSW] + (size_t)li * 3 * 768; const float* sb = F.in[I_HYSB] + li * 768; const float* sk = F.in[I_HSKIP] + li * 512;
    const float n0 = hy_norm(WSP(float, WS_FPARTC), 4, 0, ch), n1 = hy_norm(WSP(float, WS_FPARTC), 4, 1, ch);
    const int b = F.tid >> 8, t = F.tid & 255;
    auto sc = [&](int c) -> float { const bf16_t* p = HYC + (size_t)(b * CTX) * 768 + c;
        const float a = t > 0 ? bf2f(p[(size_t)(t - 1) * 768]) : 0.f, d = t + 1 < CTX ? bf2f(p[(size_t)(t + 1) * 768]) : 0.f;
        return a * sw[c] + bf2f(p[(size_t)t * 768]) * sw[768 + c] + d * sw[1536 + c] + sb[c]; };
    __syncthreads();
    const float x1 = sc(ch), x2 = sc(256 + ch), v = sc(512 + ch);
    vs[F.tid] = v;
    for (int i = F.tid; i < 1024; i += NTHR) fl[i] = filt[((size_t)(i >> 8) * 256 + ch) * CTX + (i & 255)];
    __syncthreads();
    float a = 0.f;
    for (int s = 0; s < CTX; ++s) { const int dl = t - s; a += (dl >= 0 ? fl[dl] : fl[256 - dl]) * vs[b * 256 + s]; }
    const float z = x1 * (a * n0 + sk[ch] * v);
    zs[F.tid] = z;
    __syncthreads();
    a = 0.f;
    for (int s = 0; s < CTX; ++s) { const int dl = t - s; a += (dl >= 0 ? fl[512 + dl] : fl[768 - dl]) * zs[b * 256 + s]; }
    WSP(bf16_t, WS_HBF)[((size_t)NLAT + b * CTX + t) * D + 768 + ch] = f2bf(x2 * (a * n1 + sk[256 + ch] * z));
}

DI void phase_mix(const Frame& F0, int li) {
    const Frame& F = F0;
    unsigned* head = F.ctl + CW_QHEAD + li * 64;
    volatile unsigned* qs = (volatile unsigned*)(F.lds + LDS_MISC + 32);
    const int n_hy = 256, n_da = 512, n_na = 256, n_pl = 1024;
    const int n_ctx = (li == 0) ? (4 + 4 + 16 + 256) : 0;
    const int total = n_hy + n_da + n_na + n_pl + n_ctx;
    for (;;) {
        __syncthreads();
        if (F.tid == 0) qs[0] = __hip_atomic_fetch_add(head, 1u, __ATOMIC_RELAXED, __HIP_MEMORY_SCOPE_AGENT);
        __syncthreads();
        int u = __builtin_amdgcn_readfirstlane((int)qs[0]);
        if (u >= total) break;
        Frame F = F0; refresh(F);
        if (u < n_hy) {
#ifndef SKIP_HY
#ifdef NAIVE_HY
 hyena_unit(F, li, u);
#else
 hyena_fft_unit(F, li, u);
#endif
#endif
 continue; }
        u -= n_hy;
        if (u < n_da) {
#ifndef SKIP_DA
 diffattn_unit(F, li, u >> 8, (u >> 6) & 3, u & 63);
#endif
 continue; }
        u -= n_da;
        if (u < n_na) {
#ifndef SKIP_NA
 na_unit(F, li, u);
#endif
 continue; }
        u -= n_na;
        if (u < n_pl) {
#ifndef SKIP_PL
 pool_unit(F, li, (size_t)(u >> 9) * S, S, (u & 511) * 32);
#endif
 continue; }
        u -= n_pl;
        if (u < 4) {
#ifndef SKIP_CA
 ctx_attn_a_unit(F, li, u);
#endif
 continue; }
        u -= 4;
        if (u < 4) {
#ifndef SKIP_CB
 ctx_attn_b_unit(F, u);
#endif
 continue; }
        u -= 4;
        if (u < 16) {
#ifndef SKIP_PL
 pool_unit(F, li, (size_t)NLAT + (u >> 3) * CTX, CTX, (u & 7) * 32);
#endif
 continue; }
        u -= 16;
#ifndef SKIP_HC
        hyena_ctx_unit(F, li, u);
#endif
    }
}

constexpr int PH_PER_LAYER = 8, NPH = 2 + 2 * PH_PER_LAYER;
__global__ void __launch_bounds__(NTHR, 2) mega(Args args) {
    extern __shared__ __attribute__((aligned(16))) unsigned char smem[];
    Frame F;
    F.in = args.in; F.out = args.out; F.ws = args.ws; F.ctl = (unsigned*)(args.ws + WS_CTL); F.lds = smem;
    F.tid = threadIdx.x; F.lane = F.tid & 63; F.wave = __builtin_amdgcn_readfirstlane(F.tid >> 6); F.G = gridDim.x; F.bid = blockIdx.x;
    if (F.tid < 64) ((unsigned*)(smem + LDS_MISC))[F.tid] = 0u;
    __syncthreads();
    const int lo = args.ph_lo, hi = args.ph_hi;
    const bool fused = (hi - lo) > 1;
    XcdBarrier bar; bar.bar = F.ctl; bar.x = 0; bar.st = (volatile LAS unsigned*)(smem + LDS_MISC);
    if (fused) bar = xcd_barrier_post(F.ctl, (volatile LAS unsigned*)(smem + LDS_MISC));
#define IN(k) (lo <= (k) && (k) < hi)
#define SEAM(k) do { if (IN(k) && IN((k) + 1)) xcd_barrier(bar); } while (0)
#ifndef SKIP_P0
    if (IN(0)) { refresh(F); phase_prologue(F); }
#endif
    SEAM(0);
    for (int li = 0; li < 2; ++li) {
        const int p0 = 1 + li * PH_PER_LAYER;
        const int nrows = (li == 0) ? NTOK : NLAT;
        if (IN(p0)) {
            refresh(F);
            phase_norm1(F, li, li == 0 ? 0 : 1);
            refresh(F);
#ifndef SKIP_FILT
            for (int t = F.bid; t < 256; t += F.G) filter_tile(F, li, S, t, WSP(float, WS_FILT), WSP(float, WS_FPART));
            if (li == 0) for (int t = F.bid; t < 4; t += F.G) filter_tile(F, li, CTX, t, WSP(float, WS_FILTC), WSP(float, WS_FPARTC));
#endif
        }
        SEAM(p0);
        if (IN(p0 + 1)) {
            refresh(F);
            pg8::Gemm g{WSP(bf16_t, WS_HBF), WSP(bf16_t, WS_WIN) + (size_t)li * DIN * D, D, 0};
            pg8::StaticOrder So; So.init(NTOK, DIN, F.G, F.bid);
            EpiIn E{F.ws, WSP(float, WS_ROPE), F.ctl + CW_KMAX + li * 16};
#ifndef SKIP_G1
            pg8::gemm_phase<EpiIn, pg8::StaticOrder>((LAS unsigned char*)smem, g, So, E, F.tid);
#endif
        }
        SEAM(p0 + 1);
        if (IN(p0 + 2)) { refresh(F); phase_mix(F, li); }
        SEAM(p0 + 2);
        if (IN(p0 + 3)) {
            refresh(F);
            pg8::Gemm g{WSP(bf16_t, WS_HBF), WSP(bf16_t, WS_WOUT) + (size_t)li * D * D, D, 0};
            pg8::StaticOrder So; So.init(nrows, D, F.G, F.bid);
            EpiOut E{li == 0 ? F.in[I_X] : F.out, li == 0 ? F.in[I_CTX] : WSP(float, WS_XC), F.out, WSP(float, WS_XC), WSP(float, WS_MOD) + (size_t)li * 3 * 6144};
#ifndef SKIP_G2
            pg8::gemm_phase<EpiOut, pg8::StaticOrder>((LAS unsigned char*)smem, g, So, E, F.tid);
#endif
        }
        SEAM(p0 + 3);
#ifndef SKIP_N2
        if (IN(p0 + 4)) { refresh(F); phase_norm2(F, li, nrows); }
#endif
        SEAM(p0 + 4);
        if (IN(p0 + 5)) { refresh(F); phase_gather(F, li, nrows); }
        SEAM(p0 + 5);
        if (IN(p0 + 6)) {
            refresh(F);
            int* offs = (int*)(smem + LDS_MISC + 64);
            moe_offsets(F, li, offs);
            pg8::Gemm g{WSP(bf16_t, WS_A1), WSP(bf16_t, WS_W13) + (size_t)li * NE * 1024 * 1024, D, (size_t)1024 * 1024};
            pg8::MoeOrder Mo{offs + 40, offs[17 + 16], 4, F.G, F.bid};
            EpiMoe1 E{WSP(bf16_t, WS_HMID)};
#ifndef SKIP_G3
            pg8::gemm_phase<EpiMoe1, pg8::MoeOrder>((LAS unsigned char*)smem, g, Mo, E, F.tid);
#endif
        }
        SEAM(p0 + 6);
        if (IN(p0 + 7)) {
            refresh(F);
            int* offs = (int*)(smem + LDS_MISC + 64);
            moe_offsets(F, li, offs);
            pg8::Gemm g{WSP(bf16_t, WS_HMID), WSP(bf16_t, WS_W2) + (size_t)li * NE * 1024 * 512, DE, (size_t)1024 * 512};
            pg8::MoeOrder Mo{offs + 40, offs[17 + 16], 4, F.G, F.bid};
            EpiMoe2 E{WSP(bf16_t, WS_A1)};
#ifndef SKIP_G4
            pg8::gemm_phase<EpiMoe2, pg8::MoeOrder>((LAS unsigned char*)smem, g, Mo, E, F.tid);
#endif
        }
        SEAM(p0 + 7);
    }
    if (IN(NPH - 1)) { refresh(F); phase_norm1(F, 1, 2); }
#undef IN
#undef SEAM
}

extern "C" void kernel_launch(void* const* d_in, const int* in_sizes, int n_in, void* d_out, int out_size, void* d_ws, size_t ws_size, hipStream_t stream) {
    static int grid = 0;
    if (grid == 0) {
        if (n_in != N_IN || out_size != NLAT * D || ws_size < WS_END) { fprintf(stderr, "kernel_launch: unexpected shapes (n_in %d out %d ws %zu need %zu)\n", n_in, out_size, ws_size, (size_t)WS_END); grid = -1; return; }
        int dev = 0, cus = 0, per_cu = 0;
        if (hipGetDevice(&dev) != hipSuccess || hipDeviceGetAttribute(&cus, hipDeviceAttributeMultiprocessorCount, dev) != hipSuccess) { grid = -1; return; }
        if (hipFuncSetAttribute((const void*)mega, hipFuncAttributeMaxDynamicSharedMemorySize, LDS_BYTES) != hipSuccess) { fprintf(stderr, "kernel_launch: hipFuncSetAttribute failed\n"); grid = -1; return; }
        if (hipOccupancyMaxActiveBlocksPerMultiprocessor(&per_cu, (const void*)mega, NTHR, LDS_BYTES) != hipSuccess || per_cu < 1) { fprintf(stderr, "kernel_launch: occupancy query says %d\n", per_cu); }
        (void)hipGetLastError();
        grid = cus;
    }
    if (grid < 0) return;
    (void)hipMemsetAsync((char*)d_ws + WS_CTL, 0, CTL_BYTES, stream);
    Args a{};
    for (int i = 0; i < N_IN; ++i) a.in[i] = (const float*)d_in[i];
    a.out = (float*)d_out; a.ws = (unsigned char*)d_ws;
#if N_LAUNCH_MODE == 1
    a.ph_lo = 0; a.ph_hi = NPH;
    hipLaunchKernelGGL(mega, dim3(grid), dim3(NTHR), LDS_BYTES, stream, a);
#else
    for (int p = 0; p < NPH; ++p) { a.ph_lo = p; a.ph_hi = p + 1; hipLaunchKernelGGL(mega, dim3(grid), dim3(NTHR), LDS_BYTES, stream, a); }
#endif
}
#ifdef TEST_UNITS
__global__ void __launch_bounds__(NTHR, 2) t_da(Args args) {
    extern __shared__ __attribute__((aligned(16))) unsigned char smem[];
    Frame F; F.in = args.in; F.out = args.out; F.ws = args.ws; F.ctl = (unsigned*)(args.ws + WS_CTL); F.lds = smem; F.G = gridDim.x; F.bid = blockIdx.x; refresh(F);
    diffattn_unit(F, args.ph_lo, blockIdx.x >> 8, (blockIdx.x >> 6) & 3, blockIdx.x & 63);
}
__global__ void __launch_bounds__(NTHR, 2) t_hy(Args args) {
    extern __shared__ __attribute__((aligned(16))) unsigned char smem[];
    Frame F; F.in = args.in; F.out = args.out; F.ws = args.ws; F.ctl = (unsigned*)(args.ws + WS_CTL); F.lds = smem; F.G = gridDim.x; F.bid = blockIdx.x; refresh(F);
    hyena_fft_unit(F, args.ph_lo, blockIdx.x);
}
#endif
```

```cpp
#include <hip/hip_runtime.h>
#include <stdint.h>
#include <stdio.h>

#ifndef N_LAUNCH_MODE
#define N_LAUNCH_MODE 1
#endif

#define DI __device__ __forceinline__
#define LAS __attribute__((address_space(3)))
typedef unsigned short bf16_t;
typedef short bf16x8 __attribute__((ext_vector_type(8)));
typedef short s16x4 __attribute__((ext_vector_type(4)));
typedef float f32x4 __attribute__((ext_vector_type(4)));
typedef float f32x2 __attribute__((ext_vector_type(2)));
typedef float f32x16 __attribute__((ext_vector_type(16)));
typedef unsigned u32x4 __attribute__((ext_vector_type(4)));
typedef unsigned u32x2 __attribute__((ext_vector_type(2)));
typedef _Float16 h16x2 __attribute__((ext_vector_type(2)));

constexpr int D = 1024, NB = 2, S = 16384, CTX = 256, NLAT = NB * S, NCTX = NB * CTX, NTOK = NLAT + NCTX, DIN = 2560;
constexpr int NE = 16, DE = 512, GW = 64;
constexpr int NKEY = CTX + S;
constexpr int NTHR = 512;
constexpr int SLOT_CAP = 70656;
constexpr float EPS = 1e-6f;
constexpr float LOG2E = 1.4426950408889634f;
constexpr float QSCALE_A = 0.17677669529663687f * LOG2E;
constexpr float QSCALE_B = 0.125f * LOG2E;

enum { I_X = 0, I_C, I_CTX, I_CCTX, I_N1G, I_N2G, I_ADAW, I_ADAB, I_WIN, I_WOUT, I_ALAM, I_ASUB, I_RPB, I_POOLW, I_POOLS, I_HYSW, I_HYSB,
       I_HW1, I_HB1, I_HW2, I_HB2, I_HW3, I_HB3, I_HSKIP, I_RW, I_RB, I_MW1, I_MW3, I_MW2, I_FG, N_IN };

struct Args { const float* in[N_IN]; float* out; unsigned char* ws; int ph_lo, ph_hi; };

constexpr size_t al256(size_t x) { return (x + 255) & ~(size_t)255; }
constexpr size_t WS_CTL = 0, CTL_BYTES = 65536;
constexpr size_t WS_MOD = WS_CTL + CTL_BYTES;
constexpr size_t WS_ROPE = WS_MOD + al256(2 * 3 * 6144 * 4);
constexpr size_t WS_FPART = WS_ROPE + 16384;
constexpr size_t WS_FPARTC = WS_FPART + 256 * 1024 * 4;
constexpr size_t WS_XC = WS_FPARTC + 4 * 1024 * 4;
constexpr size_t WS_WIN = WS_XC + (size_t)NCTX * D * 4;
constexpr size_t WS_WOUT = WS_WIN + (size_t)2 * DIN * D * 2;
constexpr size_t WS_W13 = WS_WOUT + (size_t)2 * D * D * 2;
constexpr size_t WS_W2 = WS_W13 + (size_t)2 * NE * 1024 * 1024 * 2;
constexpr size_t WS_FILT = WS_W2 + (size_t)2 * NE * 1024 * 512 * 2;
constexpr size_t WS_FILTC = WS_FILT + (size_t)4 * 256 * S * 4;
constexpr size_t WS_ZBUF = WS_FILTC + (size_t)4 * 256 * 256 * 4;
constexpr size_t WS_R1 = WS_ZBUF + (size_t)256 * 2 * S * 4;
constexpr size_t WS_HBF = WS_R1;
constexpr size_t TOKB = (size_t)NTOK * 256 * 2;
constexpr size_t WS_AQ = WS_HBF + (size_t)NTOK * D * 2;
constexpr size_t WS_AK = WS_AQ + TOKB;
constexpr size_t WS_AVT = WS_AK + TOKB;
constexpr size_t WS_BQ = WS_AVT + (size_t)NB * 4 * 64 * NKEY * 2;
constexpr size_t WS_BK = WS_BQ + TOKB;
constexpr size_t WS_BV = WS_BK + TOKB;
constexpr size_t WS_PL = WS_BV + TOKB;
constexpr size_t WS_HYT = WS_PL + TOKB;
constexpr size_t WS_HYC = WS_HYT + (size_t)NB * 768 * S * 2;
constexpr size_t WS_Z1BUF = WS_HYC + (size_t)NCTX * 768 * 2;
constexpr size_t WS_END_MIX = WS_Z1BUF + (size_t)256 * S * 8;
constexpr size_t WS_TOK = WS_AQ;
constexpr size_t WS_A1 = WS_TOK + al256((size_t)NTOK * 32);
constexpr size_t WS_HMID = WS_A1 + (size_t)SLOT_CAP * D * 2;
constexpr size_t WS_END_MOE = WS_HMID + (size_t)SLOT_CAP * DE * 2;
constexpr size_t WS_END = WS_END_MIX > WS_END_MOE ? WS_END_MIX : WS_END_MOE;

#define XB_TMO      128
#define XB_XCNT(j)  (256  + 64 * (j))
#define XB_XSUB(j)  (1280 + 64 * (j))
#define XB_XGEN(j)  (2304 + 64 * (j))
#define XB_TOP      3328
#define XB_TOPGEN   3392
#define XCD_BAR_WORDS 3456
#define XB_SPIN_CAP (1u << 18)
constexpr int CW_CNT = 4096;
constexpr int CW_KMAX = 4160;
constexpr int CW_QHEAD = 4224;
constexpr int CW_BCNT = 4352;
constexpr int MAXG = 256;

constexpr int LDS_MAIN = 143360, LDS_MISC = LDS_MAIN, LDS_BYTES = LDS_MAIN + 2048;

DI float bf2f(bf16_t v) { return __uint_as_float(((unsigned)v) << 16); }
DI bf16_t f2bf(float f) { unsigned u = __float_as_uint(f); u += 0x7FFFu + ((u >> 16) & 1u); return (bf16_t)(u >> 16); }
DI unsigned pk2(float lo, float hi) { unsigned r; asm volatile("v_cvt_pk_bf16_f32 %0, %1, %2" : "=v"(r) : "v"(lo), "v"(hi)); return r; }
template <int K> DI float swz_xor(float v) { return __int_as_float(__builtin_amdgcn_ds_swizzle(__float_as_int(v), (K << 10) | 0x1F)); }
DI float half_sum(float v) { const auto r = __builtin_amdgcn_permlane32_swap(__float_as_uint(v), __float_as_uint(v), false, false); return __uint_as_float(r[0]) + __uint_as_float(r[1]); }
DI float half_max(float v) { const auto r = __builtin_amdgcn_permlane32_swap(__float_as_uint(v), __float_as_uint(v), false, false); return fmaxf(__uint_as_float(r[0]), __uint_as_float(r[1])); }
DI float wave_sum(float v) { v += swz_xor<16>(v); v += swz_xor<8>(v); v += swz_xor<4>(v); v += swz_xor<2>(v); v += swz_xor<1>(v); return half_sum(v); }
DI float wave_max(float v) { v = fmaxf(v, swz_xor<16>(v)); v = fmaxf(v, swz_xor<8>(v)); v = fmaxf(v, swz_xor<4>(v)); v = fmaxf(v, swz_xor<2>(v)); v = fmaxf(v, swz_xor<1>(v)); return half_max(v); }
DI float siluf(float x) { return x / (1.f + __expf(-x)); }
DI float sin_rev(float rev) { return __builtin_amdgcn_sinf(rev - floorf(rev)); }
DI float cos_rev(float rev) { return __builtin_amdgcn_cosf(rev - floorf(rev)); }
DI float sin_rad(float x) { return sin_rev(x * 0.15915494309189535f); }

DI unsigned xb_ld(unsigned* p)              { return __hip_atomic_load(p, __ATOMIC_RELAXED, __HIP_MEMORY_SCOPE_AGENT); }
DI unsigned xb_add(unsigned* p, unsigned v) { return __hip_atomic_fetch_add(p, v, __ATOMIC_RELAXED, __HIP_MEMORY_SCOPE_AGENT); }
DI unsigned xb_xcc_id() { return (unsigned)__builtin_amdgcn_s_getreg((3 << 11) | 20) & 0xFu; }
#define XB_SPIN(cond, bar) do { unsigned _sp = 0; while (cond) { __builtin_amdgcn_s_sleep(1); \
    if ((++_sp & 255u) == 0u) { if (xb_ld(&(bar)[XB_TMO])) break; if (_sp > XB_SPIN_CAP) { atomicAdd(&(bar)[XB_TMO], 1u); break; } } } } while (0)
struct XcdBarrier { unsigned* bar; unsigned x; volatile LAS unsigned* st; };
DI XcdBarrier xcd_barrier_post(unsigned* bar, volatile LAS unsigned* st) {
    XcdBarrier b; b.bar = bar; b.x = xb_xcc_id(); b.st = st;
    if (threadIdx.x == 0) (void)xb_add(&bar[XB_XCNT(b.x)], 1u);
    return b;
}
DI void xcd_barrier_complete(unsigned* bar, unsigned x, unsigned& nloc, unsigned& nx) {
    const unsigned G = gridDim.x * gridDim.y * gridDim.z;
    unsigned sum, cnt, mine, sp = 0u;
    for (;;) {
        sum = 0u; cnt = 0u; mine = 0u;
#pragma unroll
        for (unsigned j = 0; j < 16; ++j) { const unsigned c = xb_ld(&bar[XB_XCNT(j)]); sum += c; cnt += (c > 0u) ? 1u : 0u; mine = (j == x) ? c : mine; }
        if (sum == G) break;
        __builtin_amdgcn_s_sleep(1);
        if ((++sp & 255u) == 0u) { if (xb_ld(&bar[XB_TMO])) break; if (sp > XB_SPIN_CAP) { atomicAdd(&bar[XB_TMO], 1u); break; } }
    }
    nloc = mine > 0u ? mine : 1u; nx = cnt > 0u ? cnt : 1u;
}
DI void xcd_barrier(const XcdBarrier& b) {
    asm volatile("s_waitcnt vmcnt(0)" ::: "memory");
    __syncthreads();
    if (threadIdx.x == 0) {
        unsigned* bar = b.bar;
        __builtin_amdgcn_s_waitcnt(0);
        unsigned nloc = b.st[0], nx = b.st[1];
        if (nloc == 0u) { xcd_barrier_complete(bar, b.x, nloc, nx); b.st[0] = nloc; b.st[1] = nx; }
        const unsigned old = xb_add(&bar[XB_XSUB(b.x)], 1u);
        const unsigned gen = old / nloc;
        if (old + 1u == (gen + 1u) * nloc) {
            __builtin_amdgcn_fence(__ATOMIC_RELEASE, "agent");
            asm volatile("s_waitcnt vmcnt(0)" ::: "memory");
            const unsigned og = xb_add(&bar[XB_TOP], 1u);
            const unsigned tg = og / nx;
            if (og + 1u == (tg + 1u) * nx) xb_add(&bar[XB_TOPGEN], 1u);
            else XB_SPIN(xb_ld(&bar[XB_TOPGEN]) == tg, bar);
            __builtin_amdgcn_fence(__ATOMIC_ACQUIRE, "agent");
            xb_add(&bar[XB_XGEN(b.x)], 1u);
            asm volatile("s_waitcnt vmcnt(0)" ::: "memory");
        } else {
            XB_SPIN(xb_ld(&bar[XB_XGEN(b.x)]) == gen, bar);
            __builtin_amdgcn_fence(__ATOMIC_ACQUIRE, "agent");
            asm volatile("s_waitcnt vmcnt(0)" ::: "memory");
        }
    }
    __syncthreads();
}

struct Frame {
    const float* const* in; float* out; unsigned char* ws; unsigned* ctl;
    unsigned char* lds;
    int tid, lane, wave, G, bid;
};
#define WSP(T, off) ((T*)(F.ws + (off)))
DI void refresh(Frame& F) { int t = threadIdx.x; asm volatile("" : "+v"(t)); F.tid = t; F.lane = t & 63; F.wave = __builtin_amdgcn_readfirstlane(t >> 6);
}

namespace pg8 {
constexpr int BM = 256, BK = 64, HALF = 128, HTB = HALF * BK * 2, STAGE_BYTES = 8 * HTB, NXCD = 8, WGM = 8;
DI int lds_byte(int r, int c) { const int st = (r >> 4) * 2 + (c >> 5), rr = r & 15, cc = c & 31, ob = rr * 64 + cc * 2; return st * 1024 + (ob ^ (((ob >> 9) & 1) << 5)); }
DI void stage_rc(int b, int& R, int& C) { const int st = b / 1024, sb = b % 1024, swz = sb ^ (((sb >> 9) & 1) << 5); R = (st >> 1) * 16 + swz / 64; C = (st & 1) * 32 + (swz % 64) / 2; }
struct Unit { int pm, pn, e; };
struct Gemm { const bf16_t* A; const bf16_t* Bt; int K; size_t bstride; };
struct StaticOrder {
    int nM, nN, nwg, G, c;
    DI void init(int M, int N, int G_, int c_) { nM = M / BM; nN = N / BM; nwg = nM * nN; G = G_; c = c_; }
    DI bool next(int i, Unit& u) const {
        const long L = (long)i * G + c; if (L >= nwg) return false;
        int wgid = (int)L; { const int q = nwg / NXCD, r = nwg % NXCD, xcd = wgid % NXCD, off = wgid / NXCD; wgid = (xcd < r ? xcd * (q + 1) : r * (q + 1) + (xcd - r) * q) + off; }
        const int nig = WGM * nN, gid = wgid / nig, fm = gid * WGM, gsz = (nM - fm) < WGM ? (nM - fm) : WGM;
        u.pm = fm + ((wgid % nig) % gsz); u.pn = (wgid % nig) / gsz; u.e = 0; return true;
    }
};
struct MoeOrder {
    const int* toff; int ntile, nN, G, c;
    DI bool next(int i, Unit& u) const {
        const long L = (long)i * G + c; if (L >= (long)ntile * nN) return false;
        const int t = (int)(L / nN); u.pm = t; u.pn = (int)(L % nN);
        u.e = toff[t]; return true;
    }
};

template <class Epi, class Sched>
DI void gemm_phase(LAS unsigned char* lds, const Gemm g, const Sched& S, const Epi& E, int tid) {
    const int wid = __builtin_amdgcn_readfirstlane(tid >> 6), lane = tid & 63, wr = wid >> 2, wc = wid & 3, fr = lane & 15, fq = lane >> 4;
    const int K = g.K, nt = K / BK;
    unsigned voffA[2];
#pragma unroll
    for (int i = 0; i < 2; ++i) { int R, C; stage_rc(tid * 16 + i * 8192, R, C); voffA[i] = (unsigned)(R * K + C) * 2u; }
    const size_t kstep = (size_t)(BK * 2);
    const size_t hstep = (size_t)HALF * K * 2;
    const size_t tstep = 2 * hstep;
    const unsigned ldsw = (unsigned)wid * 1024u;
    const int aoff = lds_byte(wr * 64 + fr, fq * 8), boff = lds_byte(wc * 32 + fr, fq * 8);
#define PG8_SA(b, h) (((b) * 2 + (h)) * HTB)
#define PG8_SB(b, h) ((4 + (b) * 2 + (h)) * HTB)
#define PG8_STAGE(bufoff, gbase, voff) do { _Pragma("unroll") for (int _i = 0; _i < 2; ++_i) \
        __builtin_amdgcn_global_load_lds((const unsigned*)((const char*)(gbase) + (voff)[_i]), (LAS unsigned*)(lds + (bufoff) + ldsw + _i * 8192), 16, 0, 0); } while (0)
#define PG8_LDA(dst, b, h) do { _Pragma("unroll") for (int m = 0; m < 4; ++m) _Pragma("unroll") for (int k = 0; k < 2; ++k) dst[m][k] = *(const LAS bf16x8*)(lds + PG8_SA(b, h) + aoff + m * 2048 + k * 1024); } while (0)
#define PG8_LDB(dst, b, h) do { _Pragma("unroll") for (int n = 0; n < 2; ++n) _Pragma("unroll") for (int k = 0; k < 2; ++k) dst[n][k] = *(const LAS bf16x8*)(lds + PG8_SB(b, h) + boff + n * 2048 + k * 1024); } while (0)
#define PG8_MMA(ai, bj, At, Bt) do { __builtin_amdgcn_s_setprio(1); _Pragma("unroll") for (int m = 0; m < 4; ++m) _Pragma("unroll") for (int n = 0; n < 2; ++n) _Pragma("unroll") for (int k = 0; k < 2; ++k) \
        acc[ai][bj][m][n] = __builtin_amdgcn_mfma_f32_16x16x32_bf16(Bt[n][k], At[m][k], acc[ai][bj][m][n], 0, 0, 0); __builtin_amdgcn_s_setprio(0); } while (0)
#define PG8_WAIT_V(n) asm volatile("s_waitcnt vmcnt(" #n ")" ::: "memory")
#define PG8_WAIT_L(n) asm volatile("s_waitcnt lgkmcnt(" #n ")" ::: "memory")
#define PG8_BAR __builtin_amdgcn_s_barrier()
#define PG8_SCHED __builtin_amdgcn_sched_barrier(0)
    Unit cur, nxt; int ui = 0;
    if (!S.next(0, cur)) return;
    f32x4 acc[2][2][4][2];
#pragma unroll
    for (int a = 0; a < 2; ++a)
#pragma unroll
        for (int b = 0; b < 2; ++b)
#pragma unroll
            for (int m = 0; m < 4; ++m)
#pragma unroll
                for (int n = 0; n < 2; ++n) acc[a][b][m][n] = (f32x4){0.f, 0.f, 0.f, 0.f};
    bf16x8 At[4][2], B0[2][2], B1[2][2];
    const char* cA = (const char*)g.A + (size_t)cur.pm * tstep; const char* cB = (const char*)(g.Bt + (size_t)cur.e * g.bstride) + (size_t)cur.pn * tstep;
    PG8_STAGE(PG8_SB(0, 0), cB, voffA); PG8_STAGE(PG8_SA(0, 0), cA, voffA); PG8_STAGE(PG8_SB(0, 1), cB + hstep, voffA); PG8_STAGE(PG8_SA(0, 1), cA + hstep, voffA);
    if (wr == 1) PG8_BAR;
    PG8_WAIT_V(4); PG8_BAR;
    PG8_STAGE(PG8_SB(1, 0), cB + kstep, voffA); PG8_STAGE(PG8_SA(1, 0), cA + kstep, voffA); PG8_STAGE(PG8_SB(1, 1), cB + hstep + kstep, voffA);
    PG8_WAIT_V(6); PG8_BAR;
    for (;;) {
        const bool has_next = S.next(ui + 1, nxt);
        const char* nA = has_next ? (const char*)g.A + (size_t)nxt.pm * tstep : cA; const char* nB = has_next ? (const char*)(g.Bt + (size_t)nxt.e * g.bstride) + (size_t)nxt.pn * tstep : cB;
        for (int t = 0; t < nt; t += 2) {
            const bool last = (t == nt - 2);
            const char* a1 = cA + (size_t)(t + 1) * kstep;
            const char* a2 = last ? nA : cA + (size_t)(t + 2) * kstep; const char* b2 = last ? nB : cB + (size_t)(t + 2) * kstep;
            const char* a3 = a2 + kstep; const char* b3 = b2 + kstep;
            PG8_LDB(B0, 0, 0); PG8_SCHED; PG8_LDA(At, 0, 0); PG8_STAGE(PG8_SA(1, 1), a1 + hstep, voffA);
            PG8_WAIT_L(8); PG8_BAR; PG8_WAIT_L(0); PG8_MMA(0, 0, At, B0); PG8_BAR; PG8_SCHED;
            PG8_LDB(B1, 0, 1); PG8_STAGE(PG8_SB(0, 0), b2, voffA);
            PG8_BAR; PG8_WAIT_L(0); PG8_MMA(0, 1, At, B1); PG8_BAR;
            PG8_LDA(At, 0, 1); PG8_STAGE(PG8_SA(0, 0), a2, voffA);
            PG8_BAR; PG8_WAIT_L(0); PG8_MMA(1, 0, At, B0); PG8_BAR; PG8_SCHED;
            PG8_STAGE(PG8_SB(0, 1), b2 + hstep, voffA);
            PG8_WAIT_V(6); PG8_BAR; PG8_MMA(1, 1, At, B1); PG8_BAR;
            PG8_LDB(B0, 1, 0); PG8_SCHED; PG8_LDA(At, 1, 0); PG8_STAGE(PG8_SA(0, 1), a2 + hstep, voffA);
            PG8_WAIT_L(8); PG8_BAR; PG8_WAIT_L(0); PG8_MMA(0, 0, At, B0); PG8_BAR; PG8_SCHED;
            PG8_LDB(B1, 1, 1); PG8_STAGE(PG8_SB(1, 0), b3, voffA);
            PG8_BAR; PG8_WAIT_L(0); PG8_MMA(0, 1, At, B1); PG8_BAR;
            PG8_LDA(At, 1, 1); PG8_STAGE(PG8_SA(1, 0), a3, voffA);
            PG8_BAR; PG8_WAIT_L(0); PG8_MMA(1, 0, At, B0); PG8_BAR; PG8_SCHED;
            PG8_STAGE(PG8_SB(1, 1), b3 + hstep, voffA);
            PG8_WAIT_V(6); PG8_BAR; PG8_MMA(1, 1, At, B1); PG8_BAR;
        }
        E(acc, cur, wr, wc, fr, fq);
        if (!has_next) break;
#pragma unroll
        for (int a = 0; a < 2; ++a)
#pragma unroll
            for (int b = 0; b < 2; ++b)
#pragma unroll
                for (int m = 0; m < 4; ++m)
#pragma unroll
                    for (int n = 0; n < 2; ++n) acc[a][b][m][n] = (f32x4){0.f, 0.f, 0.f, 0.f};
        cur = nxt; cA = nA; cB = nB; ++ui;
    }
    PG8_WAIT_V(0);
    if (wr == 0) PG8_BAR;
    PG8_BAR;
#undef PG8_SA
#undef PG8_SB
#undef PG8_STAGE
#undef PG8_LDA
#undef PG8_LDB
#undef PG8_MMA
#undef PG8_WAIT_V
#undef PG8_WAIT_L
#undef PG8_BAR
#undef PG8_SCHED
}
}

typedef f32x4 AccT[2][2][4][2];

struct EpiIn {
    unsigned char* ws; const float* rope; unsigned* kmax;
    DI void operator()(const AccT& acc, const pg8::Unit& u, int wr, int wc, int fr, int fq) const {
        const int pn = u.pn, row0 = u.pm * 256 + wr * 64 + fr;
        const bool isctx = (u.pm >= NLAT / 256);
        if (pn <= 1) {
            bf16_t* dst = (bf16_t*)(ws + (pn == 0 ? WS_AQ : WS_AK));
            const float sc = (pn == 0) ? QSCALE_A : 1.f;
            float nmax[2] = {0.f, 0.f};
#pragma unroll
            for (int ai = 0; ai < 2; ++ai)
#pragma unroll
                for (int m = 0; m < 4; ++m) {
                    const int r = row0 + ai * 128 + m * 16;
                    f32x4 cs0 = (f32x4){1.f, 0.f, 1.f, 0.f}, cs1 = cs0;
                    if (!isctx) { const int t = r & (S - 1); const int pos = (fq < 2) ? (t >> 6) : (t & 63);
                        const f32x4* tp = (const f32x4*)(rope + (size_t)pos * 16 + (fq & 1) * 8); cs0 = tp[0]; cs1 = tp[1]; }
                    const float cc[4] = {cs0[0], cs0[2], cs1[0], cs1[2]}, ss[4] = {cs0[1], cs0[3], cs1[1], cs1[3]};
#pragma unroll
                    for (int bj = 0; bj < 2; ++bj) {
                        const f32x4 x1 = acc[ai][bj][m][0], x2 = acc[ai][bj][m][1];
                        float o1[4], o2[4], n2 = 0.f;
#pragma unroll
                        for (int j = 0; j < 4; ++j) { o1[j] = (x1[j] * cc[j] - x2[j] * ss[j]) * sc; o2[j] = (x2[j] * cc[j] + x1[j] * ss[j]) * sc; n2 += x1[j] * x1[j] + x2[j] * x2[j]; }
                        bf16_t* p = dst + (size_t)r * 256 + bj * 128 + wc * 32 + 4 * fq;
                        *(u32x2*)p = (u32x2){pk2(o1[0], o1[1]), pk2(o1[2], o1[3])};
                        *(u32x2*)(p + 16) = (u32x2){pk2(o2[0], o2[1]), pk2(o2[2], o2[3])};
                        if (pn == 1) { n2 += swz_xor<16>(n2); n2 = half_sum(n2); nmax[bj] = fmaxf(nmax[bj], n2); }
                    }
                }
            if (pn == 1) {
                const int b = isctx ? (u.pm - NLAT / 256) : (u.pm / (S / 256));
#pragma unroll
                for (int bj = 0; bj < 2; ++bj) {
                    float v = nmax[bj];
                    v = fmaxf(v, swz_xor<1>(v)); v = fmaxf(v, swz_xor<2>(v)); v = fmaxf(v, swz_xor<4>(v)); v = fmaxf(v, swz_xor<8>(v));
                    if ((fr | fq) == 0) atomicMax(kmax + (b * 4 + (2 * bj + (wc >> 1))) * 2 + (wc & 1), __float_as_uint(v));
                }
            }
        } else if (pn == 2) {
            bf16_t* dst = (bf16_t*)(ws + WS_AVT);
#pragma unroll
            for (int ai = 0; ai < 2; ++ai)
#pragma unroll
                for (int m = 0; m < 4; ++m) {
                    const int r = row0 + ai * 128 + m * 16;
                    int b, key; if (isctx) { b = (r - NLAT) >> 8; key = (r - NLAT) & 255; } else { b = r >> 14; key = CTX + (r & (S - 1)); }
#pragma unroll
                    for (int bj = 0; bj < 2; ++bj)
#pragma unroll
                        for (int n = 0; n < 2; ++n) {
                            const int lc = bj * 128 + wc * 32 + n * 16 + 4 * fq;
#pragma unroll
                            for (int j = 0; j < 4; ++j) dst[((size_t)(b * 256 + lc + j)) * NKEY + key] = f2bf(acc[ai][bj][m][n][j]);
                        }
                }
        } else if (pn <= 6) {
            bf16_t* dst = (bf16_t*)(ws + (pn == 3 ? WS_BQ : pn == 4 ? WS_BK : pn == 5 ? WS_BV : WS_PL));
            const float sc = (pn == 3) ? QSCALE_B : 1.f;
#pragma unroll
            for (int ai = 0; ai < 2; ++ai)
#pragma unroll
                for (int m = 0; m < 4; ++m) {
                    const int r = row0 + ai * 128 + m * 16;
#pragma unroll
                    for (int bj = 0; bj < 2; ++bj)
#pragma unroll
                        for (int n = 0; n < 2; ++n) {
                            const f32x4 v = acc[ai][bj][m][n] * sc;
                            *(u32x2*)(dst + (size_t)r * 256 + bj * 128 + wc * 32 + n * 16 + 4 * fq) = (u32x2){pk2(v[0], v[1]), pk2(v[2], v[3])};
                        }
                }
        } else {
            const int hc0 = (pn - 7) * 256;
#pragma unroll
            for (int ai = 0; ai < 2; ++ai)
#pragma unroll
                for (int m = 0; m < 4; ++m) {
                    const int r = row0 + ai * 128 + m * 16;
#pragma unroll
                    for (int bj = 0; bj < 2; ++bj)
#pragma unroll
                        for (int n = 0; n < 2; ++n) {
                            const int hc = hc0 + bj * 128 + wc * 32 + n * 16 + 4 * fq; const f32x4 v = acc[ai][bj][m][n];
                            if (isctx) *(u32x2*)((bf16_t*)(ws + WS_HYC) + (size_t)(r - NLAT) * 768 + hc) = (u32x2){pk2(v[0], v[1]), pk2(v[2], v[3])};
                            else { bf16_t* dst = (bf16_t*)(ws + WS_HYT) + ((size_t)(r >> 14) * 768 + hc) * S + (r & (S - 1));
#pragma unroll
                                for (int j = 0; j < 4; ++j) dst[(size_t)j * S] = f2bf(v[j]); }
                        }
                }
        }
    }
};

struct EpiOut {
    const float* xl_old; const float* xc_old; float* xl_new; float* xc_new; const float* mod;
    DI void operator()(const AccT& acc, const pg8::Unit& u, int wr, int wc, int fr, int fq) const {
        const int row0 = u.pm * 256 + wr * 64 + fr; const bool isctx = (u.pm >= NLAT / 256);
        const int v = isctx ? 2 : (u.pm / (S / 256));
        const float* g1 = mod + (size_t)v * 6144 + 2 * 1024;
        const float* so = isctx ? xc_old - (size_t)NLAT * D : xl_old; float* dn = isctx ? xc_new - (size_t)NLAT * D : xl_new;
#pragma unroll
        for (int bj = 0; bj < 2; ++bj)
#pragma unroll
            for (int n = 0; n < 2; ++n) {
                const int c = u.pn * 256 + bj * 128 + wc * 32 + n * 16 + 4 * fq;
                const f32x4 g = *(const f32x4*)(g1 + c);
#pragma unroll
                for (int ai = 0; ai < 2; ++ai)
#pragma unroll
                    for (int m = 0; m < 4; ++m) {
                        const size_t o = (size_t)(row0 + ai * 128 + m * 16) * D + c;
                        *(f32x4*)(dn + o) = *(const f32x4*)(so + o) + g * acc[ai][bj][m][n];
                    }
            }
    }
};

struct EpiMoe1 {
    bf16_t* hmid;
    DI void operator()(const AccT& acc, const pg8::Unit& u, int wr, int wc, int fr, int fq) const {
        const int row0 = u.pm * 256 + wr * 64 + fr;
#pragma unroll
        for (int ai = 0; ai < 2; ++ai)
#pragma unroll
            for (int m = 0; m < 4; ++m)
#pragma unroll
                for (int bj = 0; bj < 2; ++bj) {
                    const f32x4 a = acc[ai][bj][m][0], b = acc[ai][bj][m][1]; float h[4];
#pragma unroll
                    for (int j = 0; j < 4; ++j) h[j] = siluf(a[j]) * b[j];
                    *(u32x2*)(hmid + (size_t)(row0 + ai * 128 + m * 16) * DE + (u.pn * 256 + bj * 128 + wc * 32) / 2 + 4 * fq) = (u32x2){pk2(h[0], h[1]), pk2(h[2], h[3])};
                }
    }
};
struct EpiMoe2 {
    bf16_t* ys;
    DI void operator()(const AccT& acc, const pg8::Unit& u, int wr, int wc, int fr, int fq) const {
        const int row0 = u.pm * 256 + wr * 64 + fr;
#pragma unroll
        for (int ai = 0; ai < 2; ++ai)
#pragma unroll
            for (int m = 0; m < 4; ++m)
#pragma unroll
                for (int bj = 0; bj < 2; ++bj)
#pragma unroll
                    for (int n = 0; n < 2; ++n) { const f32x4 v = acc[ai][bj][m][n];
                        *(u32x2*)(ys + (size_t)(row0 + ai * 128 + m * 16) * D + u.pn * 256 + bj * 128 + wc * 32 + n * 16 + 4 * fq) = (u32x2){pk2(v[0], v[1]), pk2(v[2], v[3])}; }
    }
};

DI void tconv_tile(const Frame& F, const float* src, int N, int k0, int n0, bf16_t* dst, int ldd, int mode) {
    float* tl = (float*)F.lds;
    __syncthreads();
#pragma unroll
    for (int i = 0; i < 8; ++i) { const int idx = F.tid + 512 * i, k = idx >> 6, n = idx & 63; tl[k * 65 + n] = src[(size_t)(k0 + k) * N + n0 + n]; }
    __syncthreads();
#pragma unroll
    for (int i = 0; i < 4; ++i) { const int idx = F.tid + 512 * i, n = idx >> 5, kp = idx & 31;
        const int nn = n0 + n; const int row = (mode == 0) ? nn : ((nn >> 4) * 32 + (mode - 1) * 16 + (nn & 15));
        *(unsigned*)(dst + (size_t)row * ldd + k0 + 2 * kp) = pk2(tl[(2 * kp) * 65 + n], tl[(2 * kp + 1) * 65 + n]); }
}
DI void phase_prologue(const Frame& F) {
    const int T_IN = 16 * 40, T_OUT = 16 * 16, T_E = 16 * 8;
    const int per_layer = T_IN + T_OUT + NE * 3 * T_E, total = 2 * per_layer;
    for (int u = F.bid; u < total; u += F.G) {
        const int li = u / per_layer; int r = u % per_layer;
        if (r < T_IN) { tconv_tile(F, F.in[I_WIN] + (size_t)li * D * DIN, DIN, (r / 40) * 64, (r % 40) * 64, WSP(bf16_t, WS_WIN) + (size_t)li * DIN * D, D, 0); continue; }
        r -= T_IN;
        if (r < T_OUT) { tconv_tile(F, F.in[I_WOUT] + (size_t)li * D * D, D, (r / 16) * 64, (r % 16) * 64, WSP(bf16_t, WS_WOUT) + (size_t)li * D * D, D, 0); continue; }
        r -= T_OUT;
        const int e = r / (3 * T_E), w = (r / T_E) % 3, t = r % T_E;
        if (w < 2) tconv_tile(F, F.in[w == 0 ? I_MW1 : I_MW3] + ((size_t)li * NE + e) * D * DE, DE, (t / 8) * 64, (t % 8) * 64, WSP(bf16_t, WS_W13) + ((size_t)li * NE + e) * 1024 * 1024, D, 1 + w);
        else tconv_tile(F, F.in[I_MW2] + ((size_t)li * NE + e) * DE * D, D, (t / 16) * 64, (t % 16) * 64, WSP(bf16_t, WS_W2) + ((size_t)li * NE + e) * 1024 * 512, DE, 0);
    }
    __syncthreads();
    {
        float* sc = (float*)F.lds;
        float* red = sc + 3072;
        for (int i = F.tid; i < 3072; i += NTHR) { const int v = i >> 10, k = i & 1023; const float x = (v < 2) ? F.in[I_C][v * 1024 + k] : F.in[I_CCTX][k]; sc[i] = siluf(x); }
        __syncthreads();
        for (int u = F.bid; u < 2 * 96; u += F.G) {
            const int li = u / 96, j = (u % 96) * 64 + F.lane, ko = F.wave;
            const float* w = F.in[I_ADAW] + (size_t)li * D * 6144 + j;
            float a0 = 0.f, a1 = 0.f, a2 = 0.f;
            for (int k = ko * 128; k < ko * 128 + 128; ++k) { const float wv = w[(size_t)k * 6144]; a0 += sc[k] * wv; a1 += sc[1024 + k] * wv; a2 += sc[2048 + k] * wv; }
            red[(ko * 3 + 0) * 64 + F.lane] = a0; red[(ko * 3 + 1) * 64 + F.lane] = a1; red[(ko * 3 + 2) * 64 + F.lane] = a2;
            __syncthreads();
            if (F.tid < 192) { const int v = F.tid / 64, l = F.tid % 64; float s = 0.f;
#pragma unroll
                for (int q = 0; q < 8; ++q) s += red[(q * 3 + v) * 64 + l];
                const int jj = (u % 96) * 64 + l;
                WSP(float, WS_MOD)[((size_t)li * 3 + v) * 6144 + jj] = s + F.in[I_ADAB][li * 6144 + jj]; }
            __syncthreads();
        }
    }
    if (F.bid == (F.G > 1 ? 1 : 0)) {
        for (int i = F.tid; i < 256 * 8; i += NTHR) { const int pos = i >> 3, f = i & 7; const float inv = exp2f(-(float)f * (13.287712379549449f / 8.f)); const float rev = (float)pos * inv * 0.15915494309189535f;
            WSP(float, WS_ROPE)[i * 2] = cos_rev(rev); WSP(float, WS_ROPE)[i * 2 + 1] = sin_rev(rev); }
    }
}

DI void filter_tile(const Frame& F, int li, int L, int tile, float* hT, float* part) {
    float* h1s = (float*)F.lds;
    float* h2s = h1s + 4096;
    float* stg = h2s + 4096;
    float* sq2 = stg + 256 * 65;
    const float* w1 = F.in[I_HW1] + (size_t)li * 33 * 64; const float* b1 = F.in[I_HB1] + li * 64;
    const float* w2 = F.in[I_HW2] + (size_t)li * 64 * 64; const float* b2 = F.in[I_HB2] + li * 64;
    const float* w3 = F.in[I_HW3] + (size_t)li * 64 * 1024; const float* b3 = F.in[I_HB3] + li * 1024;
    const int t0 = tile * 64;
    const float inv_lm1 = 1.f / (float)(L > 1 ? L - 1 : 1);
    __syncthreads();
    {
        const int tl = F.tid & 63, pt = F.tid >> 6; const float t = (float)(t0 + tl);
        float a[8];
#pragma unroll
        for (int jj = 0; jj < 8; ++jj) a[jj] = b1[pt * 8 + jj] + (t * inv_lm1) * w1[pt * 8 + jj];
#pragma unroll 1
        for (int i = 0; i < 16; ++i) { const float band = 1e-4f + (15.f - 1e-4f) * (float)i / 15.f; const float rev = t * band / (float)L; const float cz = cos_rev(rev), sz = sin_rev(rev);
#pragma unroll
            for (int jj = 0; jj < 8; ++jj) a[jj] += cz * w1[(1 + i) * 64 + pt * 8 + jj] + sz * w1[(17 + i) * 64 + pt * 8 + jj]; }
#pragma unroll
        for (int jj = 0; jj < 8; ++jj) h1s[tl * 64 + pt * 8 + jj] = sin_rad(a[jj]);
    }
    __syncthreads();
    {
        const int tl = F.tid & 63, pt = F.tid >> 6;
        float a[8];
#pragma unroll
        for (int jj = 0; jj < 8; ++jj) a[jj] = b2[pt * 8 + jj];
#pragma unroll 1
        for (int i = 0; i < 64; ++i) { const float hv = h1s[tl * 64 + i];
#pragma unroll
            for (int jj = 0; jj < 8; ++jj) a[jj] += hv * w2[i * 64 + pt * 8 + jj]; }
#pragma unroll
        for (int jj = 0; jj < 8; ++jj) h2s[tl * 64 + pt * 8 + jj] = sin_rad(a[jj]);
    }
    __syncthreads();
    const int c = F.tid & 255, th = F.tid >> 8;
    const float delta = 3.0701134573253945f + (15.350567286626973f - 3.0701134573253945f) * (float)c / 255.f;
#pragma unroll 1
    for (int cc = 0; cc < 4; ++cc) {
        float wr[64];
#pragma unroll
        for (int i = 0; i < 64; ++i) wr[i] = w3[(size_t)i * 1024 + cc * 256 + c];
        const float bb = b3[cc * 256 + c]; float sq = 0.f;
#pragma unroll 1
        for (int tt = th * 32; tt < th * 32 + 32; ++tt) {
            float a = bb;
#pragma unroll
            for (int i = 0; i < 64; ++i) a += h2s[tt * 64 + i] * wr[i];
            a *= __expf(-((float)(t0 + tt) * inv_lm1) * delta);
            stg[c * 65 + tt] = a; sq += a * a;
        }
        if (th == 1) sq2[c] = sq;
        __syncthreads();
        if (th == 0) part[(size_t)tile * 1024 + cc * 256 + c] = sq + sq2[c];
        for (int ch = F.wave * 32; ch < F.wave * 32 + 32; ++ch) hT[((size_t)cc * 256 + ch) * L + t0 + F.lane] = stg[ch * 65 + F.lane];
        __syncthreads();
    }
}

struct TokInfo { unsigned e0, e1, p0, p1; float g0, g1; unsigned s0, s1; };
DI void phase_norm1(const Frame& F, int li, int mode) {
    const int nrows = (mode == 2) ? NLAT : NTOK;
    const float* modp = WSP(float, WS_MOD) + (size_t)li * 3 * 6144;
    const float* modprev = WSP(float, WS_MOD) + (size_t)(mode == 2 ? 1 : li - 1) * 3 * 6144;
    const float* gam = (mode == 2) ? F.in[I_FG] : F.in[I_N1G] + (size_t)li * D;
    const TokInfo* tok = WSP(TokInfo, WS_TOK); const bf16_t* ys = WSP(bf16_t, WS_A1);
    bf16_t* hbf = WSP(bf16_t, WS_HBF);
    for (int r = F.bid * 8 + F.wave; r < nrows; r += F.G * 8) {
        const bool isctx = r >= NLAT; const int v = isctx ? 2 : (r >> 14);
        float* xrow = isctx ? WSP(float, WS_XC) + (size_t)(r - NLAT) * D : F.out + (size_t)r * D;
        const float* src = (mode == 0) ? (isctx ? F.in[I_CTX] + (size_t)(r - NLAT) * D : F.in[I_X] + (size_t)r * D) : xrow;
        f32x4 x[4];
#pragma unroll
        for (int i = 0; i < 4; ++i) x[i] = *(const f32x4*)(src + i * 256 + F.lane * 4);
        if (mode != 0) {
            const TokInfo ti = tok[r];
            const float* g2 = modprev + (size_t)v * 6144 + 5 * 1024;
#pragma unroll
            for (int i = 0; i < 4; ++i) {
                const int c = i * 256 + F.lane * 4;
                const u32x2 a = *(const u32x2*)(ys + (size_t)ti.s0 * D + c), b = *(const u32x2*)(ys + (size_t)ti.s1 * D + c);
                const f32x4 gg = *(const f32x4*)(g2 + c);
                f32x4 y;
                y[0] = ti.g0 * __uint_as_float(a[0] << 16) + ti.g1 * __uint_as_float(b[0] << 16);
                y[1] = ti.g0 * __uint_as_float(a[0] & 0xffff0000u) + ti.g1 * __uint_as_float(b[0] & 0xffff0000u);
                y[2] = ti.g0 * __uint_as_float(a[1] << 16) + ti.g1 * __uint_as_float(b[1] << 16);
                y[3] = ti.g0 * __uint_as_float(a[1] & 0xffff0000u) + ti.g1 * __uint_as_float(b[1] & 0xffff0000u);
                x[i] = x[i] + gg * y;
            }
            if (mode == 1) {
#pragma unroll
                for (int i = 0; i < 4; ++i) *(f32x4*)(xrow + i * 256 + F.lane * 4) = x[i];
            }
        }
        float ss = 0.f;
#pragma unroll
        for (int i = 0; i < 4; ++i) ss += x[i][0] * x[i][0] + x[i][1] * x[i][1] + x[i][2] * x[i][2] + x[i][3] * x[i][3];
        ss = wave_sum(ss);
        const float rstd = rsqrtf(ss * (1.f / D) + EPS);
#pragma unroll
        for (int i = 0; i < 4; ++i) {
            const int c = i * 256 + F.lane * 4;
            const f32x4 g = *(const f32x4*)(gam + c);
            if (mode == 2) { *(f32x4*)(F.out + (size_t)r * D + c) = x[i] * rstd * g; }
            else {
                const f32x4 sh = *(const f32x4*)(modp + (size_t)v * 6144 + c), sc = *(const f32x4*)(modp + (size_t)v * 6144 + 1024 + c);
                const f32x4 h = x[i] * rstd * g * (sc + 1.f) + sh;
                *(u32x2*)(hbf + (size_t)r * D + c) = (u32x2){pk2(h[0], h[1]), pk2(h[2], h[3])};
            }
        }
    }
}

DI void phase_norm2(const Frame& F, int li, int nrows) {
    float* wt = (float*)F.lds;
    __syncthreads();
    for (int i = F.tid; i < 16384; i += NTHR) { const int k = i >> 4, e = i & 15; wt[e * 1024 + k] = F.in[I_RW][i]; }
    __syncthreads();
    const float* modp = WSP(float, WS_MOD) + (size_t)li * 3 * 6144;
    const float* gam = F.in[I_N2G] + (size_t)li * D;
    bf16_t* hbf = WSP(bf16_t, WS_HBF); TokInfo* tok = WSP(TokInfo, WS_TOK);
    unsigned* lcnt = (unsigned*)(F.lds + LDS_MISC + 64);
    if (F.tid < 16) lcnt[F.tid] = 0u;
    __syncthreads();
    for (int r = F.bid * 8 + F.wave; r < nrows; r += F.G * 8) {
        const bool isctx = r >= NLAT; const int v = isctx ? 2 : (r >> 14);
        const float* src = isctx ? WSP(float, WS_XC) + (size_t)(r - NLAT) * D : F.out + (size_t)r * D;
        f32x4 x[4]; float ss = 0.f;
#pragma unroll
        for (int i = 0; i < 4; ++i) { x[i] = *(const f32x4*)(src + i * 256 + F.lane * 4); ss += x[i][0] * x[i][0] + x[i][1] * x[i][1] + x[i][2] * x[i][2] + x[i][3] * x[i][3]; }
        ss = wave_sum(ss);
        const float rstd = rsqrtf(ss * (1.f / D) + EPS);
        float lg[16];
#pragma unroll
        for (int e = 0; e < 16; ++e) lg[e] = 0.f;
#pragma unroll
        for (int i = 0; i < 4; ++i) {
            const int c = i * 256 + F.lane * 4;
            const f32x4 g = *(const f32x4*)(gam + c), sh = *(const f32x4*)(modp + (size_t)v * 6144 + 3 * 1024 + c), sc = *(const f32x4*)(modp + (size_t)v * 6144 + 4 * 1024 + c);
            const f32x4 h = x[i] * rstd * g * (sc + 1.f) + sh;
            *(u32x2*)(hbf + (size_t)r * D + c) = (u32x2){pk2(h[0], h[1]), pk2(h[2], h[3])};
#pragma unroll
            for (int e = 0; e < 16; ++e) { const f32x4 w = *(const f32x4*)(wt + e * 1024 + c); lg[e] += h[0] * w[0] + h[1] * w[1] + h[2] * w[2] + h[3] * w[3]; }
        }
#pragma unroll
        for (int e = 0; e < 16; ++e) lg[e] = wave_sum(lg[e]);
        float mx = lg[0];
#pragma unroll
        for (int e = 1; e < 16; ++e) mx = fmaxf(mx, lg[e]);
        float sc[16], sel[16], den = 0.f;
#pragma unroll
        for (int e = 0; e < 16; ++e) { sc[e] = __expf(lg[e] - mx); den += sc[e]; }
        const float rden = 1.f / den;
#pragma unroll
        for (int e = 0; e < 16; ++e) { sc[e] *= rden; sel[e] = sc[e] + F.in[I_RB][e]; }
        int bg = 0; float bgs = -1e30f;
#pragma unroll
        for (int g = 0; g < 4; ++g) {
            float m1 = -1e30f, m2 = -1e30f;
#pragma unroll
            for (int q = 0; q < 4; ++q) { const float s = sel[g * 4 + q]; if (s > m1) { m2 = m1; m1 = s; } else if (s > m2) m2 = s; }
            const float gs = m1 + m2; if (gs > bgs) { bgs = gs; bg = g; }
        }
        int e0 = 0, e1 = 0; float s0v = -1e30f, s1v = -1e30f, w0 = 0.f, w1 = 0.f;
#pragma unroll
        for (int e = 0; e < 16; ++e) {
            const bool ing = (e >> 2) == bg; const float s = sel[e];
            if (ing && s > s0v) { s1v = s0v; e1 = e0; w1 = w0; s0v = s; e0 = e; w0 = sc[e]; }
            else if (ing && s > s1v) { s1v = s; e1 = e; w1 = sc[e]; }
        }
        if (F.lane == 0) {
            TokInfo ti; ti.e0 = e0; ti.e1 = e1; ti.p0 = atomicAdd(lcnt + e0, 1u); ti.p1 = atomicAdd(lcnt + e1, 1u);
            const float ws = 1.f / (w0 + w1); ti.g0 = w0 * ws; ti.g1 = w1 * ws; ti.s0 = 0; ti.s1 = 0;
            tok[r] = ti;
        }
    }
    __syncthreads();
    if (F.tid < 16) F.ctl[CW_BCNT + (li * MAXG + F.bid) * 16 + F.tid] = lcnt[F.tid];
}

DI void moe_offsets(const Frame& F, int li, int* offs) {
    __syncthreads();
    int* tot = offs + 376;
    int* part = (int*)F.lds;
    {
        const int e = F.tid & 15, pq = F.tid >> 4;
        const unsigned* bc = F.ctl + CW_BCNT + li * MAXG * 16 + e;
        int st = 0, sb = 0;
#pragma unroll
        for (int k = 0; k < 8; ++k) { const int blk = pq * 8 + k; const int c = (blk < F.G) ? (int)__hip_atomic_load(bc + blk * 16, __ATOMIC_RELAXED, __HIP_MEMORY_SCOPE_AGENT) : 0; st += c; sb += (blk < F.bid) ? c : 0; }
        part[pq * 16 + e] = st; part[512 + pq * 16 + e] = sb;
    }
    __syncthreads();
    if (F.tid < 32) { const int e = F.tid & 15, wb = F.tid >> 4; int s = 0;
        for (int pq = 0; pq < 32; ++pq) s += part[wb * 512 + pq * 16 + e];
        if (wb) offs[360 + e] = s; else tot[e] = s; }
    __syncthreads();
    if (F.tid == 0) { int o = 0; for (int e = 0; e < NE; ++e) { offs[e] = o; offs[17 + e] = o >> 8; o += (tot[e] + 255) & ~255; }
        offs[16] = o; offs[17 + 16] = o >> 8; }
    __syncthreads();
    for (int t = F.tid; t < SLOT_CAP / 256; t += NTHR) { int e = 0; for (int k = 1; k < NE; ++k) e += (offs[17 + k] <= t) ? 1 : 0; offs[40 + t] = e; }
    if (F.tid < 16) offs[360 + F.tid] += offs[F.tid];
    __syncthreads();
}
DI void phase_gather(const Frame& F, int li, int nrows) {
    int* offs = (int*)(F.lds + LDS_MISC + 64);
    moe_offsets(F, li, offs);
    const bf16_t* hbf = WSP(bf16_t, WS_HBF); bf16_t* a1 = WSP(bf16_t, WS_A1); TokInfo* tok = WSP(TokInfo, WS_TOK);
    for (int r = F.bid * 8 + F.wave; r < nrows; r += F.G * 8) {
        TokInfo ti = tok[r];
        const unsigned s0 = offs[360 + ti.e0] + ti.p0, s1 = offs[360 + ti.e1] + ti.p1;
        const u32x4 a = *(const u32x4*)(hbf + (size_t)r * D + F.lane * 8), b = *(const u32x4*)(hbf + (size_t)r * D + 512 + F.lane * 8);
        *(u32x4*)(a1 + (size_t)s0 * D + F.lane * 8) = a; *(u32x4*)(a1 + (size_t)s0 * D + 512 + F.lane * 8) = b;
        *(u32x4*)(a1 + (size_t)s1 * D + F.lane * 8) = a; *(u32x4*)(a1 + (size_t)s1 * D + 512 + F.lane * 8) = b;
        if (F.lane == 0) { tok[r].s0 = s0; tok[r].s1 = s1; }
    }
}

#define MFMA32(a, b, c) __builtin_amdgcn_mfma_f32_32x32x16_bf16((a), (b), (c), 0, 0, 0)
DI float lam_of(const Frame& F, int li, float& lam_init) {
    const float* lv = F.in[I_ALAM] + (size_t)li * 128;
    const int i = F.lane & 31, hi = F.lane >> 5;
    float d = lv[hi * 64 + i] * lv[hi * 64 + 32 + i];
    d += swz_xor<16>(d); d += swz_xor<8>(d); d += swz_xor<4>(d); d += swz_xor<2>(d); d += swz_xor<1>(d);
    const float d0 = __int_as_float(__builtin_amdgcn_readlane(__float_as_int(d), 0)), d1 = __int_as_float(__builtin_amdgcn_readlane(__float_as_int(d), 32));
    lam_init = 0.8f - 0.6f * __expf(-0.3f * (float)li);
    return __expf(d0) - __expf(d1) + lam_init;
}
DI bf16x8 pack8(const f32x16& x, int s) {
    u32x4 p; p[0] = pk2(x[8 * s], x[8 * s + 1]); p[1] = pk2(x[8 * s + 2], x[8 * s + 3]); p[2] = pk2(x[8 * s + 4], x[8 * s + 5]); p[3] = pk2(x[8 * s + 6], x[8 * s + 7]);
    return __builtin_bit_cast(bf16x8, p);
}

DI void diffattn_unit(const Frame& F, int li, int b, int h, size_t qrow0, int NT) {
    const int lane = F.lane, r = lane & 31, hh = lane >> 5;
    const bf16_t* AQ = WSP(bf16_t, WS_AQ); const bf16_t* AK = WSP(bf16_t, WS_AK); const bf16_t* AVT = WSP(bf16_t, WS_AVT) + (size_t)(b * 4 + h) * 64 * NKEY;
    unsigned char* Ks = F.lds;
    unsigned char* Vt = F.lds + 16384;
    constexpr int VTB = 64 * 136;
    float lam_init; const float lam = lam_of(F, li, lam_init);
    const size_t qrow = qrow0 + F.wave * 32 + r;
    bf16x8 qf[2][2]; float qn2[2];
#pragma unroll
    for (int c = 0; c < 2; ++c) { qn2[c] = 0.f;
#pragma unroll
        for (int ks = 0; ks < 2; ++ks) { qf[c][ks] = *(const bf16x8*)(AQ + qrow * 256 + h * 64 + c * 32 + ks * 16 + 8 * hh);
#pragma unroll
            for (int j = 0; j < 8; ++j) { const float v = bf2f((bf16_t)qf[c][ks][j]); qn2[c] += v * v; } }
        qn2[c] = half_sum(qn2[c]); }
    const unsigned* kmx = F.ctl + CW_KMAX + li * 16 + (b * 4 + h) * 2;
    f32x16 cinit;
    { float cn = 0.f;
#pragma unroll
      for (int c = 0; c < 2; ++c) { const float km = sqrtf(__uint_as_float(__hip_atomic_load(kmx + c, __ATOMIC_RELAXED, __HIP_MEMORY_SCOPE_AGENT))); cn = fmaxf(cn, sqrtf(qn2[c]) * km); }
      cn = -(cn * 1.02f + 1e-3f);
#pragma unroll
      for (int i = 0; i < 16; ++i) cinit[i] = cn; }
    f32x16 O[2][2];
#pragma unroll
    for (int c = 0; c < 2; ++c)
#pragma unroll
        for (int dh = 0; dh < 2; ++dh)
#pragma unroll
            for (int i = 0; i < 16; ++i) O[c][dh][i] = 0.f;
    float lsum[2] = {0.f, 0.f};
    const int skey = F.tid >> 3, sch = F.tid & 7;
    const int kdst = (sch >> 2) * 4096 + skey * 64 + (((sch & 3) ^ ((skey >> 2) & 3)) * 16);
    const int vd = F.tid >> 3, vkc = F.tid & 7;
    const int vdst = vd * 136 + vkc * 16;
    auto krow_of = [&](int j) -> size_t { return j < CTX ? (size_t)NLAT + b * CTX + j : (size_t)b * S + (j - CTX); };
    u32x4 kreg, vreg;
    kreg = *(const u32x4*)(AK + krow_of(skey) * 256 + h * 64 + sch * 8);
    vreg = *(const u32x4*)(AVT + (size_t)vd * NKEY + vkc * 8);
    __syncthreads();
    *(u32x4*)(Ks + kdst) = kreg;
    *(u32x2*)(Vt + vdst) = (u32x2){vreg[0], vreg[1]}; *(u32x2*)(Vt + vdst + 8) = (u32x2){vreg[2], vreg[3]};
    __syncthreads();
    for (int kt = 0; kt < NT; ++kt) {
        const int buf = kt & 1;
        if (kt + 1 < NT) {
            const int j0 = (kt + 1) * 64;
            kreg = *(const u32x4*)(AK + krow_of(j0 + skey) * 256 + h * 64 + sch * 8);
            vreg = *(const u32x4*)(AVT + (size_t)vd * NKEY + j0 + vkc * 8);
        }
        const unsigned char* kb = Ks + buf * 8192; const unsigned char* vb = Vt + buf * VTB;
#pragma unroll 1
        for (int st = 0; st < 2; ++st) {
            const int key = 32 * st + r;
            bf16x8 pb[2][2];
#pragma unroll
            for (int c = 0; c < 2; ++c) {
                const bf16x8 k0 = *(const bf16x8*)(kb + c * 4096 + key * 64 + (((0 + hh) ^ ((key >> 2) & 3)) * 16));
                const bf16x8 k1 = *(const bf16x8*)(kb + c * 4096 + key * 64 + (((2 + hh) ^ ((key >> 2) & 3)) * 16));
                f32x16 s = MFMA32(k0, qf[c][0], cinit);
                s = MFMA32(k1, qf[c][1], s);
#pragma unroll
                for (int i = 0; i < 16; ++i) { s[i] = __builtin_amdgcn_exp2f(s[i]); lsum[c] += s[i]; }
                pb[c][0] = pack8(s, 0); pb[c][1] = pack8(s, 1);
            }
#pragma unroll
            for (int dh = 0; dh < 2; ++dh)
#pragma unroll
                for (int s = 0; s < 2; ++s) {
                    const unsigned char* vp = vb + (32 * dh + r) * 136 + (32 * st + 16 * s + 4 * hh) * 2;
                    const s16x4 lo = *(const s16x4*)vp, hi = *(const s16x4*)(vp + 16);
                    const bf16x8 vf = __builtin_shufflevector(lo, hi, 0, 1, 2, 3, 4, 5, 6, 7);
                    O[0][dh] = MFMA32(vf, pb[0][s], O[0][dh]);
                    O[1][dh] = MFMA32(vf, pb[1][s], O[1][dh]);
                }
        }
        if (kt + 1 < NT) {
            unsigned char* kw = Ks + (buf ^ 1) * 8192; unsigned char* vw = Vt + (buf ^ 1) * VTB;
            *(u32x4*)(kw + kdst) = kreg;
            *(u32x2*)(vw + vdst) = (u32x2){vreg[0], vreg[1]}; *(u32x2*)(vw + vdst + 8) = (u32x2){vreg[2], vreg[3]};
        }
        __syncthreads();
    }
    const float l0 = half_sum(lsum[0]), l1 = half_sum(lsum[1]);
    const float r0 = 1.f / l0, r1 = lam / l1;
    float o[2][16]; float ss = 0.f;
#pragma unroll
    for (int dh = 0; dh < 2; ++dh)
#pragma unroll
        for (int i = 0; i < 16; ++i) { o[dh][i] = O[0][dh][i] * r0 - O[1][dh][i] * r1; ss += o[dh][i] * o[dh][i]; }
    ss = half_sum(ss);
    const float rs = rsqrtf(ss * (1.f / 64.f) + EPS) * (1.f - lam_init);
    const float* sg = F.in[I_ASUB] + li * 64;
    bf16_t* mix = WSP(bf16_t, WS_HBF) + qrow * D + h * 64;
#pragma unroll
    for (int dh = 0; dh < 2; ++dh)
#pragma unroll
        for (int g = 0; g < 4; ++g) {
            const int d = 32 * dh + 8 * g + 4 * hh;
            const f32x4 gg = *(const f32x4*)(sg + d);
            *(u32x2*)(mix + d) = (u32x2){pk2(o[dh][4 * g] * rs * gg[0], o[dh][4 * g + 1] * rs * gg[1]), pk2(o[dh][4 * g + 2] * rs * gg[2], o[dh][4 * g + 3] * rs * gg[3])};
        }
}

DI void ctx_attn_b_unit(const Frame& F, int u) {
    const int idx = u * NTHR + F.tid, cr = idx >> 2, h = idx & 3, b = cr >> 8;
    const bf16_t* BQ = WSP(bf16_t, WS_BQ) + (size_t)(NLAT + cr) * 256 + h * 64;
    const bf16_t* BK = WSP(bf16_t, WS_BK) + (size_t)(NLAT + b * CTX) * 256 + h * 64;
    const bf16_t* BV = WSP(bf16_t, WS_BV) + (size_t)(NLAT + b * CTX) * 256 + h * 64;
    float q[64], acc[64];
#pragma unroll
    for (int i = 0; i < 64; ++i) { q[i] = bf2f(BQ[i]); acc[i] = 0.f; }
    float m = -1e30f, l = 0.f;
#pragma unroll 1
    for (int j = 0; j < CTX; ++j) {
        const bf16_t* kp = BK + (size_t)j * 256; const bf16_t* vp = BV + (size_t)j * 256;
        float s = 0.f;
#pragma unroll
        for (int i8 = 0; i8 < 8; ++i8) { const u32x4 kk = *(const u32x4*)(kp + i8 * 8);
#pragma unroll
            for (int e = 0; e < 4; ++e) { s += q[i8 * 8 + 2 * e] * __uint_as_float(kk[e] << 16) + q[i8 * 8 + 2 * e + 1] * __uint_as_float(kk[e] & 0xffff0000u); } }
        const float mn = fmaxf(m, s), al = __builtin_amdgcn_exp2f(m - mn), p = __builtin_amdgcn_exp2f(s - mn);
        l = l * al + p; m = mn;
#pragma unroll
        for (int i8 = 0; i8 < 8; ++i8) { const u32x4 vv = *(const u32x4*)(vp + i8 * 8);
#pragma unroll
            for (int e = 0; e < 4; ++e) { acc[i8 * 8 + 2 * e] = acc[i8 * 8 + 2 * e] * al + p * __uint_as_float(vv[e] << 16); acc[i8 * 8 + 2 * e + 1] = acc[i8 * 8 + 2 * e + 1] * al + p * __uint_as_float(vv[e] & 0xffff0000u); } }
    }
    const float rl = 1.f / l;
    bf16_t* mix = WSP(bf16_t, WS_HBF) + (size_t)(NLAT + cr) * D + 256 + h * 64;
#pragma unroll
    for (int i8 = 0; i8 < 8; ++i8) *(u32x4*)(mix + i8 * 8) = (u32x4){pk2(acc[i8 * 8] * rl, acc[i8 * 8 + 1] * rl), pk2(acc[i8 * 8 + 2] * rl, acc[i8 * 8 + 3] * rl), pk2(acc[i8 * 8 + 4] * rl, acc[i8 * 8 + 5] * rl), pk2(acc[i8 * 8 + 6] * rl, acc[i8 * 8 + 7] * rl)};
}

DI void na_unit(const Frame& F, int li, int u) {
    const int b = u >> 7, rp = u & 127;
    const int qi = F.tid >> 2, h = F.tid & 3;
    const int row = rp * 2 + (qi >> 6), col = qi & 63, t = row * GW + col;
    const bf16_t* BQ = WSP(bf16_t, WS_BQ) + ((size_t)b * S + t) * 256 + h * 64;
    const bf16_t* BKl = WSP(bf16_t, WS_BK) + (size_t)b * S * 256 + h * 64;
    const bf16_t* BVl = WSP(bf16_t, WS_BV) + (size_t)b * S * 256 + h * 64;
    const bf16_t* BKc = WSP(bf16_t, WS_BK) + (size_t)(NLAT + b * CTX) * 256 + h * 64;
    const bf16_t* BVc = WSP(bf16_t, WS_BV) + (size_t)(NLAT + b * CTX) * 256 + h * 64;
    const float* rpb = F.in[I_RPB] + ((size_t)li * 4 + h) * 15 * 31;
    float q[64], acc[64];
#pragma unroll
    for (int i = 0; i < 64; ++i) { q[i] = bf2f(BQ[i]); acc[i] = 0.f; }
    float m = -1e30f, l = 0.f;
    int r0 = row - 4; r0 = r0 < 0 ? 0 : (r0 > 248 ? 248 : r0);
    int c0 = col - 8; c0 = c0 < 0 ? 0 : (c0 > 48 ? 48 : c0);
    for (int j = 0; j < 128 + CTX; ++j) {
        const bf16_t *kp, *vp; float bias = 0.f;
        if (j < 128) { const int kr = r0 + (j >> 4), kc = c0 + (j & 15); kp = BKl + (size_t)(kr * GW + kc) * 256; vp = BVl + (size_t)(kr * GW + kc) * 256;
            bias = rpb[(kr - row + 7) * 31 + (kc - col + 15)] * LOG2E; }
        else { kp = BKc + (size_t)(j - 128) * 256; vp = BVc + (size_t)(j - 128) * 256; }
        float s = bias;
#pragma unroll
        for (int i8 = 0; i8 < 8; ++i8) { const u32x4 kk = *(const u32x4*)(kp + i8 * 8);
#pragma unroll
            for (int e = 0; e < 4; ++e) { s += q[i8 * 8 + 2 * e] * __uint_as_float(kk[e] << 16) + q[i8 * 8 + 2 * e + 1] * __uint_as_float(kk[e] & 0xffff0000u); } }
        const float mn = fmaxf(m, s), al = __builtin_amdgcn_exp2f(m - mn), p = __builtin_amdgcn_exp2f(s - mn);
        l = l * al + p; m = mn;
#pragma unroll
        for (int i8 = 0; i8 < 8; ++i8) { const u32x4 vv = *(const u32x4*)(vp + i8 * 8);
#pragma unroll
            for (int e = 0; e < 4; ++e) { acc[i8 * 8 + 2 * e] = acc[i8 * 8 + 2 * e] * al + p * __uint_as_float(vv[e] << 16); acc[i8 * 8 + 2 * e + 1] = acc[i8 * 8 + 2 * e + 1] * al + p * __uint_as_float(vv[e] & 0xffff0000u); } }
    }
    const float rl = 1.f / l;
    bf16_t* mix = WSP(bf16_t, WS_HBF) + ((size_t)b * S + t) * D + 256 + h * 64;
#pragma unroll
    for (int i8 = 0; i8 < 8; ++i8) *(u32x4*)(mix + i8 * 8) = (u32x4){pk2(acc[i8 * 8] * rl, acc[i8 * 8 + 1] * rl), pk2(acc[i8 * 8 + 2] * rl, acc[i8 * 8 + 3] * rl), pk2(acc[i8 * 8 + 4] * rl, acc[i8 * 8 + 5] * rl), pk2(acc[i8 * 8 + 6] * rl, acc[i8 * 8 + 7] * rl)};
}

DI void pool_unit(const Frame& F, int li, size_t seq_row0, int L, int t0) {
    float* us = (float*)F.lds;
    float* df = us + 48 * 256;
    const bf16_t* PL = WSP(bf16_t, WS_PL);
    __syncthreads();
    for (int i = F.tid; i < 48 * 32; i += NTHR) {
        const int tt = i >> 5, c8 = i & 31, t = t0 - 8 + tt;
        float v[8] = {0.f, 0.f, 0.f, 0.f, 0.f, 0.f, 0.f, 0.f};
        if (t >= 0 && t < L) { const u32x4 x = *(const u32x4*)(PL + (seq_row0 + t) * 256 + c8 * 8);
#pragma unroll
            for (int e = 0; e < 4; ++e) { v[2 * e] = __uint_as_float(x[e] << 16); v[2 * e + 1] = __uint_as_float(x[e] & 0xffff0000u); } }
#pragma unroll
        for (int e = 0; e < 8; ++e) us[tt * 256 + c8 * 8 + e] = v[e];
    }
    __syncthreads();
    for (int i = F.tid; i < 32 * 256; i += NTHR) {
        const int tl = i >> 8, ch = i & 255, g = ch >> 6, t = t0 + tl; const int hw = 1 << g;
        int lo = t - hw; lo = lo < 0 ? 0 : lo; int hi = t + hw; hi = hi > L ? L : hi;
        float s = 0.f;
        for (int tt = lo; tt < hi; ++tt) s += us[(tt - t0 + 8) * 256 + ch];
        df[tl * 256 + ch] = s / (float)(hi - lo) - us[(tl + 8) * 256 + ch];
    }
    __syncthreads();
    const float* pw = F.in[I_POOLW] + (size_t)li * 4 * 64 * 64; const float* ps = F.in[I_POOLS] + li * 256;
    bf16_t* mix = WSP(bf16_t, WS_HBF);
    {
        const int ch = F.tid & 255, th = F.tid >> 8, g = ch >> 6, j = ch & 63;
        float w[64];
#pragma unroll
        for (int i = 0; i < 64; ++i) w[i] = pw[((size_t)g * 64 + i) * 64 + j];
        const float scale = ps[ch];
        for (int tl = th * 16; tl < th * 16 + 16; ++tl) {
            float a = 0.f;
#pragma unroll
            for (int i = 0; i < 64; ++i) a += df[tl * 256 + g * 64 + i] * w[i];
            mix[(seq_row0 + t0 + tl) * D + 512 + ch] = f2bf(a * scale);
        }
    }
}

DI float hy_norm(const float* part, int ntile, int o, int ch) {
    float s = 0.f;
    for (int t = 0; t < ntile; ++t) s += part[(size_t)t * 1024 + (o * 2) * 256 + ch] + part[(size_t)t * 1024 + (o * 2 + 1) * 256 + ch];
    return rsqrtf(s + EPS);
}
DI float hy_short(const bf16_t* p, int t, int L, float w0, float w1, float w2, float bb) {
    const float a = t > 0 ? bf2f(p[t - 1]) : 0.f, c = t + 1 < L ? bf2f(p[t + 1]) : 0.f;
    return a * w0 + bf2f(p[t]) * w1 + c * w2 + bb;
}
constexpr int FM = 16384;
DI int fphys(int i) { return i + (i >> 4) + ((i >> 9) << 4); }
constexpr int brev(int m, int bits) { return bits == 5 ? (((m & 1) << 4) | ((m & 2) << 2) | (m & 4) | ((m & 8) >> 2) | ((m & 16) >> 4)) : (((m & 1) << 3) | ((m & 2) << 1) | ((m & 4) >> 1) | ((m & 8) >> 3)); }
template <int R, int LOG2R, bool INV> DI void dft_regs(float (&re)[R], float (&im)[R]) {
    constexpr float C32[16] = {1.f, 0.98078528040323043f, 0.92387953251128674f, 0.83146961230254524f, 0.70710678118654752f, 0.55557023301960218f, 0.38268343236508977f, 0.19509032201612825f,
                               0.f, -0.19509032201612825f, -0.38268343236508977f, -0.55557023301960218f, -0.70710678118654752f, -0.83146961230254524f, -0.92387953251128674f, -0.98078528040323043f};
    constexpr float S32[16] = {0.f, 0.19509032201612825f, 0.38268343236508977f, 0.55557023301960218f, 0.70710678118654752f, 0.83146961230254524f, 0.92387953251128674f, 0.98078528040323043f,
                               1.f, 0.98078528040323043f, 0.92387953251128674f, 0.83146961230254524f, 0.70710678118654752f, 0.55557023301960218f, 0.38268343236508977f, 0.19509032201612825f};
#pragma unroll
    for (int st = 0; st < LOG2R; ++st) {
        const int h = R >> (st + 1);
#pragma unroll
        for (int i = 0; i < R; i += 2 * h) {
#pragma unroll
            for (int j = 0; j < h; ++j) {
                const float xr = re[i + j], xi = im[i + j], yr = re[i + j + h], yi = im[i + j + h];
                re[i + j] = xr + yr; im[i + j] = xi + yi;
                const float dr = xr - yr, di = xi - yi;
                const int k = j * (16 / h);
                if (k == 0) { re[i + j + h] = dr; im[i + j + h] = di; }
                else if (k == 8) { re[i + j + h] = INV ? -di : di; im[i + j + h] = INV ? dr : -dr; }
                else { const float c = C32[k], sn = INV ? S32[k] : -S32[k]; re[i + j + h] = dr * c - di * sn; im[i + j + h] = dr * sn + di * c; }
            }
        }
    }
}
template <bool INV, int SP> DI void fft_pass32(f32x2* X, int bp, int rem, float inv_bs) {
    asm volatile("" : "+v"(bp), "+v"(rem));
    f32x2* P = X + bp;
    float re[32], im[32];
    if (!INV) {
#pragma unroll
        for (int q = 0; q < 32; ++q) { const f32x2 v = P[q * SP]; re[q] = v[0]; im[q] = v[1]; }
        dft_regs<32, 5, false>(re, im);
#pragma unroll
        for (int m = 0; m < 32; ++m) { const int qp = brev(m, 5);
            float r = re[m], i = im[m];
            if (qp != 0) { const float rev = (float)(rem * qp) * inv_bs; const float c = __builtin_amdgcn_cosf(rev), sn = -__builtin_amdgcn_sinf(rev); const float t = r * c - i * sn; i = r * sn + i * c; r = t; }
            P[qp * SP] = (f32x2){r, i}; }
    } else {
#pragma unroll
        for (int qp = 0; qp < 32; ++qp) { const f32x2 v = P[qp * SP]; float r = v[0], i = v[1];
            if (qp != 0) { const float rev = (float)(rem * qp) * inv_bs; const float c = __builtin_amdgcn_cosf(rev), sn = __builtin_amdgcn_sinf(rev); const float t = r * c - i * sn; i = r * sn + i * c; r = t; }
            re[qp] = r; im[qp] = i; }
        dft_regs<32, 5, true>(re, im);
#pragma unroll
        for (int m = 0; m < 32; ++m) P[brev(m, 5) * SP] = (f32x2){re[m], im[m]};
    }
}
DI void fft_fwd12(f32x2* X, int tid) {
    __syncthreads(); fft_pass32<false, 560>(X, fphys(tid), tid, 1.f / 16384.f);
    __syncthreads(); fft_pass32<false, 17>(X, (tid >> 4) * 560 + (tid & 15), tid & 15, 1.f / 512.f);
    __syncthreads();
}
DI void fft_inv21(f32x2* X, int tid) {
    __syncthreads(); fft_pass32<true, 17>(X, (tid >> 4) * 560 + (tid & 15), tid & 15, 1.f / 512.f);
    __syncthreads(); fft_pass32<true, 560>(X, fphys(tid), tid, 1.f / 16384.f);
    __syncthreads();
}
DI void hyena_fft_unit(const Frame& F, int li, int ch) {
    f32x2* X = (f32x2*)F.lds;
    const bf16_t* HYT = WSP(bf16_t, WS_HYT); const float* filt = WSP(float, WS_FILT);
    f32x2* Ye = WSP(f32x2, WS_ZBUF) + (size_t)ch * FM; f32x2* Z1 = WSP(f32x2, WS_Z1BUF) + (size_t)ch * FM;
    const float* sw = F.in[I_HYSW] + (size_t)li * 3 * 768; const float* sb = F.in[I_HYSB] + li * 768; const float* sk = F.in[I_HSKIP] + li * 512;
    const int tid = F.tid;
    const bf16_t* px1[2] = {HYT + ((size_t)0 * 768 + ch) * S, HYT + ((size_t)1 * 768 + ch) * S};
    const bf16_t* px2[2] = {HYT + ((size_t)0 * 768 + 256 + ch) * S, HYT + ((size_t)1 * 768 + 256 + ch) * S};
    const bf16_t* pv[2] = {HYT + ((size_t)0 * 768 + 512 + ch) * S, HYT + ((size_t)1 * 768 + 512 + ch) * S};
    const float wx1[4] = {sw[ch], sw[768 + ch], sw[1536 + ch], sb[ch]};
    const float wx2[4] = {sw[256 + ch], sw[768 + 256 + ch], sw[1536 + 256 + ch], sb[256 + ch]};
    const float wv[4] = {sw[512 + ch], sw[768 + 512 + ch], sw[1536 + 512 + ch], sb[512 + ch]};
#pragma unroll 1
    for (int cv = 0; cv < 2; ++cv) {
        const float* hf = filt + ((size_t)(2 * cv) * 256 + ch) * S; const float* hb = filt + ((size_t)(2 * cv + 1) * 256 + ch) * S;
        const float fnrm = hy_norm(WSP(float, WS_FPART), 256, cv, ch); const float nrm = 1.f / 32768.f;
        const float skip = sk[cv * 256 + ch];
#pragma unroll 1
        for (int half = 0; half < 2; ++half) {
            __syncthreads();
            int pb = fphys(tid); int tq = tid; asm volatile("" : "+v"(pb), "+v"(tq));
#pragma unroll 2
            for (int j = 0; j < 32; ++j) { const int n = tq + 512 * j; const float a = hf[n] * fnrm, bq = n ? hb[FM - n] * fnrm : 0.f;
                f32x2 v;
                if (half == 0) v = (f32x2){a + bq, 0.f};
                else { const float d = a - bq, rev = (float)n * (1.f / 32768.f); v = (f32x2){d * __builtin_amdgcn_cosf(rev), -d * __builtin_amdgcn_sinf(rev)}; }
                X[pb + 560 * j] = v; }
            fft_fwd12(X, tid);
            h16x2 kpk[2][16];
#pragma unroll
            for (int g = 0; g < 2; ++g) { int b16 = fphys((tid + 512 * g) * 16); asm volatile("" : "+v"(b16));
                float kre[16], kim[16];
#pragma unroll
                for (int q = 0; q < 16; ++q) { const f32x2 v = X[b16 + q]; kre[q] = v[0]; kim[q] = v[1]; }
                dft_regs<16, 4, false>(kre, kim);
#pragma unroll
                for (int q = 0; q < 16; ++q) kpk[g][q] = (h16x2){(_Float16)kre[q], (_Float16)kim[q]}; }
            __syncthreads();
            asm volatile("" : "+v"(pb), "+v"(tq));
#pragma unroll 2
            for (int j = 0; j < 32; ++j) { const int n = tq + 512 * j; f32x2 v;
                if (cv == 0) v = (f32x2){hy_short(pv[0], n, S, wv[0], wv[1], wv[2], wv[3]), hy_short(pv[1], n, S, wv[0], wv[1], wv[2], wv[3])};
                else v = Z1[n];
                if (half == 1) { const float rev = (float)n * (1.f / 32768.f); const float c = __builtin_amdgcn_cosf(rev), sn = -__builtin_amdgcn_sinf(rev); v = (f32x2){v[0] * c - v[1] * sn, v[0] * sn + v[1] * c}; }
                X[pb + 560 * j] = v; }
            fft_fwd12(X, tid);
#pragma unroll
            for (int g = 0; g < 2; ++g) { int b16 = fphys((tid + 512 * g) * 16); asm volatile("" : "+v"(b16));
                float re[16], im[16];
#pragma unroll
                for (int q = 0; q < 16; ++q) { const f32x2 v = X[b16 + q]; re[q] = v[0]; im[q] = v[1]; }
                dft_regs<16, 4, false>(re, im);
                float br[16], bi[16];
#pragma unroll
                for (int m = 0; m < 16; ++m) { const int qp = brev(m, 4); const float kr = (float)kpk[g][m][0], ki = (float)kpk[g][m][1]; br[qp] = re[m] * kr - im[m] * ki; bi[qp] = re[m] * ki + im[m] * kr; }
                dft_regs<16, 4, true>(br, bi);
#pragma unroll
                for (int m = 0; m < 16; ++m) X[b16 + brev(m, 4)] = (f32x2){br[m], bi[m]};
            }
            fft_inv21(X, tid);
            asm volatile("" : "+v"(pb), "+v"(tq));
            if (half == 0) {
#pragma unroll 2
                for (int j = 0; j < 32; ++j) { const int n = tq + 512 * j; Ye[n] = X[pb + 560 * j]; }
            } else {
#pragma unroll 1
                for (int j = 0; j < 32; ++j) { const int n = tq + 512 * j;
                    const f32x2 yo = X[pb + 560 * j], ye = Ye[n];
                    const float rev = (float)n * (1.f / 32768.f); const float c = __builtin_amdgcn_cosf(rev), sn = __builtin_amdgcn_sinf(rev);
                    const float y0 = (ye[0] + yo[0] * c - yo[1] * sn) * nrm, y1 = (ye[1] + yo[0] * sn + yo[1] * c) * nrm;
                    if (cv == 0) {
                        const float v0 = hy_short(pv[0], n, S, wv[0], wv[1], wv[2], wv[3]), v1 = hy_short(pv[1], n, S, wv[0], wv[1], wv[2], wv[3]);
                        const float a0 = hy_short(px1[0], n, S, wx1[0], wx1[1], wx1[2], wx1[3]), a1 = hy_short(px1[1], n, S, wx1[0], wx1[1], wx1[2], wx1[3]);
                        Z1[n] = (f32x2){a0 * (y0 + skip * v0), a1 * (y1 + skip * v1)};
                    } else {
                        const f32x2 z1 = Z1[n];
                        const float a0 = hy_short(px2[0], n, S, wx2[0], wx2[1], wx2[2], wx2[3]), a1 = hy_short(px2[1], n, S, wx2[0], wx2[1], wx2[2], wx2[3]);
                        bf16_t* mix = WSP(bf16_t, WS_HBF);
                        mix[((size_t)n) * D + 768 + ch] = f2bf(a0 * (y0 + skip * z1[0]));
                        mix[((size_t)S + n) * D + 768 + ch] = f2bf(a1 * (y1 + skip * z1[1]));
                    }
                }
            }
        }
    }
}
DI void hyena_ctx_unit(const Frame& F, int li, int ch) {
    float* vs = (float*)F.lds;
    float* zs = vs + 512;
    float* fl = zs + 512;
    const bf16_t* HYC = WSP(bf16_t, WS_HYC); const float* filt = WSP(float, WS_FILTC);
    const float* sw = F.in[I_HYSW] + (size_t)li * 3 * 768; const float* sb = F.in[I_HYSB] + li * 768; const float* sk = F.in[I_HSKIP] + li * 512;
    const float n0 = hy_norm(WSP(float, WS_FPARTC), 4, 0, ch), n1 = hy_norm(WSP(float, WS_FPARTC), 4, 1, ch);
    const int b = F.tid >> 8, t = F.tid & 255;
    auto sc = [&](int c) -> float { const bf16_t* p = HYC + (size_t)(b * CTX) * 768 + c;
        const float a = t > 0 ? bf2f(p[(size_t)(t - 1) * 768]) : 0.f, d = t + 1 < CTX ? bf2f(p[(size_t)(t + 1) * 768]) : 0.f;
        return a * sw[c] + bf2f(p[(size_t)t * 768]) * sw[768 + c] + d * sw[1536 + c] + sb[c]; };
    __syncthreads();
    const float x1 = sc(ch), x2 = sc(256 + ch), v = sc(512 + ch);
    vs[F.tid] = v;
    for (int i = F.tid; i < 1024; i += NTHR) fl[i] = filt[((size_t)(i >> 8) * 256 + ch) * CTX + (i & 255)];
    __syncthreads();
    float a = 0.f;
    for (int s = 0; s < CTX; ++s) { const int dl = t - s; a += (dl >= 0 ? fl[dl] : fl[256 - dl]) * vs[b * 256 + s]; }
    const float z = x1 * (a * n0 + sk[ch] * v);
    zs[F.tid] = z;
    __syncthreads();
    a = 0.f;
    for (int s = 0; s < CTX; ++s) { const int dl = t - s; a += (dl >= 0 ? fl[512 + dl] : fl[768 - dl]) * zs[b * 256 + s]; }
    WSP(bf16_t, WS_HBF)[((size_t)NLAT + b * CTX + t) * D + 768 + ch] = f2bf(x2 * (a * n1 + sk[256 + ch] * z));
}

DI void phase_mix(const Frame& F0, int li) {
    const Frame& F = F0;
    unsigned* head = F.ctl + CW_QHEAD + li * 64;
    volatile unsigned* qs = (volatile unsigned*)(F.lds + LDS_MISC + 32);
#ifndef PROBE_DA
#define PROBE_DA 1
#endif
#ifndef PROBE_HY
#define PROBE_HY 1
#endif
#ifndef PROBE_NA
#define PROBE_NA 1
#endif
#ifdef PROBE_MISC
#define PROBE_PL 2
#else
#define PROBE_PL 1
#endif
    const int n_ca = (li == 0) ? 8 : 0, n_cb = (li == 0) ? 4 : 0, n_da = 512 * PROBE_DA, n_hy = 256 * PROBE_HY, n_na = 256 * PROBE_NA, n_hc = (li == 0) ? 256 * PROBE_PL : 0, n_pl = 1024 * PROBE_PL, n_pc = (li == 0) ? 16 : 0;
    const int total = n_ca + n_cb + n_da + n_hy + n_na + n_hc + n_pl + n_pc;
    for (;;) {
        __syncthreads();
        if (F.tid == 0) qs[0] = __hip_atomic_fetch_add(head, 1u, __ATOMIC_RELAXED, __HIP_MEMORY_SCOPE_AGENT);
        __syncthreads();
        int u = __builtin_amdgcn_readfirstlane((int)qs[0]);
        if (u >= total) break;
        Frame F = F0; refresh(F);
        if (u < n_ca) {
#ifndef SKIP_CA
            diffattn_unit(F, li, u >> 2, u & 3, (size_t)NLAT + (size_t)(u >> 2) * CTX, CTX / 64);
#endif
            continue; }
        u -= n_ca;
        if (u < n_cb) {
#ifndef SKIP_CB
            ctx_attn_b_unit(F, u);
#endif
            continue; }
        u -= n_cb;
        if (u < n_da) {
#ifndef SKIP_DA
            { const int v = u & 511; diffattn_unit(F, li, v >> 8, (v >> 6) & 3, (size_t)(v >> 8) * S + (size_t)(v & 63) * 256, NKEY / 64); }
#endif
            continue; }
        u -= n_da;
        if (u < n_hy) {
#ifndef SKIP_HY
            hyena_fft_unit(F, li, u & 255);
#endif
            continue; }
        u -= n_hy;
        if (u < n_na) {
#ifndef SKIP_NA
            na_unit(F, li, u & 255);
#endif
            continue; }
        u -= n_na;
        if (u < n_hc) {
#ifndef SKIP_HC
            hyena_ctx_unit(F, li, u & 255);
#endif
            continue; }
        u -= n_hc;
        if (u < n_pl) {
#ifndef SKIP_PL
            { const int v = u & 1023; pool_unit(F, li, (size_t)(v >> 9) * S, S, (v & 511) * 32); }
#endif
            continue; }
        u -= n_pl;
#ifndef SKIP_PL
        pool_unit(F, li, (size_t)NLAT + (u >> 3) * CTX, CTX, (u & 7) * 32);
#endif
    }
}

constexpr int PH_PER_LAYER = 8, NPH = 2 + 2 * PH_PER_LAYER;
__global__ void __launch_bounds__(NTHR, 2) mega(Args args) {
    extern __shared__ __attribute__((aligned(16))) unsigned char smem[];
    Frame F;
    F.in = args.in; F.out = args.out; F.ws = args.ws; F.ctl = (unsigned*)(args.ws + WS_CTL); F.lds = smem;
    F.tid = threadIdx.x; F.lane = F.tid & 63; F.wave = __builtin_amdgcn_readfirstlane(F.tid >> 6); F.G = gridDim.x; F.bid = blockIdx.x;
    if (F.tid < 64) ((unsigned*)(smem + LDS_MISC))[F.tid] = 0u;
    __syncthreads();
    const int lo = args.ph_lo, hi = args.ph_hi;
    const bool fused = (hi - lo) > 1;
    XcdBarrier bar; bar.bar = F.ctl; bar.x = 0; bar.st = (volatile LAS unsigned*)(smem + LDS_MISC);
    if (fused) bar = xcd_barrier_post(F.ctl, (volatile LAS unsigned*)(smem + LDS_MISC));
#define IN(k) (lo <= (k) && (k) < hi)
#ifdef PROBE_BAR
#define SEAM(k) do { if (IN(k) && IN((k) + 1)) { xcd_barrier(bar); xcd_barrier(bar); xcd_barrier(bar); } } while (0)
#else
#define SEAM(k) do { if (IN(k) && IN((k) + 1)) xcd_barrier(bar); } while (0)
#endif
#ifndef SKIP_P0
    if (IN(0)) { refresh(F); phase_prologue(F);
#ifdef PROBE_MISC
        __syncthreads(); refresh(F); phase_prologue(F);
#endif
    }
#endif
    SEAM(0);
    for (int li = 0; li < 2; ++li) {
        const int p0 = 1 + li * PH_PER_LAYER;
        const int nrows = (li == 0) ? NTOK : NLAT;
        if (IN(p0)) {
            refresh(F);
            phase_norm1(F, li, li == 0 ? 0 : 1);
#ifdef PROBE_N1
            if (li == 0) { refresh(F); phase_norm1(F, li, 0); refresh(F); phase_norm1(F, li, 0); refresh(F); phase_norm1(F, li, 0); refresh(F); phase_norm1(F, li, 0); }
#endif
            refresh(F);
#ifndef SKIP_FILT
            for (int t = F.bid; t < 256; t += F.G) filter_tile(F, li, S, t, WSP(float, WS_FILT), WSP(float, WS_FPART));
            if (li == 0) for (int t = F.bid; t < 4; t += F.G) filter_tile(F, li, CTX, t, WSP(float, WS_FILTC), WSP(float, WS_FPARTC));
#ifdef PROBE_MISC
            for (int t = F.bid; t < 256; t += F.G) filter_tile(F, li, S, t, WSP(float, WS_FILT), WSP(float, WS_FPART));
#endif
#endif
        }
        SEAM(p0);
        if (IN(p0 + 1)) {
            refresh(F);
            pg8::Gemm g{WSP(bf16_t, WS_HBF), WSP(bf16_t, WS_WIN) + (size_t)li * DIN * D, D, 0};
            pg8::StaticOrder So; So.init(NTOK, DIN, F.G, F.bid);
            EpiIn E{F.ws, WSP(float, WS_ROPE), F.ctl + CW_KMAX + li * 16};
#ifndef SKIP_G1
            pg8::gemm_phase<EpiIn, pg8::StaticOrder>((LAS unsigned char*)smem, g, So, E, F.tid);
#ifdef PROBE_G1
            __syncthreads(); refresh(F); pg8::gemm_phase<EpiIn, pg8::StaticOrder>((LAS unsigned char*)smem, g, So, E, F.tid);
#endif
#endif
        }
        SEAM(p0 + 1);
        if (IN(p0 + 2)) { refresh(F); phase_mix(F, li); }
        SEAM(p0 + 2);
        if (IN(p0 + 3)) {
            refresh(F);
            pg8::Gemm g{WSP(bf16_t, WS_HBF), WSP(bf16_t, WS_WOUT) + (size_t)li * D * D, D, 0};
            pg8::StaticOrder So; So.init(nrows, D, F.G, F.bid);
            EpiOut E{li == 0 ? F.in[I_X] : F.out, li == 0 ? F.in[I_CTX] : WSP(float, WS_XC), F.out, WSP(float, WS_XC), WSP(float, WS_MOD) + (size_t)li * 3 * 6144};
#ifndef SKIP_G2
            pg8::gemm_phase<EpiOut, pg8::StaticOrder>((LAS unsigned char*)smem, g, So, E, F.tid);
#endif
        }
        SEAM(p0 + 3);
#ifndef SKIP_N2
        if (IN(p0 + 4)) { refresh(F); phase_norm2(F, li, nrows); }
#endif
        SEAM(p0 + 4);
        if (IN(p0 + 5)) { refresh(F); phase_gather(F, li, nrows);
#ifdef PROBE_MISC
            __syncthreads(); refresh(F); phase_gather(F, li, nrows);
#endif
        }
        SEAM(p0 + 5);
        if (IN(p0 + 6)) {
            refresh(F);
            int* offs = (int*)(smem + LDS_MISC + 64);
            moe_offsets(F, li, offs);
            pg8::Gemm g{WSP(bf16_t, WS_A1), WSP(bf16_t, WS_W13) + (size_t)li * NE * 1024 * 1024, D, (size_t)1024 * 1024};
            pg8::MoeOrder Mo{offs + 40, offs[17 + 16], 4, F.G, F.bid};
            EpiMoe1 E{WSP(bf16_t, WS_HMID)};
#ifndef SKIP_G3
            pg8::gemm_phase<EpiMoe1, pg8::MoeOrder>((LAS unsigned char*)smem, g, Mo, E, F.tid);
#ifdef PROBE_G3
            __syncthreads(); refresh(F); pg8::gemm_phase<EpiMoe1, pg8::MoeOrder>((LAS unsigned char*)smem, g, Mo, E, F.tid);
#endif
#endif
        }
        SEAM(p0 + 6);
        if (IN(p0 + 7)) {
            refresh(F);
            int* offs = (int*)(smem + LDS_MISC + 64);
            moe_offsets(F, li, offs);
            pg8::Gemm g{WSP(bf16_t, WS_HMID), WSP(bf16_t, WS_W2) + (size_t)li * NE * 1024 * 512, DE, (size_t)1024 * 512};
            pg8::MoeOrder Mo{offs + 40, offs[17 + 16], 4, F.G, F.bid};
            EpiMoe2 E{WSP(bf16_t, WS_A1)};
#ifndef SKIP_G4
            pg8::gemm_phase<EpiMoe2, pg8::MoeOrder>((LAS unsigned char*)smem, g, Mo, E, F.tid);
#ifdef PROBE_G4
            __syncthreads(); refresh(F); pg8::gemm_phase<EpiMoe2, pg8::MoeOrder>((LAS unsigned char*)smem, g, Mo, E, F.tid);
#endif
#endif
        }
        SEAM(p0 + 7);
    }
    if (IN(NPH - 1)) { refresh(F); phase_norm1(F, 1, 2); }
#undef IN
#undef SEAM
}

extern "C" void kernel_launch(void* const* d_in, const int* in_sizes, int n_in, void* d_out, int out_size, void* d_ws, size_t ws_size, hipStream_t stream) {
    static int grid = 0;
    if (grid == 0) {
        if (n_in != N_IN || out_size != NLAT * D || ws_size < WS_END) { fprintf(stderr, "kernel_launch: unexpected shapes (n_in %d out %d ws %zu need %zu)\n", n_in, out_size, ws_size, (size_t)WS_END); grid = -1; return; }
        int dev = 0, cus = 0, per_cu = 0;
        if (hipGetDevice(&dev) != hipSuccess || hipDeviceGetAttribute(&cus, hipDeviceAttributeMultiprocessorCount, dev) != hipSuccess) { grid = -1; return; }
        if (hipFuncSetAttribute((const void*)mega, hipFuncAttributeMaxDynamicSharedMemorySize, LDS_BYTES) != hipSuccess) { fprintf(stderr, "kernel_launch: hipFuncSetAttribute failed\n"); grid = -1; return; }
        if (hipOccupancyMaxActiveBlocksPerMultiprocessor(&per_cu, (const void*)mega, NTHR, LDS_BYTES) != hipSuccess || per_cu < 1) { fprintf(stderr, "kernel_launch: occupancy query says %d\n", per_cu); }
        (void)hipGetLastError();
        grid = cus < MAXG ? cus : MAXG;
    }
    if (grid < 0) return;
    (void)hipMemsetAsync((char*)d_ws + WS_CTL, 0, CTL_BYTES, stream);
    Args a{};
    for (int i = 0; i < N_IN; ++i) a.in[i] = (const float*)d_in[i];
    a.out = (float*)d_out; a.ws = (unsigned char*)d_ws;
#if N_LAUNCH_MODE == 1
    a.ph_lo = 0; a.ph_hi = NPH;
    hipLaunchKernelGGL(mega, dim3(grid), dim3(NTHR), LDS_BYTES, stream, a);
#else
    for (int p = 0; p < NPH; ++p) { a.ph_lo = p; a.ph_hi = p + 1; hipLaunchKernelGGL(mega, dim3(grid), dim3(NTHR), LDS_BYTES, stream, a); }
#endif
}
#ifdef TEST_UNITS
__global__ void __launch_bounds__(NTHR, 2) t_da(Args args) {
    extern __shared__ __attribute__((aligned(16))) unsigned char smem[];
    Frame F; F.in = args.in; F.out = args.out; F.ws = args.ws; F.ctl = (unsigned*)(args.ws + WS_CTL); F.lds = smem; F.G = gridDim.x; F.bid = blockIdx.x; refresh(F);
    diffattn_unit(F, args.ph_lo, blockIdx.x >> 8, (blockIdx.x >> 6) & 3, (size_t)(blockIdx.x & 63) * 256, NKEY / 64);
}
__global__ void __launch_bounds__(NTHR, 2) t_hy(Args args) {
    extern __shared__ __attribute__((aligned(16))) unsigned char smem[];
    Frame F; F.in = args.in; F.out = args.out; F.ws = args.ws; F.ctl = (unsigned*)(args.ws + WS_CTL); F.lds = smem; F.G = gridDim.x; F.bid = blockIdx.x; refresh(F);
    hyena_fft_unit(F, args.ph_lo, blockIdx.x);
}
#endif
```

```cpp
#include <hip/hip_runtime.h>
#include <stdint.h>
#include <stdio.h>

#ifndef N_LAUNCH_MODE
#define N_LAUNCH_MODE 1
#endif

#define DI __device__ __forceinline__
#define LAS __attribute__((address_space(3)))
typedef unsigned short bf16_t;
typedef short bf16x8 __attribute__((ext_vector_type(8)));
typedef short s16x4 __attribute__((ext_vector_type(4)));
typedef float f32x4 __attribute__((ext_vector_type(4)));
typedef float f32x2 __attribute__((ext_vector_type(2)));
typedef float f32x16 __attribute__((ext_vector_type(16)));
typedef unsigned u32x4 __attribute__((ext_vector_type(4)));
typedef unsigned u32x2 __attribute__((ext_vector_type(2)));
typedef _Float16 h16x2 __attribute__((ext_vector_type(2)));

constexpr int D = 1024, NB = 2, S = 16384, CTX = 256, NLAT = NB * S, NCTX = NB * CTX, NTOK = NLAT + NCTX, DIN = 2560;
constexpr int NE = 16, DE = 512, GW = 64;
constexpr int NKEY = CTX + S;
constexpr int NTHR = 512;
constexpr int SLOT_CAP = 70656;
constexpr float EPS = 1e-6f;
constexpr float LOG2E = 1.4426950408889634f;
constexpr float QSCALE_A = 0.17677669529663687f * LOG2E;
constexpr float QSCALE_B = 0.125f * LOG2E;

enum { I_X = 0, I_C, I_CTX, I_CCTX, I_N1G, I_N2G, I_ADAW, I_ADAB, I_WIN, I_WOUT, I_ALAM, I_ASUB, I_RPB, I_POOLW, I_POOLS, I_HYSW, I_HYSB,
       I_HW1, I_HB1, I_HW2, I_HB2, I_HW3, I_HB3, I_HSKIP, I_RW, I_RB, I_MW1, I_MW3, I_MW2, I_FG, N_IN };

struct Args { const float* in[N_IN]; float* out; unsigned char* ws; int ph_lo, ph_hi; };

constexpr size_t al256(size_t x) { return (x + 255) & ~(size_t)255; }
constexpr size_t WS_CTL = 0, CTL_BYTES = 65536;
constexpr size_t WS_MOD = WS_CTL + CTL_BYTES;
constexpr size_t WS_ROPE = WS_MOD + al256(2 * 3 * 6144 * 4);
constexpr size_t WS_FPART = WS_ROPE + 16384;
constexpr size_t WS_FPARTC = WS_FPART + 256 * 1024 * 4;
constexpr size_t WS_XC = WS_FPARTC + 4 * 1024 * 4;
constexpr size_t WS_WIN = WS_XC + (size_t)NCTX * D * 4;
constexpr size_t WS_WOUT = WS_WIN + (size_t)2 * DIN * D * 2;
constexpr size_t WS_W13 = WS_WOUT + (size_t)2 * D * D * 2;
constexpr size_t WS_W2 = WS_W13 + (size_t)2 * NE * 1024 * 1024 * 2;
constexpr size_t WS_FILT = WS_W2 + (size_t)2 * NE * 1024 * 512 * 2;
constexpr size_t WS_FILTC = WS_FILT + (size_t)4 * 256 * S * 4;
constexpr size_t WS_ZBUF = WS_FILTC + (size_t)4 * 256 * 256 * 4;
constexpr size_t WS_R1 = WS_ZBUF + (size_t)256 * 2 * S * 4;
constexpr size_t WS_HBF = WS_R1;
constexpr size_t TOKB = (size_t)NTOK * 256 * 2;
constexpr size_t WS_AQ = WS_HBF + (size_t)NTOK * D * 2;
constexpr size_t WS_AK = WS_AQ + TOKB;
constexpr size_t WS_AVT = WS_AK + TOKB;
constexpr size_t WS_BQ = WS_AVT + (size_t)NB * 4 * 64 * NKEY * 2;
constexpr size_t WS_BK = WS_BQ + TOKB;
constexpr size_t WS_BVT = WS_BK + TOKB;
constexpr size_t WS_PL = WS_BVT + (size_t)NB * 4 * 64 * NKEY * 2;
constexpr size_t WS_HYT = WS_PL + TOKB;
constexpr size_t WS_HYC = WS_HYT + (size_t)NB * 768 * S * 2;
constexpr size_t WS_Z1BUF = WS_HYC + (size_t)NCTX * 768 * 2;
constexpr size_t WS_END_MIX = WS_Z1BUF + (size_t)256 * S * 8;
constexpr size_t WS_TOK = WS_AQ;
constexpr size_t WS_A1 = WS_TOK + al256((size_t)NTOK * 32);
constexpr size_t WS_HMID = WS_A1 + (size_t)SLOT_CAP * D * 2;
constexpr size_t WS_END_MOE = WS_HMID + (size_t)SLOT_CAP * DE * 2;
constexpr size_t WS_END = WS_END_MIX > WS_END_MOE ? WS_END_MIX : WS_END_MOE;

#define XB_TMO      128
#define XB_XCNT(j)  (256  + 64 * (j))
#define XB_XSUB(j)  (1280 + 64 * (j))
#define XB_XGEN(j)  (2304 + 64 * (j))
#define XB_TOP      3328
#define XB_TOPGEN   3392
#define XCD_BAR_WORDS 3456
#define XB_SPIN_CAP (1u << 18)
constexpr int CW_CNT = 4096;
constexpr int CW_KMAX = 4160;
constexpr int CW_KMAXB = 4192;
constexpr int CW_QHEAD = 4224;
constexpr int CW_BCNT = 4352;
constexpr int MAXG = 256;

constexpr int LDS_MAIN = 143360, LDS_MISC = LDS_MAIN, LDS_BYTES = LDS_MAIN + 2048;

DI float bf2f(bf16_t v) { return __uint_as_float(((unsigned)v) << 16); }
DI bf16_t f2bf(float f) { unsigned u = __float_as_uint(f); u += 0x7FFFu + ((u >> 16) & 1u); return (bf16_t)(u >> 16); }
DI unsigned pk2(float lo, float hi) { unsigned r; asm volatile("v_cvt_pk_bf16_f32 %0, %1, %2" : "=v"(r) : "v"(lo), "v"(hi)); return r; }
template <int K> DI float swz_xor(float v) { return __int_as_float(__builtin_amdgcn_ds_swizzle(__float_as_int(v), (K << 10) | 0x1F)); }
DI float half_sum(float v) { const auto r = __builtin_amdgcn_permlane32_swap(__float_as_uint(v), __float_as_uint(v), false, false); return __uint_as_float(r[0]) + __uint_as_float(r[1]); }
DI float half_max(float v) { const auto r = __builtin_amdgcn_permlane32_swap(__float_as_uint(v), __float_as_uint(v), false, false); return fmaxf(__uint_as_float(r[0]), __uint_as_float(r[1])); }
DI float wave_sum(float v) { v += swz_xor<16>(v); v += swz_xor<8>(v); v += swz_xor<4>(v); v += swz_xor<2>(v); v += swz_xor<1>(v); return half_sum(v); }
DI float wave_max(float v) { v = fmaxf(v, swz_xor<16>(v)); v = fmaxf(v, swz_xor<8>(v)); v = fmaxf(v, swz_xor<4>(v)); v = fmaxf(v, swz_xor<2>(v)); v = fmaxf(v, swz_xor<1>(v)); return half_max(v); }
DI float siluf(float x) { return x / (1.f + __expf(-x)); }
DI float sin_rev(float rev) { return __builtin_amdgcn_sinf(rev - floorf(rev)); }
DI float cos_rev(float rev) { return __builtin_amdgcn_cosf(rev - floorf(rev)); }
DI float sin_rad(float x) { return sin_rev(x * 0.15915494309189535f); }

DI unsigned xb_ld(unsigned* p)              { return __hip_atomic_load(p, __ATOMIC_RELAXED, __HIP_MEMORY_SCOPE_AGENT); }
DI unsigned xb_add(unsigned* p, unsigned v) { return __hip_atomic_fetch_add(p, v, __ATOMIC_RELAXED, __HIP_MEMORY_SCOPE_AGENT); }
DI unsigned xb_xcc_id() { return (unsigned)__builtin_amdgcn_s_getreg((3 << 11) | 20) & 0xFu; }
#define XB_SPIN(cond, bar) do { unsigned _sp = 0; while (cond) { __builtin_amdgcn_s_sleep(1); \
    if ((++_sp & 255u) == 0u) { if (xb_ld(&(bar)[XB_TMO])) break; if (_sp > XB_SPIN_CAP) { atomicAdd(&(bar)[XB_TMO], 1u); break; } } } } while (0)
struct XcdBarrier { unsigned* bar; unsigned x; volatile LAS unsigned* st; };
DI XcdBarrier xcd_barrier_post(unsigned* bar, volatile LAS unsigned* st) {
    XcdBarrier b; b.bar = bar; b.x = xb_xcc_id(); b.st = st;
    if (threadIdx.x == 0) (void)xb_add(&bar[XB_XCNT(b.x)], 1u);
    return b;
}
DI void xcd_barrier_complete(unsigned* bar, unsigned x, unsigned& nloc, unsigned& nx) {
    const unsigned G = gridDim.x * gridDim.y * gridDim.z;
    unsigned sum, cnt, mine, sp = 0u;
    for (;;) {
        sum = 0u; cnt = 0u; mine = 0u;
#pragma unroll
        for (unsigned j = 0; j < 16; ++j) { const unsigned c = xb_ld(&bar[XB_XCNT(j)]); sum += c; cnt += (c > 0u) ? 1u : 0u; mine = (j == x) ? c : mine; }
        if (sum == G) break;
        __builtin_amdgcn_s_sleep(1);
        if ((++sp & 255u) == 0u) { if (xb_ld(&bar[XB_TMO])) break; if (sp > XB_SPIN_CAP) { atomicAdd(&bar[XB_TMO], 1u); break; } }
    }
    nloc = mine > 0u ? mine : 1u; nx = cnt > 0u ? cnt : 1u;
}
DI void xcd_barrier(const XcdBarrier& b) {
    asm volatile("s_waitcnt vmcnt(0)" ::: "memory");
    __syncthreads();
    if (threadIdx.x == 0) {
        unsigned* bar = b.bar;
        __builtin_amdgcn_s_waitcnt(0);
        unsigned nloc = b.st[0], nx = b.st[1];
        if (nloc == 0u) { xcd_barrier_complete(bar, b.x, nloc, nx); b.st[0] = nloc; b.st[1] = nx; }
        const unsigned old = xb_add(&bar[XB_XSUB(b.x)], 1u);
        const unsigned gen = old / nloc;
        if (old + 1u == (gen + 1u) * nloc) {
            __builtin_amdgcn_fence(__ATOMIC_RELEASE, "agent");
            asm volatile("s_waitcnt vmcnt(0)" ::: "memory");
            const unsigned og = xb_add(&bar[XB_TOP], 1u);
            const unsigned tg = og / nx;
            if (og + 1u == (tg + 1u) * nx) xb_add(&bar[XB_TOPGEN], 1u);
            else XB_SPIN(xb_ld(&bar[XB_TOPGEN]) == tg, bar);
            __builtin_amdgcn_fence(__ATOMIC_ACQUIRE, "agent");
            xb_add(&bar[XB_XGEN(b.x)], 1u);
            asm volatile("s_waitcnt vmcnt(0)" ::: "memory");
        } else {
            XB_SPIN(xb_ld(&bar[XB_XGEN(b.x)]) == gen, bar);
            __builtin_amdgcn_fence(__ATOMIC_ACQUIRE, "agent");
            asm volatile("s_waitcnt vmcnt(0)" ::: "memory");
        }
    }
    __syncthreads();
}

struct Frame {
    const float* const* in; float* out; unsigned char* ws; unsigned* ctl;
    unsigned char* lds;
    int tid, lane, wave, G, bid;
};
#define WSP(T, off) ((T*)(F.ws + (off)))
DI void refresh(Frame& F) { int t = threadIdx.x; asm volatile("" : "+v"(t)); F.tid = t; F.lane = t & 63; F.wave = __builtin_amdgcn_readfirstlane(t >> 6);
}

namespace pg8 {
constexpr int BM = 256, BK = 64, HALF = 128, HTB = HALF * BK * 2, STAGE_BYTES = 8 * HTB, NXCD = 8, WGM = 8;
DI int lds_byte(int r, int c) { const int st = (r >> 4) * 2 + (c >> 5), rr = r & 15, cc = c & 31, ob = rr * 64 + cc * 2; return st * 1024 + (ob ^ (((ob >> 9) & 1) << 5)); }
DI void stage_rc(int b, int& R, int& C) { const int st = b / 1024, sb = b % 1024, swz = sb ^ (((sb >> 9) & 1) << 5); R = (st >> 1) * 16 + swz / 64; C = (st & 1) * 32 + (swz % 64) / 2; }
struct Unit { int pm, pn, e; };
struct Gemm { const bf16_t* A; const bf16_t* Bt; int K; size_t bstride; };
struct StaticOrder {
    int nM, nN, nwg, G, c;
    DI void init(int M, int N, int G_, int c_) { nM = M / BM; nN = N / BM; nwg = nM * nN; G = G_; c = c_; }
    DI bool next(int i, Unit& u) const {
        const long L = (long)i * G + c; if (L >= nwg) return false;
        int wgid = (int)L; { const int q = nwg / NXCD, r = nwg % NXCD, xcd = wgid % NXCD, off = wgid / NXCD; wgid = (xcd < r ? xcd * (q + 1) : r * (q + 1) + (xcd - r) * q) + off; }
        const int nig = WGM * nN, gid = wgid / nig, fm = gid * WGM, gsz = (nM - fm) < WGM ? (nM - fm) : WGM;
        u.pm = fm + ((wgid % nig) % gsz); u.pn = (wgid % nig) / gsz; u.e = 0; return true;
    }
};
struct MoeOrder {
    const int* toff; int ntile, nN, G, c;
    DI bool next(int i, Unit& u) const {
        const long L = (long)i * G + c; if (L >= (long)ntile * nN) return false;
        const int t = (int)(L / nN); u.pm = t; u.pn = (int)(L % nN);
        u.e = toff[t]; return true;
    }
};

template <class Epi, class Sched>
DI void gemm_phase(LAS unsigned char* lds, const Gemm g, const Sched& S, const Epi& E, int tid) {
    const int wid = __builtin_amdgcn_readfirstlane(tid >> 6), lane = tid & 63, wr = wid >> 2, wc = wid & 3, fr = lane & 15, fq = lane >> 4;
    const int K = g.K, nt = K / BK;
    unsigned voffA[2];
#pragma unroll
    for (int i = 0; i < 2; ++i) { int R, C; stage_rc(tid * 16 + i * 8192, R, C); voffA[i] = (unsigned)(R * K + C) * 2u; }
    const size_t kstep = (size_t)(BK * 2);
    const size_t hstep = (size_t)HALF * K * 2;
    const size_t tstep = 2 * hstep;
    const unsigned ldsw = (unsigned)wid * 1024u;
    const int aoff = lds_byte(wr * 64 + fr, fq * 8), boff = lds_byte(wc * 32 + fr, fq * 8);
#define PG8_SA(b, h) (((b) * 2 + (h)) * HTB)
#define PG8_SB(b, h) ((4 + (b) * 2 + (h)) * HTB)
#define PG8_STAGE(bufoff, gbase, voff) do { _Pragma("unroll") for (int _i = 0; _i < 2; ++_i) \
        __builtin_amdgcn_global_load_lds((const unsigned*)((const char*)(gbase) + (voff)[_i]), (LAS unsigned*)(lds + (bufoff) + ldsw + _i * 8192), 16, 0, 0); } while (0)
#define PG8_LDA(dst, b, h) do { _Pragma("unroll") for (int m = 0; m < 4; ++m) _Pragma("unroll") for (int k = 0; k < 2; ++k) dst[m][k] = *(const LAS bf16x8*)(lds + PG8_SA(b, h) + aoff + m * 2048 + k * 1024); } while (0)
#define PG8_LDB(dst, b, h) do { _Pragma("unroll") for (int n = 0; n < 2; ++n) _Pragma("unroll") for (int k = 0; k < 2; ++k) dst[n][k] = *(const LAS bf16x8*)(lds + PG8_SB(b, h) + boff + n * 2048 + k * 1024); } while (0)
#define PG8_MMA(ai, bj, At, Bt) do { __builtin_amdgcn_s_setprio(1); _Pragma("unroll") for (int m = 0; m < 4; ++m) _Pragma("unroll") for (int n = 0; n < 2; ++n) _Pragma("unroll") for (int k = 0; k < 2; ++k) \
        acc[ai][bj][m][n] = __builtin_amdgcn_mfma_f32_16x16x32_bf16(Bt[n][k], At[m][k], acc[ai][bj][m][n], 0, 0, 0); __builtin_amdgcn_s_setprio(0); } while (0)
#define PG8_WAIT_V(n) asm volatile("s_waitcnt vmcnt(" #n ")" ::: "memory")
#define PG8_WAIT_L(n) asm volatile("s_waitcnt lgkmcnt(" #n ")" ::: "memory")
#define PG8_BAR __builtin_amdgcn_s_barrier()
#define PG8_SCHED __builtin_amdgcn_sched_barrier(0)
    Unit cur, nxt; int ui = 0;
    if (!S.next(0, cur)) return;
    f32x4 acc[2][2][4][2];
#pragma unroll
    for (int a = 0; a < 2; ++a)
#pragma unroll
        for (int b = 0; b < 2; ++b)
#pragma unroll
            for (int m = 0; m < 4; ++m)
#pragma unroll
                for (int n = 0; n < 2; ++n) acc[a][b][m][n] = (f32x4){0.f, 0.f, 0.f, 0.f};
    bf16x8 At[4][2], B0[2][2], B1[2][2];
    const char* cA = (const char*)g.A + (size_t)cur.pm * tstep; const char* cB = (const char*)(g.Bt + (size_t)cur.e * g.bstride) + (size_t)cur.pn * tstep;
    PG8_STAGE(PG8_SB(0, 0), cB, voffA); PG8_STAGE(PG8_SA(0, 0), cA, voffA); PG8_STAGE(PG8_SB(0, 1), cB + hstep, voffA); PG8_STAGE(PG8_SA(0, 1), cA + hstep, voffA);
    if (wr == 1) PG8_BAR;
    PG8_WAIT_V(4); PG8_BAR;
    PG8_STAGE(PG8_SB(1, 0), cB + kstep, voffA); PG8_STAGE(PG8_SA(1, 0), cA + kstep, voffA); PG8_STAGE(PG8_SB(1, 1), cB + hstep + kstep, voffA);
    PG8_WAIT_V(6); PG8_BAR;
    for (;;) {
        const bool has_next = S.next(ui + 1, nxt);
        const char* nA = has_next ? (const char*)g.A + (size_t)nxt.pm * tstep : cA; const char* nB = has_next ? (const char*)(g.Bt + (size_t)nxt.e * g.bstride) + (size_t)nxt.pn * tstep : cB;
        for (int t = 0; t < nt; t += 2) {
            const bool last = (t == nt - 2);
            const char* a1 = cA + (size_t)(t + 1) * kstep;
            const char* a2 = last ? nA : cA + (size_t)(t + 2) * kstep; const char* b2 = last ? nB : cB + (size_t)(t + 2) * kstep;
            const char* a3 = a2 + kstep; const char* b3 = b2 + kstep;
            PG8_LDB(B0, 0, 0); PG8_SCHED; PG8_LDA(At, 0, 0); PG8_STAGE(PG8_SA(1, 1), a1 + hstep, voffA);
            PG8_WAIT_L(8); PG8_BAR; PG8_WAIT_L(0); PG8_MMA(0, 0, At, B0); PG8_BAR; PG8_SCHED;
            PG8_LDB(B1, 0, 1); PG8_STAGE(PG8_SB(0, 0), b2, voffA);
            PG8_BAR; PG8_WAIT_L(0); PG8_MMA(0, 1, At, B1); PG8_BAR;
            PG8_LDA(At, 0, 1); PG8_STAGE(PG8_SA(0, 0), a2, voffA);
            PG8_BAR; PG8_WAIT_L(0); PG8_MMA(1, 0, At, B0); PG8_BAR; PG8_SCHED;
            PG8_STAGE(PG8_SB(0, 1), b2 + hstep, voffA);
            PG8_WAIT_V(6); PG8_BAR; PG8_MMA(1, 1, At, B1); PG8_BAR;
            PG8_LDB(B0, 1, 0); PG8_SCHED; PG8_LDA(At, 1, 0); PG8_STAGE(PG8_SA(0, 1), a2 + hstep, voffA);
            PG8_WAIT_L(8); PG8_BAR; PG8_WAIT_L(0); PG8_MMA(0, 0, At, B0); PG8_BAR; PG8_SCHED;
            PG8_LDB(B1, 1, 1); PG8_STAGE(PG8_SB(1, 0), b3, voffA);
            PG8_BAR; PG8_WAIT_L(0); PG8_MMA(0, 1, At, B1); PG8_BAR;
            PG8_LDA(At, 1, 1); PG8_STAGE(PG8_SA(1, 0), a3, voffA);
            PG8_BAR; PG8_WAIT_L(0); PG8_MMA(1, 0, At, B0); PG8_BAR; PG8_SCHED;
            PG8_STAGE(PG8_SB(1, 1), b3 + hstep, voffA);
            PG8_WAIT_V(6); PG8_BAR; PG8_MMA(1, 1, At, B1); PG8_BAR;
        }
        E(acc, cur, wr, wc, fr, fq);
        if (!has_next) break;
#pragma unroll
        for (int a = 0; a < 2; ++a)
#pragma unroll
            for (int b = 0; b < 2; ++b)
#pragma unroll
                for (int m = 0; m < 4; ++m)
#pragma unroll
                    for (int n = 0; n < 2; ++n) acc[a][b][m][n] = (f32x4){0.f, 0.f, 0.f, 0.f};
        cur = nxt; cA = nA; cB = nB; ++ui;
    }
    PG8_WAIT_V(0);
    if (wr == 0) PG8_BAR;
    PG8_BAR;
#undef PG8_SA
#undef PG8_SB
#undef PG8_STAGE
#undef PG8_LDA
#undef PG8_LDB
#undef PG8_MMA
#undef PG8_WAIT_V
#undef PG8_WAIT_L
#undef PG8_BAR
#undef PG8_SCHED
}
}

typedef f32x4 AccT[2][2][4][2];

struct EpiIn {
    unsigned char* ws; const float* rope; unsigned* kmax; unsigned* kmaxb;
    DI void operator()(const AccT& acc, const pg8::Unit& u, int wr, int wc, int fr, int fq) const {
        const int pn = u.pn, row0 = u.pm * 256 + wr * 64 + fr;
        const bool isctx = (u.pm >= NLAT / 256);
        if (pn <= 1) {
            bf16_t* dst = (bf16_t*)(ws + (pn == 0 ? WS_AQ : WS_AK));
            const float sc = (pn == 0) ? QSCALE_A : 1.f;
            float nmax[2] = {0.f, 0.f};
#pragma unroll
            for (int ai = 0; ai < 2; ++ai)
#pragma unroll
                for (int m = 0; m < 4; ++m) {
                    const int r = row0 + ai * 128 + m * 16;
                    f32x4 cs0 = (f32x4){1.f, 0.f, 1.f, 0.f}, cs1 = cs0;
                    if (!isctx) { const int t = r & (S - 1); const int pos = (fq < 2) ? (t >> 6) : (t & 63);
                        const f32x4* tp = (const f32x4*)(rope + (size_t)pos * 16 + (fq & 1) * 8); cs0 = tp[0]; cs1 = tp[1]; }
                    const float cc[4] = {cs0[0], cs0[2], cs1[0], cs1[2]}, ss[4] = {cs0[1], cs0[3], cs1[1], cs1[3]};
#pragma unroll
                    for (int bj = 0; bj < 2; ++bj) {
                        const f32x4 x1 = acc[ai][bj][m][0], x2 = acc[ai][bj][m][1];
                        float o1[4], o2[4], n2 = 0.f;
#pragma unroll
                        for (int j = 0; j < 4; ++j) { o1[j] = (x1[j] * cc[j] - x2[j] * ss[j]) * sc; o2[j] = (x2[j] * cc[j] + x1[j] * ss[j]) * sc; n2 += x1[j] * x1[j] + x2[j] * x2[j]; }
                        bf16_t* p = dst + (size_t)r * 256 + bj * 128 + wc * 32 + 4 * fq;
                        *(u32x2*)p = (u32x2){pk2(o1[0], o1[1]), pk2(o1[2], o1[3])};
                        *(u32x2*)(p + 16) = (u32x2){pk2(o2[0], o2[1]), pk2(o2[2], o2[3])};
                        if (pn == 1) { n2 += swz_xor<16>(n2); n2 = half_sum(n2); nmax[bj] = fmaxf(nmax[bj], n2); }
                    }
                }
            if (pn == 1) {
                const int b = isctx ? (u.pm - NLAT / 256) : (u.pm / (S / 256));
#pragma unroll
                for (int bj = 0; bj < 2; ++bj) {
                    float v = nmax[bj];
                    v = fmaxf(v, swz_xor<1>(v)); v = fmaxf(v, swz_xor<2>(v)); v = fmaxf(v, swz_xor<4>(v)); v = fmaxf(v, swz_xor<8>(v));
                    if ((fr | fq) == 0) atomicMax(kmax + (b * 4 + (2 * bj + (wc >> 1))) * 2 + (wc & 1), __float_as_uint(v));
                }
            }
        } else if (pn == 2 || pn == 5) {
            bf16_t* dst = (bf16_t*)(ws + (pn == 2 ? WS_AVT : WS_BVT));
#pragma unroll
            for (int ai = 0; ai < 2; ++ai)
#pragma unroll
                for (int m = 0; m < 4; ++m) {
                    const int r = row0 + ai * 128 + m * 16;
                    int b, key; if (isctx) { b = (r - NLAT) >> 8; key = (r - NLAT) & 255; } else { b = r >> 14; key = CTX + (r & (S - 1)); }
#pragma unroll
                    for (int bj = 0; bj < 2; ++bj)
#pragma unroll
                        for (int n = 0; n < 2; ++n) {
                            const int lc = bj * 128 + wc * 32 + n * 16 + 4 * fq;
#pragma unroll
                            for (int j = 0; j < 4; ++j) dst[((size_t)(b * 256 + lc + j)) * NKEY + key] = f2bf(acc[ai][bj][m][n][j]);
                        }
                }
        } else if (pn <= 6) {
            bf16_t* dst = (bf16_t*)(ws + (pn == 3 ? WS_BQ : pn == 4 ? WS_BK : WS_PL));
            const float sc = (pn == 3) ? QSCALE_B : 1.f;
            float nmax[2] = {0.f, 0.f};
#pragma unroll
            for (int ai = 0; ai < 2; ++ai)
#pragma unroll
                for (int m = 0; m < 4; ++m) {
                    const int r = row0 + ai * 128 + m * 16;
#pragma unroll
                    for (int bj = 0; bj < 2; ++bj)
#pragma unroll
                        for (int n = 0; n < 2; ++n) {
                            const f32x4 v = acc[ai][bj][m][n] * sc;
                            *(u32x2*)(dst + (size_t)r * 256 + bj * 128 + wc * 32 + n * 16 + 4 * fq) = (u32x2){pk2(v[0], v[1]), pk2(v[2], v[3])};
                        }
                    if (pn == 4) {
#pragma unroll
                        for (int bj = 0; bj < 2; ++bj) { const f32x4 x1 = acc[ai][bj][m][0], x2 = acc[ai][bj][m][1];
                            float n2 = x1[0] * x1[0] + x1[1] * x1[1] + x1[2] * x1[2] + x1[3] * x1[3] + x2[0] * x2[0] + x2[1] * x2[1] + x2[2] * x2[2] + x2[3] * x2[3];
                            n2 += swz_xor<16>(n2); n2 = half_sum(n2); nmax[bj] = fmaxf(nmax[bj], n2); }
                    }
                }
            if (pn == 4) {
                const int b = isctx ? (u.pm - NLAT / 256) : (u.pm / (S / 256));
#pragma unroll
                for (int bj = 0; bj < 2; ++bj) {
                    float v = nmax[bj];
                    v = fmaxf(v, swz_xor<1>(v)); v = fmaxf(v, swz_xor<2>(v)); v = fmaxf(v, swz_xor<4>(v)); v = fmaxf(v, swz_xor<8>(v));
                    if ((fr | fq) == 0) atomicMax(kmaxb + (b * 4 + (2 * bj + (wc >> 1))) * 2 + (wc & 1), __float_as_uint(v));
                }
            }
        } else {
            const int hc0 = (pn - 7) * 256;
#pragma unroll
            for (int ai = 0; ai < 2; ++ai)
#pragma unroll
                for (int m = 0; m < 4; ++m) {
                    const int r = row0 + ai * 128 + m * 16;
#pragma unroll
                    for (int bj = 0; bj < 2; ++bj)
#pragma unroll
                        for (int n = 0; n < 2; ++n) {
                            const int hc = hc0 + bj * 128 + wc * 32 + n * 16 + 4 * fq; const f32x4 v = acc[ai][bj][m][n];
                            if (isctx) *(u32x2*)((bf16_t*)(ws + WS_HYC) + (size_t)(r - NLAT) * 768 + hc) = (u32x2){pk2(v[0], v[1]), pk2(v[2], v[3])};
                            else { bf16_t* dst = (bf16_t*)(ws + WS_HYT) + ((size_t)(r >> 14) * 768 + hc) * S + (r & (S - 1));
#pragma unroll
                                for (int j = 0; j < 4; ++j) dst[(size_t)j * S] = f2bf(v[j]); }
                        }
                }
        }
    }
};

struct EpiOut {
    const float* xl_old; const float* xc_old; float* xl_new; float* xc_new; const float* mod;
    DI void operator()(const AccT& acc, const pg8::Unit& u, int wr, int wc, int fr, int fq) const {
        const int row0 = u.pm * 256 + wr * 64 + fr; const bool isctx = (u.pm >= NLAT / 256);
        const int v = isctx ? 2 : (u.pm / (S / 256));
        const float* g1 = mod + (size_t)v * 6144 + 2 * 1024;
        const float* so = isctx ? xc_old - (size_t)NLAT * D : xl_old; float* dn = isctx ? xc_new - (size_t)NLAT * D : xl_new;
#pragma unroll
        for (int bj = 0; bj < 2; ++bj)
#pragma unroll
            for (int n = 0; n < 2; ++n) {
                const int c = u.pn * 256 + bj * 128 + wc * 32 + n * 16 + 4 * fq;
                const f32x4 g = *(const f32x4*)(g1 + c);
#pragma unroll
                for (int ai = 0; ai < 2; ++ai)
#pragma unroll
                    for (int m = 0; m < 4; ++m) {
                        const size_t o = (size_t)(row0 + ai * 128 + m * 16) * D + c;
                        *(f32x4*)(dn + o) = *(const f32x4*)(so + o) + g * acc[ai][bj][m][n];
                    }
            }
    }
};

struct EpiMoe1 {
    bf16_t* hmid;
    DI void operator()(const AccT& acc, const pg8::Unit& u, int wr, int wc, int fr, int fq) const {
        const int row0 = u.pm * 256 + wr * 64 + fr;
#pragma unroll
        for (int ai = 0; ai < 2; ++ai)
#pragma unroll
            for (int m = 0; m < 4; ++m)
#pragma unroll
                for (int bj = 0; bj < 2; ++bj) {
                    const f32x4 a = acc[ai][bj][m][0], b = acc[ai][bj][m][1]; float h[4];
#pragma unroll
                    for (int j = 0; j < 4; ++j) h[j] = siluf(a[j]) * b[j];
                    *(u32x2*)(hmid + (size_t)(row0 + ai * 128 + m * 16) * DE + (u.pn * 256 + bj * 128 + wc * 32) / 2 + 4 * fq) = (u32x2){pk2(h[0], h[1]), pk2(h[2], h[3])};
                }
    }
};
struct EpiMoe2 {
    bf16_t* ys;
    DI void operator()(const AccT& acc, const pg8::Unit& u, int wr, int wc, int fr, int fq) const {
        const int row0 = u.pm * 256 + wr * 64 + fr;
#pragma unroll
        for (int ai = 0; ai < 2; ++ai)
#pragma unroll
            for (int m = 0; m < 4; ++m)
#pragma unroll
                for (int bj = 0; bj < 2; ++bj)
#pragma unroll
                    for (int n = 0; n < 2; ++n) { const f32x4 v = acc[ai][bj][m][n];
                        *(u32x2*)(ys + (size_t)(row0 + ai * 128 + m * 16) * D + u.pn * 256 + bj * 128 + wc * 32 + n * 16 + 4 * fq) = (u32x2){pk2(v[0], v[1]), pk2(v[2], v[3])}; }
    }
};

DI void tconv_tile(const Frame& F, const float* src, int N, int k0, int n0, bf16_t* dst, int ldd, int mode) {
    float* tl = (float*)F.lds;
    __syncthreads();
#pragma unroll
    for (int i = 0; i < 8; ++i) { const int idx = F.tid + 512 * i, k = idx >> 6, n = idx & 63; tl[k * 65 + n] = src[(size_t)(k0 + k) * N + n0 + n]; }
    __syncthreads();
#pragma unroll
    for (int i = 0; i < 4; ++i) { const int idx = F.tid + 512 * i, n = idx >> 5, kp = idx & 31;
        const int nn = n0 + n; const int row = (mode == 0) ? nn : ((nn >> 4) * 32 + (mode - 1) * 16 + (nn & 15));
        *(unsigned*)(dst + (size_t)row * ldd + k0 + 2 * kp) = pk2(tl[(2 * kp) * 65 + n], tl[(2 * kp + 1) * 65 + n]); }
}
DI void phase_prologue(const Frame& F) {
    const int T_IN = 16 * 40, T_OUT = 16 * 16, T_E = 16 * 8;
    const int per_layer = T_IN + T_OUT + NE * 3 * T_E, total = 2 * per_layer;
    for (int u = F.bid; u < total; u += F.G) {
        const int li = u / per_layer; int r = u % per_layer;
        if (r < T_IN) { tconv_tile(F, F.in[I_WIN] + (size_t)li * D * DIN, DIN, (r / 40) * 64, (r % 40) * 64, WSP(bf16_t, WS_WIN) + (size_t)li * DIN * D, D, 0); continue; }
        r -= T_IN;
        if (r < T_OUT) { tconv_tile(F, F.in[I_WOUT] + (size_t)li * D * D, D, (r / 16) * 64, (r % 16) * 64, WSP(bf16_t, WS_WOUT) + (size_t)li * D * D, D, 0); continue; }
        r -= T_OUT;
        const int e = r / (3 * T_E), w = (r / T_E) % 3, t = r % T_E;
        if (w < 2) tconv_tile(F, F.in[w == 0 ? I_MW1 : I_MW3] + ((size_t)li * NE + e) * D * DE, DE, (t / 8) * 64, (t % 8) * 64, WSP(bf16_t, WS_W13) + ((size_t)li * NE + e) * 1024 * 1024, D, 1 + w);
        else tconv_tile(F, F.in[I_MW2] + ((size_t)li * NE + e) * DE * D, D, (t / 16) * 64, (t % 16) * 64, WSP(bf16_t, WS_W2) + ((size_t)li * NE + e) * 1024 * 512, DE, 0);
    }
    __syncthreads();
    {
        float* sc = (float*)F.lds;
        float* red = sc + 3072;
        for (int i = F.tid; i < 3072; i += NTHR) { const int v = i >> 10, k = i & 1023; const float x = (v < 2) ? F.in[I_C][v * 1024 + k] : F.in[I_CCTX][k]; sc[i] = siluf(x); }
        __syncthreads();
        for (int u = F.bid; u < 2 * 96; u += F.G) {
            const int li = u / 96, j = (u % 96) * 64 + F.lane, ko = F.wave;
            const float* w = F.in[I_ADAW] + (size_t)li * D * 6144 + j;
            float a0 = 0.f, a1 = 0.f, a2 = 0.f;
            for (int k = ko * 128; k < ko * 128 + 128; ++k) { const float wv = w[(size_t)k * 6144]; a0 += sc[k] * wv; a1 += sc[1024 + k] * wv; a2 += sc[2048 + k] * wv; }
            red[(ko * 3 + 0) * 64 + F.lane] = a0; red[(ko * 3 + 1) * 64 + F.lane] = a1; red[(ko * 3 + 2) * 64 + F.lane] = a2;
            __syncthreads();
            if (F.tid < 192) { const int v = F.tid / 64, l = F.tid % 64; float s = 0.f;
#pragma unroll
                for (int q = 0; q < 8; ++q) s += red[(q * 3 + v) * 64 + l];
                const int jj = (u % 96) * 64 + l;
                WSP(float, WS_MOD)[((size_t)li * 3 + v) * 6144 + jj] = s + F.in[I_ADAB][li * 6144 + jj]; }
            __syncthreads();
        }
    }
    if (F.bid == (F.G > 1 ? 1 : 0)) {
        for (int i = F.tid; i < 256 * 8; i += NTHR) { const int pos = i >> 3, f = i & 7; const float inv = exp2f(-(float)f * (13.287712379549449f / 8.f)); const float rev = (float)pos * inv * 0.15915494309189535f;
            WSP(float, WS_ROPE)[i * 2] = cos_rev(rev); WSP(float, WS_ROPE)[i * 2 + 1] = sin_rev(rev); }
    }
}

DI void filter_tile(const Frame& F, int li, int L, int tile, float* hT, float* part) {
    float* h1s = (float*)F.lds;
    float* h2s = h1s + 4096;
    float* stg = h2s + 4096;
    float* sq2 = stg + 256 * 65;
    const float* w1 = F.in[I_HW1] + (size_t)li * 33 * 64; const float* b1 = F.in[I_HB1] + li * 64;
    const float* w2 = F.in[I_HW2] + (size_t)li * 64 * 64; const float* b2 = F.in[I_HB2] + li * 64;
    const float* w3 = F.in[I_HW3] + (size_t)li * 64 * 1024; const float* b3 = F.in[I_HB3] + li * 1024;
    const int t0 = tile * 64;
    const float inv_lm1 = 1.f / (float)(L > 1 ? L - 1 : 1);
    __syncthreads();
    {
        const int tl = F.tid & 63, pt = F.tid >> 6; const float t = (float)(t0 + tl);
        float a[8];
#pragma unroll
        for (int jj = 0; jj < 8; ++jj) a[jj] = b1[pt * 8 + jj] + (t * inv_lm1) * w1[pt * 8 + jj];
#pragma unroll 1
        for (int i = 0; i < 16; ++i) { const float band = 1e-4f + (15.f - 1e-4f) * (float)i / 15.f; const float rev = t * band / (float)L; const float cz = cos_rev(rev), sz = sin_rev(rev);
#pragma unroll
            for (int jj = 0; jj < 8; ++jj) a[jj] += cz * w1[(1 + i) * 64 + pt * 8 + jj] + sz * w1[(17 + i) * 64 + pt * 8 + jj]; }
#pragma unroll
        for (int jj = 0; jj < 8; ++jj) h1s[tl * 64 + pt * 8 + jj] = sin_rad(a[jj]);
    }
    __syncthreads();
    {
        const int tl = F.tid & 63, pt = F.tid >> 6;
        float a[8];
#pragma unroll
        for (int jj = 0; jj < 8; ++jj) a[jj] = b2[pt * 8 + jj];
#pragma unroll 1
        for (int i = 0; i < 64; ++i) { const float hv = h1s[tl * 64 + i];
#pragma unroll
            for (int jj = 0; jj < 8; ++jj) a[jj] += hv * w2[i * 64 + pt * 8 + jj]; }
#pragma unroll
        for (int jj = 0; jj < 8; ++jj) h2s[tl * 64 + pt * 8 + jj] = sin_rad(a[jj]);
    }
    __syncthreads();
    const int c = F.tid & 255, th = F.tid >> 8;
    const float delta = 3.0701134573253945f + (15.350567286626973f - 3.0701134573253945f) * (float)c / 255.f;
#pragma unroll 1
    for (int cc = 0; cc < 4; ++cc) {
        float wr[64];
#pragma unroll
        for (int i = 0; i < 64; ++i) wr[i] = w3[(size_t)i * 1024 + cc * 256 + c];
        const float bb = b3[cc * 256 + c]; float sq = 0.f;
#pragma unroll 1
        for (int tt = th * 32; tt < th * 32 + 32; ++tt) {
            float a = bb;
#pragma unroll
            for (int i = 0; i < 64; ++i) a += h2s[tt * 64 + i] * wr[i];
            a *= __expf(-((float)(t0 + tt) * inv_lm1) * delta);
            stg[c * 65 + tt] = a; sq += a * a;
        }
        if (th == 1) sq2[c] = sq;
        __syncthreads();
        if (th == 0) part[(size_t)tile * 1024 + cc * 256 + c] = sq + sq2[c];
        for (int ch = F.wave * 32; ch < F.wave * 32 + 32; ++ch) hT[((size_t)cc * 256 + ch) * L + t0 + F.lane] = stg[ch * 65 + F.lane];
        __syncthreads();
    }
}

struct TokInfo { unsigned e0, e1, p0, p1; float g0, g1; unsigned s0, s1; };
DI void phase_norm1(const Frame& F, int li, int mode) {
    const int nrows = (mode == 2) ? NLAT : NTOK;
    const float* modp = WSP(float, WS_MOD) + (size_t)li * 3 * 6144;
    const float* modprev = WSP(float, WS_MOD) + (size_t)(mode == 2 ? 1 : li - 1) * 3 * 6144;
    const float* gam = (mode == 2) ? F.in[I_FG] : F.in[I_N1G] + (size_t)li * D;
    const TokInfo* tok = WSP(TokInfo, WS_TOK); const bf16_t* ys = WSP(bf16_t, WS_A1);
    bf16_t* hbf = WSP(bf16_t, WS_HBF);
    for (int r = F.bid * 8 + F.wave; r < nrows; r += F.G * 8) {
        const bool isctx = r >= NLAT; const int v = isctx ? 2 : (r >> 14);
        float* xrow = isctx ? WSP(float, WS_XC) + (size_t)(r - NLAT) * D : F.out + (size_t)r * D;
        const float* src = (mode == 0) ? (isctx ? F.in[I_CTX] + (size_t)(r - NLAT) * D : F.in[I_X] + (size_t)r * D) : xrow;
        f32x4 x[4];
#pragma unroll
        for (int i = 0; i < 4; ++i) x[i] = *(const f32x4*)(src + i * 256 + F.lane * 4);
        if (mode != 0) {
            const TokInfo ti = tok[r];
            const float* g2 = modprev + (size_t)v * 6144 + 5 * 1024;
#pragma unroll
            for (int i = 0; i < 4; ++i) {
                const int c = i * 256 + F.lane * 4;
                const u32x2 a = *(const u32x2*)(ys + (size_t)ti.s0 * D + c), b = *(const u32x2*)(ys + (size_t)ti.s1 * D + c);
                const f32x4 gg = *(const f32x4*)(g2 + c);
                f32x4 y;
                y[0] = ti.g0 * __uint_as_float(a[0] << 16) + ti.g1 * __uint_as_float(b[0] << 16);
                y[1] = ti.g0 * __uint_as_float(a[0] & 0xffff0000u) + ti.g1 * __uint_as_float(b[0] & 0xffff0000u);
                y[2] = ti.g0 * __uint_as_float(a[1] << 16) + ti.g1 * __uint_as_float(b[1] << 16);
                y[3] = ti.g0 * __uint_as_float(a[1] & 0xffff0000u) + ti.g1 * __uint_as_float(b[1] & 0xffff0000u);
                x[i] = x[i] + gg * y;
            }
            if (mode == 1) {
#pragma unroll
                for (int i = 0; i < 4; ++i) *(f32x4*)(xrow + i * 256 + F.lane * 4) = x[i];
            }
        }
        float ss = 0.f;
#pragma unroll
        for (int i = 0; i < 4; ++i) ss += x[i][0] * x[i][0] + x[i][1] * x[i][1] + x[i][2] * x[i][2] + x[i][3] * x[i][3];
        ss = wave_sum(ss);
        const float rstd = rsqrtf(ss * (1.f / D) + EPS);
#pragma unroll
        for (int i = 0; i < 4; ++i) {
            const int c = i * 256 + F.lane * 4;
            const f32x4 g = *(const f32x4*)(gam + c);
            if (mode == 2) { *(f32x4*)(F.out + (size_t)r * D + c) = x[i] * rstd * g; }
            else {
                const f32x4 sh = *(const f32x4*)(modp + (size_t)v * 6144 + c), sc = *(const f32x4*)(modp + (size_t)v * 6144 + 1024 + c);
                const f32x4 h = x[i] * rstd * g * (sc + 1.f) + sh;
                *(u32x2*)(hbf + (size_t)r * D + c) = (u32x2){pk2(h[0], h[1]), pk2(h[2], h[3])};
            }
        }
    }
}

DI void phase_norm2(const Frame& F, int li, int nrows) {
    float* wt = (float*)F.lds;
    __syncthreads();
    for (int i = F.tid; i < 16384; i += NTHR) { const int k = i >> 4, e = i & 15; wt[e * 1024 + k] = F.in[I_RW][i]; }
    __syncthreads();
    const float* modp = WSP(float, WS_MOD) + (size_t)li * 3 * 6144;
    const float* gam = F.in[I_N2G] + (size_t)li * D;
    bf16_t* hbf = WSP(bf16_t, WS_HBF); TokInfo* tok = WSP(TokInfo, WS_TOK);
    unsigned* lcnt = (unsigned*)(F.lds + LDS_MISC + 64);
    if (F.tid < 16) lcnt[F.tid] = 0u;
    __syncthreads();
    for (int r = F.bid * 8 + F.wave; r < nrows; r += F.G * 8) {
        const bool isctx = r >= NLAT; const int v = isctx ? 2 : (r >> 14);
        const float* src = isctx ? WSP(float, WS_XC) + (size_t)(r - NLAT) * D : F.out + (size_t)r * D;
        f32x4 x[4]; float ss = 0.f;
#pragma unroll
        for (int i = 0; i < 4; ++i) { x[i] = *(const f32x4*)(src + i * 256 + F.lane * 4); ss += x[i][0] * x[i][0] + x[i][1] * x[i][1] + x[i][2] * x[i][2] + x[i][3] * x[i][3]; }
        ss = wave_sum(ss);
        const float rstd = rsqrtf(ss * (1.f / D) + EPS);
        float lg[16];
#pragma unroll
        for (int e = 0; e < 16; ++e) lg[e] = 0.f;
#pragma unroll
        for (int i = 0; i < 4; ++i) {
            const int c = i * 256 + F.lane * 4;
            const f32x4 g = *(const f32x4*)(gam + c), sh = *(const f32x4*)(modp + (size_t)v * 6144 + 3 * 1024 + c), sc = *(const f32x4*)(modp + (size_t)v * 6144 + 4 * 1024 + c);
            const f32x4 h = x[i] * rstd * g * (sc + 1.f) + sh;
            *(u32x2*)(hbf + (size_t)r * D + c) = (u32x2){pk2(h[0], h[1]), pk2(h[2], h[3])};
#pragma unroll
            for (int e = 0; e < 16; ++e) { const f32x4 w = *(const f32x4*)(wt + e * 1024 + c); lg[e] += h[0] * w[0] + h[1] * w[1] + h[2] * w[2] + h[3] * w[3]; }
        }
#pragma unroll
        for (int e = 0; e < 16; ++e) lg[e] = wave_sum(lg[e]);
        float mx = lg[0];
#pragma unroll
        for (int e = 1; e < 16; ++e) mx = fmaxf(mx, lg[e]);
        float sc[16], sel[16], den = 0.f;
#pragma unroll
        for (int e = 0; e < 16; ++e) { sc[e] = __expf(lg[e] - mx); den += sc[e]; }
        const float rden = 1.f / den;
#pragma unroll
        for (int e = 0; e < 16; ++e) { sc[e] *= rden; sel[e] = sc[e] + F.in[I_RB][e]; }
        int bg = 0; float bgs = -1e30f;
#pragma unroll
        for (int g = 0; g < 4; ++g) {
            float m1 = -1e30f, m2 = -1e30f;
#pragma unroll
            for (int q = 0; q < 4; ++q) { const float s = sel[g * 4 + q]; if (s > m1) { m2 = m1; m1 = s; } else if (s > m2) m2 = s; }
            const float gs = m1 + m2; if (gs > bgs) { bgs = gs; bg = g; }
        }
        int e0 = 0, e1 = 0; float s0v = -1e30f, s1v = -1e30f, w0 = 0.f, w1 = 0.f;
#pragma unroll
        for (int e = 0; e < 16; ++e) {
            const bool ing = (e >> 2) == bg; const float s = sel[e];
            if (ing && s > s0v) { s1v = s0v; e1 = e0; w1 = w0; s0v = s; e0 = e; w0 = sc[e]; }
            else if (ing && s > s1v) { s1v = s; e1 = e; w1 = sc[e]; }
        }
        if (F.lane == 0) {
            TokInfo ti; ti.e0 = e0; ti.e1 = e1; ti.p0 = atomicAdd(lcnt + e0, 1u); ti.p1 = atomicAdd(lcnt + e1, 1u);
            const float ws = 1.f / (w0 + w1); ti.g0 = w0 * ws; ti.g1 = w1 * ws; ti.s0 = 0; ti.s1 = 0;
            tok[r] = ti;
        }
    }
    __syncthreads();
    if (F.tid < 16) F.ctl[CW_BCNT + (li * MAXG + F.bid) * 16 + F.tid] = lcnt[F.tid];
}

DI void moe_offsets(const Frame& F, int li, int* offs) {
    __syncthreads();
    int* tot = offs + 376;
    int* part = (int*)F.lds;
    {
        const int e = F.tid & 15, pq = F.tid >> 4;
        const unsigned* bc = F.ctl + CW_BCNT + li * MAXG * 16 + e;
        int st = 0, sb = 0;
#pragma unroll
        for (int k = 0; k < 8; ++k) { const int blk = pq * 8 + k; const int c = (blk < F.G) ? (int)__hip_atomic_load(bc + blk * 16, __ATOMIC_RELAXED, __HIP_MEMORY_SCOPE_AGENT) : 0; st += c; sb += (blk < F.bid) ? c : 0; }
        part[pq * 16 + e] = st; part[512 + pq * 16 + e] = sb;
    }
    __syncthreads();
    if (F.tid < 32) { const int e = F.tid & 15, wb = F.tid >> 4; int s = 0;
        for (int pq = 0; pq < 32; ++pq) s += part[wb * 512 + pq * 16 + e];
        if (wb) offs[360 + e] = s; else tot[e] = s; }
    __syncthreads();
    if (F.tid == 0) { int o = 0; for (int e = 0; e < NE; ++e) { offs[e] = o; offs[17 + e] = o >> 8; o += (tot[e] + 255) & ~255; }
        offs[16] = o; offs[17 + 16] = o >> 8; }
    __syncthreads();
    for (int t = F.tid; t < SLOT_CAP / 256; t += NTHR) { int e = 0; for (int k = 1; k < NE; ++k) e += (offs[17 + k] <= t) ? 1 : 0; offs[40 + t] = e; }
    if (F.tid < 16) offs[360 + F.tid] += offs[F.tid];
    __syncthreads();
}
DI void phase_gather(const Frame& F, int li, int nrows) {
    int* offs = (int*)(F.lds + LDS_MISC + 64);
    moe_offsets(F, li, offs);
    const bf16_t* hbf = WSP(bf16_t, WS_HBF); bf16_t* a1 = WSP(bf16_t, WS_A1); TokInfo* tok = WSP(TokInfo, WS_TOK);
    for (int r = F.bid * 8 + F.wave; r < nrows; r += F.G * 8) {
        TokInfo ti = tok[r];
        const unsigned s0 = offs[360 + ti.e0] + ti.p0, s1 = offs[360 + ti.e1] + ti.p1;
        const u32x4 a = *(const u32x4*)(hbf + (size_t)r * D + F.lane * 8), b = *(const u32x4*)(hbf + (size_t)r * D + 512 + F.lane * 8);
        *(u32x4*)(a1 + (size_t)s0 * D + F.lane * 8) = a; *(u32x4*)(a1 + (size_t)s0 * D + 512 + F.lane * 8) = b;
        *(u32x4*)(a1 + (size_t)s1 * D + F.lane * 8) = a; *(u32x4*)(a1 + (size_t)s1 * D + 512 + F.lane * 8) = b;
        if (F.lane == 0) { tok[r].s0 = s0; tok[r].s1 = s1; }
    }
}

#define MFMA32(a, b, c) __builtin_amdgcn_mfma_f32_32x32x16_bf16((a), (b), (c), 0, 0, 0)
DI float lam_of(const Frame& F, int li, float& lam_init) {
    const float* lv = F.in[I_ALAM] + (size_t)li * 128;
    const int i = F.lane & 31, hi = F.lane >> 5;
    float d = lv[hi * 64 + i] * lv[hi * 64 + 32 + i];
    d += swz_xor<16>(d); d += swz_xor<8>(d); d += swz_xor<4>(d); d += swz_xor<2>(d); d += swz_xor<1>(d);
    const float d0 = __int_as_float(__builtin_amdgcn_readlane(__float_as_int(d), 0)), d1 = __int_as_float(__builtin_amdgcn_readlane(__float_as_int(d), 32));
    lam_init = 0.8f - 0.6f * __expf(-0.3f * (float)li);
    return __expf(d0) - __expf(d1) + lam_init;
}
DI bf16x8 pack8(const f32x16& x, int s) {
    u32x4 p; p[0] = pk2(x[8 * s], x[8 * s + 1]); p[1] = pk2(x[8 * s + 2], x[8 * s + 3]); p[2] = pk2(x[8 * s + 4], x[8 * s + 5]); p[3] = pk2(x[8 * s + 6], x[8 * s + 7]);
    return __builtin_bit_cast(bf16x8, p);
}

DI void diffattn_unit(const Frame& F, int li, int b, int h, size_t qrow0, int NT) {
    const int lane = F.lane, r = lane & 31, hh = lane >> 5;
    const bf16_t* AQ = WSP(bf16_t, WS_AQ); const bf16_t* AK = WSP(bf16_t, WS_AK); const bf16_t* AVT = WSP(bf16_t, WS_AVT) + (size_t)(b * 4 + h) * 64 * NKEY;
    unsigned char* Ks = F.lds;
    unsigned char* Vt = F.lds + 16384;
    constexpr int VTB = 64 * 136;
    float lam_init; const float lam = lam_of(F, li, lam_init);
    const size_t qrow = qrow0 + F.wave * 32 + r;
    bf16x8 qf[2][2]; float qn2[2];
#pragma unroll
    for (int c = 0; c < 2; ++c) { qn2[c] = 0.f;
#pragma unroll
        for (int ks = 0; ks < 2; ++ks) { qf[c][ks] = *(const bf16x8*)(AQ + qrow * 256 + h * 64 + c * 32 + ks * 16 + 8 * hh);
#pragma unroll
            for (int j = 0; j < 8; ++j) { const float v = bf2f((bf16_t)qf[c][ks][j]); qn2[c] += v * v; } }
        qn2[c] = half_sum(qn2[c]); }
    const unsigned* kmx = F.ctl + CW_KMAX + li * 16 + (b * 4 + h) * 2;
    f32x16 cinit;
    { float cn = 0.f;
#pragma unroll
      for (int c = 0; c < 2; ++c) { const float km = sqrtf(__uint_as_float(__hip_atomic_load(kmx + c, __ATOMIC_RELAXED, __HIP_MEMORY_SCOPE_AGENT))); cn = fmaxf(cn, sqrtf(qn2[c]) * km); }
      cn = -(cn * 1.02f + 1e-3f);
#pragma unroll
      for (int i = 0; i < 16; ++i) cinit[i] = cn; }
    f32x16 O[2][2];
#pragma unroll
    for (int c = 0; c < 2; ++c)
#pragma unroll
        for (int dh = 0; dh < 2; ++dh)
#pragma unroll
            for (int i = 0; i < 16; ++i) O[c][dh][i] = 0.f;
    float lsum[2] = {0.f, 0.f};
    const int skey = F.tid >> 3, sch = F.tid & 7;
    const int kdst = (sch >> 2) * 4096 + skey * 64 + (((sch & 3) ^ ((skey >> 2) & 3)) * 16);
    const int vd = F.tid >> 3, vkc = F.tid & 7;
    const int vdst = vd * 136 + vkc * 16;
    auto krow_of = [&](int j) -> size_t { return j < CTX ? (size_t)NLAT + b * CTX + j : (size_t)b * S + (j - CTX); };
    u32x4 kreg, vreg;
    kreg = *(const u32x4*)(AK + krow_of(skey) * 256 + h * 64 + sch * 8);
    vreg = *(const u32x4*)(AVT + (size_t)vd * NKEY + vkc * 8);
    __syncthreads();
    *(u32x4*)(Ks + kdst) = kreg;
    *(u32x2*)(Vt + vdst) = (u32x2){vreg[0], vreg[1]}; *(u32x2*)(Vt + vdst + 8) = (u32x2){vreg[2], vreg[3]};
    __syncthreads();
    for (int kt = 0; kt < NT; ++kt) {
        const int buf = kt & 1;
        if (kt + 1 < NT) {
            const int j0 = (kt + 1) * 64;
            kreg = *(const u32x4*)(AK + krow_of(j0 + skey) * 256 + h * 64 + sch * 8);
            vreg = *(const u32x4*)(AVT + (size_t)vd * NKEY + j0 + vkc * 8);
        }
        const unsigned char* kb = Ks + buf * 8192; const unsigned char* vb = Vt + buf * VTB;
#pragma unroll 1
        for (int st = 0; st < 2; ++st) {
            const int key = 32 * st + r;
            bf16x8 pb[2][2];
#pragma unroll
            for (int c = 0; c < 2; ++c) {
                const bf16x8 k0 = *(const bf16x8*)(kb + c * 4096 + key * 64 + (((0 + hh) ^ ((key >> 2) & 3)) * 16));
                const bf16x8 k1 = *(const bf16x8*)(kb + c * 4096 + key * 64 + (((2 + hh) ^ ((key >> 2) & 3)) * 16));
                f32x16 s = MFMA32(k0, qf[c][0], cinit);
                s = MFMA32(k1, qf[c][1], s);
#pragma unroll
                for (int i = 0; i < 16; ++i) { s[i] = __builtin_amdgcn_exp2f(s[i]); lsum[c] += s[i]; }
                pb[c][0] = pack8(s, 0); pb[c][1] = pack8(s, 1);
            }
#pragma unroll
            for (int dh = 0; dh < 2; ++dh)
#pragma unroll
                for (int s = 0; s < 2; ++s) {
                    const unsigned char* vp = vb + (32 * dh + r) * 136 + (32 * st + 16 * s + 4 * hh) * 2;
                    const s16x4 lo = *(const s16x4*)vp, hi = *(const s16x4*)(vp + 16);
                    const bf16x8 vf = __builtin_shufflevector(lo, hi, 0, 1, 2, 3, 4, 5, 6, 7);
                    O[0][dh] = MFMA32(vf, pb[0][s], O[0][dh]);
                    O[1][dh] = MFMA32(vf, pb[1][s], O[1][dh]);
                }
        }
        if (kt + 1 < NT) {
            unsigned char* kw = Ks + (buf ^ 1) * 8192; unsigned char* vw = Vt + (buf ^ 1) * VTB;
            *(u32x4*)(kw + kdst) = kreg;
            *(u32x2*)(vw + vdst) = (u32x2){vreg[0], vreg[1]}; *(u32x2*)(vw + vdst + 8) = (u32x2){vreg[2], vreg[3]};
        }
        __syncthreads();
    }
    const float l0 = half_sum(lsum[0]), l1 = half_sum(lsum[1]);
    const float r0 = 1.f / l0, r1 = lam / l1;
    float o[2][16]; float ss = 0.f;
#pragma unroll
    for (int dh = 0; dh < 2; ++dh)
#pragma unroll
        for (int i = 0; i < 16; ++i) { o[dh][i] = O[0][dh][i] * r0 - O[1][dh][i] * r1; ss += o[dh][i] * o[dh][i]; }
    ss = half_sum(ss);
    const float rs = rsqrtf(ss * (1.f / 64.f) + EPS) * (1.f - lam_init);
    const float* sg = F.in[I_ASUB] + li * 64;
    bf16_t* mix = WSP(bf16_t, WS_HBF) + qrow * D + h * 64;
#pragma unroll
    for (int dh = 0; dh < 2; ++dh)
#pragma unroll
        for (int g = 0; g < 4; ++g) {
            const int d = 32 * dh + 8 * g + 4 * hh;
            const f32x4 gg = *(const f32x4*)(sg + d);
            *(u32x2*)(mix + d) = (u32x2){pk2(o[dh][4 * g] * rs * gg[0], o[dh][4 * g + 1] * rs * gg[1]), pk2(o[dh][4 * g + 2] * rs * gg[2], o[dh][4 * g + 3] * rs * gg[3])};
        }
}

DI void na_mfma_unit(const Frame& F, int li, int b, size_t qrow0, int grow) {
    const int lane = F.lane, r31 = lane & 31, hh = lane >> 5, h = F.wave >> 1, qh = F.wave & 1;
    const bf16_t* BQ = WSP(bf16_t, WS_BQ); const bf16_t* BK = WSP(bf16_t, WS_BK); const bf16_t* BVT = WSP(bf16_t, WS_BVT);
    constexpr int KB = 4 * 8192, VB = 4 * 8704, STG = KB + VB;
    unsigned char* L = F.lds;
    float* tab = (float*)(F.lds + 2 * STG);
    const int nwin = grow >= 0 ? 8 : 0, nt = nwin + 4;
    int r0 = grow - 4; r0 = r0 < 0 ? 0 : (r0 > 248 ? 248 : r0);
    __syncthreads();
    if (nwin) for (int i = F.tid; i < 4 * 465; i += NTHR) tab[i] = F.in[I_RPB][(size_t)li * 4 * 465 + i] * LOG2E;
    const int skey = F.tid >> 3, sc64 = F.tid & 7, sh = sc64 >> 1;
    const int vrow = F.tid >> 1, vhalf = F.tid & 1;
    auto kbase = [&](int ti) -> const bf16_t* { return ti < nwin ? BK + ((size_t)b * S + (size_t)(r0 + ti) * GW) * 256 : BK + ((size_t)NLAT + b * CTX + (ti - nwin) * 64) * 256; };
    auto vkey0 = [&](int ti) -> int { return ti < nwin ? CTX + (r0 + ti) * GW : (ti - nwin) * 64; };
    u32x4 kreg[4], vreg[4];
    { const bf16_t* kp = kbase(0) + (size_t)skey * 256 + sc64 * 32; const bf16_t* vp = BVT + ((size_t)b * 256 + vrow) * NKEY + vkey0(0) + vhalf * 32;
#pragma unroll
      for (int i = 0; i < 4; ++i) { kreg[i] = *(const u32x4*)(kp + i * 8); vreg[i] = *(const u32x4*)(vp + i * 8); } }
    const size_t qrow = qrow0 + 32 * qh + r31;
    bf16x8 qf[4]; float qn2 = 0.f;
#pragma unroll
    for (int ks = 0; ks < 4; ++ks) { qf[ks] = *(const bf16x8*)(BQ + qrow * 256 + h * 64 + ks * 16 + 8 * hh);
#pragma unroll
        for (int j = 0; j < 8; ++j) { const float v = bf2f((bf16_t)qf[ks][j]); qn2 += v * v; } }
    qn2 = half_sum(qn2);
    __syncthreads();
    float bmax = 0.f;
    if (nwin) { for (int i = lane; i < 465; i += 64) bmax = fmaxf(bmax, tab[h * 465 + i]); bmax = wave_max(bmax); }
    const unsigned* kmx = F.ctl + CW_KMAXB + li * 16 + (b * 4 + h) * 2;
    const float km = sqrtf(__uint_as_float(__hip_atomic_load(kmx, __ATOMIC_RELAXED, __HIP_MEMORY_SCOPE_AGENT)) + __uint_as_float(__hip_atomic_load(kmx + 1, __ATOMIC_RELAXED, __HIP_MEMORY_SCOPE_AGENT)));
    const float cneg = -(sqrtf(qn2) * km * 1.02f + bmax + 1e-3f);
    const int cq = 32 * qh + r31; int c0q = cq - 8; c0q = c0q < 0 ? 0 : (c0q > 48 ? 48 : c0q);
    const int qrow_g = grow;
    f32x16 O[2];
#pragma unroll
    for (int dh = 0; dh < 2; ++dh)
#pragma unroll
        for (int i = 0; i < 16; ++i) O[dh][i] = 0.f;
    float lsum = 0.f;
    const int kdst = sh * 8192 + skey * 128, ksw = (skey >> 1) & 7, kch0 = (sc64 & 1) * 4;
    const int vdst = KB + (vrow >> 6) * 8704 + (vrow & 63) * 136 + vhalf * 64;
#pragma unroll
    for (int i = 0; i < 4; ++i) { *(u32x4*)(L + kdst + (((kch0 + i) ^ ksw) * 16)) = kreg[i];
        *(u32x2*)(L + vdst + i * 16) = (u32x2){vreg[i][0], vreg[i][1]}; *(u32x2*)(L + vdst + i * 16 + 8) = (u32x2){vreg[i][2], vreg[i][3]}; }
    __syncthreads();
#pragma unroll 1
    for (int ti = 0; ti < nt; ++ti) {
        const int buf = ti & 1;
        if (ti + 1 < nt) { const bf16_t* kp = kbase(ti + 1) + (size_t)skey * 256 + sc64 * 32; const bf16_t* vp = BVT + ((size_t)b * 256 + vrow) * NKEY + vkey0(ti + 1) + vhalf * 32;
#pragma unroll
            for (int i = 0; i < 4; ++i) { kreg[i] = *(const u32x4*)(kp + i * 8); vreg[i] = *(const u32x4*)(vp + i * 8); } }
        const unsigned char* kb = L + buf * STG + h * 8192; const unsigned char* vb = L + buf * STG + KB + h * 8704;
        const bool win = ti < nwin;
        const float* trow = tab + h * 465 + (win ? (r0 + ti - qrow_g + 7) * 31 : 0) + 15 - cq;
#pragma unroll
        for (int st = 0; st < 2; ++st) {
            const int key = 32 * st + r31, sw = (key >> 1) & 7;
            f32x16 s;
#pragma unroll
            for (int i = 0; i < 16; ++i) { const int kc = 32 * st + (i & 3) + 8 * (i >> 2) + 4 * hh;
                float c = cneg;
                if (win) { const bool ok = (kc >= c0q) && (kc < c0q + 16); c = ok ? trow[ok ? kc : cq] + cneg : -1e30f; }
                s[i] = c; }
#pragma unroll
            for (int ks = 0; ks < 4; ++ks) { const bf16x8 kf = *(const bf16x8*)(kb + key * 128 + (((ks * 2 + hh) ^ sw) * 16)); s = MFMA32(kf, qf[ks], s); }
#pragma unroll
            for (int i = 0; i < 16; ++i) { s[i] = __builtin_amdgcn_exp2f(s[i]); lsum += s[i]; }
            const bf16x8 p0 = pack8(s, 0), p1 = pack8(s, 1);
#pragma unroll
            for (int dh = 0; dh < 2; ++dh) {
                const unsigned char* vp = vb + (32 * dh + r31) * 136 + (32 * st + 4 * hh) * 2;
                const s16x4 a0 = *(const s16x4*)vp, a1 = *(const s16x4*)(vp + 16), b0 = *(const s16x4*)(vp + 32), b1 = *(const s16x4*)(vp + 48);
                O[dh] = MFMA32(__builtin_shufflevector(a0, a1, 0, 1, 2, 3, 4, 5, 6, 7), p0, O[dh]);
                O[dh] = MFMA32(__builtin_shufflevector(b0, b1, 0, 1, 2, 3, 4, 5, 6, 7), p1, O[dh]);
            }
        }
        if (ti + 1 < nt) { unsigned char* W = L + (buf ^ 1) * STG;
#pragma unroll
            for (int i = 0; i < 4; ++i) { *(u32x4*)(W + kdst + (((kch0 + i) ^ ksw) * 16)) = kreg[i];
                *(u32x2*)(W + vdst + i * 16) = (u32x2){vreg[i][0], vreg[i][1]}; *(u32x2*)(W + vdst + i * 16 + 8) = (u32x2){vreg[i][2], vreg[i][3]}; } }
        __syncthreads();
    }
    const float rl = 1.f / half_sum(lsum);
    bf16_t* mix = WSP(bf16_t, WS_HBF) + qrow * D + 256 + h * 64;
#pragma unroll
    for (int dh = 0; dh < 2; ++dh)
#pragma unroll
        for (int g = 0; g < 4; ++g) { const int d = 32 * dh + 8 * g + 4 * hh;
            *(u32x2*)(mix + d) = (u32x2){pk2(O[dh][4 * g] * rl, O[dh][4 * g + 1] * rl), pk2(O[dh][4 * g + 2] * rl, O[dh][4 * g + 3] * rl)}; }
}

DI void pool_unit(const Frame& F, int li, size_t seq_row0, int L, int t0) {
    float* us = (float*)F.lds;
    float* df = us + 48 * 256;
    const bf16_t* PL = WSP(bf16_t, WS_PL);
    __syncthreads();
    for (int i = F.tid; i < 48 * 32; i += NTHR) {
        const int tt = i >> 5, c8 = i & 31, t = t0 - 8 + tt;
        float v[8] = {0.f, 0.f, 0.f, 0.f, 0.f, 0.f, 0.f, 0.f};
        if (t >= 0 && t < L) { const u32x4 x = *(const u32x4*)(PL + (seq_row0 + t) * 256 + c8 * 8);
#pragma unroll
            for (int e = 0; e < 4; ++e) { v[2 * e] = __uint_as_float(x[e] << 16); v[2 * e + 1] = __uint_as_float(x[e] & 0xffff0000u); } }
#pragma unroll
        for (int e = 0; e < 8; ++e) us[tt * 256 + c8 * 8 + e] = v[e];
    }
    __syncthreads();
    for (int i = F.tid; i < 32 * 256; i += NTHR) {
        const int tl = i >> 8, ch = i & 255, g = ch >> 6, t = t0 + tl; const int hw = 1 << g;
        int lo = t - hw; lo = lo < 0 ? 0 : lo; int hi = t + hw; hi = hi > L ? L : hi;
        float s = 0.f;
        for (int tt = lo; tt < hi; ++tt) s += us[(tt - t0 + 8) * 256 + ch];
        df[tl * 256 + ch] = s / (float)(hi - lo) - us[(tl + 8) * 256 + ch];
    }
    __syncthreads();
    const float* pw = F.in[I_POOLW] + (size_t)li * 4 * 64 * 64; const float* ps = F.in[I_POOLS] + li * 256;
    bf16_t* mix = WSP(bf16_t, WS_HBF);
    {
        const int ch = F.tid & 255, th = F.tid >> 8, g = ch >> 6, j = ch & 63;
        float w[64];
#pragma unroll
        for (int i = 0; i < 64; ++i) w[i] = pw[((size_t)g * 64 + i) * 64 + j];
        const float scale = ps[ch];
        for (int tl = th * 16; tl < th * 16 + 16; ++tl) {
            float a = 0.f;
#pragma unroll
            for (int i = 0; i < 64; ++i) a += df[tl * 256 + g * 64 + i] * w[i];
            mix[(seq_row0 + t0 + tl) * D + 512 + ch] = f2bf(a * scale);
        }
    }
}

DI float hy_norm(const float* part, int ntile, int o, int ch) {
    float s = 0.f;
    for (int t = 0; t < ntile; ++t) s += part[(size_t)t * 1024 + (o * 2) * 256 + ch] + part[(size_t)t * 1024 + (o * 2 + 1) * 256 + ch];
    return rsqrtf(s + EPS);
}
DI float hy_short(const bf16_t* p, int t, int L, float w0, float w1, float w2, float bb) {
    const float a = t > 0 ? bf2f(p[t - 1]) : 0.f, c = t + 1 < L ? bf2f(p[t + 1]) : 0.f;
    return a * w0 + bf2f(p[t]) * w1 + c * w2 + bb;
}
constexpr int FM = 16384;
DI int fphys(int i) { return i + (i >> 4) + ((i >> 9) << 4); }
constexpr int brev(int m, int bits) { return bits == 5 ? (((m & 1) << 4) | ((m & 2) << 2) | (m & 4) | ((m & 8) >> 2) | ((m & 16) >> 4)) : (((m & 1) << 3) | ((m & 2) << 1) | ((m & 4) >> 1) | ((m & 8) >> 3)); }
template <int R, int LOG2R, bool INV> DI void dft_regs(float (&re)[R], float (&im)[R]) {
    constexpr float C32[16] = {1.f, 0.98078528040323043f, 0.92387953251128674f, 0.83146961230254524f, 0.70710678118654752f, 0.55557023301960218f, 0.38268343236508977f, 0.19509032201612825f,
                               0.f, -0.19509032201612825f, -0.38268343236508977f, -0.55557023301960218f, -0.70710678118654752f, -0.83146961230254524f, -0.92387953251128674f, -0.98078528040323043f};
    constexpr float S32[16] = {0.f, 0.19509032201612825f, 0.38268343236508977f, 0.55557023301960218f, 0.70710678118654752f, 0.83146961230254524f, 0.92387953251128674f, 0.98078528040323043f,
                               1.f, 0.98078528040323043f, 0.92387953251128674f, 0.83146961230254524f, 0.70710678118654752f, 0.55557023301960218f, 0.38268343236508977f, 0.19509032201612825f};
#pragma unroll
    for (int st = 0; st < LOG2R; ++st) {
        const int h = R >> (st + 1);
#pragma unroll
        for (int i = 0; i < R; i += 2 * h) {
#pragma unroll
            for (int j = 0; j < h; ++j) {
                const float xr = re[i + j], xi = im[i + j], yr = re[i + j + h], yi = im[i + j + h];
                re[i + j] = xr + yr; im[i + j] = xi + yi;
                const float dr = xr - yr, di = xi - yi;
                const int k = j * (16 / h);
                if (k == 0) { re[i + j + h] = dr; im[i + j + h] = di; }
                else if (k == 8) { re[i + j + h] = INV ? -di : di; im[i + j + h] = INV ? dr : -dr; }
                else { const float c = C32[k], sn = INV ? S32[k] : -S32[k]; re[i + j + h] = dr * c - di * sn; im[i + j + h] = dr * sn + di * c; }
            }
        }
    }
}
template <bool INV, int SP> DI void fft_pass32(f32x2* X, int bp, int rem, float inv_bs) {
    asm volatile("" : "+v"(bp), "+v"(rem));
    f32x2* P = X + bp;
    float re[32], im[32];
    if (!INV) {
#pragma unroll
        for (int q = 0; q < 32; ++q) { const f32x2 v = P[q * SP]; re[q] = v[0]; im[q] = v[1]; }
        dft_regs<32, 5, false>(re, im);
#pragma unroll
        for (int m = 0; m < 32; ++m) { const int qp = brev(m, 5);
            float r = re[m], i = im[m];
            if (qp != 0) { const float rev = (float)(rem * qp) * inv_bs; const float c = __builtin_amdgcn_cosf(rev), sn = -__builtin_amdgcn_sinf(rev); const float t = r * c - i * sn; i = r * sn + i * c; r = t; }
            P[qp * SP] = (f32x2){r, i}; }
    } else {
#pragma unroll
        for (int qp = 0; qp < 32; ++qp) { const f32x2 v = P[qp * SP]; float r = v[0], i = v[1];
            if (qp != 0) { const float rev = (float)(rem * qp) * inv_bs; const float c = __builtin_amdgcn_cosf(rev), sn = __builtin_amdgcn_sinf(rev); const float t = r * c - i * sn; i = r * sn + i * c; r = t; }
            re[qp] = r; im[qp] = i; }
        dft_regs<32, 5, true>(re, im);
#pragma unroll
        for (int m = 0; m < 32; ++m) P[brev(m, 5) * SP] = (f32x2){re[m], im[m]};
    }
}
DI void fft_fwd12(f32x2* X, int tid) {
    __syncthreads(); fft_pass32<false, 560>(X, fphys(tid), tid, 1.f / 16384.f);
    __syncthreads(); fft_pass32<false, 17>(X, (tid >> 4) * 560 + (tid & 15), tid & 15, 1.f / 512.f);
    __syncthreads();
}
DI void fft_inv21(f32x2* X, int tid) {
    __syncthreads(); fft_pass32<true, 17>(X, (tid >> 4) * 560 + (tid & 15), tid & 15, 1.f / 512.f);
    __syncthreads(); fft_pass32<true, 560>(X, fphys(tid), tid, 1.f / 16384.f);
    __syncthreads();
}
DI void hyena_fft_unit(const Frame& F, int li, int ch) {
    f32x2* X = (f32x2*)F.lds;
    const bf16_t* HYT = WSP(bf16_t, WS_HYT); const float* filt = WSP(float, WS_FILT);
    f32x2* Ye = WSP(f32x2, WS_ZBUF) + (size_t)ch * FM; f32x2* Z1 = WSP(f32x2, WS_Z1BUF) + (size_t)ch * FM;
    const float* sw = F.in[I_HYSW] + (size_t)li * 3 * 768; const float* sb = F.in[I_HYSB] + li * 768; const float* sk = F.in[I_HSKIP] + li * 512;
    const int tid = F.tid;
    const bf16_t* px1[2] = {HYT + ((size_t)0 * 768 + ch) * S, HYT + ((size_t)1 * 768 + ch) * S};
    const bf16_t* px2[2] = {HYT + ((size_t)0 * 768 + 256 + ch) * S, HYT + ((size_t)1 * 768 + 256 + ch) * S};
    const bf16_t* pv[2] = {HYT + ((size_t)0 * 768 + 512 + ch) * S, HYT + ((size_t)1 * 768 + 512 + ch) * S};
    const float wx1[4] = {sw[ch], sw[768 + ch], sw[1536 + ch], sb[ch]};
    const float wx2[4] = {sw[256 + ch], sw[768 + 256 + ch], sw[1536 + 256 + ch], sb[256 + ch]};
    const float wv[4] = {sw[512 + ch], sw[768 + 512 + ch], sw[1536 + 512 + ch], sb[512 + ch]};
#pragma unroll 1
    for (int cv = 0; cv < 2; ++cv) {
        const float* hf = filt + ((size_t)(2 * cv) * 256 + ch) * S; const float* hb = filt + ((size_t)(2 * cv + 1) * 256 + ch) * S;
        const float fnrm = hy_norm(WSP(float, WS_FPART), 256, cv, ch); const float nrm = 1.f / 32768.f;
        const float skip = sk[cv * 256 + ch];
#pragma unroll 1
        for (int half = 0; half < 2; ++half) {
            __syncthreads();
            int pb = fphys(tid); int tq = tid; asm volatile("" : "+v"(pb), "+v"(tq));
#pragma unroll 2
            for (int j = 0; j < 32; ++j) { const int n = tq + 512 * j; const float a = hf[n] * fnrm, bq = n ? hb[FM - n] * fnrm : 0.f;
                f32x2 v;
                if (half == 0) v = (f32x2){a + bq, 0.f};
                else { const float d = a - bq, rev = (float)n * (1.f / 32768.f); v = (f32x2){d * __builtin_amdgcn_cosf(rev), -d * __builtin_amdgcn_sinf(rev)}; }
                X[pb + 560 * j] = v; }
            fft_fwd12(X, tid);
            h16x2 kpk[2][16];
#pragma unroll
            for (int g = 0; g < 2; ++g) { int b16 = fphys((tid + 512 * g) * 16); asm volatile("" : "+v"(b16));
                float kre[16], kim[16];
#pragma unroll
                for (int q = 0; q < 16; ++q) { const f32x2 v = X[b16 + q]; kre[q] = v[0]; kim[q] = v[1]; }
                dft_regs<16, 4, false>(kre, kim);
#pragma unroll
                for (int q = 0; q < 16; ++q) kpk[g][q] = (h16x2){(_Float16)kre[q], (_Float16)kim[q]}; }
            __syncthreads();
            asm volatile("" : "+v"(pb), "+v"(tq));
#pragma unroll 2
            for (int j = 0; j < 32; ++j) { const int n = tq + 512 * j; f32x2 v;
                if (cv == 0) v = (f32x2){hy_short(pv[0], n, S, wv[0], wv[1], wv[2], wv[3]), hy_short(pv[1], n, S, wv[0], wv[1], wv[2], wv[3])};
                else v = Z1[n];
                if (half == 1) { const float rev = (float)n * (1.f / 32768.f); const float c = __builtin_amdgcn_cosf(rev), sn = -__builtin_amdgcn_sinf(rev); v = (f32x2){v[0] * c - v[1] * sn, v[0] * sn + v[1] * c}; }
                X[pb + 560 * j] = v; }
            fft_fwd12(X, tid);
#pragma unroll
            for (int g = 0; g < 2; ++g) { int b16 = fphys((tid + 512 * g) * 16); asm volatile("" : "+v"(b16));
                float re[16], im[16];
#pragma unroll
                for (int q = 0; q < 16; ++q) { const f32x2 v = X[b16 + q]; re[q] = v[0]; im[q] = v[1]; }
                dft_regs<16, 4, false>(re, im);
                float br[16], bi[16];
#pragma unroll
                for (int m = 0; m < 16; ++m) { const int qp = brev(m, 4); const float kr = (float)kpk[g][m][0], ki = (float)kpk[g][m][1]; br[qp] = re[m] * kr - im[m] * ki; bi[qp] = re[m] * ki + im[m] * kr; }
                dft_regs<16, 4, true>(br, bi);
#pragma unroll
                for (int m = 0; m < 16; ++m) X[b16 + brev(m, 4)] = (f32x2){br[m], bi[m]};
            }
            fft_inv21(X, tid);
            asm volatile("" : "+v"(pb), "+v"(tq));
            if (half == 0) {
#pragma unroll 2
                for (int j = 0; j < 32; ++j) { const int n = tq + 512 * j; Ye[n] = X[pb + 560 * j]; }
            } else {
#pragma unroll 1
                for (int j = 0; j < 32; ++j) { const int n = tq + 512 * j;
                    const f32x2 yo = X[pb + 560 * j], ye = Ye[n];
                    const float rev = (float)n * (1.f / 32768.f); const float c = __builtin_amdgcn_cosf(rev), sn = __builtin_amdgcn_sinf(rev);
                    const float y0 = (ye[0] + yo[0] * c - yo[1] * sn) * nrm, y1 = (ye[1] + yo[0] * sn + yo[1] * c) * nrm;
                    if (cv == 0) {
                        const float v0 = hy_short(pv[0], n, S, wv[0], wv[1], wv[2], wv[3]), v1 = hy_short(pv[1], n, S, wv[0], wv[1], wv[2], wv[3]);
                        const float a0 = hy_short(px1[0], n, S, wx1[0], wx1[1], wx1[2], wx1[3]), a1 = hy_short(px1[1], n, S, wx1[0], wx1[1], wx1[2], wx1[3]);
                        Z1[n] = (f32x2){a0 * (y0 + skip * v0), a1 * (y1 + skip * v1)};
                    } else {
                        const f32x2 z1 = Z1[n];
                        const float a0 = hy_short(px2[0], n, S, wx2[0], wx2[1], wx2[2], wx2[3]), a1 = hy_short(px2[1], n, S, wx2[0], wx2[1], wx2[2], wx2[3]);
                        bf16_t* mix = WSP(bf16_t, WS_HBF);
                        mix[((size_t)n) * D + 768 + ch] = f2bf(a0 * (y0 + skip * z1[0]));
                        mix[((size_t)S + n) * D + 768 + ch] = f2bf(a1 * (y1 + skip * z1[1]));
                    }
                }
            }
        }
    }
}
DI void hyena_ctx_unit(const Frame& F, int li, int ch) {
    float* vs = (float*)F.lds;
    float* zs = vs + 512;
    float* fl = zs + 512;
    const bf16_t* HYC = WSP(bf16_t, WS_HYC); const float* filt = WSP(float, WS_FILTC);
    const float* sw = F.in[I_HYSW] + (size_t)li * 3 * 768; const float* sb = F.in[I_HYSB] + li * 768; const float* sk = F.in[I_HSKIP] + li * 512;
    const float n0 = hy_norm(WSP(float, WS_FPARTC), 4, 0, ch), n1 = hy_norm(WSP(float, WS_FPARTC), 4, 1, ch);
    const int b = F.tid >> 8, t = F.tid & 255;
    auto sc = [&](int c) -> float { const bf16_t* p = HYC + (size_t)(b * CTX) * 768 + c;
        const float a = t > 0 ? bf2f(p[(size_t)(t - 1) * 768]) : 0.f, d = t + 1 < CTX ? bf2f(p[(size_t)(t + 1) * 768]) : 0.f;
        return a * sw[c] + bf2f(p[(size_t)t * 768]) * sw[768 + c] + d * sw[1536 + c] + sb[c]; };
    __syncthreads();
    const float x1 = sc(ch), x2 = sc(256 + ch), v = sc(512 + ch);
    vs[F.tid] = v;
    for (int i = F.tid; i < 1024; i += NTHR) fl[i] = filt[((size_t)(i >> 8) * 256 + ch) * CTX + (i & 255)];
    __syncthreads();
    float a = 0.f;
    for (int s = 0; s < CTX; ++s) { const int dl = t - s; a += (dl >= 0 ? fl[dl] : fl[256 - dl]) * vs[b * 256 + s]; }
    const float z = x1 * (a * n0 + sk[ch] * v);
    zs[F.tid] = z;
    __syncthreads();
    a = 0.f;
    for (int s = 0; s < CTX; ++s) { const int dl = t - s; a += (dl >= 0 ? fl[512 + dl] : fl[768 - dl]) * zs[b * 256 + s]; }
    WSP(bf16_t, WS_HBF)[((size_t)NLAT + b * CTX + t) * D + 768 + ch] = f2bf(x2 * (a * n1 + sk[256 + ch] * z));
}

DI void phase_mix(const Frame& F0, int li) {
    const Frame& F = F0;
    unsigned* head = F.ctl + CW_QHEAD + li * 64;
    volatile unsigned* qs = (volatile unsigned*)(F.lds + LDS_MISC + 32);
#ifndef PROBE_DA
#define PROBE_DA 1
#endif
#ifndef PROBE_HY
#define PROBE_HY 1
#endif
#ifndef PROBE_NA
#define PROBE_NA 1
#endif
#ifdef PROBE_MISC
#define PROBE_PL 2
#else
#define PROBE_PL 1
#endif
    const int n_ca = (li == 0) ? 8 : 0, n_cb = (li == 0) ? 8 : 0, n_da = 512 * PROBE_DA, n_hy = 256 * PROBE_HY, n_na = 512 * PROBE_NA, n_hc = (li == 0) ? 256 * PROBE_PL : 0, n_pl = 1024 * PROBE_PL, n_pc = (li == 0) ? 16 : 0;
    const int total = n_ca + n_cb + n_da + n_hy + n_na + n_hc + n_pl + n_pc;
    for (;;) {
        __syncthreads();
        if (F.tid == 0) qs[0] = __hip_atomic_fetch_add(head, 1u, __ATOMIC_RELAXED, __HIP_MEMORY_SCOPE_AGENT);
        __syncthreads();
        int u = __builtin_amdgcn_readfirstlane((int)qs[0]);
        if (u >= total) break;
        Frame F = F0; refresh(F);
        if (u < n_ca) {
#ifndef SKIP_CA
            diffattn_unit(F, li, u >> 2, u & 3, (size_t)NLAT + (size_t)(u >> 2) * CTX, CTX / 64);
#endif
            continue; }
        u -= n_ca;
        if (u < n_cb) {
#ifndef SKIP_CB
            na_mfma_unit(F, li, u >> 2, (size_t)NLAT + (size_t)(u >> 2) * CTX + (size_t)(u & 3) * 64, -1);
#endif
            continue; }
        u -= n_cb;
        if (u < n_da) {
#ifndef SKIP_DA
            { const int v = u & 511; diffattn_unit(F, li, v >> 8, (v >> 6) & 3, (size_t)(v >> 8) * S + (size_t)(v & 63) * 256, NKEY / 64); }
#endif
            continue; }
        u -= n_da;
        if (u < n_hy) {
#ifndef SKIP_HY
            hyena_fft_unit(F, li, u & 255);
#endif
            continue; }
        u -= n_hy;
        if (u < n_na) {
#ifndef SKIP_NA
            { const int v = u & 511; na_mfma_unit(F, li, v >> 8, (size_t)(v >> 8) * S + (size_t)(v & 255) * GW, v & 255); }
#endif
            continue; }
        u -= n_na;
        if (u < n_hc) {
#ifndef SKIP_HC
            hyena_ctx_unit(F, li, u & 255);
#endif
            continue; }
        u -= n_hc;
        if (u < n_pl) {
#ifndef SKIP_PL
            { const int v = u & 1023; pool_unit(F, li, (size_t)(v >> 9) * S, S, (v & 511) * 32); }
#endif
            continue; }
        u -= n_pl;
#ifndef SKIP_PL
        pool_unit(F, li, (size_t)NLAT + (u >> 3) * CTX, CTX, (u & 7) * 32);
#endif
    }
}

constexpr int PH_PER_LAYER = 8, NPH = 2 + 2 * PH_PER_LAYER;
__global__ void __launch_bounds__(NTHR, 2) mega(Args args) {
    extern __shared__ __attribute__((aligned(16))) unsigned char smem[];
    Frame F;
    F.in = args.in; F.out = args.out; F.ws = args.ws; F.ctl = (unsigned*)(args.ws + WS_CTL); F.lds = smem;
    F.tid = threadIdx.x; F.lane = F.tid & 63; F.wave = __builtin_amdgcn_readfirstlane(F.tid >> 6); F.G = gridDim.x; F.bid = blockIdx.x;
    if (F.tid < 64) ((unsigned*)(smem + LDS_MISC))[F.tid] = 0u;
    __syncthreads();
    const int lo = args.ph_lo, hi = args.ph_hi;
    const bool fused = (hi - lo) > 1;
    XcdBarrier bar; bar.bar = F.ctl; bar.x = 0; bar.st = (volatile LAS unsigned*)(smem + LDS_MISC);
    if (fused) bar = xcd_barrier_post(F.ctl, (volatile LAS unsigned*)(smem + LDS_MISC));
#define IN(k) (lo <= (k) && (k) < hi)
#ifdef PROBE_BAR
#define SEAM(k) do { if (IN(k) && IN((k) + 1)) { xcd_barrier(bar); xcd_barrier(bar); xcd_barrier(bar); } } while (0)
#else
#define SEAM(k) do { if (IN(k) && IN((k) + 1)) xcd_barrier(bar); } while (0)
#endif
#ifndef SKIP_P0
    if (IN(0)) { refresh(F); phase_prologue(F);
#ifdef PROBE_MISC
        __syncthreads(); refresh(F); phase_prologue(F);
#endif
    }
#endif
    SEAM(0);
    for (int li = 0; li < 2; ++li) {
        const int p0 = 1 + li * PH_PER_LAYER;
        const int nrows = (li == 0) ? NTOK : NLAT;
        if (IN(p0)) {
            refresh(F);
            phase_norm1(F, li, li == 0 ? 0 : 1);
#ifdef PROBE_N1
            if (li == 0) { refresh(F); phase_norm1(F, li, 0); refresh(F); phase_norm1(F, li, 0); refresh(F); phase_norm1(F, li, 0); refresh(F); phase_norm1(F, li, 0); }
#endif
            refresh(F);
#ifndef SKIP_FILT
            for (int t = F.bid; t < 256; t += F.G) filter_tile(F, li, S, t, WSP(float, WS_FILT), WSP(float, WS_FPART));
            if (li == 0) for (int t = F.bid; t < 4; t += F.G) filter_tile(F, li, CTX, t, WSP(float, WS_FILTC), WSP(float, WS_FPARTC));
#ifdef PROBE_MISC
            for (int t = F.bid; t < 256; t += F.G) filter_tile(F, li, S, t, WSP(float, WS_FILT), WSP(float, WS_FPART));
#endif
#endif
        }
        SEAM(p0);
        if (IN(p0 + 1)) {
            refresh(F);
            pg8::Gemm g{WSP(bf16_t, WS_HBF), WSP(bf16_t, WS_WIN) + (size_t)li * DIN * D, D, 0};
            pg8::StaticOrder So; So.init(NTOK, DIN, F.G, F.bid);
            EpiIn E{F.ws, WSP(float, WS_ROPE), F.ctl + CW_KMAX + li * 16, F.ctl + CW_KMAXB + li * 16};
#ifndef SKIP_G1
            pg8::gemm_phase<EpiIn, pg8::StaticOrder>((LAS unsigned char*)smem, g, So, E, F.tid);
#ifdef PROBE_G1
            __syncthreads(); refresh(F); pg8::gemm_phase<EpiIn, pg8::StaticOrder>((LAS unsigned char*)smem, g, So, E, F.tid);
#endif
#endif
        }
        SEAM(p0 + 1);
        if (IN(p0 + 2)) { refresh(F); phase_mix(F, li); }
        SEAM(p0 + 2);
        if (IN(p0 + 3)) {
            refresh(F);
            pg8::Gemm g{WSP(bf16_t, WS_HBF), WSP(bf16_t, WS_WOUT) + (size_t)li * D * D, D, 0};
            pg8::StaticOrder So; So.init(nrows, D, F.G, F.bid);
            EpiOut E{li == 0 ? F.in[I_X] : F.out, li == 0 ? F.in[I_CTX] : WSP(float, WS_XC), F.out, WSP(float, WS_XC), WSP(float, WS_MOD) + (size_t)li * 3 * 6144};
#ifndef SKIP_G2
            pg8::gemm_phase<EpiOut, pg8::StaticOrder>((LAS unsigned char*)smem, g, So, E, F.tid);
#endif
        }
        SEAM(p0 + 3);
#ifndef SKIP_N2
        if (IN(p0 + 4)) { refresh(F); phase_norm2(F, li, nrows); }
#endif
        SEAM(p0 + 4);
        if (IN(p0 + 5)) { refresh(F); phase_gather(F, li, nrows);
#ifdef PROBE_MISC
            __syncthreads(); refresh(F); phase_gather(F, li, nrows);
#endif
        }
        SEAM(p0 + 5);
        if (IN(p0 + 6)) {
            refresh(F);
            int* offs = (int*)(smem + LDS_MISC + 64);
            moe_offsets(F, li, offs);
            pg8::Gemm g{WSP(bf16_t, WS_A1), WSP(bf16_t, WS_W13) + (size_t)li * NE * 1024 * 1024, D, (size_t)1024 * 1024};
            pg8::MoeOrder Mo{offs + 40, offs[17 + 16], 4, F.G, F.bid};
            EpiMoe1 E{WSP(bf16_t, WS_HMID)};
#ifndef SKIP_G3
            pg8::gemm_phase<EpiMoe1, pg8::MoeOrder>((LAS unsigned char*)smem, g, Mo, E, F.tid);
#ifdef PROBE_G3
            __syncthreads(); refresh(F); pg8::gemm_phase<EpiMoe1, pg8::MoeOrder>((LAS unsigned char*)smem, g, Mo, E, F.tid);
#endif
#endif
        }
        SEAM(p0 + 6);
        if (IN(p0 + 7)) {
            refresh(F);
            int* offs = (int*)(smem + LDS_MISC + 64);
            moe_offsets(F, li, offs);
            pg8::Gemm g{WSP(bf16_t, WS_HMID), WSP(bf16_t, WS_W2) + (size_t)li * NE * 1024 * 512, DE, (size_t)1024 * 512};
            pg8::MoeOrder Mo{offs + 40, offs[17 + 16], 4, F.G, F.bid};
            EpiMoe2 E{WSP(bf16_t, WS_A1)};
#ifndef SKIP_G4
            pg8::gemm_phase<EpiMoe2, pg8::MoeOrder>((LAS unsigned char*)smem, g, Mo, E, F.tid);
#ifdef PROBE_G4
            __syncthreads(); refresh(F); pg8::gemm_phase<EpiMoe2, pg8::MoeOrder>((LAS unsigned char*)smem, g, Mo, E, F.tid);
#endif
#endif
        }
        SEAM(p0 + 7);
    }
    if (IN(NPH - 1)) { refresh(F); phase_norm1(F, 1, 2); }
#undef IN
#undef SEAM
}

extern "C" void kernel_launch(void* const* d_in, const int* in_sizes, int n_in, void* d_out, int out_size, void* d_ws, size_t ws_size, hipStream_t stream) {
    static int grid = 0;
    if (grid == 0) {
        if (n_in != N_IN || out_size != NLAT * D || ws_size < WS_END) { fprintf(stderr, "kernel_launch: unexpected shapes (n_in %d out %d ws %zu need %zu)\n", n_in, out_size, ws_size, (size_t)WS_END); grid = -1; return; }
        int dev = 0, cus = 0, per_cu = 0;
        if (hipGetDevice(&dev) != hipSuccess || hipDeviceGetAttribute(&cus, hipDeviceAttributeMultiprocessorCount, dev) != hipSuccess) { grid = -1; return; }
        if (hipFuncSetAttribute((const void*)mega, hipFuncAttributeMaxDynamicSharedMemorySize, LDS_BYTES) != hipSuccess) { fprintf(stderr, "kernel_launch: hipFuncSetAttribute failed\n"); grid = -1; return; }
        if (hipOccupancyMaxActiveBlocksPerMultiprocessor(&per_cu, (const void*)mega, NTHR, LDS_BYTES) != hipSuccess || per_cu < 1) { fprintf(stderr, "kernel_launch: occupancy query says %d\n", per_cu); }
        (void)hipGetLastError();
        grid = cus < MAXG ? cus : MAXG;
    }
    if (grid < 0) return;
    (void)hipMemsetAsync((char*)d_ws + WS_CTL, 0, CTL_BYTES, stream);
    Args a{};
    for (int i = 0; i < N_IN; ++i) a.in[i] = (const float*)d_in[i];
    a.out = (float*)d_out; a.ws = (unsigned char*)d_ws;
#if N_LAUNCH_MODE == 1
    a.ph_lo = 0; a.ph_hi = NPH;
    hipLaunchKernelGGL(mega, dim3(grid), dim3(NTHR), LDS_BYTES, stream, a);
#else
    for (int p = 0; p < NPH; ++p) { a.ph_lo = p; a.ph_hi = p + 1; hipLaunchKernelGGL(mega, dim3(grid), dim3(NTHR), LDS_BYTES, stream, a); }
#endif
}
#ifdef TEST_UNITS
__global__ void __launch_bounds__(NTHR, 2) t_da(Args args) {
    extern __shared__ __attribute__((aligned(16))) unsigned char smem[];
    Frame F; F.in = args.in; F.out = args.out; F.ws = args.ws; F.ctl = (unsigned*)(args.ws + WS_CTL); F.lds = smem; F.G = gridDim.x; F.bid = blockIdx.x; refresh(F);
    diffattn_unit(F, args.ph_lo, blockIdx.x >> 8, (blockIdx.x >> 6) & 3, (size_t)(blockIdx.x & 63) * 256, NKEY / 64);
}
__global__ void __launch_bounds__(NTHR, 2) t_hy(Args args) {
    extern __shared__ __attribute__((aligned(16))) unsigned char smem[];
    Frame F; F.in = args.in; F.out = args.out; F.ws = args.ws; F.ctl = (unsigned*)(args.ws + WS_CTL); F.lds = smem; F.G = gridDim.x; F.bid = blockIdx.x; refresh(F);
    hyena_fft_unit(F, args.ph_lo, blockIdx.x);
}
#endif
```

```cpp
#include <hip/hip_runtime.h>
#include <stdint.h>
#include <stdio.h>

#ifndef N_LAUNCH_MODE
#define N_LAUNCH_MODE 1
#endif

#define DI __device__ __forceinline__
#define LAS __attribute__((address_space(3)))
typedef unsigned short bf16_t;
typedef short bf16x8 __attribute__((ext_vector_type(8)));
typedef short s16x4 __attribute__((ext_vector_type(4)));
typedef float f32x4 __attribute__((ext_vector_type(4)));
typedef float f32x2 __attribute__((ext_vector_type(2)));
typedef float f32x16 __attribute__((ext_vector_type(16)));
typedef unsigned u32x4 __attribute__((ext_vector_type(4)));
typedef unsigned u32x2 __attribute__((ext_vector_type(2)));
typedef _Float16 h16x2 __attribute__((ext_vector_type(2)));

constexpr int D = 1024, NB = 2, S = 16384, CTX = 256, NLAT = NB * S, NCTX = NB * CTX, NTOK = NLAT + NCTX, DIN = 2560;
constexpr int NE = 16, DE = 512, GW = 64;
constexpr int NKEY = CTX + S;
constexpr int NTHR = 512;
constexpr int SLOT_CAP = 70656;
constexpr float EPS = 1e-6f;
constexpr float LOG2E = 1.4426950408889634f;
constexpr float QSCALE_A = 0.17677669529663687f * LOG2E;
constexpr float QSCALE_B = 0.125f * LOG2E;

enum { I_X = 0, I_C, I_CTX, I_CCTX, I_N1G, I_N2G, I_ADAW, I_ADAB, I_WIN, I_WOUT, I_ALAM, I_ASUB, I_RPB, I_POOLW, I_POOLS, I_HYSW, I_HYSB,
       I_HW1, I_HB1, I_HW2, I_HB2, I_HW3, I_HB3, I_HSKIP, I_RW, I_RB, I_MW1, I_MW3, I_MW2, I_FG, N_IN };

struct Args { const float* in[N_IN]; float* out; unsigned char* ws; int ph_lo, ph_hi; };

constexpr size_t al256(size_t x) { return (x + 255) & ~(size_t)255; }
constexpr size_t WS_CTL = 0, CTL_BYTES = 65536;
constexpr size_t WS_MOD = WS_CTL + CTL_BYTES;
constexpr size_t WS_ROPE = WS_MOD + al256(2 * 3 * 6144 * 4);
constexpr size_t WS_FPART = WS_ROPE + 16384;
constexpr size_t WS_FPARTC = WS_FPART + 256 * 1024 * 4;
constexpr size_t WS_XC = WS_FPARTC + 4 * 1024 * 4;
constexpr size_t WS_WIN = WS_XC + (size_t)NCTX * D * 4;
constexpr size_t WS_WOUT = WS_WIN + (size_t)2 * DIN * D * 2;
constexpr size_t WS_W13 = WS_WOUT + (size_t)2 * D * D * 2;
constexpr size_t WS_W2 = WS_W13 + (size_t)2 * NE * 1024 * 1024 * 2;
constexpr size_t WS_FILT = WS_W2 + (size_t)2 * NE * 1024 * 512 * 2;
constexpr size_t WS_FILTC = WS_FILT + (size_t)4 * 256 * S * 4;
constexpr size_t WS_ZBUF = WS_FILTC + (size_t)4 * 256 * 256 * 4;
constexpr size_t WS_R1 = WS_ZBUF + (size_t)256 * 2 * S * 4;
constexpr size_t WS_HBF = WS_R1;
constexpr size_t TOKB = (size_t)NTOK * 256 * 2;
constexpr size_t WS_AQ = WS_HBF + (size_t)NTOK * D * 2;
constexpr size_t WS_AK = WS_AQ + TOKB;
constexpr size_t WS_AVT = WS_AK + TOKB;
constexpr size_t WS_BQ = WS_AVT + (size_t)NB * 4 * 64 * NKEY * 2;
constexpr size_t WS_BK = WS_BQ + TOKB;
constexpr size_t WS_BVT = WS_BK + TOKB;
constexpr size_t WS_PL = WS_BVT + (size_t)NB * 4 * 64 * NKEY * 2;
constexpr size_t WS_HYT = WS_PL + TOKB;
constexpr size_t WS_HYC = WS_HYT + (size_t)NB * 768 * S * 2;
constexpr size_t WS_Z1BUF = WS_HYC + (size_t)NCTX * 768 * 2;
constexpr size_t WS_END_MIX = WS_Z1BUF + (size_t)256 * S * 8;
constexpr size_t WS_TOK = WS_AQ;
constexpr size_t WS_A1 = WS_TOK + al256((size_t)NTOK * 32);
constexpr size_t WS_HMID = WS_A1 + (size_t)SLOT_CAP * D * 2;
constexpr size_t WS_END_MOE = WS_HMID + (size_t)SLOT_CAP * DE * 2;
constexpr size_t WS_END = WS_END_MIX > WS_END_MOE ? WS_END_MIX : WS_END_MOE;

#define XB_TMO      128
#define XB_XCNT(j)  (256  + 64 * (j))
#define XB_XSUB(j)  (1280 + 64 * (j))
#define XB_XGEN(j)  (2304 + 64 * (j))
#define XB_TOP      3328
#define XB_TOPGEN   3392
#define XCD_BAR_WORDS 3456
#define XB_SPIN_CAP (1u << 18)
constexpr int CW_CNT = 4096;
constexpr int CW_KMAX = 4160;
constexpr int CW_KMAXB = 4192;
constexpr int CW_QHEAD = 4224;
constexpr int CW_BCNT = 4352;
constexpr int MAXG = 256;

constexpr int LDS_MAIN = 143360, LDS_MISC = LDS_MAIN, LDS_BYTES = LDS_MAIN + 2048;

DI float bf2f(bf16_t v) { return __uint_as_float(((unsigned)v) << 16); }
DI bf16_t f2bf(float f) { unsigned u = __float_as_uint(f); u += 0x7FFFu + ((u >> 16) & 1u); return (bf16_t)(u >> 16); }
DI unsigned pk2(float lo, float hi) { unsigned r; asm volatile("v_cvt_pk_bf16_f32 %0, %1, %2" : "=v"(r) : "v"(lo), "v"(hi)); return r; }
template <int K> DI float swz_xor(float v) { return __int_as_float(__builtin_amdgcn_ds_swizzle(__float_as_int(v), (K << 10) | 0x1F)); }
DI float half_sum(float v) { const auto r = __builtin_amdgcn_permlane32_swap(__float_as_uint(v), __float_as_uint(v), false, false); return __uint_as_float(r[0]) + __uint_as_float(r[1]); }
DI float half_max(float v) { const auto r = __builtin_amdgcn_permlane32_swap(__float_as_uint(v), __float_as_uint(v), false, false); return fmaxf(__uint_as_float(r[0]), __uint_as_float(r[1])); }
DI float wave_sum(float v) { v += swz_xor<16>(v); v += swz_xor<8>(v); v += swz_xor<4>(v); v += swz_xor<2>(v); v += swz_xor<1>(v); return half_sum(v); }
DI float wave_max(float v) { v = fmaxf(v, swz_xor<16>(v)); v = fmaxf(v, swz_xor<8>(v)); v = fmaxf(v, swz_xor<4>(v)); v = fmaxf(v, swz_xor<2>(v)); v = fmaxf(v, swz_xor<1>(v)); return half_max(v); }
DI float siluf(float x) { return x / (1.f + __expf(-x)); }
DI float sin_rev(float rev) { return __builtin_amdgcn_sinf(rev - floorf(rev)); }
DI float cos_rev(float rev) { return __builtin_amdgcn_cosf(rev - floorf(rev)); }
DI float sin_rad(float x) { return sin_rev(x * 0.15915494309189535f); }

DI unsigned xb_ld(unsigned* p)              { return __hip_atomic_load(p, __ATOMIC_RELAXED, __HIP_MEMORY_SCOPE_AGENT); }
DI unsigned xb_add(unsigned* p, unsigned v) { return __hip_atomic_fetch_add(p, v, __ATOMIC_RELAXED, __HIP_MEMORY_SCOPE_AGENT); }
DI unsigned xb_xcc_id() { return (unsigned)__builtin_amdgcn_s_getreg((3 << 11) | 20) & 0xFu; }
#define XB_SPIN(cond, bar) do { unsigned _sp = 0; while (cond) { __builtin_amdgcn_s_sleep(1); \
    if ((++_sp & 255u) == 0u) { if (xb_ld(&(bar)[XB_TMO])) break; if (_sp > XB_SPIN_CAP) { atomicAdd(&(bar)[XB_TMO], 1u); break; } } } } while (0)
struct XcdBarrier { unsigned* bar; unsigned x; volatile LAS unsigned* st; };
DI XcdBarrier xcd_barrier_post(unsigned* bar, volatile LAS unsigned* st) {
    XcdBarrier b; b.bar = bar; b.x = xb_xcc_id(); b.st = st;
    if (threadIdx.x == 0) (void)xb_add(&bar[XB_XCNT(b.x)], 1u);
    return b;
}
DI void xcd_barrier_complete(unsigned* bar, unsigned x, unsigned& nloc, unsigned& nx) {
    const unsigned G = gridDim.x * gridDim.y * gridDim.z;
    unsigned sum, cnt, mine, sp = 0u;
    for (;;) {
        sum = 0u; cnt = 0u; mine = 0u;
#pragma unroll
        for (unsigned j = 0; j < 16; ++j) { const unsigned c = xb_ld(&bar[XB_XCNT(j)]); sum += c; cnt += (c > 0u) ? 1u : 0u; mine = (j == x) ? c : mine; }
        if (sum == G) break;
        __builtin_amdgcn_s_sleep(1);
        if ((++sp & 255u) == 0u) { if (xb_ld(&bar[XB_TMO])) break; if (sp > XB_SPIN_CAP) { atomicAdd(&bar[XB_TMO], 1u); break; } }
    }
    nloc = mine > 0u ? mine : 1u; nx = cnt > 0u ? cnt : 1u;
}
DI void xcd_barrier(const XcdBarrier& b) {
    asm volatile("s_waitcnt vmcnt(0)" ::: "memory");
    __syncthreads();
    if (threadIdx.x == 0) {
        unsigned* bar = b.bar;
        __builtin_amdgcn_s_waitcnt(0);
        unsigned nloc = b.st[0], nx = b.st[1];
        if (nloc == 0u) { xcd_barrier_complete(bar, b.x, nloc, nx); b.st[0] = nloc; b.st[1] = nx; }
        const unsigned old = xb_add(&bar[XB_XSUB(b.x)], 1u);
        const unsigned gen = old / nloc;
        if (old + 1u == (gen + 1u) * nloc) {
            __builtin_amdgcn_fence(__ATOMIC_RELEASE, "agent");
            asm volatile("s_waitcnt vmcnt(0)" ::: "memory");
            const unsigned og = xb_add(&bar[XB_TOP], 1u);
            const unsigned tg = og / nx;
            if (og + 1u == (tg + 1u) * nx) xb_add(&bar[XB_TOPGEN], 1u);
            else XB_SPIN(xb_ld(&bar[XB_TOPGEN]) == tg, bar);
            __builtin_amdgcn_fence(__ATOMIC_ACQUIRE, "agent");
            xb_add(&bar[XB_XGEN(b.x)], 1u);
            asm volatile("s_waitcnt vmcnt(0)" ::: "memory");
        } else {
            XB_SPIN(xb_ld(&bar[XB_XGEN(b.x)]) == gen, bar);
            __builtin_amdgcn_fence(__ATOMIC_ACQUIRE, "agent");
            asm volatile("s_waitcnt vmcnt(0)" ::: "memory");
        }
    }
    __syncthreads();
}

struct Frame {
    const float* const* in; float* out; unsigned char* ws; unsigned* ctl;
    unsigned char* lds;
    int tid, lane, wave, G, bid;
};
#define WSP(T, off) ((T*)(F.ws + (off)))
DI void refresh(Frame& F) { int t = threadIdx.x; asm volatile("" : "+v"(t)); F.tid = t; F.lane = t & 63; F.wave = __builtin_amdgcn_readfirstlane(t >> 6);
}

namespace pg8 {
constexpr int BM = 256, BK = 64, HALF = 128, HTB = HALF * BK * 2, STAGE_BYTES = 8 * HTB, NXCD = 8, WGM = 8;
DI int lds_byte(int r, int c) { const int st = (r >> 4) * 2 + (c >> 5), rr = r & 15, cc = c & 31, ob = rr * 64 + cc * 2; return st * 1024 + (ob ^ (((ob >> 9) & 1) << 5)); }
DI void stage_rc(int b, int& R, int& C) { const int st = b / 1024, sb = b % 1024, swz = sb ^ (((sb >> 9) & 1) << 5); R = (st >> 1) * 16 + swz / 64; C = (st & 1) * 32 + (swz % 64) / 2; }
struct Unit { int pm, pn, e; };
struct Gemm { const bf16_t* A; const bf16_t* Bt; int K; size_t bstride; };
struct StaticOrder {
    int nM, nN, nwg, G, c;
    DI void init(int M, int N, int G_, int c_) { nM = M / BM; nN = N / BM; nwg = nM * nN; G = G_; c = c_; }
    DI bool next(int i, Unit& u) const {
        const long L = (long)i * G + c; if (L >= nwg) return false;
        int wgid = (int)L; { const int q = nwg / NXCD, r = nwg % NXCD, xcd = wgid % NXCD, off = wgid / NXCD; wgid = (xcd < r ? xcd * (q + 1) : r * (q + 1) + (xcd - r) * q) + off; }
        const int nig = WGM * nN, gid = wgid / nig, fm = gid * WGM, gsz = (nM - fm) < WGM ? (nM - fm) : WGM;
        u.pm = fm + ((wgid % nig) % gsz); u.pn = (wgid % nig) / gsz; u.e = 0; return true;
    }
};
struct MoeOrder {
    const int* toff; int ntile, nN, G, c;
    DI bool next(int i, Unit& u) const {
        const long L = (long)i * G + c; if (L >= (long)ntile * nN) return false;
        const int t = (int)(L / nN); u.pm = t; u.pn = (int)(L % nN);
        u.e = toff[t]; return true;
    }
};

template <class Epi, class Sched>
DI void gemm_phase(LAS unsigned char* lds, const Gemm g, const Sched& S, const Epi& E, int tid) {
    const int wid = __builtin_amdgcn_readfirstlane(tid >> 6), lane = tid & 63, wr = wid >> 2, wc = wid & 3, fr = lane & 15, fq = lane >> 4;
    const int K = g.K, nt = K / BK;
    unsigned voffA[2];
#pragma unroll
    for (int i = 0; i < 2; ++i) { int R, C; stage_rc(tid * 16 + i * 8192, R, C); voffA[i] = (unsigned)(R * K + C) * 2u; }
    const size_t kstep = (size_t)(BK * 2);
    const size_t hstep = (size_t)HALF * K * 2;
    const size_t tstep = 2 * hstep;
    const unsigned ldsw = (unsigned)wid * 1024u;
    const int aoff = lds_byte(wr * 64 + fr, fq * 8), boff = lds_byte(wc * 32 + fr, fq * 8);
#define PG8_SA(b, h) (((b) * 2 + (h)) * HTB)
#define PG8_SB(b, h) ((4 + (b) * 2 + (h)) * HTB)
#define PG8_STAGE(bufoff, gbase, voff) do { _Pragma("unroll") for (int _i = 0; _i < 2; ++_i) \
        __builtin_amdgcn_global_load_lds((const unsigned*)((const char*)(gbase) + (voff)[_i]), (LAS unsigned*)(lds + (bufoff) + ldsw + _i * 8192), 16, 0, 0); } while (0)
#define PG8_LDA(dst, b, h) do { _Pragma("unroll") for (int m = 0; m < 4; ++m) _Pragma("unroll") for (int k = 0; k < 2; ++k) dst[m][k] = *(const LAS bf16x8*)(lds + PG8_SA(b, h) + aoff + m * 2048 + k * 1024); } while (0)
#define PG8_LDB(dst, b, h) do { _Pragma("unroll") for (int n = 0; n < 2; ++n) _Pragma("unroll") for (int k = 0; k < 2; ++k) dst[n][k] = *(const LAS bf16x8*)(lds + PG8_SB(b, h) + boff + n * 2048 + k * 1024); } while (0)
#define PG8_MMA(ai, bj, At, Bt) do { __builtin_amdgcn_s_setprio(1); _Pragma("unroll") for (int m = 0; m < 4; ++m) _Pragma("unroll") for (int n = 0; n < 2; ++n) _Pragma("unroll") for (int k = 0; k < 2; ++k) \
        acc[ai][bj][m][n] = __builtin_amdgcn_mfma_f32_16x16x32_bf16(Bt[n][k], At[m][k], acc[ai][bj][m][n], 0, 0, 0); __builtin_amdgcn_s_setprio(0); } while (0)
#define PG8_WAIT_V(n) asm volatile("s_waitcnt vmcnt(" #n ")" ::: "memory")
#define PG8_WAIT_L(n) asm volatile("s_waitcnt lgkmcnt(" #n ")" ::: "memory")
#define PG8_BAR __builtin_amdgcn_s_barrier()
#define PG8_SCHED __builtin_amdgcn_sched_barrier(0)
    Unit cur, nxt; int ui = 0;
    if (!S.next(0, cur)) return;
    f32x4 acc[2][2][4][2];
#pragma unroll
    for (int a = 0; a < 2; ++a)
#pragma unroll
        for (int b = 0; b < 2; ++b)
#pragma unroll
            for (int m = 0; m < 4; ++m)
#pragma unroll
                for (int n = 0; n < 2; ++n) acc[a][b][m][n] = (f32x4){0.f, 0.f, 0.f, 0.f};
    bf16x8 At[4][2], B0[2][2], B1[2][2];
    const char* cA = (const char*)g.A + (size_t)cur.pm * tstep; const char* cB = (const char*)(g.Bt + (size_t)cur.e * g.bstride) + (size_t)cur.pn * tstep;
    PG8_STAGE(PG8_SB(0, 0), cB, voffA); PG8_STAGE(PG8_SA(0, 0), cA, voffA); PG8_STAGE(PG8_SB(0, 1), cB + hstep, voffA); PG8_STAGE(PG8_SA(0, 1), cA + hstep, voffA);
    if (wr == 1) PG8_BAR;
    PG8_WAIT_V(4); PG8_BAR;
    PG8_STAGE(PG8_SB(1, 0), cB + kstep, voffA); PG8_STAGE(PG8_SA(1, 0), cA + kstep, voffA); PG8_STAGE(PG8_SB(1, 1), cB + hstep + kstep, voffA);
    PG8_WAIT_V(6); PG8_BAR;
    for (;;) {
        const bool has_next = S.next(ui + 1, nxt);
        const char* nA = has_next ? (const char*)g.A + (size_t)nxt.pm * tstep : cA; const char* nB = has_next ? (const char*)(g.Bt + (size_t)nxt.e * g.bstride) + (size_t)nxt.pn * tstep : cB;
        for (int t = 0; t < nt; t += 2) {
            const bool last = (t == nt - 2);
            const char* a1 = cA + (size_t)(t + 1) * kstep;
            const char* a2 = last ? nA : cA + (size_t)(t + 2) * kstep; const char* b2 = last ? nB : cB + (size_t)(t + 2) * kstep;
            const char* a3 = a2 + kstep; const char* b3 = b2 + kstep;
            PG8_LDB(B0, 0, 0); PG8_SCHED; PG8_LDA(At, 0, 0); PG8_STAGE(PG8_SA(1, 1), a1 + hstep, voffA);
            PG8_WAIT_L(8); PG8_BAR; PG8_WAIT_L(0); PG8_MMA(0, 0, At, B0); PG8_BAR; PG8_SCHED;
            PG8_LDB(B1, 0, 1); PG8_STAGE(PG8_SB(0, 0), b2, voffA);
            PG8_BAR; PG8_WAIT_L(0); PG8_MMA(0, 1, At, B1); PG8_BAR;
            PG8_LDA(At, 0, 1); PG8_STAGE(PG8_SA(0, 0), a2, voffA);
            PG8_BAR; PG8_WAIT_L(0); PG8_MMA(1, 0, At, B0); PG8_BAR; PG8_SCHED;
            PG8_STAGE(PG8_SB(0, 1), b2 + hstep, voffA);
            PG8_WAIT_V(6); PG8_BAR; PG8_MMA(1, 1, At, B1); PG8_BAR;
            PG8_LDB(B0, 1, 0); PG8_SCHED; PG8_LDA(At, 1, 0); PG8_STAGE(PG8_SA(0, 1), a2 + hstep, voffA);
            PG8_WAIT_L(8); PG8_BAR; PG8_WAIT_L(0); PG8_MMA(0, 0, At, B0); PG8_BAR; PG8_SCHED;
            PG8_LDB(B1, 1, 1); PG8_STAGE(PG8_SB(1, 0), b3, voffA);
            PG8_BAR; PG8_WAIT_L(0); PG8_MMA(0, 1, At, B1); PG8_BAR;
            PG8_LDA(At, 1, 1); PG8_STAGE(PG8_SA(1, 0), a3, voffA);
            PG8_BAR; PG8_WAIT_L(0); PG8_MMA(1, 0, At, B0); PG8_BAR; PG8_SCHED;
            PG8_STAGE(PG8_SB(1, 1), b3 + hstep, voffA);
            PG8_WAIT_V(6); PG8_BAR; PG8_MMA(1, 1, At, B1); PG8_BAR;
        }
        E(acc, cur, wr, wc, fr, fq);
        if (!has_next) break;
#pragma unroll
        for (int a = 0; a < 2; ++a)
#pragma unroll
            for (int b = 0; b < 2; ++b)
#pragma unroll
                for (int m = 0; m < 4; ++m)
#pragma unroll
                    for (int n = 0; n < 2; ++n) acc[a][b][m][n] = (f32x4){0.f, 0.f, 0.f, 0.f};
        cur = nxt; cA = nA; cB = nB; ++ui;
    }
    PG8_WAIT_V(0);
    if (wr == 0) PG8_BAR;
    PG8_BAR;
#undef PG8_SA
#undef PG8_SB
#undef PG8_STAGE
#undef PG8_LDA
#undef PG8_LDB
#undef PG8_MMA
#undef PG8_WAIT_V
#undef PG8_WAIT_L
#undef PG8_BAR
#undef PG8_SCHED
}
}

typedef f32x4 AccT[2][2][4][2];

struct EpiIn {
    unsigned char* ws; const float* rope; unsigned* kmax; unsigned* kmaxb;
    DI void operator()(const AccT& acc, const pg8::Unit& u, int wr, int wc, int fr, int fq) const {
        const int pn = u.pn, row0 = u.pm * 256 + wr * 64 + fr;
        const bool isctx = (u.pm >= NLAT / 256);
        if (pn <= 1) {
            bf16_t* dst = (bf16_t*)(ws + (pn == 0 ? WS_AQ : WS_AK));
            const float sc = (pn == 0) ? QSCALE_A : 1.f;
            float nmax[2] = {0.f, 0.f};
#pragma unroll
            for (int ai = 0; ai < 2; ++ai)
#pragma unroll
                for (int m = 0; m < 4; ++m) {
                    const int r = row0 + ai * 128 + m * 16;
                    f32x4 cs0 = (f32x4){1.f, 0.f, 1.f, 0.f}, cs1 = cs0;
                    if (!isctx) { const int t = r & (S - 1); const int pos = (fq < 2) ? (t >> 6) : (t & 63);
                        const f32x4* tp = (const f32x4*)(rope + (size_t)pos * 16 + (fq & 1) * 8); cs0 = tp[0]; cs1 = tp[1]; }
                    const float cc[4] = {cs0[0], cs0[2], cs1[0], cs1[2]}, ss[4] = {cs0[1], cs0[3], cs1[1], cs1[3]};
#pragma unroll
                    for (int bj = 0; bj < 2; ++bj) {
                        const f32x4 x1 = acc[ai][bj][m][0], x2 = acc[ai][bj][m][1];
                        float o1[4], o2[4], n2 = 0.f;
#pragma unroll
                        for (int j = 0; j < 4; ++j) { o1[j] = (x1[j] * cc[j] - x2[j] * ss[j]) * sc; o2[j] = (x2[j] * cc[j] + x1[j] * ss[j]) * sc; n2 += x1[j] * x1[j] + x2[j] * x2[j]; }
                        bf16_t* p = dst + (size_t)r * 256 + bj * 128 + wc * 32 + 4 * fq;
                        *(u32x2*)p = (u32x2){pk2(o1[0], o1[1]), pk2(o1[2], o1[3])};
                        *(u32x2*)(p + 16) = (u32x2){pk2(o2[0], o2[1]), pk2(o2[2], o2[3])};
                        if (pn == 1) { n2 += swz_xor<16>(n2); n2 = half_sum(n2); nmax[bj] = fmaxf(nmax[bj], n2); }
                    }
                }
            if (pn == 1) {
                const int b = isctx ? (u.pm - NLAT / 256) : (u.pm / (S / 256));
#pragma unroll
                for (int bj = 0; bj < 2; ++bj) {
                    float v = nmax[bj];
                    v = fmaxf(v, swz_xor<1>(v)); v = fmaxf(v, swz_xor<2>(v)); v = fmaxf(v, swz_xor<4>(v)); v = fmaxf(v, swz_xor<8>(v));
                    if ((fr | fq) == 0) atomicMax(kmax + (b * 4 + (2 * bj + (wc >> 1))) * 2 + (wc & 1), __float_as_uint(v));
                }
            }
        } else if (pn == 2 || pn == 5) {
            bf16_t* dst = (bf16_t*)(ws + (pn == 2 ? WS_AVT : WS_BVT));
#pragma unroll
            for (int ai = 0; ai < 2; ++ai)
#pragma unroll
                for (int m = 0; m < 4; ++m) {
                    const int r = row0 + ai * 128 + m * 16;
                    int b, key; if (isctx) { b = (r - NLAT) >> 8; key = (r - NLAT) & 255; } else { b = r >> 14; key = CTX + (r & (S - 1)); }
#pragma unroll
                    for (int bj = 0; bj < 2; ++bj)
#pragma unroll
                        for (int n = 0; n < 2; ++n) {
                            const int lc = bj * 128 + wc * 32 + n * 16 + 4 * fq;
#pragma unroll
                            for (int j = 0; j < 4; ++j) dst[((size_t)(b * 256 + lc + j)) * NKEY + key] = f2bf(acc[ai][bj][m][n][j]);
                        }
                }
        } else if (pn <= 6) {
            bf16_t* dst = (bf16_t*)(ws + (pn == 3 ? WS_BQ : pn == 4 ? WS_BK : WS_PL));
            const float sc = (pn == 3) ? QSCALE_B : 1.f;
            float nmax[2] = {0.f, 0.f};
#pragma unroll
            for (int ai = 0; ai < 2; ++ai)
#pragma unroll
                for (int m = 0; m < 4; ++m) {
                    const int r = row0 + ai * 128 + m * 16;
#pragma unroll
                    for (int bj = 0; bj < 2; ++bj)
#pragma unroll
                        for (int n = 0; n < 2; ++n) {
                            const f32x4 v = acc[ai][bj][m][n] * sc;
                            *(u32x2*)(dst + (size_t)r * 256 + bj * 128 + wc * 32 + n * 16 + 4 * fq) = (u32x2){pk2(v[0], v[1]), pk2(v[2], v[3])};
                        }
                    if (pn == 4) {
#pragma unroll
                        for (int bj = 0; bj < 2; ++bj) { const f32x4 x1 = acc[ai][bj][m][0], x2 = acc[ai][bj][m][1];
                            float n2 = x1[0] * x1[0] + x1[1] * x1[1] + x1[2] * x1[2] + x1[3] * x1[3] + x2[0] * x2[0] + x2[1] * x2[1] + x2[2] * x2[2] + x2[3] * x2[3];
                            n2 += swz_xor<16>(n2); n2 = half_sum(n2); nmax[bj] = fmaxf(nmax[bj], n2); }
                    }
                }
            if (pn == 4) {
                const int b = isctx ? (u.pm - NLAT / 256) : (u.pm / (S / 256));
#pragma unroll
                for (int bj = 0; bj < 2; ++bj) {
                    float v = nmax[bj];
                    v = fmaxf(v, swz_xor<1>(v)); v = fmaxf(v, swz_xor<2>(v)); v = fmaxf(v, swz_xor<4>(v)); v = fmaxf(v, swz_xor<8>(v));
                    if ((fr | fq) == 0) atomicMax(kmaxb + (b * 4 + (2 * bj + (wc >> 1))) * 2 + (wc & 1), __float_as_uint(v));
                }
            }
        } else {
            const int hc0 = (pn - 7) * 256;
#pragma unroll
            for (int ai = 0; ai < 2; ++ai)
#pragma unroll
                for (int m = 0; m < 4; ++m) {
                    const int r = row0 + ai * 128 + m * 16;
#pragma unroll
                    for (int bj = 0; bj < 2; ++bj)
#pragma unroll
                        for (int n = 0; n < 2; ++n) {
                            const int hc = hc0 + bj * 128 + wc * 32 + n * 16 + 4 * fq; const f32x4 v = acc[ai][bj][m][n];
                            if (isctx) *(u32x2*)((bf16_t*)(ws + WS_HYC) + (size_t)(r - NLAT) * 768 + hc) = (u32x2){pk2(v[0], v[1]), pk2(v[2], v[3])};
                            else { bf16_t* dst = (bf16_t*)(ws + WS_HYT) + ((size_t)(r >> 14) * 768 + hc) * S + (r & (S - 1));
#pragma unroll
                                for (int j = 0; j < 4; ++j) dst[(size_t)j * S] = f2bf(v[j]); }
                        }
                }
        }
    }
};

struct EpiOut {
    const float* xl_old; const float* xc_old; float* xl_new; float* xc_new; const float* mod;
    DI void operator()(const AccT& acc, const pg8::Unit& u, int wr, int wc, int fr, int fq) const {
        const int row0 = u.pm * 256 + wr * 64 + fr; const bool isctx = (u.pm >= NLAT / 256);
        const int v = isctx ? 2 : (u.pm / (S / 256));
        const float* g1 = mod + (size_t)v * 6144 + 2 * 1024;
        const float* so = isctx ? xc_old - (size_t)NLAT * D : xl_old; float* dn = isctx ? xc_new - (size_t)NLAT * D : xl_new;
#pragma unroll
        for (int bj = 0; bj < 2; ++bj)
#pragma unroll
            for (int n = 0; n < 2; ++n) {
                const int c = u.pn * 256 + bj * 128 + wc * 32 + n * 16 + 4 * fq;
                const f32x4 g = *(const f32x4*)(g1 + c);
#pragma unroll
                for (int ai = 0; ai < 2; ++ai)
#pragma unroll
                    for (int m = 0; m < 4; ++m) {
                        const size_t o = (size_t)(row0 + ai * 128 + m * 16) * D + c;
                        *(f32x4*)(dn + o) = *(const f32x4*)(so + o) + g * acc[ai][bj][m][n];
                    }
            }
    }
};

struct EpiMoe1 {
    bf16_t* hmid;
    DI void operator()(const AccT& acc, const pg8::Unit& u, int wr, int wc, int fr, int fq) const {
        const int row0 = u.pm * 256 + wr * 64 + fr;
#pragma unroll
        for (int ai = 0; ai < 2; ++ai)
#pragma unroll
            for (int m = 0; m < 4; ++m)
#pragma unroll
                for (int bj = 0; bj < 2; ++bj) {
                    const f32x4 a = acc[ai][bj][m][0], b = acc[ai][bj][m][1]; float h[4];
#pragma unroll
                    for (int j = 0; j < 4; ++j) h[j] = siluf(a[j]) * b[j];
                    *(u32x2*)(hmid + (size_t)(row0 + ai * 128 + m * 16) * DE + (u.pn * 256 + bj * 128 + wc * 32) / 2 + 4 * fq) = (u32x2){pk2(h[0], h[1]), pk2(h[2], h[3])};
                }
    }
};
struct EpiMoe2 {
    bf16_t* ys;
    DI void operator()(const AccT& acc, const pg8::Unit& u, int wr, int wc, int fr, int fq) const {
        const int row0 = u.pm * 256 + wr * 64 + fr;
#pragma unroll
        for (int ai = 0; ai < 2; ++ai)
#pragma unroll
            for (int m = 0; m < 4; ++m)
#pragma unroll
                for (int bj = 0; bj < 2; ++bj)
#pragma unroll
                    for (int n = 0; n < 2; ++n) { const f32x4 v = acc[ai][bj][m][n];
                        *(u32x2*)(ys + (size_t)(row0 + ai * 128 + m * 16) * D + u.pn * 256 + bj * 128 + wc * 32 + n * 16 + 4 * fq) = (u32x2){pk2(v[0], v[1]), pk2(v[2], v[3])}; }
    }
};

DI void tconv_tile(const Frame& F, const float* src, int N, int k0, int n0, bf16_t* dst, int ldd, int mode) {
    float* tl = (float*)F.lds;
    __syncthreads();
#pragma unroll
    for (int i = 0; i < 8; ++i) { const int idx = F.tid + 512 * i, k = idx >> 6, n = idx & 63; tl[k * 65 + n] = src[(size_t)(k0 + k) * N + n0 + n]; }
    __syncthreads();
#pragma unroll
    for (int i = 0; i < 4; ++i) { const int idx = F.tid + 512 * i, n = idx >> 5, kp = idx & 31;
        const int nn = n0 + n; const int row = (mode == 0) ? nn : ((nn >> 4) * 32 + (mode - 1) * 16 + (nn & 15));
        *(unsigned*)(dst + (size_t)row * ldd + k0 + 2 * kp) = pk2(tl[(2 * kp) * 65 + n], tl[(2 * kp + 1) * 65 + n]); }
}
DI void phase_prologue(const Frame& F) {
    const int T_IN = 16 * 40, T_OUT = 16 * 16, T_E = 16 * 8;
    const int per_layer = T_IN + T_OUT + NE * 3 * T_E, total = 2 * per_layer;
    for (int u = F.bid; u < total; u += F.G) {
        const int li = u / per_layer; int r = u % per_layer;
        if (r < T_IN) { tconv_tile(F, F.in[I_WIN] + (size_t)li * D * DIN, DIN, (r / 40) * 64, (r % 40) * 64, WSP(bf16_t, WS_WIN) + (size_t)li * DIN * D, D, 0); continue; }
        r -= T_IN;
        if (r < T_OUT) { tconv_tile(F, F.in[I_WOUT] + (size_t)li * D * D, D, (r / 16) * 64, (r % 16) * 64, WSP(bf16_t, WS_WOUT) + (size_t)li * D * D, D, 0); continue; }
        r -= T_OUT;
        const int e = r / (3 * T_E), w = (r / T_E) % 3, t = r % T_E;
        if (w < 2) tconv_tile(F, F.in[w == 0 ? I_MW1 : I_MW3] + ((size_t)li * NE + e) * D * DE, DE, (t / 8) * 64, (t % 8) * 64, WSP(bf16_t, WS_W13) + ((size_t)li * NE + e) * 1024 * 1024, D, 1 + w);
        else tconv_tile(F, F.in[I_MW2] + ((size_t)li * NE + e) * DE * D, D, (t / 16) * 64, (t % 16) * 64, WSP(bf16_t, WS_W2) + ((size_t)li * NE + e) * 1024 * 512, DE, 0);
    }
    __syncthreads();
    {
        float* sc = (float*)F.lds;
        float* red = sc + 3072;
        for (int i = F.tid; i < 3072; i += NTHR) { const int v = i >> 10, k = i & 1023; const float x = (v < 2) ? F.in[I_C][v * 1024 + k] : F.in[I_CCTX][k]; sc[i] = siluf(x); }
        __syncthreads();
        for (int u = F.bid; u < 2 * 96; u += F.G) {
            const int li = u / 96, j = (u % 96) * 64 + F.lane, ko = F.wave;
            const float* w = F.in[I_ADAW] + (size_t)li * D * 6144 + j;
            float a0 = 0.f, a1 = 0.f, a2 = 0.f;
            for (int k = ko * 128; k < ko * 128 + 128; ++k) { const float wv = w[(size_t)k * 6144]; a0 += sc[k] * wv; a1 += sc[1024 + k] * wv; a2 += sc[2048 + k] * wv; }
            red[(ko * 3 + 0) * 64 + F.lane] = a0; red[(ko * 3 + 1) * 64 + F.lane] = a1; red[(ko * 3 + 2) * 64 + F.lane] = a2;
            __syncthreads();
            if (F.tid < 192) { const int v = F.tid / 64, l = F.tid % 64; float s = 0.f;
#pragma unroll
                for (int q = 0; q < 8; ++q) s += red[(q * 3 + v) * 64 + l];
                const int jj = (u % 96) * 64 + l;
                WSP(float, WS_MOD)[((size_t)li * 3 + v) * 6144 + jj] = s + F.in[I_ADAB][li * 6144 + jj]; }
            __syncthreads();
        }
    }
    if (F.bid == (F.G > 1 ? 1 : 0)) {
        for (int i = F.tid; i < 256 * 8; i += NTHR) { const int pos = i >> 3, f = i & 7; const float inv = exp2f(-(float)f * (13.287712379549449f / 8.f)); const float rev = (float)pos * inv * 0.15915494309189535f;
            WSP(float, WS_ROPE)[i * 2] = cos_rev(rev); WSP(float, WS_ROPE)[i * 2 + 1] = sin_rev(rev); }
    }
}

DI void filter_tile(const Frame& F, int li, int L, int tile, float* hT, float* part) {
    float* h1s = (float*)F.lds;
    float* h2s = h1s + 4096;
    float* stg = h2s + 4096;
    float* sq2 = stg + 256 * 65;
    const float* w1 = F.in[I_HW1] + (size_t)li * 33 * 64; const float* b1 = F.in[I_HB1] + li * 64;
    const float* w2 = F.in[I_HW2] + (size_t)li * 64 * 64; const float* b2 = F.in[I_HB2] + li * 64;
    const float* w3 = F.in[I_HW3] + (size_t)li * 64 * 1024; const float* b3 = F.in[I_HB3] + li * 1024;
    const int t0 = tile * 64;
    const float inv_lm1 = 1.f / (float)(L > 1 ? L - 1 : 1);
    __syncthreads();
    {
        const int tl = F.tid & 63, pt = F.tid >> 6; const float t = (float)(t0 + tl);
        float a[8];
#pragma unroll
        for (int jj = 0; jj < 8; ++jj) a[jj] = b1[pt * 8 + jj] + (t * inv_lm1) * w1[pt * 8 + jj];
#pragma unroll 1
        for (int i = 0; i < 16; ++i) { const float band = 1e-4f + (15.f - 1e-4f) * (float)i / 15.f; const float rev = t * band / (float)L; const float cz = cos_rev(rev), sz = sin_rev(rev);
#pragma unroll
            for (int jj = 0; jj < 8; ++jj) a[jj] += cz * w1[(1 + i) * 64 + pt * 8 + jj] + sz * w1[(17 + i) * 64 + pt * 8 + jj]; }
#pragma unroll
        for (int jj = 0; jj < 8; ++jj) h1s[tl * 64 + pt * 8 + jj] = sin_rad(a[jj]);
    }
    __syncthreads();
    {
        const int tl = F.tid & 63, pt = F.tid >> 6;
        float a[8];
#pragma unroll
        for (int jj = 0; jj < 8; ++jj) a[jj] = b2[pt * 8 + jj];
#pragma unroll 1
        for (int i = 0; i < 64; ++i) { const float hv = h1s[tl * 64 + i];
#pragma unroll
            for (int jj = 0; jj < 8; ++jj) a[jj] += hv * w2[i * 64 + pt * 8 + jj]; }
#pragma unroll
        for (int jj = 0; jj < 8; ++jj) h2s[tl * 64 + pt * 8 + jj] = sin_rad(a[jj]);
    }
    __syncthreads();
    const int c = F.tid & 255, th = F.tid >> 8;
    const float delta = 3.0701134573253945f + (15.350567286626973f - 3.0701134573253945f) * (float)c / 255.f;
#pragma unroll 1
    for (int cc = 0; cc < 4; ++cc) {
        float wr[64];
#pragma unroll
        for (int i = 0; i < 64; ++i) wr[i] = w3[(size_t)i * 1024 + cc * 256 + c];
        const float bb = b3[cc * 256 + c]; float sq = 0.f;
#pragma unroll 1
        for (int tt = th * 32; tt < th * 32 + 32; ++tt) {
            float a = bb;
#pragma unroll
            for (int i = 0; i < 64; ++i) a += h2s[tt * 64 + i] * wr[i];
            a *= __expf(-((float)(t0 + tt) * inv_lm1) * delta);
            stg[c * 65 + tt] = a; sq += a * a;
        }
        if (th == 1) sq2[c] = sq;
        __syncthreads();
        if (th == 0) part[(size_t)tile * 1024 + cc * 256 + c] = sq + sq2[c];
        for (int ch = F.wave * 32; ch < F.wave * 32 + 32; ++ch) hT[((size_t)cc * 256 + ch) * L + t0 + F.lane] = stg[ch * 65 + F.lane];
        __syncthreads();
    }
}

struct TokInfo { unsigned e0, e1, p0, p1; float g0, g1; unsigned s0, s1; };
DI void phase_norm1(const Frame& F, int li, int mode) {
    const int nrows = (mode == 2) ? NLAT : NTOK;
    const float* modp = WSP(float, WS_MOD) + (size_t)li * 3 * 6144;
    const float* modprev = WSP(float, WS_MOD) + (size_t)(mode == 2 ? 1 : li - 1) * 3 * 6144;
    const float* gam = (mode == 2) ? F.in[I_FG] : F.in[I_N1G] + (size_t)li * D;
    const TokInfo* tok = WSP(TokInfo, WS_TOK); const bf16_t* ys = WSP(bf16_t, WS_A1);
    bf16_t* hbf = WSP(bf16_t, WS_HBF);
    for (int r = F.bid * 8 + F.wave; r < nrows; r += F.G * 8) {
        const bool isctx = r >= NLAT; const int v = isctx ? 2 : (r >> 14);
        float* xrow = isctx ? WSP(float, WS_XC) + (size_t)(r - NLAT) * D : F.out + (size_t)r * D;
        const float* src = (mode == 0) ? (isctx ? F.in[I_CTX] + (size_t)(r - NLAT) * D : F.in[I_X] + (size_t)r * D) : xrow;
        f32x4 x[4];
#pragma unroll
        for (int i = 0; i < 4; ++i) x[i] = *(const f32x4*)(src + i * 256 + F.lane * 4);
        if (mode != 0) {
            const TokInfo ti = tok[r];
            const float* g2 = modprev + (size_t)v * 6144 + 5 * 1024;
#pragma unroll
            for (int i = 0; i < 4; ++i) {
                const int c = i * 256 + F.lane * 4;
                const u32x2 a = *(const u32x2*)(ys + (size_t)ti.s0 * D + c), b = *(const u32x2*)(ys + (size_t)ti.s1 * D + c);
                const f32x4 gg = *(const f32x4*)(g2 + c);
                f32x4 y;
                y[0] = ti.g0 * __uint_as_float(a[0] << 16) + ti.g1 * __uint_as_float(b[0] << 16);
                y[1] = ti.g0 * __uint_as_float(a[0] & 0xffff0000u) + ti.g1 * __uint_as_float(b[0] & 0xffff0000u);
                y[2] = ti.g0 * __uint_as_float(a[1] << 16) + ti.g1 * __uint_as_float(b[1] << 16);
                y[3] = ti.g0 * __uint_as_float(a[1] & 0xffff0000u) + ti.g1 * __uint_as_float(b[1] & 0xffff0000u);
                x[i] = x[i] + gg * y;
            }
            if (mode == 1) {
#pragma unroll
                for (int i = 0; i < 4; ++i) *(f32x4*)(xrow + i * 256 + F.lane * 4) = x[i];
            }
        }
        float ss = 0.f;
#pragma unroll
        for (int i = 0; i < 4; ++i) ss += x[i][0] * x[i][0] + x[i][1] * x[i][1] + x[i][2] * x[i][2] + x[i][3] * x[i][3];
        ss = wave_sum(ss);
        const float rstd = rsqrtf(ss * (1.f / D) + EPS);
#pragma unroll
        for (int i = 0; i < 4; ++i) {
            const int c = i * 256 + F.lane * 4;
            const f32x4 g = *(const f32x4*)(gam + c);
            if (mode == 2) { *(f32x4*)(F.out + (size_t)r * D + c) = x[i] * rstd * g; }
            else {
                const f32x4 sh = *(const f32x4*)(modp + (size_t)v * 6144 + c), sc = *(const f32x4*)(modp + (size_t)v * 6144 + 1024 + c);
                const f32x4 h = x[i] * rstd * g * (sc + 1.f) + sh;
                *(u32x2*)(hbf + (size_t)r * D + c) = (u32x2){pk2(h[0], h[1]), pk2(h[2], h[3])};
            }
        }
    }
}

DI void phase_norm2(const Frame& F, int li, int nrows) {
    float* wt = (float*)F.lds;
    __syncthreads();
    for (int i = F.tid; i < 16384; i += NTHR) { const int k = i >> 4, e = i & 15; wt[e * 1024 + k] = F.in[I_RW][i]; }
    __syncthreads();
    const float* modp = WSP(float, WS_MOD) + (size_t)li * 3 * 6144;
    const float* gam = F.in[I_N2G] + (size_t)li * D;
    bf16_t* hbf = WSP(bf16_t, WS_HBF); TokInfo* tok = WSP(TokInfo, WS_TOK);
    unsigned* lcnt = (unsigned*)(F.lds + LDS_MISC + 64);
    if (F.tid < 16) lcnt[F.tid] = 0u;
    __syncthreads();
    for (int r = F.bid * 8 + F.wave; r < nrows; r += F.G * 8) {
        const bool isctx = r >= NLAT; const int v = isctx ? 2 : (r >> 14);
        const float* src = isctx ? WSP(float, WS_XC) + (size_t)(r - NLAT) * D : F.out + (size_t)r * D;
        f32x4 x[4]; float ss = 0.f;
#pragma unroll
        for (int i = 0; i < 4; ++i) { x[i] = *(const f32x4*)(src + i * 256 + F.lane * 4); ss += x[i][0] * x[i][0] + x[i][1] * x[i][1] + x[i][2] * x[i][2] + x[i][3] * x[i][3]; }
        ss = wave_sum(ss);
        const float rstd = rsqrtf(ss * (1.f / D) + EPS);
        float lg[16];
#pragma unroll
        for (int e = 0; e < 16; ++e) lg[e] = 0.f;
#pragma unroll
        for (int i = 0; i < 4; ++i) {
            const int c = i * 256 + F.lane * 4;
            const f32x4 g = *(const f32x4*)(gam + c), sh = *(const f32x4*)(modp + (size_t)v * 6144 + 3 * 1024 + c), sc = *(const f32x4*)(modp + (size_t)v * 6144 + 4 * 1024 + c);
            const f32x4 h = x[i] * rstd * g * (sc + 1.f) + sh;
            *(u32x2*)(hbf + (size_t)r * D + c) = (u32x2){pk2(h[0], h[1]), pk2(h[2], h[3])};
#pragma unroll
            for (int e = 0; e < 16; ++e) { const f32x4 w = *(const f32x4*)(wt + e * 1024 + c); lg[e] += h[0] * w[0] + h[1] * w[1] + h[2] * w[2] + h[3] * w[3]; }
        }
#pragma unroll
        for (int e = 0; e < 16; ++e) lg[e] = wave_sum(lg[e]);
        float mx = lg[0];
#pragma unroll
        for (int e = 1; e < 16; ++e) mx = fmaxf(mx, lg[e]);
        float sc[16], sel[16], den = 0.f;
#pragma unroll
        for (int e = 0; e < 16; ++e) { sc[e] = __expf(lg[e] - mx); den += sc[e]; }
        const float rden = 1.f / den;
#pragma unroll
        for (int e = 0; e < 16; ++e) { sc[e] *= rden; sel[e] = sc[e] + F.in[I_RB][e]; }
        int bg = 0; float bgs = -1e30f;
#pragma unroll
        for (int g = 0; g < 4; ++g) {
            float m1 = -1e30f, m2 = -1e30f;
#pragma unroll
            for (int q = 0; q < 4; ++q) { const float s = sel[g * 4 + q]; if (s > m1) { m2 = m1; m1 = s; } else if (s > m2) m2 = s; }
            const float gs = m1 + m2; if (gs > bgs) { bgs = gs; bg = g; }
        }
        int e0 = 0, e1 = 0; float s0v = -1e30f, s1v = -1e30f, w0 = 0.f, w1 = 0.f;
#pragma unroll
        for (int e = 0; e < 16; ++e) {
            const bool ing = (e >> 2) == bg; const float s = sel[e];
            if (ing && s > s0v) { s1v = s0v; e1 = e0; w1 = w0; s0v = s; e0 = e; w0 = sc[e]; }
            else if (ing && s > s1v) { s1v = s; e1 = e; w1 = sc[e]; }
        }
        if (F.lane == 0) {
            TokInfo ti; ti.e0 = e0; ti.e1 = e1; ti.p0 = atomicAdd(lcnt + e0, 1u); ti.p1 = atomicAdd(lcnt + e1, 1u);
            const float ws = 1.f / (w0 + w1); ti.g0 = w0 * ws; ti.g1 = w1 * ws; ti.s0 = 0; ti.s1 = 0;
            tok[r] = ti;
        }
    }
    __syncthreads();
    if (F.tid < 16) F.ctl[CW_BCNT + (li * MAXG + F.bid) * 16 + F.tid] = lcnt[F.tid];
}

DI void moe_offsets(const Frame& F, int li, int* offs) {
    __syncthreads();
    int* tot = offs + 376;
    int* part = (int*)F.lds;
    {
        const int e = F.tid & 15, pq = F.tid >> 4;
        const unsigned* bc = F.ctl + CW_BCNT + li * MAXG * 16 + e;
        int st = 0, sb = 0;
#pragma unroll
        for (int k = 0; k < 8; ++k) { const int blk = pq * 8 + k; const int c = (blk < F.G) ? (int)__hip_atomic_load(bc + blk * 16, __ATOMIC_RELAXED, __HIP_MEMORY_SCOPE_AGENT) : 0; st += c; sb += (blk < F.bid) ? c : 0; }
        part[pq * 16 + e] = st; part[512 + pq * 16 + e] = sb;
    }
    __syncthreads();
    if (F.tid < 32) { const int e = F.tid & 15, wb = F.tid >> 4; int s = 0;
        for (int pq = 0; pq < 32; ++pq) s += part[wb * 512 + pq * 16 + e];
        if (wb) offs[360 + e] = s; else tot[e] = s; }
    __syncthreads();
    if (F.tid == 0) { int o = 0; for (int e = 0; e < NE; ++e) { offs[e] = o; offs[17 + e] = o >> 8; o += (tot[e] + 255) & ~255; }
        offs[16] = o; offs[17 + 16] = o >> 8; }
    __syncthreads();
    for (int t = F.tid; t < SLOT_CAP / 256; t += NTHR) { int e = 0; for (int k = 1; k < NE; ++k) e += (offs[17 + k] <= t) ? 1 : 0; offs[40 + t] = e; }
    if (F.tid < 16) offs[360 + F.tid] += offs[F.tid];
    __syncthreads();
}
DI void phase_gather(const Frame& F, int li, int nrows) {
    int* offs = (int*)(F.lds + LDS_MISC + 64);
    moe_offsets(F, li, offs);
    const bf16_t* hbf = WSP(bf16_t, WS_HBF); bf16_t* a1 = WSP(bf16_t, WS_A1); TokInfo* tok = WSP(TokInfo, WS_TOK);
    for (int r = F.bid * 8 + F.wave; r < nrows; r += F.G * 8) {
        TokInfo ti = tok[r];
        const unsigned s0 = offs[360 + ti.e0] + ti.p0, s1 = offs[360 + ti.e1] + ti.p1;
        const u32x4 a = *(const u32x4*)(hbf + (size_t)r * D + F.lane * 8), b = *(const u32x4*)(hbf + (size_t)r * D + 512 + F.lane * 8);
        *(u32x4*)(a1 + (size_t)s0 * D + F.lane * 8) = a; *(u32x4*)(a1 + (size_t)s0 * D + 512 + F.lane * 8) = b;
        *(u32x4*)(a1 + (size_t)s1 * D + F.lane * 8) = a; *(u32x4*)(a1 + (size_t)s1 * D + 512 + F.lane * 8) = b;
        if (F.lane == 0) { tok[r].s0 = s0; tok[r].s1 = s1; }
    }
}

#define MFMA32(a, b, c) __builtin_amdgcn_mfma_f32_32x32x16_bf16((a), (b), (c), 0, 0, 0)
DI float lam_of(const Frame& F, int li, float& lam_init) {
    const float* lv = F.in[I_ALAM] + (size_t)li * 128;
    const int i = F.lane & 31, hi = F.lane >> 5;
    float d = lv[hi * 64 + i] * lv[hi * 64 + 32 + i];
    d += swz_xor<16>(d); d += swz_xor<8>(d); d += swz_xor<4>(d); d += swz_xor<2>(d); d += swz_xor<1>(d);
    const float d0 = __int_as_float(__builtin_amdgcn_readlane(__float_as_int(d), 0)), d1 = __int_as_float(__builtin_amdgcn_readlane(__float_as_int(d), 32));
    float lif = (float)li; asm volatile("" : "+v"(lif));
    lam_init = 0.8f - 0.6f * __expf(-0.3f * lif);
    return __expf(d0) - __expf(d1) + lam_init;
}
DI bf16x8 pack8(const f32x16& x, int s) {
    u32x4 p; p[0] = pk2(x[8 * s], x[8 * s + 1]); p[1] = pk2(x[8 * s + 2], x[8 * s + 3]); p[2] = pk2(x[8 * s + 4], x[8 * s + 5]); p[3] = pk2(x[8 * s + 6], x[8 * s + 7]);
    return __builtin_bit_cast(bf16x8, p);
}

DI void diffattn_unit(const Frame& F, int li, int b, int h, size_t qrow0, int NT2) {
    const int lane = F.lane, r = lane & 31, hh = lane >> 5, c = F.wave & 1, g = F.wave >> 1;
    const bf16_t* AQ = WSP(bf16_t, WS_AQ); const bf16_t* AK = WSP(bf16_t, WS_AK); const bf16_t* AVT = WSP(bf16_t, WS_AVT) + (size_t)(b * 4 + h) * 64 * NKEY;
    float lam_init; const float lam = lam_of(F, li, lam_init);
    const size_t qrow = qrow0 + g * 32 + r;
    bf16x8 qf[2]; float qn2 = 0.f;
#pragma unroll
    for (int ks = 0; ks < 2; ++ks) { qf[ks] = *(const bf16x8*)(AQ + qrow * 256 + h * 64 + c * 32 + ks * 16 + 8 * hh);
#pragma unroll
        for (int j = 0; j < 8; ++j) { const float v = bf2f((bf16_t)qf[ks][j]); qn2 += v * v; } }
    qn2 = half_sum(qn2);
    f32x16 cinit;
    { const float km = sqrtf(__uint_as_float(__hip_atomic_load(F.ctl + CW_KMAX + li * 16 + (b * 4 + h) * 2 + c, __ATOMIC_RELAXED, __HIP_MEMORY_SCOPE_AGENT)));
      const float cn = -(sqrtf(qn2) * km * 1.02f + 1e-3f);
#pragma unroll
      for (int i = 0; i < 16; ++i) cinit[i] = cn; }
    f32x16 O[2];
#pragma unroll
    for (int dh = 0; dh < 2; ++dh)
#pragma unroll
        for (int i = 0; i < 16; ++i) O[dh][i] = 0.f;
    float lsum = 0.f;
    constexpr int KTB = 2 * 128 * 64, VTB = 64 * 264, STG = KTB + VTB;
    const int skey = F.tid >> 2, sq = F.tid & 3;
    const int kdst0 = (sq >> 1) * 8192 + skey * 64 + ((((sq & 1) * 2 + 0) ^ ((skey >> 2) & 3)) * 16);
    const int kdst1 = (sq >> 1) * 8192 + skey * 64 + ((((sq & 1) * 2 + 1) ^ ((skey >> 2) & 3)) * 16);
    const int vd = F.tid >> 3, vpart = F.tid & 7;
    const int vdst = KTB + vd * 264 + vpart * 32;
    auto krow_of = [&](int j) -> size_t { return j < CTX ? (size_t)NLAT + b * CTX + j : (size_t)b * S + (j - CTX); };
    unsigned char* L = F.lds;
    u32x4 kreg[2], vreg[2];
    { const bf16_t* kp = AK + krow_of(skey) * 256 + h * 64 + sq * 16; const bf16_t* vp = AVT + (size_t)vd * NKEY + vpart * 16;
      kreg[0] = *(const u32x4*)kp; kreg[1] = *(const u32x4*)(kp + 8); vreg[0] = *(const u32x4*)vp; vreg[1] = *(const u32x4*)(vp + 8); }
    __syncthreads();
    *(u32x4*)(L + kdst0) = kreg[0]; *(u32x4*)(L + kdst1) = kreg[1];
    *(u32x2*)(L + vdst) = (u32x2){vreg[0][0], vreg[0][1]}; *(u32x2*)(L + vdst + 8) = (u32x2){vreg[0][2], vreg[0][3]};
    *(u32x2*)(L + vdst + 16) = (u32x2){vreg[1][0], vreg[1][1]}; *(u32x2*)(L + vdst + 24) = (u32x2){vreg[1][2], vreg[1][3]};
    __syncthreads();
    const int ksw = (r >> 2) & 3;
    const int kr0 = c * 8192 + r * 64 + (((0 + hh) ^ ksw) * 16), kr1 = c * 8192 + r * 64 + (((2 + hh) ^ ksw) * 16);
    const int vr0 = r * 264 + 8 * hh;
#define DA_QK(Sx, st) do { \
        const bf16x8 k0 = *(const bf16x8*)(kb + (st) * 2048 + kr0), k1 = *(const bf16x8*)(kb + (st) * 2048 + kr1); \
        Sx = MFMA32(k0, qf[0], cinit); Sx = MFMA32(k1, qf[1], Sx); } while (0)
#define DA_PV(Sx, st) do { bf16x8 vf[2][2]; \
        _Pragma("unroll") for (int dh = 0; dh < 2; ++dh) _Pragma("unroll") for (int s2 = 0; s2 < 2; ++s2) { \
            const unsigned char* vp = vb + dh * (32 * 264) + vr0 + (st) * 64 + s2 * 32; \
            const s16x4 lo = *(const s16x4*)vp, hi = *(const s16x4*)(vp + 16); \
            vf[dh][s2] = __builtin_shufflevector(lo, hi, 0, 1, 2, 3, 4, 5, 6, 7); } \
        _Pragma("unroll") for (int i = 0; i < 16; ++i) { Sx[i] = __builtin_amdgcn_exp2f(Sx[i]); lsum += Sx[i]; } \
        const bf16x8 p0 = pack8(Sx, 0), p1 = pack8(Sx, 1); \
        O[0] = MFMA32(vf[0][0], p0, O[0]); O[1] = MFMA32(vf[1][0], p0, O[1]); \
        O[0] = MFMA32(vf[0][1], p1, O[0]); O[1] = MFMA32(vf[1][1], p1, O[1]); } while (0)
#pragma unroll 1
    for (int kt = 0; kt < NT2; ++kt) {
        const int buf = kt & 1;
        if (kt + 1 < NT2) {
            const int j0 = (kt + 1) * 128;
            const bf16_t* kp = AK + krow_of(j0 + skey) * 256 + h * 64 + sq * 16; const bf16_t* vp = AVT + (size_t)vd * NKEY + j0 + vpart * 16;
            kreg[0] = *(const u32x4*)kp; kreg[1] = *(const u32x4*)(kp + 8); vreg[0] = *(const u32x4*)vp; vreg[1] = *(const u32x4*)(vp + 8);
        }
        const unsigned char* kb = L + buf * STG; const unsigned char* vb = L + buf * STG + KTB;
        f32x16 Sa, Sb;
        DA_QK(Sa, 0);
        DA_QK(Sb, 1); DA_PV(Sa, 0);
        DA_QK(Sa, 2); DA_PV(Sb, 1);
        DA_QK(Sb, 3); DA_PV(Sa, 2);
        DA_PV(Sb, 3);
        if (kt + 1 < NT2) {
            unsigned char* W = L + (buf ^ 1) * STG;
            *(u32x4*)(W + kdst0) = kreg[0]; *(u32x4*)(W + kdst1) = kreg[1];
            *(u32x2*)(W + vdst) = (u32x2){vreg[0][0], vreg[0][1]}; *(u32x2*)(W + vdst + 8) = (u32x2){vreg[0][2], vreg[0][3]};
            *(u32x2*)(W + vdst + 16) = (u32x2){vreg[1][0], vreg[1][1]}; *(u32x2*)(W + vdst + 24) = (u32x2){vreg[1][2], vreg[1][3]};
        }
        __syncthreads();
    }
#undef DA_QK
#undef DA_PV
    const float rl = 1.f / half_sum(lsum);
    float* xb = (float*)L + (size_t)g * 32 * 64;
    if (c == 1) {
#pragma unroll
        for (int dh = 0; dh < 2; ++dh)
#pragma unroll
            for (int i = 0; i < 16; ++i) xb[(dh * 16 + i) * 64 + lane] = O[dh][i] * (rl * lam);
    }
    __syncthreads();
    if (c == 0) {
        float o[2][16]; float ss = 0.f;
#pragma unroll
        for (int dh = 0; dh < 2; ++dh)
#pragma unroll
            for (int i = 0; i < 16; ++i) { o[dh][i] = O[dh][i] * rl - xb[(dh * 16 + i) * 64 + lane]; ss += o[dh][i] * o[dh][i]; }
        ss = half_sum(ss);
        const float rs = rsqrtf(ss * (1.f / 64.f) + EPS) * (1.f - lam_init);
        const float* sg = F.in[I_ASUB] + li * 64;
        bf16_t* mix = WSP(bf16_t, WS_HBF) + qrow * D + h * 64;
#pragma unroll
        for (int dh = 0; dh < 2; ++dh)
#pragma unroll
            for (int gq = 0; gq < 4; ++gq) {
                const int d = 32 * dh + 8 * gq + 4 * hh;
                const f32x4 gg = *(const f32x4*)(sg + d);
                *(u32x2*)(mix + d) = (u32x2){pk2(o[dh][4 * gq] * rs * gg[0], o[dh][4 * gq + 1] * rs * gg[1]), pk2(o[dh][4 * gq + 2] * rs * gg[2], o[dh][4 * gq + 3] * rs * gg[3])};
            }
    }
}

DI void na_mfma_unit(const Frame& F, int li, int b, size_t qrow0, int grow) {
    const int lane = F.lane, r31 = lane & 31, hh = lane >> 5, h = F.wave >> 1, qh = F.wave & 1;
    const bf16_t* BQ = WSP(bf16_t, WS_BQ); const bf16_t* BK = WSP(bf16_t, WS_BK); const bf16_t* BVT = WSP(bf16_t, WS_BVT);
    constexpr int KB = 4 * 8192, VB = 4 * 8704, STG = KB + VB;
    unsigned char* L = F.lds;
    float* tab = (float*)(F.lds + 2 * STG);
    const int nwin = grow >= 0 ? 8 : 0, nt = nwin + 4;
    int r0 = grow - 4; r0 = r0 < 0 ? 0 : (r0 > 248 ? 248 : r0);
    __syncthreads();
    if (nwin) for (int i = F.tid; i < 4 * 465; i += NTHR) tab[i] = F.in[I_RPB][(size_t)li * 4 * 465 + i] * LOG2E;
    const int skey = F.tid >> 3, sc64 = F.tid & 7, sh = sc64 >> 1;
    const int vrow = F.tid >> 1, vhalf = F.tid & 1;
    auto kbase = [&](int ti) -> const bf16_t* { return ti < nwin ? BK + ((size_t)b * S + (size_t)(r0 + ti) * GW) * 256 : BK + ((size_t)NLAT + b * CTX + (ti - nwin) * 64) * 256; };
    auto vkey0 = [&](int ti) -> int { return ti < nwin ? CTX + (r0 + ti) * GW : (ti - nwin) * 64; };
    u32x4 kreg[4], vreg[4];
    { const bf16_t* kp = kbase(0) + (size_t)skey * 256 + sc64 * 32; const bf16_t* vp = BVT + ((size_t)b * 256 + vrow) * NKEY + vkey0(0) + vhalf * 32;
#pragma unroll
      for (int i = 0; i < 4; ++i) { kreg[i] = *(const u32x4*)(kp + i * 8); vreg[i] = *(const u32x4*)(vp + i * 8); } }
    const size_t qrow = qrow0 + 32 * qh + r31;
    bf16x8 qf[4]; float qn2 = 0.f;
#pragma unroll
    for (int ks = 0; ks < 4; ++ks) { qf[ks] = *(const bf16x8*)(BQ + qrow * 256 + h * 64 + ks * 16 + 8 * hh);
#pragma unroll
        for (int j = 0; j < 8; ++j) { const float v = bf2f((bf16_t)qf[ks][j]); qn2 += v * v; } }
    qn2 = half_sum(qn2);
    __syncthreads();
    float bmax = 0.f;
    if (nwin) { for (int i = lane; i < 465; i += 64) bmax = fmaxf(bmax, tab[h * 465 + i]); bmax = wave_max(bmax); }
    const unsigned* kmx = F.ctl + CW_KMAXB + li * 16 + (b * 4 + h) * 2;
    const float km = sqrtf(__uint_as_float(__hip_atomic_load(kmx, __ATOMIC_RELAXED, __HIP_MEMORY_SCOPE_AGENT)) + __uint_as_float(__hip_atomic_load(kmx + 1, __ATOMIC_RELAXED, __HIP_MEMORY_SCOPE_AGENT)));
    const float cneg = -(sqrtf(qn2) * km * 1.02f + bmax + 1e-3f);
    const int cq = 32 * qh + r31; int c0q = cq - 8; c0q = c0q < 0 ? 0 : (c0q > 48 ? 48 : c0q);
    const int qrow_g = grow;
    f32x16 O[2];
#pragma unroll
    for (int dh = 0; dh < 2; ++dh)
#pragma unroll
        for (int i = 0; i < 16; ++i) O[dh][i] = 0.f;
    float lsum = 0.f;
    const int kdst = sh * 8192 + skey * 128, ksw = (skey >> 1) & 7, kch0 = (sc64 & 1) * 4;
    const int vdst = KB + (vrow >> 6) * 8704 + (vrow & 63) * 136 + vhalf * 64;
#pragma unroll
    for (int i = 0; i < 4; ++i) { *(u32x4*)(L + kdst + (((kch0 + i) ^ ksw) * 16)) = kreg[i];
        *(u32x2*)(L + vdst + i * 16) = (u32x2){vreg[i][0], vreg[i][1]}; *(u32x2*)(L + vdst + i * 16 + 8) = (u32x2){vreg[i][2], vreg[i][3]}; }
    __syncthreads();
#pragma unroll 1
    for (int ti = 0; ti < nt; ++ti) {
        const int buf = ti & 1;
        if (ti + 1 < nt) { const bf16_t* kp = kbase(ti + 1) + (size_t)skey * 256 + sc64 * 32; const bf16_t* vp = BVT + ((size_t)b * 256 + vrow) * NKEY + vkey0(ti + 1) + vhalf * 32;
#pragma unroll
            for (int i = 0; i < 4; ++i) { kreg[i] = *(const u32x4*)(kp + i * 8); vreg[i] = *(const u32x4*)(vp + i * 8); } }
        const unsigned char* kb = L + buf * STG + h * 8192; const unsigned char* vb = L + buf * STG + KB + h * 8704;
        const bool win = ti < nwin;
        const float* trow = tab + h * 465 + (win ? (r0 + ti - qrow_g + 7) * 31 : 0) + 15 - cq;
#pragma unroll
        for (int st = 0; st < 2; ++st) {
            const int key = 32 * st + r31, sw = (key >> 1) & 7;
            f32x16 s;
#pragma unroll
            for (int i = 0; i < 16; ++i) { const int kc = 32 * st + (i & 3) + 8 * (i >> 2) + 4 * hh;
                float c = cneg;
                if (win) { const bool ok = (kc >= c0q) && (kc < c0q + 16); c = ok ? trow[ok ? kc : cq] + cneg : -1e30f; }
                s[i] = c; }
#pragma unroll
            for (int ks = 0; ks < 4; ++ks) { const bf16x8 kf = *(const bf16x8*)(kb + key * 128 + (((ks * 2 + hh) ^ sw) * 16)); s = MFMA32(kf, qf[ks], s); }
#pragma unroll
            for (int i = 0; i < 16; ++i) { s[i] = __builtin_amdgcn_exp2f(s[i]); lsum += s[i]; }
            const bf16x8 p0 = pack8(s, 0), p1 = pack8(s, 1);
#pragma unroll
            for (int dh = 0; dh < 2; ++dh) {
                const unsigned char* vp = vb + (32 * dh + r31) * 136 + (32 * st + 4 * hh) * 2;
                const s16x4 a0 = *(const s16x4*)vp, a1 = *(const s16x4*)(vp + 16), b0 = *(const s16x4*)(vp + 32), b1 = *(const s16x4*)(vp + 48);
                O[dh] = MFMA32(__builtin_shufflevector(a0, a1, 0, 1, 2, 3, 4, 5, 6, 7), p0, O[dh]);
                O[dh] = MFMA32(__builtin_shufflevector(b0, b1, 0, 1, 2, 3, 4, 5, 6, 7), p1, O[dh]);
            }
        }
        if (ti + 1 < nt) { unsigned char* W = L + (buf ^ 1) * STG;
#pragma unroll
            for (int i = 0; i < 4; ++i) { *(u32x4*)(W + kdst + (((kch0 + i) ^ ksw) * 16)) = kreg[i];
                *(u32x2*)(W + vdst + i * 16) = (u32x2){vreg[i][0], vreg[i][1]}; *(u32x2*)(W + vdst + i * 16 + 8) = (u32x2){vreg[i][2], vreg[i][3]}; } }
        __syncthreads();
    }
    const float rl = 1.f / half_sum(lsum);
    bf16_t* mix = WSP(bf16_t, WS_HBF) + qrow * D + 256 + h * 64;
#pragma unroll
    for (int dh = 0; dh < 2; ++dh)
#pragma unroll
        for (int g = 0; g < 4; ++g) { const int d = 32 * dh + 8 * g + 4 * hh;
            *(u32x2*)(mix + d) = (u32x2){pk2(O[dh][4 * g] * rl, O[dh][4 * g + 1] * rl), pk2(O[dh][4 * g + 2] * rl, O[dh][4 * g + 3] * rl)}; }
}

DI void pool_unit(const Frame& F, int li, size_t seq_row0, int L, int t0) {
    float* us = (float*)F.lds;
    float* df = us + 48 * 256;
    const bf16_t* PL = WSP(bf16_t, WS_PL);
    __syncthreads();
    for (int i = F.tid; i < 48 * 32; i += NTHR) {
        const int tt = i >> 5, c8 = i & 31, t = t0 - 8 + tt;
        float v[8] = {0.f, 0.f, 0.f, 0.f, 0.f, 0.f, 0.f, 0.f};
        if (t >= 0 && t < L) { const u32x4 x = *(const u32x4*)(PL + (seq_row0 + t) * 256 + c8 * 8);
#pragma unroll
            for (int e = 0; e < 4; ++e) { v[2 * e] = __uint_as_float(x[e] << 16); v[2 * e + 1] = __uint_as_float(x[e] & 0xffff0000u); } }
#pragma unroll
        for (int e = 0; e < 8; ++e) us[tt * 256 + c8 * 8 + e] = v[e];
    }
    __syncthreads();
    for (int i = F.tid; i < 32 * 256; i += NTHR) {
        const int tl = i >> 8, ch = i & 255, g = ch >> 6, t = t0 + tl; const int hw = 1 << g;
        int lo = t - hw; lo = lo < 0 ? 0 : lo; int hi = t + hw; hi = hi > L ? L : hi;
        float s = 0.f;
        for (int tt = lo; tt < hi; ++tt) s += us[(tt - t0 + 8) * 256 + ch];
        df[tl * 256 + ch] = s / (float)(hi - lo) - us[(tl + 8) * 256 + ch];
    }
    __syncthreads();
    const float* pw = F.in[I_POOLW] + (size_t)li * 4 * 64 * 64; const float* ps = F.in[I_POOLS] + li * 256;
    bf16_t* mix = WSP(bf16_t, WS_HBF);
    {
        const int ch = F.tid & 255, th = F.tid >> 8, g = ch >> 6, j = ch & 63;
        float w[64];
#pragma unroll
        for (int i = 0; i < 64; ++i) w[i] = pw[((size_t)g * 64 + i) * 64 + j];
        const float scale = ps[ch];
        for (int tl = th * 16; tl < th * 16 + 16; ++tl) {
            float a = 0.f;
#pragma unroll
            for (int i = 0; i < 64; ++i) a += df[tl * 256 + g * 64 + i] * w[i];
            mix[(seq_row0 + t0 + tl) * D + 512 + ch] = f2bf(a * scale);
        }
    }
}

DI float hy_norm(const float* part, int ntile, int o, int ch) {
    float s = 0.f;
    for (int t = 0; t < ntile; ++t) s += part[(size_t)t * 1024 + (o * 2) * 256 + ch] + part[(size_t)t * 1024 + (o * 2 + 1) * 256 + ch];
    return rsqrtf(s + EPS);
}
DI float hy_short(const bf16_t* p, int t, int L, float w0, float w1, float w2, float bb) {
    const float a = t > 0 ? bf2f(p[t - 1]) : 0.f, c = t + 1 < L ? bf2f(p[t + 1]) : 0.f;
    return a * w0 + bf2f(p[t]) * w1 + c * w2 + bb;
}
constexpr int FM = 16384;
DI int fphys(int i) { return i + (i >> 4) + ((i >> 9) << 4); }
constexpr int brev(int m, int bits) { return bits == 5 ? (((m & 1) << 4) | ((m & 2) << 2) | (m & 4) | ((m & 8) >> 2) | ((m & 16) >> 4)) : (((m & 1) << 3) | ((m & 2) << 1) | ((m & 4) >> 1) | ((m & 8) >> 3)); }
template <int R, int LOG2R, bool INV> DI void dft_regs(float (&re)[R], float (&im)[R]) {
    constexpr float C32[16] = {1.f, 0.98078528040323043f, 0.92387953251128674f, 0.83146961230254524f, 0.70710678118654752f, 0.55557023301960218f, 0.38268343236508977f, 0.19509032201612825f,
                               0.f, -0.19509032201612825f, -0.38268343236508977f, -0.55557023301960218f, -0.70710678118654752f, -0.83146961230254524f, -0.92387953251128674f, -0.98078528040323043f};
    constexpr float S32[16] = {0.f, 0.19509032201612825f, 0.38268343236508977f, 0.55557023301960218f, 0.70710678118654752f, 0.83146961230254524f, 0.92387953251128674f, 0.98078528040323043f,
                               1.f, 0.98078528040323043f, 0.92387953251128674f, 0.83146961230254524f, 0.70710678118654752f, 0.55557023301960218f, 0.38268343236508977f, 0.19509032201612825f};
#pragma unroll
    for (int st = 0; st < LOG2R; ++st) {
        const int h = R >> (st + 1);
#pragma unroll
        for (int i = 0; i < R; i += 2 * h) {
#pragma unroll
            for (int j = 0; j < h; ++j) {
                const float xr = re[i + j], xi = im[i + j], yr = re[i + j + h], yi = im[i + j + h];
                re[i + j] = xr + yr; im[i + j] = xi + yi;
                const float dr = xr - yr, di = xi - yi;
                const int k = j * (16 / h);
                if (k == 0) { re[i + j + h] = dr; im[i + j + h] = di; }
                else if (k == 8) { re[i + j + h] = INV ? -di : di; im[i + j + h] = INV ? dr : -dr; }
                else { const float c = C32[k], sn = INV ? S32[k] : -S32[k]; re[i + j + h] = dr * c - di * sn; im[i + j + h] = dr * sn + di * c; }
            }
        }
    }
}
template <bool INV, int SP> DI void fft_pass32(f32x2* X, int bp, int rem, float inv_bs) {
    asm volatile("" : "+v"(bp), "+v"(rem));
    f32x2* P = X + bp;
    float re[32], im[32];
    if (!INV) {
#pragma unroll
        for (int q = 0; q < 32; ++q) { const f32x2 v = P[q * SP]; re[q] = v[0]; im[q] = v[1]; }
        dft_regs<32, 5, false>(re, im);
#pragma unroll
        for (int m = 0; m < 32; ++m) { const int qp = brev(m, 5);
            float r = re[m], i = im[m];
            if (qp != 0) { const float rev = (float)(rem * qp) * inv_bs; const float c = __builtin_amdgcn_cosf(rev), sn = -__builtin_amdgcn_sinf(rev); const float t = r * c - i * sn; i = r * sn + i * c; r = t; }
            P[qp * SP] = (f32x2){r, i}; }
    } else {
#pragma unroll
        for (int qp = 0; qp < 32; ++qp) { const f32x2 v = P[qp * SP]; float r = v[0], i = v[1];
            if (qp != 0) { const float rev = (float)(rem * qp) * inv_bs; const float c = __builtin_amdgcn_cosf(rev), sn = __builtin_amdgcn_sinf(rev); const float t = r * c - i * sn; i = r * sn + i * c; r = t; }
            re[qp] = r; im[qp] = i; }
        dft_regs<32, 5, true>(re, im);
#pragma unroll
        for (int m = 0; m < 32; ++m) P[brev(m, 5) * SP] = (f32x2){re[m], im[m]};
    }
}
DI void fft_fwd12(f32x2* X, int tid) {
    __syncthreads(); fft_pass32<false, 560>(X, fphys(tid), tid, 1.f / 16384.f);
    __syncthreads(); fft_pass32<false, 17>(X, (tid >> 4) * 560 + (tid & 15), tid & 15, 1.f / 512.f);
    __syncthreads();
}
DI void fft_inv21(f32x2* X, int tid) {
    __syncthreads(); fft_pass32<true, 17>(X, (tid >> 4) * 560 + (tid & 15), tid & 15, 1.f / 512.f);
    __syncthreads(); fft_pass32<true, 560>(X, fphys(tid), tid, 1.f / 16384.f);
    __syncthreads();
}
DI void hyena_fft_unit(const Frame& F, int li, int ch) {
    f32x2* X = (f32x2*)F.lds;
    const bf16_t* HYT = WSP(bf16_t, WS_HYT); const float* filt = WSP(float, WS_FILT);
    f32x2* Ye = WSP(f32x2, WS_ZBUF) + (size_t)ch * FM; f32x2* Z1 = WSP(f32x2, WS_Z1BUF) + (size_t)ch * FM;
    const float* sw = F.in[I_HYSW] + (size_t)li * 3 * 768; const float* sb = F.in[I_HYSB] + li * 768; const float* sk = F.in[I_HSKIP] + li * 512;
    const int tid = F.tid;
    const bf16_t* px1[2] = {HYT + ((size_t)0 * 768 + ch) * S, HYT + ((size_t)1 * 768 + ch) * S};
    const bf16_t* px2[2] = {HYT + ((size_t)0 * 768 + 256 + ch) * S, HYT + ((size_t)1 * 768 + 256 + ch) * S};
    const bf16_t* pv[2] = {HYT + ((size_t)0 * 768 + 512 + ch) * S, HYT + ((size_t)1 * 768 + 512 + ch) * S};
    const float wx1[4] = {sw[ch], sw[768 + ch], sw[1536 + ch], sb[ch]};
    const float wx2[4] = {sw[256 + ch], sw[768 + 256 + ch], sw[1536 + 256 + ch], sb[256 + ch]};
    const float wv[4] = {sw[512 + ch], sw[768 + 512 + ch], sw[1536 + 512 + ch], sb[512 + ch]};
#pragma unroll 1
    for (int cv = 0; cv < 2; ++cv) {
        const float* hf = filt + ((size_t)(2 * cv) * 256 + ch) * S; const float* hb = filt + ((size_t)(2 * cv + 1) * 256 + ch) * S;
        float fnrm;
        { const float pv = WSP(float, WS_FPART)[(size_t)(tid & 255) * 1024 + (cv * 2 + (tid >> 8)) * 256 + ch];
          const float ws = wave_sum(pv);
          float* red = (float*)(F.lds + LDS_MISC + 128);
          __syncthreads();
          if (F.lane == 0) red[F.wave] = ws;
          __syncthreads();
          fnrm = rsqrtf(red[0] + red[1] + red[2] + red[3] + red[4] + red[5] + red[6] + red[7] + EPS); }
        const float nrm = 1.f / 32768.f;
        const float skip = sk[cv * 256 + ch];
#pragma unroll 1
        for (int half = 0; half < 2; ++half) {
            __syncthreads();
            int pb = fphys(tid); int tq = tid; asm volatile("" : "+v"(pb), "+v"(tq));
#pragma unroll 8
            for (int j = 0; j < 32; ++j) { const int n = tq + 512 * j; const float a = hf[n] * fnrm, bq = n ? hb[FM - n] * fnrm : 0.f;
                f32x2 v;
                if (half == 0) v = (f32x2){a + bq, 0.f};
                else { const float d = a - bq, rev = (float)n * (1.f / 32768.f); v = (f32x2){d * __builtin_amdgcn_cosf(rev), -d * __builtin_amdgcn_sinf(rev)}; }
                X[pb + 560 * j] = v; }
            fft_fwd12(X, tid);
            h16x2 kpk[2][16];
#pragma unroll
            for (int g = 0; g < 2; ++g) { int b16 = fphys((tid + 512 * g) * 16); asm volatile("" : "+v"(b16));
                float kre[16], kim[16];
#pragma unroll
                for (int q = 0; q < 16; ++q) { const f32x2 v = X[b16 + q]; kre[q] = v[0]; kim[q] = v[1]; }
                dft_regs<16, 4, false>(kre, kim);
#pragma unroll
                for (int q = 0; q < 16; ++q) kpk[g][q] = (h16x2){(_Float16)kre[q], (_Float16)kim[q]}; }
            __syncthreads();
            asm volatile("" : "+v"(pb), "+v"(tq));
#pragma unroll 8
            for (int j = 0; j < 32; ++j) { const int n = tq + 512 * j; f32x2 v;
                if (cv == 0) v = (f32x2){hy_short(pv[0], n, S, wv[0], wv[1], wv[2], wv[3]), hy_short(pv[1], n, S, wv[0], wv[1], wv[2], wv[3])};
                else v = Z1[n];
                if (half == 1) { const float rev = (float)n * (1.f / 32768.f); const float c = __builtin_amdgcn_cosf(rev), sn = -__builtin_amdgcn_sinf(rev); v = (f32x2){v[0] * c - v[1] * sn, v[0] * sn + v[1] * c}; }
                X[pb + 560 * j] = v; }
            fft_fwd12(X, tid);
#pragma unroll
            for (int g = 0; g < 2; ++g) { int b16 = fphys((tid + 512 * g) * 16); asm volatile("" : "+v"(b16));
                float re[16], im[16];
#pragma unroll
                for (int q = 0; q < 16; ++q) { const f32x2 v = X[b16 + q]; re[q] = v[0]; im[q] = v[1]; }
                dft_regs<16, 4, false>(re, im);
                float br[16], bi[16];
#pragma unroll
                for (int m = 0; m < 16; ++m) { const int qp = brev(m, 4); const float kr = (float)kpk[g][m][0], ki = (float)kpk[g][m][1]; br[qp] = re[m] * kr - im[m] * ki; bi[qp] = re[m] * ki + im[m] * kr; }
                dft_regs<16, 4, true>(br, bi);
#pragma unroll
                for (int m = 0; m < 16; ++m) X[b16 + brev(m, 4)] = (f32x2){br[m], bi[m]};
            }
            fft_inv21(X, tid);
            asm volatile("" : "+v"(pb), "+v"(tq));
            if (half == 0) {
#pragma unroll 8
                for (int j = 0; j < 32; ++j) { const int n = tq + 512 * j; Ye[n] = X[pb + 560 * j]; }
            } else {
#pragma unroll 4
                for (int j = 0; j < 32; ++j) { const int n = tq + 512 * j;
                    const f32x2 yo = X[pb + 560 * j], ye = Ye[n];
                    const float rev = (float)n * (1.f / 32768.f); const float c = __builtin_amdgcn_cosf(rev), sn = __builtin_amdgcn_sinf(rev);
                    const float y0 = (ye[0] + yo[0] * c - yo[1] * sn) * nrm, y1 = (ye[1] + yo[0] * sn + yo[1] * c) * nrm;
                    if (cv == 0) {
                        const float v0 = hy_short(pv[0], n, S, wv[0], wv[1], wv[2], wv[3]), v1 = hy_short(pv[1], n, S, wv[0], wv[1], wv[2], wv[3]);
                        const float a0 = hy_short(px1[0], n, S, wx1[0], wx1[1], wx1[2], wx1[3]), a1 = hy_short(px1[1], n, S, wx1[0], wx1[1], wx1[2], wx1[3]);
                        Z1[n] = (f32x2){a0 * (y0 + skip * v0), a1 * (y1 + skip * v1)};
                    } else {
                        const f32x2 z1 = Z1[n];
                        const float a0 = hy_short(px2[0], n, S, wx2[0], wx2[1], wx2[2], wx2[3]), a1 = hy_short(px2[1], n, S, wx2[0], wx2[1], wx2[2], wx2[3]);
                        bf16_t* mix = WSP(bf16_t, WS_HBF);
                        mix[((size_t)n) * D + 768 + ch] = f2bf(a0 * (y0 + skip * z1[0]));
                        mix[((size_t)S + n) * D + 768 + ch] = f2bf(a1 * (y1 + skip * z1[1]));
                    }
                }
            }
        }
    }
}
DI void hyena_ctx_unit(const Frame& F, int li, int ch) {
    float* vs = (float*)F.lds;
    float* zs = vs + 512;
    float* fl = zs + 512;
    const bf16_t* HYC = WSP(bf16_t, WS_HYC); const float* filt = WSP(float, WS_FILTC);
    const float* sw = F.in[I_HYSW] + (size_t)li * 3 * 768; const float* sb = F.in[I_HYSB] + li * 768; const float* sk = F.in[I_HSKIP] + li * 512;
    const float n0 = hy_norm(WSP(float, WS_FPARTC), 4, 0, ch), n1 = hy_norm(WSP(float, WS_FPARTC), 4, 1, ch);
    const int b = F.tid >> 8, t = F.tid & 255;
    auto sc = [&](int c) -> float { const bf16_t* p = HYC + (size_t)(b * CTX) * 768 + c;
        const float a = t > 0 ? bf2f(p[(size_t)(t - 1) * 768]) : 0.f, d = t + 1 < CTX ? bf2f(p[(size_t)(t + 1) * 768]) : 0.f;
        return a * sw[c] + bf2f(p[(size_t)t * 768]) * sw[768 + c] + d * sw[1536 + c] + sb[c]; };
    __syncthreads();
    const float x1 = sc(ch), x2 = sc(256 + ch), v = sc(512 + ch);
    vs[F.tid] = v;
    for (int i = F.tid; i < 1024; i += NTHR) fl[i] = filt[((size_t)(i >> 8) * 256 + ch) * CTX + (i & 255)];
    __syncthreads();
    float a = 0.f;
    for (int s = 0; s < CTX; ++s) { const int dl = t - s; a += (dl >= 0 ? fl[dl] : fl[256 - dl]) * vs[b * 256 + s]; }
    const float z = x1 * (a * n0 + sk[ch] * v);
    zs[F.tid] = z;
    __syncthreads();
    a = 0.f;
    for (int s = 0; s < CTX; ++s) { const int dl = t - s; a += (dl >= 0 ? fl[512 + dl] : fl[768 - dl]) * zs[b * 256 + s]; }
    WSP(bf16_t, WS_HBF)[((size_t)NLAT + b * CTX + t) * D + 768 + ch] = f2bf(x2 * (a * n1 + sk[256 + ch] * z));
}

DI void phase_mix(const Frame& F0, int li) {
    const Frame& F = F0;
    unsigned* head = F.ctl + CW_QHEAD + li * 64;
    volatile unsigned* qs = (volatile unsigned*)(F.lds + LDS_MISC + 32);
#ifndef PROBE_DA
#define PROBE_DA 1
#endif
#ifndef PROBE_HY
#define PROBE_HY 1
#endif
#ifndef PROBE_NA
#define PROBE_NA 1
#endif
#ifdef PROBE_MISC
#define PROBE_PL 2
#else
#define PROBE_PL 1
#endif
    const int n_ca = (li == 0) ? 16 : 0, n_cb = (li == 0) ? 8 : 0, n_da = 1024 * PROBE_DA, n_hy = 256 * PROBE_HY, n_na = 512 * PROBE_NA, n_hc = (li == 0) ? 256 * PROBE_PL : 0, n_pl = 1024 * PROBE_PL, n_pc = (li == 0) ? 16 : 0;
    const int total = n_ca + n_cb + n_da + n_hy + n_na + n_hc + n_pl + n_pc;
    for (;;) {
        __syncthreads();
        if (F.tid == 0) qs[0] = __hip_atomic_fetch_add(head, 1u, __ATOMIC_RELAXED, __HIP_MEMORY_SCOPE_AGENT);
        __syncthreads();
        int u = __builtin_amdgcn_readfirstlane((int)qs[0]);
        if (u >= total) break;
        Frame F = F0; refresh(F);
        if (u < n_ca) {
#ifndef SKIP_CA
            diffattn_unit(F, li, u >> 3, (u >> 1) & 3, (size_t)NLAT + (size_t)(u >> 3) * CTX + (size_t)(u & 1) * 128, CTX / 128);
#endif
            continue; }
        u -= n_ca;
        if (u < n_cb) {
#ifndef SKIP_CB
            na_mfma_unit(F, li, u >> 2, (size_t)NLAT + (size_t)(u >> 2) * CTX + (size_t)(u & 3) * 64, -1);
#endif
            continue; }
        u -= n_cb;
        if (u < n_da) {
#ifndef SKIP_DA
            { const int v = u & 1023; diffattn_unit(F, li, v >> 9, (v >> 7) & 3, (size_t)(v >> 9) * S + (size_t)(v & 127) * 128, NKEY / 128); }
#endif
            continue; }
        u -= n_da;
        if (u < n_hy) {
#ifndef SKIP_HY
            hyena_fft_unit(F, li, u & 255);
#endif
            continue; }
        u -= n_hy;
        if (u < n_na) {
#ifndef SKIP_NA
            { const int v = u & 511; na_mfma_unit(F, li, v >> 8, (size_t)(v >> 8) * S + (size_t)(v & 255) * GW, v & 255); }
#endif
            continue; }
        u -= n_na;
        if (u < n_hc) {
#ifndef SKIP_HC
            hyena_ctx_unit(F, li, u & 255);
#endif
            continue; }
        u -= n_hc;
        if (u < n_pl) {
#ifndef SKIP_PL
            { const int v = u & 1023; pool_unit(F, li, (size_t)(v >> 9) * S, S, (v & 511) * 32); }
#endif
            continue; }
        u -= n_pl;
#ifndef SKIP_PL
        pool_unit(F, li, (size_t)NLAT + (u >> 3) * CTX, CTX, (u & 7) * 32);
#endif
    }
}

constexpr int PH_PER_LAYER = 8, NPH = 2 + 2 * PH_PER_LAYER;
__global__ void __launch_bounds__(NTHR, 2) mega(Args args) {
    extern __shared__ __attribute__((aligned(16))) unsigned char smem[];
    Frame F;
    F.in = args.in; F.out = args.out; F.ws = args.ws; F.ctl = (unsigned*)(args.ws + WS_CTL); F.lds = smem;
    F.tid = threadIdx.x; F.lane = F.tid & 63; F.wave = __builtin_amdgcn_readfirstlane(F.tid >> 6); F.G = gridDim.x; F.bid = blockIdx.x;
    if (F.tid < 64) ((unsigned*)(smem + LDS_MISC))[F.tid] = 0u;
    __syncthreads();
    const int lo = args.ph_lo, hi = args.ph_hi;
    const bool fused = (hi - lo) > 1;
    XcdBarrier bar; bar.bar = F.ctl; bar.x = 0; bar.st = (volatile LAS unsigned*)(smem + LDS_MISC);
    if (fused) bar = xcd_barrier_post(F.ctl, (volatile LAS unsigned*)(smem + LDS_MISC));
#define IN(k) (lo <= (k) && (k) < hi)
#ifdef PROBE_BAR
#define SEAM(k) do { if (IN(k) && IN((k) + 1)) { xcd_barrier(bar); xcd_barrier(bar); xcd_barrier(bar); } } while (0)
#else
#define SEAM(k) do { if (IN(k) && IN((k) + 1)) xcd_barrier(bar); } while (0)
#endif
#ifndef SKIP_P0
    if (IN(0)) { refresh(F); phase_prologue(F);
#ifdef PROBE_MISC
        __syncthreads(); refresh(F); phase_prologue(F);
#endif
    }
#endif
    SEAM(0);
    for (int li = 0; li < 2; ++li) {
        const int p0 = 1 + li * PH_PER_LAYER;
        const int nrows = (li == 0) ? NTOK : NLAT;
        if (IN(p0)) {
            refresh(F);
            phase_norm1(F, li, li == 0 ? 0 : 1);
#ifdef PROBE_N1
            if (li == 0) { refresh(F); phase_norm1(F, li, 0); refresh(F); phase_norm1(F, li, 0); refresh(F); phase_norm1(F, li, 0); refresh(F); phase_norm1(F, li, 0); }
#endif
            refresh(F);
#ifndef SKIP_FILT
            for (int t = F.bid; t < 256; t += F.G) filter_tile(F, li, S, t, WSP(float, WS_FILT), WSP(float, WS_FPART));
            if (li == 0) for (int t = F.bid; t < 4; t += F.G) filter_tile(F, li, CTX, t, WSP(float, WS_FILTC), WSP(float, WS_FPARTC));
#ifdef PROBE_MISC
            for (int t = F.bid; t < 256; t += F.G) filter_tile(F, li, S, t, WSP(float, WS_FILT), WSP(float, WS_FPART));
#endif
#endif
        }
        SEAM(p0);
        if (IN(p0 + 1)) {
            refresh(F);
            pg8::Gemm g{WSP(bf16_t, WS_HBF), WSP(bf16_t, WS_WIN) + (size_t)li * DIN * D, D, 0};
            pg8::StaticOrder So; So.init(NTOK, DIN, F.G, F.bid);
            EpiIn E{F.ws, WSP(float, WS_ROPE), F.ctl + CW_KMAX + li * 16, F.ctl + CW_KMAXB + li * 16};
#ifndef SKIP_G1
            pg8::gemm_phase<EpiIn, pg8::StaticOrder>((LAS unsigned char*)smem, g, So, E, F.tid);
#ifdef PROBE_G1
            __syncthreads(); refresh(F); pg8::gemm_phase<EpiIn, pg8::StaticOrder>((LAS unsigned char*)smem, g, So, E, F.tid);
#endif
#endif
        }
        SEAM(p0 + 1);
        if (IN(p0 + 2)) { refresh(F); phase_mix(F, li); }
        SEAM(p0 + 2);
        if (IN(p0 + 3)) {
            refresh(F);
            pg8::Gemm g{WSP(bf16_t, WS_HBF), WSP(bf16_t, WS_WOUT) + (size_t)li * D * D, D, 0};
            pg8::StaticOrder So; So.init(nrows, D, F.G, F.bid);
            EpiOut E{li == 0 ? F.in[I_X] : F.out, li == 0 ? F.in[I_CTX] : WSP(float, WS_XC), F.out, WSP(float, WS_XC), WSP(float, WS_MOD) + (size_t)li * 3 * 6144};
#ifndef SKIP_G2
            pg8::gemm_phase<EpiOut, pg8::StaticOrder>((LAS unsigned char*)smem, g, So, E, F.tid);
#endif
        }
        SEAM(p0 + 3);
#ifndef SKIP_N2
        if (IN(p0 + 4)) { refresh(F); phase_norm2(F, li, nrows); }
#endif
        SEAM(p0 + 4);
        if (IN(p0 + 5)) { refresh(F); phase_gather(F, li, nrows);
#ifdef PROBE_MISC
            __syncthreads(); refresh(F); phase_gather(F, li, nrows);
#endif
        }
        SEAM(p0 + 5);
        if (IN(p0 + 6)) {
            refresh(F);
            int* offs = (int*)(smem + LDS_MISC + 64);
            moe_offsets(F, li, offs);
            pg8::Gemm g{WSP(bf16_t, WS_A1), WSP(bf16_t, WS_W13) + (size_t)li * NE * 1024 * 1024, D, (size_t)1024 * 1024};
            pg8::MoeOrder Mo{offs + 40, offs[17 + 16], 4, F.G, F.bid};
            EpiMoe1 E{WSP(bf16_t, WS_HMID)};
#ifndef SKIP_G3
            pg8::gemm_phase<EpiMoe1, pg8::MoeOrder>((LAS unsigned char*)smem, g, Mo, E, F.tid);
#ifdef PROBE_G3
            __syncthreads(); refresh(F); pg8::gemm_phase<EpiMoe1, pg8::MoeOrder>((LAS unsigned char*)smem, g, Mo, E, F.tid);
#endif
#endif
        }
        SEAM(p0 + 6);
        if (IN(p0 + 7)) {
            refresh(F);
            int* offs = (int*)(smem + LDS_MISC + 64);
            moe_offsets(F, li, offs);
            pg8::Gemm g{WSP(bf16_t, WS_HMID), WSP(bf16_t, WS_W2) + (size_t)li * NE * 1024 * 512, DE, (size_t)1024 * 512};
            pg8::MoeOrder Mo{offs + 40, offs[17 + 16], 4, F.G, F.bid};
            EpiMoe2 E{WSP(bf16_t, WS_A1)};
#ifndef SKIP_G4
            pg8::gemm_phase<EpiMoe2, pg8::MoeOrder>((LAS unsigned char*)smem, g, Mo, E, F.tid);
#ifdef PROBE_G4
            __syncthreads(); refresh(F); pg8::gemm_phase<EpiMoe2, pg8::MoeOrder>((LAS unsigned char*)smem, g, Mo, E, F.tid);
#endif
#endif
        }
        SEAM(p0 + 7);
    }
    if (IN(NPH - 1)) { refresh(F); phase_norm1(F, 1, 2); }
#undef IN
#undef SEAM
}

extern "C" void kernel_launch(void* const* d_in, const int* in_sizes, int n_in, void* d_out, int out_size, void* d_ws, size_t ws_size, hipStream_t stream) {
    static int grid = 0;
    if (grid == 0) {
        if (n_in != N_IN || out_size != NLAT * D || ws_size < WS_END) { fprintf(stderr, "kernel_launch: unexpected shapes (n_in %d out %d ws %zu need %zu)\n", n_in, out_size, ws_size, (size_t)WS_END); grid = -1; return; }
        int dev = 0, cus = 0, per_cu = 0;
        if (hipGetDevice(&dev) != hipSuccess || hipDeviceGetAttribute(&cus, hipDeviceAttributeMultiprocessorCount, dev) != hipSuccess) { grid = -1; return; }
        if (hipFuncSetAttribute((const void*)mega, hipFuncAttributeMaxDynamicSharedMemorySize, LDS_BYTES) != hipSuccess) { fprintf(stderr, "kernel_launch: hipFuncSetAttribute failed\n"); grid = -1; return; }
        if (hipOccupancyMaxActiveBlocksPerMultiprocessor(&per_cu, (const void*)mega, NTHR, LDS_BYTES) != hipSuccess || per_cu < 1) { fprintf(stderr, "kernel_launch: occupancy query says %d\n", per_cu); }
        (void)hipGetLastError();
        grid = cus < MAXG ? cus : MAXG;
    }
    if (grid < 0) return;
    (void)hipMemsetAsync((char*)d_ws + WS_CTL, 0, CTL_BYTES, stream);
    Args a{};
    for (int i = 0; i < N_IN; ++i) a.in[i] = (const float*)d_in[i];
    a.out = (float*)d_out; a.ws = (unsigned char*)d_ws;
#if N_LAUNCH_MODE == 1
    a.ph_lo = 0; a.ph_hi = NPH;
    hipLaunchKernelGGL(mega, dim3(grid), dim3(NTHR), LDS_BYTES, stream, a);
#else
    for (int p = 0; p < NPH; ++p) { a.ph_lo = p; a.ph_hi = p + 1; hipLaunchKernelGGL(mega, dim3(grid), dim3(NTHR), LDS_BYTES, stream, a); }
#endif
}
#ifdef TEST_UNITS
__global__ void __launch_bounds__(NTHR, 2) t_da(Args args) {
    extern __shared__ __attribute__((aligned(16))) unsigned char smem[];
    Frame F; F.in = args.in; F.out = args.out; F.ws = args.ws; F.ctl = (unsigned*)(args.ws + WS_CTL); F.lds = smem; F.G = gridDim.x; F.bid = blockIdx.x; refresh(F);
    diffattn_unit(F, args.ph_lo, blockIdx.x >> 8, (blockIdx.x >> 6) & 3, (size_t)(blockIdx.x & 63) * 256, NKEY / 128);
}
__global__ void __launch_bounds__(NTHR, 2) t_hy(Args args) {
    extern __shared__ __attribute__((aligned(16))) unsigned char smem[];
    Frame F; F.in = args.in; F.out = args.out; F.ws = args.ws; F.ctl = (unsigned*)(args.ws + WS_CTL); F.lds = smem; F.G = gridDim.x; F.bid = blockIdx.x; refresh(F);
    hyena_fft_unit(F, args.ph_lo, blockIdx.x);
}
#endif
```

```cpp
#include <hip/hip_runtime.h>
#include <stdint.h>
#include <stdio.h>

#ifndef N_LAUNCH_MODE
#define N_LAUNCH_MODE 1
#endif

#define DI __device__ __forceinline__
#define LAS __attribute__((address_space(3)))
typedef unsigned short bf16_t;
typedef short bf16x8 __attribute__((ext_vector_type(8)));
typedef short s16x4 __attribute__((ext_vector_type(4)));
typedef float f32x4 __attribute__((ext_vector_type(4)));
typedef float f32x2 __attribute__((ext_vector_type(2)));
typedef float f32x16 __attribute__((ext_vector_type(16)));
typedef unsigned u32x4 __attribute__((ext_vector_type(4)));
typedef unsigned u32x2 __attribute__((ext_vector_type(2)));
typedef _Float16 h16x2 __attribute__((ext_vector_type(2)));

constexpr int D = 1024, NB = 2, S = 16384, CTX = 256, NLAT = NB * S, NCTX = NB * CTX, NTOK = NLAT + NCTX, DIN = 2560;
constexpr int NE = 16, DE = 512, GW = 64;
constexpr int NKEY = CTX + S;
constexpr int NTHR = 512;
constexpr int SLOT_CAP = 70656;
constexpr float EPS = 1e-6f;
constexpr float LOG2E = 1.4426950408889634f;
constexpr float QSCALE_A = 0.17677669529663687f * LOG2E;
constexpr float QSCALE_B = 0.125f * LOG2E;

enum { I_X = 0, I_C, I_CTX, I_CCTX, I_N1G, I_N2G, I_ADAW, I_ADAB, I_WIN, I_WOUT, I_ALAM, I_ASUB, I_RPB, I_POOLW, I_POOLS, I_HYSW, I_HYSB,
       I_HW1, I_HB1, I_HW2, I_HB2, I_HW3, I_HB3, I_HSKIP, I_RW, I_RB, I_MW1, I_MW3, I_MW2, I_FG, N_IN };

struct Args { const float* in[N_IN]; float* out; unsigned char* ws; int ph_lo, ph_hi; };

constexpr size_t al256(size_t x) { return (x + 255) & ~(size_t)255; }
constexpr size_t WS_CTL = 0, CTL_BYTES = 65536;
constexpr size_t WS_MOD = WS_CTL + CTL_BYTES;
constexpr size_t WS_ROPE = WS_MOD + al256(2 * 3 * 6144 * 4);
constexpr size_t WS_FPART = WS_ROPE + 16384;
constexpr size_t WS_FPARTC = WS_FPART + 256 * 1024 * 4;
constexpr size_t WS_XC = WS_FPARTC + 4 * 1024 * 4;
constexpr size_t WS_WIN = WS_XC + (size_t)NCTX * D * 4;
constexpr size_t WS_WOUT = WS_WIN + (size_t)2 * DIN * D * 2;
constexpr size_t WS_W13 = WS_WOUT + (size_t)2 * D * D * 2;
constexpr size_t WS_W2 = WS_W13 + (size_t)2 * NE * 1024 * 1024 * 2;
constexpr size_t WS_FILT = WS_W2 + (size_t)2 * NE * 1024 * 512 * 2;
constexpr size_t WS_FILTC = WS_FILT + (size_t)4 * 256 * S * 4;
constexpr size_t WS_ZBUF = WS_FILTC + (size_t)4 * 256 * 256 * 4;
constexpr size_t WS_R1 = WS_ZBUF + (size_t)256 * 2 * S * 4;
constexpr size_t WS_HBF = WS_R1;
constexpr size_t TOKB = (size_t)NTOK * 256 * 2;
constexpr size_t WS_AQ = WS_HBF + (size_t)NTOK * D * 2;
constexpr size_t WS_AK = WS_AQ + TOKB;
constexpr size_t WS_AVT = WS_AK + TOKB;
constexpr size_t WS_BQ = WS_AVT + (size_t)NB * 4 * 64 * NKEY * 2;
constexpr size_t WS_BK = WS_BQ + TOKB;
constexpr size_t WS_BVT = WS_BK + TOKB;
constexpr size_t WS_PL = WS_BVT + (size_t)NB * 4 * 64 * NKEY * 2;
constexpr size_t WS_HYT = WS_PL + TOKB;
constexpr size_t WS_HYC = WS_HYT + (size_t)NB * 768 * S * 2;
constexpr size_t WS_Z1BUF = WS_HYC + (size_t)NCTX * 768 * 2;
constexpr size_t WS_END_MIX = WS_Z1BUF + (size_t)256 * S * 8;
constexpr size_t WS_TOK = WS_AQ;
constexpr size_t WS_A1 = WS_TOK + al256((size_t)NTOK * 32);
constexpr size_t WS_HMID = WS_A1 + (size_t)SLOT_CAP * D * 2;
constexpr size_t WS_END_MOE = WS_HMID + (size_t)SLOT_CAP * DE * 2;
constexpr size_t WS_END = WS_END_MIX > WS_END_MOE ? WS_END_MIX : WS_END_MOE;

#define XB_TMO      128
#define XB_XCNT(j)  (256  + 64 * (j))
#define XB_XSUB(j)  (1280 + 64 * (j))
#define XB_XGEN(j)  (2304 + 64 * (j))
#define XB_TOP      3328
#define XB_TOPGEN   3392
#define XCD_BAR_WORDS 3456
#define XB_SPIN_CAP (1u << 18)
constexpr int CW_CNT = 4096;
constexpr int CW_KMAX = 4160;
constexpr int CW_KMAXB = 4192;
constexpr int CW_QHEAD = 4224;
constexpr int CW_BCNT = 4352;
constexpr int MAXG = 256;

constexpr int LDS_MAIN = 143360, LDS_MISC = LDS_MAIN, LDS_BYTES = LDS_MAIN + 2048;

DI float bf2f(bf16_t v) { return __uint_as_float(((unsigned)v) << 16); }
DI bf16_t f2bf(float f) { unsigned u = __float_as_uint(f); u += 0x7FFFu + ((u >> 16) & 1u); return (bf16_t)(u >> 16); }
DI unsigned pk2(float lo, float hi) { unsigned r; asm volatile("v_cvt_pk_bf16_f32 %0, %1, %2" : "=v"(r) : "v"(lo), "v"(hi)); return r; }
template <int K> DI float swz_xor(float v) { return __int_as_float(__builtin_amdgcn_ds_swizzle(__float_as_int(v), (K << 10) | 0x1F)); }
DI float half_sum(float v) { const auto r = __builtin_amdgcn_permlane32_swap(__float_as_uint(v), __float_as_uint(v), false, false); return __uint_as_float(r[0]) + __uint_as_float(r[1]); }
DI float half_max(float v) { const auto r = __builtin_amdgcn_permlane32_swap(__float_as_uint(v), __float_as_uint(v), false, false); return fmaxf(__uint_as_float(r[0]), __uint_as_float(r[1])); }
DI float wave_sum(float v) { v += swz_xor<16>(v); v += swz_xor<8>(v); v += swz_xor<4>(v); v += swz_xor<2>(v); v += swz_xor<1>(v); return half_sum(v); }
DI float wave_max(float v) { v = fmaxf(v, swz_xor<16>(v)); v = fmaxf(v, swz_xor<8>(v)); v = fmaxf(v, swz_xor<4>(v)); v = fmaxf(v, swz_xor<2>(v)); v = fmaxf(v, swz_xor<1>(v)); return half_max(v); }
DI float siluf(float x) { return x / (1.f + __expf(-x)); }
DI float sin_rev(float rev) { return __builtin_amdgcn_sinf(rev - floorf(rev)); }
DI float cos_rev(float rev) { return __builtin_amdgcn_cosf(rev - floorf(rev)); }
DI float sin_rad(float x) { return sin_rev(x * 0.15915494309189535f); }

DI unsigned xb_ld(unsigned* p)              { return __hip_atomic_load(p, __ATOMIC_RELAXED, __HIP_MEMORY_SCOPE_AGENT); }
DI unsigned xb_add(unsigned* p, unsigned v) { return __hip_atomic_fetch_add(p, v, __ATOMIC_RELAXED, __HIP_MEMORY_SCOPE_AGENT); }
DI unsigned xb_xcc_id() { return (unsigned)__builtin_amdgcn_s_getreg((3 << 11) | 20) & 0xFu; }
#define XB_SPIN(cond, bar) do { unsigned _sp = 0; while (cond) { __builtin_amdgcn_s_sleep(1); \
    if ((++_sp & 255u) == 0u) { if (xb_ld(&(bar)[XB_TMO])) break; if (_sp > XB_SPIN_CAP) { atomicAdd(&(bar)[XB_TMO], 1u); break; } } } } while (0)
struct XcdBarrier { unsigned* bar; unsigned x; volatile LAS unsigned* st; };
DI XcdBarrier xcd_barrier_post(unsigned* bar, volatile LAS unsigned* st) {
    XcdBarrier b; b.bar = bar; b.x = xb_xcc_id(); b.st = st;
    if (threadIdx.x == 0) (void)xb_add(&bar[XB_XCNT(b.x)], 1u);
    return b;
}
DI void xcd_barrier_complete(unsigned* bar, unsigned x, unsigned& nloc, unsigned& nx) {
    const unsigned G = gridDim.x * gridDim.y * gridDim.z;
    unsigned sum, cnt, mine, sp = 0u;
    for (;;) {
        sum = 0u; cnt = 0u; mine = 0u;
#pragma unroll
        for (unsigned j = 0; j < 16; ++j) { const unsigned c = xb_ld(&bar[XB_XCNT(j)]); sum += c; cnt += (c > 0u) ? 1u : 0u; mine = (j == x) ? c : mine; }
        if (sum == G) break;
        __builtin_amdgcn_s_sleep(1);
        if ((++sp & 255u) == 0u) { if (xb_ld(&bar[XB_TMO])) break; if (sp > XB_SPIN_CAP) { atomicAdd(&bar[XB_TMO], 1u); break; } }
    }
    nloc = mine > 0u ? mine : 1u; nx = cnt > 0u ? cnt : 1u;
}
DI void xcd_barrier(const XcdBarrier& b) {
    asm volatile("s_waitcnt vmcnt(0)" ::: "memory");
    __syncthreads();
    if (threadIdx.x == 0) {
        unsigned* bar = b.bar;
        __builtin_amdgcn_s_waitcnt(0);
        unsigned nloc = b.st[0], nx = b.st[1];
        if (nloc == 0u) { xcd_barrier_complete(bar, b.x, nloc, nx); b.st[0] = nloc; b.st[1] = nx; }
        const unsigned old = xb_add(&bar[XB_XSUB(b.x)], 1u);
        const unsigned gen = old / nloc;
        if (old + 1u == (gen + 1u) * nloc) {
            __builtin_amdgcn_fence(__ATOMIC_RELEASE, "agent");
            asm volatile("s_waitcnt vmcnt(0)" ::: "memory");
            const unsigned og = xb_add(&bar[XB_TOP], 1u);
            const unsigned tg = og / nx;
            if (og + 1u == (tg + 1u) * nx) xb_add(&bar[XB_TOPGEN], 1u);
            else XB_SPIN(xb_ld(&bar[XB_TOPGEN]) == tg, bar);
            __builtin_amdgcn_fence(__ATOMIC_ACQUIRE, "agent");
            xb_add(&bar[XB_XGEN(b.x)], 1u);
            asm volatile("s_waitcnt vmcnt(0)" ::: "memory");
        } else {
            XB_SPIN(xb_ld(&bar[XB_XGEN(b.x)]) == gen, bar);
            __builtin_amdgcn_fence(__ATOMIC_ACQUIRE, "agent");
            asm volatile("s_waitcnt vmcnt(0)" ::: "memory");
        }
    }
    __syncthreads();
}

struct Frame {
    const float* const* in; float* out; unsigned char* ws; unsigned* ctl;
    unsigned char* lds;
    int tid, lane, wave, G, bid;
};
#define WSP(T, off) ((T*)(F.ws + (off)))
DI void refresh(Frame& F) { int t = threadIdx.x; asm volatile("" : "+v"(t)); F.tid = t; F.lane = t & 63; F.wave = __builtin_amdgcn_readfirstlane(t >> 6);
}

namespace pg8 {
constexpr int BM = 256, BK = 64, HALF = 128, HTB = HALF * BK * 2, STAGE_BYTES = 8 * HTB, NXCD = 8, WGM = 8;
DI int lds_byte(int r, int c) { const int st = (r >> 4) * 2 + (c >> 5), rr = r & 15, cc = c & 31, ob = rr * 64 + cc * 2; return st * 1024 + (ob ^ (((ob >> 9) & 1) << 5)); }
DI void stage_rc(int b, int& R, int& C) { const int st = b / 1024, sb = b % 1024, swz = sb ^ (((sb >> 9) & 1) << 5); R = (st >> 1) * 16 + swz / 64; C = (st & 1) * 32 + (swz % 64) / 2; }
struct Unit { int pm, pn, e; };
struct Gemm { const bf16_t* A; const bf16_t* Bt; int K; size_t bstride; };
struct StaticOrder {
    int nM, nN, nwg, G, c;
    DI void init(int M, int N, int G_, int c_) { nM = M / BM; nN = N / BM; nwg = nM * nN; G = G_; c = c_; }
    DI bool next(int i, Unit& u) const {
        const long L = (long)i * G + c; if (L >= nwg) return false;
        int wgid = (int)L; { const int q = nwg / NXCD, r = nwg % NXCD, xcd = wgid % NXCD, off = wgid / NXCD; wgid = (xcd < r ? xcd * (q + 1) : r * (q + 1) + (xcd - r) * q) + off; }
        const int nig = WGM * nN, gid = wgid / nig, fm = gid * WGM, gsz = (nM - fm) < WGM ? (nM - fm) : WGM;
        u.pm = fm + ((wgid % nig) % gsz); u.pn = (wgid % nig) / gsz; u.e = 0; return true;
    }
};
struct MoeOrder {
    const int* toff; int ntile, nN, G, c;
    DI bool next(int i, Unit& u) const {
        const long L = (long)i * G + c; if (L >= (long)ntile * nN) return false;
        const int t = (int)(L / nN); u.pm = t; u.pn = (int)(L % nN);
        u.e = toff[t]; return true;
    }
};

template <class Epi, class Sched>
DI void gemm_phase(LAS unsigned char* lds, const Gemm g, const Sched& S, const Epi& E, int tid) {
    const int wid = __builtin_amdgcn_readfirstlane(tid >> 6), lane = tid & 63, wr = wid >> 2, wc = wid & 3, fr = lane & 15, fq = lane >> 4;
    const int K = g.K, nt = K / BK;
    unsigned voffA[2];
#pragma unroll
    for (int i = 0; i < 2; ++i) { int R, C; stage_rc(tid * 16 + i * 8192, R, C); voffA[i] = (unsigned)(R * K + C) * 2u; }
    const size_t kstep = (size_t)(BK * 2);
    const size_t hstep = (size_t)HALF * K * 2;
    const size_t tstep = 2 * hstep;
    const unsigned ldsw = (unsigned)wid * 1024u;
    const int aoff = lds_byte(wr * 64 + fr, fq * 8), boff = lds_byte(wc * 32 + fr, fq * 8);
#define PG8_SA(b, h) (((b) * 2 + (h)) * HTB)
#define PG8_SB(b, h) ((4 + (b) * 2 + (h)) * HTB)
#define PG8_STAGE(bufoff, gbase, voff) do { _Pragma("unroll") for (int _i = 0; _i < 2; ++_i) \
        __builtin_amdgcn_global_load_lds((const unsigned*)((const char*)(gbase) + (voff)[_i]), (LAS unsigned*)(lds + (bufoff) + ldsw + _i * 8192), 16, 0, 0); } while (0)
#define PG8_LDA(dst, b, h) do { _Pragma("unroll") for (int m = 0; m < 4; ++m) _Pragma("unroll") for (int k = 0; k < 2; ++k) dst[m][k] = *(const LAS bf16x8*)(lds + PG8_SA(b, h) + aoff + m * 2048 + k * 1024); } while (0)
#define PG8_LDB(dst, b, h) do { _Pragma("unroll") for (int n = 0; n < 2; ++n) _Pragma("unroll") for (int k = 0; k < 2; ++k) dst[n][k] = *(const LAS bf16x8*)(lds + PG8_SB(b, h) + boff + n * 2048 + k * 1024); } while (0)
#define PG8_MMA(ai, bj, At, Bt) do { __builtin_amdgcn_s_setprio(1); _Pragma("unroll") for (int m = 0; m < 4; ++m) _Pragma("unroll") for (int n = 0; n < 2; ++n) _Pragma("unroll") for (int k = 0; k < 2; ++k) \
        acc[ai][bj][m][n] = __builtin_amdgcn_mfma_f32_16x16x32_bf16(Bt[n][k], At[m][k], acc[ai][bj][m][n], 0, 0, 0); __builtin_amdgcn_s_setprio(0); } while (0)
#define PG8_WAIT_V(n) asm volatile("s_waitcnt vmcnt(" #n ")" ::: "memory")
#define PG8_WAIT_L(n) asm volatile("s_waitcnt lgkmcnt(" #n ")" ::: "memory")
#define PG8_BAR __builtin_amdgcn_s_barrier()
#define PG8_SCHED __builtin_amdgcn_sched_barrier(0)
    Unit cur, nxt; int ui = 0;
    if (!S.next(0, cur)) return;
    f32x4 acc[2][2][4][2];
#pragma unroll
    for (int a = 0; a < 2; ++a)
#pragma unroll
        for (int b = 0; b < 2; ++b)
#pragma unroll
            for (int m = 0; m < 4; ++m)
#pragma unroll
                for (int n = 0; n < 2; ++n) acc[a][b][m][n] = (f32x4){0.f, 0.f, 0.f, 0.f};
    bf16x8 At[4][2], B0[2][2], B1[2][2];
    const char* cA = (const char*)g.A + (size_t)cur.pm * tstep; const char* cB = (const char*)(g.Bt + (size_t)cur.e * g.bstride) + (size_t)cur.pn * tstep;
    PG8_STAGE(PG8_SB(0, 0), cB, voffA); PG8_STAGE(PG8_SA(0, 0), cA, voffA); PG8_STAGE(PG8_SB(0, 1), cB + hstep, voffA); PG8_STAGE(PG8_SA(0, 1), cA + hstep, voffA);
    if (wr == 1) PG8_BAR;
    PG8_WAIT_V(4); PG8_BAR;
    PG8_STAGE(PG8_SB(1, 0), cB + kstep, voffA); PG8_STAGE(PG8_SA(1, 0), cA + kstep, voffA); PG8_STAGE(PG8_SB(1, 1), cB + hstep + kstep, voffA);
    PG8_WAIT_V(6); PG8_BAR;
    for (;;) {
        const bool has_next = S.next(ui + 1, nxt);
        const char* nA = has_next ? (const char*)g.A + (size_t)nxt.pm * tstep : cA; const char* nB = has_next ? (const char*)(g.Bt + (size_t)nxt.e * g.bstride) + (size_t)nxt.pn * tstep : cB;
        for (int t = 0; t < nt; t += 2) {
            const bool last = (t == nt - 2);
            const char* a1 = cA + (size_t)(t + 1) * kstep;
            const char* a2 = last ? nA : cA + (size_t)(t + 2) * kstep; const char* b2 = last ? nB : cB + (size_t)(t + 2) * kstep;
            const char* a3 = a2 + kstep; const char* b3 = b2 + kstep;
            PG8_LDB(B0, 0, 0); PG8_SCHED; PG8_LDA(At, 0, 0); PG8_STAGE(PG8_SA(1, 1), a1 + hstep, voffA);
            PG8_WAIT_L(8); PG8_BAR; PG8_WAIT_L(0); PG8_MMA(0, 0, At, B0); PG8_BAR; PG8_SCHED;
            PG8_LDB(B1, 0, 1); PG8_STAGE(PG8_SB(0, 0), b2, voffA);
            PG8_BAR; PG8_WAIT_L(0); PG8_MMA(0, 1, At, B1); PG8_BAR;
            PG8_LDA(At, 0, 1); PG8_STAGE(PG8_SA(0, 0), a2, voffA);
            PG8_BAR; PG8_WAIT_L(0); PG8_MMA(1, 0, At, B0); PG8_BAR; PG8_SCHED;
            PG8_STAGE(PG8_SB(0, 1), b2 + hstep, voffA);
            PG8_WAIT_V(6); PG8_BAR; PG8_MMA(1, 1, At, B1); PG8_BAR;
            PG8_LDB(B0, 1, 0); PG8_SCHED; PG8_LDA(At, 1, 0); PG8_STAGE(PG8_SA(0, 1), a2 + hstep, voffA);
            PG8_WAIT_L(8); PG8_BAR; PG8_WAIT_L(0); PG8_MMA(0, 0, At, B0); PG8_BAR; PG8_SCHED;
            PG8_LDB(B1, 1, 1); PG8_STAGE(PG8_SB(1, 0), b3, voffA);
            PG8_BAR; PG8_WAIT_L(0); PG8_MMA(0, 1, At, B1); PG8_BAR;
            PG8_LDA(At, 1, 1); PG8_STAGE(PG8_SA(1, 0), a3, voffA);
            PG8_BAR; PG8_WAIT_L(0); PG8_MMA(1, 0, At, B0); PG8_BAR; PG8_SCHED;
            PG8_STAGE(PG8_SB(1, 1), b3 + hstep, voffA);
            PG8_WAIT_V(6); PG8_BAR; PG8_MMA(1, 1, At, B1); PG8_BAR;
        }
        E(acc, cur, wr, wc, fr, fq);
        if (!has_next) break;
#pragma unroll
        for (int a = 0; a < 2; ++a)
#pragma unroll
            for (int b = 0; b < 2; ++b)
#pragma unroll
                for (int m = 0; m < 4; ++m)
#pragma unroll
                    for (int n = 0; n < 2; ++n) acc[a][b][m][n] = (f32x4){0.f, 0.f, 0.f, 0.f};
        cur = nxt; cA = nA; cB = nB; ++ui;
    }
    PG8_WAIT_V(0);
    if (wr == 0) PG8_BAR;
    PG8_BAR;
#undef PG8_SA
#undef PG8_SB
#undef PG8_STAGE
#undef PG8_LDA
#undef PG8_LDB
#undef PG8_MMA
#undef PG8_WAIT_V
#undef PG8_WAIT_L
#undef PG8_BAR
#undef PG8_SCHED
}
}

typedef f32x4 AccT[2][2][4][2];

struct EpiIn {
    unsigned char* ws; const float* rope; unsigned* kmax; unsigned* kmaxb;
    DI void operator()(const AccT& acc, const pg8::Unit& u, int wr, int wc, int fr, int fq) const {
        const int pn = u.pn, row0 = u.pm * 256 + wr * 64 + fr;
        const bool isctx = (u.pm >= NLAT / 256);
        if (pn <= 1) {
            bf16_t* dst = (bf16_t*)(ws + (pn == 0 ? WS_AQ : WS_AK));
            const float sc = (pn == 0) ? QSCALE_A : 1.f;
            float nmax[2] = {0.f, 0.f};
#pragma unroll
            for (int ai = 0; ai < 2; ++ai)
#pragma unroll
                for (int m = 0; m < 4; ++m) {
                    const int r = row0 + ai * 128 + m * 16;
                    f32x4 cs0 = (f32x4){1.f, 0.f, 1.f, 0.f}, cs1 = cs0;
                    if (!isctx) { const int t = r & (S - 1); const int pos = (fq < 2) ? (t >> 6) : (t & 63);
                        const f32x4* tp = (const f32x4*)(rope + (size_t)pos * 16 + (fq & 1) * 8); cs0 = tp[0]; cs1 = tp[1]; }
                    const float cc[4] = {cs0[0], cs0[2], cs1[0], cs1[2]}, ss[4] = {cs0[1], cs0[3], cs1[1], cs1[3]};
#pragma unroll
                    for (int bj = 0; bj < 2; ++bj) {
                        const f32x4 x1 = acc[ai][bj][m][0], x2 = acc[ai][bj][m][1];
                        float o1[4], o2[4], n2 = 0.f;
#pragma unroll
                        for (int j = 0; j < 4; ++j) { o1[j] = (x1[j] * cc[j] - x2[j] * ss[j]) * sc; o2[j] = (x2[j] * cc[j] + x1[j] * ss[j]) * sc; n2 += x1[j] * x1[j] + x2[j] * x2[j]; }
                        bf16_t* p = dst + (size_t)r * 256 + bj * 128 + wc * 32 + 4 * fq;
                        *(u32x2*)p = (u32x2){pk2(o1[0], o1[1]), pk2(o1[2], o1[3])};
                        *(u32x2*)(p + 16) = (u32x2){pk2(o2[0], o2[1]), pk2(o2[2], o2[3])};
                        if (pn == 1) { n2 += swz_xor<16>(n2); n2 = half_sum(n2); nmax[bj] = fmaxf(nmax[bj], n2); }
                    }
                }
            if (pn == 1) {
                const int b = isctx ? (u.pm - NLAT / 256) : (u.pm / (S / 256));
#pragma unroll
                for (int bj = 0; bj < 2; ++bj) {
                    float v = nmax[bj];
                    v = fmaxf(v, swz_xor<1>(v)); v = fmaxf(v, swz_xor<2>(v)); v = fmaxf(v, swz_xor<4>(v)); v = fmaxf(v, swz_xor<8>(v));
                    if ((fr | fq) == 0) atomicMax(kmax + (b * 4 + (2 * bj + (wc >> 1))) * 2 + (wc & 1), __float_as_uint(v));
                }
            }
        } else if (pn == 2 || pn == 5) {
            bf16_t* dst = (bf16_t*)(ws + (pn == 2 ? WS_AVT : WS_BVT));
#pragma unroll
            for (int ai = 0; ai < 2; ++ai)
#pragma unroll
                for (int m = 0; m < 4; ++m) {
                    const int r = row0 + ai * 128 + m * 16;
                    int b, key; if (isctx) { b = (r - NLAT) >> 8; key = (r - NLAT) & 255; } else { b = r >> 14; key = CTX + (r & (S - 1)); }
#pragma unroll
                    for (int bj = 0; bj < 2; ++bj)
#pragma unroll
                        for (int n = 0; n < 2; ++n) {
                            const int lc = bj * 128 + wc * 32 + n * 16 + 4 * fq;
#pragma unroll
                            for (int j = 0; j < 4; ++j) dst[((size_t)(b * 256 + lc + j)) * NKEY + key] = f2bf(acc[ai][bj][m][n][j]);
                        }
                }
        } else if (pn <= 6) {
            bf16_t* dst = (bf16_t*)(ws + (pn == 3 ? WS_BQ : pn == 4 ? WS_BK : WS_PL));
            const float sc = (pn == 3) ? QSCALE_B : 1.f;
            float nmax[2] = {0.f, 0.f};
#pragma unroll
            for (int ai = 0; ai < 2; ++ai)
#pragma unroll
                for (int m = 0; m < 4; ++m) {
                    const int r = row0 + ai * 128 + m * 16;
#pragma unroll
                    for (int bj = 0; bj < 2; ++bj)
#pragma unroll
                        for (int n = 0; n < 2; ++n) {
                            const f32x4 v = acc[ai][bj][m][n] * sc;
                            *(u32x2*)(dst + (size_t)r * 256 + bj * 128 + wc * 32 + n * 16 + 4 * fq) = (u32x2){pk2(v[0], v[1]), pk2(v[2], v[3])};
                        }
                    if (pn == 4) {
#pragma unroll
                        for (int bj = 0; bj < 2; ++bj) { const f32x4 x1 = acc[ai][bj][m][0], x2 = acc[ai][bj][m][1];
                            float n2 = x1[0] * x1[0] + x1[1] * x1[1] + x1[2] * x1[2] + x1[3] * x1[3] + x2[0] * x2[0] + x2[1] * x2[1] + x2[2] * x2[2] + x2[3] * x2[3];
                            n2 += swz_xor<16>(n2); n2 = half_sum(n2); nmax[bj] = fmaxf(nmax[bj], n2); }
                    }
                }
            if (pn == 4) {
                const int b = isctx ? (u.pm - NLAT / 256) : (u.pm / (S / 256));
#pragma unroll
                for (int bj = 0; bj < 2; ++bj) {
                    float v = nmax[bj];
                    v = fmaxf(v, swz_xor<1>(v)); v = fmaxf(v, swz_xor<2>(v)); v = fmaxf(v, swz_xor<4>(v)); v = fmaxf(v, swz_xor<8>(v));
                    if ((fr | fq) == 0) atomicMax(kmaxb + (b * 4 + (2 * bj + (wc >> 1))) * 2 + (wc & 1), __float_as_uint(v));
                }
            }
        } else {
            const int hc0 = (pn - 7) * 256;
#pragma unroll
            for (int ai = 0; ai < 2; ++ai)
#pragma unroll
                for (int m = 0; m < 4; ++m) {
                    const int r = row0 + ai * 128 + m * 16;
#pragma unroll
                    for (int bj = 0; bj < 2; ++bj)
#pragma unroll
                        for (int n = 0; n < 2; ++n) {
                            const int hc = hc0 + bj * 128 + wc * 32 + n * 16 + 4 * fq; const f32x4 v = acc[ai][bj][m][n];
                            if (isctx) *(u32x2*)((bf16_t*)(ws + WS_HYC) + (size_t)(r - NLAT) * 768 + hc) = (u32x2){pk2(v[0], v[1]), pk2(v[2], v[3])};
                            else { bf16_t* dst = (bf16_t*)(ws + WS_HYT) + ((size_t)(r >> 14) * 768 + hc) * S + (r & (S - 1));
#pragma unroll
                                for (int j = 0; j < 4; ++j) dst[(size_t)j * S] = f2bf(v[j]); }
                        }
                }
        }
    }
};

struct EpiOut {
    const float* xl_old; const float* xc_old; float* xl_new; float* xc_new; const float* mod;
    DI void operator()(const AccT& acc, const pg8::Unit& u, int wr, int wc, int fr, int fq) const {
        const int row0 = u.pm * 256 + wr * 64 + fr; const bool isctx = (u.pm >= NLAT / 256);
        const int v = isctx ? 2 : (u.pm / (S / 256));
        const float* g1 = mod + (size_t)v * 6144 + 2 * 1024;
        const float* so = isctx ? xc_old - (size_t)NLAT * D : xl_old; float* dn = isctx ? xc_new - (size_t)NLAT * D : xl_new;
#pragma unroll
        for (int bj = 0; bj < 2; ++bj)
#pragma unroll
            for (int n = 0; n < 2; ++n) {
                const int c = u.pn * 256 + bj * 128 + wc * 32 + n * 16 + 4 * fq;
                const f32x4 g = *(const f32x4*)(g1 + c);
#pragma unroll
                for (int ai = 0; ai < 2; ++ai)
#pragma unroll
                    for (int m = 0; m < 4; ++m) {
                        const size_t o = (size_t)(row0 + ai * 128 + m * 16) * D + c;
                        *(f32x4*)(dn + o) = *(const f32x4*)(so + o) + g * acc[ai][bj][m][n];
                    }
            }
    }
};

struct EpiMoe1 {
    bf16_t* hmid;
    DI void operator()(const AccT& acc, const pg8::Unit& u, int wr, int wc, int fr, int fq) const {
        const int row0 = u.pm * 256 + wr * 64 + fr;
#pragma unroll
        for (int ai = 0; ai < 2; ++ai)
#pragma unroll
            for (int m = 0; m < 4; ++m)
#pragma unroll
                for (int bj = 0; bj < 2; ++bj) {
                    const f32x4 a = acc[ai][bj][m][0], b = acc[ai][bj][m][1]; float h[4];
#pragma unroll
                    for (int j = 0; j < 4; ++j) h[j] = siluf(a[j]) * b[j];
                    *(u32x2*)(hmid + (size_t)(row0 + ai * 128 + m * 16) * DE + (u.pn * 256 + bj * 128 + wc * 32) / 2 + 4 * fq) = (u32x2){pk2(h[0], h[1]), pk2(h[2], h[3])};
                }
    }
};
struct EpiMoe2 {
    bf16_t* ys;
    DI void operator()(const AccT& acc, const pg8::Unit& u, int wr, int wc, int fr, int fq) const {
        const int row0 = u.pm * 256 + wr * 64 + fr;
#pragma unroll
        for (int ai = 0; ai < 2; ++ai)
#pragma unroll
            for (int m = 0; m < 4; ++m)
#pragma unroll
                for (int bj = 0; bj < 2; ++bj)
#pragma unroll
                    for (int n = 0; n < 2; ++n) { const f32x4 v = acc[ai][bj][m][n];
                        *(u32x2*)(ys + (size_t)(row0 + ai * 128 + m * 16) * D + u.pn * 256 + bj * 128 + wc * 32 + n * 16 + 4 * fq) = (u32x2){pk2(v[0], v[1]), pk2(v[2], v[3])}; }
    }
};

DI void tconv_tile(const Frame& F, const float* src, int N, int k0, int n0, bf16_t* dst, int ldd, int mode) {
    float* tl = (float*)F.lds;
    __syncthreads();
#pragma unroll
    for (int i = 0; i < 8; ++i) { const int idx = F.tid + 512 * i, k = idx >> 6, n = idx & 63; tl[k * 65 + n] = src[(size_t)(k0 + k) * N + n0 + n]; }
    __syncthreads();
#pragma unroll
    for (int i = 0; i < 4; ++i) { const int idx = F.tid + 512 * i, n = idx >> 5, kp = idx & 31;
        const int nn = n0 + n; const int row = (mode == 0) ? nn : ((nn >> 4) * 32 + (mode - 1) * 16 + (nn & 15));
        *(unsigned*)(dst + (size_t)row * ldd + k0 + 2 * kp) = pk2(tl[(2 * kp) * 65 + n], tl[(2 * kp + 1) * 65 + n]); }
}
DI void phase_prologue(const Frame& F) {
    const int T_IN = 16 * 40, T_OUT = 16 * 16, T_E = 16 * 8;
    const int per_layer = T_IN + T_OUT + NE * 3 * T_E, total = 2 * per_layer;
    for (int u = F.bid; u < total; u += F.G) {
        const int li = u / per_layer; int r = u % per_layer;
        if (r < T_IN) { tconv_tile(F, F.in[I_WIN] + (size_t)li * D * DIN, DIN, (r / 40) * 64, (r % 40) * 64, WSP(bf16_t, WS_WIN) + (size_t)li * DIN * D, D, 0); continue; }
        r -= T_IN;
        if (r < T_OUT) { tconv_tile(F, F.in[I_WOUT] + (size_t)li * D * D, D, (r / 16) * 64, (r % 16) * 64, WSP(bf16_t, WS_WOUT) + (size_t)li * D * D, D, 0); continue; }
        r -= T_OUT;
        const int e = r / (3 * T_E), w = (r / T_E) % 3, t = r % T_E;
        if (w < 2) tconv_tile(F, F.in[w == 0 ? I_MW1 : I_MW3] + ((size_t)li * NE + e) * D * DE, DE, (t / 8) * 64, (t % 8) * 64, WSP(bf16_t, WS_W13) + ((size_t)li * NE + e) * 1024 * 1024, D, 1 + w);
        else tconv_tile(F, F.in[I_MW2] + ((size_t)li * NE + e) * DE * D, D, (t / 16) * 64, (t % 16) * 64, WSP(bf16_t, WS_W2) + ((size_t)li * NE + e) * 1024 * 512, DE, 0);
    }
    __syncthreads();
    {
        float* sc = (float*)F.lds;
        float* red = sc + 3072;
        for (int i = F.tid; i < 3072; i += NTHR) { const int v = i >> 10, k = i & 1023; const float x = (v < 2) ? F.in[I_C][v * 1024 + k] : F.in[I_CCTX][k]; sc[i] = siluf(x); }
        __syncthreads();
        for (int u = F.bid; u < 2 * 96; u += F.G) {
            const int li = u / 96, j = (u % 96) * 64 + F.lane, ko = F.wave;
            const float* w = F.in[I_ADAW] + (size_t)li * D * 6144 + j;
            float a0 = 0.f, a1 = 0.f, a2 = 0.f;
            for (int k = ko * 128; k < ko * 128 + 128; ++k) { const float wv = w[(size_t)k * 6144]; a0 += sc[k] * wv; a1 += sc[1024 + k] * wv; a2 += sc[2048 + k] * wv; }
            red[(ko * 3 + 0) * 64 + F.lane] = a0; red[(ko * 3 + 1) * 64 + F.lane] = a1; red[(ko * 3 + 2) * 64 + F.lane] = a2;
            __syncthreads();
            if (F.tid < 192) { const int v = F.tid / 64, l = F.tid % 64; float s = 0.f;
#pragma unroll
                for (int q = 0; q < 8; ++q) s += red[(q * 3 + v) * 64 + l];
                const int jj = (u % 96) * 64 + l;
                WSP(float, WS_MOD)[((size_t)li * 3 + v) * 6144 + jj] = s + F.in[I_ADAB][li * 6144 + jj]; }
            __syncthreads();
        }
    }
    if (F.bid == (F.G > 1 ? 1 : 0)) {
        for (int i = F.tid; i < 256 * 8; i += NTHR) { const int pos = i >> 3, f = i & 7; const float inv = exp2f(-(float)f * (13.287712379549449f / 8.f)); const float rev = (float)pos * inv * 0.15915494309189535f;
            WSP(float, WS_ROPE)[i * 2] = cos_rev(rev); WSP(float, WS_ROPE)[i * 2 + 1] = sin_rev(rev); }
    }
}

DI void filter_tile(const Frame& F, int li, int L, int tile, float* hT, float* part) {
    float* h1s = (float*)F.lds;
    float* h2s = h1s + 4096;
    float* stg = h2s + 4096;
    float* sq2 = stg + 256 * 65;
    const float* w1 = F.in[I_HW1] + (size_t)li * 33 * 64; const float* b1 = F.in[I_HB1] + li * 64;
    const float* w2 = F.in[I_HW2] + (size_t)li * 64 * 64; const float* b2 = F.in[I_HB2] + li * 64;
    const float* w3 = F.in[I_HW3] + (size_t)li * 64 * 1024; const float* b3 = F.in[I_HB3] + li * 1024;
    const int t0 = tile * 64;
    const float inv_lm1 = 1.f / (float)(L > 1 ? L - 1 : 1);
    __syncthreads();
    {
        const int tl = F.tid & 63, pt = F.tid >> 6; const float t = (float)(t0 + tl);
        float a[8];
#pragma unroll
        for (int jj = 0; jj < 8; ++jj) a[jj] = b1[pt * 8 + jj] + (t * inv_lm1) * w1[pt * 8 + jj];
#pragma unroll 1
        for (int i = 0; i < 16; ++i) { const float band = 1e-4f + (15.f - 1e-4f) * (float)i / 15.f; const float rev = t * band / (float)L; const float cz = cos_rev(rev), sz = sin_rev(rev);
#pragma unroll
            for (int jj = 0; jj < 8; ++jj) a[jj] += cz * w1[(1 + i) * 64 + pt * 8 + jj] + sz * w1[(17 + i) * 64 + pt * 8 + jj]; }
#pragma unroll
        for (int jj = 0; jj < 8; ++jj) h1s[tl * 64 + pt * 8 + jj] = sin_rad(a[jj]);
    }
    __syncthreads();
    {
        const int tl = F.tid & 63, pt = F.tid >> 6;
        float a[8];
#pragma unroll
        for (int jj = 0; jj < 8; ++jj) a[jj] = b2[pt * 8 + jj];
#pragma unroll 1
        for (int i = 0; i < 64; ++i) { const float hv = h1s[tl * 64 + i];
#pragma unroll
            for (int jj = 0; jj < 8; ++jj) a[jj] += hv * w2[i * 64 + pt * 8 + jj]; }
#pragma unroll
        for (int jj = 0; jj < 8; ++jj) h2s[tl * 64 + pt * 8 + jj] = sin_rad(a[jj]);
    }
    __syncthreads();
    const int c = F.tid & 255, th = F.tid >> 8;
    const float delta = 3.0701134573253945f + (15.350567286626973f - 3.0701134573253945f) * (float)c / 255.f;
#pragma unroll 1
    for (int cc = 0; cc < 4; ++cc) {
        float wr[64];
#pragma unroll
        for (int i = 0; i < 64; ++i) wr[i] = w3[(size_t)i * 1024 + cc * 256 + c];
        const float bb = b3[cc * 256 + c]; float sq = 0.f;
#pragma unroll 1
        for (int tt = th * 32; tt < th * 32 + 32; ++tt) {
            float a = bb;
#pragma unroll
            for (int i = 0; i < 64; ++i) a += h2s[tt * 64 + i] * wr[i];
            a *= __expf(-((float)(t0 + tt) * inv_lm1) * delta);
            stg[c * 65 + tt] = a; sq += a * a;
        }
        if (th == 1) sq2[c] = sq;
        __syncthreads();
        if (th == 0) part[(size_t)tile * 1024 + cc * 256 + c] = sq + sq2[c];
        for (int ch = F.wave * 32; ch < F.wave * 32 + 32; ++ch) hT[((size_t)cc * 256 + ch) * L + t0 + F.lane] = stg[ch * 65 + F.lane];
        __syncthreads();
    }
}

struct TokInfo { unsigned e0, e1, p0, p1; float g0, g1; unsigned s0, s1; };
DI void phase_norm1(const Frame& F, int li, int mode) {
    const int nrows = (mode == 2) ? NLAT : NTOK;
    const float* modp = WSP(float, WS_MOD) + (size_t)li * 3 * 6144;
    const float* modprev = WSP(float, WS_MOD) + (size_t)(mode == 2 ? 1 : li - 1) * 3 * 6144;
    const float* gam = (mode == 2) ? F.in[I_FG] : F.in[I_N1G] + (size_t)li * D;
    const TokInfo* tok = WSP(TokInfo, WS_TOK); const bf16_t* ys = WSP(bf16_t, WS_A1);
    bf16_t* hbf = WSP(bf16_t, WS_HBF);
    auto xrowp = [&](int r) -> float* { return r >= NLAT ? WSP(float, WS_XC) + (size_t)(r - NLAT) * D : F.out + (size_t)r * D; };
    auto srcp = [&](int r) -> const float* { return (mode == 0) ? (r >= NLAT ? F.in[I_CTX] + (size_t)(r - NLAT) * D : F.in[I_X] + (size_t)r * D) : (const float*)xrowp(r); };
    const int r0 = F.bid * 8 + F.wave, rstep = F.G * 8, lc = F.lane * 4;
    f32x4 xn[4]; u32x2 yan[4], ybn[4]; TokInfo t1 = {}, t2 = {};
    if (r0 < nrows) {
#pragma unroll
        for (int i = 0; i < 4; ++i) xn[i] = *(const f32x4*)(srcp(r0) + i * 256 + lc);
        if (mode != 0) { t1 = tok[r0]; if (r0 + rstep < nrows) t2 = tok[r0 + rstep];
#pragma unroll
            for (int i = 0; i < 4; ++i) { yan[i] = *(const u32x2*)(ys + (size_t)t1.s0 * D + i * 256 + lc); ybn[i] = *(const u32x2*)(ys + (size_t)t1.s1 * D + i * 256 + lc); } }
    }
    for (int r = r0; r < nrows; r += rstep) {
        const bool isctx = r >= NLAT; const int v = isctx ? 2 : (r >> 14);
        f32x4 x[4]; u32x2 ya[4], yb[4]; const TokInfo ti = t1;
#pragma unroll
        for (int i = 0; i < 4; ++i) { x[i] = xn[i]; ya[i] = yan[i]; yb[i] = ybn[i]; }
        if (r + rstep < nrows) {
#pragma unroll
            for (int i = 0; i < 4; ++i) xn[i] = *(const f32x4*)(srcp(r + rstep) + i * 256 + lc);
            if (mode != 0) { t1 = t2; if (r + 2 * rstep < nrows) t2 = tok[r + 2 * rstep];
#pragma unroll
                for (int i = 0; i < 4; ++i) { yan[i] = *(const u32x2*)(ys + (size_t)t1.s0 * D + i * 256 + lc); ybn[i] = *(const u32x2*)(ys + (size_t)t1.s1 * D + i * 256 + lc); } }
        }
        if (mode != 0) {
            const float* g2 = modprev + (size_t)v * 6144 + 5 * 1024;
#pragma unroll
            for (int i = 0; i < 4; ++i) {
                const u32x2 a = ya[i], b = yb[i];
                const f32x4 gg = *(const f32x4*)(g2 + i * 256 + lc);
                f32x4 y;
                y[0] = ti.g0 * __uint_as_float(a[0] << 16) + ti.g1 * __uint_as_float(b[0] << 16);
                y[1] = ti.g0 * __uint_as_float(a[0] & 0xffff0000u) + ti.g1 * __uint_as_float(b[0] & 0xffff0000u);
                y[2] = ti.g0 * __uint_as_float(a[1] << 16) + ti.g1 * __uint_as_float(b[1] << 16);
                y[3] = ti.g0 * __uint_as_float(a[1] & 0xffff0000u) + ti.g1 * __uint_as_float(b[1] & 0xffff0000u);
                x[i] = x[i] + gg * y;
            }
            if (mode == 1) { float* xrow = xrowp(r);
#pragma unroll
                for (int i = 0; i < 4; ++i) *(f32x4*)(xrow + i * 256 + lc) = x[i]; }
        }
        float ss = 0.f;
#pragma unroll
        for (int i = 0; i < 4; ++i) ss += x[i][0] * x[i][0] + x[i][1] * x[i][1] + x[i][2] * x[i][2] + x[i][3] * x[i][3];
        ss = wave_sum(ss);
        const float rstd = rsqrtf(ss * (1.f / D) + EPS);
#pragma unroll
        for (int i = 0; i < 4; ++i) {
            const int c = i * 256 + lc;
            const f32x4 g = *(const f32x4*)(gam + c);
            if (mode == 2) { *(f32x4*)(F.out + (size_t)r * D + c) = x[i] * rstd * g; }
            else {
                const f32x4 sh = *(const f32x4*)(modp + (size_t)v * 6144 + c), sc = *(const f32x4*)(modp + (size_t)v * 6144 + 1024 + c);
                const f32x4 h = x[i] * rstd * g * (sc + 1.f) + sh;
                *(u32x2*)(hbf + (size_t)r * D + c) = (u32x2){pk2(h[0], h[1]), pk2(h[2], h[3])};
            }
        }
    }
}

DI void phase_norm2(const Frame& F, int li, int nrows) {
    float* wt = (float*)F.lds;
    __syncthreads();
    for (int i = F.tid; i < 16384; i += NTHR) { const int k = i >> 4, e = i & 15; wt[e * 1024 + k] = F.in[I_RW][i]; }
    __syncthreads();
    const float* modp = WSP(float, WS_MOD) + (size_t)li * 3 * 6144;
    const float* gam = F.in[I_N2G] + (size_t)li * D;
    bf16_t* hbf = WSP(bf16_t, WS_HBF); TokInfo* tok = WSP(TokInfo, WS_TOK);
    unsigned* lcnt = (unsigned*)(F.lds + LDS_MISC + 64);
    if (F.tid < 16) lcnt[F.tid] = 0u;
    __syncthreads();
    auto rowp = [&](int r) -> const float* { return r >= NLAT ? WSP(float, WS_XC) + (size_t)(r - NLAT) * D : F.out + (size_t)r * D; };
    const int r_first = F.bid * 8 + F.wave, rstep = F.G * 8;
    f32x4 xn[4];
    if (r_first < nrows) {
#pragma unroll
        for (int i = 0; i < 4; ++i) xn[i] = *(const f32x4*)(rowp(r_first) + i * 256 + F.lane * 4);
    }
    const bool b2 = (F.lane & 4) != 0, b3 = (F.lane & 8) != 0, b4 = (F.lane & 16) != 0;
    for (int r = r_first; r < nrows; r += rstep) {
        const bool isctx = r >= NLAT; const int v = isctx ? 2 : (r >> 14);
        f32x4 x[4]; float ss = 0.f;
#pragma unroll
        for (int i = 0; i < 4; ++i) { x[i] = xn[i]; ss += x[i][0] * x[i][0] + x[i][1] * x[i][1] + x[i][2] * x[i][2] + x[i][3] * x[i][3]; }
        if (r + rstep < nrows) {
#pragma unroll
            for (int i = 0; i < 4; ++i) xn[i] = *(const f32x4*)(rowp(r + rstep) + i * 256 + F.lane * 4);
        }
        ss = wave_sum(ss);
        const float rstd = rsqrtf(ss * (1.f / D) + EPS);
        float lg[16];
#pragma unroll
        for (int e = 0; e < 16; ++e) lg[e] = 0.f;
#pragma unroll
        for (int i = 0; i < 4; ++i) {
            const int c = i * 256 + F.lane * 4;
            const f32x4 g = *(const f32x4*)(gam + c), sh = *(const f32x4*)(modp + (size_t)v * 6144 + 3 * 1024 + c), sc = *(const f32x4*)(modp + (size_t)v * 6144 + 4 * 1024 + c);
            const f32x4 h = x[i] * rstd * g * (sc + 1.f) + sh;
            *(u32x2*)(hbf + (size_t)r * D + c) = (u32x2){pk2(h[0], h[1]), pk2(h[2], h[3])};
#pragma unroll
            for (int e = 0; e < 16; ++e) { const f32x4 w = *(const f32x4*)(wt + e * 1024 + c); lg[e] += h[0] * w[0] + h[1] * w[1] + h[2] * w[2] + h[3] * w[3]; }
        }
        float a8[8], a4[4], a2[2];
#pragma unroll
        for (int e = 0; e < 8; ++e) { const auto rr = __builtin_amdgcn_permlane32_swap(__float_as_uint(lg[e]), __float_as_uint(lg[e + 8]), false, false); a8[e] = __uint_as_float(rr[0]) + __uint_as_float(rr[1]); }
#pragma unroll
        for (int e = 0; e < 4; ++e) { const float keep = b4 ? a8[e + 4] : a8[e], send = b4 ? a8[e] : a8[e + 4]; a4[e] = keep + swz_xor<16>(send); }
#pragma unroll
        for (int e = 0; e < 2; ++e) { const float keep = b3 ? a4[e + 2] : a4[e], send = b3 ? a4[e] : a4[e + 2]; a2[e] = keep + swz_xor<8>(send); }
        float a1 = (b2 ? a2[1] : a2[0]) + swz_xor<4>(b2 ? a2[0] : a2[1]);
        a1 += swz_xor<2>(a1); a1 += swz_xor<1>(a1);
#pragma unroll
        for (int e = 0; e < 16; ++e) lg[e] = __int_as_float(__builtin_amdgcn_readlane(__float_as_int(a1), 4 * e));
        float mx = lg[0];
#pragma unroll
        for (int e = 1; e < 16; ++e) mx = fmaxf(mx, lg[e]);
        float sc[16], sel[16], den = 0.f;
#pragma unroll
        for (int e = 0; e < 16; ++e) { sc[e] = __expf(lg[e] - mx); den += sc[e]; }
        const float rden = 1.f / den;
#pragma unroll
        for (int e = 0; e < 16; ++e) { sc[e] *= rden; sel[e] = sc[e] + F.in[I_RB][e]; }
        int bg = 0; float bgs = -1e30f;
#pragma unroll
        for (int g = 0; g < 4; ++g) {
            float m1 = -1e30f, m2 = -1e30f;
#pragma unroll
            for (int q = 0; q < 4; ++q) { const float s = sel[g * 4 + q]; if (s > m1) { m2 = m1; m1 = s; } else if (s > m2) m2 = s; }
            const float gs = m1 + m2; if (gs > bgs) { bgs = gs; bg = g; }
        }
        int e0 = 0, e1 = 0; float s0v = -1e30f, s1v = -1e30f, w0 = 0.f, w1 = 0.f;
#pragma unroll
        for (int e = 0; e < 16; ++e) {
            const bool ing = (e >> 2) == bg; const float s = sel[e];
            if (ing && s > s0v) { s1v = s0v; e1 = e0; w1 = w0; s0v = s; e0 = e; w0 = sc[e]; }
            else if (ing && s > s1v) { s1v = s; e1 = e; w1 = sc[e]; }
        }
        if (F.lane == 0) {
            TokInfo ti; ti.e0 = e0; ti.e1 = e1; ti.p0 = atomicAdd(lcnt + e0, 1u); ti.p1 = atomicAdd(lcnt + e1, 1u);
            const float ws = 1.f / (w0 + w1); ti.g0 = w0 * ws; ti.g1 = w1 * ws; ti.s0 = 0; ti.s1 = 0;
            tok[r] = ti;
        }
    }
    __syncthreads();
    if (F.tid < 16) F.ctl[CW_BCNT + (li * MAXG + F.bid) * 16 + F.tid] = lcnt[F.tid];
}

DI void moe_offsets(const Frame& F, int li, int* offs) {
    __syncthreads();
    int* tot = offs + 376;
    int* part = (int*)F.lds;
    {
        const int e = F.tid & 15, pq = F.tid >> 4;
        const unsigned* bc = F.ctl + CW_BCNT + li * MAXG * 16 + e;
        int st = 0, sb = 0;
#pragma unroll
        for (int k = 0; k < 8; ++k) { const int blk = pq * 8 + k; const int c = (blk < F.G) ? (int)__hip_atomic_load(bc + blk * 16, __ATOMIC_RELAXED, __HIP_MEMORY_SCOPE_AGENT) : 0; st += c; sb += (blk < F.bid) ? c : 0; }
        part[pq * 16 + e] = st; part[512 + pq * 16 + e] = sb;
    }
    __syncthreads();
    if (F.tid < 32) { const int e = F.tid & 15, wb = F.tid >> 4; int s = 0;
        for (int pq = 0; pq < 32; ++pq) s += part[wb * 512 + pq * 16 + e];
        if (wb) offs[360 + e] = s; else tot[e] = s; }
    __syncthreads();
    if (F.tid == 0) { int o = 0; for (int e = 0; e < NE; ++e) { offs[e] = o; offs[17 + e] = o >> 8; o += (tot[e] + 255) & ~255; }
        offs[16] = o; offs[17 + 16] = o >> 8; }
    __syncthreads();
    for (int t = F.tid; t < SLOT_CAP / 256; t += NTHR) { int e = 0; for (int k = 1; k < NE; ++k) e += (offs[17 + k] <= t) ? 1 : 0; offs[40 + t] = e; }
    if (F.tid < 16) offs[360 + F.tid] += offs[F.tid];
    __syncthreads();
}
DI void phase_gather(const Frame& F, int li, int nrows) {
    int* offs = (int*)(F.lds + LDS_MISC + 64);
    moe_offsets(F, li, offs);
    const bf16_t* hbf = WSP(bf16_t, WS_HBF); bf16_t* a1 = WSP(bf16_t, WS_A1); TokInfo* tok = WSP(TokInfo, WS_TOK);
    for (int r = F.bid * 8 + F.wave; r < nrows; r += F.G * 8) {
        TokInfo ti = tok[r];
        const unsigned s0 = offs[360 + ti.e0] + ti.p0, s1 = offs[360 + ti.e1] + ti.p1;
        const u32x4 a = *(const u32x4*)(hbf + (size_t)r * D + F.lane * 8), b = *(const u32x4*)(hbf + (size_t)r * D + 512 + F.lane * 8);
        *(u32x4*)(a1 + (size_t)s0 * D + F.lane * 8) = a; *(u32x4*)(a1 + (size_t)s0 * D + 512 + F.lane * 8) = b;
        *(u32x4*)(a1 + (size_t)s1 * D + F.lane * 8) = a; *(u32x4*)(a1 + (size_t)s1 * D + 512 + F.lane * 8) = b;
        if (F.lane == 0) { tok[r].s0 = s0; tok[r].s1 = s1; }
    }
}

#define MFMA32(a, b, c) __builtin_amdgcn_mfma_f32_32x32x16_bf16((a), (b), (c), 0, 0, 0)
DI float lam_of(const Frame& F, int li, float& lam_init) {
    const float* lv = F.in[I_ALAM] + (size_t)li * 128;
    const int i = F.lane & 31, hi = F.lane >> 5;
    float d = lv[hi * 64 + i] * lv[hi * 64 + 32 + i];
    d += swz_xor<16>(d); d += swz_xor<8>(d); d += swz_xor<4>(d); d += swz_xor<2>(d); d += swz_xor<1>(d);
    const float d0 = __int_as_float(__builtin_amdgcn_readlane(__float_as_int(d), 0)), d1 = __int_as_float(__builtin_amdgcn_readlane(__float_as_int(d), 32));
    float lif = (float)li; asm volatile("" : "+v"(lif));
    lam_init = 0.8f - 0.6f * __expf(-0.3f * lif);
    return __expf(d0) - __expf(d1) + lam_init;
}
DI bf16x8 pack8(const f32x16& x, int s) {
    u32x4 p; p[0] = pk2(x[8 * s], x[8 * s + 1]); p[1] = pk2(x[8 * s + 2], x[8 * s + 3]); p[2] = pk2(x[8 * s + 4], x[8 * s + 5]); p[3] = pk2(x[8 * s + 6], x[8 * s + 7]);
    return __builtin_bit_cast(bf16x8, p);
}

DI void diffattn_unit(const Frame& F, int li, int b, int h, size_t qrow0, int NT2) {
    const int lane = F.lane, r = lane & 31, hh = lane >> 5, c = F.wave & 1, g = F.wave >> 1;
    const bf16_t* AQ = WSP(bf16_t, WS_AQ); const bf16_t* AK = WSP(bf16_t, WS_AK); const bf16_t* AVT = WSP(bf16_t, WS_AVT) + (size_t)(b * 4 + h) * 64 * NKEY;
    float lam_init; const float lam = lam_of(F, li, lam_init);
    const size_t qrow = qrow0 + g * 32 + r;
    bf16x8 qf[2]; float qn2 = 0.f;
#pragma unroll
    for (int ks = 0; ks < 2; ++ks) { qf[ks] = *(const bf16x8*)(AQ + qrow * 256 + h * 64 + c * 32 + ks * 16 + 8 * hh);
#pragma unroll
        for (int j = 0; j < 8; ++j) { const float v = bf2f((bf16_t)qf[ks][j]); qn2 += v * v; } }
    qn2 = half_sum(qn2);
    f32x16 cinit;
    { const float km = sqrtf(__uint_as_float(__hip_atomic_load(F.ctl + CW_KMAX + li * 16 + (b * 4 + h) * 2 + c, __ATOMIC_RELAXED, __HIP_MEMORY_SCOPE_AGENT)));
      const float cn = -(sqrtf(qn2) * km * 1.02f + 1e-3f);
#pragma unroll
      for (int i = 0; i < 16; ++i) cinit[i] = cn; }
    f32x16 O[2];
#pragma unroll
    for (int dh = 0; dh < 2; ++dh)
#pragma unroll
        for (int i = 0; i < 16; ++i) O[dh][i] = 0.f;
    f32x16 lacc;
#pragma unroll
    for (int i = 0; i < 16; ++i) lacc[i] = 0.f;
    constexpr int KTB = 2 * 128 * 64, VTB = 64 * 264, STG = KTB + VTB;
    const int skey = F.tid >> 2, sq = F.tid & 3;
    const int kdst0 = (sq >> 1) * 8192 + skey * 64 + ((((sq & 1) * 2 + 0) ^ ((skey >> 2) & 3)) * 16);
    const int kdst1 = (sq >> 1) * 8192 + skey * 64 + ((((sq & 1) * 2 + 1) ^ ((skey >> 2) & 3)) * 16);
    const int vd = F.tid >> 3, vpart = F.tid & 7;
    const int vdst = KTB + vd * 264 + vpart * 32;
    auto krow_of = [&](int j) -> size_t { return j < CTX ? (size_t)NLAT + b * CTX + j : (size_t)b * S + (j - CTX); };
    unsigned char* L = F.lds;
    u32x4 kreg[2], vreg[2];
    { const bf16_t* kp = AK + krow_of(skey) * 256 + h * 64 + sq * 16; const bf16_t* vp = AVT + (size_t)vd * NKEY + vpart * 16;
      kreg[0] = *(const u32x4*)kp; kreg[1] = *(const u32x4*)(kp + 8); vreg[0] = *(const u32x4*)vp; vreg[1] = *(const u32x4*)(vp + 8); }
    __syncthreads();
    *(u32x4*)(L + kdst0) = kreg[0]; *(u32x4*)(L + kdst1) = kreg[1];
    *(u32x2*)(L + vdst) = (u32x2){vreg[0][0], vreg[0][1]}; *(u32x2*)(L + vdst + 8) = (u32x2){vreg[0][2], vreg[0][3]};
    *(u32x2*)(L + vdst + 16) = (u32x2){vreg[1][0], vreg[1][1]}; *(u32x2*)(L + vdst + 24) = (u32x2){vreg[1][2], vreg[1][3]};
    __syncthreads();
    const int ksw = (r >> 2) & 3;
    const int kr0 = c * 8192 + r * 64 + (((0 + hh) ^ ksw) * 16), kr1 = c * 8192 + r * 64 + (((2 + hh) ^ ksw) * 16);
    const int vr0 = r * 264 + 8 * hh;
#define DA_QK(Sx, st) do { \
        const bf16x8 k0 = *(const bf16x8*)(kb + (st) * 2048 + kr0), k1 = *(const bf16x8*)(kb + (st) * 2048 + kr1); \
        Sx = MFMA32(k0, qf[0], cinit); Sx = MFMA32(k1, qf[1], Sx); } while (0)
#define DA_PV(Sx, st) do { bf16x8 vf[2][2]; \
        _Pragma("unroll") for (int dh = 0; dh < 2; ++dh) _Pragma("unroll") for (int s2 = 0; s2 < 2; ++s2) { \
            const unsigned char* vp = vb + dh * (32 * 264) + vr0 + (st) * 64 + s2 * 32; \
            const s16x4 lo = *(const s16x4*)vp, hi = *(const s16x4*)(vp + 16); \
            vf[dh][s2] = __builtin_shufflevector(lo, hi, 0, 1, 2, 3, 4, 5, 6, 7); } \
        _Pragma("unroll") for (int i = 0; i < 16; ++i) Sx[i] = __builtin_amdgcn_exp2f(Sx[i]); \
        lacc += Sx; \
        const bf16x8 p0 = pack8(Sx, 0), p1 = pack8(Sx, 1); \
        O[0] = MFMA32(vf[0][0], p0, O[0]); O[1] = MFMA32(vf[1][0], p0, O[1]); \
        O[0] = MFMA32(vf[0][1], p1, O[0]); O[1] = MFMA32(vf[1][1], p1, O[1]); } while (0)
#pragma unroll 1
    for (int kt = 0; kt < NT2; ++kt) {
        const int buf = kt & 1;
        if (kt + 1 < NT2) {
            const int j0 = (kt + 1) * 128;
            const bf16_t* kp = AK + krow_of(j0 + skey) * 256 + h * 64 + sq * 16; const bf16_t* vp = AVT + (size_t)vd * NKEY + j0 + vpart * 16;
            kreg[0] = *(const u32x4*)kp; kreg[1] = *(const u32x4*)(kp + 8); vreg[0] = *(const u32x4*)vp; vreg[1] = *(const u32x4*)(vp + 8);
        }
        const unsigned char* kb = L + buf * STG; const unsigned char* vb = L + buf * STG + KTB;
        f32x16 Sa, Sb;
        DA_QK(Sa, 0);
        DA_QK(Sb, 1); DA_PV(Sa, 0);
        DA_QK(Sa, 2); DA_PV(Sb, 1);
        DA_QK(Sb, 3); DA_PV(Sa, 2);
        DA_PV(Sb, 3);
        if (kt + 1 < NT2) {
            unsigned char* W = L + (buf ^ 1) * STG;
            *(u32x4*)(W + kdst0) = kreg[0]; *(u32x4*)(W + kdst1) = kreg[1];
            *(u32x2*)(W + vdst) = (u32x2){vreg[0][0], vreg[0][1]}; *(u32x2*)(W + vdst + 8) = (u32x2){vreg[0][2], vreg[0][3]};
            *(u32x2*)(W + vdst + 16) = (u32x2){vreg[1][0], vreg[1][1]}; *(u32x2*)(W + vdst + 24) = (u32x2){vreg[1][2], vreg[1][3]};
        }
        __syncthreads();
    }
#undef DA_QK
#undef DA_PV
    float lsum = 0.f;
#pragma unroll
    for (int i = 0; i < 16; ++i) lsum += lacc[i];
    const float rl = 1.f / half_sum(lsum);
    float* xb = (float*)L + (size_t)g * 32 * 64;
    if (c == 1) {
#pragma unroll
        for (int dh = 0; dh < 2; ++dh)
#pragma unroll
            for (int i = 0; i < 16; ++i) xb[(dh * 16 + i) * 64 + lane] = O[dh][i] * (rl * lam);
    }
    __syncthreads();
    if (c == 0) {
        float o[2][16]; float ss = 0.f;
#pragma unroll
        for (int dh = 0; dh < 2; ++dh)
#pragma unroll
            for (int i = 0; i < 16; ++i) { o[dh][i] = O[dh][i] * rl - xb[(dh * 16 + i) * 64 + lane]; ss += o[dh][i] * o[dh][i]; }
        ss = half_sum(ss);
        const float rs = rsqrtf(ss * (1.f / 64.f) + EPS) * (1.f - lam_init);
        const float* sg = F.in[I_ASUB] + li * 64;
        bf16_t* mix = WSP(bf16_t, WS_HBF) + qrow * D + h * 64;
#pragma unroll
        for (int dh = 0; dh < 2; ++dh)
#pragma unroll
            for (int gq = 0; gq < 4; ++gq) {
                const int d = 32 * dh + 8 * gq + 4 * hh;
                const f32x4 gg = *(const f32x4*)(sg + d);
                *(u32x2*)(mix + d) = (u32x2){pk2(o[dh][4 * gq] * rs * gg[0], o[dh][4 * gq + 1] * rs * gg[1]), pk2(o[dh][4 * gq + 2] * rs * gg[2], o[dh][4 * gq + 3] * rs * gg[3])};
            }
    }
}

DI void na_mfma_unit(const Frame& F, int li, int b, size_t qrow0, int grow) {
    const int lane = F.lane, r31 = lane & 31, hh = lane >> 5, h = F.wave >> 1, qh = F.wave & 1;
    const bf16_t* BQ = WSP(bf16_t, WS_BQ); const bf16_t* BK = WSP(bf16_t, WS_BK); const bf16_t* BVT = WSP(bf16_t, WS_BVT);
    constexpr int KB = 4 * 8192, VB = 4 * 8704, STG = KB + VB;
    unsigned char* L = F.lds;
    float* tab = (float*)(F.lds + 2 * STG);
    const int nwin = grow >= 0 ? 8 : 0, nt = nwin + 4;
    int r0 = grow - 4; r0 = r0 < 0 ? 0 : (r0 > 248 ? 248 : r0);
    __syncthreads();
    if (nwin) for (int i = F.tid; i < 4 * 465; i += NTHR) tab[i] = F.in[I_RPB][(size_t)li * 4 * 465 + i] * LOG2E;
    const int skey = F.tid >> 3, sc64 = F.tid & 7, sh = sc64 >> 1;
    const int vrow = F.tid >> 1, vhalf = F.tid & 1;
    auto kbase = [&](int ti) -> const bf16_t* { return ti < nwin ? BK + ((size_t)b * S + (size_t)(r0 + ti) * GW) * 256 : BK + ((size_t)NLAT + b * CTX + (ti - nwin) * 64) * 256; };
    auto vkey0 = [&](int ti) -> int { return ti < nwin ? CTX + (r0 + ti) * GW : (ti - nwin) * 64; };
    u32x4 kreg[4], vreg[4];
    { const bf16_t* kp = kbase(0) + (size_t)skey * 256 + sc64 * 32; const bf16_t* vp = BVT + ((size_t)b * 256 + vrow) * NKEY + vkey0(0) + vhalf * 32;
#pragma unroll
      for (int i = 0; i < 4; ++i) { kreg[i] = *(const u32x4*)(kp + i * 8); vreg[i] = *(const u32x4*)(vp + i * 8); } }
    const size_t qrow = qrow0 + 32 * qh + r31;
    bf16x8 qf[4]; float qn2 = 0.f;
#pragma unroll
    for (int ks = 0; ks < 4; ++ks) { qf[ks] = *(const bf16x8*)(BQ + qrow * 256 + h * 64 + ks * 16 + 8 * hh);
#pragma unroll
        for (int j = 0; j < 8; ++j) { const float v = bf2f((bf16_t)qf[ks][j]); qn2 += v * v; } }
    qn2 = half_sum(qn2);
    __syncthreads();
    float bmax = 0.f;
    if (nwin) { for (int i = lane; i < 465; i += 64) bmax = fmaxf(bmax, tab[h * 465 + i]); bmax = wave_max(bmax); }
    const unsigned* kmx = F.ctl + CW_KMAXB + li * 16 + (b * 4 + h) * 2;
    const float km = sqrtf(__uint_as_float(__hip_atomic_load(kmx, __ATOMIC_RELAXED, __HIP_MEMORY_SCOPE_AGENT)) + __uint_as_float(__hip_atomic_load(kmx + 1, __ATOMIC_RELAXED, __HIP_MEMORY_SCOPE_AGENT)));
    const float cneg = -(sqrtf(qn2) * km * 1.02f + bmax + 1e-3f);
    const int cq = 32 * qh + r31; int c0q = cq - 8; c0q = c0q < 0 ? 0 : (c0q > 48 ? 48 : c0q);
    const int qrow_g = grow;
    f32x16 O[2];
#pragma unroll
    for (int dh = 0; dh < 2; ++dh)
#pragma unroll
        for (int i = 0; i < 16; ++i) O[dh][i] = 0.f;
    float lsum = 0.f;
    const int kdst = sh * 8192 + skey * 128, ksw = (skey >> 1) & 7, kch0 = (sc64 & 1) * 4;
    const int vdst = KB + (vrow >> 6) * 8704 + (vrow & 63) * 136 + vhalf * 64;
#pragma unroll
    for (int i = 0; i < 4; ++i) { *(u32x4*)(L + kdst + (((kch0 + i) ^ ksw) * 16)) = kreg[i];
        *(u32x2*)(L + vdst + i * 16) = (u32x2){vreg[i][0], vreg[i][1]}; *(u32x2*)(L + vdst + i * 16 + 8) = (u32x2){vreg[i][2], vreg[i][3]}; }
    __syncthreads();
#pragma unroll 1
    for (int ti = 0; ti < nt; ++ti) {
        const int buf = ti & 1;
        if (ti + 1 < nt) { const bf16_t* kp = kbase(ti + 1) + (size_t)skey * 256 + sc64 * 32; const bf16_t* vp = BVT + ((size_t)b * 256 + vrow) * NKEY + vkey0(ti + 1) + vhalf * 32;
#pragma unroll
            for (int i = 0; i < 4; ++i) { kreg[i] = *(const u32x4*)(kp + i * 8); vreg[i] = *(const u32x4*)(vp + i * 8); } }
        const unsigned char* kb = L + buf * STG + h * 8192; const unsigned char* vb = L + buf * STG + KB + h * 8704;
        const bool win = ti < nwin;
        const float* trow = tab + h * 465 + (win ? (r0 + ti - qrow_g + 7) * 31 : 0) + 15 - cq;
#pragma unroll
        for (int st = 0; st < 2; ++st) {
            const int key = 32 * st + r31, sw = (key >> 1) & 7;
            f32x16 s;
#pragma unroll
            for (int i = 0; i < 16; ++i) { const int kc = 32 * st + (i & 3) + 8 * (i >> 2) + 4 * hh;
                float c = cneg;
                if (win) { const bool ok = (kc >= c0q) && (kc < c0q + 16); c = ok ? trow[ok ? kc : cq] + cneg : -1e30f; }
                s[i] = c; }
#pragma unroll
            for (int ks = 0; ks < 4; ++ks) { const bf16x8 kf = *(const bf16x8*)(kb + key * 128 + (((ks * 2 + hh) ^ sw) * 16)); s = MFMA32(kf, qf[ks], s); }
#pragma unroll
            for (int i = 0; i < 16; ++i) { s[i] = __builtin_amdgcn_exp2f(s[i]); lsum += s[i]; }
            const bf16x8 p0 = pack8(s, 0), p1 = pack8(s, 1);
#pragma unroll
            for (int dh = 0; dh < 2; ++dh) {
                const unsigned char* vp = vb + (32 * dh + r31) * 136 + (32 * st + 4 * hh) * 2;
                const s16x4 a0 = *(const s16x4*)vp, a1 = *(const s16x4*)(vp + 16), b0 = *(const s16x4*)(vp + 32), b1 = *(const s16x4*)(vp + 48);
                O[dh] = MFMA32(__builtin_shufflevector(a0, a1, 0, 1, 2, 3, 4, 5, 6, 7), p0, O[dh]);
                O[dh] = MFMA32(__builtin_shufflevector(b0, b1, 0, 1, 2, 3, 4, 5, 6, 7), p1, O[dh]);
            }
        }
        if (ti + 1 < nt) { unsigned char* W = L + (buf ^ 1) * STG;
#pragma unroll
            for (int i = 0; i < 4; ++i) { *(u32x4*)(W + kdst + (((kch0 + i) ^ ksw) * 16)) = kreg[i];
                *(u32x2*)(W + vdst + i * 16) = (u32x2){vreg[i][0], vreg[i][1]}; *(u32x2*)(W + vdst + i * 16 + 8) = (u32x2){vreg[i][2], vreg[i][3]}; } }
        __syncthreads();
    }
    const float rl = 1.f / half_sum(lsum);
    bf16_t* mix = WSP(bf16_t, WS_HBF) + qrow * D + 256 + h * 64;
#pragma unroll
    for (int dh = 0; dh < 2; ++dh)
#pragma unroll
        for (int g = 0; g < 4; ++g) { const int d = 32 * dh + 8 * g + 4 * hh;
            *(u32x2*)(mix + d) = (u32x2){pk2(O[dh][4 * g] * rl, O[dh][4 * g + 1] * rl), pk2(O[dh][4 * g + 2] * rl, O[dh][4 * g + 3] * rl)}; }
}

DI void pool_unit(const Frame& F, int li, size_t seq_row0, int L, int t0) {
    float* us = (float*)F.lds;
    float* df = us + 48 * 256;
    const bf16_t* PL = WSP(bf16_t, WS_PL);
    __syncthreads();
    for (int i = F.tid; i < 48 * 32; i += NTHR) {
        const int tt = i >> 5, c8 = i & 31, t = t0 - 8 + tt;
        float v[8] = {0.f, 0.f, 0.f, 0.f, 0.f, 0.f, 0.f, 0.f};
        if (t >= 0 && t < L) { const u32x4 x = *(const u32x4*)(PL + (seq_row0 + t) * 256 + c8 * 8);
#pragma unroll
            for (int e = 0; e < 4; ++e) { v[2 * e] = __uint_as_float(x[e] << 16); v[2 * e + 1] = __uint_as_float(x[e] & 0xffff0000u); } }
#pragma unroll
        for (int e = 0; e < 8; ++e) us[tt * 256 + c8 * 8 + e] = v[e];
    }
    __syncthreads();
    for (int i = F.tid; i < 32 * 256; i += NTHR) {
        const int tl = i >> 8, ch = i & 255, g = ch >> 6, t = t0 + tl; const int hw = 1 << g;
        int lo = t - hw; lo = lo < 0 ? 0 : lo; int hi = t + hw; hi = hi > L ? L : hi;
        float s = 0.f;
        for (int tt = lo; tt < hi; ++tt) s += us[(tt - t0 + 8) * 256 + ch];
        df[tl * 256 + ch] = s / (float)(hi - lo) - us[(tl + 8) * 256 + ch];
    }
    __syncthreads();
    const float* pw = F.in[I_POOLW] + (size_t)li * 4 * 64 * 64; const float* ps = F.in[I_POOLS] + li * 256;
    bf16_t* mix = WSP(bf16_t, WS_HBF);
    {
        const int ch = F.tid & 255, th = F.tid >> 8, g = ch >> 6, j = ch & 63;
        float w[64];
#pragma unroll
        for (int i = 0; i < 64; ++i) w[i] = pw[((size_t)g * 64 + i) * 64 + j];
        const float scale = ps[ch];
        for (int tl = th * 16; tl < th * 16 + 16; ++tl) {
            float a = 0.f;
#pragma unroll
            for (int i = 0; i < 64; ++i) a += df[tl * 256 + g * 64 + i] * w[i];
            mix[(seq_row0 + t0 + tl) * D + 512 + ch] = f2bf(a * scale);
        }
    }
}

DI float hy_norm(const float* part, int ntile, int o, int ch) {
    float s = 0.f;
    for (int t = 0; t < ntile; ++t) s += part[(size_t)t * 1024 + (o * 2) * 256 + ch] + part[(size_t)t * 1024 + (o * 2 + 1) * 256 + ch];
    return rsqrtf(s + EPS);
}
DI float hy_short(const bf16_t* p, int t, int L, float w0, float w1, float w2, float bb) {
    const int tm = t > 0 ? t - 1 : 0, tp = t + 1 < L ? t + 1 : L - 1;
    float a = bf2f(p[tm]), c = bf2f(p[tp]); const float m = bf2f(p[t]);
    a = t > 0 ? a : 0.f; c = t + 1 < L ? c : 0.f;
    return a * w0 + m * w1 + c * w2 + bb;
}
constexpr int FM = 16384;
DI int fphys(int i) { return i + (i >> 4) + ((i >> 9) << 4); }
constexpr int brev(int m, int bits) { return bits == 5 ? (((m & 1) << 4) | ((m & 2) << 2) | (m & 4) | ((m & 8) >> 2) | ((m & 16) >> 4)) : (((m & 1) << 3) | ((m & 2) << 1) | ((m & 4) >> 1) | ((m & 8) >> 3)); }
template <int R, int LOG2R, bool INV> DI void dft_regs(float (&re)[R], float (&im)[R]) {
    constexpr float C32[16] = {1.f, 0.98078528040323043f, 0.92387953251128674f, 0.83146961230254524f, 0.70710678118654752f, 0.55557023301960218f, 0.38268343236508977f, 0.19509032201612825f,
                               0.f, -0.19509032201612825f, -0.38268343236508977f, -0.55557023301960218f, -0.70710678118654752f, -0.83146961230254524f, -0.92387953251128674f, -0.98078528040323043f};
    constexpr float S32[16] = {0.f, 0.19509032201612825f, 0.38268343236508977f, 0.55557023301960218f, 0.70710678118654752f, 0.83146961230254524f, 0.92387953251128674f, 0.98078528040323043f,
                               1.f, 0.98078528040323043f, 0.92387953251128674f, 0.83146961230254524f, 0.70710678118654752f, 0.55557023301960218f, 0.38268343236508977f, 0.19509032201612825f};
#pragma unroll
    for (int st = 0; st < LOG2R; ++st) {
        const int h = R >> (st + 1);
#pragma unroll
        for (int i = 0; i < R; i += 2 * h) {
#pragma unroll
            for (int j = 0; j < h; ++j) {
                const float xr = re[i + j], xi = im[i + j], yr = re[i + j + h], yi = im[i + j + h];
                re[i + j] = xr + yr; im[i + j] = xi + yi;
                const float dr = xr - yr, di = xi - yi;
                const int k = j * (16 / h);
                if (k == 0) { re[i + j + h] = dr; im[i + j + h] = di; }
                else if (k == 8) { re[i + j + h] = INV ? -di : di; im[i + j + h] = INV ? dr : -dr; }
                else { const float c = C32[k], sn = INV ? S32[k] : -S32[k]; re[i + j + h] = dr * c - di * sn; im[i + j + h] = dr * sn + di * c; }
            }
        }
    }
}
template <bool INV, int SP> DI void fft_pass32(f32x2* X, int bp, int rem, float inv_bs) {
    asm volatile("" : "+v"(bp), "+v"(rem));
    f32x2* P = X + bp;
    float re[32], im[32];
    if (!INV) {
#pragma unroll
        for (int q = 0; q < 32; ++q) { const f32x2 v = P[q * SP]; re[q] = v[0]; im[q] = v[1]; }
        dft_regs<32, 5, false>(re, im);
#pragma unroll
        for (int m = 0; m < 32; ++m) { const int qp = brev(m, 5);
            float r = re[m], i = im[m];
            if (qp != 0) { const float rev = (float)(rem * qp) * inv_bs; const float c = __builtin_amdgcn_cosf(rev), sn = -__builtin_amdgcn_sinf(rev); const float t = r * c - i * sn; i = r * sn + i * c; r = t; }
            P[qp * SP] = (f32x2){r, i}; }
    } else {
#pragma unroll
        for (int qp = 0; qp < 32; ++qp) { const f32x2 v = P[qp * SP]; float r = v[0], i = v[1];
            if (qp != 0) { const float rev = (float)(rem * qp) * inv_bs; const float c = __builtin_amdgcn_cosf(rev), sn = __builtin_amdgcn_sinf(rev); const float t = r * c - i * sn; i = r * sn + i * c; r = t; }
            re[qp] = r; im[qp] = i; }
        dft_regs<32, 5, true>(re, im);
#pragma unroll
        for (int m = 0; m < 32; ++m) P[brev(m, 5) * SP] = (f32x2){re[m], im[m]};
    }
}
DI void fft_fwd12(f32x2* X, int tid) {
    __syncthreads(); fft_pass32<false, 560>(X, fphys(tid), tid, 1.f / 16384.f);
    __syncthreads(); fft_pass32<false, 17>(X, (tid >> 4) * 560 + (tid & 15), tid & 15, 1.f / 512.f);
    __syncthreads();
}
DI void fft_inv21(f32x2* X, int tid) {
    __syncthreads(); fft_pass32<true, 17>(X, (tid >> 4) * 560 + (tid & 15), tid & 15, 1.f / 512.f);
    __syncthreads(); fft_pass32<true, 560>(X, fphys(tid), tid, 1.f / 16384.f);
    __syncthreads();
}
DI void hyena_fft_unit(const Frame& F, int li, int ch) {
    f32x2* X = (f32x2*)F.lds;
    const bf16_t* HYT = WSP(bf16_t, WS_HYT); const float* filt = WSP(float, WS_FILT);
    f32x2* Ye = WSP(f32x2, WS_ZBUF) + (size_t)ch * FM; f32x2* Z1 = WSP(f32x2, WS_Z1BUF) + (size_t)ch * FM;
    const float* sw = F.in[I_HYSW] + (size_t)li * 3 * 768; const float* sb = F.in[I_HYSB] + li * 768; const float* sk = F.in[I_HSKIP] + li * 512;
    const int tid = F.tid;
    const bf16_t* px1[2] = {HYT + ((size_t)0 * 768 + ch) * S, HYT + ((size_t)1 * 768 + ch) * S};
    const bf16_t* px2[2] = {HYT + ((size_t)0 * 768 + 256 + ch) * S, HYT + ((size_t)1 * 768 + 256 + ch) * S};
    const bf16_t* pv[2] = {HYT + ((size_t)0 * 768 + 512 + ch) * S, HYT + ((size_t)1 * 768 + 512 + ch) * S};
    const float wx1[4] = {sw[ch], sw[768 + ch], sw[1536 + ch], sb[ch]};
    const float wx2[4] = {sw[256 + ch], sw[768 + 256 + ch], sw[1536 + 256 + ch], sb[256 + ch]};
    const float wv[4] = {sw[512 + ch], sw[768 + 512 + ch], sw[1536 + 512 + ch], sb[512 + ch]};
#pragma unroll 1
    for (int cv = 0; cv < 2; ++cv) {
        const float* hf = filt + ((size_t)(2 * cv) * 256 + ch) * S; const float* hb = filt + ((size_t)(2 * cv + 1) * 256 + ch) * S;
        float fnrm;
        { const float pv = WSP(float, WS_FPART)[(size_t)(tid & 255) * 1024 + (cv * 2 + (tid >> 8)) * 256 + ch];
          const float ws = wave_sum(pv);
          float* red = (float*)(F.lds + LDS_MISC + 128);
          __syncthreads();
          if (F.lane == 0) red[F.wave] = ws;
          __syncthreads();
          fnrm = rsqrtf(red[0] + red[1] + red[2] + red[3] + red[4] + red[5] + red[6] + red[7] + EPS); }
        const float nrm = 1.f / 32768.f;
        const float skip = sk[cv * 256 + ch];
#pragma unroll 1
        for (int half = 0; half < 2; ++half) {
            __syncthreads();
            int pb = fphys(tid); int tq = tid; asm volatile("" : "+v"(pb), "+v"(tq));
            if (half == 0) {
#pragma unroll 8
                for (int j = 0; j < 32; ++j) { const int n = tq + 512 * j; const float a = hf[n] * fnrm; float bq = hb[FM - n] * fnrm; bq = n ? bq : 0.f;
                    X[pb + 560 * j] = (f32x2){a + bq, 0.f}; }
            } else {
#pragma unroll 8
                for (int j = 0; j < 32; ++j) { const int n = tq + 512 * j; const float a = hf[n] * fnrm; float bq = hb[FM - n] * fnrm; bq = n ? bq : 0.f;
                    const float d = a - bq, rev = (float)n * (1.f / 32768.f);
                    X[pb + 560 * j] = (f32x2){d * __builtin_amdgcn_cosf(rev), -d * __builtin_amdgcn_sinf(rev)}; }
            }
            fft_fwd12(X, tid);
            h16x2 kpk[2][16];
#pragma unroll
            for (int g = 0; g < 2; ++g) { int b16 = fphys((tid + 512 * g) * 16); asm volatile("" : "+v"(b16));
                float kre[16], kim[16];
#pragma unroll
                for (int q = 0; q < 16; ++q) { const f32x2 v = X[b16 + q]; kre[q] = v[0]; kim[q] = v[1]; }
                dft_regs<16, 4, false>(kre, kim);
#pragma unroll
                for (int q = 0; q < 16; ++q) kpk[g][q] = (h16x2){(_Float16)kre[q], (_Float16)kim[q]}; }
            __syncthreads();
            asm volatile("" : "+v"(pb), "+v"(tq));
#define HY_MOD(v, n) do { const float rev = (float)(n) * (1.f / 32768.f); const float c = __builtin_amdgcn_cosf(rev), sn = -__builtin_amdgcn_sinf(rev); v = (f32x2){v[0] * c - v[1] * sn, v[0] * sn + v[1] * c}; } while (0)
            if (cv == 0) {
                if (half == 0) {
#pragma unroll 8
                    for (int j = 0; j < 32; ++j) { const int n = tq + 512 * j; X[pb + 560 * j] = (f32x2){hy_short(pv[0], n, S, wv[0], wv[1], wv[2], wv[3]), hy_short(pv[1], n, S, wv[0], wv[1], wv[2], wv[3])}; }
                } else {
#pragma unroll 8
                    for (int j = 0; j < 32; ++j) { const int n = tq + 512 * j; f32x2 v = (f32x2){hy_short(pv[0], n, S, wv[0], wv[1], wv[2], wv[3]), hy_short(pv[1], n, S, wv[0], wv[1], wv[2], wv[3])}; HY_MOD(v, n); X[pb + 560 * j] = v; }
                }
            } else {
                if (half == 0) {
#pragma unroll 8
                    for (int j = 0; j < 32; ++j) { const int n = tq + 512 * j; X[pb + 560 * j] = Z1[n]; }
                } else {
#pragma unroll 8
                    for (int j = 0; j < 32; ++j) { const int n = tq + 512 * j; f32x2 v = Z1[n]; HY_MOD(v, n); X[pb + 560 * j] = v; }
                }
            }
#undef HY_MOD
            fft_fwd12(X, tid);
#pragma unroll
            for (int g = 0; g < 2; ++g) { int b16 = fphys((tid + 512 * g) * 16); asm volatile("" : "+v"(b16));
                float re[16], im[16];
#pragma unroll
                for (int q = 0; q < 16; ++q) { const f32x2 v = X[b16 + q]; re[q] = v[0]; im[q] = v[1]; }
                dft_regs<16, 4, false>(re, im);
                float br[16], bi[16];
#pragma unroll
                for (int m = 0; m < 16; ++m) { const int qp = brev(m, 4); const float kr = (float)kpk[g][m][0], ki = (float)kpk[g][m][1]; br[qp] = re[m] * kr - im[m] * ki; bi[qp] = re[m] * ki + im[m] * kr; }
                dft_regs<16, 4, true>(br, bi);
#pragma unroll
                for (int m = 0; m < 16; ++m) X[b16 + brev(m, 4)] = (f32x2){br[m], bi[m]};
            }
            fft_inv21(X, tid);
            asm volatile("" : "+v"(pb), "+v"(tq));
            if (half == 0) {
#pragma unroll 8
                for (int j = 0; j < 32; ++j) { const int n = tq + 512 * j; Ye[n] = X[pb + 560 * j]; }
            } else {
#define HY_Y(n, j) const f32x2 yo = X[pb + 560 * (j)], ye = Ye[n]; \
                    const float rev = (float)(n) * (1.f / 32768.f); const float c = __builtin_amdgcn_cosf(rev), sn = __builtin_amdgcn_sinf(rev); \
                    const float y0 = (ye[0] + yo[0] * c - yo[1] * sn) * nrm, y1 = (ye[1] + yo[0] * sn + yo[1] * c) * nrm;
                if (cv == 0) {
#pragma unroll 4
                    for (int j = 0; j < 32; ++j) { const int n = tq + 512 * j; HY_Y(n, j)
                        const float v0 = hy_short(pv[0], n, S, wv[0], wv[1], wv[2], wv[3]), v1 = hy_short(pv[1], n, S, wv[0], wv[1], wv[2], wv[3]);
                        const float a0 = hy_short(px1[0], n, S, wx1[0], wx1[1], wx1[2], wx1[3]), a1 = hy_short(px1[1], n, S, wx1[0], wx1[1], wx1[2], wx1[3]);
                        Z1[n] = (f32x2){a0 * (y0 + skip * v0), a1 * (y1 + skip * v1)}; }
                } else {
                    bf16_t* mix = WSP(bf16_t, WS_HBF);
#pragma unroll 4
                    for (int j = 0; j < 32; ++j) { const int n = tq + 512 * j; HY_Y(n, j)
                        const f32x2 z1 = Z1[n];
                        const float a0 = hy_short(px2[0], n, S, wx2[0], wx2[1], wx2[2], wx2[3]), a1 = hy_short(px2[1], n, S, wx2[0], wx2[1], wx2[2], wx2[3]);
                        mix[((size_t)n) * D + 768 + ch] = f2bf(a0 * (y0 + skip * z1[0]));
                        mix[((size_t)S + n) * D + 768 + ch] = f2bf(a1 * (y1 + skip * z1[1])); }
                }
#undef HY_Y
            }
        }
    }
}
DI void hyena_ctx_unit(const Frame& F, int li, int ch) {
    float* vs = (float*)F.lds;
    float* zs = vs + 512;
    float* fl = zs + 512;
    const bf16_t* HYC = WSP(bf16_t, WS_HYC); const float* filt = WSP(float, WS_FILTC);
    const float* sw = F.in[I_HYSW] + (size_t)li * 3 * 768; const float* sb = F.in[I_HYSB] + li * 768; const float* sk = F.in[I_HSKIP] + li * 512;
    const float n0 = hy_norm(WSP(float, WS_FPARTC), 4, 0, ch), n1 = hy_norm(WSP(float, WS_FPARTC), 4, 1, ch);
    const int b = F.tid >> 8, t = F.tid & 255;
    auto sc = [&](int c) -> float { const bf16_t* p = HYC + (size_t)(b * CTX) * 768 + c;
        const float a = t > 0 ? bf2f(p[(size_t)(t - 1) * 768]) : 0.f, d = t + 1 < CTX ? bf2f(p[(size_t)(t + 1) * 768]) : 0.f;
        return a * sw[c] + bf2f(p[(size_t)t * 768]) * sw[768 + c] + d * sw[1536 + c] + sb[c]; };
    __syncthreads();
    const float x1 = sc(ch), x2 = sc(256 + ch), v = sc(512 + ch);
    vs[F.tid] = v;
    for (int i = F.tid; i < 1024; i += NTHR) fl[i] = filt[((size_t)(i >> 8) * 256 + ch) * CTX + (i & 255)];
    __syncthreads();
    float a = 0.f;
    for (int s = 0; s < CTX; ++s) { const int dl = t - s; a += (dl >= 0 ? fl[dl] : fl[256 - dl]) * vs[b * 256 + s]; }
    const float z = x1 * (a * n0 + sk[ch] * v);
    zs[F.tid] = z;
    __syncthreads();
    a = 0.f;
    for (int s = 0; s < CTX; ++s) { const int dl = t - s; a += (dl >= 0 ? fl[512 + dl] : fl[768 - dl]) * zs[b * 256 + s]; }
    WSP(bf16_t, WS_HBF)[((size_t)NLAT + b * CTX + t) * D + 768 + ch] = f2bf(x2 * (a * n1 + sk[256 + ch] * z));
}

DI void phase_mix(const Frame& F0, int li) {
    const Frame& F = F0;
    unsigned* head = F.ctl + CW_QHEAD + li * 64;
    volatile unsigned* qs = (volatile unsigned*)(F.lds + LDS_MISC + 32);
#ifndef PROBE_DA
#define PROBE_DA 1
#endif
#ifndef PROBE_HY
#define PROBE_HY 1
#endif
#ifndef PROBE_NA
#define PROBE_NA 1
#endif
#ifdef PROBE_MISC
#define PROBE_PL 2
#else
#define PROBE_PL 1
#endif
    const int n_ca = (li == 0) ? 16 : 0, n_cb = (li == 0) ? 8 : 0, n_da = 1024 * PROBE_DA, n_hy = 256 * PROBE_HY, n_na = 512 * PROBE_NA, n_hc = (li == 0) ? 256 * PROBE_PL : 0, n_pl = 1024 * PROBE_PL, n_pc = (li == 0) ? 16 : 0;
    const int total = n_ca + n_cb + n_da + n_hy + n_na + n_hc + n_pl + n_pc;
    for (;;) {
        __syncthreads();
        if (F.tid == 0) qs[0] = __hip_atomic_fetch_add(head, 1u, __ATOMIC_RELAXED, __HIP_MEMORY_SCOPE_AGENT);
        __syncthreads();
        int u = __builtin_amdgcn_readfirstlane((int)qs[0]);
        if (u >= total) break;
        Frame F = F0; refresh(F);
        if (u < n_ca) {
#ifndef SKIP_CA
            diffattn_unit(F, li, u >> 3, (u >> 1) & 3, (size_t)NLAT + (size_t)(u >> 3) * CTX + (size_t)(u & 1) * 128, CTX / 128);
#endif
            continue; }
        u -= n_ca;
        if (u < n_cb) {
#ifndef SKIP_CB
            na_mfma_unit(F, li, u >> 2, (size_t)NLAT + (size_t)(u >> 2) * CTX + (size_t)(u & 3) * 64, -1);
#endif
            continue; }
        u -= n_cb;
        if (u < n_da) {
#ifndef SKIP_DA
            { const int v = u & 1023; diffattn_unit(F, li, v >> 9, (v >> 7) & 3, (size_t)(v >> 9) * S + (size_t)(v & 127) * 128, NKEY / 128); }
#endif
            continue; }
        u -= n_da;
        if (u < n_hy) {
#ifndef SKIP_HY
            hyena_fft_unit(F, li, u & 255);
#endif
            continue; }
        u -= n_hy;
        if (u < n_na) {
#ifndef SKIP_NA
            { const int v = u & 511; na_mfma_unit(F, li, v >> 8, (size_t)(v >> 8) * S + (size_t)(v & 255) * GW, v & 255); }
#endif
            continue; }
        u -= n_na;
        if (u < n_hc) {
#ifndef SKIP_HC
            hyena_ctx_unit(F, li, u & 255);
#endif
            continue; }
        u -= n_hc;
        if (u < n_pl) {
#ifndef SKIP_PL
            { const int v = u & 1023; pool_unit(F, li, (size_t)(v >> 9) * S, S, (v & 511) * 32); }
#endif
            continue; }
        u -= n_pl;
#ifndef SKIP_PL
        pool_unit(F, li, (size_t)NLAT + (u >> 3) * CTX, CTX, (u & 7) * 32);
#endif
    }
}

constexpr int PH_PER_LAYER = 8, NPH = 2 + 2 * PH_PER_LAYER;
__global__ void __launch_bounds__(NTHR, 2) mega(Args args) {
    extern __shared__ __attribute__((aligned(16))) unsigned char smem[];
    Frame F;
    F.in = args.in; F.out = args.out; F.ws = args.ws; F.ctl = (unsigned*)(args.ws + WS_CTL); F.lds = smem;
    F.tid = threadIdx.x; F.lane = F.tid & 63; F.wave = __builtin_amdgcn_readfirstlane(F.tid >> 6); F.G = gridDim.x; F.bid = blockIdx.x;
    if (F.tid < 64) ((unsigned*)(smem + LDS_MISC))[F.tid] = 0u;
    __syncthreads();
    const int lo = args.ph_lo, hi = args.ph_hi;
    const bool fused = (hi - lo) > 1;
    XcdBarrier bar; bar.bar = F.ctl; bar.x = 0; bar.st = (volatile LAS unsigned*)(smem + LDS_MISC);
    if (fused) bar = xcd_barrier_post(F.ctl, (volatile LAS unsigned*)(smem + LDS_MISC));
#define IN(k) (lo <= (k) && (k) < hi)
#ifdef PROBE_BAR
#define SEAM(k) do { if (IN(k) && IN((k) + 1)) { xcd_barrier(bar); xcd_barrier(bar); xcd_barrier(bar); } } while (0)
#else
#define SEAM(k) do { if (IN(k) && IN((k) + 1)) xcd_barrier(bar); } while (0)
#endif
#ifndef SKIP_P0
    if (IN(0)) { refresh(F); phase_prologue(F);
#ifdef PROBE_MISC
        __syncthreads(); refresh(F); phase_prologue(F);
#endif
    }
#endif
    SEAM(0);
    for (int li = 0; li < 2; ++li) {
        const int p0 = 1 + li * PH_PER_LAYER;
        const int nrows = (li == 0) ? NTOK : NLAT;
        if (IN(p0)) {
            refresh(F);
            phase_norm1(F, li, li == 0 ? 0 : 1);
#ifdef PROBE_N1
            if (li == 0) { refresh(F); phase_norm1(F, li, 0); refresh(F); phase_norm1(F, li, 0); refresh(F); phase_norm1(F, li, 0); refresh(F); phase_norm1(F, li, 0); }
#endif
            refresh(F);
#ifndef SKIP_FILT
            for (int t = F.bid; t < 256; t += F.G) filter_tile(F, li, S, t, WSP(float, WS_FILT), WSP(float, WS_FPART));
            if (li == 0) for (int t = F.bid; t < 4; t += F.G) filter_tile(F, li, CTX, t, WSP(float, WS_FILTC), WSP(float, WS_FPARTC));
#ifdef PROBE_MISC
            for (int t = F.bid; t < 256; t += F.G) filter_tile(F, li, S, t, WSP(float, WS_FILT), WSP(float, WS_FPART));
#endif
#endif
        }
        SEAM(p0);
        if (IN(p0 + 1)) {
            refresh(F);
            pg8::Gemm g{WSP(bf16_t, WS_HBF), WSP(bf16_t, WS_WIN) + (size_t)li * DIN * D, D, 0};
            pg8::StaticOrder So; So.init(NTOK, DIN, F.G, F.bid);
            EpiIn E{F.ws, WSP(float, WS_ROPE), F.ctl + CW_KMAX + li * 16, F.ctl + CW_KMAXB + li * 16};
#ifndef SKIP_G1
            pg8::gemm_phase<EpiIn, pg8::StaticOrder>((LAS unsigned char*)smem, g, So, E, F.tid);
#ifdef PROBE_G1
            __syncthreads(); refresh(F); pg8::gemm_phase<EpiIn, pg8::StaticOrder>((LAS unsigned char*)smem, g, So, E, F.tid);
#endif
#endif
        }
        SEAM(p0 + 1);
        if (IN(p0 + 2)) { refresh(F); phase_mix(F, li); }
        SEAM(p0 + 2);
        if (IN(p0 + 3)) {
            refresh(F);
            pg8::Gemm g{WSP(bf16_t, WS_HBF), WSP(bf16_t, WS_WOUT) + (size_t)li * D * D, D, 0};
            pg8::StaticOrder So; So.init(nrows, D, F.G, F.bid);
            EpiOut E{li == 0 ? F.in[I_X] : F.out, li == 0 ? F.in[I_CTX] : WSP(float, WS_XC), F.out, WSP(float, WS_XC), WSP(float, WS_MOD) + (size_t)li * 3 * 6144};
#ifndef SKIP_G2
            pg8::gemm_phase<EpiOut, pg8::StaticOrder>((LAS unsigned char*)smem, g, So, E, F.tid);
#endif
        }
        SEAM(p0 + 3);
#ifndef SKIP_N2
        if (IN(p0 + 4)) { refresh(F); phase_norm2(F, li, nrows); }
#endif
        SEAM(p0 + 4);
        if (IN(p0 + 5)) { refresh(F); phase_gather(F, li, nrows);
#ifdef PROBE_MISC
            __syncthreads(); refresh(F); phase_gather(F, li, nrows);
#endif
        }
        SEAM(p0 + 5);
        if (IN(p0 + 6)) {
            refresh(F);
            int* offs = (int*)(smem + LDS_MISC + 64);
            moe_offsets(F, li, offs);
            pg8::Gemm g{WSP(bf16_t, WS_A1), WSP(bf16_t, WS_W13) + (size_t)li * NE * 1024 * 1024, D, (size_t)1024 * 1024};
            pg8::MoeOrder Mo{offs + 40, offs[17 + 16], 4, F.G, F.bid};
            EpiMoe1 E{WSP(bf16_t, WS_HMID)};
#ifndef SKIP_G3
            pg8::gemm_phase<EpiMoe1, pg8::MoeOrder>((LAS unsigned char*)smem, g, Mo, E, F.tid);
#ifdef PROBE_G3
            __syncthreads(); refresh(F); pg8::gemm_phase<EpiMoe1, pg8::MoeOrder>((LAS unsigned char*)smem, g, Mo, E, F.tid);
#endif
#endif
        }
        SEAM(p0 + 6);
        if (IN(p0 + 7)) {
            refresh(F);
            int* offs = (int*)(smem + LDS_MISC + 64);
            moe_offsets(F, li, offs);
            pg8::Gemm g{WSP(bf16_t, WS_HMID), WSP(bf16_t, WS_W2) + (size_t)li * NE * 1024 * 512, DE, (size_t)1024 * 512};
            pg8::MoeOrder Mo{offs + 40, offs[17 + 16], 4, F.G, F.bid};
            EpiMoe2 E{WSP(bf16_t, WS_A1)};
#ifndef SKIP_G4
            pg8::gemm_phase<EpiMoe2, pg8::MoeOrder>((LAS unsigned char*)smem, g, Mo, E, F.tid);
#ifdef PROBE_G4
            __syncthreads(); refresh(F); pg8::gemm_phase<EpiMoe2, pg8::MoeOrder>((LAS unsigned char*)smem, g, Mo, E, F.tid);
#endif
#endif
        }
        SEAM(p0 + 7);
    }
    if (IN(NPH - 1)) { refresh(F); phase_norm1(F, 1, 2); }
#undef IN
#undef SEAM
}

extern "C" void kernel_launch(void* const* d_in, const int* in_sizes, int n_in, void* d_out, int out_size, void* d_ws, size_t ws_size, hipStream_t stream) {
    static int grid = 0;
    if (grid == 0) {
        if (n_in != N_IN || out_size != NLAT * D || ws_size < WS_END) { fprintf(stderr, "kernel_launch: unexpected shapes (n_in %d out %d ws %zu need %zu)\n", n_in, out_size, ws_size, (size_t)WS_END); grid = -1; return; }
        int dev = 0, cus = 0, per_cu = 0;
        if (hipGetDevice(&dev) != hipSuccess || hipDeviceGetAttribute(&cus, hipDeviceAttributeMultiprocessorCount, dev) != hipSuccess) { grid = -1; return; }
        if (hipFuncSetAttribute((const void*)mega, hipFuncAttributeMaxDynamicSharedMemorySize, LDS_BYTES) != hipSuccess) { fprintf(stderr, "kernel_launch: hipFuncSetAttribute failed\n"); grid = -1; return; }
        if (hipOccupancyMaxActiveBlocksPerMultiprocessor(&per_cu, (const void*)mega, NTHR, LDS_BYTES) != hipSuccess || per_cu < 1) { fprintf(stderr, "kernel_launch: occupancy query says %d\n", per_cu); }
        (void)hipGetLastError();
        grid = cus < MAXG ? cus : MAXG;
    }
    if (grid < 0) return;
    (void)hipMemsetAsync((char*)d_ws + WS_CTL, 0, CTL_BYTES, stream);
    Args a{};
    for (int i = 0; i < N_IN; ++i) a.in[i] = (const float*)d_in[i];
    a.out = (float*)d_out; a.ws = (unsigned char*)d_ws;
#if N_LAUNCH_MODE == 1
    a.ph_lo = 0; a.ph_hi = NPH;
    hipLaunchKernelGGL(mega, dim3(grid), dim3(NTHR), LDS_BYTES, stream, a);
#else
    for (int p = 0; p < NPH; ++p) { a.ph_lo = p; a.ph_hi = p + 1; hipLaunchKernelGGL(mega, dim3(grid), dim3(NTHR), LDS_BYTES, stream, a); }
#endif
}
#ifdef TEST_UNITS
__global__ void __launch_bounds__(NTHR, 2) t_da(Args args) {
    extern __shared__ __attribute__((aligned(16))) unsigned char smem[];
    Frame F; F.in = args.in; F.out = args.out; F.ws = args.ws; F.ctl = (unsigned*)(args.ws + WS_CTL); F.lds = smem; F.G = gridDim.x; F.bid = blockIdx.x; refresh(F);
    diffattn_unit(F, args.ph_lo, blockIdx.x >> 8, (blockIdx.x >> 6) & 3, (size_t)(blockIdx.x & 63) * 256, NKEY / 128);
}
__global__ void __launch_bounds__(NTHR, 2) t_hy(Args args) {
    extern __shared__ __attribute__((aligned(16))) unsigned char smem[];
    Frame F; F.in = args.in; F.out = args.out; F.ws = args.ws; F.ctl = (unsigned*)(args.ws + WS_CTL); F.lds = smem; F.G = gridDim.x; F.bid = blockIdx.x; refresh(F);
    hyena_fft_unit(F, args.ph_lo, blockIdx.x);
}
#endif
```

```cpp
#include <hip/hip_runtime.h>
#include <stdint.h>
#include <stdio.h>

#ifndef N_LAUNCH_MODE
#define N_LAUNCH_MODE 1
#endif

#define DI __device__ __forceinline__
#define LAS __attribute__((address_space(3)))
typedef unsigned short bf16_t;
typedef short bf16x8 __attribute__((ext_vector_type(8)));
typedef short s16x4 __attribute__((ext_vector_type(4)));
typedef float f32x4 __attribute__((ext_vector_type(4)));
typedef float f32x2 __attribute__((ext_vector_type(2)));
typedef float f32x16 __attribute__((ext_vector_type(16)));
typedef unsigned u32x4 __attribute__((ext_vector_type(4)));
typedef unsigned u32x2 __attribute__((ext_vector_type(2)));
typedef _Float16 h16x2 __attribute__((ext_vector_type(2)));

constexpr int D = 1024, NB = 2, S = 16384, CTX = 256, NLAT = NB * S, NCTX = NB * CTX, NTOK = NLAT + NCTX, DIN = 2560;
constexpr int NE = 16, DE = 512, GW = 64;
constexpr int NKEY = CTX + S;
constexpr int NTHR = 512;
constexpr int SLOT_CAP = 70656;
constexpr float EPS = 1e-6f;
constexpr float LOG2E = 1.4426950408889634f;
constexpr float QSCALE_A = 0.17677669529663687f * LOG2E;
constexpr float QSCALE_B = 0.125f * LOG2E;

enum { I_X = 0, I_C, I_CTX, I_CCTX, I_N1G, I_N2G, I_ADAW, I_ADAB, I_WIN, I_WOUT, I_ALAM, I_ASUB, I_RPB, I_POOLW, I_POOLS, I_HYSW, I_HYSB,
       I_HW1, I_HB1, I_HW2, I_HB2, I_HW3, I_HB3, I_HSKIP, I_RW, I_RB, I_MW1, I_MW3, I_MW2, I_FG, N_IN };

struct Args { const float* in[N_IN]; float* out; unsigned char* ws; int ph_lo, ph_hi; };

constexpr size_t al256(size_t x) { return (x + 255) & ~(size_t)255; }
constexpr size_t WS_CTL = 0, CTL_BYTES = 65536;
constexpr size_t WS_MOD = WS_CTL + CTL_BYTES;
constexpr size_t WS_ROPE = WS_MOD + al256(2 * 3 * 6144 * 4);
constexpr size_t WS_FPART = WS_ROPE + 16384;
constexpr size_t WS_FPARTC = WS_FPART + 256 * 1024 * 4;
constexpr size_t WS_XC = WS_FPARTC + 4 * 1024 * 4;
constexpr size_t WS_WIN = WS_XC + (size_t)NCTX * D * 4;
constexpr size_t WS_WOUT = WS_WIN + (size_t)2 * DIN * D * 2;
constexpr size_t WS_W13 = WS_WOUT + (size_t)2 * D * D * 2;
constexpr size_t WS_W2 = WS_W13 + (size_t)2 * NE * 1024 * 1024 * 2;
constexpr size_t WS_FILT = WS_W2 + (size_t)2 * NE * 1024 * 512 * 2;
constexpr size_t WS_FILTC = WS_FILT + (size_t)4 * 256 * S * 4;
constexpr size_t WS_ZBUF = WS_FILTC + (size_t)4 * 256 * 256 * 4;
constexpr size_t WS_R1 = WS_ZBUF + (size_t)256 * 2 * S * 4;
constexpr size_t WS_HBF = WS_R1;
constexpr size_t TOKB = (size_t)NTOK * 256 * 2;
constexpr size_t WS_AQ = WS_HBF + (size_t)NTOK * D * 2;
constexpr size_t WS_AK = WS_AQ + TOKB;
constexpr size_t WS_AVT = WS_AK + TOKB;
constexpr size_t WS_BQ = WS_AVT + (size_t)NB * 4 * 64 * NKEY * 2;
constexpr size_t WS_BK = WS_BQ + TOKB;
constexpr size_t WS_BVT = WS_BK + TOKB;
constexpr size_t WS_PL = WS_BVT + (size_t)NB * 4 * 64 * NKEY * 2;
constexpr size_t WS_HYT = WS_PL + TOKB;
constexpr size_t WS_HYC = WS_HYT + (size_t)NB * 768 * S * 2;
constexpr size_t WS_Z1BUF = WS_HYC + (size_t)NCTX * 768 * 2;
constexpr size_t WS_END_MIX = WS_Z1BUF + (size_t)256 * S * 8;
constexpr size_t WS_TOK = WS_AQ;
constexpr size_t WS_A1 = WS_TOK + al256((size_t)NTOK * 32);
constexpr size_t WS_HMID = WS_A1 + (size_t)SLOT_CAP * D * 2;
constexpr size_t WS_END_MOE = WS_HMID + (size_t)SLOT_CAP * DE * 2;
constexpr size_t WS_END = WS_END_MIX > WS_END_MOE ? WS_END_MIX : WS_END_MOE;

#define XB_TMO      128
#define XB_XCNT(j)  (256  + 64 * (j))
#define XB_XSUB(j)  (1280 + 64 * (j))
#define XB_XGEN(j)  (2304 + 64 * (j))
#define XB_TOP      3328
#define XB_TOPGEN   3392
#define XCD_BAR_WORDS 3456
#define XB_SPIN_CAP (1u << 18)
constexpr int CW_CNT = 4096;
constexpr int CW_KMAX = 4160;
constexpr int CW_KMAXB = 4192;
constexpr int CW_QHEAD = 4224;
constexpr int CW_BCNT = 4352;
constexpr int MAXG = 256;

constexpr int LDS_MAIN = 143360, LDS_MISC = LDS_MAIN, LDS_BYTES = LDS_MAIN + 2048;

DI float bf2f(bf16_t v) { return __uint_as_float(((unsigned)v) << 16); }
DI bf16_t f2bf(float f) { unsigned u = __float_as_uint(f); u += 0x7FFFu + ((u >> 16) & 1u); return (bf16_t)(u >> 16); }
DI unsigned pk2(float lo, float hi) { unsigned r; asm volatile("v_cvt_pk_bf16_f32 %0, %1, %2" : "=v"(r) : "v"(lo), "v"(hi)); return r; }
template <int K> DI float swz_xor(float v) { return __int_as_float(__builtin_amdgcn_ds_swizzle(__float_as_int(v), (K << 10) | 0x1F)); }
DI float half_sum(float v) { const auto r = __builtin_amdgcn_permlane32_swap(__float_as_uint(v), __float_as_uint(v), false, false); return __uint_as_float(r[0]) + __uint_as_float(r[1]); }
DI float half_max(float v) { const auto r = __builtin_amdgcn_permlane32_swap(__float_as_uint(v), __float_as_uint(v), false, false); return fmaxf(__uint_as_float(r[0]), __uint_as_float(r[1])); }
DI float wave_sum(float v) { v += swz_xor<16>(v); v += swz_xor<8>(v); v += swz_xor<4>(v); v += swz_xor<2>(v); v += swz_xor<1>(v); return half_sum(v); }
DI float wave_max(float v) { v = fmaxf(v, swz_xor<16>(v)); v = fmaxf(v, swz_xor<8>(v)); v = fmaxf(v, swz_xor<4>(v)); v = fmaxf(v, swz_xor<2>(v)); v = fmaxf(v, swz_xor<1>(v)); return half_max(v); }
DI float siluf(float x) { return x / (1.f + __expf(-x)); }
DI float sin_rev(float rev) { return __builtin_amdgcn_sinf(rev - floorf(rev)); }
DI float cos_rev(float rev) { return __builtin_amdgcn_cosf(rev - floorf(rev)); }
DI float sin_rad(float x) { return sin_rev(x * 0.15915494309189535f); }

DI unsigned xb_ld(unsigned* p)              { return __hip_atomic_load(p, __ATOMIC_RELAXED, __HIP_MEMORY_SCOPE_AGENT); }
DI unsigned xb_add(unsigned* p, unsigned v) { return __hip_atomic_fetch_add(p, v, __ATOMIC_RELAXED, __HIP_MEMORY_SCOPE_AGENT); }
DI unsigned xb_xcc_id() { return (unsigned)__builtin_amdgcn_s_getreg((3 << 11) | 20) & 0xFu; }
#define XB_SPIN(cond, bar) do { unsigned _sp = 0; while (cond) { __builtin_amdgcn_s_sleep(1); \
    if ((++_sp & 255u) == 0u) { if (xb_ld(&(bar)[XB_TMO])) break; if (_sp > XB_SPIN_CAP) { atomicAdd(&(bar)[XB_TMO], 1u); break; } } } } while (0)
struct XcdBarrier { unsigned* bar; unsigned x; volatile LAS unsigned* st; };
DI XcdBarrier xcd_barrier_post(unsigned* bar, volatile LAS unsigned* st) {
    XcdBarrier b; b.bar = bar; b.x = xb_xcc_id(); b.st = st;
    if (threadIdx.x == 0) (void)xb_add(&bar[XB_XCNT(b.x)], 1u);
    return b;
}
DI void xcd_barrier_complete(unsigned* bar, unsigned x, unsigned& nloc, unsigned& nx) {
    const unsigned G = gridDim.x * gridDim.y * gridDim.z;
    unsigned sum, cnt, mine, sp = 0u;
    for (;;) {
        sum = 0u; cnt = 0u; mine = 0u;
#pragma unroll
        for (unsigned j = 0; j < 16; ++j) { const unsigned c = xb_ld(&bar[XB_XCNT(j)]); sum += c; cnt += (c > 0u) ? 1u : 0u; mine = (j == x) ? c : mine; }
        if (sum == G) break;
        __builtin_amdgcn_s_sleep(1);
        if ((++sp & 255u) == 0u) { if (xb_ld(&bar[XB_TMO])) break; if (sp > XB_SPIN_CAP) { atomicAdd(&bar[XB_TMO], 1u); break; } }
    }
    nloc = mine > 0u ? mine : 1u; nx = cnt > 0u ? cnt : 1u;
}
DI void xcd_barrier(const XcdBarrier& b) {
    asm volatile("s_waitcnt vmcnt(0)" ::: "memory");
    __syncthreads();
    if (threadIdx.x == 0) {
        unsigned* bar = b.bar;
        __builtin_amdgcn_s_waitcnt(0);
        unsigned nloc = b.st[0], nx = b.st[1];
        if (nloc == 0u) { xcd_barrier_complete(bar, b.x, nloc, nx); b.st[0] = nloc; b.st[1] = nx; }
        const unsigned old = xb_add(&bar[XB_XSUB(b.x)], 1u);
        const unsigned gen = old / nloc;
        if (old + 1u == (gen + 1u) * nloc) {
            __builtin_amdgcn_fence(__ATOMIC_RELEASE, "agent");
            asm volatile("s_waitcnt vmcnt(0)" ::: "memory");
            const unsigned og = xb_add(&bar[XB_TOP], 1u);
            const unsigned tg = og / nx;
            if (og + 1u == (tg + 1u) * nx) xb_add(&bar[XB_TOPGEN], 1u);
            else XB_SPIN(xb_ld(&bar[XB_TOPGEN]) == tg, bar);
            __builtin_amdgcn_fence(__ATOMIC_ACQUIRE, "agent");
            xb_add(&bar[XB_XGEN(b.x)], 1u);
            asm volatile("s_waitcnt vmcnt(0)" ::: "memory");
        } else {
            XB_SPIN(xb_ld(&bar[XB_XGEN(b.x)]) == gen, bar);
            __builtin_amdgcn_fence(__ATOMIC_ACQUIRE, "agent");
            asm volatile("s_waitcnt vmcnt(0)" ::: "memory");
        }
    }
    __syncthreads();
}

struct Frame {
    const float* const* in; float* out; unsigned char* ws; unsigned* ctl;
    unsigned char* lds;
    int tid, lane, wave, G, bid;
};
#define WSP(T, off) ((T*)(F.ws + (off)))
DI void refresh(Frame& F) { int t = threadIdx.x; asm volatile("" : "+v"(t)); F.tid = t; F.lane = t & 63; F.wave = __builtin_amdgcn_readfirstlane(t >> 6);
}

namespace pg8 {
constexpr int BM = 256, BK = 64, HALF = 128, HTB = HALF * BK * 2, STAGE_BYTES = 8 * HTB, NXCD = 8, WGM = 8;
DI int lds_byte(int r, int c) { const int st = (r >> 4) * 2 + (c >> 5), rr = r & 15, cc = c & 31, ob = rr * 64 + cc * 2; return st * 1024 + (ob ^ (((ob >> 9) & 1) << 5)); }
DI void stage_rc(int b, int& R, int& C) { const int st = b / 1024, sb = b % 1024, swz = sb ^ (((sb >> 9) & 1) << 5); R = (st >> 1) * 16 + swz / 64; C = (st & 1) * 32 + (swz % 64) / 2; }
struct Unit { int pm, pn, e; };
struct Gemm { const bf16_t* A; const bf16_t* Bt; int K; size_t bstride; };
struct StaticOrder {
    int nM, nN, nwg, G, c;
    DI void init(int M, int N, int G_, int c_) { nM = M / BM; nN = N / BM; nwg = nM * nN; G = G_; c = c_; }
    DI bool next(int i, Unit& u) const {
        const long L = (long)i * G + c; if (L >= nwg) return false;
        int wgid = (int)L; { const int q = nwg / NXCD, r = nwg % NXCD, xcd = wgid % NXCD, off = wgid / NXCD; wgid = (xcd < r ? xcd * (q + 1) : r * (q + 1) + (xcd - r) * q) + off; }
        const int nig = WGM * nN, gid = wgid / nig, fm = gid * WGM, gsz = (nM - fm) < WGM ? (nM - fm) : WGM;
        u.pm = fm + ((wgid % nig) % gsz); u.pn = (wgid % nig) / gsz; u.e = 0; return true;
    }
};
struct MoeOrder {
    const int* toff; int ntile, nN, G, c;
    DI bool next(int i, Unit& u) const {
        const long L = (long)i * G + c; if (L >= (long)ntile * nN) return false;
        const int t = (int)(L / nN); u.pm = t; u.pn = (int)(L % nN);
        u.e = toff[t]; return true;
    }
};

template <class Epi, class Sched>
DI void gemm_phase(LAS unsigned char* lds, const Gemm g, const Sched& S, const Epi& E, int tid) {
    const int wid = __builtin_amdgcn_readfirstlane(tid >> 6), lane = tid & 63, wr = wid >> 2, wc = wid & 3, fr = lane & 15, fq = lane >> 4;
    const int K = g.K, nt = K / BK;
    unsigned voffA[2];
#pragma unroll
    for (int i = 0; i < 2; ++i) { int R, C; stage_rc(tid * 16 + i * 8192, R, C); voffA[i] = (unsigned)(R * K + C) * 2u; }
    const size_t kstep = (size_t)(BK * 2);
    const size_t hstep = (size_t)HALF * K * 2;
    const size_t tstep = 2 * hstep;
    const unsigned ldsw = (unsigned)wid * 1024u;
    const int aoff = lds_byte(wr * 64 + fr, fq * 8), boff = lds_byte(wc * 32 + fr, fq * 8);
#define PG8_SA(b, h) (((b) * 2 + (h)) * HTB)
#define PG8_SB(b, h) ((4 + (b) * 2 + (h)) * HTB)
#define PG8_STAGE(bufoff, gbase, voff) do { _Pragma("unroll") for (int _i = 0; _i < 2; ++_i) \
        __builtin_amdgcn_global_load_lds((const unsigned*)((const char*)(gbase) + (voff)[_i]), (LAS unsigned*)(lds + (bufoff) + ldsw + _i * 8192), 16, 0, 0); } while (0)
#define PG8_LDA(dst, b, h) do { _Pragma("unroll") for (int m = 0; m < 4; ++m) _Pragma("unroll") for (int k = 0; k < 2; ++k) dst[m][k] = *(const LAS bf16x8*)(lds + PG8_SA(b, h) + aoff + m * 2048 + k * 1024); } while (0)
#define PG8_LDB(dst, b, h) do { _Pragma("unroll") for (int n = 0; n < 2; ++n) _Pragma("unroll") for (int k = 0; k < 2; ++k) dst[n][k] = *(const LAS bf16x8*)(lds + PG8_SB(b, h) + boff + n * 2048 + k * 1024); } while (0)
#define PG8_MMA(ai, bj, At, Bt) do { __builtin_amdgcn_s_setprio(1); _Pragma("unroll") for (int m = 0; m < 4; ++m) _Pragma("unroll") for (int n = 0; n < 2; ++n) _Pragma("unroll") for (int k = 0; k < 2; ++k) \
        acc[ai][bj][m][n] = __builtin_amdgcn_mfma_f32_16x16x32_bf16(Bt[n][k], At[m][k], acc[ai][bj][m][n], 0, 0, 0); __builtin_amdgcn_s_setprio(0); } while (0)
#define PG8_WAIT_V(n) asm volatile("s_waitcnt vmcnt(" #n ")" ::: "memory")
#define PG8_WAIT_L(n) asm volatile("s_waitcnt lgkmcnt(" #n ")" ::: "memory")
#define PG8_BAR __builtin_amdgcn_s_barrier()
#define PG8_SCHED __builtin_amdgcn_sched_barrier(0)
    Unit cur, nxt; int ui = 0;
    if (!S.next(0, cur)) return;
    f32x4 acc[2][2][4][2];
#pragma unroll
    for (int a = 0; a < 2; ++a)
#pragma unroll
        for (int b = 0; b < 2; ++b)
#pragma unroll
            for (int m = 0; m < 4; ++m)
#pragma unroll
                for (int n = 0; n < 2; ++n) acc[a][b][m][n] = (f32x4){0.f, 0.f, 0.f, 0.f};
    bf16x8 At[4][2], B0[2][2], B1[2][2];
    const char* cA = (const char*)g.A + (size_t)cur.pm * tstep; const char* cB = (const char*)(g.Bt + (size_t)cur.e * g.bstride) + (size_t)cur.pn * tstep;
    PG8_STAGE(PG8_SB(0, 0), cB, voffA); PG8_STAGE(PG8_SA(0, 0), cA, voffA); PG8_STAGE(PG8_SB(0, 1), cB + hstep, voffA); PG8_STAGE(PG8_SA(0, 1), cA + hstep, voffA);
    if (wr == 1) PG8_BAR;
    PG8_WAIT_V(4); PG8_BAR;
    PG8_STAGE(PG8_SB(1, 0), cB + kstep, voffA); PG8_STAGE(PG8_SA(1, 0), cA + kstep, voffA); PG8_STAGE(PG8_SB(1, 1), cB + hstep + kstep, voffA);
    PG8_WAIT_V(6); PG8_BAR;
    for (;;) {
        const bool has_next = S.next(ui + 1, nxt);
        const char* nA = has_next ? (const char*)g.A + (size_t)nxt.pm * tstep : cA; const char* nB = has_next ? (const char*)(g.Bt + (size_t)nxt.e * g.bstride) + (size_t)nxt.pn * tstep : cB;
        for (int t = 0; t < nt; t += 2) {
            const bool last = (t == nt - 2);
            const char* a1 = cA + (size_t)(t + 1) * kstep;
            const char* a2 = last ? nA : cA + (size_t)(t + 2) * kstep; const char* b2 = last ? nB : cB + (size_t)(t + 2) * kstep;
            const char* a3 = a2 + kstep; const char* b3 = b2 + kstep;
            PG8_LDB(B0, 0, 0); PG8_SCHED; PG8_LDA(At, 0, 0); PG8_STAGE(PG8_SA(1, 1), a1 + hstep, voffA);
            PG8_WAIT_L(8); PG8_BAR; PG8_WAIT_L(0); PG8_MMA(0, 0, At, B0); PG8_BAR; PG8_SCHED;
            PG8_LDB(B1, 0, 1); PG8_STAGE(PG8_SB(0, 0), b2, voffA);
            PG8_BAR; PG8_WAIT_L(0); PG8_MMA(0, 1, At, B1); PG8_BAR;
            PG8_LDA(At, 0, 1); PG8_STAGE(PG8_SA(0, 0), a2, voffA);
            PG8_BAR; PG8_WAIT_L(0); PG8_MMA(1, 0, At, B0); PG8_BAR; PG8_SCHED;
            PG8_STAGE(PG8_SB(0, 1), b2 + hstep, voffA);
            PG8_WAIT_V(6); PG8_BAR; PG8_MMA(1, 1, At, B1); PG8_BAR;
            PG8_LDB(B0, 1, 0); PG8_SCHED; PG8_LDA(At, 1, 0); PG8_STAGE(PG8_SA(0, 1), a2 + hstep, voffA);
            PG8_WAIT_L(8); PG8_BAR; PG8_WAIT_L(0); PG8_MMA(0, 0, At, B0); PG8_BAR; PG8_SCHED;
            PG8_LDB(B1, 1, 1); PG8_STAGE(PG8_SB(1, 0), b3, voffA);
            PG8_BAR; PG8_WAIT_L(0); PG8_MMA(0, 1, At, B1); PG8_BAR;
            PG8_LDA(At, 1, 1); PG8_STAGE(PG8_SA(1, 0), a3, voffA);
            PG8_BAR; PG8_WAIT_L(0); PG8_MMA(1, 0, At, B0); PG8_BAR; PG8_SCHED;
            PG8_STAGE(PG8_SB(1, 1), b3 + hstep, voffA);
            PG8_WAIT_V(6); PG8_BAR; PG8_MMA(1, 1, At, B1); PG8_BAR;
        }
        E(acc, cur, wr, wc, fr, fq);
        if (!has_next) break;
#pragma unroll
        for (int a = 0; a < 2; ++a)
#pragma unroll
            for (int b = 0; b < 2; ++b)
#pragma unroll
                for (int m = 0; m < 4; ++m)
#pragma unroll
                    for (int n = 0; n < 2; ++n) acc[a][b][m][n] = (f32x4){0.f, 0.f, 0.f, 0.f};
        cur = nxt; cA = nA; cB = nB; ++ui;
    }
    PG8_WAIT_V(0);
    if (wr == 0) PG8_BAR;
    PG8_BAR;
#undef PG8_SA
#undef PG8_SB
#undef PG8_STAGE
#undef PG8_LDA
#undef PG8_LDB
#undef PG8_MMA
#undef PG8_WAIT_V
#undef PG8_WAIT_L
#undef PG8_BAR
#undef PG8_SCHED
}
}

typedef f32x4 AccT[2][2][4][2];

struct EpiIn {
    unsigned char* ws; const float* rope; unsigned* kmax; unsigned* kmaxb;
    DI void operator()(const AccT& acc, const pg8::Unit& u, int wr, int wc, int fr, int fq) const {
        const int pn = u.pn, row0 = u.pm * 256 + wr * 64 + fr;
        const bool isctx = (u.pm >= NLAT / 256);
        if (pn <= 1) {
            bf16_t* dst = (bf16_t*)(ws + (pn == 0 ? WS_AQ : WS_AK));
            const float sc = (pn == 0) ? QSCALE_A : 1.f;
            float nmax[2] = {0.f, 0.f};
#pragma unroll
            for (int ai = 0; ai < 2; ++ai)
#pragma unroll
                for (int m = 0; m < 4; ++m) {
                    const int r = row0 + ai * 128 + m * 16;
                    f32x4 cs0 = (f32x4){1.f, 0.f, 1.f, 0.f}, cs1 = cs0;
                    if (!isctx) { const int t = r & (S - 1); const int pos = (fq < 2) ? (t >> 6) : (t & 63);
                        const f32x4* tp = (const f32x4*)(rope + (size_t)pos * 16 + (fq & 1) * 8); cs0 = tp[0]; cs1 = tp[1]; }
                    const float cc[4] = {cs0[0], cs0[2], cs1[0], cs1[2]}, ss[4] = {cs0[1], cs0[3], cs1[1], cs1[3]};
#pragma unroll
                    for (int bj = 0; bj < 2; ++bj) {
                        const f32x4 x1 = acc[ai][bj][m][0], x2 = acc[ai][bj][m][1];
                        float o1[4], o2[4], n2 = 0.f;
#pragma unroll
                        for (int j = 0; j < 4; ++j) { o1[j] = (x1[j] * cc[j] - x2[j] * ss[j]) * sc; o2[j] = (x2[j] * cc[j] + x1[j] * ss[j]) * sc; n2 += x1[j] * x1[j] + x2[j] * x2[j]; }
                        bf16_t* p = dst + (size_t)r * 256 + bj * 128 + wc * 32 + 4 * fq;
                        *(u32x2*)p = (u32x2){pk2(o1[0], o1[1]), pk2(o1[2], o1[3])};
                        *(u32x2*)(p + 16) = (u32x2){pk2(o2[0], o2[1]), pk2(o2[2], o2[3])};
                        if (pn == 1) { n2 += swz_xor<16>(n2); n2 = half_sum(n2); nmax[bj] = fmaxf(nmax[bj], n2); }
                    }
                }
            if (pn == 1) {
                const int b = isctx ? (u.pm - NLAT / 256) : (u.pm / (S / 256));
#pragma unroll
                for (int bj = 0; bj < 2; ++bj) {
                    float v = nmax[bj];
                    v = fmaxf(v, swz_xor<1>(v)); v = fmaxf(v, swz_xor<2>(v)); v = fmaxf(v, swz_xor<4>(v)); v = fmaxf(v, swz_xor<8>(v));
                    if ((fr | fq) == 0) atomicMax(kmax + (b * 4 + (2 * bj + (wc >> 1))) * 2 + (wc & 1), __float_as_uint(v));
                }
            }
        } else if (pn == 2 || pn == 5) {
            bf16_t* dst = (bf16_t*)(ws + (pn == 2 ? WS_AVT : WS_BVT));
#pragma unroll
            for (int ai = 0; ai < 2; ++ai)
#pragma unroll
                for (int m = 0; m < 4; ++m) {
                    const int r = row0 + ai * 128 + m * 16;
                    int b, key; if (isctx) { b = (r - NLAT) >> 8; key = (r - NLAT) & 255; } else { b = r >> 14; key = CTX + (r & (S - 1)); }
#pragma unroll
                    for (int bj = 0; bj < 2; ++bj)
#pragma unroll
                        for (int n = 0; n < 2; ++n) {
                            const int lc = bj * 128 + wc * 32 + n * 16 + 4 * fq;
#pragma unroll
                            for (int j = 0; j < 4; ++j) dst[((size_t)(b * 256 + lc + j)) * NKEY + key] = f2bf(acc[ai][bj][m][n][j]);
                        }
                }
        } else if (pn <= 6) {
            bf16_t* dst = (bf16_t*)(ws + (pn == 3 ? WS_BQ : pn == 4 ? WS_BK : WS_PL));
            const float sc = (pn == 3) ? QSCALE_B : 1.f;
            float nmax[2] = {0.f, 0.f};
#pragma unroll
            for (int ai = 0; ai < 2; ++ai)
#pragma unroll
                for (int m = 0; m < 4; ++m) {
                    const int r = row0 + ai * 128 + m * 16;
#pragma unroll
                    for (int bj = 0; bj < 2; ++bj)
#pragma unroll
                        for (int n = 0; n < 2; ++n) {
                            const f32x4 v = acc[ai][bj][m][n] * sc;
                            *(u32x2*)(dst + (size_t)r * 256 + bj * 128 + wc * 32 + n * 16 + 4 * fq) = (u32x2){pk2(v[0], v[1]), pk2(v[2], v[3])};
                        }
                    if (pn == 4) {
#pragma unroll
                        for (int bj = 0; bj < 2; ++bj) { const f32x4 x1 = acc[ai][bj][m][0], x2 = acc[ai][bj][m][1];
                            float n2 = x1[0] * x1[0] + x1[1] * x1[1] + x1[2] * x1[2] + x1[3] * x1[3] + x2[0] * x2[0] + x2[1] * x2[1] + x2[2] * x2[2] + x2[3] * x2[3];
                            n2 += swz_xor<16>(n2); n2 = half_sum(n2); nmax[bj] = fmaxf(nmax[bj], n2); }
                    }
                }
            if (pn == 4) {
                const int b = isctx ? (u.pm - NLAT / 256) : (u.pm / (S / 256));
#pragma unroll
                for (int bj = 0; bj < 2; ++bj) {
                    float v = nmax[bj];
                    v = fmaxf(v, swz_xor<1>(v)); v = fmaxf(v, swz_xor<2>(v)); v = fmaxf(v, swz_xor<4>(v)); v = fmaxf(v, swz_xor<8>(v));
                    if ((fr | fq) == 0) atomicMax(kmaxb + (b * 4 + (2 * bj + (wc >> 1))) * 2 + (wc & 1), __float_as_uint(v));
                }
            }
        } else {
            const int hc0 = (pn - 7) * 256;
#pragma unroll
            for (int ai = 0; ai < 2; ++ai)
#pragma unroll
                for (int m = 0; m < 4; ++m) {
                    const int r = row0 + ai * 128 + m * 16;
#pragma unroll
                    for (int bj = 0; bj < 2; ++bj)
#pragma unroll
                        for (int n = 0; n < 2; ++n) {
                            const int hc = hc0 + bj * 128 + wc * 32 + n * 16 + 4 * fq; const f32x4 v = acc[ai][bj][m][n];
                            if (isctx) *(u32x2*)((bf16_t*)(ws + WS_HYC) + (size_t)(r - NLAT) * 768 + hc) = (u32x2){pk2(v[0], v[1]), pk2(v[2], v[3])};
                            else { bf16_t* dst = (bf16_t*)(ws + WS_HYT) + ((size_t)(r >> 14) * 768 + hc) * S + (r & (S - 1));
#pragma unroll
                                for (int j = 0; j < 4; ++j) dst[(size_t)j * S] = f2bf(v[j]); }
                        }
                }
        }
    }
};

struct EpiOut {
    const float* xl_old; const float* xc_old; float* xl_new; float* xc_new; const float* mod;
    DI void operator()(const AccT& acc, const pg8::Unit& u, int wr, int wc, int fr, int fq) const {
        const int row0 = u.pm * 256 + wr * 64 + fr; const bool isctx = (u.pm >= NLAT / 256);
        const int v = isctx ? 2 : (u.pm / (S / 256));
        const float* g1 = mod + (size_t)v * 6144 + 2 * 1024;
        const float* so = isctx ? xc_old - (size_t)NLAT * D : xl_old; float* dn = isctx ? xc_new - (size_t)NLAT * D : xl_new;
#pragma unroll
        for (int bj = 0; bj < 2; ++bj)
#pragma unroll
            for (int n = 0; n < 2; ++n) {
                const int c = u.pn * 256 + bj * 128 + wc * 32 + n * 16 + 4 * fq;
                const f32x4 g = *(const f32x4*)(g1 + c);
#pragma unroll
                for (int ai = 0; ai < 2; ++ai)
#pragma unroll
                    for (int m = 0; m < 4; ++m) {
                        const size_t o = (size_t)(row0 + ai * 128 + m * 16) * D + c;
                        *(f32x4*)(dn + o) = *(const f32x4*)(so + o) + g * acc[ai][bj][m][n];
                    }
            }
    }
};

struct EpiMoe1 {
    bf16_t* hmid;
    DI void operator()(const AccT& acc, const pg8::Unit& u, int wr, int wc, int fr, int fq) const {
        const int row0 = u.pm * 256 + wr * 64 + fr;
#pragma unroll
        for (int ai = 0; ai < 2; ++ai)
#pragma unroll
            for (int m = 0; m < 4; ++m)
#pragma unroll
                for (int bj = 0; bj < 2; ++bj) {
                    const f32x4 a = acc[ai][bj][m][0], b = acc[ai][bj][m][1]; float h[4];
#pragma unroll
                    for (int j = 0; j < 4; ++j) h[j] = siluf(a[j]) * b[j];
                    *(u32x2*)(hmid + (size_t)(row0 + ai * 128 + m * 16) * DE + (u.pn * 256 + bj * 128 + wc * 32) / 2 + 4 * fq) = (u32x2){pk2(h[0], h[1]), pk2(h[2], h[3])};
                }
    }
};
struct EpiMoe2 {
    bf16_t* ys;
    DI void operator()(const AccT& acc, const pg8::Unit& u, int wr, int wc, int fr, int fq) const {
        const int row0 = u.pm * 256 + wr * 64 + fr;
#pragma unroll
        for (int ai = 0; ai < 2; ++ai)
#pragma unroll
            for (int m = 0; m < 4; ++m)
#pragma unroll
                for (int bj = 0; bj < 2; ++bj)
#pragma unroll
                    for (int n = 0; n < 2; ++n) { const f32x4 v = acc[ai][bj][m][n];
                        *(u32x2*)(ys + (size_t)(row0 + ai * 128 + m * 16) * D + u.pn * 256 + bj * 128 + wc * 32 + n * 16 + 4 * fq) = (u32x2){pk2(v[0], v[1]), pk2(v[2], v[3])}; }
    }
};

DI void tconv_tile(const Frame& F, const float* src, int N, int k0, int n0, bf16_t* dst, int ldd, int mode) {
    float* tl = (float*)F.lds;
    __syncthreads();
#pragma unroll
    for (int i = 0; i < 8; ++i) { const int idx = F.tid + 512 * i, k = idx >> 6, n = idx & 63; tl[k * 65 + n] = src[(size_t)(k0 + k) * N + n0 + n]; }
    __syncthreads();
#pragma unroll
    for (int i = 0; i < 4; ++i) { const int idx = F.tid + 512 * i, n = idx >> 5, kp = idx & 31;
        const int nn = n0 + n; const int row = (mode == 0) ? nn : ((nn >> 4) * 32 + (mode - 1) * 16 + (nn & 15));
        *(unsigned*)(dst + (size_t)row * ldd + k0 + 2 * kp) = pk2(tl[(2 * kp) * 65 + n], tl[(2 * kp + 1) * 65 + n]); }
}
DI void phase_prologue(const Frame& F) {
    const int T_IN = 16 * 40, T_OUT = 16 * 16, T_E = 16 * 8;
    const int per_layer = T_IN + T_OUT + NE * 3 * T_E, total = 2 * per_layer;
    for (int u = F.bid; u < total; u += F.G) {
        const int li = u / per_layer; int r = u % per_layer;
        if (r < T_IN) { tconv_tile(F, F.in[I_WIN] + (size_t)li * D * DIN, DIN, (r / 40) * 64, (r % 40) * 64, WSP(bf16_t, WS_WIN) + (size_t)li * DIN * D, D, 0); continue; }
        r -= T_IN;
        if (r < T_OUT) { tconv_tile(F, F.in[I_WOUT] + (size_t)li * D * D, D, (r / 16) * 64, (r % 16) * 64, WSP(bf16_t, WS_WOUT) + (size_t)li * D * D, D, 0); continue; }
        r -= T_OUT;
        const int e = r / (3 * T_E), w = (r / T_E) % 3, t = r % T_E;
        if (w < 2) tconv_tile(F, F.in[w == 0 ? I_MW1 : I_MW3] + ((size_t)li * NE + e) * D * DE, DE, (t / 8) * 64, (t % 8) * 64, WSP(bf16_t, WS_W13) + ((size_t)li * NE + e) * 1024 * 1024, D, 1 + w);
        else tconv_tile(F, F.in[I_MW2] + ((size_t)li * NE + e) * DE * D, D, (t / 16) * 64, (t % 16) * 64, WSP(bf16_t, WS_W2) + ((size_t)li * NE + e) * 1024 * 512, DE, 0);
    }
    __syncthreads();
    {
        float* sc = (float*)F.lds;
        float* red = sc + 3072;
        for (int i = F.tid; i < 3072; i += NTHR) { const int v = i >> 10, k = i & 1023; const float x = (v < 2) ? F.in[I_C][v * 1024 + k] : F.in[I_CCTX][k]; sc[i] = siluf(x); }
        __syncthreads();
        for (int u = F.bid; u < 2 * 96; u += F.G) {
            const int li = u / 96, j = (u % 96) * 64 + F.lane, ko = F.wave;
            const float* w = F.in[I_ADAW] + (size_t)li * D * 6144 + j;
            float a0 = 0.f, a1 = 0.f, a2 = 0.f;
            for (int k = ko * 128; k < ko * 128 + 128; ++k) { const float wv = w[(size_t)k * 6144]; a0 += sc[k] * wv; a1 += sc[1024 + k] * wv; a2 += sc[2048 + k] * wv; }
            red[(ko * 3 + 0) * 64 + F.lane] = a0; red[(ko * 3 + 1) * 64 + F.lane] = a1; red[(ko * 3 + 2) * 64 + F.lane] = a2;
            __syncthreads();
            if (F.tid < 192) { const int v = F.tid / 64, l = F.tid % 64; float s = 0.f;
#pragma unroll
                for (int q = 0; q < 8; ++q) s += red[(q * 3 + v) * 64 + l];
                const int jj = (u % 96) * 64 + l;
                WSP(float, WS_MOD)[((size_t)li * 3 + v) * 6144 + jj] = s + F.in[I_ADAB][li * 6144 + jj]; }
            __syncthreads();
        }
    }
    if (F.bid == (F.G > 1 ? 1 : 0)) {
        for (int i = F.tid; i < 256 * 8; i += NTHR) { const int pos = i >> 3, f = i & 7; const float inv = exp2f(-(float)f * (13.287712379549449f / 8.f)); const float rev = (float)pos * inv * 0.15915494309189535f;
            WSP(float, WS_ROPE)[i * 2] = cos_rev(rev); WSP(float, WS_ROPE)[i * 2 + 1] = sin_rev(rev); }
    }
}

DI void filter_tile(const Frame& F, int li, int L, int tile, float* hT, float* part) {
    float* h1s = (float*)F.lds;
    float* h2s = h1s + 4096;
    float* stg = h2s + 4096;
    float* sq2 = stg + 256 * 65;
    const float* w1 = F.in[I_HW1] + (size_t)li * 33 * 64; const float* b1 = F.in[I_HB1] + li * 64;
    const float* w2 = F.in[I_HW2] + (size_t)li * 64 * 64; const float* b2 = F.in[I_HB2] + li * 64;
    const float* w3 = F.in[I_HW3] + (size_t)li * 64 * 1024; const float* b3 = F.in[I_HB3] + li * 1024;
    const int t0 = tile * 64;
    const float inv_lm1 = 1.f / (float)(L > 1 ? L - 1 : 1);
    __syncthreads();
    {
        const int tl = F.tid & 63, pt = F.tid >> 6; const float t = (float)(t0 + tl);
        float a[8];
#pragma unroll
        for (int jj = 0; jj < 8; ++jj) a[jj] = b1[pt * 8 + jj] + (t * inv_lm1) * w1[pt * 8 + jj];
#pragma unroll 1
        for (int i = 0; i < 16; ++i) { const float band = 1e-4f + (15.f - 1e-4f) * (float)i / 15.f; const float rev = t * band / (float)L; const float cz = cos_rev(rev), sz = sin_rev(rev);
#pragma unroll
            for (int jj = 0; jj < 8; ++jj) a[jj] += cz * w1[(1 + i) * 64 + pt * 8 + jj] + sz * w1[(17 + i) * 64 + pt * 8 + jj]; }
#pragma unroll
        for (int jj = 0; jj < 8; ++jj) h1s[tl * 64 + pt * 8 + jj] = sin_rad(a[jj]);
    }
    __syncthreads();
    {
        const int tl = F.tid & 63, pt = F.tid >> 6;
        float a[8];
#pragma unroll
        for (int jj = 0; jj < 8; ++jj) a[jj] = b2[pt * 8 + jj];
#pragma unroll 1
        for (int i = 0; i < 64; ++i) { const float hv = h1s[tl * 64 + i];
#pragma unroll
            for (int jj = 0; jj < 8; ++jj) a[jj] += hv * w2[i * 64 + pt * 8 + jj]; }
#pragma unroll
        for (int jj = 0; jj < 8; ++jj) h2s[tl * 64 + pt * 8 + jj] = sin_rad(a[jj]);
    }
    __syncthreads();
    const int c = F.tid & 255, th = F.tid >> 8;
    const float delta = 3.0701134573253945f + (15.350567286626973f - 3.0701134573253945f) * (float)c / 255.f;
#pragma unroll 1
    for (int cc = 0; cc < 4; ++cc) {
        float wr[64];
#pragma unroll
        for (int i = 0; i < 64; ++i) wr[i] = w3[(size_t)i * 1024 + cc * 256 + c];
        const float bb = b3[cc * 256 + c]; float sq = 0.f;
#pragma unroll 1
        for (int tt = th * 32; tt < th * 32 + 32; ++tt) {
            float a = bb;
#pragma unroll
            for (int i = 0; i < 64; ++i) a += h2s[tt * 64 + i] * wr[i];
            a *= __expf(-((float)(t0 + tt) * inv_lm1) * delta);
            stg[c * 65 + tt] = a; sq += a * a;
        }
        if (th == 1) sq2[c] = sq;
        __syncthreads();
        if (th == 0) part[(size_t)tile * 1024 + cc * 256 + c] = sq + sq2[c];
        for (int ch = F.wave * 32; ch < F.wave * 32 + 32; ++ch) hT[((size_t)cc * 256 + ch) * L + t0 + F.lane] = stg[ch * 65 + F.lane];
        __syncthreads();
    }
}

struct TokInfo { unsigned e0, e1, p0, p1; float g0, g1; unsigned s0, s1; };
DI void phase_norm1(const Frame& F, int li, int mode) {
    const int nrows = (mode == 2) ? NLAT : NTOK;
    const float* modp = WSP(float, WS_MOD) + (size_t)li * 3 * 6144;
    const float* modprev = WSP(float, WS_MOD) + (size_t)(mode == 2 ? 1 : li - 1) * 3 * 6144;
    const float* gam = (mode == 2) ? F.in[I_FG] : F.in[I_N1G] + (size_t)li * D;
    const TokInfo* tok = WSP(TokInfo, WS_TOK); const bf16_t* ys = WSP(bf16_t, WS_A1);
    bf16_t* hbf = WSP(bf16_t, WS_HBF);
    auto xrowp = [&](int r) -> float* { return r >= NLAT ? WSP(float, WS_XC) + (size_t)(r - NLAT) * D : F.out + (size_t)r * D; };
    auto srcp = [&](int r) -> const float* { return (mode == 0) ? (r >= NLAT ? F.in[I_CTX] + (size_t)(r - NLAT) * D : F.in[I_X] + (size_t)r * D) : (const float*)xrowp(r); };
    const int r0 = F.bid * 8 + F.wave, rstep = F.G * 8, lc = F.lane * 4;
    f32x4 xn[4]; u32x2 yan[4], ybn[4]; TokInfo t1 = {}, t2 = {};
    if (r0 < nrows) {
#pragma unroll
        for (int i = 0; i < 4; ++i) xn[i] = *(const f32x4*)(srcp(r0) + i * 256 + lc);
        if (mode != 0) { t1 = tok[r0]; if (r0 + rstep < nrows) t2 = tok[r0 + rstep];
#pragma unroll
            for (int i = 0; i < 4; ++i) { yan[i] = *(const u32x2*)(ys + (size_t)t1.s0 * D + i * 256 + lc); ybn[i] = *(const u32x2*)(ys + (size_t)t1.s1 * D + i * 256 + lc); } }
    }
    for (int r = r0; r < nrows; r += rstep) {
        const bool isctx = r >= NLAT; const int v = isctx ? 2 : (r >> 14);
        f32x4 x[4]; u32x2 ya[4], yb[4]; const TokInfo ti = t1;
#pragma unroll
        for (int i = 0; i < 4; ++i) { x[i] = xn[i]; ya[i] = yan[i]; yb[i] = ybn[i]; }
        if (r + rstep < nrows) {
#pragma unroll
            for (int i = 0; i < 4; ++i) xn[i] = *(const f32x4*)(srcp(r + rstep) + i * 256 + lc);
            if (mode != 0) { t1 = t2; if (r + 2 * rstep < nrows) t2 = tok[r + 2 * rstep];
#pragma unroll
                for (int i = 0; i < 4; ++i) { yan[i] = *(const u32x2*)(ys + (size_t)t1.s0 * D + i * 256 + lc); ybn[i] = *(const u32x2*)(ys + (size_t)t1.s1 * D + i * 256 + lc); } }
        }
        if (mode != 0) {
            const float* g2 = modprev + (size_t)v * 6144 + 5 * 1024;
#pragma unroll
            for (int i = 0; i < 4; ++i) {
                const u32x2 a = ya[i], b = yb[i];
                const f32x4 gg = *(const f32x4*)(g2 + i * 256 + lc);
                f32x4 y;
                y[0] = ti.g0 * __uint_as_float(a[0] << 16) + ti.g1 * __uint_as_float(b[0] << 16);
                y[1] = ti.g0 * __uint_as_float(a[0] & 0xffff0000u) + ti.g1 * __uint_as_float(b[0] & 0xffff0000u);
                y[2] = ti.g0 * __uint_as_float(a[1] << 16) + ti.g1 * __uint_as_float(b[1] << 16);
                y[3] = ti.g0 * __uint_as_float(a[1] & 0xffff0000u) + ti.g1 * __uint_as_float(b[1] & 0xffff0000u);
                x[i] = x[i] + gg * y;
            }
            if (mode == 1) { float* xrow = xrowp(r);
#pragma unroll
                for (int i = 0; i < 4; ++i) *(f32x4*)(xrow + i * 256 + lc) = x[i]; }
        }
        float ss = 0.f;
#pragma unroll
        for (int i = 0; i < 4; ++i) ss += x[i][0] * x[i][0] + x[i][1] * x[i][1] + x[i][2] * x[i][2] + x[i][3] * x[i][3];
        ss = wave_sum(ss);
        const float rstd = rsqrtf(ss * (1.f / D) + EPS);
#pragma unroll
        for (int i = 0; i < 4; ++i) {
            const int c = i * 256 + lc;
            const f32x4 g = *(const f32x4*)(gam + c);
            if (mode == 2) { *(f32x4*)(F.out + (size_t)r * D + c) = x[i] * rstd * g; }
            else {
                const f32x4 sh = *(const f32x4*)(modp + (size_t)v * 6144 + c), sc = *(const f32x4*)(modp + (size_t)v * 6144 + 1024 + c);
                const f32x4 h = x[i] * rstd * g * (sc + 1.f) + sh;
                *(u32x2*)(hbf + (size_t)r * D + c) = (u32x2){pk2(h[0], h[1]), pk2(h[2], h[3])};
            }
        }
    }
}

DI void phase_norm2(const Frame& F, int li, int nrows) {
    float* wt = (float*)F.lds;
    __syncthreads();
    for (int i = F.tid; i < 16384; i += NTHR) { const int k = i >> 4, e = i & 15; wt[e * 1024 + k] = F.in[I_RW][i]; }
    __syncthreads();
    const float* modp = WSP(float, WS_MOD) + (size_t)li * 3 * 6144;
    const float* gam = F.in[I_N2G] + (size_t)li * D;
    bf16_t* hbf = WSP(bf16_t, WS_HBF); TokInfo* tok = WSP(TokInfo, WS_TOK);
    unsigned* lcnt = (unsigned*)(F.lds + LDS_MISC + 64);
    if (F.tid < 16) lcnt[F.tid] = 0u;
    __syncthreads();
    auto rowp = [&](int r) -> const float* { return r >= NLAT ? WSP(float, WS_XC) + (size_t)(r - NLAT) * D : F.out + (size_t)r * D; };
    const int r_first = F.bid * 8 + F.wave, rstep = F.G * 8;
    f32x4 xn[4];
    if (r_first < nrows) {
#pragma unroll
        for (int i = 0; i < 4; ++i) xn[i] = *(const f32x4*)(rowp(r_first) + i * 256 + F.lane * 4);
    }
    const bool b2 = (F.lane & 4) != 0, b3 = (F.lane & 8) != 0, b4 = (F.lane & 16) != 0;
    for (int r = r_first; r < nrows; r += rstep) {
        const bool isctx = r >= NLAT; const int v = isctx ? 2 : (r >> 14);
        f32x4 x[4]; float ss = 0.f;
#pragma unroll
        for (int i = 0; i < 4; ++i) { x[i] = xn[i]; ss += x[i][0] * x[i][0] + x[i][1] * x[i][1] + x[i][2] * x[i][2] + x[i][3] * x[i][3]; }
        if (r + rstep < nrows) {
#pragma unroll
            for (int i = 0; i < 4; ++i) xn[i] = *(const f32x4*)(rowp(r + rstep) + i * 256 + F.lane * 4);
        }
        ss = wave_sum(ss);
        const float rstd = rsqrtf(ss * (1.f / D) + EPS);
        float lg[16];
#pragma unroll
        for (int e = 0; e < 16; ++e) lg[e] = 0.f;
#pragma unroll
        for (int i = 0; i < 4; ++i) {
            const int c = i * 256 + F.lane * 4;
            const f32x4 g = *(const f32x4*)(gam + c), sh = *(const f32x4*)(modp + (size_t)v * 6144 + 3 * 1024 + c), sc = *(const f32x4*)(modp + (size_t)v * 6144 + 4 * 1024 + c);
            const f32x4 h = x[i] * rstd * g * (sc + 1.f) + sh;
            *(u32x2*)(hbf + (size_t)r * D + c) = (u32x2){pk2(h[0], h[1]), pk2(h[2], h[3])};
#pragma unroll
            for (int e = 0; e < 16; ++e) { const f32x4 w = *(const f32x4*)(wt + e * 1024 + c); lg[e] += h[0] * w[0] + h[1] * w[1] + h[2] * w[2] + h[3] * w[3]; }
        }
        float a8[8], a4[4], a2[2];
#pragma unroll
        for (int e = 0; e < 8; ++e) { const auto rr = __builtin_amdgcn_permlane32_swap(__float_as_uint(lg[e]), __float_as_uint(lg[e + 8]), false, false); a8[e] = __uint_as_float(rr[0]) + __uint_as_float(rr[1]); }
#pragma unroll
        for (int e = 0; e < 4; ++e) { const float keep = b4 ? a8[e + 4] : a8[e], send = b4 ? a8[e] : a8[e + 4]; a4[e] = keep + swz_xor<16>(send); }
#pragma unroll
        for (int e = 0; e < 2; ++e) { const float keep = b3 ? a4[e + 2] : a4[e], send = b3 ? a4[e] : a4[e + 2]; a2[e] = keep + swz_xor<8>(send); }
        float a1 = (b2 ? a2[1] : a2[0]) + swz_xor<4>(b2 ? a2[0] : a2[1]);
        a1 += swz_xor<2>(a1); a1 += swz_xor<1>(a1);
#pragma unroll
        for (int e = 0; e < 16; ++e) lg[e] = __int_as_float(__builtin_amdgcn_readlane(__float_as_int(a1), 4 * e));
        float mx = lg[0];
#pragma unroll
        for (int e = 1; e < 16; ++e) mx = fmaxf(mx, lg[e]);
        float sc[16], sel[16], den = 0.f;
#pragma unroll
        for (int e = 0; e < 16; ++e) { sc[e] = __expf(lg[e] - mx); den += sc[e]; }
        const float rden = 1.f / den;
#pragma unroll
        for (int e = 0; e < 16; ++e) { sc[e] *= rden; sel[e] = sc[e] + F.in[I_RB][e]; }
        int bg = 0; float bgs = -1e30f;
#pragma unroll
        for (int g = 0; g < 4; ++g) {
            float m1 = -1e30f, m2 = -1e30f;
#pragma unroll
            for (int q = 0; q < 4; ++q) { const float s = sel[g * 4 + q]; if (s > m1) { m2 = m1; m1 = s; } else if (s > m2) m2 = s; }
            const float gs = m1 + m2; if (gs > bgs) { bgs = gs; bg = g; }
        }
        int e0 = 0, e1 = 0; float s0v = -1e30f, s1v = -1e30f, w0 = 0.f, w1 = 0.f;
#pragma unroll
        for (int e = 0; e < 16; ++e) {
            const bool ing = (e >> 2) == bg; const float s = sel[e];
            if (ing && s > s0v) { s1v = s0v; e1 = e0; w1 = w0; s0v = s; e0 = e; w0 = sc[e]; }
            else if (ing && s > s1v) { s1v = s; e1 = e; w1 = sc[e]; }
        }
        if (F.lane == 0) {
            TokInfo ti; ti.e0 = e0; ti.e1 = e1; ti.p0 = atomicAdd(lcnt + e0, 1u); ti.p1 = atomicAdd(lcnt + e1, 1u);
            const float ws = 1.f / (w0 + w1); ti.g0 = w0 * ws; ti.g1 = w1 * ws; ti.s0 = 0; ti.s1 = 0;
            tok[r] = ti;
        }
    }
    __syncthreads();
    if (F.tid < 16) F.ctl[CW_BCNT + (li * MAXG + F.bid) * 16 + F.tid] = lcnt[F.tid];
}

DI void moe_offsets(const Frame& F, int li, int* offs) {
    __syncthreads();
    int* tot = offs + 376;
    int* part = (int*)F.lds;
    {
        const int e = F.tid & 15, pq = F.tid >> 4;
        const unsigned* bc = F.ctl + CW_BCNT + li * MAXG * 16 + e;
        int st = 0, sb = 0;
#pragma unroll
        for (int k = 0; k < 8; ++k) { const int blk = pq * 8 + k; const int c = (blk < F.G) ? (int)__hip_atomic_load(bc + blk * 16, __ATOMIC_RELAXED, __HIP_MEMORY_SCOPE_AGENT) : 0; st += c; sb += (blk < F.bid) ? c : 0; }
        part[pq * 16 + e] = st; part[512 + pq * 16 + e] = sb;
    }
    __syncthreads();
    if (F.tid < 32) { const int e = F.tid & 15, wb = F.tid >> 4; int s = 0;
        for (int pq = 0; pq < 32; ++pq) s += part[wb * 512 + pq * 16 + e];
        if (wb) offs[360 + e] = s; else tot[e] = s; }
    __syncthreads();
    if (F.tid == 0) { int o = 0; for (int e = 0; e < NE; ++e) { offs[e] = o; offs[17 + e] = o >> 8; o += (tot[e] + 255) & ~255; }
        offs[16] = o; offs[17 + 16] = o >> 8; }
    __syncthreads();
    for (int t = F.tid; t < SLOT_CAP / 256; t += NTHR) { int e = 0; for (int k = 1; k < NE; ++k) e += (offs[17 + k] <= t) ? 1 : 0; offs[40 + t] = e; }
    if (F.tid < 16) offs[360 + F.tid] += offs[F.tid];
    __syncthreads();
}
DI void phase_gather(const Frame& F, int li, int nrows) {
    int* offs = (int*)(F.lds + LDS_MISC + 64);
    moe_offsets(F, li, offs);
    const bf16_t* hbf = WSP(bf16_t, WS_HBF); bf16_t* a1 = WSP(bf16_t, WS_A1); TokInfo* tok = WSP(TokInfo, WS_TOK);
    for (int r = F.bid * 8 + F.wave; r < nrows; r += F.G * 8) {
        TokInfo ti = tok[r];
        const unsigned s0 = offs[360 + ti.e0] + ti.p0, s1 = offs[360 + ti.e1] + ti.p1;
        const u32x4 a = *(const u32x4*)(hbf + (size_t)r * D + F.lane * 8), b = *(const u32x4*)(hbf + (size_t)r * D + 512 + F.lane * 8);
        *(u32x4*)(a1 + (size_t)s0 * D + F.lane * 8) = a; *(u32x4*)(a1 + (size_t)s0 * D + 512 + F.lane * 8) = b;
        *(u32x4*)(a1 + (size_t)s1 * D + F.lane * 8) = a; *(u32x4*)(a1 + (size_t)s1 * D + 512 + F.lane * 8) = b;
        if (F.lane == 0) { tok[r].s0 = s0; tok[r].s1 = s1; }
    }
}

#define MFMA32(a, b, c) __builtin_amdgcn_mfma_f32_32x32x16_bf16((a), (b), (c), 0, 0, 0)
DI float lam_of(const Frame& F, int li, float& lam_init) {
    const float* lv = F.in[I_ALAM] + (size_t)li * 128;
    const int i = F.lane & 31, hi = F.lane >> 5;
    float d = lv[hi * 64 + i] * lv[hi * 64 + 32 + i];
    d += swz_xor<16>(d); d += swz_xor<8>(d); d += swz_xor<4>(d); d += swz_xor<2>(d); d += swz_xor<1>(d);
    const float d0 = __int_as_float(__builtin_amdgcn_readlane(__float_as_int(d), 0)), d1 = __int_as_float(__builtin_amdgcn_readlane(__float_as_int(d), 32));
    float lif = (float)li; asm volatile("" : "+v"(lif));
    lam_init = 0.8f - 0.6f * __expf(-0.3f * lif);
    return __expf(d0) - __expf(d1) + lam_init;
}
DI bf16x8 pack8(const f32x16& x, int s) {
    u32x4 p; p[0] = pk2(x[8 * s], x[8 * s + 1]); p[1] = pk2(x[8 * s + 2], x[8 * s + 3]); p[2] = pk2(x[8 * s + 4], x[8 * s + 5]); p[3] = pk2(x[8 * s + 6], x[8 * s + 7]);
    return __builtin_bit_cast(bf16x8, p);
}

DI void diffattn_unit(const Frame& F, int li, int b, int h, size_t qrow0, int NT2) {
    const int lane = F.lane, r = lane & 31, hh = lane >> 5, c = F.wave & 1, g = F.wave >> 1;
    const bf16_t* AQ = WSP(bf16_t, WS_AQ); const bf16_t* AK = WSP(bf16_t, WS_AK); const bf16_t* AVT = WSP(bf16_t, WS_AVT) + (size_t)(b * 4 + h) * 64 * NKEY;
    float lam_init; const float lam = lam_of(F, li, lam_init);
    const size_t qrow = qrow0 + g * 32 + r;
    bf16x8 qf[2]; float qn2 = 0.f;
#pragma unroll
    for (int ks = 0; ks < 2; ++ks) { qf[ks] = *(const bf16x8*)(AQ + qrow * 256 + h * 64 + c * 32 + ks * 16 + 8 * hh);
#pragma unroll
        for (int j = 0; j < 8; ++j) { const float v = bf2f((bf16_t)qf[ks][j]); qn2 += v * v; } }
    qn2 = half_sum(qn2);
    f32x16 cinit;
    { const float km = sqrtf(__uint_as_float(__hip_atomic_load(F.ctl + CW_KMAX + li * 16 + (b * 4 + h) * 2 + c, __ATOMIC_RELAXED, __HIP_MEMORY_SCOPE_AGENT)));
      const float cn = -(sqrtf(qn2) * km * 1.02f + 1e-3f);
#pragma unroll
      for (int i = 0; i < 16; ++i) cinit[i] = cn; }
    f32x16 O[2];
#pragma unroll
    for (int dh = 0; dh < 2; ++dh)
#pragma unroll
        for (int i = 0; i < 16; ++i) O[dh][i] = 0.f;
    f32x16 lacc;
#pragma unroll
    for (int i = 0; i < 16; ++i) lacc[i] = 0.f;
    constexpr int KTB = 2 * 128 * 64, VTB = 64 * 264, STG = KTB + VTB;
    const int skey = F.tid >> 2, sq = F.tid & 3;
    const int kdst0 = (sq >> 1) * 8192 + skey * 64 + ((((sq & 1) * 2 + 0) ^ ((skey >> 2) & 3)) * 16);
    const int kdst1 = (sq >> 1) * 8192 + skey * 64 + ((((sq & 1) * 2 + 1) ^ ((skey >> 2) & 3)) * 16);
    const int vd = F.tid >> 3, vpart = F.tid & 7;
    const int vdst = KTB + vd * 264 + vpart * 32;
    auto krow_of = [&](int j) -> size_t { return j < CTX ? (size_t)NLAT + b * CTX + j : (size_t)b * S + (j - CTX); };
    unsigned char* L = F.lds;
    u32x4 kreg[2], vreg[2];
    { const bf16_t* kp = AK + krow_of(skey) * 256 + h * 64 + sq * 16; const bf16_t* vp = AVT + (size_t)vd * NKEY + vpart * 16;
      kreg[0] = *(const u32x4*)kp; kreg[1] = *(const u32x4*)(kp + 8); vreg[0] = *(const u32x4*)vp; vreg[1] = *(const u32x4*)(vp + 8); }
    __syncthreads();
    *(u32x4*)(L + kdst0) = kreg[0]; *(u32x4*)(L + kdst1) = kreg[1];
    *(u32x2*)(L + vdst) = (u32x2){vreg[0][0], vreg[0][1]}; *(u32x2*)(L + vdst + 8) = (u32x2){vreg[0][2], vreg[0][3]};
    *(u32x2*)(L + vdst + 16) = (u32x2){vreg[1][0], vreg[1][1]}; *(u32x2*)(L + vdst + 24) = (u32x2){vreg[1][2], vreg[1][3]};
    __syncthreads();
    const int ksw = (r >> 2) & 3;
    const int kr0 = c * 8192 + r * 64 + (((0 + hh) ^ ksw) * 16), kr1 = c * 8192 + r * 64 + (((2 + hh) ^ ksw) * 16);
    const int vr0 = r * 264 + 8 * hh;
#define DA_QK(Sx, st) do { \
        const bf16x8 k0 = *(const bf16x8*)(kb + (st) * 2048 + kr0), k1 = *(const bf16x8*)(kb + (st) * 2048 + kr1); \
        Sx = MFMA32(k0, qf[0], cinit); Sx = MFMA32(k1, qf[1], Sx); } while (0)
#define DA_PV(Sx, st) do { bf16x8 vf[2][2]; \
        _Pragma("unroll") for (int dh = 0; dh < 2; ++dh) _Pragma("unroll") for (int s2 = 0; s2 < 2; ++s2) { \
            const unsigned char* vp = vb + dh * (32 * 264) + vr0 + (st) * 64 + s2 * 32; \
            const s16x4 lo = *(const s16x4*)vp, hi = *(const s16x4*)(vp + 16); \
            vf[dh][s2] = __builtin_shufflevector(lo, hi, 0, 1, 2, 3, 4, 5, 6, 7); } \
        _Pragma("unroll") for (int i = 0; i < 16; ++i) Sx[i] = __builtin_amdgcn_exp2f(Sx[i]); \
        lacc += Sx; \
        const bf16x8 p0 = pack8(Sx, 0), p1 = pack8(Sx, 1); \
        O[0] = MFMA32(vf[0][0], p0, O[0]); O[1] = MFMA32(vf[1][0], p0, O[1]); \
        O[0] = MFMA32(vf[0][1], p1, O[0]); O[1] = MFMA32(vf[1][1], p1, O[1]); } while (0)
#pragma unroll 1
    for (int kt = 0; kt < NT2; ++kt) {
        const int buf = kt & 1;
        if (kt + 1 < NT2) {
            const int j0 = (kt + 1) * 128;
            const bf16_t* kp = AK + krow_of(j0 + skey) * 256 + h * 64 + sq * 16; const bf16_t* vp = AVT + (size_t)vd * NKEY + j0 + vpart * 16;
            kreg[0] = *(const u32x4*)kp; kreg[1] = *(const u32x4*)(kp + 8); vreg[0] = *(const u32x4*)vp; vreg[1] = *(const u32x4*)(vp + 8);
        }
        const unsigned char* kb = L + buf * STG; const unsigned char* vb = L + buf * STG + KTB;
        f32x16 Sa, Sb;
        DA_QK(Sa, 0);
        DA_QK(Sb, 1); DA_PV(Sa, 0);
        DA_QK(Sa, 2); DA_PV(Sb, 1);
        DA_QK(Sb, 3); DA_PV(Sa, 2);
        DA_PV(Sb, 3);
        if (kt + 1 < NT2) {
            unsigned char* W = L + (buf ^ 1) * STG;
            *(u32x4*)(W + kdst0) = kreg[0]; *(u32x4*)(W + kdst1) = kreg[1];
            *(u32x2*)(W + vdst) = (u32x2){vreg[0][0], vreg[0][1]}; *(u32x2*)(W + vdst + 8) = (u32x2){vreg[0][2], vreg[0][3]};
            *(u32x2*)(W + vdst + 16) = (u32x2){vreg[1][0], vreg[1][1]}; *(u32x2*)(W + vdst + 24) = (u32x2){vreg[1][2], vreg[1][3]};
        }
        __syncthreads();
    }
#undef DA_QK
#undef DA_PV
    float lsum = 0.f;
#pragma unroll
    for (int i = 0; i < 16; ++i) lsum += lacc[i];
    const float rl = 1.f / half_sum(lsum);
    float* xb = (float*)L + (size_t)g * 32 * 64;
    if (c == 1) {
#pragma unroll
        for (int dh = 0; dh < 2; ++dh)
#pragma unroll
            for (int i = 0; i < 16; ++i) xb[(dh * 16 + i) * 64 + lane] = O[dh][i] * (rl * lam);
    }
    __syncthreads();
    if (c == 0) {
        float o[2][16]; float ss = 0.f;
#pragma unroll
        for (int dh = 0; dh < 2; ++dh)
#pragma unroll
            for (int i = 0; i < 16; ++i) { o[dh][i] = O[dh][i] * rl - xb[(dh * 16 + i) * 64 + lane]; ss += o[dh][i] * o[dh][i]; }
        ss = half_sum(ss);
        const float rs = rsqrtf(ss * (1.f / 64.f) + EPS) * (1.f - lam_init);
        const float* sg = F.in[I_ASUB] + li * 64;
        bf16_t* mix = WSP(bf16_t, WS_HBF) + qrow * D + h * 64;
#pragma unroll
        for (int dh = 0; dh < 2; ++dh)
#pragma unroll
            for (int gq = 0; gq < 4; ++gq) {
                const int d = 32 * dh + 8 * gq + 4 * hh;
                const f32x4 gg = *(const f32x4*)(sg + d);
                *(u32x2*)(mix + d) = (u32x2){pk2(o[dh][4 * gq] * rs * gg[0], o[dh][4 * gq + 1] * rs * gg[1]), pk2(o[dh][4 * gq + 2] * rs * gg[2], o[dh][4 * gq + 3] * rs * gg[3])};
            }
    }
}

DI void na_mfma_unit(const Frame& F, int li, int b, size_t qrow0, int grow) {
    const int lane = F.lane, r31 = lane & 31, hh = lane >> 5, h = F.wave >> 1, qh = F.wave & 1;
    const bf16_t* BQ = WSP(bf16_t, WS_BQ); const bf16_t* BK = WSP(bf16_t, WS_BK); const bf16_t* BVT = WSP(bf16_t, WS_BVT);
    constexpr int KB = 4 * 8192, VB = 4 * 8704, STG = KB + VB;
    unsigned char* L = F.lds;
    float* tab = (float*)(F.lds + 2 * STG);
    const int nwin = grow >= 0 ? 8 : 0, nt = nwin + 4;
    int r0 = grow - 4; r0 = r0 < 0 ? 0 : (r0 > 248 ? 248 : r0);
    __syncthreads();
    if (nwin) for (int i = F.tid; i < 4 * 465; i += NTHR) tab[i] = F.in[I_RPB][(size_t)li * 4 * 465 + i] * LOG2E;
    const int skey = F.tid >> 3, sc64 = F.tid & 7, sh = sc64 >> 1;
    const int vrow = F.tid >> 1, vhalf = F.tid & 1;
    auto kbase = [&](int ti) -> const bf16_t* { return ti < nwin ? BK + ((size_t)b * S + (size_t)(r0 + ti) * GW) * 256 : BK + ((size_t)NLAT + b * CTX + (ti - nwin) * 64) * 256; };
    auto vkey0 = [&](int ti) -> int { return ti < nwin ? CTX + (r0 + ti) * GW : (ti - nwin) * 64; };
    u32x4 kreg[4], vreg[4];
    { const bf16_t* kp = kbase(0) + (size_t)skey * 256 + sc64 * 32; const bf16_t* vp = BVT + ((size_t)b * 256 + vrow) * NKEY + vkey0(0) + vhalf * 32;
#pragma unroll
      for (int i = 0; i < 4; ++i) { kreg[i] = *(const u32x4*)(kp + i * 8); vreg[i] = *(const u32x4*)(vp + i * 8); } }
    const size_t qrow = qrow0 + 32 * qh + r31;
    bf16x8 qf[4]; float qn2 = 0.f;
#pragma unroll
    for (int ks = 0; ks < 4; ++ks) { qf[ks] = *(const bf16x8*)(BQ + qrow * 256 + h * 64 + ks * 16 + 8 * hh);
#pragma unroll
        for (int j = 0; j < 8; ++j) { const float v = bf2f((bf16_t)qf[ks][j]); qn2 += v * v; } }
    qn2 = half_sum(qn2);
    __syncthreads();
    float bmax = 0.f;
    if (nwin) { for (int i = lane; i < 465; i += 64) bmax = fmaxf(bmax, tab[h * 465 + i]); bmax = wave_max(bmax); }
    const unsigned* kmx = F.ctl + CW_KMAXB + li * 16 + (b * 4 + h) * 2;
    const float km = sqrtf(__uint_as_float(__hip_atomic_load(kmx, __ATOMIC_RELAXED, __HIP_MEMORY_SCOPE_AGENT)) + __uint_as_float(__hip_atomic_load(kmx + 1, __ATOMIC_RELAXED, __HIP_MEMORY_SCOPE_AGENT)));
    const float cneg = -(sqrtf(qn2) * km * 1.02f + bmax + 1e-3f);
    const int cq = 32 * qh + r31; int c0q = cq - 8; c0q = c0q < 0 ? 0 : (c0q > 48 ? 48 : c0q);
    const int qrow_g = grow;
    f32x16 O[2];
#pragma unroll
    for (int dh = 0; dh < 2; ++dh)
#pragma unroll
        for (int i = 0; i < 16; ++i) O[dh][i] = 0.f;
    float lsum = 0.f;
    const int kdst = sh * 8192 + skey * 128, ksw = (skey >> 1) & 7, kch0 = (sc64 & 1) * 4;
    const int vdst = KB + (vrow >> 6) * 8704 + (vrow & 63) * 136 + vhalf * 64;
#pragma unroll
    for (int i = 0; i < 4; ++i) { *(u32x4*)(L + kdst + (((kch0 + i) ^ ksw) * 16)) = kreg[i];
        *(u32x2*)(L + vdst + i * 16) = (u32x2){vreg[i][0], vreg[i][1]}; *(u32x2*)(L + vdst + i * 16 + 8) = (u32x2){vreg[i][2], vreg[i][3]}; }
    __syncthreads();
#pragma unroll 1
    for (int ti = 0; ti < nt; ++ti) {
        const int buf = ti & 1;
        if (ti + 1 < nt) { const bf16_t* kp = kbase(ti + 1) + (size_t)skey * 256 + sc64 * 32; const bf16_t* vp = BVT + ((size_t)b * 256 + vrow) * NKEY + vkey0(ti + 1) + vhalf * 32;
#pragma unroll
            for (int i = 0; i < 4; ++i) { kreg[i] = *(const u32x4*)(kp + i * 8); vreg[i] = *(const u32x4*)(vp + i * 8); } }
        const unsigned char* kb = L + buf * STG + h * 8192; const unsigned char* vb = L + buf * STG + KB + h * 8704;
        const bool win = ti < nwin;
        const float* trow = tab + h * 465 + (win ? (r0 + ti - qrow_g + 7) * 31 : 0) + 15 - cq;
#pragma unroll
        for (int st = 0; st < 2; ++st) {
            const int key = 32 * st + r31, sw = (key >> 1) & 7;
            f32x16 s;
#pragma unroll
            for (int i = 0; i < 16; ++i) { const int kc = 32 * st + (i & 3) + 8 * (i >> 2) + 4 * hh;
                float c = cneg;
                if (win) { const bool ok = (kc >= c0q) && (kc < c0q + 16); c = ok ? trow[ok ? kc : cq] + cneg : -1e30f; }
                s[i] = c; }
#pragma unroll
            for (int ks = 0; ks < 4; ++ks) { const bf16x8 kf = *(const bf16x8*)(kb + key * 128 + (((ks * 2 + hh) ^ sw) * 16)); s = MFMA32(kf, qf[ks], s); }
#pragma unroll
            for (int i = 0; i < 16; ++i) { s[i] = __builtin_amdgcn_exp2f(s[i]); lsum += s[i]; }
            const bf16x8 p0 = pack8(s, 0), p1 = pack8(s, 1);
#pragma unroll
            for (int dh = 0; dh < 2; ++dh) {
                const unsigned char* vp = vb + (32 * dh + r31) * 136 + (32 * st + 4 * hh) * 2;
                const s16x4 a0 = *(const s16x4*)vp, a1 = *(const s16x4*)(vp + 16), b0 = *(const s16x4*)(vp + 32), b1 = *(const s16x4*)(vp + 48);
                O[dh] = MFMA32(__builtin_shufflevector(a0, a1, 0, 1, 2, 3, 4, 5, 6, 7), p0, O[dh]);
                O[dh] = MFMA32(__builtin_shufflevector(b0, b1, 0, 1, 2, 3, 4, 5, 6, 7), p1, O[dh]);
            }
        }
        if (ti + 1 < nt) { unsigned char* W = L + (buf ^ 1) * STG;
#pragma unroll
            for (int i = 0; i < 4; ++i) { *(u32x4*)(W + kdst + (((kch0 + i) ^ ksw) * 16)) = kreg[i];
                *(u32x2*)(W + vdst + i * 16) = (u32x2){vreg[i][0], vreg[i][1]}; *(u32x2*)(W + vdst + i * 16 + 8) = (u32x2){vreg[i][2], vreg[i][3]}; } }
        __syncthreads();
    }
    const float rl = 1.f / half_sum(lsum);
    bf16_t* mix = WSP(bf16_t, WS_HBF) + qrow * D + 256 + h * 64;
#pragma unroll
    for (int dh = 0; dh < 2; ++dh)
#pragma unroll
        for (int g = 0; g < 4; ++g) { const int d = 32 * dh + 8 * g + 4 * hh;
            *(u32x2*)(mix + d) = (u32x2){pk2(O[dh][4 * g] * rl, O[dh][4 * g + 1] * rl), pk2(O[dh][4 * g + 2] * rl, O[dh][4 * g + 3] * rl)}; }
}

DI void pool_unit(const Frame& F, int li, size_t seq_row0, int L, int t0) {
    float* us = (float*)F.lds;
    float* df = us + 48 * 256;
    const bf16_t* PL = WSP(bf16_t, WS_PL);
    __syncthreads();
    for (int i = F.tid; i < 48 * 32; i += NTHR) {
        const int tt = i >> 5, c8 = i & 31, t = t0 - 8 + tt;
        float v[8] = {0.f, 0.f, 0.f, 0.f, 0.f, 0.f, 0.f, 0.f};
        if (t >= 0 && t < L) { const u32x4 x = *(const u32x4*)(PL + (seq_row0 + t) * 256 + c8 * 8);
#pragma unroll
            for (int e = 0; e < 4; ++e) { v[2 * e] = __uint_as_float(x[e] << 16); v[2 * e + 1] = __uint_as_float(x[e] & 0xffff0000u); } }
#pragma unroll
        for (int e = 0; e < 8; ++e) us[tt * 256 + c8 * 8 + e] = v[e];
    }
    __syncthreads();
    for (int i = F.tid; i < 32 * 256; i += NTHR) {
        const int tl = i >> 8, ch = i & 255, g = ch >> 6, t = t0 + tl; const int hw = 1 << g;
        int lo = t - hw; lo = lo < 0 ? 0 : lo; int hi = t + hw; hi = hi > L ? L : hi;
        float s = 0.f;
        for (int tt = lo; tt < hi; ++tt) s += us[(tt - t0 + 8) * 256 + ch];
        df[tl * 256 + ch] = s / (float)(hi - lo) - us[(tl + 8) * 256 + ch];
    }
    __syncthreads();
    const float* pw = F.in[I_POOLW] + (size_t)li * 4 * 64 * 64; const float* ps = F.in[I_POOLS] + li * 256;
    bf16_t* mix = WSP(bf16_t, WS_HBF);
    {
        const int ch = F.tid & 255, th = F.tid >> 8, g = ch >> 6, j = ch & 63;
        float w[64];
#pragma unroll
        for (int i = 0; i < 64; ++i) w[i] = pw[((size_t)g * 64 + i) * 64 + j];
        const float scale = ps[ch];
        for (int tl = th * 16; tl < th * 16 + 16; ++tl) {
            float a = 0.f;
#pragma unroll
            for (int i = 0; i < 64; ++i) a += df[tl * 256 + g * 64 + i] * w[i];
            mix[(seq_row0 + t0 + tl) * D + 512 + ch] = f2bf(a * scale);
        }
    }
}

DI float hy_norm(const float* part, int ntile, int o, int ch) {
    float s = 0.f;
    for (int t = 0; t < ntile; ++t) s += part[(size_t)t * 1024 + (o * 2) * 256 + ch] + part[(size_t)t * 1024 + (o * 2 + 1) * 256 + ch];
    return rsqrtf(s + EPS);
}
DI float hy_short(const bf16_t* p, int t, int L, float w0, float w1, float w2, float bb) {
    const int tm = t > 0 ? t - 1 : 0, tp = t + 1 < L ? t + 1 : L - 1;
    float a = bf2f(p[tm]), c = bf2f(p[tp]); const float m = bf2f(p[t]);
    a = t > 0 ? a : 0.f; c = t + 1 < L ? c : 0.f;
    return a * w0 + m * w1 + c * w2 + bb;
}
constexpr int FM = 16384;
DI int fphys(int i) { return i + (i >> 4) + ((i >> 9) << 4); }
constexpr int brev(int m, int bits) { return bits == 5 ? (((m & 1) << 4) | ((m & 2) << 2) | (m & 4) | ((m & 8) >> 2) | ((m & 16) >> 4)) : (((m & 1) << 3) | ((m & 2) << 1) | ((m & 4) >> 1) | ((m & 8) >> 3)); }
template <int R, int LOG2R, bool INV> DI void dft_regs(float (&re)[R], float (&im)[R]) {
    constexpr float C32[16] = {1.f, 0.98078528040323043f, 0.92387953251128674f, 0.83146961230254524f, 0.70710678118654752f, 0.55557023301960218f, 0.38268343236508977f, 0.19509032201612825f,
                               0.f, -0.19509032201612825f, -0.38268343236508977f, -0.55557023301960218f, -0.70710678118654752f, -0.83146961230254524f, -0.92387953251128674f, -0.98078528040323043f};
    constexpr float S32[16] = {0.f, 0.19509032201612825f, 0.38268343236508977f, 0.55557023301960218f, 0.70710678118654752f, 0.83146961230254524f, 0.92387953251128674f, 0.98078528040323043f,
                               1.f, 0.98078528040323043f, 0.92387953251128674f, 0.83146961230254524f, 0.70710678118654752f, 0.55557023301960218f, 0.38268343236508977f, 0.19509032201612825f};
#pragma unroll
    for (int st = 0; st < LOG2R; ++st) {
        const int h = R >> (st + 1);
#pragma unroll
        for (int i = 0; i < R; i += 2 * h) {
#pragma unroll
            for (int j = 0; j < h; ++j) {
                const float xr = re[i + j], xi = im[i + j], yr = re[i + j + h], yi = im[i + j + h];
                re[i + j] = xr + yr; im[i + j] = xi + yi;
                const float dr = xr - yr, di = xi - yi;
                const int k = j * (16 / h);
                if (k == 0) { re[i + j + h] = dr; im[i + j + h] = di; }
                else if (k == 8) { re[i + j + h] = INV ? -di : di; im[i + j + h] = INV ? dr : -dr; }
                else { const float c = C32[k], sn = INV ? S32[k] : -S32[k]; re[i + j + h] = dr * c - di * sn; im[i + j + h] = dr * sn + di * c; }
            }
        }
    }
}
template <bool INV, int SP> DI void fft_pass32(f32x2* X, int bp, int rem, float inv_bs) {
    asm volatile("" : "+v"(bp), "+v"(rem));
    f32x2* P = X + bp;
    const float revb = (float)rem * inv_bs;
    float re[32], im[32];
    if (!INV) {
#pragma unroll
        for (int q = 0; q < 32; ++q) { const f32x2 v = P[q * SP]; re[q] = v[0]; im[q] = v[1]; }
        dft_regs<32, 5, false>(re, im);
#pragma unroll
        for (int m = 0; m < 32; ++m) { const int qp = brev(m, 5);
            float r = re[m], i = im[m];
            if (qp != 0) { const float rev = revb * (float)qp; const float c = __builtin_amdgcn_cosf(rev), sn = -__builtin_amdgcn_sinf(rev); const float t = r * c - i * sn; i = r * sn + i * c; r = t; }
            P[qp * SP] = (f32x2){r, i}; }
    } else {
#pragma unroll
        for (int qp = 0; qp < 32; ++qp) { const f32x2 v = P[qp * SP]; float r = v[0], i = v[1];
            if (qp != 0) { const float rev = revb * (float)qp; const float c = __builtin_amdgcn_cosf(rev), sn = __builtin_amdgcn_sinf(rev); const float t = r * c - i * sn; i = r * sn + i * c; r = t; }
            re[qp] = r; im[qp] = i; }
        dft_regs<32, 5, true>(re, im);
#pragma unroll
        for (int m = 0; m < 32; ++m) P[brev(m, 5) * SP] = (f32x2){re[m], im[m]};
    }
}
DI void fft_fwd12(f32x2* X, int tid) {
    __syncthreads(); fft_pass32<false, 560>(X, fphys(tid), tid, 1.f / 16384.f);
    __syncthreads(); fft_pass32<false, 17>(X, (tid >> 4) * 560 + (tid & 15), tid & 15, 1.f / 512.f);
    __syncthreads();
}
DI void fft_inv21(f32x2* X, int tid) {
    __syncthreads(); fft_pass32<true, 17>(X, (tid >> 4) * 560 + (tid & 15), tid & 15, 1.f / 512.f);
    __syncthreads(); fft_pass32<true, 560>(X, fphys(tid), tid, 1.f / 16384.f);
    __syncthreads();
}
DI void hyena_fft_unit(const Frame& F, int li, int ch) {
    f32x2* X = (f32x2*)F.lds;
    const bf16_t* HYT = WSP(bf16_t, WS_HYT); const float* filt = WSP(float, WS_FILT);
    f32x2* Ye = WSP(f32x2, WS_ZBUF) + (size_t)ch * FM; f32x2* Z1 = WSP(f32x2, WS_Z1BUF) + (size_t)ch * FM;
    const float* sw = F.in[I_HYSW] + (size_t)li * 3 * 768; const float* sb = F.in[I_HYSB] + li * 768; const float* sk = F.in[I_HSKIP] + li * 512;
    const int tid = F.tid;
    const bf16_t* px1[2] = {HYT + ((size_t)0 * 768 + ch) * S, HYT + ((size_t)1 * 768 + ch) * S};
    const bf16_t* px2[2] = {HYT + ((size_t)0 * 768 + 256 + ch) * S, HYT + ((size_t)1 * 768 + 256 + ch) * S};
    const bf16_t* pv[2] = {HYT + ((size_t)0 * 768 + 512 + ch) * S, HYT + ((size_t)1 * 768 + 512 + ch) * S};
    const float wx1[4] = {sw[ch], sw[768 + ch], sw[1536 + ch], sb[ch]};
    const float wx2[4] = {sw[256 + ch], sw[768 + 256 + ch], sw[1536 + 256 + ch], sb[256 + ch]};
    const float wv[4] = {sw[512 + ch], sw[768 + 512 + ch], sw[1536 + 512 + ch], sb[512 + ch]};
#pragma unroll 1
    for (int cv = 0; cv < 2; ++cv) {
        const float* hf = filt + ((size_t)(2 * cv) * 256 + ch) * S; const float* hb = filt + ((size_t)(2 * cv + 1) * 256 + ch) * S;
        float fnrm;
        { int tn = tid; asm volatile("" : "+v"(tn));
          const float pv = WSP(float, WS_FPART)[(size_t)(tn & 255) * 1024 + (cv * 2 + (tn >> 8)) * 256 + ch];
          const float ws = wave_sum(pv);
          float* red = (float*)(F.lds + LDS_MISC + 128);
          __syncthreads();
          if (F.lane == 0) red[F.wave] = ws;
          __syncthreads();
          fnrm = rsqrtf(red[0] + red[1] + red[2] + red[3] + red[4] + red[5] + red[6] + red[7] + EPS); }
        const float nrm = 1.f / 32768.f;
        const float skip = sk[cv * 256 + ch];
#pragma unroll 1
        for (int half = 0; half < 2; ++half) {
            __syncthreads();
            int pb = fphys(tid); int tq = tid; asm volatile("" : "+v"(pb), "+v"(tq));
            if (half == 0) {
#pragma unroll 8
                for (int j = 0; j < 32; ++j) { const int n = tq + 512 * j; const float a = hf[n] * fnrm; float bq = hb[FM - n] * fnrm; bq = n ? bq : 0.f;
                    X[pb + 560 * j] = (f32x2){a + bq, 0.f}; }
            } else {
#pragma unroll 8
                for (int j = 0; j < 32; ++j) { const int n = tq + 512 * j; const float a = hf[n] * fnrm; float bq = hb[FM - n] * fnrm; bq = n ? bq : 0.f;
                    const float d = a - bq, rev = (float)n * (1.f / 32768.f);
                    X[pb + 560 * j] = (f32x2){d * __builtin_amdgcn_cosf(rev), -d * __builtin_amdgcn_sinf(rev)}; }
            }
            fft_fwd12(X, tid);
            h16x2 kpk[2][16];
#pragma unroll
            for (int g = 0; g < 2; ++g) { int b16 = fphys((tid + 512 * g) * 16); asm volatile("" : "+v"(b16));
                float kre[16], kim[16];
#pragma unroll
                for (int q = 0; q < 16; ++q) { const f32x2 v = X[b16 + q]; kre[q] = v[0]; kim[q] = v[1]; }
                dft_regs<16, 4, false>(kre, kim);
#pragma unroll
                for (int q = 0; q < 16; ++q) kpk[g][q] = (h16x2){(_Float16)kre[q], (_Float16)kim[q]}; }
            __syncthreads();
            asm volatile("" : "+v"(pb), "+v"(tq));
#define HY_MOD(v, n) do { const float rev = (float)(n) * (1.f / 32768.f); const float c = __builtin_amdgcn_cosf(rev), sn = -__builtin_amdgcn_sinf(rev); v = (f32x2){v[0] * c - v[1] * sn, v[0] * sn + v[1] * c}; } while (0)
            if (cv == 0) {
                if (half == 0) {
#pragma unroll 4
                    for (int j = 0; j < 32; ++j) { const int n = tq + 512 * j; X[pb + 560 * j] = (f32x2){hy_short(pv[0], n, S, wv[0], wv[1], wv[2], wv[3]), hy_short(pv[1], n, S, wv[0], wv[1], wv[2], wv[3])}; }
                } else {
#pragma unroll 4
                    for (int j = 0; j < 32; ++j) { const int n = tq + 512 * j; f32x2 v = (f32x2){hy_short(pv[0], n, S, wv[0], wv[1], wv[2], wv[3]), hy_short(pv[1], n, S, wv[0], wv[1], wv[2], wv[3])}; HY_MOD(v, n); X[pb + 560 * j] = v; }
                }
            } else {
                if (half == 0) {
#pragma unroll 8
                    for (int j = 0; j < 32; ++j) { const int n = tq + 512 * j; X[pb + 560 * j] = Z1[n]; }
                } else {
#pragma unroll 8
                    for (int j = 0; j < 32; ++j) { const int n = tq + 512 * j; f32x2 v = Z1[n]; HY_MOD(v, n); X[pb + 560 * j] = v; }
                }
            }
#undef HY_MOD
            fft_fwd12(X, tid);
#pragma unroll
            for (int g = 0; g < 2; ++g) { int b16 = fphys((tid + 512 * g) * 16); asm volatile("" : "+v"(b16));
                float re[16], im[16];
#pragma unroll
                for (int q = 0; q < 16; ++q) { const f32x2 v = X[b16 + q]; re[q] = v[0]; im[q] = v[1]; }
                dft_regs<16, 4, false>(re, im);
                float br[16], bi[16];
#pragma unroll
                for (int m = 0; m < 16; ++m) { const int qp = brev(m, 4); const float kr = (float)kpk[g][m][0], ki = (float)kpk[g][m][1]; br[qp] = re[m] * kr - im[m] * ki; bi[qp] = re[m] * ki + im[m] * kr; }
                dft_regs<16, 4, true>(br, bi);
#pragma unroll
                for (int m = 0; m < 16; ++m) X[b16 + brev(m, 4)] = (f32x2){br[m], bi[m]};
            }
            fft_inv21(X, tid);
            asm volatile("" : "+v"(pb), "+v"(tq));
            if (half == 0) {
#pragma unroll 8
                for (int j = 0; j < 32; ++j) { const int n = tq + 512 * j; Ye[n] = X[pb + 560 * j]; }
            } else {
#define HY_Y(n, j) const f32x2 yo = X[pb + 560 * (j)], ye = Ye[n]; \
                    const float rev = (float)(n) * (1.f / 32768.f); const float c = __builtin_amdgcn_cosf(rev), sn = __builtin_amdgcn_sinf(rev); \
                    const float y0 = (ye[0] + yo[0] * c - yo[1] * sn) * nrm, y1 = (ye[1] + yo[0] * sn + yo[1] * c) * nrm;
                if (cv == 0) {
#pragma unroll 4
                    for (int j = 0; j < 32; ++j) { const int n = tq + 512 * j; HY_Y(n, j)
                        const float v0 = hy_short(pv[0], n, S, wv[0], wv[1], wv[2], wv[3]), v1 = hy_short(pv[1], n, S, wv[0], wv[1], wv[2], wv[3]);
                        const float a0 = hy_short(px1[0], n, S, wx1[0], wx1[1], wx1[2], wx1[3]), a1 = hy_short(px1[1], n, S, wx1[0], wx1[1], wx1[2], wx1[3]);
                        Z1[n] = (f32x2){a0 * (y0 + skip * v0), a1 * (y1 + skip * v1)}; }
                } else {
                    bf16_t* mix = WSP(bf16_t, WS_HBF);
#pragma unroll 4
                    for (int j = 0; j < 32; ++j) { const int n = tq + 512 * j; HY_Y(n, j)
                        const f32x2 z1 = Z1[n];
                        const float a0 = hy_short(px2[0], n, S, wx2[0], wx2[1], wx2[2], wx2[3]), a1 = hy_short(px2[1], n, S, wx2[0], wx2[1], wx2[2], wx2[3]);
                        mix[((size_t)n) * D + 768 + ch] = f2bf(a0 * (y0 + skip * z1[0]));
                        mix[((size_t)S + n) * D + 768 + ch] = f2bf(a1 * (y1 + skip * z1[1])); }
                }
#undef HY_Y
            }
        }
    }
}
DI void hyena_ctx_unit(const Frame& F, int li, int ch) {
    float* vs = (float*)F.lds;
    float* zs = vs + 512;
    float* fl = zs + 512;
    const bf16_t* HYC = WSP(bf16_t, WS_HYC); const float* filt = WSP(float, WS_FILTC);
    const float* sw = F.in[I_HYSW] + (size_t)li * 3 * 768; const float* sb = F.in[I_HYSB] + li * 768; const float* sk = F.in[I_HSKIP] + li * 512;
    const float n0 = hy_norm(WSP(float, WS_FPARTC), 4, 0, ch), n1 = hy_norm(WSP(float, WS_FPARTC), 4, 1, ch);
    const int b = F.tid >> 8, t = F.tid & 255;
    auto sc = [&](int c) -> float { const bf16_t* p = HYC + (size_t)(b * CTX) * 768 + c;
        const float a = t > 0 ? bf2f(p[(size_t)(t - 1) * 768]) : 0.f, d = t + 1 < CTX ? bf2f(p[(size_t)(t + 1) * 768]) : 0.f;
        return a * sw[c] + bf2f(p[(size_t)t * 768]) * sw[768 + c] + d * sw[1536 + c] + sb[c]; };
    __syncthreads();
    const float x1 = sc(ch), x2 = sc(256 + ch), v = sc(512 + ch);
    vs[F.tid] = v;
    for (int i = F.tid; i < 1024; i += NTHR) fl[i] = filt[((size_t)(i >> 8) * 256 + ch) * CTX + (i & 255)];
    __syncthreads();
    float a = 0.f;
    for (int s = 0; s < CTX; ++s) { const int dl = t - s; a += (dl >= 0 ? fl[dl] : fl[256 - dl]) * vs[b * 256 + s]; }
    const float z = x1 * (a * n0 + sk[ch] * v);
    zs[F.tid] = z;
    __syncthreads();
    a = 0.f;
    for (int s = 0; s < CTX; ++s) { const int dl = t - s; a += (dl >= 0 ? fl[512 + dl] : fl[768 - dl]) * zs[b * 256 + s]; }
    WSP(bf16_t, WS_HBF)[((size_t)NLAT + b * CTX + t) * D + 768 + ch] = f2bf(x2 * (a * n1 + sk[256 + ch] * z));
}

DI void phase_mix(const Frame& F0, int li) {
    const Frame& F = F0;
    unsigned* head = F.ctl + CW_QHEAD + li * 64;
    volatile unsigned* qs = (volatile unsigned*)(F.lds + LDS_MISC + 32);
#ifndef PROBE_DA
#define PROBE_DA 1
#endif
#ifndef PROBE_HY
#define PROBE_HY 1
#endif
#ifndef PROBE_NA
#define PROBE_NA 1
#endif
#ifdef PROBE_MISC
#define PROBE_PL 2
#else
#define PROBE_PL 1
#endif
    const int n_ca = (li == 0) ? 16 : 0, n_cb = (li == 0) ? 8 : 0, n_da = 1024 * PROBE_DA, n_hy = 256 * PROBE_HY, n_na = 512 * PROBE_NA, n_hc = (li == 0) ? 256 * PROBE_PL : 0, n_pl = 1024 * PROBE_PL, n_pc = (li == 0) ? 16 : 0;
    const int total = n_ca + n_cb + n_da + n_hy + n_na + n_hc + n_pl + n_pc;
    for (;;) {
        __syncthreads();
        if (F.tid == 0) qs[0] = __hip_atomic_fetch_add(head, 1u, __ATOMIC_RELAXED, __HIP_MEMORY_SCOPE_AGENT);
        __syncthreads();
        int u = __builtin_amdgcn_readfirstlane((int)qs[0]);
        if (u >= total) break;
        Frame F = F0; refresh(F);
        if (u < n_ca) {
#ifndef SKIP_CA
            diffattn_unit(F, li, u >> 3, (u >> 1) & 3, (size_t)NLAT + (size_t)(u >> 3) * CTX + (size_t)(u & 1) * 128, CTX / 128);
#endif
            continue; }
        u -= n_ca;
        if (u < n_cb) {
#ifndef SKIP_CB
            na_mfma_unit(F, li, u >> 2, (size_t)NLAT + (size_t)(u >> 2) * CTX + (size_t)(u & 3) * 64, -1);
#endif
            continue; }
        u -= n_cb;
        if (u < n_da) {
#ifndef SKIP_DA
            { const int v = u & 1023; diffattn_unit(F, li, v >> 9, (v >> 7) & 3, (size_t)(v >> 9) * S + (size_t)(v & 127) * 128, NKEY / 128); }
#endif
            continue; }
        u -= n_da;
        if (u < n_hy) {
#ifndef SKIP_HY
            hyena_fft_unit(F, li, u & 255);
#endif
            continue; }
        u -= n_hy;
        if (u < n_na) {
#ifndef SKIP_NA
            { const int v = u & 511; na_mfma_unit(F, li, v >> 8, (size_t)(v >> 8) * S + (size_t)(v & 255) * GW, v & 255); }
#endif
            continue; }
        u -= n_na;
        if (u < n_hc) {
#ifndef SKIP_HC
            hyena_ctx_unit(F, li, u & 255);
#endif
            continue; }
        u -= n_hc;
        if (u < n_pl) {
#ifndef SKIP_PL
            { const int v = u & 1023; pool_unit(F, li, (size_t)(v >> 9) * S, S, (v & 511) * 32); }
#endif
            continue; }
        u -= n_pl;
#ifndef SKIP_PL
        pool_unit(F, li, (size_t)NLAT + (u >> 3) * CTX, CTX, (u & 7) * 32);
#endif
    }
}

constexpr int PH_PER_LAYER = 8, NPH = 2 + 2 * PH_PER_LAYER;
__global__ void __launch_bounds__(NTHR, 2) mega(Args args) {
    extern __shared__ __attribute__((aligned(16))) unsigned char smem[];
    Frame F;
    F.in = args.in; F.out = args.out; F.ws = args.ws; F.ctl = (unsigned*)(args.ws + WS_CTL); F.lds = smem;
    F.tid = threadIdx.x; F.lane = F.tid & 63; F.wave = __builtin_amdgcn_readfirstlane(F.tid >> 6); F.G = gridDim.x; F.bid = blockIdx.x;
    if (F.tid < 64) ((unsigned*)(smem + LDS_MISC))[F.tid] = 0u;
    __syncthreads();
    const int lo = args.ph_lo, hi = args.ph_hi;
    const bool fused = (hi - lo) > 1;
    XcdBarrier bar; bar.bar = F.ctl; bar.x = 0; bar.st = (volatile LAS unsigned*)(smem + LDS_MISC);
    if (fused) bar = xcd_barrier_post(F.ctl, (volatile LAS unsigned*)(smem + LDS_MISC));
#define IN(k) (lo <= (k) && (k) < hi)
#ifdef PROBE_BAR
#define SEAM(k) do { if (IN(k) && IN((k) + 1)) { xcd_barrier(bar); xcd_barrier(bar); xcd_barrier(bar); } } while (0)
#else
#define SEAM(k) do { if (IN(k) && IN((k) + 1)) xcd_barrier(bar); } while (0)
#endif
#ifndef SKIP_P0
    if (IN(0)) { refresh(F); phase_prologue(F);
#ifdef PROBE_MISC
        __syncthreads(); refresh(F); phase_prologue(F);
#endif
    }
#endif
    SEAM(0);
    for (int li = 0; li < 2; ++li) {
        const int p0 = 1 + li * PH_PER_LAYER;
        const int nrows = (li == 0) ? NTOK : NLAT;
        if (IN(p0)) {
            refresh(F);
            phase_norm1(F, li, li == 0 ? 0 : 1);
#ifdef PROBE_N1
            if (li == 0) { refresh(F); phase_norm1(F, li, 0); refresh(F); phase_norm1(F, li, 0); refresh(F); phase_norm1(F, li, 0); refresh(F); phase_norm1(F, li, 0); }
#endif
            refresh(F);
#ifndef SKIP_FILT
            for (int t = F.bid; t < 256; t += F.G) filter_tile(F, li, S, t, WSP(float, WS_FILT), WSP(float, WS_FPART));
            if (li == 0) for (int t = F.bid; t < 4; t += F.G) filter_tile(F, li, CTX, t, WSP(float, WS_FILTC), WSP(float, WS_FPARTC));
#ifdef PROBE_MISC
            for (int t = F.bid; t < 256; t += F.G) filter_tile(F, li, S, t, WSP(float, WS_FILT), WSP(float, WS_FPART));
#endif
#endif
        }
        SEAM(p0);
        if (IN(p0 + 1)) {
            refresh(F);
            pg8::Gemm g{WSP(bf16_t, WS_HBF), WSP(bf16_t, WS_WIN) + (size_t)li * DIN * D, D, 0};
            pg8::StaticOrder So; So.init(NTOK, DIN, F.G, F.bid);
            EpiIn E{F.ws, WSP(float, WS_ROPE), F.ctl + CW_KMAX + li * 16, F.ctl + CW_KMAXB + li * 16};
#ifndef SKIP_G1
            pg8::gemm_phase<EpiIn, pg8::StaticOrder>((LAS unsigned char*)smem, g, So, E, F.tid);
#ifdef PROBE_G1
            __syncthreads(); refresh(F); pg8::gemm_phase<EpiIn, pg8::StaticOrder>((LAS unsigned char*)smem, g, So, E, F.tid);
#endif
#endif
        }
        SEAM(p0 + 1);
        if (IN(p0 + 2)) { refresh(F); phase_mix(F, li); }
        SEAM(p0 + 2);
        if (IN(p0 + 3)) {
            refresh(F);
            pg8::Gemm g{WSP(bf16_t, WS_HBF), WSP(bf16_t, WS_WOUT) + (size_t)li * D * D, D, 0};
            pg8::StaticOrder So; So.init(nrows, D, F.G, F.bid);
            EpiOut E{li == 0 ? F.in[I_X] : F.out, li == 0 ? F.in[I_CTX] : WSP(float, WS_XC), F.out, WSP(float, WS_XC), WSP(float, WS_MOD) + (size_t)li * 3 * 6144};
#ifndef SKIP_G2
            pg8::gemm_phase<EpiOut, pg8::StaticOrder>((LAS unsigned char*)smem, g, So, E, F.tid);
#endif
        }
        SEAM(p0 + 3);
#ifndef SKIP_N2
        if (IN(p0 + 4)) { refresh(F); phase_norm2(F, li, nrows); }
#endif
        SEAM(p0 + 4);
        if (IN(p0 + 5)) { refresh(F); phase_gather(F, li, nrows);
#ifdef PROBE_MISC
            __syncthreads(); refresh(F); phase_gather(F, li, nrows);
#endif
        }
        SEAM(p0 + 5);
        if (IN(p0 + 6)) {
            refresh(F);
            int* offs = (int*)(smem + LDS_MISC + 64);
            moe_offsets(F, li, offs);
            pg8::Gemm g{WSP(bf16_t, WS_A1), WSP(bf16_t, WS_W13) + (size_t)li * NE * 1024 * 1024, D, (size_t)1024 * 1024};
            pg8::MoeOrder Mo{offs + 40, offs[17 + 16], 4, F.G, (F.G % 8 == 0) ? (F.bid % 8) * (F.G / 8) + F.bid / 8 : F.bid};
            EpiMoe1 E{WSP(bf16_t, WS_HMID)};
#ifndef SKIP_G3
            pg8::gemm_phase<EpiMoe1, pg8::MoeOrder>((LAS unsigned char*)smem, g, Mo, E, F.tid);
#ifdef PROBE_G3
            __syncthreads(); refresh(F); pg8::gemm_phase<EpiMoe1, pg8::MoeOrder>((LAS unsigned char*)smem, g, Mo, E, F.tid);
#endif
#endif
        }
        SEAM(p0 + 6);
        if (IN(p0 + 7)) {
            refresh(F);
            int* offs = (int*)(smem + LDS_MISC + 64);
            moe_offsets(F, li, offs);
            pg8::Gemm g{WSP(bf16_t, WS_HMID), WSP(bf16_t, WS_W2) + (size_t)li * NE * 1024 * 512, DE, (size_t)1024 * 512};
            pg8::MoeOrder Mo{offs + 40, offs[17 + 16], 4, F.G, (F.G % 8 == 0) ? (F.bid % 8) * (F.G / 8) + F.bid / 8 : F.bid};
            EpiMoe2 E{WSP(bf16_t, WS_A1)};
#ifndef SKIP_G4
            pg8::gemm_phase<EpiMoe2, pg8::MoeOrder>((LAS unsigned char*)smem, g, Mo, E, F.tid);
#ifdef PROBE_G4
            __syncthreads(); refresh(F); pg8::gemm_phase<EpiMoe2, pg8::MoeOrder>((LAS unsigned char*)smem, g, Mo, E, F.tid);
#endif
#endif
        }
        SEAM(p0 + 7);
    }
    if (IN(NPH - 1)) { refresh(F); phase_norm1(F, 1, 2); }
#undef IN
#undef SEAM
}

extern "C" void kernel_launch(void* const* d_in, const int* in_sizes, int n_in, void* d_out, int out_size, void* d_ws, size_t ws_size, hipStream_t stream) {
    static int grid = 0;
    if (grid == 0) {
        if (n_in != N_IN || out_size != NLAT * D || ws_size < WS_END) { fprintf(stderr, "kernel_launch: unexpected shapes (n_in %d out %d ws %zu need %zu)\n", n_in, out_size, ws_size, (size_t)WS_END); grid = -1; return; }
        int dev = 0, cus = 0, per_cu = 0;
        if (hipGetDevice(&dev) != hipSuccess || hipDeviceGetAttribute(&cus, hipDeviceAttributeMultiprocessorCount, dev) != hipSuccess) { grid = -1; return; }
        if (hipFuncSetAttribute((const void*)mega, hipFuncAttributeMaxDynamicSharedMemorySize, LDS_BYTES) != hipSuccess) { fprintf(stderr, "kernel_launch: hipFuncSetAttribute failed\n"); grid = -1; return; }
        if (hipOccupancyMaxActiveBlocksPerMultiprocessor(&per_cu, (const void*)mega, NTHR, LDS_BYTES) != hipSuccess || per_cu < 1) { fprintf(stderr, "kernel_launch: occupancy query says %d\n", per_cu); }
        (void)hipGetLastError();
        grid = cus < MAXG ? cus : MAXG;
    }
    if (grid < 0) return;
    (void)hipMemsetAsync((char*)d_ws + WS_CTL, 0, CTL_BYTES, stream);
    Args a{};
    for (int i = 0; i < N_IN; ++i) a.in[i] = (const float*)d_in[i];
    a.out = (float*)d_out; a.ws = (unsigned char*)d_ws;
#if N_LAUNCH_MODE == 1
    a.ph_lo = 0; a.ph_hi = NPH;
    hipLaunchKernelGGL(mega, dim3(grid), dim3(NTHR), LDS_BYTES, stream, a);
#else
    for (int p = 0; p < NPH; ++p) { a.ph_lo = p; a.ph_hi = p + 1; hipLaunchKernelGGL(mega, dim3(grid), dim3(NTHR), LDS_BYTES, stream, a); }
#endif
}
#ifdef TEST_UNITS
__global__ void __launch_bounds__(NTHR, 2) t_da(Args args) {
    extern __shared__ __attribute__((aligned(16))) unsigned char smem[];
    Frame F; F.in = args.in; F.out = args.out; F.ws = args.ws; F.ctl = (unsigned*)(args.ws + WS_CTL); F.lds = smem; F.G = gridDim.x; F.bid = blockIdx.x; refresh(F);
    diffattn_unit(F, args.ph_lo, blockIdx.x >> 8, (blockIdx.x >> 6) & 3, (size_t)(blockIdx.x & 63) * 256, NKEY / 128);
}
__global__ void __launch_bounds__(NTHR, 2) t_hy(Args args) {
    extern __shared__ __attribute__((aligned(16))) unsigned char smem[];
    Frame F; F.in = args.in; F.out = args.out; F.ws = args.ws; F.ctl = (unsigned*)(args.ws + WS_CTL); F.lds = smem; F.G = gridDim.x; F.bid = blockIdx.x; refresh(F);
    hyena_fft_unit(F, args.ph_lo, blockIdx.x);
}
#endif
```

```cpp
#include <hip/hip_runtime.h>
#include <stdint.h>
#include <stdio.h>

#ifndef N_LAUNCH_MODE
#define N_LAUNCH_MODE 1
#endif

#define DI __device__ __forceinline__
#define LAS __attribute__((address_space(3)))
typedef unsigned short bf16_t;
typedef short bf16x8 __attribute__((ext_vector_type(8)));
typedef short s16x4 __attribute__((ext_vector_type(4)));
typedef float f32x4 __attribute__((ext_vector_type(4)));
typedef float f32x2 __attribute__((ext_vector_type(2)));
typedef float f32x16 __attribute__((ext_vector_type(16)));
typedef unsigned u32x4 __attribute__((ext_vector_type(4)));
typedef unsigned u32x2 __attribute__((ext_vector_type(2)));
typedef _Float16 h16x2 __attribute__((ext_vector_type(2)));

constexpr int D = 1024, NB = 2, S = 16384, CTX = 256, NLAT = NB * S, NCTX = NB * CTX, NTOK = NLAT + NCTX, DIN = 2560;
constexpr int NE = 16, DE = 512, GW = 64;
constexpr int NKEY = CTX + S;
constexpr int NTHR = 512;
constexpr int SLOT_CAP = 70656;
constexpr float EPS = 1e-6f;
constexpr float LOG2E = 1.4426950408889634f;
constexpr float QSCALE_A = 0.17677669529663687f * LOG2E;
constexpr float QSCALE_B = 0.125f * LOG2E;

enum { I_X = 0, I_C, I_CTX, I_CCTX, I_N1G, I_N2G, I_ADAW, I_ADAB, I_WIN, I_WOUT, I_ALAM, I_ASUB, I_RPB, I_POOLW, I_POOLS, I_HYSW, I_HYSB,
       I_HW1, I_HB1, I_HW2, I_HB2, I_HW3, I_HB3, I_HSKIP, I_RW, I_RB, I_MW1, I_MW3, I_MW2, I_FG, N_IN };

struct Args { const float* in[N_IN]; float* out; unsigned char* ws; int ph_lo, ph_hi; };

constexpr size_t al256(size_t x) { return (x + 255) & ~(size_t)255; }
constexpr size_t WS_CTL = 0, CTL_BYTES = 65536;
constexpr size_t WS_MOD = WS_CTL + CTL_BYTES;
constexpr size_t WS_ROPE = WS_MOD + al256(2 * 3 * 6144 * 4);
constexpr size_t WS_FPART = WS_ROPE + 16384;
constexpr size_t WS_FPARTC = WS_FPART + 256 * 1024 * 4;
constexpr size_t WS_XC = WS_FPARTC + 4 * 1024 * 4;
constexpr size_t WS_WIN = WS_XC + (size_t)NCTX * D * 4;
constexpr size_t WS_WOUT = WS_WIN + (size_t)2 * DIN * D * 2;
constexpr size_t WS_W13 = WS_WOUT + (size_t)2 * D * D * 2;
constexpr size_t WS_W2 = WS_W13 + (size_t)2 * NE * 1024 * 1024 * 2;
constexpr size_t WS_FILT = WS_W2 + (size_t)2 * NE * 1024 * 512 * 2;
constexpr size_t WS_FILTC = WS_FILT + (size_t)4 * 256 * S * 4;
constexpr size_t WS_ZBUF = WS_FILTC + (size_t)4 * 256 * 256 * 4;
constexpr size_t WS_R1 = WS_ZBUF + (size_t)256 * 2 * S * 4;
constexpr size_t WS_HBF = WS_R1;
constexpr size_t TOKB = (size_t)NTOK * 256 * 2;
constexpr size_t WS_AQ = WS_HBF + (size_t)NTOK * D * 2;
constexpr size_t WS_AK = WS_AQ + TOKB;
constexpr size_t WS_AVT = WS_AK + TOKB;
constexpr size_t WS_BQ = WS_AVT + (size_t)NB * 4 * 64 * NKEY * 2;
constexpr size_t WS_BK = WS_BQ + TOKB;
constexpr size_t WS_BVT = WS_BK + TOKB;
constexpr size_t WS_PL = WS_BVT + (size_t)NB * 4 * 64 * NKEY * 2;
constexpr size_t WS_HYT = WS_PL + TOKB;
constexpr size_t WS_HYC = WS_HYT + (size_t)NB * 768 * S * 2;
constexpr size_t WS_Z1BUF = WS_HYC + (size_t)NCTX * 768 * 2;
constexpr size_t WS_END_MIX = WS_Z1BUF + (size_t)256 * S * 8;
constexpr size_t WS_TOK = WS_AQ;
constexpr size_t WS_A1 = WS_TOK + al256((size_t)NTOK * 32);
constexpr size_t WS_HMID = WS_A1 + (size_t)SLOT_CAP * D * 2;
constexpr size_t WS_END_MOE = WS_HMID + (size_t)SLOT_CAP * DE * 2;
constexpr size_t WS_END = WS_END_MIX > WS_END_MOE ? WS_END_MIX : WS_END_MOE;

#define XB_TMO      128
#define XB_XCNT(j)  (256  + 64 * (j))
#define XB_XSUB(j)  (1280 + 64 * (j))
#define XB_XGEN(j)  (2304 + 64 * (j))
#define XB_TOP      3328
#define XB_TOPGEN   3392
#define XCD_BAR_WORDS 3456
#define XB_SPIN_CAP (1u << 18)
constexpr int CW_CNT = 4096;
constexpr int CW_KMAX = 4160;
constexpr int CW_KMAXB = 4192;
constexpr int CW_QHEAD = 4224;
constexpr int CW_BCNT = 4352;
constexpr int MAXG = 256;

constexpr int LDS_MAIN = 143360, LDS_MISC = LDS_MAIN, LDS_BYTES = LDS_MAIN + 2048;

DI float bf2f(bf16_t v) { return __uint_as_float(((unsigned)v) << 16); }
DI bf16_t f2bf(float f) { unsigned u = __float_as_uint(f); u += 0x7FFFu + ((u >> 16) & 1u); return (bf16_t)(u >> 16); }
DI unsigned pk2(float lo, float hi) { unsigned r; asm volatile("v_cvt_pk_bf16_f32 %0, %1, %2" : "=v"(r) : "v"(lo), "v"(hi)); return r; }
template <int K> DI float swz_xor(float v) { return __int_as_float(__builtin_amdgcn_ds_swizzle(__float_as_int(v), (K << 10) | 0x1F)); }
DI float half_sum(float v) { const auto r = __builtin_amdgcn_permlane32_swap(__float_as_uint(v), __float_as_uint(v), false, false); return __uint_as_float(r[0]) + __uint_as_float(r[1]); }
DI float half_max(float v) { const auto r = __builtin_amdgcn_permlane32_swap(__float_as_uint(v), __float_as_uint(v), false, false); return fmaxf(__uint_as_float(r[0]), __uint_as_float(r[1])); }
DI float wave_sum(float v) { v += swz_xor<16>(v); v += swz_xor<8>(v); v += swz_xor<4>(v); v += swz_xor<2>(v); v += swz_xor<1>(v); return half_sum(v); }
DI float wave_max(float v) { v = fmaxf(v, swz_xor<16>(v)); v = fmaxf(v, swz_xor<8>(v)); v = fmaxf(v, swz_xor<4>(v)); v = fmaxf(v, swz_xor<2>(v)); v = fmaxf(v, swz_xor<1>(v)); return half_max(v); }
DI float siluf(float x) { return x / (1.f + __expf(-x)); }
DI float sin_rev(float rev) { return __builtin_amdgcn_sinf(rev - floorf(rev)); }
DI float cos_rev(float rev) { return __builtin_amdgcn_cosf(rev - floorf(rev)); }
DI float sin_rad(float x) { return sin_rev(x * 0.15915494309189535f); }

DI unsigned xb_ld(unsigned* p)              { return __hip_atomic_load(p, __ATOMIC_RELAXED, __HIP_MEMORY_SCOPE_AGENT); }
DI unsigned xb_add(unsigned* p, unsigned v) { return __hip_atomic_fetch_add(p, v, __ATOMIC_RELAXED, __HIP_MEMORY_SCOPE_AGENT); }
DI unsigned xb_xcc_id() { return (unsigned)__builtin_amdgcn_s_getreg((3 << 11) | 20) & 0xFu; }
#define XB_SPIN(cond, bar) do { unsigned _sp = 0; while (cond) { __builtin_amdgcn_s_sleep(1); \
    if ((++_sp & 255u) == 0u) { if (xb_ld(&(bar)[XB_TMO])) break; if (_sp > XB_SPIN_CAP) { atomicAdd(&(bar)[XB_TMO], 1u); break; } } } } while (0)
struct XcdBarrier { unsigned* bar; unsigned x; volatile LAS unsigned* st; };
DI XcdBarrier xcd_barrier_post(unsigned* bar, volatile LAS unsigned* st) {
    XcdBarrier b; b.bar = bar; b.x = xb_xcc_id(); b.st = st;
    if (threadIdx.x == 0) (void)xb_add(&bar[XB_XCNT(b.x)], 1u);
    return b;
}
DI void xcd_barrier_complete(unsigned* bar, unsigned x, unsigned& nloc, unsigned& nx) {
    const unsigned G = gridDim.x * gridDim.y * gridDim.z;
    unsigned sum, cnt, mine, sp = 0u;
    for (;;) {
        sum = 0u; cnt = 0u; mine = 0u;
#pragma unroll
        for (unsigned j = 0; j < 16; ++j) { const unsigned c = xb_ld(&bar[XB_XCNT(j)]); sum += c; cnt += (c > 0u) ? 1u : 0u; mine = (j == x) ? c : mine; }
        if (sum == G) break;
        __builtin_amdgcn_s_sleep(1);
        if ((++sp & 255u) == 0u) { if (xb_ld(&bar[XB_TMO])) break; if (sp > XB_SPIN_CAP) { atomicAdd(&bar[XB_TMO], 1u); break; } }
    }
    nloc = mine > 0u ? mine : 1u; nx = cnt > 0u ? cnt : 1u;
}
DI void xcd_barrier(const XcdBarrier& b) {
    asm volatile("s_waitcnt vmcnt(0)" ::: "memory");
    __syncthreads();
    if (threadIdx.x == 0) {
        unsigned* bar = b.bar;
        __builtin_amdgcn_s_waitcnt(0);
        unsigned nloc = b.st[0], nx = b.st[1];
        if (nloc == 0u) { xcd_barrier_complete(bar, b.x, nloc, nx); b.st[0] = nloc; b.st[1] = nx; }
        const unsigned old = xb_add(&bar[XB_XSUB(b.x)], 1u);
        const unsigned gen = old / nloc;
        if (old + 1u == (gen + 1u) * nloc) {
            __builtin_amdgcn_fence(__ATOMIC_RELEASE, "agent");
            asm volatile("s_waitcnt vmcnt(0)" ::: "memory");
            const unsigned og = xb_add(&bar[XB_TOP], 1u);
            const unsigned tg = og / nx;
            if (og + 1u == (tg + 1u) * nx) xb_add(&bar[XB_TOPGEN], 1u);
            else XB_SPIN(xb_ld(&bar[XB_TOPGEN]) == tg, bar);
            __builtin_amdgcn_fence(__ATOMIC_ACQUIRE, "agent");
            xb_add(&bar[XB_XGEN(b.x)], 1u);
            asm volatile("s_waitcnt vmcnt(0)" ::: "memory");
        } else {
            XB_SPIN(xb_ld(&bar[XB_XGEN(b.x)]) == gen, bar);
            __builtin_amdgcn_fence(__ATOMIC_ACQUIRE, "agent");
            asm volatile("s_waitcnt vmcnt(0)" ::: "memory");
        }
    }
    __syncthreads();
}

struct Frame {
    const float* const* in; float* out; unsigned char* ws; unsigned* ctl;
    unsigned char* lds;
    int tid, lane, wave, G, bid;
};
#define WSP(T, off) ((T*)(F.ws + (off)))
DI void refresh(Frame& F) { int t = threadIdx.x; asm volatile("" : "+v"(t)); F.tid = t; F.lane = t & 63; F.wave = __builtin_amdgcn_readfirstlane(t >> 6);
}

namespace pg8 {
constexpr int BM = 256, BK = 64, HALF = 128, HTB = HALF * BK * 2, STAGE_BYTES = 8 * HTB, NXCD = 8, WGM = 8;
DI int lds_byte(int r, int c) { const int st = (r >> 4) * 2 + (c >> 5), rr = r & 15, cc = c & 31, ob = rr * 64 + cc * 2; return st * 1024 + (ob ^ (((ob >> 9) & 1) << 5)); }
DI void stage_rc(int b, int& R, int& C) { const int st = b / 1024, sb = b % 1024, swz = sb ^ (((sb >> 9) & 1) << 5); R = (st >> 1) * 16 + swz / 64; C = (st & 1) * 32 + (swz % 64) / 2; }
struct Unit { int pm, pn, e; };
struct Gemm { const bf16_t* A; const bf16_t* Bt; int K; size_t bstride; };
struct StaticOrder {
    int nM, nN, nwg, G, c;
    DI void init(int M, int N, int G_, int c_) { nM = M / BM; nN = N / BM; nwg = nM * nN; G = G_; c = c_; }
    DI bool next(int i, Unit& u) const {
        const long L = (long)i * G + c; if (L >= nwg) return false;
        int wgid = (int)L; { const int q = nwg / NXCD, r = nwg % NXCD, xcd = wgid % NXCD, off = wgid / NXCD; wgid = (xcd < r ? xcd * (q + 1) : r * (q + 1) + (xcd - r) * q) + off; }
        const int nig = WGM * nN, gid = wgid / nig, fm = gid * WGM, gsz = (nM - fm) < WGM ? (nM - fm) : WGM;
        u.pm = fm + ((wgid % nig) % gsz); u.pn = (wgid % nig) / gsz; u.e = 0; return true;
    }
};
struct MoeOrder {
    const int* toff; int ntile, nN, G, c;
    DI bool next(int i, Unit& u) const {
        const long L = (long)i * G + c; if (L >= (long)ntile * nN) return false;
        const int t = (int)(L / nN); u.pm = t; u.pn = (int)(L % nN);
        u.e = toff[t]; return true;
    }
};

template <class Epi, class Sched>
DI void gemm_phase(LAS unsigned char* lds, const Gemm g, const Sched& S, const Epi& E, int tid) {
    const int wid = __builtin_amdgcn_readfirstlane(tid >> 6), lane = tid & 63, wr = wid >> 2, wc = wid & 3, fr = lane & 15, fq = lane >> 4;
    const int K = g.K, nt = K / BK;
    unsigned voffA[2];
#pragma unroll
    for (int i = 0; i < 2; ++i) { int R, C; stage_rc(tid * 16 + i * 8192, R, C); voffA[i] = (unsigned)(R * K + C) * 2u; }
    const size_t kstep = (size_t)(BK * 2);
    const size_t hstep = (size_t)HALF * K * 2;
    const size_t tstep = 2 * hstep;
    const unsigned ldsw = (unsigned)wid * 1024u;
    const int aoff = lds_byte(wr * 64 + fr, fq * 8), boff = lds_byte(wc * 32 + fr, fq * 8);
#define PG8_SA(b, h) (((b) * 2 + (h)) * HTB)
#define PG8_SB(b, h) ((4 + (b) * 2 + (h)) * HTB)
#define PG8_STAGE(bufoff, gbase, voff) do { _Pragma("unroll") for (int _i = 0; _i < 2; ++_i) \
        __builtin_amdgcn_global_load_lds((const unsigned*)((const char*)(gbase) + (voff)[_i]), (LAS unsigned*)(lds + (bufoff) + ldsw + _i * 8192), 16, 0, 0); } while (0)
#define PG8_LDA(dst, b, h) do { _Pragma("unroll") for (int m = 0; m < 4; ++m) _Pragma("unroll") for (int k = 0; k < 2; ++k) dst[m][k] = *(const LAS bf16x8*)(lds + PG8_SA(b, h) + aoff + m * 2048 + k * 1024); } while (0)
#define PG8_LDB(dst, b, h) do { _Pragma("unroll") for (int n = 0; n < 2; ++n) _Pragma("unroll") for (int k = 0; k < 2; ++k) dst[n][k] = *(const LAS bf16x8*)(lds + PG8_SB(b, h) + boff + n * 2048 + k * 1024); } while (0)
#define PG8_MMA(ai, bj, At, Bt) do { __builtin_amdgcn_s_setprio(1); _Pragma("unroll") for (int m = 0; m < 4; ++m) _Pragma("unroll") for (int n = 0; n < 2; ++n) _Pragma("unroll") for (int k = 0; k < 2; ++k) \
        acc[ai][bj][m][n] = __builtin_amdgcn_mfma_f32_16x16x32_bf16(Bt[n][k], At[m][k], acc[ai][bj][m][n], 0, 0, 0); __builtin_amdgcn_s_setprio(0); } while (0)
#define PG8_WAIT_V(n) asm volatile("s_waitcnt vmcnt(" #n ")" ::: "memory")
#define PG8_WAIT_L(n) asm volatile("s_waitcnt lgkmcnt(" #n ")" ::: "memory")
#define PG8_BAR __builtin_amdgcn_s_barrier()
#define PG8_SCHED __builtin_amdgcn_sched_barrier(0)
    Unit cur, nxt; int ui = 0;
    if (!S.next(0, cur)) return;
    f32x4 acc[2][2][4][2];
#pragma unroll
    for (int a = 0; a < 2; ++a)
#pragma unroll
        for (int b = 0; b < 2; ++b)
#pragma unroll
            for (int m = 0; m < 4; ++m)
#pragma unroll
                for (int n = 0; n < 2; ++n) acc[a][b][m][n] = (f32x4){0.f, 0.f, 0.f, 0.f};
    bf16x8 At[4][2], B0[2][2], B1[2][2];
    const char* cA = (const char*)g.A + (size_t)cur.pm * tstep; const char* cB = (const char*)(g.Bt + (size_t)cur.e * g.bstride) + (size_t)cur.pn * tstep;
    PG8_STAGE(PG8_SB(0, 0), cB, voffA); PG8_STAGE(PG8_SA(0, 0), cA, voffA); PG8_STAGE(PG8_SB(0, 1), cB + hstep, voffA); PG8_STAGE(PG8_SA(0, 1), cA + hstep, voffA);
    if (wr == 1) PG8_BAR;
    PG8_WAIT_V(4); PG8_BAR;
    PG8_STAGE(PG8_SB(1, 0), cB + kstep, voffA); PG8_STAGE(PG8_SA(1, 0), cA + kstep, voffA); PG8_STAGE(PG8_SB(1, 1), cB + hstep + kstep, voffA);
    PG8_WAIT_V(6); PG8_BAR;
    for (;;) {
        const bool has_next = S.next(ui + 1, nxt);
        const char* nA = has_next ? (const char*)g.A + (size_t)nxt.pm * tstep : cA; const char* nB = has_next ? (const char*)(g.Bt + (size_t)nxt.e * g.bstride) + (size_t)nxt.pn * tstep : cB;
        for (int t = 0; t < nt; t += 2) {
            const bool last = (t == nt - 2);
            const char* a1 = cA + (size_t)(t + 1) * kstep;
            const char* a2 = last ? nA : cA + (size_t)(t + 2) * kstep; const char* b2 = last ? nB : cB + (size_t)(t + 2) * kstep;
            const char* a3 = a2 + kstep; const char* b3 = b2 + kstep;
            PG8_LDB(B0, 0, 0); PG8_SCHED; PG8_LDA(At, 0, 0); PG8_STAGE(PG8_SA(1, 1), a1 + hstep, voffA);
            PG8_WAIT_L(8); PG8_BAR; PG8_WAIT_L(0); PG8_MMA(0, 0, At, B0); PG8_BAR; PG8_SCHED;
            PG8_LDB(B1, 0, 1); PG8_STAGE(PG8_SB(0, 0), b2, voffA);
            PG8_BAR; PG8_WAIT_L(0); PG8_MMA(0, 1, At, B1); PG8_BAR;
            PG8_LDA(At, 0, 1); PG8_STAGE(PG8_SA(0, 0), a2, voffA);
            PG8_BAR; PG8_WAIT_L(0); PG8_MMA(1, 0, At, B0); PG8_BAR; PG8_SCHED;
            PG8_STAGE(PG8_SB(0, 1), b2 + hstep, voffA);
            PG8_WAIT_V(6); PG8_BAR; PG8_MMA(1, 1, At, B1); PG8_BAR;
            PG8_LDB(B0, 1, 0); PG8_SCHED; PG8_LDA(At, 1, 0); PG8_STAGE(PG8_SA(0, 1), a2 + hstep, voffA);
            PG8_WAIT_L(8); PG8_BAR; PG8_WAIT_L(0); PG8_MMA(0, 0, At, B0); PG8_BAR; PG8_SCHED;
            PG8_LDB(B1, 1, 1); PG8_STAGE(PG8_SB(1, 0), b3, voffA);
            PG8_BAR; PG8_WAIT_L(0); PG8_MMA(0, 1, At, B1); PG8_BAR;
            PG8_LDA(At, 1, 1); PG8_STAGE(PG8_SA(1, 0), a3, voffA);
            PG8_BAR; PG8_WAIT_L(0); PG8_MMA(1, 0, At, B0); PG8_BAR; PG8_SCHED;
            PG8_STAGE(PG8_SB(1, 1), b3 + hstep, voffA);
            PG8_WAIT_V(6); PG8_BAR; PG8_MMA(1, 1, At, B1); PG8_BAR;
        }
        E(acc, cur, wr, wc, fr, fq);
        if (!has_next) break;
#pragma unroll
        for (int a = 0; a < 2; ++a)
#pragma unroll
            for (int b = 0; b < 2; ++b)
#pragma unroll
                for (int m = 0; m < 4; ++m)
#pragma unroll
                    for (int n = 0; n < 2; ++n) acc[a][b][m][n] = (f32x4){0.f, 0.f, 0.f, 0.f};
        cur = nxt; cA = nA; cB = nB; ++ui;
    }
    PG8_WAIT_V(0);
    if (wr == 0) PG8_BAR;
    PG8_BAR;
#undef PG8_SA
#undef PG8_SB
#undef PG8_STAGE
#undef PG8_LDA
#undef PG8_LDB
#undef PG8_MMA
#undef PG8_WAIT_V
#undef PG8_WAIT_L
#undef PG8_BAR
#undef PG8_SCHED
}
}

typedef f32x4 AccT[2][2][4][2];

struct EpiIn {
    unsigned char* ws; const float* rope; unsigned* kmax; unsigned* kmaxb;
    DI void operator()(const AccT& acc, const pg8::Unit& u, int wr, int wc, int fr, int fq) const {
        const int pn = u.pn, row0 = u.pm * 256 + wr * 64 + fr;
        const bool isctx = (u.pm >= NLAT / 256);
        if (pn <= 1) {
            bf16_t* dst = (bf16_t*)(ws + (pn == 0 ? WS_AQ : WS_AK));
            const float sc = (pn == 0) ? QSCALE_A : 1.f;
            float nmax[2] = {0.f, 0.f};
#pragma unroll
            for (int ai = 0; ai < 2; ++ai)
#pragma unroll
                for (int m = 0; m < 4; ++m) {
                    const int r = row0 + ai * 128 + m * 16;
                    f32x4 cs0 = (f32x4){1.f, 0.f, 1.f, 0.f}, cs1 = cs0;
                    if (!isctx) { const int t = r & (S - 1); const int pos = (fq < 2) ? (t >> 6) : (t & 63);
                        const f32x4* tp = (const f32x4*)(rope + (size_t)pos * 16 + (fq & 1) * 8); cs0 = tp[0]; cs1 = tp[1]; }
                    const float cc[4] = {cs0[0], cs0[2], cs1[0], cs1[2]}, ss[4] = {cs0[1], cs0[3], cs1[1], cs1[3]};
#pragma unroll
                    for (int bj = 0; bj < 2; ++bj) {
                        const f32x4 x1 = acc[ai][bj][m][0], x2 = acc[ai][bj][m][1];
                        float o1[4], o2[4], n2 = 0.f;
#pragma unroll
                        for (int j = 0; j < 4; ++j) { o1[j] = (x1[j] * cc[j] - x2[j] * ss[j]) * sc; o2[j] = (x2[j] * cc[j] + x1[j] * ss[j]) * sc; n2 += x1[j] * x1[j] + x2[j] * x2[j]; }
                        bf16_t* p = dst + (size_t)r * 256 + bj * 128 + wc * 32 + 4 * fq;
                        *(u32x2*)p = (u32x2){pk2(o1[0], o1[1]), pk2(o1[2], o1[3])};
                        *(u32x2*)(p + 16) = (u32x2){pk2(o2[0], o2[1]), pk2(o2[2], o2[3])};
                        if (pn == 1) { n2 += swz_xor<16>(n2); n2 = half_sum(n2); nmax[bj] = fmaxf(nmax[bj], n2); }
                    }
                }
            if (pn == 1) {
                const int b = isctx ? (u.pm - NLAT / 256) : (u.pm / (S / 256));
#pragma unroll
                for (int bj = 0; bj < 2; ++bj) {
                    float v = nmax[bj];
                    v = fmaxf(v, swz_xor<1>(v)); v = fmaxf(v, swz_xor<2>(v)); v = fmaxf(v, swz_xor<4>(v)); v = fmaxf(v, swz_xor<8>(v));
                    if ((fr | fq) == 0) atomicMax(kmax + (b * 4 + (2 * bj + (wc >> 1))) * 2 + (wc & 1), __float_as_uint(v));
                }
            }
        } else if (pn == 2 || pn == 5) {
            bf16_t* dst = (bf16_t*)(ws + (pn == 2 ? WS_AVT : WS_BVT));
#pragma unroll
            for (int ai = 0; ai < 2; ++ai)
#pragma unroll
                for (int m = 0; m < 4; ++m) {
                    const int r = row0 + ai * 128 + m * 16;
                    int b, key; if (isctx) { b = (r - NLAT) >> 8; key = (r - NLAT) & 255; } else { b = r >> 14; key = CTX + (r & (S - 1)); }
#pragma unroll
                    for (int bj = 0; bj < 2; ++bj)
#pragma unroll
                        for (int n = 0; n < 2; ++n) {
                            const int lc = bj * 128 + wc * 32 + n * 16 + 4 * fq;
#pragma unroll
                            for (int j = 0; j < 4; ++j) dst[((size_t)(b * 256 + lc + j)) * NKEY + key] = f2bf(acc[ai][bj][m][n][j]);
                        }
                }
        } else if (pn <= 6) {
            bf16_t* dst = (bf16_t*)(ws + (pn == 3 ? WS_BQ : pn == 4 ? WS_BK : WS_PL));
            const float sc = (pn == 3) ? QSCALE_B : 1.f;
            float nmax[2] = {0.f, 0.f};
#pragma unroll
            for (int ai = 0; ai < 2; ++ai)
#pragma unroll
                for (int m = 0; m < 4; ++m) {
                    const int r = row0 + ai * 128 + m * 16;
#pragma unroll
                    for (int bj = 0; bj < 2; ++bj)
#pragma unroll
                        for (int n = 0; n < 2; ++n) {
                            const f32x4 v = acc[ai][bj][m][n] * sc;
                            *(u32x2*)(dst + (size_t)r * 256 + bj * 128 + wc * 32 + n * 16 + 4 * fq) = (u32x2){pk2(v[0], v[1]), pk2(v[2], v[3])};
                        }
                    if (pn == 4) {
#pragma unroll
                        for (int bj = 0; bj < 2; ++bj) { const f32x4 x1 = acc[ai][bj][m][0], x2 = acc[ai][bj][m][1];
                            float n2 = x1[0] * x1[0] + x1[1] * x1[1] + x1[2] * x1[2] + x1[3] * x1[3] + x2[0] * x2[0] + x2[1] * x2[1] + x2[2] * x2[2] + x2[3] * x2[3];
                            n2 += swz_xor<16>(n2); n2 = half_sum(n2); nmax[bj] = fmaxf(nmax[bj], n2); }
                    }
                }
            if (pn == 4) {
                const int b = isctx ? (u.pm - NLAT / 256) : (u.pm / (S / 256));
#pragma unroll
                for (int bj = 0; bj < 2; ++bj) {
                    float v = nmax[bj];
                    v = fmaxf(v, swz_xor<1>(v)); v = fmaxf(v, swz_xor<2>(v)); v = fmaxf(v, swz_xor<4>(v)); v = fmaxf(v, swz_xor<8>(v));
                    if ((fr | fq) == 0) atomicMax(kmaxb + (b * 4 + (2 * bj + (wc >> 1))) * 2 + (wc & 1), __float_as_uint(v));
                }
            }
        } else {
            const int hc0 = (pn - 7) * 256;
#pragma unroll
            for (int ai = 0; ai < 2; ++ai)
#pragma unroll
                for (int m = 0; m < 4; ++m) {
                    const int r = row0 + ai * 128 + m * 16;
#pragma unroll
                    for (int bj = 0; bj < 2; ++bj)
#pragma unroll
                        for (int n = 0; n < 2; ++n) {
                            const int hc = hc0 + bj * 128 + wc * 32 + n * 16 + 4 * fq; const f32x4 v = acc[ai][bj][m][n];
                            if (isctx) *(u32x2*)((bf16_t*)(ws + WS_HYC) + (size_t)(r - NLAT) * 768 + hc) = (u32x2){pk2(v[0], v[1]), pk2(v[2], v[3])};
                            else { bf16_t* dst = (bf16_t*)(ws + WS_HYT) + ((size_t)(r >> 14) * 768 + hc) * S + (r & (S - 1));
#pragma unroll
                                for (int j = 0; j < 4; ++j) dst[(size_t)j * S] = f2bf(v[j]); }
                        }
                }
        }
    }
};

struct EpiOut {
    const float* xl_old; const float* xc_old; float* xl_new; float* xc_new; const float* mod;
    DI void operator()(const AccT& acc, const pg8::Unit& u, int wr, int wc, int fr, int fq) const {
        const int row0 = u.pm * 256 + wr * 64 + fr; const bool isctx = (u.pm >= NLAT / 256);
        const int v = isctx ? 2 : (u.pm / (S / 256));
        const float* g1 = mod + (size_t)v * 6144 + 2 * 1024;
        const float* so = isctx ? xc_old - (size_t)NLAT * D : xl_old; float* dn = isctx ? xc_new - (size_t)NLAT * D : xl_new;
#pragma unroll
        for (int bj = 0; bj < 2; ++bj)
#pragma unroll
            for (int n = 0; n < 2; ++n) {
                const int c = u.pn * 256 + bj * 128 + wc * 32 + n * 16 + 4 * fq;
                const f32x4 g = *(const f32x4*)(g1 + c);
#pragma unroll
                for (int ai = 0; ai < 2; ++ai)
#pragma unroll
                    for (int m = 0; m < 4; ++m) {
                        const size_t o = (size_t)(row0 + ai * 128 + m * 16) * D + c;
                        *(f32x4*)(dn + o) = *(const f32x4*)(so + o) + g * acc[ai][bj][m][n];
                    }
            }
    }
};

struct EpiMoe1 {
    bf16_t* hmid;
    DI void operator()(const AccT& acc, const pg8::Unit& u, int wr, int wc, int fr, int fq) const {
        const int row0 = u.pm * 256 + wr * 64 + fr;
#pragma unroll
        for (int ai = 0; ai < 2; ++ai)
#pragma unroll
            for (int m = 0; m < 4; ++m)
#pragma unroll
                for (int bj = 0; bj < 2; ++bj) {
                    const f32x4 a = acc[ai][bj][m][0], b = acc[ai][bj][m][1]; float h[4];
#pragma unroll
                    for (int j = 0; j < 4; ++j) h[j] = siluf(a[j]) * b[j];
                    *(u32x2*)(hmid + (size_t)(row0 + ai * 128 + m * 16) * DE + (u.pn * 256 + bj * 128 + wc * 32) / 2 + 4 * fq) = (u32x2){pk2(h[0], h[1]), pk2(h[2], h[3])};
                }
    }
};
struct EpiMoe2 {
    bf16_t* ys;
    DI void operator()(const AccT& acc, const pg8::Unit& u, int wr, int wc, int fr, int fq) const {
        const int row0 = u.pm * 256 + wr * 64 + fr;
#pragma unroll
        for (int ai = 0; ai < 2; ++ai)
#pragma unroll
            for (int m = 0; m < 4; ++m)
#pragma unroll
                for (int bj = 0; bj < 2; ++bj)
#pragma unroll
                    for (int n = 0; n < 2; ++n) { const f32x4 v = acc[ai][bj][m][n];
                        *(u32x2*)(ys + (size_t)(row0 + ai * 128 + m * 16) * D + u.pn * 256 + bj * 128 + wc * 32 + n * 16 + 4 * fq) = (u32x2){pk2(v[0], v[1]), pk2(v[2], v[3])}; }
    }
};

DI void tconv_tile(const Frame& F, const float* src, int N, int k0, int n0, bf16_t* dst, int ldd, int mode) {
    float* tl = (float*)F.lds;
    __syncthreads();
#pragma unroll
    for (int i = 0; i < 8; ++i) { const int idx = F.tid + 512 * i, k = idx >> 6, n = idx & 63; tl[k * 65 + n] = src[(size_t)(k0 + k) * N + n0 + n]; }
    __syncthreads();
#pragma unroll
    for (int i = 0; i < 4; ++i) { const int idx = F.tid + 512 * i, n = idx >> 5, kp = idx & 31;
        const int nn = n0 + n; const int row = (mode == 0) ? nn : ((nn >> 4) * 32 + (mode - 1) * 16 + (nn & 15));
        *(unsigned*)(dst + (size_t)row * ldd + k0 + 2 * kp) = pk2(tl[(2 * kp) * 65 + n], tl[(2 * kp + 1) * 65 + n]); }
}
DI void phase_prologue(const Frame& F) {
    const int T_IN = 16 * 40, T_OUT = 16 * 16, T_E = 16 * 8;
    const int per_layer = T_IN + T_OUT + NE * 3 * T_E, total = 2 * per_layer;
    for (int u = F.bid; u < total; u += F.G) {
        const int li = u / per_layer; int r = u % per_layer;
        if (r < T_IN) { tconv_tile(F, F.in[I_WIN] + (size_t)li * D * DIN, DIN, (r / 40) * 64, (r % 40) * 64, WSP(bf16_t, WS_WIN) + (size_t)li * DIN * D, D, 0); continue; }
        r -= T_IN;
        if (r < T_OUT) { tconv_tile(F, F.in[I_WOUT] + (size_t)li * D * D, D, (r / 16) * 64, (r % 16) * 64, WSP(bf16_t, WS_WOUT) + (size_t)li * D * D, D, 0); continue; }
        r -= T_OUT;
        const int e = r / (3 * T_E), w = (r / T_E) % 3, t = r % T_E;
        if (w < 2) tconv_tile(F, F.in[w == 0 ? I_MW1 : I_MW3] + ((size_t)li * NE + e) * D * DE, DE, (t / 8) * 64, (t % 8) * 64, WSP(bf16_t, WS_W13) + ((size_t)li * NE + e) * 1024 * 1024, D, 1 + w);
        else tconv_tile(F, F.in[I_MW2] + ((size_t)li * NE + e) * DE * D, D, (t / 16) * 64, (t % 16) * 64, WSP(bf16_t, WS_W2) + ((size_t)li * NE + e) * 1024 * 512, DE, 0);
    }
    __syncthreads();
    {
        float* sc = (float*)F.lds;
        float* red = sc + 3072;
        for (int i = F.tid; i < 3072; i += NTHR) { const int v = i >> 10, k = i & 1023; const float x = (v < 2) ? F.in[I_C][v * 1024 + k] : F.in[I_CCTX][k]; sc[i] = siluf(x); }
        __syncthreads();
        for (int u = F.bid; u < 2 * 96; u += F.G) {
            const int li = u / 96, j = (u % 96) * 64 + F.lane, ko = F.wave;
            const float* w = F.in[I_ADAW] + (size_t)li * D * 6144 + j;
            float a0 = 0.f, a1 = 0.f, a2 = 0.f;
            for (int k = ko * 128; k < ko * 128 + 128; ++k) { const float wv = w[(size_t)k * 6144]; a0 += sc[k] * wv; a1 += sc[1024 + k] * wv; a2 += sc[2048 + k] * wv; }
            red[(ko * 3 + 0) * 64 + F.lane] = a0; red[(ko * 3 + 1) * 64 + F.lane] = a1; red[(ko * 3 + 2) * 64 + F.lane] = a2;
            __syncthreads();
            if (F.tid < 192) { const int v = F.tid / 64, l = F.tid % 64; float s = 0.f;
#pragma unroll
                for (int q = 0; q < 8; ++q) s += red[(q * 3 + v) * 64 + l];
                const int jj = (u % 96) * 64 + l;
                WSP(float, WS_MOD)[((size_t)li * 3 + v) * 6144 + jj] = s + F.in[I_ADAB][li * 6144 + jj]; }
            __syncthreads();
        }
    }
    if (F.bid == (F.G > 1 ? 1 : 0)) {
        for (int i = F.tid; i < 256 * 8; i += NTHR) { const int pos = i >> 3, f = i & 7; const float inv = exp2f(-(float)f * (13.287712379549449f / 8.f)); const float rev = (float)pos * inv * 0.15915494309189535f;
            WSP(float, WS_ROPE)[i * 2] = cos_rev(rev); WSP(float, WS_ROPE)[i * 2 + 1] = sin_rev(rev); }
    }
}

DI void filter_tile(const Frame& F, int li, int L, int tile, float* hT, float* part) {
    float* h1s = (float*)F.lds;
    float* h2s = h1s + 4096;
    float* stg = h2s + 4096;
    float* sq2 = stg + 256 * 65;
    const float* w1 = F.in[I_HW1] + (size_t)li * 33 * 64; const float* b1 = F.in[I_HB1] + li * 64;
    const float* w2 = F.in[I_HW2] + (size_t)li * 64 * 64; const float* b2 = F.in[I_HB2] + li * 64;
    const float* w3 = F.in[I_HW3] + (size_t)li * 64 * 1024; const float* b3 = F.in[I_HB3] + li * 1024;
    const int t0 = tile * 64;
    const float inv_lm1 = 1.f / (float)(L > 1 ? L - 1 : 1);
    __syncthreads();
    {
        const int tl = F.tid & 63, pt = F.tid >> 6; const float t = (float)(t0 + tl);
        float a[8];
#pragma unroll
        for (int jj = 0; jj < 8; ++jj) a[jj] = b1[pt * 8 + jj] + (t * inv_lm1) * w1[pt * 8 + jj];
#pragma unroll 1
        for (int i = 0; i < 16; ++i) { const float band = 1e-4f + (15.f - 1e-4f) * (float)i / 15.f; const float rev = t * band / (float)L; const float cz = cos_rev(rev), sz = sin_rev(rev);
#pragma unroll
            for (int jj = 0; jj < 8; ++jj) a[jj] += cz * w1[(1 + i) * 64 + pt * 8 + jj] + sz * w1[(17 + i) * 64 + pt * 8 + jj]; }
#pragma unroll
        for (int jj = 0; jj < 8; ++jj) h1s[tl * 64 + pt * 8 + jj] = sin_rad(a[jj]);
    }
    __syncthreads();
    {
        const int tl = F.tid & 63, pt = F.tid >> 6;
        float a[8];
#pragma unroll
        for (int jj = 0; jj < 8; ++jj) a[jj] = b2[pt * 8 + jj];
#pragma unroll 1
        for (int i = 0; i < 64; ++i) { const float hv = h1s[tl * 64 + i];
#pragma unroll
            for (int jj = 0; jj < 8; ++jj) a[jj] += hv * w2[i * 64 + pt * 8 + jj]; }
#pragma unroll
        for (int jj = 0; jj < 8; ++jj) h2s[tl * 64 + pt * 8 + jj] = sin_rad(a[jj]);
    }
    __syncthreads();
    const int c = F.tid & 255, th = F.tid >> 8;
    const float delta = 3.0701134573253945f + (15.350567286626973f - 3.0701134573253945f) * (float)c / 255.f;
#pragma unroll 1
    for (int cc = 0; cc < 4; ++cc) {
        float wr[64];
#pragma unroll
        for (int i = 0; i < 64; ++i) wr[i] = w3[(size_t)i * 1024 + cc * 256 + c];
        const float bb = b3[cc * 256 + c]; float sq = 0.f;
#pragma unroll 1
        for (int tt = th * 32; tt < th * 32 + 32; ++tt) {
            float a = bb;
#pragma unroll
            for (int i = 0; i < 64; ++i) a += h2s[tt * 64 + i] * wr[i];
            a *= __expf(-((float)(t0 + tt) * inv_lm1) * delta);
            stg[c * 65 + tt] = a; sq += a * a;
        }
        if (th == 1) sq2[c] = sq;
        __syncthreads();
        if (th == 0) part[(size_t)tile * 1024 + cc * 256 + c] = sq + sq2[c];
        for (int ch = F.wave * 32; ch < F.wave * 32 + 32; ++ch) hT[((size_t)cc * 256 + ch) * L + t0 + F.lane] = stg[ch * 65 + F.lane];
        __syncthreads();
    }
}

struct TokInfo { unsigned e0, e1, p0, p1; float g0, g1; unsigned s0, s1; };
DI void phase_norm1(const Frame& F, int li, int mode) {
    const int nrows = (mode == 2) ? NLAT : NTOK;
    const float* modp = WSP(float, WS_MOD) + (size_t)li * 3 * 6144;
    const float* modprev = WSP(float, WS_MOD) + (size_t)(mode == 2 ? 1 : li - 1) * 3 * 6144;
    const float* gam = (mode == 2) ? F.in[I_FG] : F.in[I_N1G] + (size_t)li * D;
    const TokInfo* tok = WSP(TokInfo, WS_TOK); const bf16_t* ys = WSP(bf16_t, WS_A1);
    bf16_t* hbf = WSP(bf16_t, WS_HBF);
    auto xrowp = [&](int r) -> float* { return r >= NLAT ? WSP(float, WS_XC) + (size_t)(r - NLAT) * D : F.out + (size_t)r * D; };
    auto srcp = [&](int r) -> const float* { return (mode == 0) ? (r >= NLAT ? F.in[I_CTX] + (size_t)(r - NLAT) * D : F.in[I_X] + (size_t)r * D) : (const float*)xrowp(r); };
    const int r0 = F.bid * 8 + F.wave, rstep = F.G * 8, lc = F.lane * 4;
    f32x4 xn[4]; u32x2 yan[4], ybn[4]; TokInfo t1 = {}, t2 = {};
    if (r0 < nrows) {
#pragma unroll
        for (int i = 0; i < 4; ++i) xn[i] = *(const f32x4*)(srcp(r0) + i * 256 + lc);
        if (mode != 0) { t1 = tok[r0]; if (r0 + rstep < nrows) t2 = tok[r0 + rstep];
#pragma unroll
            for (int i = 0; i < 4; ++i) { yan[i] = *(const u32x2*)(ys + (size_t)t1.s0 * D + i * 256 + lc); ybn[i] = *(const u32x2*)(ys + (size_t)t1.s1 * D + i * 256 + lc); } }
    }
    for (int r = r0; r < nrows; r += rstep) {
        const bool isctx = r >= NLAT; const int v = isctx ? 2 : (r >> 14);
        f32x4 x[4]; u32x2 ya[4], yb[4]; const TokInfo ti = t1;
#pragma unroll
        for (int i = 0; i < 4; ++i) { x[i] = xn[i]; ya[i] = yan[i]; yb[i] = ybn[i]; }
        if (r + rstep < nrows) {
#pragma unroll
            for (int i = 0; i < 4; ++i) xn[i] = *(const f32x4*)(srcp(r + rstep) + i * 256 + lc);
            if (mode != 0) { t1 = t2; if (r + 2 * rstep < nrows) t2 = tok[r + 2 * rstep];
#pragma unroll
                for (int i = 0; i < 4; ++i) { yan[i] = *(const u32x2*)(ys + (size_t)t1.s0 * D + i * 256 + lc); ybn[i] = *(const u32x2*)(ys + (size_t)t1.s1 * D + i * 256 + lc); } }
        }
        if (mode != 0) {
            const float* g2 = modprev + (size_t)v * 6144 + 5 * 1024;
#pragma unroll
            for (int i = 0; i < 4; ++i) {
                const u32x2 a = ya[i], b = yb[i];
                const f32x4 gg = *(const f32x4*)(g2 + i * 256 + lc);
                f32x4 y;
                y[0] = ti.g0 * __uint_as_float(a[0] << 16) + ti.g1 * __uint_as_float(b[0] << 16);
                y[1] = ti.g0 * __uint_as_float(a[0] & 0xffff0000u) + ti.g1 * __uint_as_float(b[0] & 0xffff0000u);
                y[2] = ti.g0 * __uint_as_float(a[1] << 16) + ti.g1 * __uint_as_float(b[1] << 16);
                y[3] = ti.g0 * __uint_as_float(a[1] & 0xffff0000u) + ti.g1 * __uint_as_float(b[1] & 0xffff0000u);
                x[i] = x[i] + gg * y;
            }
            if (mode == 1) { float* xrow = xrowp(r);
#pragma unroll
                for (int i = 0; i < 4; ++i) *(f32x4*)(xrow + i * 256 + lc) = x[i]; }
        }
        float ss = 0.f;
#pragma unroll
        for (int i = 0; i < 4; ++i) ss += x[i][0] * x[i][0] + x[i][1] * x[i][1] + x[i][2] * x[i][2] + x[i][3] * x[i][3];
        ss = wave_sum(ss);
        const float rstd = rsqrtf(ss * (1.f / D) + EPS);
#pragma unroll
        for (int i = 0; i < 4; ++i) {
            const int c = i * 256 + lc;
            const f32x4 g = *(const f32x4*)(gam + c);
            if (mode == 2) { *(f32x4*)(F.out + (size_t)r * D + c) = x[i] * rstd * g; }
            else {
                const f32x4 sh = *(const f32x4*)(modp + (size_t)v * 6144 + c), sc = *(const f32x4*)(modp + (size_t)v * 6144 + 1024 + c);
                const f32x4 h = x[i] * rstd * g * (sc + 1.f) + sh;
                *(u32x2*)(hbf + (size_t)r * D + c) = (u32x2){pk2(h[0], h[1]), pk2(h[2], h[3])};
            }
        }
    }
}

DI void phase_norm2(const Frame& F, int li, int nrows) {
    float* wt = (float*)F.lds;
    __syncthreads();
    for (int i = F.tid; i < 16384; i += NTHR) { const int k = i >> 4, e = i & 15; wt[e * 1024 + k] = F.in[I_RW][i]; }
    __syncthreads();
    const float* modp = WSP(float, WS_MOD) + (size_t)li * 3 * 6144;
    const float* gam = F.in[I_N2G] + (size_t)li * D;
    bf16_t* hbf = WSP(bf16_t, WS_HBF); TokInfo* tok = WSP(TokInfo, WS_TOK);
    unsigned* lcnt = (unsigned*)(F.lds + LDS_MISC + 64);
    if (F.tid < 16) lcnt[F.tid] = 0u;
    __syncthreads();
    auto rowp = [&](int r) -> const float* { return r >= NLAT ? WSP(float, WS_XC) + (size_t)(r - NLAT) * D : F.out + (size_t)r * D; };
    const int r_first = F.bid * 8 + F.wave, rstep = F.G * 8;
    f32x4 xn[4];
    if (r_first < nrows) {
#pragma unroll
        for (int i = 0; i < 4; ++i) xn[i] = *(const f32x4*)(rowp(r_first) + i * 256 + F.lane * 4);
    }
    const bool b2 = (F.lane & 4) != 0, b3 = (F.lane & 8) != 0, b4 = (F.lane & 16) != 0;
    for (int r = r_first; r < nrows; r += rstep) {
        const bool isctx = r >= NLAT; const int v = isctx ? 2 : (r >> 14);
        f32x4 x[4]; float ss = 0.f;
#pragma unroll
        for (int i = 0; i < 4; ++i) { x[i] = xn[i]; ss += x[i][0] * x[i][0] + x[i][1] * x[i][1] + x[i][2] * x[i][2] + x[i][3] * x[i][3]; }
        if (r + rstep < nrows) {
#pragma unroll
            for (int i = 0; i < 4; ++i) xn[i] = *(const f32x4*)(rowp(r + rstep) + i * 256 + F.lane * 4);
        }
        ss = wave_sum(ss);
        const float rstd = rsqrtf(ss * (1.f / D) + EPS);
        float lg[16];
#pragma unroll
        for (int e = 0; e < 16; ++e) lg[e] = 0.f;
#pragma unroll
        for (int i = 0; i < 4; ++i) {
            const int c = i * 256 + F.lane * 4;
            const f32x4 g = *(const f32x4*)(gam + c), sh = *(const f32x4*)(modp + (size_t)v * 6144 + 3 * 1024 + c), sc = *(const f32x4*)(modp + (size_t)v * 6144 + 4 * 1024 + c);
            const f32x4 h = x[i] * rstd * g * (sc + 1.f) + sh;
            *(u32x2*)(hbf + (size_t)r * D + c) = (u32x2){pk2(h[0], h[1]), pk2(h[2], h[3])};
#pragma unroll
            for (int e = 0; e < 16; ++e) { const f32x4 w = *(const f32x4*)(wt + e * 1024 + c); lg[e] += h[0] * w[0] + h[1] * w[1] + h[2] * w[2] + h[3] * w[3]; }
        }
        float a8[8], a4[4], a2[2];
#pragma unroll
        for (int e = 0; e < 8; ++e) { const auto rr = __builtin_amdgcn_permlane32_swap(__float_as_uint(lg[e]), __float_as_uint(lg[e + 8]), false, false); a8[e] = __uint_as_float(rr[0]) + __uint_as_float(rr[1]); }
#pragma unroll
        for (int e = 0; e < 4; ++e) { const float keep = b4 ? a8[e + 4] : a8[e], send = b4 ? a8[e] : a8[e + 4]; a4[e] = keep + swz_xor<16>(send); }
#pragma unroll
        for (int e = 0; e < 2; ++e) { const float keep = b3 ? a4[e + 2] : a4[e], send = b3 ? a4[e] : a4[e + 2]; a2[e] = keep + swz_xor<8>(send); }
        float a1 = (b2 ? a2[1] : a2[0]) + swz_xor<4>(b2 ? a2[0] : a2[1]);
        a1 += swz_xor<2>(a1); a1 += swz_xor<1>(a1);
#pragma unroll
        for (int e = 0; e < 16; ++e) lg[e] = __int_as_float(__builtin_amdgcn_readlane(__float_as_int(a1), 4 * e));
        float mx = lg[0];
#pragma unroll
        for (int e = 1; e < 16; ++e) mx = fmaxf(mx, lg[e]);
        float sc[16], sel[16], den = 0.f;
#pragma unroll
        for (int e = 0; e < 16; ++e) { sc[e] = __expf(lg[e] - mx); den += sc[e]; }
        const float rden = 1.f / den;
#pragma unroll
        for (int e = 0; e < 16; ++e) { sc[e] *= rden; sel[e] = sc[e] + F.in[I_RB][e]; }
        int bg = 0; float bgs = -1e30f;
#pragma unroll
        for (int g = 0; g < 4; ++g) {
            float m1 = -1e30f, m2 = -1e30f;
#pragma unroll
            for (int q = 0; q < 4; ++q) { const float s = sel[g * 4 + q]; if (s > m1) { m2 = m1; m1 = s; } else if (s > m2) m2 = s; }
            const float gs = m1 + m2; if (gs > bgs) { bgs = gs; bg = g; }
        }
        int e0 = 0, e1 = 0; float s0v = -1e30f, s1v = -1e30f, w0 = 0.f, w1 = 0.f;
#pragma unroll
        for (int e = 0; e < 16; ++e) {
            const bool ing = (e >> 2) == bg; const float s = sel[e];
            if (ing && s > s0v) { s1v = s0v; e1 = e0; w1 = w0; s0v = s; e0 = e; w0 = sc[e]; }
            else if (ing && s > s1v) { s1v = s; e1 = e; w1 = sc[e]; }
        }
        if (F.lane == 0) {
            TokInfo ti; ti.e0 = e0; ti.e1 = e1; ti.p0 = atomicAdd(lcnt + e0, 1u); ti.p1 = atomicAdd(lcnt + e1, 1u);
            const float ws = 1.f / (w0 + w1); ti.g0 = w0 * ws; ti.g1 = w1 * ws; ti.s0 = 0; ti.s1 = 0;
            tok[r] = ti;
        }
    }
    __syncthreads();
    if (F.tid < 16) F.ctl[CW_BCNT + (li * MAXG + F.bid) * 16 + F.tid] = lcnt[F.tid];
}

DI void moe_offsets(const Frame& F, int li, int* offs) {
    __syncthreads();
    int* tot = offs + 376;
    int* part = (int*)F.lds;
    {
        const int e = F.tid & 15, pq = F.tid >> 4;
        const unsigned* bc = F.ctl + CW_BCNT + li * MAXG * 16 + e;
        int st = 0, sb = 0;
#pragma unroll
        for (int k = 0; k < 8; ++k) { const int blk = pq * 8 + k; const int c = (blk < F.G) ? (int)__hip_atomic_load(bc + blk * 16, __ATOMIC_RELAXED, __HIP_MEMORY_SCOPE_AGENT) : 0; st += c; sb += (blk < F.bid) ? c : 0; }
        part[pq * 16 + e] = st; part[512 + pq * 16 + e] = sb;
    }
    __syncthreads();
    if (F.tid < 32) { const int e = F.tid & 15, wb = F.tid >> 4; int s = 0;
        for (int pq = 0; pq < 32; ++pq) s += part[wb * 512 + pq * 16 + e];
        if (wb) offs[360 + e] = s; else tot[e] = s; }
    __syncthreads();
    if (F.tid == 0) { int o = 0; for (int e = 0; e < NE; ++e) { offs[e] = o; offs[17 + e] = o >> 8; o += (tot[e] + 255) & ~255; }
        offs[16] = o; offs[17 + 16] = o >> 8; }
    __syncthreads();
    for (int t = F.tid; t < SLOT_CAP / 256; t += NTHR) { int e = 0; for (int k = 1; k < NE; ++k) e += (offs[17 + k] <= t) ? 1 : 0; offs[40 + t] = e; }
    if (F.tid < 16) offs[360 + F.tid] += offs[F.tid];
    __syncthreads();
}
DI void phase_gather(const Frame& F, int li, int nrows) {
    int* offs = (int*)(F.lds + LDS_MISC + 64);
    moe_offsets(F, li, offs);
    const bf16_t* hbf = WSP(bf16_t, WS_HBF); bf16_t* a1 = WSP(bf16_t, WS_A1); TokInfo* tok = WSP(TokInfo, WS_TOK);
    for (int r = F.bid * 8 + F.wave; r < nrows; r += F.G * 8) {
        TokInfo ti = tok[r];
        const unsigned s0 = offs[360 + ti.e0] + ti.p0, s1 = offs[360 + ti.e1] + ti.p1;
        const u32x4 a = *(const u32x4*)(hbf + (size_t)r * D + F.lane * 8), b = *(const u32x4*)(hbf + (size_t)r * D + 512 + F.lane * 8);
        *(u32x4*)(a1 + (size_t)s0 * D + F.lane * 8) = a; *(u32x4*)(a1 + (size_t)s0 * D + 512 + F.lane * 8) = b;
        *(u32x4*)(a1 + (size_t)s1 * D + F.lane * 8) = a; *(u32x4*)(a1 + (size_t)s1 * D + 512 + F.lane * 8) = b;
        if (F.lane == 0) { tok[r].s0 = s0; tok[r].s1 = s1; }
    }
}

#define MFMA32(a, b, c) __builtin_amdgcn_mfma_f32_32x32x16_bf16((a), (b), (c), 0, 0, 0)
DI float lam_of(const Frame& F, int li, float& lam_init) {
    const float* lv = F.in[I_ALAM] + (size_t)li * 128;
    const int i = F.lane & 31, hi = F.lane >> 5;
    float d = lv[hi * 64 + i] * lv[hi * 64 + 32 + i];
    d += swz_xor<16>(d); d += swz_xor<8>(d); d += swz_xor<4>(d); d += swz_xor<2>(d); d += swz_xor<1>(d);
    const float d0 = __int_as_float(__builtin_amdgcn_readlane(__float_as_int(d), 0)), d1 = __int_as_float(__builtin_amdgcn_readlane(__float_as_int(d), 32));
    float lif = (float)li; asm volatile("" : "+v"(lif));
    lam_init = 0.8f - 0.6f * __expf(-0.3f * lif);
    return __expf(d0) - __expf(d1) + lam_init;
}
DI bf16x8 pack8(const f32x16& x, int s) {
    u32x4 p; p[0] = pk2(x[8 * s], x[8 * s + 1]); p[1] = pk2(x[8 * s + 2], x[8 * s + 3]); p[2] = pk2(x[8 * s + 4], x[8 * s + 5]); p[3] = pk2(x[8 * s + 6], x[8 * s + 7]);
    return __builtin_bit_cast(bf16x8, p);
}

DI void diffattn_unit(const Frame& F, int li, int b, int h, size_t qrow0, int NT2) {
    const int lane = F.lane, r = lane & 31, hh = lane >> 5, c = F.wave & 1, g = F.wave >> 1;
    const bf16_t* AQ = WSP(bf16_t, WS_AQ); const bf16_t* AK = WSP(bf16_t, WS_AK); const bf16_t* AVT = WSP(bf16_t, WS_AVT) + (size_t)(b * 4 + h) * 64 * NKEY;
    float lam_init; const float lam = lam_of(F, li, lam_init);
    const size_t qrow = qrow0 + g * 32 + r;
    bf16x8 qf[2]; float qn2 = 0.f;
#pragma unroll
    for (int ks = 0; ks < 2; ++ks) { qf[ks] = *(const bf16x8*)(AQ + qrow * 256 + h * 64 + c * 32 + ks * 16 + 8 * hh);
#pragma unroll
        for (int j = 0; j < 8; ++j) { const float v = bf2f((bf16_t)qf[ks][j]); qn2 += v * v; } }
    qn2 = half_sum(qn2);
    f32x16 cinit;
    { const float km = sqrtf(__uint_as_float(__hip_atomic_load(F.ctl + CW_KMAX + li * 16 + (b * 4 + h) * 2 + c, __ATOMIC_RELAXED, __HIP_MEMORY_SCOPE_AGENT)));
      const float cn = -(sqrtf(qn2) * km * 1.02f + 1e-3f);
#pragma unroll
      for (int i = 0; i < 16; ++i) cinit[i] = cn; }
    f32x16 O[2];
#pragma unroll
    for (int dh = 0; dh < 2; ++dh)
#pragma unroll
        for (int i = 0; i < 16; ++i) O[dh][i] = 0.f;
    f32x16 lacc;
#pragma unroll
    for (int i = 0; i < 16; ++i) lacc[i] = 0.f;
    constexpr int KTB = 2 * 128 * 64, VTB = 64 * 264, STG = KTB + VTB;
    const int skey = F.tid >> 2, sq = F.tid & 3;
    const int kdst0 = (sq >> 1) * 8192 + skey * 64 + ((((sq & 1) * 2 + 0) ^ ((skey >> 2) & 3)) * 16);
    const int kdst1 = (sq >> 1) * 8192 + skey * 64 + ((((sq & 1) * 2 + 1) ^ ((skey >> 2) & 3)) * 16);
    const int vd = F.tid >> 3, vpart = F.tid & 7;
    const int vdst = KTB + vd * 264 + vpart * 32;
    auto krow_of = [&](int j) -> size_t { return j < CTX ? (size_t)NLAT + b * CTX + j : (size_t)b * S + (j - CTX); };
    unsigned char* L = F.lds;
    u32x4 kreg[2], vreg[2];
    { const bf16_t* kp = AK + krow_of(skey) * 256 + h * 64 + sq * 16; const bf16_t* vp = AVT + (size_t)vd * NKEY + vpart * 16;
      kreg[0] = *(const u32x4*)kp; kreg[1] = *(const u32x4*)(kp + 8); vreg[0] = *(const u32x4*)vp; vreg[1] = *(const u32x4*)(vp + 8); }
    __syncthreads();
    *(u32x4*)(L + kdst0) = kreg[0]; *(u32x4*)(L + kdst1) = kreg[1];
    *(u32x2*)(L + vdst) = (u32x2){vreg[0][0], vreg[0][1]}; *(u32x2*)(L + vdst + 8) = (u32x2){vreg[0][2], vreg[0][3]};
    *(u32x2*)(L + vdst + 16) = (u32x2){vreg[1][0], vreg[1][1]}; *(u32x2*)(L + vdst + 24) = (u32x2){vreg[1][2], vreg[1][3]};
    __syncthreads();
    const int ksw = (r >> 2) & 3;
    const int kr0 = c * 8192 + r * 64 + (((0 + hh) ^ ksw) * 16), kr1 = c * 8192 + r * 64 + (((2 + hh) ^ ksw) * 16);
    const int vr0 = r * 264 + 8 * hh;
#define DA_QK(Sx, st) do { \
        const bf16x8 k0 = *(const bf16x8*)(kb + (st) * 2048 + kr0), k1 = *(const bf16x8*)(kb + (st) * 2048 + kr1); \
        Sx = MFMA32(k0, qf[0], cinit); Sx = MFMA32(k1, qf[1], Sx); } while (0)
#define DA_PV(Sx, st) do { bf16x8 vf[2][2]; \
        _Pragma("unroll") for (int dh = 0; dh < 2; ++dh) _Pragma("unroll") for (int s2 = 0; s2 < 2; ++s2) { \
            const unsigned char* vp = vb + dh * (32 * 264) + vr0 + (st) * 64 + s2 * 32; \
            const s16x4 lo = *(const s16x4*)vp, hi = *(const s16x4*)(vp + 16); \
            vf[dh][s2] = __builtin_shufflevector(lo, hi, 0, 1, 2, 3, 4, 5, 6, 7); } \
        _Pragma("unroll") for (int i = 0; i < 16; ++i) Sx[i] = __builtin_amdgcn_exp2f(Sx[i]); \
        lacc += Sx; \
        const bf16x8 p0 = pack8(Sx, 0), p1 = pack8(Sx, 1); \
        O[0] = MFMA32(vf[0][0], p0, O[0]); O[1] = MFMA32(vf[1][0], p0, O[1]); \
        O[0] = MFMA32(vf[0][1], p1, O[0]); O[1] = MFMA32(vf[1][1], p1, O[1]); } while (0)
#pragma unroll 1
    for (int kt = 0; kt < NT2; ++kt) {
        const int buf = kt & 1;
        if (kt + 1 < NT2) {
            const int j0 = (kt + 1) * 128;
            const bf16_t* kp = AK + krow_of(j0 + skey) * 256 + h * 64 + sq * 16; const bf16_t* vp = AVT + (size_t)vd * NKEY + j0 + vpart * 16;
            kreg[0] = *(const u32x4*)kp; kreg[1] = *(const u32x4*)(kp + 8); vreg[0] = *(const u32x4*)vp; vreg[1] = *(const u32x4*)(vp + 8);
        }
        const unsigned char* kb = L + buf * STG; const unsigned char* vb = L + buf * STG + KTB;
        f32x16 Sa, Sb;
        DA_QK(Sa, 0);
        DA_QK(Sb, 1); DA_PV(Sa, 0);
        DA_QK(Sa, 2); DA_PV(Sb, 1);
        DA_QK(Sb, 3); DA_PV(Sa, 2);
        DA_PV(Sb, 3);
        if (kt + 1 < NT2) {
            unsigned char* W = L + (buf ^ 1) * STG;
            *(u32x4*)(W + kdst0) = kreg[0]; *(u32x4*)(W + kdst1) = kreg[1];
            *(u32x2*)(W + vdst) = (u32x2){vreg[0][0], vreg[0][1]}; *(u32x2*)(W + vdst + 8) = (u32x2){vreg[0][2], vreg[0][3]};
            *(u32x2*)(W + vdst + 16) = (u32x2){vreg[1][0], vreg[1][1]}; *(u32x2*)(W + vdst + 24) = (u32x2){vreg[1][2], vreg[1][3]};
        }
        __syncthreads();
    }
#undef DA_QK
#undef DA_PV
    float lsum = 0.f;
#pragma unroll
    for (int i = 0; i < 16; ++i) lsum += lacc[i];
    const float rl = 1.f / half_sum(lsum);
    float* xb = (float*)L + (size_t)g * 32 * 64;
    if (c == 1) {
#pragma unroll
        for (int dh = 0; dh < 2; ++dh)
#pragma unroll
            for (int i = 0; i < 16; ++i) xb[(dh * 16 + i) * 64 + lane] = O[dh][i] * (rl * lam);
    }
    __syncthreads();
    if (c == 0) {
        float o[2][16]; float ss = 0.f;
#pragma unroll
        for (int dh = 0; dh < 2; ++dh)
#pragma unroll
            for (int i = 0; i < 16; ++i) { o[dh][i] = O[dh][i] * rl - xb[(dh * 16 + i) * 64 + lane]; ss += o[dh][i] * o[dh][i]; }
        ss = half_sum(ss);
        const float rs = rsqrtf(ss * (1.f / 64.f) + EPS) * (1.f - lam_init);
        const float* sg = F.in[I_ASUB] + li * 64;
        bf16_t* mix = WSP(bf16_t, WS_HBF) + qrow * D + h * 64;
#pragma unroll
        for (int dh = 0; dh < 2; ++dh)
#pragma unroll
            for (int gq = 0; gq < 4; ++gq) {
                const int d = 32 * dh + 8 * gq + 4 * hh;
                const f32x4 gg = *(const f32x4*)(sg + d);
                *(u32x2*)(mix + d) = (u32x2){pk2(o[dh][4 * gq] * rs * gg[0], o[dh][4 * gq + 1] * rs * gg[1]), pk2(o[dh][4 * gq + 2] * rs * gg[2], o[dh][4 * gq + 3] * rs * gg[3])};
            }
    }
}

DI void na_mfma_unit(const Frame& F, int li, int b, size_t qrow0, int grow) {
    const int lane = F.lane, r31 = lane & 31, hh = lane >> 5, h = F.wave >> 1, qh = F.wave & 1;
    const bf16_t* BQ = WSP(bf16_t, WS_BQ); const bf16_t* BK = WSP(bf16_t, WS_BK); const bf16_t* BVT = WSP(bf16_t, WS_BVT);
    constexpr int KB = 4 * 8192, VB = 4 * 8704, STG = KB + VB;
    unsigned char* L = F.lds;
    float* tab = (float*)(F.lds + 2 * STG);
    const int nwin = grow >= 0 ? 8 : 0, nt = nwin + 4;
    int r0 = grow - 4; r0 = r0 < 0 ? 0 : (r0 > 248 ? 248 : r0);
    __syncthreads();
    if (nwin) for (int i = F.tid; i < 4 * 15 * 32; i += NTHR) { const int c31 = i & 31, hr = i >> 5; tab[i] = (c31 < 31) ? F.in[I_RPB][(size_t)li * 4 * 465 + hr * 31 + c31] * LOG2E : -1e30f; }
    const int skey = F.tid >> 3, sc64 = F.tid & 7, sh = sc64 >> 1;
    const int vrow = F.tid >> 1, vhalf = F.tid & 1;
    auto kbase = [&](int ti) -> const bf16_t* { return ti < nwin ? BK + ((size_t)b * S + (size_t)(r0 + ti) * GW) * 256 : BK + ((size_t)NLAT + b * CTX + (ti - nwin) * 64) * 256; };
    auto vkey0 = [&](int ti) -> int { return ti < nwin ? CTX + (r0 + ti) * GW : (ti - nwin) * 64; };
    u32x4 kreg[4], vreg[4];
    { const bf16_t* kp = kbase(0) + (size_t)skey * 256 + sc64 * 32; const bf16_t* vp = BVT + ((size_t)b * 256 + vrow) * NKEY + vkey0(0) + vhalf * 32;
#pragma unroll
      for (int i = 0; i < 4; ++i) { kreg[i] = *(const u32x4*)(kp + i * 8); vreg[i] = *(const u32x4*)(vp + i * 8); } }
    const size_t qrow = qrow0 + 32 * qh + r31;
    bf16x8 qf[4]; float qn2 = 0.f;
#pragma unroll
    for (int ks = 0; ks < 4; ++ks) { qf[ks] = *(const bf16x8*)(BQ + qrow * 256 + h * 64 + ks * 16 + 8 * hh);
#pragma unroll
        for (int j = 0; j < 8; ++j) { const float v = bf2f((bf16_t)qf[ks][j]); qn2 += v * v; } }
    qn2 = half_sum(qn2);
    __syncthreads();
    float bmax = 0.f;
    if (nwin) { for (int i = lane; i < 480; i += 64) bmax = fmaxf(bmax, tab[h * 480 + i]); bmax = wave_max(bmax); }
    const unsigned* kmx = F.ctl + CW_KMAXB + li * 16 + (b * 4 + h) * 2;
    const float km = sqrtf(__uint_as_float(__hip_atomic_load(kmx, __ATOMIC_RELAXED, __HIP_MEMORY_SCOPE_AGENT)) + __uint_as_float(__hip_atomic_load(kmx + 1, __ATOMIC_RELAXED, __HIP_MEMORY_SCOPE_AGENT)));
    const float cneg = -(sqrtf(qn2) * km * 1.02f + bmax + 1e-3f);
    const int cq = 32 * qh + r31; int c0q = cq - 8; c0q = c0q < 0 ? 0 : (c0q > 48 ? 48 : c0q);
    const int qrow_g = grow;
    f32x16 O[2];
#pragma unroll
    for (int dh = 0; dh < 2; ++dh)
#pragma unroll
        for (int i = 0; i < 16; ++i) O[dh][i] = 0.f;
    f32x16 lacc;
#pragma unroll
    for (int i = 0; i < 16; ++i) lacc[i] = 0.f;
    int tcol[2][16];
#pragma unroll
    for (int st = 0; st < 2; ++st)
#pragma unroll
        for (int i = 0; i < 16; ++i) { const int kc = 32 * st + (i & 3) + 8 * (i >> 2) + 4 * hh; tcol[st][i] = ((kc >= c0q) && (kc < c0q + 16)) ? (kc - cq + 15) : 31; }
    const int kdst = sh * 8192 + skey * 128, ksw = (skey >> 1) & 7, kch0 = (sc64 & 1) * 4;
    const int vdst = KB + (vrow >> 6) * 8704 + (vrow & 63) * 136 + vhalf * 64;
#pragma unroll
    for (int i = 0; i < 4; ++i) { *(u32x4*)(L + kdst + (((kch0 + i) ^ ksw) * 16)) = kreg[i];
        *(u32x2*)(L + vdst + i * 16) = (u32x2){vreg[i][0], vreg[i][1]}; *(u32x2*)(L + vdst + i * 16 + 8) = (u32x2){vreg[i][2], vreg[i][3]}; }
    __syncthreads();
#pragma unroll 1
    for (int ti = 0; ti < nt; ++ti) {
        const int buf = ti & 1;
        if (ti + 1 < nt) { const bf16_t* kp = kbase(ti + 1) + (size_t)skey * 256 + sc64 * 32; const bf16_t* vp = BVT + ((size_t)b * 256 + vrow) * NKEY + vkey0(ti + 1) + vhalf * 32;
#pragma unroll
            for (int i = 0; i < 4; ++i) { kreg[i] = *(const u32x4*)(kp + i * 8); vreg[i] = *(const u32x4*)(vp + i * 8); } }
        const unsigned char* kb = L + buf * STG + h * 8192; const unsigned char* vb = L + buf * STG + KB + h * 8704;
        const bool win = ti < nwin;
        const float* trow = tab + (h * 15 + (win ? (r0 + ti - qrow_g + 7) : 0)) * 32;
#pragma unroll
        for (int st = 0; st < 2; ++st) {
            const int key = 32 * st + r31, sw = (key >> 1) & 7;
            f32x16 s;
            if (win) {
#pragma unroll
                for (int i = 0; i < 16; ++i) s[i] = trow[tcol[st][i]] + cneg;
            } else {
#pragma unroll
                for (int i = 0; i < 16; ++i) s[i] = cneg;
            }
#pragma unroll
            for (int ks = 0; ks < 4; ++ks) { const bf16x8 kf = *(const bf16x8*)(kb + key * 128 + (((ks * 2 + hh) ^ sw) * 16)); s = MFMA32(kf, qf[ks], s); }
#pragma unroll
            for (int i = 0; i < 16; ++i) s[i] = __builtin_amdgcn_exp2f(s[i]);
            lacc += s;
            const bf16x8 p0 = pack8(s, 0), p1 = pack8(s, 1);
#pragma unroll
            for (int dh = 0; dh < 2; ++dh) {
                const unsigned char* vp = vb + (32 * dh + r31) * 136 + (32 * st + 4 * hh) * 2;
                const s16x4 a0 = *(const s16x4*)vp, a1 = *(const s16x4*)(vp + 16), b0 = *(const s16x4*)(vp + 32), b1 = *(const s16x4*)(vp + 48);
                O[dh] = MFMA32(__builtin_shufflevector(a0, a1, 0, 1, 2, 3, 4, 5, 6, 7), p0, O[dh]);
                O[dh] = MFMA32(__builtin_shufflevector(b0, b1, 0, 1, 2, 3, 4, 5, 6, 7), p1, O[dh]);
            }
        }
        if (ti + 1 < nt) { unsigned char* W = L + (buf ^ 1) * STG;
#pragma unroll
            for (int i = 0; i < 4; ++i) { *(u32x4*)(W + kdst + (((kch0 + i) ^ ksw) * 16)) = kreg[i];
                *(u32x2*)(W + vdst + i * 16) = (u32x2){vreg[i][0], vreg[i][1]}; *(u32x2*)(W + vdst + i * 16 + 8) = (u32x2){vreg[i][2], vreg[i][3]}; } }
        __syncthreads();
    }
    float lsum = 0.f;
#pragma unroll
    for (int i = 0; i < 16; ++i) lsum += lacc[i];
    const float rl = 1.f / half_sum(lsum);
    bf16_t* mix = WSP(bf16_t, WS_HBF) + qrow * D + 256 + h * 64;
#pragma unroll
    for (int dh = 0; dh < 2; ++dh)
#pragma unroll
        for (int g = 0; g < 4; ++g) { const int d = 32 * dh + 8 * g + 4 * hh;
            *(u32x2*)(mix + d) = (u32x2){pk2(O[dh][4 * g] * rl, O[dh][4 * g + 1] * rl), pk2(O[dh][4 * g + 2] * rl, O[dh][4 * g + 3] * rl)}; }
}

DI void pool_unit(const Frame& F, int li, size_t seq_row0, int L, int t0) {
    float* us = (float*)F.lds;
    float* df = us + 48 * 256;
    const bf16_t* PL = WSP(bf16_t, WS_PL);
    __syncthreads();
    for (int i = F.tid; i < 48 * 32; i += NTHR) {
        const int tt = i >> 5, c8 = i & 31, t = t0 - 8 + tt;
        float v[8] = {0.f, 0.f, 0.f, 0.f, 0.f, 0.f, 0.f, 0.f};
        if (t >= 0 && t < L) { const u32x4 x = *(const u32x4*)(PL + (seq_row0 + t) * 256 + c8 * 8);
#pragma unroll
            for (int e = 0; e < 4; ++e) { v[2 * e] = __uint_as_float(x[e] << 16); v[2 * e + 1] = __uint_as_float(x[e] & 0xffff0000u); } }
#pragma unroll
        for (int e = 0; e < 8; ++e) us[tt * 256 + c8 * 8 + e] = v[e];
    }
    __syncthreads();
    for (int i = F.tid; i < 32 * 256; i += NTHR) {
        const int tl = i >> 8, ch = i & 255, g = ch >> 6, t = t0 + tl; const int hw = 1 << g;
        int lo = t - hw; lo = lo < 0 ? 0 : lo; int hi = t + hw; hi = hi > L ? L : hi;
        float s = 0.f;
        for (int tt = lo; tt < hi; ++tt) s += us[(tt - t0 + 8) * 256 + ch];
        df[tl * 256 + ch] = s / (float)(hi - lo) - us[(tl + 8) * 256 + ch];
    }
    __syncthreads();
    const float* pw = F.in[I_POOLW] + (size_t)li * 4 * 64 * 64; const float* ps = F.in[I_POOLS] + li * 256;
    bf16_t* mix = WSP(bf16_t, WS_HBF);
    {
        const int ch = F.tid & 255, th = F.tid >> 8, g = ch >> 6, j = ch & 63;
        float w[64];
#pragma unroll
        for (int i = 0; i < 64; ++i) w[i] = pw[((size_t)g * 64 + i) * 64 + j];
        const float scale = ps[ch];
        for (int tl = th * 16; tl < th * 16 + 16; ++tl) {
            float a = 0.f;
#pragma unroll
            for (int i = 0; i < 64; ++i) a += df[tl * 256 + g * 64 + i] * w[i];
            mix[(seq_row0 + t0 + tl) * D + 512 + ch] = f2bf(a * scale);
        }
    }
}

DI float hy_norm(const float* part, int ntile, int o, int ch) {
    float s = 0.f;
    for (int t = 0; t < ntile; ++t) s += part[(size_t)t * 1024 + (o * 2) * 256 + ch] + part[(size_t)t * 1024 + (o * 2 + 1) * 256 + ch];
    return rsqrtf(s + EPS);
}
DI float hy_short(const bf16_t* p, int t, int L, float w0, float w1, float w2, float bb) {
    const int tm = t > 0 ? t - 1 : 0, tp = t + 1 < L ? t + 1 : L - 1;
    float a = bf2f(p[tm]), c = bf2f(p[tp]); const float m = bf2f(p[t]);
    a = t > 0 ? a : 0.f; c = t + 1 < L ? c : 0.f;
    return a * w0 + m * w1 + c * w2 + bb;
}
constexpr int FM = 16384;
DI int fphys(int i) { return i + (i >> 4) + ((i >> 9) << 4); }
constexpr int brev(int m, int bits) { return bits == 5 ? (((m & 1) << 4) | ((m & 2) << 2) | (m & 4) | ((m & 8) >> 2) | ((m & 16) >> 4)) : (((m & 1) << 3) | ((m & 2) << 1) | ((m & 4) >> 1) | ((m & 8) >> 3)); }
template <int R, int LOG2R, bool INV> DI void dft_regs(float (&re)[R], float (&im)[R]) {
    constexpr float C32[16] = {1.f, 0.98078528040323043f, 0.92387953251128674f, 0.83146961230254524f, 0.70710678118654752f, 0.55557023301960218f, 0.38268343236508977f, 0.19509032201612825f,
                               0.f, -0.19509032201612825f, -0.38268343236508977f, -0.55557023301960218f, -0.70710678118654752f, -0.83146961230254524f, -0.92387953251128674f, -0.98078528040323043f};
    constexpr float S32[16] = {0.f, 0.19509032201612825f, 0.38268343236508977f, 0.55557023301960218f, 0.70710678118654752f, 0.83146961230254524f, 0.92387953251128674f, 0.98078528040323043f,
                               1.f, 0.98078528040323043f, 0.92387953251128674f, 0.83146961230254524f, 0.70710678118654752f, 0.55557023301960218f, 0.38268343236508977f, 0.19509032201612825f};
#pragma unroll
    for (int st = 0; st < LOG2R; ++st) {
        const int h = R >> (st + 1);
#pragma unroll
        for (int i = 0; i < R; i += 2 * h) {
#pragma unroll
            for (int j = 0; j < h; ++j) {
                const float xr = re[i + j], xi = im[i + j], yr = re[i + j + h], yi = im[i + j + h];
                re[i + j] = xr + yr; im[i + j] = xi + yi;
                const float dr = xr - yr, di = xi - yi;
                const int k = j * (16 / h);
                if (k == 0) { re[i + j + h] = dr; im[i + j + h] = di; }
                else if (k == 8) { re[i + j + h] = INV ? -di : di; im[i + j + h] = INV ? dr : -dr; }
                else { const float c = C32[k], sn = INV ? S32[k] : -S32[k]; re[i + j + h] = dr * c - di * sn; im[i + j + h] = dr * sn + di * c; }
            }
        }
    }
}
template <bool INV, int SP> DI void fft_pass32(f32x2* X, int bp, int rem, float inv_bs) {
    asm volatile("" : "+v"(bp), "+v"(rem));
    f32x2* P = X + bp;
    const float revb = (float)rem * inv_bs;
    float re[32], im[32];
    if (!INV) {
#pragma unroll
        for (int q = 0; q < 32; ++q) { const f32x2 v = P[q * SP]; re[q] = v[0]; im[q] = v[1]; }
        dft_regs<32, 5, false>(re, im);
#pragma unroll
        for (int m = 0; m < 32; ++m) { const int qp = brev(m, 5);
            float r = re[m], i = im[m];
            if (qp != 0) { const float rev = revb * (float)qp; const float c = __builtin_amdgcn_cosf(rev), sn = -__builtin_amdgcn_sinf(rev); const float t = r * c - i * sn; i = r * sn + i * c; r = t; }
            P[qp * SP] = (f32x2){r, i}; }
    } else {
#pragma unroll
        for (int qp = 0; qp < 32; ++qp) { const f32x2 v = P[qp * SP]; float r = v[0], i = v[1];
            if (qp != 0) { const float rev = revb * (float)qp; const float c = __builtin_amdgcn_cosf(rev), sn = __builtin_amdgcn_sinf(rev); const float t = r * c - i * sn; i = r * sn + i * c; r = t; }
            re[qp] = r; im[qp] = i; }
        dft_regs<32, 5, true>(re, im);
#pragma unroll
        for (int m = 0; m < 32; ++m) P[brev(m, 5) * SP] = (f32x2){re[m], im[m]};
    }
}
DI void fft_fwd12(f32x2* X, int tid) {
    __syncthreads(); fft_pass32<false, 560>(X, fphys(tid), tid, 1.f / 16384.f);
    __syncthreads(); fft_pass32<false, 17>(X, (tid >> 4) * 560 + (tid & 15), tid & 15, 1.f / 512.f);
    __syncthreads();
}
DI void fft_inv21(f32x2* X, int tid) {
    __syncthreads(); fft_pass32<true, 17>(X, (tid >> 4) * 560 + (tid & 15), tid & 15, 1.f / 512.f);
    __syncthreads(); fft_pass32<true, 560>(X, fphys(tid), tid, 1.f / 16384.f);
    __syncthreads();
}
DI void hyena_fft_unit(const Frame& F, int li, int ch) {
    f32x2* X = (f32x2*)F.lds;
    const bf16_t* HYT = WSP(bf16_t, WS_HYT); const float* filt = WSP(float, WS_FILT);
    f32x2* Ye = WSP(f32x2, WS_ZBUF) + (size_t)ch * FM; f32x2* Z1 = WSP(f32x2, WS_Z1BUF) + (size_t)ch * FM;
    const float* sw = F.in[I_HYSW] + (size_t)li * 3 * 768; const float* sb = F.in[I_HYSB] + li * 768; const float* sk = F.in[I_HSKIP] + li * 512;
    const int tid = F.tid;
    const bf16_t* px1[2] = {HYT + ((size_t)0 * 768 + ch) * S, HYT + ((size_t)1 * 768 + ch) * S};
    const bf16_t* px2[2] = {HYT + ((size_t)0 * 768 + 256 + ch) * S, HYT + ((size_t)1 * 768 + 256 + ch) * S};
    const bf16_t* pv[2] = {HYT + ((size_t)0 * 768 + 512 + ch) * S, HYT + ((size_t)1 * 768 + 512 + ch) * S};
    const float wx1[4] = {sw[ch], sw[768 + ch], sw[1536 + ch], sb[ch]};
    const float wx2[4] = {sw[256 + ch], sw[768 + 256 + ch], sw[1536 + 256 + ch], sb[256 + ch]};
    const float wv[4] = {sw[512 + ch], sw[768 + 512 + ch], sw[1536 + 512 + ch], sb[512 + ch]};
#pragma unroll 1
    for (int cv = 0; cv < 2; ++cv) {
        const float* hf = filt + ((size_t)(2 * cv) * 256 + ch) * S; const float* hb = filt + ((size_t)(2 * cv + 1) * 256 + ch) * S;
        float fnrm;
        { int tn = tid; asm volatile("" : "+v"(tn));
          const float pv = WSP(float, WS_FPART)[(size_t)(tn & 255) * 1024 + (cv * 2 + (tn >> 8)) * 256 + ch];
          const float ws = wave_sum(pv);
          float* red = (float*)(F.lds + LDS_MISC + 128);
          __syncthreads();
          if (F.lane == 0) red[F.wave] = ws;
          __syncthreads();
          fnrm = rsqrtf(red[0] + red[1] + red[2] + red[3] + red[4] + red[5] + red[6] + red[7] + EPS); }
        const float nrm = 1.f / 32768.f;
        const float skip = sk[cv * 256 + ch];
#pragma unroll 1
        for (int half = 0; half < 2; ++half) {
            __syncthreads();
            int pb = fphys(tid); int tq = tid; asm volatile("" : "+v"(pb), "+v"(tq));
            if (half == 0) {
#pragma unroll 8
                for (int j = 0; j < 32; ++j) { const int n = tq + 512 * j; const float a = hf[n] * fnrm; float bq = hb[FM - n] * fnrm; bq = n ? bq : 0.f;
                    X[pb + 560 * j] = (f32x2){a + bq, 0.f}; }
            } else {
#pragma unroll 8
                for (int j = 0; j < 32; ++j) { const int n = tq + 512 * j; const float a = hf[n] * fnrm; float bq = hb[FM - n] * fnrm; bq = n ? bq : 0.f;
                    const float d = a - bq, rev = (float)n * (1.f / 32768.f);
                    X[pb + 560 * j] = (f32x2){d * __builtin_amdgcn_cosf(rev), -d * __builtin_amdgcn_sinf(rev)}; }
            }
            fft_fwd12(X, tid);
            h16x2 kpk[2][16];
#pragma unroll
            for (int g = 0; g < 2; ++g) { int b16 = fphys((tid + 512 * g) * 16); asm volatile("" : "+v"(b16));
                float kre[16], kim[16];
#pragma unroll
                for (int q = 0; q < 16; ++q) { const f32x2 v = X[b16 + q]; kre[q] = v[0]; kim[q] = v[1]; }
                dft_regs<16, 4, false>(kre, kim);
#pragma unroll
                for (int q = 0; q < 16; ++q) kpk[g][q] = (h16x2){(_Float16)kre[q], (_Float16)kim[q]}; }
            __syncthreads();
            asm volatile("" : "+v"(pb), "+v"(tq));
#define HY_MOD(v, n) do { const float rev = (float)(n) * (1.f / 32768.f); const float c = __builtin_amdgcn_cosf(rev), sn = -__builtin_amdgcn_sinf(rev); v = (f32x2){v[0] * c - v[1] * sn, v[0] * sn + v[1] * c}; } while (0)
            if (cv == 0) {
                if (half == 0) {
#pragma unroll 4
                    for (int j = 0; j < 32; ++j) { const int n = tq + 512 * j; X[pb + 560 * j] = (f32x2){hy_short(pv[0], n, S, wv[0], wv[1], wv[2], wv[3]), hy_short(pv[1], n, S, wv[0], wv[1], wv[2], wv[3])}; }
                } else {
#pragma unroll 4
                    for (int j = 0; j < 32; ++j) { const int n = tq + 512 * j; f32x2 v = (f32x2){hy_short(pv[0], n, S, wv[0], wv[1], wv[2], wv[3]), hy_short(pv[1], n, S, wv[0], wv[1], wv[2], wv[3])}; HY_MOD(v, n); X[pb + 560 * j] = v; }
                }
            } else {
                if (half == 0) {
#pragma unroll 8
                    for (int j = 0; j < 32; ++j) { const int n = tq + 512 * j; X[pb + 560 * j] = Z1[n]; }
                } else {
#pragma unroll 8
                    for (int j = 0; j < 32; ++j) { const int n = tq + 512 * j; f32x2 v = Z1[n]; HY_MOD(v, n); X[pb + 560 * j] = v; }
                }
            }
#undef HY_MOD
            fft_fwd12(X, tid);
#pragma unroll
            for (int g = 0; g < 2; ++g) { int b16 = fphys((tid + 512 * g) * 16); asm volatile("" : "+v"(b16));
                float re[16], im[16];
#pragma unroll
                for (int q = 0; q < 16; ++q) { const f32x2 v = X[b16 + q]; re[q] = v[0]; im[q] = v[1]; }
                dft_regs<16, 4, false>(re, im);
                float br[16], bi[16];
#pragma unroll
                for (int m = 0; m < 16; ++m) { const int qp = brev(m, 4); const float kr = (float)kpk[g][m][0], ki = (float)kpk[g][m][1]; br[qp] = re[m] * kr - im[m] * ki; bi[qp] = re[m] * ki + im[m] * kr; }
                dft_regs<16, 4, true>(br, bi);
#pragma unroll
                for (int m = 0; m < 16; ++m) X[b16 + brev(m, 4)] = (f32x2){br[m], bi[m]};
            }
            fft_inv21(X, tid);
            asm volatile("" : "+v"(pb), "+v"(tq));
            if (half == 0) {
#pragma unroll 8
                for (int j = 0; j < 32; ++j) { const int n = tq + 512 * j; Ye[n] = X[pb + 560 * j]; }
            } else {
#define HY_Y(n, j) const f32x2 yo = X[pb + 560 * (j)], ye = Ye[n]; \
                    const float rev = (float)(n) * (1.f / 32768.f); const float c = __builtin_amdgcn_cosf(rev), sn = __builtin_amdgcn_sinf(rev); \
                    const float y0 = (ye[0] + yo[0] * c - yo[1] * sn) * nrm, y1 = (ye[1] + yo[0] * sn + yo[1] * c) * nrm;
                if (cv == 0) {
#pragma unroll 4
                    for (int j = 0; j < 32; ++j) { const int n = tq + 512 * j; HY_Y(n, j)
                        const float v0 = hy_short(pv[0], n, S, wv[0], wv[1], wv[2], wv[3]), v1 = hy_short(pv[1], n, S, wv[0], wv[1], wv[2], wv[3]);
                        const float a0 = hy_short(px1[0], n, S, wx1[0], wx1[1], wx1[2], wx1[3]), a1 = hy_short(px1[1], n, S, wx1[0], wx1[1], wx1[2], wx1[3]);
                        Z1[n] = (f32x2){a0 * (y0 + skip * v0), a1 * (y1 + skip * v1)}; }
                } else {
                    bf16_t* mix = WSP(bf16_t, WS_HBF);
#pragma unroll 4
                    for (int j = 0; j < 32; ++j) { const int n = tq + 512 * j; HY_Y(n, j)
                        const f32x2 z1 = Z1[n];
                        const float a0 = hy_short(px2[0], n, S, wx2[0], wx2[1], wx2[2], wx2[3]), a1 = hy_short(px2[1], n, S, wx2[0], wx2[1], wx2[2], wx2[3]);
                        mix[((size_t)n) * D + 768 + ch] = f2bf(a0 * (y0 + skip * z1[0]));
                        mix[((size_t)S + n) * D + 768 + ch] = f2bf(a1 * (y1 + skip * z1[1])); }
                }
#undef HY_Y
            }
        }
    }
}
DI void hyena_ctx_unit(const Frame& F, int li, int ch) {
    float* vs = (float*)F.lds;
    float* zs = vs + 512;
    float* fl = zs + 512;
    const bf16_t* HYC = WSP(bf16_t, WS_HYC); const float* filt = WSP(float, WS_FILTC);
    const float* sw = F.in[I_HYSW] + (size_t)li * 3 * 768; const float* sb = F.in[I_HYSB] + li * 768; const float* sk = F.in[I_HSKIP] + li * 512;
    const float n0 = hy_norm(WSP(float, WS_FPARTC), 4, 0, ch), n1 = hy_norm(WSP(float, WS_FPARTC), 4, 1, ch);
    const int b = F.tid >> 8, t = F.tid & 255;
    auto sc = [&](int c) -> float { const bf16_t* p = HYC + (size_t)(b * CTX) * 768 + c;
        const float a = t > 0 ? bf2f(p[(size_t)(t - 1) * 768]) : 0.f, d = t + 1 < CTX ? bf2f(p[(size_t)(t + 1) * 768]) : 0.f;
        return a * sw[c] + bf2f(p[(size_t)t * 768]) * sw[768 + c] + d * sw[1536 + c] + sb[c]; };
    __syncthreads();
    const float x1 = sc(ch), x2 = sc(256 + ch), v = sc(512 + ch);
    vs[F.tid] = v;
    for (int i = F.tid; i < 1024; i += NTHR) fl[i] = filt[((size_t)(i >> 8) * 256 + ch) * CTX + (i & 255)];
    __syncthreads();
    float a = 0.f;
    for (int s = 0; s < CTX; ++s) { const int dl = t - s; a += (dl >= 0 ? fl[dl] : fl[256 - dl]) * vs[b * 256 + s]; }
    const float z = x1 * (a * n0 + sk[ch] * v);
    zs[F.tid] = z;
    __syncthreads();
    a = 0.f;
    for (int s = 0; s < CTX; ++s) { const int dl = t - s; a += (dl >= 0 ? fl[512 + dl] : fl[768 - dl]) * zs[b * 256 + s]; }
    WSP(bf16_t, WS_HBF)[((size_t)NLAT + b * CTX + t) * D + 768 + ch] = f2bf(x2 * (a * n1 + sk[256 + ch] * z));
}

DI void phase_mix(const Frame& F0, int li) {
    const Frame& F = F0;
    unsigned* head = F.ctl + CW_QHEAD + li * 64;
    volatile unsigned* qs = (volatile unsigned*)(F.lds + LDS_MISC + 32);
#ifndef PROBE_DA
#define PROBE_DA 1
#endif
#ifndef PROBE_HY
#define PROBE_HY 1
#endif
#ifndef PROBE_NA
#define PROBE_NA 1
#endif
#ifdef PROBE_MISC
#define PROBE_PL 2
#else
#define PROBE_PL 1
#endif
    const int n_ca = (li == 0) ? 16 : 0, n_cb = (li == 0) ? 8 : 0, n_da = 1024 * PROBE_DA, n_hy = 256 * PROBE_HY, n_na = 512 * PROBE_NA, n_hc = (li == 0) ? 256 * PROBE_PL : 0, n_pl = 1024 * PROBE_PL, n_pc = (li == 0) ? 16 : 0;
    const int total = n_ca + n_cb + n_da + n_hy + n_na + n_hc + n_pl + n_pc;
    for (;;) {
        __syncthreads();
        if (F.tid == 0) qs[0] = __hip_atomic_fetch_add(head, 1u, __ATOMIC_RELAXED, __HIP_MEMORY_SCOPE_AGENT);
        __syncthreads();
        int u = __builtin_amdgcn_readfirstlane((int)qs[0]);
        if (u >= total) break;
        Frame F = F0; refresh(F);
        if (u < n_ca) {
#ifndef SKIP_CA
            diffattn_unit(F, li, u >> 3, (u >> 1) & 3, (size_t)NLAT + (size_t)(u >> 3) * CTX + (size_t)(u & 1) * 128, CTX / 128);
#endif
            continue; }
        u -= n_ca;
        if (u < n_cb) {
#ifndef SKIP_CB
            na_mfma_unit(F, li, u >> 2, (size_t)NLAT + (size_t)(u >> 2) * CTX + (size_t)(u & 3) * 64, -1);
#endif
            continue; }
        u -= n_cb;
        if (u < n_da) {
#ifndef SKIP_DA
            { const int v = u & 1023; diffattn_unit(F, li, v >> 9, (v >> 7) & 3, (size_t)(v >> 9) * S + (size_t)(v & 127) * 128, NKEY / 128); }
#endif
            continue; }
        u -= n_da;
        if (u < n_hy) {
#ifndef SKIP_HY
            hyena_fft_unit(F, li, u & 255);
#endif
            continue; }
        u -= n_hy;
        if (u < n_na) {
#ifndef SKIP_NA
            { const int v = u & 511; na_mfma_unit(F, li, v >> 8, (size_t)(v >> 8) * S + (size_t)(v & 255) * GW, v & 255); }
#endif
            continue; }
        u -= n_na;
        if (u < n_hc) {
#ifndef SKIP_HC
            hyena_ctx_unit(F, li, u & 255);
#endif
            continue; }
        u -= n_hc;
        if (u < n_pl) {
#ifndef SKIP_PL
            { const int v = u & 1023; pool_unit(F, li, (size_t)(v >> 9) * S, S, (v & 511) * 32); }
#endif
            continue; }
        u -= n_pl;
#ifndef SKIP_PL
        pool_unit(F, li, (size_t)NLAT + (u >> 3) * CTX, CTX, (u & 7) * 32);
#endif
    }
}

constexpr int PH_PER_LAYER = 8, NPH = 2 + 2 * PH_PER_LAYER;
__global__ void __launch_bounds__(NTHR, 2) mega(Args args) {
    extern __shared__ __attribute__((aligned(16))) unsigned char smem[];
    Frame F;
    F.in = args.in; F.out = args.out; F.ws = args.ws; F.ctl = (unsigned*)(args.ws + WS_CTL); F.lds = smem;
    F.tid = threadIdx.x; F.lane = F.tid & 63; F.wave = __builtin_amdgcn_readfirstlane(F.tid >> 6); F.G = gridDim.x; F.bid = blockIdx.x;
    if (F.tid < 64) ((unsigned*)(smem + LDS_MISC))[F.tid] = 0u;
    __syncthreads();
    const int lo = args.ph_lo, hi = args.ph_hi;
    const bool fused = (hi - lo) > 1;
    XcdBarrier bar; bar.bar = F.ctl; bar.x = 0; bar.st = (volatile LAS unsigned*)(smem + LDS_MISC);
    if (fused) bar = xcd_barrier_post(F.ctl, (volatile LAS unsigned*)(smem + LDS_MISC));
#define IN(k) (lo <= (k) && (k) < hi)
#ifdef PROBE_BAR
#define SEAM(k) do { if (IN(k) && IN((k) + 1)) { xcd_barrier(bar); xcd_barrier(bar); xcd_barrier(bar); } } while (0)
#else
#define SEAM(k) do { if (IN(k) && IN((k) + 1)) xcd_barrier(bar); } while (0)
#endif
#ifndef SKIP_P0
    if (IN(0)) { refresh(F); phase_prologue(F);
#ifdef PROBE_MISC
        __syncthreads(); refresh(F); phase_prologue(F);
#endif
    }
#endif
    SEAM(0);
    for (int li = 0; li < 2; ++li) {
        const int p0 = 1 + li * PH_PER_LAYER;
        const int nrows = (li == 0) ? NTOK : NLAT;
        if (IN(p0)) {
            refresh(F);
            phase_norm1(F, li, li == 0 ? 0 : 1);
#ifdef PROBE_N1
            if (li == 0) { refresh(F); phase_norm1(F, li, 0); refresh(F); phase_norm1(F, li, 0); refresh(F); phase_norm1(F, li, 0); refresh(F); phase_norm1(F, li, 0); }
#endif
            refresh(F);
#ifndef SKIP_FILT
            for (int t = F.bid; t < 256; t += F.G) filter_tile(F, li, S, t, WSP(float, WS_FILT), WSP(float, WS_FPART));
            if (li == 0) for (int t = F.bid; t < 4; t += F.G) filter_tile(F, li, CTX, t, WSP(float, WS_FILTC), WSP(float, WS_FPARTC));
#ifdef PROBE_MISC
            for (int t = F.bid; t < 256; t += F.G) filter_tile(F, li, S, t, WSP(float, WS_FILT), WSP(float, WS_FPART));
#endif
#endif
        }
        SEAM(p0);
        if (IN(p0 + 1)) {
            refresh(F);
            pg8::Gemm g{WSP(bf16_t, WS_HBF), WSP(bf16_t, WS_WIN) + (size_t)li * DIN * D, D, 0};
            pg8::StaticOrder So; So.init(NTOK, DIN, F.G, F.bid);
            EpiIn E{F.ws, WSP(float, WS_ROPE), F.ctl + CW_KMAX + li * 16, F.ctl + CW_KMAXB + li * 16};
#ifndef SKIP_G1
            pg8::gemm_phase<EpiIn, pg8::StaticOrder>((LAS unsigned char*)smem, g, So, E, F.tid);
#ifdef PROBE_G1
            __syncthreads(); refresh(F); pg8::gemm_phase<EpiIn, pg8::StaticOrder>((LAS unsigned char*)smem, g, So, E, F.tid);
#endif
#endif
        }
        SEAM(p0 + 1);
        if (IN(p0 + 2)) { refresh(F); phase_mix(F, li); }
        SEAM(p0 + 2);
        if (IN(p0 + 3)) {
            refresh(F);
            pg8::Gemm g{WSP(bf16_t, WS_HBF), WSP(bf16_t, WS_WOUT) + (size_t)li * D * D, D, 0};
            pg8::StaticOrder So; So.init(nrows, D, F.G, F.bid);
            EpiOut E{li == 0 ? F.in[I_X] : F.out, li == 0 ? F.in[I_CTX] : WSP(float, WS_XC), F.out, WSP(float, WS_XC), WSP(float, WS_MOD) + (size_t)li * 3 * 6144};
#ifndef SKIP_G2
            pg8::gemm_phase<EpiOut, pg8::StaticOrder>((LAS unsigned char*)smem, g, So, E, F.tid);
#endif
        }
        SEAM(p0 + 3);
#ifndef SKIP_N2
        if (IN(p0 + 4)) { refresh(F); phase_norm2(F, li, nrows); }
#endif
        SEAM(p0 + 4);
        if (IN(p0 + 5)) { refresh(F); phase_gather(F, li, nrows);
#ifdef PROBE_MISC
            __syncthreads(); refresh(F); phase_gather(F, li, nrows);
#endif
        }
        SEAM(p0 + 5);
        if (IN(p0 + 6)) {
            refresh(F);
            int* offs = (int*)(smem + LDS_MISC + 64);
            moe_offsets(F, li, offs);
            pg8::Gemm g{WSP(bf16_t, WS_A1), WSP(bf16_t, WS_W13) + (size_t)li * NE * 1024 * 1024, D, (size_t)1024 * 1024};
            pg8::MoeOrder Mo{offs + 40, offs[17 + 16], 4, F.G, (F.G % 8 == 0) ? (F.bid % 8) * (F.G / 8) + F.bid / 8 : F.bid};
            EpiMoe1 E{WSP(bf16_t, WS_HMID)};
#ifndef SKIP_G3
            pg8::gemm_phase<EpiMoe1, pg8::MoeOrder>((LAS unsigned char*)smem, g, Mo, E, F.tid);
#ifdef PROBE_G3
            __syncthreads(); refresh(F); pg8::gemm_phase<EpiMoe1, pg8::MoeOrder>((LAS unsigned char*)smem, g, Mo, E, F.tid);
#endif
#endif
        }
        SEAM(p0 + 6);
        if (IN(p0 + 7)) {
            refresh(F);
            int* offs = (int*)(smem + LDS_MISC + 64);
            moe_offsets(F, li, offs);
            pg8::Gemm g{WSP(bf16_t, WS_HMID), WSP(bf16_t, WS_W2) + (size_t)li * NE * 1024 * 512, DE, (size_t)1024 * 512};
            pg8::MoeOrder Mo{offs + 40, offs[17 + 16], 4, F.G, (F.G % 8 == 0) ? (F.bid % 8) * (F.G / 8) + F.bid / 8 : F.bid};
            EpiMoe2 E{WSP(bf16_t, WS_A1)};
#ifndef SKIP_G4
            pg8::gemm_phase<EpiMoe2, pg8::MoeOrder>((LAS unsigned char*)smem, g, Mo, E, F.tid);
#ifdef PROBE_G4
            __syncthreads(); refresh(F); pg8::gemm_phase<EpiMoe2, pg8::MoeOrder>((LAS unsigned char*)smem, g, Mo, E, F.tid);
#endif
#endif
        }
        SEAM(p0 + 7);
    }
    if (IN(NPH - 1)) { refresh(F); phase_norm1(F, 1, 2); }
#undef IN
#undef SEAM
}

extern "C" void kernel_launch(void* const* d_in, const int* in_sizes, int n_in, void* d_out, int out_size, void* d_ws, size_t ws_size, hipStream_t stream) {
    static int grid = 0;
    if (grid == 0) {
        if (n_in != N_IN || out_size != NLAT * D || ws_size < WS_END) { fprintf(stderr, "kernel_launch: unexpected shapes (n_in %d out %d ws %zu need %zu)\n", n_in, out_size, ws_size, (size_t)WS_END); grid = -1; return; }
        int dev = 0, cus = 0, per_cu = 0;
        if (hipGetDevice(&dev) != hipSuccess || hipDeviceGetAttribute(&cus, hipDeviceAttributeMultiprocessorCount, dev) != hipSuccess) { grid = -1; return; }
        if (hipFuncSetAttribute((const void*)mega, hipFuncAttributeMaxDynamicSharedMemorySize, LDS_BYTES) != hipSuccess) { fprintf(stderr, "kernel_launch: hipFuncSetAttribute failed\n"); grid = -1; return; }
        if (hipOccupancyMaxActiveBlocksPerMultiprocessor(&per_cu, (const void*)mega, NTHR, LDS_BYTES) != hipSuccess || per_cu < 1) { fprintf(stderr, "kernel_launch: occupancy query says %d\n", per_cu); }
        (void)hipGetLastError();
        grid = cus < MAXG ? cus : MAXG;
    }
    if (grid < 0) return;
    (void)hipMemsetAsync((char*)d_ws + WS_CTL, 0, CTL_BYTES, stream);
    Args a{};
    for (int i = 0; i < N_IN; ++i) a.in[i] = (const float*)d_in[i];
    a.out = (float*)d_out; a.ws = (unsigned char*)d_ws;
#if N_LAUNCH_MODE == 1
    a.ph_lo = 0; a.ph_hi = NPH;
    hipLaunchKernelGGL(mega, dim3(grid), dim3(NTHR), LDS_BYTES, stream, a);
#else
    for (int p = 0; p < NPH; ++p) { a.ph_lo = p; a.ph_hi = p + 1; hipLaunchKernelGGL(mega, dim3(grid), dim3(NTHR), LDS_BYTES, stream, a); }
#endif
}
#ifdef TEST_UNITS
__global__ void __launch_bounds__(NTHR, 2) t_da(Args args) {
    extern __shared__ __attribute__((aligned(16))) unsigned char smem[];
    Frame F; F.in = args.in; F.out = args.out; F.ws = args.ws; F.ctl = (unsigned*)(args.ws + WS_CTL); F.lds = smem; F.G = gridDim.x; F.bid = blockIdx.x; refresh(F);
    diffattn_unit(F, args.ph_lo, blockIdx.x >> 8, (blockIdx.x >> 6) & 3, (size_t)(blockIdx.x & 63) * 256, NKEY / 128);
}
__global__ void __launch_bounds__(NTHR, 2) t_hy(Args args) {
    extern __shared__ __attribute__((aligned(16))) unsigned char smem[];
    Frame F; F.in = args.in; F.out = args.out; F.ws = args.ws; F.ctl = (unsigned*)(args.ws + WS_CTL); F.lds = smem; F.G = gridDim.x; F.bid = blockIdx.x; refresh(F);
    hyena_fft_unit(F, args.ph_lo, blockIdx.x);
}
#endif
```

```cpp
#include <hip/hip_runtime.h>
#include <stdint.h>
#include <stdio.h>

#ifndef N_LAUNCH_MODE
#define N_LAUNCH_MODE 1
#endif

#define DI __device__ __forceinline__
#define LAS __attribute__((address_space(3)))
typedef unsigned short bf16_t;
typedef short bf16x8 __attribute__((ext_vector_type(8)));
typedef short s16x4 __attribute__((ext_vector_type(4)));
typedef float f32x4 __attribute__((ext_vector_type(4)));
typedef float f32x2 __attribute__((ext_vector_type(2)));
typedef float f32x16 __attribute__((ext_vector_type(16)));
typedef unsigned u32x4 __attribute__((ext_vector_type(4)));
typedef unsigned u32x2 __attribute__((ext_vector_type(2)));
typedef _Float16 h16x2 __attribute__((ext_vector_type(2)));

constexpr int D = 1024, NB = 2, S = 16384, CTX = 256, NLAT = NB * S, NCTX = NB * CTX, NTOK = NLAT + NCTX, DIN = 2560;
constexpr int NE = 16, DE = 512, GW = 64;
constexpr int NKEY = CTX + S;
constexpr int NTHR = 512;
constexpr int SLOT_CAP = 70656;
constexpr float EPS = 1e-6f;
constexpr float LOG2E = 1.4426950408889634f;
constexpr float QSCALE_A = 0.17677669529663687f * LOG2E;
constexpr float QSCALE_B = 0.125f * LOG2E;

enum { I_X = 0, I_C, I_CTX, I_CCTX, I_N1G, I_N2G, I_ADAW, I_ADAB, I_WIN, I_WOUT, I_ALAM, I_ASUB, I_RPB, I_POOLW, I_POOLS, I_HYSW, I_HYSB,
       I_HW1, I_HB1, I_HW2, I_HB2, I_HW3, I_HB3, I_HSKIP, I_RW, I_RB, I_MW1, I_MW3, I_MW2, I_FG, N_IN };

struct Args { const float* in[N_IN]; float* out; unsigned char* ws; int ph_lo, ph_hi; };

constexpr size_t al256(size_t x) { return (x + 255) & ~(size_t)255; }
constexpr size_t WS_CTL = 0, CTL_BYTES = 65536;
constexpr size_t WS_MOD = WS_CTL + CTL_BYTES;
constexpr size_t WS_ROPE = WS_MOD + al256(2 * 3 * 6144 * 4);
constexpr size_t WS_PWT = WS_ROPE + 16384;
constexpr size_t WS_FPART = WS_PWT + 65536;
constexpr size_t WS_FPARTC = WS_FPART + 256 * 1024 * 4;
constexpr size_t WS_XC = WS_FPARTC + 4 * 1024 * 4;
constexpr size_t WS_WIN = WS_XC + (size_t)NCTX * D * 4;
constexpr size_t WS_WOUT = WS_WIN + (size_t)2 * DIN * D * 2;
constexpr size_t WS_W13 = WS_WOUT + (size_t)2 * D * D * 2;
constexpr size_t WS_W2 = WS_W13 + (size_t)2 * NE * 1024 * 1024 * 2;
constexpr size_t WS_FILT = WS_W2 + (size_t)2 * NE * 1024 * 512 * 2;
constexpr size_t WS_FILTC = WS_FILT + (size_t)4 * 256 * S * 4;
constexpr size_t WS_ZBUF = WS_FILTC + (size_t)4 * 256 * 256 * 4;
constexpr size_t WS_R1 = WS_ZBUF + (size_t)256 * 2 * S * 4;
constexpr size_t WS_HBF = WS_R1;
constexpr size_t TOKB = (size_t)NTOK * 256 * 2;
constexpr size_t WS_AQ = WS_HBF + (size_t)NTOK * D * 2;
constexpr size_t WS_AK = WS_AQ + TOKB;
constexpr size_t WS_AVT = WS_AK + TOKB;
constexpr size_t WS_BQ = WS_AVT + (size_t)NB * 4 * 64 * NKEY * 2;
constexpr size_t WS_BK = WS_BQ + TOKB;
constexpr size_t WS_BVT = WS_BK + TOKB;
constexpr size_t WS_PL = WS_BVT + (size_t)NB * 4 * 64 * NKEY * 2;
constexpr size_t WS_HYT = WS_PL + TOKB;
constexpr size_t WS_HYC = WS_HYT + (size_t)NB * 768 * S * 2;
constexpr size_t WS_Z1BUF = WS_HYC + (size_t)NCTX * 768 * 2;
constexpr size_t WS_END_MIX = WS_Z1BUF + (size_t)256 * S * 8;
constexpr size_t WS_TOK = WS_AQ;
constexpr size_t WS_A1 = WS_TOK + al256((size_t)NTOK * 32);
constexpr size_t WS_HMID = WS_A1 + (size_t)SLOT_CAP * D * 2;
constexpr size_t WS_END_MOE = WS_HMID + (size_t)SLOT_CAP * DE * 2;
constexpr size_t WS_END = WS_END_MIX > WS_END_MOE ? WS_END_MIX : WS_END_MOE;

#define XB_TMO      128
#define XB_XCNT(j)  (256  + 64 * (j))
#define XB_XSUB(j)  (1280 + 64 * (j))
#define XB_XGEN(j)  (2304 + 64 * (j))
#define XB_TOP      3328
#define XB_TOPGEN   3392
#define XCD_BAR_WORDS 3456
#define XB_SPIN_CAP (1u << 18)
constexpr int CW_CNT = 4096;
constexpr int CW_KMAX = 4160;
constexpr int CW_KMAXB = 4192;
constexpr int CW_QHEAD = 4224;
constexpr int CW_BCNT = 4352;
constexpr int MAXG = 256;

constexpr int LDS_MAIN = 143360, LDS_MISC = LDS_MAIN, LDS_BYTES = LDS_MAIN + 2048;

DI float bf2f(bf16_t v) { return __uint_as_float(((unsigned)v) << 16); }
DI bf16_t f2bf(float f) { unsigned u = __float_as_uint(f); u += 0x7FFFu + ((u >> 16) & 1u); return (bf16_t)(u >> 16); }
DI unsigned pk2(float lo, float hi) { unsigned r; asm volatile("v_cvt_pk_bf16_f32 %0, %1, %2" : "=v"(r) : "v"(lo), "v"(hi)); return r; }
template <int K> DI float swz_xor(float v) { return __int_as_float(__builtin_amdgcn_ds_swizzle(__float_as_int(v), (K << 10) | 0x1F)); }
DI float half_sum(float v) { const auto r = __builtin_amdgcn_permlane32_swap(__float_as_uint(v), __float_as_uint(v), false, false); return __uint_as_float(r[0]) + __uint_as_float(r[1]); }
DI float half_max(float v) { const auto r = __builtin_amdgcn_permlane32_swap(__float_as_uint(v), __float_as_uint(v), false, false); return fmaxf(__uint_as_float(r[0]), __uint_as_float(r[1])); }
DI float wave_sum(float v) { v += swz_xor<16>(v); v += swz_xor<8>(v); v += swz_xor<4>(v); v += swz_xor<2>(v); v += swz_xor<1>(v); return half_sum(v); }
DI float wave_max(float v) { v = fmaxf(v, swz_xor<16>(v)); v = fmaxf(v, swz_xor<8>(v)); v = fmaxf(v, swz_xor<4>(v)); v = fmaxf(v, swz_xor<2>(v)); v = fmaxf(v, swz_xor<1>(v)); return half_max(v); }
DI float siluf(float x) { return x / (1.f + __expf(-x)); }
DI float sin_rev(float rev) { return __builtin_amdgcn_sinf(rev - floorf(rev)); }
DI float cos_rev(float rev) { return __builtin_amdgcn_cosf(rev - floorf(rev)); }
DI float sin_rad(float x) { return sin_rev(x * 0.15915494309189535f); }

DI unsigned xb_ld(unsigned* p)              { return __hip_atomic_load(p, __ATOMIC_RELAXED, __HIP_MEMORY_SCOPE_AGENT); }
DI unsigned xb_add(unsigned* p, unsigned v) { return __hip_atomic_fetch_add(p, v, __ATOMIC_RELAXED, __HIP_MEMORY_SCOPE_AGENT); }
DI unsigned xb_xcc_id() { return (unsigned)__builtin_amdgcn_s_getreg((3 << 11) | 20) & 0xFu; }
#define XB_SPIN(cond, bar) do { unsigned _sp = 0; while (cond) { __builtin_amdgcn_s_sleep(1); \
    if ((++_sp & 255u) == 0u) { if (xb_ld(&(bar)[XB_TMO])) break; if (_sp > XB_SPIN_CAP) { atomicAdd(&(bar)[XB_TMO], 1u); break; } } } } while (0)
struct XcdBarrier { unsigned* bar; unsigned x; volatile LAS unsigned* st; };
DI XcdBarrier xcd_barrier_post(unsigned* bar, volatile LAS unsigned* st) {
    XcdBarrier b; b.bar = bar; b.x = xb_xcc_id(); b.st = st;
    if (threadIdx.x == 0) (void)xb_add(&bar[XB_XCNT(b.x)], 1u);
    return b;
}
DI void xcd_barrier_complete(unsigned* bar, unsigned x, unsigned& nloc, unsigned& nx) {
    const unsigned G = gridDim.x * gridDim.y * gridDim.z;
    unsigned sum, cnt, mine, sp = 0u;
    for (;;) {
        sum = 0u; cnt = 0u; mine = 0u;
#pragma unroll
        for (unsigned j = 0; j < 16; ++j) { const unsigned c = xb_ld(&bar[XB_XCNT(j)]); sum += c; cnt += (c > 0u) ? 1u : 0u; mine = (j == x) ? c : mine; }
        if (sum == G) break;
        __builtin_amdgcn_s_sleep(1);
        if ((++sp & 255u) == 0u) { if (xb_ld(&bar[XB_TMO])) break; if (sp > XB_SPIN_CAP) { atomicAdd(&bar[XB_TMO], 1u); break; } }
    }
    nloc = mine > 0u ? mine : 1u; nx = cnt > 0u ? cnt : 1u;
}
DI void xcd_barrier(const XcdBarrier& b) {
    asm volatile("s_waitcnt vmcnt(0)" ::: "memory");
    __syncthreads();
    if (threadIdx.x == 0) {
        unsigned* bar = b.bar;
        __builtin_amdgcn_s_waitcnt(0);
        unsigned nloc = b.st[0], nx = b.st[1];
        if (nloc == 0u) { xcd_barrier_complete(bar, b.x, nloc, nx); b.st[0] = nloc; b.st[1] = nx; }
        const unsigned old = xb_add(&bar[XB_XSUB(b.x)], 1u);
        const unsigned gen = old / nloc;
        if (old + 1u == (gen + 1u) * nloc) {
            __builtin_amdgcn_fence(__ATOMIC_RELEASE, "agent");
            asm volatile("s_waitcnt vmcnt(0)" ::: "memory");
            const unsigned og = xb_add(&bar[XB_TOP], 1u);
            const unsigned tg = og / nx;
            if (og + 1u == (tg + 1u) * nx) xb_add(&bar[XB_TOPGEN], 1u);
            else XB_SPIN(xb_ld(&bar[XB_TOPGEN]) == tg, bar);
            __builtin_amdgcn_fence(__ATOMIC_ACQUIRE, "agent");
            xb_add(&bar[XB_XGEN(b.x)], 1u);
            asm volatile("s_waitcnt vmcnt(0)" ::: "memory");
        } else {
            XB_SPIN(xb_ld(&bar[XB_XGEN(b.x)]) == gen, bar);
            __builtin_amdgcn_fence(__ATOMIC_ACQUIRE, "agent");
            asm volatile("s_waitcnt vmcnt(0)" ::: "memory");
        }
    }
    __syncthreads();
}

struct Frame {
    const float* const* in; float* out; unsigned char* ws; unsigned* ctl;
    unsigned char* lds;
    int tid, lane, wave, G, bid;
};
#define WSP(T, off) ((T*)(F.ws + (off)))
DI void refresh(Frame& F) { int t = threadIdx.x; asm volatile("" : "+v"(t)); F.tid = t; F.lane = t & 63; F.wave = __builtin_amdgcn_readfirstlane(t >> 6);
}

namespace pg8 {
constexpr int BM = 256, BK = 64, HALF = 128, HTB = HALF * BK * 2, STAGE_BYTES = 8 * HTB, NXCD = 8, WGM = 8;
DI int lds_byte(int r, int c) { const int st = (r >> 4) * 2 + (c >> 5), rr = r & 15, cc = c & 31, ob = rr * 64 + cc * 2; return st * 1024 + (ob ^ (((ob >> 9) & 1) << 5)); }
DI void stage_rc(int b, int& R, int& C) { const int st = b / 1024, sb = b % 1024, swz = sb ^ (((sb >> 9) & 1) << 5); R = (st >> 1) * 16 + swz / 64; C = (st & 1) * 32 + (swz % 64) / 2; }
struct Unit { int pm, pn, e; };
struct Gemm { const bf16_t* A; const bf16_t* Bt; int K; size_t bstride; };
struct StaticOrder {
    int nM, nN, nwg, G, c;
    DI void init(int M, int N, int G_, int c_) { nM = M / BM; nN = N / BM; nwg = nM * nN; G = G_; c = c_; }
    DI bool next(int i, Unit& u) const {
        const long L = (long)i * G + c; if (L >= nwg) return false;
        int wgid = (int)L; { const int q = nwg / NXCD, r = nwg % NXCD, xcd = wgid % NXCD, off = wgid / NXCD; wgid = (xcd < r ? xcd * (q + 1) : r * (q + 1) + (xcd - r) * q) + off; }
        const int nig = WGM * nN, gid = wgid / nig, fm = gid * WGM, gsz = (nM - fm) < WGM ? (nM - fm) : WGM;
        u.pm = fm + ((wgid % nig) % gsz); u.pn = (wgid % nig) / gsz; u.e = 0; return true;
    }
};
struct MoeOrder {
    const int* toff; int ntile, nN, G, c;
    DI bool next(int i, Unit& u) const {
        const long L = (long)i * G + c; if (L >= (long)ntile * nN) return false;
        const int t = (int)(L / nN); u.pm = t; u.pn = (int)(L % nN);
        u.e = toff[t]; return true;
    }
};

template <class Epi, class Sched>
DI void gemm_phase(LAS unsigned char* lds, const Gemm g, const Sched& S, const Epi& E, int tid) {
    const int wid = __builtin_amdgcn_readfirstlane(tid >> 6), lane = tid & 63, wr = wid >> 2, wc = wid & 3, fr = lane & 15, fq = lane >> 4;
    const int K = g.K, nt = K / BK;
    unsigned voffA[2];
#pragma unroll
    for (int i = 0; i < 2; ++i) { int R, C; stage_rc(tid * 16 + i * 8192, R, C); voffA[i] = (unsigned)(R * K + C) * 2u; }
    const size_t kstep = (size_t)(BK * 2);
    const size_t hstep = (size_t)HALF * K * 2;
    const size_t tstep = 2 * hstep;
    const unsigned ldsw = (unsigned)wid * 1024u;
    const int aoff = lds_byte(wr * 64 + fr, fq * 8), boff = lds_byte(wc * 32 + fr, fq * 8);
#define PG8_SA(b, h) (((b) * 2 + (h)) * HTB)
#define PG8_SB(b, h) ((4 + (b) * 2 + (h)) * HTB)
#define PG8_STAGE(bufoff, gbase, voff) do { _Pragma("unroll") for (int _i = 0; _i < 2; ++_i) \
        __builtin_amdgcn_global_load_lds((const unsigned*)((const char*)(gbase) + (voff)[_i]), (LAS unsigned*)(lds + (bufoff) + ldsw + _i * 8192), 16, 0, 0); } while (0)
#define PG8_LDA(dst, b, h) do { _Pragma("unroll") for (int m = 0; m < 4; ++m) _Pragma("unroll") for (int k = 0; k < 2; ++k) dst[m][k] = *(const LAS bf16x8*)(lds + PG8_SA(b, h) + aoff + m * 2048 + k * 1024); } while (0)
#define PG8_LDB(dst, b, h) do { _Pragma("unroll") for (int n = 0; n < 2; ++n) _Pragma("unroll") for (int k = 0; k < 2; ++k) dst[n][k] = *(const LAS bf16x8*)(lds + PG8_SB(b, h) + boff + n * 2048 + k * 1024); } while (0)
#define PG8_MMA(ai, bj, At, Bt) do { __builtin_amdgcn_s_setprio(1); _Pragma("unroll") for (int m = 0; m < 4; ++m) _Pragma("unroll") for (int n = 0; n < 2; ++n) _Pragma("unroll") for (int k = 0; k < 2; ++k) \
        acc[ai][bj][m][n] = __builtin_amdgcn_mfma_f32_16x16x32_bf16(Bt[n][k], At[m][k], acc[ai][bj][m][n], 0, 0, 0); __builtin_amdgcn_s_setprio(0); } while (0)
#define PG8_WAIT_V(n) asm volatile("s_waitcnt vmcnt(" #n ")" ::: "memory")
#define PG8_WAIT_L(n) asm volatile("s_waitcnt lgkmcnt(" #n ")" ::: "memory")
#define PG8_BAR __builtin_amdgcn_s_barrier()
#define PG8_SCHED __builtin_amdgcn_sched_barrier(0)
    Unit cur, nxt; int ui = 0;
    if (!S.next(0, cur)) return;
    f32x4 acc[2][2][4][2];
#pragma unroll
    for (int a = 0; a < 2; ++a)
#pragma unroll
        for (int b = 0; b < 2; ++b)
#pragma unroll
            for (int m = 0; m < 4; ++m)
#pragma unroll
                for (int n = 0; n < 2; ++n) acc[a][b][m][n] = (f32x4){0.f, 0.f, 0.f, 0.f};
    bf16x8 At[4][2], B0[2][2], B1[2][2];
    const char* cA = (const char*)g.A + (size_t)cur.pm * tstep; const char* cB = (const char*)(g.Bt + (size_t)cur.e * g.bstride) + (size_t)cur.pn * tstep;
    PG8_STAGE(PG8_SB(0, 0), cB, voffA); PG8_STAGE(PG8_SA(0, 0), cA, voffA); PG8_STAGE(PG8_SB(0, 1), cB + hstep, voffA); PG8_STAGE(PG8_SA(0, 1), cA + hstep, voffA);
    if (wr == 1) PG8_BAR;
    PG8_WAIT_V(4); PG8_BAR;
    PG8_STAGE(PG8_SB(1, 0), cB + kstep, voffA); PG8_STAGE(PG8_SA(1, 0), cA + kstep, voffA); PG8_STAGE(PG8_SB(1, 1), cB + hstep + kstep, voffA);
    PG8_WAIT_V(6); PG8_BAR;
    for (;;) {
        const bool has_next = S.next(ui + 1, nxt);
        const char* nA = has_next ? (const char*)g.A + (size_t)nxt.pm * tstep : cA; const char* nB = has_next ? (const char*)(g.Bt + (size_t)nxt.e * g.bstride) + (size_t)nxt.pn * tstep : cB;
        for (int t = 0; t < nt; t += 2) {
            const bool last = (t == nt - 2);
            const char* a1 = cA + (size_t)(t + 1) * kstep;
            const char* a2 = last ? nA : cA + (size_t)(t + 2) * kstep; const char* b2 = last ? nB : cB + (size_t)(t + 2) * kstep;
            const char* a3 = a2 + kstep; const char* b3 = b2 + kstep;
            PG8_LDB(B0, 0, 0); PG8_SCHED; PG8_LDA(At, 0, 0); PG8_STAGE(PG8_SA(1, 1), a1 + hstep, voffA);
            PG8_WAIT_L(8); PG8_BAR; PG8_WAIT_L(0); PG8_MMA(0, 0, At, B0); PG8_BAR; PG8_SCHED;
            PG8_LDB(B1, 0, 1); PG8_STAGE(PG8_SB(0, 0), b2, voffA);
            PG8_BAR; PG8_WAIT_L(0); PG8_MMA(0, 1, At, B1); PG8_BAR;
            PG8_LDA(At, 0, 1); PG8_STAGE(PG8_SA(0, 0), a2, voffA);
            PG8_BAR; PG8_WAIT_L(0); PG8_MMA(1, 0, At, B0); PG8_BAR; PG8_SCHED;
            PG8_STAGE(PG8_SB(0, 1), b2 + hstep, voffA);
            PG8_WAIT_V(6); PG8_BAR; PG8_MMA(1, 1, At, B1); PG8_BAR;
            PG8_LDB(B0, 1, 0); PG8_SCHED; PG8_LDA(At, 1, 0); PG8_STAGE(PG8_SA(0, 1), a2 + hstep, voffA);
            PG8_WAIT_L(8); PG8_BAR; PG8_WAIT_L(0); PG8_MMA(0, 0, At, B0); PG8_BAR; PG8_SCHED;
            PG8_LDB(B1, 1, 1); PG8_STAGE(PG8_SB(1, 0), b3, voffA);
            PG8_BAR; PG8_WAIT_L(0); PG8_MMA(0, 1, At, B1); PG8_BAR;
            PG8_LDA(At, 1, 1); PG8_STAGE(PG8_SA(1, 0), a3, voffA);
            PG8_BAR; PG8_WAIT_L(0); PG8_MMA(1, 0, At, B0); PG8_BAR; PG8_SCHED;
            PG8_STAGE(PG8_SB(1, 1), b3 + hstep, voffA);
            PG8_WAIT_V(6); PG8_BAR; PG8_MMA(1, 1, At, B1); PG8_BAR;
        }
        E(acc, cur, wr, wc, fr, fq);
        if (!has_next) break;
#pragma unroll
        for (int a = 0; a < 2; ++a)
#pragma unroll
            for (int b = 0; b < 2; ++b)
#pragma unroll
                for (int m = 0; m < 4; ++m)
#pragma unroll
                    for (int n = 0; n < 2; ++n) acc[a][b][m][n] = (f32x4){0.f, 0.f, 0.f, 0.f};
        cur = nxt; cA = nA; cB = nB; ++ui;
    }
    PG8_WAIT_V(0);
    if (wr == 0) PG8_BAR;
    PG8_BAR;
#undef PG8_SA
#undef PG8_SB
#undef PG8_STAGE
#undef PG8_LDA
#undef PG8_LDB
#undef PG8_MMA
#undef PG8_WAIT_V
#undef PG8_WAIT_L
#undef PG8_BAR
#undef PG8_SCHED
}
}

typedef f32x4 AccT[2][2][4][2];

struct EpiIn {
    unsigned char* ws; const float* rope; unsigned* kmax; unsigned* kmaxb;
    DI void operator()(const AccT& acc, const pg8::Unit& u, int wr, int wc, int fr, int fq) const {
        const int pn = u.pn, row0 = u.pm * 256 + wr * 64 + fr;
        const bool isctx = (u.pm >= NLAT / 256);
        if (pn <= 1) {
            bf16_t* dst = (bf16_t*)(ws + (pn == 0 ? WS_AQ : WS_AK));
            const float sc = (pn == 0) ? QSCALE_A : 1.f;
            float nmax[2] = {0.f, 0.f};
#pragma unroll
            for (int ai = 0; ai < 2; ++ai)
#pragma unroll
                for (int m = 0; m < 4; ++m) {
                    const int r = row0 + ai * 128 + m * 16;
                    f32x4 cs0 = (f32x4){1.f, 0.f, 1.f, 0.f}, cs1 = cs0;
                    if (!isctx) { const int t = r & (S - 1); const int pos = (fq < 2) ? (t >> 6) : (t & 63);
                        const f32x4* tp = (const f32x4*)(rope + (size_t)pos * 16 + (fq & 1) * 8); cs0 = tp[0]; cs1 = tp[1]; }
                    const float cc[4] = {cs0[0], cs0[2], cs1[0], cs1[2]}, ss[4] = {cs0[1], cs0[3], cs1[1], cs1[3]};
#pragma unroll
                    for (int bj = 0; bj < 2; ++bj) {
                        const f32x4 x1 = acc[ai][bj][m][0], x2 = acc[ai][bj][m][1];
                        float o1[4], o2[4], n2 = 0.f;
#pragma unroll
                        for (int j = 0; j < 4; ++j) { o1[j] = (x1[j] * cc[j] - x2[j] * ss[j]) * sc; o2[j] = (x2[j] * cc[j] + x1[j] * ss[j]) * sc; n2 += x1[j] * x1[j] + x2[j] * x2[j]; }
                        bf16_t* p = dst + (size_t)r * 256 + bj * 128 + wc * 32 + 4 * fq;
                        *(u32x2*)p = (u32x2){pk2(o1[0], o1[1]), pk2(o1[2], o1[3])};
                        *(u32x2*)(p + 16) = (u32x2){pk2(o2[0], o2[1]), pk2(o2[2], o2[3])};
                        if (pn == 1) { n2 += swz_xor<16>(n2); n2 = half_sum(n2); nmax[bj] = fmaxf(nmax[bj], n2); }
                    }
                }
            if (pn == 1) {
                const int b = isctx ? (u.pm - NLAT / 256) : (u.pm / (S / 256));
#pragma unroll
                for (int bj = 0; bj < 2; ++bj) {
                    float v = nmax[bj];
                    v = fmaxf(v, swz_xor<1>(v)); v = fmaxf(v, swz_xor<2>(v)); v = fmaxf(v, swz_xor<4>(v)); v = fmaxf(v, swz_xor<8>(v));
                    if ((fr | fq) == 0) atomicMax(kmax + (b * 4 + (2 * bj + (wc >> 1))) * 2 + (wc & 1), __float_as_uint(v));
                }
            }
        } else if (pn == 2 || pn == 5) {
            bf16_t* dst = (bf16_t*)(ws + (pn == 2 ? WS_AVT : WS_BVT));
#pragma unroll
            for (int ai = 0; ai < 2; ++ai)
#pragma unroll
                for (int m = 0; m < 4; ++m) {
                    const int r = row0 + ai * 128 + m * 16;
                    int b, key; if (isctx) { b = (r - NLAT) >> 8; key = (r - NLAT) & 255; } else { b = r >> 14; key = CTX + (r & (S - 1)); }
#pragma unroll
                    for (int bj = 0; bj < 2; ++bj)
#pragma unroll
                        for (int n = 0; n < 2; ++n) {
                            const int lc = bj * 128 + wc * 32 + n * 16 + 4 * fq;
#pragma unroll
                            for (int j = 0; j < 4; ++j) dst[((size_t)(b * 256 + lc + j)) * NKEY + key] = f2bf(acc[ai][bj][m][n][j]);
                        }
                }
        } else if (pn <= 6) {
            bf16_t* dst = (bf16_t*)(ws + (pn == 3 ? WS_BQ : pn == 4 ? WS_BK : WS_PL));
            const float sc = (pn == 3) ? QSCALE_B : 1.f;
            float nmax[2] = {0.f, 0.f};
#pragma unroll
            for (int ai = 0; ai < 2; ++ai)
#pragma unroll
                for (int m = 0; m < 4; ++m) {
                    const int r = row0 + ai * 128 + m * 16;
#pragma unroll
                    for (int bj = 0; bj < 2; ++bj)
#pragma unroll
                        for (int n = 0; n < 2; ++n) {
                            const f32x4 v = acc[ai][bj][m][n] * sc;
                            *(u32x2*)(dst + (size_t)r * 256 + bj * 128 + wc * 32 + n * 16 + 4 * fq) = (u32x2){pk2(v[0], v[1]), pk2(v[2], v[3])};
                        }
                    if (pn == 4) {
#pragma unroll
                        for (int bj = 0; bj < 2; ++bj) { const f32x4 x1 = acc[ai][bj][m][0], x2 = acc[ai][bj][m][1];
                            float n2 = x1[0] * x1[0] + x1[1] * x1[1] + x1[2] * x1[2] + x1[3] * x1[3] + x2[0] * x2[0] + x2[1] * x2[1] + x2[2] * x2[2] + x2[3] * x2[3];
                            n2 += swz_xor<16>(n2); n2 = half_sum(n2); nmax[bj] = fmaxf(nmax[bj], n2); }
                    }
                }
            if (pn == 4) {
                const int b = isctx ? (u.pm - NLAT / 256) : (u.pm / (S / 256));
#pragma unroll
                for (int bj = 0; bj < 2; ++bj) {
                    float v = nmax[bj];
                    v = fmaxf(v, swz_xor<1>(v)); v = fmaxf(v, swz_xor<2>(v)); v = fmaxf(v, swz_xor<4>(v)); v = fmaxf(v, swz_xor<8>(v));
                    if ((fr | fq) == 0) atomicMax(kmaxb + (b * 4 + (2 * bj + (wc >> 1))) * 2 + (wc & 1), __float_as_uint(v));
                }
            }
        } else {
            const int hc0 = (pn - 7) * 256;
#pragma unroll
            for (int ai = 0; ai < 2; ++ai)
#pragma unroll
                for (int m = 0; m < 4; ++m) {
                    const int r = row0 + ai * 128 + m * 16;
#pragma unroll
                    for (int bj = 0; bj < 2; ++bj)
#pragma unroll
                        for (int n = 0; n < 2; ++n) {
                            const int hc = hc0 + bj * 128 + wc * 32 + n * 16 + 4 * fq; const f32x4 v = acc[ai][bj][m][n];
                            if (isctx) *(u32x2*)((bf16_t*)(ws + WS_HYC) + (size_t)(r - NLAT) * 768 + hc) = (u32x2){pk2(v[0], v[1]), pk2(v[2], v[3])};
                            else { bf16_t* dst = (bf16_t*)(ws + WS_HYT) + ((size_t)(r >> 14) * 768 + hc) * S + (r & (S - 1));
#pragma unroll
                                for (int j = 0; j < 4; ++j) dst[(size_t)j * S] = f2bf(v[j]); }
                        }
                }
        }
    }
};

struct EpiOut {
    const float* xl_old; const float* xc_old; float* xl_new; float* xc_new; const float* mod;
    DI void operator()(const AccT& acc, const pg8::Unit& u, int wr, int wc, int fr, int fq) const {
        const int row0 = u.pm * 256 + wr * 64 + fr; const bool isctx = (u.pm >= NLAT / 256);
        const int v = isctx ? 2 : (u.pm / (S / 256));
        const float* g1 = mod + (size_t)v * 6144 + 2 * 1024;
        const float* so = isctx ? xc_old - (size_t)NLAT * D : xl_old; float* dn = isctx ? xc_new - (size_t)NLAT * D : xl_new;
#pragma unroll
        for (int bj = 0; bj < 2; ++bj)
#pragma unroll
            for (int n = 0; n < 2; ++n) {
                const int c = u.pn * 256 + bj * 128 + wc * 32 + n * 16 + 4 * fq;
                const f32x4 g = *(const f32x4*)(g1 + c);
#pragma unroll
                for (int ai = 0; ai < 2; ++ai)
#pragma unroll
                    for (int m = 0; m < 4; ++m) {
                        const size_t o = (size_t)(row0 + ai * 128 + m * 16) * D + c;
                        *(f32x4*)(dn + o) = *(const f32x4*)(so + o) + g * acc[ai][bj][m][n];
                    }
            }
    }
};

struct EpiMoe1 {
    bf16_t* hmid;
    DI void operator()(const AccT& acc, const pg8::Unit& u, int wr, int wc, int fr, int fq) const {
        const int row0 = u.pm * 256 + wr * 64 + fr;
#pragma unroll
        for (int ai = 0; ai < 2; ++ai)
#pragma unroll
            for (int m = 0; m < 4; ++m)
#pragma unroll
                for (int bj = 0; bj < 2; ++bj) {
                    const f32x4 a = acc[ai][bj][m][0], b = acc[ai][bj][m][1]; float h[4];
#pragma unroll
                    for (int j = 0; j < 4; ++j) h[j] = siluf(a[j]) * b[j];
                    *(u32x2*)(hmid + (size_t)(row0 + ai * 128 + m * 16) * DE + (u.pn * 256 + bj * 128 + wc * 32) / 2 + 4 * fq) = (u32x2){pk2(h[0], h[1]), pk2(h[2], h[3])};
                }
    }
};
struct EpiMoe2 {
    bf16_t* ys;
    DI void operator()(const AccT& acc, const pg8::Unit& u, int wr, int wc, int fr, int fq) const {
        const int row0 = u.pm * 256 + wr * 64 + fr;
#pragma unroll
        for (int ai = 0; ai < 2; ++ai)
#pragma unroll
            for (int m = 0; m < 4; ++m)
#pragma unroll
                for (int bj = 0; bj < 2; ++bj)
#pragma unroll
                    for (int n = 0; n < 2; ++n) { const f32x4 v = acc[ai][bj][m][n];
                        *(u32x2*)(ys + (size_t)(row0 + ai * 128 + m * 16) * D + u.pn * 256 + bj * 128 + wc * 32 + n * 16 + 4 * fq) = (u32x2){pk2(v[0], v[1]), pk2(v[2], v[3])}; }
    }
};

DI void tconv_tile(const Frame& F, const float* src, int N, int k0, int n0, bf16_t* dst, int ldd, int mode) {
    float* tl = (float*)F.lds;
    __syncthreads();
#pragma unroll
    for (int i = 0; i < 8; ++i) { const int idx = F.tid + 512 * i, k = idx >> 6, n = idx & 63; tl[k * 65 + n] = src[(size_t)(k0 + k) * N + n0 + n]; }
    __syncthreads();
#pragma unroll
    for (int i = 0; i < 4; ++i) { const int idx = F.tid + 512 * i, n = idx >> 5, kp = idx & 31;
        const int nn = n0 + n; const int row = (mode == 0) ? nn : ((nn >> 4) * 32 + (mode - 1) * 16 + (nn & 15));
        *(unsigned*)(dst + (size_t)row * ldd + k0 + 2 * kp) = pk2(tl[(2 * kp) * 65 + n], tl[(2 * kp + 1) * 65 + n]); }
}
DI void phase_prologue(const Frame& F) {
    const int T_IN = 16 * 40, T_OUT = 16 * 16, T_E = 16 * 8;
    const int per_layer = T_IN + T_OUT + NE * 3 * T_E, total = 2 * per_layer;
    for (int u = F.bid; u < total; u += F.G) {
        const int li = u / per_layer; int r = u % per_layer;
        if (r < T_IN) { tconv_tile(F, F.in[I_WIN] + (size_t)li * D * DIN, DIN, (r / 40) * 64, (r % 40) * 64, WSP(bf16_t, WS_WIN) + (size_t)li * DIN * D, D, 0); continue; }
        r -= T_IN;
        if (r < T_OUT) { tconv_tile(F, F.in[I_WOUT] + (size_t)li * D * D, D, (r / 16) * 64, (r % 16) * 64, WSP(bf16_t, WS_WOUT) + (size_t)li * D * D, D, 0); continue; }
        r -= T_OUT;
        const int e = r / (3 * T_E), w = (r / T_E) % 3, t = r % T_E;
        if (w < 2) tconv_tile(F, F.in[w == 0 ? I_MW1 : I_MW3] + ((size_t)li * NE + e) * D * DE, DE, (t / 8) * 64, (t % 8) * 64, WSP(bf16_t, WS_W13) + ((size_t)li * NE + e) * 1024 * 1024, D, 1 + w);
        else tconv_tile(F, F.in[I_MW2] + ((size_t)li * NE + e) * DE * D, D, (t / 16) * 64, (t % 16) * 64, WSP(bf16_t, WS_W2) + ((size_t)li * NE + e) * 1024 * 512, DE, 0);
    }
    __syncthreads();
    {
        float* sc = (float*)F.lds;
        float* red = sc + 3072;
        for (int i = F.tid; i < 3072; i += NTHR) { const int v = i >> 10, k = i & 1023; const float x = (v < 2) ? F.in[I_C][v * 1024 + k] : F.in[I_CCTX][k]; sc[i] = siluf(x); }
        __syncthreads();
        for (int u = F.bid; u < 2 * 96; u += F.G) {
            const int li = u / 96, j = (u % 96) * 64 + F.lane, ko = F.wave;
            const float* w = F.in[I_ADAW] + (size_t)li * D * 6144 + j;
            float a0 = 0.f, a1 = 0.f, a2 = 0.f;
            for (int k = ko * 128; k < ko * 128 + 128; ++k) { const float wv = w[(size_t)k * 6144]; a0 += sc[k] * wv; a1 += sc[1024 + k] * wv; a2 += sc[2048 + k] * wv; }
            red[(ko * 3 + 0) * 64 + F.lane] = a0; red[(ko * 3 + 1) * 64 + F.lane] = a1; red[(ko * 3 + 2) * 64 + F.lane] = a2;
            __syncthreads();
            if (F.tid < 192) { const int v = F.tid / 64, l = F.tid % 64; float s = 0.f;
#pragma unroll
                for (int q = 0; q < 8; ++q) s += red[(q * 3 + v) * 64 + l];
                const int jj = (u % 96) * 64 + l;
                WSP(float, WS_MOD)[((size_t)li * 3 + v) * 6144 + jj] = s + F.in[I_ADAB][li * 6144 + jj]; }
            __syncthreads();
        }
    }
    if (F.bid == (F.G > 2 ? 2 : 0)) {
        for (int idx = F.tid; idx < 2 * 4 * 64 * 64; idx += NTHR) { const int i = idx & 63, j = (idx >> 6) & 63, lg = idx >> 12;
            WSP(bf16_t, WS_PWT)[idx] = f2bf(F.in[I_POOLW][((size_t)lg * 64 + i) * 64 + j]); }
    }
    if (F.bid == (F.G > 1 ? 1 : 0)) {
        for (int i = F.tid; i < 256 * 8; i += NTHR) { const int pos = i >> 3, f = i & 7; const float inv = exp2f(-(float)f * (13.287712379549449f / 8.f)); const float rev = (float)pos * inv * 0.15915494309189535f;
            WSP(float, WS_ROPE)[i * 2] = cos_rev(rev); WSP(float, WS_ROPE)[i * 2 + 1] = sin_rev(rev); }
    }
}

#define MFMA32(a, b, c) __builtin_amdgcn_mfma_f32_32x32x16_bf16((a), (b), (c), 0, 0, 0)
DI void filter_tile(const Frame& F, int li, int L, int tile, float* hT, float* part) {
    float* h1s = (float*)F.lds;
    float* h2s = h1s + 64 * 65;
    float* w1s = h2s + 64 * 68;
    float* w2s = w1s + 34 * 64;
    const float* w3 = F.in[I_HW3] + (size_t)li * 64 * 1024; const float* b3 = F.in[I_HB3] + li * 1024;
    const int t0 = tile * 64;
    const float inv_lm1 = 1.f / (float)(L > 1 ? L - 1 : 1);
    __syncthreads();
    {
        const float* w1 = F.in[I_HW1] + (size_t)li * 33 * 64; const float* b1 = F.in[I_HB1] + li * 64;
        const float* w2 = F.in[I_HW2] + (size_t)li * 64 * 64; const float* b2 = F.in[I_HB2] + li * 64;
        for (int i = F.tid; i < 33 * 64; i += NTHR) w1s[i] = w1[i];
        for (int i = F.tid; i < 4096; i += NTHR) w2s[i] = w2[i];
        if (F.tid < 64) { w1s[33 * 64 + F.tid] = b1[F.tid]; w2s[4096 + F.tid] = b2[F.tid]; }
    }
    __syncthreads();
    {
        const int tl = F.tid & 63, pt = F.tid >> 6; const float t = (float)(t0 + tl);
        float a[8];
#pragma unroll
        for (int jj = 0; jj < 8; ++jj) a[jj] = w1s[33 * 64 + pt * 8 + jj] + (t * inv_lm1) * w1s[pt * 8 + jj];
#pragma unroll 2
        for (int i = 0; i < 16; ++i) { const float band = 1e-4f + (15.f - 1e-4f) * (float)i / 15.f; const float rev = t * band / (float)L; const float cz = cos_rev(rev), sz = sin_rev(rev);
#pragma unroll
            for (int jj = 0; jj < 8; ++jj) a[jj] += cz * w1s[(1 + i) * 64 + pt * 8 + jj] + sz * w1s[(17 + i) * 64 + pt * 8 + jj]; }
#pragma unroll
        for (int jj = 0; jj < 8; ++jj) h1s[tl * 65 + pt * 8 + jj] = sin_rad(a[jj]);
    }
    __syncthreads();
    {
        const int tl = F.tid & 63, pt = F.tid >> 6;
        float a[8];
#pragma unroll
        for (int jj = 0; jj < 8; ++jj) a[jj] = w2s[4096 + pt * 8 + jj];
#pragma unroll 4
        for (int i = 0; i < 64; ++i) { const float hv = h1s[tl * 65 + i];
#pragma unroll
            for (int jj = 0; jj < 8; ++jj) a[jj] += hv * w2s[i * 64 + pt * 8 + jj]; }
#pragma unroll
        for (int jj = 0; jj < 8; ++jj) h2s[tl * 68 + pt * 8 + jj] = sin_rad(a[jj]);
    }
    __syncthreads();
    {
        const int l31 = F.lane & 31, kg = F.lane >> 5;
        auto split8 = [](const float (&x)[8], bf16x8& hi, bf16x8& lo) {
            u32x4 h, l;
#pragma unroll
            for (int e = 0; e < 4; ++e) { const unsigned hp = pk2(x[2 * e], x[2 * e + 1]); h[e] = hp;
                l[e] = pk2(x[2 * e] - __uint_as_float(hp << 16), x[2 * e + 1] - __uint_as_float(hp & 0xffff0000u)); }
            hi = __builtin_bit_cast(bf16x8, h); lo = __builtin_bit_cast(bf16x8, l); };
        bf16x8 Bh[2][4], Bl[2][4];
#pragma unroll
        for (int pb = 0; pb < 2; ++pb)
#pragma unroll
            for (int ks = 0; ks < 4; ++ks) { const float* hp = h2s + (pb * 32 + l31) * 68 + ks * 16 + kg * 8; const f32x4 x0 = *(const f32x4*)hp, x1 = *(const f32x4*)(hp + 4);
                const float x[8] = {x0[0], x0[1], x0[2], x0[3], x1[0], x1[1], x1[2], x1[3]}; split8(x, Bh[pb][ks], Bl[pb][ks]); }
        const float tn0 = (float)(t0 + l31) * inv_lm1, tn1 = (float)(t0 + 32 + l31) * inv_lm1;
        const bool b4 = (l31 & 16) != 0, b3q = (l31 & 8) != 0, b2 = (l31 & 4) != 0, b1q = (l31 & 2) != 0;
#pragma unroll 1
        for (int cb = 0; cb < 4; ++cb) {
            const int ch0 = F.wave * 128 + cb * 32;
            f32x16 acc0, acc1;
#pragma unroll
            for (int i = 0; i < 16; ++i) { acc0[i] = 0.f; acc1[i] = 0.f; }
#pragma unroll
            for (int ks = 0; ks < 4; ++ks) {
                float x[8];
#pragma unroll
                for (int e = 0; e < 8; ++e) x[e] = w3[(size_t)(ks * 16 + kg * 8 + e) * 1024 + ch0 + l31];
                bf16x8 Ah, Al; split8(x, Ah, Al);
                acc0 = MFMA32(Ah, Bh[0][ks], acc0); acc1 = MFMA32(Ah, Bh[1][ks], acc1);
                acc0 = MFMA32(Al, Bh[0][ks], acc0); acc1 = MFMA32(Al, Bh[1][ks], acc1);
                acc0 = MFMA32(Ah, Bl[0][ks], acc0); acc1 = MFMA32(Ah, Bl[1][ks], acc1);
            }
            float sq[16];
#pragma unroll
            for (int i = 0; i < 16; ++i) {
                const int ch = ch0 + 8 * (i >> 2) + 4 * kg + (i & 3);
                const float bb = b3[ch], delta = 3.0701134573253945f + (15.350567286626973f - 3.0701134573253945f) * (float)(ch & 255) / 255.f;
                const float v0 = (acc0[i] + bb) * __expf(-tn0 * delta), v1 = (acc1[i] + bb) * __expf(-tn1 * delta);
                float* hp = hT + (size_t)ch * L + t0 + l31; hp[0] = v0; hp[32] = v1;
                sq[i] = v0 * v0 + v1 * v1;
            }
            float a8[8], a4[4], a2[2];
#pragma unroll
            for (int e = 0; e < 8; ++e) { const float keep = b4 ? sq[e + 8] : sq[e], send = b4 ? sq[e] : sq[e + 8]; a8[e] = keep + swz_xor<16>(send); }
#pragma unroll
            for (int e = 0; e < 4; ++e) { const float keep = b3q ? a8[e + 4] : a8[e], send = b3q ? a8[e] : a8[e + 4]; a4[e] = keep + swz_xor<8>(send); }
#pragma unroll
            for (int e = 0; e < 2; ++e) { const float keep = b2 ? a4[e + 2] : a4[e], send = b2 ? a4[e] : a4[e + 2]; a2[e] = keep + swz_xor<4>(send); }
            float a1 = (b1q ? a2[1] : a2[0]) + swz_xor<2>(b1q ? a2[0] : a2[1]);
            a1 += swz_xor<1>(a1);
            const int rg = (b4 ? 8 : 0) + (b3q ? 4 : 0) + (b2 ? 2 : 0) + (b1q ? 1 : 0);
            if ((l31 & 1) == 0) part[(size_t)tile * 1024 + ch0 + 8 * (rg >> 2) + 4 * kg + (rg & 3)] = a1;
        }
    }
}

struct TokInfo { unsigned e0, e1, p0, p1; float g0, g1; unsigned s0, s1; };
DI void phase_norm1(const Frame& F, int li, int mode) {
    const int nrows = (mode == 2) ? NLAT : NTOK;
    const float* modp = WSP(float, WS_MOD) + (size_t)li * 3 * 6144;
    const float* modprev = WSP(float, WS_MOD) + (size_t)(mode == 2 ? 1 : li - 1) * 3 * 6144;
    const float* gam = (mode == 2) ? F.in[I_FG] : F.in[I_N1G] + (size_t)li * D;
    const TokInfo* tok = WSP(TokInfo, WS_TOK); const bf16_t* ys = WSP(bf16_t, WS_A1);
    bf16_t* hbf = WSP(bf16_t, WS_HBF);
    auto xrowp = [&](int r) -> float* { return r >= NLAT ? WSP(float, WS_XC) + (size_t)(r - NLAT) * D : F.out + (size_t)r * D; };
    auto srcp = [&](int r) -> const float* { return (mode == 0) ? (r >= NLAT ? F.in[I_CTX] + (size_t)(r - NLAT) * D : F.in[I_X] + (size_t)r * D) : (const float*)xrowp(r); };
    const int r0 = F.bid * 8 + F.wave, rstep = F.G * 8, lc = F.lane * 4;
    f32x4 xn[4]; u32x2 yan[4], ybn[4]; TokInfo t1 = {}, t2 = {};
    if (r0 < nrows) {
#pragma unroll
        for (int i = 0; i < 4; ++i) xn[i] = *(const f32x4*)(srcp(r0) + i * 256 + lc);
        if (mode != 0) { t1 = tok[r0]; if (r0 + rstep < nrows) t2 = tok[r0 + rstep];
#pragma unroll
            for (int i = 0; i < 4; ++i) { yan[i] = *(const u32x2*)(ys + (size_t)t1.s0 * D + i * 256 + lc); ybn[i] = *(const u32x2*)(ys + (size_t)t1.s1 * D + i * 256 + lc); } }
    }
    for (int r = r0; r < nrows; r += rstep) {
        const bool isctx = r >= NLAT; const int v = isctx ? 2 : (r >> 14);
        f32x4 x[4]; u32x2 ya[4], yb[4]; const TokInfo ti = t1;
#pragma unroll
        for (int i = 0; i < 4; ++i) { x[i] = xn[i]; ya[i] = yan[i]; yb[i] = ybn[i]; }
        if (r + rstep < nrows) {
#pragma unroll
            for (int i = 0; i < 4; ++i) xn[i] = *(const f32x4*)(srcp(r + rstep) + i * 256 + lc);
            if (mode != 0) { t1 = t2; if (r + 2 * rstep < nrows) t2 = tok[r + 2 * rstep];
#pragma unroll
                for (int i = 0; i < 4; ++i) { yan[i] = *(const u32x2*)(ys + (size_t)t1.s0 * D + i * 256 + lc); ybn[i] = *(const u32x2*)(ys + (size_t)t1.s1 * D + i * 256 + lc); } }
        }
        if (mode != 0) {
            const float* g2 = modprev + (size_t)v * 6144 + 5 * 1024;
#pragma unroll
            for (int i = 0; i < 4; ++i) {
                const u32x2 a = ya[i], b = yb[i];
                const f32x4 gg = *(const f32x4*)(g2 + i * 256 + lc);
                f32x4 y;
                y[0] = ti.g0 * __uint_as_float(a[0] << 16) + ti.g1 * __uint_as_float(b[0] << 16);
                y[1] = ti.g0 * __uint_as_float(a[0] & 0xffff0000u) + ti.g1 * __uint_as_float(b[0] & 0xffff0000u);
                y[2] = ti.g0 * __uint_as_float(a[1] << 16) + ti.g1 * __uint_as_float(b[1] << 16);
                y[3] = ti.g0 * __uint_as_float(a[1] & 0xffff0000u) + ti.g1 * __uint_as_float(b[1] & 0xffff0000u);
                x[i] = x[i] + gg * y;
            }
            if (mode == 1) { float* xrow = xrowp(r);
#pragma unroll
                for (int i = 0; i < 4; ++i) *(f32x4*)(xrow + i * 256 + lc) = x[i]; }
        }
        float ss = 0.f;
#pragma unroll
        for (int i = 0; i < 4; ++i) ss += x[i][0] * x[i][0] + x[i][1] * x[i][1] + x[i][2] * x[i][2] + x[i][3] * x[i][3];
        ss = wave_sum(ss);
        const float rstd = rsqrtf(ss * (1.f / D) + EPS);
#pragma unroll
        for (int i = 0; i < 4; ++i) {
            const int c = i * 256 + lc;
            const f32x4 g = *(const f32x4*)(gam + c);
            if (mode == 2) { *(f32x4*)(F.out + (size_t)r * D + c) = x[i] * rstd * g; }
            else {
                const f32x4 sh = *(const f32x4*)(modp + (size_t)v * 6144 + c), sc = *(const f32x4*)(modp + (size_t)v * 6144 + 1024 + c);
                const f32x4 h = x[i] * rstd * g * (sc + 1.f) + sh;
                *(u32x2*)(hbf + (size_t)r * D + c) = (u32x2){pk2(h[0], h[1]), pk2(h[2], h[3])};
            }
        }
    }
}

DI void phase_norm2(const Frame& F, int li, int nrows) {
    float* wt = (float*)F.lds;
    __syncthreads();
    for (int i = F.tid; i < 16384; i += NTHR) { const int k = i >> 4, e = i & 15; wt[e * 1024 + k] = F.in[I_RW][i]; }
    __syncthreads();
    const float* modp = WSP(float, WS_MOD) + (size_t)li * 3 * 6144;
    const float* gam = F.in[I_N2G] + (size_t)li * D;
    bf16_t* hbf = WSP(bf16_t, WS_HBF); TokInfo* tok = WSP(TokInfo, WS_TOK);
    unsigned* lcnt = (unsigned*)(F.lds + LDS_MISC + 64);
    if (F.tid < 16) lcnt[F.tid] = 0u;
    __syncthreads();
    auto rowp = [&](int r) -> const float* { return r >= NLAT ? WSP(float, WS_XC) + (size_t)(r - NLAT) * D : F.out + (size_t)r * D; };
    const int r_first = F.bid * 8 + F.wave, rstep = F.G * 8;
    f32x4 xn[4];
    if (r_first < nrows) {
#pragma unroll
        for (int i = 0; i < 4; ++i) xn[i] = *(const f32x4*)(rowp(r_first) + i * 256 + F.lane * 4);
    }
    const bool b2 = (F.lane & 4) != 0, b3 = (F.lane & 8) != 0, b4 = (F.lane & 16) != 0;
    for (int r = r_first; r < nrows; r += rstep) {
        const bool isctx = r >= NLAT; const int v = isctx ? 2 : (r >> 14);
        f32x4 x[4]; float ss = 0.f;
#pragma unroll
        for (int i = 0; i < 4; ++i) { x[i] = xn[i]; ss += x[i][0] * x[i][0] + x[i][1] * x[i][1] + x[i][2] * x[i][2] + x[i][3] * x[i][3]; }
        if (r + rstep < nrows) {
#pragma unroll
            for (int i = 0; i < 4; ++i) xn[i] = *(const f32x4*)(rowp(r + rstep) + i * 256 + F.lane * 4);
        }
        ss = wave_sum(ss);
        const float rstd = rsqrtf(ss * (1.f / D) + EPS);
        float lg[16];
#pragma unroll
        for (int e = 0; e < 16; ++e) lg[e] = 0.f;
#pragma unroll
        for (int i = 0; i < 4; ++i) {
            const int c = i * 256 + F.lane * 4;
            const f32x4 g = *(const f32x4*)(gam + c), sh = *(const f32x4*)(modp + (size_t)v * 6144 + 3 * 1024 + c), sc = *(const f32x4*)(modp + (size_t)v * 6144 + 4 * 1024 + c);
            const f32x4 h = x[i] * rstd * g * (sc + 1.f) + sh;
            *(u32x2*)(hbf + (size_t)r * D + c) = (u32x2){pk2(h[0], h[1]), pk2(h[2], h[3])};
#pragma unroll
            for (int e = 0; e < 16; ++e) { const f32x4 w = *(const f32x4*)(wt + e * 1024 + c); lg[e] += h[0] * w[0] + h[1] * w[1] + h[2] * w[2] + h[3] * w[3]; }
        }
        float a8[8], a4[4], a2[2];
#pragma unroll
        for (int e = 0; e < 8; ++e) { const auto rr = __builtin_amdgcn_permlane32_swap(__float_as_uint(lg[e]), __float_as_uint(lg[e + 8]), false, false); a8[e] = __uint_as_float(rr[0]) + __uint_as_float(rr[1]); }
#pragma unroll
        for (int e = 0; e < 4; ++e) { const float keep = b4 ? a8[e + 4] : a8[e], send = b4 ? a8[e] : a8[e + 4]; a4[e] = keep + swz_xor<16>(send); }
#pragma unroll
        for (int e = 0; e < 2; ++e) { const float keep = b3 ? a4[e + 2] : a4[e], send = b3 ? a4[e] : a4[e + 2]; a2[e] = keep + swz_xor<8>(send); }
        float a1 = (b2 ? a2[1] : a2[0]) + swz_xor<4>(b2 ? a2[0] : a2[1]);
        a1 += swz_xor<2>(a1); a1 += swz_xor<1>(a1);
#pragma unroll
        for (int e = 0; e < 16; ++e) lg[e] = __int_as_float(__builtin_amdgcn_readlane(__float_as_int(a1), 4 * e));
        float mx = lg[0];
#pragma unroll
        for (int e = 1; e < 16; ++e) mx = fmaxf(mx, lg[e]);
        float sc[16], sel[16], den = 0.f;
#pragma unroll
        for (int e = 0; e < 16; ++e) { sc[e] = __expf(lg[e] - mx); den += sc[e]; }
        const float rden = 1.f / den;
#pragma unroll
        for (int e = 0; e < 16; ++e) { sc[e] *= rden; sel[e] = sc[e] + F.in[I_RB][e]; }
        int bg = 0; float bgs = -1e30f;
#pragma unroll
        for (int g = 0; g < 4; ++g) {
            float m1 = -1e30f, m2 = -1e30f;
#pragma unroll
            for (int q = 0; q < 4; ++q) { const float s = sel[g * 4 + q]; if (s > m1) { m2 = m1; m1 = s; } else if (s > m2) m2 = s; }
            const float gs = m1 + m2; if (gs > bgs) { bgs = gs; bg = g; }
        }
        int e0 = 0, e1 = 0; float s0v = -1e30f, s1v = -1e30f, w0 = 0.f, w1 = 0.f;
#pragma unroll
        for (int e = 0; e < 16; ++e) {
            const bool ing = (e >> 2) == bg; const float s = sel[e];
            if (ing && s > s0v) { s1v = s0v; e1 = e0; w1 = w0; s0v = s; e0 = e; w0 = sc[e]; }
            else if (ing && s > s1v) { s1v = s; e1 = e; w1 = sc[e]; }
        }
        if (F.lane == 0) {
            TokInfo ti; ti.e0 = e0; ti.e1 = e1; ti.p0 = atomicAdd(lcnt + e0, 1u); ti.p1 = atomicAdd(lcnt + e1, 1u);
            const float ws = 1.f / (w0 + w1); ti.g0 = w0 * ws; ti.g1 = w1 * ws; ti.s0 = 0; ti.s1 = 0;
            tok[r] = ti;
        }
    }
    __syncthreads();
    if (F.tid < 16) F.ctl[CW_BCNT + (li * MAXG + F.bid) * 16 + F.tid] = lcnt[F.tid];
}

DI void moe_offsets(const Frame& F, int li, int* offs) {
    __syncthreads();
    int* tot = offs + 376;
    int* part = (int*)F.lds;
    {
        const int e = F.tid & 15, pq = F.tid >> 4;
        const unsigned* bc = F.ctl + CW_BCNT + li * MAXG * 16 + e;
        int st = 0, sb = 0;
#pragma unroll
        for (int k = 0; k < 8; ++k) { const int blk = pq * 8 + k; const int c = (blk < F.G) ? (int)__hip_atomic_load(bc + blk * 16, __ATOMIC_RELAXED, __HIP_MEMORY_SCOPE_AGENT) : 0; st += c; sb += (blk < F.bid) ? c : 0; }
        part[pq * 16 + e] = st; part[512 + pq * 16 + e] = sb;
    }
    __syncthreads();
    if (F.tid < 32) { const int e = F.tid & 15, wb = F.tid >> 4; int s = 0;
        for (int pq = 0; pq < 32; ++pq) s += part[wb * 512 + pq * 16 + e];
        if (wb) offs[360 + e] = s; else tot[e] = s; }
    __syncthreads();
    if (F.tid == 0) { int o = 0; for (int e = 0; e < NE; ++e) { offs[e] = o; offs[17 + e] = o >> 8; o += (tot[e] + 255) & ~255; }
        offs[16] = o; offs[17 + 16] = o >> 8; }
    __syncthreads();
    for (int t = F.tid; t < SLOT_CAP / 256; t += NTHR) { int e = 0; for (int k = 1; k < NE; ++k) e += (offs[17 + k] <= t) ? 1 : 0; offs[40 + t] = e; }
    if (F.tid < 16) offs[360 + F.tid] += offs[F.tid];
    __syncthreads();
}
DI void phase_gather(const Frame& F, int li, int nrows) {
    int* offs = (int*)(F.lds + LDS_MISC + 64);
    moe_offsets(F, li, offs);
    const bf16_t* hbf = WSP(bf16_t, WS_HBF); bf16_t* a1 = WSP(bf16_t, WS_A1); TokInfo* tok = WSP(TokInfo, WS_TOK);
    for (int r = F.bid * 8 + F.wave; r < nrows; r += F.G * 8) {
        TokInfo ti = tok[r];
        const unsigned s0 = offs[360 + ti.e0] + ti.p0, s1 = offs[360 + ti.e1] + ti.p1;
        const u32x4 a = *(const u32x4*)(hbf + (size_t)r * D + F.lane * 8), b = *(const u32x4*)(hbf + (size_t)r * D + 512 + F.lane * 8);
        *(u32x4*)(a1 + (size_t)s0 * D + F.lane * 8) = a; *(u32x4*)(a1 + (size_t)s0 * D + 512 + F.lane * 8) = b;
        *(u32x4*)(a1 + (size_t)s1 * D + F.lane * 8) = a; *(u32x4*)(a1 + (size_t)s1 * D + 512 + F.lane * 8) = b;
        if (F.lane == 0) { tok[r].s0 = s0; tok[r].s1 = s1; }
    }
}

DI float lam_of(const Frame& F, int li, float& lam_init) {
    const float* lv = F.in[I_ALAM] + (size_t)li * 128;
    const int i = F.lane & 31, hi = F.lane >> 5;
    float d = lv[hi * 64 + i] * lv[hi * 64 + 32 + i];
    d += swz_xor<16>(d); d += swz_xor<8>(d); d += swz_xor<4>(d); d += swz_xor<2>(d); d += swz_xor<1>(d);
    const float d0 = __int_as_float(__builtin_amdgcn_readlane(__float_as_int(d), 0)), d1 = __int_as_float(__builtin_amdgcn_readlane(__float_as_int(d), 32));
    float lif = (float)li; asm volatile("" : "+v"(lif));
    lam_init = 0.8f - 0.6f * __expf(-0.3f * lif);
    return __expf(d0) - __expf(d1) + lam_init;
}
DI bf16x8 pack8(const f32x16& x, int s) {
    u32x4 p; p[0] = pk2(x[8 * s], x[8 * s + 1]); p[1] = pk2(x[8 * s + 2], x[8 * s + 3]); p[2] = pk2(x[8 * s + 4], x[8 * s + 5]); p[3] = pk2(x[8 * s + 6], x[8 * s + 7]);
    return __builtin_bit_cast(bf16x8, p);
}

DI void diffattn_unit(const Frame& F, int li, int b, int h, size_t qrow0, int NT2) {
    const int lane = F.lane, r = lane & 31, hh = lane >> 5, c = F.wave & 1, g = F.wave >> 1;
    const bf16_t* AQ = WSP(bf16_t, WS_AQ); const bf16_t* AK = WSP(bf16_t, WS_AK); const bf16_t* AVT = WSP(bf16_t, WS_AVT) + (size_t)(b * 4 + h) * 64 * NKEY;
    float lam_init; const float lam = lam_of(F, li, lam_init);
    const size_t qrow = qrow0 + g * 32 + r;
    bf16x8 qf[2]; float qn2 = 0.f;
#pragma unroll
    for (int ks = 0; ks < 2; ++ks) { qf[ks] = *(const bf16x8*)(AQ + qrow * 256 + h * 64 + c * 32 + ks * 16 + 8 * hh);
#pragma unroll
        for (int j = 0; j < 8; ++j) { const float v = bf2f((bf16_t)qf[ks][j]); qn2 += v * v; } }
    qn2 = half_sum(qn2);
    f32x16 cinit;
    { const float km = sqrtf(__uint_as_float(__hip_atomic_load(F.ctl + CW_KMAX + li * 16 + (b * 4 + h) * 2 + c, __ATOMIC_RELAXED, __HIP_MEMORY_SCOPE_AGENT)));
      const float cn = -(sqrtf(qn2) * km * 1.02f + 1e-3f);
#pragma unroll
      for (int i = 0; i < 16; ++i) cinit[i] = cn; }
    f32x16 O[2];
#pragma unroll
    for (int dh = 0; dh < 2; ++dh)
#pragma unroll
        for (int i = 0; i < 16; ++i) O[dh][i] = 0.f;
    f32x16 lacc;
#pragma unroll
    for (int i = 0; i < 16; ++i) lacc[i] = 0.f;
    constexpr int KTB = 2 * 128 * 64, VTB = 64 * 264, STG = KTB + VTB;
    const int skey = F.tid >> 2, sq = F.tid & 3;
    const int kdst0 = (sq >> 1) * 8192 + skey * 64 + ((((sq & 1) * 2 + 0) ^ ((skey >> 2) & 3)) * 16);
    const int kdst1 = (sq >> 1) * 8192 + skey * 64 + ((((sq & 1) * 2 + 1) ^ ((skey >> 2) & 3)) * 16);
    const int vd = F.tid >> 3, vpart = F.tid & 7;
    const int vdst = KTB + vd * 264 + vpart * 32;
    auto krow_of = [&](int j) -> size_t { return j < CTX ? (size_t)NLAT + b * CTX + j : (size_t)b * S + (j - CTX); };
    unsigned char* L = F.lds;
    u32x4 kreg[2], vreg[2];
    { const bf16_t* kp = AK + krow_of(skey) * 256 + h * 64 + sq * 16; const bf16_t* vp = AVT + (size_t)vd * NKEY + vpart * 16;
      kreg[0] = *(const u32x4*)kp; kreg[1] = *(const u32x4*)(kp + 8); vreg[0] = *(const u32x4*)vp; vreg[1] = *(const u32x4*)(vp + 8); }
    __syncthreads();
    *(u32x4*)(L + kdst0) = kreg[0]; *(u32x4*)(L + kdst1) = kreg[1];
    *(u32x2*)(L + vdst) = (u32x2){vreg[0][0], vreg[0][1]}; *(u32x2*)(L + vdst + 8) = (u32x2){vreg[0][2], vreg[0][3]};
    *(u32x2*)(L + vdst + 16) = (u32x2){vreg[1][0], vreg[1][1]}; *(u32x2*)(L + vdst + 24) = (u32x2){vreg[1][2], vreg[1][3]};
    __syncthreads();
    const int ksw = (r >> 2) & 3;
    const int kr0 = c * 8192 + r * 64 + (((0 + hh) ^ ksw) * 16), kr1 = c * 8192 + r * 64 + (((2 + hh) ^ ksw) * 16);
    const int vr0 = r * 264 + 8 * hh;
#define DA_QK(Sx, st) do { \
        const bf16x8 k0 = *(const bf16x8*)(kb + (st) * 2048 + kr0), k1 = *(const bf16x8*)(kb + (st) * 2048 + kr1); \
        Sx = MFMA32(k0, qf[0], cinit); Sx = MFMA32(k1, qf[1], Sx); } while (0)
#define DA_PV(Sx, st) do { bf16x8 vf[2][2]; \
        _Pragma("unroll") for (int dh = 0; dh < 2; ++dh) _Pragma("unroll") for (int s2 = 0; s2 < 2; ++s2) { \
            const unsigned char* vp = vb + dh * (32 * 264) + vr0 + (st) * 64 + s2 * 32; \
            const s16x4 lo = *(const s16x4*)vp, hi = *(const s16x4*)(vp + 16); \
            vf[dh][s2] = __builtin_shufflevector(lo, hi, 0, 1, 2, 3, 4, 5, 6, 7); } \
        _Pragma("unroll") for (int i = 0; i < 16; ++i) Sx[i] = __builtin_amdgcn_exp2f(Sx[i]); \
        lacc += Sx; \
        const bf16x8 p0 = pack8(Sx, 0), p1 = pack8(Sx, 1); \
        O[0] = MFMA32(vf[0][0], p0, O[0]); O[1] = MFMA32(vf[1][0], p0, O[1]); \
        O[0] = MFMA32(vf[0][1], p1, O[0]); O[1] = MFMA32(vf[1][1], p1, O[1]); } while (0)
#pragma unroll 1
    for (int kt = 0; kt < NT2; ++kt) {
        const int buf = kt & 1;
        if (kt + 1 < NT2) {
            const int j0 = (kt + 1) * 128;
            const bf16_t* kp = AK + krow_of(j0 + skey) * 256 + h * 64 + sq * 16; const bf16_t* vp = AVT + (size_t)vd * NKEY + j0 + vpart * 16;
            kreg[0] = *(const u32x4*)kp; kreg[1] = *(const u32x4*)(kp + 8); vreg[0] = *(const u32x4*)vp; vreg[1] = *(const u32x4*)(vp + 8);
        }
        const unsigned char* kb = L + buf * STG; const unsigned char* vb = L + buf * STG + KTB;
        f32x16 Sa, Sb;
        DA_QK(Sa, 0);
        DA_QK(Sb, 1); DA_PV(Sa, 0);
        DA_QK(Sa, 2); DA_PV(Sb, 1);
        DA_QK(Sb, 3); DA_PV(Sa, 2);
        DA_PV(Sb, 3);
        if (kt + 1 < NT2) {
            unsigned char* W = L + (buf ^ 1) * STG;
            *(u32x4*)(W + kdst0) = kreg[0]; *(u32x4*)(W + kdst1) = kreg[1];
            *(u32x2*)(W + vdst) = (u32x2){vreg[0][0], vreg[0][1]}; *(u32x2*)(W + vdst + 8) = (u32x2){vreg[0][2], vreg[0][3]};
            *(u32x2*)(W + vdst + 16) = (u32x2){vreg[1][0], vreg[1][1]}; *(u32x2*)(W + vdst + 24) = (u32x2){vreg[1][2], vreg[1][3]};
        }
        __syncthreads();
    }
#undef DA_QK
#undef DA_PV
    float lsum = 0.f;
#pragma unroll
    for (int i = 0; i < 16; ++i) lsum += lacc[i];
    const float rl = 1.f / half_sum(lsum);
    float* xb = (float*)L + (size_t)g * 32 * 64;
    if (c == 1) {
#pragma unroll
        for (int dh = 0; dh < 2; ++dh)
#pragma unroll
            for (int i = 0; i < 16; ++i) xb[(dh * 16 + i) * 64 + lane] = O[dh][i] * (rl * lam);
    }
    __syncthreads();
    if (c == 0) {
        float o[2][16]; float ss = 0.f;
#pragma unroll
        for (int dh = 0; dh < 2; ++dh)
#pragma unroll
            for (int i = 0; i < 16; ++i) { o[dh][i] = O[dh][i] * rl - xb[(dh * 16 + i) * 64 + lane]; ss += o[dh][i] * o[dh][i]; }
        ss = half_sum(ss);
        const float rs = rsqrtf(ss * (1.f / 64.f) + EPS) * (1.f - lam_init);
        const float* sg = F.in[I_ASUB] + li * 64;
        bf16_t* mix = WSP(bf16_t, WS_HBF) + qrow * D + h * 64;
#pragma unroll
        for (int dh = 0; dh < 2; ++dh)
#pragma unroll
            for (int gq = 0; gq < 4; ++gq) {
                const int d = 32 * dh + 8 * gq + 4 * hh;
                const f32x4 gg = *(const f32x4*)(sg + d);
                *(u32x2*)(mix + d) = (u32x2){pk2(o[dh][4 * gq] * rs * gg[0], o[dh][4 * gq + 1] * rs * gg[1]), pk2(o[dh][4 * gq + 2] * rs * gg[2], o[dh][4 * gq + 3] * rs * gg[3])};
            }
    }
}

DI void na_mfma_unit(const Frame& F, int li, int b, size_t qrow0, int grow) {
    const int lane = F.lane, r31 = lane & 31, hh = lane >> 5, h = F.wave >> 1, qh = F.wave & 1;
    const bf16_t* BQ = WSP(bf16_t, WS_BQ); const bf16_t* BK = WSP(bf16_t, WS_BK); const bf16_t* BVT = WSP(bf16_t, WS_BVT);
    constexpr int KB = 4 * 8192, VB = 4 * 8704, STG = KB + VB;
    unsigned char* L = F.lds;
    float* tab = (float*)(F.lds + 2 * STG);
    const int nwin = grow >= 0 ? 8 : 0, nt = nwin + 4;
    int r0 = grow - 4; r0 = r0 < 0 ? 0 : (r0 > 248 ? 248 : r0);
    __syncthreads();
    if (nwin) for (int i = F.tid; i < 4 * 15 * 32; i += NTHR) { const int c31 = i & 31, hr = i >> 5; tab[i] = (c31 < 31) ? F.in[I_RPB][(size_t)li * 4 * 465 + hr * 31 + c31] * LOG2E : -1e30f; }
    const int skey = F.tid >> 3, sc64 = F.tid & 7, sh = sc64 >> 1;
    const int vrow = F.tid >> 1, vhalf = F.tid & 1;
    auto kbase = [&](int ti) -> const bf16_t* { return ti < nwin ? BK + ((size_t)b * S + (size_t)(r0 + ti) * GW) * 256 : BK + ((size_t)NLAT + b * CTX + (ti - nwin) * 64) * 256; };
    auto vkey0 = [&](int ti) -> int { return ti < nwin ? CTX + (r0 + ti) * GW : (ti - nwin) * 64; };
    u32x4 kreg[4], vreg[4];
    { const bf16_t* kp = kbase(0) + (size_t)skey * 256 + sc64 * 32; const bf16_t* vp = BVT + ((size_t)b * 256 + vrow) * NKEY + vkey0(0) + vhalf * 32;
#pragma unroll
      for (int i = 0; i < 4; ++i) { kreg[i] = *(const u32x4*)(kp + i * 8); vreg[i] = *(const u32x4*)(vp + i * 8); } }
    const size_t qrow = qrow0 + 32 * qh + r31;
    bf16x8 qf[4]; float qn2 = 0.f;
#pragma unroll
    for (int ks = 0; ks < 4; ++ks) { qf[ks] = *(const bf16x8*)(BQ + qrow * 256 + h * 64 + ks * 16 + 8 * hh);
#pragma unroll
        for (int j = 0; j < 8; ++j) { const float v = bf2f((bf16_t)qf[ks][j]); qn2 += v * v; } }
    qn2 = half_sum(qn2);
    __syncthreads();
    float bmax = 0.f;
    if (nwin) { for (int i = lane; i < 480; i += 64) bmax = fmaxf(bmax, tab[h * 480 + i]); bmax = wave_max(bmax); }
    const unsigned* kmx = F.ctl + CW_KMAXB + li * 16 + (b * 4 + h) * 2;
    const float km = sqrtf(__uint_as_float(__hip_atomic_load(kmx, __ATOMIC_RELAXED, __HIP_MEMORY_SCOPE_AGENT)) + __uint_as_float(__hip_atomic_load(kmx + 1, __ATOMIC_RELAXED, __HIP_MEMORY_SCOPE_AGENT)));
    const float cneg = -(sqrtf(qn2) * km * 1.02f + bmax + 1e-3f);
    const int cq = 32 * qh + r31; int c0q = cq - 8; c0q = c0q < 0 ? 0 : (c0q > 48 ? 48 : c0q);
    const int qrow_g = grow;
    f32x16 O[2];
#pragma unroll
    for (int dh = 0; dh < 2; ++dh)
#pragma unroll
        for (int i = 0; i < 16; ++i) O[dh][i] = 0.f;
    f32x16 lacc;
#pragma unroll
    for (int i = 0; i < 16; ++i) lacc[i] = 0.f;
    int tcol[2][16];
#pragma unroll
    for (int st = 0; st < 2; ++st)
#pragma unroll
        for (int i = 0; i < 16; ++i) { const int kc = 32 * st + (i & 3) + 8 * (i >> 2) + 4 * hh; tcol[st][i] = ((kc >= c0q) && (kc < c0q + 16)) ? (kc - cq + 15) : 31; }
    const int kdst = sh * 8192 + skey * 128, ksw = (skey >> 1) & 7, kch0 = (sc64 & 1) * 4;
    const int vdst = KB + (vrow >> 6) * 8704 + (vrow & 63) * 136 + vhalf * 64;
#pragma unroll
    for (int i = 0; i < 4; ++i) { *(u32x4*)(L + kdst + (((kch0 + i) ^ ksw) * 16)) = kreg[i];
        *(u32x2*)(L + vdst + i * 16) = (u32x2){vreg[i][0], vreg[i][1]}; *(u32x2*)(L + vdst + i * 16 + 8) = (u32x2){vreg[i][2], vreg[i][3]}; }
    __syncthreads();
#pragma unroll 1
    for (int ti = 0; ti < nt; ++ti) {
        const int buf = ti & 1;
        if (ti + 1 < nt) { const bf16_t* kp = kbase(ti + 1) + (size_t)skey * 256 + sc64 * 32; const bf16_t* vp = BVT + ((size_t)b * 256 + vrow) * NKEY + vkey0(ti + 1) + vhalf * 32;
#pragma unroll
            for (int i = 0; i < 4; ++i) { kreg[i] = *(const u32x4*)(kp + i * 8); vreg[i] = *(const u32x4*)(vp + i * 8); } }
        const unsigned char* kb = L + buf * STG + h * 8192; const unsigned char* vb = L + buf * STG + KB + h * 8704;
        const bool win = ti < nwin;
        const float* trow = tab + (h * 15 + (win ? (r0 + ti - qrow_g + 7) : 0)) * 32;
#pragma unroll
        for (int st = 0; st < 2; ++st) {
            const int key = 32 * st + r31, sw = (key >> 1) & 7;
            f32x16 s;
            if (win) {
#pragma unroll
                for (int i = 0; i < 16; ++i) s[i] = trow[tcol[st][i]] + cneg;
            } else {
#pragma unroll
                for (int i = 0; i < 16; ++i) s[i] = cneg;
            }
#pragma unroll
            for (int ks = 0; ks < 4; ++ks) { const bf16x8 kf = *(const bf16x8*)(kb + key * 128 + (((ks * 2 + hh) ^ sw) * 16)); s = MFMA32(kf, qf[ks], s); }
#pragma unroll
            for (int i = 0; i < 16; ++i) s[i] = __builtin_amdgcn_exp2f(s[i]);
            lacc += s;
            const bf16x8 p0 = pack8(s, 0), p1 = pack8(s, 1);
#pragma unroll
            for (int dh = 0; dh < 2; ++dh) {
                const unsigned char* vp = vb + (32 * dh + r31) * 136 + (32 * st + 4 * hh) * 2;
                const s16x4 a0 = *(const s16x4*)vp, a1 = *(const s16x4*)(vp + 16), b0 = *(const s16x4*)(vp + 32), b1 = *(const s16x4*)(vp + 48);
                O[dh] = MFMA32(__builtin_shufflevector(a0, a1, 0, 1, 2, 3, 4, 5, 6, 7), p0, O[dh]);
                O[dh] = MFMA32(__builtin_shufflevector(b0, b1, 0, 1, 2, 3, 4, 5, 6, 7), p1, O[dh]);
            }
        }
        if (ti + 1 < nt) { unsigned char* W = L + (buf ^ 1) * STG;
#pragma unroll
            for (int i = 0; i < 4; ++i) { *(u32x4*)(W + kdst + (((kch0 + i) ^ ksw) * 16)) = kreg[i];
                *(u32x2*)(W + vdst + i * 16) = (u32x2){vreg[i][0], vreg[i][1]}; *(u32x2*)(W + vdst + i * 16 + 8) = (u32x2){vreg[i][2], vreg[i][3]}; } }
        __syncthreads();
    }
    float lsum = 0.f;
#pragma unroll
    for (int i = 0; i < 16; ++i) lsum += lacc[i];
    const float rl = 1.f / half_sum(lsum);
    bf16_t* mix = WSP(bf16_t, WS_HBF) + qrow * D + 256 + h * 64;
#pragma unroll
    for (int dh = 0; dh < 2; ++dh)
#pragma unroll
        for (int g = 0; g < 4; ++g) { const int d = 32 * dh + 8 * g + 4 * hh;
            *(u32x2*)(mix + d) = (u32x2){pk2(O[dh][4 * g] * rl, O[dh][4 * g + 1] * rl), pk2(O[dh][4 * g + 2] * rl, O[dh][4 * g + 3] * rl)}; }
}

DI void pool_unit(const Frame& F, int li, size_t seq_row0, int L, int t0) {
    unsigned* us = (unsigned*)F.lds;
    unsigned char* dfb = F.lds + 80 * 512;
    const bf16_t* PL = WSP(bf16_t, WS_PL);
    __syncthreads();
    for (int i = F.tid; i < 80 * 32; i += NTHR) {
        const int tt = i >> 5, c8 = i & 31, t = t0 - 8 + tt;
        u32x4 x = (u32x4){0u, 0u, 0u, 0u};
        if (t >= 0 && t < L) x = *(const u32x4*)(PL + (seq_row0 + t) * 256 + c8 * 8);
        *(u32x4*)(us + tt * 128 + c8 * 4) = x;
    }
    __syncthreads();
    {
        const int cp = F.tid & 127, tl0 = (F.tid >> 7) * 16, hw = 1 << (cp >> 5);
        float s0 = 0.f, s1 = 0.f;
        for (int k = -hw; k < hw; ++k) { const unsigned w = us[(tl0 + 8 + k) * 128 + cp]; s0 += __uint_as_float(w << 16); s1 += __uint_as_float(w & 0xffff0000u); }
#pragma unroll 4
        for (int j = 0; j < 16; ++j) {
            const int tl = tl0 + j, t = t0 + tl;
            const int lo = t - hw < 0 ? 0 : t - hw, hi = t + hw > L ? L : t + hw;
            const float rc = 1.f / (float)(hi - lo);
            const unsigned c = us[(tl + 8) * 128 + cp];
            *(unsigned*)(dfb + tl * 528 + cp * 4) = pk2(s0 * rc - __uint_as_float(c << 16), s1 * rc - __uint_as_float(c & 0xffff0000u));
            const unsigned a = us[(tl + 8 + hw) * 128 + cp], b = us[(tl + 8 - hw) * 128 + cp];
            s0 += __uint_as_float(a << 16) - __uint_as_float(b << 16); s1 += __uint_as_float(a & 0xffff0000u) - __uint_as_float(b & 0xffff0000u);
        }
    }
    __syncthreads();
    {
        const int g = F.wave & 3, tq = F.wave >> 2, fr = F.lane & 15, fq = F.lane >> 4;
        const bf16_t* wt = WSP(bf16_t, WS_PWT) + ((size_t)li * 4 + g) * 4096;
        bf16x8 Af[4][2];
#pragma unroll
        for (int jb = 0; jb < 4; ++jb)
#pragma unroll
            for (int ks = 0; ks < 2; ++ks) Af[jb][ks] = *(const bf16x8*)(wt + (jb * 16 + fr) * 64 + ks * 32 + fq * 8);
        const float* ps = F.in[I_POOLS] + li * 256 + g * 64;
        bf16_t* mix = WSP(bf16_t, WS_HBF);
#pragma unroll
        for (int tb = 0; tb < 2; ++tb) {
            const int tl = (tq * 2 + tb) * 16 + fr;
            const bf16x8 B0 = *(const bf16x8*)(dfb + tl * 528 + (g * 64 + fq * 8) * 2), B1 = *(const bf16x8*)(dfb + tl * 528 + (g * 64 + 32 + fq * 8) * 2);
#pragma unroll
            for (int jb = 0; jb < 4; ++jb) {
                f32x4 acc = (f32x4){0.f, 0.f, 0.f, 0.f};
                acc = __builtin_amdgcn_mfma_f32_16x16x32_bf16(Af[jb][0], B0, acc, 0, 0, 0);
                acc = __builtin_amdgcn_mfma_f32_16x16x32_bf16(Af[jb][1], B1, acc, 0, 0, 0);
                const f32x4 sc = *(const f32x4*)(ps + jb * 16 + 4 * fq);
                *(u32x2*)(mix + (seq_row0 + t0 + tl) * D + 512 + g * 64 + jb * 16 + 4 * fq) = (u32x2){pk2(acc[0] * sc[0], acc[1] * sc[1]), pk2(acc[2] * sc[2], acc[3] * sc[3])};
            }
        }
    }
}

DI float hy_norm(const float* part, int ntile, int o, int ch) {
    float s = 0.f;
    for (int t = 0; t < ntile; ++t) s += part[(size_t)t * 1024 + (o * 2) * 256 + ch] + part[(size_t)t * 1024 + (o * 2 + 1) * 256 + ch];
    return rsqrtf(s + EPS);
}
DI float hy_short(const bf16_t* p, int t, int L, float w0, float w1, float w2, float bb) {
    const int tm = t > 0 ? t - 1 : 0, tp = t + 1 < L ? t + 1 : L - 1;
    float a = bf2f(p[tm]), c = bf2f(p[tp]); const float m = bf2f(p[t]);
    a = t > 0 ? a : 0.f; c = t + 1 < L ? c : 0.f;
    return a * w0 + m * w1 + c * w2 + bb;
}
constexpr int FM = 16384;
DI int fphys(int i) { return i + (i >> 4) + ((i >> 9) << 4); }
constexpr int brev(int m, int bits) { return bits == 5 ? (((m & 1) << 4) | ((m & 2) << 2) | (m & 4) | ((m & 8) >> 2) | ((m & 16) >> 4)) : (((m & 1) << 3) | ((m & 2) << 1) | ((m & 4) >> 1) | ((m & 8) >> 3)); }
template <int R, int LOG2R, bool INV> DI void dft_regs(float (&re)[R], float (&im)[R]) {
    constexpr float C32[16] = {1.f, 0.98078528040323043f, 0.92387953251128674f, 0.83146961230254524f, 0.70710678118654752f, 0.55557023301960218f, 0.38268343236508977f, 0.19509032201612825f,
                               0.f, -0.19509032201612825f, -0.38268343236508977f, -0.55557023301960218f, -0.70710678118654752f, -0.83146961230254524f, -0.92387953251128674f, -0.98078528040323043f};
    constexpr float S32[16] = {0.f, 0.19509032201612825f, 0.38268343236508977f, 0.55557023301960218f, 0.70710678118654752f, 0.83146961230254524f, 0.92387953251128674f, 0.98078528040323043f,
                               1.f, 0.98078528040323043f, 0.92387953251128674f, 0.83146961230254524f, 0.70710678118654752f, 0.55557023301960218f, 0.38268343236508977f, 0.19509032201612825f};
#pragma unroll
    for (int st = 0; st < LOG2R; ++st) {
        const int h = R >> (st + 1);
#pragma unroll
        for (int i = 0; i < R; i += 2 * h) {
#pragma unroll
            for (int j = 0; j < h; ++j) {
                const float xr = re[i + j], xi = im[i + j], yr = re[i + j + h], yi = im[i + j + h];
                re[i + j] = xr + yr; im[i + j] = xi + yi;
                const float dr = xr - yr, di = xi - yi;
                const int k = j * (16 / h);
                if (k == 0) { re[i + j + h] = dr; im[i + j + h] = di; }
                else if (k == 8) { re[i + j + h] = INV ? -di : di; im[i + j + h] = INV ? dr : -dr; }
                else { const float c = C32[k], sn = INV ? S32[k] : -S32[k]; re[i + j + h] = dr * c - di * sn; im[i + j + h] = dr * sn + di * c; }
            }
        }
    }
}
template <bool INV, int SP> DI void fft_pass32(f32x2* X, int bp, int rem, float inv_bs) {
    asm volatile("" : "+v"(bp), "+v"(rem));
    f32x2* P = X + bp;
    const float revb = (float)rem * inv_bs;
    float re[32], im[32];
    if (!INV) {
#pragma unroll
        for (int q = 0; q < 32; ++q) { const f32x2 v = P[q * SP]; re[q] = v[0]; im[q] = v[1]; }
        dft_regs<32, 5, false>(re, im);
#pragma unroll
        for (int m = 0; m < 32; ++m) { const int qp = brev(m, 5);
            float r = re[m], i = im[m];
            if (qp != 0) { const float rev = revb * (float)qp; const float c = __builtin_amdgcn_cosf(rev), sn = -__builtin_amdgcn_sinf(rev); const float t = r * c - i * sn; i = r * sn + i * c; r = t; }
            P[qp * SP] = (f32x2){r, i}; }
    } else {
#pragma unroll
        for (int qp = 0; qp < 32; ++qp) { const f32x2 v = P[qp * SP]; float r = v[0], i = v[1];
            if (qp != 0) { const float rev = revb * (float)qp; const float c = __builtin_amdgcn_cosf(rev), sn = __builtin_amdgcn_sinf(rev); const float t = r * c - i * sn; i = r * sn + i * c; r = t; }
            re[qp] = r; im[qp] = i; }
        dft_regs<32, 5, true>(re, im);
#pragma unroll
        for (int m = 0; m < 32; ++m) P[brev(m, 5) * SP] = (f32x2){re[m], im[m]};
    }
}
DI void fft_fwd12(f32x2* X, int tid) {
    __syncthreads(); fft_pass32<false, 560>(X, fphys(tid), tid, 1.f / 16384.f);
    __syncthreads(); fft_pass32<false, 17>(X, (tid >> 4) * 560 + (tid & 15), tid & 15, 1.f / 512.f);
    __syncthreads();
}
DI void fft_inv21(f32x2* X, int tid) {
    __syncthreads(); fft_pass32<true, 17>(X, (tid >> 4) * 560 + (tid & 15), tid & 15, 1.f / 512.f);
    __syncthreads(); fft_pass32<true, 560>(X, fphys(tid), tid, 1.f / 16384.f);
    __syncthreads();
}
DI void hyena_fft_unit(const Frame& F, int li, int ch) {
    f32x2* X = (f32x2*)F.lds;
    const bf16_t* HYT = WSP(bf16_t, WS_HYT); const float* filt = WSP(float, WS_FILT);
    f32x2* Ye = WSP(f32x2, WS_ZBUF) + (size_t)ch * FM; f32x2* Z1 = WSP(f32x2, WS_Z1BUF) + (size_t)ch * FM;
    const float* sw = F.in[I_HYSW] + (size_t)li * 3 * 768; const float* sb = F.in[I_HYSB] + li * 768; const float* sk = F.in[I_HSKIP] + li * 512;
    const int tid = F.tid;
    const bf16_t* px1[2] = {HYT + ((size_t)0 * 768 + ch) * S, HYT + ((size_t)1 * 768 + ch) * S};
    const bf16_t* px2[2] = {HYT + ((size_t)0 * 768 + 256 + ch) * S, HYT + ((size_t)1 * 768 + 256 + ch) * S};
    const bf16_t* pv[2] = {HYT + ((size_t)0 * 768 + 512 + ch) * S, HYT + ((size_t)1 * 768 + 512 + ch) * S};
    const float wx1[4] = {sw[ch], sw[768 + ch], sw[1536 + ch], sb[ch]};
    const float wx2[4] = {sw[256 + ch], sw[768 + 256 + ch], sw[1536 + 256 + ch], sb[256 + ch]};
    const float wv[4] = {sw[512 + ch], sw[768 + 512 + ch], sw[1536 + 512 + ch], sb[512 + ch]};
#pragma unroll 1
    for (int cv = 0; cv < 2; ++cv) {
        const float* hf = filt + ((size_t)(2 * cv) * 256 + ch) * S; const float* hb = filt + ((size_t)(2 * cv + 1) * 256 + ch) * S;
        float fnrm;
        { int tn = tid; asm volatile("" : "+v"(tn));
          const float pv = WSP(float, WS_FPART)[(size_t)(tn & 255) * 1024 + (cv * 2 + (tn >> 8)) * 256 + ch];
          const float ws = wave_sum(pv);
          float* red = (float*)(F.lds + LDS_MISC + 128);
          __syncthreads();
          if (F.lane == 0) red[F.wave] = ws;
          __syncthreads();
          fnrm = rsqrtf(red[0] + red[1] + red[2] + red[3] + red[4] + red[5] + red[6] + red[7] + EPS); }
        const float nrm = 1.f / 32768.f;
        const float skip = sk[cv * 256 + ch];
#pragma unroll 1
        for (int half = 0; half < 2; ++half) {
            __syncthreads();
            int pb = fphys(tid); int tq = tid; asm volatile("" : "+v"(pb), "+v"(tq));
            if (half == 0) {
#pragma unroll 8
                for (int j = 0; j < 32; ++j) { const int n = tq + 512 * j; const float a = hf[n] * fnrm; float bq = hb[FM - n] * fnrm; bq = n ? bq : 0.f;
                    X[pb + 560 * j] = (f32x2){a + bq, 0.f}; }
            } else {
#pragma unroll 8
                for (int j = 0; j < 32; ++j) { const int n = tq + 512 * j; const float a = hf[n] * fnrm; float bq = hb[FM - n] * fnrm; bq = n ? bq : 0.f;
                    const float d = a - bq, rev = (float)n * (1.f / 32768.f);
                    X[pb + 560 * j] = (f32x2){d * __builtin_amdgcn_cosf(rev), -d * __builtin_amdgcn_sinf(rev)}; }
            }
            fft_fwd12(X, tid);
            h16x2 kpk[2][16];
#pragma unroll
            for (int g = 0; g < 2; ++g) { int b16 = fphys((tid + 512 * g) * 16); asm volatile("" : "+v"(b16));
                float kre[16], kim[16];
#pragma unroll
                for (int q = 0; q < 16; ++q) { const f32x2 v = X[b16 + q]; kre[q] = v[0]; kim[q] = v[1]; }
                dft_regs<16, 4, false>(kre, kim);
#pragma unroll
                for (int q = 0; q < 16; ++q) kpk[g][q] = (h16x2){(_Float16)kre[q], (_Float16)kim[q]}; }
            __syncthreads();
            asm volatile("" : "+v"(pb), "+v"(tq));
#define HY_MOD(v, n) do { const float rev = (float)(n) * (1.f / 32768.f); const float c = __builtin_amdgcn_cosf(rev), sn = -__builtin_amdgcn_sinf(rev); v = (f32x2){v[0] * c - v[1] * sn, v[0] * sn + v[1] * c}; } while (0)
            if (cv == 0) {
                if (half == 0) {
#pragma unroll 4
                    for (int j = 0; j < 32; ++j) { const int n = tq + 512 * j; X[pb + 560 * j] = (f32x2){hy_short(pv[0], n, S, wv[0], wv[1], wv[2], wv[3]), hy_short(pv[1], n, S, wv[0], wv[1], wv[2], wv[3])}; }
                } else {
#pragma unroll 4
                    for (int j = 0; j < 32; ++j) { const int n = tq + 512 * j; f32x2 v = (f32x2){hy_short(pv[0], n, S, wv[0], wv[1], wv[2], wv[3]), hy_short(pv[1], n, S, wv[0], wv[1], wv[2], wv[3])}; HY_MOD(v, n); X[pb + 560 * j] = v; }
                }
            } else {
                if (half == 0) {
#pragma unroll 8
                    for (int j = 0; j < 32; ++j) { const int n = tq + 512 * j; X[pb + 560 * j] = Z1[n]; }
                } else {
#pragma unroll 8
                    for (int j = 0; j < 32; ++j) { const int n = tq + 512 * j; f32x2 v = Z1[n]; HY_MOD(v, n); X[pb + 560 * j] = v; }
                }
            }
#undef HY_MOD
            fft_fwd12(X, tid);
#pragma unroll
            for (int g = 0; g < 2; ++g) { int b16 = fphys((tid + 512 * g) * 16); asm volatile("" : "+v"(b16));
                float re[16], im[16];
#pragma unroll
                for (int q = 0; q < 16; ++q) { const f32x2 v = X[b16 + q]; re[q] = v[0]; im[q] = v[1]; }
                dft_regs<16, 4, false>(re, im);
                float br[16], bi[16];
#pragma unroll
                for (int m = 0; m < 16; ++m) { const int qp = brev(m, 4); const float kr = (float)kpk[g][m][0], ki = (float)kpk[g][m][1]; br[qp] = re[m] * kr - im[m] * ki; bi[qp] = re[m] * ki + im[m] * kr; }
                dft_regs<16, 4, true>(br, bi);
#pragma unroll
                for (int m = 0; m < 16; ++m) X[b16 + brev(m, 4)] = (f32x2){br[m], bi[m]};
            }
            fft_inv21(X, tid);
            asm volatile("" : "+v"(pb), "+v"(tq));
            if (half == 0) {
#pragma unroll 8
                for (int j = 0; j < 32; ++j) { const int n = tq + 512 * j; Ye[n] = X[pb + 560 * j]; }
            } else {
#define HY_Y(n, j) const f32x2 yo = X[pb + 560 * (j)], ye = Ye[n]; \
                    const float rev = (float)(n) * (1.f / 32768.f); const float c = __builtin_amdgcn_cosf(rev), sn = __builtin_amdgcn_sinf(rev); \
                    const float y0 = (ye[0] + yo[0] * c - yo[1] * sn) * nrm, y1 = (ye[1] + yo[0] * sn + yo[1] * c) * nrm;
                if (cv == 0) {
#pragma unroll 4
                    for (int j = 0; j < 32; ++j) { const int n = tq + 512 * j; HY_Y(n, j)
                        const float v0 = hy_short(pv[0], n, S, wv[0], wv[1], wv[2], wv[3]), v1 = hy_short(pv[1], n, S, wv[0], wv[1], wv[2], wv[3]);
                        const float a0 = hy_short(px1[0], n, S, wx1[0], wx1[1], wx1[2], wx1[3]), a1 = hy_short(px1[1], n, S, wx1[0], wx1[1], wx1[2], wx1[3]);
                        Z1[n] = (f32x2){a0 * (y0 + skip * v0), a1 * (y1 + skip * v1)}; }
                } else {
                    bf16_t* mix = WSP(bf16_t, WS_HBF);
#pragma unroll 4
                    for (int j = 0; j < 32; ++j) { const int n = tq + 512 * j; HY_Y(n, j)
                        const f32x2 z1 = Z1[n];
                        const float a0 = hy_short(px2[0], n, S, wx2[0], wx2[1], wx2[2], wx2[3]), a1 = hy_short(px2[1], n, S, wx2[0], wx2[1], wx2[2], wx2[3]);
                        mix[((size_t)n) * D + 768 + ch] = f2bf(a0 * (y0 + skip * z1[0]));
                        mix[((size_t)S + n) * D + 768 + ch] = f2bf(a1 * (y1 + skip * z1[1])); }
                }
#undef HY_Y
            }
        }
    }
}
DI void hyena_ctx_unit(const Frame& F, int li, int ch) {
    float* vs = (float*)F.lds;
    float* zs = vs + 512;
    float* fl = zs + 512;
    const bf16_t* HYC = WSP(bf16_t, WS_HYC); const float* filt = WSP(float, WS_FILTC);
    const float* sw = F.in[I_HYSW] + (size_t)li * 3 * 768; const float* sb = F.in[I_HYSB] + li * 768; const float* sk = F.in[I_HSKIP] + li * 512;
    const float n0 = hy_norm(WSP(float, WS_FPARTC), 4, 0, ch), n1 = hy_norm(WSP(float, WS_FPARTC), 4, 1, ch);
    const int b = F.tid >> 8, t = F.tid & 255;
    auto sc = [&](int c) -> float { const bf16_t* p = HYC + (size_t)(b * CTX) * 768 + c;
        const float a = t > 0 ? bf2f(p[(size_t)(t - 1) * 768]) : 0.f, d = t + 1 < CTX ? bf2f(p[(size_t)(t + 1) * 768]) : 0.f;
        return a * sw[c] + bf2f(p[(size_t)t * 768]) * sw[768 + c] + d * sw[1536 + c] + sb[c]; };
    __syncthreads();
    const float x1 = sc(ch), x2 = sc(256 + ch), v = sc(512 + ch);
    vs[F.tid] = v;
    for (int i = F.tid; i < 1024; i += NTHR) fl[i] = filt[((size_t)(i >> 8) * 256 + ch) * CTX + (i & 255)];
    __syncthreads();
    float a = 0.f;
    for (int s = 0; s < CTX; ++s) { const int dl = t - s; a += (dl >= 0 ? fl[dl] : fl[256 - dl]) * vs[b * 256 + s]; }
    const float z = x1 * (a * n0 + sk[ch] * v);
    zs[F.tid] = z;
    __syncthreads();
    a = 0.f;
    for (int s = 0; s < CTX; ++s) { const int dl = t - s; a += (dl >= 0 ? fl[512 + dl] : fl[768 - dl]) * zs[b * 256 + s]; }
    WSP(bf16_t, WS_HBF)[((size_t)NLAT + b * CTX + t) * D + 768 + ch] = f2bf(x2 * (a * n1 + sk[256 + ch] * z));
}

DI void phase_mix(const Frame& F0, int li) {
    const Frame& F = F0;
    unsigned* head = F.ctl + CW_QHEAD + li * 64;
    volatile unsigned* qs = (volatile unsigned*)(F.lds + LDS_MISC + 32);
#ifndef PROBE_DA
#define PROBE_DA 1
#endif
#ifndef PROBE_HY
#define PROBE_HY 1
#endif
#ifndef PROBE_NA
#define PROBE_NA 1
#endif
#ifdef PROBE_MISC
#define PROBE_PL 2
#else
#define PROBE_PL 1
#endif
    const int n_ca = (li == 0) ? 16 : 0, n_cb = (li == 0) ? 8 : 0, n_da = 1024 * PROBE_DA, n_hy = 256 * PROBE_HY, n_na = 512 * PROBE_NA, n_hc = (li == 0) ? 256 * PROBE_PL : 0, n_pl = 512 * PROBE_PL, n_pc = (li == 0) ? 8 : 0;
    const int total = n_ca + n_cb + n_da + n_hy + n_na + n_hc + n_pl + n_pc;
#if defined(PT_T) && PT_T >= 12
    unsigned long long ptk_acc = 0ull, ptk_t0 = 0ull; int ptk_kind = -1;
#endif
    for (;;) {
        __syncthreads();
#if defined(PT_T) && PT_T >= 12
        { const unsigned long long now_ = __builtin_amdgcn_s_memrealtime(); __builtin_amdgcn_s_waitcnt(0xC07F); if (ptk_kind == PT_T - 12) ptk_acc += now_ - ptk_t0; ptk_t0 = now_; }
#endif
        if (F.tid == 0) qs[0] = __hip_atomic_fetch_add(head, 1u, __ATOMIC_RELAXED, __HIP_MEMORY_SCOPE_AGENT);
        __syncthreads();
        int u = __builtin_amdgcn_readfirstlane((int)qs[0]);
#if defined(PT_T) && PT_T >= 12
        ptk_kind = u < n_ca + n_cb ? 0 : u < n_ca + n_cb + n_da ? 1 : u < n_ca + n_cb + n_da + n_hy ? 2 : u < n_ca + n_cb + n_da + n_hy + n_na ? 3 : u < n_ca + n_cb + n_da + n_hy + n_na + n_hc ? 4 : 5;
        if (u >= total) { if (F0.tid == 0) atomicAdd((unsigned long long*)(F0.ctl + 13000), ptk_acc); break; }
#endif
        if (u >= total) break;
        Frame F = F0; refresh(F);
        if (u < n_ca) {
#ifndef SKIP_CA
            diffattn_unit(F, li, u >> 3, (u >> 1) & 3, (size_t)NLAT + (size_t)(u >> 3) * CTX + (size_t)(u & 1) * 128, CTX / 128);
#endif
            continue; }
        u -= n_ca;
        if (u < n_cb) {
#ifndef SKIP_CB
            na_mfma_unit(F, li, u >> 2, (size_t)NLAT + (size_t)(u >> 2) * CTX + (size_t)(u & 3) * 64, -1);
#endif
            continue; }
        u -= n_cb;
        if (u < n_da) {
#ifndef SKIP_DA
            { const int v = u & 1023; diffattn_unit(F, li, v >> 9, (v >> 7) & 3, (size_t)(v >> 9) * S + (size_t)(v & 127) * 128, NKEY / 128); }
#endif
            continue; }
        u -= n_da;
        if (u < n_hy) {
#ifndef SKIP_HY
            hyena_fft_unit(F, li, u & 255);
#endif
            continue; }
        u -= n_hy;
        if (u < n_na) {
#ifndef SKIP_NA
            { const int v = u & 511; na_mfma_unit(F, li, v >> 8, (size_t)(v >> 8) * S + (size_t)(v & 255) * GW, v & 255); }
#endif
            continue; }
        u -= n_na;
        if (u < n_hc) {
#ifndef SKIP_HC
            hyena_ctx_unit(F, li, u & 255);
#endif
            continue; }
        u -= n_hc;
        if (u < n_pl) {
#ifndef SKIP_PL
            { const int v = u & 511; pool_unit(F, li, (size_t)(v >> 8) * S, S, (v & 255) * 64); }
#endif
            continue; }
        u -= n_pl;
#ifndef SKIP_PL
        pool_unit(F, li, (size_t)NLAT + (u >> 2) * CTX, CTX, (u & 3) * 64);
#endif
    }
}

constexpr int PH_PER_LAYER = 8, NPH = 2 + 2 * PH_PER_LAYER;
#ifdef PT_T
#define PT_SEL(k) (PT_T == 10 || (PT_T == 8 && (k) == 0) || (PT_T == 9 && (k) == NPH - 1) || (PT_T < 8 && (k) >= 1 && (k) <= 16 && (((k) - 1) & 7) == PT_T))
#define PT_MARK(k) do { const unsigned long long now_ = __builtin_amdgcn_s_memrealtime(); __builtin_amdgcn_s_waitcnt(0xC07F); if (PT_SEL(k)) pt_acc += now_ - pt_last; pt_last = now_; } while (0)
#ifndef PT_MULT
#define PT_MULT 4
#endif
#else
#define PT_MARK(k) do { } while (0)
#endif
__global__ void __launch_bounds__(NTHR, 2) mega(Args args) {
    extern __shared__ __attribute__((aligned(16))) unsigned char smem[];
    Frame F;
    F.in = args.in; F.out = args.out; F.ws = args.ws; F.ctl = (unsigned*)(args.ws + WS_CTL); F.lds = smem;
    F.tid = threadIdx.x; F.lane = F.tid & 63; F.wave = __builtin_amdgcn_readfirstlane(F.tid >> 6); F.G = gridDim.x; F.bid = blockIdx.x;
    if (F.tid < 64) ((unsigned*)(smem + LDS_MISC))[F.tid] = 0u;
    __syncthreads();
    const int lo = args.ph_lo, hi = args.ph_hi;
    const bool fused = (hi - lo) > 1;
    XcdBarrier bar; bar.bar = F.ctl; bar.x = 0; bar.st = (volatile LAS unsigned*)(smem + LDS_MISC);
    if (fused) bar = xcd_barrier_post(F.ctl, (volatile LAS unsigned*)(smem + LDS_MISC));
#define IN(k) (lo <= (k) && (k) < hi)
#ifdef PT_T
    unsigned long long pt_acc = 0ull, pt_last = __builtin_amdgcn_s_memrealtime(); __builtin_amdgcn_s_waitcnt(0xC07F);
#endif
#ifdef PROBE_BAR
#define SEAM(k) do { if (IN(k) && IN((k) + 1)) { xcd_barrier(bar); xcd_barrier(bar); xcd_barrier(bar); } } while (0)
#else
#define SEAM(k) do { if (IN(k) && IN((k) + 1)) xcd_barrier(bar); PT_MARK(k); } while (0)
#endif
#ifndef SKIP_P0
    if (IN(0)) { refresh(F); phase_prologue(F);
#ifdef PROBE_MISC
        __syncthreads(); refresh(F); phase_prologue(F);
#endif
    }
#endif
    SEAM(0);
    for (int li = 0; li < 2; ++li) {
        const int p0 = 1 + li * PH_PER_LAYER;
        const int nrows = (li == 0) ? NTOK : NLAT;
        if (IN(p0)) {
            refresh(F);
#if defined(PT_T) && PT_T >= 20 && PT_T <= 23
            const unsigned long long tn0_ = __builtin_amdgcn_s_memrealtime(); __builtin_amdgcn_s_waitcnt(0xC07F);
#endif
            phase_norm1(F, li, li == 0 ? 0 : 1);
#if defined(PT_T) && PT_T >= 20 && PT_T <= 23
            __syncthreads();
            const unsigned long long tn1_ = __builtin_amdgcn_s_memrealtime(); __builtin_amdgcn_s_waitcnt(0xC07F);
            if (threadIdx.x == 0 && PT_T == 20 + li) atomicAdd((unsigned long long*)(F.ctl + 13000), tn1_ - tn0_);
#endif
#ifdef PROBE_N1
            if (li == 0) { refresh(F); phase_norm1(F, li, 0); refresh(F); phase_norm1(F, li, 0); refresh(F); phase_norm1(F, li, 0); refresh(F); phase_norm1(F, li, 0); }
#endif
            refresh(F);
#ifndef SKIP_FILT
            for (int t = F.bid; t < 256; t += F.G) filter_tile(F, li, S, t, WSP(float, WS_FILT), WSP(float, WS_FPART));
            if (li == 0) for (int t = F.bid; t < 4; t += F.G) filter_tile(F, li, CTX, t, WSP(float, WS_FILTC), WSP(float, WS_FPARTC));
#ifdef PROBE_MISC
            for (int t = F.bid; t < 256; t += F.G) filter_tile(F, li, S, t, WSP(float, WS_FILT), WSP(float, WS_FPART));
#endif
#endif
#if defined(PT_T) && PT_T >= 20 && PT_T <= 23
            { __syncthreads(); const unsigned long long tn2_ = __builtin_amdgcn_s_memrealtime(); __builtin_amdgcn_s_waitcnt(0xC07F);
              if (threadIdx.x == 0 && PT_T == 22 + li) atomicAdd((unsigned long long*)(F.ctl + 13000), tn2_ - tn1_); }
#endif
        }
        SEAM(p0);
        if (IN(p0 + 1)) {
            refresh(F);
            pg8::Gemm g{WSP(bf16_t, WS_HBF), WSP(bf16_t, WS_WIN) + (size_t)li * DIN * D, D, 0};
            pg8::StaticOrder So; So.init(NTOK, DIN, F.G, F.bid);
            EpiIn E{F.ws, WSP(float, WS_ROPE), F.ctl + CW_KMAX + li * 16, F.ctl + CW_KMAXB + li * 16};
#ifndef SKIP_G1
            pg8::gemm_phase<EpiIn, pg8::StaticOrder>((LAS unsigned char*)smem, g, So, E, F.tid);
#ifdef PROBE_G1
            __syncthreads(); refresh(F); pg8::gemm_phase<EpiIn, pg8::StaticOrder>((LAS unsigned char*)smem, g, So, E, F.tid);
#endif
#endif
        }
        SEAM(p0 + 1);
        if (IN(p0 + 2)) { refresh(F); phase_mix(F, li); }
#if defined(PT_T) && PT_T == 11
        { const unsigned long long ta_ = __builtin_amdgcn_s_memrealtime(); __builtin_amdgcn_s_waitcnt(0xC07F);
          SEAM(p0 + 2);
          const unsigned long long tb_ = __builtin_amdgcn_s_memrealtime(); __builtin_amdgcn_s_waitcnt(0xC07F);
          if (threadIdx.x == 0) atomicAdd((unsigned long long*)(F.ctl + 13000), tb_ - ta_); }
#else
        SEAM(p0 + 2);
#endif
        if (IN(p0 + 3)) {
            refresh(F);
            pg8::Gemm g{WSP(bf16_t, WS_HBF), WSP(bf16_t, WS_WOUT) + (size_t)li * D * D, D, 0};
            pg8::StaticOrder So; So.init(nrows, D, F.G, F.bid);
            EpiOut E{li == 0 ? F.in[I_X] : F.out, li == 0 ? F.in[I_CTX] : WSP(float, WS_XC), F.out, WSP(float, WS_XC), WSP(float, WS_MOD) + (size_t)li * 3 * 6144};
#ifndef SKIP_G2
            pg8::gemm_phase<EpiOut, pg8::StaticOrder>((LAS unsigned char*)smem, g, So, E, F.tid);
#endif
        }
        SEAM(p0 + 3);
#ifndef SKIP_N2
        if (IN(p0 + 4)) { refresh(F); phase_norm2(F, li, nrows); }
#endif
        SEAM(p0 + 4);
        if (IN(p0 + 5)) { refresh(F); phase_gather(F, li, nrows);
#ifdef PROBE_MISC
            __syncthreads(); refresh(F); phase_gather(F, li, nrows);
#endif
        }
        SEAM(p0 + 5);
        if (IN(p0 + 6)) {
            refresh(F);
            int* offs = (int*)(smem + LDS_MISC + 64);
            moe_offsets(F, li, offs);
            pg8::Gemm g{WSP(bf16_t, WS_A1), WSP(bf16_t, WS_W13) + (size_t)li * NE * 1024 * 1024, D, (size_t)1024 * 1024};
            pg8::MoeOrder Mo{offs + 40, offs[17 + 16], 4, F.G, (F.G % 8 == 0) ? (F.bid % 8) * (F.G / 8) + F.bid / 8 : F.bid};
            EpiMoe1 E{WSP(bf16_t, WS_HMID)};
#ifndef SKIP_G3
            pg8::gemm_phase<EpiMoe1, pg8::MoeOrder>((LAS unsigned char*)smem, g, Mo, E, F.tid);
#ifdef PROBE_G3
            __syncthreads(); refresh(F); pg8::gemm_phase<EpiMoe1, pg8::MoeOrder>((LAS unsigned char*)smem, g, Mo, E, F.tid);
#endif
#endif
        }
        SEAM(p0 + 6);
        if (IN(p0 + 7)) {
            refresh(F);
            int* offs = (int*)(smem + LDS_MISC + 64);
            moe_offsets(F, li, offs);
            pg8::Gemm g{WSP(bf16_t, WS_HMID), WSP(bf16_t, WS_W2) + (size_t)li * NE * 1024 * 512, DE, (size_t)1024 * 512};
            pg8::MoeOrder Mo{offs + 40, offs[17 + 16], 4, F.G, (F.G % 8 == 0) ? (F.bid % 8) * (F.G / 8) + F.bid / 8 : F.bid};
            EpiMoe2 E{WSP(bf16_t, WS_A1)};
#ifndef SKIP_G4
            pg8::gemm_phase<EpiMoe2, pg8::MoeOrder>((LAS unsigned char*)smem, g, Mo, E, F.tid);
#ifdef PROBE_G4
            __syncthreads(); refresh(F); pg8::gemm_phase<EpiMoe2, pg8::MoeOrder>((LAS unsigned char*)smem, g, Mo, E, F.tid);
#endif
#endif
        }
        SEAM(p0 + 7);
    }
    if (IN(NPH - 1)) { refresh(F); phase_norm1(F, 1, 2); }
#ifdef PT_T
    asm volatile("s_waitcnt vmcnt(0)" ::: "memory"); __syncthreads();
    PT_MARK(NPH - 1);
#if PT_T >= 11
    xcd_barrier(bar);
    pt_acc = __hip_atomic_load((unsigned long long*)(F.ctl + 13000), __ATOMIC_RELAXED, __HIP_MEMORY_SCOPE_AGENT) / (unsigned long long)F.G;
    pt_last = __builtin_amdgcn_s_memrealtime();
#endif
    if (F.bid == 0) { const unsigned long long until = pt_last + (unsigned long long)PT_MULT * pt_acc;
        while (__builtin_amdgcn_s_memrealtime() < until) __builtin_amdgcn_s_sleep(8); }
#endif
#undef IN
#undef SEAM
}

extern "C" void kernel_launch(void* const* d_in, const int* in_sizes, int n_in, void* d_out, int out_size, void* d_ws, size_t ws_size, hipStream_t stream) {
    static int grid = 0;
    if (grid == 0) {
        if (n_in != N_IN || out_size != NLAT * D || ws_size < WS_END) { fprintf(stderr, "kernel_launch: unexpected shapes (n_in %d out %d ws %zu need %zu)\n", n_in, out_size, ws_size, (size_t)WS_END); grid = -1; return; }
        int dev = 0, cus = 0, per_cu = 0;
        if (hipGetDevice(&dev) != hipSuccess || hipDeviceGetAttribute(&cus, hipDeviceAttributeMultiprocessorCount, dev) != hipSuccess) { grid = -1; return; }
        if (hipFuncSetAttribute((const void*)mega, hipFuncAttributeMaxDynamicSharedMemorySize, LDS_BYTES) != hipSuccess) { fprintf(stderr, "kernel_launch: hipFuncSetAttribute failed\n"); grid = -1; return; }
        if (hipOccupancyMaxActiveBlocksPerMultiprocessor(&per_cu, (const void*)mega, NTHR, LDS_BYTES) != hipSuccess || per_cu < 1) { fprintf(stderr, "kernel_launch: occupancy query says %d\n", per_cu); }
        (void)hipGetLastError();
        grid = cus < MAXG ? cus : MAXG;
    }
    if (grid < 0) return;
    (void)hipMemsetAsync((char*)d_ws + WS_CTL, 0, CTL_BYTES, stream);
    Args a{};
    for (int i = 0; i < N_IN; ++i) a.in[i] = (const float*)d_in[i];
    a.out = (float*)d_out; a.ws = (unsigned char*)d_ws;
#if N_LAUNCH_MODE == 1
    a.ph_lo = 0; a.ph_hi = NPH;
    hipLaunchKernelGGL(mega, dim3(grid), dim3(NTHR), LDS_BYTES, stream, a);
#else
    for (int p = 0; p < NPH; ++p) { a.ph_lo = p; a.ph_hi = p + 1; hipLaunchKernelGGL(mega, dim3(grid), dim3(NTHR), LDS_BYTES, stream, a); }
#endif
}
#ifdef TEST_UNITS
__global__ void __launch_bounds__(NTHR, 2) t_da(Args args) {
    extern __shared__ __attribute__((aligned(16))) unsigned char smem[];
    Frame F; F.in = args.in; F.out = args.out; F.ws = args.ws; F.ctl = (unsigned*)(args.ws + WS_CTL); F.lds = smem; F.G = gridDim.x; F.bid = blockIdx.x; refresh(F);
    diffattn_unit(F, args.ph_lo, blockIdx.x >> 8, (blockIdx.x >> 6) & 3, (size_t)(blockIdx.x & 63) * 256, NKEY / 128);
}
__global__ void __launch_bounds__(NTHR, 2) t_hy(Args args) {
    extern __shared__ __attribute__((aligned(16))) unsigned char smem[];
    Frame F; F.in = args.in; F.out = args.out; F.ws = args.ws; F.ctl = (unsigned*)(args.ws + WS_CTL); F.lds = smem; F.G = gridDim.x; F.bid = blockIdx.x; refresh(F);
    hyena_fft_unit(F, args.ph_lo, blockIdx.x);
}
#endif
```

```cpp
#include <hip/hip_runtime.h>
#include <stdint.h>
#include <stdio.h>

#ifndef N_LAUNCH_MODE
#define N_LAUNCH_MODE 1
#endif

#define DI __device__ __forceinline__
#define LAS __attribute__((address_space(3)))
typedef unsigned short bf16_t;
typedef short bf16x8 __attribute__((ext_vector_type(8)));
typedef short s16x4 __attribute__((ext_vector_type(4)));
typedef float f32x4 __attribute__((ext_vector_type(4)));
typedef float f32x2 __attribute__((ext_vector_type(2)));
typedef float f32x16 __attribute__((ext_vector_type(16)));
typedef unsigned u32x4 __attribute__((ext_vector_type(4)));
typedef unsigned u32x2 __attribute__((ext_vector_type(2)));
typedef _Float16 h16x2 __attribute__((ext_vector_type(2)));

constexpr int D = 1024, NB = 2, S = 16384, CTX = 256, NLAT = NB * S, NCTX = NB * CTX, NTOK = NLAT + NCTX, DIN = 2560;
constexpr int NE = 16, DE = 512, GW = 64;
constexpr int NKEY = CTX + S;
constexpr int NTHR = 512;
constexpr int SLOT_CAP = 70656;
constexpr float EPS = 1e-6f;
constexpr float LOG2E = 1.4426950408889634f;
constexpr float QSCALE_A = 0.17677669529663687f * LOG2E;
constexpr float QSCALE_B = 0.125f * LOG2E;

enum { I_X = 0, I_C, I_CTX, I_CCTX, I_N1G, I_N2G, I_ADAW, I_ADAB, I_WIN, I_WOUT, I_ALAM, I_ASUB, I_RPB, I_POOLW, I_POOLS, I_HYSW, I_HYSB,
       I_HW1, I_HB1, I_HW2, I_HB2, I_HW3, I_HB3, I_HSKIP, I_RW, I_RB, I_MW1, I_MW3, I_MW2, I_FG, N_IN };

struct Args { const float* in[N_IN]; float* out; unsigned char* ws; int ph_lo, ph_hi; };

constexpr size_t al256(size_t x) { return (x + 255) & ~(size_t)255; }
constexpr size_t WS_CTL = 0, CTL_BYTES = 65536;
constexpr size_t WS_MOD = WS_CTL + CTL_BYTES;
constexpr size_t WS_ROPE = WS_MOD + al256(2 * 3 * 6144 * 4);
constexpr size_t WS_PWT = WS_ROPE + 16384;
constexpr size_t WS_FPART = WS_PWT + 65536;
constexpr size_t WS_FPARTC = WS_FPART + 256 * 1024 * 4;
constexpr size_t WS_XC = WS_FPARTC + 4 * 1024 * 4;
constexpr size_t WS_WIN = WS_XC + (size_t)NCTX * D * 4;
constexpr size_t WS_WOUT = WS_WIN + (size_t)2 * DIN * D * 2;
constexpr size_t WS_W13 = WS_WOUT + (size_t)2 * D * D * 2;
constexpr size_t WS_W2 = WS_W13 + (size_t)2 * NE * 1024 * 1024 * 2;
constexpr size_t WS_FILT = WS_W2 + (size_t)2 * NE * 1024 * 512 * 2;
constexpr size_t WS_FILTC = WS_FILT + (size_t)4 * 256 * S * 4;
constexpr size_t WS_ZBUF = WS_FILTC + (size_t)4 * 256 * 256 * 4;
constexpr size_t WS_R1 = WS_ZBUF + (size_t)256 * 2 * S * 4;
constexpr size_t WS_HBF = WS_R1;
constexpr size_t TOKB = (size_t)NTOK * 256 * 2;
constexpr size_t WS_AQ = WS_HBF + (size_t)NTOK * D * 2;
constexpr size_t WS_AK = WS_AQ + TOKB;
constexpr size_t WS_AVT = WS_AK + TOKB;
constexpr size_t WS_BQ = WS_AVT + (size_t)NB * 4 * 64 * NKEY * 2;
constexpr size_t WS_BK = WS_BQ + TOKB;
constexpr size_t WS_BVT = WS_BK + TOKB;
constexpr size_t WS_PL = WS_BVT + (size_t)NB * 4 * 64 * NKEY * 2;
constexpr size_t WS_HYT = WS_PL + TOKB;
constexpr size_t WS_HYC = WS_HYT + (size_t)NB * 768 * S * 2;
constexpr size_t WS_Z1BUF = WS_HYC + (size_t)NCTX * 768 * 2;
constexpr size_t WS_END_MIX = WS_Z1BUF + (size_t)256 * S * 8;
constexpr size_t WS_TOK = WS_AQ;
constexpr size_t WS_A1 = WS_TOK + al256((size_t)NTOK * 32);
constexpr size_t WS_HMID = WS_A1 + (size_t)SLOT_CAP * D * 2;
constexpr size_t WS_END_MOE = WS_HMID + (size_t)SLOT_CAP * DE * 2;
constexpr size_t WS_END = WS_END_MIX > WS_END_MOE ? WS_END_MIX : WS_END_MOE;

#define XB_TMO      128
#define XB_XCNT(j)  (256  + 64 * (j))
#define XB_XSUB(j)  (1280 + 64 * (j))
#define XB_XGEN(j)  (2304 + 64 * (j))
#define XB_TOP      3328
#define XB_TOPGEN   3392
#define XCD_BAR_WORDS 3456
#define XB_SPIN_CAP (1u << 18)
constexpr int CW_CNT = 4096;
constexpr int CW_KMAX = 4160;
constexpr int CW_KMAXB = 4192;
constexpr int CW_QHEAD = 4224;
constexpr int CW_BCNT = 4352;
constexpr int MAXG = 256;

constexpr int LDS_MAIN = 147456, LDS_MISC = LDS_MAIN, LDS_BYTES = LDS_MAIN + 2048;

DI float bf2f(bf16_t v) { return __uint_as_float(((unsigned)v) << 16); }
DI bf16_t f2bf(float f) { unsigned u = __float_as_uint(f); u += 0x7FFFu + ((u >> 16) & 1u); return (bf16_t)(u >> 16); }
DI unsigned pk2(float lo, float hi) { unsigned r; asm volatile("v_cvt_pk_bf16_f32 %0, %1, %2" : "=v"(r) : "v"(lo), "v"(hi)); return r; }
template <int K> DI float swz_xor(float v) { return __int_as_float(__builtin_amdgcn_ds_swizzle(__float_as_int(v), (K << 10) | 0x1F)); }
DI float half_sum(float v) { const auto r = __builtin_amdgcn_permlane32_swap(__float_as_uint(v), __float_as_uint(v), false, false); return __uint_as_float(r[0]) + __uint_as_float(r[1]); }
DI float half_max(float v) { const auto r = __builtin_amdgcn_permlane32_swap(__float_as_uint(v), __float_as_uint(v), false, false); return fmaxf(__uint_as_float(r[0]), __uint_as_float(r[1])); }
DI float wave_sum(float v) { v += swz_xor<16>(v); v += swz_xor<8>(v); v += swz_xor<4>(v); v += swz_xor<2>(v); v += swz_xor<1>(v); return half_sum(v); }
DI float wave_max(float v) { v = fmaxf(v, swz_xor<16>(v)); v = fmaxf(v, swz_xor<8>(v)); v = fmaxf(v, swz_xor<4>(v)); v = fmaxf(v, swz_xor<2>(v)); v = fmaxf(v, swz_xor<1>(v)); return half_max(v); }
DI float siluf(float x) { return x / (1.f + __expf(-x)); }
DI float sin_rev(float rev) { return __builtin_amdgcn_sinf(rev - floorf(rev)); }
DI float cos_rev(float rev) { return __builtin_amdgcn_cosf(rev - floorf(rev)); }
DI float sin_rad(float x) { return sin_rev(x * 0.15915494309189535f); }

DI unsigned xb_ld(unsigned* p)              { return __hip_atomic_load(p, __ATOMIC_RELAXED, __HIP_MEMORY_SCOPE_AGENT); }
DI unsigned xb_add(unsigned* p, unsigned v) { return __hip_atomic_fetch_add(p, v, __ATOMIC_RELAXED, __HIP_MEMORY_SCOPE_AGENT); }
DI unsigned xb_xcc_id() { return (unsigned)__builtin_amdgcn_s_getreg((3 << 11) | 20) & 0xFu; }
#define XB_SPIN(cond, bar) do { unsigned _sp = 0; while (cond) { __builtin_amdgcn_s_sleep(1); \
    if ((++_sp & 255u) == 0u) { if (xb_ld(&(bar)[XB_TMO])) break; if (_sp > XB_SPIN_CAP) { atomicAdd(&(bar)[XB_TMO], 1u); break; } } } } while (0)
struct XcdBarrier { unsigned* bar; unsigned x; volatile LAS unsigned* st; };
DI XcdBarrier xcd_barrier_post(unsigned* bar, volatile LAS unsigned* st) {
    XcdBarrier b; b.bar = bar; b.x = xb_xcc_id(); b.st = st;
    if (threadIdx.x == 0) (void)xb_add(&bar[XB_XCNT(b.x)], 1u);
    return b;
}
DI void xcd_barrier_complete(unsigned* bar, unsigned x, unsigned& nloc, unsigned& nx) {
    const unsigned G = gridDim.x * gridDim.y * gridDim.z;
    unsigned sum, cnt, mine, sp = 0u;
    for (;;) {
        sum = 0u; cnt = 0u; mine = 0u;
#pragma unroll
        for (unsigned j = 0; j < 16; ++j) { const unsigned c = xb_ld(&bar[XB_XCNT(j)]); sum += c; cnt += (c > 0u) ? 1u : 0u; mine = (j == x) ? c : mine; }
        if (sum == G) break;
        __builtin_amdgcn_s_sleep(1);
        if ((++sp & 255u) == 0u) { if (xb_ld(&bar[XB_TMO])) break; if (sp > XB_SPIN_CAP) { atomicAdd(&bar[XB_TMO], 1u); break; } }
    }
    nloc = mine > 0u ? mine : 1u; nx = cnt > 0u ? cnt : 1u;
}
DI void xcd_barrier(const XcdBarrier& b) {
    asm volatile("s_waitcnt vmcnt(0)" ::: "memory");
    __syncthreads();
    if (threadIdx.x == 0) {
        unsigned* bar = b.bar;
        __builtin_amdgcn_s_waitcnt(0);
        unsigned nloc = b.st[0], nx = b.st[1];
        if (nloc == 0u) { xcd_barrier_complete(bar, b.x, nloc, nx); b.st[0] = nloc; b.st[1] = nx; }
        const unsigned old = xb_add(&bar[XB_XSUB(b.x)], 1u);
        const unsigned gen = old / nloc;
        if (old + 1u == (gen + 1u) * nloc) {
            __builtin_amdgcn_fence(__ATOMIC_RELEASE, "agent");
            asm volatile("s_waitcnt vmcnt(0)" ::: "memory");
            const unsigned og = xb_add(&bar[XB_TOP], 1u);
            const unsigned tg = og / nx;
            if (og + 1u == (tg + 1u) * nx) xb_add(&bar[XB_TOPGEN], 1u);
            else XB_SPIN(xb_ld(&bar[XB_TOPGEN]) == tg, bar);
            __builtin_amdgcn_fence(__ATOMIC_ACQUIRE, "agent");
            xb_add(&bar[XB_XGEN(b.x)], 1u);
            asm volatile("s_waitcnt vmcnt(0)" ::: "memory");
        } else {
            XB_SPIN(xb_ld(&bar[XB_XGEN(b.x)]) == gen, bar);
            __builtin_amdgcn_fence(__ATOMIC_ACQUIRE, "agent");
            asm volatile("s_waitcnt vmcnt(0)" ::: "memory");
        }
    }
    __syncthreads();
}

struct Frame {
    const float* const* in; float* out; unsigned char* ws; unsigned* ctl;
    unsigned char* lds;
    int tid, lane, wave, G, bid;
};
#define WSP(T, off) ((T*)(F.ws + (off)))
DI void refresh(Frame& F) { int t = threadIdx.x; asm volatile("" : "+v"(t)); F.tid = t; F.lane = t & 63; F.wave = __builtin_amdgcn_readfirstlane(t >> 6);
}

namespace pg8 {
constexpr int BM = 256, BK = 64, HALF = 128, HTB = HALF * BK * 2, STAGE_BYTES = 8 * HTB, NXCD = 8, WGM = 8;
DI int lds_byte(int r, int c) { const int st = (r >> 4) * 2 + (c >> 5), rr = r & 15, cc = c & 31, ob = rr * 64 + cc * 2; return st * 1024 + (ob ^ (((ob >> 9) & 1) << 5)); }
DI void stage_rc(int b, int& R, int& C) { const int st = b / 1024, sb = b % 1024, swz = sb ^ (((sb >> 9) & 1) << 5); R = (st >> 1) * 16 + swz / 64; C = (st & 1) * 32 + (swz % 64) / 2; }
struct Unit { int pm, pn, e; };
struct Gemm { const bf16_t* A; const bf16_t* Bt; int K; size_t bstride; };
struct StaticOrder {
    int nM, nN, nwg, G, c;
    DI void init(int M, int N, int G_, int c_) { nM = M / BM; nN = N / BM; nwg = nM * nN; G = G_; c = c_; }
    DI bool next(int i, Unit& u) const {
        const long L = (long)i * G + c; if (L >= nwg) return false;
        int wgid = (int)L; { const int q = nwg / NXCD, r = nwg % NXCD, xcd = wgid % NXCD, off = wgid / NXCD; wgid = (xcd < r ? xcd * (q + 1) : r * (q + 1) + (xcd - r) * q) + off; }
        const int nig = WGM * nN, gid = wgid / nig, fm = gid * WGM, gsz = (nM - fm) < WGM ? (nM - fm) : WGM;
        u.pm = fm + ((wgid % nig) % gsz); u.pn = (wgid % nig) / gsz; u.e = 0; return true;
    }
};
struct MoeOrder {
    const int* toff; int ntile, nN, G, c;
    DI bool next(int i, Unit& u) const {
        const long L = (long)i * G + c; if (L >= (long)ntile * nN) return false;
        const int t = (int)(L / nN); u.pm = t; u.pn = (int)(L % nN);
        u.e = toff[t]; return true;
    }
};

template <class Epi, class Sched>
DI void gemm_phase(LAS unsigned char* lds, const Gemm g, const Sched& S, const Epi& E, int tid) {
    const int wid = __builtin_amdgcn_readfirstlane(tid >> 6), lane = tid & 63, wr = wid >> 2, wc = wid & 3, fr = lane & 15, fq = lane >> 4;
    const int K = g.K, nt = K / BK;
    unsigned voffA[2];
#pragma unroll
    for (int i = 0; i < 2; ++i) { int R, C; stage_rc(tid * 16 + i * 8192, R, C); voffA[i] = (unsigned)(R * K + C) * 2u; }
    const size_t kstep = (size_t)(BK * 2);
    const size_t hstep = (size_t)HALF * K * 2;
    const size_t tstep = 2 * hstep;
    const unsigned ldsw = (unsigned)wid * 1024u;
    const int aoff = lds_byte(wr * 64 + fr, fq * 8), boff = lds_byte(wc * 32 + fr, fq * 8);
#define PG8_SA(b, h) (((b) * 2 + (h)) * HTB)
#define PG8_SB(b, h) ((4 + (b) * 2 + (h)) * HTB)
#define PG8_STAGE(bufoff, gbase, voff) do { _Pragma("unroll") for (int _i = 0; _i < 2; ++_i) \
        __builtin_amdgcn_global_load_lds((const unsigned*)((const char*)(gbase) + (voff)[_i]), (LAS unsigned*)(lds + (bufoff) + ldsw + _i * 8192), 16, 0, 0); } while (0)
#define PG8_LDA(dst, b, h) do { _Pragma("unroll") for (int m = 0; m < 4; ++m) _Pragma("unroll") for (int k = 0; k < 2; ++k) dst[m][k] = *(const LAS bf16x8*)(lds + PG8_SA(b, h) + aoff + m * 2048 + k * 1024); } while (0)
#define PG8_LDB(dst, b, h) do { _Pragma("unroll") for (int n = 0; n < 2; ++n) _Pragma("unroll") for (int k = 0; k < 2; ++k) dst[n][k] = *(const LAS bf16x8*)(lds + PG8_SB(b, h) + boff + n * 2048 + k * 1024); } while (0)
#define PG8_MMA(ai, bj, At, Bt) do { __builtin_amdgcn_s_setprio(1); _Pragma("unroll") for (int m = 0; m < 4; ++m) _Pragma("unroll") for (int n = 0; n < 2; ++n) _Pragma("unroll") for (int k = 0; k < 2; ++k) \
        acc[ai][bj][m][n] = __builtin_amdgcn_mfma_f32_16x16x32_bf16(Bt[n][k], At[m][k], acc[ai][bj][m][n], 0, 0, 0); __builtin_amdgcn_s_setprio(0); } while (0)
#define PG8_WAIT_V(n) asm volatile("s_waitcnt vmcnt(" #n ")" ::: "memory")
#define PG8_WAIT_L(n) asm volatile("s_waitcnt lgkmcnt(" #n ")" ::: "memory")
#define PG8_BAR __builtin_amdgcn_s_barrier()
#define PG8_SCHED __builtin_amdgcn_sched_barrier(0)
    Unit cur, nxt; int ui = 0;
    if (!S.next(0, cur)) return;
    f32x4 acc[2][2][4][2];
#pragma unroll
    for (int a = 0; a < 2; ++a)
#pragma unroll
        for (int b = 0; b < 2; ++b)
#pragma unroll
            for (int m = 0; m < 4; ++m)
#pragma unroll
                for (int n = 0; n < 2; ++n) acc[a][b][m][n] = (f32x4){0.f, 0.f, 0.f, 0.f};
    bf16x8 At[4][2], B0[2][2], B1[2][2];
    const char* cA = (const char*)g.A + (size_t)cur.pm * tstep; const char* cB = (const char*)(g.Bt + (size_t)cur.e * g.bstride) + (size_t)cur.pn * tstep;
    PG8_STAGE(PG8_SB(0, 0), cB, voffA); PG8_STAGE(PG8_SA(0, 0), cA, voffA); PG8_STAGE(PG8_SB(0, 1), cB + hstep, voffA); PG8_STAGE(PG8_SA(0, 1), cA + hstep, voffA);
    if (wr == 1) PG8_BAR;
    PG8_WAIT_V(4); PG8_BAR;
    PG8_STAGE(PG8_SB(1, 0), cB + kstep, voffA); PG8_STAGE(PG8_SA(1, 0), cA + kstep, voffA); PG8_STAGE(PG8_SB(1, 1), cB + hstep + kstep, voffA);
    PG8_WAIT_V(6); PG8_BAR;
    for (;;) {
        const bool has_next = S.next(ui + 1, nxt);
        const char* nA = has_next ? (const char*)g.A + (size_t)nxt.pm * tstep : cA; const char* nB = has_next ? (const char*)(g.Bt + (size_t)nxt.e * g.bstride) + (size_t)nxt.pn * tstep : cB;
        for (int t = 0; t < nt; t += 2) {
            const bool last = (t == nt - 2);
            const char* a1 = cA + (size_t)(t + 1) * kstep;
            const char* a2 = last ? nA : cA + (size_t)(t + 2) * kstep; const char* b2 = last ? nB : cB + (size_t)(t + 2) * kstep;
            const char* a3 = a2 + kstep; const char* b3 = b2 + kstep;
            PG8_LDB(B0, 0, 0); PG8_SCHED; PG8_LDA(At, 0, 0); PG8_STAGE(PG8_SA(1, 1), a1 + hstep, voffA);
            PG8_WAIT_L(8); PG8_BAR; PG8_WAIT_L(0); PG8_MMA(0, 0, At, B0); PG8_BAR; PG8_SCHED;
            PG8_LDB(B1, 0, 1); PG8_STAGE(PG8_SB(0, 0), b2, voffA);
            PG8_BAR; PG8_WAIT_L(0); PG8_MMA(0, 1, At, B1); PG8_BAR;
            PG8_LDA(At, 0, 1); PG8_STAGE(PG8_SA(0, 0), a2, voffA);
            PG8_BAR; PG8_WAIT_L(0); PG8_MMA(1, 0, At, B0); PG8_BAR; PG8_SCHED;
            PG8_STAGE(PG8_SB(0, 1), b2 + hstep, voffA);
            PG8_WAIT_V(6); PG8_BAR; PG8_MMA(1, 1, At, B1); PG8_BAR;
            PG8_LDB(B0, 1, 0); PG8_SCHED; PG8_LDA(At, 1, 0); PG8_STAGE(PG8_SA(0, 1), a2 + hstep, voffA);
            PG8_WAIT_L(8); PG8_BAR; PG8_WAIT_L(0); PG8_MMA(0, 0, At, B0); PG8_BAR; PG8_SCHED;
            PG8_LDB(B1, 1, 1); PG8_STAGE(PG8_SB(1, 0), b3, voffA);
            PG8_BAR; PG8_WAIT_L(0); PG8_MMA(0, 1, At, B1); PG8_BAR;
            PG8_LDA(At, 1, 1); PG8_STAGE(PG8_SA(1, 0), a3, voffA);
            PG8_BAR; PG8_WAIT_L(0); PG8_MMA(1, 0, At, B0); PG8_BAR; PG8_SCHED;
            PG8_STAGE(PG8_SB(1, 1), b3 + hstep, voffA);
            PG8_WAIT_V(6); PG8_BAR; PG8_MMA(1, 1, At, B1); PG8_BAR;
        }
        E(acc, cur, wr, wc, fr, fq);
        if (!has_next) break;
#pragma unroll
        for (int a = 0; a < 2; ++a)
#pragma unroll
            for (int b = 0; b < 2; ++b)
#pragma unroll
                for (int m = 0; m < 4; ++m)
#pragma unroll
                    for (int n = 0; n < 2; ++n) acc[a][b][m][n] = (f32x4){0.f, 0.f, 0.f, 0.f};
        cur = nxt; cA = nA; cB = nB; ++ui;
    }
    PG8_WAIT_V(0);
    if (wr == 0) PG8_BAR;
    PG8_BAR;
#undef PG8_SA
#undef PG8_SB
#undef PG8_STAGE
#undef PG8_LDA
#undef PG8_LDB
#undef PG8_MMA
#undef PG8_WAIT_V
#undef PG8_WAIT_L
#undef PG8_BAR
#undef PG8_SCHED
}
}

typedef f32x4 AccT[2][2][4][2];

struct EpiIn {
    unsigned char* ws; const float* rope; unsigned* kmax; unsigned* kmaxb;
    DI void operator()(const AccT& acc, const pg8::Unit& u, int wr, int wc, int fr, int fq) const {
        const int pn = u.pn, row0 = u.pm * 256 + wr * 64 + fr;
        const bool isctx = (u.pm >= NLAT / 256);
        if (pn <= 1) {
            bf16_t* dst = (bf16_t*)(ws + (pn == 0 ? WS_AQ : WS_AK));
            const float sc = (pn == 0) ? QSCALE_A : 1.f;
            float nmax[2] = {0.f, 0.f};
#pragma unroll
            for (int ai = 0; ai < 2; ++ai)
#pragma unroll
                for (int m = 0; m < 4; ++m) {
                    const int r = row0 + ai * 128 + m * 16;
                    f32x4 cs0 = (f32x4){1.f, 0.f, 1.f, 0.f}, cs1 = cs0;
                    if (!isctx) { const int t = r & (S - 1); const int pos = (fq < 2) ? (t >> 6) : (t & 63);
                        const f32x4* tp = (const f32x4*)(rope + (size_t)pos * 16 + (fq & 1) * 8); cs0 = tp[0]; cs1 = tp[1]; }
                    const float cc[4] = {cs0[0], cs0[2], cs1[0], cs1[2]}, ss[4] = {cs0[1], cs0[3], cs1[1], cs1[3]};
#pragma unroll
                    for (int bj = 0; bj < 2; ++bj) {
                        const f32x4 x1 = acc[ai][bj][m][0], x2 = acc[ai][bj][m][1];
                        float o1[4], o2[4], n2 = 0.f;
#pragma unroll
                        for (int j = 0; j < 4; ++j) { o1[j] = (x1[j] * cc[j] - x2[j] * ss[j]) * sc; o2[j] = (x2[j] * cc[j] + x1[j] * ss[j]) * sc; n2 += x1[j] * x1[j] + x2[j] * x2[j]; }
                        bf16_t* p = dst + (size_t)r * 256 + bj * 128 + wc * 32 + 4 * fq;
                        *(u32x2*)p = (u32x2){pk2(o1[0], o1[1]), pk2(o1[2], o1[3])};
                        *(u32x2*)(p + 16) = (u32x2){pk2(o2[0], o2[1]), pk2(o2[2], o2[3])};
                        if (pn == 1) { n2 += swz_xor<16>(n2); n2 = half_sum(n2); nmax[bj] = fmaxf(nmax[bj], n2); }
                    }
                }
            if (pn == 1) {
                const int b = isctx ? (u.pm - NLAT / 256) : (u.pm / (S / 256));
#pragma unroll
                for (int bj = 0; bj < 2; ++bj) {
                    float v = nmax[bj];
                    v = fmaxf(v, swz_xor<1>(v)); v = fmaxf(v, swz_xor<2>(v)); v = fmaxf(v, swz_xor<4>(v)); v = fmaxf(v, swz_xor<8>(v));
                    if ((fr | fq) == 0) atomicMax(kmax + (b * 4 + (2 * bj + (wc >> 1))) * 2 + (wc & 1), __float_as_uint(v));
                }
            }
        } else if (pn == 2 || pn == 5) {
            bf16_t* dst = (bf16_t*)(ws + (pn == 2 ? WS_AVT : WS_BVT));
#pragma unroll
            for (int ai = 0; ai < 2; ++ai)
#pragma unroll
                for (int m = 0; m < 4; ++m) {
                    const int r = row0 + ai * 128 + m * 16;
                    int b, key; if (isctx) { b = (r - NLAT) >> 8; key = (r - NLAT) & 255; } else { b = r >> 14; key = CTX + (r & (S - 1)); }
#pragma unroll
                    for (int bj = 0; bj < 2; ++bj)
#pragma unroll
                        for (int n = 0; n < 2; ++n) {
                            const int lc = bj * 128 + wc * 32 + n * 16 + 4 * fq;
#pragma unroll
                            for (int j = 0; j < 4; ++j) dst[((size_t)(b * 256 + lc + j)) * NKEY + key] = f2bf(acc[ai][bj][m][n][j]);
                        }
                }
        } else if (pn <= 6) {
            bf16_t* dst = (bf16_t*)(ws + (pn == 3 ? WS_BQ : pn == 4 ? WS_BK : WS_PL));
            const float sc = (pn == 3) ? QSCALE_B : 1.f;
            float nmax[2] = {0.f, 0.f};
#pragma unroll
            for (int ai = 0; ai < 2; ++ai)
#pragma unroll
                for (int m = 0; m < 4; ++m) {
                    const int r = row0 + ai * 128 + m * 16;
#pragma unroll
                    for (int bj = 0; bj < 2; ++bj)
#pragma unroll
                        for (int n = 0; n < 2; ++n) {
                            const f32x4 v = acc[ai][bj][m][n] * sc;
                            *(u32x2*)(dst + (size_t)r * 256 + bj * 128 + wc * 32 + n * 16 + 4 * fq) = (u32x2){pk2(v[0], v[1]), pk2(v[2], v[3])};
                        }
                    if (pn == 4) {
#pragma unroll
                        for (int bj = 0; bj < 2; ++bj) { const f32x4 x1 = acc[ai][bj][m][0], x2 = acc[ai][bj][m][1];
                            float n2 = x1[0] * x1[0] + x1[1] * x1[1] + x1[2] * x1[2] + x1[3] * x1[3] + x2[0] * x2[0] + x2[1] * x2[1] + x2[2] * x2[2] + x2[3] * x2[3];
                            n2 += swz_xor<16>(n2); n2 = half_sum(n2); nmax[bj] = fmaxf(nmax[bj], n2); }
                    }
                }
            if (pn == 4) {
                const int b = isctx ? (u.pm - NLAT / 256) : (u.pm / (S / 256));
#pragma unroll
                for (int bj = 0; bj < 2; ++bj) {
                    float v = nmax[bj];
                    v = fmaxf(v, swz_xor<1>(v)); v = fmaxf(v, swz_xor<2>(v)); v = fmaxf(v, swz_xor<4>(v)); v = fmaxf(v, swz_xor<8>(v));
                    if ((fr | fq) == 0) atomicMax(kmaxb + (b * 4 + (2 * bj + (wc >> 1))) * 2 + (wc & 1), __float_as_uint(v));
                }
            }
        } else {
            const int hc0 = (pn - 7) * 256;
#pragma unroll
            for (int ai = 0; ai < 2; ++ai)
#pragma unroll
                for (int m = 0; m < 4; ++m) {
                    const int r = row0 + ai * 128 + m * 16;
#pragma unroll
                    for (int bj = 0; bj < 2; ++bj)
#pragma unroll
                        for (int n = 0; n < 2; ++n) {
                            const int hc = hc0 + bj * 128 + wc * 32 + n * 16 + 4 * fq; const f32x4 v = acc[ai][bj][m][n];
                            if (isctx) *(u32x2*)((bf16_t*)(ws + WS_HYC) + (size_t)(r - NLAT) * 768 + hc) = (u32x2){pk2(v[0], v[1]), pk2(v[2], v[3])};
                            else { bf16_t* dst = (bf16_t*)(ws + WS_HYT) + ((size_t)(r >> 14) * 768 + hc) * S + (r & (S - 1));
#pragma unroll
                                for (int j = 0; j < 4; ++j) dst[(size_t)j * S] = f2bf(v[j]); }
                        }
                }
        }
    }
};

struct EpiOut {
    const float* xl_old; const float* xc_old; float* xl_new; float* xc_new; const float* mod;
    DI void operator()(const AccT& acc, const pg8::Unit& u, int wr, int wc, int fr, int fq) const {
        const int row0 = u.pm * 256 + wr * 64 + fr; const bool isctx = (u.pm >= NLAT / 256);
        const int v = isctx ? 2 : (u.pm / (S / 256));
        const float* g1 = mod + (size_t)v * 6144 + 2 * 1024;
        const float* so = isctx ? xc_old - (size_t)NLAT * D : xl_old; float* dn = isctx ? xc_new - (size_t)NLAT * D : xl_new;
#pragma unroll
        for (int bj = 0; bj < 2; ++bj)
#pragma unroll
            for (int n = 0; n < 2; ++n) {
                const int c = u.pn * 256 + bj * 128 + wc * 32 + n * 16 + 4 * fq;
                const f32x4 g = *(const f32x4*)(g1 + c);
#pragma unroll
                for (int ai = 0; ai < 2; ++ai)
#pragma unroll
                    for (int m = 0; m < 4; ++m) {
                        const size_t o = (size_t)(row0 + ai * 128 + m * 16) * D + c;
                        *(f32x4*)(dn + o) = *(const f32x4*)(so + o) + g * acc[ai][bj][m][n];
                    }
            }
    }
};

struct EpiMoe1 {
    bf16_t* hmid;
    DI void operator()(const AccT& acc, const pg8::Unit& u, int wr, int wc, int fr, int fq) const {
        const int row0 = u.pm * 256 + wr * 64 + fr;
#pragma unroll
        for (int ai = 0; ai < 2; ++ai)
#pragma unroll
            for (int m = 0; m < 4; ++m)
#pragma unroll
                for (int bj = 0; bj < 2; ++bj) {
                    const f32x4 a = acc[ai][bj][m][0], b = acc[ai][bj][m][1]; float h[4];
#pragma unroll
                    for (int j = 0; j < 4; ++j) h[j] = siluf(a[j]) * b[j];
                    *(u32x2*)(hmid + (size_t)(row0 + ai * 128 + m * 16) * DE + (u.pn * 256 + bj * 128 + wc * 32) / 2 + 4 * fq) = (u32x2){pk2(h[0], h[1]), pk2(h[2], h[3])};
                }
    }
};
struct EpiMoe2 {
    bf16_t* ys;
    DI void operator()(const AccT& acc, const pg8::Unit& u, int wr, int wc, int fr, int fq) const {
        const int row0 = u.pm * 256 + wr * 64 + fr;
#pragma unroll
        for (int ai = 0; ai < 2; ++ai)
#pragma unroll
            for (int m = 0; m < 4; ++m)
#pragma unroll
                for (int bj = 0; bj < 2; ++bj)
#pragma unroll
                    for (int n = 0; n < 2; ++n) { const f32x4 v = acc[ai][bj][m][n];
                        *(u32x2*)(ys + (size_t)(row0 + ai * 128 + m * 16) * D + u.pn * 256 + bj * 128 + wc * 32 + n * 16 + 4 * fq) = (u32x2){pk2(v[0], v[1]), pk2(v[2], v[3])}; }
    }
};

DI void tconv_tile(const Frame& F, const float* src, int N, int k0, int n0, bf16_t* dst, int ldd, int mode) {
    float* tl = (float*)F.lds;
    __syncthreads();
#pragma unroll
    for (int i = 0; i < 8; ++i) { const int idx = F.tid + 512 * i, k = idx >> 6, n = idx & 63; tl[k * 65 + n] = src[(size_t)(k0 + k) * N + n0 + n]; }
    __syncthreads();
#pragma unroll
    for (int i = 0; i < 4; ++i) { const int idx = F.tid + 512 * i, n = idx >> 5, kp = idx & 31;
        const int nn = n0 + n; const int row = (mode == 0) ? nn : ((nn >> 4) * 32 + (mode - 1) * 16 + (nn & 15));
        *(unsigned*)(dst + (size_t)row * ldd + k0 + 2 * kp) = pk2(tl[(2 * kp) * 65 + n], tl[(2 * kp + 1) * 65 + n]); }
}
DI void phase_prologue(const Frame& F) {
    const int T_IN = 16 * 40, T_OUT = 16 * 16, T_E = 16 * 8;
    const int per_layer = T_IN + T_OUT + NE * 3 * T_E, total = 2 * per_layer;
    for (int u = F.bid; u < total; u += F.G) {
        const int li = u / per_layer; int r = u % per_layer;
        if (r < T_IN) { tconv_tile(F, F.in[I_WIN] + (size_t)li * D * DIN, DIN, (r / 40) * 64, (r % 40) * 64, WSP(bf16_t, WS_WIN) + (size_t)li * DIN * D, D, 0); continue; }
        r -= T_IN;
        if (r < T_OUT) { tconv_tile(F, F.in[I_WOUT] + (size_t)li * D * D, D, (r / 16) * 64, (r % 16) * 64, WSP(bf16_t, WS_WOUT) + (size_t)li * D * D, D, 0); continue; }
        r -= T_OUT;
        const int e = r / (3 * T_E), w = (r / T_E) % 3, t = r % T_E;
        if (w < 2) tconv_tile(F, F.in[w == 0 ? I_MW1 : I_MW3] + ((size_t)li * NE + e) * D * DE, DE, (t / 8) * 64, (t % 8) * 64, WSP(bf16_t, WS_W13) + ((size_t)li * NE + e) * 1024 * 1024, D, 1 + w);
        else tconv_tile(F, F.in[I_MW2] + ((size_t)li * NE + e) * DE * D, D, (t / 16) * 64, (t % 16) * 64, WSP(bf16_t, WS_W2) + ((size_t)li * NE + e) * 1024 * 512, DE, 0);
    }
    __syncthreads();
    {
        float* sc = (float*)F.lds;
        float* red = sc + 3072;
        for (int i = F.tid; i < 3072; i += NTHR) { const int v = i >> 10, k = i & 1023; const float x = (v < 2) ? F.in[I_C][v * 1024 + k] : F.in[I_CCTX][k]; sc[i] = siluf(x); }
        __syncthreads();
        for (int u = F.bid; u < 2 * 96; u += F.G) {
            const int li = u / 96, j = (u % 96) * 64 + F.lane, ko = F.wave;
            const float* w = F.in[I_ADAW] + (size_t)li * D * 6144 + j;
            float a0 = 0.f, a1 = 0.f, a2 = 0.f;
            for (int k = ko * 128; k < ko * 128 + 128; ++k) { const float wv = w[(size_t)k * 6144]; a0 += sc[k] * wv; a1 += sc[1024 + k] * wv; a2 += sc[2048 + k] * wv; }
            red[(ko * 3 + 0) * 64 + F.lane] = a0; red[(ko * 3 + 1) * 64 + F.lane] = a1; red[(ko * 3 + 2) * 64 + F.lane] = a2;
            __syncthreads();
            if (F.tid < 192) { const int v = F.tid / 64, l = F.tid % 64; float s = 0.f;
#pragma unroll
                for (int q = 0; q < 8; ++q) s += red[(q * 3 + v) * 64 + l];
                const int jj = (u % 96) * 64 + l;
                WSP(float, WS_MOD)[((size_t)li * 3 + v) * 6144 + jj] = s + F.in[I_ADAB][li * 6144 + jj]; }
            __syncthreads();
        }
    }
    if (F.bid == (F.G > 2 ? 2 : 0)) {
        for (int idx = F.tid; idx < 2 * 4 * 64 * 64; idx += NTHR) { const int i = idx & 63, j = (idx >> 6) & 63, lg = idx >> 12;
            WSP(bf16_t, WS_PWT)[idx] = f2bf(F.in[I_POOLW][((size_t)lg * 64 + i) * 64 + j]); }
    }
    if (F.bid == (F.G > 1 ? 1 : 0)) {
        for (int i = F.tid; i < 256 * 8; i += NTHR) { const int pos = i >> 3, f = i & 7; const float inv = exp2f(-(float)f * (13.287712379549449f / 8.f)); const float rev = (float)pos * inv * 0.15915494309189535f;
            WSP(float, WS_ROPE)[i * 2] = cos_rev(rev); WSP(float, WS_ROPE)[i * 2 + 1] = sin_rev(rev); }
    }
}

#define MFMA32(a, b, c) __builtin_amdgcn_mfma_f32_32x32x16_bf16((a), (b), (c), 0, 0, 0)
DI void filter_tile(const Frame& F, int li, int L, int tile, float* hT, float* part) {
    float* h1s = (float*)F.lds;
    float* h2s = h1s + 64 * 65;
    float* w1s = h2s + 64 * 68;
    float* w2s = w1s + 34 * 64;
    const float* w3 = F.in[I_HW3] + (size_t)li * 64 * 1024; const float* b3 = F.in[I_HB3] + li * 1024;
    const int t0 = tile * 64;
    const float inv_lm1 = 1.f / (float)(L > 1 ? L - 1 : 1);
    __syncthreads();
    {
        const float* w1 = F.in[I_HW1] + (size_t)li * 33 * 64; const float* b1 = F.in[I_HB1] + li * 64;
        const float* w2 = F.in[I_HW2] + (size_t)li * 64 * 64; const float* b2 = F.in[I_HB2] + li * 64;
        for (int i = F.tid; i < 33 * 64; i += NTHR) w1s[i] = w1[i];
        for (int i = F.tid; i < 4096; i += NTHR) w2s[i] = w2[i];
        if (F.tid < 64) { w1s[33 * 64 + F.tid] = b1[F.tid]; w2s[4096 + F.tid] = b2[F.tid]; }
    }
    __syncthreads();
    {
        const int tl = F.tid & 63, pt = F.tid >> 6; const float t = (float)(t0 + tl);
        float a[8];
#pragma unroll
        for (int jj = 0; jj < 8; ++jj) a[jj] = w1s[33 * 64 + pt * 8 + jj] + (t * inv_lm1) * w1s[pt * 8 + jj];
#pragma unroll 2
        for (int i = 0; i < 16; ++i) { const float band = 1e-4f + (15.f - 1e-4f) * (float)i / 15.f; const float rev = t * band / (float)L; const float cz = cos_rev(rev), sz = sin_rev(rev);
#pragma unroll
            for (int jj = 0; jj < 8; ++jj) a[jj] += cz * w1s[(1 + i) * 64 + pt * 8 + jj] + sz * w1s[(17 + i) * 64 + pt * 8 + jj]; }
#pragma unroll
        for (int jj = 0; jj < 8; ++jj) h1s[tl * 65 + pt * 8 + jj] = sin_rad(a[jj]);
    }
    __syncthreads();
    {
        const int tl = F.tid & 63, pt = F.tid >> 6;
        float a[8];
#pragma unroll
        for (int jj = 0; jj < 8; ++jj) a[jj] = w2s[4096 + pt * 8 + jj];
#pragma unroll 4
        for (int i = 0; i < 64; ++i) { const float hv = h1s[tl * 65 + i];
#pragma unroll
            for (int jj = 0; jj < 8; ++jj) a[jj] += hv * w2s[i * 64 + pt * 8 + jj]; }
#pragma unroll
        for (int jj = 0; jj < 8; ++jj) h2s[tl * 68 + pt * 8 + jj] = sin_rad(a[jj]);
    }
    __syncthreads();
    {
        const int l31 = F.lane & 31, kg = F.lane >> 5;
        auto split8 = [](const float (&x)[8], bf16x8& hi, bf16x8& lo) {
            u32x4 h, l;
#pragma unroll
            for (int e = 0; e < 4; ++e) { const unsigned hp = pk2(x[2 * e], x[2 * e + 1]); h[e] = hp;
                l[e] = pk2(x[2 * e] - __uint_as_float(hp << 16), x[2 * e + 1] - __uint_as_float(hp & 0xffff0000u)); }
            hi = __builtin_bit_cast(bf16x8, h); lo = __builtin_bit_cast(bf16x8, l); };
        bf16x8 Bh[2][4], Bl[2][4];
#pragma unroll
        for (int pb = 0; pb < 2; ++pb)
#pragma unroll
            for (int ks = 0; ks < 4; ++ks) { const float* hp = h2s + (pb * 32 + l31) * 68 + ks * 16 + kg * 8; const f32x4 x0 = *(const f32x4*)hp, x1 = *(const f32x4*)(hp + 4);
                const float x[8] = {x0[0], x0[1], x0[2], x0[3], x1[0], x1[1], x1[2], x1[3]}; split8(x, Bh[pb][ks], Bl[pb][ks]); }
        const float tn0 = (float)(t0 + l31) * inv_lm1, tn1 = (float)(t0 + 32 + l31) * inv_lm1;
        const bool b4 = (l31 & 16) != 0, b3q = (l31 & 8) != 0, b2 = (l31 & 4) != 0, b1q = (l31 & 2) != 0;
#pragma unroll 1
        for (int cb = 0; cb < 4; ++cb) {
            const int ch0 = F.wave * 128 + cb * 32;
            f32x16 acc0, acc1;
#pragma unroll
            for (int i = 0; i < 16; ++i) { acc0[i] = 0.f; acc1[i] = 0.f; }
#pragma unroll
            for (int ks = 0; ks < 4; ++ks) {
                float x[8];
#pragma unroll
                for (int e = 0; e < 8; ++e) x[e] = w3[(size_t)(ks * 16 + kg * 8 + e) * 1024 + ch0 + l31];
                bf16x8 Ah, Al; split8(x, Ah, Al);
                acc0 = MFMA32(Ah, Bh[0][ks], acc0); acc1 = MFMA32(Ah, Bh[1][ks], acc1);
                acc0 = MFMA32(Al, Bh[0][ks], acc0); acc1 = MFMA32(Al, Bh[1][ks], acc1);
                acc0 = MFMA32(Ah, Bl[0][ks], acc0); acc1 = MFMA32(Ah, Bl[1][ks], acc1);
            }
            float sq[16];
#pragma unroll
            for (int i = 0; i < 16; ++i) {
                const int ch = ch0 + 8 * (i >> 2) + 4 * kg + (i & 3);
                const float bb = b3[ch], delta = 3.0701134573253945f + (15.350567286626973f - 3.0701134573253945f) * (float)(ch & 255) / 255.f;
                const float v0 = (acc0[i] + bb) * __expf(-tn0 * delta), v1 = (acc1[i] + bb) * __expf(-tn1 * delta);
                float* hp = hT + (size_t)ch * L + t0 + l31; hp[0] = v0; hp[32] = v1;
                sq[i] = v0 * v0 + v1 * v1;
            }
            float a8[8], a4[4], a2[2];
#pragma unroll
            for (int e = 0; e < 8; ++e) { const float keep = b4 ? sq[e + 8] : sq[e], send = b4 ? sq[e] : sq[e + 8]; a8[e] = keep + swz_xor<16>(send); }
#pragma unroll
            for (int e = 0; e < 4; ++e) { const float keep = b3q ? a8[e + 4] : a8[e], send = b3q ? a8[e] : a8[e + 4]; a4[e] = keep + swz_xor<8>(send); }
#pragma unroll
            for (int e = 0; e < 2; ++e) { const float keep = b2 ? a4[e + 2] : a4[e], send = b2 ? a4[e] : a4[e + 2]; a2[e] = keep + swz_xor<4>(send); }
            float a1 = (b1q ? a2[1] : a2[0]) + swz_xor<2>(b1q ? a2[0] : a2[1]);
            a1 += swz_xor<1>(a1);
            const int rg = (b4 ? 8 : 0) + (b3q ? 4 : 0) + (b2 ? 2 : 0) + (b1q ? 1 : 0);
            if ((l31 & 1) == 0) part[(size_t)tile * 1024 + ch0 + 8 * (rg >> 2) + 4 * kg + (rg & 3)] = a1;
        }
    }
}

struct TokInfo { unsigned e0, e1, p0, p1; float g0, g1; unsigned s0, s1; };
DI void phase_norm1(const Frame& F, int li, int mode) {
    const int nrows = (mode == 2) ? NLAT : NTOK;
    const float* modp = WSP(float, WS_MOD) + (size_t)li * 3 * 6144;
    const float* modprev = WSP(float, WS_MOD) + (size_t)(mode == 2 ? 1 : li - 1) * 3 * 6144;
    const float* gam = (mode == 2) ? F.in[I_FG] : F.in[I_N1G] + (size_t)li * D;
    const TokInfo* tok = WSP(TokInfo, WS_TOK); const bf16_t* ys = WSP(bf16_t, WS_A1);
    bf16_t* hbf = WSP(bf16_t, WS_HBF);
    auto xrowp = [&](int r) -> float* { return r >= NLAT ? WSP(float, WS_XC) + (size_t)(r - NLAT) * D : F.out + (size_t)r * D; };
    auto srcp = [&](int r) -> const float* { return (mode == 0) ? (r >= NLAT ? F.in[I_CTX] + (size_t)(r - NLAT) * D : F.in[I_X] + (size_t)r * D) : (const float*)xrowp(r); };
    const int r0 = F.bid * 8 + F.wave, rstep = F.G * 8, lc = F.lane * 4;
    f32x4 xn[4]; u32x2 yan[4], ybn[4]; TokInfo t1 = {}, t2 = {};
    if (r0 < nrows) {
#pragma unroll
        for (int i = 0; i < 4; ++i) xn[i] = *(const f32x4*)(srcp(r0) + i * 256 + lc);
        if (mode != 0) { t1 = tok[r0]; if (r0 + rstep < nrows) t2 = tok[r0 + rstep];
#pragma unroll
            for (int i = 0; i < 4; ++i) { yan[i] = *(const u32x2*)(ys + (size_t)t1.s0 * D + i * 256 + lc); ybn[i] = *(const u32x2*)(ys + (size_t)t1.s1 * D + i * 256 + lc); } }
    }
    for (int r = r0; r < nrows; r += rstep) {
        const bool isctx = r >= NLAT; const int v = isctx ? 2 : (r >> 14);
        f32x4 x[4]; u32x2 ya[4], yb[4]; const TokInfo ti = t1;
#pragma unroll
        for (int i = 0; i < 4; ++i) { x[i] = xn[i]; ya[i] = yan[i]; yb[i] = ybn[i]; }
        if (r + rstep < nrows) {
#pragma unroll
            for (int i = 0; i < 4; ++i) xn[i] = *(const f32x4*)(srcp(r + rstep) + i * 256 + lc);
            if (mode != 0) { t1 = t2; if (r + 2 * rstep < nrows) t2 = tok[r + 2 * rstep];
#pragma unroll
                for (int i = 0; i < 4; ++i) { yan[i] = *(const u32x2*)(ys + (size_t)t1.s0 * D + i * 256 + lc); ybn[i] = *(const u32x2*)(ys + (size_t)t1.s1 * D + i * 256 + lc); } }
        }
        if (mode != 0) {
            const float* g2 = modprev + (size_t)v * 6144 + 5 * 1024;
#pragma unroll
            for (int i = 0; i < 4; ++i) {
                const u32x2 a = ya[i], b = yb[i];
                const f32x4 gg = *(const f32x4*)(g2 + i * 256 + lc);
                f32x4 y;
                y[0] = ti.g0 * __uint_as_float(a[0] << 16) + ti.g1 * __uint_as_float(b[0] << 16);
                y[1] = ti.g0 * __uint_as_float(a[0] & 0xffff0000u) + ti.g1 * __uint_as_float(b[0] & 0xffff0000u);
                y[2] = ti.g0 * __uint_as_float(a[1] << 16) + ti.g1 * __uint_as_float(b[1] << 16);
                y[3] = ti.g0 * __uint_as_float(a[1] & 0xffff0000u) + ti.g1 * __uint_as_float(b[1] & 0xffff0000u);
                x[i] = x[i] + gg * y;
            }
            if (mode == 1) { float* xrow = xrowp(r);
#pragma unroll
                for (int i = 0; i < 4; ++i) *(f32x4*)(xrow + i * 256 + lc) = x[i]; }
        }
        float ss = 0.f;
#pragma unroll
        for (int i = 0; i < 4; ++i) ss += x[i][0] * x[i][0] + x[i][1] * x[i][1] + x[i][2] * x[i][2] + x[i][3] * x[i][3];
        ss = wave_sum(ss);
        const float rstd = rsqrtf(ss * (1.f / D) + EPS);
#pragma unroll
        for (int i = 0; i < 4; ++i) {
            const int c = i * 256 + lc;
            const f32x4 g = *(const f32x4*)(gam + c);
            if (mode == 2) { *(f32x4*)(F.out + (size_t)r * D + c) = x[i] * rstd * g; }
            else {
                const f32x4 sh = *(const f32x4*)(modp + (size_t)v * 6144 + c), sc = *(const f32x4*)(modp + (size_t)v * 6144 + 1024 + c);
                const f32x4 h = x[i] * rstd * g * (sc + 1.f) + sh;
                *(u32x2*)(hbf + (size_t)r * D + c) = (u32x2){pk2(h[0], h[1]), pk2(h[2], h[3])};
            }
        }
    }
}

DI void phase_norm2(const Frame& F, int li, int nrows) {
    float* wt = (float*)F.lds;
    __syncthreads();
    for (int i = F.tid; i < 16384; i += NTHR) { const int k = i >> 4, e = i & 15; wt[e * 1024 + k] = F.in[I_RW][i]; }
    __syncthreads();
    const float* modp = WSP(float, WS_MOD) + (size_t)li * 3 * 6144;
    const float* gam = F.in[I_N2G] + (size_t)li * D;
    bf16_t* hbf = WSP(bf16_t, WS_HBF); TokInfo* tok = WSP(TokInfo, WS_TOK);
    unsigned* lcnt = (unsigned*)(F.lds + LDS_MISC + 64);
    if (F.tid < 16) lcnt[F.tid] = 0u;
    __syncthreads();
    auto rowp = [&](int r) -> const float* { return r >= NLAT ? WSP(float, WS_XC) + (size_t)(r - NLAT) * D : F.out + (size_t)r * D; };
    const int r_first = F.bid * 8 + F.wave, rstep = F.G * 8;
    f32x4 xn[4];
    if (r_first < nrows) {
#pragma unroll
        for (int i = 0; i < 4; ++i) xn[i] = *(const f32x4*)(rowp(r_first) + i * 256 + F.lane * 4);
    }
    const bool b2 = (F.lane & 4) != 0, b3 = (F.lane & 8) != 0, b4 = (F.lane & 16) != 0;
    for (int r = r_first; r < nrows; r += rstep) {
        const bool isctx = r >= NLAT; const int v = isctx ? 2 : (r >> 14);
        f32x4 x[4]; float ss = 0.f;
#pragma unroll
        for (int i = 0; i < 4; ++i) { x[i] = xn[i]; ss += x[i][0] * x[i][0] + x[i][1] * x[i][1] + x[i][2] * x[i][2] + x[i][3] * x[i][3]; }
        if (r + rstep < nrows) {
#pragma unroll
            for (int i = 0; i < 4; ++i) xn[i] = *(const f32x4*)(rowp(r + rstep) + i * 256 + F.lane * 4);
        }
        ss = wave_sum(ss);
        const float rstd = rsqrtf(ss * (1.f / D) + EPS);
        float lg[16];
#pragma unroll
        for (int e = 0; e < 16; ++e) lg[e] = 0.f;
#pragma unroll
        for (int i = 0; i < 4; ++i) {
            const int c = i * 256 + F.lane * 4;
            const f32x4 g = *(const f32x4*)(gam + c), sh = *(const f32x4*)(modp + (size_t)v * 6144 + 3 * 1024 + c), sc = *(const f32x4*)(modp + (size_t)v * 6144 + 4 * 1024 + c);
            const f32x4 h = x[i] * rstd * g * (sc + 1.f) + sh;
            *(u32x2*)(hbf + (size_t)r * D + c) = (u32x2){pk2(h[0], h[1]), pk2(h[2], h[3])};
#pragma unroll
            for (int e = 0; e < 16; ++e) { const f32x4 w = *(const f32x4*)(wt + e * 1024 + c); lg[e] += h[0] * w[0] + h[1] * w[1] + h[2] * w[2] + h[3] * w[3]; }
        }
        float a8[8], a4[4], a2[2];
#pragma unroll
        for (int e = 0; e < 8; ++e) { const auto rr = __builtin_amdgcn_permlane32_swap(__float_as_uint(lg[e]), __float_as_uint(lg[e + 8]), false, false); a8[e] = __uint_as_float(rr[0]) + __uint_as_float(rr[1]); }
#pragma unroll
        for (int e = 0; e < 4; ++e) { const float keep = b4 ? a8[e + 4] : a8[e], send = b4 ? a8[e] : a8[e + 4]; a4[e] = keep + swz_xor<16>(send); }
#pragma unroll
        for (int e = 0; e < 2; ++e) { const float keep = b3 ? a4[e + 2] : a4[e], send = b3 ? a4[e] : a4[e + 2]; a2[e] = keep + swz_xor<8>(send); }
        float a1 = (b2 ? a2[1] : a2[0]) + swz_xor<4>(b2 ? a2[0] : a2[1]);
        a1 += swz_xor<2>(a1); a1 += swz_xor<1>(a1);
#pragma unroll
        for (int e = 0; e < 16; ++e) lg[e] = __int_as_float(__builtin_amdgcn_readlane(__float_as_int(a1), 4 * e));
        float mx = lg[0];
#pragma unroll
        for (int e = 1; e < 16; ++e) mx = fmaxf(mx, lg[e]);
        float sc[16], sel[16], den = 0.f;
#pragma unroll
        for (int e = 0; e < 16; ++e) { sc[e] = __expf(lg[e] - mx); den += sc[e]; }
        const float rden = 1.f / den;
#pragma unroll
        for (int e = 0; e < 16; ++e) { sc[e] *= rden; sel[e] = sc[e] + F.in[I_RB][e]; }
        int bg = 0; float bgs = -1e30f;
#pragma unroll
        for (int g = 0; g < 4; ++g) {
            float m1 = -1e30f, m2 = -1e30f;
#pragma unroll
            for (int q = 0; q < 4; ++q) { const float s = sel[g * 4 + q]; if (s > m1) { m2 = m1; m1 = s; } else if (s > m2) m2 = s; }
            const float gs = m1 + m2; if (gs > bgs) { bgs = gs; bg = g; }
        }
        int e0 = 0, e1 = 0; float s0v = -1e30f, s1v = -1e30f, w0 = 0.f, w1 = 0.f;
#pragma unroll
        for (int e = 0; e < 16; ++e) {
            const bool ing = (e >> 2) == bg; const float s = sel[e];
            if (ing && s > s0v) { s1v = s0v; e1 = e0; w1 = w0; s0v = s; e0 = e; w0 = sc[e]; }
            else if (ing && s > s1v) { s1v = s; e1 = e; w1 = sc[e]; }
        }
        if (F.lane == 0) {
            TokInfo ti; ti.e0 = e0; ti.e1 = e1; ti.p0 = atomicAdd(lcnt + e0, 1u); ti.p1 = atomicAdd(lcnt + e1, 1u);
            const float ws = 1.f / (w0 + w1); ti.g0 = w0 * ws; ti.g1 = w1 * ws; ti.s0 = 0; ti.s1 = 0;
            tok[r] = ti;
        }
    }
    __syncthreads();
    if (F.tid < 16) F.ctl[CW_BCNT + (li * MAXG + F.bid) * 16 + F.tid] = lcnt[F.tid];
}

DI void moe_offsets(const Frame& F, int li, int* offs) {
    __syncthreads();
    int* tot = offs + 376;
    int* part = (int*)F.lds;
    {
        const int e = F.tid & 15, pq = F.tid >> 4;
        const unsigned* bc = F.ctl + CW_BCNT + li * MAXG * 16 + e;
        int st = 0, sb = 0;
#pragma unroll
        for (int k = 0; k < 8; ++k) { const int blk = pq * 8 + k; const int c = (blk < F.G) ? (int)__hip_atomic_load(bc + blk * 16, __ATOMIC_RELAXED, __HIP_MEMORY_SCOPE_AGENT) : 0; st += c; sb += (blk < F.bid) ? c : 0; }
        part[pq * 16 + e] = st; part[512 + pq * 16 + e] = sb;
    }
    __syncthreads();
    if (F.tid < 32) { const int e = F.tid & 15, wb = F.tid >> 4; int s = 0;
        for (int pq = 0; pq < 32; ++pq) s += part[wb * 512 + pq * 16 + e];
        if (wb) offs[360 + e] = s; else tot[e] = s; }
    __syncthreads();
    if (F.tid == 0) { int o = 0; for (int e = 0; e < NE; ++e) { offs[e] = o; offs[17 + e] = o >> 8; o += (tot[e] + 255) & ~255; }
        offs[16] = o; offs[17 + 16] = o >> 8; }
    __syncthreads();
    for (int t = F.tid; t < SLOT_CAP / 256; t += NTHR) { int e = 0; for (int k = 1; k < NE; ++k) e += (offs[17 + k] <= t) ? 1 : 0; offs[40 + t] = e; }
    if (F.tid < 16) offs[360 + F.tid] += offs[F.tid];
    __syncthreads();
}
DI void phase_gather(const Frame& F, int li, int nrows) {
    int* offs = (int*)(F.lds + LDS_MISC + 64);
    moe_offsets(F, li, offs);
    const bf16_t* hbf = WSP(bf16_t, WS_HBF); bf16_t* a1 = WSP(bf16_t, WS_A1); TokInfo* tok = WSP(TokInfo, WS_TOK);
    for (int r = F.bid * 8 + F.wave; r < nrows; r += F.G * 8) {
        TokInfo ti = tok[r];
        const unsigned s0 = offs[360 + ti.e0] + ti.p0, s1 = offs[360 + ti.e1] + ti.p1;
        const u32x4 a = *(const u32x4*)(hbf + (size_t)r * D + F.lane * 8), b = *(const u32x4*)(hbf + (size_t)r * D + 512 + F.lane * 8);
        *(u32x4*)(a1 + (size_t)s0 * D + F.lane * 8) = a; *(u32x4*)(a1 + (size_t)s0 * D + 512 + F.lane * 8) = b;
        *(u32x4*)(a1 + (size_t)s1 * D + F.lane * 8) = a; *(u32x4*)(a1 + (size_t)s1 * D + 512 + F.lane * 8) = b;
        if (F.lane == 0) { tok[r].s0 = s0; tok[r].s1 = s1; }
    }
}

DI float lam_of(const Frame& F, int li, float& lam_init) {
    const float* lv = F.in[I_ALAM] + (size_t)li * 128;
    const int i = F.lane & 31, hi = F.lane >> 5;
    float d = lv[hi * 64 + i] * lv[hi * 64 + 32 + i];
    d += swz_xor<16>(d); d += swz_xor<8>(d); d += swz_xor<4>(d); d += swz_xor<2>(d); d += swz_xor<1>(d);
    const float d0 = __int_as_float(__builtin_amdgcn_readlane(__float_as_int(d), 0)), d1 = __int_as_float(__builtin_amdgcn_readlane(__float_as_int(d), 32));
    float lif = (float)li; asm volatile("" : "+v"(lif));
    lam_init = 0.8f - 0.6f * __expf(-0.3f * lif);
    return __expf(d0) - __expf(d1) + lam_init;
}
DI bf16x8 pack8(const f32x16& x, int s) {
    u32x4 p; p[0] = pk2(x[8 * s], x[8 * s + 1]); p[1] = pk2(x[8 * s + 2], x[8 * s + 3]); p[2] = pk2(x[8 * s + 4], x[8 * s + 5]); p[3] = pk2(x[8 * s + 6], x[8 * s + 7]);
    return __builtin_bit_cast(bf16x8, p);
}

DI void diffattn_unit(const Frame& F, int li, int b, int h, size_t qrow0, int NT2) {
    const int lane = F.lane, r = lane & 31, hh = lane >> 5, c = F.wave & 1, g = F.wave >> 1;
    const bf16_t* AQ = WSP(bf16_t, WS_AQ); const bf16_t* AK = WSP(bf16_t, WS_AK); const bf16_t* AVT = WSP(bf16_t, WS_AVT) + (size_t)(b * 4 + h) * 64 * NKEY;
    float lam_init; const float lam = lam_of(F, li, lam_init);
    const size_t qrow = qrow0 + g * 32 + r;
    bf16x8 qf[2]; float qn2 = 0.f;
#pragma unroll
    for (int ks = 0; ks < 2; ++ks) { qf[ks] = *(const bf16x8*)(AQ + qrow * 256 + h * 64 + c * 32 + ks * 16 + 8 * hh);
#pragma unroll
        for (int j = 0; j < 8; ++j) { const float v = bf2f((bf16_t)qf[ks][j]); qn2 += v * v; } }
    qn2 = half_sum(qn2);
    f32x16 cinit;
    { const float km = sqrtf(__uint_as_float(__hip_atomic_load(F.ctl + CW_KMAX + li * 16 + (b * 4 + h) * 2 + c, __ATOMIC_RELAXED, __HIP_MEMORY_SCOPE_AGENT)));
      const float cn = -(sqrtf(qn2) * km * 1.02f + 1e-3f);
#pragma unroll
      for (int i = 0; i < 16; ++i) cinit[i] = cn; }
    f32x16 O[2];
#pragma unroll
    for (int dh = 0; dh < 2; ++dh)
#pragma unroll
        for (int i = 0; i < 16; ++i) O[dh][i] = 0.f;
    f32x16 lacc;
#pragma unroll
    for (int i = 0; i < 16; ++i) lacc[i] = 0.f;
    constexpr int KTB = 2 * 128 * 64, VTB = 64 * 272, STG = KTB + VTB;
    const int skey = F.tid >> 2, sq = F.tid & 3;
    const int kdst0 = (sq >> 1) * 8192 + skey * 64 + ((((sq & 1) * 2 + 0) ^ ((skey >> 2) & 3)) * 16);
    const int kdst1 = (sq >> 1) * 8192 + skey * 64 + ((((sq & 1) * 2 + 1) ^ ((skey >> 2) & 3)) * 16);
    const int vd = F.tid >> 3, vpart = F.tid & 7;
    const int vdst = KTB + vd * 272 + vpart * 32;
    auto krow_of = [&](int j) -> size_t { return j < CTX ? (size_t)NLAT + b * CTX + j : (size_t)b * S + (j - CTX); };
    unsigned char* L = F.lds;
    u32x4 kreg[2], vreg[2];
    { const bf16_t* kp = AK + krow_of(skey) * 256 + h * 64 + sq * 16; const bf16_t* vp = AVT + (size_t)vd * NKEY + vpart * 16;
      kreg[0] = *(const u32x4*)kp; kreg[1] = *(const u32x4*)(kp + 8); vreg[0] = *(const u32x4*)vp; vreg[1] = *(const u32x4*)(vp + 8); }
    __syncthreads();
    *(u32x4*)(L + kdst0) = kreg[0]; *(u32x4*)(L + kdst1) = kreg[1];
    *(u32x4*)(L + vdst) = (u32x4){vreg[0][0], vreg[0][1], vreg[1][0], vreg[1][1]}; *(u32x4*)(L + vdst + 16) = (u32x4){vreg[0][2], vreg[0][3], vreg[1][2], vreg[1][3]};
    __syncthreads();
    const int ksw = (r >> 2) & 3;
    const int kr0 = c * 8192 + r * 64 + (((0 + hh) ^ ksw) * 16), kr1 = c * 8192 + r * 64 + (((2 + hh) ^ ksw) * 16);
    const int vr0 = r * 272 + 16 * hh;
#define DA_QK(Sx, st) do { \
        const bf16x8 k0 = *(const bf16x8*)(kb + (st) * 2048 + kr0), k1 = *(const bf16x8*)(kb + (st) * 2048 + kr1); \
        Sx = MFMA32(k0, qf[0], cinit); Sx = MFMA32(k1, qf[1], Sx); } while (0)
#define DA_PV(Sx, st) do { bf16x8 vf[2][2]; \
        _Pragma("unroll") for (int dh = 0; dh < 2; ++dh) _Pragma("unroll") for (int s2 = 0; s2 < 2; ++s2) \
            vf[dh][s2] = *(const bf16x8*)(vb + dh * (32 * 272) + vr0 + (st) * 64 + s2 * 32); \
        _Pragma("unroll") for (int i = 0; i < 16; ++i) Sx[i] = __builtin_amdgcn_exp2f(Sx[i]); \
        lacc += Sx; \
        const bf16x8 p0 = pack8(Sx, 0), p1 = pack8(Sx, 1); \
        O[0] = MFMA32(vf[0][0], p0, O[0]); O[1] = MFMA32(vf[1][0], p0, O[1]); \
        O[0] = MFMA32(vf[0][1], p1, O[0]); O[1] = MFMA32(vf[1][1], p1, O[1]); } while (0)
#pragma unroll 1
    for (int kt = 0; kt < NT2; ++kt) {
        const int buf = kt & 1;
        if (kt + 1 < NT2) {
            const int j0 = (kt + 1) * 128;
            const bf16_t* kp = AK + krow_of(j0 + skey) * 256 + h * 64 + sq * 16; const bf16_t* vp = AVT + (size_t)vd * NKEY + j0 + vpart * 16;
            kreg[0] = *(const u32x4*)kp; kreg[1] = *(const u32x4*)(kp + 8); vreg[0] = *(const u32x4*)vp; vreg[1] = *(const u32x4*)(vp + 8);
        }
        const unsigned char* kb = L + buf * STG; const unsigned char* vb = L + buf * STG + KTB;
        f32x16 Sa, Sb;
        DA_QK(Sa, 0);
        DA_QK(Sb, 1); DA_PV(Sa, 0);
        DA_QK(Sa, 2); DA_PV(Sb, 1);
        DA_QK(Sb, 3); DA_PV(Sa, 2);
        DA_PV(Sb, 3);
        if (kt + 1 < NT2) {
            unsigned char* W = L + (buf ^ 1) * STG;
            *(u32x4*)(W + kdst0) = kreg[0]; *(u32x4*)(W + kdst1) = kreg[1];
            *(u32x4*)(W + vdst) = (u32x4){vreg[0][0], vreg[0][1], vreg[1][0], vreg[1][1]}; *(u32x4*)(W + vdst + 16) = (u32x4){vreg[0][2], vreg[0][3], vreg[1][2], vreg[1][3]};
        }
        __syncthreads();
    }
#undef DA_QK
#undef DA_PV
    float lsum = 0.f;
#pragma unroll
    for (int i = 0; i < 16; ++i) lsum += lacc[i];
    const float rl = 1.f / half_sum(lsum);
    float* xb = (float*)L + (size_t)g * 32 * 64;
    if (c == 1) {
#pragma unroll
        for (int dh = 0; dh < 2; ++dh)
#pragma unroll
            for (int i = 0; i < 16; ++i) xb[(dh * 16 + i) * 64 + lane] = O[dh][i] * (rl * lam);
    }
    __syncthreads();
    if (c == 0) {
        float o[2][16]; float ss = 0.f;
#pragma unroll
        for (int dh = 0; dh < 2; ++dh)
#pragma unroll
            for (int i = 0; i < 16; ++i) { o[dh][i] = O[dh][i] * rl - xb[(dh * 16 + i) * 64 + lane]; ss += o[dh][i] * o[dh][i]; }
        ss = half_sum(ss);
        const float rs = rsqrtf(ss * (1.f / 64.f) + EPS) * (1.f - lam_init);
        const float* sg = F.in[I_ASUB] + li * 64;
        bf16_t* mix = WSP(bf16_t, WS_HBF) + qrow * D + h * 64;
#pragma unroll
        for (int dh = 0; dh < 2; ++dh)
#pragma unroll
            for (int gq = 0; gq < 4; ++gq) {
                const int d = 32 * dh + 8 * gq + 4 * hh;
                const f32x4 gg = *(const f32x4*)(sg + d);
                *(u32x2*)(mix + d) = (u32x2){pk2(o[dh][4 * gq] * rs * gg[0], o[dh][4 * gq + 1] * rs * gg[1]), pk2(o[dh][4 * gq + 2] * rs * gg[2], o[dh][4 * gq + 3] * rs * gg[3])};
            }
    }
}

DI void na_mfma_unit(const Frame& F, int li, int b, size_t qrow0, int grow) {
    const int lane = F.lane, r31 = lane & 31, hh = lane >> 5, h = F.wave >> 1, qh = F.wave & 1;
    const bf16_t* BQ = WSP(bf16_t, WS_BQ); const bf16_t* BK = WSP(bf16_t, WS_BK); const bf16_t* BVT = WSP(bf16_t, WS_BVT);
    constexpr int KB = 4 * 8192, VB = 4 * 9216, STG = KB + VB;
    unsigned char* L = F.lds;
    float* tab = (float*)(F.lds + 2 * STG);
    const int nwin = grow >= 0 ? 8 : 0, nt = nwin + 4;
    int r0 = grow - 4; r0 = r0 < 0 ? 0 : (r0 > 248 ? 248 : r0);
    __syncthreads();
    if (nwin) for (int i = F.tid; i < 4 * 15 * 32; i += NTHR) { const int c31 = i & 31, hr = i >> 5; tab[i] = (c31 < 31) ? F.in[I_RPB][(size_t)li * 4 * 465 + hr * 31 + c31] * LOG2E : -1e30f; }
    const int skey = F.tid >> 3, sc64 = F.tid & 7, sh = sc64 >> 1;
    const int vrow = F.tid >> 1, vhalf = F.tid & 1;
    auto kbase = [&](int ti) -> const bf16_t* { return ti < nwin ? BK + ((size_t)b * S + (size_t)(r0 + ti) * GW) * 256 : BK + ((size_t)NLAT + b * CTX + (ti - nwin) * 64) * 256; };
    auto vkey0 = [&](int ti) -> int { return ti < nwin ? CTX + (r0 + ti) * GW : (ti - nwin) * 64; };
    u32x4 kreg[4], vreg[4];
    { const bf16_t* kp = kbase(0) + (size_t)skey * 256 + sc64 * 32; const bf16_t* vp = BVT + ((size_t)b * 256 + vrow) * NKEY + vkey0(0) + vhalf * 32;
#pragma unroll
      for (int i = 0; i < 4; ++i) { kreg[i] = *(const u32x4*)(kp + i * 8); vreg[i] = *(const u32x4*)(vp + i * 8); } }
    const size_t qrow = qrow0 + 32 * qh + r31;
    bf16x8 qf[4]; float qn2 = 0.f;
#pragma unroll
    for (int ks = 0; ks < 4; ++ks) { qf[ks] = *(const bf16x8*)(BQ + qrow * 256 + h * 64 + ks * 16 + 8 * hh);
#pragma unroll
        for (int j = 0; j < 8; ++j) { const float v = bf2f((bf16_t)qf[ks][j]); qn2 += v * v; } }
    qn2 = half_sum(qn2);
    __syncthreads();
    float bmax = 0.f;
    if (nwin) { for (int i = lane; i < 480; i += 64) bmax = fmaxf(bmax, tab[h * 480 + i]); bmax = wave_max(bmax); }
    const unsigned* kmx = F.ctl + CW_KMAXB + li * 16 + (b * 4 + h) * 2;
    const float km = sqrtf(__uint_as_float(__hip_atomic_load(kmx, __ATOMIC_RELAXED, __HIP_MEMORY_SCOPE_AGENT)) + __uint_as_float(__hip_atomic_load(kmx + 1, __ATOMIC_RELAXED, __HIP_MEMORY_SCOPE_AGENT)));
    const float cneg = -(sqrtf(qn2) * km * 1.02f + bmax + 1e-3f);
    const int cq = 32 * qh + r31; int c0q = cq - 8; c0q = c0q < 0 ? 0 : (c0q > 48 ? 48 : c0q);
    const int qrow_g = grow;
    f32x16 O[2];
#pragma unroll
    for (int dh = 0; dh < 2; ++dh)
#pragma unroll
        for (int i = 0; i < 16; ++i) O[dh][i] = 0.f;
    f32x16 lacc;
#pragma unroll
    for (int i = 0; i < 16; ++i) lacc[i] = 0.f;
    int tcol[2][16];
#pragma unroll
    for (int st = 0; st < 2; ++st)
#pragma unroll
        for (int i = 0; i < 16; ++i) { const int kc = 32 * st + (i & 3) + 8 * (i >> 2) + 4 * hh; tcol[st][i] = ((kc >= c0q) && (kc < c0q + 16)) ? (kc - cq + 15) : 31; }
    const int kdst = sh * 8192 + skey * 128, ksw = (skey >> 1) & 7, kch0 = (sc64 & 1) * 4;
    const int vdst = KB + (vrow >> 6) * 9216 + (vrow & 63) * 144 + vhalf * 64;
#pragma unroll
    for (int i = 0; i < 4; ++i) *(u32x4*)(L + kdst + (((kch0 + i) ^ ksw) * 16)) = kreg[i];
#pragma unroll
    for (int i = 0; i < 2; ++i) { *(u32x4*)(L + vdst + i * 32) = (u32x4){vreg[2 * i][0], vreg[2 * i][1], vreg[2 * i + 1][0], vreg[2 * i + 1][1]};
        *(u32x4*)(L + vdst + i * 32 + 16) = (u32x4){vreg[2 * i][2], vreg[2 * i][3], vreg[2 * i + 1][2], vreg[2 * i + 1][3]}; }
    __syncthreads();
#pragma unroll 1
    for (int ti = 0; ti < nt; ++ti) {
        const int buf = ti & 1;
        if (ti + 1 < nt) { const bf16_t* kp = kbase(ti + 1) + (size_t)skey * 256 + sc64 * 32; const bf16_t* vp = BVT + ((size_t)b * 256 + vrow) * NKEY + vkey0(ti + 1) + vhalf * 32;
#pragma unroll
            for (int i = 0; i < 4; ++i) { kreg[i] = *(const u32x4*)(kp + i * 8); vreg[i] = *(const u32x4*)(vp + i * 8); } }
        const unsigned char* kb = L + buf * STG + h * 8192; const unsigned char* vb = L + buf * STG + KB + h * 9216;
        const bool win = ti < nwin;
        const float* trow = tab + (h * 15 + (win ? (r0 + ti - qrow_g + 7) : 0)) * 32;
#pragma unroll
        for (int st = 0; st < 2; ++st) {
            const int key = 32 * st + r31, sw = (key >> 1) & 7;
            f32x16 s;
            if (win) {
#pragma unroll
                for (int i = 0; i < 16; ++i) s[i] = trow[tcol[st][i]] + cneg;
            } else {
#pragma unroll
                for (int i = 0; i < 16; ++i) s[i] = cneg;
            }
#pragma unroll
            for (int ks = 0; ks < 4; ++ks) { const bf16x8 kf = *(const bf16x8*)(kb + key * 128 + (((ks * 2 + hh) ^ sw) * 16)); s = MFMA32(kf, qf[ks], s); }
#pragma unroll
            for (int i = 0; i < 16; ++i) s[i] = __builtin_amdgcn_exp2f(s[i]);
            lacc += s;
            const bf16x8 p0 = pack8(s, 0), p1 = pack8(s, 1);
#pragma unroll
            for (int dh = 0; dh < 2; ++dh) {
                const unsigned char* vp = vb + (32 * dh + r31) * 144 + st * 64 + hh * 16;
                O[dh] = MFMA32(*(const bf16x8*)vp, p0, O[dh]);
                O[dh] = MFMA32(*(const bf16x8*)(vp + 32), p1, O[dh]);
            }
        }
        if (ti + 1 < nt) { unsigned char* W = L + (buf ^ 1) * STG;
#pragma unroll
            for (int i = 0; i < 4; ++i) *(u32x4*)(W + kdst + (((kch0 + i) ^ ksw) * 16)) = kreg[i];
#pragma unroll
            for (int i = 0; i < 2; ++i) { *(u32x4*)(W + vdst + i * 32) = (u32x4){vreg[2 * i][0], vreg[2 * i][1], vreg[2 * i + 1][0], vreg[2 * i + 1][1]};
                *(u32x4*)(W + vdst + i * 32 + 16) = (u32x4){vreg[2 * i][2], vreg[2 * i][3], vreg[2 * i + 1][2], vreg[2 * i + 1][3]}; } }
        __syncthreads();
    }
    float lsum = 0.f;
#pragma unroll
    for (int i = 0; i < 16; ++i) lsum += lacc[i];
    const float rl = 1.f / half_sum(lsum);
    bf16_t* mix = WSP(bf16_t, WS_HBF) + qrow * D + 256 + h * 64;
#pragma unroll
    for (int dh = 0; dh < 2; ++dh)
#pragma unroll
        for (int g = 0; g < 4; ++g) { const int d = 32 * dh + 8 * g + 4 * hh;
            *(u32x2*)(mix + d) = (u32x2){pk2(O[dh][4 * g] * rl, O[dh][4 * g + 1] * rl), pk2(O[dh][4 * g + 2] * rl, O[dh][4 * g + 3] * rl)}; }
}

DI void pool_unit(const Frame& F, int li, size_t seq_row0, int L, int t0) {
    unsigned* us = (unsigned*)F.lds;
    unsigned char* dfb = F.lds + 80 * 512;
    const bf16_t* PL = WSP(bf16_t, WS_PL);
    __syncthreads();
    for (int i = F.tid; i < 80 * 32; i += NTHR) {
        const int tt = i >> 5, c8 = i & 31, t = t0 - 8 + tt;
        u32x4 x = (u32x4){0u, 0u, 0u, 0u};
        if (t >= 0 && t < L) x = *(const u32x4*)(PL + (seq_row0 + t) * 256 + c8 * 8);
        *(u32x4*)(us + tt * 128 + c8 * 4) = x;
    }
    __syncthreads();
    {
        const int cp = F.tid & 127, tl0 = (F.tid >> 7) * 16, hw = 1 << (cp >> 5);
        float s0 = 0.f, s1 = 0.f;
        for (int k = -hw; k < hw; ++k) { const unsigned w = us[(tl0 + 8 + k) * 128 + cp]; s0 += __uint_as_float(w << 16); s1 += __uint_as_float(w & 0xffff0000u); }
#pragma unroll 4
        for (int j = 0; j < 16; ++j) {
            const int tl = tl0 + j, t = t0 + tl;
            const int lo = t - hw < 0 ? 0 : t - hw, hi = t + hw > L ? L : t + hw;
            const float rc = 1.f / (float)(hi - lo);
            const unsigned c = us[(tl + 8) * 128 + cp];
            *(unsigned*)(dfb + tl * 528 + cp * 4) = pk2(s0 * rc - __uint_as_float(c << 16), s1 * rc - __uint_as_float(c & 0xffff0000u));
            const unsigned a = us[(tl + 8 + hw) * 128 + cp], b = us[(tl + 8 - hw) * 128 + cp];
            s0 += __uint_as_float(a << 16) - __uint_as_float(b << 16); s1 += __uint_as_float(a & 0xffff0000u) - __uint_as_float(b & 0xffff0000u);
        }
    }
    __syncthreads();
    {
        const int g = F.wave & 3, tq = F.wave >> 2, fr = F.lane & 15, fq = F.lane >> 4;
        const bf16_t* wt = WSP(bf16_t, WS_PWT) + ((size_t)li * 4 + g) * 4096;
        bf16x8 Af[4][2];
#pragma unroll
        for (int jb = 0; jb < 4; ++jb)
#pragma unroll
            for (int ks = 0; ks < 2; ++ks) Af[jb][ks] = *(const bf16x8*)(wt + (jb * 16 + fr) * 64 + ks * 32 + fq * 8);
        const float* ps = F.in[I_POOLS] + li * 256 + g * 64;
        bf16_t* mix = WSP(bf16_t, WS_HBF);
#pragma unroll
        for (int tb = 0; tb < 2; ++tb) {
            const int tl = (tq * 2 + tb) * 16 + fr;
            const bf16x8 B0 = *(const bf16x8*)(dfb + tl * 528 + (g * 64 + fq * 8) * 2), B1 = *(const bf16x8*)(dfb + tl * 528 + (g * 64 + 32 + fq * 8) * 2);
#pragma unroll
            for (int jb = 0; jb < 4; ++jb) {
                f32x4 acc = (f32x4){0.f, 0.f, 0.f, 0.f};
                acc = __builtin_amdgcn_mfma_f32_16x16x32_bf16(Af[jb][0], B0, acc, 0, 0, 0);
                acc = __builtin_amdgcn_mfma_f32_16x16x32_bf16(Af[jb][1], B1, acc, 0, 0, 0);
                const f32x4 sc = *(const f32x4*)(ps + jb * 16 + 4 * fq);
                *(u32x2*)(mix + (seq_row0 + t0 + tl) * D + 512 + g * 64 + jb * 16 + 4 * fq) = (u32x2){pk2(acc[0] * sc[0], acc[1] * sc[1]), pk2(acc[2] * sc[2], acc[3] * sc[3])};
            }
        }
    }
}

DI float hy_norm(const float* part, int ntile, int o, int ch) {
    float s = 0.f;
    for (int t = 0; t < ntile; ++t) s += part[(size_t)t * 1024 + (o * 2) * 256 + ch] + part[(size_t)t * 1024 + (o * 2 + 1) * 256 + ch];
    return rsqrtf(s + EPS);
}
DI float hy_short(const bf16_t* p, int t, int L, float w0, float w1, float w2, float bb) {
    const int tm = t > 0 ? t - 1 : 0, tp = t + 1 < L ? t + 1 : L - 1;
    float a = bf2f(p[tm]), c = bf2f(p[tp]); const float m = bf2f(p[t]);
    a = t > 0 ? a : 0.f; c = t + 1 < L ? c : 0.f;
    return a * w0 + m * w1 + c * w2 + bb;
}
constexpr int FM = 16384;
DI int fphys(int i) { return i + (i >> 4) + ((i >> 9) << 4); }
constexpr int brev(int m, int bits) { return bits == 5 ? (((m & 1) << 4) | ((m & 2) << 2) | (m & 4) | ((m & 8) >> 2) | ((m & 16) >> 4)) : (((m & 1) << 3) | ((m & 2) << 1) | ((m & 4) >> 1) | ((m & 8) >> 3)); }
template <int R, int LOG2R, bool INV> DI void dft_regs(float (&re)[R], float (&im)[R]) {
    constexpr float C32[16] = {1.f, 0.98078528040323043f, 0.92387953251128674f, 0.83146961230254524f, 0.70710678118654752f, 0.55557023301960218f, 0.38268343236508977f, 0.19509032201612825f,
                               0.f, -0.19509032201612825f, -0.38268343236508977f, -0.55557023301960218f, -0.70710678118654752f, -0.83146961230254524f, -0.92387953251128674f, -0.98078528040323043f};
    constexpr float S32[16] = {0.f, 0.19509032201612825f, 0.38268343236508977f, 0.55557023301960218f, 0.70710678118654752f, 0.83146961230254524f, 0.92387953251128674f, 0.98078528040323043f,
                               1.f, 0.98078528040323043f, 0.92387953251128674f, 0.83146961230254524f, 0.70710678118654752f, 0.55557023301960218f, 0.38268343236508977f, 0.19509032201612825f};
#pragma unroll
    for (int st = 0; st < LOG2R; ++st) {
        const int h = R >> (st + 1);
#pragma unroll
        for (int i = 0; i < R; i += 2 * h) {
#pragma unroll
            for (int j = 0; j < h; ++j) {
                const float xr = re[i + j], xi = im[i + j], yr = re[i + j + h], yi = im[i + j + h];
                re[i + j] = xr + yr; im[i + j] = xi + yi;
                const float dr = xr - yr, di = xi - yi;
                const int k = j * (16 / h);
                if (k == 0) { re[i + j + h] = dr; im[i + j + h] = di; }
                else if (k == 8) { re[i + j + h] = INV ? -di : di; im[i + j + h] = INV ? dr : -dr; }
                else { const float c = C32[k], sn = INV ? S32[k] : -S32[k]; re[i + j + h] = dr * c - di * sn; im[i + j + h] = dr * sn + di * c; }
            }
        }
    }
}
template <bool INV, int SP> DI void fft_pass32(f32x2* X, int bp, int rem, float inv_bs) {
    asm volatile("" : "+v"(bp), "+v"(rem));
    f32x2* P = X + bp;
    const float revb = (float)rem * inv_bs;
    float re[32], im[32];
    if (!INV) {
#pragma unroll
        for (int q = 0; q < 32; ++q) { const f32x2 v = P[q * SP]; re[q] = v[0]; im[q] = v[1]; }
        dft_regs<32, 5, false>(re, im);
#pragma unroll
        for (int m = 0; m < 32; ++m) { const int qp = brev(m, 5);
            float r = re[m], i = im[m];
            if (qp != 0) { const float rev = revb * (float)qp; const float c = __builtin_amdgcn_cosf(rev), sn = -__builtin_amdgcn_sinf(rev); const float t = r * c - i * sn; i = r * sn + i * c; r = t; }
            P[qp * SP] = (f32x2){r, i}; }
    } else {
#pragma unroll
        for (int qp = 0; qp < 32; ++qp) { const f32x2 v = P[qp * SP]; float r = v[0], i = v[1];
            if (qp != 0) { const float rev = revb * (float)qp; const float c = __builtin_amdgcn_cosf(rev), sn = __builtin_amdgcn_sinf(rev); const float t = r * c - i * sn; i = r * sn + i * c; r = t; }
            re[qp] = r; im[qp] = i; }
        dft_regs<32, 5, true>(re, im);
#pragma unroll
        for (int m = 0; m < 32; ++m) P[brev(m, 5) * SP] = (f32x2){re[m], im[m]};
    }
}
DI void fft_fwd12(f32x2* X, int tid) {
    __syncthreads(); fft_pass32<false, 560>(X, fphys(tid), tid, 1.f / 16384.f);
    __syncthreads(); fft_pass32<false, 17>(X, (tid >> 4) * 560 + (tid & 15), tid & 15, 1.f / 512.f);
    __syncthreads();
}
DI void fft_inv21(f32x2* X, int tid) {
    __syncthreads(); fft_pass32<true, 17>(X, (tid >> 4) * 560 + (tid & 15), tid & 15, 1.f / 512.f);
    __syncthreads(); fft_pass32<true, 560>(X, fphys(tid), tid, 1.f / 16384.f);
    __syncthreads();
}
DI void hyena_fft_unit(const Frame& F, int li, int ch) {
    f32x2* X = (f32x2*)F.lds;
    const bf16_t* HYT = WSP(bf16_t, WS_HYT); const float* filt = WSP(float, WS_FILT);
    f32x2* Ye = WSP(f32x2, WS_ZBUF) + (size_t)ch * FM; f32x2* Z1 = WSP(f32x2, WS_Z1BUF) + (size_t)ch * FM;
    const float* sw = F.in[I_HYSW] + (size_t)li * 3 * 768; const float* sb = F.in[I_HYSB] + li * 768; const float* sk = F.in[I_HSKIP] + li * 512;
    const int tid = F.tid;
    const bf16_t* px1[2] = {HYT + ((size_t)0 * 768 + ch) * S, HYT + ((size_t)1 * 768 + ch) * S};
    const bf16_t* px2[2] = {HYT + ((size_t)0 * 768 + 256 + ch) * S, HYT + ((size_t)1 * 768 + 256 + ch) * S};
    const bf16_t* pv[2] = {HYT + ((size_t)0 * 768 + 512 + ch) * S, HYT + ((size_t)1 * 768 + 512 + ch) * S};
    const float wx1[4] = {sw[ch], sw[768 + ch], sw[1536 + ch], sb[ch]};
    const float wx2[4] = {sw[256 + ch], sw[768 + 256 + ch], sw[1536 + 256 + ch], sb[256 + ch]};
    const float wv[4] = {sw[512 + ch], sw[768 + 512 + ch], sw[1536 + 512 + ch], sb[512 + ch]};
#pragma unroll 1
    for (int cv = 0; cv < 2; ++cv) {
        const float* hf = filt + ((size_t)(2 * cv) * 256 + ch) * S; const float* hb = filt + ((size_t)(2 * cv + 1) * 256 + ch) * S;
        float fnrm;
        { int tn = tid; asm volatile("" : "+v"(tn));
          const float pv = WSP(float, WS_FPART)[(size_t)(tn & 255) * 1024 + (cv * 2 + (tn >> 8)) * 256 + ch];
          const float ws = wave_sum(pv);
          float* red = (float*)(F.lds + LDS_MISC + 128);
          __syncthreads();
          if (F.lane == 0) red[F.wave] = ws;
          __syncthreads();
          fnrm = rsqrtf(red[0] + red[1] + red[2] + red[3] + red[4] + red[5] + red[6] + red[7] + EPS); }
        const float nrm = 1.f / 32768.f;
        const float skip = sk[cv * 256 + ch];
#pragma unroll 1
        for (int half = 0; half < 2; ++half) {
            __syncthreads();
            int pb = fphys(tid); int tq = tid; asm volatile("" : "+v"(pb), "+v"(tq));
            if (half == 0) {
#pragma unroll 8
                for (int j = 0; j < 32; ++j) { const int n = tq + 512 * j; const float a = hf[n] * fnrm; float bq = hb[FM - n] * fnrm; bq = n ? bq : 0.f;
                    X[pb + 560 * j] = (f32x2){a + bq, 0.f}; }
            } else {
#pragma unroll 8
                for (int j = 0; j < 32; ++j) { const int n = tq + 512 * j; const float a = hf[n] * fnrm; float bq = hb[FM - n] * fnrm; bq = n ? bq : 0.f;
                    const float d = a - bq, rev = (float)n * (1.f / 32768.f);
                    X[pb + 560 * j] = (f32x2){d * __builtin_amdgcn_cosf(rev), -d * __builtin_amdgcn_sinf(rev)}; }
            }
            fft_fwd12(X, tid);
            h16x2 kpk[2][16];
#pragma unroll
            for (int g = 0; g < 2; ++g) { int b16 = fphys((tid + 512 * g) * 16); asm volatile("" : "+v"(b16));
                float kre[16], kim[16];
#pragma unroll
                for (int q = 0; q < 16; ++q) { const f32x2 v = X[b16 + q]; kre[q] = v[0]; kim[q] = v[1]; }
                dft_regs<16, 4, false>(kre, kim);
#pragma unroll
                for (int q = 0; q < 16; ++q) kpk[g][q] = (h16x2){(_Float16)kre[q], (_Float16)kim[q]}; }
            __syncthreads();
            asm volatile("" : "+v"(pb), "+v"(tq));
#define HY_MOD(v, n) do { const float rev = (float)(n) * (1.f / 32768.f); const float c = __builtin_amdgcn_cosf(rev), sn = -__builtin_amdgcn_sinf(rev); v = (f32x2){v[0] * c - v[1] * sn, v[0] * sn + v[1] * c}; } while (0)
            if (cv == 0) {
                if (half == 0) {
#pragma unroll 4
                    for (int j = 0; j < 32; ++j) { const int n = tq + 512 * j; X[pb + 560 * j] = (f32x2){hy_short(pv[0], n, S, wv[0], wv[1], wv[2], wv[3]), hy_short(pv[1], n, S, wv[0], wv[1], wv[2], wv[3])}; }
                } else {
#pragma unroll 4
                    for (int j = 0; j < 32; ++j) { const int n = tq + 512 * j; f32x2 v = (f32x2){hy_short(pv[0], n, S, wv[0], wv[1], wv[2], wv[3]), hy_short(pv[1], n, S, wv[0], wv[1], wv[2], wv[3])}; HY_MOD(v, n); X[pb + 560 * j] = v; }
                }
            } else {
                if (half == 0) {
#pragma unroll 8
                    for (int j = 0; j < 32; ++j) { const int n = tq + 512 * j; X[pb + 560 * j] = Z1[n]; }
                } else {
#pragma unroll 8
                    for (int j = 0; j < 32; ++j) { const int n = tq + 512 * j; f32x2 v = Z1[n]; HY_MOD(v, n); X[pb + 560 * j] = v; }
                }
            }
#undef HY_MOD
            fft_fwd12(X, tid);
#pragma unroll
            for (int g = 0; g < 2; ++g) { int b16 = fphys((tid + 512 * g) * 16); asm volatile("" : "+v"(b16));
                float re[16], im[16];
#pragma unroll
                for (int q = 0; q < 16; ++q) { const f32x2 v = X[b16 + q]; re[q] = v[0]; im[q] = v[1]; }
                dft_regs<16, 4, false>(re, im);
                float br[16], bi[16];
#pragma unroll
                for (int m = 0; m < 16; ++m) { const int qp = brev(m, 4); const float kr = (float)kpk[g][m][0], ki = (float)kpk[g][m][1]; br[qp] = re[m] * kr - im[m] * ki; bi[qp] = re[m] * ki + im[m] * kr; }
                dft_regs<16, 4, true>(br, bi);
#pragma unroll
                for (int m = 0; m < 16; ++m) X[b16 + brev(m, 4)] = (f32x2){br[m], bi[m]};
            }
            fft_inv21(X, tid);
            asm volatile("" : "+v"(pb), "+v"(tq));
            if (half == 0) {
#pragma unroll 8
                for (int j = 0; j < 32; ++j) { const int n = tq + 512 * j; Ye[n] = X[pb + 560 * j]; }
            } else {
#define HY_Y(n, j) const f32x2 yo = X[pb + 560 * (j)], ye = Ye[n]; \
                    const float rev = (float)(n) * (1.f / 32768.f); const float c = __builtin_amdgcn_cosf(rev), sn = __builtin_amdgcn_sinf(rev); \
                    const float y0 = (ye[0] + yo[0] * c - yo[1] * sn) * nrm, y1 = (ye[1] + yo[0] * sn + yo[1] * c) * nrm;
                if (cv == 0) {
#pragma unroll 4
                    for (int j = 0; j < 32; ++j) { const int n = tq + 512 * j; HY_Y(n, j)
                        const float v0 = hy_short(pv[0], n, S, wv[0], wv[1], wv[2], wv[3]), v1 = hy_short(pv[1], n, S, wv[0], wv[1], wv[2], wv[3]);
                        const float a0 = hy_short(px1[0], n, S, wx1[0], wx1[1], wx1[2], wx1[3]), a1 = hy_short(px1[1], n, S, wx1[0], wx1[1], wx1[2], wx1[3]);
                        Z1[n] = (f32x2){a0 * (y0 + skip * v0), a1 * (y1 + skip * v1)}; }
                } else {
                    bf16_t* mix = WSP(bf16_t, WS_HBF);
#pragma unroll 4
                    for (int j = 0; j < 32; ++j) { const int n = tq + 512 * j; HY_Y(n, j)
                        const f32x2 z1 = Z1[n];
                        const float a0 = hy_short(px2[0], n, S, wx2[0], wx2[1], wx2[2], wx2[3]), a1 = hy_short(px2[1], n, S, wx2[0], wx2[1], wx2[2], wx2[3]);
                        mix[((size_t)n) * D + 768 + ch] = f2bf(a0 * (y0 + skip * z1[0]));
                        mix[((size_t)S + n) * D + 768 + ch] = f2bf(a1 * (y1 + skip * z1[1])); }
                }
#undef HY_Y
            }
        }
    }
}
DI void hyena_ctx_unit(const Frame& F, int li, int ch) {
    float* vs = (float*)F.lds;
    float* zs = vs + 512;
    float* fl = zs + 512;
    const bf16_t* HYC = WSP(bf16_t, WS_HYC); const float* filt = WSP(float, WS_FILTC);
    const float* sw = F.in[I_HYSW] + (size_t)li * 3 * 768; const float* sb = F.in[I_HYSB] + li * 768; const float* sk = F.in[I_HSKIP] + li * 512;
    const float n0 = hy_norm(WSP(float, WS_FPARTC), 4, 0, ch), n1 = hy_norm(WSP(float, WS_FPARTC), 4, 1, ch);
    const int b = F.tid >> 8, t = F.tid & 255;
    auto sc = [&](int c) -> float { const bf16_t* p = HYC + (size_t)(b * CTX) * 768 + c;
        const float a = t > 0 ? bf2f(p[(size_t)(t - 1) * 768]) : 0.f, d = t + 1 < CTX ? bf2f(p[(size_t)(t + 1) * 768]) : 0.f;
        return a * sw[c] + bf2f(p[(size_t)t * 768]) * sw[768 + c] + d * sw[1536 + c] + sb[c]; };
    __syncthreads();
    const float x1 = sc(ch), x2 = sc(256 + ch), v = sc(512 + ch);
    vs[F.tid] = v;
    for (int i = F.tid; i < 1024; i += NTHR) fl[i] = filt[((size_t)(i >> 8) * 256 + ch) * CTX + (i & 255)];
    __syncthreads();
    float a = 0.f;
    for (int s = 0; s < CTX; ++s) { const int dl = t - s; a += (dl >= 0 ? fl[dl] : fl[256 - dl]) * vs[b * 256 + s]; }
    const float z = x1 * (a * n0 + sk[ch] * v);
    zs[F.tid] = z;
    __syncthreads();
    a = 0.f;
    for (int s = 0; s < CTX; ++s) { const int dl = t - s; a += (dl >= 0 ? fl[512 + dl] : fl[768 - dl]) * zs[b * 256 + s]; }
    WSP(bf16_t, WS_HBF)[((size_t)NLAT + b * CTX + t) * D + 768 + ch] = f2bf(x2 * (a * n1 + sk[256 + ch] * z));
}

DI void phase_mix(const Frame& F0, int li) {
    const Frame& F = F0;
    unsigned* head = F.ctl + CW_QHEAD + li * 64;
    volatile unsigned* qs = (volatile unsigned*)(F.lds + LDS_MISC + 32);
#ifndef PROBE_DA
#define PROBE_DA 1
#endif
#ifndef PROBE_HY
#define PROBE_HY 1
#endif
#ifndef PROBE_NA
#define PROBE_NA 1
#endif
#ifdef PROBE_MISC
#define PROBE_PL 2
#else
#define PROBE_PL 1
#endif
    const int n_ca = (li == 0) ? 16 : 0, n_cb = (li == 0) ? 8 : 0, n_da = 1024 * PROBE_DA, n_hy = 256 * PROBE_HY, n_na = 512 * PROBE_NA, n_hc = (li == 0) ? 256 * PROBE_PL : 0, n_pl = 512 * PROBE_PL, n_pc = (li == 0) ? 8 : 0;
    const int total = n_ca + n_cb + n_da + n_hy + n_na + n_hc + n_pl + n_pc;
#if defined(PT_T) && PT_T >= 12
    unsigned long long ptk_acc = 0ull, ptk_t0 = 0ull; int ptk_kind = -1;
#endif
    for (;;) {
        __syncthreads();
#if defined(PT_T) && PT_T >= 12
        { const unsigned long long now_ = __builtin_amdgcn_s_memrealtime(); __builtin_amdgcn_s_waitcnt(0xC07F); if (ptk_kind == PT_T - 12) ptk_acc += now_ - ptk_t0; ptk_t0 = now_; }
#endif
        if (F.tid == 0) qs[0] = __hip_atomic_fetch_add(head, 1u, __ATOMIC_RELAXED, __HIP_MEMORY_SCOPE_AGENT);
        __syncthreads();
        int u = __builtin_amdgcn_readfirstlane((int)qs[0]);
#if defined(PT_T) && PT_T >= 12
        ptk_kind = u < n_ca + n_cb ? 0 : u < n_ca + n_cb + n_da ? 1 : u < n_ca + n_cb + n_da + n_hy ? 2 : u < n_ca + n_cb + n_da + n_hy + n_na ? 3 : u < n_ca + n_cb + n_da + n_hy + n_na + n_hc ? 4 : 5;
        if (u >= total) { if (F0.tid == 0) atomicAdd((unsigned long long*)(F0.ctl + 13000), ptk_acc); break; }
#endif
        if (u >= total) break;
        Frame F = F0; refresh(F);
        if (u < n_ca) {
#ifndef SKIP_CA
            diffattn_unit(F, li, u >> 3, (u >> 1) & 3, (size_t)NLAT + (size_t)(u >> 3) * CTX + (size_t)(u & 1) * 128, CTX / 128);
#endif
            continue; }
        u -= n_ca;
        if (u < n_cb) {
#ifndef SKIP_CB
            na_mfma_unit(F, li, u >> 2, (size_t)NLAT + (size_t)(u >> 2) * CTX + (size_t)(u & 3) * 64, -1);
#endif
            continue; }
        u -= n_cb;
        if (u < n_da) {
#ifndef SKIP_DA
            { const int v = u & 1023; diffattn_unit(F, li, v >> 9, (v >> 7) & 3, (size_t)(v >> 9) * S + (size_t)(v & 127) * 128, NKEY / 128); }
#endif
            continue; }
        u -= n_da;
        if (u < n_hy) {
#ifndef SKIP_HY
            hyena_fft_unit(F, li, u & 255);
#endif
            continue; }
        u -= n_hy;
        if (u < n_na) {
#ifndef SKIP_NA
            { const int v = u & 511; na_mfma_unit(F, li, v >> 8, (size_t)(v >> 8) * S + (size_t)(v & 255) * GW, v & 255); }
#endif
            continue; }
        u -= n_na;
        if (u < n_hc) {
#ifndef SKIP_HC
            hyena_ctx_unit(F, li, u & 255);
#endif
            continue; }
        u -= n_hc;
        if (u < n_pl) {
#ifndef SKIP_PL
            { const int v = u & 511; pool_unit(F, li, (size_t)(v >> 8) * S, S, (v & 255) * 64); }
#endif
            continue; }
        u -= n_pl;
#ifndef SKIP_PL
        pool_unit(F, li, (size_t)NLAT + (u >> 2) * CTX, CTX, (u & 3) * 64);
#endif
    }
}

constexpr int PH_PER_LAYER = 8, NPH = 2 + 2 * PH_PER_LAYER;
#ifdef PT_T
#define PT_SEL(k) (PT_T == 10 || (PT_T == 8 && (k) == 0) || (PT_T == 9 && (k) == NPH - 1) || (PT_T < 8 && (k) >= 1 && (k) <= 16 && (((k) - 1) & 7) == PT_T))
#define PT_MARK(k) do { const unsigned long long now_ = __builtin_amdgcn_s_memrealtime(); __builtin_amdgcn_s_waitcnt(0xC07F); if (PT_SEL(k)) pt_acc += now_ - pt_last; pt_last = now_; } while (0)
#ifndef PT_MULT
#define PT_MULT 4
#endif
#else
#define PT_MARK(k) do { } while (0)
#endif
__global__ void __launch_bounds__(NTHR, 2) mega(Args args) {
    extern __shared__ __attribute__((aligned(16))) unsigned char smem[];
    Frame F;
    F.in = args.in; F.out = args.out; F.ws = args.ws; F.ctl = (unsigned*)(args.ws + WS_CTL); F.lds = smem;
    F.tid = threadIdx.x; F.lane = F.tid & 63; F.wave = __builtin_amdgcn_readfirstlane(F.tid >> 6); F.G = gridDim.x; F.bid = blockIdx.x;
    if (F.tid < 64) ((unsigned*)(smem + LDS_MISC))[F.tid] = 0u;
    __syncthreads();
    const int lo = args.ph_lo, hi = args.ph_hi;
    const bool fused = (hi - lo) > 1;
    XcdBarrier bar; bar.bar = F.ctl; bar.x = 0; bar.st = (volatile LAS unsigned*)(smem + LDS_MISC);
    if (fused) bar = xcd_barrier_post(F.ctl, (volatile LAS unsigned*)(smem + LDS_MISC));
#define IN(k) (lo <= (k) && (k) < hi)
#ifdef PT_T
    unsigned long long pt_acc = 0ull, pt_last = __builtin_amdgcn_s_memrealtime(); __builtin_amdgcn_s_waitcnt(0xC07F);
#endif
#ifdef PROBE_BAR
#define SEAM(k) do { if (IN(k) && IN((k) + 1)) { xcd_barrier(bar); xcd_barrier(bar); xcd_barrier(bar); } } while (0)
#else
#define SEAM(k) do { if (IN(k) && IN((k) + 1)) xcd_barrier(bar); PT_MARK(k); } while (0)
#endif
#ifndef SKIP_P0
    if (IN(0)) { refresh(F); phase_prologue(F);
#ifdef PROBE_MISC
        __syncthreads(); refresh(F); phase_prologue(F);
#endif
    }
#endif
    SEAM(0);
    for (int li = 0; li < 2; ++li) {
        const int p0 = 1 + li * PH_PER_LAYER;
        const int nrows = (li == 0) ? NTOK : NLAT;
        if (IN(p0)) {
            refresh(F);
#if defined(PT_T) && PT_T >= 20 && PT_T <= 23
            const unsigned long long tn0_ = __builtin_amdgcn_s_memrealtime(); __builtin_amdgcn_s_waitcnt(0xC07F);
#endif
            phase_norm1(F, li, li == 0 ? 0 : 1);
#if defined(PT_T) && PT_T >= 20 && PT_T <= 23
            __syncthreads();
            const unsigned long long tn1_ = __builtin_amdgcn_s_memrealtime(); __builtin_amdgcn_s_waitcnt(0xC07F);
            if (threadIdx.x == 0 && PT_T == 20 + li) atomicAdd((unsigned long long*)(F.ctl + 13000), tn1_ - tn0_);
#endif
#ifdef PROBE_N1
            if (li == 0) { refresh(F); phase_norm1(F, li, 0); refresh(F); phase_norm1(F, li, 0); refresh(F); phase_norm1(F, li, 0); refresh(F); phase_norm1(F, li, 0); }
#endif
            refresh(F);
#ifndef SKIP_FILT
            for (int t = F.bid; t < 256; t += F.G) filter_tile(F, li, S, t, WSP(float, WS_FILT), WSP(float, WS_FPART));
            if (li == 0) for (int t = F.bid; t < 4; t += F.G) filter_tile(F, li, CTX, t, WSP(float, WS_FILTC), WSP(float, WS_FPARTC));
#ifdef PROBE_MISC
            for (int t = F.bid; t < 256; t += F.G) filter_tile(F, li, S, t, WSP(float, WS_FILT), WSP(float, WS_FPART));
#endif
#endif
#if defined(PT_T) && PT_T >= 20 && PT_T <= 23
            { __syncthreads(); const unsigned long long tn2_ = __builtin_amdgcn_s_memrealtime(); __builtin_amdgcn_s_waitcnt(0xC07F);
              if (threadIdx.x == 0 && PT_T == 22 + li) atomicAdd((unsigned long long*)(F.ctl + 13000), tn2_ - tn1_); }
#endif
        }
        SEAM(p0);
        if (IN(p0 + 1)) {
            refresh(F);
            pg8::Gemm g{WSP(bf16_t, WS_HBF), WSP(bf16_t, WS_WIN) + (size_t)li * DIN * D, D, 0};
            pg8::StaticOrder So; So.init(NTOK, DIN, F.G, F.bid);
            EpiIn E{F.ws, WSP(float, WS_ROPE), F.ctl + CW_KMAX + li * 16, F.ctl + CW_KMAXB + li * 16};
#ifndef SKIP_G1
            pg8::gemm_phase<EpiIn, pg8::StaticOrder>((LAS unsigned char*)smem, g, So, E, F.tid);
#ifdef PROBE_G1
            __syncthreads(); refresh(F); pg8::gemm_phase<EpiIn, pg8::StaticOrder>((LAS unsigned char*)smem, g, So, E, F.tid);
#endif
#endif
        }
        SEAM(p0 + 1);
        if (IN(p0 + 2)) { refresh(F); phase_mix(F, li); }
#if defined(PT_T) && PT_T == 11
        { const unsigned long long ta_ = __builtin_amdgcn_s_memrealtime(); __builtin_amdgcn_s_waitcnt(0xC07F);
          SEAM(p0 + 2);
          const unsigned long long tb_ = __builtin_amdgcn_s_memrealtime(); __builtin_amdgcn_s_waitcnt(0xC07F);
          if (threadIdx.x == 0) atomicAdd((unsigned long long*)(F.ctl + 13000), tb_ - ta_); }
#else
        SEAM(p0 + 2);
#endif
        if (IN(p0 + 3)) {
            refresh(F);
            pg8::Gemm g{WSP(bf16_t, WS_HBF), WSP(bf16_t, WS_WOUT) + (size_t)li * D * D, D, 0};
            pg8::StaticOrder So; So.init(nrows, D, F.G, F.bid);
            EpiOut E{li == 0 ? F.in[I_X] : F.out, li == 0 ? F.in[I_CTX] : WSP(float, WS_XC), F.out, WSP(float, WS_XC), WSP(float, WS_MOD) + (size_t)li * 3 * 6144};
#ifndef SKIP_G2
            pg8::gemm_phase<EpiOut, pg8::StaticOrder>((LAS unsigned char*)smem, g, So, E, F.tid);
#endif
        }
        SEAM(p0 + 3);
#ifndef SKIP_N2
        if (IN(p0 + 4)) { refresh(F); phase_norm2(F, li, nrows); }
#endif
        SEAM(p0 + 4);
        if (IN(p0 + 5)) { refresh(F); phase_gather(F, li, nrows);
#ifdef PROBE_MISC
            __syncthreads(); refresh(F); phase_gather(F, li, nrows);
#endif
        }
        SEAM(p0 + 5);
        if (IN(p0 + 6)) {
            refresh(F);
            int* offs = (int*)(smem + LDS_MISC + 64);
            moe_offsets(F, li, offs);
            pg8::Gemm g{WSP(bf16_t, WS_A1), WSP(bf16_t, WS_W13) + (size_t)li * NE * 1024 * 1024, D, (size_t)1024 * 1024};
            pg8::MoeOrder Mo{offs + 40, offs[17 + 16], 4, F.G, (F.G % 8 == 0) ? (F.bid % 8) * (F.G / 8) + F.bid / 8 : F.bid};
            EpiMoe1 E{WSP(bf16_t, WS_HMID)};
#ifndef SKIP_G3
            pg8::gemm_phase<EpiMoe1, pg8::MoeOrder>((LAS unsigned char*)smem, g, Mo, E, F.tid);
#ifdef PROBE_G3
            __syncthreads(); refresh(F); pg8::gemm_phase<EpiMoe1, pg8::MoeOrder>((LAS unsigned char*)smem, g, Mo, E, F.tid);
#endif
#endif
        }
        SEAM(p0 + 6);
        if (IN(p0 + 7)) {
            refresh(F);
            int* offs = (int*)(smem + LDS_MISC + 64);
            moe_offsets(F, li, offs);
            pg8::Gemm g{WSP(bf16_t, WS_HMID), WSP(bf16_t, WS_W2) + (size_t)li * NE * 1024 * 512, DE, (size_t)1024 * 512};
            pg8::MoeOrder Mo{offs + 40, offs[17 + 16], 4, F.G, (F.G % 8 == 0) ? (F.bid % 8) * (F.G / 8) + F.bid / 8 : F.bid};
            EpiMoe2 E{WSP(bf16_t, WS_A1)};
#ifndef SKIP_G4
            pg8::gemm_phase<EpiMoe2, pg8::MoeOrder>((LAS unsigned char*)smem, g, Mo, E, F.tid);
#ifdef PROBE_G4
            __syncthreads(); refresh(F); pg8::gemm_phase<EpiMoe2, pg8::MoeOrder>((LAS unsigned char*)smem, g, Mo, E, F.tid);
#endif
#endif
        }
        SEAM(p0 + 7);
    }
    if (IN(NPH - 1)) { refresh(F); phase_norm1(F, 1, 2); }
#ifdef PT_T
    asm volatile("s_waitcnt vmcnt(0)" ::: "memory"); __syncthreads();
    PT_MARK(NPH - 1);
#if PT_T >= 11
    xcd_barrier(bar);
    pt_acc = __hip_atomic_load((unsigned long long*)(F.ctl + 13000), __ATOMIC_RELAXED, __HIP_MEMORY_SCOPE_AGENT) / (unsigned long long)F.G;
    pt_last = __builtin_amdgcn_s_memrealtime();
#endif
    if (F.bid == 0) { const unsigned long long until = pt_last + (unsigned long long)PT_MULT * pt_acc;
        while (__builtin_amdgcn_s_memrealtime() < until) __builtin_amdgcn_s_sleep(8); }
#endif
#undef IN
#undef SEAM
}

extern "C" void kernel_launch(void* const* d_in, const int* in_sizes, int n_in, void* d_out, int out_size, void* d_ws, size_t ws_size, hipStream_t stream) {
    static int grid = 0;
    if (grid == 0) {
        if (n_in != N_IN || out_size != NLAT * D || ws_size < WS_END) { fprintf(stderr, "kernel_launch: unexpected shapes (n_in %d out %d ws %zu need %zu)\n", n_in, out_size, ws_size, (size_t)WS_END); grid = -1; return; }
        int dev = 0, cus = 0, per_cu = 0;
        if (hipGetDevice(&dev) != hipSuccess || hipDeviceGetAttribute(&cus, hipDeviceAttributeMultiprocessorCount, dev) != hipSuccess) { grid = -1; return; }
        if (hipFuncSetAttribute((const void*)mega, hipFuncAttributeMaxDynamicSharedMemorySize, LDS_BYTES) != hipSuccess) { fprintf(stderr, "kernel_launch: hipFuncSetAttribute failed\n"); grid = -1; return; }
        if (hipOccupancyMaxActiveBlocksPerMultiprocessor(&per_cu, (const void*)mega, NTHR, LDS_BYTES) != hipSuccess || per_cu < 1) { fprintf(stderr, "kernel_launch: occupancy query says %d\n", per_cu); }
        (void)hipGetLastError();
        grid = cus < MAXG ? cus : MAXG;
    }
    if (grid < 0) return;
    (void)hipMemsetAsync((char*)d_ws + WS_CTL, 0, CTL_BYTES, stream);
    Args a{};
    for (int i = 0; i < N_IN; ++i) a.in[i] = (const float*)d_in[i];
    a.out = (float*)d_out; a.ws = (unsigned char*)d_ws;
#if N_LAUNCH_MODE == 1
    a.ph_lo = 0; a.ph_hi = NPH;
    hipLaunchKernelGGL(mega, dim3(grid), dim3(NTHR), LDS_BYTES, stream, a);
#else
    for (int p = 0; p < NPH; ++p) { a.ph_lo = p; a.ph_hi = p + 1; hipLaunchKernelGGL(mega, dim3(grid), dim3(NTHR), LDS_BYTES, stream, a); }
#endif
}
#ifdef TEST_UNITS
__global__ void __launch_bounds__(NTHR, 2) t_da(Args args) {
    extern __shared__ __attribute__((aligned(16))) unsigned char smem[];
    Frame F; F.in = args.in; F.out = args.out; F.ws = args.ws; F.ctl = (unsigned*)(args.ws + WS_CTL); F.lds = smem; F.G = gridDim.x; F.bid = blockIdx.x; refresh(F);
    diffattn_unit(F, args.ph_lo, blockIdx.x >> 8, (blockIdx.x >> 6) & 3, (size_t)(blockIdx.x & 63) * 256, NKEY / 128);
}
__global__ void __launch_bounds__(NTHR, 2) t_hy(Args args) {
    extern __shared__ __attribute__((aligned(16))) unsigned char smem[];
    Frame F; F.in = args.in; F.out = args.out; F.ws = args.ws; F.ctl = (unsigned*)(args.ws + WS_CTL); F.lds = smem; F.G = gridDim.x; F.bid = blockIdx.x; refresh(F);
    hyena_fft_unit(F, args.ph_lo, blockIdx.x);
}
#endif
```

```cpp
#include <hip/hip_runtime.h>
#include <stdint.h>
#include <stdio.h>

#ifndef N_LAUNCH_MODE
#define N_LAUNCH_MODE 1
#endif

#define DI __device__ __forceinline__
#define LAS __attribute__((address_space(3)))
typedef unsigned short bf16_t;
typedef short bf16x8 __attribute__((ext_vector_type(8)));
typedef short s16x4 __attribute__((ext_vector_type(4)));
typedef float f32x4 __attribute__((ext_vector_type(4)));
typedef float f32x2 __attribute__((ext_vector_type(2)));
typedef float f32x16 __attribute__((ext_vector_type(16)));
typedef float f32x8 __attribute__((ext_vector_type(8)));
typedef unsigned u32x4 __attribute__((ext_vector_type(4)));
typedef unsigned u32x2 __attribute__((ext_vector_type(2)));
typedef _Float16 h16x2 __attribute__((ext_vector_type(2)));

constexpr int D = 1024, NB = 2, S = 16384, CTX = 256, NLAT = NB * S, NCTX = NB * CTX, NTOK = NLAT + NCTX, DIN = 2560;
constexpr int NE = 16, DE = 512, GW = 64;
constexpr int NKEY = CTX + S;
constexpr int NTHR = 512;
constexpr int SLOT_CAP = 70656;
constexpr float EPS = 1e-6f;
constexpr float LOG2E = 1.4426950408889634f;
constexpr float QSCALE_A = 0.17677669529663687f * LOG2E;
constexpr float QSCALE_B = 0.125f * LOG2E;

enum { I_X = 0, I_C, I_CTX, I_CCTX, I_N1G, I_N2G, I_ADAW, I_ADAB, I_WIN, I_WOUT, I_ALAM, I_ASUB, I_RPB, I_POOLW, I_POOLS, I_HYSW, I_HYSB,
       I_HW1, I_HB1, I_HW2, I_HB2, I_HW3, I_HB3, I_HSKIP, I_RW, I_RB, I_MW1, I_MW3, I_MW2, I_FG, N_IN };

struct Args { const float* in[N_IN]; float* out; unsigned char* ws; int ph_lo, ph_hi; };

constexpr size_t al256(size_t x) { return (x + 255) & ~(size_t)255; }
constexpr size_t WS_CTL = 0, CTL_BYTES = 65536;
constexpr size_t WS_MOD = WS_CTL + CTL_BYTES;
constexpr size_t WS_ROPE = WS_MOD + al256(2 * 3 * 6144 * 4);
constexpr size_t WS_PWT = WS_ROPE + 16384;
constexpr size_t WS_FPART = WS_PWT + 65536;
constexpr size_t WS_FPARTC = WS_FPART + 256 * 1024 * 4;
constexpr size_t WS_XC = WS_FPARTC + 4 * 1024 * 4;
constexpr size_t WS_WIN = WS_XC + (size_t)NCTX * D * 4;
constexpr size_t WS_WOUT = WS_WIN + (size_t)2 * DIN * D * 2;
constexpr size_t WS_W13 = WS_WOUT + (size_t)2 * D * D * 2;
constexpr size_t WS_W2 = WS_W13 + (size_t)2 * NE * 1024 * 1024 * 2;
constexpr size_t WS_FILT = WS_W2 + (size_t)2 * NE * 1024 * 512 * 2;
constexpr size_t WS_FILTC = WS_FILT + (size_t)4 * 256 * S * 4;
constexpr size_t WS_ZBUF = WS_FILTC + (size_t)4 * 256 * 256 * 4;
constexpr size_t WS_R1 = WS_ZBUF + (size_t)256 * 2 * S * 4;
constexpr size_t WS_HBF = WS_R1;
constexpr size_t TOKB = (size_t)NTOK * 256 * 2;
constexpr size_t WS_AQ = WS_HBF + (size_t)NTOK * D * 2;
constexpr size_t WS_AK = WS_AQ + TOKB;
constexpr size_t WS_AVT = WS_AK + TOKB;
constexpr size_t WS_BQ = WS_AVT + (size_t)NB * 4 * 64 * NKEY * 2;
constexpr size_t WS_BK = WS_BQ + TOKB;
constexpr size_t WS_BVT = WS_BK + TOKB;
constexpr size_t WS_PL = WS_BVT + (size_t)NB * 4 * 64 * NKEY * 2;
constexpr size_t WS_HYT = WS_PL + TOKB;
constexpr size_t WS_HYC = WS_HYT + (size_t)NB * 768 * S * 2;
constexpr size_t WS_Z1BUF = WS_HYC + (size_t)NCTX * 768 * 2;
constexpr size_t WS_END_MIX = WS_Z1BUF + (size_t)256 * S * 8;
constexpr size_t WS_TOK = WS_AQ;
constexpr size_t WS_A1 = WS_TOK + al256((size_t)NTOK * 32);
constexpr size_t WS_HMID = WS_A1 + (size_t)SLOT_CAP * D * 2;
constexpr size_t WS_END_MOE = WS_HMID + (size_t)SLOT_CAP * DE * 2;
constexpr size_t WS_END = WS_END_MIX > WS_END_MOE ? WS_END_MIX : WS_END_MOE;

#define XB_TMO      128
#define XB_XCNT(j)  (256  + 64 * (j))
#define XB_XSUB(j)  (1280 + 64 * (j))
#define XB_XGEN(j)  (2304 + 64 * (j))
#define XB_TOP      3328
#define XB_TOPGEN   3392
#define XCD_BAR_WORDS 3456
#define XB_SPIN_CAP (1u << 18)
constexpr int CW_CNT = 4096;
constexpr int CW_KMAX = 4160;
constexpr int CW_KMAXB = 4192;
constexpr int CW_QHEAD = 4224;
constexpr int CW_BCNT = 4352;
constexpr int MAXG = 256;

constexpr int LDS_MAIN = 147456, LDS_MISC = LDS_MAIN, LDS_BYTES = LDS_MAIN + 2048;

DI float bf2f(bf16_t v) { return __uint_as_float(((unsigned)v) << 16); }
DI bf16_t f2bf(float f) { unsigned u = __float_as_uint(f); u += 0x7FFFu + ((u >> 16) & 1u); return (bf16_t)(u >> 16); }
DI unsigned pk2(float lo, float hi) { unsigned r; asm volatile("v_cvt_pk_bf16_f32 %0, %1, %2" : "=v"(r) : "v"(lo), "v"(hi)); return r; }
template <int K> DI float swz_xor(float v) { return __int_as_float(__builtin_amdgcn_ds_swizzle(__float_as_int(v), (K << 10) | 0x1F)); }
DI float half_sum(float v) { const auto r = __builtin_amdgcn_permlane32_swap(__float_as_uint(v), __float_as_uint(v), false, false); return __uint_as_float(r[0]) + __uint_as_float(r[1]); }
DI float half_max(float v) { const auto r = __builtin_amdgcn_permlane32_swap(__float_as_uint(v), __float_as_uint(v), false, false); return fmaxf(__uint_as_float(r[0]), __uint_as_float(r[1])); }
DI float wave_sum(float v) { v += swz_xor<16>(v); v += swz_xor<8>(v); v += swz_xor<4>(v); v += swz_xor<2>(v); v += swz_xor<1>(v); return half_sum(v); }
DI float wave_max(float v) { v = fmaxf(v, swz_xor<16>(v)); v = fmaxf(v, swz_xor<8>(v)); v = fmaxf(v, swz_xor<4>(v)); v = fmaxf(v, swz_xor<2>(v)); v = fmaxf(v, swz_xor<1>(v)); return half_max(v); }
DI float siluf(float x) { return x * __builtin_amdgcn_rcpf(1.f + __expf(-x)); }
DI float sin_rev(float rev) { return __builtin_amdgcn_sinf(rev - floorf(rev)); }
DI float cos_rev(float rev) { return __builtin_amdgcn_cosf(rev - floorf(rev)); }
DI float sin_rad(float x) { return sin_rev(x * 0.15915494309189535f); }

DI unsigned xb_ld(unsigned* p)              { return __hip_atomic_load(p, __ATOMIC_RELAXED, __HIP_MEMORY_SCOPE_AGENT); }
DI unsigned xb_add(unsigned* p, unsigned v) { return __hip_atomic_fetch_add(p, v, __ATOMIC_RELAXED, __HIP_MEMORY_SCOPE_AGENT); }
DI unsigned xb_xcc_id() { return (unsigned)__builtin_amdgcn_s_getreg((3 << 11) | 20) & 0xFu; }
#define XB_SPIN(cond, bar) do { unsigned _sp = 0; while (cond) { __builtin_amdgcn_s_sleep(1); \
    if ((++_sp & 255u) == 0u) { if (xb_ld(&(bar)[XB_TMO])) break; if (_sp > XB_SPIN_CAP) { atomicAdd(&(bar)[XB_TMO], 1u); break; } } } } while (0)
struct XcdBarrier { unsigned* bar; unsigned x; volatile LAS unsigned* st; };
DI XcdBarrier xcd_barrier_post(unsigned* bar, volatile LAS unsigned* st) {
    XcdBarrier b; b.bar = bar; b.x = xb_xcc_id(); b.st = st;
    if (threadIdx.x == 0) (void)xb_add(&bar[XB_XCNT(b.x)], 1u);
    return b;
}
DI void xcd_barrier_complete(unsigned* bar, unsigned x, unsigned& nloc, unsigned& nx) {
    const unsigned G = gridDim.x * gridDim.y * gridDim.z;
    unsigned sum, cnt, mine, sp = 0u;
    for (;;) {
        sum = 0u; cnt = 0u; mine = 0u;
#pragma unroll
        for (unsigned j = 0; j < 16; ++j) { const unsigned c = xb_ld(&bar[XB_XCNT(j)]); sum += c; cnt += (c > 0u) ? 1u : 0u; mine = (j == x) ? c : mine; }
        if (sum == G) break;
        __builtin_amdgcn_s_sleep(1);
        if ((++sp & 255u) == 0u) { if (xb_ld(&bar[XB_TMO])) break; if (sp > XB_SPIN_CAP) { atomicAdd(&bar[XB_TMO], 1u); break; } }
    }
    nloc = mine > 0u ? mine : 1u; nx = cnt > 0u ? cnt : 1u;
}
DI void xcd_barrier(const XcdBarrier& b) {
    asm volatile("s_waitcnt vmcnt(0)" ::: "memory");
    __syncthreads();
    if (threadIdx.x == 0) {
        unsigned* bar = b.bar;
        __builtin_amdgcn_s_waitcnt(0);
        unsigned nloc = b.st[0], nx = b.st[1];
        if (nloc == 0u) { xcd_barrier_complete(bar, b.x, nloc, nx); b.st[0] = nloc; b.st[1] = nx; }
        const unsigned old = xb_add(&bar[XB_XSUB(b.x)], 1u);
        const unsigned gen = old / nloc;
        if (old + 1u == (gen + 1u) * nloc) {
            __builtin_amdgcn_fence(__ATOMIC_RELEASE, "agent");
            asm volatile("s_waitcnt vmcnt(0)" ::: "memory");
            const unsigned og = xb_add(&bar[XB_TOP], 1u);
            const unsigned tg = og / nx;
            if (og + 1u == (tg + 1u) * nx) xb_add(&bar[XB_TOPGEN], 1u);
            else XB_SPIN(xb_ld(&bar[XB_TOPGEN]) == tg, bar);
            __builtin_amdgcn_fence(__ATOMIC_ACQUIRE, "agent");
            xb_add(&bar[XB_XGEN(b.x)], 1u);
            asm volatile("s_waitcnt vmcnt(0)" ::: "memory");
        } else {
            XB_SPIN(xb_ld(&bar[XB_XGEN(b.x)]) == gen, bar);
            __builtin_amdgcn_fence(__ATOMIC_ACQUIRE, "agent");
            asm volatile("s_waitcnt vmcnt(0)" ::: "memory");
        }
    }
    __syncthreads();
}

struct Frame {
    const float* const* in; float* out; unsigned char* ws; unsigned* ctl;
    unsigned char* lds;
    int tid, lane, wave, G, bid;
};
#define WSP(T, off) ((T*)(F.ws + (off)))
DI void refresh(Frame& F) { int t = threadIdx.x; asm volatile("" : "+v"(t)); F.tid = t; F.lane = t & 63; F.wave = __builtin_amdgcn_readfirstlane(t >> 6);
}

namespace pg8 {
constexpr int BM = 256, BK = 64, HALF = 128, HTB = HALF * BK * 2, STAGE_BYTES = 8 * HTB, NXCD = 8, WGM = 8;
DI int lds_byte(int r, int c) { const int st = (r >> 4) * 2 + (c >> 5), rr = r & 15, cc = c & 31, ob = rr * 64 + cc * 2; return st * 1024 + (ob ^ (((ob >> 9) & 1) << 5)); }
DI void stage_rc(int b, int& R, int& C) { const int st = b / 1024, sb = b % 1024, swz = sb ^ (((sb >> 9) & 1) << 5); R = (st >> 1) * 16 + swz / 64; C = (st & 1) * 32 + (swz % 64) / 2; }
struct Unit { int pm, pn, e; };
struct Gemm { const bf16_t* A; const bf16_t* Bt; int K; size_t bstride; };
struct StaticOrder {
    int nM, nN, nwg, G, c;
    DI void init(int M, int N, int G_, int c_) { nM = M / BM; nN = N / BM; nwg = nM * nN; G = G_; c = c_; }
    DI bool next(int i, Unit& u) const {
        const long L = (long)i * G + c; if (L >= nwg) return false;
        int wgid = (int)L; { const int q = nwg / NXCD, r = nwg % NXCD, xcd = wgid % NXCD, off = wgid / NXCD; wgid = (xcd < r ? xcd * (q + 1) : r * (q + 1) + (xcd - r) * q) + off; }
        const int nig = WGM * nN, gid = wgid / nig, fm = gid * WGM, gsz = (nM - fm) < WGM ? (nM - fm) : WGM;
        u.pm = fm + ((wgid % nig) % gsz); u.pn = (wgid % nig) / gsz; u.e = 0; return true;
    }
};
struct MoeOrder {
    const int* toff; int ntile, nN, G, c;
    DI bool next(int i, Unit& u) const {
        const long L = (long)i * G + c; if (L >= (long)ntile * nN) return false;
        const int t = (int)(L / nN); u.pm = t; u.pn = (int)(L % nN);
        u.e = toff[t]; return true;
    }
};

template <class Epi, class Sched>
DI void gemm_phase(LAS unsigned char* lds, const Gemm g, const Sched& S, const Epi& E, int tid) {
    const int wid = __builtin_amdgcn_readfirstlane(tid >> 6), lane = tid & 63, wr = wid >> 2, wc = wid & 3, fr = lane & 15, fq = lane >> 4;
    const int K = g.K, nt = K / BK;
    unsigned voffA[2];
#pragma unroll
    for (int i = 0; i < 2; ++i) { int R, C; stage_rc(tid * 16 + i * 8192, R, C); voffA[i] = (unsigned)(R * K + C) * 2u; }
    const size_t kstep = (size_t)(BK * 2);
    const size_t hstep = (size_t)HALF * K * 2;
    const size_t tstep = 2 * hstep;
    const unsigned ldsw = (unsigned)wid * 1024u;
    const int aoff = lds_byte(wr * 64 + fr, fq * 8), boff = lds_byte(wc * 32 + fr, fq * 8);
#define PG8_SA(b, h) (((b) * 2 + (h)) * HTB)
#define PG8_SB(b, h) ((4 + (b) * 2 + (h)) * HTB)
#define PG8_STAGE(bufoff, gbase, voff) do { _Pragma("unroll") for (int _i = 0; _i < 2; ++_i) \
        __builtin_amdgcn_global_load_lds((const unsigned*)((const char*)(gbase) + (voff)[_i]), (LAS unsigned*)(lds + (bufoff) + ldsw + _i * 8192), 16, 0, 0); } while (0)
#define PG8_LDA(dst, b, h) do { _Pragma("unroll") for (int m = 0; m < 4; ++m) _Pragma("unroll") for (int k = 0; k < 2; ++k) dst[m][k] = *(const LAS bf16x8*)(lds + PG8_SA(b, h) + aoff + m * 2048 + k * 1024); } while (0)
#define PG8_LDB(dst, b, h) do { _Pragma("unroll") for (int n = 0; n < 2; ++n) _Pragma("unroll") for (int k = 0; k < 2; ++k) dst[n][k] = *(const LAS bf16x8*)(lds + PG8_SB(b, h) + boff + n * 2048 + k * 1024); } while (0)
#define PG8_MMA(ai, bj, At, Bt) do { __builtin_amdgcn_s_setprio(1); _Pragma("unroll") for (int m = 0; m < 4; ++m) _Pragma("unroll") for (int n = 0; n < 2; ++n) _Pragma("unroll") for (int k = 0; k < 2; ++k) \
        acc[ai][bj][m][n] = __builtin_amdgcn_mfma_f32_16x16x32_bf16(Bt[n][k], At[m][k], acc[ai][bj][m][n], 0, 0, 0); __builtin_amdgcn_s_setprio(0); } while (0)
#define PG8_WAIT_V(n) asm volatile("s_waitcnt vmcnt(" #n ")" ::: "memory")
#define PG8_WAIT_L(n) asm volatile("s_waitcnt lgkmcnt(" #n ")" ::: "memory")
#define PG8_BAR __builtin_amdgcn_s_barrier()
#define PG8_SCHED __builtin_amdgcn_sched_barrier(0)
    Unit cur, nxt; int ui = 0;
    if (!S.next(0, cur)) return;
    f32x4 acc[2][2][4][2];
#pragma unroll
    for (int a = 0; a < 2; ++a)
#pragma unroll
        for (int b = 0; b < 2; ++b)
#pragma unroll
            for (int m = 0; m < 4; ++m)
#pragma unroll
                for (int n = 0; n < 2; ++n) acc[a][b][m][n] = (f32x4){0.f, 0.f, 0.f, 0.f};
    bf16x8 At[4][2], B0[2][2], B1[2][2];
    const char* cA = (const char*)g.A + (size_t)cur.pm * tstep; const char* cB = (const char*)(g.Bt + (size_t)cur.e * g.bstride) + (size_t)cur.pn * tstep;
    PG8_STAGE(PG8_SB(0, 0), cB, voffA); PG8_STAGE(PG8_SA(0, 0), cA, voffA); PG8_STAGE(PG8_SB(0, 1), cB + hstep, voffA); PG8_STAGE(PG8_SA(0, 1), cA + hstep, voffA);
    if (wr == 1) PG8_BAR;
    PG8_WAIT_V(4); PG8_BAR;
    PG8_STAGE(PG8_SB(1, 0), cB + kstep, voffA); PG8_STAGE(PG8_SA(1, 0), cA + kstep, voffA); PG8_STAGE(PG8_SB(1, 1), cB + hstep + kstep, voffA);
    PG8_WAIT_V(6); PG8_BAR;
    for (;;) {
        const bool has_next = S.next(ui + 1, nxt);
        const char* nA = has_next ? (const char*)g.A + (size_t)nxt.pm * tstep : cA; const char* nB = has_next ? (const char*)(g.Bt + (size_t)nxt.e * g.bstride) + (size_t)nxt.pn * tstep : cB;
        for (int t = 0; t < nt; t += 2) {
            const bool last = (t == nt - 2);
            const char* a1 = cA + (size_t)(t + 1) * kstep;
            const char* a2 = last ? nA : cA + (size_t)(t + 2) * kstep; const char* b2 = last ? nB : cB + (size_t)(t + 2) * kstep;
            const char* a3 = a2 + kstep; const char* b3 = b2 + kstep;
            PG8_LDB(B0, 0, 0); PG8_SCHED; PG8_LDA(At, 0, 0); PG8_STAGE(PG8_SA(1, 1), a1 + hstep, voffA);
            PG8_WAIT_L(8); PG8_BAR; PG8_WAIT_L(0); PG8_MMA(0, 0, At, B0); PG8_BAR; PG8_SCHED;
            PG8_LDB(B1, 0, 1); PG8_STAGE(PG8_SB(0, 0), b2, voffA);
            PG8_BAR; PG8_WAIT_L(0); PG8_MMA(0, 1, At, B1); PG8_BAR;
            PG8_LDA(At, 0, 1); PG8_STAGE(PG8_SA(0, 0), a2, voffA);
            PG8_BAR; PG8_WAIT_L(0); PG8_MMA(1, 0, At, B0); PG8_BAR; PG8_SCHED;
            PG8_STAGE(PG8_SB(0, 1), b2 + hstep, voffA);
            PG8_WAIT_V(6); PG8_BAR; PG8_MMA(1, 1, At, B1); PG8_BAR;
            PG8_LDB(B0, 1, 0); PG8_SCHED; PG8_LDA(At, 1, 0); PG8_STAGE(PG8_SA(0, 1), a2 + hstep, voffA);
            PG8_WAIT_L(8); PG8_BAR; PG8_WAIT_L(0); PG8_MMA(0, 0, At, B0); PG8_BAR; PG8_SCHED;
            PG8_LDB(B1, 1, 1); PG8_STAGE(PG8_SB(1, 0), b3, voffA);
            PG8_BAR; PG8_WAIT_L(0); PG8_MMA(0, 1, At, B1); PG8_BAR;
            PG8_LDA(At, 1, 1); PG8_STAGE(PG8_SA(1, 0), a3, voffA);
            PG8_BAR; PG8_WAIT_L(0); PG8_MMA(1, 0, At, B0); PG8_BAR; PG8_SCHED;
            PG8_STAGE(PG8_SB(1, 1), b3 + hstep, voffA);
            PG8_WAIT_V(6); PG8_BAR; PG8_MMA(1, 1, At, B1); PG8_BAR;
        }
        E(acc, cur, wr, wc, fr, fq);
        if (!has_next) break;
#pragma unroll
        for (int a = 0; a < 2; ++a)
#pragma unroll
            for (int b = 0; b < 2; ++b)
#pragma unroll
                for (int m = 0; m < 4; ++m)
#pragma unroll
                    for (int n = 0; n < 2; ++n) acc[a][b][m][n] = (f32x4){0.f, 0.f, 0.f, 0.f};
        cur = nxt; cA = nA; cB = nB; ++ui;
    }
    PG8_WAIT_V(0);
    if (wr == 0) PG8_BAR;
    PG8_BAR;
#undef PG8_SA
#undef PG8_SB
#undef PG8_STAGE
#undef PG8_LDA
#undef PG8_LDB
#undef PG8_MMA
#undef PG8_WAIT_V
#undef PG8_WAIT_L
#undef PG8_BAR
#undef PG8_SCHED
}
}

typedef f32x4 AccT[2][2][4][2];

struct EpiIn {
    unsigned char* ws; const float* rope; unsigned* kmax; unsigned* kmaxb;
    DI void operator()(const AccT& acc, const pg8::Unit& u, int wr, int wc, int fr, int fq) const {
        const int pn = u.pn, row0 = u.pm * 256 + wr * 64 + fr;
        const bool isctx = (u.pm >= NLAT / 256);
        if (pn <= 1) {
            bf16_t* dst = (bf16_t*)(ws + (pn == 0 ? WS_AQ : WS_AK));
            const float sc = (pn == 0) ? QSCALE_A : 1.f;
            float nmax[2] = {0.f, 0.f};
#pragma unroll
            for (int ai = 0; ai < 2; ++ai)
#pragma unroll
                for (int m = 0; m < 4; ++m) {
                    const int r = row0 + ai * 128 + m * 16;
                    f32x4 cs0 = (f32x4){1.f, 0.f, 1.f, 0.f}, cs1 = cs0;
                    if (!isctx) { const int t = r & (S - 1); const int pos = (fq < 2) ? (t >> 6) : (t & 63);
                        const f32x4* tp = (const f32x4*)(rope + (size_t)pos * 16 + (fq & 1) * 8); cs0 = tp[0]; cs1 = tp[1]; }
                    const float cc[4] = {cs0[0], cs0[2], cs1[0], cs1[2]}, ss[4] = {cs0[1], cs0[3], cs1[1], cs1[3]};
#pragma unroll
                    for (int bj = 0; bj < 2; ++bj) {
                        const f32x4 x1 = acc[ai][bj][m][0], x2 = acc[ai][bj][m][1];
                        float o1[4], o2[4], n2 = 0.f;
#pragma unroll
                        for (int j = 0; j < 4; ++j) { o1[j] = (x1[j] * cc[j] - x2[j] * ss[j]) * sc; o2[j] = (x2[j] * cc[j] + x1[j] * ss[j]) * sc; n2 += x1[j] * x1[j] + x2[j] * x2[j]; }
                        bf16_t* p = dst + (size_t)r * 256 + bj * 128 + wc * 32 + 4 * fq;
                        *(u32x2*)p = (u32x2){pk2(o1[0], o1[1]), pk2(o1[2], o1[3])};
                        *(u32x2*)(p + 16) = (u32x2){pk2(o2[0], o2[1]), pk2(o2[2], o2[3])};
                        if (pn == 1) { n2 += swz_xor<16>(n2); n2 = half_sum(n2); nmax[bj] = fmaxf(nmax[bj], n2); }
                    }
                }
            if (pn == 1) {
                const int b = isctx ? (u.pm - NLAT / 256) : (u.pm / (S / 256));
#pragma unroll
                for (int bj = 0; bj < 2; ++bj) {
                    float v = nmax[bj];
                    v = fmaxf(v, swz_xor<1>(v)); v = fmaxf(v, swz_xor<2>(v)); v = fmaxf(v, swz_xor<4>(v)); v = fmaxf(v, swz_xor<8>(v));
                    if ((fr | fq) == 0) atomicMax(kmax + (b * 4 + (2 * bj + (wc >> 1))) * 2 + (wc & 1), __float_as_uint(v));
                }
            }
        } else if (pn == 2 || pn == 5) {
            bf16_t* dst = (bf16_t*)(ws + (pn == 2 ? WS_AVT : WS_BVT));
#pragma unroll
            for (int ai = 0; ai < 2; ++ai)
#pragma unroll
                for (int m = 0; m < 4; ++m) {
                    const int r = row0 + ai * 128 + m * 16;
                    int b, key; if (isctx) { b = (r - NLAT) >> 8; key = (r - NLAT) & 255; } else { b = r >> 14; key = CTX + (r & (S - 1)); }
#pragma unroll
                    for (int bj = 0; bj < 2; ++bj)
#pragma unroll
                        for (int n = 0; n < 2; ++n) {
                            const int lc = bj * 128 + wc * 32 + n * 16 + 4 * fq;
#pragma unroll
                            for (int j = 0; j < 4; ++j) dst[((size_t)(b * 256 + lc + j)) * NKEY + key] = f2bf(acc[ai][bj][m][n][j]);
                        }
                }
        } else if (pn <= 6) {
            bf16_t* dst = (bf16_t*)(ws + (pn == 3 ? WS_BQ : pn == 4 ? WS_BK : WS_PL));
            const float sc = (pn == 3) ? QSCALE_B : 1.f;
            float nmax[2] = {0.f, 0.f};
#pragma unroll
            for (int ai = 0; ai < 2; ++ai)
#pragma unroll
                for (int m = 0; m < 4; ++m) {
                    const int r = row0 + ai * 128 + m * 16;
#pragma unroll
                    for (int bj = 0; bj < 2; ++bj)
#pragma unroll
                        for (int n = 0; n < 2; ++n) {
                            const f32x4 v = acc[ai][bj][m][n] * sc;
                            *(u32x2*)(dst + (size_t)r * 256 + bj * 128 + wc * 32 + n * 16 + 4 * fq) = (u32x2){pk2(v[0], v[1]), pk2(v[2], v[3])};
                        }
                    if (pn == 4) {
#pragma unroll
                        for (int bj = 0; bj < 2; ++bj) { const f32x4 x1 = acc[ai][bj][m][0], x2 = acc[ai][bj][m][1];
                            float n2 = x1[0] * x1[0] + x1[1] * x1[1] + x1[2] * x1[2] + x1[3] * x1[3] + x2[0] * x2[0] + x2[1] * x2[1] + x2[2] * x2[2] + x2[3] * x2[3];
                            n2 += swz_xor<16>(n2); n2 = half_sum(n2); nmax[bj] = fmaxf(nmax[bj], n2); }
                    }
                }
            if (pn == 4) {
                const int b = isctx ? (u.pm - NLAT / 256) : (u.pm / (S / 256));
#pragma unroll
                for (int bj = 0; bj < 2; ++bj) {
                    float v = nmax[bj];
                    v = fmaxf(v, swz_xor<1>(v)); v = fmaxf(v, swz_xor<2>(v)); v = fmaxf(v, swz_xor<4>(v)); v = fmaxf(v, swz_xor<8>(v));
                    if ((fr | fq) == 0) atomicMax(kmaxb + (b * 4 + (2 * bj + (wc >> 1))) * 2 + (wc & 1), __float_as_uint(v));
                }
            }
        } else {
            const int hc0 = (pn - 7) * 256;
#pragma unroll
            for (int ai = 0; ai < 2; ++ai)
#pragma unroll
                for (int m = 0; m < 4; ++m) {
                    const int r = row0 + ai * 128 + m * 16;
#pragma unroll
                    for (int bj = 0; bj < 2; ++bj)
#pragma unroll
                        for (int n = 0; n < 2; ++n) {
                            const int hc = hc0 + bj * 128 + wc * 32 + n * 16 + 4 * fq; const f32x4 v = acc[ai][bj][m][n];
                            if (isctx) *(u32x2*)((bf16_t*)(ws + WS_HYC) + (size_t)(r - NLAT) * 768 + hc) = (u32x2){pk2(v[0], v[1]), pk2(v[2], v[3])};
                            else { bf16_t* dst = (bf16_t*)(ws + WS_HYT) + ((size_t)(r >> 14) * 768 + hc) * S + (r & (S - 1));
#pragma unroll
                                for (int j = 0; j < 4; ++j) dst[(size_t)j * S] = f2bf(v[j]); }
                        }
                }
        }
    }
};

struct EpiOut {
    const float* xl_old; const float* xc_old; float* xl_new; float* xc_new; const float* mod;
    DI void operator()(const AccT& acc, const pg8::Unit& u, int wr, int wc, int fr, int fq) const {
        const int row0 = u.pm * 256 + wr * 64 + fr; const bool isctx = (u.pm >= NLAT / 256);
        const int v = isctx ? 2 : (u.pm / (S / 256));
        const float* g1 = mod + (size_t)v * 6144 + 2 * 1024;
        const float* so = isctx ? xc_old - (size_t)NLAT * D : xl_old; float* dn = isctx ? xc_new - (size_t)NLAT * D : xl_new;
#pragma unroll
        for (int bj = 0; bj < 2; ++bj)
#pragma unroll
            for (int n = 0; n < 2; ++n) {
                const int c = u.pn * 256 + bj * 128 + wc * 32 + n * 16 + 4 * fq;
                const f32x4 g = *(const f32x4*)(g1 + c);
#pragma unroll
                for (int ai = 0; ai < 2; ++ai)
#pragma unroll
                    for (int m = 0; m < 4; ++m) {
                        const size_t o = (size_t)(row0 + ai * 128 + m * 16) * D + c;
                        *(f32x4*)(dn + o) = *(const f32x4*)(so + o) + g * acc[ai][bj][m][n];
                    }
            }
    }
};

struct EpiMoe1 {
    bf16_t* hmid;
    DI void operator()(const AccT& acc, const pg8::Unit& u, int wr, int wc, int fr, int fq) const {
        const int row0 = u.pm * 256 + wr * 64 + fr;
#pragma unroll
        for (int ai = 0; ai < 2; ++ai)
#pragma unroll
            for (int m = 0; m < 4; ++m)
#pragma unroll
                for (int bj = 0; bj < 2; ++bj) {
                    const f32x4 a = acc[ai][bj][m][0], b = acc[ai][bj][m][1]; float h[4];
#pragma unroll
                    for (int j = 0; j < 4; ++j) h[j] = siluf(a[j]) * b[j];
                    *(u32x2*)(hmid + (size_t)(row0 + ai * 128 + m * 16) * DE + (u.pn * 256 + bj * 128 + wc * 32) / 2 + 4 * fq) = (u32x2){pk2(h[0], h[1]), pk2(h[2], h[3])};
                }
    }
};
struct EpiMoe2 {
    bf16_t* ys;
    DI void operator()(const AccT& acc, const pg8::Unit& u, int wr, int wc, int fr, int fq) const {
        const int row0 = u.pm * 256 + wr * 64 + fr;
#pragma unroll
        for (int ai = 0; ai < 2; ++ai)
#pragma unroll
            for (int m = 0; m < 4; ++m)
#pragma unroll
                for (int bj = 0; bj < 2; ++bj)
#pragma unroll
                    for (int n = 0; n < 2; ++n) { const f32x4 v = acc[ai][bj][m][n];
                        *(u32x2*)(ys + (size_t)(row0 + ai * 128 + m * 16) * D + u.pn * 256 + bj * 128 + wc * 32 + n * 16 + 4 * fq) = (u32x2){pk2(v[0], v[1]), pk2(v[2], v[3])}; }
    }
};

DI void tconv_tile(const Frame& F, const float* src, int N, int k0, int n0, bf16_t* dst, int ldd, int mode) {
    float* tl = (float*)F.lds;
    __syncthreads();
#pragma unroll
    for (int i = 0; i < 8; ++i) { const int idx = F.tid + 512 * i, k = idx >> 6, n = idx & 63; tl[k * 65 + n] = src[(size_t)(k0 + k) * N + n0 + n]; }
    __syncthreads();
#pragma unroll
    for (int i = 0; i < 4; ++i) { const int idx = F.tid + 512 * i, n = idx >> 5, kp = idx & 31;
        const int nn = n0 + n; const int row = (mode == 0) ? nn : ((nn >> 4) * 32 + (mode - 1) * 16 + (nn & 15));
        *(unsigned*)(dst + (size_t)row * ldd + k0 + 2 * kp) = pk2(tl[(2 * kp) * 65 + n], tl[(2 * kp + 1) * 65 + n]); }
}
DI void phase_prologue(const Frame& F) {
    const int T_IN = 16 * 40, T_OUT = 16 * 16, T_E = 16 * 8;
    const int per_layer = T_IN + T_OUT + NE * 3 * T_E, total = 2 * per_layer;
    for (int u = F.bid; u < total; u += F.G) {
        const int li = u / per_layer; int r = u % per_layer;
        if (r < T_IN) { tconv_tile(F, F.in[I_WIN] + (size_t)li * D * DIN, DIN, (r / 40) * 64, (r % 40) * 64, WSP(bf16_t, WS_WIN) + (size_t)li * DIN * D, D, 0); continue; }
        r -= T_IN;
        if (r < T_OUT) { tconv_tile(F, F.in[I_WOUT] + (size_t)li * D * D, D, (r / 16) * 64, (r % 16) * 64, WSP(bf16_t, WS_WOUT) + (size_t)li * D * D, D, 0); continue; }
        r -= T_OUT;
        const int e = r / (3 * T_E), w = (r / T_E) % 3, t = r % T_E;
        if (w < 2) tconv_tile(F, F.in[w == 0 ? I_MW1 : I_MW3] + ((size_t)li * NE + e) * D * DE, DE, (t / 8) * 64, (t % 8) * 64, WSP(bf16_t, WS_W13) + ((size_t)li * NE + e) * 1024 * 1024, D, 1 + w);
        else tconv_tile(F, F.in[I_MW2] + ((size_t)li * NE + e) * DE * D, D, (t / 16) * 64, (t % 16) * 64, WSP(bf16_t, WS_W2) + ((size_t)li * NE + e) * 1024 * 512, DE, 0);
    }
    __syncthreads();
    {
        float* sc = (float*)F.lds;
        float* red = sc + 3072;
        for (int i = F.tid; i < 3072; i += NTHR) { const int v = i >> 10, k = i & 1023; const float x = (v < 2) ? F.in[I_C][v * 1024 + k] : F.in[I_CCTX][k]; sc[i] = siluf(x); }
        __syncthreads();
        for (int u = F.bid; u < 2 * 96; u += F.G) {
            const int li = u / 96, j = (u % 96) * 64 + F.lane, ko = F.wave;
            const float* w = F.in[I_ADAW] + (size_t)li * D * 6144 + j;
            float a0 = 0.f, a1 = 0.f, a2 = 0.f;
            for (int k = ko * 128; k < ko * 128 + 128; ++k) { const float wv = w[(size_t)k * 6144]; a0 += sc[k] * wv; a1 += sc[1024 + k] * wv; a2 += sc[2048 + k] * wv; }
            red[(ko * 3 + 0) * 64 + F.lane] = a0; red[(ko * 3 + 1) * 64 + F.lane] = a1; red[(ko * 3 + 2) * 64 + F.lane] = a2;
            __syncthreads();
            if (F.tid < 192) { const int v = F.tid / 64, l = F.tid % 64; float s = 0.f;
#pragma unroll
                for (int q = 0; q < 8; ++q) s += red[(q * 3 + v) * 64 + l];
                const int jj = (u % 96) * 64 + l;
                WSP(float, WS_MOD)[((size_t)li * 3 + v) * 6144 + jj] = s + F.in[I_ADAB][li * 6144 + jj]; }
            __syncthreads();
        }
    }
    if (F.bid == (F.G > 2 ? 2 : 0)) {
        for (int idx = F.tid; idx < 2 * 4 * 64 * 64; idx += NTHR) { const int i = idx & 63, j = (idx >> 6) & 63, lg = idx >> 12;
            WSP(bf16_t, WS_PWT)[idx] = f2bf(F.in[I_POOLW][((size_t)lg * 64 + i) * 64 + j]); }
    }
    if (F.bid == (F.G > 1 ? 1 : 0)) {
        for (int i = F.tid; i < 256 * 8; i += NTHR) { const int pos = i >> 3, f = i & 7; const float inv = exp2f(-(float)f * (13.287712379549449f / 8.f)); const float rev = (float)pos * inv * 0.15915494309189535f;
            WSP(float, WS_ROPE)[i * 2] = cos_rev(rev); WSP(float, WS_ROPE)[i * 2 + 1] = sin_rev(rev); }
    }
}

#define MFMA32(a, b, c) __builtin_amdgcn_mfma_f32_32x32x16_bf16((a), (b), (c), 0, 0, 0)
DI void filter_tile(const Frame& F, int li, int L, int tile, float* hT, float* part) {
    float* h1s = (float*)F.lds;
    float* h2s = h1s + 64 * 65;
    float* w1s = h2s + 64 * 68;
    float* w2s = w1s + 34 * 64;
    const float* w3 = F.in[I_HW3] + (size_t)li * 64 * 1024; const float* b3 = F.in[I_HB3] + li * 1024;
    const int t0 = tile * 64;
    const float inv_lm1 = 1.f / (float)(L > 1 ? L - 1 : 1);
    __syncthreads();
    {
        const float* w1 = F.in[I_HW1] + (size_t)li * 33 * 64; const float* b1 = F.in[I_HB1] + li * 64;
        const float* w2 = F.in[I_HW2] + (size_t)li * 64 * 64; const float* b2 = F.in[I_HB2] + li * 64;
        for (int i = F.tid; i < 33 * 64; i += NTHR) w1s[i] = w1[i];
        for (int i = F.tid; i < 4096; i += NTHR) w2s[i] = w2[i];
        if (F.tid < 64) { w1s[33 * 64 + F.tid] = b1[F.tid]; w2s[4096 + F.tid] = b2[F.tid]; }
    }
    __syncthreads();
    {
        const int tl = F.tid & 63, pt = F.tid >> 6; const float t = (float)(t0 + tl);
        float a[8];
#pragma unroll
        for (int jj = 0; jj < 8; ++jj) a[jj] = w1s[33 * 64 + pt * 8 + jj] + (t * inv_lm1) * w1s[pt * 8 + jj];
#pragma unroll 2
        for (int i = 0; i < 16; ++i) { const float band = 1e-4f + (15.f - 1e-4f) * (float)i / 15.f; const float rev = t * band / (float)L; const float cz = cos_rev(rev), sz = sin_rev(rev);
#pragma unroll
            for (int jj = 0; jj < 8; ++jj) a[jj] += cz * w1s[(1 + i) * 64 + pt * 8 + jj] + sz * w1s[(17 + i) * 64 + pt * 8 + jj]; }
#pragma unroll
        for (int jj = 0; jj < 8; ++jj) h1s[tl * 65 + pt * 8 + jj] = sin_rad(a[jj]);
    }
    __syncthreads();
    {
        const int tl = F.tid & 63, pt = F.tid >> 6;
        float a[8];
#pragma unroll
        for (int jj = 0; jj < 8; ++jj) a[jj] = w2s[4096 + pt * 8 + jj];
#pragma unroll 4
        for (int i = 0; i < 64; ++i) { const float hv = h1s[tl * 65 + i];
#pragma unroll
            for (int jj = 0; jj < 8; ++jj) a[jj] += hv * w2s[i * 64 + pt * 8 + jj]; }
#pragma unroll
        for (int jj = 0; jj < 8; ++jj) h2s[tl * 68 + pt * 8 + jj] = sin_rad(a[jj]);
    }
    __syncthreads();
    {
        const int l31 = F.lane & 31, kg = F.lane >> 5;
        auto split8 = [](const float (&x)[8], bf16x8& hi, bf16x8& lo) {
            u32x4 h, l;
#pragma unroll
            for (int e = 0; e < 4; ++e) { const unsigned hp = pk2(x[2 * e], x[2 * e + 1]); h[e] = hp;
                l[e] = pk2(x[2 * e] - __uint_as_float(hp << 16), x[2 * e + 1] - __uint_as_float(hp & 0xffff0000u)); }
            hi = __builtin_bit_cast(bf16x8, h); lo = __builtin_bit_cast(bf16x8, l); };
        bf16x8 Bh[2][4], Bl[2][4];
#pragma unroll
        for (int pb = 0; pb < 2; ++pb)
#pragma unroll
            for (int ks = 0; ks < 4; ++ks) { const float* hp = h2s + (pb * 32 + l31) * 68 + ks * 16 + kg * 8; const f32x4 x0 = *(const f32x4*)hp, x1 = *(const f32x4*)(hp + 4);
                const float x[8] = {x0[0], x0[1], x0[2], x0[3], x1[0], x1[1], x1[2], x1[3]}; split8(x, Bh[pb][ks], Bl[pb][ks]); }
        const float tn0 = (float)(t0 + l31) * inv_lm1, tn1 = (float)(t0 + 32 + l31) * inv_lm1;
        const bool b4 = (l31 & 16) != 0, b3q = (l31 & 8) != 0, b2 = (l31 & 4) != 0, b1q = (l31 & 2) != 0;
#pragma unroll 1
        for (int cb = 0; cb < 4; ++cb) {
            const int ch0 = F.wave * 128 + cb * 32;
            f32x16 acc0, acc1;
#pragma unroll
            for (int i = 0; i < 16; ++i) { acc0[i] = 0.f; acc1[i] = 0.f; }
#pragma unroll
            for (int ks = 0; ks < 4; ++ks) {
                float x[8];
#pragma unroll
                for (int e = 0; e < 8; ++e) x[e] = w3[(size_t)(ks * 16 + kg * 8 + e) * 1024 + ch0 + l31];
                bf16x8 Ah, Al; split8(x, Ah, Al);
                acc0 = MFMA32(Ah, Bh[0][ks], acc0); acc1 = MFMA32(Ah, Bh[1][ks], acc1);
                acc0 = MFMA32(Al, Bh[0][ks], acc0); acc1 = MFMA32(Al, Bh[1][ks], acc1);
                acc0 = MFMA32(Ah, Bl[0][ks], acc0); acc1 = MFMA32(Ah, Bl[1][ks], acc1);
            }
            float sq[16];
#pragma unroll
            for (int i = 0; i < 16; ++i) {
                const int ch = ch0 + 8 * (i >> 2) + 4 * kg + (i & 3);
                const float bb = b3[ch], delta = 3.0701134573253945f + (15.350567286626973f - 3.0701134573253945f) * (float)(ch & 255) / 255.f;
                const float v0 = (acc0[i] + bb) * __expf(-tn0 * delta), v1 = (acc1[i] + bb) * __expf(-tn1 * delta);
                float* hp = hT + (size_t)ch * L + t0 + l31; hp[0] = v0; hp[32] = v1;
                sq[i] = v0 * v0 + v1 * v1;
            }
            float a8[8], a4[4], a2[2];
#pragma unroll
            for (int e = 0; e < 8; ++e) { const float keep = b4 ? sq[e + 8] : sq[e], send = b4 ? sq[e] : sq[e + 8]; a8[e] = keep + swz_xor<16>(send); }
#pragma unroll
            for (int e = 0; e < 4; ++e) { const float keep = b3q ? a8[e + 4] : a8[e], send = b3q ? a8[e] : a8[e + 4]; a4[e] = keep + swz_xor<8>(send); }
#pragma unroll
            for (int e = 0; e < 2; ++e) { const float keep = b2 ? a4[e + 2] : a4[e], send = b2 ? a4[e] : a4[e + 2]; a2[e] = keep + swz_xor<4>(send); }
            float a1 = (b1q ? a2[1] : a2[0]) + swz_xor<2>(b1q ? a2[0] : a2[1]);
            a1 += swz_xor<1>(a1);
            const int rg = (b4 ? 8 : 0) + (b3q ? 4 : 0) + (b2 ? 2 : 0) + (b1q ? 1 : 0);
            if ((l31 & 1) == 0) part[(size_t)tile * 1024 + ch0 + 8 * (rg >> 2) + 4 * kg + (rg & 3)] = a1;
        }
    }
}

struct TokInfo { unsigned e0, e1, p0, p1; float g0, g1; unsigned s0, s1; };
DI void phase_norm1(const Frame& F, int li, int mode) {
    const int nrows = (mode == 2) ? NLAT : NTOK;
    const float* modp = WSP(float, WS_MOD) + (size_t)li * 3 * 6144;
    const float* modprev = WSP(float, WS_MOD) + (size_t)(mode == 2 ? 1 : li - 1) * 3 * 6144;
    const float* gam = (mode == 2) ? F.in[I_FG] : F.in[I_N1G] + (size_t)li * D;
    const TokInfo* tok = WSP(TokInfo, WS_TOK); const bf16_t* ys = WSP(bf16_t, WS_A1);
    bf16_t* hbf = WSP(bf16_t, WS_HBF);
    auto xrowp = [&](int r) -> float* { return r >= NLAT ? WSP(float, WS_XC) + (size_t)(r - NLAT) * D : F.out + (size_t)r * D; };
    auto srcp = [&](int r) -> const float* { return (mode == 0) ? (r >= NLAT ? F.in[I_CTX] + (size_t)(r - NLAT) * D : F.in[I_X] + (size_t)r * D) : (const float*)xrowp(r); };
    const int r0 = F.bid * 8 + F.wave, rstep = F.G * 8, lc = F.lane * 4;
    f32x4 xn[4]; u32x2 yan[4], ybn[4]; TokInfo t1 = {}, t2 = {};
    if (r0 < nrows) {
#pragma unroll
        for (int i = 0; i < 4; ++i) xn[i] = *(const f32x4*)(srcp(r0) + i * 256 + lc);
        if (mode != 0) { t1 = tok[r0]; if (r0 + rstep < nrows) t2 = tok[r0 + rstep];
#pragma unroll
            for (int i = 0; i < 4; ++i) { yan[i] = *(const u32x2*)(ys + (size_t)t1.s0 * D + i * 256 + lc); ybn[i] = *(const u32x2*)(ys + (size_t)t1.s1 * D + i * 256 + lc); } }
    }
    for (int r = r0; r < nrows; r += rstep) {
        const bool isctx = r >= NLAT; const int v = isctx ? 2 : (r >> 14);
        f32x4 x[4]; u32x2 ya[4], yb[4]; const TokInfo ti = t1;
#pragma unroll
        for (int i = 0; i < 4; ++i) { x[i] = xn[i]; ya[i] = yan[i]; yb[i] = ybn[i]; }
        if (r + rstep < nrows) {
#pragma unroll
            for (int i = 0; i < 4; ++i) xn[i] = *(const f32x4*)(srcp(r + rstep) + i * 256 + lc);
            if (mode != 0) { t1 = t2; if (r + 2 * rstep < nrows) t2 = tok[r + 2 * rstep];
#pragma unroll
                for (int i = 0; i < 4; ++i) { yan[i] = *(const u32x2*)(ys + (size_t)t1.s0 * D + i * 256 + lc); ybn[i] = *(const u32x2*)(ys + (size_t)t1.s1 * D + i * 256 + lc); } }
        }
        if (mode != 0) {
            const float* g2 = modprev + (size_t)v * 6144 + 5 * 1024;
#pragma unroll
            for (int i = 0; i < 4; ++i) {
                const u32x2 a = ya[i], b = yb[i];
                const f32x4 gg = *(const f32x4*)(g2 + i * 256 + lc);
                f32x4 y;
                y[0] = ti.g0 * __uint_as_float(a[0] << 16) + ti.g1 * __uint_as_float(b[0] << 16);
                y[1] = ti.g0 * __uint_as_float(a[0] & 0xffff0000u) + ti.g1 * __uint_as_float(b[0] & 0xffff0000u);
                y[2] = ti.g0 * __uint_as_float(a[1] << 16) + ti.g1 * __uint_as_float(b[1] << 16);
                y[3] = ti.g0 * __uint_as_float(a[1] & 0xffff0000u) + ti.g1 * __uint_as_float(b[1] & 0xffff0000u);
                x[i] = x[i] + gg * y;
            }
            if (mode == 1) { float* xrow = xrowp(r);
#pragma unroll
                for (int i = 0; i < 4; ++i) *(f32x4*)(xrow + i * 256 + lc) = x[i]; }
        }
        float ss = 0.f;
#pragma unroll
        for (int i = 0; i < 4; ++i) ss += x[i][0] * x[i][0] + x[i][1] * x[i][1] + x[i][2] * x[i][2] + x[i][3] * x[i][3];
        ss = wave_sum(ss);
        const float rstd = rsqrtf(ss * (1.f / D) + EPS);
#pragma unroll
        for (int i = 0; i < 4; ++i) {
            const int c = i * 256 + lc;
            const f32x4 g = *(const f32x4*)(gam + c);
            if (mode == 2) { *(f32x4*)(F.out + (size_t)r * D + c) = x[i] * rstd * g; }
            else {
                const f32x4 sh = *(const f32x4*)(modp + (size_t)v * 6144 + c), sc = *(const f32x4*)(modp + (size_t)v * 6144 + 1024 + c);
                const f32x4 h = x[i] * rstd * g * (sc + 1.f) + sh;
                *(u32x2*)(hbf + (size_t)r * D + c) = (u32x2){pk2(h[0], h[1]), pk2(h[2], h[3])};
            }
        }
    }
}

DI void phase_norm2(const Frame& F, int li, int nrows) {
    float* wt = (float*)F.lds;
    __syncthreads();
    for (int i = F.tid; i < 16384; i += NTHR) { const int k = i >> 4, e = i & 15; wt[e * 1024 + k] = F.in[I_RW][i]; }
    __syncthreads();
    const float* modp = WSP(float, WS_MOD) + (size_t)li * 3 * 6144;
    const float* gam = F.in[I_N2G] + (size_t)li * D;
    bf16_t* hbf = WSP(bf16_t, WS_HBF); TokInfo* tok = WSP(TokInfo, WS_TOK);
    unsigned* lcnt = (unsigned*)(F.lds + LDS_MISC + 64);
    if (F.tid < 16) lcnt[F.tid] = 0u;
    __syncthreads();
    auto rowp = [&](int r) -> const float* { return r >= NLAT ? WSP(float, WS_XC) + (size_t)(r - NLAT) * D : F.out + (size_t)r * D; };
    const int r_first = F.bid * 8 + F.wave, rstep = F.G * 8;
    f32x4 xn[4];
    if (r_first < nrows) {
#pragma unroll
        for (int i = 0; i < 4; ++i) xn[i] = *(const f32x4*)(rowp(r_first) + i * 256 + F.lane * 4);
    }
    const bool b2 = (F.lane & 4) != 0, b3 = (F.lane & 8) != 0, b4 = (F.lane & 16) != 0;
    for (int r = r_first; r < nrows; r += rstep) {
        const bool isctx = r >= NLAT; const int v = isctx ? 2 : (r >> 14);
        f32x4 x[4]; float ss = 0.f;
#pragma unroll
        for (int i = 0; i < 4; ++i) { x[i] = xn[i]; ss += x[i][0] * x[i][0] + x[i][1] * x[i][1] + x[i][2] * x[i][2] + x[i][3] * x[i][3]; }
        if (r + rstep < nrows) {
#pragma unroll
            for (int i = 0; i < 4; ++i) xn[i] = *(const f32x4*)(rowp(r + rstep) + i * 256 + F.lane * 4);
        }
        ss = wave_sum(ss);
        const float rstd = rsqrtf(ss * (1.f / D) + EPS);
        float lg[16];
#pragma unroll
        for (int e = 0; e < 16; ++e) lg[e] = 0.f;
#pragma unroll
        for (int i = 0; i < 4; ++i) {
            const int c = i * 256 + F.lane * 4;
            const f32x4 g = *(const f32x4*)(gam + c), sh = *(const f32x4*)(modp + (size_t)v * 6144 + 3 * 1024 + c), sc = *(const f32x4*)(modp + (size_t)v * 6144 + 4 * 1024 + c);
            const f32x4 h = x[i] * rstd * g * (sc + 1.f) + sh;
            *(u32x2*)(hbf + (size_t)r * D + c) = (u32x2){pk2(h[0], h[1]), pk2(h[2], h[3])};
#pragma unroll
            for (int e = 0; e < 16; ++e) { const f32x4 w = *(const f32x4*)(wt + e * 1024 + c); lg[e] += h[0] * w[0] + h[1] * w[1] + h[2] * w[2] + h[3] * w[3]; }
        }
        float a8[8], a4[4], a2[2];
#pragma unroll
        for (int e = 0; e < 8; ++e) { const auto rr = __builtin_amdgcn_permlane32_swap(__float_as_uint(lg[e]), __float_as_uint(lg[e + 8]), false, false); a8[e] = __uint_as_float(rr[0]) + __uint_as_float(rr[1]); }
#pragma unroll
        for (int e = 0; e < 4; ++e) { const float keep = b4 ? a8[e + 4] : a8[e], send = b4 ? a8[e] : a8[e + 4]; a4[e] = keep + swz_xor<16>(send); }
#pragma unroll
        for (int e = 0; e < 2; ++e) { const float keep = b3 ? a4[e + 2] : a4[e], send = b3 ? a4[e] : a4[e + 2]; a2[e] = keep + swz_xor<8>(send); }
        float a1 = (b2 ? a2[1] : a2[0]) + swz_xor<4>(b2 ? a2[0] : a2[1]);
        a1 += swz_xor<2>(a1); a1 += swz_xor<1>(a1);
#pragma unroll
        for (int e = 0; e < 16; ++e) lg[e] = __int_as_float(__builtin_amdgcn_readlane(__float_as_int(a1), 4 * e));
        float mx = lg[0];
#pragma unroll
        for (int e = 1; e < 16; ++e) mx = fmaxf(mx, lg[e]);
        float sc[16], sel[16], den = 0.f;
#pragma unroll
        for (int e = 0; e < 16; ++e) { sc[e] = __expf(lg[e] - mx); den += sc[e]; }
        const float rden = 1.f / den;
#pragma unroll
        for (int e = 0; e < 16; ++e) { sc[e] *= rden; sel[e] = sc[e] + F.in[I_RB][e]; }
        int bg = 0; float bgs = -1e30f;
#pragma unroll
        for (int g = 0; g < 4; ++g) {
            float m1 = -1e30f, m2 = -1e30f;
#pragma unroll
            for (int q = 0; q < 4; ++q) { const float s = sel[g * 4 + q]; if (s > m1) { m2 = m1; m1 = s; } else if (s > m2) m2 = s; }
            const float gs = m1 + m2; if (gs > bgs) { bgs = gs; bg = g; }
        }
        int e0 = 0, e1 = 0; float s0v = -1e30f, s1v = -1e30f, w0 = 0.f, w1 = 0.f;
#pragma unroll
        for (int e = 0; e < 16; ++e) {
            const bool ing = (e >> 2) == bg; const float s = sel[e];
            if (ing && s > s0v) { s1v = s0v; e1 = e0; w1 = w0; s0v = s; e0 = e; w0 = sc[e]; }
            else if (ing && s > s1v) { s1v = s; e1 = e; w1 = sc[e]; }
        }
        if (F.lane == 0) {
            TokInfo ti; ti.e0 = e0; ti.e1 = e1; ti.p0 = atomicAdd(lcnt + e0, 1u); ti.p1 = atomicAdd(lcnt + e1, 1u);
            const float ws = 1.f / (w0 + w1); ti.g0 = w0 * ws; ti.g1 = w1 * ws; ti.s0 = 0; ti.s1 = 0;
            tok[r] = ti;
        }
    }
    __syncthreads();
    if (F.tid < 16) F.ctl[CW_BCNT + (li * MAXG + F.bid) * 16 + F.tid] = lcnt[F.tid];
}

DI void moe_offsets(const Frame& F, int li, int* offs) {
    __syncthreads();
    int* tot = offs + 376;
    int* part = (int*)F.lds;
    {
        const int e = F.tid & 15, pq = F.tid >> 4;
        const unsigned* bc = F.ctl + CW_BCNT + li * MAXG * 16 + e;
        int st = 0, sb = 0;
#pragma unroll
        for (int k = 0; k < 8; ++k) { const int blk = pq * 8 + k; const int c = (blk < F.G) ? (int)__hip_atomic_load(bc + blk * 16, __ATOMIC_RELAXED, __HIP_MEMORY_SCOPE_AGENT) : 0; st += c; sb += (blk < F.bid) ? c : 0; }
        part[pq * 16 + e] = st; part[512 + pq * 16 + e] = sb;
    }
    __syncthreads();
    if (F.tid < 32) { const int e = F.tid & 15, wb = F.tid >> 4; int s = 0;
        for (int pq = 0; pq < 32; ++pq) s += part[wb * 512 + pq * 16 + e];
        if (wb) offs[360 + e] = s; else tot[e] = s; }
    __syncthreads();
    if (F.tid == 0) { int o = 0; for (int e = 0; e < NE; ++e) { offs[e] = o; offs[17 + e] = o >> 8; o += (tot[e] + 255) & ~255; }
        offs[16] = o; offs[17 + 16] = o >> 8; }
    __syncthreads();
    for (int t = F.tid; t < SLOT_CAP / 256; t += NTHR) { int e = 0; for (int k = 1; k < NE; ++k) e += (offs[17 + k] <= t) ? 1 : 0; offs[40 + t] = e; }
    if (F.tid < 16) offs[360 + F.tid] += offs[F.tid];
    __syncthreads();
}
DI void phase_gather(const Frame& F, int li, int nrows) {
    int* offs = (int*)(F.lds + LDS_MISC + 64);
    moe_offsets(F, li, offs);
    const bf16_t* hbf = WSP(bf16_t, WS_HBF); bf16_t* a1 = WSP(bf16_t, WS_A1); TokInfo* tok = WSP(TokInfo, WS_TOK);
    for (int r = F.bid * 8 + F.wave; r < nrows; r += F.G * 8) {
        TokInfo ti = tok[r];
        const unsigned s0 = offs[360 + ti.e0] + ti.p0, s1 = offs[360 + ti.e1] + ti.p1;
        const u32x4 a = *(const u32x4*)(hbf + (size_t)r * D + F.lane * 8), b = *(const u32x4*)(hbf + (size_t)r * D + 512 + F.lane * 8);
        *(u32x4*)(a1 + (size_t)s0 * D + F.lane * 8) = a; *(u32x4*)(a1 + (size_t)s0 * D + 512 + F.lane * 8) = b;
        *(u32x4*)(a1 + (size_t)s1 * D + F.lane * 8) = a; *(u32x4*)(a1 + (size_t)s1 * D + 512 + F.lane * 8) = b;
        if (F.lane == 0) { tok[r].s0 = s0; tok[r].s1 = s1; }
    }
}

DI float lam_of(const Frame& F, int li, float& lam_init) {
    const float* lv = F.in[I_ALAM] + (size_t)li * 128;
    const int i = F.lane & 31, hi = F.lane >> 5;
    float d = lv[hi * 64 + i] * lv[hi * 64 + 32 + i];
    d += swz_xor<16>(d); d += swz_xor<8>(d); d += swz_xor<4>(d); d += swz_xor<2>(d); d += swz_xor<1>(d);
    const float d0 = __int_as_float(__builtin_amdgcn_readlane(__float_as_int(d), 0)), d1 = __int_as_float(__builtin_amdgcn_readlane(__float_as_int(d), 32));
    float lif = (float)li; asm volatile("" : "+v"(lif));
    lam_init = 0.8f - 0.6f * __expf(-0.3f * lif);
    return __expf(d0) - __expf(d1) + lam_init;
}
DI bf16x8 pack8(const f32x16& x, int s) {
    u32x4 p; p[0] = pk2(x[8 * s], x[8 * s + 1]); p[1] = pk2(x[8 * s + 2], x[8 * s + 3]); p[2] = pk2(x[8 * s + 4], x[8 * s + 5]); p[3] = pk2(x[8 * s + 6], x[8 * s + 7]);
    return __builtin_bit_cast(bf16x8, p);
}

DI void diffattn_unit(const Frame& F, int li, int b, int h, size_t qrow0, int NT2) {
    const int lane = F.lane, r = lane & 31, hh = lane >> 5, c = F.wave & 1, g = F.wave >> 1;
    const bf16_t* AQ = WSP(bf16_t, WS_AQ); const bf16_t* AK = WSP(bf16_t, WS_AK); const bf16_t* AVT = WSP(bf16_t, WS_AVT) + (size_t)(b * 4 + h) * 64 * NKEY;
    float lam_init; const float lam = lam_of(F, li, lam_init);
    const size_t qrowA = qrow0 + g * 64 + r;
    bf16x8 qfA[2], qfB[2]; float qnA = 0.f, qnB = 0.f;
#pragma unroll
    for (int ks = 0; ks < 2; ++ks) { qfA[ks] = *(const bf16x8*)(AQ + qrowA * 256 + h * 64 + c * 32 + ks * 16 + 8 * hh); qfB[ks] = *(const bf16x8*)(AQ + (qrowA + 32) * 256 + h * 64 + c * 32 + ks * 16 + 8 * hh);
#pragma unroll
        for (int j = 0; j < 8; ++j) { const float va = bf2f((bf16_t)qfA[ks][j]), vb_ = bf2f((bf16_t)qfB[ks][j]); qnA += va * va; qnB += vb_ * vb_; } }
    f32x16 cinit;
    { const float qm = wave_max(fmaxf(half_sum(qnA), half_sum(qnB)));
      const float km = sqrtf(__uint_as_float(__hip_atomic_load(F.ctl + CW_KMAX + li * 16 + (b * 4 + h) * 2 + c, __ATOMIC_RELAXED, __HIP_MEMORY_SCOPE_AGENT)));
      const float cn = -(sqrtf(qm) * km * 1.02f + 1e-3f);
#pragma unroll
      for (int i = 0; i < 16; ++i) cinit[i] = cn; }
    f32x16 OA[2], OB[2]; f32x8 laccA, laccB;
#pragma unroll
    for (int i = 0; i < 16; ++i) { OA[0][i] = 0.f; OA[1][i] = 0.f; OB[0][i] = 0.f; OB[1][i] = 0.f; }
#pragma unroll
    for (int i = 0; i < 8; ++i) { laccA[i] = 0.f; laccB[i] = 0.f; }
    constexpr int KTB = 2 * 128 * 64, VTB = 64 * 272, STG = KTB + VTB;
    const int skey = F.tid >> 2, sq = F.tid & 3;
    const int kdst0 = (sq >> 1) * 8192 + skey * 64 + ((((sq & 1) * 2 + 0) ^ ((skey >> 2) & 3)) * 16);
    const int kdst1 = (sq >> 1) * 8192 + skey * 64 + ((((sq & 1) * 2 + 1) ^ ((skey >> 2) & 3)) * 16);
    const int vd = F.tid >> 3, vpart = F.tid & 7;
    const int vdst = KTB + vd * 272 + vpart * 32;
    auto krow_of = [&](int j) -> size_t { return j < CTX ? (size_t)NLAT + b * CTX + j : (size_t)b * S + (j - CTX); };
    unsigned char* L = F.lds;
    u32x4 kreg[2], vreg[2];
    { const bf16_t* kp = AK + krow_of(skey) * 256 + h * 64 + sq * 16; const bf16_t* vp = AVT + (size_t)vd * NKEY + vpart * 16;
      kreg[0] = *(const u32x4*)kp; kreg[1] = *(const u32x4*)(kp + 8); vreg[0] = *(const u32x4*)vp; vreg[1] = *(const u32x4*)(vp + 8); }
    __syncthreads();
    *(u32x4*)(L + kdst0) = kreg[0]; *(u32x4*)(L + kdst1) = kreg[1];
    *(u32x4*)(L + vdst) = (u32x4){vreg[0][0], vreg[0][1], vreg[1][0], vreg[1][1]}; *(u32x4*)(L + vdst + 16) = (u32x4){vreg[0][2], vreg[0][3], vreg[1][2], vreg[1][3]};
    __syncthreads();
    const int ksw = (r >> 2) & 3;
    const int kr0 = c * 8192 + r * 64 + (((0 + hh) ^ ksw) * 16), kr1 = c * 8192 + r * 64 + (((2 + hh) ^ ksw) * 16);
    const int vr0 = r * 272 + 16 * hh;
#define DA_LDK(st) do { k0 = *(const bf16x8*)(kb + (st) * 2048 + kr0); k1 = *(const bf16x8*)(kb + (st) * 2048 + kr1); } while (0)
#define DA_QK(Sx, qf) do { Sx = MFMA32(k0, qf[0], cinit); Sx = MFMA32(k1, qf[1], Sx); } while (0)
#define DA_LDV(st) do { _Pragma("unroll") for (int dh = 0; dh < 2; ++dh) _Pragma("unroll") for (int s2 = 0; s2 < 2; ++s2) \
            vf[dh][s2] = *(const bf16x8*)(vb + dh * (32 * 272) + vr0 + (st) * 64 + s2 * 32); } while (0)
#define DA_PV(Sx, Ox, lx) do { \
        _Pragma("unroll") for (int i = 0; i < 16; ++i) Sx[i] = __builtin_amdgcn_exp2f(Sx[i]); \
        lx += __builtin_shufflevector(Sx, Sx, 0, 1, 2, 3, 4, 5, 6, 7) + __builtin_shufflevector(Sx, Sx, 8, 9, 10, 11, 12, 13, 14, 15); \
        const bf16x8 p0 = pack8(Sx, 0), p1 = pack8(Sx, 1); \
        Ox[0] = MFMA32(vf[0][0], p0, Ox[0]); Ox[1] = MFMA32(vf[1][0], p0, Ox[1]); \
        Ox[0] = MFMA32(vf[0][1], p1, Ox[0]); Ox[1] = MFMA32(vf[1][1], p1, Ox[1]); } while (0)
    if (F.wave >= 4) __builtin_amdgcn_s_setprio(1);
#pragma unroll 1
    for (int kt = 0; kt < NT2; ++kt) {
        const int buf = kt & 1;
        if (kt + 1 < NT2) {
            const int j0 = (kt + 1) * 128;
            const bf16_t* kp = AK + krow_of(j0 + skey) * 256 + h * 64 + sq * 16; const bf16_t* vp = AVT + (size_t)vd * NKEY + j0 + vpart * 16;
            kreg[0] = *(const u32x4*)kp; kreg[1] = *(const u32x4*)(kp + 8); vreg[0] = *(const u32x4*)vp; vreg[1] = *(const u32x4*)(vp + 8);
        }
        const unsigned char* kb = L + buf * STG; const unsigned char* vb = L + buf * STG + KTB;
        f32x16 SA, SB; bf16x8 k0, k1, vf[2][2];
        DA_LDK(0); DA_QK(SA, qfA);
#pragma unroll 1
        for (int st = 0; st < 4; ++st) {
            DA_QK(SB, qfB);
            DA_LDV(st);
            DA_PV(SA, OA, laccA);
            if (st < 3) { DA_LDK(st + 1); DA_QK(SA, qfA); }
            DA_PV(SB, OB, laccB);
        }
        if (kt + 1 < NT2) {
            unsigned char* W = L + (buf ^ 1) * STG;
            *(u32x4*)(W + kdst0) = kreg[0]; *(u32x4*)(W + kdst1) = kreg[1];
            *(u32x4*)(W + vdst) = (u32x4){vreg[0][0], vreg[0][1], vreg[1][0], vreg[1][1]}; *(u32x4*)(W + vdst + 16) = (u32x4){vreg[0][2], vreg[0][3], vreg[1][2], vreg[1][3]};
        }
        __syncthreads();
    }
#undef DA_LDK
#undef DA_QK
#undef DA_LDV
#undef DA_PV
    __builtin_amdgcn_s_setprio(0);
    float lsA = 0.f, lsB = 0.f;
#pragma unroll
    for (int i = 0; i < 8; ++i) { lsA += laccA[i]; lsB += laccB[i]; }
    const float rlA = 1.f / half_sum(lsA), rlB = 1.f / half_sum(lsB);
    float* xb = (float*)L + (size_t)g * 2 * 32 * 64;
    if (c == 1) {
#pragma unroll
        for (int dh = 0; dh < 2; ++dh)
#pragma unroll
            for (int i = 0; i < 16; ++i) { xb[(dh * 16 + i) * 64 + lane] = OA[dh][i] * (rlA * lam); xb[2048 + (dh * 16 + i) * 64 + lane] = OB[dh][i] * (rlB * lam); }
    }
    __syncthreads();
    if (c == 0) {
        const float* sg = F.in[I_ASUB] + li * 64;
#pragma unroll
        for (int ab = 0; ab < 2; ++ab) {
            float o[2][16]; float ss = 0.f; const float rl = ab ? rlB : rlA;
#pragma unroll
            for (int dh = 0; dh < 2; ++dh)
#pragma unroll
                for (int i = 0; i < 16; ++i) { o[dh][i] = (ab ? OB[dh][i] : OA[dh][i]) * rl - xb[ab * 2048 + (dh * 16 + i) * 64 + lane]; ss += o[dh][i] * o[dh][i]; }
            ss = half_sum(ss);
            const float rs = rsqrtf(ss * (1.f / 64.f) + EPS) * (1.f - lam_init);
            bf16_t* mix = WSP(bf16_t, WS_HBF) + (qrowA + ab * 32) * D + h * 64;
#pragma unroll
            for (int dh = 0; dh < 2; ++dh)
#pragma unroll
                for (int gq = 0; gq < 4; ++gq) {
                    const int d = 32 * dh + 8 * gq + 4 * hh;
                    const f32x4 gg = *(const f32x4*)(sg + d);
                    *(u32x2*)(mix + d) = (u32x2){pk2(o[dh][4 * gq] * rs * gg[0], o[dh][4 * gq + 1] * rs * gg[1]), pk2(o[dh][4 * gq + 2] * rs * gg[2], o[dh][4 * gq + 3] * rs * gg[3])};
                }
        }
    }
}

DI void na_mfma_unit(const Frame& F, int li, int b, size_t qrow0, int grow) {
    const int lane = F.lane, r31 = lane & 31, hh = lane >> 5, h = F.wave >> 1, qh = F.wave & 1;
    const bf16_t* BQ = WSP(bf16_t, WS_BQ); const bf16_t* BK = WSP(bf16_t, WS_BK); const bf16_t* BVT = WSP(bf16_t, WS_BVT);
    constexpr int KB = 4 * 8192, VB = 4 * 9216, STG = KB + VB;
    unsigned char* L = F.lds;
    float* tab = (float*)(F.lds + 2 * STG);
    const int nwin = grow >= 0 ? 8 : 0, nt = nwin + 4;
    int r0 = grow - 4; r0 = r0 < 0 ? 0 : (r0 > 248 ? 248 : r0);
    __syncthreads();
    if (nwin) for (int i = F.tid; i < 4 * 15 * 32; i += NTHR) { const int c31 = i & 31, hr = i >> 5; tab[i] = (c31 < 31) ? F.in[I_RPB][(size_t)li * 4 * 465 + hr * 31 + c31] * LOG2E : -1e30f; }
    const int skey = F.tid >> 3, sc64 = F.tid & 7, sh = sc64 >> 1;
    const int vrow = F.tid >> 1, vhalf = F.tid & 1;
    auto kbase = [&](int ti) -> const bf16_t* { return ti < nwin ? BK + ((size_t)b * S + (size_t)(r0 + ti) * GW) * 256 : BK + ((size_t)NLAT + b * CTX + (ti - nwin) * 64) * 256; };
    auto vkey0 = [&](int ti) -> int { return ti < nwin ? CTX + (r0 + ti) * GW : (ti - nwin) * 64; };
    u32x4 kreg[4], vreg[4];
    { const bf16_t* kp = kbase(0) + (size_t)skey * 256 + sc64 * 32; const bf16_t* vp = BVT + ((size_t)b * 256 + vrow) * NKEY + vkey0(0) + vhalf * 32;
#pragma unroll
      for (int i = 0; i < 4; ++i) { kreg[i] = *(const u32x4*)(kp + i * 8); vreg[i] = *(const u32x4*)(vp + i * 8); } }
    const size_t qrow = qrow0 + 32 * qh + r31;
    bf16x8 qf[4]; float qn2 = 0.f;
#pragma unroll
    for (int ks = 0; ks < 4; ++ks) { qf[ks] = *(const bf16x8*)(BQ + qrow * 256 + h * 64 + ks * 16 + 8 * hh);
#pragma unroll
        for (int j = 0; j < 8; ++j) { const float v = bf2f((bf16_t)qf[ks][j]); qn2 += v * v; } }
    qn2 = half_sum(qn2);
    __syncthreads();
    float bmax = 0.f;
    if (nwin) { for (int i = lane; i < 480; i += 64) bmax = fmaxf(bmax, tab[h * 480 + i]); bmax = wave_max(bmax); }
    const unsigned* kmx = F.ctl + CW_KMAXB + li * 16 + (b * 4 + h) * 2;
    const float km = sqrtf(__uint_as_float(__hip_atomic_load(kmx, __ATOMIC_RELAXED, __HIP_MEMORY_SCOPE_AGENT)) + __uint_as_float(__hip_atomic_load(kmx + 1, __ATOMIC_RELAXED, __HIP_MEMORY_SCOPE_AGENT)));
    const float cneg = -(sqrtf(qn2) * km * 1.02f + bmax + 1e-3f);
    const int cq = 32 * qh + r31; int c0q = cq - 8; c0q = c0q < 0 ? 0 : (c0q > 48 ? 48 : c0q);
    const int qrow_g = grow;
    f32x16 O[2];
#pragma unroll
    for (int dh = 0; dh < 2; ++dh)
#pragma unroll
        for (int i = 0; i < 16; ++i) O[dh][i] = 0.f;
    f32x16 lacc;
#pragma unroll
    for (int i = 0; i < 16; ++i) lacc[i] = 0.f;
    int tcol[2][16];
#pragma unroll
    for (int st = 0; st < 2; ++st)
#pragma unroll
        for (int i = 0; i < 16; ++i) { const int kc = 32 * st + (i & 3) + 8 * (i >> 2) + 4 * hh; tcol[st][i] = ((kc >= c0q) && (kc < c0q + 16)) ? (kc - cq + 15) : 31; }
    const int kdst = sh * 8192 + skey * 128, ksw = (skey >> 1) & 7, kch0 = (sc64 & 1) * 4;
    const int vdst = KB + (vrow >> 6) * 9216 + (vrow & 63) * 144 + vhalf * 64;
#pragma unroll
    for (int i = 0; i < 4; ++i) *(u32x4*)(L + kdst + (((kch0 + i) ^ ksw) * 16)) = kreg[i];
#pragma unroll
    for (int i = 0; i < 2; ++i) { *(u32x4*)(L + vdst + i * 32) = (u32x4){vreg[2 * i][0], vreg[2 * i][1], vreg[2 * i + 1][0], vreg[2 * i + 1][1]};
        *(u32x4*)(L + vdst + i * 32 + 16) = (u32x4){vreg[2 * i][2], vreg[2 * i][3], vreg[2 * i + 1][2], vreg[2 * i + 1][3]}; }
    __syncthreads();
#pragma unroll 1
    for (int ti = 0; ti < nt; ++ti) {
        const int buf = ti & 1;
        if (ti + 1 < nt) { const bf16_t* kp = kbase(ti + 1) + (size_t)skey * 256 + sc64 * 32; const bf16_t* vp = BVT + ((size_t)b * 256 + vrow) * NKEY + vkey0(ti + 1) + vhalf * 32;
#pragma unroll
            for (int i = 0; i < 4; ++i) { kreg[i] = *(const u32x4*)(kp + i * 8); vreg[i] = *(const u32x4*)(vp + i * 8); } }
        const unsigned char* kb = L + buf * STG + h * 8192; const unsigned char* vb = L + buf * STG + KB + h * 9216;
        const bool win = ti < nwin;
        const float* trow = tab + (h * 15 + (win ? (r0 + ti - qrow_g + 7) : 0)) * 32;
#pragma unroll
        for (int st = 0; st < 2; ++st) {
            const int key = 32 * st + r31, sw = (key >> 1) & 7;
            f32x16 s;
            if (win) {
#pragma unroll
                for (int i = 0; i < 16; ++i) s[i] = trow[tcol[st][i]] + cneg;
            } else {
#pragma unroll
                for (int i = 0; i < 16; ++i) s[i] = cneg;
            }
#pragma unroll
            for (int ks = 0; ks < 4; ++ks) { const bf16x8 kf = *(const bf16x8*)(kb + key * 128 + (((ks * 2 + hh) ^ sw) * 16)); s = MFMA32(kf, qf[ks], s); }
#pragma unroll
            for (int i = 0; i < 16; ++i) s[i] = __builtin_amdgcn_exp2f(s[i]);
            lacc += s;
            const bf16x8 p0 = pack8(s, 0), p1 = pack8(s, 1);
#pragma unroll
            for (int dh = 0; dh < 2; ++dh) {
                const unsigned char* vp = vb + (32 * dh + r31) * 144 + st * 64 + hh * 16;
                O[dh] = MFMA32(*(const bf16x8*)vp, p0, O[dh]);
                O[dh] = MFMA32(*(const bf16x8*)(vp + 32), p1, O[dh]);
            }
        }
        if (ti + 1 < nt) { unsigned char* W = L + (buf ^ 1) * STG;
#pragma unroll
            for (int i = 0; i < 4; ++i) *(u32x4*)(W + kdst + (((kch0 + i) ^ ksw) * 16)) = kreg[i];
#pragma unroll
            for (int i = 0; i < 2; ++i) { *(u32x4*)(W + vdst + i * 32) = (u32x4){vreg[2 * i][0], vreg[2 * i][1], vreg[2 * i + 1][0], vreg[2 * i + 1][1]};
                *(u32x4*)(W + vdst + i * 32 + 16) = (u32x4){vreg[2 * i][2], vreg[2 * i][3], vreg[2 * i + 1][2], vreg[2 * i + 1][3]}; } }
        __syncthreads();
    }
    float lsum = 0.f;
#pragma unroll
    for (int i = 0; i < 16; ++i) lsum += lacc[i];
    const float rl = 1.f / half_sum(lsum);
    bf16_t* mix = WSP(bf16_t, WS_HBF) + qrow * D + 256 + h * 64;
#pragma unroll
    for (int dh = 0; dh < 2; ++dh)
#pragma unroll
        for (int g = 0; g < 4; ++g) { const int d = 32 * dh + 8 * g + 4 * hh;
            *(u32x2*)(mix + d) = (u32x2){pk2(O[dh][4 * g] * rl, O[dh][4 * g + 1] * rl), pk2(O[dh][4 * g + 2] * rl, O[dh][4 * g + 3] * rl)}; }
}

DI void pool_unit(const Frame& F, int li, size_t seq_row0, int L, int t0) {
    unsigned* us = (unsigned*)F.lds;
    unsigned char* dfb = F.lds + 80 * 512;
    const bf16_t* PL = WSP(bf16_t, WS_PL);
    __syncthreads();
    for (int i = F.tid; i < 80 * 32; i += NTHR) {
        const int tt = i >> 5, c8 = i & 31, t = t0 - 8 + tt;
        u32x4 x = (u32x4){0u, 0u, 0u, 0u};
        if (t >= 0 && t < L) x = *(const u32x4*)(PL + (seq_row0 + t) * 256 + c8 * 8);
        *(u32x4*)(us + tt * 128 + c8 * 4) = x;
    }
    __syncthreads();
    {
        const int cp = F.tid & 127, tl0 = (F.tid >> 7) * 16, hw = 1 << (cp >> 5);
        float s0 = 0.f, s1 = 0.f;
        for (int k = -hw; k < hw; ++k) { const unsigned w = us[(tl0 + 8 + k) * 128 + cp]; s0 += __uint_as_float(w << 16); s1 += __uint_as_float(w & 0xffff0000u); }
#pragma unroll 4
        for (int j = 0; j < 16; ++j) {
            const int tl = tl0 + j, t = t0 + tl;
            const int lo = t - hw < 0 ? 0 : t - hw, hi = t + hw > L ? L : t + hw;
            const float rc = __builtin_amdgcn_rcpf((float)(hi - lo));
            const unsigned c = us[(tl + 8) * 128 + cp];
            *(unsigned*)(dfb + tl * 528 + cp * 4) = pk2(s0 * rc - __uint_as_float(c << 16), s1 * rc - __uint_as_float(c & 0xffff0000u));
            const unsigned a = us[(tl + 8 + hw) * 128 + cp], b = us[(tl + 8 - hw) * 128 + cp];
            s0 += __uint_as_float(a << 16) - __uint_as_float(b << 16); s1 += __uint_as_float(a & 0xffff0000u) - __uint_as_float(b & 0xffff0000u);
        }
    }
    __syncthreads();
    {
        const int g = F.wave & 3, tq = F.wave >> 2, fr = F.lane & 15, fq = F.lane >> 4;
        const bf16_t* wt = WSP(bf16_t, WS_PWT) + ((size_t)li * 4 + g) * 4096;
        bf16x8 Af[4][2];
#pragma unroll
        for (int jb = 0; jb < 4; ++jb)
#pragma unroll
            for (int ks = 0; ks < 2; ++ks) Af[jb][ks] = *(const bf16x8*)(wt + (jb * 16 + fr) * 64 + ks * 32 + fq * 8);
        const float* ps = F.in[I_POOLS] + li * 256 + g * 64;
        bf16_t* mix = WSP(bf16_t, WS_HBF);
#pragma unroll
        for (int tb = 0; tb < 2; ++tb) {
            const int tl = (tq * 2 + tb) * 16 + fr;
            const bf16x8 B0 = *(const bf16x8*)(dfb + tl * 528 + (g * 64 + fq * 8) * 2), B1 = *(const bf16x8*)(dfb + tl * 528 + (g * 64 + 32 + fq * 8) * 2);
#pragma unroll
            for (int jb = 0; jb < 4; ++jb) {
                f32x4 acc = (f32x4){0.f, 0.f, 0.f, 0.f};
                acc = __builtin_amdgcn_mfma_f32_16x16x32_bf16(Af[jb][0], B0, acc, 0, 0, 0);
                acc = __builtin_amdgcn_mfma_f32_16x16x32_bf16(Af[jb][1], B1, acc, 0, 0, 0);
                const f32x4 sc = *(const f32x4*)(ps + jb * 16 + 4 * fq);
                *(u32x2*)(mix + (seq_row0 + t0 + tl) * D + 512 + g * 64 + jb * 16 + 4 * fq) = (u32x2){pk2(acc[0] * sc[0], acc[1] * sc[1]), pk2(acc[2] * sc[2], acc[3] * sc[3])};
            }
        }
    }
}

DI float hy_norm(const float* part, int ntile, int o, int ch) {
    float s = 0.f;
    for (int t = 0; t < ntile; ++t) s += part[(size_t)t * 1024 + (o * 2) * 256 + ch] + part[(size_t)t * 1024 + (o * 2 + 1) * 256 + ch];
    return rsqrtf(s + EPS);
}
DI float hy_short(const bf16_t* p, int t, int L, float w0, float w1, float w2, float bb) {
    const int tm = t > 0 ? t - 1 : 0, tp = t + 1 < L ? t + 1 : L - 1;
    float a = bf2f(p[tm]), c = bf2f(p[tp]); const float m = bf2f(p[t]);
    a = t > 0 ? a : 0.f; c = t + 1 < L ? c : 0.f;
    return a * w0 + m * w1 + c * w2 + bb;
}
constexpr int FM = 16384;
DI int fphys(int i) { return i + (i >> 4) + ((i >> 9) << 4); }
constexpr int brev(int m, int bits) { return bits == 5 ? (((m & 1) << 4) | ((m & 2) << 2) | (m & 4) | ((m & 8) >> 2) | ((m & 16) >> 4)) : (((m & 1) << 3) | ((m & 2) << 1) | ((m & 4) >> 1) | ((m & 8) >> 3)); }
DI f32x2 cmul(f32x2 x, float c, float sn) {
    const f32x2 xs = __builtin_shufflevector(x, x, 1, 0);
    return x * (f32x2){c, c} + xs * (f32x2){-sn, sn};
}
template <int R, int LOG2R, bool INV> DI void dft_regs(f32x2 (&x)[R]) {
    constexpr float C32[16] = {1.f, 0.98078528040323043f, 0.92387953251128674f, 0.83146961230254524f, 0.70710678118654752f, 0.55557023301960218f, 0.38268343236508977f, 0.19509032201612825f,
                               0.f, -0.19509032201612825f, -0.38268343236508977f, -0.55557023301960218f, -0.70710678118654752f, -0.83146961230254524f, -0.92387953251128674f, -0.98078528040323043f};
    constexpr float S32[16] = {0.f, 0.19509032201612825f, 0.38268343236508977f, 0.55557023301960218f, 0.70710678118654752f, 0.83146961230254524f, 0.92387953251128674f, 0.98078528040323043f,
                               1.f, 0.98078528040323043f, 0.92387953251128674f, 0.83146961230254524f, 0.70710678118654752f, 0.55557023301960218f, 0.38268343236508977f, 0.19509032201612825f};
#pragma unroll
    for (int st = 0; st < LOG2R; ++st) {
        const int h = R >> (st + 1);
        f32x2 d[R / 2], t[R / 2];
#pragma unroll
        for (int b = 0; b < R / 2; ++b) { const int i = (b / h) * 2 * h, j = b % h; const f32x2 a = x[i + j], c = x[i + j + h]; x[i + j] = a + c; d[b] = a - c; }
#pragma unroll
        for (int b = 0; b < R / 2; ++b) { const int j = b % h, k = j * (16 / h); if (k != 0 && k != 8) t[b] = d[b] * (f32x2){C32[k], C32[k]}; }
#pragma unroll
        for (int b = 0; b < R / 2; ++b) { const int i = (b / h) * 2 * h, j = b % h, k = j * (16 / h);
            if (k == 0) x[i + j + h] = d[b];
            else if (k == 8) x[i + j + h] = INV ? (f32x2){-d[b][1], d[b][0]} : (f32x2){d[b][1], -d[b][0]};
            else { const float sn = INV ? S32[k] : -S32[k]; x[i + j + h] = __builtin_shufflevector(d[b], d[b], 1, 0) * (f32x2){-sn, sn} + t[b]; } }
    }
}
template <bool INV, int SP> DI void fft_pass32(f32x2* X, int bp, int rem, float inv_bs) {
    asm volatile("" : "+v"(bp), "+v"(rem));
    f32x2* P = X + bp;
    const float revb = (float)rem * inv_bs;
    f32x2 x[32], cs[16], t[16];
    if (!INV) {
#pragma unroll
        for (int q = 0; q < 32; ++q) x[q] = P[q * SP];
        dft_regs<32, 5, false>(x);
        P[0] = x[0];
#pragma unroll
        for (int hb = 0; hb < 32; hb += 16) {
#pragma unroll
            for (int m = hb ? hb : 1; m < hb + 16; ++m) { const float rev = revb * (float)brev(m, 5); cs[m & 15] = (f32x2){__builtin_amdgcn_cosf(rev), -__builtin_amdgcn_sinf(rev)}; }
#pragma unroll
            for (int m = hb ? hb : 1; m < hb + 16; ++m) t[m & 15] = x[m] * (f32x2){cs[m & 15][0], cs[m & 15][0]};
#pragma unroll
            for (int m = hb ? hb : 1; m < hb + 16; ++m) P[brev(m, 5) * SP] = __builtin_shufflevector(x[m], x[m], 1, 0) * (f32x2){-cs[m & 15][1], cs[m & 15][1]} + t[m & 15];
        }
    } else {
#pragma unroll
        for (int qp = 0; qp < 32; ++qp) x[qp] = P[qp * SP];
#pragma unroll
        for (int hb = 0; hb < 32; hb += 16) {
#pragma unroll
            for (int qp = hb ? hb : 1; qp < hb + 16; ++qp) { const float rev = revb * (float)qp; cs[qp & 15] = (f32x2){__builtin_amdgcn_cosf(rev), __builtin_amdgcn_sinf(rev)}; }
#pragma unroll
            for (int qp = hb ? hb : 1; qp < hb + 16; ++qp) t[qp & 15] = x[qp] * (f32x2){cs[qp & 15][0], cs[qp & 15][0]};
#pragma unroll
            for (int qp = hb ? hb : 1; qp < hb + 16; ++qp) x[qp] = __builtin_shufflevector(x[qp], x[qp], 1, 0) * (f32x2){-cs[qp & 15][1], cs[qp & 15][1]} + t[qp & 15];
        }
        dft_regs<32, 5, true>(x);
#pragma unroll
        for (int m = 0; m < 32; ++m) P[brev(m, 5) * SP] = x[m];
    }
}
DI void fft_fwd12(f32x2* X, int tid) {
    __syncthreads(); fft_pass32<false, 560>(X, fphys(tid), tid, 1.f / 16384.f);
    __syncthreads(); fft_pass32<false, 17>(X, (tid >> 4) * 560 + (tid & 15), tid & 15, 1.f / 512.f);
    __syncthreads();
}
DI void fft_inv21(f32x2* X, int tid) {
    __syncthreads(); fft_pass32<true, 17>(X, (tid >> 4) * 560 + (tid & 15), tid & 15, 1.f / 512.f);
    __syncthreads(); fft_pass32<true, 560>(X, fphys(tid), tid, 1.f / 16384.f);
    __syncthreads();
}
DI void hyena_fft_unit(const Frame& F, int li, int ch) {
    f32x2* X = (f32x2*)F.lds;
    const bf16_t* HYT = WSP(bf16_t, WS_HYT); const float* filt = WSP(float, WS_FILT);
    f32x2* Ye = WSP(f32x2, WS_ZBUF) + (size_t)ch * FM; f32x2* Z1 = WSP(f32x2, WS_Z1BUF) + (size_t)ch * FM;
    const float* sw = F.in[I_HYSW] + (size_t)li * 3 * 768; const float* sb = F.in[I_HYSB] + li * 768; const float* sk = F.in[I_HSKIP] + li * 512;
    const int tid = F.tid;
    const bf16_t* px1[2] = {HYT + ((size_t)0 * 768 + ch) * S, HYT + ((size_t)1 * 768 + ch) * S};
    const bf16_t* px2[2] = {HYT + ((size_t)0 * 768 + 256 + ch) * S, HYT + ((size_t)1 * 768 + 256 + ch) * S};
    const bf16_t* pv[2] = {HYT + ((size_t)0 * 768 + 512 + ch) * S, HYT + ((size_t)1 * 768 + 512 + ch) * S};
    const float wx1[4] = {sw[ch], sw[768 + ch], sw[1536 + ch], sb[ch]};
    const float wx2[4] = {sw[256 + ch], sw[768 + 256 + ch], sw[1536 + 256 + ch], sb[256 + ch]};
    const float wv[4] = {sw[512 + ch], sw[768 + 512 + ch], sw[1536 + 512 + ch], sb[512 + ch]};
#pragma unroll 1
    for (int cv = 0; cv < 2; ++cv) {
        const float* hf = filt + ((size_t)(2 * cv) * 256 + ch) * S; const float* hb = filt + ((size_t)(2 * cv + 1) * 256 + ch) * S;
        float fnrm;
        { int tn = tid; asm volatile("" : "+v"(tn));
          const float pv = WSP(float, WS_FPART)[(size_t)(tn & 255) * 1024 + (cv * 2 + (tn >> 8)) * 256 + ch];
          const float ws = wave_sum(pv);
          float* red = (float*)(F.lds + LDS_MISC + 128);
          __syncthreads();
          if (F.lane == 0) red[F.wave] = ws;
          __syncthreads();
          fnrm = rsqrtf(red[0] + red[1] + red[2] + red[3] + red[4] + red[5] + red[6] + red[7] + EPS); }
        const float nrm = 1.f / 32768.f;
        const float skip = sk[cv * 256 + ch];
#pragma unroll 1
        for (int half = 0; half < 2; ++half) {
            __syncthreads();
            int pb = fphys(tid); int tq = tid; asm volatile("" : "+v"(pb), "+v"(tq));
            if (half == 0) {
#pragma unroll 8
                for (int j = 0; j < 32; ++j) { const int n = tq + 512 * j; const float a = hf[n] * fnrm; float bq = hb[FM - n] * fnrm; bq = n ? bq : 0.f;
                    X[pb + 560 * j] = (f32x2){a + bq, 0.f}; }
            } else {
#pragma unroll 8
                for (int j = 0; j < 32; ++j) { const int n = tq + 512 * j; const float a = hf[n] * fnrm; float bq = hb[FM - n] * fnrm; bq = n ? bq : 0.f;
                    const float d = a - bq, rev = (float)n * (1.f / 32768.f);
                    X[pb + 560 * j] = (f32x2){d * __builtin_amdgcn_cosf(rev), -d * __builtin_amdgcn_sinf(rev)}; }
            }
            fft_fwd12(X, tid);
            h16x2 kpk[2][16];
#pragma unroll
            for (int g = 0; g < 2; ++g) { int b16 = fphys((tid + 512 * g) * 16); asm volatile("" : "+v"(b16));
                f32x2 kx[16];
#pragma unroll
                for (int q = 0; q < 16; ++q) kx[q] = X[b16 + q];
                dft_regs<16, 4, false>(kx);
#pragma unroll
                for (int q = 0; q < 16; ++q) kpk[g][q] = (h16x2){(_Float16)kx[q][0], (_Float16)kx[q][1]}; }
            __syncthreads();
            asm volatile("" : "+v"(pb), "+v"(tq));
#define HY_MOD(v, n) do { const float rev = (float)(n) * (1.f / 32768.f); v = cmul(v, __builtin_amdgcn_cosf(rev), -__builtin_amdgcn_sinf(rev)); } while (0)
            if (cv == 0) {
                if (half == 0) {
#pragma unroll 4
                    for (int j = 0; j < 32; ++j) { const int n = tq + 512 * j; X[pb + 560 * j] = (f32x2){hy_short(pv[0], n, S, wv[0], wv[1], wv[2], wv[3]), hy_short(pv[1], n, S, wv[0], wv[1], wv[2], wv[3])}; }
                } else {
#pragma unroll 4
                    for (int j = 0; j < 32; ++j) { const int n = tq + 512 * j; f32x2 v = (f32x2){hy_short(pv[0], n, S, wv[0], wv[1], wv[2], wv[3]), hy_short(pv[1], n, S, wv[0], wv[1], wv[2], wv[3])}; HY_MOD(v, n); X[pb + 560 * j] = v; }
                }
            } else {
                if (half == 0) {
#pragma unroll 8
                    for (int j = 0; j < 32; ++j) { const int n = tq + 512 * j; X[pb + 560 * j] = Z1[n]; }
                } else {
#pragma unroll 8
                    for (int j = 0; j < 32; ++j) { const int n = tq + 512 * j; f32x2 v = Z1[n]; HY_MOD(v, n); X[pb + 560 * j] = v; }
                }
            }
#undef HY_MOD
            fft_fwd12(X, tid);
#pragma unroll
            for (int g = 0; g < 2; ++g) { int b16 = fphys((tid + 512 * g) * 16); asm volatile("" : "+v"(b16));
                f32x2 dx[16], bx[16];
#pragma unroll
                for (int q = 0; q < 16; ++q) dx[q] = X[b16 + q];
                dft_regs<16, 4, false>(dx);
#pragma unroll
                for (int m = 0; m < 16; ++m) bx[brev(m, 4)] = cmul(dx[m], (float)kpk[g][m][0], (float)kpk[g][m][1]);
                dft_regs<16, 4, true>(bx);
#pragma unroll
                for (int m = 0; m < 16; ++m) X[b16 + brev(m, 4)] = bx[m];
            }
            fft_inv21(X, tid);
            asm volatile("" : "+v"(pb), "+v"(tq));
            if (half == 0) {
#pragma unroll 8
                for (int j = 0; j < 32; ++j) { const int n = tq + 512 * j; Ye[n] = X[pb + 560 * j]; }
            } else {
#define HY_Y(n, j) const f32x2 yo = X[pb + 560 * (j)], ye = Ye[n]; \
                    const float rev = (float)(n) * (1.f / 32768.f); const float c = __builtin_amdgcn_cosf(rev), sn = __builtin_amdgcn_sinf(rev); \
                    const float y0 = (ye[0] + yo[0] * c - yo[1] * sn) * nrm, y1 = (ye[1] + yo[0] * sn + yo[1] * c) * nrm;
                if (cv == 0) {
#pragma unroll 4
                    for (int j = 0; j < 32; ++j) { const int n = tq + 512 * j; HY_Y(n, j)
                        const float v0 = hy_short(pv[0], n, S, wv[0], wv[1], wv[2], wv[3]), v1 = hy_short(pv[1], n, S, wv[0], wv[1], wv[2], wv[3]);
                        const float a0 = hy_short(px1[0], n, S, wx1[0], wx1[1], wx1[2], wx1[3]), a1 = hy_short(px1[1], n, S, wx1[0], wx1[1], wx1[2], wx1[3]);
                        Z1[n] = (f32x2){a0 * (y0 + skip * v0), a1 * (y1 + skip * v1)}; }
                } else {
                    bf16_t* mix = WSP(bf16_t, WS_HBF);
#pragma unroll 4
                    for (int j = 0; j < 32; ++j) { const int n = tq + 512 * j; HY_Y(n, j)
                        const f32x2 z1 = Z1[n];
                        const float a0 = hy_short(px2[0], n, S, wx2[0], wx2[1], wx2[2], wx2[3]), a1 = hy_short(px2[1], n, S, wx2[0], wx2[1], wx2[2], wx2[3]);
                        mix[((size_t)n) * D + 768 + ch] = f2bf(a0 * (y0 + skip * z1[0]));
                        mix[((size_t)S + n) * D + 768 + ch] = f2bf(a1 * (y1 + skip * z1[1])); }
                }
#undef HY_Y
            }
        }
    }
}
DI void hyena_ctx_unit(const Frame& F, int li, int ch) {
    float* vs = (float*)F.lds;
    float* zs = vs + 512;
    float* fl = zs + 512;
    const bf16_t* HYC = WSP(bf16_t, WS_HYC); const float* filt = WSP(float, WS_FILTC);
    const float* sw = F.in[I_HYSW] + (size_t)li * 3 * 768; const float* sb = F.in[I_HYSB] + li * 768; const float* sk = F.in[I_HSKIP] + li * 512;
    const float n0 = hy_norm(WSP(float, WS_FPARTC), 4, 0, ch), n1 = hy_norm(WSP(float, WS_FPARTC), 4, 1, ch);
    const int b = F.tid >> 8, t = F.tid & 255;
    auto sc = [&](int c) -> float { const bf16_t* p = HYC + (size_t)(b * CTX) * 768 + c;
        const float a = t > 0 ? bf2f(p[(size_t)(t - 1) * 768]) : 0.f, d = t + 1 < CTX ? bf2f(p[(size_t)(t + 1) * 768]) : 0.f;
        return a * sw[c] + bf2f(p[(size_t)t * 768]) * sw[768 + c] + d * sw[1536 + c] + sb[c]; };
    __syncthreads();
    const float x1 = sc(ch), x2 = sc(256 + ch), v = sc(512 + ch);
    vs[F.tid] = v;
    for (int i = F.tid; i < 1024; i += NTHR) fl[i] = filt[((size_t)(i >> 8) * 256 + ch) * CTX + (i & 255)];
    __syncthreads();
    float a = 0.f;
    for (int s = 0; s < CTX; ++s) { const int dl = t - s; a += (dl >= 0 ? fl[dl] : fl[256 - dl]) * vs[b * 256 + s]; }
    const float z = x1 * (a * n0 + sk[ch] * v);
    zs[F.tid] = z;
    __syncthreads();
    a = 0.f;
    for (int s = 0; s < CTX; ++s) { const int dl = t - s; a += (dl >= 0 ? fl[512 + dl] : fl[768 - dl]) * zs[b * 256 + s]; }
    WSP(bf16_t, WS_HBF)[((size_t)NLAT + b * CTX + t) * D + 768 + ch] = f2bf(x2 * (a * n1 + sk[256 + ch] * z));
}

DI void phase_mix(const Frame& F0, int li) {
    const Frame& F = F0;
    unsigned* head = F.ctl + CW_QHEAD + li * 64;
    volatile unsigned* qs = (volatile unsigned*)(F.lds + LDS_MISC + 32);
#ifndef PROBE_DA
#define PROBE_DA 1
#endif
#ifndef PROBE_HY
#define PROBE_HY 1
#endif
#ifndef PROBE_NA
#define PROBE_NA 1
#endif
#ifdef PROBE_MISC
#define PROBE_PL 2
#else
#define PROBE_PL 1
#endif
    const int n_ca = (li == 0) ? 8 : 0, n_cb = (li == 0) ? 8 : 0, n_da = 512 * PROBE_DA, n_hy = 256 * PROBE_HY, n_na = 512 * PROBE_NA, n_hc = (li == 0) ? 256 * PROBE_PL : 0, n_pl = 512 * PROBE_PL, n_pc = (li == 0) ? 8 : 0;
    const int total = n_ca + n_cb + n_da + n_hy + n_na + n_hc + n_pl + n_pc;
#if defined(PT_T) && PT_T >= 12
    unsigned long long ptk_acc = 0ull, ptk_t0 = 0ull; int ptk_kind = -1;
#endif
    for (;;) {
        __syncthreads();
#if defined(PT_T) && PT_T >= 12
        { const unsigned long long now_ = __builtin_amdgcn_s_memrealtime(); __builtin_amdgcn_s_waitcnt(0xC07F); if (ptk_kind == PT_T - 12) ptk_acc += now_ - ptk_t0; ptk_t0 = now_; }
#endif
        if (F.tid == 0) qs[0] = __hip_atomic_fetch_add(head, 1u, __ATOMIC_RELAXED, __HIP_MEMORY_SCOPE_AGENT);
        __syncthreads();
        int u = __builtin_amdgcn_readfirstlane((int)qs[0]);
#if defined(PT_T) && PT_T >= 12
        ptk_kind = u < n_ca + n_cb ? 0 : u < n_ca + n_cb + n_da ? 1 : u < n_ca + n_cb + n_da + n_hy ? 2 : u < n_ca + n_cb + n_da + n_hy + n_na ? 3 : u < n_ca + n_cb + n_da + n_hy + n_na + n_hc ? 4 : 5;
        if (u >= total) { if (F0.tid == 0) atomicAdd((unsigned long long*)(F0.ctl + 13000), ptk_acc); break; }
#endif
        if (u >= total) break;
        Frame F = F0; refresh(F);
        if (u < n_ca) {
#ifndef SKIP_CA
            diffattn_unit(F, li, u >> 2, u & 3, (size_t)NLAT + (size_t)(u >> 2) * CTX, CTX / 128);
#endif
            continue; }
        u -= n_ca;
        if (u < n_cb) {
#ifndef SKIP_CB
            na_mfma_unit(F, li, u >> 2, (size_t)NLAT + (size_t)(u >> 2) * CTX + (size_t)(u & 3) * 64, -1);
#endif
            continue; }
        u -= n_cb;
        if (u < n_da) {
#ifndef SKIP_DA
            { const int v = u & 511; diffattn_unit(F, li, v >> 8, (v >> 6) & 3, (size_t)(v >> 8) * S + (size_t)(v & 63) * 256, NKEY / 128); }
#endif
            continue; }
        u -= n_da;
        if (u < n_hy) {
#ifndef SKIP_HY
            hyena_fft_unit(F, li, u & 255);
#endif
            continue; }
        u -= n_hy;
        if (u < n_na) {
#ifndef SKIP_NA
            { const int v = u & 511; na_mfma_unit(F, li, v >> 8, (size_t)(v >> 8) * S + (size_t)(v & 255) * GW, v & 255); }
#endif
            continue; }
        u -= n_na;
        if (u < n_hc) {
#ifndef SKIP_HC
            hyena_ctx_unit(F, li, u & 255);
#endif
            continue; }
        u -= n_hc;
        if (u < n_pl) {
#ifndef SKIP_PL
            { const int v = u & 511; pool_unit(F, li, (size_t)(v >> 8) * S, S, (v & 255) * 64); }
#endif
            continue; }
        u -= n_pl;
#ifndef SKIP_PL
        pool_unit(F, li, (size_t)NLAT + (u >> 2) * CTX, CTX, (u & 3) * 64);
#endif
    }
}

constexpr int PH_PER_LAYER = 8, NPH = 2 + 2 * PH_PER_LAYER;
#ifdef PT_T
#define PT_SEL(k) (PT_T == 10 || (PT_T == 8 && (k) == 0) || (PT_T == 9 && (k) == NPH - 1) || (PT_T < 8 && (k) >= 1 && (k) <= 16 && (((k) - 1) & 7) == PT_T))
#define PT_MARK(k) do { const unsigned long long now_ = __builtin_amdgcn_s_memrealtime(); __builtin_amdgcn_s_waitcnt(0xC07F); if (PT_SEL(k)) pt_acc += now_ - pt_last; pt_last = now_; } while (0)
#ifndef PT_MULT
#define PT_MULT 4
#endif
#else
#define PT_MARK(k) do { } while (0)
#endif
__global__ void __launch_bounds__(NTHR, 2) mega(Args args) {
    extern __shared__ __attribute__((aligned(16))) unsigned char smem[];
    Frame F;
    F.in = args.in; F.out = args.out; F.ws = args.ws; F.ctl = (unsigned*)(args.ws + WS_CTL); F.lds = smem;
    F.tid = threadIdx.x; F.lane = F.tid & 63; F.wave = __builtin_amdgcn_readfirstlane(F.tid >> 6); F.G = gridDim.x; F.bid = blockIdx.x;
    if (F.tid < 64) ((unsigned*)(smem + LDS_MISC))[F.tid] = 0u;
    __syncthreads();
    const int lo = args.ph_lo, hi = args.ph_hi;
    const bool fused = (hi - lo) > 1;
    XcdBarrier bar; bar.bar = F.ctl; bar.x = 0; bar.st = (volatile LAS unsigned*)(smem + LDS_MISC);
    if (fused) bar = xcd_barrier_post(F.ctl, (volatile LAS unsigned*)(smem + LDS_MISC));
#define IN(k) (lo <= (k) && (k) < hi)
#ifdef PT_T
    unsigned long long pt_acc = 0ull, pt_last = __builtin_amdgcn_s_memrealtime(); __builtin_amdgcn_s_waitcnt(0xC07F);
#endif
#ifdef PROBE_BAR
#define SEAM(k) do { if (IN(k) && IN((k) + 1)) { xcd_barrier(bar); xcd_barrier(bar); xcd_barrier(bar); } } while (0)
#else
#define SEAM(k) do { if (IN(k) && IN((k) + 1)) xcd_barrier(bar); PT_MARK(k); } while (0)
#endif
#ifndef SKIP_P0
    if (IN(0)) { refresh(F); phase_prologue(F);
#ifdef PROBE_MISC
        __syncthreads(); refresh(F); phase_prologue(F);
#endif
    }
#endif
    SEAM(0);
    for (int li = 0; li < 2; ++li) {
        const int p0 = 1 + li * PH_PER_LAYER;
        const int nrows = (li == 0) ? NTOK : NLAT;
        if (IN(p0)) {
            refresh(F);
#if defined(PT_T) && PT_T >= 20 && PT_T <= 23
            const unsigned long long tn0_ = __builtin_amdgcn_s_memrealtime(); __builtin_amdgcn_s_waitcnt(0xC07F);
#endif
            phase_norm1(F, li, li == 0 ? 0 : 1);
#if defined(PT_T) && PT_T >= 20 && PT_T <= 23
            __syncthreads();
            const unsigned long long tn1_ = __builtin_amdgcn_s_memrealtime(); __builtin_amdgcn_s_waitcnt(0xC07F);
            if (threadIdx.x == 0 && PT_T == 20 + li) atomicAdd((unsigned long long*)(F.ctl + 13000), tn1_ - tn0_);
#endif
#ifdef PROBE_N1
            if (li == 0) { refresh(F); phase_norm1(F, li, 0); refresh(F); phase_norm1(F, li, 0); refresh(F); phase_norm1(F, li, 0); refresh(F); phase_norm1(F, li, 0); }
#endif
            refresh(F);
#ifndef SKIP_FILT
            for (int t = F.bid; t < 256; t += F.G) filter_tile(F, li, S, t, WSP(float, WS_FILT), WSP(float, WS_FPART));
            if (li == 0) for (int t = F.bid; t < 4; t += F.G) filter_tile(F, li, CTX, t, WSP(float, WS_FILTC), WSP(float, WS_FPARTC));
#ifdef PROBE_MISC
            for (int t = F.bid; t < 256; t += F.G) filter_tile(F, li, S, t, WSP(float, WS_FILT), WSP(float, WS_FPART));
#endif
#endif
#if defined(PT_T) && PT_T >= 20 && PT_T <= 23
            { __syncthreads(); const unsigned long long tn2_ = __builtin_amdgcn_s_memrealtime(); __builtin_amdgcn_s_waitcnt(0xC07F);
              if (threadIdx.x == 0 && PT_T == 22 + li) atomicAdd((unsigned long long*)(F.ctl + 13000), tn2_ - tn1_); }
#endif
        }
        SEAM(p0);
        if (IN(p0 + 1)) {
            refresh(F);
            pg8::Gemm g{WSP(bf16_t, WS_HBF), WSP(bf16_t, WS_WIN) + (size_t)li * DIN * D, D, 0};
            pg8::StaticOrder So; So.init(NTOK, DIN, F.G, F.bid);
            EpiIn E{F.ws, WSP(float, WS_ROPE), F.ctl + CW_KMAX + li * 16, F.ctl + CW_KMAXB + li * 16};
#ifndef SKIP_G1
            pg8::gemm_phase<EpiIn, pg8::StaticOrder>((LAS unsigned char*)smem, g, So, E, F.tid);
#ifdef PROBE_G1
            __syncthreads(); refresh(F); pg8::gemm_phase<EpiIn, pg8::StaticOrder>((LAS unsigned char*)smem, g, So, E, F.tid);
#endif
#endif
        }
        SEAM(p0 + 1);
        if (IN(p0 + 2)) { refresh(F); phase_mix(F, li); }
#if defined(PT_T) && PT_T == 11
        { const unsigned long long ta_ = __builtin_amdgcn_s_memrealtime(); __builtin_amdgcn_s_waitcnt(0xC07F);
          SEAM(p0 + 2);
          const unsigned long long tb_ = __builtin_amdgcn_s_memrealtime(); __builtin_amdgcn_s_waitcnt(0xC07F);
          if (threadIdx.x == 0) atomicAdd((unsigned long long*)(F.ctl + 13000), tb_ - ta_); }
#else
        SEAM(p0 + 2);
#endif
        if (IN(p0 + 3)) {
            refresh(F);
            pg8::Gemm g{WSP(bf16_t, WS_HBF), WSP(bf16_t, WS_WOUT) + (size_t)li * D * D, D, 0};
            pg8::StaticOrder So; So.init(nrows, D, F.G, F.bid);
            EpiOut E{li == 0 ? F.in[I_X] : F.out, li == 0 ? F.in[I_CTX] : WSP(float, WS_XC), F.out, WSP(float, WS_XC), WSP(float, WS_MOD) + (size_t)li * 3 * 6144};
#ifndef SKIP_G2
            pg8::gemm_phase<EpiOut, pg8::StaticOrder>((LAS unsigned char*)smem, g, So, E, F.tid);
#endif
        }
        SEAM(p0 + 3);
#ifndef SKIP_N2
        if (IN(p0 + 4)) { refresh(F); phase_norm2(F, li, nrows); }
#endif
        SEAM(p0 + 4);
        if (IN(p0 + 5)) { refresh(F); phase_gather(F, li, nrows);
#ifdef PROBE_MISC
            __syncthreads(); refresh(F); phase_gather(F, li, nrows);
#endif
        }
        SEAM(p0 + 5);
        if (IN(p0 + 6)) {
            refresh(F);
            int* offs = (int*)(smem + LDS_MISC + 64);
            moe_offsets(F, li, offs);
            pg8::Gemm g{WSP(bf16_t, WS_A1), WSP(bf16_t, WS_W13) + (size_t)li * NE * 1024 * 1024, D, (size_t)1024 * 1024};
            pg8::MoeOrder Mo{offs + 40, offs[17 + 16], 4, F.G, (F.G % 8 == 0) ? (F.bid % 8) * (F.G / 8) + F.bid / 8 : F.bid};
            EpiMoe1 E{WSP(bf16_t, WS_HMID)};
#ifndef SKIP_G3
            pg8::gemm_phase<EpiMoe1, pg8::MoeOrder>((LAS unsigned char*)smem, g, Mo, E, F.tid);
#ifdef PROBE_G3
            __syncthreads(); refresh(F); pg8::gemm_phase<EpiMoe1, pg8::MoeOrder>((LAS unsigned char*)smem, g, Mo, E, F.tid);
#endif
#endif
        }
        SEAM(p0 + 6);
        if (IN(p0 + 7)) {
            refresh(F);
            int* offs = (int*)(smem + LDS_MISC + 64);
            moe_offsets(F, li, offs);
            pg8::Gemm g{WSP(bf16_t, WS_HMID), WSP(bf16_t, WS_W2) + (size_t)li * NE * 1024 * 512, DE, (size_t)1024 * 512};
            pg8::MoeOrder Mo{offs + 40, offs[17 + 16], 4, F.G, (F.G % 8 == 0) ? (F.bid % 8) * (F.G / 8) + F.bid / 8 : F.bid};
            EpiMoe2 E{WSP(bf16_t, WS_A1)};
#ifndef SKIP_G4
            pg8::gemm_phase<EpiMoe2, pg8::MoeOrder>((LAS unsigned char*)smem, g, Mo, E, F.tid);
#ifdef PROBE_G4
            __syncthreads(); refresh(F); pg8::gemm_phase<EpiMoe2, pg8::MoeOrder>((LAS unsigned char*)smem, g, Mo, E, F.tid);
#endif
#endif
        }
        SEAM(p0 + 7);
    }
    if (IN(NPH - 1)) { refresh(F); phase_norm1(F, 1, 2); }
#ifdef PT_T
    asm volatile("s_waitcnt vmcnt(0)" ::: "memory"); __syncthreads();
    PT_MARK(NPH - 1);
#if PT_T >= 11
    xcd_barrier(bar);
    pt_acc = __hip_atomic_load((unsigned long long*)(F.ctl + 13000), __ATOMIC_RELAXED, __HIP_MEMORY_SCOPE_AGENT) / (unsigned long long)F.G;
    pt_last = __builtin_amdgcn_s_memrealtime();
#endif
    if (F.bid == 0) { const unsigned long long until = pt_last + (unsigned long long)PT_MULT * pt_acc;
        while (__builtin_amdgcn_s_memrealtime() < until) __builtin_amdgcn_s_sleep(8); }
#endif
#undef IN
#undef SEAM
}

extern "C" void kernel_launch(void* const* d_in, const int* in_sizes, int n_in, void* d_out, int out_size, void* d_ws, size_t ws_size, hipStream_t stream) {
    static int grid = 0;
    if (grid == 0) {
        if (n_in != N_IN || out_size != NLAT * D || ws_size < WS_END) { fprintf(stderr, "kernel_launch: unexpected shapes (n_in %d out %d ws %zu need %zu)\n", n_in, out_size, ws_size, (size_t)WS_END); grid = -1; return; }
        int dev = 0, cus = 0, per_cu = 0;
        if (hipGetDevice(&dev) != hipSuccess || hipDeviceGetAttribute(&cus, hipDeviceAttributeMultiprocessorCount, dev) != hipSuccess) { grid = -1; return; }
        if (hipFuncSetAttribute((const void*)mega, hipFuncAttributeMaxDynamicSharedMemorySize, LDS_BYTES) != hipSuccess) { fprintf(stderr, "kernel_launch: hipFuncSetAttribute failed\n"); grid = -1; return; }
        if (hipOccupancyMaxActiveBlocksPerMultiprocessor(&per_cu, (const void*)mega, NTHR, LDS_BYTES) != hipSuccess || per_cu < 1) { fprintf(stderr, "kernel_launch: occupancy query says %d\n", per_cu); }
        (void)hipGetLastError();
        grid = cus < MAXG ? cus : MAXG;
    }
    if (grid < 0) return;
    (void)hipMemsetAsync((char*)d_ws + WS_CTL, 0, CTL_BYTES, stream);
    Args a{};
    for (int i = 0; i < N_IN; ++i) a.in[i] = (const float*)d_in[i];
    a.out = (float*)d_out; a.ws = (unsigned char*)d_ws;
#if N_LAUNCH_MODE == 1
    a.ph_lo = 0; a.ph_hi = NPH;
    hipLaunchKernelGGL(mega, dim3(grid), dim3(NTHR), LDS_BYTES, stream, a);
#else
    for (int p = 0; p < NPH; ++p) { a.ph_lo = p; a.ph_hi = p + 1; hipLaunchKernelGGL(mega, dim3(grid), dim3(NTHR), LDS_BYTES, stream, a); }
#endif
}
#ifdef TEST_UNITS
__global__ void __launch_bounds__(NTHR, 2) t_da(Args args) {
    extern __shared__ __attribute__((aligned(16))) unsigned char smem[];
    Frame F; F.in = args.in; F.out = args.out; F.ws = args.ws; F.ctl = (unsigned*)(args.ws + WS_CTL); F.lds = smem; F.G = gridDim.x; F.bid = blockIdx.x; refresh(F);
    diffattn_unit(F, args.ph_lo, blockIdx.x >> 8, (blockIdx.x >> 6) & 3, (size_t)(blockIdx.x & 63) * 256, NKEY / 128);
}
__global__ void __launch_bounds__(NTHR, 2) t_hy(Args args) {
    extern __shared__ __attribute__((aligned(16))) unsigned char smem[];
    Frame F; F.in = args.in; F.out = args.out; F.ws = args.ws; F.ctl = (unsigned*)(args.ws + WS_CTL); F.lds = smem; F.G = gridDim.x; F.bid = blockIdx.x; refresh(F);
    hyena_fft_unit(F, args.ph_lo, blockIdx.x);
}
#endif
```

```cpp
#include <hip/hip_runtime.h>
#include <stdint.h>
#include <stdio.h>

#ifndef N_LAUNCH_MODE
#define N_LAUNCH_MODE 1
#endif

#define DI __device__ __forceinline__
#define LAS __attribute__((address_space(3)))
typedef unsigned short bf16_t;
typedef short bf16x8 __attribute__((ext_vector_type(8)));
typedef short s16x4 __attribute__((ext_vector_type(4)));
typedef float f32x4 __attribute__((ext_vector_type(4)));
typedef float f32x2 __attribute__((ext_vector_type(2)));
typedef float f32x16 __attribute__((ext_vector_type(16)));
typedef float f32x8 __attribute__((ext_vector_type(8)));
typedef unsigned u32x4 __attribute__((ext_vector_type(4)));
typedef unsigned u32x2 __attribute__((ext_vector_type(2)));
typedef _Float16 h16x2 __attribute__((ext_vector_type(2)));

constexpr int D = 1024, NB = 2, S = 16384, CTX = 256, NLAT = NB * S, NCTX = NB * CTX, NTOK = NLAT + NCTX, DIN = 2560;
constexpr int NE = 16, DE = 512, GW = 64;
constexpr int NKEY = CTX + S;
constexpr int NTHR = 512;
constexpr int SLOT_CAP = 70656;
constexpr float EPS = 1e-6f;
constexpr float LOG2E = 1.4426950408889634f;
constexpr float QSCALE_A = 0.17677669529663687f * LOG2E;
constexpr float QSCALE_B = 0.125f * LOG2E;

enum { I_X = 0, I_C, I_CTX, I_CCTX, I_N1G, I_N2G, I_ADAW, I_ADAB, I_WIN, I_WOUT, I_ALAM, I_ASUB, I_RPB, I_POOLW, I_POOLS, I_HYSW, I_HYSB,
       I_HW1, I_HB1, I_HW2, I_HB2, I_HW3, I_HB3, I_HSKIP, I_RW, I_RB, I_MW1, I_MW3, I_MW2, I_FG, N_IN };

struct Args { const float* in[N_IN]; float* out; unsigned char* ws; int ph_lo, ph_hi; };

constexpr size_t al256(size_t x) { return (x + 255) & ~(size_t)255; }
constexpr size_t WS_CTL = 0, CTL_BYTES = 65536;
constexpr size_t WS_MOD = WS_CTL + CTL_BYTES;
constexpr size_t WS_ROPE = WS_MOD + al256(2 * 3 * 6144 * 4);
constexpr size_t WS_PWT = WS_ROPE + 16384;
constexpr size_t WS_FPART = WS_PWT + 65536;
constexpr size_t WS_FPARTC = WS_FPART + 256 * 1024 * 4;
constexpr size_t WS_XC = WS_FPARTC + 4 * 1024 * 4;
constexpr size_t WS_WIN = WS_XC + (size_t)NCTX * D * 4;
constexpr size_t WS_WOUT = WS_WIN + (size_t)2 * DIN * D * 2;
constexpr size_t WS_W13 = WS_WOUT + (size_t)2 * D * D * 2;
constexpr size_t WS_W2 = WS_W13 + (size_t)2 * NE * 1024 * 1024 * 2;
constexpr size_t WS_FILT = WS_W2 + (size_t)2 * NE * 1024 * 512 * 2;
constexpr size_t WS_FILTC = WS_FILT + al256((size_t)4 * 256 * S * 2 + 64);
constexpr size_t WS_R1 = WS_FILTC + (size_t)4 * 256 * 256 * 2;
constexpr size_t WS_HBF = WS_R1;
constexpr size_t TOKB = (size_t)NTOK * 256 * 2;
constexpr size_t WS_AQ = WS_HBF + (size_t)NTOK * D * 2;
constexpr size_t WS_AK = WS_AQ + TOKB;
constexpr size_t WS_AVT = WS_AK + TOKB;
constexpr size_t WS_BQ = WS_AVT + (size_t)NB * 4 * 64 * NKEY * 2;
constexpr size_t WS_BK = WS_BQ + TOKB;
constexpr size_t WS_BVT = WS_BK + TOKB;
constexpr size_t WS_PL = WS_BVT + (size_t)NB * 4 * 64 * NKEY * 2;
constexpr size_t WS_HYT = WS_PL + TOKB;
constexpr size_t WS_HYC = WS_HYT + (size_t)NB * 768 * S * 2;
constexpr size_t WS_Z1BUF = WS_HYC + (size_t)NCTX * 768 * 2;
constexpr size_t WS_ZBUF = WS_Z1BUF + (size_t)256 * S * 8;
constexpr size_t WS_END_MIX = WS_ZBUF + (size_t)256 * S * 8;
constexpr size_t WS_TOK = WS_AQ;
constexpr size_t WS_A1 = WS_TOK + al256((size_t)NTOK * 32);
constexpr size_t WS_HMID = WS_A1 + (size_t)SLOT_CAP * D * 2;
constexpr size_t WS_RMAP = WS_HMID + (size_t)SLOT_CAP * DE * 2;
constexpr size_t WS_END_MOE = WS_RMAP + (size_t)SLOT_CAP * 4;
constexpr size_t WS_XB = al256(WS_END_MIX > WS_END_MOE ? WS_END_MIX : WS_END_MOE);
constexpr size_t WS_END = WS_XB + (size_t)NTOK * D * 2;

#define XB_TMO      128
#define XB_XCNT(j)  (256  + 64 * (j))
#define XB_XSUB(j)  (1280 + 64 * (j))
#define XB_XGEN(j)  (2304 + 64 * (j))
#define XB_TOP      3328
#define XB_TOPGEN   3392
#define XCD_BAR_WORDS 3456
#define XB_SPIN_CAP (1u << 18)
constexpr int CW_CNT = 4096;
constexpr int CW_KMAX = 4160;
constexpr int CW_KMAXB = 4192;
constexpr int CW_QHEAD = 4224;
constexpr int CW_BCNT = 4352;
constexpr int MAXG = 256;

constexpr int LDS_MAIN = 147456, LDS_MISC = LDS_MAIN, LDS_BYTES = LDS_MAIN + 2048;

DI float bf2f(bf16_t v) { return __uint_as_float(((unsigned)v) << 16); }
DI bf16_t f2bf(float f) { unsigned u = __float_as_uint(f); u += 0x7FFFu + ((u >> 16) & 1u); return (bf16_t)(u >> 16); }
DI unsigned pk2(float lo, float hi) { unsigned r; asm volatile("v_cvt_pk_bf16_f32 %0, %1, %2" : "=v"(r) : "v"(lo), "v"(hi)); return r; }
template <int K> DI float swz_xor(float v) { return __int_as_float(__builtin_amdgcn_ds_swizzle(__float_as_int(v), (K << 10) | 0x1F)); }
DI float half_sum(float v) { const auto r = __builtin_amdgcn_permlane32_swap(__float_as_uint(v), __float_as_uint(v), false, false); return __uint_as_float(r[0]) + __uint_as_float(r[1]); }
DI float half_max(float v) { const auto r = __builtin_amdgcn_permlane32_swap(__float_as_uint(v), __float_as_uint(v), false, false); return fmaxf(__uint_as_float(r[0]), __uint_as_float(r[1])); }
DI float wave_sum(float v) { v += swz_xor<16>(v); v += swz_xor<8>(v); v += swz_xor<4>(v); v += swz_xor<2>(v); v += swz_xor<1>(v); return half_sum(v); }
DI float wave_max(float v) { v = fmaxf(v, swz_xor<16>(v)); v = fmaxf(v, swz_xor<8>(v)); v = fmaxf(v, swz_xor<4>(v)); v = fmaxf(v, swz_xor<2>(v)); v = fmaxf(v, swz_xor<1>(v)); return half_max(v); }
DI f32x4 ld_bf4(const bf16_t* p) { const u32x2 v = *(const u32x2*)p; return (f32x4){__uint_as_float(v[0] << 16), __uint_as_float(v[0] & 0xffff0000u), __uint_as_float(v[1] << 16), __uint_as_float(v[1] & 0xffff0000u)}; }
DI f32x4 bf4_to_f4(u32x2 v) { return (f32x4){__uint_as_float(v[0] << 16), __uint_as_float(v[0] & 0xffff0000u), __uint_as_float(v[1] << 16), __uint_as_float(v[1] & 0xffff0000u)}; }
DI float siluf(float x) { return x * __builtin_amdgcn_rcpf(1.f + __expf(-x)); }
DI float sin_rev(float rev) { return __builtin_amdgcn_sinf(rev - floorf(rev)); }
DI float cos_rev(float rev) { return __builtin_amdgcn_cosf(rev - floorf(rev)); }
DI float sin_rad(float x) { return sin_rev(x * 0.15915494309189535f); }

DI unsigned xb_ld(unsigned* p)              { return __hip_atomic_load(p, __ATOMIC_RELAXED, __HIP_MEMORY_SCOPE_AGENT); }
DI unsigned xb_add(unsigned* p, unsigned v) { return __hip_atomic_fetch_add(p, v, __ATOMIC_RELAXED, __HIP_MEMORY_SCOPE_AGENT); }
DI unsigned xb_xcc_id() { return (unsigned)__builtin_amdgcn_s_getreg((3 << 11) | 20) & 0xFu; }
#define XB_SPIN(cond, bar) do { unsigned _sp = 0; while (cond) { __builtin_amdgcn_s_sleep(1); \
    if ((++_sp & 255u) == 0u) { if (xb_ld(&(bar)[XB_TMO])) break; if (_sp > XB_SPIN_CAP) { atomicAdd(&(bar)[XB_TMO], 1u); break; } } } } while (0)
struct XcdBarrier { unsigned* bar; unsigned x; volatile LAS unsigned* st; };
DI XcdBarrier xcd_barrier_post(unsigned* bar, volatile LAS unsigned* st) {
    XcdBarrier b; b.bar = bar; b.x = xb_xcc_id(); b.st = st;
    if (threadIdx.x == 0) (void)xb_add(&bar[XB_XCNT(b.x)], 1u);
    return b;
}
DI void xcd_barrier_complete(unsigned* bar, unsigned x, unsigned& nloc, unsigned& nx) {
    const unsigned G = gridDim.x * gridDim.y * gridDim.z;
    unsigned sum, cnt, mine, sp = 0u;
    for (;;) {
        sum = 0u; cnt = 0u; mine = 0u;
#pragma unroll
        for (unsigned j = 0; j < 16; ++j) { const unsigned c = xb_ld(&bar[XB_XCNT(j)]); sum += c; cnt += (c > 0u) ? 1u : 0u; mine = (j == x) ? c : mine; }
        if (sum == G) break;
        __builtin_amdgcn_s_sleep(1);
        if ((++sp & 255u) == 0u) { if (xb_ld(&bar[XB_TMO])) break; if (sp > XB_SPIN_CAP) { atomicAdd(&bar[XB_TMO], 1u); break; } }
    }
    nloc = mine > 0u ? mine : 1u; nx = cnt > 0u ? cnt : 1u;
}
DI void xcd_barrier(const XcdBarrier& b) {
    asm volatile("s_waitcnt vmcnt(0)" ::: "memory");
    __syncthreads();
    if (threadIdx.x == 0) {
        unsigned* bar = b.bar;
        __builtin_amdgcn_s_waitcnt(0);
        unsigned nloc = b.st[0], nx = b.st[1];
        if (nloc == 0u) { xcd_barrier_complete(bar, b.x, nloc, nx); b.st[0] = nloc; b.st[1] = nx; }
        const unsigned old = xb_add(&bar[XB_XSUB(b.x)], 1u);
        const unsigned gen = old / nloc;
        if (old + 1u == (gen + 1u) * nloc) {
            __builtin_amdgcn_fence(__ATOMIC_RELEASE, "agent");
            asm volatile("s_waitcnt vmcnt(0)" ::: "memory");
            const unsigned og = xb_add(&bar[XB_TOP], 1u);
            const unsigned tg = og / nx;
            if (og + 1u == (tg + 1u) * nx) xb_add(&bar[XB_TOPGEN], 1u);
            else XB_SPIN(xb_ld(&bar[XB_TOPGEN]) == tg, bar);
            __builtin_amdgcn_fence(__ATOMIC_ACQUIRE, "agent");
            xb_add(&bar[XB_XGEN(b.x)], 1u);
            asm volatile("s_waitcnt vmcnt(0)" ::: "memory");
        } else {
            XB_SPIN(xb_ld(&bar[XB_XGEN(b.x)]) == gen, bar);
            __builtin_amdgcn_fence(__ATOMIC_ACQUIRE, "agent");
            asm volatile("s_waitcnt vmcnt(0)" ::: "memory");
        }
    }
    __syncthreads();
}

struct Frame {
    const float* const* in; float* out; unsigned char* ws; unsigned* ctl;
    unsigned char* lds;
    int tid, lane, wave, G, bid;
};
#define WSP(T, off) ((T*)(F.ws + (off)))
DI void refresh(Frame& F) { int t = threadIdx.x; asm volatile("" : "+v"(t)); F.tid = t; F.lane = t & 63; F.wave = __builtin_amdgcn_readfirstlane(t >> 6);
}

namespace pg8 {
constexpr int BM = 256, BK = 64, HALF = 128, HTB = HALF * BK * 2, STAGE_BYTES = 8 * HTB, NXCD = 8, WGM = 8;
DI int lds_byte(int r, int c) { const int st = (r >> 4) * 2 + (c >> 5), rr = r & 15, cc = c & 31, ob = rr * 64 + cc * 2; return st * 1024 + (ob ^ (((ob >> 9) & 1) << 5)); }
DI void stage_rc(int b, int& R, int& C) { const int st = b / 1024, sb = b % 1024, swz = sb ^ (((sb >> 9) & 1) << 5); R = (st >> 1) * 16 + swz / 64; C = (st & 1) * 32 + (swz % 64) / 2; }
struct Unit { int pm, pn, e; };
struct Gemm { const bf16_t* A; const bf16_t* Bt; int K; size_t bstride; };
struct StaticOrder {
    int nM, nN, nwg, G, c;
    DI void init(int M, int N, int G_, int c_) { nM = M / BM; nN = N / BM; nwg = nM * nN; G = G_; c = c_; }
    DI bool next(int i, Unit& u) const {
        const long L = (long)i * G + c; if (L >= nwg) return false;
        int wgid = (int)L; { const int q = nwg / NXCD, r = nwg % NXCD, xcd = wgid % NXCD, off = wgid / NXCD; wgid = (xcd < r ? xcd * (q + 1) : r * (q + 1) + (xcd - r) * q) + off; }
        const int nig = WGM * nN, gid = wgid / nig, fm = gid * WGM, gsz = (nM - fm) < WGM ? (nM - fm) : WGM;
        u.pm = fm + ((wgid % nig) % gsz); u.pn = (wgid % nig) / gsz; u.e = 0; return true;
    }
};
struct MoeOrder {
    const int* toff; int ntile, nN, G, c;
    DI bool next(int i, Unit& u) const {
        const long L = (long)i * G + c; if (L >= (long)ntile * nN) return false;
        const int t = (int)(L / nN); u.pm = t; u.pn = (int)(L % nN);
        u.e = toff[t]; return true;
    }
};

template <class Epi, class Sched>
DI void gemm_phase(LAS unsigned char* lds, const Gemm g, const Sched& S, const Epi& E, int tid) {
    const int wid = __builtin_amdgcn_readfirstlane(tid >> 6), lane = tid & 63, wr = wid >> 2, wc = wid & 3, fr = lane & 15, fq = lane >> 4;
    const int K = g.K, nt = K / BK;
    unsigned voffA[2];
#pragma unroll
    for (int i = 0; i < 2; ++i) { int R, C; stage_rc(tid * 16 + i * 8192, R, C); voffA[i] = (unsigned)(R * K + C) * 2u; }
    const size_t kstep = (size_t)(BK * 2);
    const size_t hstep = (size_t)HALF * K * 2;
    const size_t tstep = 2 * hstep;
    const unsigned ldsw = (unsigned)wid * 1024u;
    const int aoff = lds_byte(wr * 64 + fr, fq * 8), boff = lds_byte(wc * 32 + fr, fq * 8);
#define PG8_SA(b, h) (((b) * 2 + (h)) * HTB)
#define PG8_SB(b, h) ((4 + (b) * 2 + (h)) * HTB)
#define PG8_STAGE(bufoff, gbase, voff) do { _Pragma("unroll") for (int _i = 0; _i < 2; ++_i) \
        __builtin_amdgcn_global_load_lds((const unsigned*)((const char*)(gbase) + (voff)[_i]), (LAS unsigned*)(lds + (bufoff) + ldsw + _i * 8192), 16, 0, 0); } while (0)
#define PG8_LDA(dst, b, h) do { _Pragma("unroll") for (int m = 0; m < 4; ++m) _Pragma("unroll") for (int k = 0; k < 2; ++k) dst[m][k] = *(const LAS bf16x8*)(lds + PG8_SA(b, h) + aoff + m * 2048 + k * 1024); } while (0)
#define PG8_LDB(dst, b, h) do { _Pragma("unroll") for (int n = 0; n < 2; ++n) _Pragma("unroll") for (int k = 0; k < 2; ++k) dst[n][k] = *(const LAS bf16x8*)(lds + PG8_SB(b, h) + boff + n * 2048 + k * 1024); } while (0)
#define PG8_MMA(ai, bj, At, Bt) do { __builtin_amdgcn_s_setprio(1); _Pragma("unroll") for (int m = 0; m < 4; ++m) _Pragma("unroll") for (int n = 0; n < 2; ++n) _Pragma("unroll") for (int k = 0; k < 2; ++k) \
        acc[ai][bj][m][n] = __builtin_amdgcn_mfma_f32_16x16x32_bf16(Bt[n][k], At[m][k], acc[ai][bj][m][n], 0, 0, 0); __builtin_amdgcn_s_setprio(0); } while (0)
#define PG8_WAIT_V(n) asm volatile("s_waitcnt vmcnt(" #n ")" ::: "memory")
#define PG8_WAIT_L(n) asm volatile("s_waitcnt lgkmcnt(" #n ")" ::: "memory")
#define PG8_BAR __builtin_amdgcn_s_barrier()
#define PG8_SCHED __builtin_amdgcn_sched_barrier(0)
    Unit cur, nxt; int ui = 0;
    if (!S.next(0, cur)) return;
    f32x4 acc[2][2][4][2];
#pragma unroll
    for (int a = 0; a < 2; ++a)
#pragma unroll
        for (int b = 0; b < 2; ++b)
#pragma unroll
            for (int m = 0; m < 4; ++m)
#pragma unroll
                for (int n = 0; n < 2; ++n) acc[a][b][m][n] = (f32x4){0.f, 0.f, 0.f, 0.f};
    bf16x8 At[4][2], B0[2][2], B1[2][2];
    const char* cA = (const char*)g.A + (size_t)cur.pm * tstep; const char* cB = (const char*)(g.Bt + (size_t)cur.e * g.bstride) + (size_t)cur.pn * tstep;
    PG8_STAGE(PG8_SB(0, 0), cB, voffA); PG8_STAGE(PG8_SA(0, 0), cA, voffA); PG8_STAGE(PG8_SB(0, 1), cB + hstep, voffA); PG8_STAGE(PG8_SA(0, 1), cA + hstep, voffA);
    if (wr == 1) PG8_BAR;
    PG8_WAIT_V(4); PG8_BAR;
    PG8_STAGE(PG8_SB(1, 0), cB + kstep, voffA); PG8_STAGE(PG8_SA(1, 0), cA + kstep, voffA); PG8_STAGE(PG8_SB(1, 1), cB + hstep + kstep, voffA);
    PG8_WAIT_V(6); PG8_BAR;
    for (;;) {
        const bool has_next = S.next(ui + 1, nxt);
        const char* nA = has_next ? (const char*)g.A + (size_t)nxt.pm * tstep : cA; const char* nB = has_next ? (const char*)(g.Bt + (size_t)nxt.e * g.bstride) + (size_t)nxt.pn * tstep : cB;
        for (int t = 0; t < nt; t += 2) {
            const bool last = (t == nt - 2);
            const char* a1 = cA + (size_t)(t + 1) * kstep;
            const char* a2 = last ? nA : cA + (size_t)(t + 2) * kstep; const char* b2 = last ? nB : cB + (size_t)(t + 2) * kstep;
            const char* a3 = a2 + kstep; const char* b3 = b2 + kstep;
            PG8_LDB(B0, 0, 0); PG8_SCHED; PG8_LDA(At, 0, 0); PG8_STAGE(PG8_SA(1, 1), a1 + hstep, voffA);
            PG8_WAIT_L(8); PG8_BAR; PG8_WAIT_L(0); PG8_MMA(0, 0, At, B0); PG8_BAR; PG8_SCHED;
            PG8_LDB(B1, 0, 1); PG8_STAGE(PG8_SB(0, 0), b2, voffA);
            PG8_BAR; PG8_WAIT_L(0); PG8_MMA(0, 1, At, B1); PG8_BAR;
            PG8_LDA(At, 0, 1); PG8_STAGE(PG8_SA(0, 0), a2, voffA);
            PG8_BAR; PG8_WAIT_L(0); PG8_MMA(1, 0, At, B0); PG8_BAR; PG8_SCHED;
            PG8_STAGE(PG8_SB(0, 1), b2 + hstep, voffA);
            PG8_WAIT_V(6); PG8_BAR; PG8_MMA(1, 1, At, B1); PG8_BAR;
            PG8_LDB(B0, 1, 0); PG8_SCHED; PG8_LDA(At, 1, 0); PG8_STAGE(PG8_SA(0, 1), a2 + hstep, voffA);
            PG8_WAIT_L(8); PG8_BAR; PG8_WAIT_L(0); PG8_MMA(0, 0, At, B0); PG8_BAR; PG8_SCHED;
            PG8_LDB(B1, 1, 1); PG8_STAGE(PG8_SB(1, 0), b3, voffA);
            PG8_BAR; PG8_WAIT_L(0); PG8_MMA(0, 1, At, B1); PG8_BAR;
            PG8_LDA(At, 1, 1); PG8_STAGE(PG8_SA(1, 0), a3, voffA);
            PG8_BAR; PG8_WAIT_L(0); PG8_MMA(1, 0, At, B0); PG8_BAR; PG8_SCHED;
            PG8_STAGE(PG8_SB(1, 1), b3 + hstep, voffA);
            PG8_WAIT_V(6); PG8_BAR; PG8_MMA(1, 1, At, B1); PG8_BAR;
        }
        E(acc, cur, wr, wc, fr, fq);
        if (!has_next) break;
#pragma unroll
        for (int a = 0; a < 2; ++a)
#pragma unroll
            for (int b = 0; b < 2; ++b)
#pragma unroll
                for (int m = 0; m < 4; ++m)
#pragma unroll
                    for (int n = 0; n < 2; ++n) acc[a][b][m][n] = (f32x4){0.f, 0.f, 0.f, 0.f};
        cur = nxt; cA = nA; cB = nB; ++ui;
    }
    PG8_WAIT_V(0);
    if (wr == 0) PG8_BAR;
    PG8_BAR;
#undef PG8_SA
#undef PG8_SB
#undef PG8_STAGE
#undef PG8_LDA
#undef PG8_LDB
#undef PG8_MMA
#undef PG8_WAIT_V
#undef PG8_WAIT_L
#undef PG8_BAR
#undef PG8_SCHED
}
template <class Epi, class Sched>
DI void gemm_phase_gather(LAS unsigned char* lds, const Gemm g, const Sched& S, const Epi& E, int tid, const int* rowmap) {
    const int wid = __builtin_amdgcn_readfirstlane(tid >> 6), lane = tid & 63, wr = wid >> 2, wc = wid & 3, fr = lane & 15, fq = lane >> 4;
    const int K = g.K, nt = K / BK;
    unsigned voffA[2];
#pragma unroll
    for (int i = 0; i < 2; ++i) { int R, C; stage_rc(tid * 16 + i * 8192, R, C); voffA[i] = (unsigned)(R * K + C) * 2u; }
    const unsigned rowb = (unsigned)K * 2u;
#define PG8_ROWS_PK(pm, P) do { int t_ = tid; asm volatile("" : "+v"(t_)); int R0_, C0_, R1_, C1_; stage_rc(t_ * 16, R0_, C0_); stage_rc(t_ * 16 + 8192, R1_, C1_); \
        _Pragma("unroll") for (int h_ = 0; h_ < 2; ++h_) P[h_] = (unsigned)rowmap[(pm) * 256 + h_ * 128 + R0_] | ((unsigned)rowmap[(pm) * 256 + h_ * 128 + R1_] << 16); } while (0)
#define PG8_UNPK(P, O) do { int t_ = tid; asm volatile("" : "+v"(t_)); int R0_, C0_, R1_, C1_; stage_rc(t_ * 16, R0_, C0_); stage_rc(t_ * 16 + 8192, R1_, C1_); \
        _Pragma("unroll") for (int h_ = 0; h_ < 2; ++h_) { O[h_][0] = (P[h_] & 0xffffu) * rowb + (unsigned)C0_ * 2u; O[h_][1] = (P[h_] >> 16) * rowb + (unsigned)C1_ * 2u; } } while (0)
    const size_t kstep = (size_t)(BK * 2);
    const size_t hstep = (size_t)HALF * K * 2;
    const size_t tstep = 2 * hstep;
    const unsigned ldsw = (unsigned)wid * 1024u;
    const int aoff = lds_byte(wr * 64 + fr, fq * 8), boff = lds_byte(wc * 32 + fr, fq * 8);
#define PG8_SA(b, h) (((b) * 2 + (h)) * HTB)
#define PG8_SB(b, h) ((4 + (b) * 2 + (h)) * HTB)
#define PG8_STAGE(bufoff, gbase, voff) do { _Pragma("unroll") for (int _i = 0; _i < 2; ++_i) \
        __builtin_amdgcn_global_load_lds((const unsigned*)((const char*)(gbase) + (voff)[_i]), (LAS unsigned*)(lds + (bufoff) + ldsw + _i * 8192), 16, 0, 0); } while (0)
#define PG8_LDA(dst, b, h) do { _Pragma("unroll") for (int m = 0; m < 4; ++m) _Pragma("unroll") for (int k = 0; k < 2; ++k) dst[m][k] = *(const LAS bf16x8*)(lds + PG8_SA(b, h) + aoff + m * 2048 + k * 1024); } while (0)
#define PG8_LDB(dst, b, h) do { _Pragma("unroll") for (int n = 0; n < 2; ++n) _Pragma("unroll") for (int k = 0; k < 2; ++k) dst[n][k] = *(const LAS bf16x8*)(lds + PG8_SB(b, h) + boff + n * 2048 + k * 1024); } while (0)
#define PG8_MMA(ai, bj, At, Bt) do { __builtin_amdgcn_s_setprio(1); _Pragma("unroll") for (int m = 0; m < 4; ++m) _Pragma("unroll") for (int n = 0; n < 2; ++n) _Pragma("unroll") for (int k = 0; k < 2; ++k) \
        acc[ai][bj][m][n] = __builtin_amdgcn_mfma_f32_16x16x32_bf16(Bt[n][k], At[m][k], acc[ai][bj][m][n], 0, 0, 0); __builtin_amdgcn_s_setprio(0); } while (0)
#define PG8_WAIT_V(n) asm volatile("s_waitcnt vmcnt(" #n ")" ::: "memory")
#define PG8_WAIT_L(n) asm volatile("s_waitcnt lgkmcnt(" #n ")" ::: "memory")
#define PG8_BAR __builtin_amdgcn_s_barrier()
#define PG8_SCHED __builtin_amdgcn_sched_barrier(0)
    Unit cur, nxt; int ui = 0;
    if (!S.next(0, cur)) return;
    f32x4 acc[2][2][4][2];
#pragma unroll
    for (int a = 0; a < 2; ++a)
#pragma unroll
        for (int b = 0; b < 2; ++b)
#pragma unroll
            for (int m = 0; m < 4; ++m)
#pragma unroll
                for (int n = 0; n < 2; ++n) acc[a][b][m][n] = (f32x4){0.f, 0.f, 0.f, 0.f};
    bf16x8 At[4][2], B0[2][2], B1[2][2];
    unsigned offC[2][2], pkN[2];
    PG8_ROWS_PK(cur.pm, pkN); PG8_UNPK(pkN, offC);
    const char* cA = (const char*)g.A; const char* cB = (const char*)(g.Bt + (size_t)cur.e * g.bstride) + (size_t)cur.pn * tstep;
    PG8_STAGE(PG8_SB(0, 0), cB, voffA); PG8_STAGE(PG8_SA(0, 0), cA, offC[0]); PG8_STAGE(PG8_SB(0, 1), cB + hstep, voffA); PG8_STAGE(PG8_SA(0, 1), cA, offC[1]);
    if (wr == 1) PG8_BAR;
    PG8_WAIT_V(4); PG8_BAR;
    PG8_STAGE(PG8_SB(1, 0), cB + kstep, voffA); PG8_STAGE(PG8_SA(1, 0), cA + kstep, offC[0]); PG8_STAGE(PG8_SB(1, 1), cB + hstep + kstep, voffA);
    PG8_WAIT_V(6); PG8_BAR;
    for (;;) {
        const bool has_next = S.next(ui + 1, nxt);
        if (has_next) PG8_ROWS_PK(nxt.pm, pkN);
        const char* nB = has_next ? (const char*)(g.Bt + (size_t)nxt.e * g.bstride) + (size_t)nxt.pn * tstep : cB;
        for (int t = 0; t < nt; t += 2) {
            const bool last = (t == nt - 2);
            const char* a1 = cA + (size_t)(t + 1) * kstep;
            const char* a2 = last ? cA : cA + (size_t)(t + 2) * kstep;
            const char* b2 = last ? nB : cB + (size_t)(t + 2) * kstep;
            const char* a3 = a2 + kstep; const char* b3 = b2 + kstep;
            PG8_LDB(B0, 0, 0); PG8_SCHED; PG8_LDA(At, 0, 0); PG8_STAGE(PG8_SA(1, 1), a1, offC[1]);
            if (last) PG8_UNPK(pkN, offC);
            PG8_WAIT_L(8); PG8_BAR; PG8_WAIT_L(0); PG8_MMA(0, 0, At, B0); PG8_BAR; PG8_SCHED;
            PG8_LDB(B1, 0, 1); PG8_STAGE(PG8_SB(0, 0), b2, voffA);
            PG8_BAR; PG8_WAIT_L(0); PG8_MMA(0, 1, At, B1); PG8_BAR;
            PG8_LDA(At, 0, 1); PG8_STAGE(PG8_SA(0, 0), a2, offC[0]);
            PG8_BAR; PG8_WAIT_L(0); PG8_MMA(1, 0, At, B0); PG8_BAR; PG8_SCHED;
            PG8_STAGE(PG8_SB(0, 1), b2 + hstep, voffA);
            PG8_WAIT_V(6); PG8_BAR; PG8_MMA(1, 1, At, B1); PG8_BAR;
            PG8_LDB(B0, 1, 0); PG8_SCHED; PG8_LDA(At, 1, 0); PG8_STAGE(PG8_SA(0, 1), a2, offC[1]);
            PG8_WAIT_L(8); PG8_BAR; PG8_WAIT_L(0); PG8_MMA(0, 0, At, B0); PG8_BAR; PG8_SCHED;
            PG8_LDB(B1, 1, 1); PG8_STAGE(PG8_SB(1, 0), b3, voffA);
            PG8_BAR; PG8_WAIT_L(0); PG8_MMA(0, 1, At, B1); PG8_BAR;
            PG8_LDA(At, 1, 1); PG8_STAGE(PG8_SA(1, 0), a3, offC[0]);
            PG8_BAR; PG8_WAIT_L(0); PG8_MMA(1, 0, At, B0); PG8_BAR; PG8_SCHED;
            PG8_STAGE(PG8_SB(1, 1), b3 + hstep, voffA);
            PG8_WAIT_V(6); PG8_BAR; PG8_MMA(1, 1, At, B1); PG8_BAR;
        }
        E(acc, cur, wr, wc, fr, fq);
        if (!has_next) break;
#pragma unroll
        for (int a = 0; a < 2; ++a)
#pragma unroll
            for (int b = 0; b < 2; ++b)
#pragma unroll
                for (int m = 0; m < 4; ++m)
#pragma unroll
                    for (int n = 0; n < 2; ++n) acc[a][b][m][n] = (f32x4){0.f, 0.f, 0.f, 0.f};
        cur = nxt; cB = nB; ++ui;
    }
    PG8_WAIT_V(0);
    if (wr == 0) PG8_BAR;
    PG8_BAR;
#undef PG8_ROWS_PK
#undef PG8_UNPK
#undef PG8_SA
#undef PG8_SB
#undef PG8_STAGE
#undef PG8_LDA
#undef PG8_LDB
#undef PG8_MMA
#undef PG8_WAIT_V
#undef PG8_WAIT_L
#undef PG8_BAR
#undef PG8_SCHED
}
}

typedef f32x4 AccT[2][2][4][2];

struct EpiIn {
    unsigned char* ws; const float* rope; unsigned* kmax; unsigned* kmaxb;
    DI void operator()(const AccT& acc, const pg8::Unit& u, int wr, int wc, int fr, int fq) const {
        const int pn = u.pn, row0 = u.pm * 256 + wr * 64 + fr;
        const bool isctx = (u.pm >= NLAT / 256);
        if (pn <= 1) {
            bf16_t* dst = (bf16_t*)(ws + (pn == 0 ? WS_AQ : WS_AK));
            const float sc = (pn == 0) ? QSCALE_A : 1.f;
            float nmax[2] = {0.f, 0.f};
#pragma unroll
            for (int ai = 0; ai < 2; ++ai)
#pragma unroll
                for (int m = 0; m < 4; ++m) {
                    const int r = row0 + ai * 128 + m * 16;
                    f32x4 cs0 = (f32x4){1.f, 0.f, 1.f, 0.f}, cs1 = cs0;
                    if (!isctx) { const int t = r & (S - 1); const int pos = (fq < 2) ? (t >> 6) : (t & 63);
                        const f32x4* tp = (const f32x4*)(rope + (size_t)pos * 16 + (fq & 1) * 8); cs0 = tp[0]; cs1 = tp[1]; }
                    const float cc[4] = {cs0[0], cs0[2], cs1[0], cs1[2]}, ss[4] = {cs0[1], cs0[3], cs1[1], cs1[3]};
#pragma unroll
                    for (int bj = 0; bj < 2; ++bj) {
                        const f32x4 x1 = acc[ai][bj][m][0], x2 = acc[ai][bj][m][1];
                        float o1[4], o2[4], n2 = 0.f;
#pragma unroll
                        for (int j = 0; j < 4; ++j) { o1[j] = (x1[j] * cc[j] - x2[j] * ss[j]) * sc; o2[j] = (x2[j] * cc[j] + x1[j] * ss[j]) * sc; n2 += x1[j] * x1[j] + x2[j] * x2[j]; }
                        bf16_t* p = dst + (size_t)r * 256 + bj * 128 + wc * 32 + 4 * fq;
                        *(u32x2*)p = (u32x2){pk2(o1[0], o1[1]), pk2(o1[2], o1[3])};
                        *(u32x2*)(p + 16) = (u32x2){pk2(o2[0], o2[1]), pk2(o2[2], o2[3])};
                        if (pn == 1) { n2 += swz_xor<16>(n2); n2 = half_sum(n2); nmax[bj] = fmaxf(nmax[bj], n2); }
                    }
                }
            if (pn == 1) {
                const int b = isctx ? (u.pm - NLAT / 256) : (u.pm / (S / 256));
#pragma unroll
                for (int bj = 0; bj < 2; ++bj) {
                    float v = nmax[bj];
                    v = fmaxf(v, swz_xor<1>(v)); v = fmaxf(v, swz_xor<2>(v)); v = fmaxf(v, swz_xor<4>(v)); v = fmaxf(v, swz_xor<8>(v));
                    if ((fr | fq) == 0) atomicMax(kmax + (b * 4 + (2 * bj + (wc >> 1))) * 2 + (wc & 1), __float_as_uint(v));
                }
            }
        } else if (pn == 2 || pn == 5) {
            bf16_t* dst = (bf16_t*)(ws + (pn == 2 ? WS_AVT : WS_BVT));
#pragma unroll
            for (int ai = 0; ai < 2; ++ai)
#pragma unroll
                for (int m = 0; m < 4; ++m) {
                    const int r = row0 + ai * 128 + m * 16;
                    int b, key; if (isctx) { b = (r - NLAT) >> 8; key = (r - NLAT) & 255; } else { b = r >> 14; key = CTX + (r & (S - 1)); }
                    key = (key & ~12) | ((key & 4) << 1) | ((key & 8) >> 1);
#pragma unroll
                    for (int bj = 0; bj < 2; ++bj)
#pragma unroll
                        for (int n = 0; n < 2; ++n) {
                            const int lc = bj * 128 + wc * 32 + n * 16 + 4 * fq;
#pragma unroll
                            for (int j = 0; j < 4; ++j) dst[((size_t)(b * 256 + lc + j)) * NKEY + key] = f2bf(acc[ai][bj][m][n][j]);
                        }
                }
        } else if (pn <= 6) {
            bf16_t* dst = (bf16_t*)(ws + (pn == 3 ? WS_BQ : pn == 4 ? WS_BK : WS_PL));
            const float sc = (pn == 3) ? QSCALE_B : 1.f;
            float nmax[2] = {0.f, 0.f};
#pragma unroll
            for (int ai = 0; ai < 2; ++ai)
#pragma unroll
                for (int m = 0; m < 4; ++m) {
                    const int r = row0 + ai * 128 + m * 16;
#pragma unroll
                    for (int bj = 0; bj < 2; ++bj)
#pragma unroll
                        for (int n = 0; n < 2; ++n) {
                            const f32x4 v = acc[ai][bj][m][n] * sc;
                            *(u32x2*)(dst + (size_t)r * 256 + bj * 128 + wc * 32 + n * 16 + 4 * fq) = (u32x2){pk2(v[0], v[1]), pk2(v[2], v[3])};
                        }
                    if (pn == 4) {
#pragma unroll
                        for (int bj = 0; bj < 2; ++bj) { const f32x4 x1 = acc[ai][bj][m][0], x2 = acc[ai][bj][m][1];
                            float n2 = x1[0] * x1[0] + x1[1] * x1[1] + x1[2] * x1[2] + x1[3] * x1[3] + x2[0] * x2[0] + x2[1] * x2[1] + x2[2] * x2[2] + x2[3] * x2[3];
                            n2 += swz_xor<16>(n2); n2 = half_sum(n2); nmax[bj] = fmaxf(nmax[bj], n2); }
                    }
                }
            if (pn == 4) {
                const int b = isctx ? (u.pm - NLAT / 256) : (u.pm / (S / 256));
#pragma unroll
                for (int bj = 0; bj < 2; ++bj) {
                    float v = nmax[bj];
                    v = fmaxf(v, swz_xor<1>(v)); v = fmaxf(v, swz_xor<2>(v)); v = fmaxf(v, swz_xor<4>(v)); v = fmaxf(v, swz_xor<8>(v));
                    if ((fr | fq) == 0) atomicMax(kmaxb + (b * 4 + (2 * bj + (wc >> 1))) * 2 + (wc & 1), __float_as_uint(v));
                }
            }
        } else {
            const int hc0 = (pn - 7) * 256;
#pragma unroll
            for (int ai = 0; ai < 2; ++ai)
#pragma unroll
                for (int m = 0; m < 4; ++m) {
                    const int r = row0 + ai * 128 + m * 16;
#pragma unroll
                    for (int bj = 0; bj < 2; ++bj)
#pragma unroll
                        for (int n = 0; n < 2; ++n) {
                            const int hc = hc0 + bj * 128 + wc * 32 + n * 16 + 4 * fq; const f32x4 v = acc[ai][bj][m][n];
                            if (isctx) *(u32x2*)((bf16_t*)(ws + WS_HYC) + (size_t)(r - NLAT) * 768 + hc) = (u32x2){pk2(v[0], v[1]), pk2(v[2], v[3])};
                            else { bf16_t* dst = (bf16_t*)(ws + WS_HYT) + ((size_t)(r >> 14) * 768 + hc) * S + (r & (S - 1));
#pragma unroll
                                for (int j = 0; j < 4; ++j) dst[(size_t)j * S] = f2bf(v[j]); }
                        }
                }
        }
    }
};

struct EpiOut {
    const float* xl_in; const float* xc_in; bf16_t* xb; const float* mod; bool from_inputs;
    DI void operator()(const AccT& acc, const pg8::Unit& u, int wr, int wc, int fr, int fq) const {
        const int row0 = u.pm * 256 + wr * 64 + fr; const bool isctx = (u.pm >= NLAT / 256);
        const int v = isctx ? 2 : (u.pm / (S / 256));
        const float* g1 = mod + (size_t)v * 6144 + 2 * 1024;
        const float* so = isctx ? xc_in - (size_t)NLAT * D : xl_in;
#pragma unroll
        for (int bj = 0; bj < 2; ++bj)
#pragma unroll
            for (int n = 0; n < 2; ++n) {
                const int c = u.pn * 256 + bj * 128 + wc * 32 + n * 16 + 4 * fq;
                const f32x4 g = *(const f32x4*)(g1 + c);
#pragma unroll
                for (int ai = 0; ai < 2; ++ai)
#pragma unroll
                    for (int m = 0; m < 4; ++m) {
                        const size_t o = (size_t)(row0 + ai * 128 + m * 16) * D + c;
                        const f32x4 xo = from_inputs ? *(const f32x4*)(so + o) : ld_bf4(xb + o);
                        const f32x4 xn = xo + g * acc[ai][bj][m][n];
                        *(u32x2*)(xb + o) = (u32x2){pk2(xn[0], xn[1]), pk2(xn[2], xn[3])};
                    }
            }
    }
};

struct EpiMoe1 {
    bf16_t* hmid;
    DI void operator()(const AccT& acc, const pg8::Unit& u, int wr, int wc, int fr, int fq) const {
        const int row0 = u.pm * 256 + wr * 64 + fr;
#pragma unroll
        for (int ai = 0; ai < 2; ++ai)
#pragma unroll
            for (int m = 0; m < 4; ++m)
#pragma unroll
                for (int bj = 0; bj < 2; ++bj) {
                    const f32x4 a = acc[ai][bj][m][0], b = acc[ai][bj][m][1]; float h[4];
#pragma unroll
                    for (int j = 0; j < 4; ++j) h[j] = siluf(a[j]) * b[j];
                    *(u32x2*)(hmid + (size_t)(row0 + ai * 128 + m * 16) * DE + (u.pn * 256 + bj * 128 + wc * 32) / 2 + 4 * fq) = (u32x2){pk2(h[0], h[1]), pk2(h[2], h[3])};
                }
    }
};
struct EpiMoe2 {
    bf16_t* ys;
    DI void operator()(const AccT& acc, const pg8::Unit& u, int wr, int wc, int fr, int fq) const {
        const int row0 = u.pm * 256 + wr * 64 + fr;
#pragma unroll
        for (int ai = 0; ai < 2; ++ai)
#pragma unroll
            for (int m = 0; m < 4; ++m)
#pragma unroll
                for (int bj = 0; bj < 2; ++bj)
#pragma unroll
                    for (int n = 0; n < 2; ++n) { const f32x4 v = acc[ai][bj][m][n];
                        *(u32x2*)(ys + (size_t)(row0 + ai * 128 + m * 16) * D + u.pn * 256 + bj * 128 + wc * 32 + n * 16 + 4 * fq) = (u32x2){pk2(v[0], v[1]), pk2(v[2], v[3])}; }
    }
};

struct TcTile { const float* src; bf16_t* dst; int N, k0, n0, ldd, mode; };
DI TcTile tconv_desc(const Frame& F, int u) {
    const int T_IN = 16 * 40, T_OUT = 16 * 16, T_E = 16 * 8;
    const int per_layer = T_IN + T_OUT + NE * 3 * T_E;
    const int li = u / per_layer; int r = u % per_layer; TcTile t;
    if (r < T_IN) { t.src = F.in[I_WIN] + (size_t)li * D * DIN; t.N = DIN; t.k0 = (r / 40) * 64; t.n0 = (r % 40) * 64; t.dst = WSP(bf16_t, WS_WIN) + (size_t)li * DIN * D; t.ldd = D; t.mode = 0; return t; }
    r -= T_IN;
    if (r < T_OUT) { t.src = F.in[I_WOUT] + (size_t)li * D * D; t.N = D; t.k0 = (r / 16) * 64; t.n0 = (r % 16) * 64; t.dst = WSP(bf16_t, WS_WOUT) + (size_t)li * D * D; t.ldd = D; t.mode = 0; return t; }
    r -= T_OUT;
    const int e = r / (3 * T_E), w = (r / T_E) % 3, q = r % T_E;
    if (w < 2) { t.src = F.in[w == 0 ? I_MW1 : I_MW3] + ((size_t)li * NE + e) * D * DE; t.N = DE; t.k0 = (q / 8) * 64; t.n0 = (q % 8) * 64; t.dst = WSP(bf16_t, WS_W13) + ((size_t)li * NE + e) * 1024 * 1024; t.ldd = D; t.mode = 1 + w; }
    else { t.src = F.in[I_MW2] + ((size_t)li * NE + e) * DE * D; t.N = D; t.k0 = (q / 16) * 64; t.n0 = (q % 16) * 64; t.dst = WSP(bf16_t, WS_W2) + ((size_t)li * NE + e) * 1024 * 512; t.ldd = DE; t.mode = 0; }
    return t;
}
DI void phase_prologue(const Frame& F) {
    {
        const int total = 2 * (16 * 40 + 16 * 16 + NE * 3 * 16 * 8);
        float* tl = (float*)F.lds;
        float v[8];
        int u = F.bid;
        if (u < total) { const TcTile t = tconv_desc(F, u);
#pragma unroll
            for (int i = 0; i < 8; ++i) { const int idx = F.tid + 512 * i, k = idx >> 6, n = idx & 63; v[i] = t.src[(size_t)(t.k0 + k) * t.N + t.n0 + n]; } }
        for (; u < total; u += F.G) {
            const TcTile t = tconv_desc(F, u);
            __syncthreads();
#pragma unroll
            for (int i = 0; i < 8; ++i) { const int idx = F.tid + 512 * i, k = idx >> 6, n = idx & 63; tl[k * 65 + n] = v[i]; }
            __syncthreads();
            if (u + F.G < total) { const TcTile tn = tconv_desc(F, u + F.G);
#pragma unroll
                for (int i = 0; i < 8; ++i) { const int idx = F.tid + 512 * i, k = idx >> 6, n = idx & 63; v[i] = tn.src[(size_t)(tn.k0 + k) * tn.N + tn.n0 + n]; } }
#pragma unroll
            for (int i = 0; i < 4; ++i) { const int idx = F.tid + 512 * i, n = idx >> 5, kp = idx & 31;
                const int nn = t.n0 + n; const int row = (t.mode == 0) ? nn : ((nn >> 4) * 32 + (t.mode - 1) * 16 + (nn & 15));
                *(unsigned*)(t.dst + (size_t)row * t.ldd + t.k0 + 2 * kp) = pk2(tl[(2 * kp) * 65 + n], tl[(2 * kp + 1) * 65 + n]); }
        }
    }
    __syncthreads();
    {
        float* sc = (float*)F.lds;
        float* red = sc + 3072;
        for (int i = F.tid; i < 3072; i += NTHR) { const int v = i >> 10, k = i & 1023; const float x = (v < 2) ? F.in[I_C][v * 1024 + k] : F.in[I_CCTX][k]; sc[i] = siluf(x); }
        __syncthreads();
        for (int u = F.bid; u < 2 * 96; u += F.G) {
            const int li = u / 96, j = (u % 96) * 64 + F.lane, ko = F.wave;
            const float* w = F.in[I_ADAW] + (size_t)li * D * 6144 + j;
            float a0 = 0.f, a1 = 0.f, a2 = 0.f;
            for (int k = ko * 128; k < ko * 128 + 128; ++k) { const float wv = w[(size_t)k * 6144]; a0 += sc[k] * wv; a1 += sc[1024 + k] * wv; a2 += sc[2048 + k] * wv; }
            red[(ko * 3 + 0) * 64 + F.lane] = a0; red[(ko * 3 + 1) * 64 + F.lane] = a1; red[(ko * 3 + 2) * 64 + F.lane] = a2;
            __syncthreads();
            if (F.tid < 192) { const int v = F.tid / 64, l = F.tid % 64; float s = 0.f;
#pragma unroll
                for (int q = 0; q < 8; ++q) s += red[(q * 3 + v) * 64 + l];
                const int jj = (u % 96) * 64 + l;
                WSP(float, WS_MOD)[((size_t)li * 3 + v) * 6144 + jj] = s + F.in[I_ADAB][li * 6144 + jj]; }
            __syncthreads();
        }
    }
    if (F.bid == (F.G > 2 ? 2 : 0)) {
        for (int idx = F.tid; idx < 2 * 4 * 64 * 64; idx += NTHR) { const int i = idx & 63, j = (idx >> 6) & 63, lg = idx >> 12;
            WSP(bf16_t, WS_PWT)[idx] = f2bf(F.in[I_POOLW][((size_t)lg * 64 + i) * 64 + j]); }
    }
    if (F.bid == (F.G > 1 ? 1 : 0)) {
        for (int i = F.tid; i < 256 * 8; i += NTHR) { const int pos = i >> 3, f = i & 7; const float inv = exp2f(-(float)f * (13.287712379549449f / 8.f)); const float rev = (float)pos * inv * 0.15915494309189535f;
            WSP(float, WS_ROPE)[i * 2] = cos_rev(rev); WSP(float, WS_ROPE)[i * 2 + 1] = sin_rev(rev); }
    }
}

#define MFMA32(a, b, c) __builtin_amdgcn_mfma_f32_32x32x16_bf16((a), (b), (c), 0, 0, 0)
DI void filter_tile(const Frame& F, int li, int L, int tile, _Float16* hT, float* part) {
    float* h1s = (float*)F.lds;
    float* h2s = h1s + 64 * 65;
    float* w1s = h2s + 64 * 68;
    float* w2s = w1s + 34 * 64;
    const float* w3 = F.in[I_HW3] + (size_t)li * 64 * 1024; const float* b3 = F.in[I_HB3] + li * 1024;
    const int t0 = tile * 64;
    const float inv_lm1 = 1.f / (float)(L > 1 ? L - 1 : 1);
    __syncthreads();
    {
        const float* w1 = F.in[I_HW1] + (size_t)li * 33 * 64; const float* b1 = F.in[I_HB1] + li * 64;
        const float* w2 = F.in[I_HW2] + (size_t)li * 64 * 64; const float* b2 = F.in[I_HB2] + li * 64;
        for (int i = F.tid; i < 33 * 64; i += NTHR) w1s[i] = w1[i];
        for (int i = F.tid; i < 4096; i += NTHR) w2s[i] = w2[i];
        if (F.tid < 64) { w1s[33 * 64 + F.tid] = b1[F.tid]; w2s[4096 + F.tid] = b2[F.tid]; }
    }
    __syncthreads();
    {
        const int tl = F.tid & 63, pt = F.tid >> 6; const float t = (float)(t0 + tl);
        float a[8];
#pragma unroll
        for (int jj = 0; jj < 8; ++jj) a[jj] = w1s[33 * 64 + pt * 8 + jj] + (t * inv_lm1) * w1s[pt * 8 + jj];
#pragma unroll 2
        for (int i = 0; i < 16; ++i) { const float band = 1e-4f + (15.f - 1e-4f) * (float)i / 15.f; const float rev = t * band / (float)L; const float cz = cos_rev(rev), sz = sin_rev(rev);
#pragma unroll
            for (int jj = 0; jj < 8; ++jj) a[jj] += cz * w1s[(1 + i) * 64 + pt * 8 + jj] + sz * w1s[(17 + i) * 64 + pt * 8 + jj]; }
#pragma unroll
        for (int jj = 0; jj < 8; ++jj) h1s[tl * 65 + pt * 8 + jj] = sin_rad(a[jj]);
    }
    __syncthreads();
    {
        const int tl = F.tid & 63, pt = F.tid >> 6;
        float a[8];
#pragma unroll
        for (int jj = 0; jj < 8; ++jj) a[jj] = w2s[4096 + pt * 8 + jj];
#pragma unroll 4
        for (int i = 0; i < 64; ++i) { const float hv = h1s[tl * 65 + i];
#pragma unroll
            for (int jj = 0; jj < 8; ++jj) a[jj] += hv * w2s[i * 64 + pt * 8 + jj]; }
#pragma unroll
        for (int jj = 0; jj < 8; ++jj) h2s[tl * 68 + pt * 8 + jj] = sin_rad(a[jj]);
    }
    __syncthreads();
    {
        const int l31 = F.lane & 31, kg = F.lane >> 5;
        auto split8 = [](const float (&x)[8], bf16x8& hi, bf16x8& lo) {
            u32x4 h, l;
#pragma unroll
            for (int e = 0; e < 4; ++e) { const unsigned hp = pk2(x[2 * e], x[2 * e + 1]); h[e] = hp;
                l[e] = pk2(x[2 * e] - __uint_as_float(hp << 16), x[2 * e + 1] - __uint_as_float(hp & 0xffff0000u)); }
            hi = __builtin_bit_cast(bf16x8, h); lo = __builtin_bit_cast(bf16x8, l); };
        bf16x8 Bh[2][4], Bl[2][4];
#pragma unroll
        for (int pb = 0; pb < 2; ++pb)
#pragma unroll
            for (int ks = 0; ks < 4; ++ks) { const float* hp = h2s + (pb * 32 + l31) * 68 + ks * 16 + kg * 8; const f32x4 x0 = *(const f32x4*)hp, x1 = *(const f32x4*)(hp + 4);
                const float x[8] = {x0[0], x0[1], x0[2], x0[3], x1[0], x1[1], x1[2], x1[3]}; split8(x, Bh[pb][ks], Bl[pb][ks]); }
        const float tn0 = (float)(t0 + l31) * inv_lm1, tn1 = (float)(t0 + 32 + l31) * inv_lm1;
        const bool b4 = (l31 & 16) != 0, b3q = (l31 & 8) != 0, b2 = (l31 & 4) != 0, b1q = (l31 & 2) != 0;
#pragma unroll 1
        for (int cb = 0; cb < 4; ++cb) {
            const int ch0 = F.wave * 128 + cb * 32;
            f32x16 acc0, acc1;
#pragma unroll
            for (int i = 0; i < 16; ++i) { acc0[i] = 0.f; acc1[i] = 0.f; }
#pragma unroll
            for (int ks = 0; ks < 4; ++ks) {
                float x[8];
#pragma unroll
                for (int e = 0; e < 8; ++e) x[e] = w3[(size_t)(ks * 16 + kg * 8 + e) * 1024 + ch0 + l31];
                bf16x8 Ah, Al; split8(x, Ah, Al);
                acc0 = MFMA32(Ah, Bh[0][ks], acc0); acc1 = MFMA32(Ah, Bh[1][ks], acc1);
                acc0 = MFMA32(Al, Bh[0][ks], acc0); acc1 = MFMA32(Al, Bh[1][ks], acc1);
                acc0 = MFMA32(Ah, Bl[0][ks], acc0); acc1 = MFMA32(Ah, Bl[1][ks], acc1);
            }
            float sq[16];
#pragma unroll
            for (int i = 0; i < 16; ++i) {
                const int ch = ch0 + 8 * (i >> 2) + 4 * kg + (i & 3);
                const float bb = b3[ch], delta = 3.0701134573253945f + (15.350567286626973f - 3.0701134573253945f) * (float)(ch & 255) / 255.f;
                const float v0 = (acc0[i] + bb) * __expf(-tn0 * delta), v1 = (acc1[i] + bb) * __expf(-tn1 * delta);
                _Float16* hp = hT + (size_t)ch * L + t0 + l31; hp[0] = (_Float16)v0; hp[32] = (_Float16)v1;
                sq[i] = v0 * v0 + v1 * v1;
            }
            float a8[8], a4[4], a2[2];
#pragma unroll
            for (int e = 0; e < 8; ++e) { const float keep = b4 ? sq[e + 8] : sq[e], send = b4 ? sq[e] : sq[e + 8]; a8[e] = keep + swz_xor<16>(send); }
#pragma unroll
            for (int e = 0; e < 4; ++e) { const float keep = b3q ? a8[e + 4] : a8[e], send = b3q ? a8[e] : a8[e + 4]; a4[e] = keep + swz_xor<8>(send); }
#pragma unroll
            for (int e = 0; e < 2; ++e) { const float keep = b2 ? a4[e + 2] : a4[e], send = b2 ? a4[e] : a4[e + 2]; a2[e] = keep + swz_xor<4>(send); }
            float a1 = (b1q ? a2[1] : a2[0]) + swz_xor<2>(b1q ? a2[0] : a2[1]);
            a1 += swz_xor<1>(a1);
            const int rg = (b4 ? 8 : 0) + (b3q ? 4 : 0) + (b2 ? 2 : 0) + (b1q ? 1 : 0);
            if ((l31 & 1) == 0) part[(size_t)tile * 1024 + ch0 + 8 * (rg >> 2) + 4 * kg + (rg & 3)] = a1;
        }
    }
}

struct TokInfo { unsigned e0, e1, p0, p1; float g0, g1; unsigned s0, s1; };
DI void phase_norm1(const Frame& F, int li, int mode) {
    const int nrows = (mode == 2) ? NLAT : NTOK;
    const float* modp = WSP(float, WS_MOD) + (size_t)li * 3 * 6144;
    const float* modprev = WSP(float, WS_MOD) + (size_t)(mode == 2 ? 1 : li - 1) * 3 * 6144;
    const float* gam = (mode == 2) ? F.in[I_FG] : F.in[I_N1G] + (size_t)li * D;
    const TokInfo* tok = WSP(TokInfo, WS_TOK); const bf16_t* ys = WSP(bf16_t, WS_A1);
    bf16_t* hbf = WSP(bf16_t, WS_HBF);
    bf16_t* xbuf = WSP(bf16_t, WS_XB);
    auto ldx = [&](int r, int i) -> f32x4 {
        if (mode == 0) return *(const f32x4*)((r >= NLAT ? F.in[I_CTX] + (size_t)(r - NLAT) * D : F.in[I_X] + (size_t)r * D) + i * 256 + F.lane * 4);
        return ld_bf4(xbuf + (size_t)r * D + i * 256 + F.lane * 4); };
    const int r0 = F.bid * 8 + F.wave, rstep = F.G * 8, lc = F.lane * 4;
    f32x4 xn[4]; u32x2 yan[4], ybn[4]; TokInfo t1 = {}, t2 = {};
    if (r0 < nrows) {
#pragma unroll
        for (int i = 0; i < 4; ++i) xn[i] = ldx(r0, i);
        if (mode != 0) { t1 = tok[r0]; if (r0 + rstep < nrows) t2 = tok[r0 + rstep];
#pragma unroll
            for (int i = 0; i < 4; ++i) { yan[i] = *(const u32x2*)(ys + (size_t)t1.s0 * D + i * 256 + lc); ybn[i] = *(const u32x2*)(ys + (size_t)t1.s1 * D + i * 256 + lc); } }
    }
    for (int r = r0; r < nrows; r += rstep) {
        const bool isctx = r >= NLAT; const int v = isctx ? 2 : (r >> 14);
        f32x4 x[4]; u32x2 ya[4], yb[4]; const TokInfo ti = t1;
#pragma unroll
        for (int i = 0; i < 4; ++i) { x[i] = xn[i]; ya[i] = yan[i]; yb[i] = ybn[i]; }
        if (r + rstep < nrows) {
#pragma unroll
            for (int i = 0; i < 4; ++i) xn[i] = ldx(r + rstep, i);
            if (mode != 0) { t1 = t2; if (r + 2 * rstep < nrows) t2 = tok[r + 2 * rstep];
#pragma unroll
                for (int i = 0; i < 4; ++i) { yan[i] = *(const u32x2*)(ys + (size_t)t1.s0 * D + i * 256 + lc); ybn[i] = *(const u32x2*)(ys + (size_t)t1.s1 * D + i * 256 + lc); } }
        }
        if (mode != 0) {
            const float* g2 = modprev + (size_t)v * 6144 + 5 * 1024;
#pragma unroll
            for (int i = 0; i < 4; ++i) {
                const u32x2 a = ya[i], b = yb[i];
                const f32x4 gg = *(const f32x4*)(g2 + i * 256 + lc);
                f32x4 y;
                y[0] = ti.g0 * __uint_as_float(a[0] << 16) + ti.g1 * __uint_as_float(b[0] << 16);
                y[1] = ti.g0 * __uint_as_float(a[0] & 0xffff0000u) + ti.g1 * __uint_as_float(b[0] & 0xffff0000u);
                y[2] = ti.g0 * __uint_as_float(a[1] << 16) + ti.g1 * __uint_as_float(b[1] << 16);
                y[3] = ti.g0 * __uint_as_float(a[1] & 0xffff0000u) + ti.g1 * __uint_as_float(b[1] & 0xffff0000u);
                x[i] = x[i] + gg * y;
            }
            if (mode == 1) {
#pragma unroll
                for (int i = 0; i < 4; ++i) *(u32x2*)(xbuf + (size_t)r * D + i * 256 + lc) = (u32x2){pk2(x[i][0], x[i][1]), pk2(x[i][2], x[i][3])}; }
        }
        float ss = 0.f;
#pragma unroll
        for (int i = 0; i < 4; ++i) ss += x[i][0] * x[i][0] + x[i][1] * x[i][1] + x[i][2] * x[i][2] + x[i][3] * x[i][3];
        ss = wave_sum(ss);
        const float rstd = rsqrtf(ss * (1.f / D) + EPS);
#pragma unroll
        for (int i = 0; i < 4; ++i) {
            const int c = i * 256 + lc;
            const f32x4 g = *(const f32x4*)(gam + c);
            if (mode == 2) { *(f32x4*)(F.out + (size_t)r * D + c) = x[i] * rstd * g; }
            else {
                const f32x4 sh = *(const f32x4*)(modp + (size_t)v * 6144 + c), sc = *(const f32x4*)(modp + (size_t)v * 6144 + 1024 + c);
                const f32x4 h = x[i] * rstd * g * (sc + 1.f) + sh;
                *(u32x2*)(hbf + (size_t)r * D + c) = (u32x2){pk2(h[0], h[1]), pk2(h[2], h[3])};
            }
        }
    }
}

struct Route { int e0, e1; float g0, g1; };
DI Route route_select(const float (&lg)[16], const float* rb) {
    float mx = lg[0];
#pragma unroll
    for (int e = 1; e < 16; ++e) mx = fmaxf(mx, lg[e]);
    float sc[16], sel[16], den = 0.f;
#pragma unroll
    for (int e = 0; e < 16; ++e) { sc[e] = __expf(lg[e] - mx); den += sc[e]; }
    const float rden = 1.f / den;
#pragma unroll
    for (int e = 0; e < 16; ++e) { sc[e] *= rden; sel[e] = sc[e] + rb[e]; }
    int bg = 0; float bgs = -1e30f;
#pragma unroll
    for (int g = 0; g < 4; ++g) {
        float m1 = -1e30f, m2 = -1e30f;
#pragma unroll
        for (int q = 0; q < 4; ++q) { const float s = sel[g * 4 + q]; if (s > m1) { m2 = m1; m1 = s; } else if (s > m2) m2 = s; }
        const float gs = m1 + m2; if (gs > bgs) { bgs = gs; bg = g; }
    }
    int e0 = 0, e1 = 0; float s0v = -1e30f, s1v = -1e30f, w0 = 0.f, w1 = 0.f;
#pragma unroll
    for (int e = 0; e < 16; ++e) {
        const bool ing = (e >> 2) == bg; const float s = sel[e];
        if (ing && s > s0v) { s1v = s0v; e1 = e0; w1 = w0; s0v = s; e0 = e; w0 = sc[e]; }
        else if (ing && s > s1v) { s1v = s; e1 = e; w1 = sc[e]; }
    }
    const float ws = 1.f / (w0 + w1); Route R; R.e0 = e0; R.e1 = e1; R.g0 = w0 * ws; R.g1 = w1 * ws; return R;
}
DI void norm2_rows_valu(const Frame& F, int li, int r_first, int rstep, int r_end, const float* wt, unsigned* lcnt) {
    const float* modp = WSP(float, WS_MOD) + (size_t)li * 3 * 6144;
    const float* gam = F.in[I_N2G] + (size_t)li * D;
    bf16_t* hbf = WSP(bf16_t, WS_HBF); TokInfo* tok = WSP(TokInfo, WS_TOK);
    const bf16_t* xbuf = WSP(bf16_t, WS_XB);
    const bool b2 = (F.lane & 4) != 0, b3 = (F.lane & 8) != 0, b4 = (F.lane & 16) != 0;
    for (int r = r_first; r < r_end; r += rstep) {
        const bool isctx = r >= NLAT; const int v = isctx ? 2 : (r >> 14);
        f32x4 x[4]; float ss = 0.f;
#pragma unroll
        for (int i = 0; i < 4; ++i) { x[i] = ld_bf4(xbuf + (size_t)r * D + i * 256 + F.lane * 4); ss += x[i][0] * x[i][0] + x[i][1] * x[i][1] + x[i][2] * x[i][2] + x[i][3] * x[i][3]; }
        ss = wave_sum(ss);
        const float rstd = rsqrtf(ss * (1.f / D) + EPS);
        float lg[16];
#pragma unroll
        for (int e = 0; e < 16; ++e) lg[e] = 0.f;
#pragma unroll
        for (int i = 0; i < 4; ++i) {
            const int c = i * 256 + F.lane * 4;
            const f32x4 g = *(const f32x4*)(gam + c), sh = *(const f32x4*)(modp + (size_t)v * 6144 + 3 * 1024 + c), sc = *(const f32x4*)(modp + (size_t)v * 6144 + 4 * 1024 + c);
            const f32x4 h = x[i] * rstd * g * (sc + 1.f) + sh;
            *(u32x2*)(hbf + (size_t)r * D + c) = (u32x2){pk2(h[0], h[1]), pk2(h[2], h[3])};
#pragma unroll
            for (int e = 0; e < 16; ++e) { const f32x4 w = *(const f32x4*)(wt + e * 1024 + c); lg[e] += h[0] * w[0] + h[1] * w[1] + h[2] * w[2] + h[3] * w[3]; }
        }
        float a8[8], a4[4], a2[2];
#pragma unroll
        for (int e = 0; e < 8; ++e) { const auto rr = __builtin_amdgcn_permlane32_swap(__float_as_uint(lg[e]), __float_as_uint(lg[e + 8]), false, false); a8[e] = __uint_as_float(rr[0]) + __uint_as_float(rr[1]); }
#pragma unroll
        for (int e = 0; e < 4; ++e) { const float keep = b4 ? a8[e + 4] : a8[e], send = b4 ? a8[e] : a8[e + 4]; a4[e] = keep + swz_xor<16>(send); }
#pragma unroll
        for (int e = 0; e < 2; ++e) { const float keep = b3 ? a4[e + 2] : a4[e], send = b3 ? a4[e] : a4[e + 2]; a2[e] = keep + swz_xor<8>(send); }
        float a1 = (b2 ? a2[1] : a2[0]) + swz_xor<4>(b2 ? a2[0] : a2[1]);
        a1 += swz_xor<2>(a1); a1 += swz_xor<1>(a1);
#pragma unroll
        for (int e = 0; e < 16; ++e) lg[e] = __int_as_float(__builtin_amdgcn_readlane(__float_as_int(a1), 4 * e));
        const Route R = route_select(lg, F.in[I_RB]);
        if (F.lane == 0) {
            TokInfo ti; ti.e0 = R.e0; ti.e1 = R.e1; ti.p0 = atomicAdd(lcnt + R.e0, 1u); ti.p1 = atomicAdd(lcnt + R.e1, 1u);
            ti.g0 = R.g0; ti.g1 = R.g1; ti.s0 = 0; ti.s1 = 0;
            tok[r] = ti;
        }
    }
}
DI void phase_norm2(const Frame& F, int li, int nrows) {
    float* wp = (float*)F.lds;
    float* cvec = wp + 16384;
    float* cred = cvec + 16;
    float* lgs = cred + 512 + F.wave * (16 * 17);
    float* wt = cred + 512 + 8 * 16 * 17;
    unsigned* lcnt = (unsigned*)(F.lds + LDS_MISC + 64);
    const int v = F.bid & 1, nb2 = F.G >> 1;
    const float* modp = WSP(float, WS_MOD) + (size_t)li * 3 * 6144 + (size_t)v * 6144;
    const float* gam = F.in[I_N2G] + (size_t)li * D;
    for (int c = F.bid; c < SLOT_CAP / NTHR; c += F.G) WSP(int, WS_RMAP)[c * NTHR + F.tid] = 0;
    __syncthreads();
    for (int i = F.tid; i < 16384; i += NTHR) { const int k = i >> 4, e = i & 15; const float w = F.in[I_RW][i];
        wp[(((k >> 4) * 4 + ((k >> 2) & 3)) * 16 + e) * 4 + (k & 3)] = w * gam[k] * (modp[4 * 1024 + k] + 1.f);
        if (nrows > NLAT) wt[e * 1024 + k] = w; }
    { const int e = F.tid & 15, part = F.tid >> 4; float a = 0.f;
      for (int k = part * 32; k < part * 32 + 32; ++k) a += modp[3 * 1024 + k] * F.in[I_RW][k * 16 + e];
      cred[part * 16 + e] = a; }
    if (F.tid < 16) lcnt[F.tid] = 0u;
    __syncthreads();
    if (F.tid < 16) { float a = 0.f; for (int q = 0; q < 32; ++q) a += cred[q * 16 + F.tid]; cvec[F.tid] = a; }
    __syncthreads();
    bf16_t* hbf = WSP(bf16_t, WS_HBF); TokInfo* tok = WSP(TokInfo, WS_TOK);
    const int i16 = F.lane & 15, kq = F.lane >> 4;
    if (F.bid < 2 * nb2)
    for (int gl = (F.bid >> 1) * 8 + F.wave; gl < S / 16; gl += nb2 * 8) {
        const int row0 = v * S + gl * 16;
        const bf16_t* xr = WSP(bf16_t, WS_XB) + (size_t)(row0 + i16) * D + 4 * kq;
        const float* wl = wp + (kq * 16 + i16) * 4;
        f32x4 acc = (f32x4){0.f, 0.f, 0.f, 0.f}; float ss = 0.f;
        u32x2 xa[8], xb[8];
#pragma unroll
        for (int q = 0; q < 8; ++q) xa[q] = *(const u32x2*)(xr + 16 * q);
#define N2_BATCH(cur, nxt, s0) do { \
            if ((s0) + 8 < 64) { _Pragma("unroll") for (int q = 0; q < 8; ++q) nxt[q] = *(const u32x2*)(xr + 16 * ((s0) + 8 + q)); } \
            _Pragma("unroll") for (int q = 0; q < 8; ++q) { const f32x4 xv = bf4_to_f4(cur[q]), wv = *(const f32x4*)(wl + ((s0) + q) * 256); \
                ss += xv[0] * xv[0] + xv[1] * xv[1] + xv[2] * xv[2] + xv[3] * xv[3]; \
                _Pragma("unroll") for (int t = 0; t < 4; ++t) acc = __builtin_amdgcn_mfma_f32_16x16x4f32(xv[t], wv[t], acc, 0, 0, 0); } } while (0)
#pragma unroll 1
        for (int s0 = 0; s0 < 64; s0 += 16) { N2_BATCH(xa, xb, s0); N2_BATCH(xb, xa, s0 + 8); }
#undef N2_BATCH
        ss += swz_xor<16>(ss); ss = half_sum(ss);
        const float rstd = rsqrtf(ss * (1.f / D) + EPS);
#pragma unroll
        for (int r = 0; r < 4; ++r) lgs[(4 * kq + r) * 17 + i16] = acc[r];
        asm volatile("s_waitcnt lgkmcnt(0)" ::: "memory");
        float lg[16];
#pragma unroll
        for (int e = 0; e < 16; ++e) lg[e] = lgs[i16 * 17 + e] * rstd + cvec[e];
        asm volatile("s_waitcnt lgkmcnt(0)" ::: "memory");
        const Route R = route_select(lg, F.in[I_RB]);
        if (F.lane < 16) {
            TokInfo ti; ti.e0 = R.e0; ti.e1 = R.e1; ti.p0 = atomicAdd(lcnt + R.e0, 1u); ti.p1 = atomicAdd(lcnt + R.e1, 1u);
            ti.g0 = R.g0; ti.g1 = R.g1; ti.s0 = 0; ti.s1 = 0;
            tok[row0 + F.lane] = ti;
        }
        float rj[16];
#pragma unroll
        for (int j = 0; j < 16; ++j) rj[j] = __int_as_float(__builtin_amdgcn_readlane(__float_as_int(rstd), j));
#pragma unroll 1
        for (int i = 0; i < 4; ++i) {
            const int c = i * 256 + F.lane * 4;
            const f32x4 gs = *(const f32x4*)(gam + c) * (*(const f32x4*)(modp + 4 * 1024 + c) + 1.f), sh = *(const f32x4*)(modp + 3 * 1024 + c);
            u32x2 x[16];
#pragma unroll
            for (int j = 0; j < 16; ++j) x[j] = *(const u32x2*)(WSP(bf16_t, WS_XB) + (size_t)(row0 + j) * D + c);
#pragma unroll
            for (int j = 0; j < 16; ++j) { const f32x4 h = bf4_to_f4(x[j]) * rj[j] * gs + sh;
                *(u32x2*)(hbf + (size_t)(row0 + j) * D + c) = (u32x2){pk2(h[0], h[1]), pk2(h[2], h[3])}; }
        }
    }
    if (nrows > NLAT) norm2_rows_valu(F, li, NLAT + F.bid * 8 + F.wave, F.G * 8, nrows, wt, lcnt);
    __syncthreads();
    if (F.tid < 16) F.ctl[CW_BCNT + (li * MAXG + F.bid) * 16 + F.tid] = lcnt[F.tid];
}

DI void moe_offsets(const Frame& F, int li, int* offs) {
    __syncthreads();
    int* tot = offs + 376;
    int* part = (int*)F.lds;
    {
        const int e = F.tid & 15, pq = F.tid >> 4;
        const unsigned* bc = F.ctl + CW_BCNT + li * MAXG * 16 + e;
        int st = 0, sb = 0;
#pragma unroll
        for (int k = 0; k < 8; ++k) { const int blk = pq * 8 + k; const int c = (blk < F.G) ? (int)__hip_atomic_load(bc + blk * 16, __ATOMIC_RELAXED, __HIP_MEMORY_SCOPE_AGENT) : 0; st += c; sb += (blk < F.bid) ? c : 0; }
        part[pq * 16 + e] = st; part[512 + pq * 16 + e] = sb;
    }
    __syncthreads();
    if (F.tid < 32) { const int e = F.tid & 15, wb = F.tid >> 4; int s = 0;
        for (int pq = 0; pq < 32; ++pq) s += part[wb * 512 + pq * 16 + e];
        if (wb) offs[360 + e] = s; else tot[e] = s; }
    __syncthreads();
    if (F.tid == 0) { int o = 0; for (int e = 0; e < NE; ++e) { offs[e] = o; offs[17 + e] = o >> 8; o += (tot[e] + 255) & ~255; }
        offs[16] = o; offs[17 + 16] = o >> 8; }
    __syncthreads();
    for (int t = F.tid; t < SLOT_CAP / 256; t += NTHR) { int e = 0; for (int k = 1; k < NE; ++k) e += (offs[17 + k] <= t) ? 1 : 0; offs[40 + t] = e; }
    if (F.tid < 16) offs[360 + F.tid] += offs[F.tid];
    __syncthreads();
}
DI void phase_gather(const Frame& F, int li, int nrows) {
    int* offs = (int*)(F.lds + LDS_MISC + 64);
    moe_offsets(F, li, offs);
    TokInfo* tok = WSP(TokInfo, WS_TOK); int* rmap = WSP(int, WS_RMAP);
    auto place = [&](int r) {
        const TokInfo ti = tok[r];
        const unsigned s0 = offs[360 + ti.e0] + ti.p0, s1 = offs[360 + ti.e1] + ti.p1;
        rmap[s0] = r; rmap[s1] = r; tok[r].s0 = s0; tok[r].s1 = s1;
    };
    const int v = F.bid & 1, nb2 = F.G >> 1;
    if (F.bid < 2 * nb2)
        for (int gl = (F.bid >> 1) * 8 + F.wave; gl < S / 16; gl += nb2 * 8) if (F.lane < 16) place(v * S + gl * 16 + F.lane);
    if (nrows > NLAT) for (int r = NLAT + F.bid * 8 + F.wave; r < nrows; r += F.G * 8) if (F.lane == 0) place(r);
}

DI float lam_of(const Frame& F, int li, float& lam_init) {
    const float* lv = F.in[I_ALAM] + (size_t)li * 128;
    const int i = F.lane & 31, hi = F.lane >> 5;
    float d = lv[hi * 64 + i] * lv[hi * 64 + 32 + i];
    d += swz_xor<16>(d); d += swz_xor<8>(d); d += swz_xor<4>(d); d += swz_xor<2>(d); d += swz_xor<1>(d);
    const float d0 = __int_as_float(__builtin_amdgcn_readlane(__float_as_int(d), 0)), d1 = __int_as_float(__builtin_amdgcn_readlane(__float_as_int(d), 32));
    float lif = (float)li; asm volatile("" : "+v"(lif));
    lam_init = 0.8f - 0.6f * __expf(-0.3f * lif);
    return __expf(d0) - __expf(d1) + lam_init;
}
DI bf16x8 pack8(const f32x16& x, int s) {
    u32x4 p; p[0] = pk2(x[8 * s], x[8 * s + 1]); p[1] = pk2(x[8 * s + 2], x[8 * s + 3]); p[2] = pk2(x[8 * s + 4], x[8 * s + 5]); p[3] = pk2(x[8 * s + 6], x[8 * s + 7]);
    return __builtin_bit_cast(bf16x8, p);
}

DI void diffattn_unit(const Frame& F, int li, int b, int h, size_t qrow0, int NT2) {
    const int lane = F.lane, r = lane & 31, hh = lane >> 5, c = F.wave & 1, g = F.wave >> 1;
    const bf16_t* AQ = WSP(bf16_t, WS_AQ); const bf16_t* AK = WSP(bf16_t, WS_AK); const bf16_t* AVT = WSP(bf16_t, WS_AVT) + (size_t)(b * 4 + h) * 64 * NKEY;
    float lam_init; const float lam = lam_of(F, li, lam_init);
    const size_t qrowA = qrow0 + g * 64 + r;
    bf16x8 qfA[2], qfB[2]; float qnA = 0.f, qnB = 0.f;
#pragma unroll
    for (int ks = 0; ks < 2; ++ks) { qfA[ks] = *(const bf16x8*)(AQ + qrowA * 256 + h * 64 + c * 32 + ks * 16 + 8 * hh); qfB[ks] = *(const bf16x8*)(AQ + (qrowA + 32) * 256 + h * 64 + c * 32 + ks * 16 + 8 * hh);
#pragma unroll
        for (int j = 0; j < 8; ++j) { const float va = bf2f((bf16_t)qfA[ks][j]), vb_ = bf2f((bf16_t)qfB[ks][j]); qnA += va * va; qnB += vb_ * vb_; } }
    f32x16 cinit;
    { const float qm = wave_max(fmaxf(half_sum(qnA), half_sum(qnB)));
      const float km = sqrtf(__uint_as_float(__hip_atomic_load(F.ctl + CW_KMAX + li * 16 + (b * 4 + h) * 2 + c, __ATOMIC_RELAXED, __HIP_MEMORY_SCOPE_AGENT)));
      const float cn = -(sqrtf(qm) * km * 1.02f + 1e-3f);
#pragma unroll
      for (int i = 0; i < 16; ++i) cinit[i] = cn; }
    f32x16 OA[2], OB[2]; f32x8 laccA, laccB;
#pragma unroll
    for (int i = 0; i < 16; ++i) { OA[0][i] = 0.f; OA[1][i] = 0.f; OB[0][i] = 0.f; OB[1][i] = 0.f; }
#pragma unroll
    for (int i = 0; i < 8; ++i) { laccA[i] = 0.f; laccB[i] = 0.f; }
    constexpr int KTB = 2 * 128 * 64, VTB = 64 * 256, STG = KTB + VTB;
    LAS unsigned char* Ll = (LAS unsigned char*)F.lds;
    unsigned char* L = F.lds;
    unsigned kgo[2], vgo[2];
#pragma unroll
    for (int i = 0; i < 2; ++i) { const int q = F.wave * 2 + i;
        const int key = (q & 7) * 16 + (lane >> 2), chunk = (lane & 3) ^ ((key >> 2) & 3);
        kgo[i] = (unsigned)key * 512u + (unsigned)(h * 64 + (q >> 3) * 32) * 2u + (unsigned)chunk * 16u;
        const int d = q * 4 + (lane >> 4), vch = (lane & 15) ^ (d & 15);
        vgo[i] = (unsigned)d * (unsigned)(NKEY * 2) + (unsigned)vch * 16u; }
    const unsigned ldsw = (unsigned)F.wave * 2048u;
#define DA_ISSUE(kt_, stg_) do { const int j0_ = (kt_) * 128; \
        const char* kg_ = (const char*)AK + (j0_ < CTX ? (size_t)NLAT + b * CTX + j0_ : (size_t)b * S + (j0_ - CTX)) * 512; const char* vg_ = (const char*)AVT + (size_t)j0_ * 2; \
        _Pragma("unroll") for (int i_ = 0; i_ < 2; ++i_) { \
            __builtin_amdgcn_global_load_lds((const unsigned*)(kg_ + kgo[i_]), (LAS unsigned*)(Ll + (stg_) * STG + ldsw + i_ * 1024), 16, 0, 0); \
            __builtin_amdgcn_global_load_lds((const unsigned*)(vg_ + vgo[i_]), (LAS unsigned*)(Ll + (stg_) * STG + KTB + ldsw + i_ * 1024), 16, 0, 0); } } while (0)
    __syncthreads();
    DA_ISSUE(0, 0);
    if (NT2 > 1) { DA_ISSUE(1, 1); asm volatile("s_waitcnt vmcnt(4)" ::: "memory"); } else asm volatile("s_waitcnt vmcnt(0)" ::: "memory");
    __builtin_amdgcn_s_barrier();
    const int ksw = (r >> 2) & 3;
    const int kr0 = c * 8192 + r * 64 + (((0 + hh) ^ ksw) * 16), kr1 = c * 8192 + r * 64 + (((2 + hh) ^ ksw) * 16);
    const int vlo0 = r * 256 + (((0 + hh) ^ (r & 3)) * 16), vlo1 = r * 256 + (((2 + hh) ^ (r & 3)) * 16), vrq = (r >> 2) & 3;
#define DA_LDK(st) do { k0 = *(const bf16x8*)(kb + (st) * 2048 + kr0); k1 = *(const bf16x8*)(kb + (st) * 2048 + kr1); } while (0)
#define DA_QK(Sx, qf) do { Sx = MFMA32(k0, qf[0], cinit); Sx = MFMA32(k1, qf[1], Sx); } while (0)
#define DA_LDV(st) do { const int vh_ = (((st) ^ vrq) & 3) * 64; _Pragma("unroll") for (int dh = 0; dh < 2; ++dh) { \
            vf[dh][0] = *(const bf16x8*)(vb + dh * (32 * 256) + vh_ + vlo0); vf[dh][1] = *(const bf16x8*)(vb + dh * (32 * 256) + vh_ + vlo1); } } while (0)
#define DA_PV(Sx, Ox, lx) do { \
        _Pragma("unroll") for (int i = 0; i < 16; ++i) Sx[i] = __builtin_amdgcn_exp2f(Sx[i]); \
        lx += __builtin_shufflevector(Sx, Sx, 0, 1, 2, 3, 4, 5, 6, 7) + __builtin_shufflevector(Sx, Sx, 8, 9, 10, 11, 12, 13, 14, 15); \
        const bf16x8 p0 = pack8(Sx, 0), p1 = pack8(Sx, 1); \
        Ox[0] = MFMA32(vf[0][0], p0, Ox[0]); Ox[1] = MFMA32(vf[1][0], p0, Ox[1]); \
        Ox[0] = MFMA32(vf[0][1], p1, Ox[0]); Ox[1] = MFMA32(vf[1][1], p1, Ox[1]); } while (0)
    if (F.wave >= 4) __builtin_amdgcn_s_setprio(1);
    int stg = 0;
#pragma unroll 1
    for (int kt = 0; kt < NT2; ++kt) {
        const bool more2 = kt + 2 < NT2;
        if (more2) { const int s2_ = stg >= 1 ? stg - 1 : 2; DA_ISSUE(kt + 2, s2_); }
        const unsigned char* kb = L + stg * STG; const unsigned char* vb = L + stg * STG + KTB;
        f32x16 SA, SB; bf16x8 k0, k1, vf[2][2];
        DA_LDK(0); DA_QK(SA, qfA);
#pragma unroll 1
        for (int st = 0; st < 4; ++st) {
            DA_QK(SB, qfB);
            DA_LDV(st);
            DA_PV(SA, OA, laccA);
            if (st < 3) { DA_LDK(st + 1); DA_QK(SA, qfA); }
            DA_PV(SB, OB, laccB);
        }
        if (more2) asm volatile("s_waitcnt vmcnt(4)" ::: "memory"); else asm volatile("s_waitcnt vmcnt(0)" ::: "memory");
        asm volatile("s_waitcnt lgkmcnt(0)" ::: "memory");
        __builtin_amdgcn_s_barrier();
        stg = stg == 2 ? 0 : stg + 1;
    }
#undef DA_ISSUE
#undef DA_LDK
#undef DA_QK
#undef DA_LDV
#undef DA_PV
    __builtin_amdgcn_s_setprio(0);
    float lsA = 0.f, lsB = 0.f;
#pragma unroll
    for (int i = 0; i < 8; ++i) { lsA += laccA[i]; lsB += laccB[i]; }
    const float rlA = 1.f / half_sum(lsA), rlB = 1.f / half_sum(lsB);
    float* xb = (float*)L + (size_t)g * 2 * 32 * 64;
    if (c == 1) {
#pragma unroll
        for (int dh = 0; dh < 2; ++dh)
#pragma unroll
            for (int i = 0; i < 16; ++i) { xb[(dh * 16 + i) * 64 + lane] = OA[dh][i] * (rlA * lam); xb[2048 + (dh * 16 + i) * 64 + lane] = OB[dh][i] * (rlB * lam); }
    }
    __syncthreads();
    if (c == 0) {
        const float* sg = F.in[I_ASUB] + li * 64;
#pragma unroll
        for (int ab = 0; ab < 2; ++ab) {
            float o[2][16]; float ss = 0.f; const float rl = ab ? rlB : rlA;
#pragma unroll
            for (int dh = 0; dh < 2; ++dh)
#pragma unroll
                for (int i = 0; i < 16; ++i) { o[dh][i] = (ab ? OB[dh][i] : OA[dh][i]) * rl - xb[ab * 2048 + (dh * 16 + i) * 64 + lane]; ss += o[dh][i] * o[dh][i]; }
            ss = half_sum(ss);
            const float rs = rsqrtf(ss * (1.f / 64.f) + EPS) * (1.f - lam_init);
            bf16_t* mix = WSP(bf16_t, WS_HBF) + (qrowA + ab * 32) * D + h * 64;
#pragma unroll
            for (int dh = 0; dh < 2; ++dh)
#pragma unroll
                for (int gq = 0; gq < 4; ++gq) {
                    const int d = 32 * dh + 8 * gq + 4 * hh;
                    const f32x4 gg = *(const f32x4*)(sg + d);
                    *(u32x2*)(mix + d) = (u32x2){pk2(o[dh][4 * gq] * rs * gg[0], o[dh][4 * gq + 1] * rs * gg[1]), pk2(o[dh][4 * gq + 2] * rs * gg[2], o[dh][4 * gq + 3] * rs * gg[3])};
                }
        }
    }
}

DI void na_mfma_unit(const Frame& F, int li, int b, size_t qrow0, int grow) {
    const int lane = F.lane, r31 = lane & 31, hh = lane >> 5, h = F.wave >> 1, qh = F.wave & 1;
    const bf16_t* BQ = WSP(bf16_t, WS_BQ); const bf16_t* BK = WSP(bf16_t, WS_BK); const bf16_t* BVT = WSP(bf16_t, WS_BVT);
    constexpr int KB = 4 * 8192, VB = 4 * 9216, STG = KB + VB;
    unsigned char* L = F.lds;
    float* tab = (float*)(F.lds + 2 * STG);
    const int nwin = grow >= 0 ? 8 : 0, nt = nwin + 4;
    int r0 = grow - 4; r0 = r0 < 0 ? 0 : (r0 > 248 ? 248 : r0);
    __syncthreads();
    if (nwin) for (int i = F.tid; i < 4 * 15 * 32; i += NTHR) { const int c31 = i & 31, hr = i >> 5; tab[i] = (c31 < 31) ? F.in[I_RPB][(size_t)li * 4 * 465 + hr * 31 + c31] * LOG2E : -1e30f; }
    const int skey = F.tid >> 3, sc64 = F.tid & 7, sh = sc64 >> 1;
    const int vrow = F.tid >> 1, vhalf = F.tid & 1;
    auto kbase = [&](int ti) -> const bf16_t* { return ti < nwin ? BK + ((size_t)b * S + (size_t)(r0 + ti) * GW) * 256 : BK + ((size_t)NLAT + b * CTX + (ti - nwin) * 64) * 256; };
    auto vkey0 = [&](int ti) -> int { return ti < nwin ? CTX + (r0 + ti) * GW : (ti - nwin) * 64; };
    u32x4 kreg[4], vreg[4];
    { const bf16_t* kp = kbase(0) + (size_t)skey * 256 + sc64 * 32; const bf16_t* vp = BVT + ((size_t)b * 256 + vrow) * NKEY + vkey0(0) + vhalf * 32;
#pragma unroll
      for (int i = 0; i < 4; ++i) { kreg[i] = *(const u32x4*)(kp + i * 8); vreg[i] = *(const u32x4*)(vp + i * 8); } }
    const size_t qrow = qrow0 + 32 * qh + r31;
    bf16x8 qf[4]; float qn2 = 0.f;
#pragma unroll
    for (int ks = 0; ks < 4; ++ks) { qf[ks] = *(const bf16x8*)(BQ + qrow * 256 + h * 64 + ks * 16 + 8 * hh);
#pragma unroll
        for (int j = 0; j < 8; ++j) { const float v = bf2f((bf16_t)qf[ks][j]); qn2 += v * v; } }
    qn2 = half_sum(qn2);
    __syncthreads();
    float bmax = 0.f;
    if (nwin) { for (int i = lane; i < 480; i += 64) bmax = fmaxf(bmax, tab[h * 480 + i]); bmax = wave_max(bmax); }
    const unsigned* kmx = F.ctl + CW_KMAXB + li * 16 + (b * 4 + h) * 2;
    const float km = sqrtf(__uint_as_float(__hip_atomic_load(kmx, __ATOMIC_RELAXED, __HIP_MEMORY_SCOPE_AGENT)) + __uint_as_float(__hip_atomic_load(kmx + 1, __ATOMIC_RELAXED, __HIP_MEMORY_SCOPE_AGENT)));
    const float cneg = -(sqrtf(qn2) * km * 1.02f + bmax + 1e-3f);
    const int cq = 32 * qh + r31; int c0q = cq - 8; c0q = c0q < 0 ? 0 : (c0q > 48 ? 48 : c0q);
    const int qrow_g = grow;
    f32x16 O[2];
#pragma unroll
    for (int dh = 0; dh < 2; ++dh)
#pragma unroll
        for (int i = 0; i < 16; ++i) O[dh][i] = 0.f;
    f32x16 lacc;
#pragma unroll
    for (int i = 0; i < 16; ++i) lacc[i] = 0.f;
    int tcol[2][16];
#pragma unroll
    for (int st = 0; st < 2; ++st)
#pragma unroll
        for (int i = 0; i < 16; ++i) { const int kc = 32 * st + (i & 3) + 8 * (i >> 2) + 4 * hh; tcol[st][i] = ((kc >= c0q) && (kc < c0q + 16)) ? (kc - cq + 15) : 31; }
    const int kdst = sh * 8192 + skey * 128, ksw = (skey >> 1) & 7, kch0 = (sc64 & 1) * 4;
    const int vdst = KB + (vrow >> 6) * 9216 + (vrow & 63) * 144 + vhalf * 64;
#pragma unroll
    for (int i = 0; i < 4; ++i) *(u32x4*)(L + kdst + (((kch0 + i) ^ ksw) * 16)) = kreg[i];
#pragma unroll
    for (int i = 0; i < 4; ++i) *(u32x4*)(L + vdst + i * 16) = vreg[i];
    __syncthreads();
#pragma unroll 1
    for (int ti = 0; ti < nt; ++ti) {
        const int buf = ti & 1;
        if (ti + 1 < nt) { const bf16_t* kp = kbase(ti + 1) + (size_t)skey * 256 + sc64 * 32; const bf16_t* vp = BVT + ((size_t)b * 256 + vrow) * NKEY + vkey0(ti + 1) + vhalf * 32;
#pragma unroll
            for (int i = 0; i < 4; ++i) { kreg[i] = *(const u32x4*)(kp + i * 8); vreg[i] = *(const u32x4*)(vp + i * 8); } }
        const unsigned char* kb = L + buf * STG + h * 8192; const unsigned char* vb = L + buf * STG + KB + h * 9216;
        const bool win = ti < nwin;
        const float* trow = tab + (h * 15 + (win ? (r0 + ti - qrow_g + 7) : 0)) * 32;
#pragma unroll
        for (int st = 0; st < 2; ++st) {
            const int key = 32 * st + r31, sw = (key >> 1) & 7;
            f32x16 s;
            if (win) {
#pragma unroll
                for (int i = 0; i < 16; ++i) s[i] = trow[tcol[st][i]] + cneg;
            } else {
#pragma unroll
                for (int i = 0; i < 16; ++i) s[i] = cneg;
            }
#pragma unroll
            for (int ks = 0; ks < 4; ++ks) { const bf16x8 kf = *(const bf16x8*)(kb + key * 128 + (((ks * 2 + hh) ^ sw) * 16)); s = MFMA32(kf, qf[ks], s); }
#pragma unroll
            for (int i = 0; i < 16; ++i) s[i] = __builtin_amdgcn_exp2f(s[i]);
            lacc += s;
            const bf16x8 p0 = pack8(s, 0), p1 = pack8(s, 1);
#pragma unroll
            for (int dh = 0; dh < 2; ++dh) {
                const unsigned char* vp = vb + (32 * dh + r31) * 144 + st * 64 + hh * 16;
                O[dh] = MFMA32(*(const bf16x8*)vp, p0, O[dh]);
                O[dh] = MFMA32(*(const bf16x8*)(vp + 32), p1, O[dh]);
            }
        }
        if (ti + 1 < nt) { unsigned char* W = L + (buf ^ 1) * STG;
#pragma unroll
            for (int i = 0; i < 4; ++i) *(u32x4*)(W + kdst + (((kch0 + i) ^ ksw) * 16)) = kreg[i];
#pragma unroll
            for (int i = 0; i < 4; ++i) *(u32x4*)(W + vdst + i * 16) = vreg[i]; }
        __syncthreads();
    }
    float lsum = 0.f;
#pragma unroll
    for (int i = 0; i < 16; ++i) lsum += lacc[i];
    const float rl = 1.f / half_sum(lsum);
    bf16_t* mix = WSP(bf16_t, WS_HBF) + qrow * D + 256 + h * 64;
#pragma unroll
    for (int dh = 0; dh < 2; ++dh)
#pragma unroll
        for (int g = 0; g < 4; ++g) { const int d = 32 * dh + 8 * g + 4 * hh;
            *(u32x2*)(mix + d) = (u32x2){pk2(O[dh][4 * g] * rl, O[dh][4 * g + 1] * rl), pk2(O[dh][4 * g + 2] * rl, O[dh][4 * g + 3] * rl)}; }
}

DI void pool_unit(const Frame& F, int li, size_t seq_row0, int L, int t0) {
    unsigned* us = (unsigned*)F.lds;
    unsigned char* dfb = F.lds + 80 * 512;
    const bf16_t* PL = WSP(bf16_t, WS_PL);
    __syncthreads();
    for (int i = F.tid; i < 80 * 32; i += NTHR) {
        const int tt = i >> 5, c8 = i & 31, t = t0 - 8 + tt;
        u32x4 x = (u32x4){0u, 0u, 0u, 0u};
        if (t >= 0 && t < L) x = *(const u32x4*)(PL + (seq_row0 + t) * 256 + c8 * 8);
        *(u32x4*)(us + tt * 128 + c8 * 4) = x;
    }
    __syncthreads();
    {
        const int cp = F.tid & 127, tl0 = (F.tid >> 7) * 16, hw = 1 << (cp >> 5);
        float s0 = 0.f, s1 = 0.f;
        for (int k = -hw; k < hw; ++k) { const unsigned w = us[(tl0 + 8 + k) * 128 + cp]; s0 += __uint_as_float(w << 16); s1 += __uint_as_float(w & 0xffff0000u); }
#pragma unroll 4
        for (int j = 0; j < 16; ++j) {
            const int tl = tl0 + j, t = t0 + tl;
            const int lo = t - hw < 0 ? 0 : t - hw, hi = t + hw > L ? L : t + hw;
            const float rc = __builtin_amdgcn_rcpf((float)(hi - lo));
            const unsigned c = us[(tl + 8) * 128 + cp];
            *(unsigned*)(dfb + tl * 528 + cp * 4) = pk2(s0 * rc - __uint_as_float(c << 16), s1 * rc - __uint_as_float(c & 0xffff0000u));
            const unsigned a = us[(tl + 8 + hw) * 128 + cp], b = us[(tl + 8 - hw) * 128 + cp];
            s0 += __uint_as_float(a << 16) - __uint_as_float(b << 16); s1 += __uint_as_float(a & 0xffff0000u) - __uint_as_float(b & 0xffff0000u);
        }
    }
    __syncthreads();
    {
        const int g = F.wave & 3, tq = F.wave >> 2, fr = F.lane & 15, fq = F.lane >> 4;
        const bf16_t* wt = WSP(bf16_t, WS_PWT) + ((size_t)li * 4 + g) * 4096;
        bf16x8 Af[4][2];
#pragma unroll
        for (int jb = 0; jb < 4; ++jb)
#pragma unroll
            for (int ks = 0; ks < 2; ++ks) Af[jb][ks] = *(const bf16x8*)(wt + (jb * 16 + fr) * 64 + ks * 32 + fq * 8);
        const float* ps = F.in[I_POOLS] + li * 256 + g * 64;
        bf16_t* mix = WSP(bf16_t, WS_HBF);
#pragma unroll
        for (int tb = 0; tb < 2; ++tb) {
            const int tl = (tq * 2 + tb) * 16 + fr;
            const bf16x8 B0 = *(const bf16x8*)(dfb + tl * 528 + (g * 64 + fq * 8) * 2), B1 = *(const bf16x8*)(dfb + tl * 528 + (g * 64 + 32 + fq * 8) * 2);
#pragma unroll
            for (int jb = 0; jb < 4; ++jb) {
                f32x4 acc = (f32x4){0.f, 0.f, 0.f, 0.f};
                acc = __builtin_amdgcn_mfma_f32_16x16x32_bf16(Af[jb][0], B0, acc, 0, 0, 0);
                acc = __builtin_amdgcn_mfma_f32_16x16x32_bf16(Af[jb][1], B1, acc, 0, 0, 0);
                const f32x4 sc = *(const f32x4*)(ps + jb * 16 + 4 * fq);
                *(u32x2*)(mix + (seq_row0 + t0 + tl) * D + 512 + g * 64 + jb * 16 + 4 * fq) = (u32x2){pk2(acc[0] * sc[0], acc[1] * sc[1]), pk2(acc[2] * sc[2], acc[3] * sc[3])};
            }
        }
    }
}

DI float hy_norm(const float* part, int ntile, int o, int ch) {
    float s = 0.f;
    for (int t = 0; t < ntile; ++t) s += part[(size_t)t * 1024 + (o * 2) * 256 + ch] + part[(size_t)t * 1024 + (o * 2 + 1) * 256 + ch];
    return rsqrtf(s + EPS);
}
DI float hy_short(const bf16_t* p, int t, int L, float w0, float w1, float w2, float bb) {
    const int tm = t > 0 ? t - 1 : 0, tp = t + 1 < L ? t + 1 : L - 1;
    float a = bf2f(p[tm]), c = bf2f(p[tp]); const float m = bf2f(p[t]);
    a = t > 0 ? a : 0.f; c = t + 1 < L ? c : 0.f;
    return a * w0 + m * w1 + c * w2 + bb;
}
constexpr int FM = 16384;
DI int fphys(int i) { return i + (i >> 4) + ((i >> 9) << 4); }
constexpr int brev(int m, int bits) { return bits == 5 ? (((m & 1) << 4) | ((m & 2) << 2) | (m & 4) | ((m & 8) >> 2) | ((m & 16) >> 4)) : (((m & 1) << 3) | ((m & 2) << 1) | ((m & 4) >> 1) | ((m & 8) >> 3)); }
DI f32x2 cmul(f32x2 x, float c, float sn) {
    const f32x2 xs = __builtin_shufflevector(x, x, 1, 0);
    return x * (f32x2){c, c} + xs * (f32x2){-sn, sn};
}
template <int R, int LOG2R, bool INV> DI void dft_regs(f32x2 (&x)[R]) {
    constexpr float C32[16] = {1.f, 0.98078528040323043f, 0.92387953251128674f, 0.83146961230254524f, 0.70710678118654752f, 0.55557023301960218f, 0.38268343236508977f, 0.19509032201612825f,
                               0.f, -0.19509032201612825f, -0.38268343236508977f, -0.55557023301960218f, -0.70710678118654752f, -0.83146961230254524f, -0.92387953251128674f, -0.98078528040323043f};
    constexpr float S32[16] = {0.f, 0.19509032201612825f, 0.38268343236508977f, 0.55557023301960218f, 0.70710678118654752f, 0.83146961230254524f, 0.92387953251128674f, 0.98078528040323043f,
                               1.f, 0.98078528040323043f, 0.92387953251128674f, 0.83146961230254524f, 0.70710678118654752f, 0.55557023301960218f, 0.38268343236508977f, 0.19509032201612825f};
#pragma unroll
    for (int st = 0; st < LOG2R; ++st) {
        const int h = R >> (st + 1);
        f32x2 d[R / 2], t[R / 2];
#pragma unroll
        for (int b = 0; b < R / 2; ++b) { const int i = (b / h) * 2 * h, j = b % h; const f32x2 a = x[i + j], c = x[i + j + h]; x[i + j] = a + c; d[b] = a - c; }
#pragma unroll
        for (int b = 0; b < R / 2; ++b) { const int j = b % h, k = j * (16 / h); if (k != 0 && k != 8) t[b] = d[b] * (f32x2){C32[k], C32[k]}; }
#pragma unroll
        for (int b = 0; b < R / 2; ++b) { const int i = (b / h) * 2 * h, j = b % h, k = j * (16 / h);
            if (k == 0) x[i + j + h] = d[b];
            else if (k == 8) x[i + j + h] = INV ? (f32x2){-d[b][1], d[b][0]} : (f32x2){d[b][1], -d[b][0]};
            else { const float sn = INV ? S32[k] : -S32[k]; x[i + j + h] = __builtin_shufflevector(d[b], d[b], 1, 0) * (f32x2){-sn, sn} + t[b]; } }
    }
}
template <bool INV, int SP> DI void fft_pass32(f32x2* X, int bp, int rem, float inv_bs) {
    asm volatile("" : "+v"(bp), "+v"(rem));
    f32x2* P = X + bp;
    const float revb = (float)rem * inv_bs;
    f32x2 x[32], cs[16], t[16];
    if (!INV) {
#pragma unroll
        for (int q = 0; q < 32; ++q) x[q] = P[q * SP];
        dft_regs<32, 5, false>(x);
        P[0] = x[0];
#pragma unroll
        for (int hb = 0; hb < 32; hb += 16) {
#pragma unroll
            for (int m = hb ? hb : 1; m < hb + 16; ++m) { const float rev = revb * (float)brev(m, 5); cs[m & 15] = (f32x2){__builtin_amdgcn_cosf(rev), -__builtin_amdgcn_sinf(rev)}; }
#pragma unroll
            for (int m = hb ? hb : 1; m < hb + 16; ++m) t[m & 15] = x[m] * (f32x2){cs[m & 15][0], cs[m & 15][0]};
#pragma unroll
            for (int m = hb ? hb : 1; m < hb + 16; ++m) P[brev(m, 5) * SP] = __builtin_shufflevector(x[m], x[m], 1, 0) * (f32x2){-cs[m & 15][1], cs[m & 15][1]} + t[m & 15];
        }
    } else {
#pragma unroll
        for (int qp = 0; qp < 32; ++qp) x[qp] = P[qp * SP];
#pragma unroll
        for (int hb = 0; hb < 32; hb += 16) {
#pragma unroll
            for (int qp = hb ? hb : 1; qp < hb + 16; ++qp) { const float rev = revb * (float)qp; cs[qp & 15] = (f32x2){__builtin_amdgcn_cosf(rev), __builtin_amdgcn_sinf(rev)}; }
#pragma unroll
            for (int qp = hb ? hb : 1; qp < hb + 16; ++qp) t[qp & 15] = x[qp] * (f32x2){cs[qp & 15][0], cs[qp & 15][0]};
#pragma unroll
            for (int qp = hb ? hb : 1; qp < hb + 16; ++qp) x[qp] = __builtin_shufflevector(x[qp], x[qp], 1, 0) * (f32x2){-cs[qp & 15][1], cs[qp & 15][1]} + t[qp & 15];
        }
        dft_regs<32, 5, true>(x);
#pragma unroll
        for (int m = 0; m < 32; ++m) P[brev(m, 5) * SP] = x[m];
    }
}
DI void fft_fwd12(f32x2* X, int tid) {
    __syncthreads(); fft_pass32<false, 560>(X, fphys(tid), tid, 1.f / 16384.f);
    __syncthreads(); fft_pass32<false, 17>(X, (tid >> 4) * 560 + (tid & 15), tid & 15, 1.f / 512.f);
    __syncthreads();
}
DI void fft_inv21(f32x2* X, int tid) {
    __syncthreads(); fft_pass32<true, 17>(X, (tid >> 4) * 560 + (tid & 15), tid & 15, 1.f / 512.f);
    __syncthreads(); fft_pass32<true, 560>(X, fphys(tid), tid, 1.f / 16384.f);
    __syncthreads();
}
DI void hyena_fft_unit(const Frame& F, int li, int ch) {
    f32x2* X = (f32x2*)F.lds;
    const bf16_t* HYT = WSP(bf16_t, WS_HYT); const _Float16* filt = WSP(_Float16, WS_FILT);
    f32x2* Ye = WSP(f32x2, WS_ZBUF) + (size_t)ch * FM; f32x2* Z1 = WSP(f32x2, WS_Z1BUF) + (size_t)ch * FM;
    const float* sw = F.in[I_HYSW] + (size_t)li * 3 * 768; const float* sb = F.in[I_HYSB] + li * 768; const float* sk = F.in[I_HSKIP] + li * 512;
    const int tid = F.tid;
    const bf16_t* px1[2] = {HYT + ((size_t)0 * 768 + ch) * S, HYT + ((size_t)1 * 768 + ch) * S};
    const bf16_t* px2[2] = {HYT + ((size_t)0 * 768 + 256 + ch) * S, HYT + ((size_t)1 * 768 + 256 + ch) * S};
    const bf16_t* pv[2] = {HYT + ((size_t)0 * 768 + 512 + ch) * S, HYT + ((size_t)1 * 768 + 512 + ch) * S};
    const float wx1[4] = {sw[ch], sw[768 + ch], sw[1536 + ch], sb[ch]};
    const float wx2[4] = {sw[256 + ch], sw[768 + 256 + ch], sw[1536 + 256 + ch], sb[256 + ch]};
    const float wv[4] = {sw[512 + ch], sw[768 + 512 + ch], sw[1536 + 512 + ch], sb[512 + ch]};
#pragma unroll 1
    for (int cv = 0; cv < 2; ++cv) {
        const _Float16* hf = filt + ((size_t)(2 * cv) * 256 + ch) * S; const _Float16* hb = filt + ((size_t)(2 * cv + 1) * 256 + ch) * S;
        float fnrm;
        { int tn = tid; asm volatile("" : "+v"(tn));
          const float pv = WSP(float, WS_FPART)[(size_t)(tn & 255) * 1024 + (cv * 2 + (tn >> 8)) * 256 + ch];
          const float ws = wave_sum(pv);
          float* red = (float*)(F.lds + LDS_MISC + 128);
          __syncthreads();
          if (F.lane == 0) red[F.wave] = ws;
          __syncthreads();
          fnrm = rsqrtf(red[0] + red[1] + red[2] + red[3] + red[4] + red[5] + red[6] + red[7] + EPS); }
        const float nrm = 1.f / 32768.f;
        const float skip = sk[cv * 256 + ch];
#pragma unroll 1
        for (int half = 0; half < 2; ++half) {
            __syncthreads();
            int pb = fphys(tid); int tq = tid; asm volatile("" : "+v"(pb), "+v"(tq));
            if (half == 0) {
#pragma unroll 8
                for (int j = 0; j < 32; ++j) { const int n = tq + 512 * j; const float a = (float)hf[n] * fnrm; float bq = (float)hb[FM - n] * fnrm; bq = n ? bq : 0.f;
                    X[pb + 560 * j] = (f32x2){a + bq, 0.f}; }
            } else {
#pragma unroll 8
                for (int j = 0; j < 32; ++j) { const int n = tq + 512 * j; const float a = (float)hf[n] * fnrm; float bq = (float)hb[FM - n] * fnrm; bq = n ? bq : 0.f;
                    const float d = a - bq, rev = (float)n * (1.f / 32768.f);
                    X[pb + 560 * j] = (f32x2){d * __builtin_amdgcn_cosf(rev), -d * __builtin_amdgcn_sinf(rev)}; }
            }
            fft_fwd12(X, tid);
            h16x2 kpk[2][16];
#pragma unroll
            for (int g = 0; g < 2; ++g) { int b16 = fphys((tid + 512 * g) * 16); asm volatile("" : "+v"(b16));
                f32x2 kx[16];
#pragma unroll
                for (int q = 0; q < 16; ++q) kx[q] = X[b16 + q];
                dft_regs<16, 4, false>(kx);
#pragma unroll
                for (int q = 0; q < 16; ++q) kpk[g][q] = (h16x2){(_Float16)kx[q][0], (_Float16)kx[q][1]}; }
            __syncthreads();
            asm volatile("" : "+v"(pb), "+v"(tq));
#define HY_MOD(v, n) do { const float rev = (float)(n) * (1.f / 32768.f); v = cmul(v, __builtin_amdgcn_cosf(rev), -__builtin_amdgcn_sinf(rev)); } while (0)
            if (cv == 0) {
                if (half == 0) {
#pragma unroll 4
                    for (int j = 0; j < 32; ++j) { const int n = tq + 512 * j; X[pb + 560 * j] = (f32x2){hy_short(pv[0], n, S, wv[0], wv[1], wv[2], wv[3]), hy_short(pv[1], n, S, wv[0], wv[1], wv[2], wv[3])}; }
                } else {
#pragma unroll 4
                    for (int j = 0; j < 32; ++j) { const int n = tq + 512 * j; f32x2 v = (f32x2){hy_short(pv[0], n, S, wv[0], wv[1], wv[2], wv[3]), hy_short(pv[1], n, S, wv[0], wv[1], wv[2], wv[3])}; HY_MOD(v, n); X[pb + 560 * j] = v; }
                }
            } else {
                if (half == 0) {
#pragma unroll 8
                    for (int j = 0; j < 32; ++j) { const int n = tq + 512 * j; X[pb + 560 * j] = Z1[n]; }
                } else {
#pragma unroll 8
                    for (int j = 0; j < 32; ++j) { const int n = tq + 512 * j; f32x2 v = Z1[n]; HY_MOD(v, n); X[pb + 560 * j] = v; }
                }
            }
#undef HY_MOD
            fft_fwd12(X, tid);
#pragma unroll
            for (int g = 0; g < 2; ++g) { int b16 = fphys((tid + 512 * g) * 16); asm volatile("" : "+v"(b16));
                f32x2 dx[16], bx[16];
#pragma unroll
                for (int q = 0; q < 16; ++q) dx[q] = X[b16 + q];
                dft_regs<16, 4, false>(dx);
#pragma unroll
                for (int m = 0; m < 16; ++m) bx[brev(m, 4)] = cmul(dx[m], (float)kpk[g][m][0], (float)kpk[g][m][1]);
                dft_regs<16, 4, true>(bx);
#pragma unroll
                for (int m = 0; m < 16; ++m) X[b16 + brev(m, 4)] = bx[m];
            }
            fft_inv21(X, tid);
            asm volatile("" : "+v"(pb), "+v"(tq));
            if (half == 0) {
#pragma unroll 8
                for (int j = 0; j < 32; ++j) { const int n = tq + 512 * j; Ye[n] = X[pb + 560 * j]; }
            } else {
#define HY_Y(n, j) const f32x2 yo = X[pb + 560 * (j)], ye = Ye[n]; \
                    const float rev = (float)(n) * (1.f / 32768.f); const float c = __builtin_amdgcn_cosf(rev), sn = __builtin_amdgcn_sinf(rev); \
                    const float y0 = (ye[0] + yo[0] * c - yo[1] * sn) * nrm, y1 = (ye[1] + yo[0] * sn + yo[1] * c) * nrm;
                if (cv == 0) {
#pragma unroll 4
                    for (int j = 0; j < 32; ++j) { const int n = tq + 512 * j; HY_Y(n, j)
                        const float v0 = hy_short(pv[0], n, S, wv[0], wv[1], wv[2], wv[3]), v1 = hy_short(pv[1], n, S, wv[0], wv[1], wv[2], wv[3]);
                        const float a0 = hy_short(px1[0], n, S, wx1[0], wx1[1], wx1[2], wx1[3]), a1 = hy_short(px1[1], n, S, wx1[0], wx1[1], wx1[2], wx1[3]);
                        Z1[n] = (f32x2){a0 * (y0 + skip * v0), a1 * (y1 + skip * v1)}; }
                } else {
                    bf16_t* mix = WSP(bf16_t, WS_HBF);
#pragma unroll 4
                    for (int j = 0; j < 32; ++j) { const int n = tq + 512 * j; HY_Y(n, j)
                        const f32x2 z1 = Z1[n];
                        const float a0 = hy_short(px2[0], n, S, wx2[0], wx2[1], wx2[2], wx2[3]), a1 = hy_short(px2[1], n, S, wx2[0], wx2[1], wx2[2], wx2[3]);
                        mix[((size_t)n) * D + 768 + ch] = f2bf(a0 * (y0 + skip * z1[0]));
                        mix[((size_t)S + n) * D + 768 + ch] = f2bf(a1 * (y1 + skip * z1[1])); }
                }
#undef HY_Y
            }
        }
    }
}
DI void hyena_ctx_unit(const Frame& F, int li, int ch) {
    float* vs = (float*)F.lds;
    float* zs = vs + 512;
    float* fl = zs + 512;
    const bf16_t* HYC = WSP(bf16_t, WS_HYC); const _Float16* filt = WSP(_Float16, WS_FILTC);
    const float* sw = F.in[I_HYSW] + (size_t)li * 3 * 768; const float* sb = F.in[I_HYSB] + li * 768; const float* sk = F.in[I_HSKIP] + li * 512;
    const float n0 = hy_norm(WSP(float, WS_FPARTC), 4, 0, ch), n1 = hy_norm(WSP(float, WS_FPARTC), 4, 1, ch);
    const int b = F.tid >> 8, t = F.tid & 255;
    auto sc = [&](int c) -> float { const bf16_t* p = HYC + (size_t)(b * CTX) * 768 + c;
        const float a = t > 0 ? bf2f(p[(size_t)(t - 1) * 768]) : 0.f, d = t + 1 < CTX ? bf2f(p[(size_t)(t + 1) * 768]) : 0.f;
        return a * sw[c] + bf2f(p[(size_t)t * 768]) * sw[768 + c] + d * sw[1536 + c] + sb[c]; };
    __syncthreads();
    const float x1 = sc(ch), x2 = sc(256 + ch), v = sc(512 + ch);
    vs[F.tid] = v;
    for (int i = F.tid; i < 1024; i += NTHR) fl[i] = (float)filt[((size_t)(i >> 8) * 256 + ch) * CTX + (i & 255)];
    __syncthreads();
    float a = 0.f;
    for (int s = 0; s < CTX; ++s) { const int dl = t - s; a += (dl >= 0 ? fl[dl] : fl[256 - dl]) * vs[b * 256 + s]; }
    const float z = x1 * (a * n0 + sk[ch] * v);
    zs[F.tid] = z;
    __syncthreads();
    a = 0.f;
    for (int s = 0; s < CTX; ++s) { const int dl = t - s; a += (dl >= 0 ? fl[512 + dl] : fl[768 - dl]) * zs[b * 256 + s]; }
    WSP(bf16_t, WS_HBF)[((size_t)NLAT + b * CTX + t) * D + 768 + ch] = f2bf(x2 * (a * n1 + sk[256 + ch] * z));
}

DI void phase_mix(const Frame& F0, int li) {
    const Frame& F = F0;
    unsigned* head = F.ctl + CW_QHEAD + li * 64;
    volatile unsigned* qs = (volatile unsigned*)(F.lds + LDS_MISC + 32);
#ifndef PROBE_DA
#define PROBE_DA 1
#endif
#ifndef PROBE_HY
#define PROBE_HY 1
#endif
#ifndef PROBE_NA
#define PROBE_NA 1
#endif
#ifdef PROBE_MISC
#define PROBE_PL 2
#else
#define PROBE_PL 1
#endif
    const int n_ca = (li == 0) ? 8 : 0, n_cb = (li == 0) ? 8 : 0, n_da = 512 * PROBE_DA, n_hy = 256 * PROBE_HY, n_na = 512 * PROBE_NA, n_hc = (li == 0) ? 256 * PROBE_PL : 0, n_pl = 512 * PROBE_PL, n_pc = (li == 0) ? 8 : 0;
    const int total = n_ca + n_cb + n_da + n_hy + n_na + n_hc + n_pl + n_pc;
#if defined(PT_T) && PT_T >= 12
    unsigned long long ptk_acc = 0ull, ptk_t0 = 0ull; int ptk_kind = -1;
#endif
    for (;;) {
        __syncthreads();
#if defined(PT_T) && PT_T >= 12
        { const unsigned long long now_ = __builtin_amdgcn_s_memrealtime(); __builtin_amdgcn_s_waitcnt(0xC07F); if (ptk_kind == PT_T - 12) ptk_acc += now_ - ptk_t0; ptk_t0 = now_; }
#endif
        if (F.tid == 0) qs[0] = __hip_atomic_fetch_add(head, 1u, __ATOMIC_RELAXED, __HIP_MEMORY_SCOPE_AGENT);
        __syncthreads();
        int u = __builtin_amdgcn_readfirstlane((int)qs[0]);
#if defined(PT_T) && PT_T >= 12
        ptk_kind = u < n_ca + n_cb ? 0 : u < n_ca + n_cb + n_da ? 1 : u < n_ca + n_cb + n_da + n_hy ? 2 : u < n_ca + n_cb + n_da + n_hy + n_na ? 3 : u < n_ca + n_cb + n_da + n_hy + n_na + n_hc ? 4 : 5;
        if (u >= total) { if (F0.tid == 0) atomicAdd((unsigned long long*)(F0.ctl + 13000), ptk_acc); break; }
#endif
        if (u >= total) break;
        Frame F = F0; refresh(F);
        if (u < n_ca) {
#ifndef SKIP_CA
            diffattn_unit(F, li, u >> 2, u & 3, (size_t)NLAT + (size_t)(u >> 2) * CTX, CTX / 128);
#endif
            continue; }
        u -= n_ca;
        if (u < n_cb) {
#ifndef SKIP_CB
            na_mfma_unit(F, li, u >> 2, (size_t)NLAT + (size_t)(u >> 2) * CTX + (size_t)(u & 3) * 64, -1);
#endif
            continue; }
        u -= n_cb;
        if (u < n_da) {
#ifndef SKIP_DA
            { const int v = u & 511; diffattn_unit(F, li, v >> 8, (v >> 6) & 3, (size_t)(v >> 8) * S + (size_t)(v & 63) * 256, NKEY / 128); }
#endif
            continue; }
        u -= n_da;
        if (u < n_hy) {
#ifndef SKIP_HY
            hyena_fft_unit(F, li, u & 255);
#endif
            continue; }
        u -= n_hy;
        if (u < n_na) {
#ifndef SKIP_NA
            { const int v = u & 511; na_mfma_unit(F, li, v >> 8, (size_t)(v >> 8) * S + (size_t)(v & 255) * GW, v & 255); }
#endif
            continue; }
        u -= n_na;
        if (u < n_hc) {
#ifndef SKIP_HC
            hyena_ctx_unit(F, li, u & 255);
#endif
            continue; }
        u -= n_hc;
        if (u < n_pl) {
#ifndef SKIP_PL
            { const int v = u & 511; pool_unit(F, li, (size_t)(v >> 8) * S, S, (v & 255) * 64); }
#endif
            continue; }
        u -= n_pl;
#ifndef SKIP_PL
        pool_unit(F, li, (size_t)NLAT + (u >> 2) * CTX, CTX, (u & 3) * 64);
#endif
    }
}

constexpr int PH_PER_LAYER = 8, NPH = 2 + 2 * PH_PER_LAYER;
#ifdef PT_T
#define PT_SEL(k) (PT_T == 10 || (PT_T == 8 && (k) == 0) || (PT_T == 9 && (k) == NPH - 1) || (PT_T < 8 && (k) >= 1 && (k) <= 16 && (((k) - 1) & 7) == PT_T))
#define PT_MARK(k) do { const unsigned long long now_ = __builtin_amdgcn_s_memrealtime(); __builtin_amdgcn_s_waitcnt(0xC07F); if (PT_SEL(k)) pt_acc += now_ - pt_last; pt_last = now_; } while (0)
#ifndef PT_MULT
#define PT_MULT 4
#endif
#else
#define PT_MARK(k) do { } while (0)
#endif
__global__ void __launch_bounds__(NTHR, 2) mega(Args args) {
    extern __shared__ __attribute__((aligned(16))) unsigned char smem[];
    Frame F;
    F.in = args.in; F.out = args.out; F.ws = args.ws; F.ctl = (unsigned*)(args.ws + WS_CTL); F.lds = smem;
    F.tid = threadIdx.x; F.lane = F.tid & 63; F.wave = __builtin_amdgcn_readfirstlane(F.tid >> 6); F.G = gridDim.x; F.bid = blockIdx.x;
    if (F.tid < 64) ((unsigned*)(smem + LDS_MISC))[F.tid] = 0u;
    __syncthreads();
    const int lo = args.ph_lo, hi = args.ph_hi;
    const bool fused = (hi - lo) > 1;
    XcdBarrier bar; bar.bar = F.ctl; bar.x = 0; bar.st = (volatile LAS unsigned*)(smem + LDS_MISC);
    if (fused) bar = xcd_barrier_post(F.ctl, (volatile LAS unsigned*)(smem + LDS_MISC));
#define IN(k) (lo <= (k) && (k) < hi)
#ifdef PT_T
    unsigned long long pt_acc = 0ull, pt_last = __builtin_amdgcn_s_memrealtime(); __builtin_amdgcn_s_waitcnt(0xC07F);
#endif
#ifdef PROBE_BAR
#define SEAM(k) do { if (IN(k) && IN((k) + 1)) { xcd_barrier(bar); xcd_barrier(bar); xcd_barrier(bar); } } while (0)
#else
#define SEAM(k) do { if (IN(k) && IN((k) + 1)) xcd_barrier(bar); PT_MARK(k); } while (0)
#endif
#ifndef SKIP_P0
    if (IN(0)) { refresh(F); phase_prologue(F);
#ifdef PROBE_MISC
        __syncthreads(); refresh(F); phase_prologue(F);
#endif
    }
#endif
    SEAM(0);
    for (int li = 0; li < 2; ++li) {
        const int p0 = 1 + li * PH_PER_LAYER;
        const int nrows = (li == 0) ? NTOK : NLAT;
        if (IN(p0)) {
            refresh(F);
#if defined(PT_T) && PT_T >= 20 && PT_T <= 23
            const unsigned long long tn0_ = __builtin_amdgcn_s_memrealtime(); __builtin_amdgcn_s_waitcnt(0xC07F);
#endif
            phase_norm1(F, li, li == 0 ? 0 : 1);
#if defined(PT_T) && PT_T >= 20 && PT_T <= 23
            __syncthreads();
            const unsigned long long tn1_ = __builtin_amdgcn_s_memrealtime(); __builtin_amdgcn_s_waitcnt(0xC07F);
            if (threadIdx.x == 0 && PT_T == 20 + li) atomicAdd((unsigned long long*)(F.ctl + 13000), tn1_ - tn0_);
#endif
#ifdef PROBE_N1
            if (li == 0) { refresh(F); phase_norm1(F, li, 0); refresh(F); phase_norm1(F, li, 0); refresh(F); phase_norm1(F, li, 0); refresh(F); phase_norm1(F, li, 0); }
#endif
            refresh(F);
#ifndef SKIP_FILT
            for (int t = F.bid; t < 256; t += F.G) filter_tile(F, li, S, t, WSP(_Float16, WS_FILT), WSP(float, WS_FPART));
            if (li == 0) for (int t = F.bid; t < 4; t += F.G) filter_tile(F, li, CTX, t, WSP(_Float16, WS_FILTC), WSP(float, WS_FPARTC));
#ifdef PROBE_MISC
            for (int t = F.bid; t < 256; t += F.G) filter_tile(F, li, S, t, WSP(_Float16, WS_FILT), WSP(float, WS_FPART));
#endif
#endif
#if defined(PT_T) && PT_T >= 20 && PT_T <= 23
            { __syncthreads(); const unsigned long long tn2_ = __builtin_amdgcn_s_memrealtime(); __builtin_amdgcn_s_waitcnt(0xC07F);
              if (threadIdx.x == 0 && PT_T == 22 + li) atomicAdd((unsigned long long*)(F.ctl + 13000), tn2_ - tn1_); }
#endif
        }
        SEAM(p0);
        if (IN(p0 + 1)) {
            refresh(F);
            pg8::Gemm g{WSP(bf16_t, WS_HBF), WSP(bf16_t, WS_WIN) + (size_t)li * DIN * D, D, 0};
            pg8::StaticOrder So; So.init(NTOK, DIN, F.G, F.bid);
            EpiIn E{F.ws, WSP(float, WS_ROPE), F.ctl + CW_KMAX + li * 16, F.ctl + CW_KMAXB + li * 16};
#ifndef SKIP_G1
            pg8::gemm_phase<EpiIn, pg8::StaticOrder>((LAS unsigned char*)smem, g, So, E, F.tid);
#ifdef PROBE_G1
            __syncthreads(); refresh(F); pg8::gemm_phase<EpiIn, pg8::StaticOrder>((LAS unsigned char*)smem, g, So, E, F.tid);
#endif
#endif
        }
        SEAM(p0 + 1);
        if (IN(p0 + 2)) { refresh(F); phase_mix(F, li); }
#if defined(PT_T) && PT_T == 11
        { const unsigned long long ta_ = __builtin_amdgcn_s_memrealtime(); __builtin_amdgcn_s_waitcnt(0xC07F);
          SEAM(p0 + 2);
          const unsigned long long tb_ = __builtin_amdgcn_s_memrealtime(); __builtin_amdgcn_s_waitcnt(0xC07F);
          if (threadIdx.x == 0) atomicAdd((unsigned long long*)(F.ctl + 13000), tb_ - ta_); }
#else
        SEAM(p0 + 2);
#endif
        if (IN(p0 + 3)) {
            refresh(F);
            pg8::Gemm g{WSP(bf16_t, WS_HBF), WSP(bf16_t, WS_WOUT) + (size_t)li * D * D, D, 0};
            pg8::StaticOrder So; So.init(nrows, D, F.G, F.bid);
            EpiOut E{F.in[I_X], F.in[I_CTX], WSP(bf16_t, WS_XB), WSP(float, WS_MOD) + (size_t)li * 3 * 6144, li == 0};
#ifndef SKIP_G2
            pg8::gemm_phase<EpiOut, pg8::StaticOrder>((LAS unsigned char*)smem, g, So, E, F.tid);
#endif
        }
        SEAM(p0 + 3);
#ifndef SKIP_N2
        if (IN(p0 + 4)) { refresh(F); phase_norm2(F, li, nrows); }
#endif
        SEAM(p0 + 4);
        if (IN(p0 + 5)) { refresh(F); phase_gather(F, li, nrows);
#ifdef PROBE_MISC
            __syncthreads(); refresh(F); phase_gather(F, li, nrows);
#endif
        }
        SEAM(p0 + 5);
        if (IN(p0 + 6)) {
            refresh(F);
            int* offs = (int*)(smem + LDS_MISC + 64);
            moe_offsets(F, li, offs);
            pg8::Gemm g{WSP(bf16_t, WS_HBF), WSP(bf16_t, WS_W13) + (size_t)li * NE * 1024 * 1024, D, (size_t)1024 * 1024};
            pg8::MoeOrder Mo{offs + 40, offs[17 + 16], 4, F.G, (F.G % 8 == 0) ? (F.bid % 8) * (F.G / 8) + F.bid / 8 : F.bid};
            EpiMoe1 E{WSP(bf16_t, WS_HMID)};
#ifndef SKIP_G3
            pg8::gemm_phase_gather<EpiMoe1, pg8::MoeOrder>((LAS unsigned char*)smem, g, Mo, E, F.tid, WSP(int, WS_RMAP));
#endif
        }
        SEAM(p0 + 6);
        if (IN(p0 + 7)) {
            refresh(F);
            int* offs = (int*)(smem + LDS_MISC + 64);
            moe_offsets(F, li, offs);
            pg8::Gemm g{WSP(bf16_t, WS_HMID), WSP(bf16_t, WS_W2) + (size_t)li * NE * 1024 * 512, DE, (size_t)1024 * 512};
            pg8::MoeOrder Mo{offs + 40, offs[17 + 16], 4, F.G, (F.G % 8 == 0) ? (F.bid % 8) * (F.G / 8) + F.bid / 8 : F.bid};
            EpiMoe2 E{WSP(bf16_t, WS_A1)};
#ifndef SKIP_G4
            pg8::gemm_phase<EpiMoe2, pg8::MoeOrder>((LAS unsigned char*)smem, g, Mo, E, F.tid);
#ifdef PROBE_G4
            __syncthreads(); refresh(F); pg8::gemm_phase<EpiMoe2, pg8::MoeOrder>((LAS unsigned char*)smem, g, Mo, E, F.tid);
#endif
#endif
        }
        SEAM(p0 + 7);
    }
    if (IN(NPH - 1)) { refresh(F); phase_norm1(F, 1, 2); }
#ifdef PT_T
    asm volatile("s_waitcnt vmcnt(0)" ::: "memory"); __syncthreads();
    PT_MARK(NPH - 1);
#if PT_T >= 11
    xcd_barrier(bar);
    pt_acc = __hip_atomic_load((unsigned long long*)(F.ctl + 13000), __ATOMIC_RELAXED, __HIP_MEMORY_SCOPE_AGENT) / (unsigned long long)F.G;
    pt_last = __builtin_amdgcn_s_memrealtime();
#endif
    if (F.bid == 0) { const unsigned long long until = pt_last + (unsigned long long)PT_MULT * pt_acc;
        while (__builtin_amdgcn_s_memrealtime() < until) __builtin_amdgcn_s_sleep(8); }
#endif
#undef IN
#undef SEAM
}

extern "C" void kernel_launch(void* const* d_in, const int* in_sizes, int n_in, void* d_out, int out_size, void* d_ws, size_t ws_size, hipStream_t stream) {
    static int grid = 0;
    if (grid == 0) {
        if (n_in != N_IN || out_size != NLAT * D || ws_size < WS_END) { fprintf(stderr, "kernel_launch: unexpected shapes (n_in %d out %d ws %zu need %zu)\n", n_in, out_size, ws_size, (size_t)WS_END); grid = -1; return; }
        int dev = 0, cus = 0, per_cu = 0;
        if (hipGetDevice(&dev) != hipSuccess || hipDeviceGetAttribute(&cus, hipDeviceAttributeMultiprocessorCount, dev) != hipSuccess) { grid = -1; return; }
        if (hipFuncSetAttribute((const void*)mega, hipFuncAttributeMaxDynamicSharedMemorySize, LDS_BYTES) != hipSuccess) { fprintf(stderr, "kernel_launch: hipFuncSetAttribute failed\n"); grid = -1; return; }
        if (hipOccupancyMaxActiveBlocksPerMultiprocessor(&per_cu, (const void*)mega, NTHR, LDS_BYTES) != hipSuccess || per_cu < 1) { fprintf(stderr, "kernel_launch: occupancy query says %d\n", per_cu); }
        (void)hipGetLastError();
        grid = cus < MAXG ? cus : MAXG;
    }
    if (grid < 0) return;
    (void)hipMemsetAsync((char*)d_ws + WS_CTL, 0, CTL_BYTES, stream);
    Args a{};
    for (int i = 0; i < N_IN; ++i) a.in[i] = (const float*)d_in[i];
    a.out = (float*)d_out; a.ws = (unsigned char*)d_ws;
#if N_LAUNCH_MODE == 1
    a.ph_lo = 0; a.ph_hi = NPH;
    hipLaunchKernelGGL(mega, dim3(grid), dim3(NTHR), LDS_BYTES, stream, a);
#else
    for (int p = 0; p < NPH; ++p) { a.ph_lo = p; a.ph_hi = p + 1; hipLaunchKernelGGL(mega, dim3(grid), dim3(NTHR), LDS_BYTES, stream, a); }
#endif
}
#ifdef TEST_UNITS
__global__ void __launch_bounds__(NTHR, 2) t_da(Args args) {
    extern __shared__ __attribute__((aligned(16))) unsigned char smem[];
    Frame F; F.in = args.in; F.out = args.out; F.ws = args.ws; F.ctl = (unsigned*)(args.ws + WS_CTL); F.lds = smem; F.G = gridDim.x; F.bid = blockIdx.x; refresh(F);
    diffattn_unit(F, args.ph_lo, blockIdx.x >> 8, (blockIdx.x >> 6) & 3, (size_t)(blockIdx.x & 63) * 256, NKEY / 128);
}
__global__ void __launch_bounds__(NTHR, 2) t_hy(Args args) {
    extern __shared__ __attribute__((aligned(16))) unsigned char smem[];
    Frame F; F.in = args.in; F.out = args.out; F.ws = args.ws; F.ctl = (unsigned*)(args.ws + WS_CTL); F.lds = smem; F.G = gridDim.x; F.bid = blockIdx.x; refresh(F);
    hyena_fft_unit(F, args.ph_lo, blockIdx.x);
}
#endif
```

```cpp
#include <hip/hip_runtime.h>
#include <stdint.h>
#include <stdio.h>

#ifndef N_LAUNCH_MODE
#define N_LAUNCH_MODE 1
#endif

#define DI __device__ __forceinline__
#define LAS __attribute__((address_space(3)))
typedef unsigned short bf16_t;
typedef short bf16x8 __attribute__((ext_vector_type(8)));
typedef short s16x4 __attribute__((ext_vector_type(4)));
typedef float f32x4 __attribute__((ext_vector_type(4)));
typedef float f32x2 __attribute__((ext_vector_type(2)));
typedef float f32x16 __attribute__((ext_vector_type(16)));
typedef float f32x8 __attribute__((ext_vector_type(8)));
typedef unsigned u32x4 __attribute__((ext_vector_type(4)));
typedef unsigned u32x2 __attribute__((ext_vector_type(2)));
typedef _Float16 h16x2 __attribute__((ext_vector_type(2)));

constexpr int D = 1024, NB = 2, S = 16384, CTX = 256, NLAT = NB * S, NCTX = NB * CTX, NTOK = NLAT + NCTX, DIN = 2560;
constexpr int NE = 16, DE = 512, GW = 64;
constexpr int NKEY = CTX + S;
constexpr int NTHR = 512;
constexpr int SLOT_CAP = 70656;
constexpr float EPS = 1e-6f;
constexpr float LOG2E = 1.4426950408889634f;
constexpr float QSCALE_A = 0.17677669529663687f * LOG2E;
constexpr float QSCALE_B = 0.125f * LOG2E;

enum { I_X = 0, I_C, I_CTX, I_CCTX, I_N1G, I_N2G, I_ADAW, I_ADAB, I_WIN, I_WOUT, I_ALAM, I_ASUB, I_RPB, I_POOLW, I_POOLS, I_HYSW, I_HYSB,
       I_HW1, I_HB1, I_HW2, I_HB2, I_HW3, I_HB3, I_HSKIP, I_RW, I_RB, I_MW1, I_MW3, I_MW2, I_FG, N_IN };

struct Args { const float* in[N_IN]; float* out; unsigned char* ws; int ph_lo, ph_hi; };

constexpr size_t al256(size_t x) { return (x + 255) & ~(size_t)255; }
constexpr size_t WS_CTL = 0, CTL_BYTES = 65536;
constexpr size_t WS_MOD = WS_CTL + CTL_BYTES;
constexpr size_t WS_ROPE = WS_MOD + al256(2 * 3 * 6144 * 4);
constexpr size_t WS_PWT = WS_ROPE + 16384;
constexpr size_t WS_FPART = WS_PWT + 65536;
constexpr size_t WS_FPARTC = WS_FPART + 256 * 1024 * 4;
constexpr size_t WS_XC = WS_FPARTC + 4 * 1024 * 4;
constexpr size_t WS_WIN = WS_XC + (size_t)NCTX * D * 4;
constexpr size_t WS_WOUT = WS_WIN + (size_t)2 * DIN * D * 2;
constexpr size_t WS_W13 = WS_WOUT + (size_t)2 * D * D * 2;
constexpr size_t WS_W2 = WS_W13 + (size_t)2 * NE * 1024 * 1024 * 2;
constexpr size_t WS_FILT = WS_W2 + (size_t)2 * NE * 1024 * 512 * 2;
constexpr size_t WS_FILTC = WS_FILT + al256((size_t)4 * 256 * S * 2 + 64);
constexpr size_t WS_R1 = WS_FILTC + (size_t)4 * 256 * 256 * 2;
constexpr size_t WS_HBF = WS_R1;
constexpr size_t TOKB = (size_t)NTOK * 256 * 2;
constexpr size_t WS_AQ = WS_HBF + (size_t)NTOK * D * 2;
constexpr size_t WS_AK = WS_AQ + TOKB;
constexpr size_t WS_AVT = WS_AK + TOKB;
constexpr size_t WS_BQ = WS_AVT + (size_t)NB * 4 * 64 * NKEY * 2;
constexpr size_t WS_BK = WS_BQ + TOKB;
constexpr size_t WS_BVT = WS_BK + TOKB;
constexpr size_t WS_PL = WS_BVT + (size_t)NB * 4 * 64 * NKEY * 2;
constexpr size_t WS_HYT = WS_PL + TOKB;
constexpr size_t WS_HYC = WS_HYT + (size_t)NB * 768 * S * 2;
constexpr size_t WS_Z1BUF = WS_HYC + (size_t)NCTX * 768 * 2;
constexpr size_t WS_ZBUF = WS_Z1BUF + (size_t)256 * S * 8;
constexpr size_t WS_END_MIX = WS_ZBUF + (size_t)256 * S * 8;
constexpr size_t WS_TOK = WS_AQ;
constexpr size_t WS_A1 = WS_TOK + al256((size_t)NTOK * 32);
constexpr size_t WS_HMID = WS_A1 + (size_t)SLOT_CAP * D * 2;
constexpr size_t WS_RMAP = WS_HMID + (size_t)SLOT_CAP * DE * 2;
constexpr size_t WS_END_MOE = WS_RMAP + (size_t)SLOT_CAP * 4;
constexpr size_t WS_XB = al256(WS_END_MIX > WS_END_MOE ? WS_END_MIX : WS_END_MOE);
constexpr size_t WS_END = WS_XB + (size_t)NTOK * D * 2;

#define XB_TMO      128
#define XB_XCNT(j)  (256  + 64 * (j))
#define XB_XSUB(j)  (1280 + 64 * (j))
#define XB_XGEN(j)  (2304 + 64 * (j))
#define XB_TOP      3328
#define XB_TOPGEN   3392
#define XCD_BAR_WORDS 3456
#define XB_SPIN_CAP (1u << 18)
constexpr int CW_CNT = 4096;
constexpr int CW_KMAX = 4160;
constexpr int CW_KMAXB = 4192;
constexpr int CW_QHEAD = 4224;
constexpr int CW_BCNT = 4352;
constexpr int MAXG = 256;

constexpr int LDS_MAIN = 147456, LDS_MISC = LDS_MAIN, LDS_BYTES = LDS_MAIN + 2048;

DI float bf2f(bf16_t v) { return __uint_as_float(((unsigned)v) << 16); }
DI bf16_t f2bf(float f) { unsigned u = __float_as_uint(f); u += 0x7FFFu + ((u >> 16) & 1u); return (bf16_t)(u >> 16); }
DI unsigned pk2(float lo, float hi) { unsigned r; asm volatile("v_cvt_pk_bf16_f32 %0, %1, %2" : "=v"(r) : "v"(lo), "v"(hi)); return r; }
template <int K> DI float swz_xor(float v) { return __int_as_float(__builtin_amdgcn_ds_swizzle(__float_as_int(v), (K << 10) | 0x1F)); }
DI float half_sum(float v) { const auto r = __builtin_amdgcn_permlane32_swap(__float_as_uint(v), __float_as_uint(v), false, false); return __uint_as_float(r[0]) + __uint_as_float(r[1]); }
DI float half_max(float v) { const auto r = __builtin_amdgcn_permlane32_swap(__float_as_uint(v), __float_as_uint(v), false, false); return fmaxf(__uint_as_float(r[0]), __uint_as_float(r[1])); }
DI float wave_sum(float v) { v += swz_xor<16>(v); v += swz_xor<8>(v); v += swz_xor<4>(v); v += swz_xor<2>(v); v += swz_xor<1>(v); return half_sum(v); }
DI float wave_max(float v) { v = fmaxf(v, swz_xor<16>(v)); v = fmaxf(v, swz_xor<8>(v)); v = fmaxf(v, swz_xor<4>(v)); v = fmaxf(v, swz_xor<2>(v)); v = fmaxf(v, swz_xor<1>(v)); return half_max(v); }
DI f32x4 ld_bf4(const bf16_t* p) { const u32x2 v = *(const u32x2*)p; return (f32x4){__uint_as_float(v[0] << 16), __uint_as_float(v[0] & 0xffff0000u), __uint_as_float(v[1] << 16), __uint_as_float(v[1] & 0xffff0000u)}; }
DI f32x4 bf4_to_f4(u32x2 v) { return (f32x4){__uint_as_float(v[0] << 16), __uint_as_float(v[0] & 0xffff0000u), __uint_as_float(v[1] << 16), __uint_as_float(v[1] & 0xffff0000u)}; }
DI float siluf(float x) { return x * __builtin_amdgcn_rcpf(1.f + __expf(-x)); }
DI float sin_rev(float rev) { return __builtin_amdgcn_sinf(rev - floorf(rev)); }
DI float cos_rev(float rev) { return __builtin_amdgcn_cosf(rev - floorf(rev)); }
DI float sin_rad(float x) { return sin_rev(x * 0.15915494309189535f); }

DI unsigned xb_ld(unsigned* p)              { return __hip_atomic_load(p, __ATOMIC_RELAXED, __HIP_MEMORY_SCOPE_AGENT); }
DI unsigned xb_add(unsigned* p, unsigned v) { return __hip_atomic_fetch_add(p, v, __ATOMIC_RELAXED, __HIP_MEMORY_SCOPE_AGENT); }
DI unsigned xb_xcc_id() { return (unsigned)__builtin_amdgcn_s_getreg((3 << 11) | 20) & 0xFu; }
#define XB_SPIN(cond, bar) do { unsigned _sp = 0; while (cond) { __builtin_amdgcn_s_sleep(1); \
    if ((++_sp & 255u) == 0u) { if (xb_ld(&(bar)[XB_TMO])) break; if (_sp > XB_SPIN_CAP) { atomicAdd(&(bar)[XB_TMO], 1u); break; } } } } while (0)
struct XcdBarrier { unsigned* bar; unsigned x; volatile LAS unsigned* st; };
DI XcdBarrier xcd_barrier_post(unsigned* bar, volatile LAS unsigned* st) {
    XcdBarrier b; b.bar = bar; b.x = xb_xcc_id(); b.st = st;
    if (threadIdx.x == 0) (void)xb_add(&bar[XB_XCNT(b.x)], 1u);
    return b;
}
DI void xcd_barrier_complete(unsigned* bar, unsigned x, unsigned& nloc, unsigned& nx) {
    const unsigned G = gridDim.x * gridDim.y * gridDim.z;
    unsigned sum, cnt, mine, sp = 0u;
    for (;;) {
        sum = 0u; cnt = 0u; mine = 0u;
#pragma unroll
        for (unsigned j = 0; j < 16; ++j) { const unsigned c = xb_ld(&bar[XB_XCNT(j)]); sum += c; cnt += (c > 0u) ? 1u : 0u; mine = (j == x) ? c : mine; }
        if (sum == G) break;
        __builtin_amdgcn_s_sleep(1);
        if ((++sp & 255u) == 0u) { if (xb_ld(&bar[XB_TMO])) break; if (sp > XB_SPIN_CAP) { atomicAdd(&bar[XB_TMO], 1u); break; } }
    }
    nloc = mine > 0u ? mine : 1u; nx = cnt > 0u ? cnt : 1u;
}
DI void xcd_barrier(const XcdBarrier& b) {
    asm volatile("s_waitcnt vmcnt(0)" ::: "memory");
    __syncthreads();
    if (threadIdx.x == 0) {
        unsigned* bar = b.bar;
        __builtin_amdgcn_s_waitcnt(0);
        unsigned nloc = b.st[0], nx = b.st[1];
        if (nloc == 0u) { xcd_barrier_complete(bar, b.x, nloc, nx); b.st[0] = nloc; b.st[1] = nx; }
        const unsigned old = xb_add(&bar[XB_XSUB(b.x)], 1u);
        const unsigned gen = old / nloc;
        if (old + 1u == (gen + 1u) * nloc) {
            __builtin_amdgcn_fence(__ATOMIC_RELEASE, "agent");
            asm volatile("s_waitcnt vmcnt(0)" ::: "memory");
            const unsigned og = xb_add(&bar[XB_TOP], 1u);
            const unsigned tg = og / nx;
            if (og + 1u == (tg + 1u) * nx) xb_add(&bar[XB_TOPGEN], 1u);
            else XB_SPIN(xb_ld(&bar[XB_TOPGEN]) == tg, bar);
            __builtin_amdgcn_fence(__ATOMIC_ACQUIRE, "agent");
            xb_add(&bar[XB_XGEN(b.x)], 1u);
            asm volatile("s_waitcnt vmcnt(0)" ::: "memory");
        } else {
            XB_SPIN(xb_ld(&bar[XB_XGEN(b.x)]) == gen, bar);
            __builtin_amdgcn_fence(__ATOMIC_ACQUIRE, "agent");
            asm volatile("s_waitcnt vmcnt(0)" ::: "memory");
        }
    }
    __syncthreads();
}

struct Frame {
    const float* const* in; float* out; unsigned char* ws; unsigned* ctl;
    unsigned char* lds;
    int tid, lane, wave, G, bid;
};
#define WSP(T, off) ((T*)(F.ws + (off)))
DI void refresh(Frame& F) { int t = threadIdx.x; asm volatile("" : "+v"(t)); F.tid = t; F.lane = t & 63; F.wave = __builtin_amdgcn_readfirstlane(t >> 6);
}

namespace pg8 {
constexpr int BM = 256, BK = 64, HALF = 128, HTB = HALF * BK * 2, STAGE_BYTES = 8 * HTB, NXCD = 8, WGM = 8;
DI int lds_byte(int r, int c) { const int st = (r >> 4) * 2 + (c >> 5), rr = r & 15, cc = c & 31, ob = rr * 64 + cc * 2; return st * 1024 + (ob ^ (((ob >> 9) & 1) << 5)); }
DI void stage_rc(int b, int& R, int& C) { const int st = b / 1024, sb = b % 1024, swz = sb ^ (((sb >> 9) & 1) << 5); R = (st >> 1) * 16 + swz / 64; C = (st & 1) * 32 + (swz % 64) / 2; }
struct Unit { int pm, pn, e; };
struct Gemm { const bf16_t* A; const bf16_t* Bt; int K; size_t bstride; };
struct StaticOrder {
    int nM, nN, nwg, G, c;
    DI void init(int M, int N, int G_, int c_) { nM = M / BM; nN = N / BM; nwg = nM * nN; G = G_; c = c_; }
    DI bool next(int i, Unit& u) const {
        const long L = (long)i * G + c; if (L >= nwg) return false;
        int wgid = (int)L; { const int q = nwg / NXCD, r = nwg % NXCD, xcd = wgid % NXCD, off = wgid / NXCD; wgid = (xcd < r ? xcd * (q + 1) : r * (q + 1) + (xcd - r) * q) + off; }
        const int nig = WGM * nN, gid = wgid / nig, fm = gid * WGM, gsz = (nM - fm) < WGM ? (nM - fm) : WGM;
        u.pm = fm + ((wgid % nig) % gsz); u.pn = (wgid % nig) / gsz; u.e = 0; return true;
    }
};
struct MoeOrder {
    const int* toff; int ntile, nN, G, c;
    DI bool next(int i, Unit& u) const {
        const long L = (long)i * G + c; if (L >= (long)ntile * nN) return false;
        const int t = (int)(L / nN); u.pm = t; u.pn = (int)(L % nN);
        u.e = toff[t]; return true;
    }
};

template <class Epi, class Sched, bool PERMB = false>
DI void gemm_phase(LAS unsigned char* lds, const Gemm g, const Sched& S, const Epi& E, int tid) {
    const int wid = __builtin_amdgcn_readfirstlane(tid >> 6), lane = tid & 63, wr = wid >> 2, wc = wid & 3, fr = lane & 15, fq = lane >> 4;
    const int K = g.K, nt = K / BK;
    unsigned voffA[2], voffB[2];
#pragma unroll
    for (int i = 0; i < 2; ++i) { int R, C; stage_rc(tid * 16 + i * 8192, R, C); voffA[i] = (unsigned)(R * K + C) * 2u;
        const int rho = R & 31, Rp = PERMB ? ((R & ~31) | (8 * ((rho & 15) >> 2) + 4 * (rho >> 4) + (rho & 3))) : R; voffB[i] = (unsigned)(Rp * K + C) * 2u; }
    const size_t kstep = (size_t)(BK * 2);
    const size_t hstep = (size_t)HALF * K * 2;
    const size_t tstep = 2 * hstep;
    const unsigned ldsw = (unsigned)wid * 1024u;
    const int aoff = lds_byte(wr * 64 + fr, fq * 8), boff = lds_byte(wc * 32 + fr, fq * 8);
#define PG8_SA(b, h) (((b) * 2 + (h)) * HTB)
#define PG8_SB(b, h) ((4 + (b) * 2 + (h)) * HTB)
#define PG8_STAGE(bufoff, gbase, voff) do { _Pragma("unroll") for (int _i = 0; _i < 2; ++_i) \
        __builtin_amdgcn_global_load_lds((const unsigned*)((const char*)(gbase) + (voff)[_i]), (LAS unsigned*)(lds + (bufoff) + ldsw + _i * 8192), 16, 0, 0); } while (0)
#define PG8_LDA(dst, b, h) do { _Pragma("unroll") for (int m = 0; m < 4; ++m) _Pragma("unroll") for (int k = 0; k < 2; ++k) dst[m][k] = *(const LAS bf16x8*)(lds + PG8_SA(b, h) + aoff + m * 2048 + k * 1024); } while (0)
#define PG8_LDB(dst, b, h) do { _Pragma("unroll") for (int n = 0; n < 2; ++n) _Pragma("unroll") for (int k = 0; k < 2; ++k) dst[n][k] = *(const LAS bf16x8*)(lds + PG8_SB(b, h) + boff + n * 2048 + k * 1024); } while (0)
#define PG8_MMA(ai, bj, At, Bt) do { __builtin_amdgcn_s_setprio(1); _Pragma("unroll") for (int m = 0; m < 4; ++m) _Pragma("unroll") for (int n = 0; n < 2; ++n) _Pragma("unroll") for (int k = 0; k < 2; ++k) \
        acc[ai][bj][m][n] = __builtin_amdgcn_mfma_f32_16x16x32_bf16(Bt[n][k], At[m][k], acc[ai][bj][m][n], 0, 0, 0); __builtin_amdgcn_s_setprio(0); } while (0)
#define PG8_WAIT_V(n) asm volatile("s_waitcnt vmcnt(" #n ")" ::: "memory")
#define PG8_WAIT_L(n) asm volatile("s_waitcnt lgkmcnt(" #n ")" ::: "memory")
#define PG8_BAR __builtin_amdgcn_s_barrier()
#define PG8_SCHED __builtin_amdgcn_sched_barrier(0)
    Unit cur, nxt; int ui = 0;
    if (!S.next(0, cur)) return;
    f32x4 acc[2][2][4][2];
#pragma unroll
    for (int a = 0; a < 2; ++a)
#pragma unroll
        for (int b = 0; b < 2; ++b)
#pragma unroll
            for (int m = 0; m < 4; ++m)
#pragma unroll
                for (int n = 0; n < 2; ++n) acc[a][b][m][n] = (f32x4){0.f, 0.f, 0.f, 0.f};
    bf16x8 At[4][2], B0[2][2], B1[2][2];
    const char* cA = (const char*)g.A + (size_t)cur.pm * tstep; const char* cB = (const char*)(g.Bt + (size_t)cur.e * g.bstride) + (size_t)cur.pn * tstep;
    PG8_STAGE(PG8_SB(0, 0), cB, voffB); PG8_STAGE(PG8_SA(0, 0), cA, voffA); PG8_STAGE(PG8_SB(0, 1), cB + hstep, voffB); PG8_STAGE(PG8_SA(0, 1), cA + hstep, voffA);
    if (wr == 1) PG8_BAR;
    PG8_WAIT_V(4); PG8_BAR;
    PG8_STAGE(PG8_SB(1, 0), cB + kstep, voffB); PG8_STAGE(PG8_SA(1, 0), cA + kstep, voffA); PG8_STAGE(PG8_SB(1, 1), cB + hstep + kstep, voffB);
    PG8_WAIT_V(6); PG8_BAR;
    for (;;) {
        const bool has_next = S.next(ui + 1, nxt);
        const char* nA = has_next ? (const char*)g.A + (size_t)nxt.pm * tstep : cA; const char* nB = has_next ? (const char*)(g.Bt + (size_t)nxt.e * g.bstride) + (size_t)nxt.pn * tstep : cB;
        for (int t = 0; t < nt; t += 2) {
            const bool last = (t == nt - 2);
            const char* a1 = cA + (size_t)(t + 1) * kstep;
            const char* a2 = last ? nA : cA + (size_t)(t + 2) * kstep; const char* b2 = last ? nB : cB + (size_t)(t + 2) * kstep;
            const char* a3 = a2 + kstep; const char* b3 = b2 + kstep;
            PG8_LDB(B0, 0, 0); PG8_SCHED; PG8_LDA(At, 0, 0); PG8_STAGE(PG8_SA(1, 1), a1 + hstep, voffA);
            PG8_WAIT_L(8); PG8_BAR; PG8_WAIT_L(0); PG8_MMA(0, 0, At, B0); PG8_BAR; PG8_SCHED;
            PG8_LDB(B1, 0, 1); PG8_STAGE(PG8_SB(0, 0), b2, voffB);
            PG8_BAR; PG8_WAIT_L(0); PG8_MMA(0, 1, At, B1); PG8_BAR;
            PG8_LDA(At, 0, 1); PG8_STAGE(PG8_SA(0, 0), a2, voffA);
            PG8_BAR; PG8_WAIT_L(0); PG8_MMA(1, 0, At, B0); PG8_BAR; PG8_SCHED;
            PG8_STAGE(PG8_SB(0, 1), b2 + hstep, voffB);
            PG8_WAIT_V(6); PG8_BAR; PG8_MMA(1, 1, At, B1); PG8_BAR;
            PG8_LDB(B0, 1, 0); PG8_SCHED; PG8_LDA(At, 1, 0); PG8_STAGE(PG8_SA(0, 1), a2 + hstep, voffA);
            PG8_WAIT_L(8); PG8_BAR; PG8_WAIT_L(0); PG8_MMA(0, 0, At, B0); PG8_BAR; PG8_SCHED;
            PG8_LDB(B1, 1, 1); PG8_STAGE(PG8_SB(1, 0), b3, voffB);
            PG8_BAR; PG8_WAIT_L(0); PG8_MMA(0, 1, At, B1); PG8_BAR;
            PG8_LDA(At, 1, 1); PG8_STAGE(PG8_SA(1, 0), a3, voffA);
            PG8_BAR; PG8_WAIT_L(0); PG8_MMA(1, 0, At, B0); PG8_BAR; PG8_SCHED;
            PG8_STAGE(PG8_SB(1, 1), b3 + hstep, voffB);
            PG8_WAIT_V(6); PG8_BAR; PG8_MMA(1, 1, At, B1); PG8_BAR;
        }
        E(acc, cur, wr, wc, fr, fq);
        if (!has_next) break;
#pragma unroll
        for (int a = 0; a < 2; ++a)
#pragma unroll
            for (int b = 0; b < 2; ++b)
#pragma unroll
                for (int m = 0; m < 4; ++m)
#pragma unroll
                    for (int n = 0; n < 2; ++n) acc[a][b][m][n] = (f32x4){0.f, 0.f, 0.f, 0.f};
        cur = nxt; cA = nA; cB = nB; ++ui;
    }
    PG8_WAIT_V(0);
    if (wr == 0) PG8_BAR;
    PG8_BAR;
#undef PG8_SA
#undef PG8_SB
#undef PG8_STAGE
#undef PG8_LDA
#undef PG8_LDB
#undef PG8_MMA
#undef PG8_WAIT_V
#undef PG8_WAIT_L
#undef PG8_BAR
#undef PG8_SCHED
}
template <class Epi, class Sched>
DI void gemm_phase_gather(LAS unsigned char* lds, const Gemm g, const Sched& S, const Epi& E, int tid, const int* rowmap) {
    const int wid = __builtin_amdgcn_readfirstlane(tid >> 6), lane = tid & 63, wr = wid >> 2, wc = wid & 3, fr = lane & 15, fq = lane >> 4;
    const int K = g.K, nt = K / BK;
    unsigned voffA[2];
#pragma unroll
    for (int i = 0; i < 2; ++i) { int R, C; stage_rc(tid * 16 + i * 8192, R, C); voffA[i] = (unsigned)(R * K + C) * 2u; }
    const unsigned rowb = (unsigned)K * 2u;
#define PG8_ROWS_PK(pm, P) do { int t_ = tid; asm volatile("" : "+v"(t_)); int R0_, C0_, R1_, C1_; stage_rc(t_ * 16, R0_, C0_); stage_rc(t_ * 16 + 8192, R1_, C1_); \
        _Pragma("unroll") for (int h_ = 0; h_ < 2; ++h_) P[h_] = (unsigned)rowmap[(pm) * 256 + h_ * 128 + R0_] | ((unsigned)rowmap[(pm) * 256 + h_ * 128 + R1_] << 16); } while (0)
#define PG8_UNPK(P, O) do { int t_ = tid; asm volatile("" : "+v"(t_)); int R0_, C0_, R1_, C1_; stage_rc(t_ * 16, R0_, C0_); stage_rc(t_ * 16 + 8192, R1_, C1_); \
        _Pragma("unroll") for (int h_ = 0; h_ < 2; ++h_) { O[h_][0] = (P[h_] & 0xffffu) * rowb + (unsigned)C0_ * 2u; O[h_][1] = (P[h_] >> 16) * rowb + (unsigned)C1_ * 2u; } } while (0)
    const size_t kstep = (size_t)(BK * 2);
    const size_t hstep = (size_t)HALF * K * 2;
    const size_t tstep = 2 * hstep;
    const unsigned ldsw = (unsigned)wid * 1024u;
    const int aoff = lds_byte(wr * 64 + fr, fq * 8), boff = lds_byte(wc * 32 + fr, fq * 8);
#define PG8_SA(b, h) (((b) * 2 + (h)) * HTB)
#define PG8_SB(b, h) ((4 + (b) * 2 + (h)) * HTB)
#define PG8_STAGE(bufoff, gbase, voff) do { _Pragma("unroll") for (int _i = 0; _i < 2; ++_i) \
        __builtin_amdgcn_global_load_lds((const unsigned*)((const char*)(gbase) + (voff)[_i]), (LAS unsigned*)(lds + (bufoff) + ldsw + _i * 8192), 16, 0, 0); } while (0)
#define PG8_LDA(dst, b, h) do { _Pragma("unroll") for (int m = 0; m < 4; ++m) _Pragma("unroll") for (int k = 0; k < 2; ++k) dst[m][k] = *(const LAS bf16x8*)(lds + PG8_SA(b, h) + aoff + m * 2048 + k * 1024); } while (0)
#define PG8_LDB(dst, b, h) do { _Pragma("unroll") for (int n = 0; n < 2; ++n) _Pragma("unroll") for (int k = 0; k < 2; ++k) dst[n][k] = *(const LAS bf16x8*)(lds + PG8_SB(b, h) + boff + n * 2048 + k * 1024); } while (0)
#define PG8_MMA(ai, bj, At, Bt) do { __builtin_amdgcn_s_setprio(1); _Pragma("unroll") for (int m = 0; m < 4; ++m) _Pragma("unroll") for (int n = 0; n < 2; ++n) _Pragma("unroll") for (int k = 0; k < 2; ++k) \
        acc[ai][bj][m][n] = __builtin_amdgcn_mfma_f32_16x16x32_bf16(Bt[n][k], At[m][k], acc[ai][bj][m][n], 0, 0, 0); __builtin_amdgcn_s_setprio(0); } while (0)
#define PG8_WAIT_V(n) asm volatile("s_waitcnt vmcnt(" #n ")" ::: "memory")
#define PG8_WAIT_L(n) asm volatile("s_waitcnt lgkmcnt(" #n ")" ::: "memory")
#define PG8_BAR __builtin_amdgcn_s_barrier()
#define PG8_SCHED __builtin_amdgcn_sched_barrier(0)
    Unit cur, nxt; int ui = 0;
    if (!S.next(0, cur)) return;
    f32x4 acc[2][2][4][2];
#pragma unroll
    for (int a = 0; a < 2; ++a)
#pragma unroll
        for (int b = 0; b < 2; ++b)
#pragma unroll
            for (int m = 0; m < 4; ++m)
#pragma unroll
                for (int n = 0; n < 2; ++n) acc[a][b][m][n] = (f32x4){0.f, 0.f, 0.f, 0.f};
    bf16x8 At[4][2], B0[2][2], B1[2][2];
    unsigned offC[2][2], pkN[2];
    PG8_ROWS_PK(cur.pm, pkN); PG8_UNPK(pkN, offC);
    const char* cA = (const char*)g.A; const char* cB = (const char*)(g.Bt + (size_t)cur.e * g.bstride) + (size_t)cur.pn * tstep;
    PG8_STAGE(PG8_SB(0, 0), cB, voffA); PG8_STAGE(PG8_SA(0, 0), cA, offC[0]); PG8_STAGE(PG8_SB(0, 1), cB + hstep, voffA); PG8_STAGE(PG8_SA(0, 1), cA, offC[1]);
    if (wr == 1) PG8_BAR;
    PG8_WAIT_V(4); PG8_BAR;
    PG8_STAGE(PG8_SB(1, 0), cB + kstep, voffA); PG8_STAGE(PG8_SA(1, 0), cA + kstep, offC[0]); PG8_STAGE(PG8_SB(1, 1), cB + hstep + kstep, voffA);
    PG8_WAIT_V(6); PG8_BAR;
    for (;;) {
        const bool has_next = S.next(ui + 1, nxt);
        if (has_next) PG8_ROWS_PK(nxt.pm, pkN);
        const char* nB = has_next ? (const char*)(g.Bt + (size_t)nxt.e * g.bstride) + (size_t)nxt.pn * tstep : cB;
        for (int t = 0; t < nt; t += 2) {
            const bool last = (t == nt - 2);
            const char* a1 = cA + (size_t)(t + 1) * kstep;
            const char* a2 = last ? cA : cA + (size_t)(t + 2) * kstep;
            const char* b2 = last ? nB : cB + (size_t)(t + 2) * kstep;
            const char* a3 = a2 + kstep; const char* b3 = b2 + kstep;
            PG8_LDB(B0, 0, 0); PG8_SCHED; PG8_LDA(At, 0, 0); PG8_STAGE(PG8_SA(1, 1), a1, offC[1]);
            if (last) PG8_UNPK(pkN, offC);
            PG8_WAIT_L(8); PG8_BAR; PG8_WAIT_L(0); PG8_MMA(0, 0, At, B0); PG8_BAR; PG8_SCHED;
            PG8_LDB(B1, 0, 1); PG8_STAGE(PG8_SB(0, 0), b2, voffA);
            PG8_BAR; PG8_WAIT_L(0); PG8_MMA(0, 1, At, B1); PG8_BAR;
            PG8_LDA(At, 0, 1); PG8_STAGE(PG8_SA(0, 0), a2, offC[0]);
            PG8_BAR; PG8_WAIT_L(0); PG8_MMA(1, 0, At, B0); PG8_BAR; PG8_SCHED;
            PG8_STAGE(PG8_SB(0, 1), b2 + hstep, voffA);
            PG8_WAIT_V(6); PG8_BAR; PG8_MMA(1, 1, At, B1); PG8_BAR;
            PG8_LDB(B0, 1, 0); PG8_SCHED; PG8_LDA(At, 1, 0); PG8_STAGE(PG8_SA(0, 1), a2, offC[1]);
            PG8_WAIT_L(8); PG8_BAR; PG8_WAIT_L(0); PG8_MMA(0, 0, At, B0); PG8_BAR; PG8_SCHED;
            PG8_LDB(B1, 1, 1); PG8_STAGE(PG8_SB(1, 0), b3, voffA);
            PG8_BAR; PG8_WAIT_L(0); PG8_MMA(0, 1, At, B1); PG8_BAR;
            PG8_LDA(At, 1, 1); PG8_STAGE(PG8_SA(1, 0), a3, offC[0]);
            PG8_BAR; PG8_WAIT_L(0); PG8_MMA(1, 0, At, B0); PG8_BAR; PG8_SCHED;
            PG8_STAGE(PG8_SB(1, 1), b3 + hstep, voffA);
            PG8_WAIT_V(6); PG8_BAR; PG8_MMA(1, 1, At, B1); PG8_BAR;
        }
        E(acc, cur, wr, wc, fr, fq);
        if (!has_next) break;
#pragma unroll
        for (int a = 0; a < 2; ++a)
#pragma unroll
            for (int b = 0; b < 2; ++b)
#pragma unroll
                for (int m = 0; m < 4; ++m)
#pragma unroll
                    for (int n = 0; n < 2; ++n) acc[a][b][m][n] = (f32x4){0.f, 0.f, 0.f, 0.f};
        cur = nxt; cB = nB; ++ui;
    }
    PG8_WAIT_V(0);
    if (wr == 0) PG8_BAR;
    PG8_BAR;
#undef PG8_ROWS_PK
#undef PG8_UNPK
#undef PG8_SA
#undef PG8_SB
#undef PG8_STAGE
#undef PG8_LDA
#undef PG8_LDB
#undef PG8_MMA
#undef PG8_WAIT_V
#undef PG8_WAIT_L
#undef PG8_BAR
#undef PG8_SCHED
}
}

typedef f32x4 AccT[2][2][4][2];

struct EpiIn {
    unsigned char* ws; const float* rope; unsigned* kmax; unsigned* kmaxb;
    DI void operator()(const AccT& acc, const pg8::Unit& u, int wr, int wc, int fr, int fq) const {
        const int pn = u.pn, row0 = u.pm * 256 + wr * 64 + fr;
        const bool isctx = (u.pm >= NLAT / 256);
        if (pn <= 1) {
            bf16_t* dst = (bf16_t*)(ws + (pn == 0 ? WS_AQ : WS_AK));
            const float sc = (pn == 0) ? QSCALE_A : 1.f;
            float nmax[2] = {0.f, 0.f};
#pragma unroll
            for (int ai = 0; ai < 2; ++ai)
#pragma unroll
                for (int m = 0; m < 4; ++m) {
                    const int r = row0 + ai * 128 + m * 16;
                    f32x4 cs0 = (f32x4){1.f, 0.f, 1.f, 0.f}, cs1 = cs0;
                    if (!isctx) { const int t = r & (S - 1); const int pos = (fq < 2) ? (t >> 6) : (t & 63);
                        const f32x4* tp = (const f32x4*)(rope + (size_t)pos * 16 + (fq & 1) * 8); cs0 = tp[0]; cs1 = tp[1]; }
                    const float cc[4] = {cs0[0], cs0[2], cs1[0], cs1[2]}, ss[4] = {cs0[1], cs0[3], cs1[1], cs1[3]};
#pragma unroll
                    for (int bj = 0; bj < 2; ++bj) {
                        const f32x4 x1 = acc[ai][bj][m][0], x2 = acc[ai][bj][m][1];
                        float o1[4], o2[4], n2 = 0.f;
#pragma unroll
                        for (int j = 0; j < 4; ++j) { o1[j] = (x1[j] * cc[j] - x2[j] * ss[j]) * sc; o2[j] = (x2[j] * cc[j] + x1[j] * ss[j]) * sc; n2 += x1[j] * x1[j] + x2[j] * x2[j]; }
                        bf16_t* p = dst + (size_t)r * 256 + bj * 128 + wc * 32 + 4 * fq;
                        *(u32x2*)p = (u32x2){pk2(o1[0], o1[1]), pk2(o1[2], o1[3])};
                        *(u32x2*)(p + 16) = (u32x2){pk2(o2[0], o2[1]), pk2(o2[2], o2[3])};
                        if (pn == 1) { n2 += swz_xor<16>(n2); n2 = half_sum(n2); nmax[bj] = fmaxf(nmax[bj], n2); }
                    }
                }
            if (pn == 1) {
                const int b = isctx ? (u.pm - NLAT / 256) : (u.pm / (S / 256));
#pragma unroll
                for (int bj = 0; bj < 2; ++bj) {
                    float v = nmax[bj];
                    v = fmaxf(v, swz_xor<1>(v)); v = fmaxf(v, swz_xor<2>(v)); v = fmaxf(v, swz_xor<4>(v)); v = fmaxf(v, swz_xor<8>(v));
                    if ((fr | fq) == 0) atomicMax(kmax + (b * 4 + (2 * bj + (wc >> 1))) * 2 + (wc & 1), __float_as_uint(v));
                }
            }
        } else if (pn == 2 || pn == 5) {
            bf16_t* dst = (bf16_t*)(ws + (pn == 2 ? WS_AVT : WS_BVT));
#pragma unroll
            for (int ai = 0; ai < 2; ++ai)
#pragma unroll
                for (int m = 0; m < 4; ++m) {
                    const int r = row0 + ai * 128 + m * 16;
                    int b, key; if (isctx) { b = (r - NLAT) >> 8; key = (r - NLAT) & 255; } else { b = r >> 14; key = CTX + (r & (S - 1)); }
                    key = (key & ~12) | ((key & 4) << 1) | ((key & 8) >> 1);
#pragma unroll
                    for (int bj = 0; bj < 2; ++bj)
#pragma unroll
                        for (int n = 0; n < 2; ++n) {
                            const int lc = bj * 128 + wc * 32 + n * 16 + 4 * fq;
#pragma unroll
                            for (int j = 0; j < 4; ++j) dst[((size_t)(b * 256 + lc + j)) * NKEY + key] = f2bf(acc[ai][bj][m][n][j]);
                        }
                }
        } else if (pn <= 6) {
            bf16_t* dst = (bf16_t*)(ws + (pn == 3 ? WS_BQ : pn == 4 ? WS_BK : WS_PL));
            const float sc = (pn == 3) ? QSCALE_B : 1.f;
            float nmax[2] = {0.f, 0.f};
#pragma unroll
            for (int ai = 0; ai < 2; ++ai)
#pragma unroll
                for (int m = 0; m < 4; ++m) {
                    const int r = row0 + ai * 128 + m * 16;
#pragma unroll
                    for (int bj = 0; bj < 2; ++bj)
#pragma unroll
                        for (int n = 0; n < 2; ++n) {
                            const f32x4 v = acc[ai][bj][m][n] * sc;
                            *(u32x2*)(dst + (size_t)r * 256 + bj * 128 + wc * 32 + n * 16 + 4 * fq) = (u32x2){pk2(v[0], v[1]), pk2(v[2], v[3])};
                        }
                    if (pn == 4) {
#pragma unroll
                        for (int bj = 0; bj < 2; ++bj) { const f32x4 x1 = acc[ai][bj][m][0], x2 = acc[ai][bj][m][1];
                            float n2 = x1[0] * x1[0] + x1[1] * x1[1] + x1[2] * x1[2] + x1[3] * x1[3] + x2[0] * x2[0] + x2[1] * x2[1] + x2[2] * x2[2] + x2[3] * x2[3];
                            n2 += swz_xor<16>(n2); n2 = half_sum(n2); nmax[bj] = fmaxf(nmax[bj], n2); }
                    }
                }
            if (pn == 4) {
                const int b = isctx ? (u.pm - NLAT / 256) : (u.pm / (S / 256));
#pragma unroll
                for (int bj = 0; bj < 2; ++bj) {
                    float v = nmax[bj];
                    v = fmaxf(v, swz_xor<1>(v)); v = fmaxf(v, swz_xor<2>(v)); v = fmaxf(v, swz_xor<4>(v)); v = fmaxf(v, swz_xor<8>(v));
                    if ((fr | fq) == 0) atomicMax(kmaxb + (b * 4 + (2 * bj + (wc >> 1))) * 2 + (wc & 1), __float_as_uint(v));
                }
            }
        } else {
            const int hc0 = (pn - 7) * 256;
#pragma unroll
            for (int ai = 0; ai < 2; ++ai)
#pragma unroll
                for (int m = 0; m < 4; ++m) {
                    const int r = row0 + ai * 128 + m * 16;
#pragma unroll
                    for (int bj = 0; bj < 2; ++bj)
#pragma unroll
                        for (int n = 0; n < 2; ++n) {
                            const int hc = hc0 + bj * 128 + wc * 32 + n * 16 + 4 * fq; const f32x4 v = acc[ai][bj][m][n];
                            if (isctx) *(u32x2*)((bf16_t*)(ws + WS_HYC) + (size_t)(r - NLAT) * 768 + hc) = (u32x2){pk2(v[0], v[1]), pk2(v[2], v[3])};
                            else { bf16_t* dst = (bf16_t*)(ws + WS_HYT) + ((size_t)(r >> 14) * 768 + hc) * S + (r & (S - 1));
#pragma unroll
                                for (int j = 0; j < 4; ++j) dst[(size_t)j * S] = f2bf(v[j]); }
                        }
                }
        }
    }
};

struct EpiOut {
    const float* xl_in; const float* xc_in; bf16_t* xb; const float* mod; bool from_inputs;
    DI void operator()(const AccT& acc, const pg8::Unit& u, int wr, int wc, int fr, int fq) const {
        const int row0 = u.pm * 256 + wr * 64 + fr; const bool isctx = (u.pm >= NLAT / 256);
        const int v = isctx ? 2 : (u.pm / (S / 256));
        const float* g1 = mod + (size_t)v * 6144 + 2 * 1024;
        const float* so = isctx ? xc_in - (size_t)NLAT * D : xl_in;
#pragma unroll
        for (int bj = 0; bj < 2; ++bj) {
            const int c = u.pn * 256 + bj * 128 + wc * 32 + 8 * fq;
            const f32x4 ga = *(const f32x4*)(g1 + c), gb = *(const f32x4*)(g1 + c + 4);
#pragma unroll
            for (int ai = 0; ai < 2; ++ai)
#pragma unroll
                for (int m = 0; m < 4; ++m) {
                    const size_t o = (size_t)(row0 + ai * 128 + m * 16) * D + c;
                    f32x4 xa, xb_;
                    if (from_inputs) { xa = *(const f32x4*)(so + o); xb_ = *(const f32x4*)(so + o + 4); }
                    else { const u32x4 t = *(const u32x4*)(xb + o); xa = bf4_to_f4((u32x2){t[0], t[1]}); xb_ = bf4_to_f4((u32x2){t[2], t[3]}); }
                    const f32x4 na = xa + ga * acc[ai][bj][m][0], nb = xb_ + gb * acc[ai][bj][m][1];
                    *(u32x4*)(xb + o) = (u32x4){pk2(na[0], na[1]), pk2(na[2], na[3]), pk2(nb[0], nb[1]), pk2(nb[2], nb[3])};
                }
        }
    }
};

struct EpiMoe1 {
    bf16_t* hmid;
    DI void operator()(const AccT& acc, const pg8::Unit& u, int wr, int wc, int fr, int fq) const {
        const int row0 = u.pm * 256 + wr * 64 + fr;
#pragma unroll
        for (int ai = 0; ai < 2; ++ai)
#pragma unroll
            for (int m = 0; m < 4; ++m)
#pragma unroll
                for (int bj = 0; bj < 2; ++bj) {
                    const f32x4 a = acc[ai][bj][m][0], b = acc[ai][bj][m][1]; float h[4];
#pragma unroll
                    for (int j = 0; j < 4; ++j) h[j] = siluf(a[j]) * b[j];
                    *(u32x2*)(hmid + (size_t)(row0 + ai * 128 + m * 16) * DE + (u.pn * 256 + bj * 128 + wc * 32) / 2 + 4 * fq) = (u32x2){pk2(h[0], h[1]), pk2(h[2], h[3])};
                }
    }
};
struct EpiMoe2 {
    bf16_t* ys;
    DI void operator()(const AccT& acc, const pg8::Unit& u, int wr, int wc, int fr, int fq) const {
        const int row0 = u.pm * 256 + wr * 64 + fr;
#pragma unroll
        for (int ai = 0; ai < 2; ++ai)
#pragma unroll
            for (int m = 0; m < 4; ++m)
#pragma unroll
                for (int bj = 0; bj < 2; ++bj)
                    { const f32x4 v = acc[ai][bj][m][0], w = acc[ai][bj][m][1];
                        *(u32x4*)(ys + (size_t)(row0 + ai * 128 + m * 16) * D + u.pn * 256 + bj * 128 + wc * 32 + 8 * fq) = (u32x4){pk2(v[0], v[1]), pk2(v[2], v[3]), pk2(w[0], w[1]), pk2(w[2], w[3])}; }
    }
};

struct TcTile { const float* src; bf16_t* dst; int N, k0, n0, ldd, mode; };
DI TcTile tconv_desc(const Frame& F, int u) {
    const int T_IN = 16 * 40, T_OUT = 16 * 16, T_E = 16 * 8;
    const int per_layer = T_IN + T_OUT + NE * 3 * T_E;
    const int li = u / per_layer; int r = u % per_layer; TcTile t;
    if (r < T_IN) { t.src = F.in[I_WIN] + (size_t)li * D * DIN; t.N = DIN; t.k0 = (r / 40) * 64; t.n0 = (r % 40) * 64; t.dst = WSP(bf16_t, WS_WIN) + (size_t)li * DIN * D; t.ldd = D; t.mode = 0; return t; }
    r -= T_IN;
    if (r < T_OUT) { t.src = F.in[I_WOUT] + (size_t)li * D * D; t.N = D; t.k0 = (r / 16) * 64; t.n0 = (r % 16) * 64; t.dst = WSP(bf16_t, WS_WOUT) + (size_t)li * D * D; t.ldd = D; t.mode = 0; return t; }
    r -= T_OUT;
    const int e = r / (3 * T_E), w = (r / T_E) % 3, q = r % T_E;
    if (w < 2) { t.src = F.in[w == 0 ? I_MW1 : I_MW3] + ((size_t)li * NE + e) * D * DE; t.N = DE; t.k0 = (q / 8) * 64; t.n0 = (q % 8) * 64; t.dst = WSP(bf16_t, WS_W13) + ((size_t)li * NE + e) * 1024 * 1024; t.ldd = D; t.mode = 1 + w; }
    else { t.src = F.in[I_MW2] + ((size_t)li * NE + e) * DE * D; t.N = D; t.k0 = (q / 16) * 64; t.n0 = (q % 16) * 64; t.dst = WSP(bf16_t, WS_W2) + ((size_t)li * NE + e) * 1024 * 512; t.ldd = DE; t.mode = 0; }
    return t;
}
DI void phase_prologue(const Frame& F) {
    {
        const int total = 2 * (16 * 40 + 16 * 16 + NE * 3 * 16 * 8);
        float* tl = (float*)F.lds;
        float v[8];
        int u = F.bid;
        if (u < total) { const TcTile t = tconv_desc(F, u);
#pragma unroll
            for (int i = 0; i < 8; ++i) { const int idx = F.tid + 512 * i, k = idx >> 6, n = idx & 63; v[i] = t.src[(size_t)(t.k0 + k) * t.N + t.n0 + n]; } }
        for (; u < total; u += F.G) {
            const TcTile t = tconv_desc(F, u);
            __syncthreads();
#pragma unroll
            for (int i = 0; i < 8; ++i) { const int idx = F.tid + 512 * i, k = idx >> 6, n = idx & 63; tl[k * 65 + n] = v[i]; }
            __syncthreads();
            if (u + F.G < total) { const TcTile tn = tconv_desc(F, u + F.G);
#pragma unroll
                for (int i = 0; i < 8; ++i) { const int idx = F.tid + 512 * i, k = idx >> 6, n = idx & 63; v[i] = tn.src[(size_t)(tn.k0 + k) * tn.N + tn.n0 + n]; } }
#pragma unroll
            for (int i = 0; i < 4; ++i) { const int idx = F.tid + 512 * i, n = idx >> 5, kp = idx & 31;
                const int nn = t.n0 + n; const int row = (t.mode == 0) ? nn : ((nn >> 4) * 32 + (t.mode - 1) * 16 + (nn & 15));
                *(unsigned*)(t.dst + (size_t)row * t.ldd + t.k0 + 2 * kp) = pk2(tl[(2 * kp) * 65 + n], tl[(2 * kp + 1) * 65 + n]); }
        }
    }
    __syncthreads();
    {
        float* sc = (float*)F.lds;
        float* red = sc + 3072;
        for (int i = F.tid; i < 3072; i += NTHR) { const int v = i >> 10, k = i & 1023; const float x = (v < 2) ? F.in[I_C][v * 1024 + k] : F.in[I_CCTX][k]; sc[i] = siluf(x); }
        __syncthreads();
        for (int u = F.bid; u < 2 * 96; u += F.G) {
            const int li = u / 96, j = (u % 96) * 64 + F.lane, ko = F.wave;
            const float* w = F.in[I_ADAW] + (size_t)li * D * 6144 + j;
            float a0 = 0.f, a1 = 0.f, a2 = 0.f;
            for (int k = ko * 128; k < ko * 128 + 128; ++k) { const float wv = w[(size_t)k * 6144]; a0 += sc[k] * wv; a1 += sc[1024 + k] * wv; a2 += sc[2048 + k] * wv; }
            red[(ko * 3 + 0) * 64 + F.lane] = a0; red[(ko * 3 + 1) * 64 + F.lane] = a1; red[(ko * 3 + 2) * 64 + F.lane] = a2;
            __syncthreads();
            if (F.tid < 192) { const int v = F.tid / 64, l = F.tid % 64; float s = 0.f;
#pragma unroll
                for (int q = 0; q < 8; ++q) s += red[(q * 3 + v) * 64 + l];
                const int jj = (u % 96) * 64 + l;
                WSP(float, WS_MOD)[((size_t)li * 3 + v) * 6144 + jj] = s + F.in[I_ADAB][li * 6144 + jj]; }
            __syncthreads();
        }
    }
    if (F.bid == (F.G > 2 ? 2 : 0)) {
        for (int idx = F.tid; idx < 2 * 4 * 64 * 64; idx += NTHR) { const int i = idx & 63, j = (idx >> 6) & 63, lg = idx >> 12;
            WSP(bf16_t, WS_PWT)[idx] = f2bf(F.in[I_POOLW][((size_t)lg * 64 + i) * 64 + j]); }
    }
    if (F.bid == (F.G > 1 ? 1 : 0)) {
        for (int i = F.tid; i < 256 * 8; i += NTHR) { const int pos = i >> 3, f = i & 7; const float inv = exp2f(-(float)f * (13.287712379549449f / 8.f)); const float rev = (float)pos * inv * 0.15915494309189535f;
            WSP(float, WS_ROPE)[i * 2] = cos_rev(rev); WSP(float, WS_ROPE)[i * 2 + 1] = sin_rev(rev); }
    }
}

#define MFMA32(a, b, c) __builtin_amdgcn_mfma_f32_32x32x16_bf16((a), (b), (c), 0, 0, 0)
DI void filter_tile(const Frame& F, int li, int L, int tile, _Float16* hT, float* part) {
    float* h1s = (float*)F.lds;
    float* h2s = h1s + 64 * 65;
    float* w1s = h2s + 64 * 68;
    float* w2s = w1s + 34 * 64;
    const float* w3 = F.in[I_HW3] + (size_t)li * 64 * 1024; const float* b3 = F.in[I_HB3] + li * 1024;
    const int t0 = tile * 64;
    const float inv_lm1 = 1.f / (float)(L > 1 ? L - 1 : 1);
    __syncthreads();
    {
        const float* w1 = F.in[I_HW1] + (size_t)li * 33 * 64; const float* b1 = F.in[I_HB1] + li * 64;
        const float* w2 = F.in[I_HW2] + (size_t)li * 64 * 64; const float* b2 = F.in[I_HB2] + li * 64;
        for (int i = F.tid; i < 33 * 64; i += NTHR) w1s[i] = w1[i];
        for (int i = F.tid; i < 4096; i += NTHR) w2s[i] = w2[i];
        if (F.tid < 64) { w1s[33 * 64 + F.tid] = b1[F.tid]; w2s[4096 + F.tid] = b2[F.tid]; }
    }
    __syncthreads();
    {
        const int tl = F.tid & 63, pt = F.tid >> 6; const float t = (float)(t0 + tl);
        float a[8];
#pragma unroll
        for (int jj = 0; jj < 8; ++jj) a[jj] = w1s[33 * 64 + pt * 8 + jj] + (t * inv_lm1) * w1s[pt * 8 + jj];
#pragma unroll 2
        for (int i = 0; i < 16; ++i) { const float band = 1e-4f + (15.f - 1e-4f) * (float)i / 15.f; const float rev = t * band / (float)L; const float cz = cos_rev(rev), sz = sin_rev(rev);
#pragma unroll
            for (int jj = 0; jj < 8; ++jj) a[jj] += cz * w1s[(1 + i) * 64 + pt * 8 + jj] + sz * w1s[(17 + i) * 64 + pt * 8 + jj]; }
#pragma unroll
        for (int jj = 0; jj < 8; ++jj) h1s[tl * 65 + pt * 8 + jj] = sin_rad(a[jj]);
    }
    __syncthreads();
    {
        const int tl = F.tid & 63, pt = F.tid >> 6;
        float a[8];
#pragma unroll
        for (int jj = 0; jj < 8; ++jj) a[jj] = w2s[4096 + pt * 8 + jj];
#pragma unroll 4
        for (int i = 0; i < 64; ++i) { const float hv = h1s[tl * 65 + i];
#pragma unroll
            for (int jj = 0; jj < 8; ++jj) a[jj] += hv * w2s[i * 64 + pt * 8 + jj]; }
#pragma unroll
        for (int jj = 0; jj < 8; ++jj) h2s[tl * 68 + pt * 8 + jj] = sin_rad(a[jj]);
    }
    __syncthreads();
    {
        const int l31 = F.lane & 31, kg = F.lane >> 5;
        auto split8 = [](const float (&x)[8], bf16x8& hi, bf16x8& lo) {
            u32x4 h, l;
#pragma unroll
            for (int e = 0; e < 4; ++e) { const unsigned hp = pk2(x[2 * e], x[2 * e + 1]); h[e] = hp;
                l[e] = pk2(x[2 * e] - __uint_as_float(hp << 16), x[2 * e + 1] - __uint_as_float(hp & 0xffff0000u)); }
            hi = __builtin_bit_cast(bf16x8, h); lo = __builtin_bit_cast(bf16x8, l); };
        bf16x8 Bh[2][4], Bl[2][4];
#pragma unroll
        for (int pb = 0; pb < 2; ++pb)
#pragma unroll
            for (int ks = 0; ks < 4; ++ks) { const float* hp = h2s + (pb * 32 + l31) * 68 + ks * 16 + kg * 8; const f32x4 x0 = *(const f32x4*)hp, x1 = *(const f32x4*)(hp + 4);
                const float x[8] = {x0[0], x0[1], x0[2], x0[3], x1[0], x1[1], x1[2], x1[3]}; split8(x, Bh[pb][ks], Bl[pb][ks]); }
        const float tn0 = (float)(t0 + l31) * inv_lm1, tn1 = (float)(t0 + 32 + l31) * inv_lm1;
        const bool b4 = (l31 & 16) != 0, b3q = (l31 & 8) != 0, b2 = (l31 & 4) != 0, b1q = (l31 & 2) != 0;
#pragma unroll 1
        for (int cb = 0; cb < 4; ++cb) {
            const int ch0 = F.wave * 128 + cb * 32;
            f32x16 acc0, acc1;
#pragma unroll
            for (int i = 0; i < 16; ++i) { acc0[i] = 0.f; acc1[i] = 0.f; }
#pragma unroll
            for (int ks = 0; ks < 4; ++ks) {
                float x[8];
#pragma unroll
                for (int e = 0; e < 8; ++e) x[e] = w3[(size_t)(ks * 16 + kg * 8 + e) * 1024 + ch0 + l31];
                bf16x8 Ah, Al; split8(x, Ah, Al);
                acc0 = MFMA32(Ah, Bh[0][ks], acc0); acc1 = MFMA32(Ah, Bh[1][ks], acc1);
                acc0 = MFMA32(Al, Bh[0][ks], acc0); acc1 = MFMA32(Al, Bh[1][ks], acc1);
                acc0 = MFMA32(Ah, Bl[0][ks], acc0); acc1 = MFMA32(Ah, Bl[1][ks], acc1);
            }
            float sq[16];
#pragma unroll
            for (int i = 0; i < 16; ++i) {
                const int ch = ch0 + 8 * (i >> 2) + 4 * kg + (i & 3);
                const float bb = b3[ch], delta = 3.0701134573253945f + (15.350567286626973f - 3.0701134573253945f) * (float)(ch & 255) / 255.f;
                const float v0 = (acc0[i] + bb) * __expf(-tn0 * delta), v1 = (acc1[i] + bb) * __expf(-tn1 * delta);
                _Float16* hp = hT + (size_t)ch * L + t0 + l31; hp[0] = (_Float16)v0; hp[32] = (_Float16)v1;
                sq[i] = v0 * v0 + v1 * v1;
            }
            float a8[8], a4[4], a2[2];
#pragma unroll
            for (int e = 0; e < 8; ++e) { const float keep = b4 ? sq[e + 8] : sq[e], send = b4 ? sq[e] : sq[e + 8]; a8[e] = keep + swz_xor<16>(send); }
#pragma unroll
            for (int e = 0; e < 4; ++e) { const float keep = b3q ? a8[e + 4] : a8[e], send = b3q ? a8[e] : a8[e + 4]; a4[e] = keep + swz_xor<8>(send); }
#pragma unroll
            for (int e = 0; e < 2; ++e) { const float keep = b2 ? a4[e + 2] : a4[e], send = b2 ? a4[e] : a4[e + 2]; a2[e] = keep + swz_xor<4>(send); }
            float a1 = (b1q ? a2[1] : a2[0]) + swz_xor<2>(b1q ? a2[0] : a2[1]);
            a1 += swz_xor<1>(a1);
            const int rg = (b4 ? 8 : 0) + (b3q ? 4 : 0) + (b2 ? 2 : 0) + (b1q ? 1 : 0);
            if ((l31 & 1) == 0) part[(size_t)tile * 1024 + ch0 + 8 * (rg >> 2) + 4 * kg + (rg & 3)] = a1;
        }
    }
}

struct TokInfo { unsigned e0, e1, p0, p1; float g0, g1; unsigned s0, s1; };
DI void phase_norm1(const Frame& F, int li, int mode) {
    const int nrows = (mode == 2) ? NLAT : NTOK;
    const float* modp = WSP(float, WS_MOD) + (size_t)li * 3 * 6144;
    const float* modprev = WSP(float, WS_MOD) + (size_t)(mode == 2 ? 1 : li - 1) * 3 * 6144;
    const float* gam = (mode == 2) ? F.in[I_FG] : F.in[I_N1G] + (size_t)li * D;
    const TokInfo* tok = WSP(TokInfo, WS_TOK); const bf16_t* ys = WSP(bf16_t, WS_A1);
    bf16_t* hbf = WSP(bf16_t, WS_HBF);
    bf16_t* xbuf = WSP(bf16_t, WS_XB);
    auto ldx = [&](int r, int i) -> f32x4 {
        if (mode == 0) return *(const f32x4*)((r >= NLAT ? F.in[I_CTX] + (size_t)(r - NLAT) * D : F.in[I_X] + (size_t)r * D) + i * 256 + F.lane * 4);
        return ld_bf4(xbuf + (size_t)r * D + i * 256 + F.lane * 4); };
    const int r0 = F.bid * 8 + F.wave, rstep = F.G * 8, lc = F.lane * 4;
    f32x4 xn[4]; u32x2 yan[4], ybn[4]; TokInfo t1 = {}, t2 = {};
    if (r0 < nrows) {
#pragma unroll
        for (int i = 0; i < 4; ++i) xn[i] = ldx(r0, i);
        if (mode != 0) { t1 = tok[r0]; if (r0 + rstep < nrows) t2 = tok[r0 + rstep];
#pragma unroll
            for (int i = 0; i < 4; ++i) { yan[i] = *(const u32x2*)(ys + (size_t)t1.s0 * D + i * 256 + lc); ybn[i] = *(const u32x2*)(ys + (size_t)t1.s1 * D + i * 256 + lc); } }
    }
    for (int r = r0; r < nrows; r += rstep) {
        const bool isctx = r >= NLAT; const int v = isctx ? 2 : (r >> 14);
        f32x4 x[4]; u32x2 ya[4], yb[4]; const TokInfo ti = t1;
#pragma unroll
        for (int i = 0; i < 4; ++i) { x[i] = xn[i]; ya[i] = yan[i]; yb[i] = ybn[i]; }
        if (r + rstep < nrows) {
#pragma unroll
            for (int i = 0; i < 4; ++i) xn[i] = ldx(r + rstep, i);
            if (mode != 0) { t1 = t2; if (r + 2 * rstep < nrows) t2 = tok[r + 2 * rstep];
#pragma unroll
                for (int i = 0; i < 4; ++i) { yan[i] = *(const u32x2*)(ys + (size_t)t1.s0 * D + i * 256 + lc); ybn[i] = *(const u32x2*)(ys + (size_t)t1.s1 * D + i * 256 + lc); } }
        }
        if (mode != 0) {
            const float* g2 = modprev + (size_t)v * 6144 + 5 * 1024;
#pragma unroll
            for (int i = 0; i < 4; ++i) {
                const u32x2 a = ya[i], b = yb[i];
                const f32x4 gg = *(const f32x4*)(g2 + i * 256 + lc);
                f32x4 y;
                y[0] = ti.g0 * __uint_as_float(a[0] << 16) + ti.g1 * __uint_as_float(b[0] << 16);
                y[1] = ti.g0 * __uint_as_float(a[0] & 0xffff0000u) + ti.g1 * __uint_as_float(b[0] & 0xffff0000u);
                y[2] = ti.g0 * __uint_as_float(a[1] << 16) + ti.g1 * __uint_as_float(b[1] << 16);
                y[3] = ti.g0 * __uint_as_float(a[1] & 0xffff0000u) + ti.g1 * __uint_as_float(b[1] & 0xffff0000u);
                x[i] = x[i] + gg * y;
            }
            if (mode == 1) {
#pragma unroll
                for (int i = 0; i < 4; ++i) *(u32x2*)(xbuf + (size_t)r * D + i * 256 + lc) = (u32x2){pk2(x[i][0], x[i][1]), pk2(x[i][2], x[i][3])}; }
        }
        float ss = 0.f;
#pragma unroll
        for (int i = 0; i < 4; ++i) ss += x[i][0] * x[i][0] + x[i][1] * x[i][1] + x[i][2] * x[i][2] + x[i][3] * x[i][3];
        ss = wave_sum(ss);
        const float rstd = rsqrtf(ss * (1.f / D) + EPS);
#pragma unroll
        for (int i = 0; i < 4; ++i) {
            const int c = i * 256 + lc;
            const f32x4 g = *(const f32x4*)(gam + c);
            if (mode == 2) { *(f32x4*)(F.out + (size_t)r * D + c) = x[i] * rstd * g; }
            else {
                const f32x4 sh = *(const f32x4*)(modp + (size_t)v * 6144 + c), sc = *(const f32x4*)(modp + (size_t)v * 6144 + 1024 + c);
                const f32x4 h = x[i] * rstd * g * (sc + 1.f) + sh;
                *(u32x2*)(hbf + (size_t)r * D + c) = (u32x2){pk2(h[0], h[1]), pk2(h[2], h[3])};
            }
        }
    }
}

struct Route { int e0, e1; float g0, g1; };
DI Route route_select(const float (&lg)[16], const float* rb) {
    float mx = lg[0];
#pragma unroll
    for (int e = 1; e < 16; ++e) mx = fmaxf(mx, lg[e]);
    float sc[16], sel[16], den = 0.f;
#pragma unroll
    for (int e = 0; e < 16; ++e) { sc[e] = __expf(lg[e] - mx); den += sc[e]; }
    const float rden = 1.f / den;
#pragma unroll
    for (int e = 0; e < 16; ++e) { sc[e] *= rden; sel[e] = sc[e] + rb[e]; }
    int bg = 0; float bgs = -1e30f;
#pragma unroll
    for (int g = 0; g < 4; ++g) {
        float m1 = -1e30f, m2 = -1e30f;
#pragma unroll
        for (int q = 0; q < 4; ++q) { const float s = sel[g * 4 + q]; if (s > m1) { m2 = m1; m1 = s; } else if (s > m2) m2 = s; }
        const float gs = m1 + m2; if (gs > bgs) { bgs = gs; bg = g; }
    }
    int e0 = 0, e1 = 0; float s0v = -1e30f, s1v = -1e30f, w0 = 0.f, w1 = 0.f;
#pragma unroll
    for (int e = 0; e < 16; ++e) {
        const bool ing = (e >> 2) == bg; const float s = sel[e];
        if (ing && s > s0v) { s1v = s0v; e1 = e0; w1 = w0; s0v = s; e0 = e; w0 = sc[e]; }
        else if (ing && s > s1v) { s1v = s; e1 = e; w1 = sc[e]; }
    }
    const float ws = 1.f / (w0 + w1); Route R; R.e0 = e0; R.e1 = e1; R.g0 = w0 * ws; R.g1 = w1 * ws; return R;
}
DI void norm2_rows_valu(const Frame& F, int li, int r_first, int rstep, int r_end, const float* wt, unsigned* lcnt) {
    const float* modp = WSP(float, WS_MOD) + (size_t)li * 3 * 6144;
    const float* gam = F.in[I_N2G] + (size_t)li * D;
    bf16_t* hbf = WSP(bf16_t, WS_HBF); TokInfo* tok = WSP(TokInfo, WS_TOK);
    const bf16_t* xbuf = WSP(bf16_t, WS_XB);
    const bool b2 = (F.lane & 4) != 0, b3 = (F.lane & 8) != 0, b4 = (F.lane & 16) != 0;
    for (int r = r_first; r < r_end; r += rstep) {
        const bool isctx = r >= NLAT; const int v = isctx ? 2 : (r >> 14);
        f32x4 x[4]; float ss = 0.f;
#pragma unroll
        for (int i = 0; i < 4; ++i) { x[i] = ld_bf4(xbuf + (size_t)r * D + i * 256 + F.lane * 4); ss += x[i][0] * x[i][0] + x[i][1] * x[i][1] + x[i][2] * x[i][2] + x[i][3] * x[i][3]; }
        ss = wave_sum(ss);
        const float rstd = rsqrtf(ss * (1.f / D) + EPS);
        float lg[16];
#pragma unroll
        for (int e = 0; e < 16; ++e) lg[e] = 0.f;
#pragma unroll
        for (int i = 0; i < 4; ++i) {
            const int c = i * 256 + F.lane * 4;
            const f32x4 g = *(const f32x4*)(gam + c), sh = *(const f32x4*)(modp + (size_t)v * 6144 + 3 * 1024 + c), sc = *(const f32x4*)(modp + (size_t)v * 6144 + 4 * 1024 + c);
            const f32x4 h = x[i] * rstd * g * (sc + 1.f) + sh;
            *(u32x2*)(hbf + (size_t)r * D + c) = (u32x2){pk2(h[0], h[1]), pk2(h[2], h[3])};
#pragma unroll
            for (int e = 0; e < 16; ++e) { const f32x4 w = *(const f32x4*)(wt + e * 1024 + c); lg[e] += h[0] * w[0] + h[1] * w[1] + h[2] * w[2] + h[3] * w[3]; }
        }
        float a8[8], a4[4], a2[2];
#pragma unroll
        for (int e = 0; e < 8; ++e) { const auto rr = __builtin_amdgcn_permlane32_swap(__float_as_uint(lg[e]), __float_as_uint(lg[e + 8]), false, false); a8[e] = __uint_as_float(rr[0]) + __uint_as_float(rr[1]); }
#pragma unroll
        for (int e = 0; e < 4; ++e) { const float keep = b4 ? a8[e + 4] : a8[e], send = b4 ? a8[e] : a8[e + 4]; a4[e] = keep + swz_xor<16>(send); }
#pragma unroll
        for (int e = 0; e < 2; ++e) { const float keep = b3 ? a4[e + 2] : a4[e], send = b3 ? a4[e] : a4[e + 2]; a2[e] = keep + swz_xor<8>(send); }
        float a1 = (b2 ? a2[1] : a2[0]) + swz_xor<4>(b2 ? a2[0] : a2[1]);
        a1 += swz_xor<2>(a1); a1 += swz_xor<1>(a1);
#pragma unroll
        for (int e = 0; e < 16; ++e) lg[e] = __int_as_float(__builtin_amdgcn_readlane(__float_as_int(a1), 4 * e));
        const Route R = route_select(lg, F.in[I_RB]);
        if (F.lane == 0) {
            TokInfo ti; ti.e0 = R.e0; ti.e1 = R.e1; ti.p0 = atomicAdd(lcnt + R.e0, 1u); ti.p1 = atomicAdd(lcnt + R.e1, 1u);
            ti.g0 = R.g0; ti.g1 = R.g1; ti.s0 = 0; ti.s1 = 0;
            tok[r] = ti;
        }
    }
}
DI void phase_norm2(const Frame& F, int li, int nrows) {
    float* wp = (float*)F.lds;
    float* cvec = wp + 16384;
    float* cred = cvec + 16;
    float* lgs = cred + 512 + F.wave * (16 * 17);
    float* wt = cred + 512 + 8 * 16 * 17;
    unsigned* lcnt = (unsigned*)(F.lds + LDS_MISC + 64);
    const int v = F.bid & 1, nb2 = F.G >> 1;
    const float* modp = WSP(float, WS_MOD) + (size_t)li * 3 * 6144 + (size_t)v * 6144;
    const float* gam = F.in[I_N2G] + (size_t)li * D;
    for (int c = F.bid; c < SLOT_CAP / NTHR; c += F.G) WSP(int, WS_RMAP)[c * NTHR + F.tid] = 0;
    __syncthreads();
    for (int i = F.tid; i < 16384; i += NTHR) { const int k = i >> 4, e = i & 15; const float w = F.in[I_RW][i];
        wp[(((k >> 4) * 4 + ((k >> 2) & 3)) * 16 + e) * 4 + (k & 3)] = w * gam[k] * (modp[4 * 1024 + k] + 1.f);
        if (nrows > NLAT) wt[e * 1024 + k] = w; }
    { const int e = F.tid & 15, part = F.tid >> 4; float a = 0.f;
      for (int k = part * 32; k < part * 32 + 32; ++k) a += modp[3 * 1024 + k] * F.in[I_RW][k * 16 + e];
      cred[part * 16 + e] = a; }
    if (F.tid < 16) lcnt[F.tid] = 0u;
    __syncthreads();
    if (F.tid < 16) { float a = 0.f; for (int q = 0; q < 32; ++q) a += cred[q * 16 + F.tid]; cvec[F.tid] = a; }
    __syncthreads();
    bf16_t* hbf = WSP(bf16_t, WS_HBF); TokInfo* tok = WSP(TokInfo, WS_TOK);
    const int i16 = F.lane & 15, kq = F.lane >> 4;
    if (F.bid < 2 * nb2)
    for (int gl = (F.bid >> 1) * 8 + F.wave; gl < S / 16; gl += nb2 * 8) {
        const int row0 = v * S + gl * 16;
        const bf16_t* xr = WSP(bf16_t, WS_XB) + (size_t)(row0 + i16) * D + 4 * kq;
        const float* wl = wp + (kq * 16 + i16) * 4;
        f32x4 acc = (f32x4){0.f, 0.f, 0.f, 0.f}; float ss = 0.f;
        u32x2 xa[8], xb[8];
#pragma unroll
        for (int q = 0; q < 8; ++q) xa[q] = *(const u32x2*)(xr + 16 * q);
#define N2_BATCH(cur, nxt, s0) do { \
            if ((s0) + 8 < 64) { _Pragma("unroll") for (int q = 0; q < 8; ++q) nxt[q] = *(const u32x2*)(xr + 16 * ((s0) + 8 + q)); } \
            _Pragma("unroll") for (int q = 0; q < 8; ++q) { const f32x4 xv = bf4_to_f4(cur[q]), wv = *(const f32x4*)(wl + ((s0) + q) * 256); \
                ss += xv[0] * xv[0] + xv[1] * xv[1] + xv[2] * xv[2] + xv[3] * xv[3]; \
                _Pragma("unroll") for (int t = 0; t < 4; ++t) acc = __builtin_amdgcn_mfma_f32_16x16x4f32(xv[t], wv[t], acc, 0, 0, 0); } } while (0)
#pragma unroll 1
        for (int s0 = 0; s0 < 64; s0 += 16) { N2_BATCH(xa, xb, s0); N2_BATCH(xb, xa, s0 + 8); }
#undef N2_BATCH
        ss += swz_xor<16>(ss); ss = half_sum(ss);
        const float rstd = rsqrtf(ss * (1.f / D) + EPS);
#pragma unroll
        for (int r = 0; r < 4; ++r) lgs[(4 * kq + r) * 17 + i16] = acc[r];
        asm volatile("s_waitcnt lgkmcnt(0)" ::: "memory");
        float lg[16];
#pragma unroll
        for (int e = 0; e < 16; ++e) lg[e] = lgs[i16 * 17 + e] * rstd + cvec[e];
        asm volatile("s_waitcnt lgkmcnt(0)" ::: "memory");
        const Route R = route_select(lg, F.in[I_RB]);
        if (F.lane < 16) {
            TokInfo ti; ti.e0 = R.e0; ti.e1 = R.e1; ti.p0 = atomicAdd(lcnt + R.e0, 1u); ti.p1 = atomicAdd(lcnt + R.e1, 1u);
            ti.g0 = R.g0; ti.g1 = R.g1; ti.s0 = 0; ti.s1 = 0;
            tok[row0 + F.lane] = ti;
        }
        float rj[16];
#pragma unroll
        for (int j = 0; j < 16; ++j) rj[j] = __int_as_float(__builtin_amdgcn_readlane(__float_as_int(rstd), j));
#pragma unroll 1
        for (int i = 0; i < 4; ++i) {
            const int c = i * 256 + F.lane * 4;
            const f32x4 gs = *(const f32x4*)(gam + c) * (*(const f32x4*)(modp + 4 * 1024 + c) + 1.f), sh = *(const f32x4*)(modp + 3 * 1024 + c);
            u32x2 x[16];
#pragma unroll
            for (int j = 0; j < 16; ++j) x[j] = *(const u32x2*)(WSP(bf16_t, WS_XB) + (size_t)(row0 + j) * D + c);
#pragma unroll
            for (int j = 0; j < 16; ++j) { const f32x4 h = bf4_to_f4(x[j]) * rj[j] * gs + sh;
                *(u32x2*)(hbf + (size_t)(row0 + j) * D + c) = (u32x2){pk2(h[0], h[1]), pk2(h[2], h[3])}; }
        }
    }
    if (nrows > NLAT) norm2_rows_valu(F, li, NLAT + F.bid * 8 + F.wave, F.G * 8, nrows, wt, lcnt);
    __syncthreads();
    if (F.tid < 16) F.ctl[CW_BCNT + (li * MAXG + F.bid) * 16 + F.tid] = lcnt[F.tid];
}

DI void moe_offsets(const Frame& F, int li, int* offs) {
    __syncthreads();
    int* tot = offs + 376;
    int* part = (int*)F.lds;
    {
        const int e = F.tid & 15, pq = F.tid >> 4;
        const unsigned* bc = F.ctl + CW_BCNT + li * MAXG * 16 + e;
        int st = 0, sb = 0;
#pragma unroll
        for (int k = 0; k < 8; ++k) { const int blk = pq * 8 + k; const int c = (blk < F.G) ? (int)__hip_atomic_load(bc + blk * 16, __ATOMIC_RELAXED, __HIP_MEMORY_SCOPE_AGENT) : 0; st += c; sb += (blk < F.bid) ? c : 0; }
        part[pq * 16 + e] = st; part[512 + pq * 16 + e] = sb;
    }
    __syncthreads();
    if (F.tid < 32) { const int e = F.tid & 15, wb = F.tid >> 4; int s = 0;
        for (int pq = 0; pq < 32; ++pq) s += part[wb * 512 + pq * 16 + e];
        if (wb) offs[360 + e] = s; else tot[e] = s; }
    __syncthreads();
    if (F.tid == 0) { int o = 0; for (int e = 0; e < NE; ++e) { offs[e] = o; offs[17 + e] = o >> 8; o += (tot[e] + 255) & ~255; }
        offs[16] = o; offs[17 + 16] = o >> 8; }
    __syncthreads();
    for (int t = F.tid; t < SLOT_CAP / 256; t += NTHR) { int e = 0; for (int k = 1; k < NE; ++k) e += (offs[17 + k] <= t) ? 1 : 0; offs[40 + t] = e; }
    if (F.tid < 16) offs[360 + F.tid] += offs[F.tid];
    __syncthreads();
}
DI void phase_gather(const Frame& F, int li, int nrows) {
    int* offs = (int*)(F.lds + LDS_MISC + 64);
    moe_offsets(F, li, offs);
    TokInfo* tok = WSP(TokInfo, WS_TOK); int* rmap = WSP(int, WS_RMAP);
    auto place = [&](int r) {
        const TokInfo ti = tok[r];
        const unsigned s0 = offs[360 + ti.e0] + ti.p0, s1 = offs[360 + ti.e1] + ti.p1;
        rmap[s0] = r; rmap[s1] = r; tok[r].s0 = s0; tok[r].s1 = s1;
    };
    const int v = F.bid & 1, nb2 = F.G >> 1;
    if (F.bid < 2 * nb2)
        for (int gl = (F.bid >> 1) * 8 + F.wave; gl < S / 16; gl += nb2 * 8) if (F.lane < 16) place(v * S + gl * 16 + F.lane);
    if (nrows > NLAT) for (int r = NLAT + F.bid * 8 + F.wave; r < nrows; r += F.G * 8) if (F.lane == 0) place(r);
}

DI float lam_of(const Frame& F, int li, float& lam_init) {
    const float* lv = F.in[I_ALAM] + (size_t)li * 128;
    const int i = F.lane & 31, hi = F.lane >> 5;
    float d = lv[hi * 64 + i] * lv[hi * 64 + 32 + i];
    d += swz_xor<16>(d); d += swz_xor<8>(d); d += swz_xor<4>(d); d += swz_xor<2>(d); d += swz_xor<1>(d);
    const float d0 = __int_as_float(__builtin_amdgcn_readlane(__float_as_int(d), 0)), d1 = __int_as_float(__builtin_amdgcn_readlane(__float_as_int(d), 32));
    float lif = (float)li; asm volatile("" : "+v"(lif));
    lam_init = 0.8f - 0.6f * __expf(-0.3f * lif);
    return __expf(d0) - __expf(d1) + lam_init;
}
DI bf16x8 pack8(const f32x16& x, int s) {
    u32x4 p; p[0] = pk2(x[8 * s], x[8 * s + 1]); p[1] = pk2(x[8 * s + 2], x[8 * s + 3]); p[2] = pk2(x[8 * s + 4], x[8 * s + 5]); p[3] = pk2(x[8 * s + 6], x[8 * s + 7]);
    return __builtin_bit_cast(bf16x8, p);
}

DI void diffattn_unit(const Frame& F, int li, int b, int h, size_t qrow0, int NT2) {
    const int lane = F.lane, r = lane & 31, hh = lane >> 5, c = F.wave & 1, g = F.wave >> 1;
    const bf16_t* AQ = WSP(bf16_t, WS_AQ); const bf16_t* AK = WSP(bf16_t, WS_AK); const bf16_t* AVT = WSP(bf16_t, WS_AVT) + (size_t)(b * 4 + h) * 64 * NKEY;
    float lam_init; const float lam = lam_of(F, li, lam_init);
    const size_t qrowA = qrow0 + g * 64 + r;
    bf16x8 qfA[2], qfB[2]; float qnA = 0.f, qnB = 0.f;
#pragma unroll
    for (int ks = 0; ks < 2; ++ks) { qfA[ks] = *(const bf16x8*)(AQ + qrowA * 256 + h * 64 + c * 32 + ks * 16 + 8 * hh); qfB[ks] = *(const bf16x8*)(AQ + (qrowA + 32) * 256 + h * 64 + c * 32 + ks * 16 + 8 * hh);
#pragma unroll
        for (int j = 0; j < 8; ++j) { const float va = bf2f((bf16_t)qfA[ks][j]), vb_ = bf2f((bf16_t)qfB[ks][j]); qnA += va * va; qnB += vb_ * vb_; } }
    f32x16 cinit;
    { const float qm = wave_max(fmaxf(half_sum(qnA), half_sum(qnB)));
      const float km = sqrtf(__uint_as_float(__hip_atomic_load(F.ctl + CW_KMAX + li * 16 + (b * 4 + h) * 2 + c, __ATOMIC_RELAXED, __HIP_MEMORY_SCOPE_AGENT)));
      const float cn = -(sqrtf(qm) * km * 1.02f + 1e-3f);
#pragma unroll
      for (int i = 0; i < 16; ++i) cinit[i] = cn; }
    f32x16 OA[2], OB[2]; f32x8 laccA, laccB;
#pragma unroll
    for (int i = 0; i < 16; ++i) { OA[0][i] = 0.f; OA[1][i] = 0.f; OB[0][i] = 0.f; OB[1][i] = 0.f; }
#pragma unroll
    for (int i = 0; i < 8; ++i) { laccA[i] = 0.f; laccB[i] = 0.f; }
    constexpr int KTB = 2 * 128 * 64, VTB = 64 * 256, STG = KTB + VTB;
    LAS unsigned char* Ll = (LAS unsigned char*)F.lds;
    unsigned char* L = F.lds;
    unsigned kgo[2], vgo[2];
#pragma unroll
    for (int i = 0; i < 2; ++i) { const int q = F.wave * 2 + i;
        const int key = (q & 7) * 16 + (lane >> 2), chunk = (lane & 3) ^ ((key >> 2) & 3);
        kgo[i] = (unsigned)key * 512u + (unsigned)(h * 64 + (q >> 3) * 32) * 2u + (unsigned)chunk * 16u;
        const int d = q * 4 + (lane >> 4), vch = (lane & 15) ^ (d & 15);
        vgo[i] = (unsigned)d * (unsigned)(NKEY * 2) + (unsigned)vch * 16u; }
    const unsigned ldsw = (unsigned)F.wave * 2048u;
#define DA_ISSUE(kt_, stg_) do { const int j0_ = (kt_) * 128; \
        const char* kg_ = (const char*)AK + (j0_ < CTX ? (size_t)NLAT + b * CTX + j0_ : (size_t)b * S + (j0_ - CTX)) * 512; const char* vg_ = (const char*)AVT + (size_t)j0_ * 2; \
        _Pragma("unroll") for (int i_ = 0; i_ < 2; ++i_) { \
            __builtin_amdgcn_global_load_lds((const unsigned*)(kg_ + kgo[i_]), (LAS unsigned*)(Ll + (stg_) * STG + ldsw + i_ * 1024), 16, 0, 0); \
            __builtin_amdgcn_global_load_lds((const unsigned*)(vg_ + vgo[i_]), (LAS unsigned*)(Ll + (stg_) * STG + KTB + ldsw + i_ * 1024), 16, 0, 0); } } while (0)
    __syncthreads();
    DA_ISSUE(0, 0);
    if (NT2 > 1) { DA_ISSUE(1, 1); asm volatile("s_waitcnt vmcnt(4)" ::: "memory"); } else asm volatile("s_waitcnt vmcnt(0)" ::: "memory");
    __builtin_amdgcn_s_barrier();
    const int ksw = (r >> 2) & 3;
    const int kr0 = c * 8192 + r * 64 + (((0 + hh) ^ ksw) * 16), kr1 = c * 8192 + r * 64 + (((2 + hh) ^ ksw) * 16);
    const int vlo0 = r * 256 + (((0 + hh) ^ (r & 3)) * 16), vlo1 = r * 256 + (((2 + hh) ^ (r & 3)) * 16), vrq = (r >> 2) & 3;
#define DA_LDK(st) do { k0 = *(const bf16x8*)(kb + (st) * 2048 + kr0); k1 = *(const bf16x8*)(kb + (st) * 2048 + kr1); } while (0)
#define DA_QK(Sx, qf) do { Sx = MFMA32(k0, qf[0], cinit); Sx = MFMA32(k1, qf[1], Sx); } while (0)
#define DA_LDV(st) do { const int vh_ = (((st) ^ vrq) & 3) * 64; _Pragma("unroll") for (int dh = 0; dh < 2; ++dh) { \
            vf[dh][0] = *(const bf16x8*)(vb + dh * (32 * 256) + vh_ + vlo0); vf[dh][1] = *(const bf16x8*)(vb + dh * (32 * 256) + vh_ + vlo1); } } while (0)
#define DA_PV(Sx, Ox, lx) do { \
        _Pragma("unroll") for (int i = 0; i < 16; ++i) Sx[i] = __builtin_amdgcn_exp2f(Sx[i]); \
        lx += __builtin_shufflevector(Sx, Sx, 0, 1, 2, 3, 4, 5, 6, 7) + __builtin_shufflevector(Sx, Sx, 8, 9, 10, 11, 12, 13, 14, 15); \
        const bf16x8 p0 = pack8(Sx, 0), p1 = pack8(Sx, 1); \
        Ox[0] = MFMA32(vf[0][0], p0, Ox[0]); Ox[1] = MFMA32(vf[1][0], p0, Ox[1]); \
        Ox[0] = MFMA32(vf[0][1], p1, Ox[0]); Ox[1] = MFMA32(vf[1][1], p1, Ox[1]); } while (0)
    if (F.wave >= 4) __builtin_amdgcn_s_setprio(1);
    int stg = 0;
#pragma unroll 1
    for (int kt = 0; kt < NT2; ++kt) {
        const bool more2 = kt + 2 < NT2;
        if (more2) { const int s2_ = stg >= 1 ? stg - 1 : 2; DA_ISSUE(kt + 2, s2_); }
        const unsigned char* kb = L + stg * STG; const unsigned char* vb = L + stg * STG + KTB;
        f32x16 SA, SB; bf16x8 k0, k1, vf[2][2];
        DA_LDK(0); DA_QK(SA, qfA);
#pragma unroll 1
        for (int st = 0; st < 4; ++st) {
            DA_QK(SB, qfB);
            DA_LDV(st);
            DA_PV(SA, OA, laccA);
            if (st < 3) { DA_LDK(st + 1); DA_QK(SA, qfA); }
            DA_PV(SB, OB, laccB);
        }
        if (more2) asm volatile("s_waitcnt vmcnt(4)" ::: "memory"); else asm volatile("s_waitcnt vmcnt(0)" ::: "memory");
        asm volatile("s_waitcnt lgkmcnt(0)" ::: "memory");
        __builtin_amdgcn_s_barrier();
        stg = stg == 2 ? 0 : stg + 1;
    }
#undef DA_ISSUE
#undef DA_LDK
#undef DA_QK
#undef DA_LDV
#undef DA_PV
    __builtin_amdgcn_s_setprio(0);
    float lsA = 0.f, lsB = 0.f;
#pragma unroll
    for (int i = 0; i < 8; ++i) { lsA += laccA[i]; lsB += laccB[i]; }
    const float rlA = 1.f / half_sum(lsA), rlB = 1.f / half_sum(lsB);
    float* xb = (float*)L + (size_t)g * 2 * 32 * 64;
    if (c == 1) {
#pragma unroll
        for (int dh = 0; dh < 2; ++dh)
#pragma unroll
            for (int i = 0; i < 16; ++i) { xb[(dh * 16 + i) * 64 + lane] = OA[dh][i] * (rlA * lam); xb[2048 + (dh * 16 + i) * 64 + lane] = OB[dh][i] * (rlB * lam); }
    }
    __syncthreads();
    if (c == 0) {
        const float* sg = F.in[I_ASUB] + li * 64;
#pragma unroll
        for (int ab = 0; ab < 2; ++ab) {
            float o[2][16]; float ss = 0.f; const float rl = ab ? rlB : rlA;
#pragma unroll
            for (int dh = 0; dh < 2; ++dh)
#pragma unroll
                for (int i = 0; i < 16; ++i) { o[dh][i] = (ab ? OB[dh][i] : OA[dh][i]) * rl - xb[ab * 2048 + (dh * 16 + i) * 64 + lane]; ss += o[dh][i] * o[dh][i]; }
            ss = half_sum(ss);
            const float rs = rsqrtf(ss * (1.f / 64.f) + EPS) * (1.f - lam_init);
            bf16_t* mix = WSP(bf16_t, WS_HBF) + (qrowA + ab * 32) * D + h * 64;
#pragma unroll
            for (int dh = 0; dh < 2; ++dh)
#pragma unroll
                for (int gq = 0; gq < 4; ++gq) {
                    const int d = 32 * dh + 8 * gq + 4 * hh;
                    const f32x4 gg = *(const f32x4*)(sg + d);
                    *(u32x2*)(mix + d) = (u32x2){pk2(o[dh][4 * gq] * rs * gg[0], o[dh][4 * gq + 1] * rs * gg[1]), pk2(o[dh][4 * gq + 2] * rs * gg[2], o[dh][4 * gq + 3] * rs * gg[3])};
                }
        }
    }
}

DI void na_mfma_unit(const Frame& F, int li, int b, size_t qrow0, int grow) {
    const int lane = F.lane, r31 = lane & 31, hh = lane >> 5, h = F.wave >> 1, qh = F.wave & 1;
    const bf16_t* BQ = WSP(bf16_t, WS_BQ); const bf16_t* BK = WSP(bf16_t, WS_BK); const bf16_t* BVT = WSP(bf16_t, WS_BVT);
    constexpr int KB = 4 * 8192, VB = 4 * 9216, STG = KB + VB;
    unsigned char* L = F.lds;
    float* tab = (float*)(F.lds + 2 * STG);
    const int nwin = grow >= 0 ? 8 : 0, nt = nwin + 4;
    int r0 = grow - 4; r0 = r0 < 0 ? 0 : (r0 > 248 ? 248 : r0);
    __syncthreads();
    if (nwin) for (int i = F.tid; i < 4 * 15 * 32; i += NTHR) { const int c31 = i & 31, hr = i >> 5; tab[i] = (c31 < 31) ? F.in[I_RPB][(size_t)li * 4 * 465 + hr * 31 + c31] * LOG2E : -1e30f; }
    const int skey = F.tid >> 3, sc64 = F.tid & 7, sh = sc64 >> 1;
    const int vrow = F.tid >> 1, vhalf = F.tid & 1;
    auto kbase = [&](int ti) -> const bf16_t* { return ti < nwin ? BK + ((size_t)b * S + (size_t)(r0 + ti) * GW) * 256 : BK + ((size_t)NLAT + b * CTX + (ti - nwin) * 64) * 256; };
    auto vkey0 = [&](int ti) -> int { return ti < nwin ? CTX + (r0 + ti) * GW : (ti - nwin) * 64; };
    u32x4 kreg[4], vreg[4];
    { const bf16_t* kp = kbase(0) + (size_t)skey * 256 + sc64 * 32; const bf16_t* vp = BVT + ((size_t)b * 256 + vrow) * NKEY + vkey0(0) + vhalf * 32;
#pragma unroll
      for (int i = 0; i < 4; ++i) { kreg[i] = *(const u32x4*)(kp + i * 8); vreg[i] = *(const u32x4*)(vp + i * 8); } }
    const size_t qrow = qrow0 + 32 * qh + r31;
    bf16x8 qf[4]; float qn2 = 0.f;
#pragma unroll
    for (int ks = 0; ks < 4; ++ks) { qf[ks] = *(const bf16x8*)(BQ + qrow * 256 + h * 64 + ks * 16 + 8 * hh);
#pragma unroll
        for (int j = 0; j < 8; ++j) { const float v = bf2f((bf16_t)qf[ks][j]); qn2 += v * v; } }
    qn2 = half_sum(qn2);
    __syncthreads();
    float bmax = 0.f;
    if (nwin) { for (int i = lane; i < 480; i += 64) bmax = fmaxf(bmax, tab[h * 480 + i]); bmax = wave_max(bmax); }
    const unsigned* kmx = F.ctl + CW_KMAXB + li * 16 + (b * 4 + h) * 2;
    const float km = sqrtf(__uint_as_float(__hip_atomic_load(kmx, __ATOMIC_RELAXED, __HIP_MEMORY_SCOPE_AGENT)) + __uint_as_float(__hip_atomic_load(kmx + 1, __ATOMIC_RELAXED, __HIP_MEMORY_SCOPE_AGENT)));
    const float cneg = -(sqrtf(qn2) * km * 1.02f + bmax + 1e-3f);
    const int cq = 32 * qh + r31; int c0q = cq - 8; c0q = c0q < 0 ? 0 : (c0q > 48 ? 48 : c0q);
    const int qrow_g = grow;
    f32x16 O[2];
#pragma unroll
    for (int dh = 0; dh < 2; ++dh)
#pragma unroll
        for (int i = 0; i < 16; ++i) O[dh][i] = 0.f;
    f32x16 lacc;
#pragma unroll
    for (int i = 0; i < 16; ++i) lacc[i] = 0.f;
    int tcol[2][16];
#pragma unroll
    for (int st = 0; st < 2; ++st)
#pragma unroll
        for (int i = 0; i < 16; ++i) { const int kc = 32 * st + (i & 3) + 8 * (i >> 2) + 4 * hh; tcol[st][i] = ((kc >= c0q) && (kc < c0q + 16)) ? (kc - cq + 15) : 31; }
    const int kdst = sh * 8192 + skey * 128, ksw = (skey >> 1) & 7, kch0 = (sc64 & 1) * 4;
    const int vdst = KB + (vrow >> 6) * 9216 + (vrow & 63) * 144 + vhalf * 64;
#pragma unroll
    for (int i = 0; i < 4; ++i) *(u32x4*)(L + kdst + (((kch0 + i) ^ ksw) * 16)) = kreg[i];
#pragma unroll
    for (int i = 0; i < 4; ++i) *(u32x4*)(L + vdst + i * 16) = vreg[i];
    __syncthreads();
#pragma unroll 1
    for (int ti = 0; ti < nt; ++ti) {
        const int buf = ti & 1;
        if (ti + 1 < nt) { const bf16_t* kp = kbase(ti + 1) + (size_t)skey * 256 + sc64 * 32; const bf16_t* vp = BVT + ((size_t)b * 256 + vrow) * NKEY + vkey0(ti + 1) + vhalf * 32;
#pragma unroll
            for (int i = 0; i < 4; ++i) { kreg[i] = *(const u32x4*)(kp + i * 8); vreg[i] = *(const u32x4*)(vp + i * 8); } }
        const unsigned char* kb = L + buf * STG + h * 8192; const unsigned char* vb = L + buf * STG + KB + h * 9216;
        const bool win = ti < nwin;
        const float* trow = tab + (h * 15 + (win ? (r0 + ti - qrow_g + 7) : 0)) * 32;
#pragma unroll
        for (int st = 0; st < 2; ++st) {
            const int key = 32 * st + r31, sw = (key >> 1) & 7;
            f32x16 s;
            if (win) {
#pragma unroll
                for (int i = 0; i < 16; ++i) s[i] = trow[tcol[st][i]] + cneg;
            } else {
#pragma unroll
                for (int i = 0; i < 16; ++i) s[i] = cneg;
            }
#pragma unroll
            for (int ks = 0; ks < 4; ++ks) { const bf16x8 kf = *(const bf16x8*)(kb + key * 128 + (((ks * 2 + hh) ^ sw) * 16)); s = MFMA32(kf, qf[ks], s); }
#pragma unroll
            for (int i = 0; i < 16; ++i) s[i] = __builtin_amdgcn_exp2f(s[i]);
            lacc += s;
            const bf16x8 p0 = pack8(s, 0), p1 = pack8(s, 1);
#pragma unroll
            for (int dh = 0; dh < 2; ++dh) {
                const unsigned char* vp = vb + (32 * dh + r31) * 144 + st * 64 + hh * 16;
                O[dh] = MFMA32(*(const bf16x8*)vp, p0, O[dh]);
                O[dh] = MFMA32(*(const bf16x8*)(vp + 32), p1, O[dh]);
            }
        }
        if (ti + 1 < nt) { unsigned char* W = L + (buf ^ 1) * STG;
#pragma unroll
            for (int i = 0; i < 4; ++i) *(u32x4*)(W + kdst + (((kch0 + i) ^ ksw) * 16)) = kreg[i];
#pragma unroll
            for (int i = 0; i < 4; ++i) *(u32x4*)(W + vdst + i * 16) = vreg[i]; }
        __syncthreads();
    }
    float lsum = 0.f;
#pragma unroll
    for (int i = 0; i < 16; ++i) lsum += lacc[i];
    const float rl = 1.f / half_sum(lsum);
    bf16_t* mix = WSP(bf16_t, WS_HBF) + qrow * D + 256 + h * 64;
#pragma unroll
    for (int dh = 0; dh < 2; ++dh)
#pragma unroll
        for (int g = 0; g < 4; ++g) { const int d = 32 * dh + 8 * g + 4 * hh;
            *(u32x2*)(mix + d) = (u32x2){pk2(O[dh][4 * g] * rl, O[dh][4 * g + 1] * rl), pk2(O[dh][4 * g + 2] * rl, O[dh][4 * g + 3] * rl)}; }
}

DI void pool_unit(const Frame& F, int li, size_t seq_row0, int L, int t0) {
    unsigned* us = (unsigned*)F.lds;
    unsigned char* dfb = F.lds + 80 * 512;
    const bf16_t* PL = WSP(bf16_t, WS_PL);
    __syncthreads();
    for (int i = F.tid; i < 80 * 32; i += NTHR) {
        const int tt = i >> 5, c8 = i & 31, t = t0 - 8 + tt;
        u32x4 x = (u32x4){0u, 0u, 0u, 0u};
        if (t >= 0 && t < L) x = *(const u32x4*)(PL + (seq_row0 + t) * 256 + c8 * 8);
        *(u32x4*)(us + tt * 128 + c8 * 4) = x;
    }
    __syncthreads();
    {
        const int cp = F.tid & 127, tl0 = (F.tid >> 7) * 16, hw = 1 << (cp >> 5);
        float s0 = 0.f, s1 = 0.f;
        for (int k = -hw; k < hw; ++k) { const unsigned w = us[(tl0 + 8 + k) * 128 + cp]; s0 += __uint_as_float(w << 16); s1 += __uint_as_float(w & 0xffff0000u); }
#pragma unroll 4
        for (int j = 0; j < 16; ++j) {
            const int tl = tl0 + j, t = t0 + tl;
            const int lo = t - hw < 0 ? 0 : t - hw, hi = t + hw > L ? L : t + hw;
            const float rc = __builtin_amdgcn_rcpf((float)(hi - lo));
            const unsigned c = us[(tl + 8) * 128 + cp];
            *(unsigned*)(dfb + tl * 528 + cp * 4) = pk2(s0 * rc - __uint_as_float(c << 16), s1 * rc - __uint_as_float(c & 0xffff0000u));
            const unsigned a = us[(tl + 8 + hw) * 128 + cp], b = us[(tl + 8 - hw) * 128 + cp];
            s0 += __uint_as_float(a << 16) - __uint_as_float(b << 16); s1 += __uint_as_float(a & 0xffff0000u) - __uint_as_float(b & 0xffff0000u);
        }
    }
    __syncthreads();
    {
        const int g = F.wave & 3, tq = F.wave >> 2, fr = F.lane & 15, fq = F.lane >> 4;
        const bf16_t* wt = WSP(bf16_t, WS_PWT) + ((size_t)li * 4 + g) * 4096;
        bf16x8 Af[4][2];
#pragma unroll
        for (int jb = 0; jb < 4; ++jb)
#pragma unroll
            for (int ks = 0; ks < 2; ++ks) Af[jb][ks] = *(const bf16x8*)(wt + (jb * 16 + fr) * 64 + ks * 32 + fq * 8);
        const float* ps = F.in[I_POOLS] + li * 256 + g * 64;
        bf16_t* mix = WSP(bf16_t, WS_HBF);
#pragma unroll
        for (int tb = 0; tb < 2; ++tb) {
            const int tl = (tq * 2 + tb) * 16 + fr;
            const bf16x8 B0 = *(const bf16x8*)(dfb + tl * 528 + (g * 64 + fq * 8) * 2), B1 = *(const bf16x8*)(dfb + tl * 528 + (g * 64 + 32 + fq * 8) * 2);
#pragma unroll
            for (int jb = 0; jb < 4; ++jb) {
                f32x4 acc = (f32x4){0.f, 0.f, 0.f, 0.f};
                acc = __builtin_amdgcn_mfma_f32_16x16x32_bf16(Af[jb][0], B0, acc, 0, 0, 0);
                acc = __builtin_amdgcn_mfma_f32_16x16x32_bf16(Af[jb][1], B1, acc, 0, 0, 0);
                const f32x4 sc = *(const f32x4*)(ps + jb * 16 + 4 * fq);
                *(u32x2*)(mix + (seq_row0 + t0 + tl) * D + 512 + g * 64 + jb * 16 + 4 * fq) = (u32x2){pk2(acc[0] * sc[0], acc[1] * sc[1]), pk2(acc[2] * sc[2], acc[3] * sc[3])};
            }
        }
    }
}

DI float hy_norm(const float* part, int ntile, int o, int ch) {
    float s = 0.f;
    for (int t = 0; t < ntile; ++t) s += part[(size_t)t * 1024 + (o * 2) * 256 + ch] + part[(size_t)t * 1024 + (o * 2 + 1) * 256 + ch];
    return rsqrtf(s + EPS);
}
DI float hy_short(const bf16_t* p, int t, int L, float w0, float w1, float w2, float bb) {
    const int tm = t > 0 ? t - 1 : 0, tp = t + 1 < L ? t + 1 : L - 1;
    float a = bf2f(p[tm]), c = bf2f(p[tp]); const float m = bf2f(p[t]);
    a = t > 0 ? a : 0.f; c = t + 1 < L ? c : 0.f;
    return a * w0 + m * w1 + c * w2 + bb;
}
constexpr int FM = 16384;
DI int fphys(int i) { return i + (i >> 4) + ((i >> 9) << 4); }
constexpr int brev(int m, int bits) { return bits == 5 ? (((m & 1) << 4) | ((m & 2) << 2) | (m & 4) | ((m & 8) >> 2) | ((m & 16) >> 4)) : (((m & 1) << 3) | ((m & 2) << 1) | ((m & 4) >> 1) | ((m & 8) >> 3)); }
DI f32x2 cmul(f32x2 x, float c, float sn) {
    const f32x2 xs = __builtin_shufflevector(x, x, 1, 0);
    return x * (f32x2){c, c} + xs * (f32x2){-sn, sn};
}
template <int R, int LOG2R, bool INV> DI void dft_regs(f32x2 (&x)[R]) {
    constexpr float C32[16] = {1.f, 0.98078528040323043f, 0.92387953251128674f, 0.83146961230254524f, 0.70710678118654752f, 0.55557023301960218f, 0.38268343236508977f, 0.19509032201612825f,
                               0.f, -0.19509032201612825f, -0.38268343236508977f, -0.55557023301960218f, -0.70710678118654752f, -0.83146961230254524f, -0.92387953251128674f, -0.98078528040323043f};
    constexpr float S32[16] = {0.f, 0.19509032201612825f, 0.38268343236508977f, 0.55557023301960218f, 0.70710678118654752f, 0.83146961230254524f, 0.92387953251128674f, 0.98078528040323043f,
                               1.f, 0.98078528040323043f, 0.92387953251128674f, 0.83146961230254524f, 0.70710678118654752f, 0.55557023301960218f, 0.38268343236508977f, 0.19509032201612825f};
#pragma unroll
    for (int st = 0; st < LOG2R; ++st) {
        const int h = R >> (st + 1);
        f32x2 d[R / 2], t[R / 2];
#pragma unroll
        for (int b = 0; b < R / 2; ++b) { const int i = (b / h) * 2 * h, j = b % h; const f32x2 a = x[i + j], c = x[i + j + h]; x[i + j] = a + c; d[b] = a - c; }
#pragma unroll
        for (int b = 0; b < R / 2; ++b) { const int j = b % h, k = j * (16 / h); if (k != 0 && k != 8) t[b] = d[b] * (f32x2){C32[k], C32[k]}; }
#pragma unroll
        for (int b = 0; b < R / 2; ++b) { const int i = (b / h) * 2 * h, j = b % h, k = j * (16 / h);
            if (k == 0) x[i + j + h] = d[b];
            else if (k == 8) x[i + j + h] = INV ? (f32x2){-d[b][1], d[b][0]} : (f32x2){d[b][1], -d[b][0]};
            else { const float sn = INV ? S32[k] : -S32[k]; x[i + j + h] = __builtin_shufflevector(d[b], d[b], 1, 0) * (f32x2){-sn, sn} + t[b]; } }
    }
}
template <bool INV, int SP> DI void fft_pass32(f32x2* X, int bp, int rem, float inv_bs) {
    asm volatile("" : "+v"(bp), "+v"(rem));
    f32x2* P = X + bp;
    const float revb = (float)rem * inv_bs;
    f32x2 x[32], cs[16], t[16];
    if (!INV) {
#pragma unroll
        for (int q = 0; q < 32; ++q) x[q] = P[q * SP];
        dft_regs<32, 5, false>(x);
        P[0] = x[0];
#pragma unroll
        for (int hb = 0; hb < 32; hb += 16) {
#pragma unroll
            for (int m = hb ? hb : 1; m < hb + 16; ++m) { const float rev = revb * (float)brev(m, 5); cs[m & 15] = (f32x2){__builtin_amdgcn_cosf(rev), -__builtin_amdgcn_sinf(rev)}; }
#pragma unroll
            for (int m = hb ? hb : 1; m < hb + 16; ++m) t[m & 15] = x[m] * (f32x2){cs[m & 15][0], cs[m & 15][0]};
#pragma unroll
            for (int m = hb ? hb : 1; m < hb + 16; ++m) P[brev(m, 5) * SP] = __builtin_shufflevector(x[m], x[m], 1, 0) * (f32x2){-cs[m & 15][1], cs[m & 15][1]} + t[m & 15];
        }
    } else {
#pragma unroll
        for (int qp = 0; qp < 32; ++qp) x[qp] = P[qp * SP];
#pragma unroll
        for (int hb = 0; hb < 32; hb += 16) {
#pragma unroll
            for (int qp = hb ? hb : 1; qp < hb + 16; ++qp) { const float rev = revb * (float)qp; cs[qp & 15] = (f32x2){__builtin_amdgcn_cosf(rev), __builtin_amdgcn_sinf(rev)}; }
#pragma unroll
            for (int qp = hb ? hb : 1; qp < hb + 16; ++qp) t[qp & 15] = x[qp] * (f32x2){cs[qp & 15][0], cs[qp & 15][0]};
#pragma unroll
            for (int qp = hb ? hb : 1; qp < hb + 16; ++qp) x[qp] = __builtin_shufflevector(x[qp], x[qp], 1, 0) * (f32x2){-cs[qp & 15][1], cs[qp & 15][1]} + t[qp & 15];
        }
        dft_regs<32, 5, true>(x);
#pragma unroll
        for (int m = 0; m < 32; ++m) P[brev(m, 5) * SP] = x[m];
    }
}
DI void fft_fwd12(f32x2* X, int tid) {
    __syncthreads(); fft_pass32<false, 560>(X, fphys(tid), tid, 1.f / 16384.f);
    __syncthreads(); fft_pass32<false, 17>(X, (tid >> 4) * 560 + (tid & 15), tid & 15, 1.f / 512.f);
    __syncthreads();
}
DI void fft_inv21(f32x2* X, int tid) {
    __syncthreads(); fft_pass32<true, 17>(X, (tid >> 4) * 560 + (tid & 15), tid & 15, 1.f / 512.f);
    __syncthreads(); fft_pass32<true, 560>(X, fphys(tid), tid, 1.f / 16384.f);
    __syncthreads();
}
DI void hyena_fft_unit(const Frame& F, int li, int ch) {
    f32x2* X = (f32x2*)F.lds;
    const bf16_t* HYT = WSP(bf16_t, WS_HYT); const _Float16* filt = WSP(_Float16, WS_FILT);
    f32x2* Ye = WSP(f32x2, WS_ZBUF) + (size_t)ch * FM; f32x2* Z1 = WSP(f32x2, WS_Z1BUF) + (size_t)ch * FM;
    const float* sw = F.in[I_HYSW] + (size_t)li * 3 * 768; const float* sb = F.in[I_HYSB] + li * 768; const float* sk = F.in[I_HSKIP] + li * 512;
    const int tid = F.tid;
    const bf16_t* px1[2] = {HYT + ((size_t)0 * 768 + ch) * S, HYT + ((size_t)1 * 768 + ch) * S};
    const bf16_t* px2[2] = {HYT + ((size_t)0 * 768 + 256 + ch) * S, HYT + ((size_t)1 * 768 + 256 + ch) * S};
    const bf16_t* pv[2] = {HYT + ((size_t)0 * 768 + 512 + ch) * S, HYT + ((size_t)1 * 768 + 512 + ch) * S};
    const float wx1[4] = {sw[ch], sw[768 + ch], sw[1536 + ch], sb[ch]};
    const float wx2[4] = {sw[256 + ch], sw[768 + 256 + ch], sw[1536 + 256 + ch], sb[256 + ch]};
    const float wv[4] = {sw[512 + ch], sw[768 + 512 + ch], sw[1536 + 512 + ch], sb[512 + ch]};
#pragma unroll 1
    for (int cv = 0; cv < 2; ++cv) {
        const _Float16* hf = filt + ((size_t)(2 * cv) * 256 + ch) * S; const _Float16* hb = filt + ((size_t)(2 * cv + 1) * 256 + ch) * S;
        float fnrm;
        { int tn = tid; asm volatile("" : "+v"(tn));
          const float pv = WSP(float, WS_FPART)[(size_t)(tn & 255) * 1024 + (cv * 2 + (tn >> 8)) * 256 + ch];
          const float ws = wave_sum(pv);
          float* red = (float*)(F.lds + LDS_MISC + 128);
          __syncthreads();
          if (F.lane == 0) red[F.wave] = ws;
          __syncthreads();
          fnrm = rsqrtf(red[0] + red[1] + red[2] + red[3] + red[4] + red[5] + red[6] + red[7] + EPS); }
        const float nrm = 1.f / 32768.f;
        const float skip = sk[cv * 256 + ch];
#pragma unroll 1
        for (int half = 0; half < 2; ++half) {
            __syncthreads();
            int pb = fphys(tid); int tq = tid; asm volatile("" : "+v"(pb), "+v"(tq));
            if (half == 0) {
#pragma unroll 8
                for (int j = 0; j < 32; ++j) { const int n = tq + 512 * j; const float a = (float)hf[n] * fnrm; float bq = (float)hb[FM - n] * fnrm; bq = n ? bq : 0.f;
                    X[pb + 560 * j] = (f32x2){a + bq, 0.f}; }
            } else {
#pragma unroll 8
                for (int j = 0; j < 32; ++j) { const int n = tq + 512 * j; const float a = (float)hf[n] * fnrm; float bq = (float)hb[FM - n] * fnrm; bq = n ? bq : 0.f;
                    const float d = a - bq, rev = (float)n * (1.f / 32768.f);
                    X[pb + 560 * j] = (f32x2){d * __builtin_amdgcn_cosf(rev), -d * __builtin_amdgcn_sinf(rev)}; }
            }
            fft_fwd12(X, tid);
            h16x2 kpk[2][16];
#pragma unroll
            for (int g = 0; g < 2; ++g) { int b16 = fphys((tid + 512 * g) * 16); asm volatile("" : "+v"(b16));
                f32x2 kx[16];
#pragma unroll
                for (int q = 0; q < 16; ++q) kx[q] = X[b16 + q];
                dft_regs<16, 4, false>(kx);
#pragma unroll
                for (int q = 0; q < 16; ++q) kpk[g][q] = (h16x2){(_Float16)kx[q][0], (_Float16)kx[q][1]}; }
            __syncthreads();
            asm volatile("" : "+v"(pb), "+v"(tq));
#define HY_MOD(v, n) do { const float rev = (float)(n) * (1.f / 32768.f); v = cmul(v, __builtin_amdgcn_cosf(rev), -__builtin_amdgcn_sinf(rev)); } while (0)
            if (cv == 0) {
                if (half == 0) {
#pragma unroll 4
                    for (int j = 0; j < 32; ++j) { const int n = tq + 512 * j; X[pb + 560 * j] = (f32x2){hy_short(pv[0], n, S, wv[0], wv[1], wv[2], wv[3]), hy_short(pv[1], n, S, wv[0], wv[1], wv[2], wv[3])}; }
                } else {
#pragma unroll 4
                    for (int j = 0; j < 32; ++j) { const int n = tq + 512 * j; f32x2 v = (f32x2){hy_short(pv[0], n, S, wv[0], wv[1], wv[2], wv[3]), hy_short(pv[1], n, S, wv[0], wv[1], wv[2], wv[3])}; HY_MOD(v, n); X[pb + 560 * j] = v; }
                }
            } else {
                if (half == 0) {
#pragma unroll 8
                    for (int j = 0; j < 32; ++j) { const int n = tq + 512 * j; X[pb + 560 * j] = Z1[n]; }
                } else {
#pragma unroll 8
                    for (int j = 0; j < 32; ++j) { const int n = tq + 512 * j; f32x2 v = Z1[n]; HY_MOD(v, n); X[pb + 560 * j] = v; }
                }
            }
#undef HY_MOD
            fft_fwd12(X, tid);
#pragma unroll
            for (int g = 0; g < 2; ++g) { int b16 = fphys((tid + 512 * g) * 16); asm volatile("" : "+v"(b16));
                f32x2 dx[16], bx[16];
#pragma unroll
                for (int q = 0; q < 16; ++q) dx[q] = X[b16 + q];
                dft_regs<16, 4, false>(dx);
#pragma unroll
                for (int m = 0; m < 16; ++m) bx[brev(m, 4)] = cmul(dx[m], (float)kpk[g][m][0], (float)kpk[g][m][1]);
                dft_regs<16, 4, true>(bx);
#pragma unroll
                for (int m = 0; m < 16; ++m) X[b16 + brev(m, 4)] = bx[m];
            }
            fft_inv21(X, tid);
            asm volatile("" : "+v"(pb), "+v"(tq));
            if (half == 0) {
#pragma unroll 8
                for (int j = 0; j < 32; ++j) { const int n = tq + 512 * j; Ye[n] = X[pb + 560 * j]; }
            } else {
#define HY_Y(n, j) const f32x2 yo = X[pb + 560 * (j)], ye = Ye[n]; \
                    const float rev = (float)(n) * (1.f / 32768.f); const float c = __builtin_amdgcn_cosf(rev), sn = __builtin_amdgcn_sinf(rev); \
                    const float y0 = (ye[0] + yo[0] * c - yo[1] * sn) * nrm, y1 = (ye[1] + yo[0] * sn + yo[1] * c) * nrm;
                if (cv == 0) {
#pragma unroll 4
                    for (int j = 0; j < 32; ++j) { const int n = tq + 512 * j; HY_Y(n, j)
                        const float v0 = hy_short(pv[0], n, S, wv[0], wv[1], wv[2], wv[3]), v1 = hy_short(pv[1], n, S, wv[0], wv[1], wv[2], wv[3]);
                        const float a0 = hy_short(px1[0], n, S, wx1[0], wx1[1], wx1[2], wx1[3]), a1 = hy_short(px1[1], n, S, wx1[0], wx1[1], wx1[2], wx1[3]);
                        Z1[n] = (f32x2){a0 * (y0 + skip * v0), a1 * (y1 + skip * v1)}; }
                } else {
                    bf16_t* mix = WSP(bf16_t, WS_HBF);
#pragma unroll 4
                    for (int j = 0; j < 32; ++j) { const int n = tq + 512 * j; HY_Y(n, j)
                        const f32x2 z1 = Z1[n];
                        const float a0 = hy_short(px2[0], n, S, wx2[0], wx2[1], wx2[2], wx2[3]), a1 = hy_short(px2[1], n, S, wx2[0], wx2[1], wx2[2], wx2[3]);
                        mix[((size_t)n) * D + 768 + ch] = f2bf(a0 * (y0 + skip * z1[0]));
                        mix[((size_t)S + n) * D + 768 + ch] = f2bf(a1 * (y1 + skip * z1[1])); }
                }
#undef HY_Y
            }
        }
    }
}
DI void hyena_ctx_unit(const Frame& F, int li, int ch) {
    float* vs = (float*)F.lds;
    float* zs = vs + 512;
    float* fl = zs + 512;
    const bf16_t* HYC = WSP(bf16_t, WS_HYC); const _Float16* filt = WSP(_Float16, WS_FILTC);
    const float* sw = F.in[I_HYSW] + (size_t)li * 3 * 768; const float* sb = F.in[I_HYSB] + li * 768; const float* sk = F.in[I_HSKIP] + li * 512;
    const float n0 = hy_norm(WSP(float, WS_FPARTC), 4, 0, ch), n1 = hy_norm(WSP(float, WS_FPARTC), 4, 1, ch);
    const int b = F.tid >> 8, t = F.tid & 255;
    auto sc = [&](int c) -> float { const bf16_t* p = HYC + (size_t)(b * CTX) * 768 + c;
        const float a = t > 0 ? bf2f(p[(size_t)(t - 1) * 768]) : 0.f, d = t + 1 < CTX ? bf2f(p[(size_t)(t + 1) * 768]) : 0.f;
        return a * sw[c] + bf2f(p[(size_t)t * 768]) * sw[768 + c] + d * sw[1536 + c] + sb[c]; };
    __syncthreads();
    const float x1 = sc(ch), x2 = sc(256 + ch), v = sc(512 + ch);
    vs[F.tid] = v;
    for (int i = F.tid; i < 1024; i += NTHR) fl[i] = (float)filt[((size_t)(i >> 8) * 256 + ch) * CTX + (i & 255)];
    __syncthreads();
    float a = 0.f;
    for (int s = 0; s < CTX; ++s) { const int dl = t - s; a += (dl >= 0 ? fl[dl] : fl[256 - dl]) * vs[b * 256 + s]; }
    const float z = x1 * (a * n0 + sk[ch] * v);
    zs[F.tid] = z;
    __syncthreads();
    a = 0.f;
    for (int s = 0; s < CTX; ++s) { const int dl = t - s; a += (dl >= 0 ? fl[512 + dl] : fl[768 - dl]) * zs[b * 256 + s]; }
    WSP(bf16_t, WS_HBF)[((size_t)NLAT + b * CTX + t) * D + 768 + ch] = f2bf(x2 * (a * n1 + sk[256 + ch] * z));
}

DI void phase_mix(const Frame& F0, int li) {
    const Frame& F = F0;
    unsigned* head = F.ctl + CW_QHEAD + li * 64;
    volatile unsigned* qs = (volatile unsigned*)(F.lds + LDS_MISC + 32);
#ifndef PROBE_DA
#define PROBE_DA 1
#endif
#ifndef PROBE_HY
#define PROBE_HY 1
#endif
#ifndef PROBE_NA
#define PROBE_NA 1
#endif
#ifdef PROBE_MISC
#define PROBE_PL 2
#else
#define PROBE_PL 1
#endif
    const int n_ca = (li == 0) ? 8 : 0, n_cb = (li == 0) ? 8 : 0, n_da = 512 * PROBE_DA, n_hy = 256 * PROBE_HY, n_na = 512 * PROBE_NA, n_hc = (li == 0) ? 256 * PROBE_PL : 0, n_pl = 512 * PROBE_PL, n_pc = (li == 0) ? 8 : 0;
    const int total = n_ca + n_cb + n_da + n_hy + n_na + n_hc + n_pl + n_pc;
#if defined(PT_T) && PT_T >= 12
    unsigned long long ptk_acc = 0ull, ptk_t0 = 0ull; int ptk_kind = -1;
#endif
    for (;;) {
        __syncthreads();
#if defined(PT_T) && PT_T >= 12
        { const unsigned long long now_ = __builtin_amdgcn_s_memrealtime(); __builtin_amdgcn_s_waitcnt(0xC07F); if (ptk_kind == PT_T - 12) ptk_acc += now_ - ptk_t0; ptk_t0 = now_; }
#endif
        if (F.tid == 0) qs[0] = __hip_atomic_fetch_add(head, 1u, __ATOMIC_RELAXED, __HIP_MEMORY_SCOPE_AGENT);
        __syncthreads();
        int u = __builtin_amdgcn_readfirstlane((int)qs[0]);
#if defined(PT_T) && PT_T >= 12
        ptk_kind = u < n_ca + n_cb ? 0 : u < n_ca + n_cb + n_da ? 1 : u < n_ca + n_cb + n_da + n_hy ? 2 : u < n_ca + n_cb + n_da + n_hy + n_na ? 3 : u < n_ca + n_cb + n_da + n_hy + n_na + n_hc ? 4 : 5;
        if (u >= total) { if (F0.tid == 0) atomicAdd((unsigned long long*)(F0.ctl + 13000), ptk_acc); break; }
#endif
        if (u >= total) break;
        Frame F = F0; refresh(F);
        if (u < n_ca) {
#ifndef SKIP_CA
            diffattn_unit(F, li, u >> 2, u & 3, (size_t)NLAT + (size_t)(u >> 2) * CTX, CTX / 128);
#endif
            continue; }
        u -= n_ca;
        if (u < n_cb) {
#ifndef SKIP_CB
            na_mfma_unit(F, li, u >> 2, (size_t)NLAT + (size_t)(u >> 2) * CTX + (size_t)(u & 3) * 64, -1);
#endif
            continue; }
        u -= n_cb;
        if (u < n_da) {
#ifndef SKIP_DA
            { const int v = u & 511; diffattn_unit(F, li, v >> 8, (v >> 6) & 3, (size_t)(v >> 8) * S + (size_t)(v & 63) * 256, NKEY / 128); }
#endif
            continue; }
        u -= n_da;
        if (u < n_hy) {
#ifndef SKIP_HY
            hyena_fft_unit(F, li, u & 255);
#endif
            continue; }
        u -= n_hy;
        if (u < n_na) {
#ifndef SKIP_NA
            { const int v = u & 511; na_mfma_unit(F, li, v >> 8, (size_t)(v >> 8) * S + (size_t)(v & 255) * GW, v & 255); }
#endif
            continue; }
        u -= n_na;
        if (u < n_hc) {
#ifndef SKIP_HC
            hyena_ctx_unit(F, li, u & 255);
#endif
            continue; }
        u -= n_hc;
        if (u < n_pl) {
#ifndef SKIP_PL
            { const int v = u & 511; pool_unit(F, li, (size_t)(v >> 8) * S, S, (v & 255) * 64); }
#endif
            continue; }
        u -= n_pl;
#ifndef SKIP_PL
        pool_unit(F, li, (size_t)NLAT + (u >> 2) * CTX, CTX, (u & 3) * 64);
#endif
    }
}

constexpr int PH_PER_LAYER = 8, NPH = 2 + 2 * PH_PER_LAYER;
#ifdef PT_T
#define PT_SEL(k) (PT_T == 10 || (PT_T == 8 && (k) == 0) || (PT_T == 9 && (k) == NPH - 1) || (PT_T < 8 && (k) >= 1 && (k) <= 16 && (((k) - 1) & 7) == PT_T))
#define PT_MARK(k) do { const unsigned long long now_ = __builtin_amdgcn_s_memrealtime(); __builtin_amdgcn_s_waitcnt(0xC07F); if (PT_SEL(k)) pt_acc += now_ - pt_last; pt_last = now_; } while (0)
#ifndef PT_MULT
#define PT_MULT 4
#endif
#else
#define PT_MARK(k) do { } while (0)
#endif
__global__ void __launch_bounds__(NTHR, 2) mega(Args args) {
    extern __shared__ __attribute__((aligned(16))) unsigned char smem[];
    Frame F;
    F.in = args.in; F.out = args.out; F.ws = args.ws; F.ctl = (unsigned*)(args.ws + WS_CTL); F.lds = smem;
    F.tid = threadIdx.x; F.lane = F.tid & 63; F.wave = __builtin_amdgcn_readfirstlane(F.tid >> 6); F.G = gridDim.x; F.bid = blockIdx.x;
    if (F.tid < 64) ((unsigned*)(smem + LDS_MISC))[F.tid] = 0u;
    __syncthreads();
    const int lo = args.ph_lo, hi = args.ph_hi;
    const bool fused = (hi - lo) > 1;
    XcdBarrier bar; bar.bar = F.ctl; bar.x = 0; bar.st = (volatile LAS unsigned*)(smem + LDS_MISC);
    if (fused) bar = xcd_barrier_post(F.ctl, (volatile LAS unsigned*)(smem + LDS_MISC));
#define IN(k) (lo <= (k) && (k) < hi)
#ifdef PT_T
    unsigned long long pt_acc = 0ull, pt_last = __builtin_amdgcn_s_memrealtime(); __builtin_amdgcn_s_waitcnt(0xC07F);
#endif
#ifdef PROBE_BAR
#define SEAM(k) do { if (IN(k) && IN((k) + 1)) { xcd_barrier(bar); xcd_barrier(bar); xcd_barrier(bar); } } while (0)
#else
#define SEAM(k) do { if (IN(k) && IN((k) + 1)) xcd_barrier(bar); PT_MARK(k); } while (0)
#endif
#ifndef SKIP_P0
    if (IN(0)) { refresh(F); phase_prologue(F);
#ifdef PROBE_MISC
        __syncthreads(); refresh(F); phase_prologue(F);
#endif
    }
#endif
    SEAM(0);
    for (int li = 0; li < 2; ++li) {
        const int p0 = 1 + li * PH_PER_LAYER;
        const int nrows = (li == 0) ? NTOK : NLAT;
        if (IN(p0)) {
            refresh(F);
#if defined(PT_T) && PT_T >= 20 && PT_T <= 23
            const unsigned long long tn0_ = __builtin_amdgcn_s_memrealtime(); __builtin_amdgcn_s_waitcnt(0xC07F);
#endif
            phase_norm1(F, li, li == 0 ? 0 : 1);
#if defined(PT_T) && PT_T >= 20 && PT_T <= 23
            __syncthreads();
            const unsigned long long tn1_ = __builtin_amdgcn_s_memrealtime(); __builtin_amdgcn_s_waitcnt(0xC07F);
            if (threadIdx.x == 0 && PT_T == 20 + li) atomicAdd((unsigned long long*)(F.ctl + 13000), tn1_ - tn0_);
#endif
#ifdef PROBE_N1
            if (li == 0) { refresh(F); phase_norm1(F, li, 0); refresh(F); phase_norm1(F, li, 0); refresh(F); phase_norm1(F, li, 0); refresh(F); phase_norm1(F, li, 0); }
#endif
            refresh(F);
#ifndef SKIP_FILT
            for (int t = F.bid; t < 256; t += F.G) filter_tile(F, li, S, t, WSP(_Float16, WS_FILT), WSP(float, WS_FPART));
            if (li == 0) for (int t = F.bid; t < 4; t += F.G) filter_tile(F, li, CTX, t, WSP(_Float16, WS_FILTC), WSP(float, WS_FPARTC));
#ifdef PROBE_MISC
            for (int t = F.bid; t < 256; t += F.G) filter_tile(F, li, S, t, WSP(_Float16, WS_FILT), WSP(float, WS_FPART));
#endif
#endif
#if defined(PT_T) && PT_T >= 20 && PT_T <= 23
            { __syncthreads(); const unsigned long long tn2_ = __builtin_amdgcn_s_memrealtime(); __builtin_amdgcn_s_waitcnt(0xC07F);
              if (threadIdx.x == 0 && PT_T == 22 + li) atomicAdd((unsigned long long*)(F.ctl + 13000), tn2_ - tn1_); }
#endif
        }
        SEAM(p0);
        if (IN(p0 + 1)) {
            refresh(F);
            pg8::Gemm g{WSP(bf16_t, WS_HBF), WSP(bf16_t, WS_WIN) + (size_t)li * DIN * D, D, 0};
            pg8::StaticOrder So; So.init(NTOK, DIN, F.G, F.bid);
            EpiIn E{F.ws, WSP(float, WS_ROPE), F.ctl + CW_KMAX + li * 16, F.ctl + CW_KMAXB + li * 16};
#ifndef SKIP_G1
            pg8::gemm_phase<EpiIn, pg8::StaticOrder>((LAS unsigned char*)smem, g, So, E, F.tid);
#ifdef PROBE_G1
            __syncthreads(); refresh(F); pg8::gemm_phase<EpiIn, pg8::StaticOrder>((LAS unsigned char*)smem, g, So, E, F.tid);
#endif
#endif
        }
        SEAM(p0 + 1);
        if (IN(p0 + 2)) { refresh(F); phase_mix(F, li); }
#if defined(PT_T) && PT_T == 11
        { const unsigned long long ta_ = __builtin_amdgcn_s_memrealtime(); __builtin_amdgcn_s_waitcnt(0xC07F);
          SEAM(p0 + 2);
          const unsigned long long tb_ = __builtin_amdgcn_s_memrealtime(); __builtin_amdgcn_s_waitcnt(0xC07F);
          if (threadIdx.x == 0) atomicAdd((unsigned long long*)(F.ctl + 13000), tb_ - ta_); }
#else
        SEAM(p0 + 2);
#endif
        if (IN(p0 + 3)) {
            refresh(F);
            pg8::Gemm g{WSP(bf16_t, WS_HBF), WSP(bf16_t, WS_WOUT) + (size_t)li * D * D, D, 0};
            pg8::StaticOrder So; So.init(nrows, D, F.G, F.bid);
            EpiOut E{F.in[I_X], F.in[I_CTX], WSP(bf16_t, WS_XB), WSP(float, WS_MOD) + (size_t)li * 3 * 6144, li == 0};
#ifndef SKIP_G2
            pg8::gemm_phase<EpiOut, pg8::StaticOrder, true>((LAS unsigned char*)smem, g, So, E, F.tid);
#endif
        }
        SEAM(p0 + 3);
#ifndef SKIP_N2
        if (IN(p0 + 4)) { refresh(F); phase_norm2(F, li, nrows); }
#endif
        SEAM(p0 + 4);
        if (IN(p0 + 5)) { refresh(F); phase_gather(F, li, nrows);
#ifdef PROBE_MISC
            __syncthreads(); refresh(F); phase_gather(F, li, nrows);
#endif
        }
        SEAM(p0 + 5);
        if (IN(p0 + 6)) {
            refresh(F);
            int* offs = (int*)(smem + LDS_MISC + 64);
            moe_offsets(F, li, offs);
            pg8::Gemm g{WSP(bf16_t, WS_HBF), WSP(bf16_t, WS_W13) + (size_t)li * NE * 1024 * 1024, D, (size_t)1024 * 1024};
            pg8::MoeOrder Mo{offs + 40, offs[17 + 16], 4, F.G, (F.G % 8 == 0) ? (F.bid % 8) * (F.G / 8) + F.bid / 8 : F.bid};
            EpiMoe1 E{WSP(bf16_t, WS_HMID)};
#ifndef SKIP_G3
            pg8::gemm_phase_gather<EpiMoe1, pg8::MoeOrder>((LAS unsigned char*)smem, g, Mo, E, F.tid, WSP(int, WS_RMAP));
#endif
        }
        SEAM(p0 + 6);
        if (IN(p0 + 7)) {
            refresh(F);
            int* offs = (int*)(smem + LDS_MISC + 64);
            moe_offsets(F, li, offs);
            pg8::Gemm g{WSP(bf16_t, WS_HMID), WSP(bf16_t, WS_W2) + (size_t)li * NE * 1024 * 512, DE, (size_t)1024 * 512};
            pg8::MoeOrder Mo{offs + 40, offs[17 + 16], 4, F.G, (F.G % 8 == 0) ? (F.bid % 8) * (F.G / 8) + F.bid / 8 : F.bid};
            EpiMoe2 E{WSP(bf16_t, WS_A1)};
#ifndef SKIP_G4
            pg8::gemm_phase<EpiMoe2, pg8::MoeOrder, true>((LAS unsigned char*)smem, g, Mo, E, F.tid);
#ifdef PROBE_G4
            __syncthreads(); refresh(F); pg8::gemm_phase<EpiMoe2, pg8::MoeOrder>((LAS unsigned char*)smem, g, Mo, E, F.tid);
#endif
#endif
        }
        SEAM(p0 + 7);
    }
    if (IN(NPH - 1)) { refresh(F); phase_norm1(F, 1, 2); }
#ifdef PT_T
    asm volatile("s_waitcnt vmcnt(0)" ::: "memory"); __syncthreads();
    PT_MARK(NPH - 1);
#if PT_T >= 11
    xcd_barrier(bar);
    pt_acc = __hip_atomic_load((unsigned long long*)(F.ctl + 13000), __ATOMIC_RELAXED, __HIP_MEMORY_SCOPE_AGENT) / (unsigned long long)F.G;
    pt_last = __builtin_amdgcn_s_memrealtime();
#endif
    if (F.bid == 0) { const unsigned long long until = pt_last + (unsigned long long)PT_MULT * pt_acc;
        while (__builtin_amdgcn_s_memrealtime() < until) __builtin_amdgcn_s_sleep(8); }
#endif
#undef IN
#undef SEAM
}

extern "C" void kernel_launch(void* const* d_in, const int* in_sizes, int n_in, void* d_out, int out_size, void* d_ws, size_t ws_size, hipStream_t stream) {
    static int grid = 0;
    if (grid == 0) {
        if (n_in != N_IN || out_size != NLAT * D || ws_size < WS_END) { fprintf(stderr, "kernel_launch: unexpected shapes (n_in %d out %d ws %zu need %zu)\n", n_in, out_size, ws_size, (size_t)WS_END); grid = -1; return; }
        int dev = 0, cus = 0, per_cu = 0;
        if (hipGetDevice(&dev) != hipSuccess || hipDeviceGetAttribute(&cus, hipDeviceAttributeMultiprocessorCount, dev) != hipSuccess) { grid = -1; return; }
        if (hipFuncSetAttribute((const void*)mega, hipFuncAttributeMaxDynamicSharedMemorySize, LDS_BYTES) != hipSuccess) { fprintf(stderr, "kernel_launch: hipFuncSetAttribute failed\n"); grid = -1; return; }
        if (hipOccupancyMaxActiveBlocksPerMultiprocessor(&per_cu, (const void*)mega, NTHR, LDS_BYTES) != hipSuccess || per_cu < 1) { fprintf(stderr, "kernel_launch: occupancy query says %d\n", per_cu); }
        (void)hipGetLastError();
        grid = cus < MAXG ? cus : MAXG;
    }
    if (grid < 0) return;
    (void)hipMemsetAsync((char*)d_ws + WS_CTL, 0, CTL_BYTES, stream);
    Args a{};
    for (int i = 0; i < N_IN; ++i) a.in[i] = (const float*)d_in[i];
    a.out = (float*)d_out; a.ws = (unsigned char*)d_ws;
#if N_LAUNCH_MODE == 1
    a.ph_lo = 0; a.ph_hi = NPH;
    hipLaunchKernelGGL(mega, dim3(grid), dim3(NTHR), LDS_BYTES, stream, a);
#else
    for (int p = 0; p < NPH; ++p) { a.ph_lo = p; a.ph_hi = p + 1; hipLaunchKernelGGL(mega, dim3(grid), dim3(NTHR), LDS_BYTES, stream, a); }
#endif
}
#ifdef TEST_UNITS
__global__ void __launch_bounds__(NTHR, 2) t_da(Args args) {
    extern __shared__ __attribute__((aligned(16))) unsigned char smem[];
    Frame F; F.in = args.in; F.out = args.out; F.ws = args.ws; F.ctl = (unsigned*)(args.ws + WS_CTL); F.lds = smem; F.G = gridDim.x; F.bid = blockIdx.x; refresh(F);
    diffattn_unit(F, args.ph_lo, blockIdx.x >> 8, (blockIdx.x >> 6) & 3, (size_t)(blockIdx.x & 63) * 256, NKEY / 128);
}
__global__ void __launch_bounds__(NTHR, 2) t_hy(Args args) {
    extern __shared__ __attribute__((aligned(16))) unsigned char smem[];
    Frame F; F.in = args.in; F.out = args.out; F.ws = args.ws; F.ctl = (unsigned*)(args.ws + WS_CTL); F.lds = smem; F.G = gridDim.x; F.bid = blockIdx.x; refresh(F);
    hyena_fft_unit(F, args.ph_lo, blockIdx.x);
}
#endif
```

```cpp
#include <hip/hip_runtime.h>
#include <stdint.h>
#include <stdio.h>

#ifndef N_LAUNCH_MODE
#define N_LAUNCH_MODE 1
#endif

#define DI __device__ __forceinline__
#define LAS __attribute__((address_space(3)))
typedef unsigned short bf16_t;
typedef short bf16x8 __attribute__((ext_vector_type(8)));
typedef short s16x4 __attribute__((ext_vector_type(4)));
typedef float f32x4 __attribute__((ext_vector_type(4)));
typedef float f32x2 __attribute__((ext_vector_type(2)));
typedef float f32x16 __attribute__((ext_vector_type(16)));
typedef float f32x8 __attribute__((ext_vector_type(8)));
typedef unsigned u32x4 __attribute__((ext_vector_type(4)));
typedef unsigned u32x2 __attribute__((ext_vector_type(2)));
typedef _Float16 h16x2 __attribute__((ext_vector_type(2)));

constexpr int D = 1024, NB = 2, S = 16384, CTX = 256, NLAT = NB * S, NCTX = NB * CTX, NTOK = NLAT + NCTX, DIN = 2560;
constexpr int NE = 16, DE = 512, GW = 64;
constexpr int NKEY = CTX + S;
constexpr int NTHR = 512;
constexpr int SLOT_CAP = 70656;
constexpr float EPS = 1e-6f;
constexpr float LOG2E = 1.4426950408889634f;
constexpr float QSCALE_A = 0.17677669529663687f * LOG2E;
constexpr float QSCALE_B = 0.125f * LOG2E;

enum { I_X = 0, I_C, I_CTX, I_CCTX, I_N1G, I_N2G, I_ADAW, I_ADAB, I_WIN, I_WOUT, I_ALAM, I_ASUB, I_RPB, I_POOLW, I_POOLS, I_HYSW, I_HYSB,
       I_HW1, I_HB1, I_HW2, I_HB2, I_HW3, I_HB3, I_HSKIP, I_RW, I_RB, I_MW1, I_MW3, I_MW2, I_FG, N_IN };

struct Args { const float* in[N_IN]; float* out; unsigned char* ws; int ph_lo, ph_hi; };

constexpr size_t al256(size_t x) { return (x + 255) & ~(size_t)255; }
constexpr size_t WS_CTL = 0, CTL_BYTES = 65536;
constexpr size_t WS_MOD = WS_CTL + CTL_BYTES;
constexpr size_t WS_ROPE = WS_MOD + al256(2 * 3 * 6144 * 4);
constexpr size_t WS_PWT = WS_ROPE + 16384;
constexpr size_t WS_FPART = WS_PWT + 65536;
constexpr size_t WS_FPARTC = WS_FPART + 256 * 1024 * 4;
constexpr size_t WS_XC = WS_FPARTC + 4 * 1024 * 4;
constexpr size_t WS_WIN = WS_XC + (size_t)NCTX * D * 4;
constexpr size_t WS_WOUT = WS_WIN + (size_t)2 * DIN * D * 2;
constexpr size_t WS_W13 = WS_WOUT + (size_t)2 * D * D * 2;
constexpr size_t WS_W2 = WS_W13 + (size_t)2 * NE * 1024 * 1024 * 2;
constexpr size_t WS_FILT = WS_W2 + (size_t)2 * NE * 1024 * 512 * 2;
constexpr size_t WS_FILTC = WS_FILT + al256((size_t)4 * 256 * S * 2 + 64);
constexpr size_t WS_R1 = WS_FILTC + (size_t)4 * 256 * 256 * 2;
constexpr size_t WS_HBF = WS_R1;
constexpr size_t TOKB = (size_t)NTOK * 256 * 2;
constexpr size_t WS_AQ = WS_HBF + (size_t)NTOK * D * 2;
constexpr size_t WS_AK = WS_AQ + TOKB;
constexpr size_t WS_AVT = WS_AK + TOKB;
constexpr size_t WS_BQ = WS_AVT + (size_t)NB * 4 * 64 * NKEY * 2;
constexpr size_t WS_BK = WS_BQ + TOKB;
constexpr size_t WS_BVT = WS_BK + TOKB;
constexpr size_t WS_PL = WS_BVT + (size_t)NB * 4 * 64 * NKEY * 2;
constexpr size_t WS_HYT = WS_PL + TOKB;
constexpr size_t WS_HYC = WS_HYT + (size_t)NB * 768 * S * 2;
constexpr size_t WS_Z1BUF = WS_HYC + (size_t)NCTX * 768 * 2;
constexpr size_t WS_ZBUF = WS_Z1BUF + (size_t)256 * S * 8;
constexpr size_t WS_END_MIX = WS_ZBUF + (size_t)256 * S * 8;
constexpr size_t WS_TOK = WS_AQ;
constexpr size_t WS_A1 = WS_TOK + al256((size_t)NTOK * 32);
constexpr size_t WS_HMID = WS_A1 + (size_t)SLOT_CAP * D * 2;
constexpr size_t WS_RMAP = WS_HMID + (size_t)SLOT_CAP * DE * 2;
constexpr size_t WS_END_MOE = WS_RMAP + (size_t)SLOT_CAP * 4;
constexpr size_t WS_XB = al256(WS_END_MIX > WS_END_MOE ? WS_END_MIX : WS_END_MOE);
constexpr size_t WS_END = WS_XB + (size_t)NTOK * D * 2;

#define XB_TMO      128
#define XB_XCNT(j)  (256  + 64 * (j))
#define XB_XSUB(j)  (1280 + 64 * (j))
#define XB_XGEN(j)  (2304 + 64 * (j))
#define XB_TOP      3328
#define XB_TOPGEN   3392
#define XCD_BAR_WORDS 3456
#define XB_SPIN_CAP (1u << 18)
constexpr int CW_CNT = 4096;
constexpr int CW_KMAX = 4160;
constexpr int CW_KMAXB = 4192;
constexpr int CW_QHEAD = 4224;
constexpr int CW_BCNT = 4352;
constexpr int MAXG = 256;

constexpr int LDS_MAIN = 147456, LDS_MISC = LDS_MAIN, LDS_BYTES = LDS_MAIN + 2048;

DI float bf2f(bf16_t v) { return __uint_as_float(((unsigned)v) << 16); }
DI bf16_t f2bf(float f) { unsigned u = __float_as_uint(f); u += 0x7FFFu + ((u >> 16) & 1u); return (bf16_t)(u >> 16); }
DI unsigned pk2(float lo, float hi) { unsigned r; asm("v_cvt_pk_bf16_f32 %0, %1, %2" : "=v"(r) : "v"(lo), "v"(hi)); return r; }
template <int K> DI float swz_xor(float v) { return __int_as_float(__builtin_amdgcn_ds_swizzle(__float_as_int(v), (K << 10) | 0x1F)); }
DI float half_sum(float v) { const auto r = __builtin_amdgcn_permlane32_swap(__float_as_uint(v), __float_as_uint(v), false, false); return __uint_as_float(r[0]) + __uint_as_float(r[1]); }
DI float half_max(float v) { const auto r = __builtin_amdgcn_permlane32_swap(__float_as_uint(v), __float_as_uint(v), false, false); return fmaxf(__uint_as_float(r[0]), __uint_as_float(r[1])); }
DI float wave_sum(float v) { v += swz_xor<16>(v); v += swz_xor<8>(v); v += swz_xor<4>(v); v += swz_xor<2>(v); v += swz_xor<1>(v); return half_sum(v); }
DI float wave_max(float v) { v = fmaxf(v, swz_xor<16>(v)); v = fmaxf(v, swz_xor<8>(v)); v = fmaxf(v, swz_xor<4>(v)); v = fmaxf(v, swz_xor<2>(v)); v = fmaxf(v, swz_xor<1>(v)); return half_max(v); }
DI f32x4 ld_bf4(const bf16_t* p) { const u32x2 v = *(const u32x2*)p; return (f32x4){__uint_as_float(v[0] << 16), __uint_as_float(v[0] & 0xffff0000u), __uint_as_float(v[1] << 16), __uint_as_float(v[1] & 0xffff0000u)}; }
DI f32x4 bf4_to_f4(u32x2 v) { return (f32x4){__uint_as_float(v[0] << 16), __uint_as_float(v[0] & 0xffff0000u), __uint_as_float(v[1] << 16), __uint_as_float(v[1] & 0xffff0000u)}; }
DI float siluf(float x) { return x * __builtin_amdgcn_rcpf(1.f + __expf(-x)); }
DI float sin_rev(float rev) { return __builtin_amdgcn_sinf(rev - floorf(rev)); }
DI float cos_rev(float rev) { return __builtin_amdgcn_cosf(rev - floorf(rev)); }
DI float sin_rad(float x) { return sin_rev(x * 0.15915494309189535f); }

DI unsigned xb_ld(unsigned* p)              { return __hip_atomic_load(p, __ATOMIC_RELAXED, __HIP_MEMORY_SCOPE_AGENT); }
DI unsigned xb_add(unsigned* p, unsigned v) { return __hip_atomic_fetch_add(p, v, __ATOMIC_RELAXED, __HIP_MEMORY_SCOPE_AGENT); }
DI unsigned xb_xcc_id() { return (unsigned)__builtin_amdgcn_s_getreg((3 << 11) | 20) & 0xFu; }
#define XB_SPIN(cond, bar) do { unsigned _sp = 0; while (cond) { __builtin_amdgcn_s_sleep(1); \
    if ((++_sp & 255u) == 0u) { if (xb_ld(&(bar)[XB_TMO])) break; if (_sp > XB_SPIN_CAP) { atomicAdd(&(bar)[XB_TMO], 1u); break; } } } } while (0)
struct XcdBarrier { unsigned* bar; unsigned x; volatile LAS unsigned* st; };
DI XcdBarrier xcd_barrier_post(unsigned* bar, volatile LAS unsigned* st) {
    XcdBarrier b; b.bar = bar; b.x = xb_xcc_id(); b.st = st;
    if (threadIdx.x == 0) (void)xb_add(&bar[XB_XCNT(b.x)], 1u);
    return b;
}
DI void xcd_barrier_complete(unsigned* bar, unsigned x, unsigned& nloc, unsigned& nx) {
    const unsigned G = gridDim.x * gridDim.y * gridDim.z;
    unsigned sum, cnt, mine, sp = 0u;
    for (;;) {
        sum = 0u; cnt = 0u; mine = 0u;
#pragma unroll
        for (unsigned j = 0; j < 16; ++j) { const unsigned c = xb_ld(&bar[XB_XCNT(j)]); sum += c; cnt += (c > 0u) ? 1u : 0u; mine = (j == x) ? c : mine; }
        if (sum == G) break;
        __builtin_amdgcn_s_sleep(1);
        if ((++sp & 255u) == 0u) { if (xb_ld(&bar[XB_TMO])) break; if (sp > XB_SPIN_CAP) { atomicAdd(&bar[XB_TMO], 1u); break; } }
    }
    nloc = mine > 0u ? mine : 1u; nx = cnt > 0u ? cnt : 1u;
}
DI void xcd_barrier(const XcdBarrier& b) {
    asm volatile("s_waitcnt vmcnt(0)" ::: "memory");
    __syncthreads();
    if (threadIdx.x == 0) {
        unsigned* bar = b.bar;
        __builtin_amdgcn_s_waitcnt(0);
        unsigned nloc = b.st[0], nx = b.st[1];
        if (nloc == 0u) { xcd_barrier_complete(bar, b.x, nloc, nx); b.st[0] = nloc; b.st[1] = nx; }
        const unsigned old = xb_add(&bar[XB_XSUB(b.x)], 1u);
        const unsigned gen = old / nloc;
        if (old + 1u == (gen + 1u) * nloc) {
            __builtin_amdgcn_fence(__ATOMIC_RELEASE, "agent");
            asm volatile("s_waitcnt vmcnt(0)" ::: "memory");
            const unsigned og = xb_add(&bar[XB_TOP], 1u);
            const unsigned tg = og / nx;
            if (og + 1u == (tg + 1u) * nx) xb_add(&bar[XB_TOPGEN], 1u);
            else XB_SPIN(xb_ld(&bar[XB_TOPGEN]) == tg, bar);
            __builtin_amdgcn_fence(__ATOMIC_ACQUIRE, "agent");
            xb_add(&bar[XB_XGEN(b.x)], 1u);
            asm volatile("s_waitcnt vmcnt(0)" ::: "memory");
        } else {
            XB_SPIN(xb_ld(&bar[XB_XGEN(b.x)]) == gen, bar);
            __builtin_amdgcn_fence(__ATOMIC_ACQUIRE, "agent");
            asm volatile("s_waitcnt vmcnt(0)" ::: "memory");
        }
    }
    __syncthreads();
}

struct Frame {
    const float* const* in; float* out; unsigned char* ws; unsigned* ctl;
    unsigned char* lds;
    int tid, lane, wave, G, bid;
};
#define WSP(T, off) ((T*)(F.ws + (off)))
DI void refresh(Frame& F) { int t = threadIdx.x; asm volatile("" : "+v"(t)); F.tid = t; F.lane = t & 63; F.wave = __builtin_amdgcn_readfirstlane(t >> 6);
}

namespace pg8 {
constexpr int BM = 256, BK = 64, HALF = 128, HTB = HALF * BK * 2, STAGE_BYTES = 8 * HTB, NXCD = 8, WGM = 8;
DI int lds_byte(int r, int c) { const int st = (r >> 4) * 2 + (c >> 5), rr = r & 15, cc = c & 31, ob = rr * 64 + cc * 2; return st * 1024 + (ob ^ (((ob >> 9) & 1) << 5)); }
DI void stage_rc(int b, int& R, int& C) { const int st = b / 1024, sb = b % 1024, swz = sb ^ (((sb >> 9) & 1) << 5); R = (st >> 1) * 16 + swz / 64; C = (st & 1) * 32 + (swz % 64) / 2; }
struct Unit { int pm, pn, e; };
struct Gemm { const bf16_t* A; const bf16_t* Bt; int K; size_t bstride; };
struct StaticOrder {
    int nM, nN, nwg, G, c;
    DI void init(int M, int N, int G_, int c_) { nM = M / BM; nN = N / BM; nwg = nM * nN; G = G_; c = c_; }
    DI bool next(int i, Unit& u) const {
        const long L = (long)i * G + c; if (L >= nwg) return false;
        int wgid = (int)L; { const int q = nwg / NXCD, r = nwg % NXCD, xcd = wgid % NXCD, off = wgid / NXCD; wgid = (xcd < r ? xcd * (q + 1) : r * (q + 1) + (xcd - r) * q) + off; }
        const int nig = WGM * nN, gid = wgid / nig, fm = gid * WGM, gsz = (nM - fm) < WGM ? (nM - fm) : WGM;
        u.pm = fm + ((wgid % nig) % gsz); u.pn = (wgid % nig) / gsz; u.e = 0; return true;
    }
};
struct MoeOrder {
    const int* toff; int ntile, nN, G, c;
    DI bool next(int i, Unit& u) const {
        const long L = (long)i * G + c; if (L >= (long)ntile * nN) return false;
        const int t = (int)(L / nN); u.pm = t; u.pn = (int)(L % nN);
        u.e = toff[t]; return true;
    }
};

template <class Epi, class Sched, bool PERMB = false>
DI void gemm_phase(LAS unsigned char* lds, const Gemm g, const Sched& S, const Epi& E, int tid) {
    const int wid = __builtin_amdgcn_readfirstlane(tid >> 6), lane = tid & 63, wr = wid >> 2, wc = wid & 3, fr = lane & 15, fq = lane >> 4;
    const int K = g.K, nt = K / BK;
    unsigned voffA[2], voffB[2];
#pragma unroll
    for (int i = 0; i < 2; ++i) { int R, C; stage_rc(tid * 16 + i * 8192, R, C); voffA[i] = (unsigned)(R * K + C) * 2u;
        const int rho = R & 31, Rp = PERMB ? ((R & ~31) | (8 * ((rho & 15) >> 2) + 4 * (rho >> 4) + (rho & 3))) : R; voffB[i] = (unsigned)(Rp * K + C) * 2u; }
    const size_t kstep = (size_t)(BK * 2);
    const size_t hstep = (size_t)HALF * K * 2;
    const size_t tstep = 2 * hstep;
    const unsigned ldsw = (unsigned)wid * 1024u;
    const int aoff = lds_byte(wr * 64 + fr, fq * 8), boff = lds_byte(wc * 32 + fr, fq * 8);
#define PG8_SA(b, h) (((b) * 2 + (h)) * HTB)
#define PG8_SB(b, h) ((4 + (b) * 2 + (h)) * HTB)
#define PG8_STAGE(bufoff, gbase, voff) do { _Pragma("unroll") for (int _i = 0; _i < 2; ++_i) \
        __builtin_amdgcn_global_load_lds((const unsigned*)((const char*)(gbase) + (voff)[_i]), (LAS unsigned*)(lds + (bufoff) + ldsw + _i * 8192), 16, 0, 0); } while (0)
#define PG8_LDA(dst, b, h) do { _Pragma("unroll") for (int m = 0; m < 4; ++m) _Pragma("unroll") for (int k = 0; k < 2; ++k) dst[m][k] = *(const LAS bf16x8*)(lds + PG8_SA(b, h) + aoff + m * 2048 + k * 1024); } while (0)
#define PG8_LDB(dst, b, h) do { _Pragma("unroll") for (int n = 0; n < 2; ++n) _Pragma("unroll") for (int k = 0; k < 2; ++k) dst[n][k] = *(const LAS bf16x8*)(lds + PG8_SB(b, h) + boff + n * 2048 + k * 1024); } while (0)
#define PG8_MMA(ai, bj, At, Bt) do { __builtin_amdgcn_s_setprio(1); _Pragma("unroll") for (int m = 0; m < 4; ++m) _Pragma("unroll") for (int n = 0; n < 2; ++n) _Pragma("unroll") for (int k = 0; k < 2; ++k) \
        acc[ai][bj][m][n] = __builtin_amdgcn_mfma_f32_16x16x32_bf16(Bt[n][k], At[m][k], acc[ai][bj][m][n], 0, 0, 0); __builtin_amdgcn_s_setprio(0); } while (0)
#define PG8_WAIT_V(n) asm volatile("s_waitcnt vmcnt(" #n ")" ::: "memory")
#define PG8_WAIT_L(n) asm volatile("s_waitcnt lgkmcnt(" #n ")" ::: "memory")
#define PG8_BAR __builtin_amdgcn_s_barrier()
#define PG8_SCHED __builtin_amdgcn_sched_barrier(0)
    Unit cur, nxt; int ui = 0;
    if (!S.next(0, cur)) return;
    f32x4 acc[2][2][4][2];
#pragma unroll
    for (int a = 0; a < 2; ++a)
#pragma unroll
        for (int b = 0; b < 2; ++b)
#pragma unroll
            for (int m = 0; m < 4; ++m)
#pragma unroll
                for (int n = 0; n < 2; ++n) acc[a][b][m][n] = (f32x4){0.f, 0.f, 0.f, 0.f};
    bf16x8 At[4][2], B0[2][2], B1[2][2];
    const char* cA = (const char*)g.A + (size_t)cur.pm * tstep; const char* cB = (const char*)(g.Bt + (size_t)cur.e * g.bstride) + (size_t)cur.pn * tstep;
    PG8_STAGE(PG8_SB(0, 0), cB, voffB); PG8_STAGE(PG8_SA(0, 0), cA, voffA); PG8_STAGE(PG8_SB(0, 1), cB + hstep, voffB); PG8_STAGE(PG8_SA(0, 1), cA + hstep, voffA);
    if (wr == 1) PG8_BAR;
    PG8_WAIT_V(4); PG8_BAR;
    PG8_STAGE(PG8_SB(1, 0), cB + kstep, voffB); PG8_STAGE(PG8_SA(1, 0), cA + kstep, voffA); PG8_STAGE(PG8_SB(1, 1), cB + hstep + kstep, voffB);
    PG8_WAIT_V(6); PG8_BAR;
    for (;;) {
        const bool has_next = S.next(ui + 1, nxt);
        const char* nA = has_next ? (const char*)g.A + (size_t)nxt.pm * tstep : cA; const char* nB = has_next ? (const char*)(g.Bt + (size_t)nxt.e * g.bstride) + (size_t)nxt.pn * tstep : cB;
        for (int t = 0; t < nt; t += 2) {
            const bool last = (t == nt - 2);
            const char* a1 = cA + (size_t)(t + 1) * kstep;
            const char* a2 = last ? nA : cA + (size_t)(t + 2) * kstep; const char* b2 = last ? nB : cB + (size_t)(t + 2) * kstep;
            const char* a3 = a2 + kstep; const char* b3 = b2 + kstep;
            PG8_LDB(B0, 0, 0); PG8_SCHED; PG8_LDA(At, 0, 0); PG8_STAGE(PG8_SA(1, 1), a1 + hstep, voffA);
            PG8_WAIT_L(8); PG8_BAR; PG8_WAIT_L(0); PG8_MMA(0, 0, At, B0); PG8_BAR; PG8_SCHED;
            PG8_LDB(B1, 0, 1); PG8_STAGE(PG8_SB(0, 0), b2, voffB);
            PG8_BAR; PG8_WAIT_L(0); PG8_MMA(0, 1, At, B1); PG8_BAR;
            PG8_LDA(At, 0, 1); PG8_STAGE(PG8_SA(0, 0), a2, voffA);
            PG8_BAR; PG8_WAIT_L(0); PG8_MMA(1, 0, At, B0); PG8_BAR; PG8_SCHED;
            PG8_STAGE(PG8_SB(0, 1), b2 + hstep, voffB);
            PG8_WAIT_V(6); PG8_BAR; PG8_MMA(1, 1, At, B1); PG8_BAR;
            PG8_LDB(B0, 1, 0); PG8_SCHED; PG8_LDA(At, 1, 0); PG8_STAGE(PG8_SA(0, 1), a2 + hstep, voffA);
            PG8_WAIT_L(8); PG8_BAR; PG8_WAIT_L(0); PG8_MMA(0, 0, At, B0); PG8_BAR; PG8_SCHED;
            PG8_LDB(B1, 1, 1); PG8_STAGE(PG8_SB(1, 0), b3, voffB);
            PG8_BAR; PG8_WAIT_L(0); PG8_MMA(0, 1, At, B1); PG8_BAR;
            PG8_LDA(At, 1, 1); PG8_STAGE(PG8_SA(1, 0), a3, voffA);
            PG8_BAR; PG8_WAIT_L(0); PG8_MMA(1, 0, At, B0); PG8_BAR; PG8_SCHED;
            PG8_STAGE(PG8_SB(1, 1), b3 + hstep, voffB);
            PG8_WAIT_V(6); PG8_BAR; PG8_MMA(1, 1, At, B1); PG8_BAR;
        }
        E(acc, cur, wr, wc, fr, fq);
        if (!has_next) break;
#pragma unroll
        for (int a = 0; a < 2; ++a)
#pragma unroll
            for (int b = 0; b < 2; ++b)
#pragma unroll
                for (int m = 0; m < 4; ++m)
#pragma unroll
                    for (int n = 0; n < 2; ++n) acc[a][b][m][n] = (f32x4){0.f, 0.f, 0.f, 0.f};
        cur = nxt; cA = nA; cB = nB; ++ui;
    }
    PG8_WAIT_V(0);
    if (wr == 0) PG8_BAR;
    PG8_BAR;
#undef PG8_SA
#undef PG8_SB
#undef PG8_STAGE
#undef PG8_LDA
#undef PG8_LDB
#undef PG8_MMA
#undef PG8_WAIT_V
#undef PG8_WAIT_L
#undef PG8_BAR
#undef PG8_SCHED
}
template <class Epi, class Sched>
DI void gemm_phase_gather(LAS unsigned char* lds, const Gemm g, const Sched& S, const Epi& E, int tid, const int* rowmap) {
    const int wid = __builtin_amdgcn_readfirstlane(tid >> 6), lane = tid & 63, wr = wid >> 2, wc = wid & 3, fr = lane & 15, fq = lane >> 4;
    const int K = g.K, nt = K / BK;
    unsigned voffA[2];
#pragma unroll
    for (int i = 0; i < 2; ++i) { int R, C; stage_rc(tid * 16 + i * 8192, R, C); voffA[i] = (unsigned)(R * K + C) * 2u; }
    const unsigned rowb = (unsigned)K * 2u;
#define PG8_ROWS_PK(pm, P) do { int t_ = tid; asm volatile("" : "+v"(t_)); int R0_, C0_, R1_, C1_; stage_rc(t_ * 16, R0_, C0_); stage_rc(t_ * 16 + 8192, R1_, C1_); \
        _Pragma("unroll") for (int h_ = 0; h_ < 2; ++h_) P[h_] = (unsigned)rowmap[(pm) * 256 + h_ * 128 + R0_] | ((unsigned)rowmap[(pm) * 256 + h_ * 128 + R1_] << 16); } while (0)
#define PG8_UNPK(P, O) do { int t_ = tid; asm volatile("" : "+v"(t_)); int R0_, C0_, R1_, C1_; stage_rc(t_ * 16, R0_, C0_); stage_rc(t_ * 16 + 8192, R1_, C1_); \
        _Pragma("unroll") for (int h_ = 0; h_ < 2; ++h_) { O[h_][0] = (P[h_] & 0xffffu) * rowb + (unsigned)C0_ * 2u; O[h_][1] = (P[h_] >> 16) * rowb + (unsigned)C1_ * 2u; } } while (0)
    const size_t kstep = (size_t)(BK * 2);
    const size_t hstep = (size_t)HALF * K * 2;
    const size_t tstep = 2 * hstep;
    const unsigned ldsw = (unsigned)wid * 1024u;
    const int aoff = lds_byte(wr * 64 + fr, fq * 8), boff = lds_byte(wc * 32 + fr, fq * 8);
#define PG8_SA(b, h) (((b) * 2 + (h)) * HTB)
#define PG8_SB(b, h) ((4 + (b) * 2 + (h)) * HTB)
#define PG8_STAGE(bufoff, gbase, voff) do { _Pragma("unroll") for (int _i = 0; _i < 2; ++_i) \
        __builtin_amdgcn_global_load_lds((const unsigned*)((const char*)(gbase) + (voff)[_i]), (LAS unsigned*)(lds + (bufoff) + ldsw + _i * 8192), 16, 0, 0); } while (0)
#define PG8_LDA(dst, b, h) do { _Pragma("unroll") for (int m = 0; m < 4; ++m) _Pragma("unroll") for (int k = 0; k < 2; ++k) dst[m][k] = *(const LAS bf16x8*)(lds + PG8_SA(b, h) + aoff + m * 2048 + k * 1024); } while (0)
#define PG8_LDB(dst, b, h) do { _Pragma("unroll") for (int n = 0; n < 2; ++n) _Pragma("unroll") for (int k = 0; k < 2; ++k) dst[n][k] = *(const LAS bf16x8*)(lds + PG8_SB(b, h) + boff + n * 2048 + k * 1024); } while (0)
#define PG8_MMA(ai, bj, At, Bt) do { __builtin_amdgcn_s_setprio(1); _Pragma("unroll") for (int m = 0; m < 4; ++m) _Pragma("unroll") for (int n = 0; n < 2; ++n) _Pragma("unroll") for (int k = 0; k < 2; ++k) \
        acc[ai][bj][m][n] = __builtin_amdgcn_mfma_f32_16x16x32_bf16(Bt[n][k], At[m][k], acc[ai][bj][m][n], 0, 0, 0); __builtin_amdgcn_s_setprio(0); } while (0)
#define PG8_WAIT_V(n) asm volatile("s_waitcnt vmcnt(" #n ")" ::: "memory")
#define PG8_WAIT_L(n) asm volatile("s_waitcnt lgkmcnt(" #n ")" ::: "memory")
#define PG8_BAR __builtin_amdgcn_s_barrier()
#define PG8_SCHED __builtin_amdgcn_sched_barrier(0)
    Unit cur, nxt; int ui = 0;
    if (!S.next(0, cur)) return;
    f32x4 acc[2][2][4][2];
#pragma unroll
    for (int a = 0; a < 2; ++a)
#pragma unroll
        for (int b = 0; b < 2; ++b)
#pragma unroll
            for (int m = 0; m < 4; ++m)
#pragma unroll
                for (int n = 0; n < 2; ++n) acc[a][b][m][n] = (f32x4){0.f, 0.f, 0.f, 0.f};
    bf16x8 At[4][2], B0[2][2], B1[2][2];
    unsigned offC[2][2], pkN[2];
    PG8_ROWS_PK(cur.pm, pkN); PG8_UNPK(pkN, offC);
    const char* cA = (const char*)g.A; const char* cB = (const char*)(g.Bt + (size_t)cur.e * g.bstride) + (size_t)cur.pn * tstep;
    PG8_STAGE(PG8_SB(0, 0), cB, voffA); PG8_STAGE(PG8_SA(0, 0), cA, offC[0]); PG8_STAGE(PG8_SB(0, 1), cB + hstep, voffA); PG8_STAGE(PG8_SA(0, 1), cA, offC[1]);
    if (wr == 1) PG8_BAR;
    PG8_WAIT_V(4); PG8_BAR;
    PG8_STAGE(PG8_SB(1, 0), cB + kstep, voffA); PG8_STAGE(PG8_SA(1, 0), cA + kstep, offC[0]); PG8_STAGE(PG8_SB(1, 1), cB + hstep + kstep, voffA);
    PG8_WAIT_V(6); PG8_BAR;
    for (;;) {
        const bool has_next = S.next(ui + 1, nxt);
        if (has_next) PG8_ROWS_PK(nxt.pm, pkN);
        const char* nB = has_next ? (const char*)(g.Bt + (size_t)nxt.e * g.bstride) + (size_t)nxt.pn * tstep : cB;
        for (int t = 0; t < nt; t += 2) {
            const bool last = (t == nt - 2);
            const char* a1 = cA + (size_t)(t + 1) * kstep;
            const char* a2 = last ? cA : cA + (size_t)(t + 2) * kstep;
            const char* b2 = last ? nB : cB + (size_t)(t + 2) * kstep;
            const char* a3 = a2 + kstep; const char* b3 = b2 + kstep;
            PG8_LDB(B0, 0, 0); PG8_SCHED; PG8_LDA(At, 0, 0); PG8_STAGE(PG8_SA(1, 1), a1, offC[1]);
            if (last) PG8_UNPK(pkN, offC);
            PG8_WAIT_L(8); PG8_BAR; PG8_WAIT_L(0); PG8_MMA(0, 0, At, B0); PG8_BAR; PG8_SCHED;
            PG8_LDB(B1, 0, 1); PG8_STAGE(PG8_SB(0, 0), b2, voffA);
            PG8_BAR; PG8_WAIT_L(0); PG8_MMA(0, 1, At, B1); PG8_BAR;
            PG8_LDA(At, 0, 1); PG8_STAGE(PG8_SA(0, 0), a2, offC[0]);
            PG8_BAR; PG8_WAIT_L(0); PG8_MMA(1, 0, At, B0); PG8_BAR; PG8_SCHED;
            PG8_STAGE(PG8_SB(0, 1), b2 + hstep, voffA);
            PG8_WAIT_V(6); PG8_BAR; PG8_MMA(1, 1, At, B1); PG8_BAR;
            PG8_LDB(B0, 1, 0); PG8_SCHED; PG8_LDA(At, 1, 0); PG8_STAGE(PG8_SA(0, 1), a2, offC[1]);
            PG8_WAIT_L(8); PG8_BAR; PG8_WAIT_L(0); PG8_MMA(0, 0, At, B0); PG8_BAR; PG8_SCHED;
            PG8_LDB(B1, 1, 1); PG8_STAGE(PG8_SB(1, 0), b3, voffA);
            PG8_BAR; PG8_WAIT_L(0); PG8_MMA(0, 1, At, B1); PG8_BAR;
            PG8_LDA(At, 1, 1); PG8_STAGE(PG8_SA(1, 0), a3, offC[0]);
            PG8_BAR; PG8_WAIT_L(0); PG8_MMA(1, 0, At, B0); PG8_BAR; PG8_SCHED;
            PG8_STAGE(PG8_SB(1, 1), b3 + hstep, voffA);
            PG8_WAIT_V(6); PG8_BAR; PG8_MMA(1, 1, At, B1); PG8_BAR;
        }
        E(acc, cur, wr, wc, fr, fq);
        if (!has_next) break;
#pragma unroll
        for (int a = 0; a < 2; ++a)
#pragma unroll
            for (int b = 0; b < 2; ++b)
#pragma unroll
                for (int m = 0; m < 4; ++m)
#pragma unroll
                    for (int n = 0; n < 2; ++n) acc[a][b][m][n] = (f32x4){0.f, 0.f, 0.f, 0.f};
        cur = nxt; cB = nB; ++ui;
    }
    PG8_WAIT_V(0);
    if (wr == 0) PG8_BAR;
    PG8_BAR;
#undef PG8_ROWS_PK
#undef PG8_UNPK
#undef PG8_SA
#undef PG8_SB
#undef PG8_STAGE
#undef PG8_LDA
#undef PG8_LDB
#undef PG8_MMA
#undef PG8_WAIT_V
#undef PG8_WAIT_L
#undef PG8_BAR
#undef PG8_SCHED
}
}

typedef f32x4 AccT[2][2][4][2];

struct EpiIn {
    unsigned char* ws; const float* rope; unsigned* kmax; unsigned* kmaxb;
    DI void operator()(const AccT& acc, const pg8::Unit& u, int wr, int wc, int fr, int fq) const {
        const int pn = u.pn, row0 = u.pm * 256 + wr * 64 + fr;
        const bool isctx = (u.pm >= NLAT / 256);
        if (pn <= 1) {
            bf16_t* dst = (bf16_t*)(ws + (pn == 0 ? WS_AQ : WS_AK));
            const float sc = (pn == 0) ? QSCALE_A : 1.f;
            float nmax[2] = {0.f, 0.f};
#pragma unroll
            for (int ai = 0; ai < 2; ++ai)
#pragma unroll
                for (int m = 0; m < 4; ++m) {
                    const int r = row0 + ai * 128 + m * 16;
                    f32x4 cs0 = (f32x4){1.f, 0.f, 1.f, 0.f}, cs1 = cs0;
                    if (!isctx) { const int t = r & (S - 1); const int pos = (fq < 2) ? (t >> 6) : (t & 63);
                        const f32x4* tp = (const f32x4*)(rope + (size_t)pos * 16 + (fq & 1) * 8); cs0 = tp[0]; cs1 = tp[1]; }
                    const float cc[4] = {cs0[0], cs0[2], cs1[0], cs1[2]}, ss[4] = {cs0[1], cs0[3], cs1[1], cs1[3]};
#pragma unroll
                    for (int bj = 0; bj < 2; ++bj) {
                        const f32x4 x1 = acc[ai][bj][m][0], x2 = acc[ai][bj][m][1];
                        float o1[4], o2[4], n2 = 0.f;
#pragma unroll
                        for (int j = 0; j < 4; ++j) { o1[j] = (x1[j] * cc[j] - x2[j] * ss[j]) * sc; o2[j] = (x2[j] * cc[j] + x1[j] * ss[j]) * sc; n2 += x1[j] * x1[j] + x2[j] * x2[j]; }
                        bf16_t* p = dst + (size_t)r * 256 + bj * 128 + wc * 32 + 4 * fq;
                        *(u32x2*)p = (u32x2){pk2(o1[0], o1[1]), pk2(o1[2], o1[3])};
                        *(u32x2*)(p + 16) = (u32x2){pk2(o2[0], o2[1]), pk2(o2[2], o2[3])};
                        if (pn == 1) { n2 += swz_xor<16>(n2); n2 = half_sum(n2); nmax[bj] = fmaxf(nmax[bj], n2); }
                    }
                }
            if (pn == 1) {
                const int b = isctx ? (u.pm - NLAT / 256) : (u.pm / (S / 256));
#pragma unroll
                for (int bj = 0; bj < 2; ++bj) {
                    float v = nmax[bj];
                    v = fmaxf(v, swz_xor<1>(v)); v = fmaxf(v, swz_xor<2>(v)); v = fmaxf(v, swz_xor<4>(v)); v = fmaxf(v, swz_xor<8>(v));
                    if ((fr | fq) == 0) atomicMax(kmax + (b * 4 + (2 * bj + (wc >> 1))) * 2 + (wc & 1), __float_as_uint(v));
                }
            }
        } else if (pn == 2 || pn == 5) {
            bf16_t* dst = (bf16_t*)(ws + (pn == 2 ? WS_AVT : WS_BVT));
#pragma unroll
            for (int ai = 0; ai < 2; ++ai)
#pragma unroll
                for (int m = 0; m < 4; ++m) {
                    const int r = row0 + ai * 128 + m * 16;
                    int b, key; if (isctx) { b = (r - NLAT) >> 8; key = (r - NLAT) & 255; } else { b = r >> 14; key = CTX + (r & (S - 1)); }
                    key = (key & ~12) | ((key & 4) << 1) | ((key & 8) >> 1);
#pragma unroll
                    for (int bj = 0; bj < 2; ++bj)
#pragma unroll
                        for (int n = 0; n < 2; ++n) {
                            const int lc = bj * 128 + wc * 32 + n * 16 + 4 * fq;
#pragma unroll
                            for (int j = 0; j < 4; ++j) dst[((size_t)(b * 256 + lc + j)) * NKEY + key] = f2bf(acc[ai][bj][m][n][j]);
                        }
                }
        } else if (pn <= 6) {
            bf16_t* dst = (bf16_t*)(ws + (pn == 3 ? WS_BQ : pn == 4 ? WS_BK : WS_PL));
            const float sc = (pn == 3) ? QSCALE_B : 1.f;
            float nmax[2] = {0.f, 0.f};
#pragma unroll
            for (int ai = 0; ai < 2; ++ai)
#pragma unroll
                for (int m = 0; m < 4; ++m) {
                    const int r = row0 + ai * 128 + m * 16;
#pragma unroll
                    for (int bj = 0; bj < 2; ++bj)
#pragma unroll
                        for (int n = 0; n < 2; ++n) {
                            const f32x4 v = acc[ai][bj][m][n] * sc;
                            *(u32x2*)(dst + (size_t)r * 256 + bj * 128 + wc * 32 + n * 16 + 4 * fq) = (u32x2){pk2(v[0], v[1]), pk2(v[2], v[3])};
                        }
                    if (pn == 4) {
#pragma unroll
                        for (int bj = 0; bj < 2; ++bj) { const f32x4 x1 = acc[ai][bj][m][0], x2 = acc[ai][bj][m][1];
                            float n2 = x1[0] * x1[0] + x1[1] * x1[1] + x1[2] * x1[2] + x1[3] * x1[3] + x2[0] * x2[0] + x2[1] * x2[1] + x2[2] * x2[2] + x2[3] * x2[3];
                            n2 += swz_xor<16>(n2); n2 = half_sum(n2); nmax[bj] = fmaxf(nmax[bj], n2); }
                    }
                }
            if (pn == 4) {
                const int b = isctx ? (u.pm - NLAT / 256) : (u.pm / (S / 256));
#pragma unroll
                for (int bj = 0; bj < 2; ++bj) {
                    float v = nmax[bj];
                    v = fmaxf(v, swz_xor<1>(v)); v = fmaxf(v, swz_xor<2>(v)); v = fmaxf(v, swz_xor<4>(v)); v = fmaxf(v, swz_xor<8>(v));
                    if ((fr | fq) == 0) atomicMax(kmaxb + (b * 4 + (2 * bj + (wc >> 1))) * 2 + (wc & 1), __float_as_uint(v));
                }
            }
        } else {
            const int hc0 = (pn - 7) * 256;
#pragma unroll
            for (int ai = 0; ai < 2; ++ai)
#pragma unroll
                for (int m = 0; m < 4; ++m) {
                    const int r = row0 + ai * 128 + m * 16;
#pragma unroll
                    for (int bj = 0; bj < 2; ++bj)
#pragma unroll
                        for (int n = 0; n < 2; ++n) {
                            const int hc = hc0 + bj * 128 + wc * 32 + n * 16 + 4 * fq; const f32x4 v = acc[ai][bj][m][n];
                            if (isctx) *(u32x2*)((bf16_t*)(ws + WS_HYC) + (size_t)(r - NLAT) * 768 + hc) = (u32x2){pk2(v[0], v[1]), pk2(v[2], v[3])};
                            else { bf16_t* dst = (bf16_t*)(ws + WS_HYT) + ((size_t)(r >> 14) * 768 + hc) * S + (r & (S - 1));
#pragma unroll
                                for (int j = 0; j < 4; ++j) dst[(size_t)j * S] = f2bf(v[j]); }
                        }
                }
        }
    }
};

struct EpiOut {
    const float* xl_in; const float* xc_in; bf16_t* xb; const float* mod; bool from_inputs;
    DI void operator()(const AccT& acc, const pg8::Unit& u, int wr, int wc, int fr, int fq) const {
        const int row0 = u.pm * 256 + wr * 64 + fr; const bool isctx = (u.pm >= NLAT / 256);
        const int v = isctx ? 2 : (u.pm / (S / 256));
        const float* g1 = mod + (size_t)v * 6144 + 2 * 1024;
        const float* so = isctx ? xc_in - (size_t)NLAT * D : xl_in;
#pragma unroll
        for (int bj = 0; bj < 2; ++bj) {
            const int c = u.pn * 256 + bj * 128 + wc * 32 + 8 * fq;
            const f32x4 ga = *(const f32x4*)(g1 + c), gb = *(const f32x4*)(g1 + c + 4);
#pragma unroll
            for (int ai = 0; ai < 2; ++ai)
#pragma unroll
                for (int m = 0; m < 4; ++m) {
                    const size_t o = (size_t)(row0 + ai * 128 + m * 16) * D + c;
                    f32x4 xa, xb_;
                    if (from_inputs) { xa = *(const f32x4*)(so + o); xb_ = *(const f32x4*)(so + o + 4); }
                    else { const u32x4 t = *(const u32x4*)(xb + o); xa = bf4_to_f4((u32x2){t[0], t[1]}); xb_ = bf4_to_f4((u32x2){t[2], t[3]}); }
                    const f32x4 na = xa + ga * acc[ai][bj][m][0], nb = xb_ + gb * acc[ai][bj][m][1];
                    *(u32x4*)(xb + o) = (u32x4){pk2(na[0], na[1]), pk2(na[2], na[3]), pk2(nb[0], nb[1]), pk2(nb[2], nb[3])};
                }
        }
    }
};

struct EpiMoe1 {
    bf16_t* hmid;
    DI void operator()(const AccT& acc, const pg8::Unit& u, int wr, int wc, int fr, int fq) const {
        const int row0 = u.pm * 256 + wr * 64 + fr;
#pragma unroll
        for (int ai = 0; ai < 2; ++ai)
#pragma unroll
            for (int m = 0; m < 4; ++m)
#pragma unroll
                for (int bj = 0; bj < 2; ++bj) {
                    const f32x4 a = acc[ai][bj][m][0], b = acc[ai][bj][m][1]; float h[4];
#pragma unroll
                    for (int j = 0; j < 4; ++j) h[j] = siluf(a[j]) * b[j];
                    *(u32x2*)(hmid + (size_t)(row0 + ai * 128 + m * 16) * DE + (u.pn * 256 + bj * 128 + wc * 32) / 2 + 4 * fq) = (u32x2){pk2(h[0], h[1]), pk2(h[2], h[3])};
                }
    }
};
struct EpiMoe2 {
    bf16_t* ys;
    DI void operator()(const AccT& acc, const pg8::Unit& u, int wr, int wc, int fr, int fq) const {
        const int row0 = u.pm * 256 + wr * 64 + fr;
#pragma unroll
        for (int ai = 0; ai < 2; ++ai)
#pragma unroll
            for (int m = 0; m < 4; ++m)
#pragma unroll
                for (int bj = 0; bj < 2; ++bj)
                    { const f32x4 v = acc[ai][bj][m][0], w = acc[ai][bj][m][1];
                        *(u32x4*)(ys + (size_t)(row0 + ai * 128 + m * 16) * D + u.pn * 256 + bj * 128 + wc * 32 + 8 * fq) = (u32x4){pk2(v[0], v[1]), pk2(v[2], v[3]), pk2(w[0], w[1]), pk2(w[2], w[3])}; }
    }
};

struct TcTile { const float* src; bf16_t* dst; int N, k0, n0, ldd, mode; };
DI TcTile tconv_desc(const Frame& F, int u) {
    const int T_IN = 16 * 40, T_OUT = 16 * 16, T_E = 16 * 8;
    const int per_layer = T_IN + T_OUT + NE * 3 * T_E;
    const int li = u / per_layer; int r = u % per_layer; TcTile t;
    if (r < T_IN) { t.src = F.in[I_WIN] + (size_t)li * D * DIN; t.N = DIN; t.k0 = (r / 40) * 64; t.n0 = (r % 40) * 64; t.dst = WSP(bf16_t, WS_WIN) + (size_t)li * DIN * D; t.ldd = D; t.mode = 0; return t; }
    r -= T_IN;
    if (r < T_OUT) { t.src = F.in[I_WOUT] + (size_t)li * D * D; t.N = D; t.k0 = (r / 16) * 64; t.n0 = (r % 16) * 64; t.dst = WSP(bf16_t, WS_WOUT) + (size_t)li * D * D; t.ldd = D; t.mode = 0; return t; }
    r -= T_OUT;
    const int e = r / (3 * T_E), w = (r / T_E) % 3, q = r % T_E;
    if (w < 2) { t.src = F.in[w == 0 ? I_MW1 : I_MW3] + ((size_t)li * NE + e) * D * DE; t.N = DE; t.k0 = (q / 8) * 64; t.n0 = (q % 8) * 64; t.dst = WSP(bf16_t, WS_W13) + ((size_t)li * NE + e) * 1024 * 1024; t.ldd = D; t.mode = 1 + w; }
    else { t.src = F.in[I_MW2] + ((size_t)li * NE + e) * DE * D; t.N = D; t.k0 = (q / 16) * 64; t.n0 = (q % 16) * 64; t.dst = WSP(bf16_t, WS_W2) + ((size_t)li * NE + e) * 1024 * 512; t.ldd = DE; t.mode = 0; }
    return t;
}
DI void phase_prologue(const Frame& F) {
    {
        const int total = 2 * (16 * 40 + 16 * 16 + NE * 3 * 16 * 8);
        float* tl = (float*)F.lds;
        float v[8];
        int u = F.bid;
        if (u < total) { const TcTile t = tconv_desc(F, u);
#pragma unroll
            for (int i = 0; i < 8; ++i) { const int idx = F.tid + 512 * i, k = idx >> 6, n = idx & 63; v[i] = t.src[(size_t)(t.k0 + k) * t.N + t.n0 + n]; } }
        for (; u < total; u += F.G) {
            const TcTile t = tconv_desc(F, u);
            __syncthreads();
#pragma unroll
            for (int i = 0; i < 8; ++i) { const int idx = F.tid + 512 * i, k = idx >> 6, n = idx & 63; tl[k * 65 + n] = v[i]; }
            __syncthreads();
            if (u + F.G < total) { const TcTile tn = tconv_desc(F, u + F.G);
#pragma unroll
                for (int i = 0; i < 8; ++i) { const int idx = F.tid + 512 * i, k = idx >> 6, n = idx & 63; v[i] = tn.src[(size_t)(tn.k0 + k) * tn.N + tn.n0 + n]; } }
#pragma unroll
            for (int i = 0; i < 4; ++i) { const int idx = F.tid + 512 * i, n = idx >> 5, kp = idx & 31;
                const int nn = t.n0 + n; const int row = (t.mode == 0) ? nn : ((nn >> 4) * 32 + (t.mode - 1) * 16 + (nn & 15));
                *(unsigned*)(t.dst + (size_t)row * t.ldd + t.k0 + 2 * kp) = pk2(tl[(2 * kp) * 65 + n], tl[(2 * kp + 1) * 65 + n]); }
        }
    }
    __syncthreads();
    {
        float* sc = (float*)F.lds;
        float* red = sc + 3072;
        { float xv[6];
#pragma unroll
          for (int q = 0; q < 6; ++q) { const int i = F.tid + NTHR * q, v = i >> 10, k = i & 1023; xv[q] = (v < 2) ? F.in[I_C][v * 1024 + k] : F.in[I_CCTX][k]; }
#pragma unroll
          for (int q = 0; q < 6; ++q) sc[F.tid + NTHR * q] = siluf(xv[q]); }
        __syncthreads();
        for (int u = F.bid; u < 2 * 96; u += F.G) {
            const int li = u / 96, j = (u % 96) * 64 + F.lane, ko = F.wave;
            const float* w = F.in[I_ADAW] + (size_t)li * D * 6144 + j;
            float a0 = 0.f, a1 = 0.f, a2 = 0.f;
            for (int k = ko * 128; k < ko * 128 + 128; ++k) { const float wv = w[(size_t)k * 6144]; a0 += sc[k] * wv; a1 += sc[1024 + k] * wv; a2 += sc[2048 + k] * wv; }
            red[(ko * 3 + 0) * 64 + F.lane] = a0; red[(ko * 3 + 1) * 64 + F.lane] = a1; red[(ko * 3 + 2) * 64 + F.lane] = a2;
            __syncthreads();
            if (F.tid < 192) { const int v = F.tid / 64, l = F.tid % 64; float s = 0.f;
#pragma unroll
                for (int q = 0; q < 8; ++q) s += red[(q * 3 + v) * 64 + l];
                const int jj = (u % 96) * 64 + l;
                WSP(float, WS_MOD)[((size_t)li * 3 + v) * 6144 + jj] = s + F.in[I_ADAB][li * 6144 + jj]; }
            __syncthreads();
        }
    }
    if (F.bid == (F.G > 2 ? 2 : 0)) {
        for (int idx = F.tid; idx < 2 * 4 * 64 * 64; idx += NTHR) { const int i = idx & 63, j = (idx >> 6) & 63, lg = idx >> 12;
            WSP(bf16_t, WS_PWT)[idx] = f2bf(F.in[I_POOLW][((size_t)lg * 64 + i) * 64 + j]); }
    }
    if (F.bid == (F.G > 1 ? 1 : 0)) {
        for (int i = F.tid; i < 256 * 8; i += NTHR) { const int pos = i >> 3, f = i & 7; const float inv = exp2f(-(float)f * (13.287712379549449f / 8.f)); const float rev = (float)pos * inv * 0.15915494309189535f;
            WSP(float, WS_ROPE)[i * 2] = cos_rev(rev); WSP(float, WS_ROPE)[i * 2 + 1] = sin_rev(rev); }
    }
}

#define MFMA32(a, b, c) __builtin_amdgcn_mfma_f32_32x32x16_bf16((a), (b), (c), 0, 0, 0)
DI void filter_tile(const Frame& F, int li, int L, int tile, _Float16* hT, float* part) {
    float* h1s = (float*)F.lds;
    float* h2s = h1s + 64 * 65;
    float* w1s = h2s + 64 * 68;
    float* w2s = w1s + 34 * 64;
    const float* w3 = F.in[I_HW3] + (size_t)li * 64 * 1024; const float* b3 = F.in[I_HB3] + li * 1024;
    const int t0 = tile * 64;
    const float inv_lm1 = 1.f / (float)(L > 1 ? L - 1 : 1);
    __syncthreads();
    {
        const float* w1 = F.in[I_HW1] + (size_t)li * 33 * 64; const float* b1 = F.in[I_HB1] + li * 64;
        const float* w2 = F.in[I_HW2] + (size_t)li * 64 * 64; const float* b2 = F.in[I_HB2] + li * 64;
        float t1[5], t2[8];
#pragma unroll
        for (int q = 0; q < 5; ++q) { const int i = F.tid + NTHR * q; t1[q] = w1[i < 33 * 64 ? i : 0]; }
#pragma unroll
        for (int q = 0; q < 8; ++q) t2[q] = w2[F.tid + NTHR * q];
#pragma unroll
        for (int q = 0; q < 5; ++q) { const int i = F.tid + NTHR * q; if (i < 33 * 64) w1s[i] = t1[q]; }
#pragma unroll
        for (int q = 0; q < 8; ++q) w2s[F.tid + NTHR * q] = t2[q];
        if (F.tid < 64) { w1s[33 * 64 + F.tid] = b1[F.tid]; w2s[4096 + F.tid] = b2[F.tid]; }
    }
    __syncthreads();
    {
        const int tl = F.tid & 63, pt = F.tid >> 6; const float t = (float)(t0 + tl);
        float a[8];
#pragma unroll
        for (int jj = 0; jj < 8; ++jj) a[jj] = w1s[33 * 64 + pt * 8 + jj] + (t * inv_lm1) * w1s[pt * 8 + jj];
#pragma unroll 2
        for (int i = 0; i < 16; ++i) { const float band = 1e-4f + (15.f - 1e-4f) * ((float)i * (1.f / 15.f)); const float rev = t * band * (1.f / (float)L); const float cz = cos_rev(rev), sz = sin_rev(rev);
#pragma unroll
            for (int jj = 0; jj < 8; ++jj) a[jj] += cz * w1s[(1 + i) * 64 + pt * 8 + jj] + sz * w1s[(17 + i) * 64 + pt * 8 + jj]; }
#pragma unroll
        for (int jj = 0; jj < 8; ++jj) h1s[tl * 65 + pt * 8 + jj] = sin_rad(a[jj]);
    }
    __syncthreads();
    {
        const int tl = F.tid & 63, pt = F.tid >> 6;
        float a[8];
#pragma unroll
        for (int jj = 0; jj < 8; ++jj) a[jj] = w2s[4096 + pt * 8 + jj];
#pragma unroll 4
        for (int i = 0; i < 64; ++i) { const float hv = h1s[tl * 65 + i];
#pragma unroll
            for (int jj = 0; jj < 8; ++jj) a[jj] += hv * w2s[i * 64 + pt * 8 + jj]; }
#pragma unroll
        for (int jj = 0; jj < 8; ++jj) h2s[tl * 68 + pt * 8 + jj] = sin_rad(a[jj]);
    }
    __syncthreads();
    {
        const int l31 = F.lane & 31, kg = F.lane >> 5;
        auto split8 = [](const float (&x)[8], bf16x8& hi, bf16x8& lo) {
            u32x4 h, l;
#pragma unroll
            for (int e = 0; e < 4; ++e) { const unsigned hp = pk2(x[2 * e], x[2 * e + 1]); h[e] = hp;
                l[e] = pk2(x[2 * e] - __uint_as_float(hp << 16), x[2 * e + 1] - __uint_as_float(hp & 0xffff0000u)); }
            hi = __builtin_bit_cast(bf16x8, h); lo = __builtin_bit_cast(bf16x8, l); };
        bf16x8 Bh[2][4], Bl[2][4];
#pragma unroll
        for (int pb = 0; pb < 2; ++pb)
#pragma unroll
            for (int ks = 0; ks < 4; ++ks) { const float* hp = h2s + (pb * 32 + l31) * 68 + ks * 16 + kg * 8; const f32x4 x0 = *(const f32x4*)hp, x1 = *(const f32x4*)(hp + 4);
                const float x[8] = {x0[0], x0[1], x0[2], x0[3], x1[0], x1[1], x1[2], x1[3]}; split8(x, Bh[pb][ks], Bl[pb][ks]); }
        const float tn0 = (float)(t0 + l31) * inv_lm1, tn1 = (float)(t0 + 32 + l31) * inv_lm1;
        const bool b4 = (l31 & 16) != 0, b3q = (l31 & 8) != 0, b2 = (l31 & 4) != 0, b1q = (l31 & 2) != 0;
#pragma unroll 1
        for (int cb = 0; cb < 4; ++cb) {
            const int ch0 = F.wave * 128 + cb * 32;
            f32x16 acc0, acc1;
#pragma unroll
            for (int i = 0; i < 16; ++i) { acc0[i] = 0.f; acc1[i] = 0.f; }
#pragma unroll
            for (int ks = 0; ks < 4; ++ks) {
                float x[8];
#pragma unroll
                for (int e = 0; e < 8; ++e) x[e] = w3[(size_t)(ks * 16 + kg * 8 + e) * 1024 + ch0 + l31];
                bf16x8 Ah, Al; split8(x, Ah, Al);
                acc0 = MFMA32(Ah, Bh[0][ks], acc0); acc1 = MFMA32(Ah, Bh[1][ks], acc1);
                acc0 = MFMA32(Al, Bh[0][ks], acc0); acc1 = MFMA32(Al, Bh[1][ks], acc1);
                acc0 = MFMA32(Ah, Bl[0][ks], acc0); acc1 = MFMA32(Ah, Bl[1][ks], acc1);
            }
            float sq[16];
#pragma unroll
            for (int i = 0; i < 16; ++i) {
                const int ch = ch0 + 8 * (i >> 2) + 4 * kg + (i & 3);
                const float bb = b3[ch], delta = (3.0701134573253945f + (15.350567286626973f - 3.0701134573253945f) * ((float)(ch & 255) * (1.f / 255.f))) * 1.4426950408889634f;
                const float v0 = (acc0[i] + bb) * __builtin_amdgcn_exp2f(-tn0 * delta), v1 = (acc1[i] + bb) * __builtin_amdgcn_exp2f(-tn1 * delta);
                _Float16* hp = hT + (size_t)ch * L + t0 + l31; hp[0] = (_Float16)v0; hp[32] = (_Float16)v1;
                sq[i] = v0 * v0 + v1 * v1;
            }
            float a8[8], a4[4], a2[2];
#pragma unroll
            for (int e = 0; e < 8; ++e) { const float keep = b4 ? sq[e + 8] : sq[e], send = b4 ? sq[e] : sq[e + 8]; a8[e] = keep + swz_xor<16>(send); }
#pragma unroll
            for (int e = 0; e < 4; ++e) { const float keep = b3q ? a8[e + 4] : a8[e], send = b3q ? a8[e] : a8[e + 4]; a4[e] = keep + swz_xor<8>(send); }
#pragma unroll
            for (int e = 0; e < 2; ++e) { const float keep = b2 ? a4[e + 2] : a4[e], send = b2 ? a4[e] : a4[e + 2]; a2[e] = keep + swz_xor<4>(send); }
            float a1 = (b1q ? a2[1] : a2[0]) + swz_xor<2>(b1q ? a2[0] : a2[1]);
            a1 += swz_xor<1>(a1);
            const int rg = (b4 ? 8 : 0) + (b3q ? 4 : 0) + (b2 ? 2 : 0) + (b1q ? 1 : 0);
            if ((l31 & 1) == 0) part[(size_t)tile * 1024 + ch0 + 8 * (rg >> 2) + 4 * kg + (rg & 3)] = a1;
        }
    }
}

struct TokInfo { unsigned e0, e1, p0, p1; float g0, g1; unsigned s0, s1; };
template <int NP> DI void phase_norm1(const Frame& F, int li, int mode) {
    const int nrows = (mode == 2) ? NLAT : NTOK;
    const float* modp = WSP(float, WS_MOD) + (size_t)li * 3 * 6144;
    const float* modprev = WSP(float, WS_MOD) + (size_t)(mode == 2 ? 1 : li - 1) * 3 * 6144;
    const float* gam = (mode == 2) ? F.in[I_FG] : F.in[I_N1G] + (size_t)li * D;
    const TokInfo* tok = WSP(TokInfo, WS_TOK); const bf16_t* ys = WSP(bf16_t, WS_A1);
    bf16_t* hbf = WSP(bf16_t, WS_HBF);
    bf16_t* xbuf = WSP(bf16_t, WS_XB);
    struct F8 { f32x4 a, b; };
    auto bf8 = [](u32x4 t) -> F8 { F8 o; o.a = bf4_to_f4((u32x2){t[0], t[1]}); o.b = bf4_to_f4((u32x2){t[2], t[3]}); return o; };
    auto ldx = [&](int r, int i) -> F8 {
        if (mode == 0) { const float* q = (r >= NLAT ? F.in[I_CTX] + (size_t)(r - NLAT) * D : F.in[I_X] + (size_t)r * D) + i * 512 + F.lane * 8; F8 o; o.a = *(const f32x4*)q; o.b = *(const f32x4*)(q + 4); return o; }
        return bf8(*(const u32x4*)(xbuf + (size_t)r * D + i * 512 + F.lane * 8)); };
    const int r0 = F.bid * 8 + F.wave, rstep = F.G * 8, lc = F.lane * 8;
    F8 xn[NP][2]; u32x4 yan[NP][2], ybn[NP][2]; float tg0[NP], tg1[NP]; unsigned ts0[NP], ts1[NP];
    float ug0[NP], ug1[NP]; unsigned us0[NP], us1[NP];
    const int pstep = NP * rstep;
#pragma unroll
    for (int p = 0; p < NP; ++p) {
        const int r = r0 + p * rstep;
        tg0[p] = tg1[p] = ug0[p] = ug1[p] = 0.f; ts0[p] = ts1[p] = us0[p] = us1[p] = 0u;
        if (r < nrows) {
#pragma unroll
            for (int i = 0; i < 2; ++i) xn[p][i] = ldx(r, i);
            if (mode != 0) { const TokInfo t = tok[r]; tg0[p] = t.g0; tg1[p] = t.g1; ts0[p] = t.s0; ts1[p] = t.s1;
                if (r + pstep < nrows) { const TokInfo t2 = tok[r + pstep]; ug0[p] = t2.g0; ug1[p] = t2.g1; us0[p] = t2.s0; us1[p] = t2.s1; }
#pragma unroll
                for (int i = 0; i < 2; ++i) { yan[p][i] = *(const u32x4*)(ys + (size_t)ts0[p] * D + i * 512 + lc); ybn[p][i] = *(const u32x4*)(ys + (size_t)ts1[p] * D + i * 512 + lc); } }
        }
    }
    for (int rb = r0; rb < nrows; rb += pstep) {
#pragma unroll
        for (int p = 0; p < NP; ++p) {
            const int r = rb + p * rstep;
            if (r >= nrows) continue;
            const bool isctx = r >= NLAT; const int v = isctx ? 2 : (r >> 14);
            F8 x[2]; u32x4 ya[2], yb[2]; const float g0 = tg0[p], g1 = tg1[p];
#pragma unroll
            for (int i = 0; i < 2; ++i) { x[i] = xn[p][i]; ya[i] = yan[p][i]; yb[i] = ybn[p][i]; }
            if (r + pstep < nrows) {
#pragma unroll
                for (int i = 0; i < 2; ++i) xn[p][i] = ldx(r + pstep, i);
                if (mode != 0) { tg0[p] = ug0[p]; tg1[p] = ug1[p]; ts0[p] = us0[p]; ts1[p] = us1[p];
                    if (r + 2 * pstep < nrows) { const TokInfo t2 = tok[r + 2 * pstep]; ug0[p] = t2.g0; ug1[p] = t2.g1; us0[p] = t2.s0; us1[p] = t2.s1; }
#pragma unroll
                    for (int i = 0; i < 2; ++i) { yan[p][i] = *(const u32x4*)(ys + (size_t)ts0[p] * D + i * 512 + lc); ybn[p][i] = *(const u32x4*)(ys + (size_t)ts1[p] * D + i * 512 + lc); } }
            }
            if (mode != 0) {
                const float* g2 = modprev + (size_t)v * 6144 + 5 * 1024;
#pragma unroll
                for (int i = 0; i < 2; ++i) {
                    const F8 a = bf8(ya[i]), b = bf8(yb[i]);
                    const f32x4 ga = *(const f32x4*)(g2 + i * 512 + lc), gb = *(const f32x4*)(g2 + i * 512 + lc + 4);
                    x[i].a = x[i].a + ga * (a.a * g0 + b.a * g1); x[i].b = x[i].b + gb * (a.b * g0 + b.b * g1);
                }
                if (mode == 1) {
#pragma unroll
                    for (int i = 0; i < 2; ++i) *(u32x4*)(xbuf + (size_t)r * D + i * 512 + lc) = (u32x4){pk2(x[i].a[0], x[i].a[1]), pk2(x[i].a[2], x[i].a[3]), pk2(x[i].b[0], x[i].b[1]), pk2(x[i].b[2], x[i].b[3])}; }
            }
            float ss = 0.f;
#pragma unroll
            for (int i = 0; i < 2; ++i) ss += x[i].a[0] * x[i].a[0] + x[i].a[1] * x[i].a[1] + x[i].a[2] * x[i].a[2] + x[i].a[3] * x[i].a[3] + x[i].b[0] * x[i].b[0] + x[i].b[1] * x[i].b[1] + x[i].b[2] * x[i].b[2] + x[i].b[3] * x[i].b[3];
            ss = wave_sum(ss);
            const float rstd = rsqrtf(ss * (1.f / D) + EPS);
#pragma unroll
            for (int i = 0; i < 2; ++i) {
                const int c = i * 512 + lc;
                const f32x4 ga = *(const f32x4*)(gam + c), gb = *(const f32x4*)(gam + c + 4);
                if (mode == 2) { *(f32x4*)(F.out + (size_t)r * D + c) = x[i].a * rstd * ga; *(f32x4*)(F.out + (size_t)r * D + c + 4) = x[i].b * rstd * gb; }
                else {
                    const float* mp = modp + (size_t)v * 6144 + c;
                    const f32x4 ha = x[i].a * rstd * ga * (*(const f32x4*)(mp + 1024) + 1.f) + *(const f32x4*)mp, hb = x[i].b * rstd * gb * (*(const f32x4*)(mp + 1028) + 1.f) + *(const f32x4*)(mp + 4);
                    *(u32x4*)(hbf + (size_t)r * D + c) = (u32x4){pk2(ha[0], ha[1]), pk2(ha[2], ha[3]), pk2(hb[0], hb[1]), pk2(hb[2], hb[3])};
                }
            }
        }
    }
}

struct Route { int e0, e1; float g0, g1; };
DI Route route_select(const float (&lg)[16], const float* rb) {
    float mx = lg[0];
#pragma unroll
    for (int e = 1; e < 16; ++e) mx = fmaxf(mx, lg[e]);
    float sc[16], sel[16], den = 0.f;
#pragma unroll
    for (int e = 0; e < 16; ++e) { sc[e] = __expf(lg[e] - mx); den += sc[e]; }
    const float rden = 1.f / den;
#pragma unroll
    for (int e = 0; e < 16; ++e) { sc[e] *= rden; sel[e] = sc[e] + rb[e]; }
    int bg = 0; float bgs = -1e30f;
#pragma unroll
    for (int g = 0; g < 4; ++g) {
        float m1 = -1e30f, m2 = -1e30f;
#pragma unroll
        for (int q = 0; q < 4; ++q) { const float s = sel[g * 4 + q]; if (s > m1) { m2 = m1; m1 = s; } else if (s > m2) m2 = s; }
        const float gs = m1 + m2; if (gs > bgs) { bgs = gs; bg = g; }
    }
    int e0 = 0, e1 = 0; float s0v = -1e30f, s1v = -1e30f, w0 = 0.f, w1 = 0.f;
#pragma unroll
    for (int e = 0; e < 16; ++e) {
        const bool ing = (e >> 2) == bg; const float s = sel[e];
        if (ing && s > s0v) { s1v = s0v; e1 = e0; w1 = w0; s0v = s; e0 = e; w0 = sc[e]; }
        else if (ing && s > s1v) { s1v = s; e1 = e; w1 = sc[e]; }
    }
    const float ws = 1.f / (w0 + w1); Route R; R.e0 = e0; R.e1 = e1; R.g0 = w0 * ws; R.g1 = w1 * ws; return R;
}
DI void norm2_rows_valu(const Frame& F, int li, int r_first, int rstep, int r_end, const float* wt, unsigned* lcnt) {
    const float* modp = WSP(float, WS_MOD) + (size_t)li * 3 * 6144;
    const float* gam = F.in[I_N2G] + (size_t)li * D;
    bf16_t* hbf = WSP(bf16_t, WS_HBF); TokInfo* tok = WSP(TokInfo, WS_TOK);
    const bf16_t* xbuf = WSP(bf16_t, WS_XB);
    const bool b2 = (F.lane & 4) != 0, b3 = (F.lane & 8) != 0, b4 = (F.lane & 16) != 0;
    for (int r = r_first; r < r_end; r += rstep) {
        const bool isctx = r >= NLAT; const int v = isctx ? 2 : (r >> 14);
        f32x4 x[4]; float ss = 0.f;
#pragma unroll
        for (int i = 0; i < 4; ++i) { x[i] = ld_bf4(xbuf + (size_t)r * D + i * 256 + F.lane * 4); ss += x[i][0] * x[i][0] + x[i][1] * x[i][1] + x[i][2] * x[i][2] + x[i][3] * x[i][3]; }
        ss = wave_sum(ss);
        const float rstd = rsqrtf(ss * (1.f / D) + EPS);
        float lg[16];
#pragma unroll
        for (int e = 0; e < 16; ++e) lg[e] = 0.f;
#pragma unroll
        for (int i = 0; i < 4; ++i) {
            const int c = i * 256 + F.lane * 4;
            const f32x4 g = *(const f32x4*)(gam + c), sh = *(const f32x4*)(modp + (size_t)v * 6144 + 3 * 1024 + c), sc = *(const f32x4*)(modp + (size_t)v * 6144 + 4 * 1024 + c);
            const f32x4 h = x[i] * rstd * g * (sc + 1.f) + sh;
            *(u32x2*)(hbf + (size_t)r * D + c) = (u32x2){pk2(h[0], h[1]), pk2(h[2], h[3])};
#pragma unroll
            for (int e = 0; e < 16; ++e) { const f32x4 w = *(const f32x4*)(wt + e * 1024 + c); lg[e] += h[0] * w[0] + h[1] * w[1] + h[2] * w[2] + h[3] * w[3]; }
        }
        float a8[8], a4[4], a2[2];
#pragma unroll
        for (int e = 0; e < 8; ++e) { const auto rr = __builtin_amdgcn_permlane32_swap(__float_as_uint(lg[e]), __float_as_uint(lg[e + 8]), false, false); a8[e] = __uint_as_float(rr[0]) + __uint_as_float(rr[1]); }
#pragma unroll
        for (int e = 0; e < 4; ++e) { const float keep = b4 ? a8[e + 4] : a8[e], send = b4 ? a8[e] : a8[e + 4]; a4[e] = keep + swz_xor<16>(send); }
#pragma unroll
        for (int e = 0; e < 2; ++e) { const float keep = b3 ? a4[e + 2] : a4[e], send = b3 ? a4[e] : a4[e + 2]; a2[e] = keep + swz_xor<8>(send); }
        float a1 = (b2 ? a2[1] : a2[0]) + swz_xor<4>(b2 ? a2[0] : a2[1]);
        a1 += swz_xor<2>(a1); a1 += swz_xor<1>(a1);
#pragma unroll
        for (int e = 0; e < 16; ++e) lg[e] = __int_as_float(__builtin_amdgcn_readlane(__float_as_int(a1), 4 * e));
        const Route R = route_select(lg, F.in[I_RB]);
        if (F.lane == 0) {
            TokInfo ti; ti.e0 = R.e0; ti.e1 = R.e1; ti.p0 = atomicAdd(lcnt + R.e0, 1u); ti.p1 = atomicAdd(lcnt + R.e1, 1u);
            ti.g0 = R.g0; ti.g1 = R.g1; ti.s0 = 0; ti.s1 = 0;
            tok[r] = ti;
        }
    }
}
DI void phase_norm2(const Frame& F, int li, int nrows) {
    float* wp = (float*)F.lds;
    float* cvec = wp + 16384;
    float* cred = cvec + 16;
    float* lgs = cred + 512 + F.wave * (16 * 17);
    float* gsl = cred + 512; float* shl = gsl + 1024;
    float* wt = cred + 512 + 8 * 16 * 17;
    unsigned* lcnt = (unsigned*)(F.lds + LDS_MISC + 64);
    const int v = F.bid & 1, nb2 = F.G >> 1;
    const float* modp = WSP(float, WS_MOD) + (size_t)li * 3 * 6144 + (size_t)v * 6144;
    const float* gam = F.in[I_N2G] + (size_t)li * D;
    for (int c = F.bid; c < SLOT_CAP / NTHR; c += F.G) WSP(int, WS_RMAP)[c * NTHR + F.tid] = 0;
    __syncthreads();
    {
        float wv[32];
#pragma unroll
        for (int j = 0; j < 32; ++j) wv[j] = F.in[I_RW][F.tid + 512 * j];
#pragma unroll
        for (int q = 0; q < 2; ++q) { const int k = F.tid + 512 * q; gsl[k] = gam[k] * (modp[4 * 1024 + k] + 1.f); shl[k] = modp[3 * 1024 + k]; }
        if (F.tid < 16) lcnt[F.tid] = 0u;
        __syncthreads();
        const int e = F.tid & 15; float a = 0.f;
#pragma unroll
        for (int j = 0; j < 32; ++j) { const int k = (F.tid >> 4) + 32 * j;
            wp[(((k >> 5) * 4 + ((k >> 3) & 3)) * 16 + e) * 8 + (k & 7)] = wv[j] * gsl[k];
            if (nrows > NLAT) wt[e * 1024 + k] = wv[j];
            a += shl[k] * wv[j]; }
        cred[(F.tid >> 4) * 16 + e] = a;
    }
    __syncthreads();
    if (F.tid < 16) { float a = 0.f; for (int q = 0; q < 32; ++q) a += cred[q * 16 + F.tid]; cvec[F.tid] = a; }
    __syncthreads();
    bf16_t* hbf = WSP(bf16_t, WS_HBF); TokInfo* tok = WSP(TokInfo, WS_TOK);
    const int i16 = F.lane & 15, kq = F.lane >> 4;
    if (F.bid < 2 * nb2)
    for (int gl = (F.bid >> 1) * 8 + F.wave; gl < S / 16; gl += nb2 * 8) {
        const int row0 = v * S + gl * 16;
        const bf16_t* xr = WSP(bf16_t, WS_XB) + (size_t)(row0 + i16) * D + 8 * kq;
        const float* wl = wp + (kq * 16 + i16) * 8;
        f32x4 acc = (f32x4){0.f, 0.f, 0.f, 0.f}; float ss = 0.f;
        u32x4 xa[8], xb[8];
#pragma unroll
        for (int q = 0; q < 8; ++q) xa[q] = *(const u32x4*)(xr + 32 * q);
#define N2_BATCH(cur, nxt, s0) do { \
            if ((s0) + 8 < 32) { _Pragma("unroll") for (int q = 0; q < 8; ++q) nxt[q] = *(const u32x4*)(xr + 32 * ((s0) + 8 + q)); } \
            _Pragma("unroll") for (int q = 0; q < 8; ++q) { const f32x4 x0 = bf4_to_f4((u32x2){cur[q][0], cur[q][1]}), x1 = bf4_to_f4((u32x2){cur[q][2], cur[q][3]}); \
                const f32x4 w0 = *(const f32x4*)(wl + ((s0) + q) * 512), w1 = *(const f32x4*)(wl + ((s0) + q) * 512 + 4); \
                ss += x0[0] * x0[0] + x0[1] * x0[1] + x0[2] * x0[2] + x0[3] * x0[3] + x1[0] * x1[0] + x1[1] * x1[1] + x1[2] * x1[2] + x1[3] * x1[3]; \
                _Pragma("unroll") for (int t = 0; t < 4; ++t) acc = __builtin_amdgcn_mfma_f32_16x16x4f32(x0[t], w0[t], acc, 0, 0, 0); \
                _Pragma("unroll") for (int t = 0; t < 4; ++t) acc = __builtin_amdgcn_mfma_f32_16x16x4f32(x1[t], w1[t], acc, 0, 0, 0); } } while (0)
#pragma unroll 1
        for (int s0 = 0; s0 < 32; s0 += 16) { N2_BATCH(xa, xb, s0); N2_BATCH(xb, xa, s0 + 8); }
#undef N2_BATCH
        ss += swz_xor<16>(ss); ss = half_sum(ss);
        const float rstd = rsqrtf(ss * (1.f / D) + EPS);
#pragma unroll
        for (int r = 0; r < 4; ++r) lgs[(4 * kq + r) * 17 + i16] = acc[r];
        asm volatile("s_waitcnt lgkmcnt(0)" ::: "memory");
        float lg[16];
#pragma unroll
        for (int e = 0; e < 16; ++e) lg[e] = lgs[i16 * 17 + e] * rstd + cvec[e];
        asm volatile("s_waitcnt lgkmcnt(0)" ::: "memory");
        const Route R = route_select(lg, F.in[I_RB]);
        if (F.lane < 16) {
            TokInfo ti; ti.e0 = R.e0; ti.e1 = R.e1; ti.p0 = atomicAdd(lcnt + R.e0, 1u); ti.p1 = atomicAdd(lcnt + R.e1, 1u);
            ti.g0 = R.g0; ti.g1 = R.g1; ti.s0 = 0; ti.s1 = 0;
            tok[row0 + F.lane] = ti;
        }
        float rj[16];
#pragma unroll
        for (int j = 0; j < 16; ++j) rj[j] = __int_as_float(__builtin_amdgcn_readlane(__float_as_int(rstd), j));
#pragma unroll 1
        for (int i = 0; i < 2; ++i) {
            const int c = i * 512 + F.lane * 8;
            const f32x4 gsa = *(const f32x4*)(gam + c) * (*(const f32x4*)(modp + 4 * 1024 + c) + 1.f), gsb = *(const f32x4*)(gam + c + 4) * (*(const f32x4*)(modp + 4 * 1024 + c + 4) + 1.f);
            const f32x4 sha = *(const f32x4*)(modp + 3 * 1024 + c), shb = *(const f32x4*)(modp + 3 * 1024 + c + 4);
            u32x4 x[16];
#pragma unroll
            for (int j = 0; j < 16; ++j) x[j] = *(const u32x4*)(WSP(bf16_t, WS_XB) + (size_t)(row0 + j) * D + c);
#pragma unroll
            for (int j = 0; j < 16; ++j) { const f32x4 ha = bf4_to_f4((u32x2){x[j][0], x[j][1]}) * rj[j] * gsa + sha, hb = bf4_to_f4((u32x2){x[j][2], x[j][3]}) * rj[j] * gsb + shb;
                *(u32x4*)(hbf + (size_t)(row0 + j) * D + c) = (u32x4){pk2(ha[0], ha[1]), pk2(ha[2], ha[3]), pk2(hb[0], hb[1]), pk2(hb[2], hb[3])}; }
        }
    }
    if (nrows > NLAT) norm2_rows_valu(F, li, NLAT + F.bid * 8 + F.wave, F.G * 8, nrows, wt, lcnt);
    __syncthreads();
    if (F.tid < 16) F.ctl[CW_BCNT + (li * MAXG + F.bid) * 16 + F.tid] = lcnt[F.tid];
}

DI void moe_offsets(const Frame& F, int li, int* offs) {
    __syncthreads();
    int* tot = offs + 376;
    int* part = (int*)F.lds;
    {
        const int e = F.tid & 15, pq = F.tid >> 4;
        const unsigned* bc = F.ctl + CW_BCNT + li * MAXG * 16 + e;
        int st = 0, sb = 0;
#pragma unroll
        for (int k = 0; k < 8; ++k) { const int blk = pq * 8 + k; const int c = (blk < F.G) ? (int)__hip_atomic_load(bc + blk * 16, __ATOMIC_RELAXED, __HIP_MEMORY_SCOPE_AGENT) : 0; st += c; sb += (blk < F.bid) ? c : 0; }
        part[pq * 16 + e] = st; part[512 + pq * 16 + e] = sb;
    }
    __syncthreads();
    if (F.tid < 32) { const int e = F.tid & 15, wb = F.tid >> 4; int s = 0;
        for (int pq = 0; pq < 32; ++pq) s += part[wb * 512 + pq * 16 + e];
        if (wb) offs[360 + e] = s; else tot[e] = s; }
    __syncthreads();
    if (F.tid == 0) { int o = 0; for (int e = 0; e < NE; ++e) { offs[e] = o; offs[17 + e] = o >> 8; o += (tot[e] + 255) & ~255; }
        offs[16] = o; offs[17 + 16] = o >> 8; }
    __syncthreads();
    for (int t = F.tid; t < SLOT_CAP / 256; t += NTHR) { int e = 0; for (int k = 1; k < NE; ++k) e += (offs[17 + k] <= t) ? 1 : 0; offs[40 + t] = e; }
    if (F.tid < 16) offs[360 + F.tid] += offs[F.tid];
    __syncthreads();
}
DI void phase_gather(const Frame& F, int li, int nrows) {
    int* offs = (int*)(F.lds + LDS_MISC + 64);
    moe_offsets(F, li, offs);
    TokInfo* tok = WSP(TokInfo, WS_TOK); int* rmap = WSP(int, WS_RMAP);
    auto place = [&](int r) {
        const TokInfo ti = tok[r];
        const unsigned s0 = offs[360 + ti.e0] + ti.p0, s1 = offs[360 + ti.e1] + ti.p1;
        rmap[s0] = r; rmap[s1] = r; tok[r].s0 = s0; tok[r].s1 = s1;
    };
    const int v = F.bid & 1, nb2 = F.G >> 1;
    if (F.bid < 2 * nb2)
        for (int gl = (F.bid >> 1) * 8 + F.wave; gl < S / 16; gl += nb2 * 8) if (F.lane < 16) place(v * S + gl * 16 + F.lane);
    if (nrows > NLAT) for (int r = NLAT + F.bid * 8 + F.wave; r < nrows; r += F.G * 8) if (F.lane == 0) place(r);
}

DI float lam_of(const Frame& F, int li, float& lam_init) {
    const float* lv = F.in[I_ALAM] + (size_t)li * 128;
    const int i = F.lane & 31, hi = F.lane >> 5;
    float d = lv[hi * 64 + i] * lv[hi * 64 + 32 + i];
    d += swz_xor<16>(d); d += swz_xor<8>(d); d += swz_xor<4>(d); d += swz_xor<2>(d); d += swz_xor<1>(d);
    const float d0 = __int_as_float(__builtin_amdgcn_readlane(__float_as_int(d), 0)), d1 = __int_as_float(__builtin_amdgcn_readlane(__float_as_int(d), 32));
    float lif = (float)li; asm volatile("" : "+v"(lif));
    lam_init = 0.8f - 0.6f * __expf(-0.3f * lif);
    return __expf(d0) - __expf(d1) + lam_init;
}
DI unsigned pk2t(float a, float b) { return __builtin_amdgcn_perm(__float_as_uint(b), __float_as_uint(a), 0x07060302u); }
DI bf16x8 pack8t(const f32x16& x, int s) {
    u32x4 p; p[0] = pk2t(x[8 * s], x[8 * s + 1]); p[1] = pk2t(x[8 * s + 2], x[8 * s + 3]); p[2] = pk2t(x[8 * s + 4], x[8 * s + 5]); p[3] = pk2t(x[8 * s + 6], x[8 * s + 7]);
    return __builtin_bit_cast(bf16x8, p);
}
DI bf16x8 pack8(const f32x16& x, int s) {
    u32x4 p; p[0] = pk2(x[8 * s], x[8 * s + 1]); p[1] = pk2(x[8 * s + 2], x[8 * s + 3]); p[2] = pk2(x[8 * s + 4], x[8 * s + 5]); p[3] = pk2(x[8 * s + 6], x[8 * s + 7]);
    return __builtin_bit_cast(bf16x8, p);
}

DI void diffattn_unit(const Frame& F, int li, int b, int h, size_t qrow0, int NT2) {
    const int lane = F.lane, r = lane & 31, hh = lane >> 5, c = F.wave & 1, g = F.wave >> 1;
    const bf16_t* AQ = WSP(bf16_t, WS_AQ); const bf16_t* AK = WSP(bf16_t, WS_AK); const bf16_t* AVT = WSP(bf16_t, WS_AVT) + (size_t)(b * 4 + h) * 64 * NKEY;
    float lam_init; const float lam = lam_of(F, li, lam_init);
    const size_t qrowA = qrow0 + g * 64 + r;
    bf16x8 qfA[2], qfB[2]; float qnA = 0.f, qnB = 0.f;
#pragma unroll
    for (int ks = 0; ks < 2; ++ks) { qfA[ks] = *(const bf16x8*)(AQ + qrowA * 256 + h * 64 + c * 32 + ks * 16 + 8 * hh); qfB[ks] = *(const bf16x8*)(AQ + (qrowA + 32) * 256 + h * 64 + c * 32 + ks * 16 + 8 * hh);
#pragma unroll
        for (int j = 0; j < 8; ++j) { const float va = bf2f((bf16_t)qfA[ks][j]), vb_ = bf2f((bf16_t)qfB[ks][j]); qnA += va * va; qnB += vb_ * vb_; } }
    f32x16 cinit;
    { const float qm = wave_max(fmaxf(half_sum(qnA), half_sum(qnB)));
      const float km = sqrtf(__uint_as_float(__hip_atomic_load(F.ctl + CW_KMAX + li * 16 + (b * 4 + h) * 2 + c, __ATOMIC_RELAXED, __HIP_MEMORY_SCOPE_AGENT)));
      const float cn = -(sqrtf(qm) * km * 1.02f + 1e-3f);
#pragma unroll
      for (int i = 0; i < 16; ++i) cinit[i] = cn; }
    f32x16 OA[2], OB[2]; f32x4 laccA, laccB;
    bf16x8 selv;
    { const unsigned one2 = (((lane & 15) < 8) == (((lane >> 4) & 1) == 0)) ? 0x3F803F80u : 0u; u32x4 t; t[0] = one2; t[1] = one2; t[2] = one2; t[3] = one2; selv = __builtin_bit_cast(bf16x8, t); }
#pragma unroll
    for (int i = 0; i < 16; ++i) { OA[0][i] = 0.f; OA[1][i] = 0.f; OB[0][i] = 0.f; OB[1][i] = 0.f; }
#pragma unroll
    for (int i = 0; i < 4; ++i) { laccA[i] = 0.f; laccB[i] = 0.f; }
    constexpr int KTB = 2 * 128 * 64, VTB = 64 * 256, STG = KTB + VTB;
    LAS unsigned char* Ll = (LAS unsigned char*)F.lds;
    unsigned char* L = F.lds;
    unsigned kgo[2], vgo[2];
#pragma unroll
    for (int i = 0; i < 2; ++i) { const int q = F.wave * 2 + i;
        const int key = (q & 7) * 16 + (lane >> 2), chunk = (lane & 3) ^ ((key >> 2) & 3);
        kgo[i] = (unsigned)key * 512u + (unsigned)(h * 64 + (q >> 3) * 32) * 2u + (unsigned)chunk * 16u;
        const int d = q * 4 + (lane >> 4), vch = (lane & 15) ^ (d & 15);
        vgo[i] = (unsigned)d * (unsigned)(NKEY * 2) + (unsigned)vch * 16u; }
    const unsigned ldsw = (unsigned)F.wave * 2048u;
#define DA_ISSUE(kt_, stg_) do { const int j0_ = (kt_) * 128; \
        const char* kg_ = (const char*)AK + (j0_ < CTX ? (size_t)NLAT + b * CTX + j0_ : (size_t)b * S + (j0_ - CTX)) * 512; const char* vg_ = (const char*)AVT + (size_t)j0_ * 2; \
        _Pragma("unroll") for (int i_ = 0; i_ < 2; ++i_) { \
            __builtin_amdgcn_global_load_lds((const unsigned*)(kg_ + kgo[i_]), (LAS unsigned*)(Ll + (stg_) * STG + ldsw + i_ * 1024), 16, 0, 0); \
            __builtin_amdgcn_global_load_lds((const unsigned*)(vg_ + vgo[i_]), (LAS unsigned*)(Ll + (stg_) * STG + KTB + ldsw + i_ * 1024), 16, 0, 0); } } while (0)
    __syncthreads();
    DA_ISSUE(0, 0);
    if (NT2 > 1) { DA_ISSUE(1, 1); asm volatile("s_waitcnt vmcnt(4)" ::: "memory"); } else asm volatile("s_waitcnt vmcnt(0)" ::: "memory");
    __builtin_amdgcn_s_barrier();
    const int ksw = (r >> 2) & 3;
    const int kr0 = c * 8192 + r * 64 + (((0 + hh) ^ ksw) * 16), kr1 = c * 8192 + r * 64 + (((2 + hh) ^ ksw) * 16);
    const int vlo0 = r * 256 + (((0 + hh) ^ (r & 3)) * 16), vlo1 = r * 256 + (((2 + hh) ^ (r & 3)) * 16), vrq = (r >> 2) & 3;
#define DA_LDK(st) do { k0 = *(const bf16x8*)(kb + (st) * 2048 + kr0); k1 = *(const bf16x8*)(kb + (st) * 2048 + kr1); } while (0)
#define DA_QK(Sx, qf) do { Sx = MFMA32(k0, qf[0], cinit); Sx = MFMA32(k1, qf[1], Sx); } while (0)
#define DA_LDV(st) do { const int vh_ = (((st) ^ vrq) & 3) * 64; _Pragma("unroll") for (int dh = 0; dh < 2; ++dh) { \
            vf[dh][0] = *(const bf16x8*)(vb + dh * (32 * 256) + vh_ + vlo0); vf[dh][1] = *(const bf16x8*)(vb + dh * (32 * 256) + vh_ + vlo1); } } while (0)
#define DA_PV(Sx, Ox, lx, QK0, QK1) do { \
        _Pragma("unroll") for (int i = 0; i < 4; ++i) Sx[i] = __builtin_amdgcn_exp2f(Sx[i]); \
        __builtin_amdgcn_sched_barrier(0); \
        QK0; QK1; \
        _Pragma("unroll") for (int i = 4; i < 8; ++i) Sx[i] = __builtin_amdgcn_exp2f(Sx[i]); \
        const bf16x8 p0 = pack8t(Sx, 0); \
        __builtin_amdgcn_sched_barrier(0); \
        Ox[0] = MFMA32(vf[0][0], p0, Ox[0]); Ox[1] = MFMA32(vf[1][0], p0, Ox[1]); \
        _Pragma("unroll") for (int i = 8; i < 12; ++i) Sx[i] = __builtin_amdgcn_exp2f(Sx[i]); \
        __builtin_amdgcn_sched_barrier(0); \
        lx = __builtin_amdgcn_mfma_f32_16x16x32_bf16(selv, p0, lx, 0, 0, 0); \
        _Pragma("unroll") for (int i = 12; i < 16; ++i) Sx[i] = __builtin_amdgcn_exp2f(Sx[i]); \
        const bf16x8 p1 = pack8t(Sx, 1); \
        __builtin_amdgcn_sched_barrier(0); \
        Ox[0] = MFMA32(vf[0][1], p1, Ox[0]); Ox[1] = MFMA32(vf[1][1], p1, Ox[1]); \
        lx = __builtin_amdgcn_mfma_f32_16x16x32_bf16(selv, p1, lx, 0, 0, 0); } while (0)
    if (F.wave >= 4) __builtin_amdgcn_s_setprio(1);
    int stg = 0;
#pragma unroll 1
    for (int kt = 0; kt < NT2; ++kt) {
        const bool more2 = kt + 2 < NT2;
        if (more2) { const int s2_ = stg >= 1 ? stg - 1 : 2; DA_ISSUE(kt + 2, s2_); }
        const unsigned char* kb = L + stg * STG; const unsigned char* vb = L + stg * STG + KTB;
        f32x16 SA, SB; bf16x8 k0, k1, vf[2][2];
        DA_LDK(0); DA_QK(SA, qfA);
#pragma unroll 2
        for (int st = 0; st < 4; ++st) {
            DA_LDV(st);
            DA_PV(SA, OA, laccA, SB = MFMA32(k0, qfB[0], cinit), SB = MFMA32(k1, qfB[1], SB));
            if (st < 3) DA_LDK(st + 1);
            DA_PV(SB, OB, laccB, if (st < 3) SA = MFMA32(k0, qfA[0], cinit), if (st < 3) SA = MFMA32(k1, qfA[1], SA));
        }
        if (more2) asm volatile("s_waitcnt vmcnt(4)" ::: "memory"); else asm volatile("s_waitcnt vmcnt(0)" ::: "memory");
        asm volatile("s_waitcnt lgkmcnt(0)" ::: "memory");
        __builtin_amdgcn_s_barrier();
        stg = stg == 2 ? 0 : stg + 1;
    }
#undef DA_ISSUE
#undef DA_LDK
#undef DA_QK
#undef DA_LDV
#undef DA_PV
    __builtin_amdgcn_s_setprio(0);
    const int lsrc = (lane < 16 || lane >= 48) ? lane : (lane < 32 ? lane + 16 : lane - 16);
    const float rlA = 1.f / __shfl(laccA[0], lsrc), rlB = 1.f / __shfl(laccB[0], lsrc);
    float* xb = (float*)L + (size_t)g * 2 * 32 * 64;
    if (c == 1) {
#pragma unroll
        for (int dh = 0; dh < 2; ++dh)
#pragma unroll
            for (int i = 0; i < 16; ++i) { xb[(dh * 16 + i) * 64 + lane] = OA[dh][i] * (rlA * lam); xb[2048 + (dh * 16 + i) * 64 + lane] = OB[dh][i] * (rlB * lam); }
    }
    __syncthreads();
    if (c == 0) {
        const float* sg = F.in[I_ASUB] + li * 64;
#pragma unroll
        for (int ab = 0; ab < 2; ++ab) {
            float o[2][16]; float ss = 0.f; const float rl = ab ? rlB : rlA;
#pragma unroll
            for (int dh = 0; dh < 2; ++dh)
#pragma unroll
                for (int i = 0; i < 16; ++i) { o[dh][i] = (ab ? OB[dh][i] : OA[dh][i]) * rl - xb[ab * 2048 + (dh * 16 + i) * 64 + lane]; ss += o[dh][i] * o[dh][i]; }
            ss = half_sum(ss);
            const float rs = rsqrtf(ss * (1.f / 64.f) + EPS) * (1.f - lam_init);
            bf16_t* mix = WSP(bf16_t, WS_HBF) + (qrowA + ab * 32) * D + h * 64;
#pragma unroll
            for (int dh = 0; dh < 2; ++dh)
#pragma unroll
                for (int gq = 0; gq < 4; ++gq) {
                    const int d = 32 * dh + 8 * gq + 4 * hh;
                    const f32x4 gg = *(const f32x4*)(sg + d);
                    *(u32x2*)(mix + d) = (u32x2){pk2(o[dh][4 * gq] * rs * gg[0], o[dh][4 * gq + 1] * rs * gg[1]), pk2(o[dh][4 * gq + 2] * rs * gg[2], o[dh][4 * gq + 3] * rs * gg[3])};
                }
        }
    }
}

DI void na_mfma_unit(const Frame& F, int li, int b, size_t qrow0, int grow) {
    const int lane = F.lane, r31 = lane & 31, hh = lane >> 5, h = F.wave >> 1, qh = F.wave & 1;
    const bf16_t* BQ = WSP(bf16_t, WS_BQ); const bf16_t* BK = WSP(bf16_t, WS_BK); const bf16_t* BVT = WSP(bf16_t, WS_BVT);
    constexpr int KB = 4 * 8192, VB = 4 * 9216, STG = KB + VB;
    unsigned char* L = F.lds;
    float* tab = (float*)(F.lds + 2 * STG);
    const int nwin = grow >= 0 ? 8 : 0, nt = nwin + 4;
    int r0 = grow - 4; r0 = r0 < 0 ? 0 : (r0 > 248 ? 248 : r0);
    __syncthreads();
    if (nwin) { float tv[4];
#pragma unroll
        for (int q = 0; q < 4; ++q) { const int i = F.tid + NTHR * q, c31 = i & 31, hr = (i >> 5) < 60 ? (i >> 5) : 0; tv[q] = F.in[I_RPB][(size_t)li * 4 * 465 + hr * 31 + (c31 < 31 ? c31 : 0)]; }
#pragma unroll
        for (int q = 0; q < 4; ++q) { const int i = F.tid + NTHR * q; if (i < 4 * 15 * 32) tab[i] = ((i & 31) < 31) ? tv[q] * LOG2E : -1e30f; } }
    const int skey = F.tid >> 3, sc64 = F.tid & 7, sh = sc64 >> 1;
    const int vrow = F.tid >> 1, vhalf = F.tid & 1;
    auto kbase = [&](int ti) -> const bf16_t* { return ti < nwin ? BK + ((size_t)b * S + (size_t)(r0 + ti) * GW) * 256 : BK + ((size_t)NLAT + b * CTX + (ti - nwin) * 64) * 256; };
    auto vkey0 = [&](int ti) -> int { return ti < nwin ? CTX + (r0 + ti) * GW : (ti - nwin) * 64; };
    u32x4 kreg[4], vreg[4];
    { const bf16_t* kp = kbase(0) + (size_t)skey * 256 + sc64 * 32; const bf16_t* vp = BVT + ((size_t)b * 256 + vrow) * NKEY + vkey0(0) + vhalf * 32;
#pragma unroll
      for (int i = 0; i < 4; ++i) { kreg[i] = *(const u32x4*)(kp + i * 8); vreg[i] = *(const u32x4*)(vp + i * 8); } }
    const size_t qrow = qrow0 + 32 * qh + r31;
    bf16x8 qf[4]; float qn2 = 0.f;
#pragma unroll
    for (int ks = 0; ks < 4; ++ks) { qf[ks] = *(const bf16x8*)(BQ + qrow * 256 + h * 64 + ks * 16 + 8 * hh);
#pragma unroll
        for (int j = 0; j < 8; ++j) { const float v = bf2f((bf16_t)qf[ks][j]); qn2 += v * v; } }
    qn2 = half_sum(qn2);
    __syncthreads();
    float bmax = 0.f;
    if (nwin) { for (int i = lane; i < 480; i += 64) bmax = fmaxf(bmax, tab[h * 480 + i]); bmax = wave_max(bmax); }
    const unsigned* kmx = F.ctl + CW_KMAXB + li * 16 + (b * 4 + h) * 2;
    const float km = sqrtf(__uint_as_float(__hip_atomic_load(kmx, __ATOMIC_RELAXED, __HIP_MEMORY_SCOPE_AGENT)) + __uint_as_float(__hip_atomic_load(kmx + 1, __ATOMIC_RELAXED, __HIP_MEMORY_SCOPE_AGENT)));
    const float cneg = -(sqrtf(qn2) * km * 1.02f + bmax + 1e-3f);
    const int cq = 32 * qh + r31; int c0q = cq - 8; c0q = c0q < 0 ? 0 : (c0q > 48 ? 48 : c0q);
    const int qrow_g = grow;
    f32x16 O[2];
#pragma unroll
    for (int dh = 0; dh < 2; ++dh)
#pragma unroll
        for (int i = 0; i < 16; ++i) O[dh][i] = 0.f;
    f32x4 lacc; bf16x8 selv;
    { const unsigned one2 = (((F.lane & 15) < 8) == (((F.lane >> 4) & 1) == 0)) ? 0x3F803F80u : 0u; u32x4 t; t[0] = one2; t[1] = one2; t[2] = one2; t[3] = one2; selv = __builtin_bit_cast(bf16x8, t); }
#pragma unroll
    for (int i = 0; i < 4; ++i) lacc[i] = 0.f;
    int tcol[2][16];
#pragma unroll
    for (int st = 0; st < 2; ++st)
#pragma unroll
        for (int i = 0; i < 16; ++i) { const int kc = 32 * st + (i & 3) + 8 * (i >> 2) + 4 * hh; tcol[st][i] = ((kc >= c0q) && (kc < c0q + 16)) ? (kc - cq + 15) : 31; }
    const int kdst = sh * 8192 + skey * 128, ksw = (skey >> 1) & 7, kch0 = (sc64 & 1) * 4;
    const int vdst = KB + (vrow >> 6) * 9216 + (vrow & 63) * 144 + vhalf * 64;
#pragma unroll
    for (int i = 0; i < 4; ++i) *(u32x4*)(L + kdst + (((kch0 + i) ^ ksw) * 16)) = kreg[i];
#pragma unroll
    for (int i = 0; i < 4; ++i) *(u32x4*)(L + vdst + i * 16) = vreg[i];
    __syncthreads();
    if (F.wave >= 4) __builtin_amdgcn_s_setprio(1);
#pragma unroll 1
    for (int ti = 0; ti < nt; ++ti) {
        const int buf = ti & 1;
        if (ti + 1 < nt) { const bf16_t* kp = kbase(ti + 1) + (size_t)skey * 256 + sc64 * 32; const bf16_t* vp = BVT + ((size_t)b * 256 + vrow) * NKEY + vkey0(ti + 1) + vhalf * 32;
#pragma unroll
            for (int i = 0; i < 4; ++i) { kreg[i] = *(const u32x4*)(kp + i * 8); vreg[i] = *(const u32x4*)(vp + i * 8); } }
        const unsigned char* kb = L + buf * STG + h * 8192; const unsigned char* vb = L + buf * STG + KB + h * 9216;
        const bool win = ti < nwin;
        const float* trow = tab + (h * 15 + (win ? (r0 + ti - qrow_g + 7) : 0)) * 32;
#pragma unroll
        for (int st = 0; st < 2; ++st) {
            const int key = 32 * st + r31, sw = (key >> 1) & 7;
            f32x16 s;
            if (win) {
#pragma unroll
                for (int i = 0; i < 16; ++i) s[i] = trow[tcol[st][i]] + cneg;
            } else {
#pragma unroll
                for (int i = 0; i < 16; ++i) s[i] = cneg;
            }
#pragma unroll
            for (int ks = 0; ks < 4; ++ks) { const bf16x8 kf = *(const bf16x8*)(kb + key * 128 + (((ks * 2 + hh) ^ sw) * 16)); s = MFMA32(kf, qf[ks], s); }
#pragma unroll
            for (int i = 0; i < 16; ++i) s[i] = __builtin_amdgcn_exp2f(s[i]);
            const bf16x8 p0 = pack8t(s, 0), p1 = pack8t(s, 1);
            lacc = __builtin_amdgcn_mfma_f32_16x16x32_bf16(selv, p0, lacc, 0, 0, 0);
            lacc = __builtin_amdgcn_mfma_f32_16x16x32_bf16(selv, p1, lacc, 0, 0, 0);
#pragma unroll
            for (int dh = 0; dh < 2; ++dh) {
                const unsigned char* vp = vb + (32 * dh + r31) * 144 + st * 64 + hh * 16;
                O[dh] = MFMA32(*(const bf16x8*)vp, p0, O[dh]);
                O[dh] = MFMA32(*(const bf16x8*)(vp + 32), p1, O[dh]);
            }
        }
        if (ti + 1 < nt) { unsigned char* W = L + (buf ^ 1) * STG;
#pragma unroll
            for (int i = 0; i < 4; ++i) *(u32x4*)(W + kdst + (((kch0 + i) ^ ksw) * 16)) = kreg[i];
#pragma unroll
            for (int i = 0; i < 4; ++i) *(u32x4*)(W + vdst + i * 16) = vreg[i]; }
        __syncthreads();
    }
    __builtin_amdgcn_s_setprio(0);
    const int lsrc = (F.lane < 16 || F.lane >= 48) ? F.lane : (F.lane < 32 ? F.lane + 16 : F.lane - 16);
    const float rl = 1.f / __shfl(lacc[0], lsrc);
    bf16_t* mix = WSP(bf16_t, WS_HBF) + qrow * D + 256 + h * 64;
#pragma unroll
    for (int dh = 0; dh < 2; ++dh)
#pragma unroll
        for (int g = 0; g < 4; ++g) { const int d = 32 * dh + 8 * g + 4 * hh;
            *(u32x2*)(mix + d) = (u32x2){pk2(O[dh][4 * g] * rl, O[dh][4 * g + 1] * rl), pk2(O[dh][4 * g + 2] * rl, O[dh][4 * g + 3] * rl)}; }
}

DI void pool_unit(const Frame& F, int li, size_t seq_row0, int L, int t0) {
    unsigned* us = (unsigned*)F.lds;
    unsigned char* dfb = F.lds + 80 * 512;
    const bf16_t* PL = WSP(bf16_t, WS_PL);
    bf16x8 Af[4][2];
    { const bf16_t* wt = WSP(bf16_t, WS_PWT) + ((size_t)li * 4 + (F.wave & 3)) * 4096; const int fr = F.lane & 15, fq = F.lane >> 4;
#pragma unroll
      for (int jb = 0; jb < 4; ++jb)
#pragma unroll
          for (int ks = 0; ks < 2; ++ks) Af[jb][ks] = *(const bf16x8*)(wt + (jb * 16 + fr) * 64 + ks * 32 + fq * 8); }
    __syncthreads();
    { u32x4 xv[5];
#pragma unroll
      for (int q = 0; q < 5; ++q) { const int i = F.tid + NTHR * q, tt = i >> 5, c8 = i & 31, t = t0 - 8 + tt; const int tc = t < 0 ? 0 : (t >= L ? L - 1 : t);
          const u32x4 x = *(const u32x4*)(PL + (seq_row0 + tc) * 256 + c8 * 8); xv[q] = (t >= 0 && t < L) ? x : (u32x4){0u, 0u, 0u, 0u}; }
#pragma unroll
      for (int q = 0; q < 5; ++q) { const int i = F.tid + NTHR * q; *(u32x4*)(us + (i >> 5) * 128 + (i & 31) * 4) = xv[q]; } }
    __syncthreads();
    {
        const int cp = F.tid & 127, tl0 = (F.tid >> 7) * 16, hw = 1 << (cp >> 5);
        float s0 = 0.f, s1 = 0.f;
        for (int k = -hw; k < hw; ++k) { const unsigned w = us[(tl0 + 8 + k) * 128 + cp]; s0 += __uint_as_float(w << 16); s1 += __uint_as_float(w & 0xffff0000u); }
#pragma unroll 4
        for (int j = 0; j < 16; ++j) {
            const int tl = tl0 + j, t = t0 + tl;
            const int lo = t - hw < 0 ? 0 : t - hw, hi = t + hw > L ? L : t + hw;
            const float rc = __builtin_amdgcn_rcpf((float)(hi - lo));
            const unsigned c = us[(tl + 8) * 128 + cp];
            *(unsigned*)(dfb + tl * 528 + cp * 4) = pk2(s0 * rc - __uint_as_float(c << 16), s1 * rc - __uint_as_float(c & 0xffff0000u));
            const unsigned a = us[(tl + 8 + hw) * 128 + cp], b = us[(tl + 8 - hw) * 128 + cp];
            s0 += __uint_as_float(a << 16) - __uint_as_float(b << 16); s1 += __uint_as_float(a & 0xffff0000u) - __uint_as_float(b & 0xffff0000u);
        }
    }
    __syncthreads();
    {
        const int g = F.wave & 3, tq = F.wave >> 2, fr = F.lane & 15, fq = F.lane >> 4;
        const float* ps = F.in[I_POOLS] + li * 256 + g * 64;
        bf16_t* mix = WSP(bf16_t, WS_HBF);
#pragma unroll
        for (int tb = 0; tb < 2; ++tb) {
            const int tl = (tq * 2 + tb) * 16 + fr;
            const bf16x8 B0 = *(const bf16x8*)(dfb + tl * 528 + (g * 64 + fq * 8) * 2), B1 = *(const bf16x8*)(dfb + tl * 528 + (g * 64 + 32 + fq * 8) * 2);
#pragma unroll
            for (int jb = 0; jb < 4; ++jb) {
                f32x4 acc = (f32x4){0.f, 0.f, 0.f, 0.f};
                acc = __builtin_amdgcn_mfma_f32_16x16x32_bf16(Af[jb][0], B0, acc, 0, 0, 0);
                acc = __builtin_amdgcn_mfma_f32_16x16x32_bf16(Af[jb][1], B1, acc, 0, 0, 0);
                const f32x4 sc = *(const f32x4*)(ps + jb * 16 + 4 * fq);
                *(u32x2*)(mix + (seq_row0 + t0 + tl) * D + 512 + g * 64 + jb * 16 + 4 * fq) = (u32x2){pk2(acc[0] * sc[0], acc[1] * sc[1]), pk2(acc[2] * sc[2], acc[3] * sc[3])};
            }
        }
    }
}

DI float hy_norm(const float* part, int ntile, int o, int ch) {
    float s = 0.f;
    for (int t = 0; t < ntile; ++t) s += part[(size_t)t * 1024 + (o * 2) * 256 + ch] + part[(size_t)t * 1024 + (o * 2 + 1) * 256 + ch];
    return rsqrtf(s + EPS);
}
DI float hy_short(const bf16_t* p, int t, int L, float w0, float w1, float w2, float bb) {
    const int tm = t > 0 ? t - 1 : 0, tp = t + 1 < L ? t + 1 : L - 1;
    float a = bf2f(p[tm]), c = bf2f(p[tp]); const float m = bf2f(p[t]);
    a = t > 0 ? a : 0.f; c = t + 1 < L ? c : 0.f;
    return a * w0 + m * w1 + c * w2 + bb;
}
constexpr int FM = 16384;
DI int fphys(int i) { return i + (i >> 4) + ((i >> 9) << 4); }
constexpr int brev(int m, int bits) { return bits == 5 ? (((m & 1) << 4) | ((m & 2) << 2) | (m & 4) | ((m & 8) >> 2) | ((m & 16) >> 4)) : (((m & 1) << 3) | ((m & 2) << 1) | ((m & 4) >> 1) | ((m & 8) >> 3)); }
DI f32x2 cmul(f32x2 x, float c, float sn) {
    const f32x2 xs = __builtin_shufflevector(x, x, 1, 0);
    return x * (f32x2){c, c} + xs * (f32x2){-sn, sn};
}
template <int R, int LOG2R, bool INV> DI void dft_regs(f32x2 (&x)[R]) {
    constexpr float C32[16] = {1.f, 0.98078528040323043f, 0.92387953251128674f, 0.83146961230254524f, 0.70710678118654752f, 0.55557023301960218f, 0.38268343236508977f, 0.19509032201612825f,
                               0.f, -0.19509032201612825f, -0.38268343236508977f, -0.55557023301960218f, -0.70710678118654752f, -0.83146961230254524f, -0.92387953251128674f, -0.98078528040323043f};
    constexpr float S32[16] = {0.f, 0.19509032201612825f, 0.38268343236508977f, 0.55557023301960218f, 0.70710678118654752f, 0.83146961230254524f, 0.92387953251128674f, 0.98078528040323043f,
                               1.f, 0.98078528040323043f, 0.92387953251128674f, 0.83146961230254524f, 0.70710678118654752f, 0.55557023301960218f, 0.38268343236508977f, 0.19509032201612825f};
#pragma unroll
    for (int st = 0; st < LOG2R; ++st) {
        const int h = R >> (st + 1);
        f32x2 d[R / 2], t[R / 2];
#pragma unroll
        for (int b = 0; b < R / 2; ++b) { const int i = (b / h) * 2 * h, j = b % h; const f32x2 a = x[i + j], c = x[i + j + h]; x[i + j] = a + c; d[b] = a - c; }
#pragma unroll
        for (int b = 0; b < R / 2; ++b) { const int j = b % h, k = j * (16 / h); if (k != 0 && k != 8) t[b] = d[b] * (f32x2){C32[k], C32[k]}; }
#pragma unroll
        for (int b = 0; b < R / 2; ++b) { const int i = (b / h) * 2 * h, j = b % h, k = j * (16 / h);
            if (k == 0) x[i + j + h] = d[b];
            else if (k == 8) x[i + j + h] = INV ? (f32x2){-d[b][1], d[b][0]} : (f32x2){d[b][1], -d[b][0]};
            else { const float sn = INV ? S32[k] : -S32[k]; x[i + j + h] = __builtin_shufflevector(d[b], d[b], 1, 0) * (f32x2){-sn, sn} + t[b]; } }
    }
}
template <bool INV, int SP> DI void fft_pass32(f32x2* X, int bp, int rem, float inv_bs) {
    asm volatile("" : "+v"(bp), "+v"(rem));
    f32x2* P = X + bp;
    const float revb = (float)rem * inv_bs;
    f32x2 x[32], cs[16], t[16];
    if (!INV) {
#pragma unroll
        for (int q = 0; q < 32; ++q) x[q] = P[q * SP];
        dft_regs<32, 5, false>(x);
        P[0] = x[0];
#pragma unroll
        for (int hb = 0; hb < 32; hb += 16) {
#pragma unroll
            for (int m = hb ? hb : 1; m < hb + 16; ++m) { const float rev = revb * (float)brev(m, 5); cs[m & 15] = (f32x2){__builtin_amdgcn_cosf(rev), -__builtin_amdgcn_sinf(rev)}; }
#pragma unroll
            for (int m = hb ? hb : 1; m < hb + 16; ++m) t[m & 15] = x[m] * (f32x2){cs[m & 15][0], cs[m & 15][0]};
#pragma unroll
            for (int m = hb ? hb : 1; m < hb + 16; ++m) P[brev(m, 5) * SP] = __builtin_shufflevector(x[m], x[m], 1, 0) * (f32x2){-cs[m & 15][1], cs[m & 15][1]} + t[m & 15];
        }
    } else {
#pragma unroll
        for (int qp = 0; qp < 32; ++qp) x[qp] = P[qp * SP];
#pragma unroll
        for (int hb = 0; hb < 32; hb += 16) {
#pragma unroll
            for (int qp = hb ? hb : 1; qp < hb + 16; ++qp) { const float rev = revb * (float)qp; cs[qp & 15] = (f32x2){__builtin_amdgcn_cosf(rev), __builtin_amdgcn_sinf(rev)}; }
#pragma unroll
            for (int qp = hb ? hb : 1; qp < hb + 16; ++qp) t[qp & 15] = x[qp] * (f32x2){cs[qp & 15][0], cs[qp & 15][0]};
#pragma unroll
            for (int qp = hb ? hb : 1; qp < hb + 16; ++qp) x[qp] = __builtin_shufflevector(x[qp], x[qp], 1, 0) * (f32x2){-cs[qp & 15][1], cs[qp & 15][1]} + t[qp & 15];
        }
        dft_regs<32, 5, true>(x);
#pragma unroll
        for (int m = 0; m < 32; ++m) P[brev(m, 5) * SP] = x[m];
    }
}
DI void fft_fwd12(f32x2* X, int tid) {
    __syncthreads(); fft_pass32<false, 560>(X, fphys(tid), tid, 1.f / 16384.f);
    __syncthreads(); fft_pass32<false, 17>(X, (tid >> 4) * 560 + (tid & 15), tid & 15, 1.f / 512.f);
    __syncthreads();
}
DI void fft_inv21(f32x2* X, int tid) {
    __syncthreads(); fft_pass32<true, 17>(X, (tid >> 4) * 560 + (tid & 15), tid & 15, 1.f / 512.f);
    __syncthreads(); fft_pass32<true, 560>(X, fphys(tid), tid, 1.f / 16384.f);
    __syncthreads();
}
typedef _Float16 h16x8 __attribute__((ext_vector_type(8)));
DI void hy_short8(const bf16_t* p, int n, int L, const float (&w)[4], float (&y)[8]) {
    const u32x4 r = *(const u32x4*)(p + n);
    const int nm = n > 0 ? n - 1 : 0, np = n + 8 < L ? n + 8 : L - 1;
    float u[10]; const float a = bf2f(p[nm]), c = bf2f(p[np]); u[0] = n > 0 ? a : 0.f; u[9] = n + 8 < L ? c : 0.f;
#pragma unroll
    for (int e = 0; e < 4; ++e) { u[1 + 2 * e] = __uint_as_float(r[e] << 16); u[2 + 2 * e] = __uint_as_float(r[e] & 0xffff0000u); }
#pragma unroll
    for (int e = 0; e < 8; ++e) y[e] = u[e] * w[0] + u[e + 1] * w[1] + u[e + 2] * w[2] + w[3];
}
DI void hyena_fft_unit(const Frame& F, int li, int ch) {
    f32x2* X = (f32x2*)F.lds;
    const bf16_t* HYT = WSP(bf16_t, WS_HYT); const _Float16* filt = WSP(_Float16, WS_FILT);
    f32x2* Ye = WSP(f32x2, WS_ZBUF) + (size_t)ch * FM; f32x2* Z1 = WSP(f32x2, WS_Z1BUF) + (size_t)ch * FM;
    const float* sw = F.in[I_HYSW] + (size_t)li * 3 * 768; const float* sb = F.in[I_HYSB] + li * 768; const float* sk = F.in[I_HSKIP] + li * 512;
    const int tid = F.tid;
    const bf16_t* px1[2] = {HYT + ((size_t)0 * 768 + ch) * S, HYT + ((size_t)1 * 768 + ch) * S};
    const bf16_t* px2[2] = {HYT + ((size_t)0 * 768 + 256 + ch) * S, HYT + ((size_t)1 * 768 + 256 + ch) * S};
    const bf16_t* pv[2] = {HYT + ((size_t)0 * 768 + 512 + ch) * S, HYT + ((size_t)1 * 768 + 512 + ch) * S};
    const float wx1[4] = {sw[ch], sw[768 + ch], sw[1536 + ch], sb[ch]};
    const float wx2[4] = {sw[256 + ch], sw[768 + 256 + ch], sw[1536 + 256 + ch], sb[256 + ch]};
    const float wv[4] = {sw[512 + ch], sw[768 + 512 + ch], sw[1536 + 512 + ch], sb[512 + ch]};
#pragma unroll 1
    for (int cv = 0; cv < 2; ++cv) {
        const _Float16* hf = filt + ((size_t)(2 * cv) * 256 + ch) * S; const _Float16* hb = filt + ((size_t)(2 * cv + 1) * 256 + ch) * S;
        float fnrm;
        { int tn = tid; asm volatile("" : "+v"(tn));
          const float pv = WSP(float, WS_FPART)[(size_t)(tn & 255) * 1024 + (cv * 2 + (tn >> 8)) * 256 + ch];
          const float ws = wave_sum(pv);
          float* red = (float*)(F.lds + LDS_MISC + 128);
          __syncthreads();
          if (F.lane == 0) red[F.wave] = ws;
          __syncthreads();
          fnrm = rsqrtf(red[0] + red[1] + red[2] + red[3] + red[4] + red[5] + red[6] + red[7] + EPS); }
        const float nrm = 1.f / 32768.f;
        const float skip = sk[cv * 256 + ch];
#pragma unroll 1
        for (int half = 0; half < 2; ++half) {
            __syncthreads();
            int xb = 34 * tid + 16 * (tid >> 4), n0 = 32 * tid; asm volatile("" : "+v"(xb), "+v"(n0));
#pragma unroll 2
            for (int c = 0; c < 4; ++c) { const int n = n0 + 8 * c; f32x2* Xc = X + xb + 8 * c + (c >> 1);
                const h16x8 fa = *(const h16x8*)(hf + n), fb = *(const h16x8*)(hb + FM - n - 8); const float b0 = (float)hb[FM - n];
#pragma unroll
                for (int e = 0; e < 8; ++e) { const float a = (float)fa[e] * fnrm; float bq = (e == 0 ? b0 : (float)fb[(8 - e) & 7]) * fnrm; bq = (n + e) ? bq : 0.f;
                    if (half == 0) Xc[e] = (f32x2){a + bq, 0.f};
                    else { const float d = a - bq, rev = (float)(n + e) * (1.f / 32768.f); Xc[e] = (f32x2){d * __builtin_amdgcn_cosf(rev), -d * __builtin_amdgcn_sinf(rev)}; } }
            }
            fft_fwd12(X, tid);
            h16x2 kpk[2][16];
#pragma unroll
            for (int g = 0; g < 2; ++g) { int b16 = fphys((tid + 512 * g) * 16); asm volatile("" : "+v"(b16));
                f32x2 kx[16];
#pragma unroll
                for (int q = 0; q < 16; ++q) kx[q] = X[b16 + q];
                dft_regs<16, 4, false>(kx);
#pragma unroll
                for (int q = 0; q < 16; ++q) kpk[g][q] = (h16x2){(_Float16)kx[q][0], (_Float16)kx[q][1]}; }
            __syncthreads();
            asm volatile("" : "+v"(xb), "+v"(n0));
#define HY_MOD(v, n) do { const float rev = (float)(n) * (1.f / 32768.f); v = cmul(v, __builtin_amdgcn_cosf(rev), -__builtin_amdgcn_sinf(rev)); } while (0)
            if (cv == 0) {
#pragma unroll 2
                for (int c = 0; c < 4; ++c) { const int n = n0 + 8 * c; f32x2* Xc = X + xb + 8 * c + (c >> 1);
                    float y0[8], y1[8]; hy_short8(pv[0], n, S, wv, y0); hy_short8(pv[1], n, S, wv, y1);
#pragma unroll
                    for (int e = 0; e < 8; ++e) { f32x2 v = (f32x2){y0[e], y1[e]}; if (half) HY_MOD(v, n + e); Xc[e] = v; } }
            } else {
#pragma unroll 2
                for (int c = 0; c < 4; ++c) { const int n = n0 + 8 * c; f32x2* Xc = X + xb + 8 * c + (c >> 1);
                    const f32x4* zp = (const f32x4*)(Z1 + n); f32x4 z[4];
#pragma unroll
                    for (int q = 0; q < 4; ++q) z[q] = zp[q];
#pragma unroll
                    for (int e = 0; e < 8; ++e) { f32x2 v = (f32x2){z[e >> 1][2 * (e & 1)], z[e >> 1][2 * (e & 1) + 1]}; if (half) HY_MOD(v, n + e); Xc[e] = v; } }
            }
#undef HY_MOD
            fft_fwd12(X, tid);
#pragma unroll
            for (int g = 0; g < 2; ++g) { int b16 = fphys((tid + 512 * g) * 16); asm volatile("" : "+v"(b16));
                f32x2 dx[16], bx[16];
#pragma unroll
                for (int q = 0; q < 16; ++q) dx[q] = X[b16 + q];
                dft_regs<16, 4, false>(dx);
#pragma unroll
                for (int m = 0; m < 16; ++m) bx[brev(m, 4)] = cmul(dx[m], (float)kpk[g][m][0], (float)kpk[g][m][1]);
                dft_regs<16, 4, true>(bx);
#pragma unroll
                for (int m = 0; m < 16; ++m) X[b16 + brev(m, 4)] = bx[m];
            }
            fft_inv21(X, tid);
            asm volatile("" : "+v"(xb), "+v"(n0));
            if (half == 0) {
#pragma unroll 2
                for (int c = 0; c < 4; ++c) { const int n = n0 + 8 * c; const f32x2* Xc = X + xb + 8 * c + (c >> 1); f32x4* yp = (f32x4*)(Ye + n);
#pragma unroll
                    for (int q = 0; q < 4; ++q) { const f32x2 lo = Xc[2 * q], hi = Xc[2 * q + 1]; yp[q] = (f32x4){lo[0], lo[1], hi[0], hi[1]}; } }
            } else {
#pragma unroll 1
                for (int c = 0; c < 4; ++c) { const int n = n0 + 8 * c; const f32x2* Xc = X + xb + 8 * c + (c >> 1);
                    const f32x4* yp = (const f32x4*)(Ye + n); f32x4 yv[4];
#pragma unroll
                    for (int q = 0; q < 4; ++q) yv[q] = yp[q];
                    float y0[8], y1[8];
#pragma unroll
                    for (int e = 0; e < 8; ++e) { const f32x2 yo = Xc[e]; const float ye0 = yv[e >> 1][2 * (e & 1)], ye1 = yv[e >> 1][2 * (e & 1) + 1];
                        const float rev = (float)(n + e) * (1.f / 32768.f); const float cs = __builtin_amdgcn_cosf(rev), sn = __builtin_amdgcn_sinf(rev);
                        y0[e] = (ye0 + yo[0] * cs - yo[1] * sn) * nrm; y1[e] = (ye1 + yo[0] * sn + yo[1] * cs) * nrm; }
                    if (cv == 0) {
                        float v0[8], v1[8], a0[8], a1[8];
                        hy_short8(pv[0], n, S, wv, v0); hy_short8(pv[1], n, S, wv, v1); hy_short8(px1[0], n, S, wx1, a0); hy_short8(px1[1], n, S, wx1, a1);
                        f32x4* zp = (f32x4*)(Z1 + n);
#pragma unroll
                        for (int q = 0; q < 4; ++q) zp[q] = (f32x4){a0[2 * q] * (y0[2 * q] + skip * v0[2 * q]), a1[2 * q] * (y1[2 * q] + skip * v1[2 * q]),
                                                                  a0[2 * q + 1] * (y0[2 * q + 1] + skip * v0[2 * q + 1]), a1[2 * q + 1] * (y1[2 * q + 1] + skip * v1[2 * q + 1])};
                    } else {
                        bf16_t* ob0 = (bf16_t*)(WSP(_Float16, WS_FILT) + ((size_t)0 * 256 + ch) * S); bf16_t* ob1 = (bf16_t*)(WSP(_Float16, WS_FILT) + ((size_t)1 * 256 + ch) * S);
                        const f32x4* zp = (const f32x4*)(Z1 + n); f32x4 z[4];
#pragma unroll
                        for (int q = 0; q < 4; ++q) z[q] = zp[q];
                        float a0[8], a1[8]; hy_short8(px2[0], n, S, wx2, a0); hy_short8(px2[1], n, S, wx2, a1);
                        float r0[8], r1[8];
#pragma unroll
                        for (int e = 0; e < 8; ++e) { r0[e] = a0[e] * (y0[e] + skip * z[e >> 1][2 * (e & 1)]); r1[e] = a1[e] * (y1[e] + skip * z[e >> 1][2 * (e & 1) + 1]); }
                        *(u32x4*)(ob0 + n) = (u32x4){pk2(r0[0], r0[1]), pk2(r0[2], r0[3]), pk2(r0[4], r0[5]), pk2(r0[6], r0[7])};
                        *(u32x4*)(ob1 + n) = (u32x4){pk2(r1[0], r1[1]), pk2(r1[2], r1[3]), pk2(r1[4], r1[5]), pk2(r1[6], r1[7])};
                    }
                }
            }
        }
    }
}
DI void hyena_ctx_unit(const Frame& F, int li, int ch) {
    float* vs = (float*)F.lds;
    float* zs = vs + 512;
    float* fl = zs + 512;
    const bf16_t* HYC = WSP(bf16_t, WS_HYC); const _Float16* filt = WSP(_Float16, WS_FILTC);
    const float* sw = F.in[I_HYSW] + (size_t)li * 3 * 768; const float* sb = F.in[I_HYSB] + li * 768; const float* sk = F.in[I_HSKIP] + li * 512;
    const float n0 = hy_norm(WSP(float, WS_FPARTC), 4, 0, ch), n1 = hy_norm(WSP(float, WS_FPARTC), 4, 1, ch);
    const int b = F.tid >> 8, t = F.tid & 255;
    auto sc = [&](int c) -> float { const bf16_t* p = HYC + (size_t)(b * CTX) * 768 + c;
        const float a = t > 0 ? bf2f(p[(size_t)(t - 1) * 768]) : 0.f, d = t + 1 < CTX ? bf2f(p[(size_t)(t + 1) * 768]) : 0.f;
        return a * sw[c] + bf2f(p[(size_t)t * 768]) * sw[768 + c] + d * sw[1536 + c] + sb[c]; };
    __syncthreads();
    const float x1 = sc(ch), x2 = sc(256 + ch), v = sc(512 + ch);
    vs[F.tid] = v;
    { const _Float16 f0 = filt[((size_t)(F.tid >> 8) * 256 + ch) * CTX + (F.tid & 255)], f1 = filt[((size_t)((F.tid >> 8) + 2) * 256 + ch) * CTX + (F.tid & 255)]; fl[F.tid] = (float)f0; fl[F.tid + 512] = (float)f1; }
    __syncthreads();
    float a = 0.f;
    for (int s = 0; s < CTX; ++s) { const int dl = t - s; a += (dl >= 0 ? fl[dl] : fl[256 - dl]) * vs[b * 256 + s]; }
    const float z = x1 * (a * n0 + sk[ch] * v);
    zs[F.tid] = z;
    __syncthreads();
    a = 0.f;
    for (int s = 0; s < CTX; ++s) { const int dl = t - s; a += (dl >= 0 ? fl[512 + dl] : fl[768 - dl]) * zs[b * 256 + s]; }
    WSP(bf16_t, WS_HBF)[((size_t)NLAT + b * CTX + t) * D + 768 + ch] = f2bf(x2 * (a * n1 + sk[256 + ch] * z));
}

DI void hy_transpose_unit(const Frame& F, int b, int t0) {
    unsigned char* L = F.lds;
    const bf16_t* src = (const bf16_t*)(WSP(_Float16, WS_FILT) + (size_t)b * 256 * S);
    __syncthreads();
#pragma unroll
    for (int k = 0; k < 8; ++k) { const int id = F.tid + 512 * k, ch = id >> 4, part = id & 15;
        *(u32x4*)(L + ch * 256 + ((part ^ ((ch >> 3) & 15)) * 16)) = *(const u32x4*)(src + (size_t)ch * S + t0 + part * 8); }
    __syncthreads();
    bf16_t* mix = WSP(bf16_t, WS_HBF);
#pragma unroll
    for (int k = 0; k < 8; ++k) { const int id = F.tid + 512 * k, t = id >> 5, cg = id & 31;
        const unsigned char* q = L + (8 * cg) * 256 + ((((t >> 3) ^ (cg & 15)) * 16) + (t & 7) * 2);
        u32x4 o;
#pragma unroll
        for (int j = 0; j < 4; ++j) o[j] = (unsigned)*(const unsigned short*)(q + (2 * j) * 256) | ((unsigned)*(const unsigned short*)(q + (2 * j + 1) * 256) << 16);
        *(u32x4*)(mix + ((size_t)b * S + t0 + t) * D + 768 + 8 * cg) = o; }
}
constexpr int CW_HYDONE = 12992;
constexpr int CW_CTXDONE = 12800;
constexpr int N_CTX_UNITS = 8 + 8 + 256 + 8;
struct OneOrder {
    static constexpr bool SWAP = false;
    int pm, pn;
    DI bool next(int i, pg8::Unit& u) const { if (i) return false; u.pm = pm; u.pn = pn; u.e = 0; return true; }
};
DI void unit_done(const Frame& F, int word) {
    asm volatile("s_waitcnt vmcnt(0)" ::: "memory");
    __syncthreads();
    if (F.tid == 0) { __builtin_amdgcn_fence(__ATOMIC_RELEASE, "agent"); asm volatile("s_waitcnt vmcnt(0)" ::: "memory"); (void)xb_add(F.ctl + word, 1u); }
}
DI void ctx_unit_done(const Frame& F) { unit_done(F, CW_CTXDONE); }
DI void wait_count(const Frame& F, int word, unsigned need) {
    if (F.tid == 0) { unsigned sp = 0; while (xb_ld(F.ctl + word) < need && ++sp < (1u << 22)) __builtin_amdgcn_s_sleep(8);
        __builtin_amdgcn_fence(__ATOMIC_ACQUIRE, "agent"); asm volatile("s_waitcnt vmcnt(0)" ::: "memory"); }
    __syncthreads();
}
DI void phase_mix(const Frame& F0, int li) {
    const Frame& F = F0;
    unsigned* head = F.ctl + CW_QHEAD + li * 64;
    volatile unsigned* qs = (volatile unsigned*)(F.lds + LDS_MISC + 32);
    const int n_ca = (li == 0) ? 8 : 0, n_cb = (li == 0) ? 8 : 0, n_hc = (li == 0) ? 256 : 0, n_pc = (li == 0) ? 8 : 0, n_da = 512, n_go = (li == 0) ? 8 : 0, n_hy = 256, n_na = 512, n_pl = 512, n_tr = 256;
    const int total = n_ca + n_cb + n_hc + n_pc + n_da + n_go + n_hy + n_na + n_pl + n_tr;
    for (;;) {
        __syncthreads();
        if (F.tid == 0) qs[0] = __hip_atomic_fetch_add(head, 1u, __ATOMIC_RELAXED, __HIP_MEMORY_SCOPE_AGENT);
        __syncthreads();
        int u = __builtin_amdgcn_readfirstlane((int)qs[0]);
        if (u >= total) break;
        Frame F = F0; refresh(F);
        if (u < n_ca) { diffattn_unit(F, li, u >> 2, u & 3, (size_t)NLAT + (size_t)(u >> 2) * CTX, CTX / 128); ctx_unit_done(F); continue; }
        u -= n_ca;
        if (u < n_cb) { na_mfma_unit(F, li, u >> 2, (size_t)NLAT + (size_t)(u >> 2) * CTX + (size_t)(u & 3) * 64, -1); ctx_unit_done(F); continue; }
        u -= n_cb;
        if (u < n_hc) { hyena_ctx_unit(F, li, u & 255); ctx_unit_done(F); continue; }
        u -= n_hc;
        if (u < n_pc) { pool_unit(F, li, (size_t)NLAT + (u >> 2) * CTX, CTX, (u & 3) * 64); ctx_unit_done(F); continue; }
        u -= n_pc;
        if (u < n_da) { const int v = u & 511; diffattn_unit(F, li, v >> 8, (v >> 6) & 3, (size_t)(v >> 8) * S + (size_t)(v & 63) * 256, NKEY / 128); continue; }
        u -= n_da;
        if (u < n_hy) { hyena_fft_unit(F, li, u & 255); unit_done(F, CW_HYDONE + li * 64); continue; }
        u -= n_hy;
        if (u < n_go) {
            wait_count(F, CW_CTXDONE, (unsigned)N_CTX_UNITS);
            pg8::Gemm g{WSP(bf16_t, WS_HBF), WSP(bf16_t, WS_WOUT) + (size_t)li * D * D, D, 0};
            OneOrder Oo{NLAT / 256 + (u >> 2), u & 3};
            EpiOut E{F.in[I_X], F.in[I_CTX], WSP(bf16_t, WS_XB), WSP(float, WS_MOD) + (size_t)li * 3 * 6144, true};
            pg8::gemm_phase<EpiOut, OneOrder, true>((LAS unsigned char*)F.lds, g, Oo, E, F.tid);
            continue; }
        u -= n_go;
        if (u < n_na) { const int v = u & 511; na_mfma_unit(F, li, v >> 8, (size_t)(v >> 8) * S + (size_t)(v & 255) * GW, v & 255); continue; }
        u -= n_na;
        if (u < n_pl) { const int v = u & 511; pool_unit(F, li, (size_t)(v >> 8) * S, S, (v & 255) * 64); continue; }
        u -= n_pl;
        wait_count(F, CW_HYDONE + li * 64, 256u);
        hy_transpose_unit(F, u >> 7, (u & 127) * 128);
    }
}

constexpr int PH_PER_LAYER = 8, NPH = 2 + 2 * PH_PER_LAYER;
#ifdef PT_T
#define PT_SEL(k) (PT_T == 10 || (PT_T == 8 && (k) == 0) || (PT_T == 9 && (k) == NPH - 1) || (PT_T < 8 && (k) >= 1 && (k) <= 16 && (((k) - 1) & 7) == PT_T))
#define PT_MARK(k) do { const unsigned long long now_ = __builtin_amdgcn_s_memrealtime(); __builtin_amdgcn_s_waitcnt(0xC07F); if (PT_SEL(k)) pt_acc += now_ - pt_last; pt_last = now_; } while (0)
#ifndef PT_MULT
#define PT_MULT 4
#endif
#else
#define PT_MARK(k) do { } while (0)
#endif
__global__ void __launch_bounds__(NTHR, 2) mega(Args args) {
    extern __shared__ __attribute__((aligned(16))) unsigned char smem[];
    Frame F;
    F.in = args.in; F.out = args.out; F.ws = args.ws; F.ctl = (unsigned*)(args.ws + WS_CTL); F.lds = smem;
    F.tid = threadIdx.x; F.lane = F.tid & 63; F.wave = __builtin_amdgcn_readfirstlane(F.tid >> 6); F.G = gridDim.x; F.bid = blockIdx.x;
    if (F.tid < 64) ((unsigned*)(smem + LDS_MISC))[F.tid] = 0u;
    __syncthreads();
    const int lo = args.ph_lo, hi = args.ph_hi;
    const bool fused = (hi - lo) > 1;
    XcdBarrier bar; bar.bar = F.ctl; bar.x = 0; bar.st = (volatile LAS unsigned*)(smem + LDS_MISC);
    if (fused) bar = xcd_barrier_post(F.ctl, (volatile LAS unsigned*)(smem + LDS_MISC));
#define IN(k) (lo <= (k) && (k) < hi)
#ifdef PT_T
    unsigned long long pt_acc = 0ull, pt_last = __builtin_amdgcn_s_memrealtime(); __builtin_amdgcn_s_waitcnt(0xC07F);
#endif
#ifdef PROBE_BAR
#define SEAM(k) do { if (IN(k) && IN((k) + 1)) { xcd_barrier(bar); xcd_barrier(bar); xcd_barrier(bar); } } while (0)
#else
#define SEAM(k) do { if (IN(k) && IN((k) + 1)) xcd_barrier(bar); PT_MARK(k); } while (0)
#endif
#ifndef SKIP_P0
    if (IN(0)) { refresh(F); phase_prologue(F);
#ifdef PROBE_MISC
        __syncthreads(); refresh(F); phase_prologue(F);
#endif
    }
#endif
    SEAM(0);
    for (int li = 0; li < 2; ++li) {
        const int p0 = 1 + li * PH_PER_LAYER;
        const int nrows = (li == 0) ? NTOK : NLAT;
        if (IN(p0)) {
            refresh(F);
#if defined(PT_T) && PT_T >= 20 && PT_T <= 23
            const unsigned long long tn0_ = __builtin_amdgcn_s_memrealtime(); __builtin_amdgcn_s_waitcnt(0xC07F);
#endif
            if (li == 0) phase_norm1<2>(F, li, 0); else phase_norm1<1>(F, li, 1);
#if defined(PT_T) && PT_T >= 20 && PT_T <= 23
            __syncthreads();
            const unsigned long long tn1_ = __builtin_amdgcn_s_memrealtime(); __builtin_amdgcn_s_waitcnt(0xC07F);
            if (threadIdx.x == 0 && PT_T == 20 + li) atomicAdd((unsigned long long*)(F.ctl + 13000), tn1_ - tn0_);
#endif
#ifdef PROBE_N1
            if (li == 0) { refresh(F); phase_norm1<2>(F, li, 0); }
#endif
            refresh(F);
#ifndef SKIP_FILT
            for (int t = F.bid; t < 256; t += F.G) filter_tile(F, li, S, t, WSP(_Float16, WS_FILT), WSP(float, WS_FPART));
            if (li == 0) for (int t = F.bid; t < 4; t += F.G) filter_tile(F, li, CTX, t, WSP(_Float16, WS_FILTC), WSP(float, WS_FPARTC));
#ifdef PROBE_MISC
            for (int t = F.bid; t < 256; t += F.G) filter_tile(F, li, S, t, WSP(_Float16, WS_FILT), WSP(float, WS_FPART));
#endif
#endif
#if defined(PT_T) && PT_T >= 20 && PT_T <= 23
            { __syncthreads(); const unsigned long long tn2_ = __builtin_amdgcn_s_memrealtime(); __builtin_amdgcn_s_waitcnt(0xC07F);
              if (threadIdx.x == 0 && PT_T == 22 + li) atomicAdd((unsigned long long*)(F.ctl + 13000), tn2_ - tn1_); }
#endif
        }
        SEAM(p0);
        if (IN(p0 + 1)) {
            refresh(F);
            pg8::Gemm g{WSP(bf16_t, WS_HBF), WSP(bf16_t, WS_WIN) + (size_t)li * DIN * D, D, 0};
            pg8::StaticOrder So; So.init(NTOK, DIN, F.G, F.bid);
            EpiIn E{F.ws, WSP(float, WS_ROPE), F.ctl + CW_KMAX + li * 16, F.ctl + CW_KMAXB + li * 16};
#ifndef SKIP_G1
            pg8::gemm_phase<EpiIn, pg8::StaticOrder>((LAS unsigned char*)smem, g, So, E, F.tid);
#ifdef PROBE_G1
            __syncthreads(); refresh(F); pg8::gemm_phase<EpiIn, pg8::StaticOrder>((LAS unsigned char*)smem, g, So, E, F.tid);
#endif
#endif
        }
        SEAM(p0 + 1);
        if (IN(p0 + 2)) { refresh(F); phase_mix(F, li); }
#if defined(PT_T) && PT_T == 11
        { const unsigned long long ta_ = __builtin_amdgcn_s_memrealtime(); __builtin_amdgcn_s_waitcnt(0xC07F);
          SEAM(p0 + 2);
          const unsigned long long tb_ = __builtin_amdgcn_s_memrealtime(); __builtin_amdgcn_s_waitcnt(0xC07F);
          if (threadIdx.x == 0) atomicAdd((unsigned long long*)(F.ctl + 13000), tb_ - ta_); }
#else
        SEAM(p0 + 2);
#endif
        if (IN(p0 + 3)) {
            refresh(F);
            pg8::Gemm g{WSP(bf16_t, WS_HBF), WSP(bf16_t, WS_WOUT) + (size_t)li * D * D, D, 0};
            pg8::StaticOrder So; So.init(NLAT, D, F.G, F.bid);
            EpiOut E{F.in[I_X], F.in[I_CTX], WSP(bf16_t, WS_XB), WSP(float, WS_MOD) + (size_t)li * 3 * 6144, li == 0};
#ifndef SKIP_G2
            pg8::gemm_phase<EpiOut, pg8::StaticOrder, true>((LAS unsigned char*)smem, g, So, E, F.tid);
#endif
        }
        SEAM(p0 + 3);
#ifndef SKIP_N2
        if (IN(p0 + 4)) { refresh(F); phase_norm2(F, li, nrows); }
#endif
        SEAM(p0 + 4);
        if (IN(p0 + 5)) { refresh(F); phase_gather(F, li, nrows);
#ifdef PROBE_MISC
            __syncthreads(); refresh(F); phase_gather(F, li, nrows);
#endif
        }
        SEAM(p0 + 5);
        if (IN(p0 + 6)) {
            refresh(F);
            int* offs = (int*)(smem + LDS_MISC + 64);
            moe_offsets(F, li, offs);
            pg8::Gemm g{WSP(bf16_t, WS_HBF), WSP(bf16_t, WS_W13) + (size_t)li * NE * 1024 * 1024, D, (size_t)1024 * 1024};
            pg8::MoeOrder Mo{offs + 40, offs[17 + 16], 4, F.G, (F.G % 8 == 0) ? (F.bid % 8) * (F.G / 8) + F.bid / 8 : F.bid};
            EpiMoe1 E{WSP(bf16_t, WS_HMID)};
#ifndef SKIP_G3
            pg8::gemm_phase_gather<EpiMoe1, pg8::MoeOrder>((LAS unsigned char*)smem, g, Mo, E, F.tid, WSP(int, WS_RMAP));
#endif
        }
        SEAM(p0 + 6);
        if (IN(p0 + 7)) {
            refresh(F);
            int* offs = (int*)(smem + LDS_MISC + 64);
            moe_offsets(F, li, offs);
            pg8::Gemm g{WSP(bf16_t, WS_HMID), WSP(bf16_t, WS_W2) + (size_t)li * NE * 1024 * 512, DE, (size_t)1024 * 512};
            pg8::MoeOrder Mo{offs + 40, offs[17 + 16], 4, F.G, (F.G % 8 == 0) ? (F.bid % 8) * (F.G / 8) + F.bid / 8 : F.bid};
            EpiMoe2 E{WSP(bf16_t, WS_A1)};
#ifndef SKIP_G4
            pg8::gemm_phase<EpiMoe2, pg8::MoeOrder, true>((LAS unsigned char*)smem, g, Mo, E, F.tid);
#ifdef PROBE_G4
            __syncthreads(); refresh(F); pg8::gemm_phase<EpiMoe2, pg8::MoeOrder>((LAS unsigned char*)smem, g, Mo, E, F.tid);
#endif
#endif
        }
        SEAM(p0 + 7);
    }
    if (IN(NPH - 1)) { refresh(F); phase_norm1<2>(F, 1, 2); }
#ifdef PT_T
    asm volatile("s_waitcnt vmcnt(0)" ::: "memory"); __syncthreads();
    PT_MARK(NPH - 1);
#if PT_T >= 11
    xcd_barrier(bar);
    pt_acc = __hip_atomic_load((unsigned long long*)(F.ctl + 13000), __ATOMIC_RELAXED, __HIP_MEMORY_SCOPE_AGENT) / (unsigned long long)F.G;
    pt_last = __builtin_amdgcn_s_memrealtime();
#endif
    if (F.bid == 0) { const unsigned long long until = pt_last + (unsigned long long)PT_MULT * pt_acc;
        while (__builtin_amdgcn_s_memrealtime() < until) __builtin_amdgcn_s_sleep(8); }
#endif
#undef IN
#undef SEAM
}

extern "C" void kernel_launch(void* const* d_in, const int* in_sizes, int n_in, void* d_out, int out_size, void* d_ws, size_t ws_size, hipStream_t stream) {
    static int grid = 0;
    if (grid == 0) {
        if (n_in != N_IN || out_size != NLAT * D || ws_size < WS_END) { fprintf(stderr, "kernel_launch: unexpected shapes (n_in %d out %d ws %zu need %zu)\n", n_in, out_size, ws_size, (size_t)WS_END); grid = -1; return; }
        int dev = 0, cus = 0, per_cu = 0;
        if (hipGetDevice(&dev) != hipSuccess || hipDeviceGetAttribute(&cus, hipDeviceAttributeMultiprocessorCount, dev) != hipSuccess) { grid = -1; return; }
        if (hipFuncSetAttribute((const void*)mega, hipFuncAttributeMaxDynamicSharedMemorySize, LDS_BYTES) != hipSuccess) { fprintf(stderr, "kernel_launch: hipFuncSetAttribute failed\n"); grid = -1; return; }
        if (hipOccupancyMaxActiveBlocksPerMultiprocessor(&per_cu, (const void*)mega, NTHR, LDS_BYTES) != hipSuccess || per_cu < 1) { fprintf(stderr, "kernel_launch: occupancy query says %d\n", per_cu); }
        (void)hipGetLastError();
        grid = cus < MAXG ? cus : MAXG;
    }
    if (grid < 0) return;
    (void)hipMemsetAsync((char*)d_ws + WS_CTL, 0, CTL_BYTES, stream);
    Args a{};
    for (int i = 0; i < N_IN; ++i) a.in[i] = (const float*)d_in[i];
    a.out = (float*)d_out; a.ws = (unsigned char*)d_ws;
#if N_LAUNCH_MODE == 1
    a.ph_lo = 0; a.ph_hi = NPH;
    hipLaunchKernelGGL(mega, dim3(grid), dim3(NTHR), LDS_BYTES, stream, a);
#else
    for (int p = 0; p < NPH; ++p) { a.ph_lo = p; a.ph_hi = p + 1; hipLaunchKernelGGL(mega, dim3(grid), dim3(NTHR), LDS_BYTES, stream, a); }
#endif
}
#ifdef TEST_UNITS
__global__ void __launch_bounds__(NTHR, 2) t_da(Args args) {
    extern __shared__ __attribute__((aligned(16))) unsigned char smem[];
    Frame F; F.in = args.in; F.out = args.out; F.ws = args.ws; F.ctl = (unsigned*)(args.ws + WS_CTL); F.lds = smem; F.G = gridDim.x; F.bid = blockIdx.x; refresh(F);
    diffattn_unit(F, args.ph_lo, blockIdx.x >> 8, (blockIdx.x >> 6) & 3, (size_t)(blockIdx.x & 63) * 256, NKEY / 128);
}
__global__ void __launch_bounds__(NTHR, 2) t_hy(Args args) {
    extern __shared__ __attribute__((aligned(16))) unsigned char smem[];
    Frame F; F.in = args.in; F.out = args.out; F.ws = args.ws; F.ctl = (unsigned*)(args.ws + WS_CTL); F.lds = smem; F.G = gridDim.x; F.bid = blockIdx.x; refresh(F);
    hyena_fft_unit(F, args.ph_lo, blockIdx.x);
}
#endif
```
